# Optimizing an MI355X kernel written in HIP

```python
import math
import jax
import jax.numpy as jnp
from jax import lax
import numpy as np

D_MODEL = 1024
BATCH = 2
SEQ = 8192
DEPTH = 2

GRID_W = 64
CTX_LEN = 256
N_MIXERS = 4
GROUP_W = D_MODEL // N_MIXERS
HEAD_DIM = 64
N_HEADS = GROUP_W // HEAD_DIM
CONV_K = 3
W_LORA = 16
A_LORA = 16
G_LORA = 32
RWKV_DECAY_SCALE = math.exp(-0.5)
KV_HEADS = 2
Q_PER_KV = N_HEADS // KV_HEADS
KV_W = KV_HEADS * HEAD_DIM
WINDOW = 128
ATT_BLOCK = 128
ATT_SCALE = HEAD_DIM ** -0.5
ROPE_BASE = 10000.0
MLSTM_CHUNK = 128
N_GATE_COLS = 2 * 2 * N_HEADS
PEER_HEADS = 8
N_KEYS = 128
N_EXPERTS = N_KEYS * N_KEYS
PEER_TOPK = 16
PEER_QDIM = 256
PEER_HALF = PEER_QDIM // 2
PEER_BLOCK = 128
EPS = 1e-6
F32 = jnp.float32
IN_SIZES = (GROUP_W, GROUP_W, GROUP_W,
            GROUP_W, GROUP_W, GROUP_W, W_LORA, A_LORA, G_LORA,
            GROUP_W, KV_W, KV_W,
            GROUP_W, GROUP_W, GROUP_W, GROUP_W, N_GATE_COLS)
D_IN = sum(IN_SIZES)
IN_OFFSETS = tuple(int(o) for o in np.cumsum(IN_SIZES)[:-1])

kernel_name = 'hybrid_parallel_group_peer_dit_block'


def rms_norm(x, g):
    xf = x.astype(F32)
    y = xf * lax.rsqrt(jnp.mean(xf * xf, axis=-1, keepdims=True) + EPS)
    return (y * g.astype(F32)).astype(x.dtype)


def heads(t):
    return t.reshape(t.shape[:-1] + (N_HEADS, HEAD_DIM))


def head_norm_merge(y, g):
    return rms_norm(y, g).reshape(y.shape[:-2] + (GROUP_W,))


def rope_2d(x, row, col):
    quarter = HEAD_DIM // 4
    inv = ROPE_BASE ** (-jnp.arange(quarter, dtype=F32) / quarter)
    xf = x.astype(F32)
    extra = (1,) * (x.ndim - 3)

    def rot(xa, pos):
        ang = pos.astype(F32)[:, None] * inv[None, :]
        ang = ang.reshape((1, ang.shape[0]) + extra + (quarter,))
        cos, sin = jnp.cos(ang), jnp.sin(ang)
        x1, x2 = xa[..., :quarter], xa[..., quarter:]
        return jnp.concatenate([x1 * cos - x2 * sin, x2 * cos + x1 * sin], axis=-1)

    half = HEAD_DIM // 2
    return jnp.concatenate([rot(xf[..., :half], row), rot(xf[..., half:], col)], axis=-1).astype(x.dtype)


def conv_mixer(hx, b_gate, c_gate, w, g):
    u = c_gate * hx
    up = jnp.pad(u, ((0, 0), (1, 1), (0, 0)))
    y = b_gate * (w[0] * up[:, :-2] + w[1] * up[:, 1:-1] + w[2] * up[:, 2:])
    return head_norm_merge(heads(y), g)


def rwkv_stream(r, k, v, xw, xa, xg, w0, w2, a0, a2, g2, k_k, k_a):
    kk = heads((k * k_k).astype(F32))
    kk = kk * lax.rsqrt(jnp.sum(kk * kk, axis=-1, keepdims=True) + EPS)
    g = jax.nn.sigmoid(xg) @ g2
    per_dir = []
    for d in range(2):
        decay = jnp.exp(-RWKV_DECAY_SCALE * jax.nn.sigmoid(w0[d] + jnp.tanh(xw) @ w2[d]))
        a = jax.nn.sigmoid(a0[d] + xa @ a2[d])
        kd = k * (1 + (a - 1) * k_a)
        per_dir.append((heads(decay.astype(F32)), heads(a.astype(F32)), heads(kd.astype(F32))))
    return heads(r.astype(F32)), heads(v.astype(F32)), kk, g, per_dir


def rwkv_scan(S0, r, decay, k, v, kk, a, reverse):
    xs = tuple(jnp.moveaxis(t, 1, 0) for t in (r, decay, k, v, kk, a))

    def step(S, inp):
        r_t, w_t, k_t, v_t, kk_t, a_t = inp
        sa = jnp.einsum('bhvk,bhk->bhv', S, kk_t)
        S = (S * w_t[:, :, None, :] - sa[..., None] * (kk_t * a_t)[:, :, None, :]
             + v_t[..., None] * k_t[:, :, None, :])
        return S, jnp.einsum('bhvk,bhk->bhv', S, r_t)

    S, y = lax.scan(step, S0, xs, reverse=reverse)
    return S, jnp.moveaxis(y, 0, 1)


def rwkv_mixer(lat, ctx, w0, w2, a0, a2, g2, k_k, k_a, r_k, ln_g, need_ctx):
    sc = rwkv_stream(*ctx, w0, w2, a0, a2, g2, k_k, k_a)
    sl = rwkv_stream(*lat, w0, w2, a0, a2, g2, k_k, k_a)
    B = sl[0].shape[0]
    zero = jnp.zeros((B, N_HEADS, HEAD_DIM, HEAD_DIM), F32)
    ys_c, ys_l = [], []
    for d in range(2):
        dec_c, a_c, k_c = sc[4][d]
        S_c, y_c = rwkv_scan(zero, sc[0], dec_c, k_c, sc[1], sc[2], a_c, reverse=(d == 1))
        dec_l, a_l, k_l = sl[4][d]
        _, y_l = rwkv_scan(S_c, sl[0], dec_l, k_l, sl[1], sl[2], a_l, reverse=(d == 1))
        ys_c.append(y_c)
        ys_l.append(y_l)

    def finish(s, ys):
        r, v, _, g, per_dir = s
        y = rms_norm(ys[0] + ys[1], ln_g)
        bonus = (jnp.sum(r * per_dir[0][2] * r_k, axis=-1, keepdims=True)
                 + jnp.sum(r * per_dir[1][2] * r_k, axis=-1, keepdims=True)) * v
        return (y + bonus).reshape(y.shape[:-2] + (GROUP_W,)) * g

    y_lat = finish(sl, ys_l)
    y_ctx = finish(sc, ys_c) if need_ctx else None
    return y_lat, y_ctx


def attn_project(q, k, v, q_g, k_g):
    B, T, _ = q.shape
    q = rms_norm(q.reshape(B, T, KV_HEADS, Q_PER_KV, HEAD_DIM), q_g)
    k = rms_norm(k.reshape(B, T, KV_HEADS, HEAD_DIM), k_g)
    v = v.reshape(B, T, KV_HEADS, HEAD_DIM)
    return q, k, v


def latent_attention(q, k, v, kc, vc, sink):
    B, T = q.shape[:2]
    nb = T // ATT_BLOCK
    qb = q.reshape(B, nb, ATT_BLOCK, KV_HEADS, Q_PER_KV, HEAD_DIM)

    def band(t):
        tp = jnp.pad(t, ((0, 0), (ATT_BLOCK, ATT_BLOCK), (0, 0), (0, 0)))
        tp = tp.reshape(B, nb + 2, ATT_BLOCK, KV_HEADS, HEAD_DIM)
        return jnp.concatenate([tp[:, :-2], tp[:, 1:-1], tp[:, 2:]], axis=2)

    kw, vw = band(k), band(v)
    start = jnp.arange(nb)[:, None] * ATT_BLOCK
    qpos = start + jnp.arange(ATT_BLOCK)[None, :]
    kpos = start - ATT_BLOCK + jnp.arange(3 * ATT_BLOCK)[None, :]
    mask = ((jnp.abs(qpos[:, :, None] - kpos[:, None, :]) <= WINDOW)
            & (kpos[:, None, :] >= 0) & (kpos[:, None, :] < T))
    s_loc = jnp.einsum('bnqhgd,bnkhd->bhgnqk', qb, kw).astype(F32) * ATT_SCALE
    s_loc = jnp.where(mask, s_loc, -jnp.inf)
    s_ctx = jnp.einsum('bnqhgd,bchd->bhgnqc', qb, kc).astype(F32) * ATT_SCALE
    sk = jnp.broadcast_to(sink.astype(F32).reshape(KV_HEADS, Q_PER_KV, 1, 1, 1), s_loc.shape[:-1] + (1,))
    p = jax.nn.softmax(jnp.concatenate([s_loc, s_ctx, sk], axis=-1), axis=-1).astype(v.dtype)
    nw = 3 * ATT_BLOCK
    o = (jnp.einsum('bhgnqk,bnkhd->bnqhgd', p[..., :nw], vw)
         + jnp.einsum('bhgnqc,bchd->bnqhgd', p[..., nw:-1], vc))
    return o.reshape(B, T, N_HEADS, HEAD_DIM)


def ctx_attention(qc, kc, vc, sink):
    s = jnp.einsum('bqhgd,bchd->bhgqc', qc, kc).astype(F32) * ATT_SCALE
    sk = jnp.broadcast_to(sink.astype(F32).reshape(KV_HEADS, Q_PER_KV, 1, 1), s.shape[:-1] + (1,))
    p = jax.nn.softmax(jnp.concatenate([s, sk], axis=-1), axis=-1)[..., :-1].astype(vc.dtype)
    o = jnp.einsum('bhgqc,bchd->bqhgd', p, vc)
    return o.reshape(qc.shape[0], qc.shape[1], N_HEADS, HEAD_DIM)


def mlstm_chunk_scan(state, q, k, v, logi, logf):
    B, H, T, Dh = q.shape
    L = MLSTM_CHUNK
    nc = T // L

    def chunks(t):
        return jnp.moveaxis(t.reshape((B, H, nc, L) + t.shape[3:]), 2, 0)

    xs = (chunks(q), chunks(k), chunks(v), chunks(logi), chunks(logf))
    causal = jnp.tril(jnp.ones((L, L), dtype=bool))

    def step(carry, inp):
        C, n, m = carry
        qc, kc, vc, li, lf = inp
        b = jnp.cumsum(lf, axis=-1)
        d_intra = jnp.where(causal, b[..., :, None] - b[..., None, :] + li[..., None, :], -jnp.inf)
        d_inter = b + m[..., None]
        m_t = jnp.maximum(jnp.max(d_intra, axis=-1), d_inter)
        w_intra = jnp.exp(d_intra - m_t[..., None])
        w_inter = jnp.exp(d_inter - m_t)
        s = jnp.einsum('bhtd,bhsd->bhts', qc, kc) * w_intra
        num = (jnp.einsum('bhts,bhsd->bhtd', s, vc)
               + w_inter[..., None] * jnp.einsum('bhvk,bhtk->bhtv', C, qc))
        den = jnp.sum(s, axis=-1) + w_inter * jnp.einsum('bhk,bhtk->bht', n, qc)
        h = num / jnp.maximum(jnp.abs(den), jnp.exp(-m_t))[..., None]
        b_end = b[..., -1]
        d_end = b_end[..., None] - b + li
        m_new = jnp.maximum(b_end + m, jnp.max(d_end, axis=-1))
        w_end = jnp.exp(d_end - m_new[..., None])
        carry_decay = jnp.exp(b_end + m - m_new)
        C = carry_decay[..., None, None] * C + jnp.einsum('bhs,bhsv,bhsk->bhvk', w_end, vc, kc)
        n = carry_decay[..., None] * n + jnp.einsum('bhs,bhsk->bhk', w_end, kc)
        return (C, n, m_new), h

    state, h = lax.scan(step, state, xs)
    return state, jnp.moveaxis(h, 0, 2).reshape(B, H, T, Dh)


def mlstm_stream(q, k, v, o, gates, i_b, f_b):
    B, T, _ = q.shape

    def th(t):
        return jnp.moveaxis(heads(t.astype(F32)), 2, 1)

    gates = gates.astype(F32).reshape(B, T, 2, 2, N_HEADS) + jnp.stack([i_b, f_b], axis=1).astype(F32)
    gates = jnp.moveaxis(gates, 1, -1)
    logi = gates[:, :, 0]
    logf = jax.nn.log_sigmoid(gates[:, :, 1])
    return th(q), th(k) * (HEAD_DIM ** -0.5), th(v), jax.nn.sigmoid(o), logi, logf


def mlstm_mixer(lat, ctx, i_b, f_b, out_g, need_ctx):
    sc = mlstm_stream(*ctx, i_b, f_b)
    sl = mlstm_stream(*lat, i_b, f_b)
    B = sl[0].shape[0]
    zero = (jnp.zeros((B, N_HEADS, HEAD_DIM, HEAD_DIM), F32),
            jnp.zeros((B, N_HEADS, HEAD_DIM), F32),
            jnp.zeros((B, N_HEADS), F32))

    def flip(t):
        return jnp.flip(t, axis=2)

    def run(state, s, d):
        q, k, v, _, logi, logf = s
        li, lf = logi[:, d], logf[:, d]
        if d == 0:
            return mlstm_chunk_scan(state, q, k, v, li, lf)
        st, h = mlstm_chunk_scan(state, flip(q), flip(k), flip(v), flip(li), flip(lf))
        return st, flip(h)

    h_c, h_l = [], []
    for d in range(2):
        st, hc = run(zero, sc, d)
        _, hl = run(st, sl, d)
        h_c.append(hc)
        h_l.append(hl)

    def finish(s, hs):
        h = jnp.moveaxis(hs[0] + hs[1], 1, 2)
        return s[3] * head_norm_merge(h, out_g)

    y_lat = finish(sl, h_l)
    y_ctx = finish(sc, h_c) if need_ctx else None
    return y_lat, y_ctx


def peer_ffn(h, w_q, sub_keys, u, v):
    B, T, D = h.shape
    M = B * T
    hf = h.reshape(M, D)
    q = (hf @ w_q).astype(F32).reshape(M, PEER_HEADS, 2, PEER_HALF)
    s = jnp.einsum('mhpd,hpkd->mhpk', q, sub_keys.astype(F32))
    sv, si = lax.top_k(s, PEER_TOPK)
    n_cand = PEER_TOPK * PEER_TOPK
    cand = (sv[:, :, 0, :, None] + sv[:, :, 1, None, :]).reshape(M, PEER_HEADS, n_cand)
    cidx = (si[:, :, 0, :, None] * N_KEYS + si[:, :, 1, None, :]).reshape(M, PEER_HEADS, n_cand)
    tv, ti = lax.top_k(cand, PEER_TOPK)
    experts = jnp.take_along_axis(cidx, ti, axis=-1)
    gates = jax.nn.softmax(tv, axis=-1)
    nblk = M // PEER_BLOCK

    def block(args):
        hb, eb, gb = args
        act = jax.nn.gelu(jnp.einsum('mhkd,md->mhk', u[eb], hb).astype(F32))
        return jnp.einsum('mhk,mhkd->md', (gb * act).astype(v.dtype), v[eb])

    out = lax.map(block, (hf.reshape(nblk, PEER_BLOCK, D),
                          experts.reshape(nblk, PEER_BLOCK, PEER_HEADS, PEER_TOPK),
                          gates.reshape(nblk, PEER_BLOCK, PEER_HEADS, PEER_TOPK)))
    return out.reshape(B, T, D).astype(h.dtype)


def setup_inputs(seed: int = 0) -> dict:
    key = jax.random.key(seed)
    ks = jax.random.split(key, 40)
    L, D = DEPTH, D_MODEL

    def nrm(i, shape, scale):
        return scale * jax.random.normal(ks[i], shape, F32)

    return {
        'x': nrm(0, (BATCH, SEQ, D), 1.0),
        'c': nrm(1, (BATCH, D), 1.0),
        'ctx': nrm(2, (BATCH, CTX_LEN, D), 1.0),
        'c_ctx': nrm(3, (D,), 1.0),
        'ada_w': nrm(4, (L, D, 6 * D), 0.5 * D ** -0.5),
        'ada_b': nrm(5, (L, 6 * D), 0.02),
        'norm1_g': 1.0 + nrm(6, (L, D), 0.02),
        'norm2_g': 1.0 + nrm(7, (L, D), 0.02),
        'w_in': nrm(8, (L, D, D_IN), D ** -0.5),
        'w_out': nrm(9, (L, D, D), D ** -0.5),
        'conv_w': nrm(10, (L, CONV_K, GROUP_W), CONV_K ** -0.5),
        'conv_g': 1.0 + nrm(11, (L, N_HEADS, HEAD_DIM), 0.02),
        'rwkv_w0': nrm(12, (L, 2, GROUP_W), 0.5),
        'rwkv_w2': nrm(13, (L, 2, W_LORA, GROUP_W), W_LORA ** -0.5),
        'rwkv_a0': nrm(14, (L, 2, GROUP_W), 0.5),
        'rwkv_a2': nrm(15, (L, 2, A_LORA, GROUP_W), A_LORA ** -0.5),
        'rwkv_g2': nrm(16, (L, G_LORA, GROUP_W), G_LORA ** -0.5),
        'rwkv_kk': 0.85 + nrm(17, (L, GROUP_W), 0.05),
        'rwkv_ka': 1.0 + nrm(18, (L, GROUP_W), 0.05),
        'rwkv_rk': nrm(19, (L, N_HEADS, HEAD_DIM), 0.1),
        'rwkv_ln_g': 1.0 + nrm(20, (L, N_HEADS, HEAD_DIM), 0.02),
        'att_q_g': 1.0 + nrm(21, (L, HEAD_DIM), 0.02),
        'att_k_g': 1.0 + nrm(22, (L, HEAD_DIM), 0.02),
        'att_sink': nrm(23, (L, N_HEADS), 0.5),
        'att_out_g': 1.0 + nrm(24, (L, N_HEADS, HEAD_DIM), 0.02),
        'ml_i_b': nrm(25, (L, 2, N_HEADS), 0.1),
        'ml_f_b': 3.0 + nrm(26, (L, 2, N_HEADS), 0.5),
        'ml_out_g': 1.0 + nrm(27, (L, N_HEADS, HEAD_DIM), 0.02),
        'peer_wq': nrm(28, (L, D, PEER_HEADS * PEER_QDIM), D ** -0.5),
        'peer_keys': nrm(29, (L, PEER_HEADS, 2, N_KEYS, PEER_HALF), PEER_HALF ** -0.5),
        'peer_u': nrm(30, (L, N_EXPERTS, D), D ** -0.5),
        'peer_v': nrm(31, (L, N_EXPERTS, D), PEER_HEADS ** -0.5),
    }


def reference(x, c, ctx, c_ctx, ada_w, ada_b, norm1_g, norm2_g, w_in, w_out, conv_w, conv_g,
              rwkv_w0, rwkv_w2, rwkv_a0, rwkv_a2, rwkv_g2, rwkv_kk, rwkv_ka, rwkv_rk, rwkv_ln_g,
              att_q_g, att_k_g, att_sink, att_out_g, ml_i_b, ml_f_b, ml_out_g,
              peer_wq, peer_keys, peer_u, peer_v):
    B, T, D = x.shape
    ROWS = T // GRID_W
    row = jnp.repeat(jnp.arange(ROWS), GRID_W)
    col = jnp.arange(ROWS * GRID_W) % GRID_W
    for l in range(DEPTH):
        need_ctx = l < DEPTH - 1
        mod = jax.nn.silu(c) @ ada_w[l] + ada_b[l]
        mod_c = jax.nn.silu(c_ctx) @ ada_w[l] + ada_b[l]
        sh1, sc1, gt1, sh2, sc2, gt2 = jnp.split(mod[:, None, :], 6, axis=-1)
        csh1, csc1, cgt1, csh2, csc2, cgt2 = jnp.split(mod_c, 6, axis=-1)

        h = rms_norm(x, norm1_g[l]) * (1 + sc1) + sh1
        hc = rms_norm(ctx, norm1_g[l]) * (1 + csc1) + csh1
        P = jnp.split(h @ w_in[l], IN_OFFSETS, axis=-1)
        Pc = jnp.split(hc @ w_in[l], IN_OFFSETS, axis=-1)

        y_a = conv_mixer(P[0], P[1], P[2], conv_w[l], conv_g[l])
        y_b, yc_b = rwkv_mixer(P[3:9], Pc[3:9], rwkv_w0[l], rwkv_w2[l], rwkv_a0[l], rwkv_a2[l],
                               rwkv_g2[l], rwkv_kk[l], rwkv_ka[l], rwkv_rk[l], rwkv_ln_g[l], need_ctx)
        q, k, v = attn_project(P[9], P[10], P[11], att_q_g[l], att_k_g[l])
        q, k = rope_2d(q, row, col), rope_2d(k, row, col)
        qc, kc, vc = attn_project(Pc[9], Pc[10], Pc[11], att_q_g[l], att_k_g[l])
        y_c = head_norm_merge(latent_attention(q, k, v, kc, vc, att_sink[l]), att_out_g[l])
        y_d, yc_d = mlstm_mixer(P[12:17], Pc[12:17], ml_i_b[l], ml_f_b[l], ml_out_g[l], need_ctx)

        y = jnp.concatenate([t.astype(x.dtype) for t in (y_a, y_b, y_c, y_d)], axis=-1) @ w_out[l]
        x = x + gt1 * y
        h2 = rms_norm(x, norm2_g[l]) * (1 + sc2) + sh2
        x = x + gt2 * peer_ffn(h2, peer_wq[l], peer_keys[l], peer_u[l], peer_v[l])

        if need_ctx:
            yc_a = conv_mixer(Pc[0], Pc[1], Pc[2], conv_w[l], conv_g[l])
            yc_c = head_norm_merge(ctx_attention(qc, kc, vc, att_sink[l]), att_out_g[l])
            yc = jnp.concatenate([t.astype(ctx.dtype) for t in (yc_a, yc_b, yc_c, yc_d)], axis=-1) @ w_out[l]
            ctx = ctx + cgt1 * yc
            hc2 = rms_norm(ctx, norm2_g[l]) * (1 + csc2) + csh2
            ctx = ctx + cgt2 * peer_ffn(hc2, peer_wq[l], peer_keys[l], peer_u[l], peer_v[l])
    return x
```

```cpp
#include <hip/hip_runtime.h>
#include <cstdio>
#include <cstdint>

#ifndef MK_MULTI
#define MK_MULTI 0
#endif
namespace pg8 {
#define PG8_LAS __attribute__((address_space(3)))
typedef unsigned short bf16_t;
typedef short bf16x8 __attribute__((ext_vector_type(8)));
typedef float f32x4 __attribute__((ext_vector_type(4)));
typedef unsigned u32x4 __attribute__((ext_vector_type(4)));
constexpr int BM = 256, BK = 64, HALF = 128, HTB = HALF * BK * 2  , STAGE_BYTES = 8 * HTB, NXCD = 8, WGM = 8;

__host__ __device__ __forceinline__ int lds_byte(int r, int c) { const int st = (r >> 4) * 2 + (c >> 5), rr = r & 15, cc = c & 31, ob = rr * 64 + cc * 2; return st * 1024 + (ob ^ (((ob >> 9) & 1) << 5)); }
__host__ __device__ __forceinline__ void stage_rc(int b, int& R, int& C) { const int st = b / 1024, sb = b % 1024, swz = sb ^ (((sb >> 9) & 1) << 5); R = (st >> 1) * 16 + swz / 64; C = (st & 1) * 32 + (swz % 64) / 2; }
__host__ __device__ __forceinline__ int perm32(int rho) { const int n = rho >> 4, i = rho & 15; return 8 * (i >> 2) + 4 * n + (i & 3); }

struct Unit { int pm, pn; };
struct Gemm { const bf16_t* A; const bf16_t* Bt; int M, N, K; };

struct StaticOrder {
    int nM, nN, nwg, G, c;
    __host__ __device__ void init(int M, int N, int G_, int c_) { nM = M / BM; nN = N / BM; nwg = nM * nN; G = G_; c = c_; }
    __host__ __device__ bool next(int i, Unit& u) const {
        const long L = (long)i * G + c; if (L >= nwg) return false;
        int wgid = (int)L; { const int q = nwg / NXCD, r = nwg % NXCD, xcd = wgid % NXCD, off = wgid / NXCD; wgid = (xcd < r ? xcd * (q + 1) : r * (q + 1) + (xcd - r) * q) + off; }
        const int nig = WGM * nN, gid = wgid / nig, fm = gid * WGM, gsz = (nM - fm) < WGM ? (nM - fm) : WGM;
        u.pm = fm + ((wgid % nig) % gsz); u.pn = (wgid % nig) / gsz; return true;
    }
    __device__ __forceinline__ void a_ready(const Unit&) const {}
    __device__ __forceinline__ void done(const Unit&) const {}
};

__device__ __forceinline__ unsigned cvt_pk_bf16(float lo, float hi) { unsigned r; asm volatile("v_cvt_pk_bf16_f32 %0, %1, %2" : "=v"(r) : "v"(lo), "v"(hi)); return r; }

struct EpiBf16 {
    static constexpr bool PERM = true, AFTER_DRAIN = false;
    bf16_t* O; int ldc;
    __device__ __forceinline__ void operator()(const f32x4 (&acc)[2][2][4][2], const Unit& u, int wr, int wc, int fr, int fq) const {
        const int row0 = u.pm * BM + wr * 64 + fr; const int col0 = u.pn * BM + wc * 32 + 8 * fq;
#pragma unroll
        for (int ai = 0; ai < 2; ++ai)
#pragma unroll
            for (int m = 0; m < 4; ++m) { bf16_t* rowp = O + (size_t)(row0 + ai * HALF + m * 16) * ldc + col0;
#pragma unroll
                for (int bj = 0; bj < 2; ++bj) { const f32x4 v0 = acc[ai][bj][m][0], v1 = acc[ai][bj][m][1];
                    u32x4 w; w.x = cvt_pk_bf16(v0[0], v0[1]); w.y = cvt_pk_bf16(v0[2], v0[3]); w.z = cvt_pk_bf16(v1[0], v1[1]); w.w = cvt_pk_bf16(v1[2], v1[3]);
                    *(u32x4*)(rowp + bj * HALF) = w; } }
    }
};
struct EpiF32 {
    static constexpr bool PERM = false, AFTER_DRAIN = false;
    float* O; int ldc;
    __device__ __forceinline__ void operator()(const f32x4 (&acc)[2][2][4][2], const Unit& u, int wr, int wc, int fr, int fq) const {
        const int row0 = u.pm * BM + wr * 64 + fr; const int col0 = u.pn * BM + wc * 32 + 4 * fq;
#pragma unroll
        for (int ai = 0; ai < 2; ++ai)
#pragma unroll
            for (int m = 0; m < 4; ++m) { float* rowp = O + (size_t)(row0 + ai * HALF + m * 16) * ldc + col0;
#pragma unroll
                for (int bj = 0; bj < 2; ++bj)
#pragma unroll
                    for (int n = 0; n < 2; ++n) *(f32x4*)(rowp + bj * HALF + n * 16) = acc[ai][bj][m][n]; }
    }
};
struct EpiRes {
    static constexpr bool PERM = false, AFTER_DRAIN = false;
    const float* src_lat; const float* src_ctx; float* dst_lat; float* dst_ctx; const float* gate;
    __device__ __forceinline__ void operator()(const f32x4 (&acc)[2][2][4][2], const Unit& u, int wr, int wc, int fr, int fq) const {
        const bool isc = u.pm >= 64; const int smp = isc ? 2 : (u.pm >> 5);
        const int prow = (isc ? (u.pm - 64) * BM : u.pm * BM) + wr * 64 + fr;
        const float* src = isc ? src_ctx : src_lat; float* dst = isc ? dst_ctx : dst_lat;
        const float* gt = gate + smp * 6144 + 2048;
        const int col0 = u.pn * BM + wc * 32 + 4 * fq;
        f32x4 gv[2][2];
#pragma unroll
        for (int bj = 0; bj < 2; ++bj)
#pragma unroll
            for (int n = 0; n < 2; ++n) gv[bj][n] = *(const f32x4*)(gt + col0 + bj * HALF + n * 16);
#pragma unroll
        for (int ai = 0; ai < 2; ++ai)
#pragma unroll
            for (int m = 0; m < 4; ++m) { const size_t off = (size_t)(prow + ai * HALF + m * 16) * 1024 + col0;
#pragma unroll
                for (int bj = 0; bj < 2; ++bj)
#pragma unroll
                    for (int n = 0; n < 2; ++n) { const f32x4 s = *(const f32x4*)(src + off + bj * HALF + n * 16);
                        *(f32x4*)(dst + off + bj * HALF + n * 16) = s + gv[bj][n] * acc[ai][bj][m][n]; } }
    }
};

template <class Epi, class Sched, bool ALIGN_EPI = false, bool SP2 = false>
__device__ __forceinline__ void gemm_phase(PG8_LAS unsigned char* lds, const Gemm g, const Sched& S, const Epi& E, const int tid) {
    const int wid = __builtin_amdgcn_readfirstlane(tid >> 6), lane = tid & 63, wr = wid >> 2, wc = wid & 3, fr = lane & 15, fq = lane >> 4;
    const int K = g.K, nt = K / BK;
    unsigned voffA[2], voffB[2];
#pragma unroll
    for (int i = 0; i < 2; ++i) { int R, C; stage_rc(tid * 16 + i * 8192, R, C); const int Rb = Epi::PERM ? ((R & ~31) + perm32(R & 31)) : R;
        voffA[i] = (unsigned)(R * K + C) * 2u; voffB[i] = (unsigned)(Rb * K + C) * 2u; }
    const size_t kstep = (size_t)(BK * 2);
    const size_t hstep = (size_t)HALF * K * 2;
    const size_t tstep = 2 * hstep;
    const unsigned ldsw = (unsigned)wid * 1024u;
    const int aoff = lds_byte(wr * 64 + fr, fq * 8), boff = lds_byte(wc * 32 + fr, fq * 8);
#define PG8_SA(b, h) (((b) * 2 + (h)) * HTB)
#define PG8_SB(b, h) ((4 + (b) * 2 + (h)) * HTB)
#define PG8_STAGE(bufoff, gbase, voff) do { _Pragma("unroll") for (int _i = 0; _i < 2; ++_i) \
        __builtin_amdgcn_global_load_lds((const unsigned*)((const char*)(gbase) + (voff)[_i]), (PG8_LAS unsigned*)(lds + (bufoff) + ldsw + _i * 8192), 16, 0, 0); } while (0)
#define PG8_LDA(dst, b, h) do { _Pragma("unroll") for (int m = 0; m < 4; ++m) _Pragma("unroll") for (int k = 0; k < 2; ++k) dst[m][k] = *(const PG8_LAS bf16x8*)(lds + PG8_SA(b, h) + aoff + m * 2048 + k * 1024); } while (0)
#define PG8_LDB(dst, b, h) do { _Pragma("unroll") for (int n = 0; n < 2; ++n) _Pragma("unroll") for (int k = 0; k < 2; ++k) dst[n][k] = *(const PG8_LAS bf16x8*)(lds + PG8_SB(b, h) + boff + n * 2048 + k * 1024); } while (0)
#define PG8_MMA(ai, bj, At, Bt) do { __builtin_amdgcn_s_setprio(1); _Pragma("unroll") for (int m = 0; m < 4; ++m) _Pragma("unroll") for (int n = 0; n < 2; ++n) _Pragma("unroll") for (int k = 0; k < 2; ++k) \
        acc[ai][bj][m][n] = __builtin_amdgcn_mfma_f32_16x16x32_bf16(Bt[n][k], At[m][k], acc[ai][bj][m][n], 0, 0, 0); __builtin_amdgcn_s_setprio(0); } while (0)
#define PG8_WAIT_V(n) asm volatile("s_waitcnt vmcnt(" #n ")" ::: "memory")
#define PG8_WAIT_L(n) asm volatile("s_waitcnt lgkmcnt(" #n ")" ::: "memory")
#define PG8_BAR __builtin_amdgcn_s_barrier()
#define PG8_SCHED __builtin_amdgcn_sched_barrier(0)
    Unit cur, nxt; int ui = 0;
    if (!S.next(0, cur)) return;
    f32x4 acc[2][2][4][2];
#pragma unroll
    for (int a = 0; a < 2; ++a)
#pragma unroll
        for (int b = 0; b < 2; ++b)
#pragma unroll
            for (int m = 0; m < 4; ++m)
#pragma unroll
                for (int n = 0; n < 2; ++n) acc[a][b][m][n] = (f32x4){0.f, 0.f, 0.f, 0.f};
    bf16x8 At[4][2], B0[2][2], B1[2][2];
    const char* cA = (const char*)g.A + (size_t)cur.pm * tstep; const char* cB = (const char*)g.Bt + (size_t)cur.pn * tstep;
    S.a_ready(cur);
    if constexpr (SP2) {
        PG8_STAGE(PG8_SB(0, 0), cB, voffB); PG8_STAGE(PG8_SB(0, 1), cB + hstep, voffB); PG8_STAGE(PG8_SA(0, 0), cA, voffA); PG8_STAGE(PG8_SA(0, 1), cA + hstep, voffA);
        if (wr == 1) PG8_BAR;
        PG8_WAIT_V(2); PG8_BAR;
        PG8_STAGE(PG8_SB(1, 0), cB + kstep, voffB); PG8_STAGE(PG8_SA(1, 0), cA + kstep, voffA); PG8_STAGE(PG8_SB(1, 1), cB + hstep + kstep, voffB);
        PG8_WAIT_V(6); PG8_BAR;
    } else {
        PG8_STAGE(PG8_SB(0, 0), cB, voffB); PG8_STAGE(PG8_SA(0, 0), cA, voffA); PG8_STAGE(PG8_SB(0, 1), cB + hstep, voffB); PG8_STAGE(PG8_SA(0, 1), cA + hstep, voffA);
        if (wr == 1) PG8_BAR;
        PG8_WAIT_V(4); PG8_BAR;
        PG8_STAGE(PG8_SB(1, 0), cB + kstep, voffB); PG8_STAGE(PG8_SA(1, 0), cA + kstep, voffA); PG8_STAGE(PG8_SB(1, 1), cB + hstep + kstep, voffB);
        PG8_WAIT_V(6); PG8_BAR;
    }
    for (;;) {
        const bool has_next = S.next(ui + 1, nxt);
        const char* nA = has_next ? (const char*)g.A + (size_t)nxt.pm * tstep : cA; const char* nB = has_next ? (const char*)g.Bt + (size_t)nxt.pn * tstep : cB;
        for (int t = 0; t < nt; t += 2) {
            const bool last = (t == nt - 2);
            const char* a1 = cA + (size_t)(t + 1) * kstep;
            const char* a2 = last ? nA : cA + (size_t)(t + 2) * kstep; const char* b2 = last ? nB : cB + (size_t)(t + 2) * kstep;
            const char* a3 = a2 + kstep; const char* b3 = b2 + kstep;
            if (last && has_next) S.a_ready(nxt);
            if constexpr (SP2) {
            PG8_LDB(B0, 0, 0); PG8_LDB(B1, 0, 1); PG8_SCHED; PG8_LDA(At, 0, 0); PG8_STAGE(PG8_SA(1, 1), a1 + hstep, voffA);
            PG8_WAIT_V(8); PG8_WAIT_L(0); PG8_BAR; PG8_MMA(0, 0, At, B0); PG8_MMA(0, 1, At, B1); PG8_BAR; PG8_SCHED;
            PG8_LDA(At, 0, 1); PG8_STAGE(PG8_SB(0, 0), b2, voffB); PG8_STAGE(PG8_SB(0, 1), b2 + hstep, voffB); PG8_STAGE(PG8_SA(0, 0), a2, voffA);
            PG8_WAIT_V(8); PG8_WAIT_L(0); PG8_BAR; PG8_MMA(1, 0, At, B0); PG8_MMA(1, 1, At, B1); PG8_BAR; PG8_SCHED;
            PG8_LDB(B0, 1, 0); PG8_LDB(B1, 1, 1); PG8_SCHED; PG8_LDA(At, 1, 0); PG8_STAGE(PG8_SA(0, 1), a2 + hstep, voffA);
            PG8_WAIT_V(8); PG8_WAIT_L(0); PG8_BAR; PG8_MMA(0, 0, At, B0); PG8_MMA(0, 1, At, B1); PG8_BAR; PG8_SCHED;
            PG8_LDA(At, 1, 1); PG8_STAGE(PG8_SB(1, 0), b3, voffB); PG8_STAGE(PG8_SB(1, 1), b3 + hstep, voffB); PG8_STAGE(PG8_SA(1, 0), a3, voffA);
            PG8_WAIT_V(8); PG8_WAIT_L(0); PG8_BAR; PG8_MMA(1, 0, At, B0); PG8_MMA(1, 1, At, B1); PG8_BAR; PG8_SCHED;
            } else {
            PG8_LDB(B0, 0, 0); PG8_SCHED; PG8_LDA(At, 0, 0); PG8_STAGE(PG8_SA(1, 1), a1 + hstep, voffA);
            PG8_WAIT_L(8); PG8_BAR; PG8_WAIT_L(0); PG8_MMA(0, 0, At, B0); PG8_BAR; PG8_SCHED;
            PG8_LDB(B1, 0, 1); PG8_STAGE(PG8_SB(0, 0), b2, voffB);
            PG8_BAR; PG8_WAIT_L(0); PG8_MMA(0, 1, At, B1); PG8_BAR;
            PG8_LDA(At, 0, 1); PG8_STAGE(PG8_SA(0, 0), a2, voffA);
            PG8_BAR; PG8_WAIT_L(0); PG8_MMA(1, 0, At, B0); PG8_BAR; PG8_SCHED;
            PG8_STAGE(PG8_SB(0, 1), b2 + hstep, voffB);
            PG8_WAIT_V(6); PG8_BAR; PG8_MMA(1, 1, At, B1); PG8_BAR;
            PG8_LDB(B0, 1, 0); PG8_SCHED; PG8_LDA(At, 1, 0); PG8_STAGE(PG8_SA(0, 1), a2 + hstep, voffA);
            PG8_WAIT_L(8); PG8_BAR; PG8_WAIT_L(0); PG8_MMA(0, 0, At, B0); PG8_BAR; PG8_SCHED;
            PG8_LDB(B1, 1, 1); PG8_STAGE(PG8_SB(1, 0), b3, voffB);
            PG8_BAR; PG8_WAIT_L(0); PG8_MMA(0, 1, At, B1); PG8_BAR;
            PG8_LDA(At, 1, 1); PG8_STAGE(PG8_SA(1, 0), a3, voffA);
            PG8_BAR; PG8_WAIT_L(0); PG8_MMA(1, 0, At, B0); PG8_BAR; PG8_SCHED;
            PG8_STAGE(PG8_SB(1, 1), b3 + hstep, voffB);
            PG8_WAIT_V(6); PG8_BAR; PG8_MMA(1, 1, At, B1); PG8_BAR;
            }
        }
        if constexpr (ALIGN_EPI) { if (wr == 0) PG8_BAR; }
        if constexpr (!Epi::AFTER_DRAIN) { E(acc, cur, wr, wc, fr, fq); S.done(cur); }
        if (!has_next) break;
#pragma unroll
        for (int a = 0; a < 2; ++a)
#pragma unroll
            for (int b = 0; b < 2; ++b)
#pragma unroll
                for (int m = 0; m < 4; ++m)
#pragma unroll
                    for (int n = 0; n < 2; ++n) acc[a][b][m][n] = (f32x4){0.f, 0.f, 0.f, 0.f};
        cur = nxt; cA = nA; cB = nB; ++ui;
        if constexpr (ALIGN_EPI) { if (wr == 1) PG8_BAR; }
    }
    PG8_WAIT_V(0);
    if constexpr (!ALIGN_EPI) { if (wr == 0) PG8_BAR; }
    PG8_BAR;
    if constexpr (Epi::AFTER_DRAIN) { E.fused(acc, cur, wr, wc, fr, fq, lds, wid, lane); S.done(cur); }
#undef PG8_SA
#undef PG8_SB
#undef PG8_STAGE
#undef PG8_LDA
#undef PG8_LDB
#undef PG8_MMA
#undef PG8_WAIT_V
#undef PG8_WAIT_L
#undef PG8_BAR
#undef PG8_SCHED
}
}
#ifndef ZMASK
#define ZMASK 0
#endif
#define ZF(bit) ((ZMASK & (bit)) ? 0.f : 1.f)
using pg8::bf16_t; using pg8::bf16x8; using pg8::f32x4; using pg8::u32x4;
constexpr int NWAVES = 8, NTHR = 512;
constexpr int DM = 1024, TLAT = 8192, TCTX = 256, MLAT = 2 * TLAT, MCTX = 2 * TCTX, MALL = MLAT + MCTX;
constexpr int DIN = 3152, DINP = 3328;
constexpr int C_CH = 0, C_CB = 256, C_CC = 512, C_RR = 768, C_RK = 1024, C_RV = 1280, C_XW = 1536, C_XA = 1552, C_XG = 1568,
              C_AQ = 1600, C_AK = 1856, C_AV = 1984, C_MQ = 2112, C_MK = 2368, C_MV = 2624, C_MO = 2880, C_MG = 3136;
constexpr float EPSN = 1e-6f;
constexpr int NCHK = 66;
constexpr int CST = 4160;
constexpr int RWREC = 4608;
constexpr size_t MiB = 1u << 20;
constexpr size_t WS_CTL = 0, CTL_ZERO_BYTES = 1 * MiB, WS_MOD = 1 * MiB;
constexpr size_t WS_WIN = 2 * MiB, WIN_LSTRIDE = (size_t)DINP * DM * 2;
constexpr size_t WS_WOUT = 16 * MiB, WOUT_LSTRIDE = 2 * MiB;
constexpr size_t WS_WEFF = 20 * MiB, WEFF_LSTRIDE = 4 * MiB;
constexpr size_t WS_XC = 28 * MiB, WS_GA = 30 * MiB, WS_H = 32 * MiB, WS_YCAT = 65 * MiB, WS_U = 98 * MiB, WS_V = 130 * MiB;
constexpr size_t WS_P = 162 * MiB, WS_RW = 270 * MiB, WS_YR = 345 * MiB, WS_QA = 378 * MiB, WS_KA = 387 * MiB;
constexpr size_t WS_LC = 392 * MiB, WS_ST = 409 * MiB, WS_LB = 426 * MiB, WS_EG = 427 * MiB, WS_GB = 444 * MiB, WS_BS = 453 * MiB, WS_END = 454 * MiB;
constexpr size_t WS_S = WS_P;
static_assert(WS_P + (size_t)MALL * DINP * 2 <= WS_RW && WS_RW + (size_t)MALL * RWREC <= WS_YR && WS_S + (size_t)MALL * 2048 * 4 <= WS_YR, "ws map");
static_assert(WS_LC + (size_t)16 * NCHK * CST * 4 <= WS_ST && WS_ST + (size_t)16 * NCHK * CST * 4 <= WS_LB && WS_EG + (size_t)MALL * 128 * 8 <= WS_GB, "ws map 2");
constexpr int CW_BAR = 4096;
constexpr int RING_BYTES = 131072, LDSCTL_OFF = RING_BYTES, MISC_OFF = LDSCTL_OFF + 320, LDS_BYTES = 147456;

#define GAS __attribute__((address_space(1)))
#define LAS __attribute__((address_space(3)))
typedef unsigned u32x2 __attribute__((ext_vector_type(2)));
typedef float f32x2 __attribute__((ext_vector_type(2)));
typedef __bf16 bf16x2_t __attribute__((ext_vector_type(2)));
typedef GAS unsigned gu32;
#define LDS_WAIT() asm volatile("s_waitcnt lgkmcnt(0)" ::: "memory")

__device__ __forceinline__ float lo2f(unsigned w) { return __uint_as_float(w << 16); }
__device__ __forceinline__ float hi2f(unsigned w) { return __uint_as_float(w & 0xffff0000u); }
__device__ __forceinline__ float bf2f(bf16_t b) { return __uint_as_float((unsigned)b << 16); }
__device__ __forceinline__ unsigned f2bf(float f) { unsigned u = __float_as_uint(f); return (u + 0x7fffu + ((u >> 16) & 1u)) >> 16; }
__device__ __forceinline__ unsigned pk2(float lo, float hi) { return f2bf(lo) | (f2bf(hi) << 16); }
__device__ __forceinline__ f32x4 ld4bf(const bf16_t* p) { const u32x2 w = *(const u32x2*)p; return (f32x4){lo2f(w.x), hi2f(w.x), lo2f(w.y), hi2f(w.y)}; }
__device__ __forceinline__ void st4bf(bf16_t* p, f32x4 v) { u32x2 w; w.x = pk2(v[0], v[1]); w.y = pk2(v[2], v[3]); *(u32x2*)p = w; }
__device__ __forceinline__ float sigmoidf_(float x) { return 1.f / (1.f + __expf(-x)); }
__device__ __forceinline__ float tanhf_(float x) { const float e = __expf(-2.f * fabsf(x)); const float t = (1.f - e) / (1.f + e); return x < 0.f ? -t : t; }
template <int CTRL> __device__ __forceinline__ float dppf(float x) { return __int_as_float(__builtin_amdgcn_update_dpp(0, __float_as_int(x), CTRL, 0xf, 0xf, true)); }
__device__ __forceinline__ float red16(float x) { x += dppf<0xB1>(x); x += dppf<0x4E>(x); x += dppf<0x141>(x); x += dppf<0x140>(x); return x; }
__device__ __forceinline__ float wave_sum(float v) {
#pragma unroll
    for (int o = 1; o < 64; o <<= 1) v += __shfl_xor(v, o);
    return v;
}
#define XB_TMO      128
#define XB_XCNT(j)  (256  + 64 * (j))
#define XB_XSUB(j)  (1280 + 64 * (j))
#define XB_XGEN(j)  (2304 + 64 * (j))
#define XB_TOP      3328
#define XB_TOPGEN   3392
#define XCD_BAR_WORDS 3456
#define XB_SPIN_CAP (1u << 18)

__device__ __forceinline__ unsigned xb_ld(unsigned* p)              { return __hip_atomic_load(p, __ATOMIC_RELAXED, __HIP_MEMORY_SCOPE_AGENT); }
__device__ __forceinline__ unsigned xb_add(unsigned* p, unsigned v) { return __hip_atomic_fetch_add(p, v, __ATOMIC_RELAXED, __HIP_MEMORY_SCOPE_AGENT); }
__device__ __forceinline__ unsigned xb_xcc_id() { return (unsigned)__builtin_amdgcn_s_getreg((3 << 11) | 20) & 0xFu; }
#define XB_SPIN(cond, bar) do { unsigned _sp = 0; while (cond) { __builtin_amdgcn_s_sleep(1); \
    if ((++_sp & 255u) == 0u) { if (xb_ld(&(bar)[XB_TMO])) break; if (_sp > XB_SPIN_CAP) { atomicAdd(&(bar)[XB_TMO], 1u); break; } } } } while (0)

struct XcdBarrier {
    unsigned* bar; unsigned x;
    volatile LAS unsigned* st;
};

__device__ __forceinline__ XcdBarrier xcd_barrier_post(unsigned* bar, volatile LAS unsigned* st) {
    XcdBarrier b; b.bar = bar; b.x = xb_xcc_id(); b.st = st;
    if (threadIdx.x == 0) (void)xb_add(&bar[XB_XCNT(b.x)], 1u);
    return b;
}
__device__ __forceinline__ void xcd_barrier_complete(unsigned* bar, unsigned x, unsigned& nloc, unsigned& nx) {
    const unsigned G = gridDim.x * gridDim.y * gridDim.z;
    unsigned sum, cnt, mine, sp = 0u;
    for (;;) {
        sum = 0u; cnt = 0u; mine = 0u;
#pragma unroll
        for (unsigned j = 0; j < 16; ++j) { const unsigned c = xb_ld(&bar[XB_XCNT(j)]); sum += c; cnt += (c > 0u) ? 1u : 0u; mine = (j == x) ? c : mine; }
        if (sum == G) break;
        __builtin_amdgcn_s_sleep(1);
        if ((++sp & 255u) == 0u) { if (xb_ld(&bar[XB_TMO])) break; if (sp > XB_SPIN_CAP) { atomicAdd(&bar[XB_TMO], 1u); break; } }
    }
    nloc = mine > 0u ? mine : 1u; nx = cnt > 0u ? cnt : 1u;
}

__device__ __forceinline__ void xcd_barrier(const XcdBarrier& b) {
    asm volatile("s_waitcnt vmcnt(0)" ::: "memory");
    __syncthreads();
    if (threadIdx.x == 0) {
        unsigned* bar = b.bar;
        __builtin_amdgcn_s_waitcnt(0);
        unsigned nloc = b.st[0], nx = b.st[1];
        if (nloc == 0u) { xcd_barrier_complete(bar, b.x, nloc, nx); b.st[0] = nloc; b.st[1] = nx; }
        const unsigned old = xb_add(&bar[XB_XSUB(b.x)], 1u);
        const unsigned gen = old / nloc;
        if (old + 1u == (gen + 1u) * nloc) {
            __builtin_amdgcn_fence(__ATOMIC_RELEASE, "agent");
            asm volatile("s_waitcnt vmcnt(0)" ::: "memory");
            const unsigned og = xb_add(&bar[XB_TOP], 1u);
            const unsigned tg = og / nx;
            if (og + 1u == (tg + 1u) * nx) xb_add(&bar[XB_TOPGEN], 1u);
            else XB_SPIN(xb_ld(&bar[XB_TOPGEN]) == tg, bar);
            __builtin_amdgcn_fence(__ATOMIC_ACQUIRE, "agent");
            xb_add(&bar[XB_XGEN(b.x)], 1u);
            asm volatile("s_waitcnt vmcnt(0)" ::: "memory");
        } else {
            XB_SPIN(xb_ld(&bar[XB_XGEN(b.x)]) == gen, bar);
            __builtin_amdgcn_fence(__ATOMIC_ACQUIRE, "agent");
            asm volatile("s_waitcnt vmcnt(0)" ::: "memory");
        }
    }
    __syncthreads();
}
struct Ctx {
    LAS unsigned char* lds; int tid, lane, wave, vcu, G;
    const float* in[32]; float* out; unsigned char* ws;
};
#define WSP(T, off) ((T*)(F.ws + (off)))

__device__ __forceinline__ void p0_transpose_item(const float* W, int K, int N, bf16_t* WT, LAS float* scr, int item, int lane) {
    const int nblk = (N + 31) / 32, kb = item / nblk, nb = item % nblk, k0 = 64 * kb, n0 = 32 * nb;
    const int nn = n0 + (lane & 31);
#pragma unroll 8
    for (int i = 0; i < 32; ++i) { const int kk = 2 * i + (lane >> 5); scr[kk * 33 + (lane & 31)] = nn < N ? W[(size_t)(k0 + kk) * N + nn] : 0.f; }
    LDS_WAIT(); asm volatile("" ::: "memory");
    const int c = lane & 7;
#pragma unroll
    for (int j = 0; j < 4; ++j) { const int n = (lane >> 3) + 8 * j; const LAS float* s = scr + (8 * c) * 33 + n;
        u32x4 o; o.x = pk2(s[0 * 33], s[1 * 33]); o.y = pk2(s[2 * 33], s[3 * 33]); o.z = pk2(s[4 * 33], s[5 * 33]); o.w = pk2(s[6 * 33], s[7 * 33]);
        *(u32x4*)(WT + (size_t)(n0 + n) * K + k0 + 8 * c) = o; }
    LDS_WAIT(); asm volatile("" ::: "memory");
}
__device__ __forceinline__ void convert_uv(const Ctx& F, int l) {
    const size_t n8 = (size_t)16384 * 1024 / 8;
    const f32x4* su = (const f32x4*)(F.in[30] + (size_t)l * 16384 * 1024); const f32x4* sv = (const f32x4*)(F.in[31] + (size_t)l * 16384 * 1024);
    u32x4* du = WSP(u32x4, WS_U); u32x4* dv = WSP(u32x4, WS_V);
    for (size_t i = (size_t)F.vcu * NTHR + F.tid; i < n8; i += (size_t)F.G * NTHR) {
        const f32x4 a = su[2 * i], b = su[2 * i + 1], c = sv[2 * i], d = sv[2 * i + 1];
        u32x4 o; o.x = pk2(a[0], a[1]); o.y = pk2(a[2], a[3]); o.z = pk2(b[0], b[1]); o.w = pk2(b[2], b[3]); du[i] = o;
        u32x4 p; p.x = pk2(c[0], c[1]); p.y = pk2(c[2], c[3]); p.z = pk2(d[0], d[1]); p.w = pk2(d[2], d[3]); dv[i] = p;
    }
}
__device__ __forceinline__ void phase_prologue(const Ctx& F) {
    float* MOD = WSP(float, WS_MOD);
    {
        LAS float* sl = (LAS float*)F.lds; LAS float* red = sl + 3072;
        for (int it = F.vcu; it < 192; it += F.G) {
            const int l = it / 96, n0 = (it % 96) * 64;
            for (int i = F.tid; i < 3072; i += NTHR) { const int s = i >> 10, k = i & 1023; const float c = s < 2 ? F.in[1][s * 1024 + k] : F.in[3][k]; sl[i] = c / (1.f + __expf(-c)); }
            __syncthreads();
            const int c = F.tid & 63, kg = F.tid >> 6;
            const float* W = F.in[4] + (size_t)l * 1024 * 6144 + n0 + c;
            float a0 = 0.f, a1 = 0.f, a2 = 0.f;
#pragma unroll 8
            for (int k = kg * 128; k < kg * 128 + 128; ++k) { const float w = W[(size_t)k * 6144]; a0 += sl[k] * w; a1 += sl[1024 + k] * w; a2 += sl[2048 + k] * w; }
            red[(kg * 3 + 0) * 64 + c] = a0; red[(kg * 3 + 1) * 64 + c] = a1; red[(kg * 3 + 2) * 64 + c] = a2;
            __syncthreads();
            if (F.tid < 192) { const int s = F.tid >> 6, cc = F.tid & 63; float t = F.in[5][l * 6144 + n0 + cc];
#pragma unroll
                for (int g = 0; g < 8; ++g) t += red[(g * 3 + s) * 64 + cc];
                MOD[(l * 3 + s) * 6144 + n0 + cc] = t; }
            __syncthreads();
        }
    }
    {
        LAS float* scr = (LAS float*)(F.lds + F.wave * 16384);
        const int gw = F.vcu * NWAVES + F.wave, NGW = F.G * NWAVES;
        constexpr int I_IN = 16 * 99, I_OUT = 16 * 32, I_L = I_IN + I_OUT;
        for (int it = gw; it < 2 * I_L; it += NGW) {
            const int l = it / I_L; int r = it % I_L;
            if (r < I_IN) p0_transpose_item(F.in[8] + (size_t)l * DM * DIN, DM, DIN, WSP(bf16_t, WS_WIN + l * WIN_LSTRIDE), scr, r, F.lane);
            else p0_transpose_item(F.in[9] + (size_t)l * DM * DM, DM, DM, WSP(bf16_t, WS_WOUT + l * WOUT_LSTRIDE), scr, r - I_IN, F.lane);
        }
        for (int i = F.vcu * NTHR + F.tid; i < 2 * 160 * 128; i += F.G * NTHR) { const int l = i / (160 * 128), r = i % (160 * 128);
            *(u32x4*)(WSP(bf16_t, WS_WIN + l * WIN_LSTRIDE) + (size_t)3168 * DM + (size_t)r * 8) = (u32x4){0u, 0u, 0u, 0u}; }
    }
    __syncthreads();
    {
        LAS float* KEYS = (LAS float*)F.lds; LAS float* WQl = KEYS + 128 * 129;
        for (int it = F.vcu; it < 512; it += F.G) {
            const int l = it >> 8, hh = (it >> 4) & 15, kb = it & 15;
            const float* ksrc = F.in[29] + ((size_t)l * 16 + hh) * 128 * 128;
            for (int i = F.tid; i < 16384; i += NTHR) KEYS[(i >> 7) * 129 + (i & 127)] = ksrc[i];
            const float* wsrc = F.in[28] + (size_t)l * DM * 2048 + (size_t)(kb * 64) * 2048 + hh * 128;
            for (int i = F.tid; i < 64 * 128; i += NTHR) { const int kk = i >> 7, d = i & 127; WQl[d * 68 + kk] = wsrc[(size_t)kk * 2048 + d]; }
            __syncthreads();
            const int key = F.tid & 127, kq = F.tid >> 7;
            float acc[16];
#pragma unroll
            for (int j = 0; j < 16; ++j) acc[j] = 0.f;
#pragma unroll 4
            for (int d = 0; d < 128; ++d) { const float a = KEYS[key * 129 + d]; const LAS f32x4* wq = (const LAS f32x4*)(WQl + d * 68 + kq * 16);
#pragma unroll
                for (int q = 0; q < 4; ++q) { const f32x4 w = wq[q]; acc[4 * q] += a * w[0]; acc[4 * q + 1] += a * w[1]; acc[4 * q + 2] += a * w[2]; acc[4 * q + 3] += a * w[3]; } }
            bf16_t* dst = WSP(bf16_t, WS_WEFF + l * WEFF_LSTRIDE) + (size_t)(hh * 128 + key) * DM + kb * 64 + kq * 16;
            u32x4 o0, o1; o0.x = pk2(acc[0], acc[1]); o0.y = pk2(acc[2], acc[3]); o0.z = pk2(acc[4], acc[5]); o0.w = pk2(acc[6], acc[7]);
            o1.x = pk2(acc[8], acc[9]); o1.y = pk2(acc[10], acc[11]); o1.z = pk2(acc[12], acc[13]); o1.w = pk2(acc[14], acc[15]);
            *(u32x4*)dst = o0; *(u32x4*)(dst + 8) = o1;
            __syncthreads();
        }
    }
    convert_uv(F, 0);
}

__device__ __forceinline__ void phase_norm(const Ctx& F, int l, int which, int nrows, const float* xlat, const float* xctx) {
    const float* gain = F.in[6 + which] + l * DM; const float* mod = WSP(float, WS_MOD) + (size_t)l * 3 * 6144;
    const int shoff = which ? 3072 : 0, scoff = which ? 4096 : 1024;
    bf16_t* H = WSP(bf16_t, WS_H);
    const int gw = F.vcu * NWAVES + F.wave, NGW = F.G * NWAVES;
    for (int row = gw; row < nrows; row += NGW) {
        const bool isc = row >= MLAT; const float* src = isc ? xctx + (size_t)(row - MLAT) * DM : xlat + (size_t)row * DM; const int smp = isc ? 2 : (row >> 13);
        const float* mb = mod + smp * 6144;
        f32x4 v[4]; float ss = 0.f;
#pragma unroll
        for (int j = 0; j < 4; ++j) { v[j] = *(const f32x4*)(src + F.lane * 4 + 256 * j); ss += (v[j][0] * v[j][0] + v[j][1] * v[j][1]) + (v[j][2] * v[j][2] + v[j][3] * v[j][3]); }
        const float rs = rsqrtf(wave_sum(ss) * (1.f / DM) + EPSN);
#pragma unroll
        for (int j = 0; j < 4; ++j) { const int c = F.lane * 4 + 256 * j; const f32x4 g = *(const f32x4*)(gain + c), sc = *(const f32x4*)(mb + scoff + c), sh = *(const f32x4*)(mb + shoff + c);
            const f32x4 o = (v[j] * rs * g) * (1.f + sc) + sh; st4bf(H + (size_t)row * DM + c, o); }
    }
}

__device__ __forceinline__ float log_sigmoid_(float x) { return fminf(x, 0.f) - __logf(1.f + __expf(-fabsf(x))); }
__device__ __forceinline__ void phase_prep(const Ctx& F, int l) {
    LAS float* W2s = (LAS float*)F.lds; LAS float* A2s = W2s + 8192; LAS float* G2s = A2s + 8192; LAS float* tsc = G2s + 8192 + F.wave * 64;
    { const float* w2 = F.in[13] + l * 8192; const float* a2 = F.in[15] + l * 8192; const float* g2 = F.in[16] + l * 8192;
      for (int i = F.tid; i < 8192; i += NTHR) { W2s[i] = w2[i]; A2s[i] = a2[i]; G2s[i] = g2[i]; } }
    __syncthreads();
    const bf16_t* P = WSP(bf16_t, WS_P); bf16_t* YC = WSP(bf16_t, WS_YCAT); bf16_t* QA = WSP(bf16_t, WS_QA); bf16_t* KA = WSP(bf16_t, WS_KA);
    unsigned char* RW = WSP(unsigned char, WS_RW); bf16_t* GB = WSP(bf16_t, WS_GB); float* BS = WSP(float, WS_BS); float* GA = WSP(float, WS_GA);
    const int lane = F.lane, c4 = lane * 4, i16 = lane & 15;
    const f32x4 cw0 = *(const f32x4*)(F.in[10] + l * 768 + c4), cw1 = *(const f32x4*)(F.in[10] + l * 768 + 256 + c4), cw2 = *(const f32x4*)(F.in[10] + l * 768 + 512 + c4);
    const f32x4 cg = *(const f32x4*)(F.in[11] + l * 256 + c4);
    const f32x4 qg = *(const f32x4*)(F.in[21] + l * 64 + (c4 & 63)), kg = *(const f32x4*)(F.in[22] + l * 64 + (c4 & 63));
    const f32x4 k_k = *(const f32x4*)(F.in[17] + l * 256 + c4), k_a = *(const f32x4*)(F.in[18] + l * 256 + c4), r_k = *(const f32x4*)(F.in[19] + l * 256 + c4);
    f32x4 w0[2], a0[2];
#pragma unroll
    for (int d = 0; d < 2; ++d) { w0[d] = *(const f32x4*)(F.in[12] + (l * 2 + d) * 256 + c4); a0[d] = *(const f32x4*)(F.in[14] + (l * 2 + d) * 256 + c4); }
    float invf[4];
#pragma unroll
    for (int j = 0; j < 4; ++j) invf[j] = exp2f(-(float)((c4 + j) & 15) * (13.287712379549449f / 16.f));
    const int gw = F.vcu * NWAVES + F.wave, NGW = F.G * NWAVES;
    for (int row = gw; row < MALL; row += NGW) {
        const bool isc = row >= MLAT; const int t = isc ? ((row - MLAT) & 255) : (row & 8191); const int T = isc ? TCTX : TLAT;
        const bf16_t* pr = P + (size_t)row * DINP;
        {
            const f32x4 h1 = ld4bf(pr + C_CH + c4), bg = ld4bf(pr + C_CB + c4), c1 = ld4bf(pr + C_CC + c4);
            f32x4 up = {0.f, 0.f, 0.f, 0.f}, un = {0.f, 0.f, 0.f, 0.f};
            if (t > 0) up = ld4bf(pr - DINP + C_CH + c4) * ld4bf(pr - DINP + C_CC + c4);
            if (t < T - 1) un = ld4bf(pr + DINP + C_CH + c4) * ld4bf(pr + DINP + C_CC + c4);
            const f32x4 y = bg * (cw0 * up + cw1 * (c1 * h1) + cw2 * un);
            const float ss = red16((y[0] * y[0] + y[1] * y[1]) + (y[2] * y[2] + y[3] * y[3]));
            const float rs = rsqrtf(ss * (1.f / 64.f) + EPSN);
            st4bf(YC + (size_t)row * DM + c4, y * rs * cg * ZF(2));
        }
        asm volatile("" ::: "memory");
        {
            const f32x4 q = ld4bf(pr + C_AQ + c4); const f32x4 k = ld4bf(pr + C_AK + (c4 & 127));
            const float qs = red16((q[0] * q[0] + q[1] * q[1]) + (q[2] * q[2] + q[3] * q[3]));
            const float ks = red16((k[0] * k[0] + k[1] * k[1]) + (k[2] * k[2] + k[3] * k[3]));
            f32x4 qn = q * rsqrtf(qs * (1.f / 64.f) + EPSN) * qg, kn = k * rsqrtf(ks * (1.f / 64.f) + EPSN) * kg;
            if (!isc) {
                f32x4 qp, kp;
#pragma unroll
                for (int j = 0; j < 4; ++j) { qp[j] = __shfl_xor(qn[j], 4); kp[j] = __shfl_xor(kn[j], 4); }
                const int d0 = c4 & 63; const float pos = (d0 < 32) ? (float)(t >> 6) : (float)(t & 63); const bool lowh = (d0 & 16) == 0;
#pragma unroll
                for (int j = 0; j < 4; ++j) { const float th = pos * invf[j]; const float cs = __cosf(th), sn = __sinf(th);
                    qn[j] = lowh ? qn[j] * cs - qp[j] * sn : qn[j] * cs + qp[j] * sn; kn[j] = lowh ? kn[j] * cs - kp[j] * sn : kn[j] * cs + kp[j] * sn; }
            }
            st4bf(QA + (size_t)row * 256 + c4, qn * (0.125f * 1.4426950408889634f));
            if (lane < 32) st4bf(KA + (size_t)row * 128 + c4, kn);
        }
        asm volatile("" ::: "memory");
        {
            const f32x4 r = ld4bf(pr + C_RR + c4), k = ld4bf(pr + C_RK + c4);
            { const float xv = bf2f(pr[C_XW + lane]);
              tsc[lane] = lane < 16 ? tanhf_(xv) : (lane < 32 ? xv : sigmoidf_(xv)); }
            const f32x4 kx = k * k_k;
            const float kss = red16((kx[0] * kx[0] + kx[1] * kx[1]) + (kx[2] * kx[2] + kx[3] * kx[3]));
            const f32x4 kk = kx * rsqrtf(kss + EPSN);
            bf16_t* recb = (bf16_t*)(RW + (size_t)row * RWREC); float* recf = (float*)(RW + (size_t)row * RWREC + 2560);
            st4bf(recb + c4, kk);
            f32x4 kdsum = {0.f, 0.f, 0.f, 0.f};
#pragma unroll
            for (int d = 0; d < 2; ++d) {
                f32x4 dw = w0[d], da = a0[d];
#pragma unroll 4
                for (int ii = 0; ii < 16; ++ii) { dw += tsc[ii] * *(const LAS f32x4*)(W2s + (d * 16 + ii) * 256 + c4); da += tsc[16 + ii] * *(const LAS f32x4*)(A2s + (d * 16 + ii) * 256 + c4); }
                f32x4 dec, av;
#pragma unroll
                for (int j = 0; j < 4; ++j) { dec[j] = __expf(-0.6065306597126334f * sigmoidf_(dw[j])); av[j] = sigmoidf_(da[j]); }
                const f32x4 kd = k * (1.f + (av - 1.f) * k_a);
                kdsum += kd;
                st4bf(recb + 256 + d * 256 + c4, kk * av);
                st4bf(recb + 768 + d * 256 + c4, kd);
                *(f32x4*)(recf + d * 256 + c4) = dec;
            }
            f32x4 gv = {0.f, 0.f, 0.f, 0.f};
#pragma unroll 4
            for (int ii = 0; ii < 32; ++ii) gv += tsc[32 + ii] * *(const LAS f32x4*)(G2s + ii * 256 + c4);
            st4bf(GB + (size_t)row * 256 + c4, gv);
            const f32x4 bt = r * kdsum * r_k;
            const float bsum = red16((bt[0] + bt[1]) + (bt[2] + bt[3]));
            if (i16 == 0) BS[(size_t)row * 4 + (lane >> 4)] = bsum;
        }
        asm volatile("" ::: "memory");
        if (lane < 16) { const int dir = lane >> 3, gate = (lane >> 2) & 1, hd = lane & 3; const float x = bf2f(pr[C_MG + lane]);
            const float bias = gate ? F.in[26][(l * 2 + dir) * 4 + hd] : F.in[25][(l * 2 + dir) * 4 + hd];
            GA[(size_t)row * 16 + lane] = gate ? log_sigmoid_(x + bias) : (x + bias); }
    }
}
__device__ __forceinline__ int scan_row(int b, int dir, int i) {
    if (i < TCTX) return MLAT + b * TCTX + (dir ? (TCTX - 1 - i) : i);
    const int p = i - TCTX; return b * TLAT + (dir ? (TLAT - 1 - p) : p);
}
__device__ __forceinline__ void rwkv_scan(const Ctx& F, int blk) {
    const int chain = blk >> 1, half = blk & 1, b = chain >> 3, head = (chain >> 1) & 3, dir = chain & 1;
    const int rowv = (half * 8 + F.wave) * 4 + (F.lane >> 4), s = F.lane & 15;
    LAS float* buf = (LAS float*)F.lds;
    const bf16_t* P = WSP(bf16_t, WS_P); const unsigned char* RW = WSP(unsigned char, WS_RW); float* YR = WSP(float, WS_YR) + (size_t)dir * MALL * 256;
    const int st = F.tid >> 4, sub = F.tid & 15;
    constexpr int NSTEP = TCTX + TLAT, NCH = NSTEP / 32;
    u32x2 g_kk, g_al, g_kd, g_r, g_v; f32x4 g_w;
#define RW_LOAD(c) do { const int row_ = scan_row(b, dir, (c) * 32 + st); const bf16_t* rb_ = (const bf16_t*)(RW + (size_t)row_ * RWREC) + head * 64 + sub * 4; \
        g_kk = *(const u32x2*)rb_; g_al = *(const u32x2*)(rb_ + 256 + dir * 256); g_kd = *(const u32x2*)(rb_ + 768 + dir * 256); \
        g_w = *(const f32x4*)((const float*)(RW + (size_t)row_ * RWREC + 2560) + dir * 256 + head * 64 + sub * 4); \
        const bf16_t* pp_ = P + (size_t)row_ * DINP + head * 64 + sub * 4; g_r = *(const u32x2*)(pp_ + C_RR); g_v = *(const u32x2*)(pp_ + C_RV); } while (0)
#define RW_STORE(par) do { LAS float* d_ = buf + ((par) * 32 + st) * 384 + sub * 4; \
        *(LAS f32x4*)(d_) = (f32x4){lo2f(g_kk.x), hi2f(g_kk.x), lo2f(g_kk.y), hi2f(g_kk.y)}; *(LAS f32x4*)(d_ + 64) = (f32x4){lo2f(g_al.x), hi2f(g_al.x), lo2f(g_al.y), hi2f(g_al.y)}; \
        *(LAS f32x4*)(d_ + 128) = (f32x4){lo2f(g_kd.x), hi2f(g_kd.x), lo2f(g_kd.y), hi2f(g_kd.y)}; *(LAS f32x4*)(d_ + 192) = g_w; \
        *(LAS f32x4*)(d_ + 256) = (f32x4){lo2f(g_r.x), hi2f(g_r.x), lo2f(g_r.y), hi2f(g_r.y)}; *(LAS f32x4*)(d_ + 320) = (f32x4){lo2f(g_v.x), hi2f(g_v.x), lo2f(g_v.y), hi2f(g_v.y)}; } while (0)
    f32x4 S = {0.f, 0.f, 0.f, 0.f};
    RW_LOAD(0); RW_STORE(0); __syncthreads();
    for (int c = 0; c < NCH; ++c) {
        const int par = c & 1;
        if (c + 1 < NCH) RW_LOAD(c + 1);
#pragma unroll 8
        for (int i = 0; i < 32; ++i) {
            const LAS float* d = buf + (par * 32 + i) * 384;
            const f32x4 kk = *(const LAS f32x4*)(d + s * 4), al = *(const LAS f32x4*)(d + 64 + s * 4), kd = *(const LAS f32x4*)(d + 128 + s * 4),
                        w = *(const LAS f32x4*)(d + 192 + s * 4), r = *(const LAS f32x4*)(d + 256 + s * 4);
            const float vr = d[320 + rowv];
            const float sa = red16((S[0] * kk[0] + S[1] * kk[1]) + (S[2] * kk[2] + S[3] * kk[3]));
            S = S * w + (vr * kd - sa * al);
            const float y = red16((S[0] * r[0] + S[1] * r[1]) + (S[2] * r[2] + S[3] * r[3]));
            if (s == 0) { const int row = scan_row(b, dir, c * 32 + i); YR[(size_t)row * 256 + head * 64 + rowv] = y; }
        }
        if (c + 1 < NCH) RW_STORE(par ^ 1);
        __syncthreads();
    }
#undef RW_LOAD
#undef RW_STORE
}

typedef union { u32x4 u; bf16x8 b; } frag_u;
__device__ __forceinline__ void attn_unit(const Ctx& F, int l, int unit) {
    LAS bf16_t* Kl = (LAS bf16_t*)F.lds; LAS bf16_t* Vt = Kl + 64 * 72;
    const bf16_t* P = WSP(bf16_t, WS_P); const bf16_t* QA = WSP(bf16_t, WS_QA); const bf16_t* KA = WSP(bf16_t, WS_KA); bf16_t* YC = WSP(bf16_t, WS_YCAT);
    const bool isc = unit >= 256; int b, kvh, n;
    if (!isc) { b = unit >> 7; kvh = (unit >> 6) & 1; n = unit & 63; } else { const int u = unit - 256; b = u >> 2; kvh = (u >> 1) & 1; n = u & 1; }
    const int g = F.wave >> 2, ps = F.wave & 3, head = kvh * 2 + g, i = F.lane & 15, gq = F.lane >> 4;
    const int qpos0 = n * 128 + ps * 32, qrow0 = (isc ? MLAT + b * TCTX : b * TLAT) + qpos0;
    bf16x8 Qf[2][2];
#pragma unroll
    for (int qb = 0; qb < 2; ++qb)
#pragma unroll
        for (int ks = 0; ks < 2; ++ks) Qf[qb][ks] = *(const bf16x8*)(QA + (size_t)(qrow0 + qb * 16 + i) * 256 + head * 64 + ks * 32 + gq * 8);
    const float sinkl = F.in[23][l * 4 + head] * 1.4426950408889634f;
    float mrun[2] = {sinkl, sinkl}, lsum[2]; lsum[0] = lsum[1] = (gq == 0) ? 1.f : 0.f;
    f32x4 ao[4][2];
#pragma unroll
    for (int db = 0; db < 4; ++db) { ao[db][0] = (f32x4){0.f, 0.f, 0.f, 0.f}; ao[db][1] = (f32x4){0.f, 0.f, 0.f, 0.f}; }
    const int ntl = isc ? 4 : 10;
    const int skey = F.tid >> 3, sch = F.tid & 7;
    for (int tt = 0; tt < ntl; ++tt) {
        int krow0, kpos0 = 0; bool band = false;
        if (!isc && tt < 6) { const int kt = 2 * (n - 1) + tt; if (kt < 0 || kt >= 128) continue; krow0 = b * TLAT + kt * 64; kpos0 = kt * 64; band = true; }
        else { const int c = isc ? tt : tt - 6; krow0 = MLAT + b * TCTX + c * 64; }
        __syncthreads();
        { const u32x4 kv = *(const u32x4*)(KA + (size_t)(krow0 + skey) * 128 + kvh * 64 + sch * 8);
          const u32x4 vv = *(const u32x4*)(P + (size_t)(krow0 + skey) * DINP + C_AV + kvh * 64 + sch * 8);
          *(LAS u32x4*)(Kl + skey * 72 + sch * 8) = kv;
          const unsigned ww[4] = {vv.x, vv.y, vv.z, vv.w};
#pragma unroll
          for (int j = 0; j < 4; ++j) { Vt[(sch * 8 + 2 * j) * 72 + skey] = (bf16_t)(ww[j] & 0xffffu); Vt[(sch * 8 + 2 * j + 1) * 72 + skey] = (bf16_t)(ww[j] >> 16); } }
        __syncthreads();
        f32x4 sc[4][2];
#pragma unroll
        for (int kb = 0; kb < 4; ++kb) {
            sc[kb][0] = (f32x4){0.f, 0.f, 0.f, 0.f}; sc[kb][1] = (f32x4){0.f, 0.f, 0.f, 0.f};
#pragma unroll
            for (int ks = 0; ks < 2; ++ks) { const bf16x8 kf = *(const LAS bf16x8*)(Kl + (kb * 16 + i) * 72 + ks * 32 + gq * 8);
                sc[kb][0] = __builtin_amdgcn_mfma_f32_16x16x32_bf16(kf, Qf[0][ks], sc[kb][0], 0, 0, 0);
                sc[kb][1] = __builtin_amdgcn_mfma_f32_16x16x32_bf16(kf, Qf[1][ks], sc[kb][1], 0, 0, 0); }
        }
#pragma unroll
        for (int qb = 0; qb < 2; ++qb) {
            const int qp = qpos0 + qb * 16 + i;
            float mx = -1e30f;
#pragma unroll
            for (int kb = 0; kb < 4; ++kb)
#pragma unroll
                for (int r = 0; r < 4; ++r) { if (band) { const int dd = (kpos0 + kb * 16 + 4 * gq + r) - qp; if (dd > 128 || dd < -128) sc[kb][qb][r] = -1e30f; } mx = fmaxf(mx, sc[kb][qb][r]); }
            mx = fmaxf(mx, __shfl_xor(mx, 16)); mx = fmaxf(mx, __shfl_xor(mx, 32));
            const float mnew = fmaxf(mrun[qb], mx), alpha = exp2f(mrun[qb] - mnew); mrun[qb] = mnew;
            float ps_ = 0.f;
#pragma unroll
            for (int kb = 0; kb < 4; ++kb)
#pragma unroll
                for (int r = 0; r < 4; ++r) { const float p = exp2f(sc[kb][qb][r] - mnew); sc[kb][qb][r] = p; ps_ += p; }
            lsum[qb] = lsum[qb] * alpha + ps_;
#pragma unroll
            for (int db = 0; db < 4; ++db) ao[db][qb] *= alpha;
        }
#pragma unroll
        for (int ks2 = 0; ks2 < 2; ++ks2) {
            frag_u pf[2];
#pragma unroll
            for (int qb = 0; qb < 2; ++qb) { pf[qb].u.x = pg8::cvt_pk_bf16(sc[2 * ks2][qb][0], sc[2 * ks2][qb][1]); pf[qb].u.y = pg8::cvt_pk_bf16(sc[2 * ks2][qb][2], sc[2 * ks2][qb][3]);
                pf[qb].u.z = pg8::cvt_pk_bf16(sc[2 * ks2 + 1][qb][0], sc[2 * ks2 + 1][qb][1]); pf[qb].u.w = pg8::cvt_pk_bf16(sc[2 * ks2 + 1][qb][2], sc[2 * ks2 + 1][qb][3]); }
#pragma unroll
            for (int db = 0; db < 4; ++db) { frag_u vf; const LAS bf16_t* vp = Vt + (db * 16 + i) * 72 + (2 * ks2) * 16 + 4 * gq;
                const u32x2 v0 = *(const LAS u32x2*)vp, v1 = *(const LAS u32x2*)(vp + 16); vf.u = (u32x4){v0.x, v0.y, v1.x, v1.y};
                ao[db][0] = __builtin_amdgcn_mfma_f32_16x16x32_bf16(vf.b, pf[0].b, ao[db][0], 0, 0, 0);
                ao[db][1] = __builtin_amdgcn_mfma_f32_16x16x32_bf16(vf.b, pf[1].b, ao[db][1], 0, 0, 0); }
        }
    }
    const float* og = F.in[24] + l * 256 + head * 64;
#pragma unroll
    for (int qb = 0; qb < 2; ++qb) {
        float lt = lsum[qb]; lt += __shfl_xor(lt, 16); lt += __shfl_xor(lt, 32);
        const float il = 1.f / lt; float ss = 0.f;
#pragma unroll
        for (int db = 0; db < 4; ++db) { ao[db][qb] *= il; ss += (ao[db][qb][0] * ao[db][qb][0] + ao[db][qb][1] * ao[db][qb][1]) + (ao[db][qb][2] * ao[db][qb][2] + ao[db][qb][3] * ao[db][qb][3]); }
        ss += __shfl_xor(ss, 16); ss += __shfl_xor(ss, 32);
        const float rs = rsqrtf(ss * (1.f / 64.f) + EPSN);
        bf16_t* yo = YC + (size_t)(qrow0 + qb * 16 + i) * DM + 512 + head * 64;
#pragma unroll
        for (int db = 0; db < 4; ++db) { const f32x4 gg = *(const f32x4*)(og + db * 16 + 4 * gq); st4bf(yo + db * 16 + 4 * gq, ao[db][qb] * rs * gg * ZF(8)); }
    }
    __syncthreads();
}

__device__ __forceinline__ int ml_row(int b, int dir, int j, int tp) {
    if (j < 2) { const int p = j * 128 + tp; return MLAT + b * TCTX + (dir ? (TCTX - 1 - p) : p); }
    const int p = (j - 2) * 128 + tp; return b * TLAT + (dir ? (TLAT - 1 - p) : p);
}
__device__ __forceinline__ void scan128_add(float& x0, float& x1, int lane) {
    x1 += x0; float t = x1;
#pragma unroll
    for (int o = 1; o < 64; o <<= 1) { const float u = __shfl_up(t, o); if (lane >= o) t += u; }
    const float ex = t - x1; x0 += ex; x1 = t;
}
__device__ __forceinline__ void scan128_max(float& x0, float& x1, int lane) {
    x1 = fmaxf(x1, x0); float t = x1;
#pragma unroll
    for (int o = 1; o < 64; o <<= 1) { const float u = __shfl_up(t, o); if (lane >= o) t = fmaxf(t, u); }
    const float pv = __shfl_up(t, 1); if (lane > 0) x0 = fmaxf(x0, pv); x1 = t;
}
__device__ __forceinline__ void ml_stage_T(const Ctx& F, const bf16_t* P, int b, int dir, int j, int col0, LAS bf16_t* dst, const LAS float* sw, float cscale) {
#pragma unroll
    for (int it = 0; it < 2; ++it) { const int id = F.tid + it * NTHR, tp = id >> 3, ch = id & 7;
        const u32x4 v = *(const u32x4*)(P + (size_t)ml_row(b, dir, j, tp) * DINP + col0 + ch * 8); const float s = (sw ? sw[tp] : 1.f) * cscale;
        const unsigned ww[4] = {v.x, v.y, v.z, v.w};
#pragma unroll
        for (int q = 0; q < 4; ++q) { dst[(ch * 8 + 2 * q) * 136 + tp] = (bf16_t)f2bf(lo2f(ww[q]) * s); dst[(ch * 8 + 2 * q + 1) * 136 + tp] = (bf16_t)f2bf(hi2f(ww[q]) * s); } }
}
__device__ __forceinline__ void ml_stage_R(const Ctx& F, const bf16_t* P, int b, int dir, int j, int col0, LAS bf16_t* dst, float cscale) {
#pragma unroll
    for (int it = 0; it < 2; ++it) { const int id = F.tid + it * NTHR, tp = id >> 3, ch = id & 7;
        u32x4 v = *(const u32x4*)(P + (size_t)ml_row(b, dir, j, tp) * DINP + col0 + ch * 8);
        if (cscale != 1.f) { v.x = pk2(lo2f(v.x) * cscale, hi2f(v.x) * cscale); v.y = pk2(lo2f(v.y) * cscale, hi2f(v.y) * cscale); v.z = pk2(lo2f(v.z) * cscale, hi2f(v.z) * cscale); v.w = pk2(lo2f(v.w) * cscale, hi2f(v.w) * cscale); }
        *(LAS u32x4*)(dst + tp * 72 + ch * 8) = v; }
}
__device__ __forceinline__ void mlstm_local(const Ctx& F, int task) {
    const int chain = task / NCHK, j = task % NCHK, b = chain >> 3, head = (chain >> 1) & 3, dir = chain & 1;
    const bf16_t* P = WSP(bf16_t, WS_P); const float* GA = WSP(float, WS_GA);
    LAS bf16_t* Vt = (LAS bf16_t*)F.lds; LAS bf16_t* Kt = Vt + 64 * 136; LAS float* wS = (LAS float*)(Kt + 64 * 136); LAS float* sc2 = wS + 128;
    __syncthreads();
    if (F.wave == 0) {
        const int r0 = ml_row(b, dir, j, 2 * F.lane), r1 = ml_row(b, dir, j, 2 * F.lane + 1);
        const float li0 = GA[(size_t)r0 * 16 + dir * 8 + head], li1 = GA[(size_t)r1 * 16 + dir * 8 + head];
        float b0 = GA[(size_t)r0 * 16 + dir * 8 + 4 + head], b1 = GA[(size_t)r1 * 16 + dir * 8 + 4 + head];
        scan128_add(b0, b1, F.lane);
        const float bend = __shfl(b1, 63);
        const float d0 = bend - b0 + li0, d1 = bend - b1 + li1;
        float mx = fmaxf(d0, d1);
#pragma unroll
        for (int o = 1; o < 64; o <<= 1) mx = fmaxf(mx, __shfl_xor(mx, o));
        wS[2 * F.lane] = __expf(d0 - mx); wS[2 * F.lane + 1] = __expf(d1 - mx);
        if (F.lane == 0) { sc2[0] = mx; sc2[1] = bend; }
    }
    __syncthreads();
    ml_stage_T(F, P, b, dir, j, C_MV + head * 64, Vt, wS, 1.f);
    ml_stage_T(F, P, b, dir, j, C_MK + head * 64, Kt, nullptr, 0.125f);
    __syncthreads();
    float* LC = WSP(float, WS_LC) + (size_t)task * CST;
    { const int vb = F.wave >> 1, i = F.lane & 15, gq = F.lane >> 4;
#pragma unroll
      for (int kk2 = 0; kk2 < 2; ++kk2) { const int kb = 2 * (F.wave & 1) + kk2; f32x4 acc = {0.f, 0.f, 0.f, 0.f};
#pragma unroll
          for (int ks = 0; ks < 4; ++ks) { const bf16x8 a = *(const LAS bf16x8*)(Vt + (vb * 16 + i) * 136 + ks * 32 + gq * 8), bb = *(const LAS bf16x8*)(Kt + (kb * 16 + i) * 136 + ks * 32 + gq * 8);
              acc = __builtin_amdgcn_mfma_f32_16x16x32_bf16(a, bb, acc, 0, 0, 0); }
#pragma unroll
          for (int r = 0; r < 4; ++r) LC[(vb * 16 + 4 * gq + r) * 64 + kb * 16 + i] = acc[r]; } }
    if (F.tid < 64) { float a = 0.f;
#pragma unroll 8
        for (int s = 0; s < 128; ++s) a += wS[s] * bf2f(Kt[F.tid * 136 + s]);
        LC[4096 + F.tid] = a; }
    if (F.tid == 0) { float* LB = WSP(float, WS_LB); LB[task * 2] = sc2[0]; LB[task * 2 + 1] = sc2[1]; }
}
__device__ __forceinline__ void mlstm_chain(const Ctx& F) {
    const int gt = F.vcu * NTHR + F.tid; if (gt >= 16 * CST) return;
    const int chain = gt / CST, e = gt % CST;
    const float* LC = WSP(float, WS_LC) + (size_t)chain * NCHK * CST + e; float* ST = WSP(float, WS_ST) + (size_t)chain * NCHK * CST + e;
    const float* LB = WSP(float, WS_LB) + chain * NCHK * 2; float* SM = WSP(float, WS_LB) + 4096 + chain * NCHK;
    float m = 0.f, x = 0.f;
#pragma unroll 6
    for (int j = 0; j < NCHK; ++j) {
        const float d = LC[(size_t)j * CST], L = LB[2 * j], Bv = LB[2 * j + 1];
        ST[(size_t)j * CST] = x; if (e == 0) SM[j] = m;
        const float mn = fmaxf(Bv + m, L);
        x = __expf(Bv + m - mn) * x + __expf(L - mn) * d; m = mn;
    }
}
__device__ __forceinline__ void mlstm_out(const Ctx& F, int l, int unit) {
    const bool isc = unit >= 512; int b, chunk, head;
    if (!isc) { b = unit >> 8; chunk = (unit >> 2) & 63; head = unit & 3; } else { const int u = unit - 512; b = u >> 3; chunk = (u >> 2) & 1; head = u & 3; }
    const bf16_t* P = WSP(bf16_t, WS_P); const float* GA = WSP(float, WS_GA); bf16_t* YC = WSP(bf16_t, WS_YCAT);
    LAS bf16_t* Ql = (LAS bf16_t*)F.lds; LAS bf16_t* Kl = Ql + 128 * 72; LAS bf16_t* Vt = Kl + 128 * 72; LAS bf16_t* Cb = Vt + 64 * 136;
    LAS float* nS = (LAS float*)(Cb + 64 * 72); LAS float* aS = nS + 64; LAS float* bS = aS + 128; LAS float* MS = bS + 128; LAS float* Hs = MS + 128;
    const int i = F.lane & 15, gq = F.lane >> 4, w = F.wave;
    for (int dir = 0; dir < 2; ++dir) {
        const int j = isc ? (dir ? 1 - chunk : chunk) : 2 + (dir ? 63 - chunk : chunk);
        const int chain = (b * 4 + head) * 2 + dir;
        const float* ST = WSP(float, WS_ST) + ((size_t)chain * NCHK + j) * CST; const float mprev = WSP(float, WS_LB)[4096 + chain * NCHK + j];
        __syncthreads();
        if (w == 0) {
            const int r0 = ml_row(b, dir, j, 2 * F.lane), r1 = ml_row(b, dir, j, 2 * F.lane + 1);
            const float li0 = GA[(size_t)r0 * 16 + dir * 8 + head], li1 = GA[(size_t)r1 * 16 + dir * 8 + head];
            float b0 = GA[(size_t)r0 * 16 + dir * 8 + 4 + head], b1 = GA[(size_t)r1 * 16 + dir * 8 + 4 + head];
            scan128_add(b0, b1, F.lane);
            const float a0 = li0 - b0, a1 = li1 - b1; float A0 = a0, A1 = a1;
            scan128_max(A0, A1, F.lane);
            aS[2 * F.lane] = a0; aS[2 * F.lane + 1] = a1; bS[2 * F.lane] = b0; bS[2 * F.lane + 1] = b1;
            MS[2 * F.lane] = fmaxf(A0, mprev); MS[2 * F.lane + 1] = fmaxf(A1, mprev);
        }
        ml_stage_R(F, P, b, dir, j, C_MQ + head * 64, Ql, 1.f);
        ml_stage_R(F, P, b, dir, j, C_MK + head * 64, Kl, 0.125f);
        ml_stage_T(F, P, b, dir, j, C_MV + head * 64, Vt, nullptr, 1.f);
        { const f32x4 c0 = *(const f32x4*)(ST + F.tid * 8), c1 = *(const f32x4*)(ST + F.tid * 8 + 4); const int v = F.tid >> 3, k0 = (F.tid & 7) * 8;
          u32x4 o; o.x = pk2(c0[0], c0[1]); o.y = pk2(c0[2], c0[3]); o.z = pk2(c1[0], c1[1]); o.w = pk2(c1[2], c1[3]); *(LAS u32x4*)(Cb + v * 72 + k0) = o;
          if (F.tid < 64) nS[F.tid] = ST[4096 + F.tid]; }
        __syncthreads();
        const int t = 16 * w + i; const float Mt = MS[t], bt = bS[t];
        bf16x8 Qf[2];
#pragma unroll
        for (int ks = 0; ks < 2; ++ks) Qf[ks] = *(const LAS bf16x8*)(Ql + t * 72 + ks * 32 + gq * 8);
        f32x4 sc[8];
#pragma unroll
        for (int sb = 0; sb < 8; ++sb) { sc[sb] = (f32x4){0.f, 0.f, 0.f, 0.f};
            if (sb <= w) {
#pragma unroll
                for (int ks = 0; ks < 2; ++ks) { const bf16x8 kf = *(const LAS bf16x8*)(Kl + (sb * 16 + i) * 72 + ks * 32 + gq * 8); sc[sb] = __builtin_amdgcn_mfma_f32_16x16x32_bf16(kf, Qf[ks], sc[sb], 0, 0, 0); }
#pragma unroll
                for (int r = 0; r < 4; ++r) { const int s = sb * 16 + 4 * gq + r; sc[sb][r] = (s <= t) ? sc[sb][r] * __expf(aS[s] - Mt) : 0.f; }
            } }
        float den = 0.f;
#pragma unroll
        for (int sb = 0; sb < 8; ++sb) den += (sc[sb][0] + sc[sb][1]) + (sc[sb][2] + sc[sb][3]);
        den += __shfl_xor(den, 16); den += __shfl_xor(den, 32);
        f32x4 nm[4], it_[4];
#pragma unroll
        for (int vb = 0; vb < 4; ++vb) { nm[vb] = (f32x4){0.f, 0.f, 0.f, 0.f}; it_[vb] = (f32x4){0.f, 0.f, 0.f, 0.f}; }
#pragma unroll
        for (int ks2 = 0; ks2 < 4; ++ks2) if (2 * ks2 <= w) {
            frag_u pf; pf.u.x = pg8::cvt_pk_bf16(sc[2 * ks2][0], sc[2 * ks2][1]); pf.u.y = pg8::cvt_pk_bf16(sc[2 * ks2][2], sc[2 * ks2][3]);
            pf.u.z = pg8::cvt_pk_bf16(sc[2 * ks2 + 1][0], sc[2 * ks2 + 1][1]); pf.u.w = pg8::cvt_pk_bf16(sc[2 * ks2 + 1][2], sc[2 * ks2 + 1][3]);
#pragma unroll
            for (int vb = 0; vb < 4; ++vb) { frag_u vf; const LAS bf16_t* vp = Vt + (vb * 16 + i) * 136 + (2 * ks2) * 16 + 4 * gq;
                const u32x2 v0 = *(const LAS u32x2*)vp, v1 = *(const LAS u32x2*)(vp + 16); vf.u = (u32x4){v0.x, v0.y, v1.x, v1.y};
                nm[vb] = __builtin_amdgcn_mfma_f32_16x16x32_bf16(vf.b, pf.b, nm[vb], 0, 0, 0); }
        }
#pragma unroll
        for (int vb = 0; vb < 4; ++vb)
#pragma unroll
            for (int ks = 0; ks < 2; ++ks) { const bf16x8 cf = *(const LAS bf16x8*)(Cb + (vb * 16 + i) * 72 + ks * 32 + gq * 8); it_[vb] = __builtin_amdgcn_mfma_f32_16x16x32_bf16(cf, Qf[ks], it_[vb], 0, 0, 0); }
        float nq = 0.f;
#pragma unroll
        for (int c = 0; c < 2; ++c) { const u32x4 qv = *(const LAS u32x4*)(Ql + t * 72 + gq * 16 + c * 8); const unsigned ww[4] = {qv.x, qv.y, qv.z, qv.w};
#pragma unroll
            for (int q = 0; q < 4; ++q) nq += nS[gq * 16 + c * 8 + 2 * q] * lo2f(ww[q]) + nS[gq * 16 + c * 8 + 2 * q + 1] * hi2f(ww[q]); }
        nq += __shfl_xor(nq, 16); nq += __shfl_xor(nq, 32);
        const float wint = __expf(mprev - Mt); den += wint * nq;
        const float dn = 1.f / fmaxf(fabsf(den), __expf(-(bt + Mt)));
        const int torig = dir ? 127 - t : t;
#pragma unroll
        for (int vb = 0; vb < 4; ++vb)
#pragma unroll
            for (int r = 0; r < 4; ++r) { const float hv = (nm[vb][r] + wint * it_[vb][r]) * dn; LAS float* hp = Hs + torig * 65 + vb * 16 + 4 * gq + r; if (dir == 0) *hp = hv; else *hp += hv; }
    }
    __syncthreads();
    {
        const int t = F.tid >> 2, vq = F.tid & 3; const int row = (isc ? MLAT + b * TCTX : b * TLAT) + chunk * 128 + t;
        float hv[16], ss = 0.f;
#pragma unroll
        for (int q = 0; q < 16; ++q) { hv[q] = Hs[t * 65 + vq * 16 + q]; ss += hv[q] * hv[q]; }
        ss += __shfl_xor(ss, 1); ss += __shfl_xor(ss, 2);
        const float rs = rsqrtf(ss * (1.f / 64.f) + EPSN);
        const float* og = F.in[27] + l * 256 + head * 64 + vq * 16; const bf16_t* op = P + (size_t)row * DINP + C_MO + head * 64 + vq * 16;
        const u32x4 o0 = *(const u32x4*)op, o1 = *(const u32x4*)(op + 8); const unsigned ow[8] = {o0.x, o0.y, o0.z, o0.w, o1.x, o1.y, o1.z, o1.w};
        unsigned res[8];
#pragma unroll
        for (int q = 0; q < 8; ++q) { const float y0 = sigmoidf_(lo2f(ow[q])) * hv[2 * q] * rs * og[2 * q], y1 = sigmoidf_(hi2f(ow[q])) * hv[2 * q + 1] * rs * og[2 * q + 1]; res[q] = pk2(y0 * ZF(16), y1 * ZF(16)); }
        bf16_t* yo = YC + (size_t)row * DM + 768 + head * 64 + vq * 16;
        *(u32x4*)yo = (u32x4){res[0], res[1], res[2], res[3]}; *(u32x4*)(yo + 8) = (u32x4){res[4], res[5], res[6], res[7]};
    }
    __syncthreads();
}
__device__ __forceinline__ void rwkv_finish(const Ctx& F, int l, int nrows) {
    const bf16_t* P = WSP(bf16_t, WS_P); const float* YR = WSP(float, WS_YR); const bf16_t* GB = WSP(bf16_t, WS_GB); const float* BS = WSP(float, WS_BS); bf16_t* YC = WSP(bf16_t, WS_YCAT);
    const int c4 = F.lane * 4; const f32x4 lg = *(const f32x4*)(F.in[20] + l * 256 + c4);
    const int gw = F.vcu * NWAVES + F.wave, NGW = F.G * NWAVES;
    for (int row = gw; row < nrows; row += NGW) {
        const f32x4 y = *(const f32x4*)(YR + (size_t)row * 256 + c4) + *(const f32x4*)(YR + (size_t)(MALL + row) * 256 + c4);
        const float ss = red16((y[0] * y[0] + y[1] * y[1]) + (y[2] * y[2] + y[3] * y[3]));
        const float rs = rsqrtf(ss * (1.f / 64.f) + EPSN);
        const f32x4 v = ld4bf(P + (size_t)row * DINP + C_RV + c4), g = ld4bf(GB + (size_t)row * 256 + c4);
        const float bn = BS[(size_t)row * 4 + (F.lane >> 4)];
        st4bf(YC + (size_t)row * DM + 256 + c4, (y * rs * lg * ZF(32) + bn * v * ZF(64)) * g * ZF(4));
    }
}
__device__ __forceinline__ float clr7(float x) { return __uint_as_float(__float_as_uint(x) & 0xFFFFFF80u); }
__device__ __forceinline__ void ins16(float (&L)[16], float p) {
#pragma unroll
    for (int j = 15; j >= 1; --j) L[j] = __builtin_amdgcn_fmed3f(L[j - 1], L[j], p);
    L[0] = fmaxf(L[0], p);
}
__device__ __forceinline__ void peer_topk_task(const float* srow, u32x2* eg) {
    float L0[16], L1[16];
#pragma unroll
    for (int j = 0; j < 16; ++j) { L0[j] = -INFINITY; L1[j] = -INFINITY; }
    for (int i = 0; i < 128; i += 4) {
        const f32x4 a = *(const f32x4*)(srow + i), b = *(const f32x4*)(srow + 128 + i);
#pragma unroll
        for (int q = 0; q < 4; ++q) { ins16(L0, __uint_as_float((__float_as_uint(a[q]) & 0xFFFFFF80u) | (unsigned)(i + q)));
                                      ins16(L1, __uint_as_float((__float_as_uint(b[q]) & 0xFFFFFF80u) | (unsigned)(i + q))); }
    }
    float T[16];
#pragma unroll
    for (int j = 0; j < 16; ++j) T[j] = -INFINITY;
#pragma unroll
    for (int a = 0; a < 16; ++a)
#pragma unroll
        for (int b = 0; b < 16; ++b) if ((a + 1) * (b + 1) <= 16) { const float s = clr7(L0[a]) + clr7(L1[b]);
            ins16(T, __uint_as_float((__float_as_uint(s) & 0xFFFFFF00u) | (unsigned)(a * 16 + b))); }
    float e[16], sum = 0.f; const float mx = __uint_as_float(__float_as_uint(T[0]) & 0xFFFFFF00u);
#pragma unroll
    for (int j = 0; j < 16; ++j) { e[j] = __expf(__uint_as_float(__float_as_uint(T[j]) & 0xFFFFFF00u) - mx); sum += e[j]; }
    const float inv = 1.f / sum;
#pragma unroll
    for (int j = 0; j < 16; ++j) {
        const unsigned ab = __float_as_uint(T[j]) & 0xFFu, a = ab >> 4, b = ab & 15u; unsigned i0 = 0u, i1 = 0u;
#pragma unroll
        for (int q = 0; q < 16; ++q) { i0 = (a == (unsigned)q) ? (__float_as_uint(L0[q]) & 0x7Fu) : i0; i1 = (b == (unsigned)q) ? (__float_as_uint(L1[q]) & 0x7Fu) : i1; }
        eg[j] = (u32x2){i0 * 128u + i1, __float_as_uint(e[j] * inv)};
    }
}
__device__ __forceinline__ float gelu_tanh(float x) { const float u = 0.7978845608028654f * (x + 0.044715f * x * x * x); return 0.5f * x * (1.f + tanhf_(u)); }
__device__ __forceinline__ float dot2bf(unsigned w, unsigned x, float acc) { return __builtin_amdgcn_fdot2_f32_bf16(__builtin_bit_cast(bf16x2_t, w), __builtin_bit_cast(bf16x2_t, x), acc, false); }
__device__ __forceinline__ float wave_total63(float x) {
    x = red16(x);
    x += __int_as_float(__builtin_amdgcn_update_dpp(0, __float_as_int(x), 0x142, 0xa, 0xf, false));
    x += __int_as_float(__builtin_amdgcn_update_dpp(0, __float_as_int(x), 0x143, 0xc, 0xf, false));
    return x;
}
__device__ __forceinline__ void phase_peer(const Ctx& F, int l, int nrows, const float* mod) {
    const float* S = WSP(float, WS_S); u32x2* EG = WSP(u32x2, WS_EG); const bf16_t* H = WSP(bf16_t, WS_H);
    const bf16_t* U = WSP(bf16_t, WS_U); const bf16_t* V = WSP(bf16_t, WS_V);
    const int tpb = nrows / F.G, tok0 = F.vcu * tpb;
    for (int task = F.tid; task < tpb * 8; task += NTHR) { const int row = tok0 + (task >> 3), hd = task & 7;
        peer_topk_task(S + (size_t)row * 2048 + hd * 256, EG + (size_t)row * 128 + hd * 16); }
    __threadfence_block(); __syncthreads();
    const int lane = F.lane;
    for (int tk = F.wave; tk < tpb; tk += NWAVES) {
        const int row = tok0 + tk; const bool isc = row >= MLAT; const int smp = isc ? 2 : (row >> 13);
        float* xrow = isc ? WSP(float, WS_XC) + (size_t)(row - MLAT) * DM : F.out + (size_t)row * DM;
        const u32x4 h0 = *(const u32x4*)(H + (size_t)row * DM + lane * 8), h1 = *(const u32x4*)(H + (size_t)row * DM + 512 + lane * 8);
        const u32x2 eg0 = EG[(size_t)row * 128 + lane], eg1 = EG[(size_t)row * 128 + 64 + lane];
        float act0 = 0.f, act1 = 0.f;
#pragma unroll 1
        for (int grp = 0; grp < 16; ++grp) {
            u32x4 ua[8], ub[8];
#pragma unroll
            for (int q = 0; q < 8; ++q) { const int ii = grp * 8 + q; const unsigned e = __builtin_amdgcn_readlane(ii < 64 ? eg0.x : eg1.x, ii & 63);
                const bf16_t* up = U + (size_t)e * DM + lane * 8; ua[q] = *(const u32x4*)up; ub[q] = *(const u32x4*)(up + 512); }
#pragma unroll
            for (int q = 0; q < 8; ++q) { const int ii = grp * 8 + q;
                float d = dot2bf(ua[q].x, h0.x, 0.f); d = dot2bf(ua[q].y, h0.y, d); d = dot2bf(ua[q].z, h0.z, d); d = dot2bf(ua[q].w, h0.w, d);
                float f = dot2bf(ub[q].x, h1.x, 0.f); f = dot2bf(ub[q].y, h1.y, f); f = dot2bf(ub[q].z, h1.z, f); f = dot2bf(ub[q].w, h1.w, f);
                const float tot = __int_as_float(__builtin_amdgcn_readlane(__float_as_int(wave_total63(d + f)), 63));
                if (ii < 64) act0 = (lane == (ii & 63)) ? tot : act0; else act1 = (lane == (ii & 63)) ? tot : act1; }
        }
        const float cf0 = __uint_as_float(eg0.y) * gelu_tanh(act0), cf1 = __uint_as_float(eg1.y) * gelu_tanh(act1);
        float acc[16];
#pragma unroll
        for (int q = 0; q < 16; ++q) acc[q] = 0.f;
#pragma unroll 1
        for (int grp = 0; grp < 16; ++grp) {
            u32x4 va[8], vb[8];
#pragma unroll
            for (int q = 0; q < 8; ++q) { const int ii = grp * 8 + q; const unsigned e = __builtin_amdgcn_readlane(ii < 64 ? eg0.x : eg1.x, ii & 63);
                const bf16_t* vp = V + (size_t)e * DM + lane * 8; va[q] = *(const u32x4*)vp; vb[q] = *(const u32x4*)(vp + 512); }
#pragma unroll
            for (int q = 0; q < 8; ++q) { const int ii = grp * 8 + q; const float cf = __int_as_float(__builtin_amdgcn_readlane(__float_as_int(ii < 64 ? cf0 : cf1), ii & 63));
                acc[0] += cf * lo2f(va[q].x); acc[1] += cf * hi2f(va[q].x); acc[2] += cf * lo2f(va[q].y); acc[3] += cf * hi2f(va[q].y);
                acc[4] += cf * lo2f(va[q].z); acc[5] += cf * hi2f(va[q].z); acc[6] += cf * lo2f(va[q].w); acc[7] += cf * hi2f(va[q].w);
                acc[8] += cf * lo2f(vb[q].x); acc[9] += cf * hi2f(vb[q].x); acc[10] += cf * lo2f(vb[q].y); acc[11] += cf * hi2f(vb[q].y);
                acc[12] += cf * lo2f(vb[q].z); acc[13] += cf * hi2f(vb[q].z); acc[14] += cf * lo2f(vb[q].w); acc[15] += cf * hi2f(vb[q].w); }
        }
        const float* gt = mod + smp * 6144 + 5120;
#pragma unroll
        for (int hh = 0; hh < 2; ++hh)
#pragma unroll
            for (int q = 0; q < 2; ++q) { const int c = hh * 512 + lane * 8 + q * 4; const f32x4 g = *(const f32x4*)(gt + c), x = *(const f32x4*)(xrow + c);
                *(f32x4*)(xrow + c) = x + ZF(1) * g * (f32x4){acc[hh * 8 + q * 4], acc[hh * 8 + q * 4 + 1], acc[hh * 8 + q * 4 + 2], acc[hh * 8 + q * 4 + 3]}; }
    }
}

constexpr int PH_PER_LAYER = 10, N_PHASES = 1 + 2 * PH_PER_LAYER;
struct Args { const float* in[32]; float* out; unsigned char* ws; int ph_lo, ph_hi, li, pad; };
__global__ void __launch_bounds__(NTHR, 2) mk_fwd(Args args) {
    extern __shared__ __attribute__((aligned(16))) unsigned char lds[];
    Ctx F;
    F.lds = (LAS unsigned char*)lds;
    volatile LAS unsigned* MISC = (volatile LAS unsigned*)(F.lds + MISC_OFF);
    F.tid = threadIdx.x; F.lane = F.tid & 63; F.wave = __builtin_amdgcn_readfirstlane(F.tid >> 6);
    F.G = gridDim.x; { const int bx = blockIdx.x; F.vcu = (F.G % 8 == 0) ? (bx % 8) * (F.G / 8) + bx / 8 : bx; }
#pragma unroll
    for (int i = 0; i < 32; ++i) F.in[i] = args.in[i];
    F.out = args.out; F.ws = args.ws;
    for (int u = F.tid; u < (LDS_BYTES - LDSCTL_OFF) / 4; u += NTHR) ((LAS unsigned*)(F.lds + LDSCTL_OFF))[u] = 0u;
    __syncthreads();
    XcdBarrier bar; bar.bar = (unsigned*)(args.ws + WS_CTL) + CW_BAR; bar.x = 0; bar.st = nullptr;
#if !MK_MULTI
    bar = xcd_barrier_post((unsigned*)(args.ws + WS_CTL) + CW_BAR, MISC + 8);
#endif
    const int lo = args.ph_lo, hi = args.ph_hi;
#define IN(k) (lo <= (k) && (k) < hi)
#define PHCTX Ctx Fp = F; { int t_ = F.tid; asm volatile("" : "+v"(t_)); Fp.tid = t_; Fp.lane = t_ & 63; }
#if MK_MULTI
#define SEAM(k) do { } while (0)
#else
#define SEAM(k) do { if (IN(k) && IN((k) + 1)) xcd_barrier(bar); } while (0)
#endif
    if (IN(0)) { PHCTX; phase_prologue(Fp); }
    SEAM(0);
    float* XC = WSP(float, WS_XC);
#pragma unroll 1
    for (int l = 0; l < 2; ++l) {
        const int pb = 1 + l * PH_PER_LAYER;
        const float* xlat = l == 0 ? F.in[0] : F.out; const float* xctx = l == 0 ? F.in[2] : XC;
        const int mrows = l == 0 ? MALL : MLAT;
        const float* mod = WSP(float, WS_MOD) + (size_t)l * 3 * 6144;
        if (IN(pb + 0)) { PHCTX; phase_norm(Fp, l, 0, MALL, xlat, xctx); if (l == 1) convert_uv(Fp, 1); }
        SEAM(pb + 0);
        if (IN(pb + 1)) { PHCTX; pg8::Gemm g{WSP(bf16_t, WS_H), WSP(bf16_t, WS_WIN + l * WIN_LSTRIDE), MALL, DINP, DM}; pg8::StaticOrder So; So.init(MALL, DINP, F.G, (int)blockIdx.x);
            pg8::EpiBf16 E{WSP(bf16_t, WS_P), DINP}; pg8::gemm_phase<pg8::EpiBf16, pg8::StaticOrder, true, true>(F.lds, g, So, E, Fp.tid); }
        SEAM(pb + 1);
        if (IN(pb + 2)) { PHCTX; phase_prep(Fp, l); }
        SEAM(pb + 2);
        if (IN(pb + 3)) { PHCTX;
            if (F.vcu < 32) rwkv_scan(Fp, F.vcu);
            else { const int nb = F.G - 32, wb = F.vcu - 32; const int natt = l == 0 ? 264 : 256, ntask = natt + 16 * NCHK;
                for (int task = wb; task < ntask; task += nb) { if (task < natt) attn_unit(Fp, l, task); else mlstm_local(Fp, task - natt); } }
        }
        SEAM(pb + 3);
        if (IN(pb + 4)) { PHCTX; mlstm_chain(Fp); }
        SEAM(pb + 4);
        if (IN(pb + 5)) { PHCTX; const int nun = l == 0 ? 528 : 512; for (int u = F.vcu; u < nun; u += F.G) mlstm_out(Fp, l, u); rwkv_finish(Fp, l, mrows); }
        SEAM(pb + 5);
        if (IN(pb + 6)) { PHCTX; pg8::Gemm g{WSP(bf16_t, WS_YCAT), WSP(bf16_t, WS_WOUT + l * WOUT_LSTRIDE), mrows, DM, DM}; pg8::StaticOrder So; So.init(mrows, DM, F.G, (int)blockIdx.x);
            pg8::EpiRes E{xlat, xctx, F.out, XC, mod}; pg8::gemm_phase<pg8::EpiRes, pg8::StaticOrder, true, true>(F.lds, g, So, E, Fp.tid); }
        SEAM(pb + 6);
        if (IN(pb + 7)) { PHCTX; phase_norm(Fp, l, 1, mrows, F.out, XC); }
        SEAM(pb + 7);
        if (IN(pb + 8)) { PHCTX; pg8::Gemm g{WSP(bf16_t, WS_H), WSP(bf16_t, WS_WEFF + l * WEFF_LSTRIDE), mrows, 2048, DM}; pg8::StaticOrder So; So.init(mrows, 2048, F.G, (int)blockIdx.x);
            pg8::EpiF32 E{WSP(float, WS_S), 2048}; pg8::gemm_phase<pg8::EpiF32, pg8::StaticOrder, true, true>(F.lds, g, So, E, Fp.tid); }
        SEAM(pb + 8);
        if (IN(pb + 9)) { PHCTX; phase_peer(Fp, l, mrows, mod); }
        SEAM(pb + 9);
    }
#undef IN
#undef SEAM
}

extern "C" void kernel_launch(void* const* d_in, const int* in_sizes, int n_in, void* d_out, int out_size, void* d_ws, size_t ws_size, hipStream_t stream) {
    static int grid = 0;
    if (grid == 0) {
        if (n_in != 32 || out_size != MLAT * DM || ws_size < WS_END) { fprintf(stderr, "kernel_launch: unexpected shapes: n_in %d out %d ws %zu (need %zu)\n", n_in, out_size, ws_size, (size_t)WS_END); grid = -1; return; }
        int dev = 0, cus = 0, per_cu = 0;
        if (hipGetDevice(&dev) != hipSuccess || hipDeviceGetAttribute(&cus, hipDeviceAttributeMultiprocessorCount, dev) != hipSuccess) { grid = -1; return; }
        if (hipFuncSetAttribute((const void*)mk_fwd, hipFuncAttributeMaxDynamicSharedMemorySize, LDS_BYTES) != hipSuccess) { fprintf(stderr, "kernel_launch: hipFuncSetAttribute failed\n"); grid = -1; return; }
        if (hipOccupancyMaxActiveBlocksPerMultiprocessor(&per_cu, (const void*)mk_fwd, NTHR, LDS_BYTES) != hipSuccess || per_cu < 1) fprintf(stderr, "kernel_launch: occupancy query reports %d\n", per_cu);
        (void)hipGetLastError();
        grid = cus;
        if (grid != 256) fprintf(stderr, "kernel_launch: grid %d (built for 256 CUs)\n", grid);
    }
    if (grid < 0) return;
    (void)hipMemsetAsync((char*)d_ws + WS_CTL, 0, CTL_ZERO_BYTES, stream);
    Args a{};
    for (int i = 0; i < 32; ++i) a.in[i] = (const float*)d_in[i];
    a.out = (float*)d_out; a.ws = (unsigned char*)d_ws;
#if MK_MULTI
    for (int p = 0; p < N_PHASES; ++p) { a.ph_lo = p; a.ph_hi = p + 1; a.li = p; hipLaunchKernelGGL(mk_fwd, dim3(grid), dim3(NTHR), LDS_BYTES, stream, a); }
#else
    a.ph_lo = 0; a.ph_hi = N_PHASES; a.li = 0;
    hipLaunchKernelGGL(mk_fwd, dim3(grid), dim3(NTHR), LDS_BYTES, stream, a);
#endif
}
```

```cpp
#include <hip/hip_runtime.h>
#include <cstdio>
#include <cstdint>

#ifndef MK_MULTI
#define MK_MULTI 0
#endif
namespace pg8 {
#define PG8_LAS __attribute__((address_space(3)))
typedef unsigned short bf16_t;
typedef short bf16x8 __attribute__((ext_vector_type(8)));
typedef float f32x4 __attribute__((ext_vector_type(4)));
typedef unsigned u32x4 __attribute__((ext_vector_type(4)));
constexpr int BM = 256, BK = 64, HALF = 128, HTB = HALF * BK * 2  , STAGE_BYTES = 8 * HTB, NXCD = 8, WGM = 8;

__host__ __device__ __forceinline__ int lds_byte(int r, int c) { const int st = (r >> 4) * 2 + (c >> 5), rr = r & 15, cc = c & 31, ob = rr * 64 + cc * 2; return st * 1024 + (ob ^ (((ob >> 9) & 1) << 5)); }
__host__ __device__ __forceinline__ void stage_rc(int b, int& R, int& C) { const int st = b / 1024, sb = b % 1024, swz = sb ^ (((sb >> 9) & 1) << 5); R = (st >> 1) * 16 + swz / 64; C = (st & 1) * 32 + (swz % 64) / 2; }
__host__ __device__ __forceinline__ int perm32(int rho) { const int n = rho >> 4, i = rho & 15; return 8 * (i >> 2) + 4 * n + (i & 3); }

struct Unit { int pm, pn; };
struct Gemm { const bf16_t* A; const bf16_t* Bt; int M, N, K; };

struct StaticOrder {
    int nM, nN, nwg, G, c;
    __host__ __device__ void init(int M, int N, int G_, int c_) { nM = M / BM; nN = N / BM; nwg = nM * nN; G = G_; c = c_; }
    __host__ __device__ bool next(int i, Unit& u) const {
        const long L = (long)i * G + c; if (L >= nwg) return false;
        int wgid = (int)L; { const int q = nwg / NXCD, r = nwg % NXCD, xcd = wgid % NXCD, off = wgid / NXCD; wgid = (xcd < r ? xcd * (q + 1) : r * (q + 1) + (xcd - r) * q) + off; }
        const int nig = WGM * nN, gid = wgid / nig, fm = gid * WGM, gsz = (nM - fm) < WGM ? (nM - fm) : WGM;
        u.pm = fm + ((wgid % nig) % gsz); u.pn = (wgid % nig) / gsz; return true;
    }
    __device__ __forceinline__ void a_ready(const Unit&) const {}
    __device__ __forceinline__ void done(const Unit&) const {}
};

__device__ __forceinline__ unsigned cvt_pk_bf16(float lo, float hi) { unsigned r; asm volatile("v_cvt_pk_bf16_f32 %0, %1, %2" : "=v"(r) : "v"(lo), "v"(hi)); return r; }

struct EpiBf16 {
    static constexpr bool PERM = true, AFTER_DRAIN = false;
    bf16_t* O; int ldc;
    __device__ __forceinline__ void operator()(const f32x4 (&acc)[2][2][4][2], const Unit& u, int wr, int wc, int fr, int fq) const {
        const int row0 = u.pm * BM + wr * 64 + fr; const int col0 = u.pn * BM + wc * 32 + 8 * fq;
#pragma unroll
        for (int ai = 0; ai < 2; ++ai)
#pragma unroll
            for (int m = 0; m < 4; ++m) { bf16_t* rowp = O + (size_t)(row0 + ai * HALF + m * 16) * ldc + col0;
#pragma unroll
                for (int bj = 0; bj < 2; ++bj) { const f32x4 v0 = acc[ai][bj][m][0], v1 = acc[ai][bj][m][1];
                    u32x4 w; w.x = cvt_pk_bf16(v0[0], v0[1]); w.y = cvt_pk_bf16(v0[2], v0[3]); w.z = cvt_pk_bf16(v1[0], v1[1]); w.w = cvt_pk_bf16(v1[2], v1[3]);
                    *(u32x4*)(rowp + bj * HALF) = w; } }
    }
};
struct EpiF32 {
    static constexpr bool PERM = false, AFTER_DRAIN = false;
    float* O; int ldc;
    __device__ __forceinline__ void operator()(const f32x4 (&acc)[2][2][4][2], const Unit& u, int wr, int wc, int fr, int fq) const {
        const int row0 = u.pm * BM + wr * 64 + fr; const int col0 = u.pn * BM + wc * 32 + 4 * fq;
#pragma unroll
        for (int ai = 0; ai < 2; ++ai)
#pragma unroll
            for (int m = 0; m < 4; ++m) { float* rowp = O + (size_t)(row0 + ai * HALF + m * 16) * ldc + col0;
#pragma unroll
                for (int bj = 0; bj < 2; ++bj)
#pragma unroll
                    for (int n = 0; n < 2; ++n) *(f32x4*)(rowp + bj * HALF + n * 16) = acc[ai][bj][m][n]; }
    }
};
struct EpiRes {
    static constexpr bool PERM = false, AFTER_DRAIN = false;
    const float* src_lat; const float* src_ctx; float* dst_lat; float* dst_ctx; const float* gate;
    __device__ __forceinline__ void operator()(const f32x4 (&acc)[2][2][4][2], const Unit& u, int wr, int wc, int fr, int fq) const {
        const bool isc = u.pm >= 64; const int smp = isc ? 2 : (u.pm >> 5);
        const int prow = (isc ? (u.pm - 64) * BM : u.pm * BM) + wr * 64 + fr;
        const float* src = isc ? src_ctx : src_lat; float* dst = isc ? dst_ctx : dst_lat;
        const float* gt = gate + smp * 6144 + 2048;
        const int col0 = u.pn * BM + wc * 32 + 4 * fq;
        f32x4 gv[2][2];
#pragma unroll
        for (int bj = 0; bj < 2; ++bj)
#pragma unroll
            for (int n = 0; n < 2; ++n) gv[bj][n] = *(const f32x4*)(gt + col0 + bj * HALF + n * 16);
#pragma unroll
        for (int ai = 0; ai < 2; ++ai)
#pragma unroll
            for (int m = 0; m < 4; ++m) { const size_t off = (size_t)(prow + ai * HALF + m * 16) * 1024 + col0;
#pragma unroll
                for (int bj = 0; bj < 2; ++bj)
#pragma unroll
                    for (int n = 0; n < 2; ++n) { const f32x4 s = *(const f32x4*)(src + off + bj * HALF + n * 16);
                        *(f32x4*)(dst + off + bj * HALF + n * 16) = s + gv[bj][n] * acc[ai][bj][m][n]; } }
    }
};

template <class Epi, class Sched, bool ALIGN_EPI = false, bool SP2 = false>
__device__ __forceinline__ void gemm_phase(PG8_LAS unsigned char* lds, const Gemm g, const Sched& S, const Epi& E, const int tid) {
    const int wid = __builtin_amdgcn_readfirstlane(tid >> 6), lane = tid & 63, wr = wid >> 2, wc = wid & 3, fr = lane & 15, fq = lane >> 4;
    const int K = g.K, nt = K / BK;
    unsigned voffA[2], voffB[2];
#pragma unroll
    for (int i = 0; i < 2; ++i) { int R, C; stage_rc(tid * 16 + i * 8192, R, C); const int Rb = Epi::PERM ? ((R & ~31) + perm32(R & 31)) : R;
        voffA[i] = (unsigned)(R * K + C) * 2u; voffB[i] = (unsigned)(Rb * K + C) * 2u; }
    const size_t kstep = (size_t)(BK * 2);
    const size_t hstep = (size_t)HALF * K * 2;
    const size_t tstep = 2 * hstep;
    const unsigned ldsw = (unsigned)wid * 1024u;
    const int aoff = lds_byte(wr * 64 + fr, fq * 8), boff = lds_byte(wc * 32 + fr, fq * 8);
#define PG8_SA(b, h) (((b) * 2 + (h)) * HTB)
#define PG8_SB(b, h) ((4 + (b) * 2 + (h)) * HTB)
#define PG8_STAGE(bufoff, gbase, voff) do { _Pragma("unroll") for (int _i = 0; _i < 2; ++_i) \
        __builtin_amdgcn_global_load_lds((const unsigned*)((const char*)(gbase) + (voff)[_i]), (PG8_LAS unsigned*)(lds + (bufoff) + ldsw + _i * 8192), 16, 0, 0); } while (0)
#define PG8_LDA(dst, b, h) do { _Pragma("unroll") for (int m = 0; m < 4; ++m) _Pragma("unroll") for (int k = 0; k < 2; ++k) dst[m][k] = *(const PG8_LAS bf16x8*)(lds + PG8_SA(b, h) + aoff + m * 2048 + k * 1024); } while (0)
#define PG8_LDB(dst, b, h) do { _Pragma("unroll") for (int n = 0; n < 2; ++n) _Pragma("unroll") for (int k = 0; k < 2; ++k) dst[n][k] = *(const PG8_LAS bf16x8*)(lds + PG8_SB(b, h) + boff + n * 2048 + k * 1024); } while (0)
#define PG8_MMA(ai, bj, At, Bt) do { __builtin_amdgcn_s_setprio(1); _Pragma("unroll") for (int m = 0; m < 4; ++m) _Pragma("unroll") for (int n = 0; n < 2; ++n) _Pragma("unroll") for (int k = 0; k < 2; ++k) \
        acc[ai][bj][m][n] = __builtin_amdgcn_mfma_f32_16x16x32_bf16(Bt[n][k], At[m][k], acc[ai][bj][m][n], 0, 0, 0); __builtin_amdgcn_s_setprio(0); } while (0)
#define PG8_WAIT_V(n) asm volatile("s_waitcnt vmcnt(" #n ")" ::: "memory")
#define PG8_WAIT_L(n) asm volatile("s_waitcnt lgkmcnt(" #n ")" ::: "memory")
#define PG8_BAR __builtin_amdgcn_s_barrier()
#define PG8_SCHED __builtin_amdgcn_sched_barrier(0)
    Unit cur, nxt; int ui = 0;
    if (!S.next(0, cur)) return;
    f32x4 acc[2][2][4][2];
#pragma unroll
    for (int a = 0; a < 2; ++a)
#pragma unroll
        for (int b = 0; b < 2; ++b)
#pragma unroll
            for (int m = 0; m < 4; ++m)
#pragma unroll
                for (int n = 0; n < 2; ++n) acc[a][b][m][n] = (f32x4){0.f, 0.f, 0.f, 0.f};
    bf16x8 At[4][2], B0[2][2], B1[2][2];
    const char* cA = (const char*)g.A + (size_t)cur.pm * tstep; const char* cB = (const char*)g.Bt + (size_t)cur.pn * tstep;
    S.a_ready(cur);
    if constexpr (SP2) {
        PG8_STAGE(PG8_SB(0, 0), cB, voffB); PG8_STAGE(PG8_SB(0, 1), cB + hstep, voffB); PG8_STAGE(PG8_SA(0, 0), cA, voffA); PG8_STAGE(PG8_SA(0, 1), cA + hstep, voffA);
        if (wr == 1) PG8_BAR;
        PG8_WAIT_V(2); PG8_BAR;
        PG8_STAGE(PG8_SB(1, 0), cB + kstep, voffB); PG8_STAGE(PG8_SA(1, 0), cA + kstep, voffA); PG8_STAGE(PG8_SB(1, 1), cB + hstep + kstep, voffB);
        PG8_WAIT_V(6); PG8_BAR;
    } else {
        PG8_STAGE(PG8_SB(0, 0), cB, voffB); PG8_STAGE(PG8_SA(0, 0), cA, voffA); PG8_STAGE(PG8_SB(0, 1), cB + hstep, voffB); PG8_STAGE(PG8_SA(0, 1), cA + hstep, voffA);
        if (wr == 1) PG8_BAR;
        PG8_WAIT_V(4); PG8_BAR;
        PG8_STAGE(PG8_SB(1, 0), cB + kstep, voffB); PG8_STAGE(PG8_SA(1, 0), cA + kstep, voffA); PG8_STAGE(PG8_SB(1, 1), cB + hstep + kstep, voffB);
        PG8_WAIT_V(6); PG8_BAR;
    }
    for (;;) {
        const bool has_next = S.next(ui + 1, nxt);
        const char* nA = has_next ? (const char*)g.A + (size_t)nxt.pm * tstep : cA; const char* nB = has_next ? (const char*)g.Bt + (size_t)nxt.pn * tstep : cB;
        for (int t = 0; t < nt; t += 2) {
            const bool last = (t == nt - 2);
            const char* a1 = cA + (size_t)(t + 1) * kstep;
            const char* a2 = last ? nA : cA + (size_t)(t + 2) * kstep; const char* b2 = last ? nB : cB + (size_t)(t + 2) * kstep;
            const char* a3 = a2 + kstep; const char* b3 = b2 + kstep;
            if (last && has_next) S.a_ready(nxt);
            if constexpr (SP2) {
            PG8_LDB(B0, 0, 0); PG8_LDB(B1, 0, 1); PG8_SCHED; PG8_LDA(At, 0, 0); PG8_STAGE(PG8_SA(1, 1), a1 + hstep, voffA);
            PG8_WAIT_V(8); PG8_WAIT_L(0); PG8_BAR; PG8_MMA(0, 0, At, B0); PG8_MMA(0, 1, At, B1); PG8_BAR; PG8_SCHED;
            PG8_LDA(At, 0, 1); PG8_STAGE(PG8_SB(0, 0), b2, voffB); PG8_STAGE(PG8_SB(0, 1), b2 + hstep, voffB); PG8_STAGE(PG8_SA(0, 0), a2, voffA);
            PG8_WAIT_V(8); PG8_WAIT_L(0); PG8_BAR; PG8_MMA(1, 0, At, B0); PG8_MMA(1, 1, At, B1); PG8_BAR; PG8_SCHED;
            PG8_LDB(B0, 1, 0); PG8_LDB(B1, 1, 1); PG8_SCHED; PG8_LDA(At, 1, 0); PG8_STAGE(PG8_SA(0, 1), a2 + hstep, voffA);
            PG8_WAIT_V(8); PG8_WAIT_L(0); PG8_BAR; PG8_MMA(0, 0, At, B0); PG8_MMA(0, 1, At, B1); PG8_BAR; PG8_SCHED;
            PG8_LDA(At, 1, 1); PG8_STAGE(PG8_SB(1, 0), b3, voffB); PG8_STAGE(PG8_SB(1, 1), b3 + hstep, voffB); PG8_STAGE(PG8_SA(1, 0), a3, voffA);
            PG8_WAIT_V(8); PG8_WAIT_L(0); PG8_BAR; PG8_MMA(1, 0, At, B0); PG8_MMA(1, 1, At, B1); PG8_BAR; PG8_SCHED;
            } else {
            PG8_LDB(B0, 0, 0); PG8_SCHED; PG8_LDA(At, 0, 0); PG8_STAGE(PG8_SA(1, 1), a1 + hstep, voffA);
            PG8_WAIT_L(8); PG8_BAR; PG8_WAIT_L(0); PG8_MMA(0, 0, At, B0); PG8_BAR; PG8_SCHED;
            PG8_LDB(B1, 0, 1); PG8_STAGE(PG8_SB(0, 0), b2, voffB);
            PG8_BAR; PG8_WAIT_L(0); PG8_MMA(0, 1, At, B1); PG8_BAR;
            PG8_LDA(At, 0, 1); PG8_STAGE(PG8_SA(0, 0), a2, voffA);
            PG8_BAR; PG8_WAIT_L(0); PG8_MMA(1, 0, At, B0); PG8_BAR; PG8_SCHED;
            PG8_STAGE(PG8_SB(0, 1), b2 + hstep, voffB);
            PG8_WAIT_V(6); PG8_BAR; PG8_MMA(1, 1, At, B1); PG8_BAR;
            PG8_LDB(B0, 1, 0); PG8_SCHED; PG8_LDA(At, 1, 0); PG8_STAGE(PG8_SA(0, 1), a2 + hstep, voffA);
            PG8_WAIT_L(8); PG8_BAR; PG8_WAIT_L(0); PG8_MMA(0, 0, At, B0); PG8_BAR; PG8_SCHED;
            PG8_LDB(B1, 1, 1); PG8_STAGE(PG8_SB(1, 0), b3, voffB);
            PG8_BAR; PG8_WAIT_L(0); PG8_MMA(0, 1, At, B1); PG8_BAR;
            PG8_LDA(At, 1, 1); PG8_STAGE(PG8_SA(1, 0), a3, voffA);
            PG8_BAR; PG8_WAIT_L(0); PG8_MMA(1, 0, At, B0); PG8_BAR; PG8_SCHED;
            PG8_STAGE(PG8_SB(1, 1), b3 + hstep, voffB);
            PG8_WAIT_V(6); PG8_BAR; PG8_MMA(1, 1, At, B1); PG8_BAR;
            }
        }
        if constexpr (ALIGN_EPI) { if (wr == 0) PG8_BAR; }
        if constexpr (!Epi::AFTER_DRAIN) { E(acc, cur, wr, wc, fr, fq); S.done(cur); }
        if (!has_next) break;
#pragma unroll
        for (int a = 0; a < 2; ++a)
#pragma unroll
            for (int b = 0; b < 2; ++b)
#pragma unroll
                for (int m = 0; m < 4; ++m)
#pragma unroll
                    for (int n = 0; n < 2; ++n) acc[a][b][m][n] = (f32x4){0.f, 0.f, 0.f, 0.f};
        cur = nxt; cA = nA; cB = nB; ++ui;
        if constexpr (ALIGN_EPI) { if (wr == 1) PG8_BAR; }
    }
    PG8_WAIT_V(0);
    if constexpr (!ALIGN_EPI) { if (wr == 0) PG8_BAR; }
    PG8_BAR;
    if constexpr (Epi::AFTER_DRAIN) { E.fused(acc, cur, wr, wc, fr, fq, lds, wid, lane); S.done(cur); }
#undef PG8_SA
#undef PG8_SB
#undef PG8_STAGE
#undef PG8_LDA
#undef PG8_LDB
#undef PG8_MMA
#undef PG8_WAIT_V
#undef PG8_WAIT_L
#undef PG8_BAR
#undef PG8_SCHED
}
}
#ifndef ZMASK
#define ZMASK 0
#endif
#define ZF(bit) ((ZMASK & (bit)) ? 0.f : 1.f)
using pg8::bf16_t; using pg8::bf16x8; using pg8::f32x4; using pg8::u32x4;
constexpr int NWAVES = 8, NTHR = 512;
constexpr int DM = 1024, TLAT = 8192, TCTX = 256, MLAT = 2 * TLAT, MCTX = 2 * TCTX, MALL = MLAT + MCTX;
constexpr int DIN = 3152, DINP = 3328;
constexpr int C_CH = 0, C_CB = 256, C_CC = 512, C_RR = 768, C_RK = 1024, C_RV = 1280, C_XW = 1536, C_XA = 1552, C_XG = 1568,
              C_AQ = 1600, C_AK = 1856, C_AV = 1984, C_MQ = 2112, C_MK = 2368, C_MV = 2624, C_MO = 2880, C_MG = 3136;
constexpr float EPSN = 1e-6f;
constexpr int NCHK = 66;
constexpr int CST = 4160;
constexpr int RWREC = 4608;
constexpr size_t MiB = 1u << 20;
constexpr size_t WS_CTL = 0, CTL_ZERO_BYTES = 1 * MiB, WS_MOD = 1 * MiB;
constexpr size_t WS_WIN = 2 * MiB, WIN_LSTRIDE = (size_t)DINP * DM * 2;
constexpr size_t WS_WOUT = 16 * MiB, WOUT_LSTRIDE = 2 * MiB;
constexpr size_t WS_WEFF = 20 * MiB, WEFF_LSTRIDE = 4 * MiB;
constexpr size_t WS_XC = 28 * MiB, WS_GA = 30 * MiB, WS_H = 32 * MiB, WS_YCAT = 65 * MiB, WS_U = 98 * MiB, WS_V = 130 * MiB;
constexpr size_t WS_P = 162 * MiB, WS_RW = 270 * MiB, WS_YR = 345 * MiB, WS_QA = 378 * MiB, WS_KA = 387 * MiB;
constexpr size_t WS_LC = 392 * MiB, WS_ST = 409 * MiB, WS_LB = 426 * MiB, WS_EG = 427 * MiB, WS_GB = 444 * MiB, WS_BS = 453 * MiB, WS_END = 454 * MiB;
constexpr size_t WS_S = WS_P;
static_assert(WS_P + (size_t)MALL * DINP * 2 <= WS_RW && WS_RW + (size_t)MALL * RWREC <= WS_YR && WS_S + (size_t)MALL * 2048 * 4 <= WS_YR, "ws map");
static_assert(WS_LC + (size_t)16 * NCHK * CST * 4 <= WS_ST && WS_ST + (size_t)16 * NCHK * CST * 4 <= WS_LB && WS_EG + (size_t)MALL * 128 * 8 <= WS_GB, "ws map 2");
constexpr int CW_BAR = 4096;
constexpr int RING_BYTES = 131072, LDSCTL_OFF = RING_BYTES, MISC_OFF = LDSCTL_OFF + 320, LDS_BYTES = 147456;

#define GAS __attribute__((address_space(1)))
#define LAS __attribute__((address_space(3)))
typedef unsigned u32x2 __attribute__((ext_vector_type(2)));
typedef float f32x2 __attribute__((ext_vector_type(2)));
typedef __bf16 bf16x2_t __attribute__((ext_vector_type(2)));
typedef GAS unsigned gu32;
#define LDS_WAIT() asm volatile("s_waitcnt lgkmcnt(0)" ::: "memory")

__device__ __forceinline__ float lo2f(unsigned w) { return __uint_as_float(w << 16); }
__device__ __forceinline__ float hi2f(unsigned w) { return __uint_as_float(w & 0xffff0000u); }
__device__ __forceinline__ float bf2f(bf16_t b) { return __uint_as_float((unsigned)b << 16); }
__device__ __forceinline__ unsigned f2bf(float f) { unsigned u = __float_as_uint(f); return (u + 0x7fffu + ((u >> 16) & 1u)) >> 16; }
__device__ __forceinline__ unsigned pk2(float lo, float hi) { return f2bf(lo) | (f2bf(hi) << 16); }
__device__ __forceinline__ f32x4 ld4bf(const bf16_t* p) { const u32x2 w = *(const u32x2*)p; return (f32x4){lo2f(w.x), hi2f(w.x), lo2f(w.y), hi2f(w.y)}; }
__device__ __forceinline__ void st4bf(bf16_t* p, f32x4 v) { u32x2 w; w.x = pk2(v[0], v[1]); w.y = pk2(v[2], v[3]); *(u32x2*)p = w; }
__device__ __forceinline__ float sigmoidf_(float x) { return 1.f / (1.f + __expf(-x)); }
__device__ __forceinline__ float tanhf_(float x) { const float e = __expf(-2.f * fabsf(x)); const float t = (1.f - e) / (1.f + e); return x < 0.f ? -t : t; }
template <int CTRL> __device__ __forceinline__ float dppf(float x) { return __int_as_float(__builtin_amdgcn_update_dpp(0, __float_as_int(x), CTRL, 0xf, 0xf, true)); }
__device__ __forceinline__ float red16(float x) { x += dppf<0xB1>(x); x += dppf<0x4E>(x); x += dppf<0x141>(x); x += dppf<0x140>(x); return x; }
__device__ __forceinline__ float wave_sum(float v) {
#pragma unroll
    for (int o = 1; o < 64; o <<= 1) v += __shfl_xor(v, o);
    return v;
}
#define XB_TMO      128
#define XB_XCNT(j)  (256  + 64 * (j))
#define XB_XSUB(j)  (1280 + 64 * (j))
#define XB_XGEN(j)  (2304 + 64 * (j))
#define XB_TOP      3328
#define XB_TOPGEN   3392
#define XCD_BAR_WORDS 3456
#define XB_SPIN_CAP (1u << 18)

__device__ __forceinline__ unsigned xb_ld(unsigned* p)              { return __hip_atomic_load(p, __ATOMIC_RELAXED, __HIP_MEMORY_SCOPE_AGENT); }
__device__ __forceinline__ unsigned xb_add(unsigned* p, unsigned v) { return __hip_atomic_fetch_add(p, v, __ATOMIC_RELAXED, __HIP_MEMORY_SCOPE_AGENT); }
__device__ __forceinline__ unsigned xb_xcc_id() { return (unsigned)__builtin_amdgcn_s_getreg((3 << 11) | 20) & 0xFu; }
#define XB_SPIN(cond, bar) do { unsigned _sp = 0; while (cond) { __builtin_amdgcn_s_sleep(1); \
    if ((++_sp & 255u) == 0u) { if (xb_ld(&(bar)[XB_TMO])) break; if (_sp > XB_SPIN_CAP) { atomicAdd(&(bar)[XB_TMO], 1u); break; } } } } while (0)

struct XcdBarrier {
    unsigned* bar; unsigned x;
    volatile LAS unsigned* st;
};

__device__ __forceinline__ XcdBarrier xcd_barrier_post(unsigned* bar, volatile LAS unsigned* st) {
    XcdBarrier b; b.bar = bar; b.x = xb_xcc_id(); b.st = st;
    if (threadIdx.x == 0) (void)xb_add(&bar[XB_XCNT(b.x)], 1u);
    return b;
}
__device__ __forceinline__ void xcd_barrier_complete(unsigned* bar, unsigned x, unsigned& nloc, unsigned& nx) {
    const unsigned G = gridDim.x * gridDim.y * gridDim.z;
    unsigned sum, cnt, mine, sp = 0u;
    for (;;) {
        sum = 0u; cnt = 0u; mine = 0u;
#pragma unroll
        for (unsigned j = 0; j < 16; ++j) { const unsigned c = xb_ld(&bar[XB_XCNT(j)]); sum += c; cnt += (c > 0u) ? 1u : 0u; mine = (j == x) ? c : mine; }
        if (sum == G) break;
        __builtin_amdgcn_s_sleep(1);
        if ((++sp & 255u) == 0u) { if (xb_ld(&bar[XB_TMO])) break; if (sp > XB_SPIN_CAP) { atomicAdd(&bar[XB_TMO], 1u); break; } }
    }
    nloc = mine > 0u ? mine : 1u; nx = cnt > 0u ? cnt : 1u;
}

__device__ __forceinline__ void xcd_barrier(const XcdBarrier& b) {
    asm volatile("s_waitcnt vmcnt(0)" ::: "memory");
    __syncthreads();
    if (threadIdx.x == 0) {
        unsigned* bar = b.bar;
        __builtin_amdgcn_s_waitcnt(0);
        unsigned nloc = b.st[0], nx = b.st[1];
        if (nloc == 0u) { xcd_barrier_complete(bar, b.x, nloc, nx); b.st[0] = nloc; b.st[1] = nx; }
        const unsigned old = xb_add(&bar[XB_XSUB(b.x)], 1u);
        const unsigned gen = old / nloc;
        if (old + 1u == (gen + 1u) * nloc) {
            __builtin_amdgcn_fence(__ATOMIC_RELEASE, "agent");
            asm volatile("s_waitcnt vmcnt(0)" ::: "memory");
            const unsigned og = xb_add(&bar[XB_TOP], 1u);
            const unsigned tg = og / nx;
            if (og + 1u == (tg + 1u) * nx) xb_add(&bar[XB_TOPGEN], 1u);
            else XB_SPIN(xb_ld(&bar[XB_TOPGEN]) == tg, bar);
            __builtin_amdgcn_fence(__ATOMIC_ACQUIRE, "agent");
            xb_add(&bar[XB_XGEN(b.x)], 1u);
            asm volatile("s_waitcnt vmcnt(0)" ::: "memory");
        } else {
            XB_SPIN(xb_ld(&bar[XB_XGEN(b.x)]) == gen, bar);
            __builtin_amdgcn_fence(__ATOMIC_ACQUIRE, "agent");
            asm volatile("s_waitcnt vmcnt(0)" ::: "memory");
        }
    }
    __syncthreads();
}
struct Ctx {
    LAS unsigned char* lds; int tid, lane, wave, vcu, G;
    const float* in[32]; float* out; unsigned char* ws;
};
#define WSP(T, off) ((T*)(F.ws + (off)))

__device__ __forceinline__ void p0_transpose_item(const float* W, int K, int N, bf16_t* WT, LAS float* scr, int item, int lane) {
    const int nblk = (N + 31) / 32, kb = item / nblk, nb = item % nblk, k0 = 64 * kb, n0 = 32 * nb;
    const int nn = n0 + (lane & 31);
#pragma unroll 8
    for (int i = 0; i < 32; ++i) { const int kk = 2 * i + (lane >> 5); scr[kk * 33 + (lane & 31)] = nn < N ? W[(size_t)(k0 + kk) * N + nn] : 0.f; }
    LDS_WAIT(); asm volatile("" ::: "memory");
    const int c = lane & 7;
#pragma unroll
    for (int j = 0; j < 4; ++j) { const int n = (lane >> 3) + 8 * j; const LAS float* s = scr + (8 * c) * 33 + n;
        u32x4 o; o.x = pk2(s[0 * 33], s[1 * 33]); o.y = pk2(s[2 * 33], s[3 * 33]); o.z = pk2(s[4 * 33], s[5 * 33]); o.w = pk2(s[6 * 33], s[7 * 33]);
        *(u32x4*)(WT + (size_t)(n0 + n) * K + k0 + 8 * c) = o; }
    LDS_WAIT(); asm volatile("" ::: "memory");
}
__device__ __forceinline__ void convert_uv(const Ctx& F, int l) {
    const size_t n8 = (size_t)16384 * 1024 / 8;
    const f32x4* su = (const f32x4*)(F.in[30] + (size_t)l * 16384 * 1024); const f32x4* sv = (const f32x4*)(F.in[31] + (size_t)l * 16384 * 1024);
    u32x4* du = WSP(u32x4, WS_U); u32x4* dv = WSP(u32x4, WS_V);
    for (size_t i = (size_t)F.vcu * NTHR + F.tid; i < n8; i += (size_t)F.G * NTHR) {
        const f32x4 a = su[2 * i], b = su[2 * i + 1], c = sv[2 * i], d = sv[2 * i + 1];
        u32x4 o; o.x = pk2(a[0], a[1]); o.y = pk2(a[2], a[3]); o.z = pk2(b[0], b[1]); o.w = pk2(b[2], b[3]); du[i] = o;
        u32x4 p; p.x = pk2(c[0], c[1]); p.y = pk2(c[2], c[3]); p.z = pk2(d[0], d[1]); p.w = pk2(d[2], d[3]); dv[i] = p;
    }
}
__device__ __forceinline__ void phase_prologue(const Ctx& F) {
    float* MOD = WSP(float, WS_MOD);
    {
        LAS float* sl = (LAS float*)F.lds; LAS float* red = sl + 3072;
        for (int it = F.vcu; it < 192; it += F.G) {
            const int l = it / 96, n0 = (it % 96) * 64;
            for (int i = F.tid; i < 3072; i += NTHR) { const int s = i >> 10, k = i & 1023; const float c = s < 2 ? F.in[1][s * 1024 + k] : F.in[3][k]; sl[i] = c / (1.f + __expf(-c)); }
            __syncthreads();
            const int c = F.tid & 63, kg = F.tid >> 6;
            const float* W = F.in[4] + (size_t)l * 1024 * 6144 + n0 + c;
            float a0 = 0.f, a1 = 0.f, a2 = 0.f;
#pragma unroll 8
            for (int k = kg * 128; k < kg * 128 + 128; ++k) { const float w = W[(size_t)k * 6144]; a0 += sl[k] * w; a1 += sl[1024 + k] * w; a2 += sl[2048 + k] * w; }
            red[(kg * 3 + 0) * 64 + c] = a0; red[(kg * 3 + 1) * 64 + c] = a1; red[(kg * 3 + 2) * 64 + c] = a2;
            __syncthreads();
            if (F.tid < 192) { const int s = F.tid >> 6, cc = F.tid & 63; float t = F.in[5][l * 6144 + n0 + cc];
#pragma unroll
                for (int g = 0; g < 8; ++g) t += red[(g * 3 + s) * 64 + cc];
                MOD[(l * 3 + s) * 6144 + n0 + cc] = t; }
            __syncthreads();
        }
    }
    {
        LAS float* scr = (LAS float*)(F.lds + F.wave * 16384);
        const int gw = F.vcu * NWAVES + F.wave, NGW = F.G * NWAVES;
        constexpr int I_IN = 16 * 99, I_OUT = 16 * 32, I_L = I_IN + I_OUT;
        for (int it = gw; it < 2 * I_L; it += NGW) {
            const int l = it / I_L; int r = it % I_L;
            if (r < I_IN) p0_transpose_item(F.in[8] + (size_t)l * DM * DIN, DM, DIN, WSP(bf16_t, WS_WIN + l * WIN_LSTRIDE), scr, r, F.lane);
            else p0_transpose_item(F.in[9] + (size_t)l * DM * DM, DM, DM, WSP(bf16_t, WS_WOUT + l * WOUT_LSTRIDE), scr, r - I_IN, F.lane);
        }
        for (int i = F.vcu * NTHR + F.tid; i < 2 * 160 * 128; i += F.G * NTHR) { const int l = i / (160 * 128), r = i % (160 * 128);
            *(u32x4*)(WSP(bf16_t, WS_WIN + l * WIN_LSTRIDE) + (size_t)3168 * DM + (size_t)r * 8) = (u32x4){0u, 0u, 0u, 0u}; }
    }
    __syncthreads();
    {
        LAS float* KEYS = (LAS float*)F.lds; LAS float* WQl = KEYS + 128 * 129;
        for (int it = F.vcu; it < 512; it += F.G) {
            const int l = it >> 8, hh = (it >> 4) & 15, kb = it & 15;
            const float* ksrc = F.in[29] + ((size_t)l * 16 + hh) * 128 * 128;
            for (int i = F.tid; i < 16384; i += NTHR) KEYS[(i >> 7) * 129 + (i & 127)] = ksrc[i];
            const float* wsrc = F.in[28] + (size_t)l * DM * 2048 + (size_t)(kb * 64) * 2048 + hh * 128;
            for (int i = F.tid; i < 64 * 128; i += NTHR) { const int kk = i >> 7, d = i & 127; WQl[d * 68 + kk] = wsrc[(size_t)kk * 2048 + d]; }
            __syncthreads();
            const int key = F.tid & 127, kq = F.tid >> 7;
            float acc[16];
#pragma unroll
            for (int j = 0; j < 16; ++j) acc[j] = 0.f;
#pragma unroll 4
            for (int d = 0; d < 128; ++d) { const float a = KEYS[key * 129 + d]; const LAS f32x4* wq = (const LAS f32x4*)(WQl + d * 68 + kq * 16);
#pragma unroll
                for (int q = 0; q < 4; ++q) { const f32x4 w = wq[q]; acc[4 * q] += a * w[0]; acc[4 * q + 1] += a * w[1]; acc[4 * q + 2] += a * w[2]; acc[4 * q + 3] += a * w[3]; } }
            bf16_t* dst = WSP(bf16_t, WS_WEFF + l * WEFF_LSTRIDE) + (size_t)(hh * 128 + key) * DM + kb * 64 + kq * 16;
            u32x4 o0, o1; o0.x = pk2(acc[0], acc[1]); o0.y = pk2(acc[2], acc[3]); o0.z = pk2(acc[4], acc[5]); o0.w = pk2(acc[6], acc[7]);
            o1.x = pk2(acc[8], acc[9]); o1.y = pk2(acc[10], acc[11]); o1.z = pk2(acc[12], acc[13]); o1.w = pk2(acc[14], acc[15]);
            *(u32x4*)dst = o0; *(u32x4*)(dst + 8) = o1;
            __syncthreads();
        }
    }
    convert_uv(F, 0);
}

__device__ __forceinline__ void phase_norm(const Ctx& F, int l, int which, int nrows, const float* xlat, const float* xctx) {
    const float* gain = F.in[6 + which] + l * DM; const float* mod = WSP(float, WS_MOD) + (size_t)l * 3 * 6144;
    const int shoff = which ? 3072 : 0, scoff = which ? 4096 : 1024;
    bf16_t* H = WSP(bf16_t, WS_H);
    const int gw = F.vcu * NWAVES + F.wave, NGW = F.G * NWAVES;
    for (int row = gw; row < nrows; row += NGW) {
        const bool isc = row >= MLAT; const float* src = isc ? xctx + (size_t)(row - MLAT) * DM : xlat + (size_t)row * DM; const int smp = isc ? 2 : (row >> 13);
        const float* mb = mod + smp * 6144;
        f32x4 v[4]; float ss = 0.f;
#pragma unroll
        for (int j = 0; j < 4; ++j) { v[j] = *(const f32x4*)(src + F.lane * 4 + 256 * j); ss += (v[j][0] * v[j][0] + v[j][1] * v[j][1]) + (v[j][2] * v[j][2] + v[j][3] * v[j][3]); }
        const float rs = rsqrtf(wave_sum(ss) * (1.f / DM) + EPSN);
#pragma unroll
        for (int j = 0; j < 4; ++j) { const int c = F.lane * 4 + 256 * j; const f32x4 g = *(const f32x4*)(gain + c), sc = *(const f32x4*)(mb + scoff + c), sh = *(const f32x4*)(mb + shoff + c);
            const f32x4 o = (v[j] * rs * g) * (1.f + sc) + sh; st4bf(H + (size_t)row * DM + c, o); }
    }
}

__device__ __forceinline__ float log_sigmoid_(float x) { return fminf(x, 0.f) - __logf(1.f + __expf(-fabsf(x))); }
__device__ __forceinline__ void phase_prep(const Ctx& F, int l) {
    LAS float* W2s = (LAS float*)F.lds; LAS float* A2s = W2s + 8192; LAS float* G2s = A2s + 8192; LAS float* tsc = G2s + 8192 + F.wave * 64;
    { const float* w2 = F.in[13] + l * 8192; const float* a2 = F.in[15] + l * 8192; const float* g2 = F.in[16] + l * 8192;
      for (int i = F.tid; i < 8192; i += NTHR) { W2s[i] = w2[i]; A2s[i] = a2[i]; G2s[i] = g2[i]; } }
    __syncthreads();
    const bf16_t* P = WSP(bf16_t, WS_P); bf16_t* YC = WSP(bf16_t, WS_YCAT); bf16_t* QA = WSP(bf16_t, WS_QA); bf16_t* KA = WSP(bf16_t, WS_KA);
    unsigned char* RW = WSP(unsigned char, WS_RW); bf16_t* GB = WSP(bf16_t, WS_GB); float* BS = WSP(float, WS_BS); float* GA = WSP(float, WS_GA);
    const int lane = F.lane, c4 = lane * 4, i16 = lane & 15;
    const f32x4 cw0 = *(const f32x4*)(F.in[10] + l * 768 + c4), cw1 = *(const f32x4*)(F.in[10] + l * 768 + 256 + c4), cw2 = *(const f32x4*)(F.in[10] + l * 768 + 512 + c4);
    const f32x4 cg = *(const f32x4*)(F.in[11] + l * 256 + c4);
    const f32x4 qg = *(const f32x4*)(F.in[21] + l * 64 + (c4 & 63)), kg = *(const f32x4*)(F.in[22] + l * 64 + (c4 & 63));
    const f32x4 k_k = *(const f32x4*)(F.in[17] + l * 256 + c4), k_a = *(const f32x4*)(F.in[18] + l * 256 + c4), r_k = *(const f32x4*)(F.in[19] + l * 256 + c4);
    f32x4 w0[2], a0[2];
#pragma unroll
    for (int d = 0; d < 2; ++d) { w0[d] = *(const f32x4*)(F.in[12] + (l * 2 + d) * 256 + c4); a0[d] = *(const f32x4*)(F.in[14] + (l * 2 + d) * 256 + c4); }
    float invf[4];
#pragma unroll
    for (int j = 0; j < 4; ++j) invf[j] = exp2f(-(float)((c4 + j) & 15) * (13.287712379549449f / 16.f));
    const int gw = F.vcu * NWAVES + F.wave, NGW = F.G * NWAVES;
    for (int row = gw; row < MALL; row += NGW) {
        const bool isc = row >= MLAT; const int t = isc ? ((row - MLAT) & 255) : (row & 8191); const int T = isc ? TCTX : TLAT;
        const bf16_t* pr = P + (size_t)row * DINP;
        {
            const f32x4 h1 = ld4bf(pr + C_CH + c4), bg = ld4bf(pr + C_CB + c4), c1 = ld4bf(pr + C_CC + c4);
            f32x4 up = {0.f, 0.f, 0.f, 0.f}, un = {0.f, 0.f, 0.f, 0.f};
            if (t > 0) up = ld4bf(pr - DINP + C_CH + c4) * ld4bf(pr - DINP + C_CC + c4);
            if (t < T - 1) un = ld4bf(pr + DINP + C_CH + c4) * ld4bf(pr + DINP + C_CC + c4);
            const f32x4 y = bg * (cw0 * up + cw1 * (c1 * h1) + cw2 * un);
            const float ss = red16((y[0] * y[0] + y[1] * y[1]) + (y[2] * y[2] + y[3] * y[3]));
            const float rs = rsqrtf(ss * (1.f / 64.f) + EPSN);
            st4bf(YC + (size_t)row * DM + c4, y * rs * cg * ZF(2));
        }
        asm volatile("" ::: "memory");
        {
            const f32x4 q = ld4bf(pr + C_AQ + c4); const f32x4 k = ld4bf(pr + C_AK + (c4 & 127));
            const float qs = red16((q[0] * q[0] + q[1] * q[1]) + (q[2] * q[2] + q[3] * q[3]));
            const float ks = red16((k[0] * k[0] + k[1] * k[1]) + (k[2] * k[2] + k[3] * k[3]));
            f32x4 qn = q * rsqrtf(qs * (1.f / 64.f) + EPSN) * qg, kn = k * rsqrtf(ks * (1.f / 64.f) + EPSN) * kg;
            if (!isc) {
                f32x4 qp, kp;
#pragma unroll
                for (int j = 0; j < 4; ++j) { qp[j] = __shfl_xor(qn[j], 4); kp[j] = __shfl_xor(kn[j], 4); }
                const int d0 = c4 & 63; const float pos = (d0 < 32) ? (float)(t >> 6) : (float)(t & 63); const bool lowh = (d0 & 16) == 0;
#pragma unroll
                for (int j = 0; j < 4; ++j) { const float th = pos * invf[j]; const float cs = __cosf(th), sn = __sinf(th);
                    qn[j] = lowh ? qn[j] * cs - qp[j] * sn : qn[j] * cs + qp[j] * sn; kn[j] = lowh ? kn[j] * cs - kp[j] * sn : kn[j] * cs + kp[j] * sn; }
            }
            st4bf(QA + (size_t)row * 256 + c4, qn * (0.125f * 1.4426950408889634f));
            if (lane < 32) st4bf(KA + (size_t)row * 128 + c4, kn);
        }
        asm volatile("" ::: "memory");
        {
            const f32x4 r = ld4bf(pr + C_RR + c4), k = ld4bf(pr + C_RK + c4);
            { const float xv = bf2f(pr[C_XW + lane]);
              tsc[lane] = lane < 16 ? tanhf_(xv) : (lane < 32 ? xv : sigmoidf_(xv)); }
            const f32x4 kx = k * k_k;
            const float kss = red16((kx[0] * kx[0] + kx[1] * kx[1]) + (kx[2] * kx[2] + kx[3] * kx[3]));
            const f32x4 kk = kx * rsqrtf(kss + EPSN);
            bf16_t* recb = (bf16_t*)(RW + (size_t)row * RWREC); float* recf = (float*)(RW + (size_t)row * RWREC + 2560);
            st4bf(recb + c4, kk);
            f32x4 kdsum = {0.f, 0.f, 0.f, 0.f};
#pragma unroll
            for (int d = 0; d < 2; ++d) {
                f32x4 dw = w0[d], da = a0[d];
#pragma unroll 4
                for (int ii = 0; ii < 16; ++ii) { dw += tsc[ii] * *(const LAS f32x4*)(W2s + (d * 16 + ii) * 256 + c4); da += tsc[16 + ii] * *(const LAS f32x4*)(A2s + (d * 16 + ii) * 256 + c4); }
                f32x4 dec, av;
#pragma unroll
                for (int j = 0; j < 4; ++j) { dec[j] = __expf(-0.6065306597126334f * sigmoidf_(dw[j])); av[j] = sigmoidf_(da[j]); }
                const f32x4 kd = k * (1.f + (av - 1.f) * k_a);
                kdsum += kd;
                st4bf(recb + 256 + d * 256 + c4, kk * av);
                st4bf(recb + 768 + d * 256 + c4, kd);
                *(f32x4*)(recf + d * 256 + c4) = dec;
            }
            f32x4 gv = {0.f, 0.f, 0.f, 0.f};
#pragma unroll 4
            for (int ii = 0; ii < 32; ++ii) gv += tsc[32 + ii] * *(const LAS f32x4*)(G2s + ii * 256 + c4);
            st4bf(GB + (size_t)row * 256 + c4, gv);
            const f32x4 bt = r * kdsum * r_k;
            const float bsum = red16((bt[0] + bt[1]) + (bt[2] + bt[3]));
            if (i16 == 0) BS[(size_t)row * 4 + (lane >> 4)] = bsum;
        }
        asm volatile("" ::: "memory");
        if (lane < 16) { const int dir = lane >> 3, gate = (lane >> 2) & 1, hd = lane & 3; const float x = bf2f(pr[C_MG + lane]);
            const float bias = gate ? F.in[26][(l * 2 + dir) * 4 + hd] : F.in[25][(l * 2 + dir) * 4 + hd];
            GA[(size_t)row * 16 + lane] = gate ? log_sigmoid_(x + bias) : (x + bias); }
    }
}
__device__ __forceinline__ int scan_row(int b, int dir, int i) {
    if (i < TCTX) return MLAT + b * TCTX + (dir ? (TCTX - 1 - i) : i);
    const int p = i - TCTX; return b * TLAT + (dir ? (TLAT - 1 - p) : p);
}
__device__ __forceinline__ void rwkv_scan(const Ctx& F, int blk) {
    const int chain = blk >> 2, quarter = blk & 3, b = chain >> 3, head = (chain >> 1) & 3, dir = chain & 1;
    const bool scanner = F.wave < 4;
    const int rowv = (quarter * 4 + (F.wave & 3)) * 4 + (F.lane >> 4), s = F.lane & 15;
    LAS float* buf = (LAS float*)F.lds;
    const bf16_t* P = WSP(bf16_t, WS_P); const unsigned char* RW = WSP(unsigned char, WS_RW); float* YR = WSP(float, WS_YR) + (size_t)dir * MALL * 256;
    const int st = F.tid >> 4, sub = F.tid & 15;
    constexpr int NSTEP = TCTX + TLAT, NCH = NSTEP / 32;
    u32x2 g_kk, g_al, g_kd, g_r, g_v; f32x4 g_w;
#define RW_LOAD(c) do { const int row_ = scan_row(b, dir, (c) * 32 + st); const bf16_t* rb_ = (const bf16_t*)(RW + (size_t)row_ * RWREC) + head * 64 + sub * 4; \
        g_kk = *(const u32x2*)rb_; g_al = *(const u32x2*)(rb_ + 256 + dir * 256); g_kd = *(const u32x2*)(rb_ + 768 + dir * 256); \
        g_w = *(const f32x4*)((const float*)(RW + (size_t)row_ * RWREC + 2560) + dir * 256 + head * 64 + sub * 4); \
        const bf16_t* pp_ = P + (size_t)row_ * DINP + head * 64 + sub * 4; g_r = *(const u32x2*)(pp_ + C_RR); g_v = *(const u32x2*)(pp_ + C_RV); } while (0)
#define RW_STORE(par) do { LAS float* d_ = buf + ((par) * 32 + st) * 384 + sub * 4; \
        *(LAS f32x4*)(d_) = (f32x4){lo2f(g_kk.x), hi2f(g_kk.x), lo2f(g_kk.y), hi2f(g_kk.y)}; *(LAS f32x4*)(d_ + 64) = (f32x4){lo2f(g_al.x), hi2f(g_al.x), lo2f(g_al.y), hi2f(g_al.y)}; \
        *(LAS f32x4*)(d_ + 128) = (f32x4){lo2f(g_kd.x), hi2f(g_kd.x), lo2f(g_kd.y), hi2f(g_kd.y)}; *(LAS f32x4*)(d_ + 192) = g_w; \
        *(LAS f32x4*)(d_ + 256) = (f32x4){lo2f(g_r.x), hi2f(g_r.x), lo2f(g_r.y), hi2f(g_r.y)}; *(LAS f32x4*)(d_ + 320) = (f32x4){lo2f(g_v.x), hi2f(g_v.x), lo2f(g_v.y), hi2f(g_v.y)}; } while (0)
    f32x4 S = {0.f, 0.f, 0.f, 0.f};
    RW_LOAD(0); RW_STORE(0); __syncthreads();
    for (int c = 0; c < NCH; ++c) {
        const int par = c & 1;
        if (c + 1 < NCH) RW_LOAD(c + 1);
        if (scanner) {
        float ykeep = 0.f;
        f32x4 Lkk[3], Lal[3], Lkd[3], Lw[3], Lr[3]; float Lv[3];
#define SC_LD(set, i_) do { const LAS float* d_ = buf + (par * 32 + (i_)) * 384; Lkk[set] = *(const LAS f32x4*)(d_ + s * 4); Lal[set] = *(const LAS f32x4*)(d_ + 64 + s * 4); \
            Lkd[set] = *(const LAS f32x4*)(d_ + 128 + s * 4); Lw[set] = *(const LAS f32x4*)(d_ + 192 + s * 4); Lr[set] = *(const LAS f32x4*)(d_ + 256 + s * 4); Lv[set] = d_[320 + rowv]; } while (0)
        SC_LD(0, 0); SC_LD(1, 1);
#pragma unroll
        for (int i = 0; i < 32; ++i) {
            if (i + 2 < 32) SC_LD((i + 2) % 3, i + 2);
            const f32x4 kk = Lkk[i % 3], al = Lal[i % 3], kd = Lkd[i % 3], w = Lw[i % 3], r = Lr[i % 3]; const float vr = Lv[i % 3];
            const float sa = red16((S[0] * kk[0] + S[1] * kk[1]) + (S[2] * kk[2] + S[3] * kk[3]));
            S = S * w + (vr * kd - sa * al);
            const float y = red16((S[0] * r[0] + S[1] * r[1]) + (S[2] * r[2] + S[3] * r[3]));
            ykeep = (s == (i & 15)) ? y : ykeep;
            if ((i & 15) == 15) {
                const int stp = c * 32 + (i - 15) + s; const int pc = dir ? (TCTX - 1 - stp) : stp, pl = dir ? (TLAT - 1 - (stp - TCTX)) : (stp - TCTX);
                const int row = stp < TCTX ? (MLAT + b * TCTX + pc) : (b * TLAT + pl);
                YR[(size_t)row * 256 + head * 64 + rowv] = ykeep; }
        }
#undef SC_LD
        }
        if (c + 1 < NCH) RW_STORE(par ^ 1);
        __syncthreads();
    }
#undef RW_LOAD
#undef RW_STORE
}

typedef union { u32x4 u; bf16x8 b; } frag_u;
__device__ __forceinline__ void attn_unit(const Ctx& F, int l, int unit) {
    LAS bf16_t* Kl = (LAS bf16_t*)F.lds; LAS bf16_t* Vt = Kl + 64 * 72;
    const bf16_t* P = WSP(bf16_t, WS_P); const bf16_t* QA = WSP(bf16_t, WS_QA); const bf16_t* KA = WSP(bf16_t, WS_KA); bf16_t* YC = WSP(bf16_t, WS_YCAT);
    const bool isc = unit >= 256; int b, kvh, n;
    if (!isc) { b = unit >> 7; kvh = (unit >> 6) & 1; n = unit & 63; } else { const int u = unit - 256; b = u >> 2; kvh = (u >> 1) & 1; n = u & 1; }
    const int g = F.wave >> 2, ps = F.wave & 3, head = kvh * 2 + g, i = F.lane & 15, gq = F.lane >> 4;
    const int qpos0 = n * 128 + ps * 32, qrow0 = (isc ? MLAT + b * TCTX : b * TLAT) + qpos0;
    bf16x8 Qf[2][2];
#pragma unroll
    for (int qb = 0; qb < 2; ++qb)
#pragma unroll
        for (int ks = 0; ks < 2; ++ks) Qf[qb][ks] = *(const bf16x8*)(QA + (size_t)(qrow0 + qb * 16 + i) * 256 + head * 64 + ks * 32 + gq * 8);
    const float sinkl = F.in[23][l * 4 + head] * 1.4426950408889634f;
    float mrun[2] = {sinkl, sinkl}, lsum[2]; lsum[0] = lsum[1] = (gq == 0) ? 1.f : 0.f;
    f32x4 ao[4][2];
#pragma unroll
    for (int db = 0; db < 4; ++db) { ao[db][0] = (f32x4){0.f, 0.f, 0.f, 0.f}; ao[db][1] = (f32x4){0.f, 0.f, 0.f, 0.f}; }
    const int ntl = isc ? 4 : 10;
    const int skey = F.tid >> 3, sch = F.tid & 7;
    for (int tt = 0; tt < ntl; ++tt) {
        int krow0, kpos0 = 0; bool band = false;
        if (!isc && tt < 6) { const int kt = 2 * (n - 1) + tt; if (kt < 0 || kt >= 128) continue; krow0 = b * TLAT + kt * 64; kpos0 = kt * 64; band = true; }
        else { const int c = isc ? tt : tt - 6; krow0 = MLAT + b * TCTX + c * 64; }
        __syncthreads();
        { const u32x4 kv = *(const u32x4*)(KA + (size_t)(krow0 + skey) * 128 + kvh * 64 + sch * 8);
          const u32x4 vv = *(const u32x4*)(P + (size_t)(krow0 + skey) * DINP + C_AV + kvh * 64 + sch * 8);
          *(LAS u32x4*)(Kl + skey * 72 + sch * 8) = kv;
          const unsigned ww[4] = {vv.x, vv.y, vv.z, vv.w};
#pragma unroll
          for (int j = 0; j < 4; ++j) { Vt[(sch * 8 + 2 * j) * 72 + skey] = (bf16_t)(ww[j] & 0xffffu); Vt[(sch * 8 + 2 * j + 1) * 72 + skey] = (bf16_t)(ww[j] >> 16); } }
        __syncthreads();
        f32x4 sc[4][2];
#pragma unroll
        for (int kb = 0; kb < 4; ++kb) {
            sc[kb][0] = (f32x4){0.f, 0.f, 0.f, 0.f}; sc[kb][1] = (f32x4){0.f, 0.f, 0.f, 0.f};
#pragma unroll
            for (int ks = 0; ks < 2; ++ks) { const bf16x8 kf = *(const LAS bf16x8*)(Kl + (kb * 16 + i) * 72 + ks * 32 + gq * 8);
                sc[kb][0] = __builtin_amdgcn_mfma_f32_16x16x32_bf16(kf, Qf[0][ks], sc[kb][0], 0, 0, 0);
                sc[kb][1] = __builtin_amdgcn_mfma_f32_16x16x32_bf16(kf, Qf[1][ks], sc[kb][1], 0, 0, 0); }
        }
#pragma unroll
        for (int qb = 0; qb < 2; ++qb) {
            const int qp = qpos0 + qb * 16 + i;
            float mx = -1e30f;
#pragma unroll
            for (int kb = 0; kb < 4; ++kb)
#pragma unroll
                for (int r = 0; r < 4; ++r) { if (band) { const int dd = (kpos0 + kb * 16 + 4 * gq + r) - qp; if (dd > 128 || dd < -128) sc[kb][qb][r] = -1e30f; } mx = fmaxf(mx, sc[kb][qb][r]); }
            mx = fmaxf(mx, __shfl_xor(mx, 16)); mx = fmaxf(mx, __shfl_xor(mx, 32));
            const float mnew = fmaxf(mrun[qb], mx), alpha = exp2f(mrun[qb] - mnew); mrun[qb] = mnew;
            float ps_ = 0.f;
#pragma unroll
            for (int kb = 0; kb < 4; ++kb)
#pragma unroll
                for (int r = 0; r < 4; ++r) { const float p = exp2f(sc[kb][qb][r] - mnew); sc[kb][qb][r] = p; ps_ += p; }
            lsum[qb] = lsum[qb] * alpha + ps_;
#pragma unroll
            for (int db = 0; db < 4; ++db) ao[db][qb] *= alpha;
        }
#pragma unroll
        for (int ks2 = 0; ks2 < 2; ++ks2) {
            frag_u pf[2];
#pragma unroll
            for (int qb = 0; qb < 2; ++qb) { pf[qb].u.x = pg8::cvt_pk_bf16(sc[2 * ks2][qb][0], sc[2 * ks2][qb][1]); pf[qb].u.y = pg8::cvt_pk_bf16(sc[2 * ks2][qb][2], sc[2 * ks2][qb][3]);
                pf[qb].u.z = pg8::cvt_pk_bf16(sc[2 * ks2 + 1][qb][0], sc[2 * ks2 + 1][qb][1]); pf[qb].u.w = pg8::cvt_pk_bf16(sc[2 * ks2 + 1][qb][2], sc[2 * ks2 + 1][qb][3]); }
#pragma unroll
            for (int db = 0; db < 4; ++db) { frag_u vf; const LAS bf16_t* vp = Vt + (db * 16 + i) * 72 + (2 * ks2) * 16 + 4 * gq;
                const u32x2 v0 = *(const LAS u32x2*)vp, v1 = *(const LAS u32x2*)(vp + 16); vf.u = (u32x4){v0.x, v0.y, v1.x, v1.y};
                ao[db][0] = __builtin_amdgcn_mfma_f32_16x16x32_bf16(vf.b, pf[0].b, ao[db][0], 0, 0, 0);
                ao[db][1] = __builtin_amdgcn_mfma_f32_16x16x32_bf16(vf.b, pf[1].b, ao[db][1], 0, 0, 0); }
        }
    }
    const float* og = F.in[24] + l * 256 + head * 64;
#pragma unroll
    for (int qb = 0; qb < 2; ++qb) {
        float lt = lsum[qb]; lt += __shfl_xor(lt, 16); lt += __shfl_xor(lt, 32);
        const float il = 1.f / lt; float ss = 0.f;
#pragma unroll
        for (int db = 0; db < 4; ++db) { ao[db][qb] *= il; ss += (ao[db][qb][0] * ao[db][qb][0] + ao[db][qb][1] * ao[db][qb][1]) + (ao[db][qb][2] * ao[db][qb][2] + ao[db][qb][3] * ao[db][qb][3]); }
        ss += __shfl_xor(ss, 16); ss += __shfl_xor(ss, 32);
        const float rs = rsqrtf(ss * (1.f / 64.f) + EPSN);
        bf16_t* yo = YC + (size_t)(qrow0 + qb * 16 + i) * DM + 512 + head * 64;
#pragma unroll
        for (int db = 0; db < 4; ++db) { const f32x4 gg = *(const f32x4*)(og + db * 16 + 4 * gq); st4bf(yo + db * 16 + 4 * gq, ao[db][qb] * rs * gg * ZF(8)); }
    }
    __syncthreads();
}

__device__ __forceinline__ int ml_row(int b, int dir, int j, int tp) {
    if (j < 2) { const int p = j * 128 + tp; return MLAT + b * TCTX + (dir ? (TCTX - 1 - p) : p); }
    const int p = (j - 2) * 128 + tp; return b * TLAT + (dir ? (TLAT - 1 - p) : p);
}
__device__ __forceinline__ void scan128_add(float& x0, float& x1, int lane) {
    x1 += x0; float t = x1;
#pragma unroll
    for (int o = 1; o < 64; o <<= 1) { const float u = __shfl_up(t, o); if (lane >= o) t += u; }
    const float ex = t - x1; x0 += ex; x1 = t;
}
__device__ __forceinline__ void scan128_max(float& x0, float& x1, int lane) {
    x1 = fmaxf(x1, x0); float t = x1;
#pragma unroll
    for (int o = 1; o < 64; o <<= 1) { const float u = __shfl_up(t, o); if (lane >= o) t = fmaxf(t, u); }
    const float pv = __shfl_up(t, 1); if (lane > 0) x0 = fmaxf(x0, pv); x1 = t;
}
__device__ __forceinline__ void ml_stage_T(const Ctx& F, const bf16_t* P, int b, int dir, int j, int col0, LAS bf16_t* dst, const LAS float* sw, float cscale) {
#pragma unroll
    for (int it = 0; it < 2; ++it) { const int id = F.tid + it * NTHR, tp = id >> 3, ch = id & 7;
        const u32x4 v = *(const u32x4*)(P + (size_t)ml_row(b, dir, j, tp) * DINP + col0 + ch * 8); const float s = (sw ? sw[tp] : 1.f) * cscale;
        const unsigned ww[4] = {v.x, v.y, v.z, v.w};
#pragma unroll
        for (int q = 0; q < 4; ++q) { dst[(ch * 8 + 2 * q) * 136 + tp] = (bf16_t)f2bf(lo2f(ww[q]) * s); dst[(ch * 8 + 2 * q + 1) * 136 + tp] = (bf16_t)f2bf(hi2f(ww[q]) * s); } }
}
__device__ __forceinline__ void ml_stage_R(const Ctx& F, const bf16_t* P, int b, int dir, int j, int col0, LAS bf16_t* dst, float cscale) {
#pragma unroll
    for (int it = 0; it < 2; ++it) { const int id = F.tid + it * NTHR, tp = id >> 3, ch = id & 7;
        u32x4 v = *(const u32x4*)(P + (size_t)ml_row(b, dir, j, tp) * DINP + col0 + ch * 8);
        if (cscale != 1.f) { v.x = pk2(lo2f(v.x) * cscale, hi2f(v.x) * cscale); v.y = pk2(lo2f(v.y) * cscale, hi2f(v.y) * cscale); v.z = pk2(lo2f(v.z) * cscale, hi2f(v.z) * cscale); v.w = pk2(lo2f(v.w) * cscale, hi2f(v.w) * cscale); }
        *(LAS u32x4*)(dst + tp * 72 + ch * 8) = v; }
}
__device__ __forceinline__ void mlstm_local(const Ctx& F, int task) {
    const int chain = task / NCHK, j = task % NCHK, b = chain >> 3, head = (chain >> 1) & 3, dir = chain & 1;
    const bf16_t* P = WSP(bf16_t, WS_P); const float* GA = WSP(float, WS_GA);
    LAS bf16_t* Vt = (LAS bf16_t*)F.lds; LAS bf16_t* Kt = Vt + 64 * 136; LAS float* wS = (LAS float*)(Kt + 64 * 136); LAS float* sc2 = wS + 128;
    __syncthreads();
    if (F.wave == 0) {
        const int r0 = ml_row(b, dir, j, 2 * F.lane), r1 = ml_row(b, dir, j, 2 * F.lane + 1);
        const float li0 = GA[(size_t)r0 * 16 + dir * 8 + head], li1 = GA[(size_t)r1 * 16 + dir * 8 + head];
        float b0 = GA[(size_t)r0 * 16 + dir * 8 + 4 + head], b1 = GA[(size_t)r1 * 16 + dir * 8 + 4 + head];
        scan128_add(b0, b1, F.lane);
        const float bend = __shfl(b1, 63);
        const float d0 = bend - b0 + li0, d1 = bend - b1 + li1;
        float mx = fmaxf(d0, d1);
#pragma unroll
        for (int o = 1; o < 64; o <<= 1) mx = fmaxf(mx, __shfl_xor(mx, o));
        wS[2 * F.lane] = __expf(d0 - mx); wS[2 * F.lane + 1] = __expf(d1 - mx);
        if (F.lane == 0) { sc2[0] = mx; sc2[1] = bend; }
    }
    __syncthreads();
    ml_stage_T(F, P, b, dir, j, C_MV + head * 64, Vt, wS, 1.f);
    ml_stage_T(F, P, b, dir, j, C_MK + head * 64, Kt, nullptr, 0.125f);
    __syncthreads();
    float* LC = WSP(float, WS_LC) + (size_t)task * CST;
    { const int vb = F.wave >> 1, i = F.lane & 15, gq = F.lane >> 4;
#pragma unroll
      for (int kk2 = 0; kk2 < 2; ++kk2) { const int kb = 2 * (F.wave & 1) + kk2; f32x4 acc = {0.f, 0.f, 0.f, 0.f};
#pragma unroll
          for (int ks = 0; ks < 4; ++ks) { const bf16x8 a = *(const LAS bf16x8*)(Vt + (vb * 16 + i) * 136 + ks * 32 + gq * 8), bb = *(const LAS bf16x8*)(Kt + (kb * 16 + i) * 136 + ks * 32 + gq * 8);
              acc = __builtin_amdgcn_mfma_f32_16x16x32_bf16(a, bb, acc, 0, 0, 0); }
#pragma unroll
          for (int r = 0; r < 4; ++r) LC[(vb * 16 + 4 * gq + r) * 64 + kb * 16 + i] = acc[r]; } }
    if (F.tid < 64) { float a = 0.f;
#pragma unroll 8
        for (int s = 0; s < 128; ++s) a += wS[s] * bf2f(Kt[F.tid * 136 + s]);
        LC[4096 + F.tid] = a; }
    if (F.tid == 0) { float* LB = WSP(float, WS_LB); LB[task * 2] = sc2[0]; LB[task * 2 + 1] = sc2[1]; }
}
__device__ __forceinline__ void mlstm_chain(const Ctx& F) {
    const int gt = F.vcu * NTHR + F.tid; if (gt >= 16 * CST) return;
    const int chain = gt / CST, e = gt % CST;
    const float* LC = WSP(float, WS_LC) + (size_t)chain * NCHK * CST + e; float* ST = WSP(float, WS_ST) + (size_t)chain * NCHK * CST + e;
    const float* LB = WSP(float, WS_LB) + chain * NCHK * 2; float* SM = WSP(float, WS_LB) + 4096 + chain * NCHK;
    float m = 0.f, x = 0.f;
#pragma unroll 6
    for (int j = 0; j < NCHK; ++j) {
        const float d = LC[(size_t)j * CST], L = LB[2 * j], Bv = LB[2 * j + 1];
        ST[(size_t)j * CST] = x; if (e == 0) SM[j] = m;
        const float mn = fmaxf(Bv + m, L);
        x = __expf(Bv + m - mn) * x + __expf(L - mn) * d; m = mn;
    }
}
__device__ __forceinline__ void mlstm_out(const Ctx& F, int l, int unit) {
    const bool isc = unit >= 512; int b, chunk, head;
    if (!isc) { b = unit >> 8; chunk = (unit >> 2) & 63; head = unit & 3; } else { const int u = unit - 512; b = u >> 3; chunk = (u >> 2) & 1; head = u & 3; }
    const bf16_t* P = WSP(bf16_t, WS_P); const float* GA = WSP(float, WS_GA); bf16_t* YC = WSP(bf16_t, WS_YCAT);
    LAS bf16_t* Ql = (LAS bf16_t*)F.lds; LAS bf16_t* Kl = Ql + 128 * 72; LAS bf16_t* Vt = Kl + 128 * 72; LAS bf16_t* Cb = Vt + 64 * 136;
    LAS float* nS = (LAS float*)(Cb + 64 * 72); LAS float* aS = nS + 64; LAS float* bS = aS + 128; LAS float* MS = bS + 128; LAS float* Hs = MS + 128;
    const int i = F.lane & 15, gq = F.lane >> 4, w = F.wave;
    for (int dir = 0; dir < 2; ++dir) {
        const int j = isc ? (dir ? 1 - chunk : chunk) : 2 + (dir ? 63 - chunk : chunk);
        const int chain = (b * 4 + head) * 2 + dir;
        const float* ST = WSP(float, WS_ST) + ((size_t)chain * NCHK + j) * CST; const float mprev = WSP(float, WS_LB)[4096 + chain * NCHK + j];
        __syncthreads();
        if (w == 0) {
            const int r0 = ml_row(b, dir, j, 2 * F.lane), r1 = ml_row(b, dir, j, 2 * F.lane + 1);
            const float li0 = GA[(size_t)r0 * 16 + dir * 8 + head], li1 = GA[(size_t)r1 * 16 + dir * 8 + head];
            float b0 = GA[(size_t)r0 * 16 + dir * 8 + 4 + head], b1 = GA[(size_t)r1 * 16 + dir * 8 + 4 + head];
            scan128_add(b0, b1, F.lane);
            const float a0 = li0 - b0, a1 = li1 - b1; float A0 = a0, A1 = a1;
            scan128_max(A0, A1, F.lane);
            aS[2 * F.lane] = a0; aS[2 * F.lane + 1] = a1; bS[2 * F.lane] = b0; bS[2 * F.lane + 1] = b1;
            MS[2 * F.lane] = fmaxf(A0, mprev); MS[2 * F.lane + 1] = fmaxf(A1, mprev);
        }
        ml_stage_R(F, P, b, dir, j, C_MQ + head * 64, Ql, 1.f);
        ml_stage_R(F, P, b, dir, j, C_MK + head * 64, Kl, 0.125f);
        ml_stage_T(F, P, b, dir, j, C_MV + head * 64, Vt, nullptr, 1.f);
        { const f32x4 c0 = *(const f32x4*)(ST + F.tid * 8), c1 = *(const f32x4*)(ST + F.tid * 8 + 4); const int v = F.tid >> 3, k0 = (F.tid & 7) * 8;
          u32x4 o; o.x = pk2(c0[0], c0[1]); o.y = pk2(c0[2], c0[3]); o.z = pk2(c1[0], c1[1]); o.w = pk2(c1[2], c1[3]); *(LAS u32x4*)(Cb + v * 72 + k0) = o;
          if (F.tid < 64) nS[F.tid] = ST[4096 + F.tid]; }
        __syncthreads();
        const int t = 16 * w + i; const float Mt = MS[t], bt = bS[t];
        bf16x8 Qf[2];
#pragma unroll
        for (int ks = 0; ks < 2; ++ks) Qf[ks] = *(const LAS bf16x8*)(Ql + t * 72 + ks * 32 + gq * 8);
        f32x4 sc[8];
#pragma unroll
        for (int sb = 0; sb < 8; ++sb) { sc[sb] = (f32x4){0.f, 0.f, 0.f, 0.f};
            if (sb <= w) {
#pragma unroll
                for (int ks = 0; ks < 2; ++ks) { const bf16x8 kf = *(const LAS bf16x8*)(Kl + (sb * 16 + i) * 72 + ks * 32 + gq * 8); sc[sb] = __builtin_amdgcn_mfma_f32_16x16x32_bf16(kf, Qf[ks], sc[sb], 0, 0, 0); }
#pragma unroll
                for (int r = 0; r < 4; ++r) { const int s = sb * 16 + 4 * gq + r; sc[sb][r] = (s <= t) ? sc[sb][r] * __expf(aS[s] - Mt) : 0.f; }
            } }
        float den = 0.f;
#pragma unroll
        for (int sb = 0; sb < 8; ++sb) den += (sc[sb][0] + sc[sb][1]) + (sc[sb][2] + sc[sb][3]);
        den += __shfl_xor(den, 16); den += __shfl_xor(den, 32);
        f32x4 nm[4], it_[4];
#pragma unroll
        for (int vb = 0; vb < 4; ++vb) { nm[vb] = (f32x4){0.f, 0.f, 0.f, 0.f}; it_[vb] = (f32x4){0.f, 0.f, 0.f, 0.f}; }
#pragma unroll
        for (int ks2 = 0; ks2 < 4; ++ks2) if (2 * ks2 <= w) {
            frag_u pf; pf.u.x = pg8::cvt_pk_bf16(sc[2 * ks2][0], sc[2 * ks2][1]); pf.u.y = pg8::cvt_pk_bf16(sc[2 * ks2][2], sc[2 * ks2][3]);
            pf.u.z = pg8::cvt_pk_bf16(sc[2 * ks2 + 1][0], sc[2 * ks2 + 1][1]); pf.u.w = pg8::cvt_pk_bf16(sc[2 * ks2 + 1][2], sc[2 * ks2 + 1][3]);
#pragma unroll
            for (int vb = 0; vb < 4; ++vb) { frag_u vf; const LAS bf16_t* vp = Vt + (vb * 16 + i) * 136 + (2 * ks2) * 16 + 4 * gq;
                const u32x2 v0 = *(const LAS u32x2*)vp, v1 = *(const LAS u32x2*)(vp + 16); vf.u = (u32x4){v0.x, v0.y, v1.x, v1.y};
                nm[vb] = __builtin_amdgcn_mfma_f32_16x16x32_bf16(vf.b, pf.b, nm[vb], 0, 0, 0); }
        }
#pragma unroll
        for (int vb = 0; vb < 4; ++vb)
#pragma unroll
            for (int ks = 0; ks < 2; ++ks) { const bf16x8 cf = *(const LAS bf16x8*)(Cb + (vb * 16 + i) * 72 + ks * 32 + gq * 8); it_[vb] = __builtin_amdgcn_mfma_f32_16x16x32_bf16(cf, Qf[ks], it_[vb], 0, 0, 0); }
        float nq = 0.f;
#pragma unroll
        for (int c = 0; c < 2; ++c) { const u32x4 qv = *(const LAS u32x4*)(Ql + t * 72 + gq * 16 + c * 8); const unsigned ww[4] = {qv.x, qv.y, qv.z, qv.w};
#pragma unroll
            for (int q = 0; q < 4; ++q) nq += nS[gq * 16 + c * 8 + 2 * q] * lo2f(ww[q]) + nS[gq * 16 + c * 8 + 2 * q + 1] * hi2f(ww[q]); }
        nq += __shfl_xor(nq, 16); nq += __shfl_xor(nq, 32);
        const float wint = __expf(mprev - Mt); den += wint * nq;
        const float dn = 1.f / fmaxf(fabsf(den), __expf(-(bt + Mt)));
        const int torig = dir ? 127 - t : t;
#pragma unroll
        for (int vb = 0; vb < 4; ++vb)
#pragma unroll
            for (int r = 0; r < 4; ++r) { const float hv = (nm[vb][r] + wint * it_[vb][r]) * dn; LAS float* hp = Hs + torig * 65 + vb * 16 + 4 * gq + r; if (dir == 0) *hp = hv; else *hp += hv; }
    }
    __syncthreads();
    {
        const int t = F.tid >> 2, vq = F.tid & 3; const int row = (isc ? MLAT + b * TCTX : b * TLAT) + chunk * 128 + t;
        float hv[16], ss = 0.f;
#pragma unroll
        for (int q = 0; q < 16; ++q) { hv[q] = Hs[t * 65 + vq * 16 + q]; ss += hv[q] * hv[q]; }
        ss += __shfl_xor(ss, 1); ss += __shfl_xor(ss, 2);
        const float rs = rsqrtf(ss * (1.f / 64.f) + EPSN);
        const float* og = F.in[27] + l * 256 + head * 64 + vq * 16; const bf16_t* op = P + (size_t)row * DINP + C_MO + head * 64 + vq * 16;
        const u32x4 o0 = *(const u32x4*)op, o1 = *(const u32x4*)(op + 8); const unsigned ow[8] = {o0.x, o0.y, o0.z, o0.w, o1.x, o1.y, o1.z, o1.w};
        unsigned res[8];
#pragma unroll
        for (int q = 0; q < 8; ++q) { const float y0 = sigmoidf_(lo2f(ow[q])) * hv[2 * q] * rs * og[2 * q], y1 = sigmoidf_(hi2f(ow[q])) * hv[2 * q + 1] * rs * og[2 * q + 1]; res[q] = pk2(y0 * ZF(16), y1 * ZF(16)); }
        bf16_t* yo = YC + (size_t)row * DM + 768 + head * 64 + vq * 16;
        *(u32x4*)yo = (u32x4){res[0], res[1], res[2], res[3]}; *(u32x4*)(yo + 8) = (u32x4){res[4], res[5], res[6], res[7]};
    }
    __syncthreads();
}
__device__ __forceinline__ void rwkv_finish(const Ctx& F, int l, int nrows) {
    const bf16_t* P = WSP(bf16_t, WS_P); const float* YR = WSP(float, WS_YR); const bf16_t* GB = WSP(bf16_t, WS_GB); const float* BS = WSP(float, WS_BS); bf16_t* YC = WSP(bf16_t, WS_YCAT);
    const int c4 = F.lane * 4; const f32x4 lg = *(const f32x4*)(F.in[20] + l * 256 + c4);
    const int gw = F.vcu * NWAVES + F.wave, NGW = F.G * NWAVES;
    for (int row = gw; row < nrows; row += NGW) {
        const f32x4 y = *(const f32x4*)(YR + (size_t)row * 256 + c4) + *(const f32x4*)(YR + (size_t)(MALL + row) * 256 + c4);
        const float ss = red16((y[0] * y[0] + y[1] * y[1]) + (y[2] * y[2] + y[3] * y[3]));
        const float rs = rsqrtf(ss * (1.f / 64.f) + EPSN);
        const f32x4 v = ld4bf(P + (size_t)row * DINP + C_RV + c4), g = ld4bf(GB + (size_t)row * 256 + c4);
        const float bn = BS[(size_t)row * 4 + (F.lane >> 4)];
        st4bf(YC + (size_t)row * DM + 256 + c4, (y * rs * lg * ZF(32) + bn * v * ZF(64)) * g * ZF(4));
    }
}
__device__ __forceinline__ float clr7(float x) { return __uint_as_float(__float_as_uint(x) & 0xFFFFFF80u); }
__device__ __forceinline__ void ins16(float (&L)[16], float p) {
#pragma unroll
    for (int j = 15; j >= 1; --j) L[j] = __builtin_amdgcn_fmed3f(L[j - 1], L[j], p);
    L[0] = fmaxf(L[0], p);
}
__device__ __forceinline__ void peer_topk_task(const float* srow, u32x2* eg) {
    float L0[16], L1[16];
#pragma unroll
    for (int j = 0; j < 16; ++j) { L0[j] = -INFINITY; L1[j] = -INFINITY; }
    for (int i = 0; i < 128; i += 4) {
        const f32x4 a = *(const f32x4*)(srow + i), b = *(const f32x4*)(srow + 128 + i);
#pragma unroll
        for (int q = 0; q < 4; ++q) { ins16(L0, __uint_as_float((__float_as_uint(a[q]) & 0xFFFFFF80u) | (unsigned)(i + q)));
                                      ins16(L1, __uint_as_float((__float_as_uint(b[q]) & 0xFFFFFF80u) | (unsigned)(i + q))); }
    }
    float T[16];
#pragma unroll
    for (int j = 0; j < 16; ++j) T[j] = -INFINITY;
#pragma unroll
    for (int a = 0; a < 16; ++a)
#pragma unroll
        for (int b = 0; b < 16; ++b) if ((a + 1) * (b + 1) <= 16) { const float s = clr7(L0[a]) + clr7(L1[b]);
            ins16(T, __uint_as_float((__float_as_uint(s) & 0xFFFFFF00u) | (unsigned)(a * 16 + b))); }
    float e[16], sum = 0.f; const float mx = __uint_as_float(__float_as_uint(T[0]) & 0xFFFFFF00u);
#pragma unroll
    for (int j = 0; j < 16; ++j) { e[j] = __expf(__uint_as_float(__float_as_uint(T[j]) & 0xFFFFFF00u) - mx); sum += e[j]; }
    const float inv = 1.f / sum;
#pragma unroll
    for (int j = 0; j < 16; ++j) {
        const unsigned ab = __float_as_uint(T[j]) & 0xFFu, a = ab >> 4, b = ab & 15u; unsigned i0 = 0u, i1 = 0u;
#pragma unroll
        for (int q = 0; q < 16; ++q) { i0 = (a == (unsigned)q) ? (__float_as_uint(L0[q]) & 0x7Fu) : i0; i1 = (b == (unsigned)q) ? (__float_as_uint(L1[q]) & 0x7Fu) : i1; }
        eg[j] = (u32x2){i0 * 128u + i1, __float_as_uint(e[j] * inv)};
    }
}
__device__ __forceinline__ float gelu_tanh(float x) { const float u = 0.7978845608028654f * (x + 0.044715f * x * x * x); return 0.5f * x * (1.f + tanhf_(u)); }
__device__ __forceinline__ float dot2bf(unsigned w, unsigned x, float acc) { return __builtin_amdgcn_fdot2_f32_bf16(__builtin_bit_cast(bf16x2_t, w), __builtin_bit_cast(bf16x2_t, x), acc, false); }
__device__ __forceinline__ float wave_total63(float x) {
    x = red16(x);
    x += __int_as_float(__builtin_amdgcn_update_dpp(0, __float_as_int(x), 0x142, 0xa, 0xf, false));
    x += __int_as_float(__builtin_amdgcn_update_dpp(0, __float_as_int(x), 0x143, 0xc, 0xf, false));
    return x;
}
__device__ __forceinline__ void phase_peer(const Ctx& F, int l, int nrows, const float* mod, float* wr_override) {
    const float* S = WSP(float, WS_S); u32x2* EG = WSP(u32x2, WS_EG); const bf16_t* H = WSP(bf16_t, WS_H);
    const bf16_t* U = WSP(bf16_t, WS_U); const bf16_t* V = WSP(bf16_t, WS_V);
    const int tpb = nrows / F.G, tok0 = F.vcu * tpb;
    for (int task = F.tid; task < tpb * 8; task += NTHR) { const int row = tok0 + (task >> 3), hd = task & 7;
        peer_topk_task(S + (size_t)row * 2048 + hd * 256, EG + (size_t)row * 128 + hd * 16); }
    __threadfence_block(); __syncthreads();
    const int lane = F.lane;
    for (int tk = F.wave; tk < tpb; tk += NWAVES) {
        const int row = tok0 + tk; const bool isc = row >= MLAT; const int smp = isc ? 2 : (row >> 13);
        float* xrow = isc ? WSP(float, WS_XC) + (size_t)(row - MLAT) * DM : F.out + (size_t)row * DM;
        const u32x4 h0 = *(const u32x4*)(H + (size_t)row * DM + lane * 8), h1 = *(const u32x4*)(H + (size_t)row * DM + 512 + lane * 8);
        const u32x2 eg0 = EG[(size_t)row * 128 + lane], eg1 = EG[(size_t)row * 128 + 64 + lane];
        float act0 = 0.f, act1 = 0.f;
#pragma unroll 1
        for (int grp = 0; grp < 16; ++grp) {
            u32x4 ua[8], ub[8];
#pragma unroll
            for (int q = 0; q < 8; ++q) { const int ii = grp * 8 + q; const unsigned e = __builtin_amdgcn_readlane(ii < 64 ? eg0.x : eg1.x, ii & 63);
                const bf16_t* up = U + (size_t)e * DM + lane * 8; ua[q] = *(const u32x4*)up; ub[q] = *(const u32x4*)(up + 512); }
#pragma unroll
            for (int q = 0; q < 8; ++q) { const int ii = grp * 8 + q;
                float d = dot2bf(ua[q].x, h0.x, 0.f); d = dot2bf(ua[q].y, h0.y, d); d = dot2bf(ua[q].z, h0.z, d); d = dot2bf(ua[q].w, h0.w, d);
                float f = dot2bf(ub[q].x, h1.x, 0.f); f = dot2bf(ub[q].y, h1.y, f); f = dot2bf(ub[q].z, h1.z, f); f = dot2bf(ub[q].w, h1.w, f);
                const float tot = __int_as_float(__builtin_amdgcn_readlane(__float_as_int(wave_total63(d + f)), 63));
                if (ii < 64) act0 = (lane == (ii & 63)) ? tot : act0; else act1 = (lane == (ii & 63)) ? tot : act1; }
        }
        const float cf0 = __uint_as_float(eg0.y) * gelu_tanh(act0), cf1 = __uint_as_float(eg1.y) * gelu_tanh(act1);
        float acc[16];
#pragma unroll
        for (int q = 0; q < 16; ++q) acc[q] = 0.f;
#pragma unroll 1
        for (int grp = 0; grp < 16; ++grp) {
            u32x4 va[8], vb[8];
#pragma unroll
            for (int q = 0; q < 8; ++q) { const int ii = grp * 8 + q; const unsigned e = __builtin_amdgcn_readlane(ii < 64 ? eg0.x : eg1.x, ii & 63);
                const bf16_t* vp = V + (size_t)e * DM + lane * 8; va[q] = *(const u32x4*)vp; vb[q] = *(const u32x4*)(vp + 512); }
#pragma unroll
            for (int q = 0; q < 8; ++q) { const int ii = grp * 8 + q; const float cf = __int_as_float(__builtin_amdgcn_readlane(__float_as_int(ii < 64 ? cf0 : cf1), ii & 63));
                acc[0] += cf * lo2f(va[q].x); acc[1] += cf * hi2f(va[q].x); acc[2] += cf * lo2f(va[q].y); acc[3] += cf * hi2f(va[q].y);
                acc[4] += cf * lo2f(va[q].z); acc[5] += cf * hi2f(va[q].z); acc[6] += cf * lo2f(va[q].w); acc[7] += cf * hi2f(va[q].w);
                acc[8] += cf * lo2f(vb[q].x); acc[9] += cf * hi2f(vb[q].x); acc[10] += cf * lo2f(vb[q].y); acc[11] += cf * hi2f(vb[q].y);
                acc[12] += cf * lo2f(vb[q].z); acc[13] += cf * hi2f(vb[q].z); acc[14] += cf * lo2f(vb[q].w); acc[15] += cf * hi2f(vb[q].w); }
        }
        const float* gt = mod + smp * 6144 + 5120;
#pragma unroll
        for (int hh = 0; hh < 2; ++hh)
#pragma unroll
            for (int q = 0; q < 2; ++q) { const int c = hh * 512 + lane * 8 + q * 4; const f32x4 g = *(const f32x4*)(gt + c), x = *(const f32x4*)(xrow + c);
                *(f32x4*)((wr_override ? wr_override + (size_t)row * DM : xrow) + c) = x + ZF(1) * g * (f32x4){acc[hh * 8 + q * 4], acc[hh * 8 + q * 4 + 1], acc[hh * 8 + q * 4 + 2], acc[hh * 8 + q * 4 + 3]}; }
    }
}

constexpr int PH_PER_LAYER = 10, N_PHASES = 1 + 2 * PH_PER_LAYER;
struct Args { const float* in[32]; float* out; unsigned char* ws; int ph_lo, ph_hi, li, pad; };
__global__ void __launch_bounds__(NTHR, 2) mk_fwd(Args args) {
    extern __shared__ __attribute__((aligned(16))) unsigned char lds[];
    Ctx F;
    F.lds = (LAS unsigned char*)lds;
    volatile LAS unsigned* MISC = (volatile LAS unsigned*)(F.lds + MISC_OFF);
    F.tid = threadIdx.x; F.lane = F.tid & 63; F.wave = __builtin_amdgcn_readfirstlane(F.tid >> 6);
    F.G = gridDim.x; { const int bx = blockIdx.x; F.vcu = (F.G % 8 == 0) ? (bx % 8) * (F.G / 8) + bx / 8 : bx; }
#pragma unroll
    for (int i = 0; i < 32; ++i) F.in[i] = args.in[i];
    F.out = args.out; F.ws = args.ws;
    for (int u = F.tid; u < (LDS_BYTES - LDSCTL_OFF) / 4; u += NTHR) ((LAS unsigned*)(F.lds + LDSCTL_OFF))[u] = 0u;
    __syncthreads();
    XcdBarrier bar; bar.bar = (unsigned*)(args.ws + WS_CTL) + CW_BAR; bar.x = 0; bar.st = nullptr;
#if !MK_MULTI
    bar = xcd_barrier_post((unsigned*)(args.ws + WS_CTL) + CW_BAR, MISC + 8);
#endif
    const int lo = args.ph_lo, hi = args.ph_hi;
#define IN(k) (lo <= (k) && (k) < hi)
#ifndef REP_PH
#define REP_PH -1
#endif
#define REPS(k) ((REP_PH == (k)) ? 2 : 1)
#define PHCTX Ctx Fp = F; { int t_ = F.tid; asm volatile("" : "+v"(t_)); Fp.tid = t_; Fp.lane = t_ & 63; }
#if MK_MULTI
#define SEAM(k) do { } while (0)
#else
#define SEAM(k) do { if (IN(k) && IN((k) + 1)) xcd_barrier(bar); } while (0)
#endif
    if (IN(0)) { PHCTX; for (int rep = 0; rep < REPS(100); ++rep) phase_prologue(Fp); }
    SEAM(0);
    float* XC = WSP(float, WS_XC);
#pragma unroll 1
    for (int l = 0; l < 2; ++l) {
        const int pb = 1 + l * PH_PER_LAYER;
        const float* xlat = l == 0 ? F.in[0] : F.out; const float* xctx = l == 0 ? F.in[2] : XC;
        const int mrows = l == 0 ? MALL : MLAT;
        const float* mod = WSP(float, WS_MOD) + (size_t)l * 3 * 6144;
        if (IN(pb + 0)) { PHCTX; for (int rep = 0; rep < REPS(0); ++rep) { phase_norm(Fp, l, 0, MALL, xlat, xctx); if (l == 1) convert_uv(Fp, 1); } }
        SEAM(pb + 0);
        if (IN(pb + 1)) for (int rep = 0; rep < REPS(1); ++rep) { PHCTX; pg8::Gemm g{WSP(bf16_t, WS_H), WSP(bf16_t, WS_WIN + l * WIN_LSTRIDE), MALL, DINP, DM}; pg8::StaticOrder So; So.init(MALL, DINP, F.G, (int)blockIdx.x);
            pg8::EpiBf16 E{WSP(bf16_t, WS_P), DINP}; pg8::gemm_phase<pg8::EpiBf16, pg8::StaticOrder, true, true>(F.lds, g, So, E, Fp.tid); }
        SEAM(pb + 1);
        if (IN(pb + 2)) { PHCTX; for (int rep = 0; rep < REPS(2); ++rep) { phase_prep(Fp, l); __syncthreads(); } }
        SEAM(pb + 2);
        if (IN(pb + 3)) for (int rep = 0; rep < REPS(3); ++rep) { PHCTX;
            if (F.vcu < 64) rwkv_scan(Fp, F.vcu);
            else { const int nb = F.G - 64, wb = F.vcu - 64; const int natt = l == 0 ? 264 : 256, ntask = natt + 16 * NCHK;
                for (int task = wb; task < ntask; task += nb) { if (task < natt) attn_unit(Fp, l, task); else mlstm_local(Fp, task - natt); } }
        }
        SEAM(pb + 3);
        if (IN(pb + 4)) { PHCTX; for (int rep = 0; rep < REPS(4); ++rep) mlstm_chain(Fp); }
        SEAM(pb + 4);
        if (IN(pb + 5)) for (int rep = 0; rep < REPS(5); ++rep) { PHCTX; const int nun = l == 0 ? 528 : 512; for (int u = F.vcu; u < nun; u += F.G) mlstm_out(Fp, l, u); rwkv_finish(Fp, l, mrows); }
        SEAM(pb + 5);
        if (IN(pb + 6)) for (int rep = 0; rep < REPS(6); ++rep) { PHCTX; pg8::Gemm g{WSP(bf16_t, WS_YCAT), WSP(bf16_t, WS_WOUT + l * WOUT_LSTRIDE), mrows, DM, DM}; pg8::StaticOrder So; So.init(mrows, DM, F.G, (int)blockIdx.x);
            float* dummy = WSP(float, WS_YR); const bool dm_ = (REPS(6) == 2 && rep == 0); pg8::EpiRes E{xlat, xctx, dm_ ? dummy : F.out, dm_ ? dummy : XC, mod}; pg8::gemm_phase<pg8::EpiRes, pg8::StaticOrder, true, true>(F.lds, g, So, E, Fp.tid); }
        SEAM(pb + 6);
        if (IN(pb + 7)) { PHCTX; for (int rep = 0; rep < REPS(7); ++rep) phase_norm(Fp, l, 1, mrows, F.out, XC); }
        SEAM(pb + 7);
        if (IN(pb + 8)) for (int rep = 0; rep < REPS(8); ++rep) { PHCTX; pg8::Gemm g{WSP(bf16_t, WS_H), WSP(bf16_t, WS_WEFF + l * WEFF_LSTRIDE), mrows, 2048, DM}; pg8::StaticOrder So; So.init(mrows, 2048, F.G, (int)blockIdx.x);
            pg8::EpiF32 E{WSP(float, WS_S), 2048}; pg8::gemm_phase<pg8::EpiF32, pg8::StaticOrder, true, true>(F.lds, g, So, E, Fp.tid); }
        SEAM(pb + 8);
        if (IN(pb + 9)) { PHCTX; for (int rep = 0; rep < REPS(9); ++rep) { phase_peer(Fp, l, mrows, mod, (REPS(9) == 2 && rep == 0) ? WSP(float, WS_YR) : nullptr); __syncthreads(); } }
        SEAM(pb + 9);
    }
#undef IN
#undef SEAM
}

extern "C" void kernel_launch(void* const* d_in, const int* in_sizes, int n_in, void* d_out, int out_size, void* d_ws, size_t ws_size, hipStream_t stream) {
    static int grid = 0;
    if (grid == 0) {
        if (n_in != 32 || out_size != MLAT * DM || ws_size < WS_END) { fprintf(stderr, "kernel_launch: unexpected shapes: n_in %d out %d ws %zu (need %zu)\n", n_in, out_size, ws_size, (size_t)WS_END); grid = -1; return; }
        int dev = 0, cus = 0, per_cu = 0;
        if (hipGetDevice(&dev) != hipSuccess || hipDeviceGetAttribute(&cus, hipDeviceAttributeMultiprocessorCount, dev) != hipSuccess) { grid = -1; return; }
        if (hipFuncSetAttribute((const void*)mk_fwd, hipFuncAttributeMaxDynamicSharedMemorySize, LDS_BYTES) != hipSuccess) { fprintf(stderr, "kernel_launch: hipFuncSetAttribute failed\n"); grid = -1; return; }
        if (hipOccupancyMaxActiveBlocksPerMultiprocessor(&per_cu, (const void*)mk_fwd, NTHR, LDS_BYTES) != hipSuccess || per_cu < 1) fprintf(stderr, "kernel_launch: occupancy query reports %d\n", per_cu);
        (void)hipGetLastError();
        grid = cus;
        if (grid != 256) fprintf(stderr, "kernel_launch: grid %d (built for 256 CUs)\n", grid);
    }
    if (grid < 0) return;
    (void)hipMemsetAsync((char*)d_ws + WS_CTL, 0, CTL_ZERO_BYTES, stream);
    Args a{};
    for (int i = 0; i < 32; ++i) a.in[i] = (const float*)d_in[i];
    a.out = (float*)d_out; a.ws = (unsigned char*)d_ws;
#if MK_MULTI
    for (int p = 0; p < N_PHASES; ++p) { a.ph_lo = p; a.ph_hi = p + 1; a.li = p; hipLaunchKernelGGL(mk_fwd, dim3(grid), dim3(NTHR), LDS_BYTES, stream, a); }
#else
    a.ph_lo = 0; a.ph_hi = N_PHASES; a.li = 0;
    hipLaunchKernelGGL(mk_fwd, dim3(grid), dim3(NTHR), LDS_BYTES, stream, a);
#endif
}
```

```cpp
#include <hip/hip_runtime.h>
#include <cstdio>
#include <cstdint>

#ifndef MK_MULTI
#define MK_MULTI 0
#endif
namespace pg8 {
#define PG8_LAS __attribute__((address_space(3)))
typedef unsigned short bf16_t;
typedef short bf16x8 __attribute__((ext_vector_type(8)));
typedef float f32x4 __attribute__((ext_vector_type(4)));
typedef unsigned u32x4 __attribute__((ext_vector_type(4)));
constexpr int BM = 256, BK = 64, HALF = 128, HTB = HALF * BK * 2  , STAGE_BYTES = 8 * HTB, NXCD = 8, WGM = 8;

__host__ __device__ __forceinline__ int lds_byte(int r, int c) { const int st = (r >> 4) * 2 + (c >> 5), rr = r & 15, cc = c & 31, ob = rr * 64 + cc * 2; return st * 1024 + (ob ^ (((ob >> 9) & 1) << 5)); }
__host__ __device__ __forceinline__ void stage_rc(int b, int& R, int& C) { const int st = b / 1024, sb = b % 1024, swz = sb ^ (((sb >> 9) & 1) << 5); R = (st >> 1) * 16 + swz / 64; C = (st & 1) * 32 + (swz % 64) / 2; }
__host__ __device__ __forceinline__ int perm32(int rho) { const int n = rho >> 4, i = rho & 15; return 8 * (i >> 2) + 4 * n + (i & 3); }

struct Unit { int pm, pn; };
struct Gemm { const bf16_t* A; const bf16_t* Bt; int M, N, K; };

struct StaticOrder {
    int nM, nN, nwg, G, c;
    __host__ __device__ void init(int M, int N, int G_, int c_) { nM = M / BM; nN = N / BM; nwg = nM * nN; G = G_; c = c_; }
    __host__ __device__ bool next(int i, Unit& u) const {
        const long L = (long)i * G + c; if (L >= nwg) return false;
        int wgid = (int)L; { const int q = nwg / NXCD, r = nwg % NXCD, xcd = wgid % NXCD, off = wgid / NXCD; wgid = (xcd < r ? xcd * (q + 1) : r * (q + 1) + (xcd - r) * q) + off; }
        const int nig = WGM * nN, gid = wgid / nig, fm = gid * WGM, gsz = (nM - fm) < WGM ? (nM - fm) : WGM;
        u.pm = fm + ((wgid % nig) % gsz); u.pn = (wgid % nig) / gsz; return true;
    }
    __device__ __forceinline__ void a_ready(const Unit&) const {}
    __device__ __forceinline__ void done(const Unit&) const {}
};

__device__ __forceinline__ unsigned cvt_pk_bf16(float lo, float hi) { unsigned r; asm volatile("v_cvt_pk_bf16_f32 %0, %1, %2" : "=v"(r) : "v"(lo), "v"(hi)); return r; }

struct EpiBf16 {
    static constexpr bool PERM = true, AFTER_DRAIN = false;
    bf16_t* O; int ldc;
    __device__ __forceinline__ void operator()(const f32x4 (&acc)[2][2][4][2], const Unit& u, int wr, int wc, int fr, int fq) const {
        const int row0 = u.pm * BM + wr * 64 + fr; const int col0 = u.pn * BM + wc * 32 + 8 * fq;
#pragma unroll
        for (int ai = 0; ai < 2; ++ai)
#pragma unroll
            for (int m = 0; m < 4; ++m) { bf16_t* rowp = O + (size_t)(row0 + ai * HALF + m * 16) * ldc + col0;
#pragma unroll
                for (int bj = 0; bj < 2; ++bj) { const f32x4 v0 = acc[ai][bj][m][0], v1 = acc[ai][bj][m][1];
                    u32x4 w; w.x = cvt_pk_bf16(v0[0], v0[1]); w.y = cvt_pk_bf16(v0[2], v0[3]); w.z = cvt_pk_bf16(v1[0], v1[1]); w.w = cvt_pk_bf16(v1[2], v1[3]);
                    *(u32x4*)(rowp + bj * HALF) = w; } }
    }
};
struct EpiF32 {
    static constexpr bool PERM = false, AFTER_DRAIN = false;
    float* O; int ldc;
    __device__ __forceinline__ void operator()(const f32x4 (&acc)[2][2][4][2], const Unit& u, int wr, int wc, int fr, int fq) const {
        const int row0 = u.pm * BM + wr * 64 + fr; const int col0 = u.pn * BM + wc * 32 + 4 * fq;
#pragma unroll
        for (int ai = 0; ai < 2; ++ai)
#pragma unroll
            for (int m = 0; m < 4; ++m) { float* rowp = O + (size_t)(row0 + ai * HALF + m * 16) * ldc + col0;
#pragma unroll
                for (int bj = 0; bj < 2; ++bj)
#pragma unroll
                    for (int n = 0; n < 2; ++n) *(f32x4*)(rowp + bj * HALF + n * 16) = acc[ai][bj][m][n]; }
    }
};
struct EpiRes {
    static constexpr bool PERM = false, AFTER_DRAIN = false;
    const float* src_lat; const float* src_ctx; float* dst_lat; float* dst_ctx; const float* gate;
    __device__ __forceinline__ void operator()(const f32x4 (&acc)[2][2][4][2], const Unit& u, int wr, int wc, int fr, int fq) const {
        const bool isc = u.pm >= 64; const int smp = isc ? 2 : (u.pm >> 5);
        const int prow = (isc ? (u.pm - 64) * BM : u.pm * BM) + wr * 64 + fr;
        const float* src = isc ? src_ctx : src_lat; float* dst = isc ? dst_ctx : dst_lat;
        const float* gt = gate + smp * 6144 + 2048;
        const int col0 = u.pn * BM + wc * 32 + 4 * fq;
        f32x4 gv[2][2];
#pragma unroll
        for (int bj = 0; bj < 2; ++bj)
#pragma unroll
            for (int n = 0; n < 2; ++n) gv[bj][n] = *(const f32x4*)(gt + col0 + bj * HALF + n * 16);
#pragma unroll
        for (int ai = 0; ai < 2; ++ai)
#pragma unroll
            for (int m = 0; m < 4; ++m) { const size_t off = (size_t)(prow + ai * HALF + m * 16) * 1024 + col0;
#pragma unroll
                for (int bj = 0; bj < 2; ++bj)
#pragma unroll
                    for (int n = 0; n < 2; ++n) { const f32x4 s = *(const f32x4*)(src + off + bj * HALF + n * 16);
                        *(f32x4*)(dst + off + bj * HALF + n * 16) = s + gv[bj][n] * acc[ai][bj][m][n]; } }
    }
};

template <class Epi, class Sched, bool ALIGN_EPI = false, bool SP2 = false>
__device__ __forceinline__ void gemm_phase(PG8_LAS unsigned char* lds, const Gemm g, const Sched& S, const Epi& E, const int tid) {
    const int wid = __builtin_amdgcn_readfirstlane(tid >> 6), lane = tid & 63, wr = wid >> 2, wc = wid & 3, fr = lane & 15, fq = lane >> 4;
    const int K = g.K, nt = K / BK;
    unsigned voffA[2], voffB[2];
#pragma unroll
    for (int i = 0; i < 2; ++i) { int R, C; stage_rc(tid * 16 + i * 8192, R, C); const int Rb = Epi::PERM ? ((R & ~31) + perm32(R & 31)) : R;
        voffA[i] = (unsigned)(R * K + C) * 2u; voffB[i] = (unsigned)(Rb * K + C) * 2u; }
    const size_t kstep = (size_t)(BK * 2);
    const size_t hstep = (size_t)HALF * K * 2;
    const size_t tstep = 2 * hstep;
    const unsigned ldsw = (unsigned)wid * 1024u;
    const int aoff = lds_byte(wr * 64 + fr, fq * 8), boff = lds_byte(wc * 32 + fr, fq * 8);
#define PG8_SA(b, h) (((b) * 2 + (h)) * HTB)
#define PG8_SB(b, h) ((4 + (b) * 2 + (h)) * HTB)
#define PG8_STAGE(bufoff, gbase, voff) do { _Pragma("unroll") for (int _i = 0; _i < 2; ++_i) \
        __builtin_amdgcn_global_load_lds((const unsigned*)((const char*)(gbase) + (voff)[_i]), (PG8_LAS unsigned*)(lds + (bufoff) + ldsw + _i * 8192), 16, 0, 0); } while (0)
#define PG8_LDA(dst, b, h) do { _Pragma("unroll") for (int m = 0; m < 4; ++m) _Pragma("unroll") for (int k = 0; k < 2; ++k) dst[m][k] = *(const PG8_LAS bf16x8*)(lds + PG8_SA(b, h) + aoff + m * 2048 + k * 1024); } while (0)
#define PG8_LDB(dst, b, h) do { _Pragma("unroll") for (int n = 0; n < 2; ++n) _Pragma("unroll") for (int k = 0; k < 2; ++k) dst[n][k] = *(const PG8_LAS bf16x8*)(lds + PG8_SB(b, h) + boff + n * 2048 + k * 1024); } while (0)
#define PG8_MMA(ai, bj, At, Bt) do { __builtin_amdgcn_s_setprio(1); _Pragma("unroll") for (int m = 0; m < 4; ++m) _Pragma("unroll") for (int n = 0; n < 2; ++n) _Pragma("unroll") for (int k = 0; k < 2; ++k) \
        acc[ai][bj][m][n] = __builtin_amdgcn_mfma_f32_16x16x32_bf16(Bt[n][k], At[m][k], acc[ai][bj][m][n], 0, 0, 0); __builtin_amdgcn_s_setprio(0); } while (0)
#define PG8_WAIT_V(n) asm volatile("s_waitcnt vmcnt(" #n ")" ::: "memory")
#define PG8_WAIT_L(n) asm volatile("s_waitcnt lgkmcnt(" #n ")" ::: "memory")
#define PG8_BAR __builtin_amdgcn_s_barrier()
#define PG8_SCHED __builtin_amdgcn_sched_barrier(0)
    Unit cur, nxt; int ui = 0;
    if (!S.next(0, cur)) return;
    f32x4 acc[2][2][4][2];
#pragma unroll
    for (int a = 0; a < 2; ++a)
#pragma unroll
        for (int b = 0; b < 2; ++b)
#pragma unroll
            for (int m = 0; m < 4; ++m)
#pragma unroll
                for (int n = 0; n < 2; ++n) acc[a][b][m][n] = (f32x4){0.f, 0.f, 0.f, 0.f};
    bf16x8 At[4][2], B0[2][2], B1[2][2];
    const char* cA = (const char*)g.A + (size_t)cur.pm * tstep; const char* cB = (const char*)g.Bt + (size_t)cur.pn * tstep;
    S.a_ready(cur);
    if constexpr (SP2) {
        PG8_STAGE(PG8_SB(0, 0), cB, voffB); PG8_STAGE(PG8_SB(0, 1), cB + hstep, voffB); PG8_STAGE(PG8_SA(0, 0), cA, voffA); PG8_STAGE(PG8_SA(0, 1), cA + hstep, voffA);
        if (wr == 1) PG8_BAR;
        PG8_WAIT_V(2); PG8_BAR;
        PG8_STAGE(PG8_SB(1, 0), cB + kstep, voffB); PG8_STAGE(PG8_SA(1, 0), cA + kstep, voffA); PG8_STAGE(PG8_SB(1, 1), cB + hstep + kstep, voffB);
        PG8_WAIT_V(6); PG8_BAR;
    } else {
        PG8_STAGE(PG8_SB(0, 0), cB, voffB); PG8_STAGE(PG8_SA(0, 0), cA, voffA); PG8_STAGE(PG8_SB(0, 1), cB + hstep, voffB); PG8_STAGE(PG8_SA(0, 1), cA + hstep, voffA);
        if (wr == 1) PG8_BAR;
        PG8_WAIT_V(4); PG8_BAR;
        PG8_STAGE(PG8_SB(1, 0), cB + kstep, voffB); PG8_STAGE(PG8_SA(1, 0), cA + kstep, voffA); PG8_STAGE(PG8_SB(1, 1), cB + hstep + kstep, voffB);
        PG8_WAIT_V(6); PG8_BAR;
    }
    for (;;) {
        const bool has_next = S.next(ui + 1, nxt);
        const char* nA = has_next ? (const char*)g.A + (size_t)nxt.pm * tstep : cA; const char* nB = has_next ? (const char*)g.Bt + (size_t)nxt.pn * tstep : cB;
        for (int t = 0; t < nt; t += 2) {
            const bool last = (t == nt - 2);
            const char* a1 = cA + (size_t)(t + 1) * kstep;
            const char* a2 = last ? nA : cA + (size_t)(t + 2) * kstep; const char* b2 = last ? nB : cB + (size_t)(t + 2) * kstep;
            const char* a3 = a2 + kstep; const char* b3 = b2 + kstep;
            if (last && has_next) S.a_ready(nxt);
            if constexpr (SP2) {
            PG8_LDB(B0, 0, 0); PG8_LDB(B1, 0, 1); PG8_SCHED; PG8_LDA(At, 0, 0); PG8_STAGE(PG8_SA(1, 1), a1 + hstep, voffA);
            PG8_WAIT_V(8); PG8_WAIT_L(0); PG8_BAR; PG8_MMA(0, 0, At, B0); PG8_MMA(0, 1, At, B1); PG8_BAR; PG8_SCHED;
            PG8_LDA(At, 0, 1); PG8_STAGE(PG8_SB(0, 0), b2, voffB); PG8_STAGE(PG8_SB(0, 1), b2 + hstep, voffB); PG8_STAGE(PG8_SA(0, 0), a2, voffA);
            PG8_WAIT_V(8); PG8_WAIT_L(0); PG8_BAR; PG8_MMA(1, 0, At, B0); PG8_MMA(1, 1, At, B1); PG8_BAR; PG8_SCHED;
            PG8_LDB(B0, 1, 0); PG8_LDB(B1, 1, 1); PG8_SCHED; PG8_LDA(At, 1, 0); PG8_STAGE(PG8_SA(0, 1), a2 + hstep, voffA);
            PG8_WAIT_V(8); PG8_WAIT_L(0); PG8_BAR; PG8_MMA(0, 0, At, B0); PG8_MMA(0, 1, At, B1); PG8_BAR; PG8_SCHED;
            PG8_LDA(At, 1, 1); PG8_STAGE(PG8_SB(1, 0), b3, voffB); PG8_STAGE(PG8_SB(1, 1), b3 + hstep, voffB); PG8_STAGE(PG8_SA(1, 0), a3, voffA);
            PG8_WAIT_V(8); PG8_WAIT_L(0); PG8_BAR; PG8_MMA(1, 0, At, B0); PG8_MMA(1, 1, At, B1); PG8_BAR; PG8_SCHED;
            } else {
            PG8_LDB(B0, 0, 0); PG8_SCHED; PG8_LDA(At, 0, 0); PG8_STAGE(PG8_SA(1, 1), a1 + hstep, voffA);
            PG8_WAIT_L(8); PG8_BAR; PG8_WAIT_L(0); PG8_MMA(0, 0, At, B0); PG8_BAR; PG8_SCHED;
            PG8_LDB(B1, 0, 1); PG8_STAGE(PG8_SB(0, 0), b2, voffB);
            PG8_BAR; PG8_WAIT_L(0); PG8_MMA(0, 1, At, B1); PG8_BAR;
            PG8_LDA(At, 0, 1); PG8_STAGE(PG8_SA(0, 0), a2, voffA);
            PG8_BAR; PG8_WAIT_L(0); PG8_MMA(1, 0, At, B0); PG8_BAR; PG8_SCHED;
            PG8_STAGE(PG8_SB(0, 1), b2 + hstep, voffB);
            PG8_WAIT_V(6); PG8_BAR; PG8_MMA(1, 1, At, B1); PG8_BAR;
            PG8_LDB(B0, 1, 0); PG8_SCHED; PG8_LDA(At, 1, 0); PG8_STAGE(PG8_SA(0, 1), a2 + hstep, voffA);
            PG8_WAIT_L(8); PG8_BAR; PG8_WAIT_L(0); PG8_MMA(0, 0, At, B0); PG8_BAR; PG8_SCHED;
            PG8_LDB(B1, 1, 1); PG8_STAGE(PG8_SB(1, 0), b3, voffB);
            PG8_BAR; PG8_WAIT_L(0); PG8_MMA(0, 1, At, B1); PG8_BAR;
            PG8_LDA(At, 1, 1); PG8_STAGE(PG8_SA(1, 0), a3, voffA);
            PG8_BAR; PG8_WAIT_L(0); PG8_MMA(1, 0, At, B0); PG8_BAR; PG8_SCHED;
            PG8_STAGE(PG8_SB(1, 1), b3 + hstep, voffB);
            PG8_WAIT_V(6); PG8_BAR; PG8_MMA(1, 1, At, B1); PG8_BAR;
            }
        }
        if constexpr (ALIGN_EPI) { if (wr == 0) PG8_BAR; }
        if constexpr (!Epi::AFTER_DRAIN) { E(acc, cur, wr, wc, fr, fq); S.done(cur); }
        if (!has_next) break;
#pragma unroll
        for (int a = 0; a < 2; ++a)
#pragma unroll
            for (int b = 0; b < 2; ++b)
#pragma unroll
                for (int m = 0; m < 4; ++m)
#pragma unroll
                    for (int n = 0; n < 2; ++n) acc[a][b][m][n] = (f32x4){0.f, 0.f, 0.f, 0.f};
        cur = nxt; cA = nA; cB = nB; ++ui;
        if constexpr (ALIGN_EPI) { if (wr == 1) PG8_BAR; }
    }
    PG8_WAIT_V(0);
    if constexpr (!ALIGN_EPI) { if (wr == 0) PG8_BAR; }
    PG8_BAR;
    if constexpr (Epi::AFTER_DRAIN) { E.fused(acc, cur, wr, wc, fr, fq, lds, wid, lane); S.done(cur); }
#undef PG8_SA
#undef PG8_SB
#undef PG8_STAGE
#undef PG8_LDA
#undef PG8_LDB
#undef PG8_MMA
#undef PG8_WAIT_V
#undef PG8_WAIT_L
#undef PG8_BAR
#undef PG8_SCHED
}
}
#ifndef ZMASK
#define ZMASK 0
#endif
#define ZF(bit) ((ZMASK & (bit)) ? 0.f : 1.f)
using pg8::bf16_t; using pg8::bf16x8; using pg8::f32x4; using pg8::u32x4;
constexpr int NWAVES = 8, NTHR = 512;
constexpr int DM = 1024, TLAT = 8192, TCTX = 256, MLAT = 2 * TLAT, MCTX = 2 * TCTX, MALL = MLAT + MCTX;
constexpr int DIN = 3152, DINP = 3328;
constexpr int C_CH = 0, C_CB = 256, C_CC = 512, C_RR = 768, C_RK = 1024, C_RV = 1280, C_XW = 1536, C_XA = 1552, C_XG = 1568,
              C_AQ = 1600, C_AK = 1856, C_AV = 1984, C_MQ = 2112, C_MK = 2368, C_MV = 2624, C_MO = 2880, C_MG = 3136;
constexpr float EPSN = 1e-6f;
constexpr int NCHK = 66;
constexpr int CST = 4160;
constexpr int RWREC = 4608;
constexpr size_t MiB = 1u << 20;
constexpr size_t WS_CTL = 0, CTL_ZERO_BYTES = 1 * MiB, WS_MOD = 1 * MiB;
constexpr size_t WS_WIN = 2 * MiB, WIN_LSTRIDE = (size_t)DINP * DM * 2;
constexpr size_t WS_WOUT = 16 * MiB, WOUT_LSTRIDE = 2 * MiB;
constexpr size_t WS_WEFF = 20 * MiB, WEFF_LSTRIDE = 4 * MiB;
constexpr size_t WS_XC = 28 * MiB, WS_GA = 30 * MiB, WS_H = 32 * MiB, WS_YCAT = 65 * MiB, WS_U = 98 * MiB, WS_V = 130 * MiB;
constexpr size_t WS_P = 162 * MiB, WS_RW = 270 * MiB, WS_YR = 345 * MiB, WS_QA = 378 * MiB, WS_KA = 387 * MiB;
constexpr size_t WS_LC = 392 * MiB, WS_ST = 409 * MiB, WS_LB = 426 * MiB, WS_EG = 427 * MiB, WS_GB = 444 * MiB, WS_BS = 453 * MiB, WS_SC = 453 * MiB + 512 * 1024, WS_END = 454 * MiB;
constexpr size_t UV_LSTRIDE = 16 * MiB;
constexpr size_t WS_S = WS_P;
static_assert(WS_P + (size_t)MALL * DINP * 2 <= WS_RW && WS_RW + (size_t)MALL * RWREC <= WS_YR && WS_S + (size_t)MALL * 2048 * 4 <= WS_YR, "ws map");
static_assert(WS_LC + (size_t)16 * NCHK * CST * 4 <= WS_ST && WS_ST + (size_t)16 * NCHK * CST * 4 <= WS_LB && WS_EG + (size_t)MALL * 128 * 8 <= WS_GB, "ws map 2");
constexpr int CW_BAR = 4096;
constexpr int RING_BYTES = 131072, LDSCTL_OFF = RING_BYTES, MISC_OFF = LDSCTL_OFF + 320, LDS_BYTES = 147456;

#define GAS __attribute__((address_space(1)))
#define LAS __attribute__((address_space(3)))
typedef unsigned u32x2 __attribute__((ext_vector_type(2)));
typedef float f32x2 __attribute__((ext_vector_type(2)));
typedef __bf16 bf16x2_t __attribute__((ext_vector_type(2)));
typedef GAS unsigned gu32;
#define LDS_WAIT() asm volatile("s_waitcnt lgkmcnt(0)" ::: "memory")

__device__ __forceinline__ float lo2f(unsigned w) { return __uint_as_float(w << 16); }
__device__ __forceinline__ float hi2f(unsigned w) { return __uint_as_float(w & 0xffff0000u); }
__device__ __forceinline__ float bf2f(bf16_t b) { return __uint_as_float((unsigned)b << 16); }
__device__ __forceinline__ unsigned f2bf(float f) { unsigned u = __float_as_uint(f); return (u + 0x7fffu + ((u >> 16) & 1u)) >> 16; }
__device__ __forceinline__ unsigned pk2(float lo, float hi) { return f2bf(lo) | (f2bf(hi) << 16); }
__device__ __forceinline__ f32x4 ld4bf(const bf16_t* p) { const u32x2 w = *(const u32x2*)p; return (f32x4){lo2f(w.x), hi2f(w.x), lo2f(w.y), hi2f(w.y)}; }
__device__ __forceinline__ void st4bf(bf16_t* p, f32x4 v) { u32x2 w; w.x = pk2(v[0], v[1]); w.y = pk2(v[2], v[3]); *(u32x2*)p = w; }
__device__ __forceinline__ float sigmoidf_(float x) { return 1.f / (1.f + __expf(-x)); }
__device__ __forceinline__ float tanhf_(float x) { const float e = __expf(-2.f * fabsf(x)); const float t = (1.f - e) / (1.f + e); return x < 0.f ? -t : t; }
template <int CTRL> __device__ __forceinline__ float dppf(float x) { return __int_as_float(__builtin_amdgcn_update_dpp(0, __float_as_int(x), CTRL, 0xf, 0xf, true)); }
__device__ __forceinline__ float red16(float x) { x += dppf<0xB1>(x); x += dppf<0x4E>(x); x += dppf<0x141>(x); x += dppf<0x140>(x); return x; }
__device__ __forceinline__ float wave_sum(float v) {
#pragma unroll
    for (int o = 1; o < 64; o <<= 1) v += __shfl_xor(v, o);
    return v;
}
#define XB_TMO      128
#define XB_XCNT(j)  (256  + 64 * (j))
#define XB_XSUB(j)  (1280 + 64 * (j))
#define XB_XGEN(j)  (2304 + 64 * (j))
#define XB_TOP      3328
#define XB_TOPGEN   3392
#define XCD_BAR_WORDS 3456
#define XB_SPIN_CAP (1u << 18)

__device__ __forceinline__ unsigned xb_ld(unsigned* p)              { return __hip_atomic_load(p, __ATOMIC_RELAXED, __HIP_MEMORY_SCOPE_AGENT); }
__device__ __forceinline__ unsigned xb_add(unsigned* p, unsigned v) { return __hip_atomic_fetch_add(p, v, __ATOMIC_RELAXED, __HIP_MEMORY_SCOPE_AGENT); }
__device__ __forceinline__ unsigned xb_xcc_id() { return (unsigned)__builtin_amdgcn_s_getreg((3 << 11) | 20) & 0xFu; }
#define XB_SPIN(cond, bar) do { unsigned _sp = 0; while (cond) { __builtin_amdgcn_s_sleep(1); \
    if ((++_sp & 255u) == 0u) { if (xb_ld(&(bar)[XB_TMO])) break; if (_sp > XB_SPIN_CAP) { atomicAdd(&(bar)[XB_TMO], 1u); break; } } } } while (0)

struct XcdBarrier {
    unsigned* bar; unsigned x;
    volatile LAS unsigned* st;
};

__device__ __forceinline__ XcdBarrier xcd_barrier_post(unsigned* bar, volatile LAS unsigned* st) {
    XcdBarrier b; b.bar = bar; b.x = xb_xcc_id(); b.st = st;
    if (threadIdx.x == 0) (void)xb_add(&bar[XB_XCNT(b.x)], 1u);
    return b;
}
__device__ __forceinline__ void xcd_barrier_complete(unsigned* bar, unsigned x, unsigned& nloc, unsigned& nx) {
    const unsigned G = gridDim.x * gridDim.y * gridDim.z;
    unsigned sum, cnt, mine, sp = 0u;
    for (;;) {
        sum = 0u; cnt = 0u; mine = 0u;
#pragma unroll
        for (unsigned j = 0; j < 16; ++j) { const unsigned c = xb_ld(&bar[XB_XCNT(j)]); sum += c; cnt += (c > 0u) ? 1u : 0u; mine = (j == x) ? c : mine; }
        if (sum == G) break;
        __builtin_amdgcn_s_sleep(1);
        if ((++sp & 255u) == 0u) { if (xb_ld(&bar[XB_TMO])) break; if (sp > XB_SPIN_CAP) { atomicAdd(&bar[XB_TMO], 1u); break; } }
    }
    nloc = mine > 0u ? mine : 1u; nx = cnt > 0u ? cnt : 1u;
}

__device__ __forceinline__ void xcd_barrier(const XcdBarrier& b) {
    asm volatile("s_waitcnt vmcnt(0)" ::: "memory");
    __syncthreads();
    if (threadIdx.x == 0) {
        unsigned* bar = b.bar;
        __builtin_amdgcn_s_waitcnt(0);
        unsigned nloc = b.st[0], nx = b.st[1];
        if (nloc == 0u) { xcd_barrier_complete(bar, b.x, nloc, nx); b.st[0] = nloc; b.st[1] = nx; }
        const unsigned old = xb_add(&bar[XB_XSUB(b.x)], 1u);
        const unsigned gen = old / nloc;
        if (old + 1u == (gen + 1u) * nloc) {
            __builtin_amdgcn_fence(__ATOMIC_RELEASE, "agent");
            asm volatile("s_waitcnt vmcnt(0)" ::: "memory");
            const unsigned og = xb_add(&bar[XB_TOP], 1u);
            const unsigned tg = og / nx;
            if (og + 1u == (tg + 1u) * nx) xb_add(&bar[XB_TOPGEN], 1u);
            else XB_SPIN(xb_ld(&bar[XB_TOPGEN]) == tg, bar);
            __builtin_amdgcn_fence(__ATOMIC_ACQUIRE, "agent");
            xb_add(&bar[XB_XGEN(b.x)], 1u);
            asm volatile("s_waitcnt vmcnt(0)" ::: "memory");
        } else {
            XB_SPIN(xb_ld(&bar[XB_XGEN(b.x)]) == gen, bar);
            __builtin_amdgcn_fence(__ATOMIC_ACQUIRE, "agent");
            asm volatile("s_waitcnt vmcnt(0)" ::: "memory");
        }
    }
    __syncthreads();
}
struct Ctx {
    LAS unsigned char* lds; int tid, lane, wave, vcu, G;
    const float* in[32]; float* out; unsigned char* ws;
};
#define WSP(T, off) ((T*)(F.ws + (off)))

__device__ __forceinline__ void p0_transpose_item(const float* W, int K, int N, bf16_t* WT, LAS float* scr, int item, int lane) {
    const int nblk = (N + 31) / 32, kb = item / nblk, nb = item % nblk, k0 = 64 * kb, n0 = 32 * nb;
    const int nn = n0 + (lane & 31);
#pragma unroll 8
    for (int i = 0; i < 32; ++i) { const int kk = 2 * i + (lane >> 5); scr[kk * 33 + (lane & 31)] = nn < N ? W[(size_t)(k0 + kk) * N + nn] : 0.f; }
    LDS_WAIT(); asm volatile("" ::: "memory");
    const int c = lane & 7;
#pragma unroll
    for (int j = 0; j < 4; ++j) { const int n = (lane >> 3) + 8 * j; const LAS float* s = scr + (8 * c) * 33 + n;
        u32x4 o; o.x = pk2(s[0 * 33], s[1 * 33]); o.y = pk2(s[2 * 33], s[3 * 33]); o.z = pk2(s[4 * 33], s[5 * 33]); o.w = pk2(s[6 * 33], s[7 * 33]);
        *(u32x4*)(WT + (size_t)(n0 + n) * K + k0 + 8 * c) = o; }
    LDS_WAIT(); asm volatile("" ::: "memory");
}
__device__ __forceinline__ void convert_uv(const Ctx& F, int l) {
    const int gw = F.vcu * NWAVES + F.wave, NGW = F.G * NWAVES;
    float* SC = WSP(float, WS_SC) + (size_t)l * 2 * 16384;
    for (int r = gw; r < 2 * 16384; r += NGW) {
        const int tb = r >> 14, row = r & 16383;
        const float* src = (tb ? F.in[31] : F.in[30]) + ((size_t)l * 16384 + row) * 1024 + F.lane * 16;
        f32x4 v[4]; float am = 0.f;
#pragma unroll
        for (int j = 0; j < 4; ++j) { v[j] = *(const f32x4*)(src + 4 * j); am = fmaxf(am, fmaxf(fmaxf(fabsf(v[j][0]), fabsf(v[j][1])), fmaxf(fabsf(v[j][2]), fabsf(v[j][3])))); }
#pragma unroll
        for (int o = 1; o < 64; o <<= 1) am = fmaxf(am, __shfl_xor(am, o));
        const float sc = am > 0.f ? 448.f / am : 1.f;
        u32x4 o4; unsigned ow[4];
#pragma unroll
        for (int j = 0; j < 4; ++j) { int w = __builtin_amdgcn_cvt_pk_fp8_f32(v[j][0] * sc, v[j][1] * sc, 0, false); w = __builtin_amdgcn_cvt_pk_fp8_f32(v[j][2] * sc, v[j][3] * sc, w, true); ow[j] = (unsigned)w; }
        o4 = (u32x4){ow[0], ow[1], ow[2], ow[3]};
        *(u32x4*)(F.ws + (tb ? WS_V : WS_U) + (size_t)l * UV_LSTRIDE + (size_t)row * 1024 + F.lane * 16) = o4;
        if (F.lane == 0) SC[tb * 16384 + row] = am > 0.f ? am * (1.f / 448.f) : 1.f;
    }
}
__device__ __forceinline__ void phase_prologue(const Ctx& F) {
    float* MOD = WSP(float, WS_MOD);
    {
        LAS float* sl = (LAS float*)F.lds; LAS float* red = sl + 3072;
        for (int it = F.vcu; it < 192; it += F.G) {
            const int l = it / 96, n0 = (it % 96) * 64;
            for (int i = F.tid; i < 3072; i += NTHR) { const int s = i >> 10, k = i & 1023; const float c = s < 2 ? F.in[1][s * 1024 + k] : F.in[3][k]; sl[i] = c / (1.f + __expf(-c)); }
            __syncthreads();
            const int c = F.tid & 63, kg = F.tid >> 6;
            const float* W = F.in[4] + (size_t)l * 1024 * 6144 + n0 + c;
            float a0 = 0.f, a1 = 0.f, a2 = 0.f;
#pragma unroll 8
            for (int k = kg * 128; k < kg * 128 + 128; ++k) { const float w = W[(size_t)k * 6144]; a0 += sl[k] * w; a1 += sl[1024 + k] * w; a2 += sl[2048 + k] * w; }
            red[(kg * 3 + 0) * 64 + c] = a0; red[(kg * 3 + 1) * 64 + c] = a1; red[(kg * 3 + 2) * 64 + c] = a2;
            __syncthreads();
            if (F.tid < 192) { const int s = F.tid >> 6, cc = F.tid & 63; float t = F.in[5][l * 6144 + n0 + cc];
#pragma unroll
                for (int g = 0; g < 8; ++g) t += red[(g * 3 + s) * 64 + cc];
                MOD[(l * 3 + s) * 6144 + n0 + cc] = t; }
            __syncthreads();
        }
    }
    {
        LAS float* scr = (LAS float*)(F.lds + F.wave * 16384);
        const int gw = F.vcu * NWAVES + F.wave, NGW = F.G * NWAVES;
        constexpr int I_IN = 16 * 99, I_OUT = 16 * 32, I_L = I_IN + I_OUT;
        for (int it = gw; it < 2 * I_L; it += NGW) {
            const int l = it / I_L; int r = it % I_L;
            if (r < I_IN) p0_transpose_item(F.in[8] + (size_t)l * DM * DIN, DM, DIN, WSP(bf16_t, WS_WIN + l * WIN_LSTRIDE), scr, r, F.lane);
            else p0_transpose_item(F.in[9] + (size_t)l * DM * DM, DM, DM, WSP(bf16_t, WS_WOUT + l * WOUT_LSTRIDE), scr, r - I_IN, F.lane);
        }
        for (int i = F.vcu * NTHR + F.tid; i < 2 * 160 * 128; i += F.G * NTHR) { const int l = i / (160 * 128), r = i % (160 * 128);
            *(u32x4*)(WSP(bf16_t, WS_WIN + l * WIN_LSTRIDE) + (size_t)3168 * DM + (size_t)r * 8) = (u32x4){0u, 0u, 0u, 0u}; }
    }
    __syncthreads();
    {
        LAS float* KEYS = (LAS float*)F.lds; LAS float* WQl = KEYS + 128 * 129;
        for (int it = F.vcu; it < 512; it += F.G) {
            const int l = it >> 8, hh = (it >> 4) & 15, kb = it & 15;
            const float* ksrc = F.in[29] + ((size_t)l * 16 + hh) * 128 * 128;
            for (int i = F.tid; i < 16384; i += NTHR) KEYS[(i >> 7) * 129 + (i & 127)] = ksrc[i];
            const float* wsrc = F.in[28] + (size_t)l * DM * 2048 + (size_t)(kb * 64) * 2048 + hh * 128;
            for (int i = F.tid; i < 64 * 128; i += NTHR) { const int kk = i >> 7, d = i & 127; WQl[d * 68 + kk] = wsrc[(size_t)kk * 2048 + d]; }
            __syncthreads();
            const int key = F.tid & 127, kq = F.tid >> 7;
            float acc[16];
#pragma unroll
            for (int j = 0; j < 16; ++j) acc[j] = 0.f;
#pragma unroll 4
            for (int d = 0; d < 128; ++d) { const float a = KEYS[key * 129 + d]; const LAS f32x4* wq = (const LAS f32x4*)(WQl + d * 68 + kq * 16);
#pragma unroll
                for (int q = 0; q < 4; ++q) { const f32x4 w = wq[q]; acc[4 * q] += a * w[0]; acc[4 * q + 1] += a * w[1]; acc[4 * q + 2] += a * w[2]; acc[4 * q + 3] += a * w[3]; } }
            bf16_t* dst = WSP(bf16_t, WS_WEFF + l * WEFF_LSTRIDE) + (size_t)(hh * 128 + key) * DM + kb * 64 + kq * 16;
            u32x4 o0, o1; o0.x = pk2(acc[0], acc[1]); o0.y = pk2(acc[2], acc[3]); o0.z = pk2(acc[4], acc[5]); o0.w = pk2(acc[6], acc[7]);
            o1.x = pk2(acc[8], acc[9]); o1.y = pk2(acc[10], acc[11]); o1.z = pk2(acc[12], acc[13]); o1.w = pk2(acc[14], acc[15]);
            *(u32x4*)dst = o0; *(u32x4*)(dst + 8) = o1;
            __syncthreads();
        }
    }
    convert_uv(F, 0); convert_uv(F, 1);
}

__device__ __forceinline__ void phase_norm(const Ctx& F, int l, int which, int nrows, const float* xlat, const float* xctx) {
    const float* gain = F.in[6 + which] + l * DM; const float* mod = WSP(float, WS_MOD) + (size_t)l * 3 * 6144;
    const int shoff = which ? 3072 : 0, scoff = which ? 4096 : 1024;
    bf16_t* H = WSP(bf16_t, WS_H);
    const int gw = F.vcu * NWAVES + F.wave, NGW = F.G * NWAVES;
    for (int row = gw; row < nrows; row += NGW) {
        const bool isc = row >= MLAT; const float* src = isc ? xctx + (size_t)(row - MLAT) * DM : xlat + (size_t)row * DM; const int smp = isc ? 2 : (row >> 13);
        const float* mb = mod + smp * 6144;
        f32x4 v[4]; float ss = 0.f;
#pragma unroll
        for (int j = 0; j < 4; ++j) { v[j] = *(const f32x4*)(src + F.lane * 4 + 256 * j); ss += (v[j][0] * v[j][0] + v[j][1] * v[j][1]) + (v[j][2] * v[j][2] + v[j][3] * v[j][3]); }
        const float rs = rsqrtf(wave_sum(ss) * (1.f / DM) + EPSN);
#pragma unroll
        for (int j = 0; j < 4; ++j) { const int c = F.lane * 4 + 256 * j; const f32x4 g = *(const f32x4*)(gain + c), sc = *(const f32x4*)(mb + scoff + c), sh = *(const f32x4*)(mb + shoff + c);
            const f32x4 o = (v[j] * rs * g) * (1.f + sc) + sh; st4bf(H + (size_t)row * DM + c, o); }
    }
}

__device__ __forceinline__ float log_sigmoid_(float x) { return fminf(x, 0.f) - __logf(1.f + __expf(-fabsf(x))); }
__device__ __forceinline__ void phase_prep(const Ctx& F, int l) {
    LAS float* W2s = (LAS float*)F.lds; LAS float* A2s = W2s + 8192; LAS float* G2s = A2s + 8192; LAS float* tsc = G2s + 8192 + F.wave * 64;
    { const float* w2 = F.in[13] + l * 8192; const float* a2 = F.in[15] + l * 8192; const float* g2 = F.in[16] + l * 8192;
      for (int i = F.tid; i < 8192; i += NTHR) { W2s[i] = w2[i]; A2s[i] = a2[i]; G2s[i] = g2[i]; } }
    __syncthreads();
    const bf16_t* P = WSP(bf16_t, WS_P); bf16_t* YC = WSP(bf16_t, WS_YCAT); bf16_t* QA = WSP(bf16_t, WS_QA); bf16_t* KA = WSP(bf16_t, WS_KA);
    unsigned char* RW = WSP(unsigned char, WS_RW); bf16_t* GB = WSP(bf16_t, WS_GB); float* BS = WSP(float, WS_BS); float* GA = WSP(float, WS_GA);
    const int lane = F.lane, c4 = lane * 4, i16 = lane & 15;
    const f32x4 cw0 = *(const f32x4*)(F.in[10] + l * 768 + c4), cw1 = *(const f32x4*)(F.in[10] + l * 768 + 256 + c4), cw2 = *(const f32x4*)(F.in[10] + l * 768 + 512 + c4);
    const f32x4 cg = *(const f32x4*)(F.in[11] + l * 256 + c4);
    const f32x4 qg = *(const f32x4*)(F.in[21] + l * 64 + (c4 & 63)), kg = *(const f32x4*)(F.in[22] + l * 64 + (c4 & 63));
    const f32x4 k_k = *(const f32x4*)(F.in[17] + l * 256 + c4), k_a = *(const f32x4*)(F.in[18] + l * 256 + c4), r_k = *(const f32x4*)(F.in[19] + l * 256 + c4);
    f32x4 w0[2], a0[2];
#pragma unroll
    for (int d = 0; d < 2; ++d) { w0[d] = *(const f32x4*)(F.in[12] + (l * 2 + d) * 256 + c4); a0[d] = *(const f32x4*)(F.in[14] + (l * 2 + d) * 256 + c4); }
    float invf[4];
#pragma unroll
    for (int j = 0; j < 4; ++j) invf[j] = exp2f(-(float)((c4 + j) & 15) * (13.287712379549449f / 16.f));
    const int gw = F.vcu * NWAVES + F.wave, NGW = F.G * NWAVES;
    for (int row = gw; row < MALL; row += NGW) {
        const bool isc = row >= MLAT; const int t = isc ? ((row - MLAT) & 255) : (row & 8191); const int T = isc ? TCTX : TLAT;
        const bf16_t* pr = P + (size_t)row * DINP;
        {
            const f32x4 h1 = ld4bf(pr + C_CH + c4), bg = ld4bf(pr + C_CB + c4), c1 = ld4bf(pr + C_CC + c4);
            f32x4 up = {0.f, 0.f, 0.f, 0.f}, un = {0.f, 0.f, 0.f, 0.f};
            if (t > 0) up = ld4bf(pr - DINP + C_CH + c4) * ld4bf(pr - DINP + C_CC + c4);
            if (t < T - 1) un = ld4bf(pr + DINP + C_CH + c4) * ld4bf(pr + DINP + C_CC + c4);
            const f32x4 y = bg * (cw0 * up + cw1 * (c1 * h1) + cw2 * un);
            const float ss = red16((y[0] * y[0] + y[1] * y[1]) + (y[2] * y[2] + y[3] * y[3]));
            const float rs = rsqrtf(ss * (1.f / 64.f) + EPSN);
            st4bf(YC + (size_t)row * DM + c4, y * rs * cg * ZF(2));
        }
        asm volatile("" ::: "memory");
        {
            const f32x4 q = ld4bf(pr + C_AQ + c4); const f32x4 k = ld4bf(pr + C_AK + (c4 & 127));
            const float qs = red16((q[0] * q[0] + q[1] * q[1]) + (q[2] * q[2] + q[3] * q[3]));
            const float ks = red16((k[0] * k[0] + k[1] * k[1]) + (k[2] * k[2] + k[3] * k[3]));
            f32x4 qn = q * rsqrtf(qs * (1.f / 64.f) + EPSN) * qg, kn = k * rsqrtf(ks * (1.f / 64.f) + EPSN) * kg;
            if (!isc) {
                f32x4 qp, kp;
#pragma unroll
                for (int j = 0; j < 4; ++j) { qp[j] = __shfl_xor(qn[j], 4); kp[j] = __shfl_xor(kn[j], 4); }
                const int d0 = c4 & 63; const float pos = (d0 < 32) ? (float)(t >> 6) : (float)(t & 63); const bool lowh = (d0 & 16) == 0;
#pragma unroll
                for (int j = 0; j < 4; ++j) { const float th = pos * invf[j]; const float cs = __cosf(th), sn = __sinf(th);
                    qn[j] = lowh ? qn[j] * cs - qp[j] * sn : qn[j] * cs + qp[j] * sn; kn[j] = lowh ? kn[j] * cs - kp[j] * sn : kn[j] * cs + kp[j] * sn; }
            }
            st4bf(QA + (size_t)row * 256 + c4, qn * (0.125f * 1.4426950408889634f));
            if (lane < 32) st4bf(KA + (size_t)row * 128 + c4, kn);
        }
        asm volatile("" ::: "memory");
        {
            const f32x4 r = ld4bf(pr + C_RR + c4), k = ld4bf(pr + C_RK + c4);
            { const float xv = bf2f(pr[C_XW + lane]);
              tsc[lane] = lane < 16 ? tanhf_(xv) : (lane < 32 ? xv : sigmoidf_(xv)); }
            const f32x4 kx = k * k_k;
            const float kss = red16((kx[0] * kx[0] + kx[1] * kx[1]) + (kx[2] * kx[2] + kx[3] * kx[3]));
            const f32x4 kk = kx * rsqrtf(kss + EPSN);
            bf16_t* recb = (bf16_t*)(RW + (size_t)row * RWREC); float* recf = (float*)(RW + (size_t)row * RWREC + 2560);
            st4bf(recb + c4, kk);
            f32x4 kdsum = {0.f, 0.f, 0.f, 0.f};
#pragma unroll
            for (int d = 0; d < 2; ++d) {
                f32x4 dw = w0[d], da = a0[d];
#pragma unroll 4
                for (int ii = 0; ii < 16; ++ii) { dw += tsc[ii] * *(const LAS f32x4*)(W2s + (d * 16 + ii) * 256 + c4); da += tsc[16 + ii] * *(const LAS f32x4*)(A2s + (d * 16 + ii) * 256 + c4); }
                f32x4 dec, av;
#pragma unroll
                for (int j = 0; j < 4; ++j) { dec[j] = __expf(-0.6065306597126334f * sigmoidf_(dw[j])); av[j] = sigmoidf_(da[j]); }
                const f32x4 kd = k * (1.f + (av - 1.f) * k_a);
                kdsum += kd;
                st4bf(recb + 256 + d * 256 + c4, kk * av);
                st4bf(recb + 768 + d * 256 + c4, kd);
                *(f32x4*)(recf + d * 256 + c4) = dec;
            }
            f32x4 gv = {0.f, 0.f, 0.f, 0.f};
#pragma unroll 4
            for (int ii = 0; ii < 32; ++ii) gv += tsc[32 + ii] * *(const LAS f32x4*)(G2s + ii * 256 + c4);
            st4bf(GB + (size_t)row * 256 + c4, gv);
            const f32x4 bt = r * kdsum * r_k;
            const float bsum = red16((bt[0] + bt[1]) + (bt[2] + bt[3]));
            if (i16 == 0) BS[(size_t)row * 4 + (lane >> 4)] = bsum;
        }
        asm volatile("" ::: "memory");
        if (lane < 16) { const int dir = lane >> 3, gate = (lane >> 2) & 1, hd = lane & 3; const float x = bf2f(pr[C_MG + lane]);
            const float bias = gate ? F.in[26][(l * 2 + dir) * 4 + hd] : F.in[25][(l * 2 + dir) * 4 + hd];
            GA[(size_t)row * 16 + lane] = gate ? log_sigmoid_(x + bias) : (x + bias); }
    }
}
__device__ __forceinline__ int scan_row(int b, int dir, int i) {
    if (i < TCTX) return MLAT + b * TCTX + (dir ? (TCTX - 1 - i) : i);
    const int p = i - TCTX; return b * TLAT + (dir ? (TLAT - 1 - p) : p);
}
__device__ __forceinline__ void rwkv_scan(const Ctx& F, int blk) {
    const int chain = blk >> 2, quarter = blk & 3, b = chain >> 3, head = (chain >> 1) & 3, dir = chain & 1;
    const bool scanner = F.wave < 4;
    const int rowv = (quarter * 4 + (F.wave & 3)) * 4 + (F.lane >> 4), s = F.lane & 15;
    LAS float* buf = (LAS float*)F.lds;
    const bf16_t* P = WSP(bf16_t, WS_P); const unsigned char* RW = WSP(unsigned char, WS_RW); float* YR = WSP(float, WS_YR) + (size_t)dir * MALL * 256;
    const int st = F.tid >> 4, sub = F.tid & 15;
    constexpr int NSTEP = TCTX + TLAT, NCH = NSTEP / 32;
    u32x2 g_kk, g_al, g_kd, g_r, g_v; f32x4 g_w;
#define RW_LOAD(c) do { const int row_ = scan_row(b, dir, (c) * 32 + st); const bf16_t* rb_ = (const bf16_t*)(RW + (size_t)row_ * RWREC) + head * 64 + sub * 4; \
        g_kk = *(const u32x2*)rb_; g_al = *(const u32x2*)(rb_ + 256 + dir * 256); g_kd = *(const u32x2*)(rb_ + 768 + dir * 256); \
        g_w = *(const f32x4*)((const float*)(RW + (size_t)row_ * RWREC + 2560) + dir * 256 + head * 64 + sub * 4); \
        const bf16_t* pp_ = P + (size_t)row_ * DINP + head * 64 + sub * 4; g_r = *(const u32x2*)(pp_ + C_RR); g_v = *(const u32x2*)(pp_ + C_RV); } while (0)
#define RW_STORE(par) do { LAS float* d_ = buf + ((par) * 32 + st) * 384 + sub * 4; \
        *(LAS f32x4*)(d_) = (f32x4){lo2f(g_kk.x), hi2f(g_kk.x), lo2f(g_kk.y), hi2f(g_kk.y)}; *(LAS f32x4*)(d_ + 64) = (f32x4){lo2f(g_al.x), hi2f(g_al.x), lo2f(g_al.y), hi2f(g_al.y)}; \
        *(LAS f32x4*)(d_ + 128) = (f32x4){lo2f(g_kd.x), hi2f(g_kd.x), lo2f(g_kd.y), hi2f(g_kd.y)}; *(LAS f32x4*)(d_ + 192) = g_w; \
        *(LAS f32x4*)(d_ + 256) = (f32x4){lo2f(g_r.x), hi2f(g_r.x), lo2f(g_r.y), hi2f(g_r.y)}; *(LAS f32x4*)(d_ + 320) = (f32x4){lo2f(g_v.x), hi2f(g_v.x), lo2f(g_v.y), hi2f(g_v.y)}; } while (0)
    f32x4 S = {0.f, 0.f, 0.f, 0.f};
    RW_LOAD(0); RW_STORE(0); __syncthreads();
    for (int c = 0; c < NCH; ++c) {
        const int par = c & 1;
        if (c + 1 < NCH) RW_LOAD(c + 1);
        if (scanner) {
        float ykeep = 0.f;
        f32x4 Lkk[3], Lal[3], Lkd[3], Lw[3], Lr[3]; float Lv[3];
#define SC_LD(set, i_) do { const LAS float* d_ = buf + (par * 32 + (i_)) * 384; Lkk[set] = *(const LAS f32x4*)(d_ + s * 4); Lal[set] = *(const LAS f32x4*)(d_ + 64 + s * 4); \
            Lkd[set] = *(const LAS f32x4*)(d_ + 128 + s * 4); Lw[set] = *(const LAS f32x4*)(d_ + 192 + s * 4); Lr[set] = *(const LAS f32x4*)(d_ + 256 + s * 4); Lv[set] = d_[320 + rowv]; } while (0)
        SC_LD(0, 0); SC_LD(1, 1);
#pragma unroll
        for (int i = 0; i < 32; ++i) {
            if (i + 2 < 32) SC_LD((i + 2) % 3, i + 2);
            const f32x4 kk = Lkk[i % 3], al = Lal[i % 3], kd = Lkd[i % 3], w = Lw[i % 3], r = Lr[i % 3]; const float vr = Lv[i % 3];
            const float sa = red16((S[0] * kk[0] + S[1] * kk[1]) + (S[2] * kk[2] + S[3] * kk[3]));
            S = S * w + (vr * kd - sa * al);
            const float y = red16((S[0] * r[0] + S[1] * r[1]) + (S[2] * r[2] + S[3] * r[3]));
            ykeep = (s == (i & 15)) ? y : ykeep;
            if ((i & 15) == 15) {
                const int stp = c * 32 + (i - 15) + s; const int pc = dir ? (TCTX - 1 - stp) : stp, pl = dir ? (TLAT - 1 - (stp - TCTX)) : (stp - TCTX);
                const int row = stp < TCTX ? (MLAT + b * TCTX + pc) : (b * TLAT + pl);
                YR[(size_t)row * 256 + head * 64 + rowv] = ykeep; }
        }
#undef SC_LD
        }
        if (c + 1 < NCH) RW_STORE(par ^ 1);
        __syncthreads();
    }
#undef RW_LOAD
#undef RW_STORE
}

typedef union { u32x4 u; bf16x8 b; } frag_u;
__device__ __forceinline__ void attn_unit(const Ctx& F, int l, int unit) {
    LAS bf16_t* Kl = (LAS bf16_t*)F.lds; LAS bf16_t* Vt = Kl + 64 * 72;
    const bf16_t* P = WSP(bf16_t, WS_P); const bf16_t* QA = WSP(bf16_t, WS_QA); const bf16_t* KA = WSP(bf16_t, WS_KA); bf16_t* YC = WSP(bf16_t, WS_YCAT);
    const bool isc = unit >= 256; int b, kvh, n;
    if (!isc) { b = unit >> 7; kvh = (unit >> 6) & 1; n = unit & 63; } else { const int u = unit - 256; b = u >> 2; kvh = (u >> 1) & 1; n = u & 1; }
    const int g = F.wave >> 2, ps = F.wave & 3, head = kvh * 2 + g, i = F.lane & 15, gq = F.lane >> 4;
    const int qpos0 = n * 128 + ps * 32, qrow0 = (isc ? MLAT + b * TCTX : b * TLAT) + qpos0;
    bf16x8 Qf[2][2];
#pragma unroll
    for (int qb = 0; qb < 2; ++qb)
#pragma unroll
        for (int ks = 0; ks < 2; ++ks) Qf[qb][ks] = *(const bf16x8*)(QA + (size_t)(qrow0 + qb * 16 + i) * 256 + head * 64 + ks * 32 + gq * 8);
    const float sinkl = F.in[23][l * 4 + head] * 1.4426950408889634f;
    float mrun[2] = {sinkl, sinkl}, lsum[2]; lsum[0] = lsum[1] = (gq == 0) ? 1.f : 0.f;
    f32x4 ao[4][2];
#pragma unroll
    for (int db = 0; db < 4; ++db) { ao[db][0] = (f32x4){0.f, 0.f, 0.f, 0.f}; ao[db][1] = (f32x4){0.f, 0.f, 0.f, 0.f}; }
    const int ntl = isc ? 4 : 10;
    const int skey = F.tid >> 3, sch = F.tid & 7;
    for (int tt = 0; tt < ntl; ++tt) {
        int krow0, kpos0 = 0; bool band = false;
        if (!isc && tt < 6) { const int kt = 2 * (n - 1) + tt; if (kt < 0 || kt >= 128) continue; krow0 = b * TLAT + kt * 64; kpos0 = kt * 64; band = true; }
        else { const int c = isc ? tt : tt - 6; krow0 = MLAT + b * TCTX + c * 64; }
        __syncthreads();
        { const u32x4 kv = *(const u32x4*)(KA + (size_t)(krow0 + skey) * 128 + kvh * 64 + sch * 8);
          const u32x4 vv = *(const u32x4*)(P + (size_t)(krow0 + skey) * DINP + C_AV + kvh * 64 + sch * 8);
          *(LAS u32x4*)(Kl + skey * 72 + sch * 8) = kv;
          const unsigned ww[4] = {vv.x, vv.y, vv.z, vv.w};
#pragma unroll
          for (int j = 0; j < 4; ++j) { Vt[(sch * 8 + 2 * j) * 72 + skey] = (bf16_t)(ww[j] & 0xffffu); Vt[(sch * 8 + 2 * j + 1) * 72 + skey] = (bf16_t)(ww[j] >> 16); } }
        __syncthreads();
        f32x4 sc[4][2];
#pragma unroll
        for (int kb = 0; kb < 4; ++kb) {
            sc[kb][0] = (f32x4){0.f, 0.f, 0.f, 0.f}; sc[kb][1] = (f32x4){0.f, 0.f, 0.f, 0.f};
#pragma unroll
            for (int ks = 0; ks < 2; ++ks) { const bf16x8 kf = *(const LAS bf16x8*)(Kl + (kb * 16 + i) * 72 + ks * 32 + gq * 8);
                sc[kb][0] = __builtin_amdgcn_mfma_f32_16x16x32_bf16(kf, Qf[0][ks], sc[kb][0], 0, 0, 0);
                sc[kb][1] = __builtin_amdgcn_mfma_f32_16x16x32_bf16(kf, Qf[1][ks], sc[kb][1], 0, 0, 0); }
        }
#pragma unroll
        for (int qb = 0; qb < 2; ++qb) {
            const int qp = qpos0 + qb * 16 + i;
            float mx = -1e30f;
#pragma unroll
            for (int kb = 0; kb < 4; ++kb)
#pragma unroll
                for (int r = 0; r < 4; ++r) { if (band) { const int dd = (kpos0 + kb * 16 + 4 * gq + r) - qp; if (dd > 128 || dd < -128) sc[kb][qb][r] = -1e30f; } mx = fmaxf(mx, sc[kb][qb][r]); }
            mx = fmaxf(mx, __shfl_xor(mx, 16)); mx = fmaxf(mx, __shfl_xor(mx, 32));
            const float mnew = fmaxf(mrun[qb], mx), alpha = exp2f(mrun[qb] - mnew); mrun[qb] = mnew;
            float ps_ = 0.f;
#pragma unroll
            for (int kb = 0; kb < 4; ++kb)
#pragma unroll
                for (int r = 0; r < 4; ++r) { const float p = exp2f(sc[kb][qb][r] - mnew); sc[kb][qb][r] = p; ps_ += p; }
            lsum[qb] = lsum[qb] * alpha + ps_;
#pragma unroll
            for (int db = 0; db < 4; ++db) ao[db][qb] *= alpha;
        }
#pragma unroll
        for (int ks2 = 0; ks2 < 2; ++ks2) {
            frag_u pf[2];
#pragma unroll
            for (int qb = 0; qb < 2; ++qb) { pf[qb].u.x = pg8::cvt_pk_bf16(sc[2 * ks2][qb][0], sc[2 * ks2][qb][1]); pf[qb].u.y = pg8::cvt_pk_bf16(sc[2 * ks2][qb][2], sc[2 * ks2][qb][3]);
                pf[qb].u.z = pg8::cvt_pk_bf16(sc[2 * ks2 + 1][qb][0], sc[2 * ks2 + 1][qb][1]); pf[qb].u.w = pg8::cvt_pk_bf16(sc[2 * ks2 + 1][qb][2], sc[2 * ks2 + 1][qb][3]); }
#pragma unroll
            for (int db = 0; db < 4; ++db) { frag_u vf; const LAS bf16_t* vp = Vt + (db * 16 + i) * 72 + (2 * ks2) * 16 + 4 * gq;
                const u32x2 v0 = *(const LAS u32x2*)vp, v1 = *(const LAS u32x2*)(vp + 16); vf.u = (u32x4){v0.x, v0.y, v1.x, v1.y};
                ao[db][0] = __builtin_amdgcn_mfma_f32_16x16x32_bf16(vf.b, pf[0].b, ao[db][0], 0, 0, 0);
                ao[db][1] = __builtin_amdgcn_mfma_f32_16x16x32_bf16(vf.b, pf[1].b, ao[db][1], 0, 0, 0); }
        }
    }
    const float* og = F.in[24] + l * 256 + head * 64;
#pragma unroll
    for (int qb = 0; qb < 2; ++qb) {
        float lt = lsum[qb]; lt += __shfl_xor(lt, 16); lt += __shfl_xor(lt, 32);
        const float il = 1.f / lt; float ss = 0.f;
#pragma unroll
        for (int db = 0; db < 4; ++db) { ao[db][qb] *= il; ss += (ao[db][qb][0] * ao[db][qb][0] + ao[db][qb][1] * ao[db][qb][1]) + (ao[db][qb][2] * ao[db][qb][2] + ao[db][qb][3] * ao[db][qb][3]); }
        ss += __shfl_xor(ss, 16); ss += __shfl_xor(ss, 32);
        const float rs = rsqrtf(ss * (1.f / 64.f) + EPSN);
        bf16_t* yo = YC + (size_t)(qrow0 + qb * 16 + i) * DM + 512 + head * 64;
#pragma unroll
        for (int db = 0; db < 4; ++db) { const f32x4 gg = *(const f32x4*)(og + db * 16 + 4 * gq); st4bf(yo + db * 16 + 4 * gq, ao[db][qb] * rs * gg * ZF(8)); }
    }
    __syncthreads();
}

__device__ __forceinline__ int ml_row(int b, int dir, int j, int tp) {
    if (j < 2) { const int p = j * 128 + tp; return MLAT + b * TCTX + (dir ? (TCTX - 1 - p) : p); }
    const int p = (j - 2) * 128 + tp; return b * TLAT + (dir ? (TLAT - 1 - p) : p);
}
__device__ __forceinline__ void scan128_add(float& x0, float& x1, int lane) {
    x1 += x0; float t = x1;
#pragma unroll
    for (int o = 1; o < 64; o <<= 1) { const float u = __shfl_up(t, o); if (lane >= o) t += u; }
    const float ex = t - x1; x0 += ex; x1 = t;
}
__device__ __forceinline__ void scan128_max(float& x0, float& x1, int lane) {
    x1 = fmaxf(x1, x0); float t = x1;
#pragma unroll
    for (int o = 1; o < 64; o <<= 1) { const float u = __shfl_up(t, o); if (lane >= o) t = fmaxf(t, u); }
    const float pv = __shfl_up(t, 1); if (lane > 0) x0 = fmaxf(x0, pv); x1 = t;
}
__device__ __forceinline__ void ml_stage_T(const Ctx& F, const bf16_t* P, int b, int dir, int j, int col0, LAS bf16_t* dst, const LAS float* sw, float cscale) {
#pragma unroll
    for (int it = 0; it < 2; ++it) { const int id = F.tid + it * NTHR, tp = id >> 3, ch = id & 7;
        const u32x4 v = *(const u32x4*)(P + (size_t)ml_row(b, dir, j, tp) * DINP + col0 + ch * 8); const float s = (sw ? sw[tp] : 1.f) * cscale;
        const unsigned ww[4] = {v.x, v.y, v.z, v.w};
#pragma unroll
        for (int q = 0; q < 4; ++q) { dst[(ch * 8 + 2 * q) * 136 + tp] = (bf16_t)f2bf(lo2f(ww[q]) * s); dst[(ch * 8 + 2 * q + 1) * 136 + tp] = (bf16_t)f2bf(hi2f(ww[q]) * s); } }
}
__device__ __forceinline__ void ml_stage_R(const Ctx& F, const bf16_t* P, int b, int dir, int j, int col0, LAS bf16_t* dst, float cscale) {
#pragma unroll
    for (int it = 0; it < 2; ++it) { const int id = F.tid + it * NTHR, tp = id >> 3, ch = id & 7;
        u32x4 v = *(const u32x4*)(P + (size_t)ml_row(b, dir, j, tp) * DINP + col0 + ch * 8);
        if (cscale != 1.f) { v.x = pk2(lo2f(v.x) * cscale, hi2f(v.x) * cscale); v.y = pk2(lo2f(v.y) * cscale, hi2f(v.y) * cscale); v.z = pk2(lo2f(v.z) * cscale, hi2f(v.z) * cscale); v.w = pk2(lo2f(v.w) * cscale, hi2f(v.w) * cscale); }
        *(LAS u32x4*)(dst + tp * 72 + ch * 8) = v; }
}
__device__ __forceinline__ void mlstm_local(const Ctx& F, int task) {
    const int chain = task / NCHK, j = task % NCHK, b = chain >> 3, head = (chain >> 1) & 3, dir = chain & 1;
    const bf16_t* P = WSP(bf16_t, WS_P); const float* GA = WSP(float, WS_GA);
    LAS bf16_t* Vt = (LAS bf16_t*)F.lds; LAS bf16_t* Kt = Vt + 64 * 136; LAS float* wS = (LAS float*)(Kt + 64 * 136); LAS float* sc2 = wS + 128;
    __syncthreads();
    if (F.wave == 0) {
        const int r0 = ml_row(b, dir, j, 2 * F.lane), r1 = ml_row(b, dir, j, 2 * F.lane + 1);
        const float li0 = GA[(size_t)r0 * 16 + dir * 8 + head], li1 = GA[(size_t)r1 * 16 + dir * 8 + head];
        float b0 = GA[(size_t)r0 * 16 + dir * 8 + 4 + head], b1 = GA[(size_t)r1 * 16 + dir * 8 + 4 + head];
        scan128_add(b0, b1, F.lane);
        const float bend = __shfl(b1, 63);
        const float d0 = bend - b0 + li0, d1 = bend - b1 + li1;
        float mx = fmaxf(d0, d1);
#pragma unroll
        for (int o = 1; o < 64; o <<= 1) mx = fmaxf(mx, __shfl_xor(mx, o));
        wS[2 * F.lane] = __expf(d0 - mx); wS[2 * F.lane + 1] = __expf(d1 - mx);
        if (F.lane == 0) { sc2[0] = mx; sc2[1] = bend; }
    }
    __syncthreads();
    ml_stage_T(F, P, b, dir, j, C_MV + head * 64, Vt, wS, 1.f);
    ml_stage_T(F, P, b, dir, j, C_MK + head * 64, Kt, nullptr, 0.125f);
    __syncthreads();
    float* LC = WSP(float, WS_LC) + (size_t)task * CST;
    { const int vb = F.wave >> 1, i = F.lane & 15, gq = F.lane >> 4;
#pragma unroll
      for (int kk2 = 0; kk2 < 2; ++kk2) { const int kb = 2 * (F.wave & 1) + kk2; f32x4 acc = {0.f, 0.f, 0.f, 0.f};
#pragma unroll
          for (int ks = 0; ks < 4; ++ks) { const bf16x8 a = *(const LAS bf16x8*)(Vt + (vb * 16 + i) * 136 + ks * 32 + gq * 8), bb = *(const LAS bf16x8*)(Kt + (kb * 16 + i) * 136 + ks * 32 + gq * 8);
              acc = __builtin_amdgcn_mfma_f32_16x16x32_bf16(a, bb, acc, 0, 0, 0); }
#pragma unroll
          for (int r = 0; r < 4; ++r) LC[(vb * 16 + 4 * gq + r) * 64 + kb * 16 + i] = acc[r]; } }
    if (F.tid < 64) { float a = 0.f;
#pragma unroll 8
        for (int s = 0; s < 128; ++s) a += wS[s] * bf2f(Kt[F.tid * 136 + s]);
        LC[4096 + F.tid] = a; }
    if (F.tid == 0) { float* LB = WSP(float, WS_LB); LB[task * 2] = sc2[0]; LB[task * 2 + 1] = sc2[1]; }
}
__device__ __forceinline__ void mlstm_chain(const Ctx& F) {
    const int gt = F.vcu * NTHR + F.tid; if (gt >= 16 * CST) return;
    const int chain = gt / CST, e = gt % CST;
    const float* LC = WSP(float, WS_LC) + (size_t)chain * NCHK * CST + e; float* ST = WSP(float, WS_ST) + (size_t)chain * NCHK * CST + e;
    const float* LB = WSP(float, WS_LB) + chain * NCHK * 2; float* SM = WSP(float, WS_LB) + 4096 + chain * NCHK;
    float m = 0.f, x = 0.f;
#pragma unroll 6
    for (int j = 0; j < NCHK; ++j) {
        const float d = LC[(size_t)j * CST], L = LB[2 * j], Bv = LB[2 * j + 1];
        ST[(size_t)j * CST] = x; if (e == 0) SM[j] = m;
        const float mn = fmaxf(Bv + m, L);
        x = __expf(Bv + m - mn) * x + __expf(L - mn) * d; m = mn;
    }
}
__device__ __forceinline__ void mlstm_out(const Ctx& F, int l, int unit) {
    const bool isc = unit >= 512; int b, chunk, head;
    if (!isc) { b = unit >> 8; chunk = (unit >> 2) & 63; head = unit & 3; } else { const int u = unit - 512; b = u >> 3; chunk = (u >> 2) & 1; head = u & 3; }
    const bf16_t* P = WSP(bf16_t, WS_P); const float* GA = WSP(float, WS_GA); bf16_t* YC = WSP(bf16_t, WS_YCAT);
    LAS bf16_t* Ql = (LAS bf16_t*)F.lds; LAS bf16_t* Kl = Ql + 128 * 72; LAS bf16_t* Vt = Kl + 128 * 72; LAS bf16_t* Cb = Vt + 64 * 136;
    LAS float* nS = (LAS float*)(Cb + 64 * 72); LAS float* aS = nS + 64; LAS float* bS = aS + 128; LAS float* MS = bS + 128; LAS float* Hs = MS + 128;
    const int i = F.lane & 15, gq = F.lane >> 4, w = F.wave;
    for (int dir = 0; dir < 2; ++dir) {
        const int j = isc ? (dir ? 1 - chunk : chunk) : 2 + (dir ? 63 - chunk : chunk);
        const int chain = (b * 4 + head) * 2 + dir;
        const float* ST = WSP(float, WS_ST) + ((size_t)chain * NCHK + j) * CST; const float mprev = WSP(float, WS_LB)[4096 + chain * NCHK + j];
        __syncthreads();
        if (w == 0) {
            const int r0 = ml_row(b, dir, j, 2 * F.lane), r1 = ml_row(b, dir, j, 2 * F.lane + 1);
            const float li0 = GA[(size_t)r0 * 16 + dir * 8 + head], li1 = GA[(size_t)r1 * 16 + dir * 8 + head];
            float b0 = GA[(size_t)r0 * 16 + dir * 8 + 4 + head], b1 = GA[(size_t)r1 * 16 + dir * 8 + 4 + head];
            scan128_add(b0, b1, F.lane);
            const float a0 = li0 - b0, a1 = li1 - b1; float A0 = a0, A1 = a1;
            scan128_max(A0, A1, F.lane);
            aS[2 * F.lane] = a0; aS[2 * F.lane + 1] = a1; bS[2 * F.lane] = b0; bS[2 * F.lane + 1] = b1;
            MS[2 * F.lane] = fmaxf(A0, mprev); MS[2 * F.lane + 1] = fmaxf(A1, mprev);
        }
        ml_stage_R(F, P, b, dir, j, C_MQ + head * 64, Ql, 1.f);
        ml_stage_R(F, P, b, dir, j, C_MK + head * 64, Kl, 0.125f);
        ml_stage_T(F, P, b, dir, j, C_MV + head * 64, Vt, nullptr, 1.f);
        { const f32x4 c0 = *(const f32x4*)(ST + F.tid * 8), c1 = *(const f32x4*)(ST + F.tid * 8 + 4); const int v = F.tid >> 3, k0 = (F.tid & 7) * 8;
          u32x4 o; o.x = pk2(c0[0], c0[1]); o.y = pk2(c0[2], c0[3]); o.z = pk2(c1[0], c1[1]); o.w = pk2(c1[2], c1[3]); *(LAS u32x4*)(Cb + v * 72 + k0) = o;
          if (F.tid < 64) nS[F.tid] = ST[4096 + F.tid]; }
        __syncthreads();
        const int t = 16 * w + i; const float Mt = MS[t], bt = bS[t];
        bf16x8 Qf[2];
#pragma unroll
        for (int ks = 0; ks < 2; ++ks) Qf[ks] = *(const LAS bf16x8*)(Ql + t * 72 + ks * 32 + gq * 8);
        f32x4 sc[8];
#pragma unroll
        for (int sb = 0; sb < 8; ++sb) { sc[sb] = (f32x4){0.f, 0.f, 0.f, 0.f};
            if (sb <= w) {
#pragma unroll
                for (int ks = 0; ks < 2; ++ks) { const bf16x8 kf = *(const LAS bf16x8*)(Kl + (sb * 16 + i) * 72 + ks * 32 + gq * 8); sc[sb] = __builtin_amdgcn_mfma_f32_16x16x32_bf16(kf, Qf[ks], sc[sb], 0, 0, 0); }
#pragma unroll
                for (int r = 0; r < 4; ++r) { const int s = sb * 16 + 4 * gq + r; sc[sb][r] = (s <= t) ? sc[sb][r] * __expf(aS[s] - Mt) : 0.f; }
            } }
        float den = 0.f;
#pragma unroll
        for (int sb = 0; sb < 8; ++sb) den += (sc[sb][0] + sc[sb][1]) + (sc[sb][2] + sc[sb][3]);
        den += __shfl_xor(den, 16); den += __shfl_xor(den, 32);
        f32x4 nm[4], it_[4];
#pragma unroll
        for (int vb = 0; vb < 4; ++vb) { nm[vb] = (f32x4){0.f, 0.f, 0.f, 0.f}; it_[vb] = (f32x4){0.f, 0.f, 0.f, 0.f}; }
#pragma unroll
        for (int ks2 = 0; ks2 < 4; ++ks2) if (2 * ks2 <= w) {
            frag_u pf; pf.u.x = pg8::cvt_pk_bf16(sc[2 * ks2][0], sc[2 * ks2][1]); pf.u.y = pg8::cvt_pk_bf16(sc[2 * ks2][2], sc[2 * ks2][3]);
            pf.u.z = pg8::cvt_pk_bf16(sc[2 * ks2 + 1][0], sc[2 * ks2 + 1][1]); pf.u.w = pg8::cvt_pk_bf16(sc[2 * ks2 + 1][2], sc[2 * ks2 + 1][3]);
#pragma unroll
            for (int vb = 0; vb < 4; ++vb) { frag_u vf; const LAS bf16_t* vp = Vt + (vb * 16 + i) * 136 + (2 * ks2) * 16 + 4 * gq;
                const u32x2 v0 = *(const LAS u32x2*)vp, v1 = *(const LAS u32x2*)(vp + 16); vf.u = (u32x4){v0.x, v0.y, v1.x, v1.y};
                nm[vb] = __builtin_amdgcn_mfma_f32_16x16x32_bf16(vf.b, pf.b, nm[vb], 0, 0, 0); }
        }
#pragma unroll
        for (int vb = 0; vb < 4; ++vb)
#pragma unroll
            for (int ks = 0; ks < 2; ++ks) { const bf16x8 cf = *(const LAS bf16x8*)(Cb + (vb * 16 + i) * 72 + ks * 32 + gq * 8); it_[vb] = __builtin_amdgcn_mfma_f32_16x16x32_bf16(cf, Qf[ks], it_[vb], 0, 0, 0); }
        float nq = 0.f;
#pragma unroll
        for (int c = 0; c < 2; ++c) { const u32x4 qv = *(const LAS u32x4*)(Ql + t * 72 + gq * 16 + c * 8); const unsigned ww[4] = {qv.x, qv.y, qv.z, qv.w};
#pragma unroll
            for (int q = 0; q < 4; ++q) nq += nS[gq * 16 + c * 8 + 2 * q] * lo2f(ww[q]) + nS[gq * 16 + c * 8 + 2 * q + 1] * hi2f(ww[q]); }
        nq += __shfl_xor(nq, 16); nq += __shfl_xor(nq, 32);
        const float wint = __expf(mprev - Mt); den += wint * nq;
        const float dn = 1.f / fmaxf(fabsf(den), __expf(-(bt + Mt)));
        const int torig = dir ? 127 - t : t;
#pragma unroll
        for (int vb = 0; vb < 4; ++vb)
#pragma unroll
            for (int r = 0; r < 4; ++r) { const float hv = (nm[vb][r] + wint * it_[vb][r]) * dn; LAS float* hp = Hs + torig * 65 + vb * 16 + 4 * gq + r; if (dir == 0) *hp = hv; else *hp += hv; }
    }
    __syncthreads();
    {
        const int t = F.tid >> 2, vq = F.tid & 3; const int row = (isc ? MLAT + b * TCTX : b * TLAT) + chunk * 128 + t;
        float hv[16], ss = 0.f;
#pragma unroll
        for (int q = 0; q < 16; ++q) { hv[q] = Hs[t * 65 + vq * 16 + q]; ss += hv[q] * hv[q]; }
        ss += __shfl_xor(ss, 1); ss += __shfl_xor(ss, 2);
        const float rs = rsqrtf(ss * (1.f / 64.f) + EPSN);
        const float* og = F.in[27] + l * 256 + head * 64 + vq * 16; const bf16_t* op = P + (size_t)row * DINP + C_MO + head * 64 + vq * 16;
        const u32x4 o0 = *(const u32x4*)op, o1 = *(const u32x4*)(op + 8); const unsigned ow[8] = {o0.x, o0.y, o0.z, o0.w, o1.x, o1.y, o1.z, o1.w};
        unsigned res[8];
#pragma unroll
        for (int q = 0; q < 8; ++q) { const float y0 = sigmoidf_(lo2f(ow[q])) * hv[2 * q] * rs * og[2 * q], y1 = sigmoidf_(hi2f(ow[q])) * hv[2 * q + 1] * rs * og[2 * q + 1]; res[q] = pk2(y0 * ZF(16), y1 * ZF(16)); }
        bf16_t* yo = YC + (size_t)row * DM + 768 + head * 64 + vq * 16;
        *(u32x4*)yo = (u32x4){res[0], res[1], res[2], res[3]}; *(u32x4*)(yo + 8) = (u32x4){res[4], res[5], res[6], res[7]};
    }
    __syncthreads();
}
__device__ __forceinline__ void rwkv_finish(const Ctx& F, int l, int nrows) {
    const bf16_t* P = WSP(bf16_t, WS_P); const float* YR = WSP(float, WS_YR); const bf16_t* GB = WSP(bf16_t, WS_GB); const float* BS = WSP(float, WS_BS); bf16_t* YC = WSP(bf16_t, WS_YCAT);
    const int c4 = F.lane * 4; const f32x4 lg = *(const f32x4*)(F.in[20] + l * 256 + c4);
    const int gw = F.vcu * NWAVES + F.wave, NGW = F.G * NWAVES;
    for (int row = gw; row < nrows; row += NGW) {
        const f32x4 y = *(const f32x4*)(YR + (size_t)row * 256 + c4) + *(const f32x4*)(YR + (size_t)(MALL + row) * 256 + c4);
        const float ss = red16((y[0] * y[0] + y[1] * y[1]) + (y[2] * y[2] + y[3] * y[3]));
        const float rs = rsqrtf(ss * (1.f / 64.f) + EPSN);
        const f32x4 v = ld4bf(P + (size_t)row * DINP + C_RV + c4), g = ld4bf(GB + (size_t)row * 256 + c4);
        const float bn = BS[(size_t)row * 4 + (F.lane >> 4)];
        st4bf(YC + (size_t)row * DM + 256 + c4, (y * rs * lg * ZF(32) + bn * v * ZF(64)) * g * ZF(4));
    }
}
__device__ __forceinline__ float clr7(float x) { return __uint_as_float(__float_as_uint(x) & 0xFFFFFF80u); }
__device__ __forceinline__ void ins16(float (&L)[16], float p) {
#pragma unroll
    for (int j = 15; j >= 1; --j) L[j] = __builtin_amdgcn_fmed3f(L[j - 1], L[j], p);
    L[0] = fmaxf(L[0], p);
}
__device__ __forceinline__ void peer_topk_task(const float* srow, u32x2* eg) {
    float L0[16], L1[16];
#pragma unroll
    for (int j = 0; j < 16; ++j) { L0[j] = -INFINITY; L1[j] = -INFINITY; }
    for (int i = 0; i < 128; i += 4) {
        const f32x4 a = *(const f32x4*)(srow + i), b = *(const f32x4*)(srow + 128 + i);
#pragma unroll
        for (int q = 0; q < 4; ++q) { ins16(L0, __uint_as_float((__float_as_uint(a[q]) & 0xFFFFFF80u) | (unsigned)(i + q)));
                                      ins16(L1, __uint_as_float((__float_as_uint(b[q]) & 0xFFFFFF80u) | (unsigned)(i + q))); }
    }
    float T[16];
#pragma unroll
    for (int j = 0; j < 16; ++j) T[j] = -INFINITY;
#pragma unroll
    for (int a = 0; a < 16; ++a)
#pragma unroll
        for (int b = 0; b < 16; ++b) if ((a + 1) * (b + 1) <= 16) { const float s = clr7(L0[a]) + clr7(L1[b]);
            ins16(T, __uint_as_float((__float_as_uint(s) & 0xFFFFFF00u) | (unsigned)(a * 16 + b))); }
    float e[16], sum = 0.f; const float mx = __uint_as_float(__float_as_uint(T[0]) & 0xFFFFFF00u);
#pragma unroll
    for (int j = 0; j < 16; ++j) { e[j] = __expf(__uint_as_float(__float_as_uint(T[j]) & 0xFFFFFF00u) - mx); sum += e[j]; }
    const float inv = 1.f / sum;
#pragma unroll
    for (int j = 0; j < 16; ++j) {
        const unsigned ab = __float_as_uint(T[j]) & 0xFFu, a = ab >> 4, b = ab & 15u; unsigned i0 = 0u, i1 = 0u;
#pragma unroll
        for (int q = 0; q < 16; ++q) { i0 = (a == (unsigned)q) ? (__float_as_uint(L0[q]) & 0x7Fu) : i0; i1 = (b == (unsigned)q) ? (__float_as_uint(L1[q]) & 0x7Fu) : i1; }
        eg[j] = (u32x2){i0 * 128u + i1, __float_as_uint(e[j] * inv)};
    }
}
__device__ __forceinline__ float gelu_tanh(float x) { const float u = 0.7978845608028654f * (x + 0.044715f * x * x * x); return 0.5f * x * (1.f + tanhf_(u)); }
__device__ __forceinline__ float dot2bf(unsigned w, unsigned x, float acc) { return __builtin_amdgcn_fdot2_f32_bf16(__builtin_bit_cast(bf16x2_t, w), __builtin_bit_cast(bf16x2_t, x), acc, false); }
__device__ __forceinline__ float wave_total63(float x) {
    x = red16(x);
    x += __int_as_float(__builtin_amdgcn_update_dpp(0, __float_as_int(x), 0x142, 0xa, 0xf, false));
    x += __int_as_float(__builtin_amdgcn_update_dpp(0, __float_as_int(x), 0x143, 0xc, 0xf, false));
    return x;
}
__device__ __forceinline__ void phase_peer(const Ctx& F, int l, int nrows, const float* mod, float* wr_override) {
    const float* S = WSP(float, WS_S); u32x2* EG = WSP(u32x2, WS_EG); const bf16_t* H = WSP(bf16_t, WS_H);
    const unsigned char* U = F.ws + WS_U + (size_t)l * UV_LSTRIDE; const unsigned char* V = F.ws + WS_V + (size_t)l * UV_LSTRIDE;
    const float* USC = WSP(float, WS_SC) + (size_t)l * 2 * 16384; const float* VSC = USC + 16384;
    const int tpb = nrows / F.G, tok0 = F.vcu * tpb;
    for (int task = F.tid; task < tpb * 8; task += NTHR) { const int row = tok0 + (task >> 3), hd = task & 7;
        peer_topk_task(S + (size_t)row * 2048 + hd * 256, EG + (size_t)row * 128 + hd * 16); }
    __threadfence_block(); __syncthreads();
    const int lane = F.lane;
    for (int tk = F.wave; tk < tpb; tk += NWAVES) {
        const int row = tok0 + tk; const bool isc = row >= MLAT; const int smp = isc ? 2 : (row >> 13);
        float* xrow = isc ? WSP(float, WS_XC) + (size_t)(row - MLAT) * DM : F.out + (size_t)row * DM;
        f32x2 hv[8];
        { const u32x4 h0 = *(const u32x4*)(H + (size_t)row * DM + lane * 16), h1 = *(const u32x4*)(H + (size_t)row * DM + lane * 16 + 8);
          const unsigned hw[8] = {h0.x, h0.y, h0.z, h0.w, h1.x, h1.y, h1.z, h1.w};
#pragma unroll
          for (int q = 0; q < 8; ++q) hv[q] = (f32x2){lo2f(hw[q]), hi2f(hw[q])}; }
        const u32x2 eg0 = EG[(size_t)row * 128 + lane], eg1 = EG[(size_t)row * 128 + 64 + lane];
        float act0 = 0.f, act1 = 0.f;
#pragma unroll 1
        for (int grp = 0; grp < 8; ++grp) {
            u32x4 ua[16];
#pragma unroll
            for (int q = 0; q < 16; ++q) { const int ii = grp * 16 + q; const unsigned e = __builtin_amdgcn_readlane(ii < 64 ? eg0.x : eg1.x, ii & 63);
                ua[q] = *(const u32x4*)(U + (size_t)e * 1024 + lane * 16); }
#pragma unroll
            for (int q = 0; q < 16; ++q) { const int ii = grp * 16 + q; const unsigned e = __builtin_amdgcn_readlane(ii < 64 ? eg0.x : eg1.x, ii & 63);
                const unsigned uw[4] = {ua[q].x, ua[q].y, ua[q].z, ua[q].w}; f32x2 d2 = {0.f, 0.f};
#pragma unroll
                for (int j = 0; j < 4; ++j) { d2 += __builtin_amdgcn_cvt_pk_f32_fp8((int)uw[j], false) * hv[2 * j]; d2 += __builtin_amdgcn_cvt_pk_f32_fp8((int)uw[j], true) * hv[2 * j + 1]; }
                const float tot = __int_as_float(__builtin_amdgcn_readlane(__float_as_int(wave_total63(d2.x + d2.y)), 63)) * USC[e];
                if (ii < 64) act0 = (lane == (ii & 63)) ? tot : act0; else act1 = (lane == (ii & 63)) ? tot : act1; }
        }
        const float cf0 = __uint_as_float(eg0.y) * gelu_tanh(act0) * VSC[eg0.x], cf1 = __uint_as_float(eg1.y) * gelu_tanh(act1) * VSC[eg1.x];
        f32x2 ac[8];
#pragma unroll
        for (int q = 0; q < 8; ++q) ac[q] = (f32x2){0.f, 0.f};
#pragma unroll 1
        for (int grp = 0; grp < 8; ++grp) {
            u32x4 va[16];
#pragma unroll
            for (int q = 0; q < 16; ++q) { const int ii = grp * 16 + q; const unsigned e = __builtin_amdgcn_readlane(ii < 64 ? eg0.x : eg1.x, ii & 63);
                va[q] = *(const u32x4*)(V + (size_t)e * 1024 + lane * 16); }
#pragma unroll
            for (int q = 0; q < 16; ++q) { const int ii = grp * 16 + q; const float cf = __int_as_float(__builtin_amdgcn_readlane(__float_as_int(ii < 64 ? cf0 : cf1), ii & 63));
                const unsigned vw[4] = {va[q].x, va[q].y, va[q].z, va[q].w};
#pragma unroll
                for (int j = 0; j < 4; ++j) { ac[2 * j] += cf * __builtin_amdgcn_cvt_pk_f32_fp8((int)vw[j], false); ac[2 * j + 1] += cf * __builtin_amdgcn_cvt_pk_f32_fp8((int)vw[j], true); } }
        }
        float acc[16];
#pragma unroll
        for (int q = 0; q < 8; ++q) { acc[2 * q] = ac[q].x; acc[2 * q + 1] = ac[q].y; }
        const float* gt = mod + smp * 6144 + 5120;
#pragma unroll
        for (int q = 0; q < 4; ++q) { const int c = lane * 16 + q * 4; const f32x4 g = *(const f32x4*)(gt + c), x = *(const f32x4*)(xrow + c);
            *(f32x4*)((wr_override ? wr_override + (size_t)row * DM : xrow) + c) = x + ZF(1) * g * (f32x4){acc[q * 4], acc[q * 4 + 1], acc[q * 4 + 2], acc[q * 4 + 3]}; }
    }
}

constexpr int PH_PER_LAYER = 10, N_PHASES = 1 + 2 * PH_PER_LAYER;
struct Args { const float* in[32]; float* out; unsigned char* ws; int ph_lo, ph_hi, li, pad; };
__global__ void __launch_bounds__(NTHR, 2) mk_fwd(Args args) {
    extern __shared__ __attribute__((aligned(16))) unsigned char lds[];
    Ctx F;
    F.lds = (LAS unsigned char*)lds;
    volatile LAS unsigned* MISC = (volatile LAS unsigned*)(F.lds + MISC_OFF);
    F.tid = threadIdx.x; F.lane = F.tid & 63; F.wave = __builtin_amdgcn_readfirstlane(F.tid >> 6);
    F.G = gridDim.x; { const int bx = blockIdx.x; F.vcu = (F.G % 8 == 0) ? (bx % 8) * (F.G / 8) + bx / 8 : bx; }
#pragma unroll
    for (int i = 0; i < 32; ++i) F.in[i] = args.in[i];
    F.out = args.out; F.ws = args.ws;
    for (int u = F.tid; u < (LDS_BYTES - LDSCTL_OFF) / 4; u += NTHR) ((LAS unsigned*)(F.lds + LDSCTL_OFF))[u] = 0u;
    __syncthreads();
    XcdBarrier bar; bar.bar = (unsigned*)(args.ws + WS_CTL) + CW_BAR; bar.x = 0; bar.st = nullptr;
#if !MK_MULTI
    bar = xcd_barrier_post((unsigned*)(args.ws + WS_CTL) + CW_BAR, MISC + 8);
#endif
    const int lo = args.ph_lo, hi = args.ph_hi;
#define IN(k) (lo <= (k) && (k) < hi)
#ifndef REP_PH
#define REP_PH -1
#endif
#define REPS(k) ((REP_PH == (k)) ? 2 : 1)
#define PHCTX Ctx Fp = F; { int t_ = F.tid; asm volatile("" : "+v"(t_)); Fp.tid = t_; Fp.lane = t_ & 63; }
#if MK_MULTI
#define SEAM(k) do { } while (0)
#else
#ifndef BAR_REPS
#define BAR_REPS 1
#endif
#define SEAM(k) do { if (IN(k) && IN((k) + 1)) for (int br_ = 0; br_ < BAR_REPS; ++br_) xcd_barrier(bar); } while (0)
#endif
    if (IN(0)) { PHCTX; for (int rep = 0; rep < REPS(100); ++rep) phase_prologue(Fp); }
    SEAM(0);
    float* XC = WSP(float, WS_XC);
#pragma unroll 1
    for (int l = 0; l < 2; ++l) {
        const int pb = 1 + l * PH_PER_LAYER;
        const float* xlat = l == 0 ? F.in[0] : F.out; const float* xctx = l == 0 ? F.in[2] : XC;
        const int mrows = l == 0 ? MALL : MLAT;
        const float* mod = WSP(float, WS_MOD) + (size_t)l * 3 * 6144;
        if (IN(pb + 0)) { PHCTX; for (int rep = 0; rep < REPS(0); ++rep) { phase_norm(Fp, l, 0, MALL, xlat, xctx); } }
        SEAM(pb + 0);
        if (IN(pb + 1)) for (int rep = 0; rep < REPS(1); ++rep) { PHCTX; pg8::Gemm g{WSP(bf16_t, WS_H), WSP(bf16_t, WS_WIN + l * WIN_LSTRIDE), MALL, DINP, DM}; pg8::StaticOrder So; So.init(MALL, DINP, F.G, (int)blockIdx.x);
            pg8::EpiBf16 E{WSP(bf16_t, WS_P), DINP}; pg8::gemm_phase<pg8::EpiBf16, pg8::StaticOrder, true, true>(F.lds, g, So, E, Fp.tid); }
        SEAM(pb + 1);
        if (IN(pb + 2)) { PHCTX; for (int rep = 0; rep < REPS(2); ++rep) { phase_prep(Fp, l); __syncthreads(); } }
        SEAM(pb + 2);
        if (IN(pb + 3)) for (int rep = 0; rep < REPS(3); ++rep) { PHCTX;
            if (F.vcu < 64) rwkv_scan(Fp, F.vcu);
            else { const int nb = F.G - 64, wb = F.vcu - 64; const int natt = l == 0 ? 264 : 256, ntask = natt + 16 * NCHK;
                for (int task = wb; task < ntask; task += nb) { if (task < natt) attn_unit(Fp, l, task); else mlstm_local(Fp, task - natt); } }
        }
        SEAM(pb + 3);
        if (IN(pb + 4)) { PHCTX; for (int rep = 0; rep < REPS(4); ++rep) mlstm_chain(Fp); }
        SEAM(pb + 4);
        if (IN(pb + 5)) for (int rep = 0; rep < REPS(5); ++rep) { PHCTX; const int nun = l == 0 ? 528 : 512; for (int u = F.vcu; u < nun; u += F.G) mlstm_out(Fp, l, u); rwkv_finish(Fp, l, mrows); }
        SEAM(pb + 5);
        if (IN(pb + 6)) for (int rep = 0; rep < REPS(6); ++rep) { PHCTX; pg8::Gemm g{WSP(bf16_t, WS_YCAT), WSP(bf16_t, WS_WOUT + l * WOUT_LSTRIDE), mrows, DM, DM}; pg8::StaticOrder So; So.init(mrows, DM, F.G, (int)blockIdx.x);
            float* dummy = WSP(float, WS_YR); const bool dm_ = (REPS(6) == 2 && rep == 0); pg8::EpiRes E{xlat, xctx, dm_ ? dummy : F.out, dm_ ? dummy : XC, mod}; pg8::gemm_phase<pg8::EpiRes, pg8::StaticOrder, true, true>(F.lds, g, So, E, Fp.tid); }
        SEAM(pb + 6);
        if (IN(pb + 7)) { PHCTX; for (int rep = 0; rep < REPS(7); ++rep) phase_norm(Fp, l, 1, mrows, F.out, XC); }
        SEAM(pb + 7);
        if (IN(pb + 8)) for (int rep = 0; rep < REPS(8); ++rep) { PHCTX; pg8::Gemm g{WSP(bf16_t, WS_H), WSP(bf16_t, WS_WEFF + l * WEFF_LSTRIDE), mrows, 2048, DM}; pg8::StaticOrder So; So.init(mrows, 2048, F.G, (int)blockIdx.x);
            pg8::EpiF32 E{WSP(float, WS_S), 2048}; pg8::gemm_phase<pg8::EpiF32, pg8::StaticOrder, true, true>(F.lds, g, So, E, Fp.tid); }
        SEAM(pb + 8);
        if (IN(pb + 9)) { PHCTX; for (int rep = 0; rep < REPS(9); ++rep) { phase_peer(Fp, l, mrows, mod, (REPS(9) == 2 && rep == 0) ? WSP(float, WS_YR) : nullptr); __syncthreads(); } }
        SEAM(pb + 9);
    }
#undef IN
#undef SEAM
}

extern "C" void kernel_launch(void* const* d_in, const int* in_sizes, int n_in, void* d_out, int out_size, void* d_ws, size_t ws_size, hipStream_t stream) {
    static int grid = 0;
    if (grid == 0) {
        if (n_in != 32 || out_size != MLAT * DM || ws_size < WS_END) { fprintf(stderr, "kernel_launch: unexpected shapes: n_in %d out %d ws %zu (need %zu)\n", n_in, out_size, ws_size, (size_t)WS_END); grid = -1; return; }
        int dev = 0, cus = 0, per_cu = 0;
        if (hipGetDevice(&dev) != hipSuccess || hipDeviceGetAttribute(&cus, hipDeviceAttributeMultiprocessorCount, dev) != hipSuccess) { grid = -1; return; }
        if (hipFuncSetAttribute((const void*)mk_fwd, hipFuncAttributeMaxDynamicSharedMemorySize, LDS_BYTES) != hipSuccess) { fprintf(stderr, "kernel_launch: hipFuncSetAttribute failed\n"); grid = -1; return; }
        if (hipOccupancyMaxActiveBlocksPerMultiprocessor(&per_cu, (const void*)mk_fwd, NTHR, LDS_BYTES) != hipSuccess || per_cu < 1) fprintf(stderr, "kernel_launch: occupancy query reports %d\n", per_cu);
        (void)hipGetLastError();
        grid = cus;
        if (grid != 256) fprintf(stderr, "kernel_launch: grid %d (built for 256 CUs)\n", grid);
    }
    if (grid < 0) return;
    (void)hipMemsetAsync((char*)d_ws + WS_CTL, 0, CTL_ZERO_BYTES, stream);
    Args a{};
    for (int i = 0; i < 32; ++i) a.in[i] = (const float*)d_in[i];
    a.out = (float*)d_out; a.ws = (unsigned char*)d_ws;
#if MK_MULTI
    for (int p = 0; p < N_PHASES; ++p) { a.ph_lo = p; a.ph_hi = p + 1; a.li = p; hipLaunchKernelGGL(mk_fwd, dim3(grid), dim3(NTHR), LDS_BYTES, stream, a); }
#else
    a.ph_lo = 0; a.ph_hi = N_PHASES; a.li = 0;
    hipLaunchKernelGGL(mk_fwd, dim3(grid), dim3(NTHR), LDS_BYTES, stream, a);
#endif
}
```

```cpp
#include <hip/hip_runtime.h>
#include <cstdio>
#include <cstdint>

#ifndef MK_MULTI
#define MK_MULTI 0
#endif
namespace pg8 {
#define PG8_LAS __attribute__((address_space(3)))
typedef unsigned short bf16_t;
typedef short bf16x8 __attribute__((ext_vector_type(8)));
typedef float f32x4 __attribute__((ext_vector_type(4)));
typedef unsigned u32x4 __attribute__((ext_vector_type(4)));
constexpr int BM = 256, BK = 64, HALF = 128, HTB = HALF * BK * 2  , STAGE_BYTES = 8 * HTB, NXCD = 8, WGM = 8;

__host__ __device__ __forceinline__ int lds_byte(int r, int c) { const int st = (r >> 4) * 2 + (c >> 5), rr = r & 15, cc = c & 31, ob = rr * 64 + cc * 2; return st * 1024 + (ob ^ (((ob >> 9) & 1) << 5)); }
__host__ __device__ __forceinline__ void stage_rc(int b, int& R, int& C) { const int st = b / 1024, sb = b % 1024, swz = sb ^ (((sb >> 9) & 1) << 5); R = (st >> 1) * 16 + swz / 64; C = (st & 1) * 32 + (swz % 64) / 2; }
__host__ __device__ __forceinline__ int perm32(int rho) { const int n = rho >> 4, i = rho & 15; return 8 * (i >> 2) + 4 * n + (i & 3); }

struct Unit { int pm, pn; };
struct Gemm { const bf16_t* A; const bf16_t* Bt; int M, N, K; };

struct StaticOrder {
    int nM, nN, nwg, G, c;
    __host__ __device__ void init(int M, int N, int G_, int c_) { nM = M / BM; nN = N / BM; nwg = nM * nN; G = G_; c = c_; }
    __host__ __device__ bool next(int i, Unit& u) const {
        const long L = (long)i * G + c; if (L >= nwg) return false;
        int wgid = (int)L; { const int q = nwg / NXCD, r = nwg % NXCD, xcd = wgid % NXCD, off = wgid / NXCD; wgid = (xcd < r ? xcd * (q + 1) : r * (q + 1) + (xcd - r) * q) + off; }
        const int nig = WGM * nN, gid = wgid / nig, fm = gid * WGM, gsz = (nM - fm) < WGM ? (nM - fm) : WGM;
        u.pm = fm + ((wgid % nig) % gsz); u.pn = (wgid % nig) / gsz; return true;
    }
    __device__ __forceinline__ void a_ready(const Unit&) const {}
    __device__ __forceinline__ void done(const Unit&) const {}
};

__device__ __forceinline__ unsigned cvt_pk_bf16(float lo, float hi) { unsigned r; asm volatile("v_cvt_pk_bf16_f32 %0, %1, %2" : "=v"(r) : "v"(lo), "v"(hi)); return r; }

struct EpiBf16 {
    static constexpr bool PERM = true, AFTER_DRAIN = false;
    bf16_t* O; int ldc;
    __device__ __forceinline__ void operator()(const f32x4 (&acc)[2][2][4][2], const Unit& u, int wr, int wc, int fr, int fq) const {
        const int row0 = u.pm * BM + wr * 64 + fr; const int col0 = u.pn * BM + wc * 32 + 8 * fq;
#pragma unroll
        for (int ai = 0; ai < 2; ++ai)
#pragma unroll
            for (int m = 0; m < 4; ++m) { bf16_t* rowp = O + (size_t)(row0 + ai * HALF + m * 16) * ldc + col0;
#pragma unroll
                for (int bj = 0; bj < 2; ++bj) { const f32x4 v0 = acc[ai][bj][m][0], v1 = acc[ai][bj][m][1];
                    u32x4 w; w.x = cvt_pk_bf16(v0[0], v0[1]); w.y = cvt_pk_bf16(v0[2], v0[3]); w.z = cvt_pk_bf16(v1[0], v1[1]); w.w = cvt_pk_bf16(v1[2], v1[3]);
                    *(u32x4*)(rowp + bj * HALF) = w; } }
    }
};
struct EpiF32 {
    static constexpr bool PERM = false, AFTER_DRAIN = false;
    float* O; int ldc;
    __device__ __forceinline__ void operator()(const f32x4 (&acc)[2][2][4][2], const Unit& u, int wr, int wc, int fr, int fq) const {
        const int row0 = u.pm * BM + wr * 64 + fr; const int col0 = u.pn * BM + wc * 32 + 4 * fq;
#pragma unroll
        for (int ai = 0; ai < 2; ++ai)
#pragma unroll
            for (int m = 0; m < 4; ++m) { float* rowp = O + (size_t)(row0 + ai * HALF + m * 16) * ldc + col0;
#pragma unroll
                for (int bj = 0; bj < 2; ++bj)
#pragma unroll
                    for (int n = 0; n < 2; ++n) *(f32x4*)(rowp + bj * HALF + n * 16) = acc[ai][bj][m][n]; }
    }
};
struct EpiRes {
    static constexpr bool PERM = false, AFTER_DRAIN = false;
    const float* src_lat; const float* src_ctx; float* dst_lat; float* dst_ctx; const float* gate;
    __device__ __forceinline__ void operator()(const f32x4 (&acc)[2][2][4][2], const Unit& u, int wr, int wc, int fr, int fq) const {
        const bool isc = u.pm >= 64; const int smp = isc ? 2 : (u.pm >> 5);
        const int prow = (isc ? (u.pm - 64) * BM : u.pm * BM) + wr * 64 + fr;
        const float* src = isc ? src_ctx : src_lat; float* dst = isc ? dst_ctx : dst_lat;
        const float* gt = gate + smp * 6144 + 2048;
        const int col0 = u.pn * BM + wc * 32 + 4 * fq;
        f32x4 gv[2][2];
#pragma unroll
        for (int bj = 0; bj < 2; ++bj)
#pragma unroll
            for (int n = 0; n < 2; ++n) gv[bj][n] = *(const f32x4*)(gt + col0 + bj * HALF + n * 16);
#pragma unroll
        for (int ai = 0; ai < 2; ++ai)
#pragma unroll
            for (int m = 0; m < 4; ++m) { const size_t off = (size_t)(prow + ai * HALF + m * 16) * 1024 + col0;
#pragma unroll
                for (int bj = 0; bj < 2; ++bj)
#pragma unroll
                    for (int n = 0; n < 2; ++n) { const f32x4 s = *(const f32x4*)(src + off + bj * HALF + n * 16);
                        *(f32x4*)(dst + off + bj * HALF + n * 16) = s + gv[bj][n] * acc[ai][bj][m][n]; } }
    }
};

template <class Epi, class Sched, bool ALIGN_EPI = false, bool SP2 = false>
__device__ __forceinline__ void gemm_phase(PG8_LAS unsigned char* lds, const Gemm g, const Sched& S, const Epi& E, const int tid) {
    const int wid = __builtin_amdgcn_readfirstlane(tid >> 6), lane = tid & 63, wr = wid >> 2, wc = wid & 3, fr = lane & 15, fq = lane >> 4;
    const int K = g.K, nt = K / BK;
    unsigned voffA[2], voffB[2];
#pragma unroll
    for (int i = 0; i < 2; ++i) { int R, C; stage_rc(tid * 16 + i * 8192, R, C); const int Rb = Epi::PERM ? ((R & ~31) + perm32(R & 31)) : R;
        voffA[i] = (unsigned)(R * K + C) * 2u; voffB[i] = (unsigned)(Rb * K + C) * 2u; }
    const size_t kstep = (size_t)(BK * 2);
    const size_t hstep = (size_t)HALF * K * 2;
    const size_t tstep = 2 * hstep;
    const unsigned ldsw = (unsigned)wid * 1024u;
    const int aoff = lds_byte(wr * 64 + fr, fq * 8), boff = lds_byte(wc * 32 + fr, fq * 8);
#define PG8_SA(b, h) (((b) * 2 + (h)) * HTB)
#define PG8_SB(b, h) ((4 + (b) * 2 + (h)) * HTB)
#define PG8_STAGE(bufoff, gbase, voff) do { _Pragma("unroll") for (int _i = 0; _i < 2; ++_i) \
        __builtin_amdgcn_global_load_lds((const unsigned*)((const char*)(gbase) + (voff)[_i]), (PG8_LAS unsigned*)(lds + (bufoff) + ldsw + _i * 8192), 16, 0, 0); } while (0)
#define PG8_LDA(dst, b, h) do { _Pragma("unroll") for (int m = 0; m < 4; ++m) _Pragma("unroll") for (int k = 0; k < 2; ++k) dst[m][k] = *(const PG8_LAS bf16x8*)(lds + PG8_SA(b, h) + aoff + m * 2048 + k * 1024); } while (0)
#define PG8_LDB(dst, b, h) do { _Pragma("unroll") for (int n = 0; n < 2; ++n) _Pragma("unroll") for (int k = 0; k < 2; ++k) dst[n][k] = *(const PG8_LAS bf16x8*)(lds + PG8_SB(b, h) + boff + n * 2048 + k * 1024); } while (0)
#define PG8_MMA(ai, bj, At, Bt) do { __builtin_amdgcn_s_setprio(1); _Pragma("unroll") for (int m = 0; m < 4; ++m) _Pragma("unroll") for (int n = 0; n < 2; ++n) _Pragma("unroll") for (int k = 0; k < 2; ++k) \
        acc[ai][bj][m][n] = __builtin_amdgcn_mfma_f32_16x16x32_bf16(Bt[n][k], At[m][k], acc[ai][bj][m][n], 0, 0, 0); __builtin_amdgcn_s_setprio(0); } while (0)
#define PG8_WAIT_V(n) asm volatile("s_waitcnt vmcnt(" #n ")" ::: "memory")
#define PG8_WAIT_L(n) asm volatile("s_waitcnt lgkmcnt(" #n ")" ::: "memory")
#define PG8_BAR __builtin_amdgcn_s_barrier()
#define PG8_SCHED __builtin_amdgcn_sched_barrier(0)
    Unit cur, nxt; int ui = 0;
    if (!S.next(0, cur)) return;
    f32x4 acc[2][2][4][2];
#pragma unroll
    for (int a = 0; a < 2; ++a)
#pragma unroll
        for (int b = 0; b < 2; ++b)
#pragma unroll
            for (int m = 0; m < 4; ++m)
#pragma unroll
                for (int n = 0; n < 2; ++n) acc[a][b][m][n] = (f32x4){0.f, 0.f, 0.f, 0.f};
    bf16x8 At[4][2], B0[2][2], B1[2][2];
    const char* cA = (const char*)g.A + (size_t)cur.pm * tstep; const char* cB = (const char*)g.Bt + (size_t)cur.pn * tstep;
    S.a_ready(cur);
    if constexpr (SP2) {
        PG8_STAGE(PG8_SB(0, 0), cB, voffB); PG8_STAGE(PG8_SB(0, 1), cB + hstep, voffB); PG8_STAGE(PG8_SA(0, 0), cA, voffA); PG8_STAGE(PG8_SA(0, 1), cA + hstep, voffA);
        if (wr == 1) PG8_BAR;
        PG8_WAIT_V(2); PG8_BAR;
        PG8_STAGE(PG8_SB(1, 0), cB + kstep, voffB); PG8_STAGE(PG8_SA(1, 0), cA + kstep, voffA); PG8_STAGE(PG8_SB(1, 1), cB + hstep + kstep, voffB);
        PG8_WAIT_V(6); PG8_BAR;
    } else {
        PG8_STAGE(PG8_SB(0, 0), cB, voffB); PG8_STAGE(PG8_SA(0, 0), cA, voffA); PG8_STAGE(PG8_SB(0, 1), cB + hstep, voffB); PG8_STAGE(PG8_SA(0, 1), cA + hstep, voffA);
        if (wr == 1) PG8_BAR;
        PG8_WAIT_V(4); PG8_BAR;
        PG8_STAGE(PG8_SB(1, 0), cB + kstep, voffB); PG8_STAGE(PG8_SA(1, 0), cA + kstep, voffA); PG8_STAGE(PG8_SB(1, 1), cB + hstep + kstep, voffB);
        PG8_WAIT_V(6); PG8_BAR;
    }
    for (;;) {
        const bool has_next = S.next(ui + 1, nxt);
        const char* nA = has_next ? (const char*)g.A + (size_t)nxt.pm * tstep : cA; const char* nB = has_next ? (const char*)g.Bt + (size_t)nxt.pn * tstep : cB;
        for (int t = 0; t < nt; t += 2) {
            const bool last = (t == nt - 2);
            const char* a1 = cA + (size_t)(t + 1) * kstep;
            const char* a2 = last ? nA : cA + (size_t)(t + 2) * kstep; const char* b2 = last ? nB : cB + (size_t)(t + 2) * kstep;
            const char* a3 = a2 + kstep; const char* b3 = b2 + kstep;
            if (last && has_next) S.a_ready(nxt);
            if constexpr (SP2) {
            PG8_LDB(B0, 0, 0); PG8_LDB(B1, 0, 1); PG8_SCHED; PG8_LDA(At, 0, 0); PG8_STAGE(PG8_SA(1, 1), a1 + hstep, voffA);
            PG8_WAIT_V(8); PG8_WAIT_L(0); PG8_BAR; PG8_MMA(0, 0, At, B0); PG8_MMA(0, 1, At, B1); PG8_BAR; PG8_SCHED;
            PG8_LDA(At, 0, 1); PG8_STAGE(PG8_SB(0, 0), b2, voffB); PG8_STAGE(PG8_SB(0, 1), b2 + hstep, voffB); PG8_STAGE(PG8_SA(0, 0), a2, voffA);
            PG8_WAIT_V(8); PG8_WAIT_L(0); PG8_BAR; PG8_MMA(1, 0, At, B0); PG8_MMA(1, 1, At, B1); PG8_BAR; PG8_SCHED;
            PG8_LDB(B0, 1, 0); PG8_LDB(B1, 1, 1); PG8_SCHED; PG8_LDA(At, 1, 0); PG8_STAGE(PG8_SA(0, 1), a2 + hstep, voffA);
            PG8_WAIT_V(8); PG8_WAIT_L(0); PG8_BAR; PG8_MMA(0, 0, At, B0); PG8_MMA(0, 1, At, B1); PG8_BAR; PG8_SCHED;
            PG8_LDA(At, 1, 1); PG8_STAGE(PG8_SB(1, 0), b3, voffB); PG8_STAGE(PG8_SB(1, 1), b3 + hstep, voffB); PG8_STAGE(PG8_SA(1, 0), a3, voffA);
            PG8_WAIT_V(8); PG8_WAIT_L(0); PG8_BAR; PG8_MMA(1, 0, At, B0); PG8_MMA(1, 1, At, B1); PG8_BAR; PG8_SCHED;
            } else {
            PG8_LDB(B0, 0, 0); PG8_SCHED; PG8_LDA(At, 0, 0); PG8_STAGE(PG8_SA(1, 1), a1 + hstep, voffA);
            PG8_WAIT_L(8); PG8_BAR; PG8_WAIT_L(0); PG8_MMA(0, 0, At, B0); PG8_BAR; PG8_SCHED;
            PG8_LDB(B1, 0, 1); PG8_STAGE(PG8_SB(0, 0), b2, voffB);
            PG8_BAR; PG8_WAIT_L(0); PG8_MMA(0, 1, At, B1); PG8_BAR;
            PG8_LDA(At, 0, 1); PG8_STAGE(PG8_SA(0, 0), a2, voffA);
            PG8_BAR; PG8_WAIT_L(0); PG8_MMA(1, 0, At, B0); PG8_BAR; PG8_SCHED;
            PG8_STAGE(PG8_SB(0, 1), b2 + hstep, voffB);
            PG8_WAIT_V(6); PG8_BAR; PG8_MMA(1, 1, At, B1); PG8_BAR;
            PG8_LDB(B0, 1, 0); PG8_SCHED; PG8_LDA(At, 1, 0); PG8_STAGE(PG8_SA(0, 1), a2 + hstep, voffA);
            PG8_WAIT_L(8); PG8_BAR; PG8_WAIT_L(0); PG8_MMA(0, 0, At, B0); PG8_BAR; PG8_SCHED;
            PG8_LDB(B1, 1, 1); PG8_STAGE(PG8_SB(1, 0), b3, voffB);
            PG8_BAR; PG8_WAIT_L(0); PG8_MMA(0, 1, At, B1); PG8_BAR;
            PG8_LDA(At, 1, 1); PG8_STAGE(PG8_SA(1, 0), a3, voffA);
            PG8_BAR; PG8_WAIT_L(0); PG8_MMA(1, 0, At, B0); PG8_BAR; PG8_SCHED;
            PG8_STAGE(PG8_SB(1, 1), b3 + hstep, voffB);
            PG8_WAIT_V(6); PG8_BAR; PG8_MMA(1, 1, At, B1); PG8_BAR;
            }
        }
        if constexpr (ALIGN_EPI) { if (wr == 0) PG8_BAR; }
        if constexpr (!Epi::AFTER_DRAIN) { E(acc, cur, wr, wc, fr, fq); S.done(cur); }
        if (!has_next) break;
#pragma unroll
        for (int a = 0; a < 2; ++a)
#pragma unroll
            for (int b = 0; b < 2; ++b)
#pragma unroll
                for (int m = 0; m < 4; ++m)
#pragma unroll
                    for (int n = 0; n < 2; ++n) acc[a][b][m][n] = (f32x4){0.f, 0.f, 0.f, 0.f};
        cur = nxt; cA = nA; cB = nB; ++ui;
        if constexpr (ALIGN_EPI) { if (wr == 1) PG8_BAR; }
    }
    PG8_WAIT_V(0);
    if constexpr (!ALIGN_EPI) { if (wr == 0) PG8_BAR; }
    PG8_BAR;
    if constexpr (Epi::AFTER_DRAIN) { E.fused(acc, cur, wr, wc, fr, fq, lds, wid, lane); S.done(cur); }
#undef PG8_SA
#undef PG8_SB
#undef PG8_STAGE
#undef PG8_LDA
#undef PG8_LDB
#undef PG8_MMA
#undef PG8_WAIT_V
#undef PG8_WAIT_L
#undef PG8_BAR
#undef PG8_SCHED
}
}
#ifndef ZMASK
#define ZMASK 0
#endif
#define ZF(bit) ((ZMASK & (bit)) ? 0.f : 1.f)
using pg8::bf16_t; using pg8::bf16x8; using pg8::f32x4; using pg8::u32x4;
constexpr int NWAVES = 8, NTHR = 512;
constexpr int DM = 1024, TLAT = 8192, TCTX = 256, MLAT = 2 * TLAT, MCTX = 2 * TCTX, MALL = MLAT + MCTX;
constexpr int DIN = 3152, DINP = 3328;
constexpr int C_CH = 0, C_CB = 256, C_CC = 512, C_RR = 768, C_RK = 1024, C_RV = 1280, C_XW = 1536, C_XA = 1552, C_XG = 1568,
              C_AQ = 1600, C_AK = 1856, C_AV = 1984, C_MQ = 2112, C_MK = 2368, C_MV = 2624, C_MO = 2880, C_MG = 3136;
constexpr float EPSN = 1e-6f;
constexpr int NCHK = 66;
constexpr int CST = 4160;
constexpr int RWREC = 4608;
constexpr size_t MiB = 1u << 20;
constexpr size_t WS_CTL = 0, CTL_ZERO_BYTES = 1 * MiB, WS_MOD = 1 * MiB;
constexpr size_t WS_WIN = 2 * MiB, WIN_LSTRIDE = (size_t)DINP * DM * 2;
constexpr size_t WS_WOUT = 16 * MiB, WOUT_LSTRIDE = 2 * MiB;
constexpr size_t WS_WEFF = 20 * MiB, WEFF_LSTRIDE = 4 * MiB;
constexpr size_t WS_XC = 28 * MiB, WS_GA = 30 * MiB, WS_H = 32 * MiB, WS_YCAT = 65 * MiB, WS_U = 98 * MiB, WS_V = 130 * MiB;
constexpr size_t WS_P = 162 * MiB, WS_RW = 270 * MiB, WS_YR = 345 * MiB, WS_QA = 378 * MiB, WS_KA = 387 * MiB;
constexpr size_t WS_LC = 392 * MiB, WS_ST = 409 * MiB, WS_LB = 426 * MiB, WS_EG = 427 * MiB, WS_GB = 444 * MiB, WS_BS = 453 * MiB, WS_SC = 453 * MiB + 512 * 1024, WS_END = 454 * MiB;
constexpr size_t UV_LSTRIDE = 16 * MiB;
constexpr size_t WS_S = WS_P;
static_assert(WS_P + (size_t)MALL * DINP * 2 <= WS_RW && WS_RW + (size_t)MALL * RWREC <= WS_YR && WS_S + (size_t)MALL * 2048 * 4 <= WS_YR, "ws map");
static_assert(WS_LC + (size_t)16 * NCHK * CST * 4 <= WS_ST && WS_ST + (size_t)16 * NCHK * CST * 4 <= WS_LB && WS_EG + (size_t)MALL * 128 * 8 <= WS_GB, "ws map 2");
constexpr int CW_BAR = 4096;
constexpr int RING_BYTES = 131072, LDSCTL_OFF = RING_BYTES, MISC_OFF = LDSCTL_OFF + 320, LDS_BYTES = 147456;

#define GAS __attribute__((address_space(1)))
#define LAS __attribute__((address_space(3)))
typedef unsigned u32x2 __attribute__((ext_vector_type(2)));
typedef float f32x2 __attribute__((ext_vector_type(2)));
typedef __bf16 bf16x2_t __attribute__((ext_vector_type(2)));
typedef GAS unsigned gu32;
#define LDS_WAIT() asm volatile("s_waitcnt lgkmcnt(0)" ::: "memory")

__device__ __forceinline__ float lo2f(unsigned w) { return __uint_as_float(w << 16); }
__device__ __forceinline__ float hi2f(unsigned w) { return __uint_as_float(w & 0xffff0000u); }
__device__ __forceinline__ float bf2f(bf16_t b) { return __uint_as_float((unsigned)b << 16); }
__device__ __forceinline__ unsigned f2bf(float f) { unsigned u = __float_as_uint(f); return (u + 0x7fffu + ((u >> 16) & 1u)) >> 16; }
__device__ __forceinline__ unsigned pk2(float lo, float hi) { return f2bf(lo) | (f2bf(hi) << 16); }
__device__ __forceinline__ f32x4 ld4bf(const bf16_t* p) { const u32x2 w = *(const u32x2*)p; return (f32x4){lo2f(w.x), hi2f(w.x), lo2f(w.y), hi2f(w.y)}; }
__device__ __forceinline__ void st4bf(bf16_t* p, f32x4 v) { u32x2 w; w.x = pk2(v[0], v[1]); w.y = pk2(v[2], v[3]); *(u32x2*)p = w; }
__device__ __forceinline__ float sigmoidf_(float x) { return 1.f / (1.f + __expf(-x)); }
__device__ __forceinline__ float tanhf_(float x) { const float e = __expf(-2.f * fabsf(x)); const float t = (1.f - e) / (1.f + e); return x < 0.f ? -t : t; }
template <int CTRL> __device__ __forceinline__ float dppf(float x) { return __int_as_float(__builtin_amdgcn_update_dpp(0, __float_as_int(x), CTRL, 0xf, 0xf, true)); }
__device__ __forceinline__ float red16(float x) { x += dppf<0xB1>(x); x += dppf<0x4E>(x); x += dppf<0x141>(x); x += dppf<0x140>(x); return x; }
__device__ __forceinline__ float wave_sum(float v) {
#pragma unroll
    for (int o = 1; o < 64; o <<= 1) v += __shfl_xor(v, o);
    return v;
}
#define XB_TMO      128
#define XB_XCNT(j)  (256  + 64 * (j))
#define XB_XSUB(j)  (1280 + 64 * (j))
#define XB_XGEN(j)  (2304 + 64 * (j))
#define XB_TOP      3328
#define XB_TOPGEN   3392
#define XCD_BAR_WORDS 3456
#define XB_SPIN_CAP (1u << 18)

__device__ __forceinline__ unsigned xb_ld(unsigned* p)              { return __hip_atomic_load(p, __ATOMIC_RELAXED, __HIP_MEMORY_SCOPE_AGENT); }
__device__ __forceinline__ unsigned xb_add(unsigned* p, unsigned v) { return __hip_atomic_fetch_add(p, v, __ATOMIC_RELAXED, __HIP_MEMORY_SCOPE_AGENT); }
__device__ __forceinline__ unsigned xb_xcc_id() { return (unsigned)__builtin_amdgcn_s_getreg((3 << 11) | 20) & 0xFu; }
#define XB_SPIN(cond, bar) do { unsigned _sp = 0; while (cond) { __builtin_amdgcn_s_sleep(1); \
    if ((++_sp & 255u) == 0u) { if (xb_ld(&(bar)[XB_TMO])) break; if (_sp > XB_SPIN_CAP) { atomicAdd(&(bar)[XB_TMO], 1u); break; } } } } while (0)

struct XcdBarrier {
    unsigned* bar; unsigned x;
    volatile LAS unsigned* st;
};

__device__ __forceinline__ XcdBarrier xcd_barrier_post(unsigned* bar, volatile LAS unsigned* st) {
    XcdBarrier b; b.bar = bar; b.x = xb_xcc_id(); b.st = st;
    if (threadIdx.x == 0) (void)xb_add(&bar[XB_XCNT(b.x)], 1u);
    return b;
}
__device__ __forceinline__ void xcd_barrier_complete(unsigned* bar, unsigned x, unsigned& nloc, unsigned& nx) {
    const unsigned G = gridDim.x * gridDim.y * gridDim.z;
    unsigned sum, cnt, mine, sp = 0u;
    for (;;) {
        sum = 0u; cnt = 0u; mine = 0u;
#pragma unroll
        for (unsigned j = 0; j < 16; ++j) { const unsigned c = xb_ld(&bar[XB_XCNT(j)]); sum += c; cnt += (c > 0u) ? 1u : 0u; mine = (j == x) ? c : mine; }
        if (sum == G) break;
        __builtin_amdgcn_s_sleep(1);
        if ((++sp & 255u) == 0u) { if (xb_ld(&bar[XB_TMO])) break; if (sp > XB_SPIN_CAP) { atomicAdd(&bar[XB_TMO], 1u); break; } }
    }
    nloc = mine > 0u ? mine : 1u; nx = cnt > 0u ? cnt : 1u;
}

__device__ __forceinline__ void xcd_barrier(const XcdBarrier& b) {
    asm volatile("s_waitcnt vmcnt(0)" ::: "memory");
    __syncthreads();
    if (threadIdx.x == 0) {
        unsigned* bar = b.bar;
        __builtin_amdgcn_s_waitcnt(0);
        unsigned nloc = b.st[0], nx = b.st[1];
        if (nloc == 0u) { xcd_barrier_complete(bar, b.x, nloc, nx); b.st[0] = nloc; b.st[1] = nx; }
        const unsigned old = xb_add(&bar[XB_XSUB(b.x)], 1u);
        const unsigned gen = old / nloc;
        if (old + 1u == (gen + 1u) * nloc) {
            __builtin_amdgcn_fence(__ATOMIC_RELEASE, "agent");
            asm volatile("s_waitcnt vmcnt(0)" ::: "memory");
            const unsigned og = xb_add(&bar[XB_TOP], 1u);
            const unsigned tg = og / nx;
            if (og + 1u == (tg + 1u) * nx) xb_add(&bar[XB_TOPGEN], 1u);
            else XB_SPIN(xb_ld(&bar[XB_TOPGEN]) == tg, bar);
            __builtin_amdgcn_fence(__ATOMIC_ACQUIRE, "agent");
            xb_add(&bar[XB_XGEN(b.x)], 1u);
            asm volatile("s_waitcnt vmcnt(0)" ::: "memory");
        } else {
            XB_SPIN(xb_ld(&bar[XB_XGEN(b.x)]) == gen, bar);
            __builtin_amdgcn_fence(__ATOMIC_ACQUIRE, "agent");
            asm volatile("s_waitcnt vmcnt(0)" ::: "memory");
        }
    }
    __syncthreads();
}
struct Ctx {
    LAS unsigned char* lds; int tid, lane, wave, vcu, G;
    const float* in[32]; float* out; unsigned char* ws;
};
#define WSP(T, off) ((T*)(F.ws + (off)))

__device__ __forceinline__ void p0_transpose_item(const float* W, int K, int N, bf16_t* WT, LAS float* scr, int item, int lane) {
    const int nblk = (N + 31) / 32, kb = item / nblk, nb = item % nblk, k0 = 64 * kb, n0 = 32 * nb;
    const int nn = n0 + (lane & 31);
#pragma unroll 8
    for (int i = 0; i < 32; ++i) { const int kk = 2 * i + (lane >> 5); scr[kk * 33 + (lane & 31)] = nn < N ? W[(size_t)(k0 + kk) * N + nn] : 0.f; }
    LDS_WAIT(); asm volatile("" ::: "memory");
    const int c = lane & 7;
#pragma unroll
    for (int j = 0; j < 4; ++j) { const int n = (lane >> 3) + 8 * j; const LAS float* s = scr + (8 * c) * 33 + n;
        u32x4 o; o.x = pk2(s[0 * 33], s[1 * 33]); o.y = pk2(s[2 * 33], s[3 * 33]); o.z = pk2(s[4 * 33], s[5 * 33]); o.w = pk2(s[6 * 33], s[7 * 33]);
        *(u32x4*)(WT + (size_t)(n0 + n) * K + k0 + 8 * c) = o; }
    LDS_WAIT(); asm volatile("" ::: "memory");
}
__device__ __forceinline__ void convert_uv(const Ctx& F, int l) {
    const int gw = F.vcu * NWAVES + F.wave, NGW = F.G * NWAVES;
    float* SC = WSP(float, WS_SC) + (size_t)l * 2 * 16384;
    for (int r = gw; r < 2 * 16384; r += NGW) {
        const int tb = r >> 14, row = r & 16383;
        const float* src = (tb ? F.in[31] : F.in[30]) + ((size_t)l * 16384 + row) * 1024 + F.lane * 16;
        f32x4 v[4]; float am = 0.f;
#pragma unroll
        for (int j = 0; j < 4; ++j) { v[j] = *(const f32x4*)(src + 4 * j); am = fmaxf(am, fmaxf(fmaxf(fabsf(v[j][0]), fabsf(v[j][1])), fmaxf(fabsf(v[j][2]), fabsf(v[j][3])))); }
#pragma unroll
        for (int o = 1; o < 64; o <<= 1) am = fmaxf(am, __shfl_xor(am, o));
        const float sc = am > 0.f ? 448.f / am : 1.f;
        u32x4 o4; unsigned ow[4];
#pragma unroll
        for (int j = 0; j < 4; ++j) { int w = __builtin_amdgcn_cvt_pk_fp8_f32(v[j][0] * sc, v[j][1] * sc, 0, false); w = __builtin_amdgcn_cvt_pk_fp8_f32(v[j][2] * sc, v[j][3] * sc, w, true); ow[j] = (unsigned)w; }
        o4 = (u32x4){ow[0], ow[1], ow[2], ow[3]};
        *(u32x4*)(F.ws + (tb ? WS_V : WS_U) + (size_t)l * UV_LSTRIDE + (size_t)row * 1024 + F.lane * 16) = o4;
        if (F.lane == 0) SC[tb * 16384 + row] = am > 0.f ? am * (1.f / 448.f) : 1.f;
    }
}
__device__ __forceinline__ void phase_prologue(const Ctx& F) {
    float* MOD = WSP(float, WS_MOD);
    {
        LAS float* sl = (LAS float*)F.lds; LAS float* red = sl + 3072;
        for (int it = F.vcu; it < 192; it += F.G) {
            const int l = it / 96, n0 = (it % 96) * 64;
            for (int i = F.tid; i < 3072; i += NTHR) { const int s = i >> 10, k = i & 1023; const float c = s < 2 ? F.in[1][s * 1024 + k] : F.in[3][k]; sl[i] = c / (1.f + __expf(-c)); }
            __syncthreads();
            const int c = F.tid & 63, kg = F.tid >> 6;
            const float* W = F.in[4] + (size_t)l * 1024 * 6144 + n0 + c;
            float a0 = 0.f, a1 = 0.f, a2 = 0.f;
#pragma unroll 8
            for (int k = kg * 128; k < kg * 128 + 128; ++k) { const float w = W[(size_t)k * 6144]; a0 += sl[k] * w; a1 += sl[1024 + k] * w; a2 += sl[2048 + k] * w; }
            red[(kg * 3 + 0) * 64 + c] = a0; red[(kg * 3 + 1) * 64 + c] = a1; red[(kg * 3 + 2) * 64 + c] = a2;
            __syncthreads();
            if (F.tid < 192) { const int s = F.tid >> 6, cc = F.tid & 63; float t = F.in[5][l * 6144 + n0 + cc];
#pragma unroll
                for (int g = 0; g < 8; ++g) t += red[(g * 3 + s) * 64 + cc];
                MOD[(l * 3 + s) * 6144 + n0 + cc] = t; }
            __syncthreads();
        }
    }
    {
        LAS float* scr = (LAS float*)(F.lds + F.wave * 16384);
        const int gw = F.vcu * NWAVES + F.wave, NGW = F.G * NWAVES;
        constexpr int I_IN = 16 * 99, I_OUT = 16 * 32, I_L = I_IN + I_OUT;
        for (int it = gw; it < 2 * I_L; it += NGW) {
            const int l = it / I_L; int r = it % I_L;
            if (r < I_IN) p0_transpose_item(F.in[8] + (size_t)l * DM * DIN, DM, DIN, WSP(bf16_t, WS_WIN + l * WIN_LSTRIDE), scr, r, F.lane);
            else p0_transpose_item(F.in[9] + (size_t)l * DM * DM, DM, DM, WSP(bf16_t, WS_WOUT + l * WOUT_LSTRIDE), scr, r - I_IN, F.lane);
        }
        for (int i = F.vcu * NTHR + F.tid; i < 2 * 160 * 128; i += F.G * NTHR) { const int l = i / (160 * 128), r = i % (160 * 128);
            *(u32x4*)(WSP(bf16_t, WS_WIN + l * WIN_LSTRIDE) + (size_t)3168 * DM + (size_t)r * 8) = (u32x4){0u, 0u, 0u, 0u}; }
    }
    __syncthreads();
    {
        LAS float* KEYS = (LAS float*)F.lds; LAS float* WQl = KEYS + 128 * 129;
        for (int it = F.vcu; it < 512; it += F.G) {
            const int l = it >> 8, hh = (it >> 4) & 15, kb = it & 15;
            const float* ksrc = F.in[29] + ((size_t)l * 16 + hh) * 128 * 128;
            for (int i = F.tid; i < 16384; i += NTHR) KEYS[(i >> 7) * 129 + (i & 127)] = ksrc[i];
            const float* wsrc = F.in[28] + (size_t)l * DM * 2048 + (size_t)(kb * 64) * 2048 + hh * 128;
            for (int i = F.tid; i < 64 * 128; i += NTHR) { const int kk = i >> 7, d = i & 127; WQl[d * 68 + kk] = wsrc[(size_t)kk * 2048 + d]; }
            __syncthreads();
            const int key = F.tid & 127, kq = F.tid >> 7;
            float acc[16];
#pragma unroll
            for (int j = 0; j < 16; ++j) acc[j] = 0.f;
#pragma unroll 4
            for (int d = 0; d < 128; ++d) { const float a = KEYS[key * 129 + d]; const LAS f32x4* wq = (const LAS f32x4*)(WQl + d * 68 + kq * 16);
#pragma unroll
                for (int q = 0; q < 4; ++q) { const f32x4 w = wq[q]; acc[4 * q] += a * w[0]; acc[4 * q + 1] += a * w[1]; acc[4 * q + 2] += a * w[2]; acc[4 * q + 3] += a * w[3]; } }
            bf16_t* dst = WSP(bf16_t, WS_WEFF + l * WEFF_LSTRIDE) + (size_t)(hh * 128 + key) * DM + kb * 64 + kq * 16;
            u32x4 o0, o1; o0.x = pk2(acc[0], acc[1]); o0.y = pk2(acc[2], acc[3]); o0.z = pk2(acc[4], acc[5]); o0.w = pk2(acc[6], acc[7]);
            o1.x = pk2(acc[8], acc[9]); o1.y = pk2(acc[10], acc[11]); o1.z = pk2(acc[12], acc[13]); o1.w = pk2(acc[14], acc[15]);
            *(u32x4*)dst = o0; *(u32x4*)(dst + 8) = o1;
            __syncthreads();
        }
    }
    convert_uv(F, 0); convert_uv(F, 1);
}

__device__ __forceinline__ void phase_norm(const Ctx& F, int l, int which, int nrows, const float* xlat, const float* xctx) {
    const float* gain = F.in[6 + which] + l * DM; const float* mod = WSP(float, WS_MOD) + (size_t)l * 3 * 6144;
    const int shoff = which ? 3072 : 0, scoff = which ? 4096 : 1024;
    bf16_t* H = WSP(bf16_t, WS_H);
    const int gw = F.vcu * NWAVES + F.wave, NGW = F.G * NWAVES;
    for (int row = gw; row < nrows; row += NGW) {
        const bool isc = row >= MLAT; const float* src = isc ? xctx + (size_t)(row - MLAT) * DM : xlat + (size_t)row * DM; const int smp = isc ? 2 : (row >> 13);
        const float* mb = mod + smp * 6144;
        f32x4 v[4]; float ss = 0.f;
#pragma unroll
        for (int j = 0; j < 4; ++j) { v[j] = *(const f32x4*)(src + F.lane * 4 + 256 * j); ss += (v[j][0] * v[j][0] + v[j][1] * v[j][1]) + (v[j][2] * v[j][2] + v[j][3] * v[j][3]); }
        const float rs = rsqrtf(wave_sum(ss) * (1.f / DM) + EPSN);
#pragma unroll
        for (int j = 0; j < 4; ++j) { const int c = F.lane * 4 + 256 * j; const f32x4 g = *(const f32x4*)(gain + c), sc = *(const f32x4*)(mb + scoff + c), sh = *(const f32x4*)(mb + shoff + c);
            const f32x4 o = (v[j] * rs * g) * (1.f + sc) + sh; st4bf(H + (size_t)row * DM + c, o); }
    }
}

__device__ __forceinline__ float log_sigmoid_(float x) { return fminf(x, 0.f) - __logf(1.f + __expf(-fabsf(x))); }
__device__ __forceinline__ void phase_prep(const Ctx& F, int l) {
    LAS float* W2s = (LAS float*)F.lds; LAS float* A2s = W2s + 8192; LAS float* G2s = A2s + 8192; LAS float* tsc = G2s + 8192 + F.wave * 64;
    { const float* w2 = F.in[13] + l * 8192; const float* a2 = F.in[15] + l * 8192; const float* g2 = F.in[16] + l * 8192;
      for (int i = F.tid; i < 8192; i += NTHR) { W2s[i] = w2[i]; A2s[i] = a2[i]; G2s[i] = g2[i]; } }
    __syncthreads();
    const bf16_t* P = WSP(bf16_t, WS_P); bf16_t* YC = WSP(bf16_t, WS_YCAT); bf16_t* QA = WSP(bf16_t, WS_QA); bf16_t* KA = WSP(bf16_t, WS_KA);
    unsigned char* RW = WSP(unsigned char, WS_RW); bf16_t* GB = WSP(bf16_t, WS_GB); float* BS = WSP(float, WS_BS); float* GA = WSP(float, WS_GA);
    const int lane = F.lane, c4 = lane * 4, i16 = lane & 15;
    const f32x4 cw0 = *(const f32x4*)(F.in[10] + l * 768 + c4), cw1 = *(const f32x4*)(F.in[10] + l * 768 + 256 + c4), cw2 = *(const f32x4*)(F.in[10] + l * 768 + 512 + c4);
    const f32x4 cg = *(const f32x4*)(F.in[11] + l * 256 + c4);
    const f32x4 qg = *(const f32x4*)(F.in[21] + l * 64 + (c4 & 63)), kg = *(const f32x4*)(F.in[22] + l * 64 + (c4 & 63));
    const f32x4 k_k = *(const f32x4*)(F.in[17] + l * 256 + c4), k_a = *(const f32x4*)(F.in[18] + l * 256 + c4), r_k = *(const f32x4*)(F.in[19] + l * 256 + c4);
    f32x4 w0[2], a0[2];
#pragma unroll
    for (int d = 0; d < 2; ++d) { w0[d] = *(const f32x4*)(F.in[12] + (l * 2 + d) * 256 + c4); a0[d] = *(const f32x4*)(F.in[14] + (l * 2 + d) * 256 + c4); }
    float invf[4];
#pragma unroll
    for (int j = 0; j < 4; ++j) invf[j] = exp2f(-(float)((c4 + j) & 15) * (13.287712379549449f / 16.f));
    const int gw = F.vcu * NWAVES + F.wave, NGW = F.G * NWAVES;
    for (int row = gw; row < MALL; row += NGW) {
        const bool isc = row >= MLAT; const int t = isc ? ((row - MLAT) & 255) : (row & 8191); const int T = isc ? TCTX : TLAT;
        const bf16_t* pr = P + (size_t)row * DINP;
        {
            const f32x4 h1 = ld4bf(pr + C_CH + c4), bg = ld4bf(pr + C_CB + c4), c1 = ld4bf(pr + C_CC + c4);
            f32x4 up = {0.f, 0.f, 0.f, 0.f}, un = {0.f, 0.f, 0.f, 0.f};
            if (t > 0) up = ld4bf(pr - DINP + C_CH + c4) * ld4bf(pr - DINP + C_CC + c4);
            if (t < T - 1) un = ld4bf(pr + DINP + C_CH + c4) * ld4bf(pr + DINP + C_CC + c4);
            const f32x4 y = bg * (cw0 * up + cw1 * (c1 * h1) + cw2 * un);
            const float ss = red16((y[0] * y[0] + y[1] * y[1]) + (y[2] * y[2] + y[3] * y[3]));
            const float rs = rsqrtf(ss * (1.f / 64.f) + EPSN);
            st4bf(YC + (size_t)row * DM + c4, y * rs * cg * ZF(2));
        }
        asm volatile("" ::: "memory");
        {
            const f32x4 q = ld4bf(pr + C_AQ + c4); const f32x4 k = ld4bf(pr + C_AK + (c4 & 127));
            const float qs = red16((q[0] * q[0] + q[1] * q[1]) + (q[2] * q[2] + q[3] * q[3]));
            const float ks = red16((k[0] * k[0] + k[1] * k[1]) + (k[2] * k[2] + k[3] * k[3]));
            f32x4 qn = q * rsqrtf(qs * (1.f / 64.f) + EPSN) * qg, kn = k * rsqrtf(ks * (1.f / 64.f) + EPSN) * kg;
            if (!isc) {
                f32x4 qp, kp;
#pragma unroll
                for (int j = 0; j < 4; ++j) { qp[j] = __shfl_xor(qn[j], 4); kp[j] = __shfl_xor(kn[j], 4); }
                const int d0 = c4 & 63; const float pos = (d0 < 32) ? (float)(t >> 6) : (float)(t & 63); const bool lowh = (d0 & 16) == 0;
#pragma unroll
                for (int j = 0; j < 4; ++j) { const float th = pos * invf[j]; const float cs = __cosf(th), sn = __sinf(th);
                    qn[j] = lowh ? qn[j] * cs - qp[j] * sn : qn[j] * cs + qp[j] * sn; kn[j] = lowh ? kn[j] * cs - kp[j] * sn : kn[j] * cs + kp[j] * sn; }
            }
            st4bf(QA + (size_t)row * 256 + c4, qn * (0.125f * 1.4426950408889634f));
            if (lane < 32) st4bf(KA + (size_t)row * 128 + c4, kn);
        }
        asm volatile("" ::: "memory");
        {
            const f32x4 r = ld4bf(pr + C_RR + c4), k = ld4bf(pr + C_RK + c4);
            { const float xv = bf2f(pr[C_XW + lane]);
              tsc[lane] = lane < 16 ? tanhf_(xv) : (lane < 32 ? xv : sigmoidf_(xv)); }
            const f32x4 kx = k * k_k;
            const float kss = red16((kx[0] * kx[0] + kx[1] * kx[1]) + (kx[2] * kx[2] + kx[3] * kx[3]));
            const f32x4 kk = kx * rsqrtf(kss + EPSN);
            bf16_t* recb = (bf16_t*)(RW + (size_t)row * RWREC); float* recf = (float*)(RW + (size_t)row * RWREC + 2560);
            st4bf(recb + c4, kk);
            f32x4 kdsum = {0.f, 0.f, 0.f, 0.f};
#pragma unroll
            for (int d = 0; d < 2; ++d) {
                f32x4 dw = w0[d], da = a0[d];
#pragma unroll 4
                for (int ii = 0; ii < 16; ++ii) { dw += tsc[ii] * *(const LAS f32x4*)(W2s + (d * 16 + ii) * 256 + c4); da += tsc[16 + ii] * *(const LAS f32x4*)(A2s + (d * 16 + ii) * 256 + c4); }
                f32x4 dec, av;
#pragma unroll
                for (int j = 0; j < 4; ++j) { dec[j] = -0.6065306597126334f * sigmoidf_(dw[j]); av[j] = sigmoidf_(da[j]); }
                const f32x4 kd = k * (1.f + (av - 1.f) * k_a);
                kdsum += kd;
                st4bf(recb + 256 + d * 256 + c4, kk * av);
                st4bf(recb + 768 + d * 256 + c4, kd);
                *(f32x4*)(recf + d * 256 + c4) = dec;
            }
            f32x4 gv = {0.f, 0.f, 0.f, 0.f};
#pragma unroll 4
            for (int ii = 0; ii < 32; ++ii) gv += tsc[32 + ii] * *(const LAS f32x4*)(G2s + ii * 256 + c4);
            st4bf(GB + (size_t)row * 256 + c4, gv);
            const f32x4 bt = r * kdsum * r_k;
            const float bsum = red16((bt[0] + bt[1]) + (bt[2] + bt[3]));
            if (i16 == 0) BS[(size_t)row * 4 + (lane >> 4)] = bsum;
        }
        asm volatile("" ::: "memory");
        if (lane < 16) { const int dir = lane >> 3, gate = (lane >> 2) & 1, hd = lane & 3; const float x = bf2f(pr[C_MG + lane]);
            const float bias = gate ? F.in[26][(l * 2 + dir) * 4 + hd] : F.in[25][(l * 2 + dir) * 4 + hd];
            GA[(size_t)row * 16 + lane] = gate ? log_sigmoid_(x + bias) : (x + bias); }
    }
}
__device__ __forceinline__ int scan_row(int b, int dir, int i) {
    if (i < TCTX) return MLAT + b * TCTX + (dir ? (TCTX - 1 - i) : i);
    const int p = i - TCTX; return b * TLAT + (dir ? (TLAT - 1 - p) : p);
}
__device__ __forceinline__ void rwkv_scan(const Ctx& F, int blk) {
    const int chain = blk >> 2, quarter = blk & 3, b = chain >> 3, head = (chain >> 1) & 3, dir = chain & 1;
    const bool scanner = F.wave < 4;
    const int rowv = (quarter * 4 + (F.wave & 3)) * 4 + (F.lane >> 4), s = F.lane & 15;
    LAS float* buf = (LAS float*)F.lds;
    const bf16_t* P = WSP(bf16_t, WS_P); const unsigned char* RW = WSP(unsigned char, WS_RW); float* YR = WSP(float, WS_YR) + (size_t)dir * MALL * 256;
    const int st = F.tid >> 4, sub = F.tid & 15;
    constexpr int NSTEP = TCTX + TLAT, NCH = NSTEP / 32;
    u32x2 g_kk, g_al, g_kd, g_r, g_v; f32x4 g_w;
#define RW_LOAD(c) do { const int row_ = scan_row(b, dir, (c) * 32 + st); const bf16_t* rb_ = (const bf16_t*)(RW + (size_t)row_ * RWREC) + head * 64 + sub * 4; \
        g_kk = *(const u32x2*)rb_; g_al = *(const u32x2*)(rb_ + 256 + dir * 256); g_kd = *(const u32x2*)(rb_ + 768 + dir * 256); \
        g_w = *(const f32x4*)((const float*)(RW + (size_t)row_ * RWREC + 2560) + dir * 256 + head * 64 + sub * 4); \
        const bf16_t* pp_ = P + (size_t)row_ * DINP + head * 64 + sub * 4; g_r = *(const u32x2*)(pp_ + C_RR); g_v = *(const u32x2*)(pp_ + C_RV); } while (0)
#define RW_STORE(par) do { LAS float* d_ = buf + ((par) * 32 + st) * 384 + sub * 4; \
        *(LAS f32x4*)(d_) = (f32x4){lo2f(g_kk.x), hi2f(g_kk.x), lo2f(g_kk.y), hi2f(g_kk.y)}; *(LAS f32x4*)(d_ + 64) = (f32x4){lo2f(g_al.x), hi2f(g_al.x), lo2f(g_al.y), hi2f(g_al.y)}; \
        *(LAS f32x4*)(d_ + 128) = (f32x4){lo2f(g_kd.x), hi2f(g_kd.x), lo2f(g_kd.y), hi2f(g_kd.y)}; *(LAS f32x4*)(d_ + 192) = g_w; \
        *(LAS f32x4*)(d_ + 256) = (f32x4){lo2f(g_r.x), hi2f(g_r.x), lo2f(g_r.y), hi2f(g_r.y)}; *(LAS f32x4*)(d_ + 320) = (f32x4){lo2f(g_v.x), hi2f(g_v.x), lo2f(g_v.y), hi2f(g_v.y)}; } while (0)
    f32x4 S = {0.f, 0.f, 0.f, 0.f};
    RW_LOAD(0); RW_STORE(0); __syncthreads();
    for (int c = 0; c < NCH; ++c) {
        const int par = c & 1;
        if (c + 1 < NCH) RW_LOAD(c + 1);
        if (scanner) {
        float ykeep = 0.f;
        f32x4 Lkk[3], Lal[3], Lkd[3], Lw[3], Lr[3]; float Lv[3];
#define SC_LD(set, i_) do { const LAS float* d_ = buf + (par * 32 + (i_)) * 384; Lkk[set] = *(const LAS f32x4*)(d_ + s * 4); Lal[set] = *(const LAS f32x4*)(d_ + 64 + s * 4); \
            Lkd[set] = *(const LAS f32x4*)(d_ + 128 + s * 4); Lw[set] = *(const LAS f32x4*)(d_ + 192 + s * 4); Lr[set] = *(const LAS f32x4*)(d_ + 256 + s * 4); Lv[set] = d_[320 + rowv]; } while (0)
        SC_LD(0, 0); SC_LD(1, 1);
#pragma unroll
        for (int i = 0; i < 32; ++i) {
            if (i + 2 < 32) SC_LD((i + 2) % 3, i + 2);
            const f32x4 kk = Lkk[i % 3], al = Lal[i % 3], kd = Lkd[i % 3], w = Lw[i % 3], r = Lr[i % 3]; const float vr = Lv[i % 3];
            const float sa = red16((S[0] * kk[0] + S[1] * kk[1]) + (S[2] * kk[2] + S[3] * kk[3]));
            S = S * w + (vr * kd - sa * al);
            const float y = red16((S[0] * r[0] + S[1] * r[1]) + (S[2] * r[2] + S[3] * r[3]));
            ykeep = (s == (i & 15)) ? y : ykeep;
            if ((i & 15) == 15) {
                const int stp = c * 32 + (i - 15) + s; const int pc = dir ? (TCTX - 1 - stp) : stp, pl = dir ? (TLAT - 1 - (stp - TCTX)) : (stp - TCTX);
                const int row = stp < TCTX ? (MLAT + b * TCTX + pc) : (b * TLAT + pl);
                YR[(size_t)row * 256 + head * 64 + rowv] = ykeep; }
        }
#undef SC_LD
        }
        if (c + 1 < NCH) RW_STORE(par ^ 1);
        __syncthreads();
    }
#undef RW_LOAD
#undef RW_STORE
}

typedef union { u32x4 u; bf16x8 b; } frag_u;
__device__ __forceinline__ void attn_unit(const Ctx& F, int l, int unit) {
    LAS bf16_t* Kl = (LAS bf16_t*)F.lds; LAS bf16_t* Vt = Kl + 64 * 72;
    const bf16_t* P = WSP(bf16_t, WS_P); const bf16_t* QA = WSP(bf16_t, WS_QA); const bf16_t* KA = WSP(bf16_t, WS_KA); bf16_t* YC = WSP(bf16_t, WS_YCAT);
    const bool isc = unit >= 256; int b, kvh, n;
    if (!isc) { b = unit >> 7; kvh = (unit >> 6) & 1; n = unit & 63; } else { const int u = unit - 256; b = u >> 2; kvh = (u >> 1) & 1; n = u & 1; }
    const int g = F.wave >> 2, ps = F.wave & 3, head = kvh * 2 + g, i = F.lane & 15, gq = F.lane >> 4;
    const int qpos0 = n * 128 + ps * 32, qrow0 = (isc ? MLAT + b * TCTX : b * TLAT) + qpos0;
    bf16x8 Qf[2][2];
#pragma unroll
    for (int qb = 0; qb < 2; ++qb)
#pragma unroll
        for (int ks = 0; ks < 2; ++ks) Qf[qb][ks] = *(const bf16x8*)(QA + (size_t)(qrow0 + qb * 16 + i) * 256 + head * 64 + ks * 32 + gq * 8);
    const float sinkl = F.in[23][l * 4 + head] * 1.4426950408889634f;
    float mrun[2] = {sinkl, sinkl}, lsum[2]; lsum[0] = lsum[1] = (gq == 0) ? 1.f : 0.f;
    f32x4 ao[4][2];
#pragma unroll
    for (int db = 0; db < 4; ++db) { ao[db][0] = (f32x4){0.f, 0.f, 0.f, 0.f}; ao[db][1] = (f32x4){0.f, 0.f, 0.f, 0.f}; }
    const int ntl = isc ? 4 : 10;
    const int skey = F.tid >> 3, sch = F.tid & 7;
    for (int tt = 0; tt < ntl; ++tt) {
        int krow0, kpos0 = 0; bool band = false;
        if (!isc && tt < 6) { const int kt = 2 * (n - 1) + tt; if (kt < 0 || kt >= 128) continue; krow0 = b * TLAT + kt * 64; kpos0 = kt * 64; band = true; }
        else { const int c = isc ? tt : tt - 6; krow0 = MLAT + b * TCTX + c * 64; }
        __syncthreads();
        { const u32x4 kv = *(const u32x4*)(KA + (size_t)(krow0 + skey) * 128 + kvh * 64 + sch * 8);
          const u32x4 vv = *(const u32x4*)(P + (size_t)(krow0 + skey) * DINP + C_AV + kvh * 64 + sch * 8);
          *(LAS u32x4*)(Kl + skey * 72 + sch * 8) = kv;
          const unsigned ww[4] = {vv.x, vv.y, vv.z, vv.w};
#pragma unroll
          for (int j = 0; j < 4; ++j) { Vt[(sch * 8 + 2 * j) * 72 + skey] = (bf16_t)(ww[j] & 0xffffu); Vt[(sch * 8 + 2 * j + 1) * 72 + skey] = (bf16_t)(ww[j] >> 16); } }
        __syncthreads();
        f32x4 sc[4][2];
#pragma unroll
        for (int kb = 0; kb < 4; ++kb) {
            sc[kb][0] = (f32x4){0.f, 0.f, 0.f, 0.f}; sc[kb][1] = (f32x4){0.f, 0.f, 0.f, 0.f};
#pragma unroll
            for (int ks = 0; ks < 2; ++ks) { const bf16x8 kf = *(const LAS bf16x8*)(Kl + (kb * 16 + i) * 72 + ks * 32 + gq * 8);
                sc[kb][0] = __builtin_amdgcn_mfma_f32_16x16x32_bf16(kf, Qf[0][ks], sc[kb][0], 0, 0, 0);
                sc[kb][1] = __builtin_amdgcn_mfma_f32_16x16x32_bf16(kf, Qf[1][ks], sc[kb][1], 0, 0, 0); }
        }
#pragma unroll
        for (int qb = 0; qb < 2; ++qb) {
            const int qp = qpos0 + qb * 16 + i;
            float mx = -1e30f;
#pragma unroll
            for (int kb = 0; kb < 4; ++kb)
#pragma unroll
                for (int r = 0; r < 4; ++r) { if (band) { const int dd = (kpos0 + kb * 16 + 4 * gq + r) - qp; if (dd > 128 || dd < -128) sc[kb][qb][r] = -1e30f; } mx = fmaxf(mx, sc[kb][qb][r]); }
            mx = fmaxf(mx, __shfl_xor(mx, 16)); mx = fmaxf(mx, __shfl_xor(mx, 32));
            const float mnew = fmaxf(mrun[qb], mx), alpha = exp2f(mrun[qb] - mnew); mrun[qb] = mnew;
            float ps_ = 0.f;
#pragma unroll
            for (int kb = 0; kb < 4; ++kb)
#pragma unroll
                for (int r = 0; r < 4; ++r) { const float p = exp2f(sc[kb][qb][r] - mnew); sc[kb][qb][r] = p; ps_ += p; }
            lsum[qb] = lsum[qb] * alpha + ps_;
#pragma unroll
            for (int db = 0; db < 4; ++db) ao[db][qb] *= alpha;
        }
#pragma unroll
        for (int ks2 = 0; ks2 < 2; ++ks2) {
            frag_u pf[2];
#pragma unroll
            for (int qb = 0; qb < 2; ++qb) { pf[qb].u.x = pg8::cvt_pk_bf16(sc[2 * ks2][qb][0], sc[2 * ks2][qb][1]); pf[qb].u.y = pg8::cvt_pk_bf16(sc[2 * ks2][qb][2], sc[2 * ks2][qb][3]);
                pf[qb].u.z = pg8::cvt_pk_bf16(sc[2 * ks2 + 1][qb][0], sc[2 * ks2 + 1][qb][1]); pf[qb].u.w = pg8::cvt_pk_bf16(sc[2 * ks2 + 1][qb][2], sc[2 * ks2 + 1][qb][3]); }
#pragma unroll
            for (int db = 0; db < 4; ++db) { frag_u vf; const LAS bf16_t* vp = Vt + (db * 16 + i) * 72 + (2 * ks2) * 16 + 4 * gq;
                const u32x2 v0 = *(const LAS u32x2*)vp, v1 = *(const LAS u32x2*)(vp + 16); vf.u = (u32x4){v0.x, v0.y, v1.x, v1.y};
                ao[db][0] = __builtin_amdgcn_mfma_f32_16x16x32_bf16(vf.b, pf[0].b, ao[db][0], 0, 0, 0);
                ao[db][1] = __builtin_amdgcn_mfma_f32_16x16x32_bf16(vf.b, pf[1].b, ao[db][1], 0, 0, 0); }
        }
    }
    const float* og = F.in[24] + l * 256 + head * 64;
#pragma unroll
    for (int qb = 0; qb < 2; ++qb) {
        float lt = lsum[qb]; lt += __shfl_xor(lt, 16); lt += __shfl_xor(lt, 32);
        const float il = 1.f / lt; float ss = 0.f;
#pragma unroll
        for (int db = 0; db < 4; ++db) { ao[db][qb] *= il; ss += (ao[db][qb][0] * ao[db][qb][0] + ao[db][qb][1] * ao[db][qb][1]) + (ao[db][qb][2] * ao[db][qb][2] + ao[db][qb][3] * ao[db][qb][3]); }
        ss += __shfl_xor(ss, 16); ss += __shfl_xor(ss, 32);
        const float rs = rsqrtf(ss * (1.f / 64.f) + EPSN);
        bf16_t* yo = YC + (size_t)(qrow0 + qb * 16 + i) * DM + 512 + head * 64;
#pragma unroll
        for (int db = 0; db < 4; ++db) { const f32x4 gg = *(const f32x4*)(og + db * 16 + 4 * gq); st4bf(yo + db * 16 + 4 * gq, ao[db][qb] * rs * gg * ZF(8)); }
    }
    __syncthreads();
}

__device__ __forceinline__ int ml_row(int b, int dir, int j, int tp) {
    if (j < 2) { const int p = j * 128 + tp; return MLAT + b * TCTX + (dir ? (TCTX - 1 - p) : p); }
    const int p = (j - 2) * 128 + tp; return b * TLAT + (dir ? (TLAT - 1 - p) : p);
}
__device__ __forceinline__ void scan128_add(float& x0, float& x1, int lane) {
    x1 += x0; float t = x1;
#pragma unroll
    for (int o = 1; o < 64; o <<= 1) { const float u = __shfl_up(t, o); if (lane >= o) t += u; }
    const float ex = t - x1; x0 += ex; x1 = t;
}
__device__ __forceinline__ void scan128_max(float& x0, float& x1, int lane) {
    x1 = fmaxf(x1, x0); float t = x1;
#pragma unroll
    for (int o = 1; o < 64; o <<= 1) { const float u = __shfl_up(t, o); if (lane >= o) t = fmaxf(t, u); }
    const float pv = __shfl_up(t, 1); if (lane > 0) x0 = fmaxf(x0, pv); x1 = t;
}
__device__ __forceinline__ void ml_stage_T(const Ctx& F, const bf16_t* P, int b, int dir, int j, int col0, LAS bf16_t* dst, const LAS float* sw, float cscale) {
#pragma unroll
    for (int it = 0; it < 2; ++it) { const int id = F.tid + it * NTHR, tp = id >> 3, ch = id & 7;
        const u32x4 v = *(const u32x4*)(P + (size_t)ml_row(b, dir, j, tp) * DINP + col0 + ch * 8); const float s = (sw ? sw[tp] : 1.f) * cscale;
        const unsigned ww[4] = {v.x, v.y, v.z, v.w};
#pragma unroll
        for (int q = 0; q < 4; ++q) { dst[(ch * 8 + 2 * q) * 136 + tp] = (bf16_t)f2bf(lo2f(ww[q]) * s); dst[(ch * 8 + 2 * q + 1) * 136 + tp] = (bf16_t)f2bf(hi2f(ww[q]) * s); } }
}
__device__ __forceinline__ void ml_stage_R(const Ctx& F, const bf16_t* P, int b, int dir, int j, int col0, LAS bf16_t* dst, float cscale) {
#pragma unroll
    for (int it = 0; it < 2; ++it) { const int id = F.tid + it * NTHR, tp = id >> 3, ch = id & 7;
        u32x4 v = *(const u32x4*)(P + (size_t)ml_row(b, dir, j, tp) * DINP + col0 + ch * 8);
        if (cscale != 1.f) { v.x = pk2(lo2f(v.x) * cscale, hi2f(v.x) * cscale); v.y = pk2(lo2f(v.y) * cscale, hi2f(v.y) * cscale); v.z = pk2(lo2f(v.z) * cscale, hi2f(v.z) * cscale); v.w = pk2(lo2f(v.w) * cscale, hi2f(v.w) * cscale); }
        *(LAS u32x4*)(dst + tp * 72 + ch * 8) = v; }
}
__device__ __forceinline__ void mlstm_local(const Ctx& F, int task) {
    const int chain = task / NCHK, j = task % NCHK, b = chain >> 3, head = (chain >> 1) & 3, dir = chain & 1;
    const bf16_t* P = WSP(bf16_t, WS_P); const float* GA = WSP(float, WS_GA);
    LAS bf16_t* Vt = (LAS bf16_t*)F.lds; LAS bf16_t* Kt = Vt + 64 * 136; LAS float* wS = (LAS float*)(Kt + 64 * 136); LAS float* sc2 = wS + 128;
    __syncthreads();
    if (F.wave == 0) {
        const int r0 = ml_row(b, dir, j, 2 * F.lane), r1 = ml_row(b, dir, j, 2 * F.lane + 1);
        const float li0 = GA[(size_t)r0 * 16 + dir * 8 + head], li1 = GA[(size_t)r1 * 16 + dir * 8 + head];
        float b0 = GA[(size_t)r0 * 16 + dir * 8 + 4 + head], b1 = GA[(size_t)r1 * 16 + dir * 8 + 4 + head];
        scan128_add(b0, b1, F.lane);
        const float bend = __shfl(b1, 63);
        const float d0 = bend - b0 + li0, d1 = bend - b1 + li1;
        float mx = fmaxf(d0, d1);
#pragma unroll
        for (int o = 1; o < 64; o <<= 1) mx = fmaxf(mx, __shfl_xor(mx, o));
        wS[2 * F.lane] = __expf(d0 - mx); wS[2 * F.lane + 1] = __expf(d1 - mx);
        if (F.lane == 0) { sc2[0] = mx; sc2[1] = bend; }
    }
    __syncthreads();
    ml_stage_T(F, P, b, dir, j, C_MV + head * 64, Vt, wS, 1.f);
    ml_stage_T(F, P, b, dir, j, C_MK + head * 64, Kt, nullptr, 0.125f);
    __syncthreads();
    float* LC = WSP(float, WS_LC) + (size_t)task * CST;
    { const int vb = F.wave >> 1, i = F.lane & 15, gq = F.lane >> 4;
#pragma unroll
      for (int kk2 = 0; kk2 < 2; ++kk2) { const int kb = 2 * (F.wave & 1) + kk2; f32x4 acc = {0.f, 0.f, 0.f, 0.f};
#pragma unroll
          for (int ks = 0; ks < 4; ++ks) { const bf16x8 a = *(const LAS bf16x8*)(Vt + (vb * 16 + i) * 136 + ks * 32 + gq * 8), bb = *(const LAS bf16x8*)(Kt + (kb * 16 + i) * 136 + ks * 32 + gq * 8);
              acc = __builtin_amdgcn_mfma_f32_16x16x32_bf16(a, bb, acc, 0, 0, 0); }
#pragma unroll
          for (int r = 0; r < 4; ++r) LC[(vb * 16 + 4 * gq + r) * 64 + kb * 16 + i] = acc[r]; } }
    if (F.tid < 64) { float a = 0.f;
#pragma unroll 8
        for (int s = 0; s < 128; ++s) a += wS[s] * bf2f(Kt[F.tid * 136 + s]);
        LC[4096 + F.tid] = a; }
    if (F.tid == 0) { float* LB = WSP(float, WS_LB); LB[task * 2] = sc2[0]; LB[task * 2 + 1] = sc2[1]; }
}
__device__ __forceinline__ void mlstm_chain(const Ctx& F, int blk0) {
    const int gt = (F.vcu - blk0) * NTHR + F.tid; if (gt < 0 || gt >= 16 * CST) return;
    const int chain = gt / CST, e = gt % CST;
    const float* LC = WSP(float, WS_LC) + (size_t)chain * NCHK * CST + e; float* ST = WSP(float, WS_ST) + (size_t)chain * NCHK * CST + e;
    const float* LB = WSP(float, WS_LB) + chain * NCHK * 2; float* SM = WSP(float, WS_LB) + 4096 + chain * NCHK;
    float m = 0.f, x = 0.f;
#pragma unroll 6
    for (int j = 0; j < NCHK; ++j) {
        const float d = LC[(size_t)j * CST], L = LB[2 * j], Bv = LB[2 * j + 1];
        ST[(size_t)j * CST] = x; if (e == 0) SM[j] = m;
        const float mn = fmaxf(Bv + m, L);
        x = __expf(Bv + m - mn) * x + __expf(L - mn) * d; m = mn;
    }
}
__device__ __forceinline__ void mlstm_out(const Ctx& F, int l, int unit) {
    const bool isc = unit >= 512; int b, chunk, head;
    if (!isc) { b = unit >> 8; chunk = (unit >> 2) & 63; head = unit & 3; } else { const int u = unit - 512; b = u >> 3; chunk = (u >> 2) & 1; head = u & 3; }
    const bf16_t* P = WSP(bf16_t, WS_P); const float* GA = WSP(float, WS_GA); bf16_t* YC = WSP(bf16_t, WS_YCAT);
    LAS bf16_t* Ql = (LAS bf16_t*)F.lds; LAS bf16_t* Kl = Ql + 128 * 72; LAS bf16_t* Vt = Kl + 128 * 72; LAS bf16_t* Cb = Vt + 64 * 136;
    LAS float* nS = (LAS float*)(Cb + 64 * 72); LAS float* aS = nS + 64; LAS float* bS = aS + 128; LAS float* MS = bS + 128; LAS float* Hs = MS + 128;
    const int i = F.lane & 15, gq = F.lane >> 4, w = F.wave;
    for (int dir = 0; dir < 2; ++dir) {
        const int j = isc ? (dir ? 1 - chunk : chunk) : 2 + (dir ? 63 - chunk : chunk);
        const int chain = (b * 4 + head) * 2 + dir;
        const float* ST = WSP(float, WS_ST) + ((size_t)chain * NCHK + j) * CST; const float mprev = WSP(float, WS_LB)[4096 + chain * NCHK + j];
        __syncthreads();
        if (w == 0) {
            const int r0 = ml_row(b, dir, j, 2 * F.lane), r1 = ml_row(b, dir, j, 2 * F.lane + 1);
            const float li0 = GA[(size_t)r0 * 16 + dir * 8 + head], li1 = GA[(size_t)r1 * 16 + dir * 8 + head];
            float b0 = GA[(size_t)r0 * 16 + dir * 8 + 4 + head], b1 = GA[(size_t)r1 * 16 + dir * 8 + 4 + head];
            scan128_add(b0, b1, F.lane);
            const float a0 = li0 - b0, a1 = li1 - b1; float A0 = a0, A1 = a1;
            scan128_max(A0, A1, F.lane);
            aS[2 * F.lane] = a0; aS[2 * F.lane + 1] = a1; bS[2 * F.lane] = b0; bS[2 * F.lane + 1] = b1;
            MS[2 * F.lane] = fmaxf(A0, mprev); MS[2 * F.lane + 1] = fmaxf(A1, mprev);
        }
        ml_stage_R(F, P, b, dir, j, C_MQ + head * 64, Ql, 1.f);
        ml_stage_R(F, P, b, dir, j, C_MK + head * 64, Kl, 0.125f);
        ml_stage_T(F, P, b, dir, j, C_MV + head * 64, Vt, nullptr, 1.f);
        { const f32x4 c0 = *(const f32x4*)(ST + F.tid * 8), c1 = *(const f32x4*)(ST + F.tid * 8 + 4); const int v = F.tid >> 3, k0 = (F.tid & 7) * 8;
          u32x4 o; o.x = pk2(c0[0], c0[1]); o.y = pk2(c0[2], c0[3]); o.z = pk2(c1[0], c1[1]); o.w = pk2(c1[2], c1[3]); *(LAS u32x4*)(Cb + v * 72 + k0) = o;
          if (F.tid < 64) nS[F.tid] = ST[4096 + F.tid]; }
        __syncthreads();
        const int t = 16 * w + i; const float Mt = MS[t], bt = bS[t];
        bf16x8 Qf[2];
#pragma unroll
        for (int ks = 0; ks < 2; ++ks) Qf[ks] = *(const LAS bf16x8*)(Ql + t * 72 + ks * 32 + gq * 8);
        f32x4 sc[8];
#pragma unroll
        for (int sb = 0; sb < 8; ++sb) { sc[sb] = (f32x4){0.f, 0.f, 0.f, 0.f};
            if (sb <= w) {
#pragma unroll
                for (int ks = 0; ks < 2; ++ks) { const bf16x8 kf = *(const LAS bf16x8*)(Kl + (sb * 16 + i) * 72 + ks * 32 + gq * 8); sc[sb] = __builtin_amdgcn_mfma_f32_16x16x32_bf16(kf, Qf[ks], sc[sb], 0, 0, 0); }
#pragma unroll
                for (int r = 0; r < 4; ++r) { const int s = sb * 16 + 4 * gq + r; sc[sb][r] = (s <= t) ? sc[sb][r] * __expf(aS[s] - Mt) : 0.f; }
            } }
        float den = 0.f;
#pragma unroll
        for (int sb = 0; sb < 8; ++sb) den += (sc[sb][0] + sc[sb][1]) + (sc[sb][2] + sc[sb][3]);
        den += __shfl_xor(den, 16); den += __shfl_xor(den, 32);
        f32x4 nm[4], it_[4];
#pragma unroll
        for (int vb = 0; vb < 4; ++vb) { nm[vb] = (f32x4){0.f, 0.f, 0.f, 0.f}; it_[vb] = (f32x4){0.f, 0.f, 0.f, 0.f}; }
#pragma unroll
        for (int ks2 = 0; ks2 < 4; ++ks2) if (2 * ks2 <= w) {
            frag_u pf; pf.u.x = pg8::cvt_pk_bf16(sc[2 * ks2][0], sc[2 * ks2][1]); pf.u.y = pg8::cvt_pk_bf16(sc[2 * ks2][2], sc[2 * ks2][3]);
            pf.u.z = pg8::cvt_pk_bf16(sc[2 * ks2 + 1][0], sc[2 * ks2 + 1][1]); pf.u.w = pg8::cvt_pk_bf16(sc[2 * ks2 + 1][2], sc[2 * ks2 + 1][3]);
#pragma unroll
            for (int vb = 0; vb < 4; ++vb) { frag_u vf; const LAS bf16_t* vp = Vt + (vb * 16 + i) * 136 + (2 * ks2) * 16 + 4 * gq;
                const u32x2 v0 = *(const LAS u32x2*)vp, v1 = *(const LAS u32x2*)(vp + 16); vf.u = (u32x4){v0.x, v0.y, v1.x, v1.y};
                nm[vb] = __builtin_amdgcn_mfma_f32_16x16x32_bf16(vf.b, pf.b, nm[vb], 0, 0, 0); }
        }
#pragma unroll
        for (int vb = 0; vb < 4; ++vb)
#pragma unroll
            for (int ks = 0; ks < 2; ++ks) { const bf16x8 cf = *(const LAS bf16x8*)(Cb + (vb * 16 + i) * 72 + ks * 32 + gq * 8); it_[vb] = __builtin_amdgcn_mfma_f32_16x16x32_bf16(cf, Qf[ks], it_[vb], 0, 0, 0); }
        float nq = 0.f;
#pragma unroll
        for (int c = 0; c < 2; ++c) { const u32x4 qv = *(const LAS u32x4*)(Ql + t * 72 + gq * 16 + c * 8); const unsigned ww[4] = {qv.x, qv.y, qv.z, qv.w};
#pragma unroll
            for (int q = 0; q < 4; ++q) nq += nS[gq * 16 + c * 8 + 2 * q] * lo2f(ww[q]) + nS[gq * 16 + c * 8 + 2 * q + 1] * hi2f(ww[q]); }
        nq += __shfl_xor(nq, 16); nq += __shfl_xor(nq, 32);
        const float wint = __expf(mprev - Mt); den += wint * nq;
        const float dn = 1.f / fmaxf(fabsf(den), __expf(-(bt + Mt)));
        const int torig = dir ? 127 - t : t;
#pragma unroll
        for (int vb = 0; vb < 4; ++vb)
#pragma unroll
            for (int r = 0; r < 4; ++r) { const float hv = (nm[vb][r] + wint * it_[vb][r]) * dn; LAS float* hp = Hs + torig * 65 + vb * 16 + 4 * gq + r; if (dir == 0) *hp = hv; else *hp += hv; }
    }
    __syncthreads();
    {
        const int t = F.tid >> 2, vq = F.tid & 3; const int row = (isc ? MLAT + b * TCTX : b * TLAT) + chunk * 128 + t;
        float hv[16], ss = 0.f;
#pragma unroll
        for (int q = 0; q < 16; ++q) { hv[q] = Hs[t * 65 + vq * 16 + q]; ss += hv[q] * hv[q]; }
        ss += __shfl_xor(ss, 1); ss += __shfl_xor(ss, 2);
        const float rs = rsqrtf(ss * (1.f / 64.f) + EPSN);
        const float* og = F.in[27] + l * 256 + head * 64 + vq * 16; const bf16_t* op = P + (size_t)row * DINP + C_MO + head * 64 + vq * 16;
        const u32x4 o0 = *(const u32x4*)op, o1 = *(const u32x4*)(op + 8); const unsigned ow[8] = {o0.x, o0.y, o0.z, o0.w, o1.x, o1.y, o1.z, o1.w};
        unsigned res[8];
#pragma unroll
        for (int q = 0; q < 8; ++q) { const float y0 = sigmoidf_(lo2f(ow[q])) * hv[2 * q] * rs * og[2 * q], y1 = sigmoidf_(hi2f(ow[q])) * hv[2 * q + 1] * rs * og[2 * q + 1]; res[q] = pk2(y0 * ZF(16), y1 * ZF(16)); }
        bf16_t* yo = YC + (size_t)row * DM + 768 + head * 64 + vq * 16;
        *(u32x4*)yo = (u32x4){res[0], res[1], res[2], res[3]}; *(u32x4*)(yo + 8) = (u32x4){res[4], res[5], res[6], res[7]};
    }
    __syncthreads();
}
__device__ __forceinline__ void rwkv_finish(const Ctx& F, int l, int nrows) {
    const bf16_t* P = WSP(bf16_t, WS_P); const float* YR = WSP(float, WS_YR); const bf16_t* GB = WSP(bf16_t, WS_GB); const float* BS = WSP(float, WS_BS); bf16_t* YC = WSP(bf16_t, WS_YCAT);
    const int c4 = F.lane * 4; const f32x4 lg = *(const f32x4*)(F.in[20] + l * 256 + c4);
    const int gw = F.vcu * NWAVES + F.wave, NGW = F.G * NWAVES;
    for (int row = gw; row < nrows; row += NGW) {
        const f32x4 y = *(const f32x4*)(YR + (size_t)row * 256 + c4) + *(const f32x4*)(YR + (size_t)(MALL + row) * 256 + c4);
        const float ss = red16((y[0] * y[0] + y[1] * y[1]) + (y[2] * y[2] + y[3] * y[3]));
        const float rs = rsqrtf(ss * (1.f / 64.f) + EPSN);
        const f32x4 v = ld4bf(P + (size_t)row * DINP + C_RV + c4), g = ld4bf(GB + (size_t)row * 256 + c4);
        const float bn = BS[(size_t)row * 4 + (F.lane >> 4)];
        st4bf(YC + (size_t)row * DM + 256 + c4, (y * rs * lg * ZF(32) + bn * v * ZF(64)) * g * ZF(4));
    }
}
constexpr int RCH = 132;
constexpr int MP = 72, SLOT = 64 * MP;
constexpr size_t WS_RG = 454 * MiB, RG_TASK = 3 * 8192, WS_SST = WS_RW;
constexpr size_t WS_END2 = 504 * MiB;
static_assert(WS_RG + (size_t)16 * RCH * RG_TASK <= WS_END2 && (size_t)16 * RCH * 8192 <= (size_t)MALL * RWREC, "rwkv chunk ws map");

__device__ __forceinline__ void mm64(const LAS bf16_t* A, const LAS bf16_t* Bt, int w, int lane, f32x4 (&acc)[2]) {
    const int i = lane & 15, gq = lane >> 4, mb = w >> 1, nb0 = 2 * (w & 1);
    acc[0] = (f32x4){0.f, 0.f, 0.f, 0.f}; acc[1] = (f32x4){0.f, 0.f, 0.f, 0.f};
#pragma unroll
    for (int ks = 0; ks < 2; ++ks) { const bf16x8 a = *(const LAS bf16x8*)(A + (mb * 16 + i) * MP + ks * 32 + gq * 8);
#pragma unroll
        for (int q = 0; q < 2; ++q) { const bf16x8 b = *(const LAS bf16x8*)(Bt + ((nb0 + q) * 16 + i) * MP + ks * 32 + gq * 8); acc[q] = __builtin_amdgcn_mfma_f32_16x16x32_bf16(a, b, acc[q], 0, 0, 0); } }
}
__device__ __forceinline__ u32x2 pk4(f32x4 v) { u32x2 o; o.x = pk2(v[0], v[1]); o.y = pk2(v[2], v[3]); return o; }
__device__ __forceinline__ f32x4 up4(u32x2 w) { return (f32x4){lo2f(w.x), hi2f(w.x), lo2f(w.y), hi2f(w.y)}; }

__device__ __forceinline__ void rwkv_chunk_pre(const Ctx& F, int task) {
    const int chain = task / RCH, c = task % RCH, b = chain >> 3, head = (chain >> 1) & 3, dir = chain & 1;
    const bf16_t* P = WSP(bf16_t, WS_P); const unsigned char* RW = WSP(unsigned char, WS_RW);
    LAS bf16_t* L0 = (LAS bf16_t*)F.lds;
#define SL(k) (L0 + (k) * SLOT)
    LAS float* LD = (LAS float*)SL(8);
    LAS float* SEG = (LAS float*)SL(10);
    LAS float* WLs = (LAS float*)SL(14);
    const int w = F.wave, lane = F.lane, i = lane & 15, gq = lane >> 4, mb = w >> 1, nb0 = 2 * (w & 1), m0 = mb * 16 + 4 * gq;
    __syncthreads();
    const int t = F.tid >> 3, ch0 = (F.tid & 7) * 8;
    const int row = scan_row(b, dir, c * 64 + t);
    const bf16_t* rb = (const bf16_t*)(RW + (size_t)row * RWREC) + head * 64 + ch0;
    const u32x4 g_kk = *(const u32x4*)rb, g_al = *(const u32x4*)(rb + 256 + dir * 256), g_kd = *(const u32x4*)(rb + 768 + dir * 256);
    const float* ldp = (const float*)(RW + (size_t)row * RWREC + 2560) + dir * 256 + head * 64 + ch0;
    const f32x4 ld0 = *(const f32x4*)ldp, ld1 = *(const f32x4*)(ldp + 4);
    const bf16_t* pp = P + (size_t)row * DINP + head * 64 + ch0;
    const u32x4 g_r = *(const u32x4*)(pp + C_RR), g_v = *(const u32x4*)(pp + C_RV);
    *(LAS f32x4*)(LD + t * 64 + ch0) = ld0; *(LAS f32x4*)(LD + t * 64 + ch0 + 4) = ld1;
    __syncthreads();
    { const int k = F.tid & 63, seg = F.tid >> 6; float s = 0.f;
#pragma unroll
      for (int j = 0; j < 8; ++j) s += LD[(seg * 8 + j) * 64 + k];
      SEG[seg * 64 + k] = s;
      __syncthreads();
      float off = 0.f;
#pragma unroll
      for (int j = 0; j < 8; ++j) off += (j < seg) ? SEG[j * 64 + k] : 0.f;
#pragma unroll
      for (int j = 0; j < 8; ++j) { off += LD[(seg * 8 + j) * 64 + k]; LD[(seg * 8 + j) * 64 + k] = off; }
    }
    __syncthreads();
    {
        const unsigned kkw[4] = {g_kk.x, g_kk.y, g_kk.z, g_kk.w}, alw[4] = {g_al.x, g_al.y, g_al.z, g_al.w}, kdw[4] = {g_kd.x, g_kd.y, g_kd.z, g_kd.w},
                       rw_[4] = {g_r.x, g_r.y, g_r.z, g_r.w}, vw[4] = {g_v.x, g_v.y, g_v.z, g_v.w};
        float okt[8], oai[8], oki[8], ort[8], oat[8], okb[8];
#pragma unroll
        for (int j = 0; j < 8; ++j) {
            const float cl = LD[t * 64 + ch0 + j], clp = t > 0 ? LD[(t - 1) * 64 + ch0 + j] : 0.f, clL = LD[63 * 64 + ch0 + j];
            const float kkv = (j & 1) ? hi2f(kkw[j >> 1]) : lo2f(kkw[j >> 1]), alv = (j & 1) ? hi2f(alw[j >> 1]) : lo2f(alw[j >> 1]), kdv = (j & 1) ? hi2f(kdw[j >> 1]) : lo2f(kdw[j >> 1]),
                        rv = (j & 1) ? hi2f(rw_[j >> 1]) : lo2f(rw_[j >> 1]);
            const float en = __expf(-cl), eL = __expf(clL - cl);
            okt[j] = kkv * __expf(clp); oai[j] = alv * en; oki[j] = kdv * en; ort[j] = rv * __expf(cl); oat[j] = alv * eL; okb[j] = kdv * eL;
        }
        u32x4 o;
        o = (u32x4){pk2(okt[0], okt[1]), pk2(okt[2], okt[3]), pk2(okt[4], okt[5]), pk2(okt[6], okt[7])}; *(LAS u32x4*)(SL(0) + t * MP + ch0) = o;
        o = (u32x4){pk2(oai[0], oai[1]), pk2(oai[2], oai[3]), pk2(oai[4], oai[5]), pk2(oai[6], oai[7])}; *(LAS u32x4*)(SL(2) + t * MP + ch0) = o;
        o = (u32x4){pk2(oki[0], oki[1]), pk2(oki[2], oki[3]), pk2(oki[4], oki[5]), pk2(oki[6], oki[7])}; *(LAS u32x4*)(SL(3) + t * MP + ch0) = o;
        o = (u32x4){pk2(ort[0], ort[1]), pk2(ort[2], ort[3]), pk2(ort[4], ort[5]), pk2(ort[6], ort[7])}; *(LAS u32x4*)(SL(4) + t * MP + ch0) = o;
#pragma unroll
        for (int j = 0; j < 8; ++j) { SL(1)[(ch0 + j) * MP + t] = (bf16_t)f2bf(okt[j]); SL(5)[(ch0 + j) * MP + t] = (bf16_t)f2bf(oat[j]); SL(6)[(ch0 + j) * MP + t] = (bf16_t)f2bf(okb[j]);
            SL(7)[(ch0 + j) * MP + t] = (bf16_t)(((j & 1) ? (vw[j >> 1] >> 16) : (vw[j >> 1] & 0xffffu))); }
        if (t == 63) {
#pragma unroll
            for (int j = 0; j < 8; ++j) WLs[ch0 + j] = __expf(LD[63 * 64 + ch0 + j]); }
    }
    __syncthreads();
    f32x4 acc[2];
    mm64(SL(0), SL(2), w, lane, acc);
#pragma unroll
    for (int q = 0; q < 2; ++q) { const int n = (nb0 + q) * 16 + i; f32x4 a, ti;
#pragma unroll
        for (int r = 0; r < 4; ++r) { const bool keep = (m0 + r) > n; a[r] = keep ? acc[q][r] : 0.f; ti[r] = ((m0 + r) == n ? 1.f : 0.f) - a[r]; }
#pragma unroll
        for (int r = 0; r < 4; ++r) { SL(8)[(m0 + r) * MP + n] = (bf16_t)f2bf(a[r]); SL(13)[(m0 + r) * MP + n] = (bf16_t)f2bf(ti[r]); }
        *(LAS u32x2*)(SL(9) + n * MP + m0) = pk4(a); }
    mm64(SL(0), SL(3), w, lane, acc);
#pragma unroll
    for (int q = 0; q < 2; ++q) { const int n = (nb0 + q) * 16 + i;
#pragma unroll
        for (int r = 0; r < 4; ++r) SL(10)[(m0 + r) * MP + n] = (bf16_t)f2bf((m0 + r) > n ? acc[q][r] : 0.f); }
    mm64(SL(4), SL(2), w, lane, acc);
#pragma unroll
    for (int q = 0; q < 2; ++q) { const int n = (nb0 + q) * 16 + i;
#pragma unroll
        for (int r = 0; r < 4; ++r) SL(11)[(m0 + r) * MP + n] = (bf16_t)f2bf((m0 + r) >= n ? acc[q][r] : 0.f); }
    mm64(SL(4), SL(3), w, lane, acc);
#pragma unroll
    for (int q = 0; q < 2; ++q) { const int n = (nb0 + q) * 16 + i;
#pragma unroll
        for (int r = 0; r < 4; ++r) SL(12)[(m0 + r) * MP + n] = (bf16_t)f2bf((m0 + r) >= n ? acc[q][r] : 0.f); }
    __syncthreads();
#pragma unroll
    for (int it = 0; it < 5; ++it) {
        LAS bf16_t* Xs = (it & 1) ? SL(2) : SL(8); LAS bf16_t* XsT = (it & 1) ? SL(3) : SL(9);
        LAS bf16_t* Xd = (it & 1) ? SL(8) : SL(2); LAS bf16_t* XdT = (it & 1) ? SL(9) : SL(3);
        LAS bf16_t* Tsrc = (it & 1) ? SL(0) : SL(13); LAS bf16_t* Tdst = (it & 1) ? SL(13) : SL(0);
        mm64(Xs, XsT, w, lane, acc);
#pragma unroll
        for (int q = 0; q < 2; ++q) { const int n = (nb0 + q) * 16 + i;
#pragma unroll
            for (int r = 0; r < 4; ++r) Xd[(m0 + r) * MP + n] = (bf16_t)f2bf(acc[q][r]);
            *(LAS u32x2*)(XdT + n * MP + m0) = pk4(acc[q]); }
        __syncthreads();
        mm64(Tsrc, XdT, w, lane, acc);
#pragma unroll
        for (int q = 0; q < 2; ++q) { const int n = (nb0 + q) * 16 + i;
#pragma unroll
            for (int r = 0; r < 4; ++r) Tdst[(m0 + r) * MP + n] = (bf16_t)f2bf(bf2f(Tsrc[(m0 + r) * MP + n]) + acc[q][r]); }
        __syncthreads();
    }
    LAS bf16_t* Ti = SL(0);
    mm64(Ti, SL(1), w, lane, acc);
#pragma unroll
    for (int q = 0; q < 2; ++q) { const int n = (nb0 + q) * 16 + i; *(LAS u32x2*)(SL(2) + n * MP + m0) = pk4(acc[q]); }
    mm64(SL(10), SL(7), w, lane, acc);
#pragma unroll
    for (int q = 0; q < 2; ++q) { const int n = (nb0 + q) * 16 + i; *(LAS u32x2*)(SL(3) + n * MP + m0) = pk4(acc[q]); }
    __syncthreads();
    mm64(Ti, SL(3), w, lane, acc);
#pragma unroll
    for (int q = 0; q < 2; ++q) { const int n = (nb0 + q) * 16 + i; *(LAS u32x2*)(SL(8) + n * MP + m0) = pk4(acc[q]); }
    __syncthreads();
    bf16_t* RG = (bf16_t*)(F.ws + WS_RG + (size_t)task * RG_TASK);
    f32x4 acc2[2];
    mm64(SL(2), SL(11), w, lane, acc);
#pragma unroll
    for (int q = 0; q < 2; ++q) { const int n = (nb0 + q) * 16 + i; const f32x4 rt = up4(*(const LAS u32x2*)(SL(4) + n * MP + m0)); *(u32x2*)(RG + n * 64 + m0) = pk4(rt - acc[q]); }
    mm64(SL(2), SL(5), w, lane, acc);
#pragma unroll
    for (int q = 0; q < 2; ++q) { const int n = (nb0 + q) * 16 + i; f32x4 g;
#pragma unroll
        for (int r = 0; r < 4; ++r) g[r] = ((m0 + r) == n ? WLs[n] : 0.f) - acc[q][r];
        *(u32x2*)(RG + 4096 + n * 64 + m0) = pk4(g); }
    mm64(SL(6), SL(7), w, lane, acc); mm64(SL(5), SL(8), w, lane, acc2);
#pragma unroll
    for (int q = 0; q < 2; ++q) { const int n = (nb0 + q) * 16 + i; *(u32x2*)(RG + 8192 + n * 64 + m0) = pk4(acc[q] - acc2[q]); }
    mm64(SL(7), SL(12), w, lane, acc); mm64(SL(8), SL(11), w, lane, acc2);
    float* YR = WSP(float, WS_YR) + (size_t)dir * MALL * 256;
#pragma unroll
    for (int q = 0; q < 2; ++q) { const int n = (nb0 + q) * 16 + i; const int rown = scan_row(b, dir, c * 64 + n); *(f32x4*)(YR + (size_t)rown * 256 + head * 64 + m0) = acc[q] - acc2[q]; }
#undef SL
}

__device__ __forceinline__ void rwkv_chain(const Ctx& F, int chain) {
    LAS bf16_t* Gl[2] = {(LAS bf16_t*)F.lds, (LAS bf16_t*)F.lds + SLOT}; LAS bf16_t* Sl[2] = {(LAS bf16_t*)F.lds + 2 * SLOT, (LAS bf16_t*)F.lds + 3 * SLOT};
    const int w = F.wave, lane = F.lane, i = lane & 15, gq = lane >> 4, mb = w >> 1, nb0 = 2 * (w & 1), m0 = mb * 16 + 4 * gq;
    const bf16_t* RGc = (const bf16_t*)(F.ws + WS_RG + (size_t)chain * RCH * RG_TASK); bf16_t* SST = (bf16_t*)(F.ws + WS_SST) + (size_t)chain * RCH * 4096;
    const int gr = F.tid >> 3, gc = (F.tid & 7) * 8;
    __syncthreads();
    *(LAS u32x4*)(Sl[0] + gr * MP + gc) = (u32x4){0u, 0u, 0u, 0u};
    *(u32x4*)(SST + gr * 64 + gc) = (u32x4){0u, 0u, 0u, 0u};
    u32x4 gnext = *(const u32x4*)(RGc + 4096 + gr * 64 + gc);
    *(LAS u32x4*)(Gl[0] + gr * MP + gc) = gnext;
    u32x2 hcur[2], hnext[2];
#pragma unroll
    for (int q = 0; q < 2; ++q) hcur[q] = *(const u32x2*)(RGc + 8192 + ((nb0 + q) * 16 + i) * 64 + m0);
    __syncthreads();
#pragma unroll 1
    for (int c = 0; c < RCH - 1; ++c) {
        const int par = c & 1; const bf16_t* nx = RGc + (size_t)(c + 1) * (RG_TASK / 2);
        gnext = *(const u32x4*)(nx + 4096 + gr * 64 + gc);
#pragma unroll
        for (int q = 0; q < 2; ++q) hnext[q] = *(const u32x2*)(nx + 8192 + ((nb0 + q) * 16 + i) * 64 + m0);
        f32x4 acc[2]; mm64(Gl[par], Sl[par], w, lane, acc);
        bf16_t* so = SST + (size_t)(c + 1) * 4096;
#pragma unroll
        for (int q = 0; q < 2; ++q) { const int n = (nb0 + q) * 16 + i; const u32x2 o = pk4(acc[q] + up4(hcur[q])); *(LAS u32x2*)(Sl[par ^ 1] + n * MP + m0) = o; *(u32x2*)(so + n * 64 + m0) = o; hcur[q] = hnext[q]; }
        *(LAS u32x4*)(Gl[par ^ 1] + gr * MP + gc) = gnext;
        __syncthreads();
    }
    __syncthreads();
}

__device__ __forceinline__ void rwkv_out(const Ctx& F, int l, int unit) {
    const bool isc = unit >= 256; int b, chunk; if (!isc) { b = unit >> 7; chunk = unit & 127; } else { const int u = unit - 256; b = u >> 2; chunk = u & 3; }
    LAS bf16_t* Rl = (LAS bf16_t*)F.lds; LAS bf16_t* Sl = Rl + SLOT; LAS float* Ys = (LAS float*)(F.lds + 4 * SLOT * 2);
    const int w = F.wave, lane = F.lane, i = lane & 15, gq = lane >> 4, mb = w >> 1, nb0 = 2 * (w & 1), m0 = mb * 16 + 4 * gq;
    const int row0 = (isc ? MLAT + b * TCTX : b * TLAT) + chunk * 64;
    const int gr = F.tid >> 3, gc = (F.tid & 7) * 8;
#pragma unroll 1
    for (int hd = 0; hd < 8; ++hd) {
        const int head = hd >> 1, dir = hd & 1, chain = (b * 4 + head) * 2 + dir;
        const int cc = isc ? (dir ? 3 - chunk : chunk) : 4 + (dir ? 127 - chunk : chunk);
        const bf16_t* RG = (const bf16_t*)(F.ws + WS_RG + ((size_t)chain * RCH + cc) * RG_TASK); const bf16_t* SS = (const bf16_t*)(F.ws + WS_SST) + ((size_t)chain * RCH + cc) * 4096;
        const float* YR = WSP(float, WS_YR) + (size_t)dir * MALL * 256;
        const u32x4 rv = *(const u32x4*)(RG + gr * 64 + gc), sv = *(const u32x4*)(SS + gr * 64 + gc);
        __syncthreads();
        *(LAS u32x4*)(Rl + gr * MP + gc) = rv; *(LAS u32x4*)(Sl + gr * MP + gc) = sv;
        __syncthreads();
        f32x4 acc[2]; mm64(Sl, Rl, w, lane, acc);
#pragma unroll
        for (int q = 0; q < 2; ++q) { const int n = (nb0 + q) * 16 + i; const int tor = dir ? 63 - n : n;
            const f32x4 yl = *(const f32x4*)(YR + (size_t)(row0 + tor) * 256 + head * 64 + m0);
            LAS f32x4* yp = (LAS f32x4*)(Ys + tor * 260 + head * 64 + m0);
            if (dir == 0) *yp = acc[q] + yl; else *yp = *yp + acc[q] + yl; }
    }
    __syncthreads();
    {
        const bf16_t* P = WSP(bf16_t, WS_P); const bf16_t* GB = WSP(bf16_t, WS_GB); const float* BS = WSP(float, WS_BS); bf16_t* YC = WSP(bf16_t, WS_YCAT);
        const int c4 = lane * 4; const f32x4 lg = *(const f32x4*)(F.in[20] + l * 256 + c4);
#pragma unroll 1
        for (int tt = w; tt < 64; tt += NWAVES) { const int row = row0 + tt;
            const f32x4 y = *(const LAS f32x4*)(Ys + tt * 260 + c4);
            const float ss = red16((y[0] * y[0] + y[1] * y[1]) + (y[2] * y[2] + y[3] * y[3]));
            const float rs = rsqrtf(ss * (1.f / 64.f) + EPSN);
            const f32x4 v = ld4bf(P + (size_t)row * DINP + C_RV + c4), g = ld4bf(GB + (size_t)row * 256 + c4);
            const float bn = BS[(size_t)row * 4 + (lane >> 4)];
            st4bf(YC + (size_t)row * DM + 256 + c4, (y * rs * lg * ZF(32) + bn * v * ZF(64)) * g * ZF(4)); }
    }
    __syncthreads();
}
__device__ __forceinline__ float clr7(float x) { return __uint_as_float(__float_as_uint(x) & 0xFFFFFF80u); }
__device__ __forceinline__ void ins16(float (&L)[16], float p) {
#pragma unroll
    for (int j = 15; j >= 1; --j) L[j] = __builtin_amdgcn_fmed3f(L[j - 1], L[j], p);
    L[0] = fmaxf(L[0], p);
}
__device__ __forceinline__ void peer_topk_task(const float* srow, u32x2* eg) {
    float L0[16], L1[16];
#pragma unroll
    for (int j = 0; j < 16; ++j) { L0[j] = -INFINITY; L1[j] = -INFINITY; }
    for (int i = 0; i < 128; i += 4) {
        const f32x4 a = *(const f32x4*)(srow + i), b = *(const f32x4*)(srow + 128 + i);
#pragma unroll
        for (int q = 0; q < 4; ++q) { ins16(L0, __uint_as_float((__float_as_uint(a[q]) & 0xFFFFFF80u) | (unsigned)(i + q)));
                                      ins16(L1, __uint_as_float((__float_as_uint(b[q]) & 0xFFFFFF80u) | (unsigned)(i + q))); }
    }
    float T[16];
#pragma unroll
    for (int j = 0; j < 16; ++j) T[j] = -INFINITY;
#pragma unroll
    for (int a = 0; a < 16; ++a)
#pragma unroll
        for (int b = 0; b < 16; ++b) if ((a + 1) * (b + 1) <= 16) { const float s = clr7(L0[a]) + clr7(L1[b]);
            ins16(T, __uint_as_float((__float_as_uint(s) & 0xFFFFFF00u) | (unsigned)(a * 16 + b))); }
    float e[16], sum = 0.f; const float mx = __uint_as_float(__float_as_uint(T[0]) & 0xFFFFFF00u);
#pragma unroll
    for (int j = 0; j < 16; ++j) { e[j] = __expf(__uint_as_float(__float_as_uint(T[j]) & 0xFFFFFF00u) - mx); sum += e[j]; }
    const float inv = 1.f / sum;
#pragma unroll
    for (int j = 0; j < 16; ++j) {
        const unsigned ab = __float_as_uint(T[j]) & 0xFFu, a = ab >> 4, b = ab & 15u; unsigned i0 = 0u, i1 = 0u;
#pragma unroll
        for (int q = 0; q < 16; ++q) { i0 = (a == (unsigned)q) ? (__float_as_uint(L0[q]) & 0x7Fu) : i0; i1 = (b == (unsigned)q) ? (__float_as_uint(L1[q]) & 0x7Fu) : i1; }
        eg[j] = (u32x2){i0 * 128u + i1, __float_as_uint(e[j] * inv)};
    }
}
__device__ __forceinline__ float gelu_tanh(float x) { const float u = 0.7978845608028654f * (x + 0.044715f * x * x * x); return 0.5f * x * (1.f + tanhf_(u)); }
__device__ __forceinline__ float dot2bf(unsigned w, unsigned x, float acc) { return __builtin_amdgcn_fdot2_f32_bf16(__builtin_bit_cast(bf16x2_t, w), __builtin_bit_cast(bf16x2_t, x), acc, false); }
__device__ __forceinline__ float wave_total63(float x) {
    x = red16(x);
    x += __int_as_float(__builtin_amdgcn_update_dpp(0, __float_as_int(x), 0x142, 0xa, 0xf, false));
    x += __int_as_float(__builtin_amdgcn_update_dpp(0, __float_as_int(x), 0x143, 0xc, 0xf, false));
    return x;
}
__device__ __forceinline__ void phase_peer(const Ctx& F, int l, int nrows, const float* mod, float* wr_override) {
    const float* S = WSP(float, WS_S); u32x2* EG = WSP(u32x2, WS_EG); const bf16_t* H = WSP(bf16_t, WS_H);
    const unsigned char* U = F.ws + WS_U + (size_t)l * UV_LSTRIDE; const unsigned char* V = F.ws + WS_V + (size_t)l * UV_LSTRIDE;
    const float* USC = WSP(float, WS_SC) + (size_t)l * 2 * 16384; const float* VSC = USC + 16384;
    const int tpb = nrows / F.G, tok0 = F.vcu * tpb;
    for (int task = F.tid; task < tpb * 8; task += NTHR) { const int row = tok0 + (task >> 3), hd = task & 7;
        peer_topk_task(S + (size_t)row * 2048 + hd * 256, EG + (size_t)row * 128 + hd * 16); }
    __threadfence_block(); __syncthreads();
    const int lane = F.lane;
    for (int tk = F.wave; tk < tpb; tk += NWAVES) {
        const int row = tok0 + tk; const bool isc = row >= MLAT; const int smp = isc ? 2 : (row >> 13);
        float* xrow = isc ? WSP(float, WS_XC) + (size_t)(row - MLAT) * DM : F.out + (size_t)row * DM;
        f32x2 hv[8];
        { const u32x4 h0 = *(const u32x4*)(H + (size_t)row * DM + lane * 16), h1 = *(const u32x4*)(H + (size_t)row * DM + lane * 16 + 8);
          const unsigned hw[8] = {h0.x, h0.y, h0.z, h0.w, h1.x, h1.y, h1.z, h1.w};
#pragma unroll
          for (int q = 0; q < 8; ++q) hv[q] = (f32x2){lo2f(hw[q]), hi2f(hw[q])}; }
        const u32x2 eg0 = EG[(size_t)row * 128 + lane], eg1 = EG[(size_t)row * 128 + 64 + lane];
        float act0 = 0.f, act1 = 0.f;
#pragma unroll 1
        for (int grp = 0; grp < 8; ++grp) {
            u32x4 ua[16];
#pragma unroll
            for (int q = 0; q < 16; ++q) { const int ii = grp * 16 + q; const unsigned e = __builtin_amdgcn_readlane(ii < 64 ? eg0.x : eg1.x, ii & 63);
                ua[q] = *(const u32x4*)(U + (size_t)e * 1024 + lane * 16); }
#pragma unroll
            for (int q = 0; q < 16; ++q) { const int ii = grp * 16 + q; const unsigned e = __builtin_amdgcn_readlane(ii < 64 ? eg0.x : eg1.x, ii & 63);
                const unsigned uw[4] = {ua[q].x, ua[q].y, ua[q].z, ua[q].w}; f32x2 d2 = {0.f, 0.f};
#pragma unroll
                for (int j = 0; j < 4; ++j) { d2 += __builtin_amdgcn_cvt_pk_f32_fp8((int)uw[j], false) * hv[2 * j]; d2 += __builtin_amdgcn_cvt_pk_f32_fp8((int)uw[j], true) * hv[2 * j + 1]; }
                const float tot = __int_as_float(__builtin_amdgcn_readlane(__float_as_int(wave_total63(d2.x + d2.y)), 63)) * USC[e];
                if (ii < 64) act0 = (lane == (ii & 63)) ? tot : act0; else act1 = (lane == (ii & 63)) ? tot : act1; }
        }
        const float cf0 = __uint_as_float(eg0.y) * gelu_tanh(act0) * VSC[eg0.x], cf1 = __uint_as_float(eg1.y) * gelu_tanh(act1) * VSC[eg1.x];
        f32x2 ac[8];
#pragma unroll
        for (int q = 0; q < 8; ++q) ac[q] = (f32x2){0.f, 0.f};
#pragma unroll 1
        for (int grp = 0; grp < 8; ++grp) {
            u32x4 va[16];
#pragma unroll
            for (int q = 0; q < 16; ++q) { const int ii = grp * 16 + q; const unsigned e = __builtin_amdgcn_readlane(ii < 64 ? eg0.x : eg1.x, ii & 63);
                va[q] = *(const u32x4*)(V + (size_t)e * 1024 + lane * 16); }
#pragma unroll
            for (int q = 0; q < 16; ++q) { const int ii = grp * 16 + q; const float cf = __int_as_float(__builtin_amdgcn_readlane(__float_as_int(ii < 64 ? cf0 : cf1), ii & 63));
                const unsigned vw[4] = {va[q].x, va[q].y, va[q].z, va[q].w};
#pragma unroll
                for (int j = 0; j < 4; ++j) { ac[2 * j] += cf * __builtin_amdgcn_cvt_pk_f32_fp8((int)vw[j], false); ac[2 * j + 1] += cf * __builtin_amdgcn_cvt_pk_f32_fp8((int)vw[j], true); } }
        }
        float acc[16];
#pragma unroll
        for (int q = 0; q < 8; ++q) { acc[2 * q] = ac[q].x; acc[2 * q + 1] = ac[q].y; }
        const float* gt = mod + smp * 6144 + 5120;
#pragma unroll
        for (int q = 0; q < 4; ++q) { const int c = lane * 16 + q * 4; const f32x4 g = *(const f32x4*)(gt + c), x = *(const f32x4*)(xrow + c);
            *(f32x4*)((wr_override ? wr_override + (size_t)row * DM : xrow) + c) = x + ZF(1) * g * (f32x4){acc[q * 4], acc[q * 4 + 1], acc[q * 4 + 2], acc[q * 4 + 3]}; }
    }
}

constexpr int PH_PER_LAYER = 10, N_PHASES = 1 + 2 * PH_PER_LAYER;
struct Args { const float* in[32]; float* out; unsigned char* ws; int ph_lo, ph_hi, li, pad; };
__global__ void __launch_bounds__(NTHR, 2) mk_fwd(Args args) {
    extern __shared__ __attribute__((aligned(16))) unsigned char lds[];
    Ctx F;
    F.lds = (LAS unsigned char*)lds;
    volatile LAS unsigned* MISC = (volatile LAS unsigned*)(F.lds + MISC_OFF);
    F.tid = threadIdx.x; F.lane = F.tid & 63; F.wave = __builtin_amdgcn_readfirstlane(F.tid >> 6);
    F.G = gridDim.x; { const int bx = blockIdx.x; F.vcu = (F.G % 8 == 0) ? (bx % 8) * (F.G / 8) + bx / 8 : bx; }
#pragma unroll
    for (int i = 0; i < 32; ++i) F.in[i] = args.in[i];
    F.out = args.out; F.ws = args.ws;
    for (int u = F.tid; u < (LDS_BYTES - LDSCTL_OFF) / 4; u += NTHR) ((LAS unsigned*)(F.lds + LDSCTL_OFF))[u] = 0u;
    __syncthreads();
    XcdBarrier bar; bar.bar = (unsigned*)(args.ws + WS_CTL) + CW_BAR; bar.x = 0; bar.st = nullptr;
#if !MK_MULTI
    bar = xcd_barrier_post((unsigned*)(args.ws + WS_CTL) + CW_BAR, MISC + 8);
#endif
    const int lo = args.ph_lo, hi = args.ph_hi;
#ifndef KMAX
#define KMAX 1000
#endif
#define IN(k) (lo <= (k) && (k) < hi && (REP_ALL == 1 || ra == REP_ALL - 1 || (k) <= KMAX))
#ifndef REP_PH
#define REP_PH -1
#endif
#define REPS(k) ((REP_PH == (k)) ? 2 : 1)
#define PHCTX Ctx Fp = F; { int t_ = F.tid; asm volatile("" : "+v"(t_)); Fp.tid = t_; Fp.lane = t_ & 63; }
#if MK_MULTI
#define SEAM(k) do { } while (0)
#else
#ifndef BAR_REPS
#define BAR_REPS 1
#endif
#define SEAM(k) do { if (IN(k) && IN((k) + 1)) for (int br_ = 0; br_ < BAR_REPS; ++br_) xcd_barrier(bar); } while (0)
#endif
#ifndef REP_ALL
#define REP_ALL 1
#endif
#pragma unroll 1
    for (int ra = 0; ra < REP_ALL; ++ra) {
    if (ra > 0) xcd_barrier(bar);
    if (IN(0)) { PHCTX; for (int rep = 0; rep < REPS(100); ++rep) phase_prologue(Fp); }
    SEAM(0);
    float* XC = WSP(float, WS_XC);
#pragma unroll 1
    for (int l = 0; l < 2; ++l) {
        const int pb = 1 + l * PH_PER_LAYER;
        const float* xlat = l == 0 ? F.in[0] : F.out; const float* xctx = l == 0 ? F.in[2] : XC;
        const int mrows = l == 0 ? MALL : MLAT;
        const float* mod = WSP(float, WS_MOD) + (size_t)l * 3 * 6144;
        if (IN(pb + 0)) { PHCTX; for (int rep = 0; rep < REPS(0); ++rep) { phase_norm(Fp, l, 0, MALL, xlat, xctx); } }
        SEAM(pb + 0);
        if (IN(pb + 1)) for (int rep = 0; rep < REPS(1); ++rep) { PHCTX; pg8::Gemm g{WSP(bf16_t, WS_H), WSP(bf16_t, WS_WIN + l * WIN_LSTRIDE), MALL, DINP, DM}; pg8::StaticOrder So; So.init(MALL, DINP, F.G, (int)blockIdx.x);
            pg8::EpiBf16 E{WSP(bf16_t, WS_P), DINP}; pg8::gemm_phase<pg8::EpiBf16, pg8::StaticOrder, true, true>(F.lds, g, So, E, Fp.tid); }
        SEAM(pb + 1);
        if (IN(pb + 2)) { PHCTX; for (int rep = 0; rep < REPS(2); ++rep) { phase_prep(Fp, l); __syncthreads(); } }
        SEAM(pb + 2);
        if (IN(pb + 3)) for (int rep = 0; rep < REPS(3); ++rep) { PHCTX;
            const int natt = l == 0 ? 264 : 256, nra = 16 * RCH, ntask = natt + nra + 16 * NCHK;
            for (int task = F.vcu; task < ntask; task += F.G) { if (task < natt) attn_unit(Fp, l, task); else if (task < natt + nra) rwkv_chunk_pre(Fp, task - natt); else mlstm_local(Fp, task - natt - nra); }
        }
        SEAM(pb + 3);
        if (IN(pb + 4)) { PHCTX; for (int rep = 0; rep < REPS(4); ++rep) { if (F.vcu < 16) rwkv_chain(Fp, F.vcu); else mlstm_chain(Fp, 16); } }
        SEAM(pb + 4);
        if (IN(pb + 5)) for (int rep = 0; rep < REPS(5); ++rep) { PHCTX; const int nro = l == 0 ? 264 : 256, nun = l == 0 ? 528 : 512;
            for (int u = F.vcu; u < nro + nun; u += F.G) { if (u < nro) rwkv_out(Fp, l, u); else mlstm_out(Fp, l, u - nro); } }
        SEAM(pb + 5);
        if (IN(pb + 6)) for (int rep = 0; rep < REPS(6); ++rep) { PHCTX; pg8::Gemm g{WSP(bf16_t, WS_YCAT), WSP(bf16_t, WS_WOUT + l * WOUT_LSTRIDE), mrows, DM, DM}; pg8::StaticOrder So; So.init(mrows, DM, F.G, (int)blockIdx.x);
            float* dummy = WSP(float, WS_YR); const bool dm_ = (REPS(6) == 2 && rep == 0); pg8::EpiRes E{xlat, xctx, dm_ ? dummy : F.out, dm_ ? dummy : XC, mod}; pg8::gemm_phase<pg8::EpiRes, pg8::StaticOrder, true, true>(F.lds, g, So, E, Fp.tid); }
        SEAM(pb + 6);
        if (IN(pb + 7)) { PHCTX; for (int rep = 0; rep < REPS(7); ++rep) phase_norm(Fp, l, 1, mrows, F.out, XC); }
        SEAM(pb + 7);
        if (IN(pb + 8)) for (int rep = 0; rep < REPS(8); ++rep) { PHCTX; pg8::Gemm g{WSP(bf16_t, WS_H), WSP(bf16_t, WS_WEFF + l * WEFF_LSTRIDE), mrows, 2048, DM}; pg8::StaticOrder So; So.init(mrows, 2048, F.G, (int)blockIdx.x);
            pg8::EpiF32 E{WSP(float, WS_S), 2048}; pg8::gemm_phase<pg8::EpiF32, pg8::StaticOrder, true, true>(F.lds, g, So, E, Fp.tid); }
        SEAM(pb + 8);
        if (IN(pb + 9)) { PHCTX; for (int rep = 0; rep < REPS(9); ++rep) { phase_peer(Fp, l, mrows, mod, (REPS(9) == 2 && rep == 0) ? WSP(float, WS_YR) : nullptr); __syncthreads(); } }
        SEAM(pb + 9);
    }
    }
#undef IN
#undef SEAM
}

extern "C" void kernel_launch(void* const* d_in, const int* in_sizes, int n_in, void* d_out, int out_size, void* d_ws, size_t ws_size, hipStream_t stream) {
    static int grid = 0;
    if (grid == 0) {
        if (n_in != 32 || out_size != MLAT * DM || ws_size < WS_END2) { fprintf(stderr, "kernel_launch: unexpected shapes: n_in %d out %d ws %zu (need %zu)\n", n_in, out_size, ws_size, (size_t)WS_END2); grid = -1; return; }
        int dev = 0, cus = 0, per_cu = 0;
        if (hipGetDevice(&dev) != hipSuccess || hipDeviceGetAttribute(&cus, hipDeviceAttributeMultiprocessorCount, dev) != hipSuccess) { grid = -1; return; }
        if (hipFuncSetAttribute((const void*)mk_fwd, hipFuncAttributeMaxDynamicSharedMemorySize, LDS_BYTES) != hipSuccess) { fprintf(stderr, "kernel_launch: hipFuncSetAttribute failed\n"); grid = -1; return; }
        if (hipOccupancyMaxActiveBlocksPerMultiprocessor(&per_cu, (const void*)mk_fwd, NTHR, LDS_BYTES) != hipSuccess || per_cu < 1) fprintf(stderr, "kernel_launch: occupancy query reports %d\n", per_cu);
        (void)hipGetLastError();
        grid = cus;
        if (grid != 256) fprintf(stderr, "kernel_launch: grid %d (built for 256 CUs)\n", grid);
    }
    if (grid < 0) return;
    (void)hipMemsetAsync((char*)d_ws + WS_CTL, 0, CTL_ZERO_BYTES, stream);
    Args a{};
    for (int i = 0; i < 32; ++i) a.in[i] = (const float*)d_in[i];
    a.out = (float*)d_out; a.ws = (unsigned char*)d_ws;
#if MK_MULTI
    for (int p = 0; p < N_PHASES; ++p) { a.ph_lo = p; a.ph_hi = p + 1; a.li = p; hipLaunchKernelGGL(mk_fwd, dim3(grid), dim3(NTHR), LDS_BYTES, stream, a); }
#else
    a.ph_lo = 0; a.ph_hi = N_PHASES; a.li = 0;
    hipLaunchKernelGGL(mk_fwd, dim3(grid), dim3(NTHR), LDS_BYTES, stream, a);
#endif
}
```

```cpp
#include <hip/hip_runtime.h>
#include <cstdio>
#include <cstdint>

#ifndef MK_MULTI
#define MK_MULTI 0
#endif
namespace pg8 {
#define PG8_LAS __attribute__((address_space(3)))
typedef unsigned short bf16_t;
typedef short bf16x8 __attribute__((ext_vector_type(8)));
typedef float f32x4 __attribute__((ext_vector_type(4)));
typedef unsigned u32x4 __attribute__((ext_vector_type(4)));
constexpr int BM = 256, BK = 64, HALF = 128, HTB = HALF * BK * 2  , STAGE_BYTES = 8 * HTB, NXCD = 8, WGM = 8;

__host__ __device__ __forceinline__ int lds_byte(int r, int c) { const int st = (r >> 4) * 2 + (c >> 5), rr = r & 15, cc = c & 31, ob = rr * 64 + cc * 2; return st * 1024 + (ob ^ (((ob >> 9) & 1) << 5)); }
__host__ __device__ __forceinline__ void stage_rc(int b, int& R, int& C) { const int st = b / 1024, sb = b % 1024, swz = sb ^ (((sb >> 9) & 1) << 5); R = (st >> 1) * 16 + swz / 64; C = (st & 1) * 32 + (swz % 64) / 2; }
__host__ __device__ __forceinline__ int perm32(int rho) { const int n = rho >> 4, i = rho & 15; return 8 * (i >> 2) + 4 * n + (i & 3); }

struct Unit { int pm, pn; };
struct Gemm { const bf16_t* A; const bf16_t* Bt; int M, N, K; };

struct StaticOrder {
    int nM, nN, nwg, G, c;
    __host__ __device__ void init(int M, int N, int G_, int c_) { nM = M / BM; nN = N / BM; nwg = nM * nN; G = G_; c = c_; }
    __host__ __device__ bool next(int i, Unit& u) const {
        const long L = (long)i * G + c; if (L >= nwg) return false;
        int wgid = (int)L; { const int q = nwg / NXCD, r = nwg % NXCD, xcd = wgid % NXCD, off = wgid / NXCD; wgid = (xcd < r ? xcd * (q + 1) : r * (q + 1) + (xcd - r) * q) + off; }
        const int nig = WGM * nN, gid = wgid / nig, fm = gid * WGM, gsz = (nM - fm) < WGM ? (nM - fm) : WGM;
        u.pm = fm + ((wgid % nig) % gsz); u.pn = (wgid % nig) / gsz; return true;
    }
    __device__ __forceinline__ void a_ready(const Unit&) const {}
    __device__ __forceinline__ void done(const Unit&) const {}
};

__device__ __forceinline__ unsigned cvt_pk_bf16(float lo, float hi) { unsigned r; asm volatile("v_cvt_pk_bf16_f32 %0, %1, %2" : "=v"(r) : "v"(lo), "v"(hi)); return r; }

struct EpiBf16 {
    static constexpr bool PERM = true, AFTER_DRAIN = false;
    bf16_t* O; int ldc;
    __device__ __forceinline__ void operator()(const f32x4 (&acc)[2][2][4][2], const Unit& u, int wr, int wc, int fr, int fq) const {
        const int row0 = u.pm * BM + wr * 64 + fr; const int col0 = u.pn * BM + wc * 32 + 8 * fq;
#pragma unroll
        for (int ai = 0; ai < 2; ++ai)
#pragma unroll
            for (int m = 0; m < 4; ++m) { bf16_t* rowp = O + (size_t)(row0 + ai * HALF + m * 16) * ldc + col0;
#pragma unroll
                for (int bj = 0; bj < 2; ++bj) { const f32x4 v0 = acc[ai][bj][m][0], v1 = acc[ai][bj][m][1];
                    u32x4 w; w.x = cvt_pk_bf16(v0[0], v0[1]); w.y = cvt_pk_bf16(v0[2], v0[3]); w.z = cvt_pk_bf16(v1[0], v1[1]); w.w = cvt_pk_bf16(v1[2], v1[3]);
                    *(u32x4*)(rowp + bj * HALF) = w; } }
    }
};
struct EpiF32 {
    static constexpr bool PERM = false, AFTER_DRAIN = false;
    float* O; int ldc;
    __device__ __forceinline__ void operator()(const f32x4 (&acc)[2][2][4][2], const Unit& u, int wr, int wc, int fr, int fq) const {
        const int row0 = u.pm * BM + wr * 64 + fr; const int col0 = u.pn * BM + wc * 32 + 4 * fq;
#pragma unroll
        for (int ai = 0; ai < 2; ++ai)
#pragma unroll
            for (int m = 0; m < 4; ++m) { float* rowp = O + (size_t)(row0 + ai * HALF + m * 16) * ldc + col0;
#pragma unroll
                for (int bj = 0; bj < 2; ++bj)
#pragma unroll
                    for (int n = 0; n < 2; ++n) *(f32x4*)(rowp + bj * HALF + n * 16) = acc[ai][bj][m][n]; }
    }
};
struct EpiRes {
    static constexpr bool PERM = false, AFTER_DRAIN = false;
    const float* src_lat; const float* src_ctx; float* dst_lat; float* dst_ctx; const float* gate;
    __device__ __forceinline__ void operator()(const f32x4 (&acc)[2][2][4][2], const Unit& u, int wr, int wc, int fr, int fq) const {
        const bool isc = u.pm >= 64; const int smp = isc ? 2 : (u.pm >> 5);
        const int prow = (isc ? (u.pm - 64) * BM : u.pm * BM) + wr * 64 + fr;
        const float* src = isc ? src_ctx : src_lat; float* dst = isc ? dst_ctx : dst_lat;
        const float* gt = gate + smp * 6144 + 2048;
        const int col0 = u.pn * BM + wc * 32 + 4 * fq;
        f32x4 gv[2][2];
#pragma unroll
        for (int bj = 0; bj < 2; ++bj)
#pragma unroll
            for (int n = 0; n < 2; ++n) gv[bj][n] = *(const f32x4*)(gt + col0 + bj * HALF + n * 16);
#pragma unroll
        for (int ai = 0; ai < 2; ++ai)
#pragma unroll
            for (int m = 0; m < 4; ++m) { const size_t off = (size_t)(prow + ai * HALF + m * 16) * 1024 + col0;
#pragma unroll
                for (int bj = 0; bj < 2; ++bj)
#pragma unroll
                    for (int n = 0; n < 2; ++n) { const f32x4 s = *(const f32x4*)(src + off + bj * HALF + n * 16);
                        *(f32x4*)(dst + off + bj * HALF + n * 16) = s + gv[bj][n] * acc[ai][bj][m][n]; } }
    }
};

template <class Epi, class Sched, bool ALIGN_EPI = false, bool SP2 = false>
__device__ __forceinline__ void gemm_phase(PG8_LAS unsigned char* lds, const Gemm g, const Sched& S, const Epi& E, const int tid) {
    const int wid = __builtin_amdgcn_readfirstlane(tid >> 6), lane = tid & 63, wr = wid >> 2, wc = wid & 3, fr = lane & 15, fq = lane >> 4;
    const int K = g.K, nt = K / BK;
    unsigned voffA[2], voffB[2];
#pragma unroll
    for (int i = 0; i < 2; ++i) { int R, C; stage_rc(tid * 16 + i * 8192, R, C); const int Rb = Epi::PERM ? ((R & ~31) + perm32(R & 31)) : R;
        voffA[i] = (unsigned)(R * K + C) * 2u; voffB[i] = (unsigned)(Rb * K + C) * 2u; }
    const size_t kstep = (size_t)(BK * 2);
    const size_t hstep = (size_t)HALF * K * 2;
    const size_t tstep = 2 * hstep;
    const unsigned ldsw = (unsigned)wid * 1024u;
    const int aoff = lds_byte(wr * 64 + fr, fq * 8), boff = lds_byte(wc * 32 + fr, fq * 8);
#define PG8_SA(b, h) (((b) * 2 + (h)) * HTB)
#define PG8_SB(b, h) ((4 + (b) * 2 + (h)) * HTB)
#define PG8_STAGE(bufoff, gbase, voff) do { _Pragma("unroll") for (int _i = 0; _i < 2; ++_i) \
        __builtin_amdgcn_global_load_lds((const unsigned*)((const char*)(gbase) + (voff)[_i]), (PG8_LAS unsigned*)(lds + (bufoff) + ldsw + _i * 8192), 16, 0, 0); } while (0)
#define PG8_LDA(dst, b, h) do { _Pragma("unroll") for (int m = 0; m < 4; ++m) _Pragma("unroll") for (int k = 0; k < 2; ++k) dst[m][k] = *(const PG8_LAS bf16x8*)(lds + PG8_SA(b, h) + aoff + m * 2048 + k * 1024); } while (0)
#define PG8_LDB(dst, b, h) do { _Pragma("unroll") for (int n = 0; n < 2; ++n) _Pragma("unroll") for (int k = 0; k < 2; ++k) dst[n][k] = *(const PG8_LAS bf16x8*)(lds + PG8_SB(b, h) + boff + n * 2048 + k * 1024); } while (0)
#define PG8_MMA(ai, bj, At, Bt) do { __builtin_amdgcn_s_setprio(1); _Pragma("unroll") for (int m = 0; m < 4; ++m) _Pragma("unroll") for (int n = 0; n < 2; ++n) _Pragma("unroll") for (int k = 0; k < 2; ++k) \
        acc[ai][bj][m][n] = __builtin_amdgcn_mfma_f32_16x16x32_bf16(Bt[n][k], At[m][k], acc[ai][bj][m][n], 0, 0, 0); __builtin_amdgcn_s_setprio(0); } while (0)
#define PG8_WAIT_V(n) asm volatile("s_waitcnt vmcnt(" #n ")" ::: "memory")
#define PG8_WAIT_L(n) asm volatile("s_waitcnt lgkmcnt(" #n ")" ::: "memory")
#define PG8_BAR __builtin_amdgcn_s_barrier()
#define PG8_SCHED __builtin_amdgcn_sched_barrier(0)
    Unit cur, nxt; int ui = 0;
    if (!S.next(0, cur)) return;
    f32x4 acc[2][2][4][2];
#pragma unroll
    for (int a = 0; a < 2; ++a)
#pragma unroll
        for (int b = 0; b < 2; ++b)
#pragma unroll
            for (int m = 0; m < 4; ++m)
#pragma unroll
                for (int n = 0; n < 2; ++n) acc[a][b][m][n] = (f32x4){0.f, 0.f, 0.f, 0.f};
    bf16x8 At[4][2], B0[2][2], B1[2][2];
    const char* cA = (const char*)g.A + (size_t)cur.pm * tstep; const char* cB = (const char*)g.Bt + (size_t)cur.pn * tstep;
    S.a_ready(cur);
    if constexpr (SP2) {
        PG8_STAGE(PG8_SB(0, 0), cB, voffB); PG8_STAGE(PG8_SB(0, 1), cB + hstep, voffB); PG8_STAGE(PG8_SA(0, 0), cA, voffA); PG8_STAGE(PG8_SA(0, 1), cA + hstep, voffA);
        if (wr == 1) PG8_BAR;
        PG8_WAIT_V(2); PG8_BAR;
        PG8_STAGE(PG8_SB(1, 0), cB + kstep, voffB); PG8_STAGE(PG8_SA(1, 0), cA + kstep, voffA); PG8_STAGE(PG8_SB(1, 1), cB + hstep + kstep, voffB);
        PG8_WAIT_V(6); PG8_BAR;
    } else {
        PG8_STAGE(PG8_SB(0, 0), cB, voffB); PG8_STAGE(PG8_SA(0, 0), cA, voffA); PG8_STAGE(PG8_SB(0, 1), cB + hstep, voffB); PG8_STAGE(PG8_SA(0, 1), cA + hstep, voffA);
        if (wr == 1) PG8_BAR;
        PG8_WAIT_V(4); PG8_BAR;
        PG8_STAGE(PG8_SB(1, 0), cB + kstep, voffB); PG8_STAGE(PG8_SA(1, 0), cA + kstep, voffA); PG8_STAGE(PG8_SB(1, 1), cB + hstep + kstep, voffB);
        PG8_WAIT_V(6); PG8_BAR;
    }
    for (;;) {
        const bool has_next = S.next(ui + 1, nxt);
        const char* nA = has_next ? (const char*)g.A + (size_t)nxt.pm * tstep : cA; const char* nB = has_next ? (const char*)g.Bt + (size_t)nxt.pn * tstep : cB;
        for (int t = 0; t < nt; t += 2) {
            const bool last = (t == nt - 2);
            const char* a1 = cA + (size_t)(t + 1) * kstep;
            const char* a2 = last ? nA : cA + (size_t)(t + 2) * kstep; const char* b2 = last ? nB : cB + (size_t)(t + 2) * kstep;
            const char* a3 = a2 + kstep; const char* b3 = b2 + kstep;
            if (last && has_next) S.a_ready(nxt);
            if constexpr (SP2) {
            PG8_LDB(B0, 0, 0); PG8_LDB(B1, 0, 1); PG8_SCHED; PG8_LDA(At, 0, 0); PG8_STAGE(PG8_SA(1, 1), a1 + hstep, voffA);
            PG8_WAIT_V(8); PG8_WAIT_L(0); PG8_BAR; PG8_MMA(0, 0, At, B0); PG8_MMA(0, 1, At, B1); PG8_BAR; PG8_SCHED;
            PG8_LDA(At, 0, 1); PG8_STAGE(PG8_SB(0, 0), b2, voffB); PG8_STAGE(PG8_SB(0, 1), b2 + hstep, voffB); PG8_STAGE(PG8_SA(0, 0), a2, voffA);
            PG8_WAIT_V(8); PG8_WAIT_L(0); PG8_BAR; PG8_MMA(1, 0, At, B0); PG8_MMA(1, 1, At, B1); PG8_BAR; PG8_SCHED;
            PG8_LDB(B0, 1, 0); PG8_LDB(B1, 1, 1); PG8_SCHED; PG8_LDA(At, 1, 0); PG8_STAGE(PG8_SA(0, 1), a2 + hstep, voffA);
            PG8_WAIT_V(8); PG8_WAIT_L(0); PG8_BAR; PG8_MMA(0, 0, At, B0); PG8_MMA(0, 1, At, B1); PG8_BAR; PG8_SCHED;
            PG8_LDA(At, 1, 1); PG8_STAGE(PG8_SB(1, 0), b3, voffB); PG8_STAGE(PG8_SB(1, 1), b3 + hstep, voffB); PG8_STAGE(PG8_SA(1, 0), a3, voffA);
            PG8_WAIT_V(8); PG8_WAIT_L(0); PG8_BAR; PG8_MMA(1, 0, At, B0); PG8_MMA(1, 1, At, B1); PG8_BAR; PG8_SCHED;
            } else {
            PG8_LDB(B0, 0, 0); PG8_SCHED; PG8_LDA(At, 0, 0); PG8_STAGE(PG8_SA(1, 1), a1 + hstep, voffA);
            PG8_WAIT_L(8); PG8_BAR; PG8_WAIT_L(0); PG8_MMA(0, 0, At, B0); PG8_BAR; PG8_SCHED;
            PG8_LDB(B1, 0, 1); PG8_STAGE(PG8_SB(0, 0), b2, voffB);
            PG8_BAR; PG8_WAIT_L(0); PG8_MMA(0, 1, At, B1); PG8_BAR;
            PG8_LDA(At, 0, 1); PG8_STAGE(PG8_SA(0, 0), a2, voffA);
            PG8_BAR; PG8_WAIT_L(0); PG8_MMA(1, 0, At, B0); PG8_BAR; PG8_SCHED;
            PG8_STAGE(PG8_SB(0, 1), b2 + hstep, voffB);
            PG8_WAIT_V(6); PG8_BAR; PG8_MMA(1, 1, At, B1); PG8_BAR;
            PG8_LDB(B0, 1, 0); PG8_SCHED; PG8_LDA(At, 1, 0); PG8_STAGE(PG8_SA(0, 1), a2 + hstep, voffA);
            PG8_WAIT_L(8); PG8_BAR; PG8_WAIT_L(0); PG8_MMA(0, 0, At, B0); PG8_BAR; PG8_SCHED;
            PG8_LDB(B1, 1, 1); PG8_STAGE(PG8_SB(1, 0), b3, voffB);
            PG8_BAR; PG8_WAIT_L(0); PG8_MMA(0, 1, At, B1); PG8_BAR;
            PG8_LDA(At, 1, 1); PG8_STAGE(PG8_SA(1, 0), a3, voffA);
            PG8_BAR; PG8_WAIT_L(0); PG8_MMA(1, 0, At, B0); PG8_BAR; PG8_SCHED;
            PG8_STAGE(PG8_SB(1, 1), b3 + hstep, voffB);
            PG8_WAIT_V(6); PG8_BAR; PG8_MMA(1, 1, At, B1); PG8_BAR;
            }
        }
        if constexpr (ALIGN_EPI) { if (wr == 0) PG8_BAR; }
        if constexpr (!Epi::AFTER_DRAIN) { E(acc, cur, wr, wc, fr, fq); S.done(cur); }
        if (!has_next) break;
#pragma unroll
        for (int a = 0; a < 2; ++a)
#pragma unroll
            for (int b = 0; b < 2; ++b)
#pragma unroll
                for (int m = 0; m < 4; ++m)
#pragma unroll
                    for (int n = 0; n < 2; ++n) acc[a][b][m][n] = (f32x4){0.f, 0.f, 0.f, 0.f};
        cur = nxt; cA = nA; cB = nB; ++ui;
        if constexpr (ALIGN_EPI) { if (wr == 1) PG8_BAR; }
    }
    PG8_WAIT_V(0);
    if constexpr (!ALIGN_EPI) { if (wr == 0) PG8_BAR; }
    PG8_BAR;
    if constexpr (Epi::AFTER_DRAIN) { E.fused(acc, cur, wr, wc, fr, fq, lds, wid, lane); S.done(cur); }
#undef PG8_SA
#undef PG8_SB
#undef PG8_STAGE
#undef PG8_LDA
#undef PG8_LDB
#undef PG8_MMA
#undef PG8_WAIT_V
#undef PG8_WAIT_L
#undef PG8_BAR
#undef PG8_SCHED
}
}
#ifndef ZMASK
#define ZMASK 0
#endif
#define ZF(bit) ((ZMASK & (bit)) ? 0.f : 1.f)
using pg8::bf16_t; using pg8::bf16x8; using pg8::f32x4; using pg8::u32x4;
constexpr int NWAVES = 8, NTHR = 512;
constexpr int DM = 1024, TLAT = 8192, TCTX = 256, MLAT = 2 * TLAT, MCTX = 2 * TCTX, MALL = MLAT + MCTX;
constexpr int DIN = 3152, DINP = 3328;
constexpr int C_CH = 0, C_CB = 256, C_CC = 512, C_RR = 768, C_RK = 1024, C_RV = 1280, C_XW = 1536, C_XA = 1552, C_XG = 1568,
              C_AQ = 1600, C_AK = 1856, C_AV = 1984, C_MQ = 2112, C_MK = 2368, C_MV = 2624, C_MO = 2880, C_MG = 3136;
constexpr float EPSN = 1e-6f;
constexpr int NCHK = 66;
constexpr int CST = 4160;
constexpr int RWREC = 4608;
constexpr size_t MiB = 1u << 20;
constexpr size_t WS_CTL = 0, CTL_ZERO_BYTES = 1 * MiB, WS_MOD = 1 * MiB;
constexpr size_t WS_WIN = 2 * MiB, WIN_LSTRIDE = (size_t)DINP * DM * 2;
constexpr size_t WS_WOUT = 16 * MiB, WOUT_LSTRIDE = 2 * MiB;
constexpr size_t WS_WEFF = 20 * MiB, WEFF_LSTRIDE = 4 * MiB;
constexpr size_t WS_XC = 28 * MiB, WS_GA = 30 * MiB, WS_H = 32 * MiB, WS_YCAT = 65 * MiB, WS_U = 98 * MiB, WS_V = 130 * MiB;
constexpr size_t WS_P = 162 * MiB, WS_RW = 270 * MiB, WS_YR = 345 * MiB, WS_QA = 378 * MiB, WS_KA = 387 * MiB;
constexpr size_t WS_LC = 392 * MiB, WS_ST = 409 * MiB, WS_LB = 426 * MiB, WS_EG = 427 * MiB, WS_GB = 444 * MiB, WS_BS = 453 * MiB, WS_SC = 453 * MiB + 512 * 1024, WS_END = 454 * MiB;
constexpr size_t UV_LSTRIDE = 16 * MiB;
constexpr size_t WS_S = WS_P;
static_assert(WS_P + (size_t)MALL * DINP * 2 <= WS_RW && WS_RW + (size_t)MALL * RWREC <= WS_YR && WS_S + (size_t)MALL * 2048 * 4 <= WS_YR, "ws map");
static_assert(WS_LC + (size_t)16 * NCHK * CST * 4 <= WS_ST && WS_ST + (size_t)16 * NCHK * CST * 4 <= WS_LB && WS_EG + (size_t)MALL * 128 * 8 <= WS_GB, "ws map 2");
constexpr int CW_BAR = 4096;
constexpr int RING_BYTES = 131072, LDSCTL_OFF = RING_BYTES, MISC_OFF = LDSCTL_OFF + 320, LDS_BYTES = 147456;

#define GAS __attribute__((address_space(1)))
#define LAS __attribute__((address_space(3)))
typedef unsigned u32x2 __attribute__((ext_vector_type(2)));
typedef float f32x2 __attribute__((ext_vector_type(2)));
typedef __bf16 bf16x2_t __attribute__((ext_vector_type(2)));
typedef GAS unsigned gu32;
#define LDS_WAIT() asm volatile("s_waitcnt lgkmcnt(0)" ::: "memory")

__device__ __forceinline__ float lo2f(unsigned w) { return __uint_as_float(w << 16); }
__device__ __forceinline__ float hi2f(unsigned w) { return __uint_as_float(w & 0xffff0000u); }
__device__ __forceinline__ float bf2f(bf16_t b) { return __uint_as_float((unsigned)b << 16); }
__device__ __forceinline__ unsigned f2bf(float f) { unsigned u = __float_as_uint(f); return (u + 0x7fffu + ((u >> 16) & 1u)) >> 16; }
__device__ __forceinline__ unsigned pk2(float lo, float hi) { const f32x2 v = {lo, hi}; const bf16x2_t b = __builtin_convertvector(v, bf16x2_t); return __builtin_bit_cast(unsigned, b); }
__device__ __forceinline__ f32x4 ld4bf(const bf16_t* p) { const u32x2 w = *(const u32x2*)p; return (f32x4){lo2f(w.x), hi2f(w.x), lo2f(w.y), hi2f(w.y)}; }
__device__ __forceinline__ void st4bf(bf16_t* p, f32x4 v) { u32x2 w; w.x = pk2(v[0], v[1]); w.y = pk2(v[2], v[3]); *(u32x2*)p = w; }
__device__ __forceinline__ float sigmoidf_(float x) { return 1.f / (1.f + __expf(-x)); }
__device__ __forceinline__ float tanhf_(float x) { const float e = __expf(-2.f * fabsf(x)); const float t = (1.f - e) / (1.f + e); return x < 0.f ? -t : t; }
template <int CTRL> __device__ __forceinline__ float dppf(float x) { return __int_as_float(__builtin_amdgcn_update_dpp(0, __float_as_int(x), CTRL, 0xf, 0xf, true)); }
__device__ __forceinline__ float red16(float x) { x += dppf<0xB1>(x); x += dppf<0x4E>(x); x += dppf<0x141>(x); x += dppf<0x140>(x); return x; }
__device__ __forceinline__ float wave_sum(float v) {
#pragma unroll
    for (int o = 1; o < 64; o <<= 1) v += __shfl_xor(v, o);
    return v;
}
#define XB_TMO      128
#define XB_XCNT(j)  (256  + 64 * (j))
#define XB_XSUB(j)  (1280 + 64 * (j))
#define XB_XGEN(j)  (2304 + 64 * (j))
#define XB_TOP      3328
#define XB_TOPGEN   3392
#define XCD_BAR_WORDS 3456
#define XB_SPIN_CAP (1u << 18)
#ifndef XB_SLEEP
#define XB_SLEEP 1
#endif

__device__ __forceinline__ unsigned xb_ld(unsigned* p)              { return __hip_atomic_load(p, __ATOMIC_RELAXED, __HIP_MEMORY_SCOPE_AGENT); }
__device__ __forceinline__ unsigned xb_add(unsigned* p, unsigned v) { return __hip_atomic_fetch_add(p, v, __ATOMIC_RELAXED, __HIP_MEMORY_SCOPE_AGENT); }
__device__ __forceinline__ unsigned xb_xcc_id() { return (unsigned)__builtin_amdgcn_s_getreg((3 << 11) | 20) & 0xFu; }
#define XB_SPIN(cond, bar) do { unsigned _sp = 0; while (cond) { __builtin_amdgcn_s_sleep(XB_SLEEP); \
    if ((++_sp & 255u) == 0u) { if (xb_ld(&(bar)[XB_TMO])) break; if (_sp > XB_SPIN_CAP) { atomicAdd(&(bar)[XB_TMO], 1u); break; } } } } while (0)

struct XcdBarrier {
    unsigned* bar; unsigned x;
    volatile LAS unsigned* st;
};

__device__ __forceinline__ XcdBarrier xcd_barrier_post(unsigned* bar, volatile LAS unsigned* st) {
    XcdBarrier b; b.bar = bar; b.x = xb_xcc_id(); b.st = st;
    if (threadIdx.x == 0) (void)xb_add(&bar[XB_XCNT(b.x)], 1u);
    return b;
}
__device__ __forceinline__ void xcd_barrier_complete(unsigned* bar, unsigned x, unsigned& nloc, unsigned& nx) {
    const unsigned G = gridDim.x * gridDim.y * gridDim.z;
    unsigned sum, cnt, mine, sp = 0u;
    for (;;) {
        sum = 0u; cnt = 0u; mine = 0u;
#pragma unroll
        for (unsigned j = 0; j < 16; ++j) { const unsigned c = xb_ld(&bar[XB_XCNT(j)]); sum += c; cnt += (c > 0u) ? 1u : 0u; mine = (j == x) ? c : mine; }
        if (sum == G) break;
        __builtin_amdgcn_s_sleep(1);
        if ((++sp & 255u) == 0u) { if (xb_ld(&bar[XB_TMO])) break; if (sp > XB_SPIN_CAP) { atomicAdd(&bar[XB_TMO], 1u); break; } }
    }
    nloc = mine > 0u ? mine : 1u; nx = cnt > 0u ? cnt : 1u;
}

__device__ __forceinline__ void xcd_barrier(const XcdBarrier& b) {
    asm volatile("s_waitcnt vmcnt(0)" ::: "memory");
    __syncthreads();
    if (threadIdx.x == 0) {
        unsigned* bar = b.bar;
        __builtin_amdgcn_s_waitcnt(0);
        unsigned nloc = b.st[0], nx = b.st[1];
        if (nloc == 0u) { xcd_barrier_complete(bar, b.x, nloc, nx); b.st[0] = nloc; b.st[1] = nx; }
        const unsigned old = xb_add(&bar[XB_XSUB(b.x)], 1u);
        const unsigned gen = old / nloc;
        if (old + 1u == (gen + 1u) * nloc) {
            __builtin_amdgcn_fence(__ATOMIC_RELEASE, "agent");
            asm volatile("s_waitcnt vmcnt(0)" ::: "memory");
            const unsigned og = xb_add(&bar[XB_TOP], 1u);
            const unsigned tg = og / nx;
            if (og + 1u == (tg + 1u) * nx) xb_add(&bar[XB_TOPGEN], 1u);
            else XB_SPIN(xb_ld(&bar[XB_TOPGEN]) == tg, bar);
            __builtin_amdgcn_fence(__ATOMIC_ACQUIRE, "agent");
            xb_add(&bar[XB_XGEN(b.x)], 1u);
            asm volatile("s_waitcnt vmcnt(0)" ::: "memory");
        } else {
            XB_SPIN(xb_ld(&bar[XB_XGEN(b.x)]) == gen, bar);
            __builtin_amdgcn_fence(__ATOMIC_ACQUIRE, "agent");
            asm volatile("s_waitcnt vmcnt(0)" ::: "memory");
        }
    }
    __syncthreads();
}
struct Ctx {
    LAS unsigned char* lds; int tid, lane, wave, vcu, G;
    const float* in[32]; float* out; unsigned char* ws;
};
#define WSP(T, off) ((T*)(F.ws + (off)))

__device__ __forceinline__ void p0_transpose_item(const float* W, int K, int N, bf16_t* WT, LAS float* scr, int item, int lane) {
    const int nblk = (N + 31) / 32, kb = item / nblk, nb = item % nblk, k0 = 64 * kb, n0 = 32 * nb;
    const int nn = n0 + (lane & 31);
#pragma unroll 8
    for (int i = 0; i < 32; ++i) { const int kk = 2 * i + (lane >> 5); scr[kk * 33 + (lane & 31)] = nn < N ? W[(size_t)(k0 + kk) * N + nn] : 0.f; }
    LDS_WAIT(); asm volatile("" ::: "memory");
    const int c = lane & 7;
#pragma unroll
    for (int j = 0; j < 4; ++j) { const int n = (lane >> 3) + 8 * j; const LAS float* s = scr + (8 * c) * 33 + n;
        u32x4 o; o.x = pk2(s[0 * 33], s[1 * 33]); o.y = pk2(s[2 * 33], s[3 * 33]); o.z = pk2(s[4 * 33], s[5 * 33]); o.w = pk2(s[6 * 33], s[7 * 33]);
        *(u32x4*)(WT + (size_t)(n0 + n) * K + k0 + 8 * c) = o; }
    LDS_WAIT(); asm volatile("" ::: "memory");
}
__device__ __forceinline__ void convert_uv(const Ctx& F, int l) {
    const int gw = F.vcu * NWAVES + F.wave, NGW = F.G * NWAVES;
    float* SC = WSP(float, WS_SC) + (size_t)l * 2 * 16384;
    for (int r = gw; r < 2 * 16384; r += NGW) {
        const int tb = r >> 14, row = r & 16383;
        const float* src = (tb ? F.in[31] : F.in[30]) + ((size_t)l * 16384 + row) * 1024 + F.lane * 16;
        f32x4 v[4]; float am = 0.f;
#pragma unroll
        for (int j = 0; j < 4; ++j) { v[j] = *(const f32x4*)(src + 4 * j); am = fmaxf(am, fmaxf(fmaxf(fabsf(v[j][0]), fabsf(v[j][1])), fmaxf(fabsf(v[j][2]), fabsf(v[j][3])))); }
#pragma unroll
        for (int o = 1; o < 64; o <<= 1) am = fmaxf(am, __shfl_xor(am, o));
        const float sc = am > 0.f ? 448.f / am : 1.f;
        u32x4 o4; unsigned ow[4];
#pragma unroll
        for (int j = 0; j < 4; ++j) { int w = __builtin_amdgcn_cvt_pk_fp8_f32(v[j][0] * sc, v[j][1] * sc, 0, false); w = __builtin_amdgcn_cvt_pk_fp8_f32(v[j][2] * sc, v[j][3] * sc, w, true); ow[j] = (unsigned)w; }
        o4 = (u32x4){ow[0], ow[1], ow[2], ow[3]};
        *(u32x4*)(F.ws + (tb ? WS_V : WS_U) + (size_t)l * UV_LSTRIDE + (size_t)row * 1024 + F.lane * 16) = o4;
        if (F.lane == 0) SC[tb * 16384 + row] = am > 0.f ? am * (1.f / 448.f) : 1.f;
    }
}
__device__ __forceinline__ void phase_prologue(const Ctx& F) {
    float* MOD = WSP(float, WS_MOD);
    {
        LAS float* sl = (LAS float*)F.lds; LAS float* red = sl + 3072;
        for (int it = F.vcu; it < 192; it += F.G) {
            const int l = it / 96, n0 = (it % 96) * 64;
            for (int i = F.tid; i < 3072; i += NTHR) { const int s = i >> 10, k = i & 1023; const float c = s < 2 ? F.in[1][s * 1024 + k] : F.in[3][k]; sl[i] = c / (1.f + __expf(-c)); }
            __syncthreads();
            const int c = F.tid & 63, kg = F.tid >> 6;
            const float* W = F.in[4] + (size_t)l * 1024 * 6144 + n0 + c;
            float a0 = 0.f, a1 = 0.f, a2 = 0.f;
#pragma unroll 8
            for (int k = kg * 128; k < kg * 128 + 128; ++k) { const float w = W[(size_t)k * 6144]; a0 += sl[k] * w; a1 += sl[1024 + k] * w; a2 += sl[2048 + k] * w; }
            red[(kg * 3 + 0) * 64 + c] = a0; red[(kg * 3 + 1) * 64 + c] = a1; red[(kg * 3 + 2) * 64 + c] = a2;
            __syncthreads();
            if (F.tid < 192) { const int s = F.tid >> 6, cc = F.tid & 63; float t = F.in[5][l * 6144 + n0 + cc];
#pragma unroll
                for (int g = 0; g < 8; ++g) t += red[(g * 3 + s) * 64 + cc];
                MOD[(l * 3 + s) * 6144 + n0 + cc] = t; }
            __syncthreads();
        }
    }
    {
        LAS float* scr = (LAS float*)(F.lds + F.wave * 16384);
        const int gw = F.vcu * NWAVES + F.wave, NGW = F.G * NWAVES;
        constexpr int I_IN = 16 * 99, I_OUT = 16 * 32, I_L = I_IN + I_OUT;
        for (int it = gw; it < 2 * I_L; it += NGW) {
            const int l = it / I_L; int r = it % I_L;
            if (r < I_IN) p0_transpose_item(F.in[8] + (size_t)l * DM * DIN, DM, DIN, WSP(bf16_t, WS_WIN + l * WIN_LSTRIDE), scr, r, F.lane);
            else p0_transpose_item(F.in[9] + (size_t)l * DM * DM, DM, DM, WSP(bf16_t, WS_WOUT + l * WOUT_LSTRIDE), scr, r - I_IN, F.lane);
        }
        for (int i = F.vcu * NTHR + F.tid; i < 2 * 160 * 128; i += F.G * NTHR) { const int l = i / (160 * 128), r = i % (160 * 128);
            *(u32x4*)(WSP(bf16_t, WS_WIN + l * WIN_LSTRIDE) + (size_t)3168 * DM + (size_t)r * 8) = (u32x4){0u, 0u, 0u, 0u}; }
    }
    __syncthreads();
    {
        LAS float* KEYS = (LAS float*)F.lds; LAS float* WQl = KEYS + 128 * 129;
        for (int it = F.vcu; it < 512; it += F.G) {
            const int l = it >> 8, hh = (it >> 4) & 15, kb = it & 15;
            const float* ksrc = F.in[29] + ((size_t)l * 16 + hh) * 128 * 128;
            for (int i = F.tid; i < 16384; i += NTHR) KEYS[(i >> 7) * 129 + (i & 127)] = ksrc[i];
            const float* wsrc = F.in[28] + (size_t)l * DM * 2048 + (size_t)(kb * 64) * 2048 + hh * 128;
            for (int i = F.tid; i < 64 * 128; i += NTHR) { const int kk = i >> 7, d = i & 127; WQl[d * 68 + kk] = wsrc[(size_t)kk * 2048 + d]; }
            __syncthreads();
            const int key = F.tid & 127, kq = F.tid >> 7;
            float acc[16];
#pragma unroll
            for (int j = 0; j < 16; ++j) acc[j] = 0.f;
#pragma unroll 4
            for (int d = 0; d < 128; ++d) { const float a = KEYS[key * 129 + d]; const LAS f32x4* wq = (const LAS f32x4*)(WQl + d * 68 + kq * 16);
#pragma unroll
                for (int q = 0; q < 4; ++q) { const f32x4 w = wq[q]; acc[4 * q] += a * w[0]; acc[4 * q + 1] += a * w[1]; acc[4 * q + 2] += a * w[2]; acc[4 * q + 3] += a * w[3]; } }
            bf16_t* dst = WSP(bf16_t, WS_WEFF + l * WEFF_LSTRIDE) + (size_t)(hh * 128 + key) * DM + kb * 64 + kq * 16;
            u32x4 o0, o1; o0.x = pk2(acc[0], acc[1]); o0.y = pk2(acc[2], acc[3]); o0.z = pk2(acc[4], acc[5]); o0.w = pk2(acc[6], acc[7]);
            o1.x = pk2(acc[8], acc[9]); o1.y = pk2(acc[10], acc[11]); o1.z = pk2(acc[12], acc[13]); o1.w = pk2(acc[14], acc[15]);
            *(u32x4*)dst = o0; *(u32x4*)(dst + 8) = o1;
            __syncthreads();
        }
    }
    convert_uv(F, 0); convert_uv(F, 1);
}

__device__ __forceinline__ void phase_norm(const Ctx& F, int l, int which, int nrows, const float* xlat, const float* xctx) {
    const float* gain = F.in[6 + which] + l * DM; const float* mod = WSP(float, WS_MOD) + (size_t)l * 3 * 6144;
    const int shoff = which ? 3072 : 0, scoff = which ? 4096 : 1024;
    bf16_t* H = WSP(bf16_t, WS_H);
    const int gw = F.vcu * NWAVES + F.wave, NGW = F.G * NWAVES;
    for (int row = gw; row < nrows; row += NGW) {
        const bool isc = row >= MLAT; const float* src = isc ? xctx + (size_t)(row - MLAT) * DM : xlat + (size_t)row * DM; const int smp = isc ? 2 : (row >> 13);
        const float* mb = mod + smp * 6144;
        f32x4 v[4]; float ss = 0.f;
#pragma unroll
        for (int j = 0; j < 4; ++j) { v[j] = *(const f32x4*)(src + F.lane * 4 + 256 * j); ss += (v[j][0] * v[j][0] + v[j][1] * v[j][1]) + (v[j][2] * v[j][2] + v[j][3] * v[j][3]); }
        const float rs = rsqrtf(wave_sum(ss) * (1.f / DM) + EPSN);
#pragma unroll
        for (int j = 0; j < 4; ++j) { const int c = F.lane * 4 + 256 * j; const f32x4 g = *(const f32x4*)(gain + c), sc = *(const f32x4*)(mb + scoff + c), sh = *(const f32x4*)(mb + shoff + c);
            const f32x4 o = (v[j] * rs * g) * (1.f + sc) + sh; st4bf(H + (size_t)row * DM + c, o); }
    }
}

__device__ __forceinline__ float log_sigmoid_(float x) { return fminf(x, 0.f) - __logf(1.f + __expf(-fabsf(x))); }
__device__ __forceinline__ void phase_prep(const Ctx& F, int l) {
    LAS float* W2s = (LAS float*)F.lds; LAS float* A2s = W2s + 8192; LAS float* G2s = A2s + 8192; LAS float* tsc = G2s + 8192 + F.wave * 64;
    { const float* w2 = F.in[13] + l * 8192; const float* a2 = F.in[15] + l * 8192; const float* g2 = F.in[16] + l * 8192;
      for (int i = F.tid; i < 8192; i += NTHR) { W2s[i] = w2[i]; A2s[i] = a2[i]; G2s[i] = g2[i]; } }
    __syncthreads();
    const bf16_t* P = WSP(bf16_t, WS_P); bf16_t* YC = WSP(bf16_t, WS_YCAT); bf16_t* QA = WSP(bf16_t, WS_QA); bf16_t* KA = WSP(bf16_t, WS_KA);
    unsigned char* RW = WSP(unsigned char, WS_RW); bf16_t* GB = WSP(bf16_t, WS_GB); float* BS = WSP(float, WS_BS); float* GA = WSP(float, WS_GA);
    const int lane = F.lane, c4 = lane * 4, i16 = lane & 15;
    const f32x4 cw0 = *(const f32x4*)(F.in[10] + l * 768 + c4), cw1 = *(const f32x4*)(F.in[10] + l * 768 + 256 + c4), cw2 = *(const f32x4*)(F.in[10] + l * 768 + 512 + c4);
    const f32x4 cg = *(const f32x4*)(F.in[11] + l * 256 + c4);
    const f32x4 qg = *(const f32x4*)(F.in[21] + l * 64 + (c4 & 63)), kg = *(const f32x4*)(F.in[22] + l * 64 + (c4 & 63));
    const f32x4 k_k = *(const f32x4*)(F.in[17] + l * 256 + c4), k_a = *(const f32x4*)(F.in[18] + l * 256 + c4), r_k = *(const f32x4*)(F.in[19] + l * 256 + c4);
    f32x4 w0[2], a0[2];
#pragma unroll
    for (int d = 0; d < 2; ++d) { w0[d] = *(const f32x4*)(F.in[12] + (l * 2 + d) * 256 + c4); a0[d] = *(const f32x4*)(F.in[14] + (l * 2 + d) * 256 + c4); }
    float invf[4];
#pragma unroll
    for (int j = 0; j < 4; ++j) invf[j] = exp2f(-(float)((c4 + j) & 15) * (13.287712379549449f / 16.f));
    const int gw = F.vcu * NWAVES + F.wave, NGW = F.G * NWAVES;
    for (int row = gw; row < MALL; row += NGW) {
        const bool isc = row >= MLAT; const int t = isc ? ((row - MLAT) & 255) : (row & 8191); const int T = isc ? TCTX : TLAT;
        const bf16_t* pr = P + (size_t)row * DINP;
        {
            const f32x4 h1 = ld4bf(pr + C_CH + c4), bg = ld4bf(pr + C_CB + c4), c1 = ld4bf(pr + C_CC + c4);
            f32x4 up = {0.f, 0.f, 0.f, 0.f}, un = {0.f, 0.f, 0.f, 0.f};
            if (t > 0) up = ld4bf(pr - DINP + C_CH + c4) * ld4bf(pr - DINP + C_CC + c4);
            if (t < T - 1) un = ld4bf(pr + DINP + C_CH + c4) * ld4bf(pr + DINP + C_CC + c4);
            const f32x4 y = bg * (cw0 * up + cw1 * (c1 * h1) + cw2 * un);
            const float ss = red16((y[0] * y[0] + y[1] * y[1]) + (y[2] * y[2] + y[3] * y[3]));
            const float rs = rsqrtf(ss * (1.f / 64.f) + EPSN);
            st4bf(YC + (size_t)row * DM + c4, y * rs * cg * ZF(2));
        }
        asm volatile("" ::: "memory");
        {
            const f32x4 q = ld4bf(pr + C_AQ + c4); const f32x4 k = ld4bf(pr + C_AK + (c4 & 127));
            const float qs = red16((q[0] * q[0] + q[1] * q[1]) + (q[2] * q[2] + q[3] * q[3]));
            const float ks = red16((k[0] * k[0] + k[1] * k[1]) + (k[2] * k[2] + k[3] * k[3]));
            f32x4 qn = q * rsqrtf(qs * (1.f / 64.f) + EPSN) * qg, kn = k * rsqrtf(ks * (1.f / 64.f) + EPSN) * kg;
            if (!isc) {
                f32x4 qp, kp;
#pragma unroll
                for (int j = 0; j < 4; ++j) { qp[j] = __shfl_xor(qn[j], 4); kp[j] = __shfl_xor(kn[j], 4); }
                const int d0 = c4 & 63; const float pos = (d0 < 32) ? (float)(t >> 6) : (float)(t & 63); const bool lowh = (d0 & 16) == 0;
#pragma unroll
                for (int j = 0; j < 4; ++j) { const float th = pos * invf[j]; const float cs = __cosf(th), sn = __sinf(th);
                    qn[j] = lowh ? qn[j] * cs - qp[j] * sn : qn[j] * cs + qp[j] * sn; kn[j] = lowh ? kn[j] * cs - kp[j] * sn : kn[j] * cs + kp[j] * sn; }
            }
            st4bf(QA + (size_t)row * 256 + c4, qn * (0.125f * 1.4426950408889634f));
            if (lane < 32) st4bf(KA + (size_t)row * 128 + c4, kn);
        }
        asm volatile("" ::: "memory");
        {
            const f32x4 r = ld4bf(pr + C_RR + c4), k = ld4bf(pr + C_RK + c4);
            { const float xv = bf2f(pr[C_XW + lane]);
              tsc[lane] = lane < 16 ? tanhf_(xv) : (lane < 32 ? xv : sigmoidf_(xv)); }
            const f32x4 kx = k * k_k;
            const float kss = red16((kx[0] * kx[0] + kx[1] * kx[1]) + (kx[2] * kx[2] + kx[3] * kx[3]));
            const f32x4 kk = kx * rsqrtf(kss + EPSN);
            bf16_t* recb = (bf16_t*)(RW + (size_t)row * RWREC); float* recf = (float*)(RW + (size_t)row * RWREC + 2560);
            st4bf(recb + c4, kk);
            f32x4 kdsum = {0.f, 0.f, 0.f, 0.f};
#pragma unroll
            for (int d = 0; d < 2; ++d) {
                f32x4 dw = w0[d], da = a0[d];
#pragma unroll 4
                for (int ii = 0; ii < 16; ++ii) { dw += tsc[ii] * *(const LAS f32x4*)(W2s + (d * 16 + ii) * 256 + c4); da += tsc[16 + ii] * *(const LAS f32x4*)(A2s + (d * 16 + ii) * 256 + c4); }
                f32x4 dec, av;
#pragma unroll
                for (int j = 0; j < 4; ++j) { dec[j] = -0.6065306597126334f * sigmoidf_(dw[j]); av[j] = sigmoidf_(da[j]); }
                const f32x4 kd = k * (1.f + (av - 1.f) * k_a);
                kdsum += kd;
                st4bf(recb + 256 + d * 256 + c4, kk * av);
                st4bf(recb + 768 + d * 256 + c4, kd);
                *(f32x4*)(recf + d * 256 + c4) = dec;
            }
            f32x4 gv = {0.f, 0.f, 0.f, 0.f};
#pragma unroll 4
            for (int ii = 0; ii < 32; ++ii) gv += tsc[32 + ii] * *(const LAS f32x4*)(G2s + ii * 256 + c4);
            st4bf(GB + (size_t)row * 256 + c4, gv);
            const f32x4 bt = r * kdsum * r_k;
            const float bsum = red16((bt[0] + bt[1]) + (bt[2] + bt[3]));
            if (i16 == 0) BS[(size_t)row * 4 + (lane >> 4)] = bsum;
        }
        asm volatile("" ::: "memory");
        if (lane < 16) { const int dir = lane >> 3, gate = (lane >> 2) & 1, hd = lane & 3; const float x = bf2f(pr[C_MG + lane]);
            const float bias = gate ? F.in[26][(l * 2 + dir) * 4 + hd] : F.in[25][(l * 2 + dir) * 4 + hd];
            GA[(size_t)row * 16 + lane] = gate ? log_sigmoid_(x + bias) : (x + bias); }
    }
}
__device__ __forceinline__ int scan_row(int b, int dir, int i) {
    if (i < TCTX) return MLAT + b * TCTX + (dir ? (TCTX - 1 - i) : i);
    const int p = i - TCTX; return b * TLAT + (dir ? (TLAT - 1 - p) : p);
}
__device__ __forceinline__ void rwkv_scan(const Ctx& F, int blk) {
    const int chain = blk >> 2, quarter = blk & 3, b = chain >> 3, head = (chain >> 1) & 3, dir = chain & 1;
    const bool scanner = F.wave < 4;
    const int rowv = (quarter * 4 + (F.wave & 3)) * 4 + (F.lane >> 4), s = F.lane & 15;
    LAS float* buf = (LAS float*)F.lds;
    const bf16_t* P = WSP(bf16_t, WS_P); const unsigned char* RW = WSP(unsigned char, WS_RW); float* YR = WSP(float, WS_YR) + (size_t)dir * MALL * 256;
    const int st = F.tid >> 4, sub = F.tid & 15;
    constexpr int NSTEP = TCTX + TLAT, NCH = NSTEP / 32;
    u32x2 g_kk, g_al, g_kd, g_r, g_v; f32x4 g_w;
#define RW_LOAD(c) do { const int row_ = scan_row(b, dir, (c) * 32 + st); const bf16_t* rb_ = (const bf16_t*)(RW + (size_t)row_ * RWREC) + head * 64 + sub * 4; \
        g_kk = *(const u32x2*)rb_; g_al = *(const u32x2*)(rb_ + 256 + dir * 256); g_kd = *(const u32x2*)(rb_ + 768 + dir * 256); \
        g_w = *(const f32x4*)((const float*)(RW + (size_t)row_ * RWREC + 2560) + dir * 256 + head * 64 + sub * 4); \
        const bf16_t* pp_ = P + (size_t)row_ * DINP + head * 64 + sub * 4; g_r = *(const u32x2*)(pp_ + C_RR); g_v = *(const u32x2*)(pp_ + C_RV); } while (0)
#define RW_STORE(par) do { LAS float* d_ = buf + ((par) * 32 + st) * 384 + sub * 4; \
        *(LAS f32x4*)(d_) = (f32x4){lo2f(g_kk.x), hi2f(g_kk.x), lo2f(g_kk.y), hi2f(g_kk.y)}; *(LAS f32x4*)(d_ + 64) = (f32x4){lo2f(g_al.x), hi2f(g_al.x), lo2f(g_al.y), hi2f(g_al.y)}; \
        *(LAS f32x4*)(d_ + 128) = (f32x4){lo2f(g_kd.x), hi2f(g_kd.x), lo2f(g_kd.y), hi2f(g_kd.y)}; *(LAS f32x4*)(d_ + 192) = g_w; \
        *(LAS f32x4*)(d_ + 256) = (f32x4){lo2f(g_r.x), hi2f(g_r.x), lo2f(g_r.y), hi2f(g_r.y)}; *(LAS f32x4*)(d_ + 320) = (f32x4){lo2f(g_v.x), hi2f(g_v.x), lo2f(g_v.y), hi2f(g_v.y)}; } while (0)
    f32x4 S = {0.f, 0.f, 0.f, 0.f};
    RW_LOAD(0); RW_STORE(0); __syncthreads();
    for (int c = 0; c < NCH; ++c) {
        const int par = c & 1;
        if (c + 1 < NCH) RW_LOAD(c + 1);
        if (scanner) {
        float ykeep = 0.f;
        f32x4 Lkk[3], Lal[3], Lkd[3], Lw[3], Lr[3]; float Lv[3];
#define SC_LD(set, i_) do { const LAS float* d_ = buf + (par * 32 + (i_)) * 384; Lkk[set] = *(const LAS f32x4*)(d_ + s * 4); Lal[set] = *(const LAS f32x4*)(d_ + 64 + s * 4); \
            Lkd[set] = *(const LAS f32x4*)(d_ + 128 + s * 4); Lw[set] = *(const LAS f32x4*)(d_ + 192 + s * 4); Lr[set] = *(const LAS f32x4*)(d_ + 256 + s * 4); Lv[set] = d_[320 + rowv]; } while (0)
        SC_LD(0, 0); SC_LD(1, 1);
#pragma unroll
        for (int i = 0; i < 32; ++i) {
            if (i + 2 < 32) SC_LD((i + 2) % 3, i + 2);
            const f32x4 kk = Lkk[i % 3], al = Lal[i % 3], kd = Lkd[i % 3], w = Lw[i % 3], r = Lr[i % 3]; const float vr = Lv[i % 3];
            const float sa = red16((S[0] * kk[0] + S[1] * kk[1]) + (S[2] * kk[2] + S[3] * kk[3]));
            S = S * w + (vr * kd - sa * al);
            const float y = red16((S[0] * r[0] + S[1] * r[1]) + (S[2] * r[2] + S[3] * r[3]));
            ykeep = (s == (i & 15)) ? y : ykeep;
            if ((i & 15) == 15) {
                const int stp = c * 32 + (i - 15) + s; const int pc = dir ? (TCTX - 1 - stp) : stp, pl = dir ? (TLAT - 1 - (stp - TCTX)) : (stp - TCTX);
                const int row = stp < TCTX ? (MLAT + b * TCTX + pc) : (b * TLAT + pl);
                YR[(size_t)row * 256 + head * 64 + rowv] = ykeep; }
        }
#undef SC_LD
        }
        if (c + 1 < NCH) RW_STORE(par ^ 1);
        __syncthreads();
    }
#undef RW_LOAD
#undef RW_STORE
}

typedef union { u32x4 u; bf16x8 b; } frag_u;
__device__ __forceinline__ void attn_unit(const Ctx& F, int l, int unit) {
    LAS bf16_t* Kl = (LAS bf16_t*)F.lds; LAS bf16_t* Vt = Kl + 64 * 72;
    const bf16_t* P = WSP(bf16_t, WS_P); const bf16_t* QA = WSP(bf16_t, WS_QA); const bf16_t* KA = WSP(bf16_t, WS_KA); bf16_t* YC = WSP(bf16_t, WS_YCAT);
    const bool isc = unit >= 256; int b, kvh, n;
    if (!isc) { b = unit >> 7; kvh = (unit >> 6) & 1; n = unit & 63; } else { const int u = unit - 256; b = u >> 2; kvh = (u >> 1) & 1; n = u & 1; }
    const int g = F.wave >> 2, ps = F.wave & 3, head = kvh * 2 + g, i = F.lane & 15, gq = F.lane >> 4;
    const int qpos0 = n * 128 + ps * 32, qrow0 = (isc ? MLAT + b * TCTX : b * TLAT) + qpos0;
    bf16x8 Qf[2][2];
#pragma unroll
    for (int qb = 0; qb < 2; ++qb)
#pragma unroll
        for (int ks = 0; ks < 2; ++ks) Qf[qb][ks] = *(const bf16x8*)(QA + (size_t)(qrow0 + qb * 16 + i) * 256 + head * 64 + ks * 32 + gq * 8);
    const float sinkl = F.in[23][l * 4 + head] * 1.4426950408889634f;
    float mrun[2] = {sinkl, sinkl}, lsum[2]; lsum[0] = lsum[1] = (gq == 0) ? 1.f : 0.f;
    f32x4 ao[4][2];
#pragma unroll
    for (int db = 0; db < 4; ++db) { ao[db][0] = (f32x4){0.f, 0.f, 0.f, 0.f}; ao[db][1] = (f32x4){0.f, 0.f, 0.f, 0.f}; }
    const int ntl = isc ? 4 : 10;
    const int skey = F.tid >> 3, sch = F.tid & 7;
    for (int tt = 0; tt < ntl; ++tt) {
        int krow0, kpos0 = 0; bool band = false;
        if (!isc && tt < 6) { const int kt = 2 * (n - 1) + tt; if (kt < 0 || kt >= 128) continue; krow0 = b * TLAT + kt * 64; kpos0 = kt * 64; band = true; }
        else { const int c = isc ? tt : tt - 6; krow0 = MLAT + b * TCTX + c * 64; }
        __syncthreads();
        { const u32x4 kv = *(const u32x4*)(KA + (size_t)(krow0 + skey) * 128 + kvh * 64 + sch * 8);
          const u32x4 vv = *(const u32x4*)(P + (size_t)(krow0 + skey) * DINP + C_AV + kvh * 64 + sch * 8);
          *(LAS u32x4*)(Kl + skey * 72 + sch * 8) = kv;
          const unsigned ww[4] = {vv.x, vv.y, vv.z, vv.w};
#pragma unroll
          for (int j = 0; j < 4; ++j) { Vt[(sch * 8 + 2 * j) * 72 + skey] = (bf16_t)(ww[j] & 0xffffu); Vt[(sch * 8 + 2 * j + 1) * 72 + skey] = (bf16_t)(ww[j] >> 16); } }
        __syncthreads();
        f32x4 sc[4][2];
#pragma unroll
        for (int kb = 0; kb < 4; ++kb) {
            sc[kb][0] = (f32x4){0.f, 0.f, 0.f, 0.f}; sc[kb][1] = (f32x4){0.f, 0.f, 0.f, 0.f};
#pragma unroll
            for (int ks = 0; ks < 2; ++ks) { const bf16x8 kf = *(const LAS bf16x8*)(Kl + (kb * 16 + i) * 72 + ks * 32 + gq * 8);
                sc[kb][0] = __builtin_amdgcn_mfma_f32_16x16x32_bf16(kf, Qf[0][ks], sc[kb][0], 0, 0, 0);
                sc[kb][1] = __builtin_amdgcn_mfma_f32_16x16x32_bf16(kf, Qf[1][ks], sc[kb][1], 0, 0, 0); }
        }
#pragma unroll
        for (int qb = 0; qb < 2; ++qb) {
            const int qp = qpos0 + qb * 16 + i;
            float mx = -1e30f;
#pragma unroll
            for (int kb = 0; kb < 4; ++kb)
#pragma unroll
                for (int r = 0; r < 4; ++r) { if (band) { const int dd = (kpos0 + kb * 16 + 4 * gq + r) - qp; if (dd > 128 || dd < -128) sc[kb][qb][r] = -1e30f; } mx = fmaxf(mx, sc[kb][qb][r]); }
            mx = fmaxf(mx, __shfl_xor(mx, 16)); mx = fmaxf(mx, __shfl_xor(mx, 32));
            const float mnew = fmaxf(mrun[qb], mx), alpha = exp2f(mrun[qb] - mnew); mrun[qb] = mnew;
            float ps_ = 0.f;
#pragma unroll
            for (int kb = 0; kb < 4; ++kb)
#pragma unroll
                for (int r = 0; r < 4; ++r) { const float p = exp2f(sc[kb][qb][r] - mnew); sc[kb][qb][r] = p; ps_ += p; }
            lsum[qb] = lsum[qb] * alpha + ps_;
#pragma unroll
            for (int db = 0; db < 4; ++db) ao[db][qb] *= alpha;
        }
#pragma unroll
        for (int ks2 = 0; ks2 < 2; ++ks2) {
            frag_u pf[2];
#pragma unroll
            for (int qb = 0; qb < 2; ++qb) { pf[qb].u.x = pg8::cvt_pk_bf16(sc[2 * ks2][qb][0], sc[2 * ks2][qb][1]); pf[qb].u.y = pg8::cvt_pk_bf16(sc[2 * ks2][qb][2], sc[2 * ks2][qb][3]);
                pf[qb].u.z = pg8::cvt_pk_bf16(sc[2 * ks2 + 1][qb][0], sc[2 * ks2 + 1][qb][1]); pf[qb].u.w = pg8::cvt_pk_bf16(sc[2 * ks2 + 1][qb][2], sc[2 * ks2 + 1][qb][3]); }
#pragma unroll
            for (int db = 0; db < 4; ++db) { frag_u vf; const LAS bf16_t* vp = Vt + (db * 16 + i) * 72 + (2 * ks2) * 16 + 4 * gq;
                const u32x2 v0 = *(const LAS u32x2*)vp, v1 = *(const LAS u32x2*)(vp + 16); vf.u = (u32x4){v0.x, v0.y, v1.x, v1.y};
                ao[db][0] = __builtin_amdgcn_mfma_f32_16x16x32_bf16(vf.b, pf[0].b, ao[db][0], 0, 0, 0);
                ao[db][1] = __builtin_amdgcn_mfma_f32_16x16x32_bf16(vf.b, pf[1].b, ao[db][1], 0, 0, 0); }
        }
    }
    const float* og = F.in[24] + l * 256 + head * 64;
#pragma unroll
    for (int qb = 0; qb < 2; ++qb) {
        float lt = lsum[qb]; lt += __shfl_xor(lt, 16); lt += __shfl_xor(lt, 32);
        const float il = 1.f / lt; float ss = 0.f;
#pragma unroll
        for (int db = 0; db < 4; ++db) { ao[db][qb] *= il; ss += (ao[db][qb][0] * ao[db][qb][0] + ao[db][qb][1] * ao[db][qb][1]) + (ao[db][qb][2] * ao[db][qb][2] + ao[db][qb][3] * ao[db][qb][3]); }
        ss += __shfl_xor(ss, 16); ss += __shfl_xor(ss, 32);
        const float rs = rsqrtf(ss * (1.f / 64.f) + EPSN);
        bf16_t* yo = YC + (size_t)(qrow0 + qb * 16 + i) * DM + 512 + head * 64;
#pragma unroll
        for (int db = 0; db < 4; ++db) { const f32x4 gg = *(const f32x4*)(og + db * 16 + 4 * gq); st4bf(yo + db * 16 + 4 * gq, ao[db][qb] * rs * gg * ZF(8)); }
    }
    __syncthreads();
}

__device__ __forceinline__ int ml_row(int b, int dir, int j, int tp) {
    if (j < 2) { const int p = j * 128 + tp; return MLAT + b * TCTX + (dir ? (TCTX - 1 - p) : p); }
    const int p = (j - 2) * 128 + tp; return b * TLAT + (dir ? (TLAT - 1 - p) : p);
}
__device__ __forceinline__ void scan128_add(float& x0, float& x1, int lane) {
    x1 += x0; float t = x1;
#pragma unroll
    for (int o = 1; o < 64; o <<= 1) { const float u = __shfl_up(t, o); if (lane >= o) t += u; }
    const float ex = t - x1; x0 += ex; x1 = t;
}
__device__ __forceinline__ void scan128_max(float& x0, float& x1, int lane) {
    x1 = fmaxf(x1, x0); float t = x1;
#pragma unroll
    for (int o = 1; o < 64; o <<= 1) { const float u = __shfl_up(t, o); if (lane >= o) t = fmaxf(t, u); }
    const float pv = __shfl_up(t, 1); if (lane > 0) x0 = fmaxf(x0, pv); x1 = t;
}
__device__ __forceinline__ void ml_stage_T(const Ctx& F, const bf16_t* P, int b, int dir, int j, int col0, LAS bf16_t* dst, const LAS float* sw, float cscale) {
#pragma unroll
    for (int it = 0; it < 2; ++it) { const int id = F.tid + it * NTHR, tp = id >> 3, ch = id & 7;
        const u32x4 v = *(const u32x4*)(P + (size_t)ml_row(b, dir, j, tp) * DINP + col0 + ch * 8); const float s = (sw ? sw[tp] : 1.f) * cscale;
        const unsigned ww[4] = {v.x, v.y, v.z, v.w};
#pragma unroll
        for (int q = 0; q < 4; ++q) { dst[(ch * 8 + 2 * q) * 136 + tp] = (bf16_t)f2bf(lo2f(ww[q]) * s); dst[(ch * 8 + 2 * q + 1) * 136 + tp] = (bf16_t)f2bf(hi2f(ww[q]) * s); } }
}
__device__ __forceinline__ void ml_stage_R(const Ctx& F, const bf16_t* P, int b, int dir, int j, int col0, LAS bf16_t* dst, float cscale) {
#pragma unroll
    for (int it = 0; it < 2; ++it) { const int id = F.tid + it * NTHR, tp = id >> 3, ch = id & 7;
        u32x4 v = *(const u32x4*)(P + (size_t)ml_row(b, dir, j, tp) * DINP + col0 + ch * 8);
        if (cscale != 1.f) { v.x = pk2(lo2f(v.x) * cscale, hi2f(v.x) * cscale); v.y = pk2(lo2f(v.y) * cscale, hi2f(v.y) * cscale); v.z = pk2(lo2f(v.z) * cscale, hi2f(v.z) * cscale); v.w = pk2(lo2f(v.w) * cscale, hi2f(v.w) * cscale); }
        *(LAS u32x4*)(dst + tp * 72 + ch * 8) = v; }
}
__device__ __forceinline__ void mlstm_local(const Ctx& F, int task) {
    const int chain = task / NCHK, j = task % NCHK, b = chain >> 3, head = (chain >> 1) & 3, dir = chain & 1;
    const bf16_t* P = WSP(bf16_t, WS_P); const float* GA = WSP(float, WS_GA);
    LAS bf16_t* Vt = (LAS bf16_t*)F.lds; LAS bf16_t* Kt = Vt + 64 * 136; LAS float* wS = (LAS float*)(Kt + 64 * 136); LAS float* sc2 = wS + 128;
    __syncthreads();
    if (F.wave == 0) {
        const int r0 = ml_row(b, dir, j, 2 * F.lane), r1 = ml_row(b, dir, j, 2 * F.lane + 1);
        const float li0 = GA[(size_t)r0 * 16 + dir * 8 + head], li1 = GA[(size_t)r1 * 16 + dir * 8 + head];
        float b0 = GA[(size_t)r0 * 16 + dir * 8 + 4 + head], b1 = GA[(size_t)r1 * 16 + dir * 8 + 4 + head];
        scan128_add(b0, b1, F.lane);
        const float bend = __shfl(b1, 63);
        const float d0 = bend - b0 + li0, d1 = bend - b1 + li1;
        float mx = fmaxf(d0, d1);
#pragma unroll
        for (int o = 1; o < 64; o <<= 1) mx = fmaxf(mx, __shfl_xor(mx, o));
        wS[2 * F.lane] = __expf(d0 - mx); wS[2 * F.lane + 1] = __expf(d1 - mx);
        if (F.lane == 0) { sc2[0] = mx; sc2[1] = bend; }
    }
    __syncthreads();
    ml_stage_T(F, P, b, dir, j, C_MV + head * 64, Vt, wS, 1.f);
    ml_stage_T(F, P, b, dir, j, C_MK + head * 64, Kt, nullptr, 0.125f);
    __syncthreads();
    float* LC = WSP(float, WS_LC) + (size_t)task * CST;
    { const int vb = F.wave >> 1, i = F.lane & 15, gq = F.lane >> 4;
#pragma unroll
      for (int kk2 = 0; kk2 < 2; ++kk2) { const int kb = 2 * (F.wave & 1) + kk2; f32x4 acc = {0.f, 0.f, 0.f, 0.f};
#pragma unroll
          for (int ks = 0; ks < 4; ++ks) { const bf16x8 a = *(const LAS bf16x8*)(Vt + (vb * 16 + i) * 136 + ks * 32 + gq * 8), bb = *(const LAS bf16x8*)(Kt + (kb * 16 + i) * 136 + ks * 32 + gq * 8);
              acc = __builtin_amdgcn_mfma_f32_16x16x32_bf16(a, bb, acc, 0, 0, 0); }
#pragma unroll
          for (int r = 0; r < 4; ++r) LC[(vb * 16 + 4 * gq + r) * 64 + kb * 16 + i] = acc[r]; } }
    if (F.tid < 64) { float a = 0.f;
#pragma unroll 8
        for (int s = 0; s < 128; ++s) a += wS[s] * bf2f(Kt[F.tid * 136 + s]);
        LC[4096 + F.tid] = a; }
    if (F.tid == 0) { float* LB = WSP(float, WS_LB); LB[task * 2] = sc2[0]; LB[task * 2 + 1] = sc2[1]; }
}
__device__ __forceinline__ void mlstm_chain(const Ctx& F, int blk0) {
    const int gt = (F.vcu - blk0) * NTHR + F.tid; if (gt < 0 || gt >= 16 * CST) return;
    const int chain = gt / CST, e = gt % CST;
    const float* LC = WSP(float, WS_LC) + (size_t)chain * NCHK * CST + e; float* ST = WSP(float, WS_ST) + (size_t)chain * NCHK * CST + e;
    const float* LB = WSP(float, WS_LB) + chain * NCHK * 2; float* SM = WSP(float, WS_LB) + 4096 + chain * NCHK;
    float m = 0.f, x = 0.f;
#pragma unroll 1
    for (int g = 0; g < 3; ++g) {
        float d[22], Lv[22], Bv[22];
#pragma unroll
        for (int q = 0; q < 22; ++q) { const int j = g * 22 + q; d[q] = LC[(size_t)j * CST]; Lv[q] = LB[2 * j]; Bv[q] = LB[2 * j + 1]; }
#pragma unroll
        for (int q = 0; q < 22; ++q) { const int j = g * 22 + q;
            ST[(size_t)j * CST] = x; if (e == 0) SM[j] = m;
            const float mn = fmaxf(Bv[q] + m, Lv[q]);
            x = __expf(Bv[q] + m - mn) * x + __expf(Lv[q] - mn) * d[q]; m = mn; }
    }
}
__device__ __forceinline__ void mlstm_out(const Ctx& F, int l, int unit) {
    const bool isc = unit >= 512; int b, chunk, head;
    if (!isc) { b = unit >> 8; chunk = (unit >> 2) & 63; head = unit & 3; } else { const int u = unit - 512; b = u >> 3; chunk = (u >> 2) & 1; head = u & 3; }
    const bf16_t* P = WSP(bf16_t, WS_P); const float* GA = WSP(float, WS_GA); bf16_t* YC = WSP(bf16_t, WS_YCAT);
    LAS bf16_t* Ql = (LAS bf16_t*)F.lds; LAS bf16_t* Kl = Ql + 128 * 72; LAS bf16_t* Vt = Kl + 128 * 72; LAS bf16_t* Cb = Vt + 64 * 136;
    LAS float* nS = (LAS float*)(Cb + 64 * 72); LAS float* aS = nS + 64; LAS float* bS = aS + 128; LAS float* MS = bS + 128; LAS float* Hs = MS + 128;
    const int i = F.lane & 15, gq = F.lane >> 4, w = F.wave;
    for (int dir = 0; dir < 2; ++dir) {
        const int j = isc ? (dir ? 1 - chunk : chunk) : 2 + (dir ? 63 - chunk : chunk);
        const int chain = (b * 4 + head) * 2 + dir;
        const float* ST = WSP(float, WS_ST) + ((size_t)chain * NCHK + j) * CST; const float mprev = WSP(float, WS_LB)[4096 + chain * NCHK + j];
        __syncthreads();
        if (w == 0) {
            const int r0 = ml_row(b, dir, j, 2 * F.lane), r1 = ml_row(b, dir, j, 2 * F.lane + 1);
            const float li0 = GA[(size_t)r0 * 16 + dir * 8 + head], li1 = GA[(size_t)r1 * 16 + dir * 8 + head];
            float b0 = GA[(size_t)r0 * 16 + dir * 8 + 4 + head], b1 = GA[(size_t)r1 * 16 + dir * 8 + 4 + head];
            scan128_add(b0, b1, F.lane);
            const float a0 = li0 - b0, a1 = li1 - b1; float A0 = a0, A1 = a1;
            scan128_max(A0, A1, F.lane);
            aS[2 * F.lane] = a0; aS[2 * F.lane + 1] = a1; bS[2 * F.lane] = b0; bS[2 * F.lane + 1] = b1;
            MS[2 * F.lane] = fmaxf(A0, mprev); MS[2 * F.lane + 1] = fmaxf(A1, mprev);
        }
        ml_stage_R(F, P, b, dir, j, C_MQ + head * 64, Ql, 1.f);
        ml_stage_R(F, P, b, dir, j, C_MK + head * 64, Kl, 0.125f);
        ml_stage_T(F, P, b, dir, j, C_MV + head * 64, Vt, nullptr, 1.f);
        { const f32x4 c0 = *(const f32x4*)(ST + F.tid * 8), c1 = *(const f32x4*)(ST + F.tid * 8 + 4); const int v = F.tid >> 3, k0 = (F.tid & 7) * 8;
          u32x4 o; o.x = pk2(c0[0], c0[1]); o.y = pk2(c0[2], c0[3]); o.z = pk2(c1[0], c1[1]); o.w = pk2(c1[2], c1[3]); *(LAS u32x4*)(Cb + v * 72 + k0) = o;
          if (F.tid < 64) nS[F.tid] = ST[4096 + F.tid]; }
        __syncthreads();
        const int t = 16 * w + i; const float Mt = MS[t], bt = bS[t];
        bf16x8 Qf[2];
#pragma unroll
        for (int ks = 0; ks < 2; ++ks) Qf[ks] = *(const LAS bf16x8*)(Ql + t * 72 + ks * 32 + gq * 8);
        f32x4 sc[8];
#pragma unroll
        for (int sb = 0; sb < 8; ++sb) { sc[sb] = (f32x4){0.f, 0.f, 0.f, 0.f};
            if (sb <= w) {
#pragma unroll
                for (int ks = 0; ks < 2; ++ks) { const bf16x8 kf = *(const LAS bf16x8*)(Kl + (sb * 16 + i) * 72 + ks * 32 + gq * 8); sc[sb] = __builtin_amdgcn_mfma_f32_16x16x32_bf16(kf, Qf[ks], sc[sb], 0, 0, 0); }
#pragma unroll
                for (int r = 0; r < 4; ++r) { const int s = sb * 16 + 4 * gq + r; sc[sb][r] = (s <= t) ? sc[sb][r] * __expf(aS[s] - Mt) : 0.f; }
            } }
        float den = 0.f;
#pragma unroll
        for (int sb = 0; sb < 8; ++sb) den += (sc[sb][0] + sc[sb][1]) + (sc[sb][2] + sc[sb][3]);
        den += __shfl_xor(den, 16); den += __shfl_xor(den, 32);
        f32x4 nm[4], it_[4];
#pragma unroll
        for (int vb = 0; vb < 4; ++vb) { nm[vb] = (f32x4){0.f, 0.f, 0.f, 0.f}; it_[vb] = (f32x4){0.f, 0.f, 0.f, 0.f}; }
#pragma unroll
        for (int ks2 = 0; ks2 < 4; ++ks2) if (2 * ks2 <= w) {
            frag_u pf; pf.u.x = pg8::cvt_pk_bf16(sc[2 * ks2][0], sc[2 * ks2][1]); pf.u.y = pg8::cvt_pk_bf16(sc[2 * ks2][2], sc[2 * ks2][3]);
            pf.u.z = pg8::cvt_pk_bf16(sc[2 * ks2 + 1][0], sc[2 * ks2 + 1][1]); pf.u.w = pg8::cvt_pk_bf16(sc[2 * ks2 + 1][2], sc[2 * ks2 + 1][3]);
#pragma unroll
            for (int vb = 0; vb < 4; ++vb) { frag_u vf; const LAS bf16_t* vp = Vt + (vb * 16 + i) * 136 + (2 * ks2) * 16 + 4 * gq;
                const u32x2 v0 = *(const LAS u32x2*)vp, v1 = *(const LAS u32x2*)(vp + 16); vf.u = (u32x4){v0.x, v0.y, v1.x, v1.y};
                nm[vb] = __builtin_amdgcn_mfma_f32_16x16x32_bf16(vf.b, pf.b, nm[vb], 0, 0, 0); }
        }
#pragma unroll
        for (int vb = 0; vb < 4; ++vb)
#pragma unroll
            for (int ks = 0; ks < 2; ++ks) { const bf16x8 cf = *(const LAS bf16x8*)(Cb + (vb * 16 + i) * 72 + ks * 32 + gq * 8); it_[vb] = __builtin_amdgcn_mfma_f32_16x16x32_bf16(cf, Qf[ks], it_[vb], 0, 0, 0); }
        float nq = 0.f;
#pragma unroll
        for (int c = 0; c < 2; ++c) { const u32x4 qv = *(const LAS u32x4*)(Ql + t * 72 + gq * 16 + c * 8); const unsigned ww[4] = {qv.x, qv.y, qv.z, qv.w};
#pragma unroll
            for (int q = 0; q < 4; ++q) nq += nS[gq * 16 + c * 8 + 2 * q] * lo2f(ww[q]) + nS[gq * 16 + c * 8 + 2 * q + 1] * hi2f(ww[q]); }
        nq += __shfl_xor(nq, 16); nq += __shfl_xor(nq, 32);
        const float wint = __expf(mprev - Mt); den += wint * nq;
        const float dn = 1.f / fmaxf(fabsf(den), __expf(-(bt + Mt)));
        const int torig = dir ? 127 - t : t;
#pragma unroll
        for (int vb = 0; vb < 4; ++vb)
#pragma unroll
            for (int r = 0; r < 4; ++r) { const float hv = (nm[vb][r] + wint * it_[vb][r]) * dn; LAS float* hp = Hs + torig * 65 + vb * 16 + 4 * gq + r; if (dir == 0) *hp = hv; else *hp += hv; }
    }
    __syncthreads();
    {
        const int t = F.tid >> 2, vq = F.tid & 3; const int row = (isc ? MLAT + b * TCTX : b * TLAT) + chunk * 128 + t;
        float hv[16], ss = 0.f;
#pragma unroll
        for (int q = 0; q < 16; ++q) { hv[q] = Hs[t * 65 + vq * 16 + q]; ss += hv[q] * hv[q]; }
        ss += __shfl_xor(ss, 1); ss += __shfl_xor(ss, 2);
        const float rs = rsqrtf(ss * (1.f / 64.f) + EPSN);
        const float* og = F.in[27] + l * 256 + head * 64 + vq * 16; const bf16_t* op = P + (size_t)row * DINP + C_MO + head * 64 + vq * 16;
        const u32x4 o0 = *(const u32x4*)op, o1 = *(const u32x4*)(op + 8); const unsigned ow[8] = {o0.x, o0.y, o0.z, o0.w, o1.x, o1.y, o1.z, o1.w};
        unsigned res[8];
#pragma unroll
        for (int q = 0; q < 8; ++q) { const float y0 = sigmoidf_(lo2f(ow[q])) * hv[2 * q] * rs * og[2 * q], y1 = sigmoidf_(hi2f(ow[q])) * hv[2 * q + 1] * rs * og[2 * q + 1]; res[q] = pk2(y0 * ZF(16), y1 * ZF(16)); }
        bf16_t* yo = YC + (size_t)row * DM + 768 + head * 64 + vq * 16;
        *(u32x4*)yo = (u32x4){res[0], res[1], res[2], res[3]}; *(u32x4*)(yo + 8) = (u32x4){res[4], res[5], res[6], res[7]};
    }
    __syncthreads();
}
__device__ __forceinline__ void rwkv_finish(const Ctx& F, int l, int nrows) {
    const bf16_t* P = WSP(bf16_t, WS_P); const float* YR = WSP(float, WS_YR); const bf16_t* GB = WSP(bf16_t, WS_GB); const float* BS = WSP(float, WS_BS); bf16_t* YC = WSP(bf16_t, WS_YCAT);
    const int c4 = F.lane * 4; const f32x4 lg = *(const f32x4*)(F.in[20] + l * 256 + c4);
    const int gw = F.vcu * NWAVES + F.wave, NGW = F.G * NWAVES;
    for (int row = gw; row < nrows; row += NGW) {
        const f32x4 y = *(const f32x4*)(YR + (size_t)row * 256 + c4) + *(const f32x4*)(YR + (size_t)(MALL + row) * 256 + c4);
        const float ss = red16((y[0] * y[0] + y[1] * y[1]) + (y[2] * y[2] + y[3] * y[3]));
        const float rs = rsqrtf(ss * (1.f / 64.f) + EPSN);
        const f32x4 v = ld4bf(P + (size_t)row * DINP + C_RV + c4), g = ld4bf(GB + (size_t)row * 256 + c4);
        const float bn = BS[(size_t)row * 4 + (F.lane >> 4)];
        st4bf(YC + (size_t)row * DM + 256 + c4, (y * rs * lg * ZF(32) + bn * v * ZF(64)) * g * ZF(4));
    }
}
constexpr int RCH = 132;
constexpr int MP = 72, SLOT = 64 * MP;
constexpr size_t WS_RG = 454 * MiB, RG_TASK = 3 * 8192, WS_SST = WS_RW;
constexpr size_t WS_END2 = 504 * MiB;
static_assert(WS_RG + (size_t)16 * RCH * RG_TASK <= WS_END2 && (size_t)16 * RCH * 8192 <= (size_t)MALL * RWREC, "rwkv chunk ws map");

__device__ __forceinline__ void mm64(const LAS bf16_t* A, const LAS bf16_t* Bt, int w, int lane, f32x4 (&acc)[2]) {
    const int i = lane & 15, gq = lane >> 4, mb = w >> 1, nb0 = 2 * (w & 1);
    acc[0] = (f32x4){0.f, 0.f, 0.f, 0.f}; acc[1] = (f32x4){0.f, 0.f, 0.f, 0.f};
#pragma unroll
    for (int ks = 0; ks < 2; ++ks) { const bf16x8 a = *(const LAS bf16x8*)(A + (mb * 16 + i) * MP + ks * 32 + gq * 8);
#pragma unroll
        for (int q = 0; q < 2; ++q) { const bf16x8 b = *(const LAS bf16x8*)(Bt + ((nb0 + q) * 16 + i) * MP + ks * 32 + gq * 8); acc[q] = __builtin_amdgcn_mfma_f32_16x16x32_bf16(a, b, acc[q], 0, 0, 0); } }
}
__device__ __forceinline__ u32x2 pk4(f32x4 v) { u32x2 o; o.x = pk2(v[0], v[1]); o.y = pk2(v[2], v[3]); return o; }
__device__ __forceinline__ f32x4 up4(u32x2 w) { return (f32x4){lo2f(w.x), hi2f(w.x), lo2f(w.y), hi2f(w.y)}; }

__device__ __forceinline__ void rwkv_chunk_pre(const Ctx& F, int task) {
    const int chain = task / RCH, c = task % RCH, b = chain >> 3, head = (chain >> 1) & 3, dir = chain & 1;
    const bf16_t* P = WSP(bf16_t, WS_P); const unsigned char* RW = WSP(unsigned char, WS_RW);
    LAS bf16_t* L0 = (LAS bf16_t*)F.lds;
#define SL(k) (L0 + (k) * SLOT)
    LAS float* LD = (LAS float*)SL(8);
    LAS float* SEG = (LAS float*)SL(10);
    LAS float* WLs = (LAS float*)SL(14);
    const int w = F.wave, lane = F.lane, i = lane & 15, gq = lane >> 4, mb = w >> 1, nb0 = 2 * (w & 1), m0 = mb * 16 + 4 * gq;
    __syncthreads();
    const int t = F.tid >> 3, ch0 = (F.tid & 7) * 8;
    const int row = scan_row(b, dir, c * 64 + t);
    const bf16_t* rb = (const bf16_t*)(RW + (size_t)row * RWREC) + head * 64 + ch0;
    const u32x4 g_kk = *(const u32x4*)rb, g_al = *(const u32x4*)(rb + 256 + dir * 256), g_kd = *(const u32x4*)(rb + 768 + dir * 256);
    const float* ldp = (const float*)(RW + (size_t)row * RWREC + 2560) + dir * 256 + head * 64 + ch0;
    const f32x4 ld0 = *(const f32x4*)ldp, ld1 = *(const f32x4*)(ldp + 4);
    const bf16_t* pp = P + (size_t)row * DINP + head * 64 + ch0;
    const u32x4 g_r = *(const u32x4*)(pp + C_RR), g_v = *(const u32x4*)(pp + C_RV);
    *(LAS f32x4*)(LD + t * 64 + ch0) = ld0; *(LAS f32x4*)(LD + t * 64 + ch0 + 4) = ld1;
    __syncthreads();
    { const int k = F.tid & 63, seg = F.tid >> 6; float s = 0.f;
#pragma unroll
      for (int j = 0; j < 8; ++j) s += LD[(seg * 8 + j) * 64 + k];
      SEG[seg * 64 + k] = s;
      __syncthreads();
      float off = 0.f;
#pragma unroll
      for (int j = 0; j < 8; ++j) off += (j < seg) ? SEG[j * 64 + k] : 0.f;
#pragma unroll
      for (int j = 0; j < 8; ++j) { off += LD[(seg * 8 + j) * 64 + k]; LD[(seg * 8 + j) * 64 + k] = off; }
    }
    __syncthreads();
    {
        const unsigned kkw[4] = {g_kk.x, g_kk.y, g_kk.z, g_kk.w}, alw[4] = {g_al.x, g_al.y, g_al.z, g_al.w}, kdw[4] = {g_kd.x, g_kd.y, g_kd.z, g_kd.w},
                       rw_[4] = {g_r.x, g_r.y, g_r.z, g_r.w}, vw[4] = {g_v.x, g_v.y, g_v.z, g_v.w};
        float okt[8], oai[8], oki[8], ort[8], oat[8], okb[8];
#pragma unroll
        for (int j = 0; j < 8; ++j) {
            const float cl = LD[t * 64 + ch0 + j], clp = t > 0 ? LD[(t - 1) * 64 + ch0 + j] : 0.f, clL = LD[63 * 64 + ch0 + j];
            const float kkv = (j & 1) ? hi2f(kkw[j >> 1]) : lo2f(kkw[j >> 1]), alv = (j & 1) ? hi2f(alw[j >> 1]) : lo2f(alw[j >> 1]), kdv = (j & 1) ? hi2f(kdw[j >> 1]) : lo2f(kdw[j >> 1]),
                        rv = (j & 1) ? hi2f(rw_[j >> 1]) : lo2f(rw_[j >> 1]);
            const float en = __expf(-cl), eL = __expf(clL - cl);
            okt[j] = kkv * __expf(clp); oai[j] = alv * en; oki[j] = kdv * en; ort[j] = rv * __expf(cl); oat[j] = alv * eL; okb[j] = kdv * eL;
        }
        u32x4 o;
        o = (u32x4){pk2(okt[0], okt[1]), pk2(okt[2], okt[3]), pk2(okt[4], okt[5]), pk2(okt[6], okt[7])}; *(LAS u32x4*)(SL(0) + t * MP + ch0) = o;
        o = (u32x4){pk2(oai[0], oai[1]), pk2(oai[2], oai[3]), pk2(oai[4], oai[5]), pk2(oai[6], oai[7])}; *(LAS u32x4*)(SL(2) + t * MP + ch0) = o;
        o = (u32x4){pk2(oki[0], oki[1]), pk2(oki[2], oki[3]), pk2(oki[4], oki[5]), pk2(oki[6], oki[7])}; *(LAS u32x4*)(SL(3) + t * MP + ch0) = o;
        o = (u32x4){pk2(ort[0], ort[1]), pk2(ort[2], ort[3]), pk2(ort[4], ort[5]), pk2(ort[6], ort[7])}; *(LAS u32x4*)(SL(4) + t * MP + ch0) = o;
#pragma unroll
        for (int j = 0; j < 8; ++j) { SL(1)[(ch0 + j) * MP + t] = (bf16_t)f2bf(okt[j]); SL(5)[(ch0 + j) * MP + t] = (bf16_t)f2bf(oat[j]); SL(6)[(ch0 + j) * MP + t] = (bf16_t)f2bf(okb[j]);
            SL(7)[(ch0 + j) * MP + t] = (bf16_t)(((j & 1) ? (vw[j >> 1] >> 16) : (vw[j >> 1] & 0xffffu))); }
        if (t == 63) {
#pragma unroll
            for (int j = 0; j < 8; ++j) WLs[ch0 + j] = __expf(LD[63 * 64 + ch0 + j]); }
    }
    __syncthreads();
    f32x4 acc[2];
    mm64(SL(0), SL(2), w, lane, acc);
#pragma unroll
    for (int q = 0; q < 2; ++q) { const int n = (nb0 + q) * 16 + i; f32x4 a, ti;
#pragma unroll
        for (int r = 0; r < 4; ++r) { const bool keep = (m0 + r) > n; a[r] = keep ? acc[q][r] : 0.f; ti[r] = ((m0 + r) == n ? 1.f : 0.f) - a[r]; }
#pragma unroll
        for (int r = 0; r < 4; ++r) { SL(8)[(m0 + r) * MP + n] = (bf16_t)f2bf(a[r]); SL(13)[(m0 + r) * MP + n] = (bf16_t)f2bf(ti[r]); }
        *(LAS u32x2*)(SL(9) + n * MP + m0) = pk4(a); }
    mm64(SL(0), SL(3), w, lane, acc);
#pragma unroll
    for (int q = 0; q < 2; ++q) { const int n = (nb0 + q) * 16 + i;
#pragma unroll
        for (int r = 0; r < 4; ++r) SL(10)[(m0 + r) * MP + n] = (bf16_t)f2bf((m0 + r) > n ? acc[q][r] : 0.f); }
    mm64(SL(4), SL(2), w, lane, acc);
#pragma unroll
    for (int q = 0; q < 2; ++q) { const int n = (nb0 + q) * 16 + i;
#pragma unroll
        for (int r = 0; r < 4; ++r) SL(11)[(m0 + r) * MP + n] = (bf16_t)f2bf((m0 + r) >= n ? acc[q][r] : 0.f); }
    mm64(SL(4), SL(3), w, lane, acc);
#pragma unroll
    for (int q = 0; q < 2; ++q) { const int n = (nb0 + q) * 16 + i;
#pragma unroll
        for (int r = 0; r < 4; ++r) SL(12)[(m0 + r) * MP + n] = (bf16_t)f2bf((m0 + r) >= n ? acc[q][r] : 0.f); }
    __syncthreads();
#pragma unroll
    for (int it = 0; it < 5; ++it) {
        LAS bf16_t* Xs = (it & 1) ? SL(2) : SL(8); LAS bf16_t* XsT = (it & 1) ? SL(3) : SL(9);
        LAS bf16_t* Xd = (it & 1) ? SL(8) : SL(2); LAS bf16_t* XdT = (it & 1) ? SL(9) : SL(3);
        LAS bf16_t* Tsrc = (it & 1) ? SL(0) : SL(13); LAS bf16_t* Tdst = (it & 1) ? SL(13) : SL(0);
        mm64(Xs, XsT, w, lane, acc);
#pragma unroll
        for (int q = 0; q < 2; ++q) { const int n = (nb0 + q) * 16 + i;
#pragma unroll
            for (int r = 0; r < 4; ++r) Xd[(m0 + r) * MP + n] = (bf16_t)f2bf(acc[q][r]);
            *(LAS u32x2*)(XdT + n * MP + m0) = pk4(acc[q]); }
        __syncthreads();
        mm64(Tsrc, XdT, w, lane, acc);
#pragma unroll
        for (int q = 0; q < 2; ++q) { const int n = (nb0 + q) * 16 + i;
#pragma unroll
            for (int r = 0; r < 4; ++r) Tdst[(m0 + r) * MP + n] = (bf16_t)f2bf(bf2f(Tsrc[(m0 + r) * MP + n]) + acc[q][r]); }
        __syncthreads();
    }
    LAS bf16_t* Ti = SL(0);
    mm64(Ti, SL(1), w, lane, acc);
#pragma unroll
    for (int q = 0; q < 2; ++q) { const int n = (nb0 + q) * 16 + i; *(LAS u32x2*)(SL(2) + n * MP + m0) = pk4(acc[q]); }
    mm64(SL(10), SL(7), w, lane, acc);
#pragma unroll
    for (int q = 0; q < 2; ++q) { const int n = (nb0 + q) * 16 + i; *(LAS u32x2*)(SL(3) + n * MP + m0) = pk4(acc[q]); }
    __syncthreads();
    mm64(Ti, SL(3), w, lane, acc);
#pragma unroll
    for (int q = 0; q < 2; ++q) { const int n = (nb0 + q) * 16 + i; *(LAS u32x2*)(SL(8) + n * MP + m0) = pk4(acc[q]); }
    __syncthreads();
    bf16_t* RG = (bf16_t*)(F.ws + WS_RG + (size_t)task * RG_TASK);
    f32x4 acc2[2];
    mm64(SL(2), SL(11), w, lane, acc);
#pragma unroll
    for (int q = 0; q < 2; ++q) { const int n = (nb0 + q) * 16 + i; const f32x4 rt = up4(*(const LAS u32x2*)(SL(4) + n * MP + m0)); *(u32x2*)(RG + n * 64 + m0) = pk4(rt - acc[q]); }
    mm64(SL(2), SL(5), w, lane, acc);
#pragma unroll
    for (int q = 0; q < 2; ++q) { const int n = (nb0 + q) * 16 + i; f32x4 g;
#pragma unroll
        for (int r = 0; r < 4; ++r) g[r] = ((m0 + r) == n ? WLs[n] : 0.f) - acc[q][r];
        *(u32x2*)(RG + 4096 + n * 64 + m0) = pk4(g); }
    mm64(SL(6), SL(7), w, lane, acc); mm64(SL(5), SL(8), w, lane, acc2);
#pragma unroll
    for (int q = 0; q < 2; ++q) { const int n = (nb0 + q) * 16 + i; *(u32x2*)(RG + 8192 + n * 64 + m0) = pk4(acc[q] - acc2[q]); }
    mm64(SL(7), SL(12), w, lane, acc); mm64(SL(8), SL(11), w, lane, acc2);
    float* YR = WSP(float, WS_YR) + (size_t)dir * MALL * 256;
#pragma unroll
    for (int q = 0; q < 2; ++q) { const int n = (nb0 + q) * 16 + i; const int rown = scan_row(b, dir, c * 64 + n); *(f32x4*)(YR + (size_t)rown * 256 + head * 64 + m0) = acc[q] - acc2[q]; }
#undef SL
}

__device__ __forceinline__ void rwkv_chain(const Ctx& F, int chain) {
    LAS bf16_t* const L0 = (LAS bf16_t*)F.lds;
    LAS bf16_t* Gl[2] = {L0, L0 + SLOT}; LAS bf16_t* Sl[2] = {L0 + 2 * SLOT, L0 + 3 * SLOT}; LAS bf16_t* Hl[2] = {L0 + 4 * SLOT, L0 + 5 * SLOT};
    const int w = F.wave, lane = F.lane, i = lane & 15, gq = lane >> 4, mb = w >> 1, nb0 = 2 * (w & 1), m0 = mb * 16 + 4 * gq;
    const bf16_t* RGc = (const bf16_t*)(F.ws + WS_RG + (size_t)chain * RCH * RG_TASK); bf16_t* SST = (bf16_t*)(F.ws + WS_SST) + (size_t)chain * RCH * 4096;
    const int gr = F.tid >> 3, gc = (F.tid & 7) * 8, goff = gr * 64 + gc, loff = gr * MP + gc;
    constexpr int RBD = 6, RBU = 66;
    static_assert(RBU % RBD == 0 && RCH % RBU == 0, "ring depth / unroll");
    u32x4 rg[RBD], rh[RBD];
#define RB_LOAD(slot, cc) do { const bf16_t* p_ = RGc + (size_t)((cc) < RCH ? (cc) : RCH - 1) * (RG_TASK / 2); rg[slot] = *(const u32x4*)(p_ + 4096 + goff); rh[slot] = *(const u32x4*)(p_ + 8192 + goff); } while (0)
#pragma unroll
    for (int j = 0; j < RBD; ++j) RB_LOAD(j, j);
    __syncthreads();
    *(LAS u32x4*)(Sl[0] + loff) = (u32x4){0u, 0u, 0u, 0u};
    *(LAS u32x4*)(Gl[0] + loff) = rg[0]; *(LAS u32x4*)(Hl[0] + loff) = rh[0];
    __syncthreads();
#ifdef TPROBE
    const unsigned long long tp0_ = __builtin_amdgcn_s_memrealtime();
#endif
#define RB_STEP(j) do { const int c = c0 + (j); if (c < RCH - 1) { const int par = c & 1; \
        *(u32x4*)(SST + (size_t)c * 4096 + goff) = *(const LAS u32x4*)(Sl[par] + loff);            \
        f32x4 acc[2]; mm64(Gl[par], Sl[par], w, lane, acc); \
        { const f32x4 h0 = up4(*(const LAS u32x2*)(Hl[par] + (nb0 * 16 + i) * MP + m0)), h1 = up4(*(const LAS u32x2*)(Hl[par] + ((nb0 + 1) * 16 + i) * MP + m0)); \
          *(LAS u32x2*)(Sl[par ^ 1] + (nb0 * 16 + i) * MP + m0) = pk4(acc[0] + h0); *(LAS u32x2*)(Sl[par ^ 1] + ((nb0 + 1) * 16 + i) * MP + m0) = pk4(acc[1] + h1); } \
        *(LAS u32x4*)(Gl[par ^ 1] + loff) = rg[((j) + 1) % RBD]; *(LAS u32x4*)(Hl[par ^ 1] + loff) = rh[((j) + 1) % RBD]; \
        RB_LOAD((j) % RBD, c + RBD); \
        asm volatile("s_waitcnt lgkmcnt(0)" ::: "memory"); __builtin_amdgcn_s_barrier(); asm volatile("" ::: "memory"); } } while (0)
#pragma unroll 1
    for (int c0 = 0; c0 < RCH; c0 += RBU) {
#pragma unroll
        for (int j = 0; j < RBU; ++j) RB_STEP(j); }
#undef RB_STEP
#undef RB_LOAD
    *(u32x4*)(SST + (size_t)(RCH - 1) * 4096 + goff) = *(const LAS u32x4*)(Sl[(RCH - 1) & 1] + loff);
#ifdef TPROBE
    if (chain == 0 && F.tid == 0) *(float*)(F.ws + WS_CTL + 65536) = 3000.f * (floorf((float)(__builtin_amdgcn_s_memrealtime() - tp0_) * (1.f / 3000.f)) + 0.5f);
#endif
    __syncthreads();
}

__device__ __forceinline__ void rwkv_out(const Ctx& F, int l, int unit) {
    const bool isc = unit >= 256; int b, chunk; if (!isc) { b = unit >> 7; chunk = unit & 127; } else { const int u = unit - 256; b = u >> 2; chunk = u & 3; }
    LAS bf16_t* Rl = (LAS bf16_t*)F.lds; LAS bf16_t* Sl = Rl + SLOT; LAS float* Ys = (LAS float*)(F.lds + 4 * SLOT * 2);
    const int w = F.wave, lane = F.lane, i = lane & 15, gq = lane >> 4, mb = w >> 1, nb0 = 2 * (w & 1), m0 = mb * 16 + 4 * gq;
    const int row0 = (isc ? MLAT + b * TCTX : b * TLAT) + chunk * 64;
    const int gr = F.tid >> 3, gc = (F.tid & 7) * 8;
#pragma unroll 1
    for (int hd = 0; hd < 8; ++hd) {
        const int head = hd >> 1, dir = hd & 1, chain = (b * 4 + head) * 2 + dir;
        const int cc = isc ? (dir ? 3 - chunk : chunk) : 4 + (dir ? 127 - chunk : chunk);
        const bf16_t* RG = (const bf16_t*)(F.ws + WS_RG + ((size_t)chain * RCH + cc) * RG_TASK); const bf16_t* SS = (const bf16_t*)(F.ws + WS_SST) + ((size_t)chain * RCH + cc) * 4096;
        const float* YR = WSP(float, WS_YR) + (size_t)dir * MALL * 256;
        const u32x4 rv = *(const u32x4*)(RG + gr * 64 + gc), sv = *(const u32x4*)(SS + gr * 64 + gc);
        __syncthreads();
        *(LAS u32x4*)(Rl + gr * MP + gc) = rv; *(LAS u32x4*)(Sl + gr * MP + gc) = sv;
        __syncthreads();
        f32x4 acc[2]; mm64(Sl, Rl, w, lane, acc);
#pragma unroll
        for (int q = 0; q < 2; ++q) { const int n = (nb0 + q) * 16 + i; const int tor = dir ? 63 - n : n;
            const f32x4 yl = *(const f32x4*)(YR + (size_t)(row0 + tor) * 256 + head * 64 + m0);
            LAS f32x4* yp = (LAS f32x4*)(Ys + tor * 260 + head * 64 + m0);
            if (dir == 0) *yp = acc[q] + yl; else *yp = *yp + acc[q] + yl; }
    }
    __syncthreads();
    {
        const bf16_t* P = WSP(bf16_t, WS_P); const bf16_t* GB = WSP(bf16_t, WS_GB); const float* BS = WSP(float, WS_BS); bf16_t* YC = WSP(bf16_t, WS_YCAT);
        const int c4 = lane * 4; const f32x4 lg = *(const f32x4*)(F.in[20] + l * 256 + c4);
#pragma unroll 1
        for (int tt = w; tt < 64; tt += NWAVES) { const int row = row0 + tt;
            const f32x4 y = *(const LAS f32x4*)(Ys + tt * 260 + c4);
            const float ss = red16((y[0] * y[0] + y[1] * y[1]) + (y[2] * y[2] + y[3] * y[3]));
            const float rs = rsqrtf(ss * (1.f / 64.f) + EPSN);
            const f32x4 v = ld4bf(P + (size_t)row * DINP + C_RV + c4), g = ld4bf(GB + (size_t)row * 256 + c4);
            const float bn = BS[(size_t)row * 4 + (lane >> 4)];
            st4bf(YC + (size_t)row * DM + 256 + c4, (y * rs * lg * ZF(32) + bn * v * ZF(64)) * g * ZF(4)); }
    }
    __syncthreads();
}
__device__ __forceinline__ float clr7(float x) { return __uint_as_float(__float_as_uint(x) & 0xFFFFFF80u); }
__device__ __forceinline__ void ins16(float (&L)[16], float p) {
#pragma unroll
    for (int j = 15; j >= 1; --j) L[j] = __builtin_amdgcn_fmed3f(L[j - 1], L[j], p);
    L[0] = fmaxf(L[0], p);
}
__device__ __forceinline__ void peer_topk_task(const float* srow, u32x2* eg) {
    float L0[16], L1[16];
#pragma unroll
    for (int j = 0; j < 16; ++j) { L0[j] = -INFINITY; L1[j] = -INFINITY; }
    for (int i = 0; i < 128; i += 4) {
        const f32x4 a = *(const f32x4*)(srow + i), b = *(const f32x4*)(srow + 128 + i);
#pragma unroll
        for (int q = 0; q < 4; ++q) { ins16(L0, __uint_as_float((__float_as_uint(a[q]) & 0xFFFFFF80u) | (unsigned)(i + q)));
                                      ins16(L1, __uint_as_float((__float_as_uint(b[q]) & 0xFFFFFF80u) | (unsigned)(i + q))); }
    }
    float T[16];
#pragma unroll
    for (int j = 0; j < 16; ++j) T[j] = -INFINITY;
#pragma unroll
    for (int a = 0; a < 16; ++a)
#pragma unroll
        for (int b = 0; b < 16; ++b) if ((a + 1) * (b + 1) <= 16) { const float s = clr7(L0[a]) + clr7(L1[b]);
            ins16(T, __uint_as_float((__float_as_uint(s) & 0xFFFFFF00u) | (unsigned)(a * 16 + b))); }
    float e[16], sum = 0.f; const float mx = __uint_as_float(__float_as_uint(T[0]) & 0xFFFFFF00u);
#pragma unroll
    for (int j = 0; j < 16; ++j) { e[j] = __expf(__uint_as_float(__float_as_uint(T[j]) & 0xFFFFFF00u) - mx); sum += e[j]; }
    const float inv = 1.f / sum;
#pragma unroll
    for (int j = 0; j < 16; ++j) {
        const unsigned ab = __float_as_uint(T[j]) & 0xFFu, a = ab >> 4, b = ab & 15u; unsigned i0 = 0u, i1 = 0u;
#pragma unroll
        for (int q = 0; q < 16; ++q) { i0 = (a == (unsigned)q) ? (__float_as_uint(L0[q]) & 0x7Fu) : i0; i1 = (b == (unsigned)q) ? (__float_as_uint(L1[q]) & 0x7Fu) : i1; }
        eg[j] = (u32x2){i0 * 128u + i1, __float_as_uint(e[j] * inv)};
    }
}
__device__ __forceinline__ float gelu_tanh(float x) { const float u = 0.7978845608028654f * (x + 0.044715f * x * x * x); return 0.5f * x * (1.f + tanhf_(u)); }
__device__ __forceinline__ float dot2bf(unsigned w, unsigned x, float acc) { return __builtin_amdgcn_fdot2_f32_bf16(__builtin_bit_cast(bf16x2_t, w), __builtin_bit_cast(bf16x2_t, x), acc, false); }
__device__ __forceinline__ float wave_total63(float x) {
    x = red16(x);
    x += __int_as_float(__builtin_amdgcn_update_dpp(0, __float_as_int(x), 0x142, 0xa, 0xf, false));
    x += __int_as_float(__builtin_amdgcn_update_dpp(0, __float_as_int(x), 0x143, 0xc, 0xf, false));
    return x;
}
__device__ __forceinline__ void phase_peer(const Ctx& F, int l, int nrows, const float* mod, float* wr_override) {
    const float* S = WSP(float, WS_S); u32x2* EG = WSP(u32x2, WS_EG); const bf16_t* H = WSP(bf16_t, WS_H);
    const unsigned char* U = F.ws + WS_U + (size_t)l * UV_LSTRIDE; const unsigned char* V = F.ws + WS_V + (size_t)l * UV_LSTRIDE;
    const float* USC = WSP(float, WS_SC) + (size_t)l * 2 * 16384; const float* VSC = USC + 16384;
    const int tpb = nrows / F.G, tok0 = F.vcu * tpb;
    for (int task = F.tid; task < tpb * 8; task += NTHR) { const int row = tok0 + (task >> 3), hd = task & 7;
        peer_topk_task(S + (size_t)row * 2048 + hd * 256, EG + (size_t)row * 128 + hd * 16); }
    __threadfence_block(); __syncthreads();
    const int lane = F.lane;
    for (int tk = F.wave; tk < tpb; tk += NWAVES) {
        const int row = tok0 + tk; const bool isc = row >= MLAT; const int smp = isc ? 2 : (row >> 13);
        float* xrow = isc ? WSP(float, WS_XC) + (size_t)(row - MLAT) * DM : F.out + (size_t)row * DM;
        f32x2 hv[8];
        { const u32x4 h0 = *(const u32x4*)(H + (size_t)row * DM + lane * 16), h1 = *(const u32x4*)(H + (size_t)row * DM + lane * 16 + 8);
          const unsigned hw[8] = {h0.x, h0.y, h0.z, h0.w, h1.x, h1.y, h1.z, h1.w};
#pragma unroll
          for (int q = 0; q < 8; ++q) hv[q] = (f32x2){lo2f(hw[q]), hi2f(hw[q])}; }
        const u32x2 eg0 = EG[(size_t)row * 128 + lane], eg1 = EG[(size_t)row * 128 + 64 + lane];
        float act0 = 0.f, act1 = 0.f;
#pragma unroll 1
        for (int grp = 0; grp < 8; ++grp) {
            u32x4 ua[16];
#pragma unroll
            for (int q = 0; q < 16; ++q) { const int ii = grp * 16 + q; const unsigned e = __builtin_amdgcn_readlane(ii < 64 ? eg0.x : eg1.x, ii & 63);
                ua[q] = *(const u32x4*)(U + (size_t)e * 1024 + lane * 16); }
#pragma unroll
            for (int q = 0; q < 16; ++q) { const int ii = grp * 16 + q; const unsigned e = __builtin_amdgcn_readlane(ii < 64 ? eg0.x : eg1.x, ii & 63);
                const unsigned uw[4] = {ua[q].x, ua[q].y, ua[q].z, ua[q].w}; f32x2 d2 = {0.f, 0.f};
#pragma unroll
                for (int j = 0; j < 4; ++j) { d2 += __builtin_amdgcn_cvt_pk_f32_fp8((int)uw[j], false) * hv[2 * j]; d2 += __builtin_amdgcn_cvt_pk_f32_fp8((int)uw[j], true) * hv[2 * j + 1]; }
                const float tot = __int_as_float(__builtin_amdgcn_readlane(__float_as_int(wave_total63(d2.x + d2.y)), 63)) * USC[e];
                if (ii < 64) act0 = (lane == (ii & 63)) ? tot : act0; else act1 = (lane == (ii & 63)) ? tot : act1; }
        }
        const float cf0 = __uint_as_float(eg0.y) * gelu_tanh(act0) * VSC[eg0.x], cf1 = __uint_as_float(eg1.y) * gelu_tanh(act1) * VSC[eg1.x];
        f32x2 ac[8];
#pragma unroll
        for (int q = 0; q < 8; ++q) ac[q] = (f32x2){0.f, 0.f};
#pragma unroll 1
        for (int grp = 0; grp < 8; ++grp) {
            u32x4 va[16];
#pragma unroll
            for (int q = 0; q < 16; ++q) { const int ii = grp * 16 + q; const unsigned e = __builtin_amdgcn_readlane(ii < 64 ? eg0.x : eg1.x, ii & 63);
                va[q] = *(const u32x4*)(V + (size_t)e * 1024 + lane * 16); }
#pragma unroll
            for (int q = 0; q < 16; ++q) { const int ii = grp * 16 + q; const float cf = __int_as_float(__builtin_amdgcn_readlane(__float_as_int(ii < 64 ? cf0 : cf1), ii & 63));
                const unsigned vw[4] = {va[q].x, va[q].y, va[q].z, va[q].w};
#pragma unroll
                for (int j = 0; j < 4; ++j) { ac[2 * j] += cf * __builtin_amdgcn_cvt_pk_f32_fp8((int)vw[j], false); ac[2 * j + 1] += cf * __builtin_amdgcn_cvt_pk_f32_fp8((int)vw[j], true); } }
        }
        float acc[16];
#pragma unroll
        for (int q = 0; q < 8; ++q) { acc[2 * q] = ac[q].x; acc[2 * q + 1] = ac[q].y; }
        const float* gt = mod + smp * 6144 + 5120;
#pragma unroll
        for (int q = 0; q < 4; ++q) { const int c = lane * 16 + q * 4; const f32x4 g = *(const f32x4*)(gt + c), x = *(const f32x4*)(xrow + c);
            f32x4 res_ = x + ZF(1) * g * (f32x4){acc[q * 4], acc[q * 4 + 1], acc[q * 4 + 2], acc[q * 4 + 3]};
#ifdef TPROBE
            if (l == 1) res_ = res_ * (1.f + 1e-5f * *(const float*)(F.ws + WS_CTL + 65536));
#endif
            *(f32x4*)((wr_override ? wr_override + (size_t)row * DM : xrow) + c) = res_; }
    }
}

constexpr int PH_PER_LAYER = 10, N_PHASES = 1 + 2 * PH_PER_LAYER;
struct Args { const float* in[32]; float* out; unsigned char* ws; int ph_lo, ph_hi, li, pad; };
__global__ void __launch_bounds__(NTHR, 2) mk_fwd(Args args) {
    extern __shared__ __attribute__((aligned(16))) unsigned char lds[];
    Ctx F;
    F.lds = (LAS unsigned char*)lds;
    volatile LAS unsigned* MISC = (volatile LAS unsigned*)(F.lds + MISC_OFF);
    F.tid = threadIdx.x; F.lane = F.tid & 63; F.wave = __builtin_amdgcn_readfirstlane(F.tid >> 6);
    F.G = gridDim.x; { const int bx = blockIdx.x; F.vcu = (F.G % 8 == 0) ? (bx % 8) * (F.G / 8) + bx / 8 : bx; }
#pragma unroll
    for (int i = 0; i < 32; ++i) F.in[i] = args.in[i];
    F.out = args.out; F.ws = args.ws;
    for (int u = F.tid; u < (LDS_BYTES - LDSCTL_OFF) / 4; u += NTHR) ((LAS unsigned*)(F.lds + LDSCTL_OFF))[u] = 0u;
    __syncthreads();
    XcdBarrier bar; bar.bar = (unsigned*)(args.ws + WS_CTL) + CW_BAR; bar.x = 0; bar.st = nullptr;
#if !MK_MULTI
    bar = xcd_barrier_post((unsigned*)(args.ws + WS_CTL) + CW_BAR, MISC + 8);
#endif
    const int lo = args.ph_lo, hi = args.ph_hi;
#ifndef KMAX
#define KMAX 1000
#endif
#define IN(k) (lo <= (k) && (k) < hi && (REP_ALL == 1 || ra == REP_ALL - 1 || (k) <= KMAX))
#ifndef REP_PH
#define REP_PH -1
#endif
#define REPS(k) ((REP_PH == (k)) ? 2 : 1)
#define PHCTX Ctx Fp = F; { int t_ = F.tid; asm volatile("" : "+v"(t_)); Fp.tid = t_; Fp.lane = t_ & 63; }
#if MK_MULTI
#define SEAM(k) do { } while (0)
#else
#ifndef BAR_REPS
#define BAR_REPS 1
#endif
#define SEAM(k) do { if (IN(k) && IN((k) + 1)) for (int br_ = 0; br_ < BAR_REPS; ++br_) xcd_barrier(bar); } while (0)
#endif
#ifndef REP_ALL
#define REP_ALL 1
#endif
#pragma unroll 1
    for (int ra = 0; ra < REP_ALL; ++ra) {
    if (ra > 0) xcd_barrier(bar);
    if (IN(0)) { PHCTX; for (int rep = 0; rep < REPS(100); ++rep) phase_prologue(Fp); }
    SEAM(0);
    float* XC = WSP(float, WS_XC);
#pragma unroll 1
    for (int l = 0; l < 2; ++l) {
        const int pb = 1 + l * PH_PER_LAYER;
        const float* xlat = l == 0 ? F.in[0] : F.out; const float* xctx = l == 0 ? F.in[2] : XC;
        const int mrows = l == 0 ? MALL : MLAT;
        const float* mod = WSP(float, WS_MOD) + (size_t)l * 3 * 6144;
        if (IN(pb + 0)) { PHCTX; for (int rep = 0; rep < REPS(0); ++rep) { phase_norm(Fp, l, 0, MALL, xlat, xctx); } }
        SEAM(pb + 0);
        if (IN(pb + 1)) for (int rep = 0; rep < REPS(1); ++rep) { PHCTX; pg8::Gemm g{WSP(bf16_t, WS_H), WSP(bf16_t, WS_WIN + l * WIN_LSTRIDE), MALL, DINP, DM}; pg8::StaticOrder So; So.init(MALL, DINP, F.G, (int)blockIdx.x);
            pg8::EpiBf16 E{WSP(bf16_t, WS_P), DINP}; pg8::gemm_phase<pg8::EpiBf16, pg8::StaticOrder, true, true>(F.lds, g, So, E, Fp.tid); }
        SEAM(pb + 1);
        if (IN(pb + 2)) { PHCTX; for (int rep = 0; rep < REPS(2); ++rep) { phase_prep(Fp, l); __syncthreads(); } }
        SEAM(pb + 2);
        if (IN(pb + 3)) for (int rep = 0; rep < REPS(3); ++rep) {
            const int natt = l == 0 ? 264 : 256, nra = 16 * RCH, nml = 16 * NCHK;
            { PHCTX; for (int task = F.vcu; task < natt; task += F.G) attn_unit(Fp, l, task); }
            { PHCTX; for (int task = (F.vcu + F.G - 8) % F.G; task < nra; task += F.G) rwkv_chunk_pre(Fp, task); }
            { PHCTX; for (int task = (F.vcu + F.G - 72) % F.G; task < nml; task += F.G) mlstm_local(Fp, task); }
        }
        SEAM(pb + 3);
        #ifndef REP_SUB
#define REP_SUB 0
#endif
        if (IN(pb + 4)) { PHCTX; for (int rep = 0; rep < REPS(4); ++rep) { if (F.vcu < 16) { for (int r2 = 0; r2 < (REP_SUB == 1 ? 2 : 1); ++r2) rwkv_chain(Fp, F.vcu); } else { for (int r2 = 0; r2 < (REP_SUB == 2 ? 2 : 1); ++r2) mlstm_chain(Fp, 16); } } }
        SEAM(pb + 4);
        if (IN(pb + 5)) for (int rep = 0; rep < REPS(5); ++rep) { const int nro = l == 0 ? 264 : 256, nun = l == 0 ? 528 : 512;
            { PHCTX; for (int u = F.vcu; u < nro; u += F.G) rwkv_out(Fp, l, u); }
            { PHCTX; for (int u = (F.vcu + F.G - 8) % F.G; u < nun; u += F.G) mlstm_out(Fp, l, u); } }
        SEAM(pb + 5);
        if (IN(pb + 6)) for (int rep = 0; rep < REPS(6); ++rep) { PHCTX; pg8::Gemm g{WSP(bf16_t, WS_YCAT), WSP(bf16_t, WS_WOUT + l * WOUT_LSTRIDE), mrows, DM, DM}; pg8::StaticOrder So; So.init(mrows, DM, F.G, (int)blockIdx.x);
            float* dummy = WSP(float, WS_YR); const bool dm_ = (REPS(6) == 2 && rep == 0); pg8::EpiRes E{xlat, xctx, dm_ ? dummy : F.out, dm_ ? dummy : XC, mod}; pg8::gemm_phase<pg8::EpiRes, pg8::StaticOrder, true, true>(F.lds, g, So, E, Fp.tid); }
        SEAM(pb + 6);
        if (IN(pb + 7)) { PHCTX; for (int rep = 0; rep < REPS(7); ++rep) phase_norm(Fp, l, 1, mrows, F.out, XC); }
        SEAM(pb + 7);
        if (IN(pb + 8)) for (int rep = 0; rep < REPS(8); ++rep) { PHCTX; pg8::Gemm g{WSP(bf16_t, WS_H), WSP(bf16_t, WS_WEFF + l * WEFF_LSTRIDE), mrows, 2048, DM}; pg8::StaticOrder So; So.init(mrows, 2048, F.G, (int)blockIdx.x);
            pg8::EpiF32 E{WSP(float, WS_S), 2048}; pg8::gemm_phase<pg8::EpiF32, pg8::StaticOrder, true, true>(F.lds, g, So, E, Fp.tid); }
        SEAM(pb + 8);
        if (IN(pb + 9)) { PHCTX; for (int rep = 0; rep < REPS(9); ++rep) { phase_peer(Fp, l, mrows, mod, (REPS(9) == 2 && rep == 0) ? WSP(float, WS_YR) : nullptr); __syncthreads(); } }
        SEAM(pb + 9);
    }
    }
#undef IN
#undef SEAM
}

extern "C" void kernel_launch(void* const* d_in, const int* in_sizes, int n_in, void* d_out, int out_size, void* d_ws, size_t ws_size, hipStream_t stream) {
    static int grid = 0;
    if (grid == 0) {
        if (n_in != 32 || out_size != MLAT * DM || ws_size < WS_END2) { fprintf(stderr, "kernel_launch: unexpected shapes: n_in %d out %d ws %zu (need %zu)\n", n_in, out_size, ws_size, (size_t)WS_END2); grid = -1; return; }
        int dev = 0, cus = 0, per_cu = 0;
        if (hipGetDevice(&dev) != hipSuccess || hipDeviceGetAttribute(&cus, hipDeviceAttributeMultiprocessorCount, dev) != hipSuccess) { grid = -1; return; }
        if (hipFuncSetAttribute((const void*)mk_fwd, hipFuncAttributeMaxDynamicSharedMemorySize, LDS_BYTES) != hipSuccess) { fprintf(stderr, "kernel_launch: hipFuncSetAttribute failed\n"); grid = -1; return; }
        if (hipOccupancyMaxActiveBlocksPerMultiprocessor(&per_cu, (const void*)mk_fwd, NTHR, LDS_BYTES) != hipSuccess || per_cu < 1) fprintf(stderr, "kernel_launch: occupancy query reports %d\n", per_cu);
        (void)hipGetLastError();
        grid = cus;
        if (grid != 256) fprintf(stderr, "kernel_launch: grid %d (built for 256 CUs)\n", grid);
    }
    if (grid < 0) return;
    (void)hipMemsetAsync((char*)d_ws + WS_CTL, 0, CTL_ZERO_BYTES, stream);
    Args a{};
    for (int i = 0; i < 32; ++i) a.in[i] = (const float*)d_in[i];
    a.out = (float*)d_out; a.ws = (unsigned char*)d_ws;
#if MK_MULTI
    for (int p = 0; p < N_PHASES; ++p) { a.ph_lo = p; a.ph_hi = p + 1; a.li = p; hipLaunchKernelGGL(mk_fwd, dim3(grid), dim3(NTHR), LDS_BYTES, stream, a); }
#else
    a.ph_lo = 0; a.ph_hi = N_PHASES; a.li = 0;
    hipLaunchKernelGGL(mk_fwd, dim3(grid), dim3(NTHR), LDS_BYTES, stream, a);
#endif
}
```

```cpp
#include <hip/hip_runtime.h>
#include <cstdio>
#include <cstdint>

#ifndef MK_MULTI
#define MK_MULTI 0
#endif
namespace pg8 {
#define PG8_LAS __attribute__((address_space(3)))
typedef unsigned short bf16_t;
typedef short bf16x8 __attribute__((ext_vector_type(8)));
typedef float f32x4 __attribute__((ext_vector_type(4)));
typedef unsigned u32x4 __attribute__((ext_vector_type(4)));
constexpr int BM = 256, BK = 64, HALF = 128, HTB = HALF * BK * 2  , STAGE_BYTES = 8 * HTB, NXCD = 8, WGM = 8;

__host__ __device__ __forceinline__ int lds_byte(int r, int c) { const int st = (r >> 4) * 2 + (c >> 5), rr = r & 15, cc = c & 31, ob = rr * 64 + cc * 2; return st * 1024 + (ob ^ (((ob >> 9) & 1) << 5)); }
__host__ __device__ __forceinline__ void stage_rc(int b, int& R, int& C) { const int st = b / 1024, sb = b % 1024, swz = sb ^ (((sb >> 9) & 1) << 5); R = (st >> 1) * 16 + swz / 64; C = (st & 1) * 32 + (swz % 64) / 2; }
__host__ __device__ __forceinline__ int perm32(int rho) { const int n = rho >> 4, i = rho & 15; return 8 * (i >> 2) + 4 * n + (i & 3); }

struct Unit { int pm, pn; };
struct Gemm { const bf16_t* A; const bf16_t* Bt; int M, N, K; };

struct StaticOrder {
    int nM, nN, nwg, G, c;
    __host__ __device__ void init(int M, int N, int G_, int c_) { nM = M / BM; nN = N / BM; nwg = nM * nN; G = G_; c = c_; }
    __host__ __device__ bool next(int i, Unit& u) const {
        const long L = (long)i * G + c; if (L >= nwg) return false;
        int wgid = (int)L; { const int q = nwg / NXCD, r = nwg % NXCD, xcd = wgid % NXCD, off = wgid / NXCD; wgid = (xcd < r ? xcd * (q + 1) : r * (q + 1) + (xcd - r) * q) + off; }
        const int nig = WGM * nN, gid = wgid / nig, fm = gid * WGM, gsz = (nM - fm) < WGM ? (nM - fm) : WGM;
        u.pm = fm + ((wgid % nig) % gsz); u.pn = (wgid % nig) / gsz; return true;
    }
    __device__ __forceinline__ void a_ready(const Unit&) const {}
    __device__ __forceinline__ void done(const Unit&) const {}
};

__device__ __forceinline__ unsigned cvt_pk_bf16(float lo, float hi) { unsigned r; asm volatile("v_cvt_pk_bf16_f32 %0, %1, %2" : "=v"(r) : "v"(lo), "v"(hi)); return r; }

struct EpiBf16 {
    static constexpr bool PERM = true, AFTER_DRAIN = false;
    bf16_t* O; int ldc;
    __device__ __forceinline__ void operator()(const f32x4 (&acc)[2][2][4][2], const Unit& u, int wr, int wc, int fr, int fq) const {
        const int row0 = u.pm * BM + wr * 64 + fr; const int col0 = u.pn * BM + wc * 32 + 8 * fq;
#pragma unroll
        for (int ai = 0; ai < 2; ++ai)
#pragma unroll
            for (int m = 0; m < 4; ++m) { bf16_t* rowp = O + (size_t)(row0 + ai * HALF + m * 16) * ldc + col0;
#pragma unroll
                for (int bj = 0; bj < 2; ++bj) { const f32x4 v0 = acc[ai][bj][m][0], v1 = acc[ai][bj][m][1];
                    u32x4 w; w.x = cvt_pk_bf16(v0[0], v0[1]); w.y = cvt_pk_bf16(v0[2], v0[3]); w.z = cvt_pk_bf16(v1[0], v1[1]); w.w = cvt_pk_bf16(v1[2], v1[3]);
                    *(u32x4*)(rowp + bj * HALF) = w; } }
    }
};
struct EpiF32 {
    static constexpr bool PERM = false, AFTER_DRAIN = false;
    float* O; int ldr;
    __device__ __forceinline__ void operator()(const f32x4 (&acc)[2][2][4][2], const Unit& u, int wr, int wc, int fr, int fq) const {
        const int row0 = u.pm * BM + wr * 64 + fr; const int col0 = u.pn * BM + wc * 32 + 4 * fq;
#pragma unroll
        for (int ai = 0; ai < 2; ++ai)
#pragma unroll
            for (int m = 0; m < 4; ++m) { const int row = row0 + ai * HALF + m * 16;
#pragma unroll
                for (int bj = 0; bj < 2; ++bj)
#pragma unroll
                    for (int n = 0; n < 2; ++n) { const int cg = (col0 + bj * HALF + n * 16) >> 2; *(f32x4*)(O + ((size_t)cg * ldr + row) * 4) = acc[ai][bj][m][n]; } }
    }
};
struct EpiRes {
    static constexpr bool PERM = false, AFTER_DRAIN = false;
    const float* src_lat; const float* src_ctx; float* dst_lat; float* dst_ctx; const float* gate;
    __device__ __forceinline__ void operator()(const f32x4 (&acc)[2][2][4][2], const Unit& u, int wr, int wc, int fr, int fq) const {
        const bool isc = u.pm >= 64; const int smp = isc ? 2 : (u.pm >> 5);
        const int prow = (isc ? (u.pm - 64) * BM : u.pm * BM) + wr * 64 + fr;
        const float* src = isc ? src_ctx : src_lat; float* dst = isc ? dst_ctx : dst_lat;
        const float* gt = gate + smp * 6144 + 2048;
        const int col0 = u.pn * BM + wc * 32 + 4 * fq;
        f32x4 gv[2][2];
#pragma unroll
        for (int bj = 0; bj < 2; ++bj)
#pragma unroll
            for (int n = 0; n < 2; ++n) gv[bj][n] = *(const f32x4*)(gt + col0 + bj * HALF + n * 16);
#pragma unroll
        for (int ai = 0; ai < 2; ++ai)
#pragma unroll
            for (int m = 0; m < 4; ++m) { const size_t off = (size_t)(prow + ai * HALF + m * 16) * 1024 + col0;
#pragma unroll
                for (int bj = 0; bj < 2; ++bj)
#pragma unroll
                    for (int n = 0; n < 2; ++n) { const f32x4 s = *(const f32x4*)(src + off + bj * HALF + n * 16);
                        *(f32x4*)(dst + off + bj * HALF + n * 16) = s + gv[bj][n] * acc[ai][bj][m][n]; } }
    }
};

template <class Epi, class Sched, bool ALIGN_EPI = false, bool SP2 = false>
__device__ __forceinline__ void gemm_phase(PG8_LAS unsigned char* lds, const Gemm g, const Sched& S, const Epi& E, const int tid) {
    const int wid = __builtin_amdgcn_readfirstlane(tid >> 6), lane = tid & 63, wr = wid >> 2, wc = wid & 3, fr = lane & 15, fq = lane >> 4;
    const int K = g.K, nt = K / BK;
    unsigned voffA[2], voffB[2];
#pragma unroll
    for (int i = 0; i < 2; ++i) { int R, C; stage_rc(tid * 16 + i * 8192, R, C); const int Rb = Epi::PERM ? ((R & ~31) + perm32(R & 31)) : R;
        voffA[i] = (unsigned)(R * K + C) * 2u; voffB[i] = (unsigned)(Rb * K + C) * 2u; }
    const size_t kstep = (size_t)(BK * 2);
    const size_t hstep = (size_t)HALF * K * 2;
    const size_t tstep = 2 * hstep;
    const unsigned ldsw = (unsigned)wid * 1024u;
    const int aoff = lds_byte(wr * 64 + fr, fq * 8), boff = lds_byte(wc * 32 + fr, fq * 8);
#define PG8_SA(b, h) (((b) * 2 + (h)) * HTB)
#define PG8_SB(b, h) ((4 + (b) * 2 + (h)) * HTB)
#define PG8_STAGE(bufoff, gbase, voff) do { _Pragma("unroll") for (int _i = 0; _i < 2; ++_i) \
        __builtin_amdgcn_global_load_lds((const unsigned*)((const char*)(gbase) + (voff)[_i]), (PG8_LAS unsigned*)(lds + (bufoff) + ldsw + _i * 8192), 16, 0, 0); } while (0)
#define PG8_LDA(dst, b, h) do { _Pragma("unroll") for (int m = 0; m < 4; ++m) _Pragma("unroll") for (int k = 0; k < 2; ++k) dst[m][k] = *(const PG8_LAS bf16x8*)(lds + PG8_SA(b, h) + aoff + m * 2048 + k * 1024); } while (0)
#define PG8_LDB(dst, b, h) do { _Pragma("unroll") for (int n = 0; n < 2; ++n) _Pragma("unroll") for (int k = 0; k < 2; ++k) dst[n][k] = *(const PG8_LAS bf16x8*)(lds + PG8_SB(b, h) + boff + n * 2048 + k * 1024); } while (0)
#define PG8_MMA(ai, bj, At, Bt) do { __builtin_amdgcn_s_setprio(1); _Pragma("unroll") for (int m = 0; m < 4; ++m) _Pragma("unroll") for (int n = 0; n < 2; ++n) _Pragma("unroll") for (int k = 0; k < 2; ++k) \
        acc[ai][bj][m][n] = __builtin_amdgcn_mfma_f32_16x16x32_bf16(Bt[n][k], At[m][k], acc[ai][bj][m][n], 0, 0, 0); __builtin_amdgcn_s_setprio(0); } while (0)
#define PG8_WAIT_V(n) asm volatile("s_waitcnt vmcnt(" #n ")" ::: "memory")
#define PG8_WAIT_L(n) asm volatile("s_waitcnt lgkmcnt(" #n ")" ::: "memory")
#define PG8_BAR __builtin_amdgcn_s_barrier()
#define PG8_SCHED __builtin_amdgcn_sched_barrier(0)
    Unit cur, nxt; int ui = 0;
    if (!S.next(0, cur)) return;
    f32x4 acc[2][2][4][2];
#pragma unroll
    for (int a = 0; a < 2; ++a)
#pragma unroll
        for (int b = 0; b < 2; ++b)
#pragma unroll
            for (int m = 0; m < 4; ++m)
#pragma unroll
                for (int n = 0; n < 2; ++n) acc[a][b][m][n] = (f32x4){0.f, 0.f, 0.f, 0.f};
    bf16x8 At[4][2], B0[2][2], B1[2][2];
    const char* cA = (const char*)g.A + (size_t)cur.pm * tstep; const char* cB = (const char*)g.Bt + (size_t)cur.pn * tstep;
    S.a_ready(cur);
    if constexpr (SP2) {
        PG8_STAGE(PG8_SB(0, 0), cB, voffB); PG8_STAGE(PG8_SB(0, 1), cB + hstep, voffB); PG8_STAGE(PG8_SA(0, 0), cA, voffA); PG8_STAGE(PG8_SA(0, 1), cA + hstep, voffA);
        if (wr == 1) PG8_BAR;
        PG8_WAIT_V(2); PG8_BAR;
        PG8_STAGE(PG8_SB(1, 0), cB + kstep, voffB); PG8_STAGE(PG8_SA(1, 0), cA + kstep, voffA); PG8_STAGE(PG8_SB(1, 1), cB + hstep + kstep, voffB);
        PG8_WAIT_V(6); PG8_BAR;
    } else {
        PG8_STAGE(PG8_SB(0, 0), cB, voffB); PG8_STAGE(PG8_SA(0, 0), cA, voffA); PG8_STAGE(PG8_SB(0, 1), cB + hstep, voffB); PG8_STAGE(PG8_SA(0, 1), cA + hstep, voffA);
        if (wr == 1) PG8_BAR;
        PG8_WAIT_V(4); PG8_BAR;
        PG8_STAGE(PG8_SB(1, 0), cB + kstep, voffB); PG8_STAGE(PG8_SA(1, 0), cA + kstep, voffA); PG8_STAGE(PG8_SB(1, 1), cB + hstep + kstep, voffB);
        PG8_WAIT_V(6); PG8_BAR;
    }
    for (;;) {
        const bool has_next = S.next(ui + 1, nxt);
        const char* nA = has_next ? (const char*)g.A + (size_t)nxt.pm * tstep : cA; const char* nB = has_next ? (const char*)g.Bt + (size_t)nxt.pn * tstep : cB;
        for (int t = 0; t < nt; t += 2) {
            const bool last = (t == nt - 2);
            const char* a1 = cA + (size_t)(t + 1) * kstep;
            const char* a2 = last ? nA : cA + (size_t)(t + 2) * kstep; const char* b2 = last ? nB : cB + (size_t)(t + 2) * kstep;
            const char* a3 = a2 + kstep; const char* b3 = b2 + kstep;
            if (last && has_next) S.a_ready(nxt);
            if constexpr (SP2) {
            PG8_LDB(B0, 0, 0); PG8_LDB(B1, 0, 1); PG8_SCHED; PG8_LDA(At, 0, 0); PG8_STAGE(PG8_SA(1, 1), a1 + hstep, voffA);
            PG8_WAIT_V(8); PG8_WAIT_L(0); PG8_BAR; PG8_MMA(0, 0, At, B0); PG8_MMA(0, 1, At, B1); PG8_BAR; PG8_SCHED;
            PG8_LDA(At, 0, 1); PG8_STAGE(PG8_SB(0, 0), b2, voffB); PG8_STAGE(PG8_SB(0, 1), b2 + hstep, voffB); PG8_STAGE(PG8_SA(0, 0), a2, voffA);
            PG8_WAIT_V(8); PG8_WAIT_L(0); PG8_BAR; PG8_MMA(1, 0, At, B0); PG8_MMA(1, 1, At, B1); PG8_BAR; PG8_SCHED;
            PG8_LDB(B0, 1, 0); PG8_LDB(B1, 1, 1); PG8_SCHED; PG8_LDA(At, 1, 0); PG8_STAGE(PG8_SA(0, 1), a2 + hstep, voffA);
            PG8_WAIT_V(8); PG8_WAIT_L(0); PG8_BAR; PG8_MMA(0, 0, At, B0); PG8_MMA(0, 1, At, B1); PG8_BAR; PG8_SCHED;
            PG8_LDA(At, 1, 1); PG8_STAGE(PG8_SB(1, 0), b3, voffB); PG8_STAGE(PG8_SB(1, 1), b3 + hstep, voffB); PG8_STAGE(PG8_SA(1, 0), a3, voffA);
            PG8_WAIT_V(8); PG8_WAIT_L(0); PG8_BAR; PG8_MMA(1, 0, At, B0); PG8_MMA(1, 1, At, B1); PG8_BAR; PG8_SCHED;
            } else {
            PG8_LDB(B0, 0, 0); PG8_SCHED; PG8_LDA(At, 0, 0); PG8_STAGE(PG8_SA(1, 1), a1 + hstep, voffA);
            PG8_WAIT_L(8); PG8_BAR; PG8_WAIT_L(0); PG8_MMA(0, 0, At, B0); PG8_BAR; PG8_SCHED;
            PG8_LDB(B1, 0, 1); PG8_STAGE(PG8_SB(0, 0), b2, voffB);
            PG8_BAR; PG8_WAIT_L(0); PG8_MMA(0, 1, At, B1); PG8_BAR;
            PG8_LDA(At, 0, 1); PG8_STAGE(PG8_SA(0, 0), a2, voffA);
            PG8_BAR; PG8_WAIT_L(0); PG8_MMA(1, 0, At, B0); PG8_BAR; PG8_SCHED;
            PG8_STAGE(PG8_SB(0, 1), b2 + hstep, voffB);
            PG8_WAIT_V(6); PG8_BAR; PG8_MMA(1, 1, At, B1); PG8_BAR;
            PG8_LDB(B0, 1, 0); PG8_SCHED; PG8_LDA(At, 1, 0); PG8_STAGE(PG8_SA(0, 1), a2 + hstep, voffA);
            PG8_WAIT_L(8); PG8_BAR; PG8_WAIT_L(0); PG8_MMA(0, 0, At, B0); PG8_BAR; PG8_SCHED;
            PG8_LDB(B1, 1, 1); PG8_STAGE(PG8_SB(1, 0), b3, voffB);
            PG8_BAR; PG8_WAIT_L(0); PG8_MMA(0, 1, At, B1); PG8_BAR;
            PG8_LDA(At, 1, 1); PG8_STAGE(PG8_SA(1, 0), a3, voffA);
            PG8_BAR; PG8_WAIT_L(0); PG8_MMA(1, 0, At, B0); PG8_BAR; PG8_SCHED;
            PG8_STAGE(PG8_SB(1, 1), b3 + hstep, voffB);
            PG8_WAIT_V(6); PG8_BAR; PG8_MMA(1, 1, At, B1); PG8_BAR;
            }
        }
        if constexpr (ALIGN_EPI) { if (wr == 0) PG8_BAR; }
        if constexpr (!Epi::AFTER_DRAIN) { E(acc, cur, wr, wc, fr, fq); S.done(cur); }
        if (!has_next) break;
#pragma unroll
        for (int a = 0; a < 2; ++a)
#pragma unroll
            for (int b = 0; b < 2; ++b)
#pragma unroll
                for (int m = 0; m < 4; ++m)
#pragma unroll
                    for (int n = 0; n < 2; ++n) acc[a][b][m][n] = (f32x4){0.f, 0.f, 0.f, 0.f};
        cur = nxt; cA = nA; cB = nB; ++ui;
        if constexpr (ALIGN_EPI) { if (wr == 1) PG8_BAR; }
    }
    PG8_WAIT_V(0);
    if constexpr (!ALIGN_EPI) { if (wr == 0) PG8_BAR; }
    PG8_BAR;
    if constexpr (Epi::AFTER_DRAIN) { E.fused(acc, cur, wr, wc, fr, fq, lds, wid, lane); S.done(cur); }
#undef PG8_SA
#undef PG8_SB
#undef PG8_STAGE
#undef PG8_LDA
#undef PG8_LDB
#undef PG8_MMA
#undef PG8_WAIT_V
#undef PG8_WAIT_L
#undef PG8_BAR
#undef PG8_SCHED
}
}
#ifndef ZMASK
#define ZMASK 0
#endif
#define ZF(bit) ((ZMASK & (bit)) ? 0.f : 1.f)
using pg8::bf16_t; using pg8::bf16x8; using pg8::f32x4; using pg8::u32x4;
constexpr int NWAVES = 8, NTHR = 512;
constexpr int DM = 1024, TLAT = 8192, TCTX = 256, MLAT = 2 * TLAT, MCTX = 2 * TCTX, MALL = MLAT + MCTX;
constexpr int DIN = 3152, DINP = 3328;
constexpr int C_CH = 0, C_CB = 256, C_CC = 512, C_RR = 768, C_RK = 1024, C_RV = 1280, C_XW = 1536, C_XA = 1552, C_XG = 1568,
              C_AQ = 1600, C_AK = 1856, C_AV = 1984, C_MQ = 2112, C_MK = 2368, C_MV = 2624, C_MO = 2880, C_MG = 3136;
constexpr float EPSN = 1e-6f;
constexpr int NCHK = 66;
constexpr int CST = 4160;
constexpr int RWREC = 4608;
constexpr size_t MiB = 1u << 20;
constexpr size_t WS_CTL = 0, CTL_ZERO_BYTES = 1 * MiB, WS_MOD = 1 * MiB;
constexpr size_t WS_WIN = 2 * MiB, WIN_LSTRIDE = (size_t)DINP * DM * 2;
constexpr size_t WS_WOUT = 16 * MiB, WOUT_LSTRIDE = 2 * MiB;
constexpr size_t WS_WEFF = 20 * MiB, WEFF_LSTRIDE = 4 * MiB;
constexpr size_t WS_XC = 28 * MiB, WS_GA = 30 * MiB, WS_H = 32 * MiB, WS_YCAT = 65 * MiB, WS_U = 98 * MiB, WS_V = 130 * MiB;
constexpr size_t WS_P = 162 * MiB, WS_RW = 270 * MiB, WS_YR = 345 * MiB, WS_QA = 378 * MiB, WS_KA = 387 * MiB;
constexpr size_t WS_LC = 392 * MiB, WS_ST = 409 * MiB, WS_LB = 426 * MiB, WS_EG = 427 * MiB, WS_GB = 444 * MiB, WS_BS = 453 * MiB, WS_SC = 453 * MiB + 512 * 1024, WS_END = 454 * MiB;
constexpr size_t UV_LSTRIDE = 16 * MiB;
constexpr size_t WS_S = WS_P;
static_assert(WS_P + (size_t)MALL * DINP * 2 <= WS_RW && WS_RW + (size_t)MALL * RWREC <= WS_YR && WS_S + (size_t)MALL * 2048 * 4 <= WS_YR, "ws map");
static_assert(WS_LC + (size_t)16 * NCHK * CST * 4 <= WS_ST && WS_ST + (size_t)16 * NCHK * CST * 4 <= WS_LB && WS_EG + (size_t)MALL * 128 * 8 <= WS_GB, "ws map 2");
constexpr int CW_BAR = 4096;
constexpr int RING_BYTES = 131072, LDSCTL_OFF = RING_BYTES, MISC_OFF = LDSCTL_OFF + 320, LDS_BYTES = 147456;

#define GAS __attribute__((address_space(1)))
#define LAS __attribute__((address_space(3)))
typedef unsigned u32x2 __attribute__((ext_vector_type(2)));
typedef float f32x2 __attribute__((ext_vector_type(2)));
typedef __bf16 bf16x2_t __attribute__((ext_vector_type(2)));
typedef GAS unsigned gu32;
#define LDS_WAIT() asm volatile("s_waitcnt lgkmcnt(0)" ::: "memory")

__device__ __forceinline__ float lo2f(unsigned w) { return __uint_as_float(w << 16); }
__device__ __forceinline__ float hi2f(unsigned w) { return __uint_as_float(w & 0xffff0000u); }
__device__ __forceinline__ float bf2f(bf16_t b) { return __uint_as_float((unsigned)b << 16); }
__device__ __forceinline__ unsigned f2bf(float f) { unsigned u = __float_as_uint(f); return (u + 0x7fffu + ((u >> 16) & 1u)) >> 16; }
__device__ __forceinline__ unsigned pk2(float lo, float hi) { const f32x2 v = {lo, hi}; const bf16x2_t b = __builtin_convertvector(v, bf16x2_t); return __builtin_bit_cast(unsigned, b); }
__device__ __forceinline__ f32x4 ld4bf(const bf16_t* p) { const u32x2 w = *(const u32x2*)p; return (f32x4){lo2f(w.x), hi2f(w.x), lo2f(w.y), hi2f(w.y)}; }
__device__ __forceinline__ void st4bf(bf16_t* p, f32x4 v) { u32x2 w; w.x = pk2(v[0], v[1]); w.y = pk2(v[2], v[3]); *(u32x2*)p = w; }
__device__ __forceinline__ float sigmoidf_(float x) { return 1.f / (1.f + __expf(-x)); }
__device__ __forceinline__ float tanhf_(float x) { const float e = __expf(-2.f * fabsf(x)); const float t = (1.f - e) / (1.f + e); return x < 0.f ? -t : t; }
template <int CTRL> __device__ __forceinline__ float dppf(float x) { return __int_as_float(__builtin_amdgcn_update_dpp(0, __float_as_int(x), CTRL, 0xf, 0xf, true)); }
__device__ __forceinline__ float red16(float x) { x += dppf<0xB1>(x); x += dppf<0x4E>(x); x += dppf<0x141>(x); x += dppf<0x140>(x); return x; }
__device__ __forceinline__ float wave_sum(float v) {
#pragma unroll
    for (int o = 1; o < 64; o <<= 1) v += __shfl_xor(v, o);
    return v;
}
#define XB_TMO      128
#define XB_XCNT(j)  (256  + 64 * (j))
#define XB_XSUB(j)  (1280 + 64 * (j))
#define XB_XGEN(j)  (2304 + 64 * (j))
#define XB_TOP      3328
#define XB_TOPGEN   3392
#define XCD_BAR_WORDS 3456
#define XB_SPIN_CAP (1u << 18)
#ifndef XB_SLEEP
#define XB_SLEEP 1
#endif

__device__ __forceinline__ unsigned xb_ld(unsigned* p)              { return __hip_atomic_load(p, __ATOMIC_RELAXED, __HIP_MEMORY_SCOPE_AGENT); }
__device__ __forceinline__ unsigned xb_add(unsigned* p, unsigned v) { return __hip_atomic_fetch_add(p, v, __ATOMIC_RELAXED, __HIP_MEMORY_SCOPE_AGENT); }
__device__ __forceinline__ unsigned xb_xcc_id() { return (unsigned)__builtin_amdgcn_s_getreg((3 << 11) | 20) & 0xFu; }
#define XB_SPIN(cond, bar) do { unsigned _sp = 0; while (cond) { __builtin_amdgcn_s_sleep(XB_SLEEP); \
    if ((++_sp & 255u) == 0u) { if (xb_ld(&(bar)[XB_TMO])) break; if (_sp > XB_SPIN_CAP) { atomicAdd(&(bar)[XB_TMO], 1u); break; } } } } while (0)

struct XcdBarrier {
    unsigned* bar; unsigned x;
    volatile LAS unsigned* st;
};

__device__ __forceinline__ XcdBarrier xcd_barrier_post(unsigned* bar, volatile LAS unsigned* st) {
    XcdBarrier b; b.bar = bar; b.x = xb_xcc_id(); b.st = st;
    if (threadIdx.x == 0) (void)xb_add(&bar[XB_XCNT(b.x)], 1u);
    return b;
}
__device__ __forceinline__ void xcd_barrier_complete(unsigned* bar, unsigned x, unsigned& nloc, unsigned& nx) {
    const unsigned G = gridDim.x * gridDim.y * gridDim.z;
    unsigned sum, cnt, mine, sp = 0u;
    for (;;) {
        sum = 0u; cnt = 0u; mine = 0u;
#pragma unroll
        for (unsigned j = 0; j < 16; ++j) { const unsigned c = xb_ld(&bar[XB_XCNT(j)]); sum += c; cnt += (c > 0u) ? 1u : 0u; mine = (j == x) ? c : mine; }
        if (sum == G) break;
        __builtin_amdgcn_s_sleep(1);
        if ((++sp & 255u) == 0u) { if (xb_ld(&bar[XB_TMO])) break; if (sp > XB_SPIN_CAP) { atomicAdd(&bar[XB_TMO], 1u); break; } }
    }
    nloc = mine > 0u ? mine : 1u; nx = cnt > 0u ? cnt : 1u;
}

__device__ __forceinline__ void xcd_barrier(const XcdBarrier& b) {
    asm volatile("s_waitcnt vmcnt(0)" ::: "memory");
    __syncthreads();
    if (threadIdx.x == 0) {
        unsigned* bar = b.bar;
        __builtin_amdgcn_s_waitcnt(0);
        unsigned nloc = b.st[0], nx = b.st[1];
        if (nloc == 0u) { xcd_barrier_complete(bar, b.x, nloc, nx); b.st[0] = nloc; b.st[1] = nx; }
        const unsigned old = xb_add(&bar[XB_XSUB(b.x)], 1u);
        const unsigned gen = old / nloc;
        if (old + 1u == (gen + 1u) * nloc) {
            __builtin_amdgcn_fence(__ATOMIC_RELEASE, "agent");
            asm volatile("s_waitcnt vmcnt(0)" ::: "memory");
            const unsigned og = xb_add(&bar[XB_TOP], 1u);
            const unsigned tg = og / nx;
            if (og + 1u == (tg + 1u) * nx) xb_add(&bar[XB_TOPGEN], 1u);
            else XB_SPIN(xb_ld(&bar[XB_TOPGEN]) == tg, bar);
            __builtin_amdgcn_fence(__ATOMIC_ACQUIRE, "agent");
            xb_add(&bar[XB_XGEN(b.x)], 1u);
            asm volatile("s_waitcnt vmcnt(0)" ::: "memory");
        } else {
            XB_SPIN(xb_ld(&bar[XB_XGEN(b.x)]) == gen, bar);
            __builtin_amdgcn_fence(__ATOMIC_ACQUIRE, "agent");
            asm volatile("s_waitcnt vmcnt(0)" ::: "memory");
        }
    }
    __syncthreads();
}
struct Ctx {
    LAS unsigned char* lds; int tid, lane, wave, vcu, G;
    const float* in[32]; float* out; unsigned char* ws;
};
#define WSP(T, off) ((T*)(F.ws + (off)))

__device__ __forceinline__ void p0_transpose_item(const float* W, int K, int N, bf16_t* WT, LAS float* scr, int item, int lane) {
    const int nblk = (N + 31) / 32, kb = item / nblk, nb = item % nblk, k0 = 64 * kb, n0 = 32 * nb;
    const int nn = n0 + (lane & 31);
#pragma unroll 8
    for (int i = 0; i < 32; ++i) { const int kk = 2 * i + (lane >> 5); scr[kk * 33 + (lane & 31)] = nn < N ? W[(size_t)(k0 + kk) * N + nn] : 0.f; }
    LDS_WAIT(); asm volatile("" ::: "memory");
    const int c = lane & 7;
#pragma unroll
    for (int j = 0; j < 4; ++j) { const int n = (lane >> 3) + 8 * j; const LAS float* s = scr + (8 * c) * 33 + n;
        u32x4 o; o.x = pk2(s[0 * 33], s[1 * 33]); o.y = pk2(s[2 * 33], s[3 * 33]); o.z = pk2(s[4 * 33], s[5 * 33]); o.w = pk2(s[6 * 33], s[7 * 33]);
        *(u32x4*)(WT + (size_t)(n0 + n) * K + k0 + 8 * c) = o; }
    LDS_WAIT(); asm volatile("" ::: "memory");
}
__device__ __forceinline__ void convert_uv(const Ctx& F, int l) {
    const int gw = F.vcu * NWAVES + F.wave, NGW = F.G * NWAVES;
    float* SC = WSP(float, WS_SC) + (size_t)l * 2 * 16384;
    for (int r = gw; r < 2 * 16384; r += NGW) {
        const int tb = r >> 14, row = r & 16383;
        const float* src = (tb ? F.in[31] : F.in[30]) + ((size_t)l * 16384 + row) * 1024 + F.lane * 16;
        f32x4 v[4]; float am = 0.f;
#pragma unroll
        for (int j = 0; j < 4; ++j) { v[j] = *(const f32x4*)(src + 4 * j); am = fmaxf(am, fmaxf(fmaxf(fabsf(v[j][0]), fabsf(v[j][1])), fmaxf(fabsf(v[j][2]), fabsf(v[j][3])))); }
#pragma unroll
        for (int o = 1; o < 64; o <<= 1) am = fmaxf(am, __shfl_xor(am, o));
        const float sc = am > 0.f ? 448.f / am : 1.f;
        u32x4 o4; unsigned ow[4];
#pragma unroll
        for (int j = 0; j < 4; ++j) { int w = __builtin_amdgcn_cvt_pk_fp8_f32(v[j][0] * sc, v[j][1] * sc, 0, false); w = __builtin_amdgcn_cvt_pk_fp8_f32(v[j][2] * sc, v[j][3] * sc, w, true); ow[j] = (unsigned)w; }
        o4 = (u32x4){ow[0], ow[1], ow[2], ow[3]};
        *(u32x4*)(F.ws + (tb ? WS_V : WS_U) + (size_t)l * UV_LSTRIDE + (size_t)row * 1024 + F.lane * 16) = o4;
        if (F.lane == 0) SC[tb * 16384 + row] = am > 0.f ? am * (1.f / 448.f) : 1.f;
    }
}
__device__ __forceinline__ void phase_prologue(const Ctx& F) {
    float* MOD = WSP(float, WS_MOD);
    {
        LAS float* sl = (LAS float*)F.lds; LAS float* red = sl + 3072;
        for (int it = F.vcu; it < 192; it += F.G) {
            const int l = it / 96, n0 = (it % 96) * 64;
            for (int i = F.tid; i < 3072; i += NTHR) { const int s = i >> 10, k = i & 1023; const float c = s < 2 ? F.in[1][s * 1024 + k] : F.in[3][k]; sl[i] = c / (1.f + __expf(-c)); }
            __syncthreads();
            const int c = F.tid & 63, kg = F.tid >> 6;
            const float* W = F.in[4] + (size_t)l * 1024 * 6144 + n0 + c;
            float a0 = 0.f, a1 = 0.f, a2 = 0.f;
#pragma unroll 8
            for (int k = kg * 128; k < kg * 128 + 128; ++k) { const float w = W[(size_t)k * 6144]; a0 += sl[k] * w; a1 += sl[1024 + k] * w; a2 += sl[2048 + k] * w; }
            red[(kg * 3 + 0) * 64 + c] = a0; red[(kg * 3 + 1) * 64 + c] = a1; red[(kg * 3 + 2) * 64 + c] = a2;
            __syncthreads();
            if (F.tid < 192) { const int s = F.tid >> 6, cc = F.tid & 63; float t = F.in[5][l * 6144 + n0 + cc];
#pragma unroll
                for (int g = 0; g < 8; ++g) t += red[(g * 3 + s) * 64 + cc];
                MOD[(l * 3 + s) * 6144 + n0 + cc] = t; }
            __syncthreads();
        }
    }
    {
        LAS float* scr = (LAS float*)(F.lds + F.wave * 16384);
        const int gw = F.vcu * NWAVES + F.wave, NGW = F.G * NWAVES;
        constexpr int I_IN = 16 * 99, I_OUT = 16 * 32, I_L = I_IN + I_OUT;
        for (int it = gw; it < 2 * I_L; it += NGW) {
            const int l = it / I_L; int r = it % I_L;
            if (r < I_IN) p0_transpose_item(F.in[8] + (size_t)l * DM * DIN, DM, DIN, WSP(bf16_t, WS_WIN + l * WIN_LSTRIDE), scr, r, F.lane);
            else p0_transpose_item(F.in[9] + (size_t)l * DM * DM, DM, DM, WSP(bf16_t, WS_WOUT + l * WOUT_LSTRIDE), scr, r - I_IN, F.lane);
        }
        for (int i = F.vcu * NTHR + F.tid; i < 2 * 160 * 128; i += F.G * NTHR) { const int l = i / (160 * 128), r = i % (160 * 128);
            *(u32x4*)(WSP(bf16_t, WS_WIN + l * WIN_LSTRIDE) + (size_t)3168 * DM + (size_t)r * 8) = (u32x4){0u, 0u, 0u, 0u}; }
    }
    __syncthreads();
    {
        LAS float* KEYS = (LAS float*)F.lds; LAS float* WQl = KEYS + 128 * 129;
        for (int it = F.vcu; it < 512; it += F.G) {
            const int l = it >> 8, hh = (it >> 4) & 15, kb = it & 15;
            const float* ksrc = F.in[29] + ((size_t)l * 16 + hh) * 128 * 128;
            for (int i = F.tid; i < 16384; i += NTHR) KEYS[(i >> 7) * 129 + (i & 127)] = ksrc[i];
            const float* wsrc = F.in[28] + (size_t)l * DM * 2048 + (size_t)(kb * 64) * 2048 + hh * 128;
            for (int i = F.tid; i < 64 * 128; i += NTHR) { const int kk = i >> 7, d = i & 127; WQl[d * 68 + kk] = wsrc[(size_t)kk * 2048 + d]; }
            __syncthreads();
            const int key = F.tid & 127, kq = F.tid >> 7;
            float acc[16];
#pragma unroll
            for (int j = 0; j < 16; ++j) acc[j] = 0.f;
#pragma unroll 4
            for (int d = 0; d < 128; ++d) { const float a = KEYS[key * 129 + d]; const LAS f32x4* wq = (const LAS f32x4*)(WQl + d * 68 + kq * 16);
#pragma unroll
                for (int q = 0; q < 4; ++q) { const f32x4 w = wq[q]; acc[4 * q] += a * w[0]; acc[4 * q + 1] += a * w[1]; acc[4 * q + 2] += a * w[2]; acc[4 * q + 3] += a * w[3]; } }
            bf16_t* dst = WSP(bf16_t, WS_WEFF + l * WEFF_LSTRIDE) + (size_t)(hh * 128 + key) * DM + kb * 64 + kq * 16;
            u32x4 o0, o1; o0.x = pk2(acc[0], acc[1]); o0.y = pk2(acc[2], acc[3]); o0.z = pk2(acc[4], acc[5]); o0.w = pk2(acc[6], acc[7]);
            o1.x = pk2(acc[8], acc[9]); o1.y = pk2(acc[10], acc[11]); o1.z = pk2(acc[12], acc[13]); o1.w = pk2(acc[14], acc[15]);
            *(u32x4*)dst = o0; *(u32x4*)(dst + 8) = o1;
            __syncthreads();
        }
    }
    convert_uv(F, 0); convert_uv(F, 1);
}

__device__ __forceinline__ void phase_norm(const Ctx& F, int l, int which, int nrows, const float* xlat, const float* xctx) {
    const float* gain = F.in[6 + which] + l * DM; const float* mod = WSP(float, WS_MOD) + (size_t)l * 3 * 6144;
    const int shoff = which ? 3072 : 0, scoff = which ? 4096 : 1024;
    bf16_t* H = WSP(bf16_t, WS_H);
    const int gw = F.vcu * NWAVES + F.wave, NGW = F.G * NWAVES;
    for (int row = gw; row < nrows; row += NGW) {
        const bool isc = row >= MLAT; const float* src = isc ? xctx + (size_t)(row - MLAT) * DM : xlat + (size_t)row * DM; const int smp = isc ? 2 : (row >> 13);
        const float* mb = mod + smp * 6144;
        f32x4 v[4]; float ss = 0.f;
#pragma unroll
        for (int j = 0; j < 4; ++j) { v[j] = *(const f32x4*)(src + F.lane * 4 + 256 * j); ss += (v[j][0] * v[j][0] + v[j][1] * v[j][1]) + (v[j][2] * v[j][2] + v[j][3] * v[j][3]); }
        const float rs = rsqrtf(wave_sum(ss) * (1.f / DM) + EPSN);
#pragma unroll
        for (int j = 0; j < 4; ++j) { const int c = F.lane * 4 + 256 * j; const f32x4 g = *(const f32x4*)(gain + c), sc = *(const f32x4*)(mb + scoff + c), sh = *(const f32x4*)(mb + shoff + c);
            const f32x4 o = (v[j] * rs * g) * (1.f + sc) + sh; st4bf(H + (size_t)row * DM + c, o); }
    }
}

__device__ __forceinline__ float log_sigmoid_(float x) { return fminf(x, 0.f) - __logf(1.f + __expf(-fabsf(x))); }
__device__ __forceinline__ void phase_prep(const Ctx& F, int l) {
    LAS float* W2s = (LAS float*)F.lds; LAS float* A2s = W2s + 8192; LAS float* G2s = A2s + 8192; LAS float* tsc = G2s + 8192 + F.wave * 64;
    { const float* w2 = F.in[13] + l * 8192; const float* a2 = F.in[15] + l * 8192; const float* g2 = F.in[16] + l * 8192;
      for (int i = F.tid; i < 8192; i += NTHR) { W2s[i] = w2[i]; A2s[i] = a2[i]; G2s[i] = g2[i]; } }
    __syncthreads();
    const bf16_t* P = WSP(bf16_t, WS_P); bf16_t* YC = WSP(bf16_t, WS_YCAT); bf16_t* QA = WSP(bf16_t, WS_QA); bf16_t* KA = WSP(bf16_t, WS_KA);
    unsigned char* RW = WSP(unsigned char, WS_RW); bf16_t* GB = WSP(bf16_t, WS_GB); float* BS = WSP(float, WS_BS); float* GA = WSP(float, WS_GA);
    const int lane = F.lane, c4 = lane * 4, i16 = lane & 15;
    const f32x4 cw0 = *(const f32x4*)(F.in[10] + l * 768 + c4), cw1 = *(const f32x4*)(F.in[10] + l * 768 + 256 + c4), cw2 = *(const f32x4*)(F.in[10] + l * 768 + 512 + c4);
    const f32x4 cg = *(const f32x4*)(F.in[11] + l * 256 + c4);
    const f32x4 qg = *(const f32x4*)(F.in[21] + l * 64 + (c4 & 63)), kg = *(const f32x4*)(F.in[22] + l * 64 + (c4 & 63));
    const f32x4 k_k = *(const f32x4*)(F.in[17] + l * 256 + c4), k_a = *(const f32x4*)(F.in[18] + l * 256 + c4), r_k = *(const f32x4*)(F.in[19] + l * 256 + c4);
    f32x4 w0[2], a0[2];
#pragma unroll
    for (int d = 0; d < 2; ++d) { w0[d] = *(const f32x4*)(F.in[12] + (l * 2 + d) * 256 + c4); a0[d] = *(const f32x4*)(F.in[14] + (l * 2 + d) * 256 + c4); }
    float invf[4];
#pragma unroll
    for (int j = 0; j < 4; ++j) invf[j] = exp2f(-(float)((c4 + j) & 15) * (13.287712379549449f / 16.f));
    const int gw = F.vcu * NWAVES + F.wave, NGW = F.G * NWAVES;
    struct PrepRaw { u32x2 h1, bg, c1, hp, cp, hn, cn, q, k, r, rk; unsigned xv, mg; };
#define PREP_LOAD(dst, row_) do { const int r_ = (row_); const bool isc_ = r_ >= MLAT; const int t_ = isc_ ? ((r_ - MLAT) & 255) : (r_ & 8191); const int T_ = isc_ ? TCTX : TLAT; \
        const bf16_t* pr_ = P + (size_t)r_ * DINP; const bf16_t* pp_ = t_ > 0 ? pr_ - DINP : pr_; const bf16_t* pn_ = t_ < T_ - 1 ? pr_ + DINP : pr_; \
        dst.h1 = *(const u32x2*)(pr_ + C_CH + c4); dst.bg = *(const u32x2*)(pr_ + C_CB + c4); dst.c1 = *(const u32x2*)(pr_ + C_CC + c4); \
        dst.hp = *(const u32x2*)(pp_ + C_CH + c4); dst.cp = *(const u32x2*)(pp_ + C_CC + c4); dst.hn = *(const u32x2*)(pn_ + C_CH + c4); dst.cn = *(const u32x2*)(pn_ + C_CC + c4); \
        dst.q = *(const u32x2*)(pr_ + C_AQ + c4); dst.k = *(const u32x2*)(pr_ + C_AK + (c4 & 127)); dst.r = *(const u32x2*)(pr_ + C_RR + c4); dst.rk = *(const u32x2*)(pr_ + C_RK + c4); \
        dst.xv = pr_[C_XW + lane]; dst.mg = pr_[C_MG + (lane & 15)]; } while (0)
#define UP4(w_) ((f32x4){lo2f((w_).x), hi2f((w_).x), lo2f((w_).y), hi2f((w_).y)})
    PrepRaw cur, nxt;
    if (gw < MALL) PREP_LOAD(cur, gw);
    for (int row = gw; row < MALL; row += NGW) {
        const bool isc = row >= MLAT; const int t = isc ? ((row - MLAT) & 255) : (row & 8191); const int T = isc ? TCTX : TLAT;
        { const int rn = row + NGW < MALL ? row + NGW : row; PREP_LOAD(nxt, rn); }
        {
            const f32x4 h1 = UP4(cur.h1), bg = UP4(cur.bg), c1 = UP4(cur.c1);
            f32x4 up = UP4(cur.hp) * UP4(cur.cp), un = UP4(cur.hn) * UP4(cur.cn);
            if (t == 0) up = (f32x4){0.f, 0.f, 0.f, 0.f};
            if (t == T - 1) un = (f32x4){0.f, 0.f, 0.f, 0.f};
            const f32x4 y = bg * (cw0 * up + cw1 * (c1 * h1) + cw2 * un);
            const float ss = red16((y[0] * y[0] + y[1] * y[1]) + (y[2] * y[2] + y[3] * y[3]));
            const float rs = rsqrtf(ss * (1.f / 64.f) + EPSN);
            st4bf(YC + (size_t)row * DM + c4, y * rs * cg * ZF(2));
        }
        {
            const f32x4 q = UP4(cur.q); const f32x4 k = UP4(cur.k);
            const float qs = red16((q[0] * q[0] + q[1] * q[1]) + (q[2] * q[2] + q[3] * q[3]));
            const float ks = red16((k[0] * k[0] + k[1] * k[1]) + (k[2] * k[2] + k[3] * k[3]));
            f32x4 qn = q * rsqrtf(qs * (1.f / 64.f) + EPSN) * qg, kn = k * rsqrtf(ks * (1.f / 64.f) + EPSN) * kg;
            if (!isc) {
                f32x4 qp, kp;
#pragma unroll
                for (int j = 0; j < 4; ++j) { qp[j] = __shfl_xor(qn[j], 4); kp[j] = __shfl_xor(kn[j], 4); }
                const int d0 = c4 & 63; const float pos = (d0 < 32) ? (float)(t >> 6) : (float)(t & 63); const bool lowh = (d0 & 16) == 0;
#pragma unroll
                for (int j = 0; j < 4; ++j) { const float th = pos * invf[j]; const float cs = __cosf(th), sn = __sinf(th);
                    qn[j] = lowh ? qn[j] * cs - qp[j] * sn : qn[j] * cs + qp[j] * sn; kn[j] = lowh ? kn[j] * cs - kp[j] * sn : kn[j] * cs + kp[j] * sn; }
            }
            st4bf(QA + (size_t)row * 256 + c4, qn * (0.125f * 1.4426950408889634f));
            if (lane < 32) st4bf(KA + (size_t)row * 128 + c4, kn);
        }
        {
            const f32x4 r = UP4(cur.r), k = UP4(cur.rk);
            { const float xv = bf2f((bf16_t)cur.xv);
              tsc[lane] = lane < 16 ? tanhf_(xv) : (lane < 32 ? xv : sigmoidf_(xv)); }
            const f32x4 kx = k * k_k;
            const float kss = red16((kx[0] * kx[0] + kx[1] * kx[1]) + (kx[2] * kx[2] + kx[3] * kx[3]));
            const f32x4 kk = kx * rsqrtf(kss + EPSN);
            bf16_t* recb = (bf16_t*)(RW + (size_t)row * RWREC); float* recf = (float*)(RW + (size_t)row * RWREC + 2560);
            st4bf(recb + c4, kk);
            f32x4 kdsum = {0.f, 0.f, 0.f, 0.f};
#pragma unroll
            for (int d = 0; d < 2; ++d) {
                f32x4 dw = w0[d], da = a0[d];
#pragma unroll 4
                for (int ii = 0; ii < 16; ++ii) { dw += tsc[ii] * *(const LAS f32x4*)(W2s + (d * 16 + ii) * 256 + c4); da += tsc[16 + ii] * *(const LAS f32x4*)(A2s + (d * 16 + ii) * 256 + c4); }
                f32x4 dec, av;
#pragma unroll
                for (int j = 0; j < 4; ++j) { dec[j] = -0.6065306597126334f * sigmoidf_(dw[j]); av[j] = sigmoidf_(da[j]); }
                const f32x4 kd = k * (1.f + (av - 1.f) * k_a);
                kdsum += kd;
                st4bf(recb + 256 + d * 256 + c4, kk * av);
                st4bf(recb + 768 + d * 256 + c4, kd);
                *(f32x4*)(recf + d * 256 + c4) = dec;
            }
            f32x4 gv = {0.f, 0.f, 0.f, 0.f};
#pragma unroll 4
            for (int ii = 0; ii < 32; ++ii) gv += tsc[32 + ii] * *(const LAS f32x4*)(G2s + ii * 256 + c4);
            st4bf(GB + (size_t)row * 256 + c4, gv);
            const f32x4 bt = r * kdsum * r_k;
            const float bsum = red16((bt[0] + bt[1]) + (bt[2] + bt[3]));
            if (i16 == 0) BS[(size_t)row * 4 + (lane >> 4)] = bsum;
        }
        if (lane < 16) { const int dir = lane >> 3, gate = (lane >> 2) & 1, hd = lane & 3; const float x = bf2f((bf16_t)cur.mg);
            const float bias = gate ? F.in[26][(l * 2 + dir) * 4 + hd] : F.in[25][(l * 2 + dir) * 4 + hd];
            GA[(size_t)row * 16 + lane] = gate ? log_sigmoid_(x + bias) : (x + bias); }
        cur = nxt;
    }
#undef PREP_LOAD
#undef UP4
}
__device__ __forceinline__ int scan_row(int b, int dir, int i) {
    if (i < TCTX) return MLAT + b * TCTX + (dir ? (TCTX - 1 - i) : i);
    const int p = i - TCTX; return b * TLAT + (dir ? (TLAT - 1 - p) : p);
}
__device__ __forceinline__ void rwkv_scan(const Ctx& F, int blk) {
    const int chain = blk >> 2, quarter = blk & 3, b = chain >> 3, head = (chain >> 1) & 3, dir = chain & 1;
    const bool scanner = F.wave < 4;
    const int rowv = (quarter * 4 + (F.wave & 3)) * 4 + (F.lane >> 4), s = F.lane & 15;
    LAS float* buf = (LAS float*)F.lds;
    const bf16_t* P = WSP(bf16_t, WS_P); const unsigned char* RW = WSP(unsigned char, WS_RW); float* YR = WSP(float, WS_YR) + (size_t)dir * MALL * 256;
    const int st = F.tid >> 4, sub = F.tid & 15;
    constexpr int NSTEP = TCTX + TLAT, NCH = NSTEP / 32;
    u32x2 g_kk, g_al, g_kd, g_r, g_v; f32x4 g_w;
#define RW_LOAD(c) do { const int row_ = scan_row(b, dir, (c) * 32 + st); const bf16_t* rb_ = (const bf16_t*)(RW + (size_t)row_ * RWREC) + head * 64 + sub * 4; \
        g_kk = *(const u32x2*)rb_; g_al = *(const u32x2*)(rb_ + 256 + dir * 256); g_kd = *(const u32x2*)(rb_ + 768 + dir * 256); \
        g_w = *(const f32x4*)((const float*)(RW + (size_t)row_ * RWREC + 2560) + dir * 256 + head * 64 + sub * 4); \
        const bf16_t* pp_ = P + (size_t)row_ * DINP + head * 64 + sub * 4; g_r = *(const u32x2*)(pp_ + C_RR); g_v = *(const u32x2*)(pp_ + C_RV); } while (0)
#define RW_STORE(par) do { LAS float* d_ = buf + ((par) * 32 + st) * 384 + sub * 4; \
        *(LAS f32x4*)(d_) = (f32x4){lo2f(g_kk.x), hi2f(g_kk.x), lo2f(g_kk.y), hi2f(g_kk.y)}; *(LAS f32x4*)(d_ + 64) = (f32x4){lo2f(g_al.x), hi2f(g_al.x), lo2f(g_al.y), hi2f(g_al.y)}; \
        *(LAS f32x4*)(d_ + 128) = (f32x4){lo2f(g_kd.x), hi2f(g_kd.x), lo2f(g_kd.y), hi2f(g_kd.y)}; *(LAS f32x4*)(d_ + 192) = g_w; \
        *(LAS f32x4*)(d_ + 256) = (f32x4){lo2f(g_r.x), hi2f(g_r.x), lo2f(g_r.y), hi2f(g_r.y)}; *(LAS f32x4*)(d_ + 320) = (f32x4){lo2f(g_v.x), hi2f(g_v.x), lo2f(g_v.y), hi2f(g_v.y)}; } while (0)
    f32x4 S = {0.f, 0.f, 0.f, 0.f};
    RW_LOAD(0); RW_STORE(0); __syncthreads();
    for (int c = 0; c < NCH; ++c) {
        const int par = c & 1;
        if (c + 1 < NCH) RW_LOAD(c + 1);
        if (scanner) {
        float ykeep = 0.f;
        f32x4 Lkk[3], Lal[3], Lkd[3], Lw[3], Lr[3]; float Lv[3];
#define SC_LD(set, i_) do { const LAS float* d_ = buf + (par * 32 + (i_)) * 384; Lkk[set] = *(const LAS f32x4*)(d_ + s * 4); Lal[set] = *(const LAS f32x4*)(d_ + 64 + s * 4); \
            Lkd[set] = *(const LAS f32x4*)(d_ + 128 + s * 4); Lw[set] = *(const LAS f32x4*)(d_ + 192 + s * 4); Lr[set] = *(const LAS f32x4*)(d_ + 256 + s * 4); Lv[set] = d_[320 + rowv]; } while (0)
        SC_LD(0, 0); SC_LD(1, 1);
#pragma unroll
        for (int i = 0; i < 32; ++i) {
            if (i + 2 < 32) SC_LD((i + 2) % 3, i + 2);
            const f32x4 kk = Lkk[i % 3], al = Lal[i % 3], kd = Lkd[i % 3], w = Lw[i % 3], r = Lr[i % 3]; const float vr = Lv[i % 3];
            const float sa = red16((S[0] * kk[0] + S[1] * kk[1]) + (S[2] * kk[2] + S[3] * kk[3]));
            S = S * w + (vr * kd - sa * al);
            const float y = red16((S[0] * r[0] + S[1] * r[1]) + (S[2] * r[2] + S[3] * r[3]));
            ykeep = (s == (i & 15)) ? y : ykeep;
            if ((i & 15) == 15) {
                const int stp = c * 32 + (i - 15) + s; const int pc = dir ? (TCTX - 1 - stp) : stp, pl = dir ? (TLAT - 1 - (stp - TCTX)) : (stp - TCTX);
                const int row = stp < TCTX ? (MLAT + b * TCTX + pc) : (b * TLAT + pl);
                YR[(size_t)row * 256 + head * 64 + rowv] = ykeep; }
        }
#undef SC_LD
        }
        if (c + 1 < NCH) RW_STORE(par ^ 1);
        __syncthreads();
    }
#undef RW_LOAD
#undef RW_STORE
}

typedef union { u32x4 u; bf16x8 b; } frag_u;
__device__ __forceinline__ void attn_unit(const Ctx& F, int l, int unit) {
    LAS bf16_t* Kl = (LAS bf16_t*)F.lds; LAS bf16_t* Vt = Kl + 64 * 72;
    const bf16_t* P = WSP(bf16_t, WS_P); const bf16_t* QA = WSP(bf16_t, WS_QA); const bf16_t* KA = WSP(bf16_t, WS_KA); bf16_t* YC = WSP(bf16_t, WS_YCAT);
    const bool isc = unit >= 256; int b, kvh, n;
    if (!isc) { b = unit >> 7; kvh = (unit >> 6) & 1; n = unit & 63; } else { const int u = unit - 256; b = u >> 2; kvh = (u >> 1) & 1; n = u & 1; }
    const int g = F.wave >> 2, ps = F.wave & 3, head = kvh * 2 + g, i = F.lane & 15, gq = F.lane >> 4;
    const int qpos0 = n * 128 + ps * 32, qrow0 = (isc ? MLAT + b * TCTX : b * TLAT) + qpos0;
    bf16x8 Qf[2][2];
#pragma unroll
    for (int qb = 0; qb < 2; ++qb)
#pragma unroll
        for (int ks = 0; ks < 2; ++ks) Qf[qb][ks] = *(const bf16x8*)(QA + (size_t)(qrow0 + qb * 16 + i) * 256 + head * 64 + ks * 32 + gq * 8);
    const float sinkl = F.in[23][l * 4 + head] * 1.4426950408889634f;
    float mrun[2] = {sinkl, sinkl}, lsum[2]; lsum[0] = lsum[1] = (gq == 0) ? 1.f : 0.f;
    f32x4 ao[4][2];
#pragma unroll
    for (int db = 0; db < 4; ++db) { ao[db][0] = (f32x4){0.f, 0.f, 0.f, 0.f}; ao[db][1] = (f32x4){0.f, 0.f, 0.f, 0.f}; }
    const int ntl = isc ? 4 : 10;
    const int skey = F.tid >> 3, sch = F.tid & 7;
    for (int tt = 0; tt < ntl; ++tt) {
        int krow0, kpos0 = 0; bool band = false;
        if (!isc && tt < 6) { const int kt = 2 * (n - 1) + tt; if (kt < 0 || kt >= 128) continue; krow0 = b * TLAT + kt * 64; kpos0 = kt * 64; band = true; }
        else { const int c = isc ? tt : tt - 6; krow0 = MLAT + b * TCTX + c * 64; }
        __syncthreads();
        { const u32x4 kv = *(const u32x4*)(KA + (size_t)(krow0 + skey) * 128 + kvh * 64 + sch * 8);
          const u32x4 vv = *(const u32x4*)(P + (size_t)(krow0 + skey) * DINP + C_AV + kvh * 64 + sch * 8);
          *(LAS u32x4*)(Kl + skey * 72 + sch * 8) = kv;
          const unsigned ww[4] = {vv.x, vv.y, vv.z, vv.w};
#pragma unroll
          for (int j = 0; j < 4; ++j) { Vt[(sch * 8 + 2 * j) * 72 + skey] = (bf16_t)(ww[j] & 0xffffu); Vt[(sch * 8 + 2 * j + 1) * 72 + skey] = (bf16_t)(ww[j] >> 16); } }
        __syncthreads();
        f32x4 sc[4][2];
#pragma unroll
        for (int kb = 0; kb < 4; ++kb) {
            sc[kb][0] = (f32x4){0.f, 0.f, 0.f, 0.f}; sc[kb][1] = (f32x4){0.f, 0.f, 0.f, 0.f};
#pragma unroll
            for (int ks = 0; ks < 2; ++ks) { const bf16x8 kf = *(const LAS bf16x8*)(Kl + (kb * 16 + i) * 72 + ks * 32 + gq * 8);
                sc[kb][0] = __builtin_amdgcn_mfma_f32_16x16x32_bf16(kf, Qf[0][ks], sc[kb][0], 0, 0, 0);
                sc[kb][1] = __builtin_amdgcn_mfma_f32_16x16x32_bf16(kf, Qf[1][ks], sc[kb][1], 0, 0, 0); }
        }
#pragma unroll
        for (int qb = 0; qb < 2; ++qb) {
            const int qp = qpos0 + qb * 16 + i;
            float mx = -1e30f;
#pragma unroll
            for (int kb = 0; kb < 4; ++kb)
#pragma unroll
                for (int r = 0; r < 4; ++r) { if (band) { const int dd = (kpos0 + kb * 16 + 4 * gq + r) - qp; if (dd > 128 || dd < -128) sc[kb][qb][r] = -1e30f; } mx = fmaxf(mx, sc[kb][qb][r]); }
            mx = fmaxf(mx, __shfl_xor(mx, 16)); mx = fmaxf(mx, __shfl_xor(mx, 32));
            const float mnew = fmaxf(mrun[qb], mx), alpha = exp2f(mrun[qb] - mnew); mrun[qb] = mnew;
            float ps_ = 0.f;
#pragma unroll
            for (int kb = 0; kb < 4; ++kb)
#pragma unroll
                for (int r = 0; r < 4; ++r) { const float p = exp2f(sc[kb][qb][r] - mnew); sc[kb][qb][r] = p; ps_ += p; }
            lsum[qb] = lsum[qb] * alpha + ps_;
#pragma unroll
            for (int db = 0; db < 4; ++db) ao[db][qb] *= alpha;
        }
#pragma unroll
        for (int ks2 = 0; ks2 < 2; ++ks2) {
            frag_u pf[2];
#pragma unroll
            for (int qb = 0; qb < 2; ++qb) { pf[qb].u.x = pg8::cvt_pk_bf16(sc[2 * ks2][qb][0], sc[2 * ks2][qb][1]); pf[qb].u.y = pg8::cvt_pk_bf16(sc[2 * ks2][qb][2], sc[2 * ks2][qb][3]);
                pf[qb].u.z = pg8::cvt_pk_bf16(sc[2 * ks2 + 1][qb][0], sc[2 * ks2 + 1][qb][1]); pf[qb].u.w = pg8::cvt_pk_bf16(sc[2 * ks2 + 1][qb][2], sc[2 * ks2 + 1][qb][3]); }
#pragma unroll
            for (int db = 0; db < 4; ++db) { frag_u vf; const LAS bf16_t* vp = Vt + (db * 16 + i) * 72 + (2 * ks2) * 16 + 4 * gq;
                const u32x2 v0 = *(const LAS u32x2*)vp, v1 = *(const LAS u32x2*)(vp + 16); vf.u = (u32x4){v0.x, v0.y, v1.x, v1.y};
                ao[db][0] = __builtin_amdgcn_mfma_f32_16x16x32_bf16(vf.b, pf[0].b, ao[db][0], 0, 0, 0);
                ao[db][1] = __builtin_amdgcn_mfma_f32_16x16x32_bf16(vf.b, pf[1].b, ao[db][1], 0, 0, 0); }
        }
    }
    const float* og = F.in[24] + l * 256 + head * 64;
#pragma unroll
    for (int qb = 0; qb < 2; ++qb) {
        float lt = lsum[qb]; lt += __shfl_xor(lt, 16); lt += __shfl_xor(lt, 32);
        const float il = 1.f / lt; float ss = 0.f;
#pragma unroll
        for (int db = 0; db < 4; ++db) { ao[db][qb] *= il; ss += (ao[db][qb][0] * ao[db][qb][0] + ao[db][qb][1] * ao[db][qb][1]) + (ao[db][qb][2] * ao[db][qb][2] + ao[db][qb][3] * ao[db][qb][3]); }
        ss += __shfl_xor(ss, 16); ss += __shfl_xor(ss, 32);
        const float rs = rsqrtf(ss * (1.f / 64.f) + EPSN);
        bf16_t* yo = YC + (size_t)(qrow0 + qb * 16 + i) * DM + 512 + head * 64;
#pragma unroll
        for (int db = 0; db < 4; ++db) { const f32x4 gg = *(const f32x4*)(og + db * 16 + 4 * gq); st4bf(yo + db * 16 + 4 * gq, ao[db][qb] * rs * gg * ZF(8)); }
    }
    __syncthreads();
}

__device__ __forceinline__ int ml_row(int b, int dir, int j, int tp) {
    if (j < 2) { const int p = j * 128 + tp; return MLAT + b * TCTX + (dir ? (TCTX - 1 - p) : p); }
    const int p = (j - 2) * 128 + tp; return b * TLAT + (dir ? (TLAT - 1 - p) : p);
}
__device__ __forceinline__ void scan128_add(float& x0, float& x1, int lane) {
    x1 += x0; float t = x1;
#pragma unroll
    for (int o = 1; o < 64; o <<= 1) { const float u = __shfl_up(t, o); if (lane >= o) t += u; }
    const float ex = t - x1; x0 += ex; x1 = t;
}
__device__ __forceinline__ void scan128_max(float& x0, float& x1, int lane) {
    x1 = fmaxf(x1, x0); float t = x1;
#pragma unroll
    for (int o = 1; o < 64; o <<= 1) { const float u = __shfl_up(t, o); if (lane >= o) t = fmaxf(t, u); }
    const float pv = __shfl_up(t, 1); if (lane > 0) x0 = fmaxf(x0, pv); x1 = t;
}
__device__ __forceinline__ void ml_stage_T(const Ctx& F, const bf16_t* P, int b, int dir, int j, int col0, LAS bf16_t* dst, const LAS float* sw, float cscale) {
#pragma unroll
    for (int it = 0; it < 2; ++it) { const int id = F.tid + it * NTHR, tp = id >> 3, ch = id & 7;
        const u32x4 v = *(const u32x4*)(P + (size_t)ml_row(b, dir, j, tp) * DINP + col0 + ch * 8); const float s = (sw ? sw[tp] : 1.f) * cscale;
        const unsigned ww[4] = {v.x, v.y, v.z, v.w};
#pragma unroll
        for (int q = 0; q < 4; ++q) { dst[(ch * 8 + 2 * q) * 136 + tp] = (bf16_t)f2bf(lo2f(ww[q]) * s); dst[(ch * 8 + 2 * q + 1) * 136 + tp] = (bf16_t)f2bf(hi2f(ww[q]) * s); } }
}
__device__ __forceinline__ void ml_stage_R(const Ctx& F, const bf16_t* P, int b, int dir, int j, int col0, LAS bf16_t* dst, float cscale) {
#pragma unroll
    for (int it = 0; it < 2; ++it) { const int id = F.tid + it * NTHR, tp = id >> 3, ch = id & 7;
        u32x4 v = *(const u32x4*)(P + (size_t)ml_row(b, dir, j, tp) * DINP + col0 + ch * 8);
        if (cscale != 1.f) { v.x = pk2(lo2f(v.x) * cscale, hi2f(v.x) * cscale); v.y = pk2(lo2f(v.y) * cscale, hi2f(v.y) * cscale); v.z = pk2(lo2f(v.z) * cscale, hi2f(v.z) * cscale); v.w = pk2(lo2f(v.w) * cscale, hi2f(v.w) * cscale); }
        *(LAS u32x4*)(dst + tp * 72 + ch * 8) = v; }
}
__device__ __forceinline__ void mlstm_local(const Ctx& F, int task) {
    const int chain = task / NCHK, j = task % NCHK, b = chain >> 3, head = (chain >> 1) & 3, dir = chain & 1;
    const bf16_t* P = WSP(bf16_t, WS_P); const float* GA = WSP(float, WS_GA);
    LAS bf16_t* Vt = (LAS bf16_t*)F.lds; LAS bf16_t* Kt = Vt + 64 * 136; LAS float* wS = (LAS float*)(Kt + 64 * 136); LAS float* sc2 = wS + 128;
    __syncthreads();
    if (F.wave == 0) {
        const int r0 = ml_row(b, dir, j, 2 * F.lane), r1 = ml_row(b, dir, j, 2 * F.lane + 1);
        const float li0 = GA[(size_t)r0 * 16 + dir * 8 + head], li1 = GA[(size_t)r1 * 16 + dir * 8 + head];
        float b0 = GA[(size_t)r0 * 16 + dir * 8 + 4 + head], b1 = GA[(size_t)r1 * 16 + dir * 8 + 4 + head];
        scan128_add(b0, b1, F.lane);
        const float bend = __shfl(b1, 63);
        const float d0 = bend - b0 + li0, d1 = bend - b1 + li1;
        float mx = fmaxf(d0, d1);
#pragma unroll
        for (int o = 1; o < 64; o <<= 1) mx = fmaxf(mx, __shfl_xor(mx, o));
        wS[2 * F.lane] = __expf(d0 - mx); wS[2 * F.lane + 1] = __expf(d1 - mx);
        if (F.lane == 0) { sc2[0] = mx; sc2[1] = bend; }
    }
    __syncthreads();
    ml_stage_T(F, P, b, dir, j, C_MV + head * 64, Vt, wS, 1.f);
    ml_stage_T(F, P, b, dir, j, C_MK + head * 64, Kt, nullptr, 0.125f);
    __syncthreads();
    float* LC = WSP(float, WS_LC) + (size_t)task * CST;
    { const int vb = F.wave >> 1, i = F.lane & 15, gq = F.lane >> 4;
#pragma unroll
      for (int kk2 = 0; kk2 < 2; ++kk2) { const int kb = 2 * (F.wave & 1) + kk2; f32x4 acc = {0.f, 0.f, 0.f, 0.f};
#pragma unroll
          for (int ks = 0; ks < 4; ++ks) { const bf16x8 a = *(const LAS bf16x8*)(Vt + (vb * 16 + i) * 136 + ks * 32 + gq * 8), bb = *(const LAS bf16x8*)(Kt + (kb * 16 + i) * 136 + ks * 32 + gq * 8);
              acc = __builtin_amdgcn_mfma_f32_16x16x32_bf16(a, bb, acc, 0, 0, 0); }
#pragma unroll
          for (int r = 0; r < 4; ++r) LC[(vb * 16 + 4 * gq + r) * 64 + kb * 16 + i] = acc[r]; } }
    if (F.tid < 64) { float a = 0.f;
#pragma unroll 8
        for (int s = 0; s < 128; ++s) a += wS[s] * bf2f(Kt[F.tid * 136 + s]);
        LC[4096 + F.tid] = a; }
    if (F.tid == 0) { float* LB = WSP(float, WS_LB); LB[task * 2] = sc2[0]; LB[task * 2 + 1] = sc2[1]; }
}
__device__ __forceinline__ void mlstm_chain(const Ctx& F, int blk0) {
    const int gt = (F.vcu - blk0) * NTHR + F.tid; if (gt < 0 || gt >= 16 * CST) return;
    const int chain = gt / CST, e = gt % CST;
    const float* LC = WSP(float, WS_LC) + (size_t)chain * NCHK * CST + e; float* ST = WSP(float, WS_ST) + (size_t)chain * NCHK * CST + e;
    const float* LB = WSP(float, WS_LB) + chain * NCHK * 2; float* SM = WSP(float, WS_LB) + 4096 + chain * NCHK;
    float m = 0.f, x = 0.f;
#pragma unroll 1
    for (int g = 0; g < 3; ++g) {
        float d[22], Lv[22], Bv[22];
#pragma unroll
        for (int q = 0; q < 22; ++q) { const int j = g * 22 + q; d[q] = LC[(size_t)j * CST]; Lv[q] = LB[2 * j]; Bv[q] = LB[2 * j + 1]; }
#pragma unroll
        for (int q = 0; q < 22; ++q) { const int j = g * 22 + q;
            ST[(size_t)j * CST] = x; if (e == 0) SM[j] = m;
            const float mn = fmaxf(Bv[q] + m, Lv[q]);
            x = __expf(Bv[q] + m - mn) * x + __expf(Lv[q] - mn) * d[q]; m = mn; }
    }
}
__device__ __forceinline__ void mlstm_out(const Ctx& F, int l, int unit) {
    const bool isc = unit >= 512; int b, chunk, head;
    if (!isc) { b = unit >> 8; chunk = (unit >> 2) & 63; head = unit & 3; } else { const int u = unit - 512; b = u >> 3; chunk = (u >> 2) & 1; head = u & 3; }
    const bf16_t* P = WSP(bf16_t, WS_P); const float* GA = WSP(float, WS_GA); bf16_t* YC = WSP(bf16_t, WS_YCAT);
    LAS bf16_t* Ql = (LAS bf16_t*)F.lds; LAS bf16_t* Kl = Ql + 128 * 72; LAS bf16_t* Vt = Kl + 128 * 72; LAS bf16_t* Cb = Vt + 64 * 136;
    LAS float* nS = (LAS float*)(Cb + 64 * 72); LAS float* aS = nS + 64; LAS float* bS = aS + 128; LAS float* MS = bS + 128; LAS float* Hs = MS + 128;
    const int i = F.lane & 15, gq = F.lane >> 4, w = F.wave;
    for (int dir = 0; dir < 2; ++dir) {
        const int j = isc ? (dir ? 1 - chunk : chunk) : 2 + (dir ? 63 - chunk : chunk);
        const int chain = (b * 4 + head) * 2 + dir;
        const float* ST = WSP(float, WS_ST) + ((size_t)chain * NCHK + j) * CST; const float mprev = WSP(float, WS_LB)[4096 + chain * NCHK + j];
        __syncthreads();
        if (w == 0) {
            const int r0 = ml_row(b, dir, j, 2 * F.lane), r1 = ml_row(b, dir, j, 2 * F.lane + 1);
            const float li0 = GA[(size_t)r0 * 16 + dir * 8 + head], li1 = GA[(size_t)r1 * 16 + dir * 8 + head];
            float b0 = GA[(size_t)r0 * 16 + dir * 8 + 4 + head], b1 = GA[(size_t)r1 * 16 + dir * 8 + 4 + head];
            scan128_add(b0, b1, F.lane);
            const float a0 = li0 - b0, a1 = li1 - b1; float A0 = a0, A1 = a1;
            scan128_max(A0, A1, F.lane);
            aS[2 * F.lane] = a0; aS[2 * F.lane + 1] = a1; bS[2 * F.lane] = b0; bS[2 * F.lane + 1] = b1;
            MS[2 * F.lane] = fmaxf(A0, mprev); MS[2 * F.lane + 1] = fmaxf(A1, mprev);
        }
        ml_stage_R(F, P, b, dir, j, C_MQ + head * 64, Ql, 1.f);
        ml_stage_R(F, P, b, dir, j, C_MK + head * 64, Kl, 0.125f);
        ml_stage_T(F, P, b, dir, j, C_MV + head * 64, Vt, nullptr, 1.f);
        { const f32x4 c0 = *(const f32x4*)(ST + F.tid * 8), c1 = *(const f32x4*)(ST + F.tid * 8 + 4); const int v = F.tid >> 3, k0 = (F.tid & 7) * 8;
          u32x4 o; o.x = pk2(c0[0], c0[1]); o.y = pk2(c0[2], c0[3]); o.z = pk2(c1[0], c1[1]); o.w = pk2(c1[2], c1[3]); *(LAS u32x4*)(Cb + v * 72 + k0) = o;
          if (F.tid < 64) nS[F.tid] = ST[4096 + F.tid]; }
        __syncthreads();
        const int t = 16 * w + i; const float Mt = MS[t], bt = bS[t];
        bf16x8 Qf[2];
#pragma unroll
        for (int ks = 0; ks < 2; ++ks) Qf[ks] = *(const LAS bf16x8*)(Ql + t * 72 + ks * 32 + gq * 8);
        f32x4 sc[8];
#pragma unroll
        for (int sb = 0; sb < 8; ++sb) { sc[sb] = (f32x4){0.f, 0.f, 0.f, 0.f};
            if (sb <= w) {
#pragma unroll
                for (int ks = 0; ks < 2; ++ks) { const bf16x8 kf = *(const LAS bf16x8*)(Kl + (sb * 16 + i) * 72 + ks * 32 + gq * 8); sc[sb] = __builtin_amdgcn_mfma_f32_16x16x32_bf16(kf, Qf[ks], sc[sb], 0, 0, 0); }
#pragma unroll
                for (int r = 0; r < 4; ++r) { const int s = sb * 16 + 4 * gq + r; sc[sb][r] = (s <= t) ? sc[sb][r] * __expf(aS[s] - Mt) : 0.f; }
            } }
        float den = 0.f;
#pragma unroll
        for (int sb = 0; sb < 8; ++sb) den += (sc[sb][0] + sc[sb][1]) + (sc[sb][2] + sc[sb][3]);
        den += __shfl_xor(den, 16); den += __shfl_xor(den, 32);
        f32x4 nm[4], it_[4];
#pragma unroll
        for (int vb = 0; vb < 4; ++vb) { nm[vb] = (f32x4){0.f, 0.f, 0.f, 0.f}; it_[vb] = (f32x4){0.f, 0.f, 0.f, 0.f}; }
#pragma unroll
        for (int ks2 = 0; ks2 < 4; ++ks2) if (2 * ks2 <= w) {
            frag_u pf; pf.u.x = pg8::cvt_pk_bf16(sc[2 * ks2][0], sc[2 * ks2][1]); pf.u.y = pg8::cvt_pk_bf16(sc[2 * ks2][2], sc[2 * ks2][3]);
            pf.u.z = pg8::cvt_pk_bf16(sc[2 * ks2 + 1][0], sc[2 * ks2 + 1][1]); pf.u.w = pg8::cvt_pk_bf16(sc[2 * ks2 + 1][2], sc[2 * ks2 + 1][3]);
#pragma unroll
            for (int vb = 0; vb < 4; ++vb) { frag_u vf; const LAS bf16_t* vp = Vt + (vb * 16 + i) * 136 + (2 * ks2) * 16 + 4 * gq;
                const u32x2 v0 = *(const LAS u32x2*)vp, v1 = *(const LAS u32x2*)(vp + 16); vf.u = (u32x4){v0.x, v0.y, v1.x, v1.y};
                nm[vb] = __builtin_amdgcn_mfma_f32_16x16x32_bf16(vf.b, pf.b, nm[vb], 0, 0, 0); }
        }
#pragma unroll
        for (int vb = 0; vb < 4; ++vb)
#pragma unroll
            for (int ks = 0; ks < 2; ++ks) { const bf16x8 cf = *(const LAS bf16x8*)(Cb + (vb * 16 + i) * 72 + ks * 32 + gq * 8); it_[vb] = __builtin_amdgcn_mfma_f32_16x16x32_bf16(cf, Qf[ks], it_[vb], 0, 0, 0); }
        float nq = 0.f;
#pragma unroll
        for (int c = 0; c < 2; ++c) { const u32x4 qv = *(const LAS u32x4*)(Ql + t * 72 + gq * 16 + c * 8); const unsigned ww[4] = {qv.x, qv.y, qv.z, qv.w};
#pragma unroll
            for (int q = 0; q < 4; ++q) nq += nS[gq * 16 + c * 8 + 2 * q] * lo2f(ww[q]) + nS[gq * 16 + c * 8 + 2 * q + 1] * hi2f(ww[q]); }
        nq += __shfl_xor(nq, 16); nq += __shfl_xor(nq, 32);
        const float wint = __expf(mprev - Mt); den += wint * nq;
        const float dn = 1.f / fmaxf(fabsf(den), __expf(-(bt + Mt)));
        const int torig = dir ? 127 - t : t;
#pragma unroll
        for (int vb = 0; vb < 4; ++vb)
#pragma unroll
            for (int r = 0; r < 4; ++r) { const float hv = (nm[vb][r] + wint * it_[vb][r]) * dn; LAS float* hp = Hs + torig * 65 + vb * 16 + 4 * gq + r; if (dir == 0) *hp = hv; else *hp += hv; }
    }
    __syncthreads();
    {
        const int t = F.tid >> 2, vq = F.tid & 3; const int row = (isc ? MLAT + b * TCTX : b * TLAT) + chunk * 128 + t;
        float hv[16], ss = 0.f;
#pragma unroll
        for (int q = 0; q < 16; ++q) { hv[q] = Hs[t * 65 + vq * 16 + q]; ss += hv[q] * hv[q]; }
        ss += __shfl_xor(ss, 1); ss += __shfl_xor(ss, 2);
        const float rs = rsqrtf(ss * (1.f / 64.f) + EPSN);
        const float* og = F.in[27] + l * 256 + head * 64 + vq * 16; const bf16_t* op = P + (size_t)row * DINP + C_MO + head * 64 + vq * 16;
        const u32x4 o0 = *(const u32x4*)op, o1 = *(const u32x4*)(op + 8); const unsigned ow[8] = {o0.x, o0.y, o0.z, o0.w, o1.x, o1.y, o1.z, o1.w};
        unsigned res[8];
#pragma unroll
        for (int q = 0; q < 8; ++q) { const float y0 = sigmoidf_(lo2f(ow[q])) * hv[2 * q] * rs * og[2 * q], y1 = sigmoidf_(hi2f(ow[q])) * hv[2 * q + 1] * rs * og[2 * q + 1]; res[q] = pk2(y0 * ZF(16), y1 * ZF(16)); }
        bf16_t* yo = YC + (size_t)row * DM + 768 + head * 64 + vq * 16;
        *(u32x4*)yo = (u32x4){res[0], res[1], res[2], res[3]}; *(u32x4*)(yo + 8) = (u32x4){res[4], res[5], res[6], res[7]};
    }
    __syncthreads();
}
__device__ __forceinline__ void rwkv_finish(const Ctx& F, int l, int nrows) {
    const bf16_t* P = WSP(bf16_t, WS_P); const float* YR = WSP(float, WS_YR); const bf16_t* GB = WSP(bf16_t, WS_GB); const float* BS = WSP(float, WS_BS); bf16_t* YC = WSP(bf16_t, WS_YCAT);
    const int c4 = F.lane * 4; const f32x4 lg = *(const f32x4*)(F.in[20] + l * 256 + c4);
    const int gw = F.vcu * NWAVES + F.wave, NGW = F.G * NWAVES;
    for (int row = gw; row < nrows; row += NGW) {
        const f32x4 y = *(const f32x4*)(YR + (size_t)row * 256 + c4) + *(const f32x4*)(YR + (size_t)(MALL + row) * 256 + c4);
        const float ss = red16((y[0] * y[0] + y[1] * y[1]) + (y[2] * y[2] + y[3] * y[3]));
        const float rs = rsqrtf(ss * (1.f / 64.f) + EPSN);
        const f32x4 v = ld4bf(P + (size_t)row * DINP + C_RV + c4), g = ld4bf(GB + (size_t)row * 256 + c4);
        const float bn = BS[(size_t)row * 4 + (F.lane >> 4)];
        st4bf(YC + (size_t)row * DM + 256 + c4, (y * rs * lg * ZF(32) + bn * v * ZF(64)) * g * ZF(4));
    }
}
constexpr int RCH = 132;
constexpr int MP = 72, SLOT = 64 * MP;
constexpr size_t WS_RG = 454 * MiB, RG_TASK = 3 * 8192, WS_SST = WS_RW;
constexpr size_t WS_END2 = 504 * MiB;
static_assert(WS_RG + (size_t)16 * RCH * RG_TASK <= WS_END2 && (size_t)16 * RCH * 8192 <= (size_t)MALL * RWREC, "rwkv chunk ws map");

__device__ __forceinline__ void mm64(const LAS bf16_t* A, const LAS bf16_t* Bt, int w, int lane, f32x4 (&acc)[2]) {
    const int i = lane & 15, gq = lane >> 4, mb = w >> 1, nb0 = 2 * (w & 1);
    acc[0] = (f32x4){0.f, 0.f, 0.f, 0.f}; acc[1] = (f32x4){0.f, 0.f, 0.f, 0.f};
#pragma unroll
    for (int ks = 0; ks < 2; ++ks) { const bf16x8 a = *(const LAS bf16x8*)(A + (mb * 16 + i) * MP + ks * 32 + gq * 8);
#pragma unroll
        for (int q = 0; q < 2; ++q) { const bf16x8 b = *(const LAS bf16x8*)(Bt + ((nb0 + q) * 16 + i) * MP + ks * 32 + gq * 8); acc[q] = __builtin_amdgcn_mfma_f32_16x16x32_bf16(a, b, acc[q], 0, 0, 0); } }
}
__device__ __forceinline__ u32x2 pk4(f32x4 v) { u32x2 o; o.x = pk2(v[0], v[1]); o.y = pk2(v[2], v[3]); return o; }
__device__ __forceinline__ f32x4 up4(u32x2 w) { return (f32x4){lo2f(w.x), hi2f(w.x), lo2f(w.y), hi2f(w.y)}; }

__device__ __forceinline__ void rwkv_chunk_pre(const Ctx& F, int task) {
    const int chain = task / RCH, c = task % RCH, b = chain >> 3, head = (chain >> 1) & 3, dir = chain & 1;
    const bf16_t* P = WSP(bf16_t, WS_P); const unsigned char* RW = WSP(unsigned char, WS_RW);
    LAS bf16_t* L0 = (LAS bf16_t*)F.lds;
#define SL(k) (L0 + (k) * SLOT)
    LAS float* LD = (LAS float*)SL(8);
    LAS float* SEG = (LAS float*)SL(10);
    LAS float* WLs = (LAS float*)SL(14);
    const int w = F.wave, lane = F.lane, i = lane & 15, gq = lane >> 4, mb = w >> 1, nb0 = 2 * (w & 1), m0 = mb * 16 + 4 * gq;
    __syncthreads();
    const int t = F.tid >> 3, ch0 = (F.tid & 7) * 8;
    const int row = scan_row(b, dir, c * 64 + t);
    const bf16_t* rb = (const bf16_t*)(RW + (size_t)row * RWREC) + head * 64 + ch0;
    const u32x4 g_kk = *(const u32x4*)rb, g_al = *(const u32x4*)(rb + 256 + dir * 256), g_kd = *(const u32x4*)(rb + 768 + dir * 256);
    const float* ldp = (const float*)(RW + (size_t)row * RWREC + 2560) + dir * 256 + head * 64 + ch0;
    const f32x4 ld0 = *(const f32x4*)ldp, ld1 = *(const f32x4*)(ldp + 4);
    const bf16_t* pp = P + (size_t)row * DINP + head * 64 + ch0;
    const u32x4 g_r = *(const u32x4*)(pp + C_RR), g_v = *(const u32x4*)(pp + C_RV);
    *(LAS f32x4*)(LD + t * 64 + ch0) = ld0; *(LAS f32x4*)(LD + t * 64 + ch0 + 4) = ld1;
    __syncthreads();
    { const int k = F.tid & 63, seg = F.tid >> 6; float s = 0.f;
#pragma unroll
      for (int j = 0; j < 8; ++j) s += LD[(seg * 8 + j) * 64 + k];
      SEG[seg * 64 + k] = s;
      __syncthreads();
      float off = 0.f;
#pragma unroll
      for (int j = 0; j < 8; ++j) off += (j < seg) ? SEG[j * 64 + k] : 0.f;
#pragma unroll
      for (int j = 0; j < 8; ++j) { off += LD[(seg * 8 + j) * 64 + k]; LD[(seg * 8 + j) * 64 + k] = off; }
    }
    __syncthreads();
    {
        const unsigned kkw[4] = {g_kk.x, g_kk.y, g_kk.z, g_kk.w}, alw[4] = {g_al.x, g_al.y, g_al.z, g_al.w}, kdw[4] = {g_kd.x, g_kd.y, g_kd.z, g_kd.w},
                       rw_[4] = {g_r.x, g_r.y, g_r.z, g_r.w}, vw[4] = {g_v.x, g_v.y, g_v.z, g_v.w};
        float okt[8], oai[8], oki[8], ort[8], oat[8], okb[8];
#pragma unroll
        for (int j = 0; j < 8; ++j) {
            const float cl = LD[t * 64 + ch0 + j], clp = t > 0 ? LD[(t - 1) * 64 + ch0 + j] : 0.f, clL = LD[63 * 64 + ch0 + j];
            const float kkv = (j & 1) ? hi2f(kkw[j >> 1]) : lo2f(kkw[j >> 1]), alv = (j & 1) ? hi2f(alw[j >> 1]) : lo2f(alw[j >> 1]), kdv = (j & 1) ? hi2f(kdw[j >> 1]) : lo2f(kdw[j >> 1]),
                        rv = (j & 1) ? hi2f(rw_[j >> 1]) : lo2f(rw_[j >> 1]);
            const float en = __expf(-cl), eL = __expf(clL - cl);
            okt[j] = kkv * __expf(clp); oai[j] = alv * en; oki[j] = kdv * en; ort[j] = rv * __expf(cl); oat[j] = alv * eL; okb[j] = kdv * eL;
        }
        u32x4 o;
        o = (u32x4){pk2(okt[0], okt[1]), pk2(okt[2], okt[3]), pk2(okt[4], okt[5]), pk2(okt[6], okt[7])}; *(LAS u32x4*)(SL(0) + t * MP + ch0) = o;
        o = (u32x4){pk2(oai[0], oai[1]), pk2(oai[2], oai[3]), pk2(oai[4], oai[5]), pk2(oai[6], oai[7])}; *(LAS u32x4*)(SL(2) + t * MP + ch0) = o;
        o = (u32x4){pk2(oki[0], oki[1]), pk2(oki[2], oki[3]), pk2(oki[4], oki[5]), pk2(oki[6], oki[7])}; *(LAS u32x4*)(SL(3) + t * MP + ch0) = o;
        o = (u32x4){pk2(ort[0], ort[1]), pk2(ort[2], ort[3]), pk2(ort[4], ort[5]), pk2(ort[6], ort[7])}; *(LAS u32x4*)(SL(4) + t * MP + ch0) = o;
#pragma unroll
        for (int j = 0; j < 8; ++j) { SL(1)[(ch0 + j) * MP + t] = (bf16_t)f2bf(okt[j]); SL(5)[(ch0 + j) * MP + t] = (bf16_t)f2bf(oat[j]); SL(6)[(ch0 + j) * MP + t] = (bf16_t)f2bf(okb[j]);
            SL(7)[(ch0 + j) * MP + t] = (bf16_t)(((j & 1) ? (vw[j >> 1] >> 16) : (vw[j >> 1] & 0xffffu))); }
        if (t == 63) {
#pragma unroll
            for (int j = 0; j < 8; ++j) WLs[ch0 + j] = __expf(LD[63 * 64 + ch0 + j]); }
    }
    __syncthreads();
    f32x4 acc[2];
    mm64(SL(0), SL(2), w, lane, acc);
#pragma unroll
    for (int q = 0; q < 2; ++q) { const int n = (nb0 + q) * 16 + i; f32x4 a, ti;
#pragma unroll
        for (int r = 0; r < 4; ++r) { const bool keep = (m0 + r) > n; a[r] = keep ? acc[q][r] : 0.f; ti[r] = ((m0 + r) == n ? 1.f : 0.f) - a[r]; }
#pragma unroll
        for (int r = 0; r < 4; ++r) { SL(8)[(m0 + r) * MP + n] = (bf16_t)f2bf(a[r]); SL(13)[(m0 + r) * MP + n] = (bf16_t)f2bf(ti[r]); }
        *(LAS u32x2*)(SL(9) + n * MP + m0) = pk4(a); }
    mm64(SL(0), SL(3), w, lane, acc);
#pragma unroll
    for (int q = 0; q < 2; ++q) { const int n = (nb0 + q) * 16 + i;
#pragma unroll
        for (int r = 0; r < 4; ++r) SL(10)[(m0 + r) * MP + n] = (bf16_t)f2bf((m0 + r) > n ? acc[q][r] : 0.f); }
    mm64(SL(4), SL(2), w, lane, acc);
#pragma unroll
    for (int q = 0; q < 2; ++q) { const int n = (nb0 + q) * 16 + i;
#pragma unroll
        for (int r = 0; r < 4; ++r) SL(11)[(m0 + r) * MP + n] = (bf16_t)f2bf((m0 + r) >= n ? acc[q][r] : 0.f); }
    mm64(SL(4), SL(3), w, lane, acc);
#pragma unroll
    for (int q = 0; q < 2; ++q) { const int n = (nb0 + q) * 16 + i;
#pragma unroll
        for (int r = 0; r < 4; ++r) SL(12)[(m0 + r) * MP + n] = (bf16_t)f2bf((m0 + r) >= n ? acc[q][r] : 0.f); }
    __syncthreads();
#pragma unroll
    for (int it = 0; it < 5; ++it) {
        LAS bf16_t* Xs = (it & 1) ? SL(2) : SL(8); LAS bf16_t* XsT = (it & 1) ? SL(3) : SL(9);
        LAS bf16_t* Xd = (it & 1) ? SL(8) : SL(2); LAS bf16_t* XdT = (it & 1) ? SL(9) : SL(3);
        LAS bf16_t* Tsrc = (it & 1) ? SL(0) : SL(13); LAS bf16_t* Tdst = (it & 1) ? SL(13) : SL(0);
        mm64(Xs, XsT, w, lane, acc);
#pragma unroll
        for (int q = 0; q < 2; ++q) { const int n = (nb0 + q) * 16 + i;
#pragma unroll
            for (int r = 0; r < 4; ++r) Xd[(m0 + r) * MP + n] = (bf16_t)f2bf(acc[q][r]);
            *(LAS u32x2*)(XdT + n * MP + m0) = pk4(acc[q]); }
        __syncthreads();
        mm64(Tsrc, XdT, w, lane, acc);
#pragma unroll
        for (int q = 0; q < 2; ++q) { const int n = (nb0 + q) * 16 + i;
#pragma unroll
            for (int r = 0; r < 4; ++r) Tdst[(m0 + r) * MP + n] = (bf16_t)f2bf(bf2f(Tsrc[(m0 + r) * MP + n]) + acc[q][r]); }
        __syncthreads();
    }
    LAS bf16_t* Ti = SL(0);
    mm64(Ti, SL(1), w, lane, acc);
#pragma unroll
    for (int q = 0; q < 2; ++q) { const int n = (nb0 + q) * 16 + i; *(LAS u32x2*)(SL(2) + n * MP + m0) = pk4(acc[q]); }
    mm64(SL(10), SL(7), w, lane, acc);
#pragma unroll
    for (int q = 0; q < 2; ++q) { const int n = (nb0 + q) * 16 + i; *(LAS u32x2*)(SL(3) + n * MP + m0) = pk4(acc[q]); }
    __syncthreads();
    mm64(Ti, SL(3), w, lane, acc);
#pragma unroll
    for (int q = 0; q < 2; ++q) { const int n = (nb0 + q) * 16 + i; *(LAS u32x2*)(SL(8) + n * MP + m0) = pk4(acc[q]); }
    __syncthreads();
    bf16_t* RG = (bf16_t*)(F.ws + WS_RG + (size_t)task * RG_TASK);
    f32x4 acc2[2];
    mm64(SL(2), SL(11), w, lane, acc);
#pragma unroll
    for (int q = 0; q < 2; ++q) { const int n = (nb0 + q) * 16 + i; const f32x4 rt = up4(*(const LAS u32x2*)(SL(4) + n * MP + m0)); *(u32x2*)(RG + n * 64 + m0) = pk4(rt - acc[q]); }
    mm64(SL(2), SL(5), w, lane, acc);
#pragma unroll
    for (int q = 0; q < 2; ++q) { const int n = (nb0 + q) * 16 + i; f32x4 g;
#pragma unroll
        for (int r = 0; r < 4; ++r) g[r] = ((m0 + r) == n ? WLs[n] : 0.f) - acc[q][r];
        *(u32x2*)(RG + 4096 + n * 64 + m0) = pk4(g); }
    mm64(SL(6), SL(7), w, lane, acc); mm64(SL(5), SL(8), w, lane, acc2);
#pragma unroll
    for (int q = 0; q < 2; ++q) { const int n = (nb0 + q) * 16 + i; *(u32x2*)(RG + 8192 + n * 64 + m0) = pk4(acc[q] - acc2[q]); }
    mm64(SL(7), SL(12), w, lane, acc); mm64(SL(8), SL(11), w, lane, acc2);
    float* YR = WSP(float, WS_YR) + (size_t)dir * MALL * 256;
#pragma unroll
    for (int q = 0; q < 2; ++q) { const int n = (nb0 + q) * 16 + i; const int rown = scan_row(b, dir, c * 64 + n); *(f32x4*)(YR + (size_t)rown * 256 + head * 64 + m0) = acc[q] - acc2[q]; }
#undef SL
}

__device__ __forceinline__ void rwkv_chain(const Ctx& F, int chain) {
    LAS bf16_t* const L0 = (LAS bf16_t*)F.lds;
    LAS bf16_t* Gl[2] = {L0, L0 + SLOT}; LAS bf16_t* Sl[2] = {L0 + 2 * SLOT, L0 + 3 * SLOT}; LAS bf16_t* Hl[2] = {L0 + 4 * SLOT, L0 + 5 * SLOT};
    const int w = F.wave, lane = F.lane, i = lane & 15, gq = lane >> 4, mb = w >> 1, nb0 = 2 * (w & 1), m0 = mb * 16 + 4 * gq;
    const bf16_t* RGc = (const bf16_t*)(F.ws + WS_RG + (size_t)chain * RCH * RG_TASK); bf16_t* SST = (bf16_t*)(F.ws + WS_SST) + (size_t)chain * RCH * 4096;
    const int gr = F.tid >> 3, gc = (F.tid & 7) * 8, goff = gr * 64 + gc, loff = gr * MP + gc;
    constexpr int RBD = 6, RBU = 66;
    static_assert(RBU % RBD == 0 && RCH % RBU == 0, "ring depth / unroll");
    u32x4 rg[RBD], rh[RBD];
#define RB_LOAD(slot, cc) do { const bf16_t* p_ = RGc + (size_t)((cc) < RCH ? (cc) : RCH - 1) * (RG_TASK / 2); rg[slot] = *(const u32x4*)(p_ + 4096 + goff); rh[slot] = *(const u32x4*)(p_ + 8192 + goff); } while (0)
#pragma unroll
    for (int j = 0; j < RBD; ++j) RB_LOAD(j, j);
    __syncthreads();
    { unsigned z_; asm volatile("v_mov_b32 %0, 0" : "=v"(z_)); *(LAS u32x4*)(Sl[0] + loff) = (u32x4){z_, z_, z_, z_}; }
    *(LAS u32x4*)(Gl[0] + loff) = rg[0]; *(LAS u32x4*)(Hl[0] + loff) = rh[0];
    __syncthreads();
#ifdef TPROBE
    const unsigned long long tp0_ = __builtin_amdgcn_s_memrealtime();
#endif
#define RB_STEP(j) do { const int c = c0 + (j); if (c < RCH - 1) { const int par = c & 1; \
        *(u32x4*)(SST + (size_t)c * 4096 + goff) = *(const LAS u32x4*)(Sl[par] + loff);            \
        f32x4 acc[2]; mm64(Gl[par], Sl[par], w, lane, acc); \
        { const f32x4 h0 = up4(*(const LAS u32x2*)(Hl[par] + (nb0 * 16 + i) * MP + m0)), h1 = up4(*(const LAS u32x2*)(Hl[par] + ((nb0 + 1) * 16 + i) * MP + m0)); \
          *(LAS u32x2*)(Sl[par ^ 1] + (nb0 * 16 + i) * MP + m0) = pk4(acc[0] + h0); *(LAS u32x2*)(Sl[par ^ 1] + ((nb0 + 1) * 16 + i) * MP + m0) = pk4(acc[1] + h1); } \
        *(LAS u32x4*)(Gl[par ^ 1] + loff) = rg[((j) + 1) % RBD]; *(LAS u32x4*)(Hl[par ^ 1] + loff) = rh[((j) + 1) % RBD]; \
        RB_LOAD((j) % RBD, c + RBD); \
        asm volatile("s_waitcnt lgkmcnt(0)" ::: "memory"); __builtin_amdgcn_s_barrier(); asm volatile("" ::: "memory"); } } while (0)
#pragma unroll 1
    for (int c0 = 0; c0 < RCH; c0 += RBU) {
#pragma unroll
        for (int j = 0; j < RBU; ++j) RB_STEP(j); }
#undef RB_STEP
#undef RB_LOAD
    *(u32x4*)(SST + (size_t)(RCH - 1) * 4096 + goff) = *(const LAS u32x4*)(Sl[(RCH - 1) & 1] + loff);
#ifdef TPROBE
    if (chain == 0 && F.tid == 0) *(float*)(F.ws + WS_CTL + 65536) = 3000.f * (floorf((float)(__builtin_amdgcn_s_memrealtime() - tp0_) * (1.f / 3000.f)) + 0.5f);
#endif
    __syncthreads();
}

__device__ __forceinline__ void rwkv_out(const Ctx& F, int l, int unit) {
    const bool isc = unit >= 256; int b, chunk; if (!isc) { b = unit >> 7; chunk = unit & 127; } else { const int u = unit - 256; b = u >> 2; chunk = u & 3; }
    LAS bf16_t* Rl = (LAS bf16_t*)F.lds; LAS bf16_t* Sl = Rl + SLOT; LAS float* Ys = (LAS float*)(F.lds + 4 * SLOT * 2);
    const int w = F.wave, lane = F.lane, i = lane & 15, gq = lane >> 4, mb = w >> 1, nb0 = 2 * (w & 1), m0 = mb * 16 + 4 * gq;
    const int row0 = (isc ? MLAT + b * TCTX : b * TLAT) + chunk * 64;
    const int gr = F.tid >> 3, gc = (F.tid & 7) * 8;
#pragma unroll 1
    for (int hd = 0; hd < 8; ++hd) {
        const int head = hd >> 1, dir = hd & 1, chain = (b * 4 + head) * 2 + dir;
        const int cc = isc ? (dir ? 3 - chunk : chunk) : 4 + (dir ? 127 - chunk : chunk);
        const bf16_t* RG = (const bf16_t*)(F.ws + WS_RG + ((size_t)chain * RCH + cc) * RG_TASK); const bf16_t* SS = (const bf16_t*)(F.ws + WS_SST) + ((size_t)chain * RCH + cc) * 4096;
        const float* YR = WSP(float, WS_YR) + (size_t)dir * MALL * 256;
        const u32x4 rv = *(const u32x4*)(RG + gr * 64 + gc), sv = *(const u32x4*)(SS + gr * 64 + gc);
        __syncthreads();
        *(LAS u32x4*)(Rl + gr * MP + gc) = rv; *(LAS u32x4*)(Sl + gr * MP + gc) = sv;
        __syncthreads();
        f32x4 acc[2]; mm64(Sl, Rl, w, lane, acc);
#pragma unroll
        for (int q = 0; q < 2; ++q) { const int n = (nb0 + q) * 16 + i; const int tor = dir ? 63 - n : n;
            const f32x4 yl = *(const f32x4*)(YR + (size_t)(row0 + tor) * 256 + head * 64 + m0);
            LAS f32x4* yp = (LAS f32x4*)(Ys + tor * 260 + head * 64 + m0);
            if (dir == 0) *yp = acc[q] + yl; else *yp = *yp + acc[q] + yl; }
    }
    __syncthreads();
    {
        const bf16_t* P = WSP(bf16_t, WS_P); const bf16_t* GB = WSP(bf16_t, WS_GB); const float* BS = WSP(float, WS_BS); bf16_t* YC = WSP(bf16_t, WS_YCAT);
        const int c4 = lane * 4; const f32x4 lg = *(const f32x4*)(F.in[20] + l * 256 + c4);
#pragma unroll 1
        for (int tt = w; tt < 64; tt += NWAVES) { const int row = row0 + tt;
            const f32x4 y = *(const LAS f32x4*)(Ys + tt * 260 + c4);
            const float ss = red16((y[0] * y[0] + y[1] * y[1]) + (y[2] * y[2] + y[3] * y[3]));
            const float rs = rsqrtf(ss * (1.f / 64.f) + EPSN);
            const f32x4 v = ld4bf(P + (size_t)row * DINP + C_RV + c4), g = ld4bf(GB + (size_t)row * 256 + c4);
            const float bn = BS[(size_t)row * 4 + (lane >> 4)];
            st4bf(YC + (size_t)row * DM + 256 + c4, (y * rs * lg * ZF(32) + bn * v * ZF(64)) * g * ZF(4)); }
    }
    __syncthreads();
}
__device__ __forceinline__ float clr7(float x) { return __uint_as_float(__float_as_uint(x) & 0xFFFFFF80u); }
__device__ __forceinline__ void ins16(float (&L)[16], float p) {
#pragma unroll
    for (int j = 15; j >= 1; --j) L[j] = __builtin_amdgcn_fmed3f(L[j - 1], L[j], p);
    L[0] = fmaxf(L[0], p);
}
__device__ __forceinline__ void peer_topk_task(const float* sg, size_t gstride, u32x2* eg) {
    float L0[16], L1[16];
#pragma unroll
    for (int j = 0; j < 16; ++j) { L0[j] = -INFINITY; L1[j] = -INFINITY; }
    for (int i = 0; i < 128; i += 4) {
        const f32x4 a = *(const f32x4*)(sg + (size_t)(i >> 2) * gstride), b = *(const f32x4*)(sg + (size_t)(32 + (i >> 2)) * gstride);
#pragma unroll
        for (int q = 0; q < 4; ++q) { ins16(L0, __uint_as_float((__float_as_uint(a[q]) & 0xFFFFFF80u) | (unsigned)(i + q)));
                                      ins16(L1, __uint_as_float((__float_as_uint(b[q]) & 0xFFFFFF80u) | (unsigned)(i + q))); }
    }
    float T[16];
#pragma unroll
    for (int j = 0; j < 16; ++j) T[j] = -INFINITY;
#pragma unroll
    for (int a = 0; a < 16; ++a)
#pragma unroll
        for (int b = 0; b < 16; ++b) if ((a + 1) * (b + 1) <= 16) { const float s = clr7(L0[a]) + clr7(L1[b]);
            ins16(T, __uint_as_float((__float_as_uint(s) & 0xFFFFFF00u) | (unsigned)(a * 16 + b))); }
    float e[16], sum = 0.f; const float mx = __uint_as_float(__float_as_uint(T[0]) & 0xFFFFFF00u);
#pragma unroll
    for (int j = 0; j < 16; ++j) { e[j] = __expf(__uint_as_float(__float_as_uint(T[j]) & 0xFFFFFF00u) - mx); sum += e[j]; }
    const float inv = 1.f / sum;
#pragma unroll
    for (int j = 0; j < 16; ++j) {
        const unsigned ab = __float_as_uint(T[j]) & 0xFFu, a = ab >> 4, b = ab & 15u; unsigned i0 = 0u, i1 = 0u;
#pragma unroll
        for (int q = 0; q < 16; ++q) { i0 = (a == (unsigned)q) ? (__float_as_uint(L0[q]) & 0x7Fu) : i0; i1 = (b == (unsigned)q) ? (__float_as_uint(L1[q]) & 0x7Fu) : i1; }
        eg[j] = (u32x2){i0 * 128u + i1, __float_as_uint(e[j] * inv)};
    }
}
__device__ __forceinline__ float gelu_tanh(float x) { const float u = 0.7978845608028654f * (x + 0.044715f * x * x * x); return 0.5f * x * (1.f + tanhf_(u)); }
__device__ __forceinline__ float dot2bf(unsigned w, unsigned x, float acc) { return __builtin_amdgcn_fdot2_f32_bf16(__builtin_bit_cast(bf16x2_t, w), __builtin_bit_cast(bf16x2_t, x), acc, false); }
__device__ __forceinline__ float wave_total63(float x) {
    x = red16(x);
    x += __int_as_float(__builtin_amdgcn_update_dpp(0, __float_as_int(x), 0x142, 0xa, 0xf, false));
    x += __int_as_float(__builtin_amdgcn_update_dpp(0, __float_as_int(x), 0x143, 0xc, 0xf, false));
    return x;
}
__device__ __forceinline__ void phase_peer(const Ctx& F, int l, int nrows, const float* mod, float* wr_override) {
    const float* S = WSP(float, WS_S); u32x2* EG = WSP(u32x2, WS_EG); const bf16_t* H = WSP(bf16_t, WS_H);
    const unsigned char* U = F.ws + WS_U + (size_t)l * UV_LSTRIDE; const unsigned char* V = F.ws + WS_V + (size_t)l * UV_LSTRIDE;
    const float* USC = WSP(float, WS_SC) + (size_t)l * 2 * 16384; const float* VSC = USC + 16384;
    const int tpb = nrows / F.G, tok0 = F.vcu * tpb;
    for (int task = F.tid; task < tpb * 8; task += NTHR) { const int hd = task / tpb, row = tok0 + (task - hd * tpb);
        peer_topk_task(S + ((size_t)(hd * 64) * MALL + row) * 4, (size_t)MALL * 4, EG + (size_t)row * 128 + hd * 16); }
    __threadfence_block(); __syncthreads();
    const int lane = F.lane;
    for (int tk = F.wave; tk < tpb; tk += NWAVES) {
        const int row = tok0 + tk; const bool isc = row >= MLAT; const int smp = isc ? 2 : (row >> 13);
        float* xrow = isc ? WSP(float, WS_XC) + (size_t)(row - MLAT) * DM : F.out + (size_t)row * DM;
        f32x2 hv[8];
        { const u32x4 h0 = *(const u32x4*)(H + (size_t)row * DM + lane * 16), h1 = *(const u32x4*)(H + (size_t)row * DM + lane * 16 + 8);
          const unsigned hw[8] = {h0.x, h0.y, h0.z, h0.w, h1.x, h1.y, h1.z, h1.w};
#pragma unroll
          for (int q = 0; q < 8; ++q) hv[q] = (f32x2){lo2f(hw[q]), hi2f(hw[q])}; }
        const u32x2 eg0 = EG[(size_t)row * 128 + lane], eg1 = EG[(size_t)row * 128 + 64 + lane];
        float act0 = 0.f, act1 = 0.f;
        constexpr int GS = 8, NG2 = 128 / (2 * GS);
        u32x4 ra[GS], rb[GS];
#define PG_LOAD(dst, tab, grp_) do { _Pragma("unroll") for (int q = 0; q < GS; ++q) { const int ii = (grp_) * GS + q; const unsigned e = __builtin_amdgcn_readlane(ii < 64 ? eg0.x : eg1.x, ii & 63); \
            dst[q] = *(const u32x4*)((tab) + (size_t)e * 1024 + lane * 16); } } while (0)
#define PG_UDOT(src, grp_) do { _Pragma("unroll") for (int q = 0; q < GS; ++q) { const int ii = (grp_) * GS + q; const unsigned e = __builtin_amdgcn_readlane(ii < 64 ? eg0.x : eg1.x, ii & 63); \
            const unsigned uw[4] = {src[q].x, src[q].y, src[q].z, src[q].w}; f32x2 d2 = {0.f, 0.f}; \
            _Pragma("unroll") for (int j = 0; j < 4; ++j) { d2 += __builtin_amdgcn_cvt_pk_f32_fp8((int)uw[j], false) * hv[2 * j]; d2 += __builtin_amdgcn_cvt_pk_f32_fp8((int)uw[j], true) * hv[2 * j + 1]; } \
            const float tot = __int_as_float(__builtin_amdgcn_readlane(__float_as_int(wave_total63(d2.x + d2.y)), 63)) * USC[e]; \
            if (ii < 64) act0 = (lane == (ii & 63)) ? tot : act0; else act1 = (lane == (ii & 63)) ? tot : act1; } } while (0)
        PG_LOAD(ra, U, 0);
#pragma unroll 1
        for (int g2 = 0; g2 < NG2; ++g2) {
            PG_LOAD(rb, U, 2 * g2 + 1); PG_UDOT(ra, 2 * g2);
            if (g2 < NG2 - 1) PG_LOAD(ra, U, 2 * g2 + 2); else PG_LOAD(ra, V, 0);
            PG_UDOT(rb, 2 * g2 + 1);
        }
        const float cf0 = __uint_as_float(eg0.y) * gelu_tanh(act0) * VSC[eg0.x], cf1 = __uint_as_float(eg1.y) * gelu_tanh(act1) * VSC[eg1.x];
        f32x2 ac[8];
#pragma unroll
        for (int q = 0; q < 8; ++q) ac[q] = (f32x2){0.f, 0.f};
#define PG_VACC(src, grp_) do { _Pragma("unroll") for (int q = 0; q < GS; ++q) { const int ii = (grp_) * GS + q; const float cf = __int_as_float(__builtin_amdgcn_readlane(__float_as_int(ii < 64 ? cf0 : cf1), ii & 63)); \
            const unsigned vw[4] = {src[q].x, src[q].y, src[q].z, src[q].w}; \
            _Pragma("unroll") for (int j = 0; j < 4; ++j) { ac[2 * j] += cf * __builtin_amdgcn_cvt_pk_f32_fp8((int)vw[j], false); ac[2 * j + 1] += cf * __builtin_amdgcn_cvt_pk_f32_fp8((int)vw[j], true); } } } while (0)
#pragma unroll 1
        for (int g2 = 0; g2 < NG2; ++g2) {
            PG_LOAD(rb, V, 2 * g2 + 1); PG_VACC(ra, 2 * g2);
            if (g2 < NG2 - 1) PG_LOAD(ra, V, 2 * g2 + 2);
            PG_VACC(rb, 2 * g2 + 1);
        }
#undef PG_LOAD
#undef PG_UDOT
#undef PG_VACC
        float acc[16];
#pragma unroll
        for (int q = 0; q < 8; ++q) { acc[2 * q] = ac[q].x; acc[2 * q + 1] = ac[q].y; }
        const float* gt = mod + smp * 6144 + 5120;
        f32x4 res[4]; float ss = 0.f;
#pragma unroll
        for (int q = 0; q < 4; ++q) { const int c = lane * 16 + q * 4; const f32x4 g = *(const f32x4*)(gt + c), x = *(const f32x4*)(xrow + c);
            res[q] = x + ZF(1) * g * (f32x4){acc[q * 4], acc[q * 4 + 1], acc[q * 4 + 2], acc[q * 4 + 3]};
            *(f32x4*)((wr_override ? wr_override + (size_t)row * DM : xrow) + c) = res[q];
            ss += (res[q][0] * res[q][0] + res[q][1] * res[q][1]) + (res[q][2] * res[q][2] + res[q][3] * res[q][3]); }
        if (l == 0 && !wr_override) {
            const float rs = rsqrtf(wave_sum(ss) * (1.f / DM) + EPSN); const float* mb1 = mod + 3 * 6144 + smp * 6144; const float* g1 = F.in[6] + DM;
            bf16_t* Hw = WSP(bf16_t, WS_H) + (size_t)row * DM;
#pragma unroll
            for (int q = 0; q < 4; ++q) { const int c = lane * 16 + q * 4; const f32x4 g = *(const f32x4*)(g1 + c), sc = *(const f32x4*)(mb1 + 1024 + c), sh = *(const f32x4*)(mb1 + c);
                st4bf(Hw + c, (res[q] * rs * g) * (1.f + sc) + sh); }
        }
    }
}

constexpr int PH_PER_LAYER = 10, N_PHASES = 1 + 2 * PH_PER_LAYER;
struct Args { const float* in[32]; float* out; unsigned char* ws; int ph_lo, ph_hi, li, pad; };
__global__ void __launch_bounds__(NTHR, 2) mk_fwd(Args args) {
    extern __shared__ __attribute__((aligned(16))) unsigned char lds[];
    Ctx F;
    F.lds = (LAS unsigned char*)lds;
    volatile LAS unsigned* MISC = (volatile LAS unsigned*)(F.lds + MISC_OFF);
    F.tid = threadIdx.x; F.lane = F.tid & 63; F.wave = __builtin_amdgcn_readfirstlane(F.tid >> 6);
    F.G = gridDim.x; { const int bx = blockIdx.x; F.vcu = (F.G % 8 == 0) ? (bx % 8) * (F.G / 8) + bx / 8 : bx; }
#pragma unroll
    for (int i = 0; i < 32; ++i) F.in[i] = args.in[i];
    F.out = args.out; F.ws = args.ws;
    for (int u = F.tid; u < (LDS_BYTES - LDSCTL_OFF) / 4; u += NTHR) ((LAS unsigned*)(F.lds + LDSCTL_OFF))[u] = 0u;
    __syncthreads();
    XcdBarrier bar; bar.bar = (unsigned*)(args.ws + WS_CTL) + CW_BAR; bar.x = 0; bar.st = nullptr;
#if !MK_MULTI
    bar = xcd_barrier_post((unsigned*)(args.ws + WS_CTL) + CW_BAR, MISC + 8);
#endif
    const int lo = args.ph_lo, hi = args.ph_hi;
#ifndef KMAX
#define KMAX 1000
#endif
#define IN(k) (lo <= (k) && (k) < hi && (REP_ALL == 1 || ra == REP_ALL - 1 || (k) <= KMAX))
#ifndef REP_PH
#define REP_PH -1
#endif
#define REPS(k) ((REP_PH == (k)) ? 2 : 1)
#define PHCTX Ctx Fp = F; { int t_ = F.tid; asm volatile("" : "+v"(t_)); Fp.tid = t_; Fp.lane = t_ & 63; }
#if MK_MULTI
#define SEAM(k) do { } while (0)
#else
#ifndef BAR_REPS
#define BAR_REPS 1
#endif
#define SEAM(k) do { if (IN(k) && IN((k) + 1)) for (int br_ = 0; br_ < BAR_REPS; ++br_) xcd_barrier(bar); } while (0)
#endif
#ifndef REP_ALL
#define REP_ALL 1
#endif
#ifndef REP_SUB
#define REP_SUB 0
#endif
#pragma unroll 1
    for (int ra = 0; ra < REP_ALL; ++ra) {
    if (ra > 0) xcd_barrier(bar);
    if (IN(0)) { PHCTX; for (int rep = 0; rep < REPS(100); ++rep) phase_prologue(Fp); }
    SEAM(0);
    float* XC = WSP(float, WS_XC);
#pragma unroll 1
    for (int l = 0; l < 2; ++l) {
        const int pb = 1 + l * PH_PER_LAYER;
        const float* xlat = l == 0 ? F.in[0] : F.out; const float* xctx = l == 0 ? F.in[2] : XC;
        const int mrows = l == 0 ? MALL : MLAT;
        const float* mod = WSP(float, WS_MOD) + (size_t)l * 3 * 6144;
        if (IN(pb + 0) && l == 0) { PHCTX; for (int rep = 0; rep < REPS(0); ++rep) { phase_norm(Fp, l, 0, MALL, xlat, xctx); } }
        if (l == 0) SEAM(pb + 0);
        if (IN(pb + 1)) for (int rep = 0; rep < REPS(1); ++rep) { PHCTX; pg8::Gemm g{WSP(bf16_t, WS_H), WSP(bf16_t, WS_WIN + l * WIN_LSTRIDE), MALL, DINP, DM}; pg8::StaticOrder So; So.init(MALL, DINP, F.G, (int)blockIdx.x);
            pg8::EpiBf16 E{WSP(bf16_t, WS_P), DINP}; pg8::gemm_phase<pg8::EpiBf16, pg8::StaticOrder, true, true>(F.lds, g, So, E, Fp.tid); }
        SEAM(pb + 1);
        if (IN(pb + 2)) { PHCTX; for (int rep = 0; rep < REPS(2); ++rep) { phase_prep(Fp, l); __syncthreads(); } }
        SEAM(pb + 2);
        if (IN(pb + 3)) for (int rep = 0; rep < REPS(3); ++rep) {
            const int nra = 16 * RCH, nml = 16 * NCHK;
            for (int r3 = 0; r3 < (REP_SUB == 3 ? 2 : 1); ++r3) { PHCTX; for (int task = F.vcu; task < nra; task += F.G) rwkv_chunk_pre(Fp, task); }
            for (int r3 = 0; r3 < (REP_SUB == 4 ? 2 : 1); ++r3) { PHCTX; for (int task = (F.vcu + F.G - 72) % F.G; task < nml; task += F.G) mlstm_local(Fp, task); }
        }
        SEAM(pb + 3);
                if (IN(pb + 4)) for (int rep = 0; rep < REPS(4); ++rep) {
            if (F.vcu < 16) { PHCTX; rwkv_chain(Fp, F.vcu); }
            else { { PHCTX; mlstm_chain(Fp, 16); }
                   { PHCTX; const int natt = l == 0 ? 264 : 256; for (int task = F.vcu - 16; task < natt; task += F.G - 16) attn_unit(Fp, l, task); } } }
        SEAM(pb + 4);
        if (IN(pb + 5)) for (int rep = 0; rep < REPS(5); ++rep) { const int nro = l == 0 ? 264 : 256, nun = l == 0 ? 528 : 512;
            { PHCTX; for (int u = F.vcu; u < nro; u += F.G) rwkv_out(Fp, l, u); }
            { PHCTX; for (int u = (F.vcu + F.G - 8) % F.G; u < nun; u += F.G) mlstm_out(Fp, l, u); } }
        SEAM(pb + 5);
        if (IN(pb + 6)) for (int rep = 0; rep < REPS(6); ++rep) { PHCTX; pg8::Gemm g{WSP(bf16_t, WS_YCAT), WSP(bf16_t, WS_WOUT + l * WOUT_LSTRIDE), mrows, DM, DM}; pg8::StaticOrder So; So.init(mrows, DM, F.G, (int)blockIdx.x);
            float* dummy = WSP(float, WS_YR); const bool dm_ = (REPS(6) == 2 && rep == 0); pg8::EpiRes E{xlat, xctx, dm_ ? dummy : F.out, dm_ ? dummy : XC, mod}; pg8::gemm_phase<pg8::EpiRes, pg8::StaticOrder, true, true>(F.lds, g, So, E, Fp.tid); }
        SEAM(pb + 6);
        if (IN(pb + 7)) { PHCTX; for (int rep = 0; rep < REPS(7); ++rep) phase_norm(Fp, l, 1, mrows, F.out, XC); }
        SEAM(pb + 7);
        if (IN(pb + 8)) for (int rep = 0; rep < REPS(8); ++rep) { PHCTX; pg8::Gemm g{WSP(bf16_t, WS_H), WSP(bf16_t, WS_WEFF + l * WEFF_LSTRIDE), mrows, 2048, DM}; pg8::StaticOrder So; So.init(mrows, 2048, F.G, (int)blockIdx.x);
            pg8::EpiF32 E{WSP(float, WS_S), MALL}; pg8::gemm_phase<pg8::EpiF32, pg8::StaticOrder, true, true>(F.lds, g, So, E, Fp.tid); }
        SEAM(pb + 8);
        if (IN(pb + 9)) { PHCTX; for (int rep = 0; rep < REPS(9); ++rep) { phase_peer(Fp, l, mrows, mod, (REPS(9) == 2 && rep == 0) ? WSP(float, WS_YR) : nullptr); __syncthreads(); } }
        SEAM(pb + 9);
    }
    }
#undef IN
#undef SEAM
}

extern "C" void kernel_launch(void* const* d_in, const int* in_sizes, int n_in, void* d_out, int out_size, void* d_ws, size_t ws_size, hipStream_t stream) {
    static int grid = 0;
    if (grid == 0) {
        if (n_in != 32 || out_size != MLAT * DM || ws_size < WS_END2) { fprintf(stderr, "kernel_launch: unexpected shapes: n_in %d out %d ws %zu (need %zu)\n", n_in, out_size, ws_size, (size_t)WS_END2); grid = -1; return; }
        int dev = 0, cus = 0, per_cu = 0;
        if (hipGetDevice(&dev) != hipSuccess || hipDeviceGetAttribute(&cus, hipDeviceAttributeMultiprocessorCount, dev) != hipSuccess) { grid = -1; return; }
        if (hipFuncSetAttribute((const void*)mk_fwd, hipFuncAttributeMaxDynamicSharedMemorySize, LDS_BYTES) != hipSuccess) { fprintf(stderr, "kernel_launch: hipFuncSetAttribute failed\n"); grid = -1; return; }
        if (hipOccupancyMaxActiveBlocksPerMultiprocessor(&per_cu, (const void*)mk_fwd, NTHR, LDS_BYTES) != hipSuccess || per_cu < 1) fprintf(stderr, "kernel_launch: occupancy query reports %d\n", per_cu);
        (void)hipGetLastError();
        grid = cus;
        if (grid != 256) fprintf(stderr, "kernel_launch: grid %d (built for 256 CUs)\n", grid);
    }
    if (grid < 0) return;
    (void)hipMemsetAsync((char*)d_ws + WS_CTL, 0, CTL_ZERO_BYTES, stream);
    Args a{};
    for (int i = 0; i < 32; ++i) a.in[i] = (const float*)d_in[i];
    a.out = (float*)d_out; a.ws = (unsigned char*)d_ws;
#if MK_MULTI
    for (int p = 0; p < N_PHASES; ++p) { a.ph_lo = p; a.ph_hi = p + 1; a.li = p; hipLaunchKernelGGL(mk_fwd, dim3(grid), dim3(NTHR), LDS_BYTES, stream, a); }
#else
    a.ph_lo = 0; a.ph_hi = N_PHASES; a.li = 0;
    hipLaunchKernelGGL(mk_fwd, dim3(grid), dim3(NTHR), LDS_BYTES, stream, a);
#endif
}
```

```cpp
#include <hip/hip_runtime.h>
#include <cstdio>
#include <cstdint>

#ifndef MK_MULTI
#define MK_MULTI 0
#endif
namespace pg8 {
#define PG8_LAS __attribute__((address_space(3)))
typedef unsigned short bf16_t;
typedef short bf16x8 __attribute__((ext_vector_type(8)));
typedef float f32x4 __attribute__((ext_vector_type(4)));
typedef unsigned u32x4 __attribute__((ext_vector_type(4)));
constexpr int BM = 256, BK = 64, HALF = 128, HTB = HALF * BK * 2  , STAGE_BYTES = 8 * HTB, NXCD = 8, WGM = 8;

__host__ __device__ __forceinline__ int lds_byte(int r, int c) { const int st = (r >> 4) * 2 + (c >> 5), rr = r & 15, cc = c & 31, ob = rr * 64 + cc * 2; return st * 1024 + (ob ^ (((ob >> 9) & 1) << 5)); }
__host__ __device__ __forceinline__ void stage_rc(int b, int& R, int& C) { const int st = b / 1024, sb = b % 1024, swz = sb ^ (((sb >> 9) & 1) << 5); R = (st >> 1) * 16 + swz / 64; C = (st & 1) * 32 + (swz % 64) / 2; }
__host__ __device__ __forceinline__ int perm32(int rho) { const int n = rho >> 4, i = rho & 15; return 8 * (i >> 2) + 4 * n + (i & 3); }

struct Unit { int pm, pn; };
struct Gemm { const bf16_t* A; const bf16_t* Bt; int M, N, K; };

struct StaticOrder {
    int nM, nN, nwg, G, c;
    __host__ __device__ void init(int M, int N, int G_, int c_) { nM = M / BM; nN = N / BM; nwg = nM * nN; G = G_; c = c_; }
    __host__ __device__ bool next(int i, Unit& u) const {
        const long L = (long)i * G + c; if (L >= nwg) return false;
        int wgid = (int)L; { const int q = nwg / NXCD, r = nwg % NXCD, xcd = wgid % NXCD, off = wgid / NXCD; wgid = (xcd < r ? xcd * (q + 1) : r * (q + 1) + (xcd - r) * q) + off; }
        const int nig = WGM * nN, gid = wgid / nig, fm = gid * WGM, gsz = (nM - fm) < WGM ? (nM - fm) : WGM;
        u.pm = fm + ((wgid % nig) % gsz); u.pn = (wgid % nig) / gsz; return true;
    }
    __device__ __forceinline__ void a_ready(const Unit&) const {}
    __device__ __forceinline__ void done(const Unit&) const {}
};

__device__ __forceinline__ unsigned cvt_pk_bf16(float lo, float hi) { unsigned r; asm volatile("v_cvt_pk_bf16_f32 %0, %1, %2" : "=v"(r) : "v"(lo), "v"(hi)); return r; }

struct EpiBf16 {
    static constexpr bool PERM = true, AFTER_DRAIN = false;
    bf16_t* O; int ldc;
    __device__ __forceinline__ void operator()(const f32x4 (&acc)[2][2][4][2], const Unit& u, int wr, int wc, int fr, int fq) const {
        const int row0 = u.pm * BM + wr * 64 + fr; const int col0 = u.pn * BM + wc * 32 + 8 * fq;
#pragma unroll
        for (int ai = 0; ai < 2; ++ai)
#pragma unroll
            for (int m = 0; m < 4; ++m) { bf16_t* rowp = O + (size_t)(row0 + ai * HALF + m * 16) * ldc + col0;
#pragma unroll
                for (int bj = 0; bj < 2; ++bj) { const f32x4 v0 = acc[ai][bj][m][0], v1 = acc[ai][bj][m][1];
                    u32x4 w; w.x = cvt_pk_bf16(v0[0], v0[1]); w.y = cvt_pk_bf16(v0[2], v0[3]); w.z = cvt_pk_bf16(v1[0], v1[1]); w.w = cvt_pk_bf16(v1[2], v1[3]);
                    *(u32x4*)(rowp + bj * HALF) = w; } }
    }
};
struct EpiF32 {
    static constexpr bool PERM = false, AFTER_DRAIN = false;
    float* O; int ldr;
    __device__ __forceinline__ void operator()(const f32x4 (&acc)[2][2][4][2], const Unit& u, int wr, int wc, int fr, int fq) const {
        const int row0 = u.pm * BM + wr * 64 + fr; const int col0 = u.pn * BM + wc * 32 + 4 * fq;
#pragma unroll
        for (int ai = 0; ai < 2; ++ai)
#pragma unroll
            for (int m = 0; m < 4; ++m) { const int row = row0 + ai * HALF + m * 16;
#pragma unroll
                for (int bj = 0; bj < 2; ++bj)
#pragma unroll
                    for (int n = 0; n < 2; ++n) { const int cg = (col0 + bj * HALF + n * 16) >> 2; *(f32x4*)(O + ((size_t)cg * ldr + row) * 4) = acc[ai][bj][m][n]; } }
    }
};
struct EpiRes {
    static constexpr bool PERM = false, AFTER_DRAIN = false;
    const float* src_lat; const float* src_ctx; float* dst_lat; float* dst_ctx; const float* gate;
    __device__ __forceinline__ void operator()(const f32x4 (&acc)[2][2][4][2], const Unit& u, int wr, int wc, int fr, int fq) const {
        const bool isc = u.pm >= 64; const int smp = isc ? 2 : (u.pm >> 5);
        const int prow = (isc ? (u.pm - 64) * BM : u.pm * BM) + wr * 64 + fr;
        const float* src = isc ? src_ctx : src_lat; float* dst = isc ? dst_ctx : dst_lat;
        const float* gt = gate + smp * 6144 + 2048;
        const int col0 = u.pn * BM + wc * 32 + 4 * fq;
        f32x4 gv[2][2];
#pragma unroll
        for (int bj = 0; bj < 2; ++bj)
#pragma unroll
            for (int n = 0; n < 2; ++n) gv[bj][n] = *(const f32x4*)(gt + col0 + bj * HALF + n * 16);
#pragma unroll
        for (int ai = 0; ai < 2; ++ai)
#pragma unroll
            for (int m = 0; m < 4; ++m) { const size_t off = (size_t)(prow + ai * HALF + m * 16) * 1024 + col0;
#pragma unroll
                for (int bj = 0; bj < 2; ++bj)
#pragma unroll
                    for (int n = 0; n < 2; ++n) { const f32x4 s = *(const f32x4*)(src + off + bj * HALF + n * 16);
                        *(f32x4*)(dst + off + bj * HALF + n * 16) = s + gv[bj][n] * acc[ai][bj][m][n]; } }
    }
};

template <class Epi, class Sched, bool ALIGN_EPI = false, bool SP2 = false>
__device__ __forceinline__ void gemm_phase(PG8_LAS unsigned char* lds, const Gemm g, const Sched& S, const Epi& E, const int tid) {
    const int wid = __builtin_amdgcn_readfirstlane(tid >> 6), lane = tid & 63, wr = wid >> 2, wc = wid & 3, fr = lane & 15, fq = lane >> 4;
    const int K = g.K, nt = K / BK;
    unsigned voffA[2], voffB[2];
#pragma unroll
    for (int i = 0; i < 2; ++i) { int R, C; stage_rc(tid * 16 + i * 8192, R, C); const int Rb = Epi::PERM ? ((R & ~31) + perm32(R & 31)) : R;
        voffA[i] = (unsigned)(R * K + C) * 2u; voffB[i] = (unsigned)(Rb * K + C) * 2u; }
    const size_t kstep = (size_t)(BK * 2);
    const size_t hstep = (size_t)HALF * K * 2;
    const size_t tstep = 2 * hstep;
    const unsigned ldsw = (unsigned)wid * 1024u;
    const int aoff = lds_byte(wr * 64 + fr, fq * 8), boff = lds_byte(wc * 32 + fr, fq * 8);
#define PG8_SA(b, h) (((b) * 2 + (h)) * HTB)
#define PG8_SB(b, h) ((4 + (b) * 2 + (h)) * HTB)
#define PG8_STAGE(bufoff, gbase, voff) do { _Pragma("unroll") for (int _i = 0; _i < 2; ++_i) \
        __builtin_amdgcn_global_load_lds((const unsigned*)((const char*)(gbase) + (voff)[_i]), (PG8_LAS unsigned*)(lds + (bufoff) + ldsw + _i * 8192), 16, 0, 0); } while (0)
#define PG8_LDA(dst, b, h) do { _Pragma("unroll") for (int m = 0; m < 4; ++m) _Pragma("unroll") for (int k = 0; k < 2; ++k) dst[m][k] = *(const PG8_LAS bf16x8*)(lds + PG8_SA(b, h) + aoff + m * 2048 + k * 1024); } while (0)
#define PG8_LDB(dst, b, h) do { _Pragma("unroll") for (int n = 0; n < 2; ++n) _Pragma("unroll") for (int k = 0; k < 2; ++k) dst[n][k] = *(const PG8_LAS bf16x8*)(lds + PG8_SB(b, h) + boff + n * 2048 + k * 1024); } while (0)
#define PG8_MMA(ai, bj, At, Bt) do { __builtin_amdgcn_s_setprio(1); _Pragma("unroll") for (int m = 0; m < 4; ++m) _Pragma("unroll") for (int n = 0; n < 2; ++n) _Pragma("unroll") for (int k = 0; k < 2; ++k) \
        acc[ai][bj][m][n] = __builtin_amdgcn_mfma_f32_16x16x32_bf16(Bt[n][k], At[m][k], acc[ai][bj][m][n], 0, 0, 0); __builtin_amdgcn_s_setprio(0); } while (0)
#define PG8_WAIT_V(n) asm volatile("s_waitcnt vmcnt(" #n ")" ::: "memory")
#define PG8_WAIT_L(n) asm volatile("s_waitcnt lgkmcnt(" #n ")" ::: "memory")
#define PG8_BAR __builtin_amdgcn_s_barrier()
#define PG8_SCHED __builtin_amdgcn_sched_barrier(0)
    Unit cur, nxt; int ui = 0;
    if (!S.next(0, cur)) return;
    f32x4 acc[2][2][4][2];
#pragma unroll
    for (int a = 0; a < 2; ++a)
#pragma unroll
        for (int b = 0; b < 2; ++b)
#pragma unroll
            for (int m = 0; m < 4; ++m)
#pragma unroll
                for (int n = 0; n < 2; ++n) acc[a][b][m][n] = (f32x4){0.f, 0.f, 0.f, 0.f};
    bf16x8 At[4][2], B0[2][2], B1[2][2];
    const char* cA = (const char*)g.A + (size_t)cur.pm * tstep; const char* cB = (const char*)g.Bt + (size_t)cur.pn * tstep;
    S.a_ready(cur);
    if constexpr (SP2) {
        PG8_STAGE(PG8_SB(0, 0), cB, voffB); PG8_STAGE(PG8_SB(0, 1), cB + hstep, voffB); PG8_STAGE(PG8_SA(0, 0), cA, voffA); PG8_STAGE(PG8_SA(0, 1), cA + hstep, voffA);
        if (wr == 1) PG8_BAR;
        PG8_WAIT_V(2); PG8_BAR;
        PG8_STAGE(PG8_SB(1, 0), cB + kstep, voffB); PG8_STAGE(PG8_SA(1, 0), cA + kstep, voffA); PG8_STAGE(PG8_SB(1, 1), cB + hstep + kstep, voffB);
        PG8_WAIT_V(6); PG8_BAR;
    } else {
        PG8_STAGE(PG8_SB(0, 0), cB, voffB); PG8_STAGE(PG8_SA(0, 0), cA, voffA); PG8_STAGE(PG8_SB(0, 1), cB + hstep, voffB); PG8_STAGE(PG8_SA(0, 1), cA + hstep, voffA);
        if (wr == 1) PG8_BAR;
        PG8_WAIT_V(4); PG8_BAR;
        PG8_STAGE(PG8_SB(1, 0), cB + kstep, voffB); PG8_STAGE(PG8_SA(1, 0), cA + kstep, voffA); PG8_STAGE(PG8_SB(1, 1), cB + hstep + kstep, voffB);
        PG8_WAIT_V(6); PG8_BAR;
    }
    for (;;) {
        const bool has_next = S.next(ui + 1, nxt);
        const char* nA = has_next ? (const char*)g.A + (size_t)nxt.pm * tstep : cA; const char* nB = has_next ? (const char*)g.Bt + (size_t)nxt.pn * tstep : cB;
        for (int t = 0; t < nt; t += 2) {
            const bool last = (t == nt - 2);
            const char* a1 = cA + (size_t)(t + 1) * kstep;
            const char* a2 = last ? nA : cA + (size_t)(t + 2) * kstep; const char* b2 = last ? nB : cB + (size_t)(t + 2) * kstep;
            const char* a3 = a2 + kstep; const char* b3 = b2 + kstep;
            if (last && has_next) S.a_ready(nxt);
            if constexpr (SP2) {
            PG8_LDB(B0, 0, 0); PG8_LDB(B1, 0, 1); PG8_SCHED; PG8_LDA(At, 0, 0); PG8_STAGE(PG8_SA(1, 1), a1 + hstep, voffA);
            PG8_WAIT_V(8); PG8_WAIT_L(0); PG8_BAR; PG8_MMA(0, 0, At, B0); PG8_MMA(0, 1, At, B1); PG8_BAR; PG8_SCHED;
            PG8_LDA(At, 0, 1); PG8_STAGE(PG8_SB(0, 0), b2, voffB); PG8_STAGE(PG8_SB(0, 1), b2 + hstep, voffB); PG8_STAGE(PG8_SA(0, 0), a2, voffA);
            PG8_WAIT_V(8); PG8_WAIT_L(0); PG8_BAR; PG8_MMA(1, 0, At, B0); PG8_MMA(1, 1, At, B1); PG8_BAR; PG8_SCHED;
            PG8_LDB(B0, 1, 0); PG8_LDB(B1, 1, 1); PG8_SCHED; PG8_LDA(At, 1, 0); PG8_STAGE(PG8_SA(0, 1), a2 + hstep, voffA);
            PG8_WAIT_V(8); PG8_WAIT_L(0); PG8_BAR; PG8_MMA(0, 0, At, B0); PG8_MMA(0, 1, At, B1); PG8_BAR; PG8_SCHED;
            PG8_LDA(At, 1, 1); PG8_STAGE(PG8_SB(1, 0), b3, voffB); PG8_STAGE(PG8_SB(1, 1), b3 + hstep, voffB); PG8_STAGE(PG8_SA(1, 0), a3, voffA);
            PG8_WAIT_V(8); PG8_WAIT_L(0); PG8_BAR; PG8_MMA(1, 0, At, B0); PG8_MMA(1, 1, At, B1); PG8_BAR; PG8_SCHED;
            } else {
            PG8_LDB(B0, 0, 0); PG8_SCHED; PG8_LDA(At, 0, 0); PG8_STAGE(PG8_SA(1, 1), a1 + hstep, voffA);
            PG8_WAIT_L(8); PG8_BAR; PG8_WAIT_L(0); PG8_MMA(0, 0, At, B0); PG8_BAR; PG8_SCHED;
            PG8_LDB(B1, 0, 1); PG8_STAGE(PG8_SB(0, 0), b2, voffB);
            PG8_BAR; PG8_WAIT_L(0); PG8_MMA(0, 1, At, B1); PG8_BAR;
            PG8_LDA(At, 0, 1); PG8_STAGE(PG8_SA(0, 0), a2, voffA);
            PG8_BAR; PG8_WAIT_L(0); PG8_MMA(1, 0, At, B0); PG8_BAR; PG8_SCHED;
            PG8_STAGE(PG8_SB(0, 1), b2 + hstep, voffB);
            PG8_WAIT_V(6); PG8_BAR; PG8_MMA(1, 1, At, B1); PG8_BAR;
            PG8_LDB(B0, 1, 0); PG8_SCHED; PG8_LDA(At, 1, 0); PG8_STAGE(PG8_SA(0, 1), a2 + hstep, voffA);
            PG8_WAIT_L(8); PG8_BAR; PG8_WAIT_L(0); PG8_MMA(0, 0, At, B0); PG8_BAR; PG8_SCHED;
            PG8_LDB(B1, 1, 1); PG8_STAGE(PG8_SB(1, 0), b3, voffB);
            PG8_BAR; PG8_WAIT_L(0); PG8_MMA(0, 1, At, B1); PG8_BAR;
            PG8_LDA(At, 1, 1); PG8_STAGE(PG8_SA(1, 0), a3, voffA);
            PG8_BAR; PG8_WAIT_L(0); PG8_MMA(1, 0, At, B0); PG8_BAR; PG8_SCHED;
            PG8_STAGE(PG8_SB(1, 1), b3 + hstep, voffB);
            PG8_WAIT_V(6); PG8_BAR; PG8_MMA(1, 1, At, B1); PG8_BAR;
            }
        }
        if constexpr (ALIGN_EPI) { if (wr == 0) PG8_BAR; }
        if constexpr (!Epi::AFTER_DRAIN) { E(acc, cur, wr, wc, fr, fq); S.done(cur); }
        if (!has_next) break;
#pragma unroll
        for (int a = 0; a < 2; ++a)
#pragma unroll
            for (int b = 0; b < 2; ++b)
#pragma unroll
                for (int m = 0; m < 4; ++m)
#pragma unroll
                    for (int n = 0; n < 2; ++n) acc[a][b][m][n] = (f32x4){0.f, 0.f, 0.f, 0.f};
        cur = nxt; cA = nA; cB = nB; ++ui;
        if constexpr (ALIGN_EPI) { if (wr == 1) PG8_BAR; }
    }
    PG8_WAIT_V(0);
    if constexpr (!ALIGN_EPI) { if (wr == 0) PG8_BAR; }
    PG8_BAR;
    if constexpr (Epi::AFTER_DRAIN) { E.fused(acc, cur, wr, wc, fr, fq, lds, wid, lane); S.done(cur); }
#undef PG8_SA
#undef PG8_SB
#undef PG8_STAGE
#undef PG8_LDA
#undef PG8_LDB
#undef PG8_MMA
#undef PG8_WAIT_V
#undef PG8_WAIT_L
#undef PG8_BAR
#undef PG8_SCHED
}
}
#ifndef ZMASK
#define ZMASK 0
#endif
#define ZF(bit) ((ZMASK & (bit)) ? 0.f : 1.f)
using pg8::bf16_t; using pg8::bf16x8; using pg8::f32x4; using pg8::u32x4;
constexpr int NWAVES = 8, NTHR = 512;
constexpr int DM = 1024, TLAT = 8192, TCTX = 256, MLAT = 2 * TLAT, MCTX = 2 * TCTX, MALL = MLAT + MCTX;
constexpr int DIN = 3152, DINP = 3328;
constexpr int C_CH = 0, C_CB = 256, C_CC = 512, C_RR = 768, C_RK = 1024, C_RV = 1280, C_XW = 1536, C_XA = 1552, C_XG = 1568,
              C_AQ = 1600, C_AK = 1856, C_AV = 1984, C_MQ = 2112, C_MK = 2368, C_MV = 2624, C_MO = 2880, C_MG = 3136;
constexpr float EPSN = 1e-6f;
constexpr int NCHK = 66;
constexpr int CST = 4160;
constexpr int RWREC = 4608;
constexpr size_t MiB = 1u << 20;
constexpr size_t WS_CTL = 0, CTL_ZERO_BYTES = 1 * MiB, WS_MOD = 1 * MiB;
constexpr size_t WS_WIN = 2 * MiB, WIN_LSTRIDE = (size_t)DINP * DM * 2;
constexpr size_t WS_WOUT = 16 * MiB, WOUT_LSTRIDE = 2 * MiB;
constexpr size_t WS_WEFF = 20 * MiB, WEFF_LSTRIDE = 4 * MiB;
constexpr size_t WS_XC = 28 * MiB, WS_GA = 30 * MiB, WS_H = 32 * MiB, WS_YCAT = 65 * MiB, WS_U = 98 * MiB, WS_V = 130 * MiB;
constexpr size_t WS_P = 162 * MiB, WS_RW = 270 * MiB, WS_YR = 345 * MiB, WS_QA = 378 * MiB, WS_KA = 387 * MiB;
constexpr size_t WS_LC = 392 * MiB, WS_ST = 409 * MiB, WS_LB = 426 * MiB, WS_EG = 427 * MiB, WS_GB = 444 * MiB, WS_BS = 453 * MiB, WS_SC = 453 * MiB + 512 * 1024, WS_END = 454 * MiB;
constexpr size_t UV_LSTRIDE = 16 * MiB;
constexpr size_t WS_S = WS_P;
static_assert(WS_P + (size_t)MALL * DINP * 2 <= WS_RW && WS_RW + (size_t)MALL * RWREC <= WS_YR && WS_S + (size_t)MALL * 2048 * 4 <= WS_YR, "ws map");
static_assert(WS_LC + (size_t)16 * NCHK * CST * 4 <= WS_ST && WS_ST + (size_t)16 * NCHK * CST * 4 <= WS_LB && WS_EG + (size_t)MALL * 128 * 8 <= WS_GB, "ws map 2");
constexpr int CW_BAR = 4096;
constexpr int RING_BYTES = 131072, LDSCTL_OFF = RING_BYTES, MISC_OFF = LDSCTL_OFF + 320, LDS_BYTES = 147456;

#define GAS __attribute__((address_space(1)))
#define LAS __attribute__((address_space(3)))
typedef unsigned u32x2 __attribute__((ext_vector_type(2)));
typedef float f32x2 __attribute__((ext_vector_type(2)));
typedef __bf16 bf16x2_t __attribute__((ext_vector_type(2)));
typedef GAS unsigned gu32;
#define LDS_WAIT() asm volatile("s_waitcnt lgkmcnt(0)" ::: "memory")
#define LDS_BARRIER() do { asm volatile("s_waitcnt lgkmcnt(0)" ::: "memory"); __builtin_amdgcn_s_barrier(); asm volatile("" ::: "memory"); } while (0)

__device__ __forceinline__ float lo2f(unsigned w) { return __uint_as_float(w << 16); }
__device__ __forceinline__ float hi2f(unsigned w) { return __uint_as_float(w & 0xffff0000u); }
__device__ __forceinline__ float bf2f(bf16_t b) { return __uint_as_float((unsigned)b << 16); }
__device__ __forceinline__ unsigned f2bf(float f) { unsigned u = __float_as_uint(f); return (u + 0x7fffu + ((u >> 16) & 1u)) >> 16; }
__device__ __forceinline__ unsigned pk2(float lo, float hi) { const f32x2 v = {lo, hi}; const bf16x2_t b = __builtin_convertvector(v, bf16x2_t); return __builtin_bit_cast(unsigned, b); }
__device__ __forceinline__ f32x4 ld4bf(const bf16_t* p) { const u32x2 w = *(const u32x2*)p; return (f32x4){lo2f(w.x), hi2f(w.x), lo2f(w.y), hi2f(w.y)}; }
__device__ __forceinline__ void st4bf(bf16_t* p, f32x4 v) { u32x2 w; w.x = pk2(v[0], v[1]); w.y = pk2(v[2], v[3]); *(u32x2*)p = w; }
__device__ __forceinline__ float sigmoidf_(float x) { return 1.f / (1.f + __expf(-x)); }
__device__ __forceinline__ float tanhf_(float x) { const float e = __expf(-2.f * fabsf(x)); const float t = (1.f - e) / (1.f + e); return x < 0.f ? -t : t; }
template <int CTRL> __device__ __forceinline__ float dppf(float x) { return __int_as_float(__builtin_amdgcn_update_dpp(0, __float_as_int(x), CTRL, 0xf, 0xf, true)); }
__device__ __forceinline__ float red16(float x) { x += dppf<0xB1>(x); x += dppf<0x4E>(x); x += dppf<0x141>(x); x += dppf<0x140>(x); return x; }
__device__ __forceinline__ float wave_sum(float v) {
#pragma unroll
    for (int o = 1; o < 64; o <<= 1) v += __shfl_xor(v, o);
    return v;
}
#define XB_TMO      128
#define XB_XCNT(j)  (256  + 64 * (j))
#define XB_XSUB(j)  (1280 + 64 * (j))
#define XB_XGEN(j)  (2304 + 64 * (j))
#define XB_TOP      3328
#define XB_TOPGEN   3392
#define XCD_BAR_WORDS 3456
#define XB_SPIN_CAP (1u << 18)
#ifndef XB_SLEEP
#define XB_SLEEP 1
#endif

__device__ __forceinline__ unsigned xb_ld(unsigned* p)              { return __hip_atomic_load(p, __ATOMIC_RELAXED, __HIP_MEMORY_SCOPE_AGENT); }
__device__ __forceinline__ unsigned xb_add(unsigned* p, unsigned v) { return __hip_atomic_fetch_add(p, v, __ATOMIC_RELAXED, __HIP_MEMORY_SCOPE_AGENT); }
__device__ __forceinline__ unsigned xb_xcc_id() { return (unsigned)__builtin_amdgcn_s_getreg((3 << 11) | 20) & 0xFu; }
#define XB_SPIN(cond, bar) do { unsigned _sp = 0; while (cond) { __builtin_amdgcn_s_sleep(XB_SLEEP); \
    if ((++_sp & 255u) == 0u) { if (xb_ld(&(bar)[XB_TMO])) break; if (_sp > XB_SPIN_CAP) { atomicAdd(&(bar)[XB_TMO], 1u); break; } } } } while (0)

struct XcdBarrier {
    unsigned* bar; unsigned x;
    volatile LAS unsigned* st;
};

__device__ __forceinline__ XcdBarrier xcd_barrier_post(unsigned* bar, volatile LAS unsigned* st) {
    XcdBarrier b; b.bar = bar; b.x = xb_xcc_id(); b.st = st;
    if (threadIdx.x == 0) (void)xb_add(&bar[XB_XCNT(b.x)], 1u);
    return b;
}
__device__ __forceinline__ void xcd_barrier_complete(unsigned* bar, unsigned x, unsigned& nloc, unsigned& nx) {
    const unsigned G = gridDim.x * gridDim.y * gridDim.z;
    unsigned sum, cnt, mine, sp = 0u;
    for (;;) {
        sum = 0u; cnt = 0u; mine = 0u;
#pragma unroll
        for (unsigned j = 0; j < 16; ++j) { const unsigned c = xb_ld(&bar[XB_XCNT(j)]); sum += c; cnt += (c > 0u) ? 1u : 0u; mine = (j == x) ? c : mine; }
        if (sum == G) break;
        __builtin_amdgcn_s_sleep(1);
        if ((++sp & 255u) == 0u) { if (xb_ld(&bar[XB_TMO])) break; if (sp > XB_SPIN_CAP) { atomicAdd(&bar[XB_TMO], 1u); break; } }
    }
    nloc = mine > 0u ? mine : 1u; nx = cnt > 0u ? cnt : 1u;
}

__device__ __forceinline__ void xcd_barrier(const XcdBarrier& b) {
    asm volatile("s_waitcnt vmcnt(0)" ::: "memory");
    __syncthreads();
    if (threadIdx.x == 0) {
        unsigned* bar = b.bar;
        __builtin_amdgcn_s_waitcnt(0);
        unsigned nloc = b.st[0], nx = b.st[1];
        if (nloc == 0u) { xcd_barrier_complete(bar, b.x, nloc, nx); b.st[0] = nloc; b.st[1] = nx; }
        const unsigned old = xb_add(&bar[XB_XSUB(b.x)], 1u);
        const unsigned gen = old / nloc;
        if (old + 1u == (gen + 1u) * nloc) {
            __builtin_amdgcn_fence(__ATOMIC_RELEASE, "agent");
            asm volatile("s_waitcnt vmcnt(0)" ::: "memory");
            const unsigned og = xb_add(&bar[XB_TOP], 1u);
            const unsigned tg = og / nx;
            if (og + 1u == (tg + 1u) * nx) xb_add(&bar[XB_TOPGEN], 1u);
            else XB_SPIN(xb_ld(&bar[XB_TOPGEN]) == tg, bar);
            __builtin_amdgcn_fence(__ATOMIC_ACQUIRE, "agent");
            xb_add(&bar[XB_XGEN(b.x)], 1u);
            asm volatile("s_waitcnt vmcnt(0)" ::: "memory");
        } else {
            XB_SPIN(xb_ld(&bar[XB_XGEN(b.x)]) == gen, bar);
            __builtin_amdgcn_fence(__ATOMIC_ACQUIRE, "agent");
            asm volatile("s_waitcnt vmcnt(0)" ::: "memory");
        }
    }
    __syncthreads();
}
struct Ctx {
    LAS unsigned char* lds; int tid, lane, wave, vcu, G;
    const float* in[32]; float* out; unsigned char* ws;
};
#define WSP(T, off) ((T*)(F.ws + (off)))

__device__ __forceinline__ void p0_transpose_item(const float* W, int K, int N, bf16_t* WT, LAS float* scr, int item, int lane) {
    const int nblk = (N + 31) / 32, kb = item / nblk, nb = item % nblk, k0 = 64 * kb, n0 = 32 * nb;
    const int nn = n0 + (lane & 31);
#pragma unroll 8
    for (int i = 0; i < 32; ++i) { const int kk = 2 * i + (lane >> 5); scr[kk * 33 + (lane & 31)] = nn < N ? W[(size_t)(k0 + kk) * N + nn] : 0.f; }
    LDS_WAIT(); asm volatile("" ::: "memory");
    const int c = lane & 7;
#pragma unroll
    for (int j = 0; j < 4; ++j) { const int n = (lane >> 3) + 8 * j; const LAS float* s = scr + (8 * c) * 33 + n;
        u32x4 o; o.x = pk2(s[0 * 33], s[1 * 33]); o.y = pk2(s[2 * 33], s[3 * 33]); o.z = pk2(s[4 * 33], s[5 * 33]); o.w = pk2(s[6 * 33], s[7 * 33]);
        *(u32x4*)(WT + (size_t)(n0 + n) * K + k0 + 8 * c) = o; }
    LDS_WAIT(); asm volatile("" ::: "memory");
}
__device__ __forceinline__ void convert_uv_rows(const Ctx& F, int l, int r_lo, int r_hi, int widx, int nworkers) {
    float* SC = WSP(float, WS_SC) + (size_t)l * 2 * 16384;
    for (int r0 = r_lo + widx; r0 < r_hi; r0 += 4 * nworkers) {
        f32x4 v[4][4];
#pragma unroll
        for (int u = 0; u < 4; ++u) { const int r = r0 + u * nworkers < r_hi ? r0 + u * nworkers : r0; const int tb = r >> 14, row = r & 16383;
            const float* src = (tb ? F.in[31] : F.in[30]) + ((size_t)l * 16384 + row) * 1024 + F.lane * 16;
#pragma unroll
            for (int j = 0; j < 4; ++j) v[u][j] = *(const f32x4*)(src + 4 * j); }
#pragma unroll
        for (int u = 0; u < 4; ++u) { const int r = r0 + u * nworkers; if (r >= r_hi) break; const int tb = r >> 14, row = r & 16383;
            float am = 0.f;
#pragma unroll
            for (int j = 0; j < 4; ++j) am = fmaxf(am, fmaxf(fmaxf(fabsf(v[u][j][0]), fabsf(v[u][j][1])), fmaxf(fabsf(v[u][j][2]), fabsf(v[u][j][3]))));
#pragma unroll
            for (int o = 1; o < 64; o <<= 1) am = fmaxf(am, __shfl_xor(am, o));
            const float sc = am > 0.f ? 448.f / am : 1.f;
            unsigned ow[4];
#pragma unroll
            for (int j = 0; j < 4; ++j) { int w = __builtin_amdgcn_cvt_pk_fp8_f32(v[u][j][0] * sc, v[u][j][1] * sc, 0, false); w = __builtin_amdgcn_cvt_pk_fp8_f32(v[u][j][2] * sc, v[u][j][3] * sc, w, true); ow[j] = (unsigned)w; }
            *(u32x4*)(F.ws + (tb ? WS_V : WS_U) + (size_t)l * UV_LSTRIDE + (size_t)row * 1024 + F.lane * 16) = (u32x4){ow[0], ow[1], ow[2], ow[3]};
            if (F.lane == 0) SC[tb * 16384 + row] = am > 0.f ? am * (1.f / 448.f) : 1.f; }
    }
}
__device__ __forceinline__ void convert_uv(const Ctx& F, int l) { convert_uv_rows(F, l, 0, 2 * 16384, F.vcu * NWAVES + F.wave, F.G * NWAVES); }
__device__ __forceinline__ void phase_prologue(const Ctx& F) {
    float* MOD = WSP(float, WS_MOD);
    {
        LAS float* sl = (LAS float*)F.lds; LAS float* red = sl + 3072;
        for (int it = F.vcu; it < 192; it += F.G) {
            const int l = it / 96, n0 = (it % 96) * 64;
            for (int i = F.tid; i < 3072; i += NTHR) { const int s = i >> 10, k = i & 1023; const float c = s < 2 ? F.in[1][s * 1024 + k] : F.in[3][k]; sl[i] = c / (1.f + __expf(-c)); }
            __syncthreads();
            const int c = F.tid & 63, kg = F.tid >> 6;
            const float* W = F.in[4] + (size_t)l * 1024 * 6144 + n0 + c;
            float a0 = 0.f, a1 = 0.f, a2 = 0.f;
#pragma unroll 32
            for (int k = kg * 128; k < kg * 128 + 128; ++k) { const float w = W[(size_t)k * 6144]; a0 += sl[k] * w; a1 += sl[1024 + k] * w; a2 += sl[2048 + k] * w; }
            red[(kg * 3 + 0) * 64 + c] = a0; red[(kg * 3 + 1) * 64 + c] = a1; red[(kg * 3 + 2) * 64 + c] = a2;
            __syncthreads();
            if (F.tid < 192) { const int s = F.tid >> 6, cc = F.tid & 63; float t = F.in[5][l * 6144 + n0 + cc];
#pragma unroll
                for (int g = 0; g < 8; ++g) t += red[(g * 3 + s) * 64 + cc];
                MOD[(l * 3 + s) * 6144 + n0 + cc] = t; }
            __syncthreads();
        }
    }
    {
        LAS float* scr = (LAS float*)(F.lds + F.wave * 16384);
        const int gw = F.vcu * NWAVES + F.wave, NGW = F.G * NWAVES;
        constexpr int I_IN = 16 * 99, I_OUT = 16 * 32, I_L = I_IN + I_OUT;
        for (int it = gw; it < 2 * I_L; it += NGW) {
            const int l = it / I_L; int r = it % I_L;
            if (r < I_IN) p0_transpose_item(F.in[8] + (size_t)l * DM * DIN, DM, DIN, WSP(bf16_t, WS_WIN + l * WIN_LSTRIDE), scr, r, F.lane);
            else p0_transpose_item(F.in[9] + (size_t)l * DM * DM, DM, DM, WSP(bf16_t, WS_WOUT + l * WOUT_LSTRIDE), scr, r - I_IN, F.lane);
        }
        for (int i = F.vcu * NTHR + F.tid; i < 2 * 160 * 128; i += F.G * NTHR) { const int l = i / (160 * 128), r = i % (160 * 128);
            *(u32x4*)(WSP(bf16_t, WS_WIN + l * WIN_LSTRIDE) + (size_t)3168 * DM + (size_t)r * 8) = (u32x4){0u, 0u, 0u, 0u}; }
    }
    __syncthreads();
    {
        LAS float* KEYS = (LAS float*)F.lds; LAS float* WQl = KEYS + 128 * 129;
        const int nper = F.G / 32 > 0 ? F.G / 32 : 1;
        const int tile = F.vcu / nper, sub = F.vcu % nper;
        if (tile < 32) {
            const int l = tile >> 4, hh = tile & 15;
            const float* ksrc = F.in[29] + ((size_t)l * 16 + hh) * 128 * 128;
            { f32x4 kv[8];
#pragma unroll
              for (int q = 0; q < 8; ++q) kv[q] = *(const f32x4*)(ksrc + (size_t)(F.tid + q * NTHR) * 4);
#pragma unroll
              for (int q = 0; q < 8; ++q) { const int i = (F.tid + q * NTHR) * 4; LAS float* d = KEYS + (i >> 7) * 129 + (i & 127); d[0] = kv[q][0]; d[1] = kv[q][1]; d[2] = kv[q][2]; d[3] = kv[q][3]; } }
            for (int kb = sub; kb < 16; kb += nper) {
                const float* wsrc = F.in[28] + (size_t)l * DM * 2048 + (size_t)(kb * 64) * 2048 + hh * 128;
                __syncthreads();
                { f32x4 wv[4];
#pragma unroll
                  for (int q = 0; q < 4; ++q) { const int i = (F.tid + q * NTHR) * 4; wv[q] = *(const f32x4*)(wsrc + (size_t)(i >> 7) * 2048 + (i & 127)); }
#pragma unroll
                  for (int q = 0; q < 4; ++q) { const int i = (F.tid + q * NTHR) * 4, kk = i >> 7, d = i & 127; WQl[d * 68 + kk] = wv[q][0]; WQl[(d + 1) * 68 + kk] = wv[q][1]; WQl[(d + 2) * 68 + kk] = wv[q][2]; WQl[(d + 3) * 68 + kk] = wv[q][3]; } }
                __syncthreads();
                const int key = F.tid & 127, kq = F.tid >> 7;
                float acc[16];
#pragma unroll
                for (int j = 0; j < 16; ++j) acc[j] = 0.f;
#pragma unroll 4
                for (int d = 0; d < 128; ++d) { const float a = KEYS[key * 129 + d]; const LAS f32x4* wq = (const LAS f32x4*)(WQl + d * 68 + kq * 16);
#pragma unroll
                    for (int q = 0; q < 4; ++q) { const f32x4 w = wq[q]; acc[4 * q] += a * w[0]; acc[4 * q + 1] += a * w[1]; acc[4 * q + 2] += a * w[2]; acc[4 * q + 3] += a * w[3]; } }
                bf16_t* dst = WSP(bf16_t, WS_WEFF + l * WEFF_LSTRIDE) + (size_t)(hh * 128 + key) * DM + kb * 64 + kq * 16;
                u32x4 o0, o1; o0.x = pk2(acc[0], acc[1]); o0.y = pk2(acc[2], acc[3]); o0.z = pk2(acc[4], acc[5]); o0.w = pk2(acc[6], acc[7]);
                o1.x = pk2(acc[8], acc[9]); o1.y = pk2(acc[10], acc[11]); o1.z = pk2(acc[12], acc[13]); o1.w = pk2(acc[14], acc[15]);
                *(u32x4*)dst = o0; *(u32x4*)(dst + 8) = o1;
            }
        }
        __syncthreads();
    }
    convert_uv(F, 0); convert_uv(F, 1);
}

__device__ __forceinline__ void phase_norm(const Ctx& F, int l, int which, int nrows, const float* xlat, const float* xctx) {
    const float* gain = F.in[6 + which] + l * DM; const float* mod = WSP(float, WS_MOD) + (size_t)l * 3 * 6144;
    const int shoff = which ? 3072 : 0, scoff = which ? 4096 : 1024;
    bf16_t* H = WSP(bf16_t, WS_H);
    const int gw = F.vcu * NWAVES + F.wave, NGW = F.G * NWAVES;
    for (int row = gw; row < nrows; row += NGW) {
        const bool isc = row >= MLAT; const float* src = isc ? xctx + (size_t)(row - MLAT) * DM : xlat + (size_t)row * DM; const int smp = isc ? 2 : (row >> 13);
        const float* mb = mod + smp * 6144;
        f32x4 v[4]; float ss = 0.f;
#pragma unroll
        for (int j = 0; j < 4; ++j) { v[j] = *(const f32x4*)(src + F.lane * 4 + 256 * j); ss += (v[j][0] * v[j][0] + v[j][1] * v[j][1]) + (v[j][2] * v[j][2] + v[j][3] * v[j][3]); }
        const float rs = rsqrtf(wave_sum(ss) * (1.f / DM) + EPSN);
#pragma unroll
        for (int j = 0; j < 4; ++j) { const int c = F.lane * 4 + 256 * j; const f32x4 g = *(const f32x4*)(gain + c), sc = *(const f32x4*)(mb + scoff + c), sh = *(const f32x4*)(mb + shoff + c);
            const f32x4 o = (v[j] * rs * g) * (1.f + sc) + sh; st4bf(H + (size_t)row * DM + c, o); }
    }
}

__device__ __forceinline__ float log_sigmoid_(float x) { return fminf(x, 0.f) - __logf(1.f + __expf(-fabsf(x))); }
__device__ __forceinline__ void phase_prep(const Ctx& F, int l) {
    LAS float* W2s = (LAS float*)F.lds; LAS float* A2s = W2s + 8192; LAS float* G2s = A2s + 8192; LAS float* tsc = G2s + 8192 + F.wave * 64;
    { const float* w2 = F.in[13] + l * 8192; const float* a2 = F.in[15] + l * 8192; const float* g2 = F.in[16] + l * 8192;
      for (int i = F.tid; i < 8192; i += NTHR) { W2s[i] = w2[i]; A2s[i] = a2[i]; G2s[i] = g2[i]; } }
    __syncthreads();
    const bf16_t* P = WSP(bf16_t, WS_P); bf16_t* YC = WSP(bf16_t, WS_YCAT); bf16_t* QA = WSP(bf16_t, WS_QA); bf16_t* KA = WSP(bf16_t, WS_KA);
    unsigned char* RW = WSP(unsigned char, WS_RW); bf16_t* GB = WSP(bf16_t, WS_GB); float* BS = WSP(float, WS_BS); float* GA = WSP(float, WS_GA);
    const int lane = F.lane, c4 = lane * 4, i16 = lane & 15;
    const f32x4 cw0 = *(const f32x4*)(F.in[10] + l * 768 + c4), cw1 = *(const f32x4*)(F.in[10] + l * 768 + 256 + c4), cw2 = *(const f32x4*)(F.in[10] + l * 768 + 512 + c4);
    const f32x4 cg = *(const f32x4*)(F.in[11] + l * 256 + c4);
    const f32x4 qg = *(const f32x4*)(F.in[21] + l * 64 + (c4 & 63)), kg = *(const f32x4*)(F.in[22] + l * 64 + (c4 & 63));
    const f32x4 k_k = *(const f32x4*)(F.in[17] + l * 256 + c4), k_a = *(const f32x4*)(F.in[18] + l * 256 + c4), r_k = *(const f32x4*)(F.in[19] + l * 256 + c4);
    f32x4 w0[2], a0[2];
#pragma unroll
    for (int d = 0; d < 2; ++d) { w0[d] = *(const f32x4*)(F.in[12] + (l * 2 + d) * 256 + c4); a0[d] = *(const f32x4*)(F.in[14] + (l * 2 + d) * 256 + c4); }
    float invf[4];
#pragma unroll
    for (int j = 0; j < 4; ++j) invf[j] = exp2f(-(float)((c4 + j) & 15) * (13.287712379549449f / 16.f));
    const int gw = F.vcu * NWAVES + F.wave, NGW = F.G * NWAVES;
    struct PrepRaw { u32x2 h1, bg, c1, hp, cp, hn, cn, q, k, r, rk; unsigned xv, mg; };
#define PREP_LOAD(dst, row_) do { const int r_ = (row_); const bool isc_ = r_ >= MLAT; const int t_ = isc_ ? ((r_ - MLAT) & 255) : (r_ & 8191); const int T_ = isc_ ? TCTX : TLAT; \
        const bf16_t* pr_ = P + (size_t)r_ * DINP; const bf16_t* pp_ = t_ > 0 ? pr_ - DINP : pr_; const bf16_t* pn_ = t_ < T_ - 1 ? pr_ + DINP : pr_; \
        dst.h1 = *(const u32x2*)(pr_ + C_CH + c4); dst.bg = *(const u32x2*)(pr_ + C_CB + c4); dst.c1 = *(const u32x2*)(pr_ + C_CC + c4); \
        dst.hp = *(const u32x2*)(pp_ + C_CH + c4); dst.cp = *(const u32x2*)(pp_ + C_CC + c4); dst.hn = *(const u32x2*)(pn_ + C_CH + c4); dst.cn = *(const u32x2*)(pn_ + C_CC + c4); \
        dst.q = *(const u32x2*)(pr_ + C_AQ + c4); dst.k = *(const u32x2*)(pr_ + C_AK + (c4 & 127)); dst.r = *(const u32x2*)(pr_ + C_RR + c4); dst.rk = *(const u32x2*)(pr_ + C_RK + c4); \
        dst.xv = pr_[C_XW + lane]; dst.mg = pr_[C_MG + (lane & 15)]; } while (0)
#define UP4(w_) ((f32x4){lo2f((w_).x), hi2f((w_).x), lo2f((w_).y), hi2f((w_).y)})
    PrepRaw cur, nxt;
    if (gw < MALL) PREP_LOAD(cur, gw);
    for (int row = gw; row < MALL; row += NGW) {
        const bool isc = row >= MLAT; const int t = isc ? ((row - MLAT) & 255) : (row & 8191); const int T = isc ? TCTX : TLAT;
        { const int rn = row + NGW < MALL ? row + NGW : row; PREP_LOAD(nxt, rn); }
        {
            const f32x4 h1 = UP4(cur.h1), bg = UP4(cur.bg), c1 = UP4(cur.c1);
            f32x4 up = UP4(cur.hp) * UP4(cur.cp), un = UP4(cur.hn) * UP4(cur.cn);
            if (t == 0) up = (f32x4){0.f, 0.f, 0.f, 0.f};
            if (t == T - 1) un = (f32x4){0.f, 0.f, 0.f, 0.f};
            const f32x4 y = bg * (cw0 * up + cw1 * (c1 * h1) + cw2 * un);
            const float ss = red16((y[0] * y[0] + y[1] * y[1]) + (y[2] * y[2] + y[3] * y[3]));
            const float rs = rsqrtf(ss * (1.f / 64.f) + EPSN);
            st4bf(YC + (size_t)row * DM + c4, y * rs * cg * ZF(2));
        }
        {
            const f32x4 q = UP4(cur.q); const f32x4 k = UP4(cur.k);
            const float qs = red16((q[0] * q[0] + q[1] * q[1]) + (q[2] * q[2] + q[3] * q[3]));
            const float ks = red16((k[0] * k[0] + k[1] * k[1]) + (k[2] * k[2] + k[3] * k[3]));
            f32x4 qn = q * rsqrtf(qs * (1.f / 64.f) + EPSN) * qg, kn = k * rsqrtf(ks * (1.f / 64.f) + EPSN) * kg;
            if (!isc) {
                f32x4 qp, kp;
#pragma unroll
                for (int j = 0; j < 4; ++j) { qp[j] = __shfl_xor(qn[j], 4); kp[j] = __shfl_xor(kn[j], 4); }
                const int d0 = c4 & 63; const float pos = (d0 < 32) ? (float)(t >> 6) : (float)(t & 63); const bool lowh = (d0 & 16) == 0;
#pragma unroll
                for (int j = 0; j < 4; ++j) { const float th = pos * invf[j]; const float cs = __cosf(th), sn = __sinf(th);
                    qn[j] = lowh ? qn[j] * cs - qp[j] * sn : qn[j] * cs + qp[j] * sn; kn[j] = lowh ? kn[j] * cs - kp[j] * sn : kn[j] * cs + kp[j] * sn; }
            }
            st4bf(QA + (size_t)row * 256 + c4, qn * (0.125f * 1.4426950408889634f));
            if (lane < 32) st4bf(KA + (size_t)row * 128 + c4, kn);
        }
        {
            const f32x4 r = UP4(cur.r), k = UP4(cur.rk);
            { const float xv = bf2f((bf16_t)cur.xv);
              tsc[lane] = lane < 16 ? tanhf_(xv) : (lane < 32 ? xv : sigmoidf_(xv)); }
            const f32x4 kx = k * k_k;
            const float kss = red16((kx[0] * kx[0] + kx[1] * kx[1]) + (kx[2] * kx[2] + kx[3] * kx[3]));
            const f32x4 kk = kx * rsqrtf(kss + EPSN);
            bf16_t* recb = (bf16_t*)(RW + (size_t)row * RWREC); float* recf = (float*)(RW + (size_t)row * RWREC + 2560);
            st4bf(recb + c4, kk);
            f32x4 kdsum = {0.f, 0.f, 0.f, 0.f};
#pragma unroll
            for (int d = 0; d < 2; ++d) {
                f32x4 dw = w0[d], da = a0[d];
#pragma unroll 4
                for (int ii = 0; ii < 16; ++ii) { dw += tsc[ii] * *(const LAS f32x4*)(W2s + (d * 16 + ii) * 256 + c4); da += tsc[16 + ii] * *(const LAS f32x4*)(A2s + (d * 16 + ii) * 256 + c4); }
                f32x4 dec, av;
#pragma unroll
                for (int j = 0; j < 4; ++j) { dec[j] = -0.6065306597126334f * sigmoidf_(dw[j]); av[j] = sigmoidf_(da[j]); }
                const f32x4 kd = k * (1.f + (av - 1.f) * k_a);
                kdsum += kd;
                st4bf(recb + 256 + d * 256 + c4, kk * av);
                st4bf(recb + 768 + d * 256 + c4, kd);
                *(f32x4*)(recf + d * 256 + c4) = dec;
            }
            f32x4 gv = {0.f, 0.f, 0.f, 0.f};
#pragma unroll 4
            for (int ii = 0; ii < 32; ++ii) gv += tsc[32 + ii] * *(const LAS f32x4*)(G2s + ii * 256 + c4);
            st4bf(GB + (size_t)row * 256 + c4, gv);
            const f32x4 bt = r * kdsum * r_k;
            const float bsum = red16((bt[0] + bt[1]) + (bt[2] + bt[3]));
            if (i16 == 0) BS[(size_t)row * 4 + (lane >> 4)] = bsum;
        }
        if (lane < 16) { const int dir = lane >> 3, gate = (lane >> 2) & 1, hd = lane & 3; const float x = bf2f((bf16_t)cur.mg);
            const float bias = gate ? F.in[26][(l * 2 + dir) * 4 + hd] : F.in[25][(l * 2 + dir) * 4 + hd];
            GA[(size_t)row * 16 + lane] = gate ? log_sigmoid_(x + bias) : (x + bias); }
        cur = nxt;
    }
#undef PREP_LOAD
#undef UP4
}
__device__ __forceinline__ int scan_row(int b, int dir, int i) {
    if (i < TCTX) return MLAT + b * TCTX + (dir ? (TCTX - 1 - i) : i);
    const int p = i - TCTX; return b * TLAT + (dir ? (TLAT - 1 - p) : p);
}
__device__ __forceinline__ void rwkv_scan(const Ctx& F, int blk) {
    const int chain = blk >> 2, quarter = blk & 3, b = chain >> 3, head = (chain >> 1) & 3, dir = chain & 1;
    const bool scanner = F.wave < 4;
    const int rowv = (quarter * 4 + (F.wave & 3)) * 4 + (F.lane >> 4), s = F.lane & 15;
    LAS float* buf = (LAS float*)F.lds;
    const bf16_t* P = WSP(bf16_t, WS_P); const unsigned char* RW = WSP(unsigned char, WS_RW); float* YR = WSP(float, WS_YR) + (size_t)dir * MALL * 256;
    const int st = F.tid >> 4, sub = F.tid & 15;
    constexpr int NSTEP = TCTX + TLAT, NCH = NSTEP / 32;
    u32x2 g_kk, g_al, g_kd, g_r, g_v; f32x4 g_w;
#define RW_LOAD(c) do { const int row_ = scan_row(b, dir, (c) * 32 + st); const bf16_t* rb_ = (const bf16_t*)(RW + (size_t)row_ * RWREC) + head * 64 + sub * 4; \
        g_kk = *(const u32x2*)rb_; g_al = *(const u32x2*)(rb_ + 256 + dir * 256); g_kd = *(const u32x2*)(rb_ + 768 + dir * 256); \
        g_w = *(const f32x4*)((const float*)(RW + (size_t)row_ * RWREC + 2560) + dir * 256 + head * 64 + sub * 4); \
        const bf16_t* pp_ = P + (size_t)row_ * DINP + head * 64 + sub * 4; g_r = *(const u32x2*)(pp_ + C_RR); g_v = *(const u32x2*)(pp_ + C_RV); } while (0)
#define RW_STORE(par) do { LAS float* d_ = buf + ((par) * 32 + st) * 384 + sub * 4; \
        *(LAS f32x4*)(d_) = (f32x4){lo2f(g_kk.x), hi2f(g_kk.x), lo2f(g_kk.y), hi2f(g_kk.y)}; *(LAS f32x4*)(d_ + 64) = (f32x4){lo2f(g_al.x), hi2f(g_al.x), lo2f(g_al.y), hi2f(g_al.y)}; \
        *(LAS f32x4*)(d_ + 128) = (f32x4){lo2f(g_kd.x), hi2f(g_kd.x), lo2f(g_kd.y), hi2f(g_kd.y)}; *(LAS f32x4*)(d_ + 192) = g_w; \
        *(LAS f32x4*)(d_ + 256) = (f32x4){lo2f(g_r.x), hi2f(g_r.x), lo2f(g_r.y), hi2f(g_r.y)}; *(LAS f32x4*)(d_ + 320) = (f32x4){lo2f(g_v.x), hi2f(g_v.x), lo2f(g_v.y), hi2f(g_v.y)}; } while (0)
    f32x4 S = {0.f, 0.f, 0.f, 0.f};
    RW_LOAD(0); RW_STORE(0); __syncthreads();
    for (int c = 0; c < NCH; ++c) {
        const int par = c & 1;
        if (c + 1 < NCH) RW_LOAD(c + 1);
        if (scanner) {
        float ykeep = 0.f;
        f32x4 Lkk[3], Lal[3], Lkd[3], Lw[3], Lr[3]; float Lv[3];
#define SC_LD(set, i_) do { const LAS float* d_ = buf + (par * 32 + (i_)) * 384; Lkk[set] = *(const LAS f32x4*)(d_ + s * 4); Lal[set] = *(const LAS f32x4*)(d_ + 64 + s * 4); \
            Lkd[set] = *(const LAS f32x4*)(d_ + 128 + s * 4); Lw[set] = *(const LAS f32x4*)(d_ + 192 + s * 4); Lr[set] = *(const LAS f32x4*)(d_ + 256 + s * 4); Lv[set] = d_[320 + rowv]; } while (0)
        SC_LD(0, 0); SC_LD(1, 1);
#pragma unroll
        for (int i = 0; i < 32; ++i) {
            if (i + 2 < 32) SC_LD((i + 2) % 3, i + 2);
            const f32x4 kk = Lkk[i % 3], al = Lal[i % 3], kd = Lkd[i % 3], w = Lw[i % 3], r = Lr[i % 3]; const float vr = Lv[i % 3];
            const float sa = red16((S[0] * kk[0] + S[1] * kk[1]) + (S[2] * kk[2] + S[3] * kk[3]));
            S = S * w + (vr * kd - sa * al);
            const float y = red16((S[0] * r[0] + S[1] * r[1]) + (S[2] * r[2] + S[3] * r[3]));
            ykeep = (s == (i & 15)) ? y : ykeep;
            if ((i & 15) == 15) {
                const int stp = c * 32 + (i - 15) + s; const int pc = dir ? (TCTX - 1 - stp) : stp, pl = dir ? (TLAT - 1 - (stp - TCTX)) : (stp - TCTX);
                const int row = stp < TCTX ? (MLAT + b * TCTX + pc) : (b * TLAT + pl);
                YR[(size_t)row * 256 + head * 64 + rowv] = ykeep; }
        }
#undef SC_LD
        }
        if (c + 1 < NCH) RW_STORE(par ^ 1);
        __syncthreads();
    }
#undef RW_LOAD
#undef RW_STORE
}

typedef union { u32x4 u; bf16x8 b; } frag_u;
__device__ __forceinline__ void attn_unit(const Ctx& F, int l, int unit) {
    LAS bf16_t* Kl = (LAS bf16_t*)F.lds; LAS bf16_t* Vt = Kl + 64 * 72;
    const bf16_t* P = WSP(bf16_t, WS_P); const bf16_t* QA = WSP(bf16_t, WS_QA); const bf16_t* KA = WSP(bf16_t, WS_KA); bf16_t* YC = WSP(bf16_t, WS_YCAT);
    const bool isc = unit >= 256; int b, kvh, n;
    if (!isc) { b = unit >> 7; kvh = (unit >> 6) & 1; n = unit & 63; } else { const int u = unit - 256; b = u >> 2; kvh = (u >> 1) & 1; n = u & 1; }
    const int g = F.wave >> 2, ps = F.wave & 3, head = kvh * 2 + g, i = F.lane & 15, gq = F.lane >> 4;
    const int qpos0 = n * 128 + ps * 32, qrow0 = (isc ? MLAT + b * TCTX : b * TLAT) + qpos0;
    bf16x8 Qf[2][2];
#pragma unroll
    for (int qb = 0; qb < 2; ++qb)
#pragma unroll
        for (int ks = 0; ks < 2; ++ks) Qf[qb][ks] = *(const bf16x8*)(QA + (size_t)(qrow0 + qb * 16 + i) * 256 + head * 64 + ks * 32 + gq * 8);
    const float sinkl = F.in[23][l * 4 + head] * 1.4426950408889634f;
    float mrun[2] = {sinkl, sinkl}, lsum[2]; lsum[0] = lsum[1] = (gq == 0) ? 1.f : 0.f;
    f32x4 ao[4][2];
#pragma unroll
    for (int db = 0; db < 4; ++db) { ao[db][0] = (f32x4){0.f, 0.f, 0.f, 0.f}; ao[db][1] = (f32x4){0.f, 0.f, 0.f, 0.f}; }
    const int ntl = isc ? 4 : 10;
    const int skey = F.tid >> 3, sch = F.tid & 7;
#define ATT_KROW(tt_) ((!isc && (tt_) < 6) ? ((2 * (n - 1) + (tt_) < 0 || 2 * (n - 1) + (tt_) >= 128) ? -1 : b * TLAT + (2 * (n - 1) + (tt_)) * 64) : MLAT + b * TCTX + (isc ? (tt_) : (tt_) - 6) * 64)
#define ATT_LOAD(tt_) do { const int kr_ = ATT_KROW(tt_); if (kr_ >= 0) { pk_kv = *(const u32x4*)(KA + (size_t)(kr_ + skey) * 128 + kvh * 64 + sch * 8); pk_vv = *(const u32x4*)(P + (size_t)(kr_ + skey) * DINP + C_AV + kvh * 64 + sch * 8); } } while (0)
    u32x4 pk_kv = {0u, 0u, 0u, 0u}, pk_vv = {0u, 0u, 0u, 0u};
    int tt0 = 0; while (tt0 < ntl && ATT_KROW(tt0) < 0) ++tt0;
    ATT_LOAD(tt0);
    for (int tt = tt0; tt < ntl; ++tt) {
        const int krow0 = ATT_KROW(tt); if (krow0 < 0) continue;
        const bool band = !isc && tt < 6; const int kpos0 = band ? (2 * (n - 1) + tt) * 64 : 0;
        LDS_BARRIER();
        { const u32x4 kv = pk_kv, vv = pk_vv;
          *(LAS u32x4*)(Kl + skey * 72 + sch * 8) = kv;
          const unsigned ww[4] = {vv.x, vv.y, vv.z, vv.w};
#pragma unroll
          for (int j = 0; j < 4; ++j) { Vt[(sch * 8 + 2 * j) * 72 + skey] = (bf16_t)(ww[j] & 0xffffu); Vt[(sch * 8 + 2 * j + 1) * 72 + skey] = (bf16_t)(ww[j] >> 16); } }
        { int tn = tt + 1; while (tn < ntl && ATT_KROW(tn) < 0) ++tn; if (tn < ntl) ATT_LOAD(tn); }
        LDS_BARRIER();
        f32x4 sc[4][2];
#pragma unroll
        for (int kb = 0; kb < 4; ++kb) {
            sc[kb][0] = (f32x4){0.f, 0.f, 0.f, 0.f}; sc[kb][1] = (f32x4){0.f, 0.f, 0.f, 0.f};
#pragma unroll
            for (int ks = 0; ks < 2; ++ks) { const bf16x8 kf = *(const LAS bf16x8*)(Kl + (kb * 16 + i) * 72 + ks * 32 + gq * 8);
                sc[kb][0] = __builtin_amdgcn_mfma_f32_16x16x32_bf16(kf, Qf[0][ks], sc[kb][0], 0, 0, 0);
                sc[kb][1] = __builtin_amdgcn_mfma_f32_16x16x32_bf16(kf, Qf[1][ks], sc[kb][1], 0, 0, 0); }
        }
#pragma unroll
        for (int qb = 0; qb < 2; ++qb) {
            const int qp = qpos0 + qb * 16 + i;
            float mx = -1e30f;
#pragma unroll
            for (int kb = 0; kb < 4; ++kb)
#pragma unroll
                for (int r = 0; r < 4; ++r) { if (band) { const int dd = (kpos0 + kb * 16 + 4 * gq + r) - qp; if (dd > 128 || dd < -128) sc[kb][qb][r] = -1e30f; } mx = fmaxf(mx, sc[kb][qb][r]); }
            mx = fmaxf(mx, __shfl_xor(mx, 16)); mx = fmaxf(mx, __shfl_xor(mx, 32));
            const float mnew = fmaxf(mrun[qb], mx), alpha = exp2f(mrun[qb] - mnew); mrun[qb] = mnew;
            float ps_ = 0.f;
#pragma unroll
            for (int kb = 0; kb < 4; ++kb)
#pragma unroll
                for (int r = 0; r < 4; ++r) { const float p = exp2f(sc[kb][qb][r] - mnew); sc[kb][qb][r] = p; ps_ += p; }
            lsum[qb] = lsum[qb] * alpha + ps_;
#pragma unroll
            for (int db = 0; db < 4; ++db) ao[db][qb] *= alpha;
        }
#pragma unroll
        for (int ks2 = 0; ks2 < 2; ++ks2) {
            frag_u pf[2];
#pragma unroll
            for (int qb = 0; qb < 2; ++qb) { pf[qb].u.x = pg8::cvt_pk_bf16(sc[2 * ks2][qb][0], sc[2 * ks2][qb][1]); pf[qb].u.y = pg8::cvt_pk_bf16(sc[2 * ks2][qb][2], sc[2 * ks2][qb][3]);
                pf[qb].u.z = pg8::cvt_pk_bf16(sc[2 * ks2 + 1][qb][0], sc[2 * ks2 + 1][qb][1]); pf[qb].u.w = pg8::cvt_pk_bf16(sc[2 * ks2 + 1][qb][2], sc[2 * ks2 + 1][qb][3]); }
#pragma unroll
            for (int db = 0; db < 4; ++db) { frag_u vf; const LAS bf16_t* vp = Vt + (db * 16 + i) * 72 + (2 * ks2) * 16 + 4 * gq;
                const u32x2 v0 = *(const LAS u32x2*)vp, v1 = *(const LAS u32x2*)(vp + 16); vf.u = (u32x4){v0.x, v0.y, v1.x, v1.y};
                ao[db][0] = __builtin_amdgcn_mfma_f32_16x16x32_bf16(vf.b, pf[0].b, ao[db][0], 0, 0, 0);
                ao[db][1] = __builtin_amdgcn_mfma_f32_16x16x32_bf16(vf.b, pf[1].b, ao[db][1], 0, 0, 0); }
        }
    }
#undef ATT_KROW
#undef ATT_LOAD
    const float* og = F.in[24] + l * 256 + head * 64;
#pragma unroll
    for (int qb = 0; qb < 2; ++qb) {
        float lt = lsum[qb]; lt += __shfl_xor(lt, 16); lt += __shfl_xor(lt, 32);
        const float il = 1.f / lt; float ss = 0.f;
#pragma unroll
        for (int db = 0; db < 4; ++db) { ao[db][qb] *= il; ss += (ao[db][qb][0] * ao[db][qb][0] + ao[db][qb][1] * ao[db][qb][1]) + (ao[db][qb][2] * ao[db][qb][2] + ao[db][qb][3] * ao[db][qb][3]); }
        ss += __shfl_xor(ss, 16); ss += __shfl_xor(ss, 32);
        const float rs = rsqrtf(ss * (1.f / 64.f) + EPSN);
        bf16_t* yo = YC + (size_t)(qrow0 + qb * 16 + i) * DM + 512 + head * 64;
#pragma unroll
        for (int db = 0; db < 4; ++db) { const f32x4 gg = *(const f32x4*)(og + db * 16 + 4 * gq); st4bf(yo + db * 16 + 4 * gq, ao[db][qb] * rs * gg * ZF(8)); }
    }
    __syncthreads();
}

__device__ __forceinline__ int ml_row(int b, int dir, int j, int tp) {
    if (j < 2) { const int p = j * 128 + tp; return MLAT + b * TCTX + (dir ? (TCTX - 1 - p) : p); }
    const int p = (j - 2) * 128 + tp; return b * TLAT + (dir ? (TLAT - 1 - p) : p);
}
__device__ __forceinline__ void scan128_add(float& x0, float& x1, int lane) {
    x1 += x0; float t = x1;
#pragma unroll
    for (int o = 1; o < 64; o <<= 1) { const float u = __shfl_up(t, o); if (lane >= o) t += u; }
    const float ex = t - x1; x0 += ex; x1 = t;
}
__device__ __forceinline__ void scan128_max(float& x0, float& x1, int lane) {
    x1 = fmaxf(x1, x0); float t = x1;
#pragma unroll
    for (int o = 1; o < 64; o <<= 1) { const float u = __shfl_up(t, o); if (lane >= o) t = fmaxf(t, u); }
    const float pv = __shfl_up(t, 1); if (lane > 0) x0 = fmaxf(x0, pv); x1 = t;
}
__device__ __forceinline__ void ml_stage_T(const Ctx& F, const bf16_t* P, int b, int dir, int j, int col0, LAS bf16_t* dst, const LAS float* sw, float cscale) {
#pragma unroll
    for (int it = 0; it < 2; ++it) { const int id = F.tid + it * NTHR, tp = id >> 3, ch = id & 7;
        const u32x4 v = *(const u32x4*)(P + (size_t)ml_row(b, dir, j, tp) * DINP + col0 + ch * 8); const float s = (sw ? sw[tp] : 1.f) * cscale;
        const unsigned ww[4] = {v.x, v.y, v.z, v.w};
#pragma unroll
        for (int q = 0; q < 4; ++q) { dst[(ch * 8 + 2 * q) * 136 + tp] = (bf16_t)f2bf(lo2f(ww[q]) * s); dst[(ch * 8 + 2 * q + 1) * 136 + tp] = (bf16_t)f2bf(hi2f(ww[q]) * s); } }
}
__device__ __forceinline__ void ml_stage_R(const Ctx& F, const bf16_t* P, int b, int dir, int j, int col0, LAS bf16_t* dst, float cscale) {
#pragma unroll
    for (int it = 0; it < 2; ++it) { const int id = F.tid + it * NTHR, tp = id >> 3, ch = id & 7;
        u32x4 v = *(const u32x4*)(P + (size_t)ml_row(b, dir, j, tp) * DINP + col0 + ch * 8);
        if (cscale != 1.f) { v.x = pk2(lo2f(v.x) * cscale, hi2f(v.x) * cscale); v.y = pk2(lo2f(v.y) * cscale, hi2f(v.y) * cscale); v.z = pk2(lo2f(v.z) * cscale, hi2f(v.z) * cscale); v.w = pk2(lo2f(v.w) * cscale, hi2f(v.w) * cscale); }
        *(LAS u32x4*)(dst + tp * 72 + ch * 8) = v; }
}
__device__ __forceinline__ void mlstm_local(const Ctx& F, int task) {
    const int chain = task / NCHK, j = task % NCHK, b = chain >> 3, head = (chain >> 1) & 3, dir = chain & 1;
    const bf16_t* P = WSP(bf16_t, WS_P); const float* GA = WSP(float, WS_GA);
    LAS bf16_t* Vt = (LAS bf16_t*)F.lds; LAS bf16_t* Kt = Vt + 64 * 136; LAS float* wS = (LAS float*)(Kt + 64 * 136); LAS float* sc2 = wS + 128;
    __syncthreads();
    if (F.wave == 0) {
        const int r0 = ml_row(b, dir, j, 2 * F.lane), r1 = ml_row(b, dir, j, 2 * F.lane + 1);
        const float li0 = GA[(size_t)r0 * 16 + dir * 8 + head], li1 = GA[(size_t)r1 * 16 + dir * 8 + head];
        float b0 = GA[(size_t)r0 * 16 + dir * 8 + 4 + head], b1 = GA[(size_t)r1 * 16 + dir * 8 + 4 + head];
        scan128_add(b0, b1, F.lane);
        const float bend = __shfl(b1, 63);
        const float d0 = bend - b0 + li0, d1 = bend - b1 + li1;
        float mx = fmaxf(d0, d1);
#pragma unroll
        for (int o = 1; o < 64; o <<= 1) mx = fmaxf(mx, __shfl_xor(mx, o));
        wS[2 * F.lane] = __expf(d0 - mx); wS[2 * F.lane + 1] = __expf(d1 - mx);
        if (F.lane == 0) { sc2[0] = mx; sc2[1] = bend; }
    }
    __syncthreads();
    ml_stage_T(F, P, b, dir, j, C_MV + head * 64, Vt, wS, 1.f);
    ml_stage_T(F, P, b, dir, j, C_MK + head * 64, Kt, nullptr, 0.125f);
    __syncthreads();
    float* LC = WSP(float, WS_LC) + (size_t)task * CST;
    { const int vb = F.wave >> 1, i = F.lane & 15, gq = F.lane >> 4;
#pragma unroll
      for (int kk2 = 0; kk2 < 2; ++kk2) { const int kb = 2 * (F.wave & 1) + kk2; f32x4 acc = {0.f, 0.f, 0.f, 0.f};
#pragma unroll
          for (int ks = 0; ks < 4; ++ks) { const bf16x8 a = *(const LAS bf16x8*)(Vt + (vb * 16 + i) * 136 + ks * 32 + gq * 8), bb = *(const LAS bf16x8*)(Kt + (kb * 16 + i) * 136 + ks * 32 + gq * 8);
              acc = __builtin_amdgcn_mfma_f32_16x16x32_bf16(a, bb, acc, 0, 0, 0); }
#pragma unroll
          for (int r = 0; r < 4; ++r) LC[(vb * 16 + 4 * gq + r) * 64 + kb * 16 + i] = acc[r]; } }
    if (F.tid < 64) { float a = 0.f;
#pragma unroll 8
        for (int s = 0; s < 128; ++s) a += wS[s] * bf2f(Kt[F.tid * 136 + s]);
        LC[4096 + F.tid] = a; }
    if (F.tid == 0) { float* LB = WSP(float, WS_LB); LB[task * 2] = sc2[0]; LB[task * 2 + 1] = sc2[1]; }
}
__device__ __forceinline__ void mlstm_chain(const Ctx& F, int blk0) {
    const int gt = (F.vcu - blk0) * NTHR + F.tid; if (gt < 0 || gt >= 16 * CST) return;
    const int chain = gt / CST, e = gt % CST;
    const float* LC = WSP(float, WS_LC) + (size_t)chain * NCHK * CST + e; float* ST = WSP(float, WS_ST) + (size_t)chain * NCHK * CST + e;
    const float* LB = WSP(float, WS_LB) + chain * NCHK * 2; float* SM = WSP(float, WS_LB) + 4096 + chain * NCHK;
    float m = 0.f, x = 0.f;
#pragma unroll 1
    for (int g = 0; g < 3; ++g) {
        float d[22], Lv[22], Bv[22];
#pragma unroll
        for (int q = 0; q < 22; ++q) { const int j = g * 22 + q; d[q] = LC[(size_t)j * CST]; Lv[q] = LB[2 * j]; Bv[q] = LB[2 * j + 1]; }
#pragma unroll
        for (int q = 0; q < 22; ++q) { const int j = g * 22 + q;
            ST[(size_t)j * CST] = x; if (e == 0) SM[j] = m;
            const float mn = fmaxf(Bv[q] + m, Lv[q]);
            x = __expf(Bv[q] + m - mn) * x + __expf(Lv[q] - mn) * d[q]; m = mn; }
    }
}
__device__ __forceinline__ void mlstm_out(const Ctx& F, int l, int unit) {
    const bool isc = unit >= 512; int b, chunk, head;
    if (!isc) { b = unit >> 8; chunk = (unit >> 2) & 63; head = unit & 3; } else { const int u = unit - 512; b = u >> 3; chunk = (u >> 2) & 1; head = u & 3; }
    const bf16_t* P = WSP(bf16_t, WS_P); const float* GA = WSP(float, WS_GA); bf16_t* YC = WSP(bf16_t, WS_YCAT);
    LAS bf16_t* Ql = (LAS bf16_t*)F.lds; LAS bf16_t* Kl = Ql + 128 * 72; LAS bf16_t* Vt = Kl + 128 * 72; LAS bf16_t* Cb = Vt + 64 * 136;
    LAS float* nS = (LAS float*)(Cb + 64 * 72); LAS float* aS = nS + 64; LAS float* bS = aS + 128; LAS float* MS = bS + 128; LAS float* Hs = MS + 128;
    const int i = F.lane & 15, gq = F.lane >> 4, w = F.wave;
    for (int dir = 0; dir < 2; ++dir) {
        const int j = isc ? (dir ? 1 - chunk : chunk) : 2 + (dir ? 63 - chunk : chunk);
        const int chain = (b * 4 + head) * 2 + dir;
        const float* ST = WSP(float, WS_ST) + ((size_t)chain * NCHK + j) * CST; const float mprev = WSP(float, WS_LB)[4096 + chain * NCHK + j];
        __syncthreads();
        if (w == 0) {
            const int r0 = ml_row(b, dir, j, 2 * F.lane), r1 = ml_row(b, dir, j, 2 * F.lane + 1);
            const float li0 = GA[(size_t)r0 * 16 + dir * 8 + head], li1 = GA[(size_t)r1 * 16 + dir * 8 + head];
            float b0 = GA[(size_t)r0 * 16 + dir * 8 + 4 + head], b1 = GA[(size_t)r1 * 16 + dir * 8 + 4 + head];
            scan128_add(b0, b1, F.lane);
            const float a0 = li0 - b0, a1 = li1 - b1; float A0 = a0, A1 = a1;
            scan128_max(A0, A1, F.lane);
            aS[2 * F.lane] = a0; aS[2 * F.lane + 1] = a1; bS[2 * F.lane] = b0; bS[2 * F.lane + 1] = b1;
            MS[2 * F.lane] = fmaxf(A0, mprev); MS[2 * F.lane + 1] = fmaxf(A1, mprev);
        }
        ml_stage_R(F, P, b, dir, j, C_MQ + head * 64, Ql, 1.f);
        ml_stage_R(F, P, b, dir, j, C_MK + head * 64, Kl, 0.125f);
        ml_stage_T(F, P, b, dir, j, C_MV + head * 64, Vt, nullptr, 1.f);
        { const f32x4 c0 = *(const f32x4*)(ST + F.tid * 8), c1 = *(const f32x4*)(ST + F.tid * 8 + 4); const int v = F.tid >> 3, k0 = (F.tid & 7) * 8;
          u32x4 o; o.x = pk2(c0[0], c0[1]); o.y = pk2(c0[2], c0[3]); o.z = pk2(c1[0], c1[1]); o.w = pk2(c1[2], c1[3]); *(LAS u32x4*)(Cb + v * 72 + k0) = o;
          if (F.tid < 64) nS[F.tid] = ST[4096 + F.tid]; }
        __syncthreads();
        const int t = 16 * w + i; const float Mt = MS[t], bt = bS[t];
        bf16x8 Qf[2];
#pragma unroll
        for (int ks = 0; ks < 2; ++ks) Qf[ks] = *(const LAS bf16x8*)(Ql + t * 72 + ks * 32 + gq * 8);
        f32x4 sc[8];
#pragma unroll
        for (int sb = 0; sb < 8; ++sb) { sc[sb] = (f32x4){0.f, 0.f, 0.f, 0.f};
            if (sb <= w) {
#pragma unroll
                for (int ks = 0; ks < 2; ++ks) { const bf16x8 kf = *(const LAS bf16x8*)(Kl + (sb * 16 + i) * 72 + ks * 32 + gq * 8); sc[sb] = __builtin_amdgcn_mfma_f32_16x16x32_bf16(kf, Qf[ks], sc[sb], 0, 0, 0); }
#pragma unroll
                for (int r = 0; r < 4; ++r) { const int s = sb * 16 + 4 * gq + r; sc[sb][r] = (s <= t) ? sc[sb][r] * __expf(aS[s] - Mt) : 0.f; }
            } }
        float den = 0.f;
#pragma unroll
        for (int sb = 0; sb < 8; ++sb) den += (sc[sb][0] + sc[sb][1]) + (sc[sb][2] + sc[sb][3]);
        den += __shfl_xor(den, 16); den += __shfl_xor(den, 32);
        f32x4 nm[4], it_[4];
#pragma unroll
        for (int vb = 0; vb < 4; ++vb) { nm[vb] = (f32x4){0.f, 0.f, 0.f, 0.f}; it_[vb] = (f32x4){0.f, 0.f, 0.f, 0.f}; }
#pragma unroll
        for (int ks2 = 0; ks2 < 4; ++ks2) if (2 * ks2 <= w) {
            frag_u pf; pf.u.x = pg8::cvt_pk_bf16(sc[2 * ks2][0], sc[2 * ks2][1]); pf.u.y = pg8::cvt_pk_bf16(sc[2 * ks2][2], sc[2 * ks2][3]);
            pf.u.z = pg8::cvt_pk_bf16(sc[2 * ks2 + 1][0], sc[2 * ks2 + 1][1]); pf.u.w = pg8::cvt_pk_bf16(sc[2 * ks2 + 1][2], sc[2 * ks2 + 1][3]);
#pragma unroll
            for (int vb = 0; vb < 4; ++vb) { frag_u vf; const LAS bf16_t* vp = Vt + (vb * 16 + i) * 136 + (2 * ks2) * 16 + 4 * gq;
                const u32x2 v0 = *(const LAS u32x2*)vp, v1 = *(const LAS u32x2*)(vp + 16); vf.u = (u32x4){v0.x, v0.y, v1.x, v1.y};
                nm[vb] = __builtin_amdgcn_mfma_f32_16x16x32_bf16(vf.b, pf.b, nm[vb], 0, 0, 0); }
        }
#pragma unroll
        for (int vb = 0; vb < 4; ++vb)
#pragma unroll
            for (int ks = 0; ks < 2; ++ks) { const bf16x8 cf = *(const LAS bf16x8*)(Cb + (vb * 16 + i) * 72 + ks * 32 + gq * 8); it_[vb] = __builtin_amdgcn_mfma_f32_16x16x32_bf16(cf, Qf[ks], it_[vb], 0, 0, 0); }
        float nq = 0.f;
#pragma unroll
        for (int c = 0; c < 2; ++c) { const u32x4 qv = *(const LAS u32x4*)(Ql + t * 72 + gq * 16 + c * 8); const unsigned ww[4] = {qv.x, qv.y, qv.z, qv.w};
#pragma unroll
            for (int q = 0; q < 4; ++q) nq += nS[gq * 16 + c * 8 + 2 * q] * lo2f(ww[q]) + nS[gq * 16 + c * 8 + 2 * q + 1] * hi2f(ww[q]); }
        nq += __shfl_xor(nq, 16); nq += __shfl_xor(nq, 32);
        const float wint = __expf(mprev - Mt); den += wint * nq;
        const float dn = 1.f / fmaxf(fabsf(den), __expf(-(bt + Mt)));
        const int torig = dir ? 127 - t : t;
#pragma unroll
        for (int vb = 0; vb < 4; ++vb)
#pragma unroll
            for (int r = 0; r < 4; ++r) { const float hv = (nm[vb][r] + wint * it_[vb][r]) * dn; LAS float* hp = Hs + torig * 65 + vb * 16 + 4 * gq + r; if (dir == 0) *hp = hv; else *hp += hv; }
    }
    __syncthreads();
    {
        const int t = F.tid >> 2, vq = F.tid & 3; const int row = (isc ? MLAT + b * TCTX : b * TLAT) + chunk * 128 + t;
        float hv[16], ss = 0.f;
#pragma unroll
        for (int q = 0; q < 16; ++q) { hv[q] = Hs[t * 65 + vq * 16 + q]; ss += hv[q] * hv[q]; }
        ss += __shfl_xor(ss, 1); ss += __shfl_xor(ss, 2);
        const float rs = rsqrtf(ss * (1.f / 64.f) + EPSN);
        const float* og = F.in[27] + l * 256 + head * 64 + vq * 16; const bf16_t* op = P + (size_t)row * DINP + C_MO + head * 64 + vq * 16;
        const u32x4 o0 = *(const u32x4*)op, o1 = *(const u32x4*)(op + 8); const unsigned ow[8] = {o0.x, o0.y, o0.z, o0.w, o1.x, o1.y, o1.z, o1.w};
        unsigned res[8];
#pragma unroll
        for (int q = 0; q < 8; ++q) { const float y0 = sigmoidf_(lo2f(ow[q])) * hv[2 * q] * rs * og[2 * q], y1 = sigmoidf_(hi2f(ow[q])) * hv[2 * q + 1] * rs * og[2 * q + 1]; res[q] = pk2(y0 * ZF(16), y1 * ZF(16)); }
        bf16_t* yo = YC + (size_t)row * DM + 768 + head * 64 + vq * 16;
        *(u32x4*)yo = (u32x4){res[0], res[1], res[2], res[3]}; *(u32x4*)(yo + 8) = (u32x4){res[4], res[5], res[6], res[7]};
    }
    __syncthreads();
}
__device__ __forceinline__ void rwkv_finish(const Ctx& F, int l, int nrows) {
    const bf16_t* P = WSP(bf16_t, WS_P); const float* YR = WSP(float, WS_YR); const bf16_t* GB = WSP(bf16_t, WS_GB); const float* BS = WSP(float, WS_BS); bf16_t* YC = WSP(bf16_t, WS_YCAT);
    const int c4 = F.lane * 4; const f32x4 lg = *(const f32x4*)(F.in[20] + l * 256 + c4);
    const int gw = F.vcu * NWAVES + F.wave, NGW = F.G * NWAVES;
    for (int row = gw; row < nrows; row += NGW) {
        const f32x4 y = *(const f32x4*)(YR + (size_t)row * 256 + c4) + *(const f32x4*)(YR + (size_t)(MALL + row) * 256 + c4);
        const float ss = red16((y[0] * y[0] + y[1] * y[1]) + (y[2] * y[2] + y[3] * y[3]));
        const float rs = rsqrtf(ss * (1.f / 64.f) + EPSN);
        const f32x4 v = ld4bf(P + (size_t)row * DINP + C_RV + c4), g = ld4bf(GB + (size_t)row * 256 + c4);
        const float bn = BS[(size_t)row * 4 + (F.lane >> 4)];
        st4bf(YC + (size_t)row * DM + 256 + c4, (y * rs * lg * ZF(32) + bn * v * ZF(64)) * g * ZF(4));
    }
}
constexpr int RCH = 132;
constexpr int MP = 72, SLOT = 64 * MP;
constexpr size_t WS_RG = 454 * MiB, RG_TASK = 3 * 8192, WS_SST = WS_RW;
constexpr size_t WS_END2 = 504 * MiB;
static_assert(WS_RG + (size_t)16 * RCH * RG_TASK <= WS_END2 && (size_t)16 * RCH * 8192 <= (size_t)MALL * RWREC, "rwkv chunk ws map");

__device__ __forceinline__ void mm64(const LAS bf16_t* A, const LAS bf16_t* Bt, int w, int lane, f32x4 (&acc)[2]) {
    const int i = lane & 15, gq = lane >> 4, mb = w >> 1, nb0 = 2 * (w & 1);
    acc[0] = (f32x4){0.f, 0.f, 0.f, 0.f}; acc[1] = (f32x4){0.f, 0.f, 0.f, 0.f};
#pragma unroll
    for (int ks = 0; ks < 2; ++ks) { const bf16x8 a = *(const LAS bf16x8*)(A + (mb * 16 + i) * MP + ks * 32 + gq * 8);
#pragma unroll
        for (int q = 0; q < 2; ++q) { const bf16x8 b = *(const LAS bf16x8*)(Bt + ((nb0 + q) * 16 + i) * MP + ks * 32 + gq * 8); acc[q] = __builtin_amdgcn_mfma_f32_16x16x32_bf16(a, b, acc[q], 0, 0, 0); } }
}
__device__ __forceinline__ u32x2 pk4(f32x4 v) { u32x2 o; o.x = pk2(v[0], v[1]); o.y = pk2(v[2], v[3]); return o; }
__device__ __forceinline__ f32x4 up4(u32x2 w) { return (f32x4){lo2f(w.x), hi2f(w.x), lo2f(w.y), hi2f(w.y)}; }

struct RaRaw { u32x4 kk, al, kd, r, v; f32x4 ld0, ld1; };
__device__ __forceinline__ void ra_load(const Ctx& F, int task, RaRaw& g) {
    const int chain = task / RCH, c = task % RCH, b = chain >> 3, head = (chain >> 1) & 3, dir = chain & 1;
    const bf16_t* P = WSP(bf16_t, WS_P); const unsigned char* RW = WSP(unsigned char, WS_RW);
    const int t = F.tid >> 3, ch0 = (F.tid & 7) * 8; const int row = scan_row(b, dir, c * 64 + t);
    const bf16_t* rb = (const bf16_t*)(RW + (size_t)row * RWREC) + head * 64 + ch0;
    g.kk = *(const u32x4*)rb; g.al = *(const u32x4*)(rb + 256 + dir * 256); g.kd = *(const u32x4*)(rb + 768 + dir * 256);
    const float* ldp = (const float*)(RW + (size_t)row * RWREC + 2560) + dir * 256 + head * 64 + ch0;
    g.ld0 = *(const f32x4*)ldp; g.ld1 = *(const f32x4*)(ldp + 4);
    const bf16_t* pp = P + (size_t)row * DINP + head * 64 + ch0;
    g.r = *(const u32x4*)(pp + C_RR); g.v = *(const u32x4*)(pp + C_RV);
}
__device__ __forceinline__ void rwkv_chunk_pre(const Ctx& F, int task, const RaRaw& cur) {
    const int chain = task / RCH, c = task % RCH, b = chain >> 3, head = (chain >> 1) & 3, dir = chain & 1;
    LAS bf16_t* L0 = (LAS bf16_t*)F.lds;
#define SL(k) (L0 + (k) * SLOT)
    LAS float* LD = (LAS float*)SL(8);
    LAS float* SEG = (LAS float*)SL(10);
    LAS float* WLs = (LAS float*)SL(14);
    const int w = F.wave, lane = F.lane, i = lane & 15, gq = lane >> 4, mb = w >> 1, nb0 = 2 * (w & 1), m0 = mb * 16 + 4 * gq;
    LDS_BARRIER();
    const int t = F.tid >> 3, ch0 = (F.tid & 7) * 8;
    const u32x4 g_kk = cur.kk, g_al = cur.al, g_kd = cur.kd, g_r = cur.r, g_v = cur.v; const f32x4 ld0 = cur.ld0, ld1 = cur.ld1;
    *(LAS f32x4*)(LD + t * 64 + ch0) = ld0; *(LAS f32x4*)(LD + t * 64 + ch0 + 4) = ld1;
    LDS_BARRIER();
    { const int k = F.tid & 63, seg = F.tid >> 6; float s = 0.f;
#pragma unroll
      for (int j = 0; j < 8; ++j) s += LD[(seg * 8 + j) * 64 + k];
      SEG[seg * 64 + k] = s;
      LDS_BARRIER();
      float off = 0.f;
#pragma unroll
      for (int j = 0; j < 8; ++j) off += (j < seg) ? SEG[j * 64 + k] : 0.f;
#pragma unroll
      for (int j = 0; j < 8; ++j) { off += LD[(seg * 8 + j) * 64 + k]; LD[(seg * 8 + j) * 64 + k] = off; }
    }
    LDS_BARRIER();
    {
        const unsigned kkw[4] = {g_kk.x, g_kk.y, g_kk.z, g_kk.w}, alw[4] = {g_al.x, g_al.y, g_al.z, g_al.w}, kdw[4] = {g_kd.x, g_kd.y, g_kd.z, g_kd.w},
                       rw_[4] = {g_r.x, g_r.y, g_r.z, g_r.w}, vw[4] = {g_v.x, g_v.y, g_v.z, g_v.w};
        float okt[8], oai[8], oki[8], ort[8], oat[8], okb[8];
#pragma unroll
        for (int j = 0; j < 8; ++j) {
            const float cl = LD[t * 64 + ch0 + j], clp = t > 0 ? LD[(t - 1) * 64 + ch0 + j] : 0.f, clL = LD[63 * 64 + ch0 + j];
            const float kkv = (j & 1) ? hi2f(kkw[j >> 1]) : lo2f(kkw[j >> 1]), alv = (j & 1) ? hi2f(alw[j >> 1]) : lo2f(alw[j >> 1]), kdv = (j & 1) ? hi2f(kdw[j >> 1]) : lo2f(kdw[j >> 1]),
                        rv = (j & 1) ? hi2f(rw_[j >> 1]) : lo2f(rw_[j >> 1]);
            const float ec = __expf(cl), en = __builtin_amdgcn_rcpf(ec), eL = __expf(clL) * en;
            okt[j] = kkv * __expf(clp); oai[j] = alv * en; oki[j] = kdv * en; ort[j] = rv * ec; oat[j] = alv * eL; okb[j] = kdv * eL;
        }
        u32x4 o;
        o = (u32x4){pk2(okt[0], okt[1]), pk2(okt[2], okt[3]), pk2(okt[4], okt[5]), pk2(okt[6], okt[7])}; *(LAS u32x4*)(SL(0) + t * MP + ch0) = o;
        o = (u32x4){pk2(oai[0], oai[1]), pk2(oai[2], oai[3]), pk2(oai[4], oai[5]), pk2(oai[6], oai[7])}; *(LAS u32x4*)(SL(2) + t * MP + ch0) = o;
        o = (u32x4){pk2(oki[0], oki[1]), pk2(oki[2], oki[3]), pk2(oki[4], oki[5]), pk2(oki[6], oki[7])}; *(LAS u32x4*)(SL(3) + t * MP + ch0) = o;
        o = (u32x4){pk2(ort[0], ort[1]), pk2(ort[2], ort[3]), pk2(ort[4], ort[5]), pk2(ort[6], ort[7])}; *(LAS u32x4*)(SL(4) + t * MP + ch0) = o;
#pragma unroll
        for (int j = 0; j < 8; ++j) { SL(1)[(ch0 + j) * MP + t] = (bf16_t)f2bf(okt[j]); SL(5)[(ch0 + j) * MP + t] = (bf16_t)f2bf(oat[j]); SL(6)[(ch0 + j) * MP + t] = (bf16_t)f2bf(okb[j]);
            SL(7)[(ch0 + j) * MP + t] = (bf16_t)(((j & 1) ? (vw[j >> 1] >> 16) : (vw[j >> 1] & 0xffffu))); }
        if (t == 63) {
#pragma unroll
            for (int j = 0; j < 8; ++j) WLs[ch0 + j] = __expf(LD[63 * 64 + ch0 + j]); }
    }
    LDS_BARRIER();
    f32x4 acc[2];
    mm64(SL(0), SL(2), w, lane, acc);
#pragma unroll
    for (int q = 0; q < 2; ++q) { const int n = (nb0 + q) * 16 + i; f32x4 a, ti;
#pragma unroll
        for (int r = 0; r < 4; ++r) { const bool keep = (m0 + r) > n; a[r] = keep ? acc[q][r] : 0.f; ti[r] = ((m0 + r) == n ? 1.f : 0.f) - a[r]; }
#pragma unroll
        for (int r = 0; r < 4; ++r) { SL(8)[(m0 + r) * MP + n] = (bf16_t)f2bf(a[r]); SL(13)[(m0 + r) * MP + n] = (bf16_t)f2bf(ti[r]); }
        *(LAS u32x2*)(SL(9) + n * MP + m0) = pk4(a); }
    mm64(SL(0), SL(3), w, lane, acc);
#pragma unroll
    for (int q = 0; q < 2; ++q) { const int n = (nb0 + q) * 16 + i;
#pragma unroll
        for (int r = 0; r < 4; ++r) SL(10)[(m0 + r) * MP + n] = (bf16_t)f2bf((m0 + r) > n ? acc[q][r] : 0.f); }
    mm64(SL(4), SL(2), w, lane, acc);
#pragma unroll
    for (int q = 0; q < 2; ++q) { const int n = (nb0 + q) * 16 + i;
#pragma unroll
        for (int r = 0; r < 4; ++r) SL(11)[(m0 + r) * MP + n] = (bf16_t)f2bf((m0 + r) >= n ? acc[q][r] : 0.f); }
    mm64(SL(4), SL(3), w, lane, acc);
#pragma unroll
    for (int q = 0; q < 2; ++q) { const int n = (nb0 + q) * 16 + i;
#pragma unroll
        for (int r = 0; r < 4; ++r) SL(12)[(m0 + r) * MP + n] = (bf16_t)f2bf((m0 + r) >= n ? acc[q][r] : 0.f); }
    LDS_BARRIER();
#pragma unroll
    for (int it = 0; it < 5; ++it) {
        LAS bf16_t* Xs = (it & 1) ? SL(2) : SL(8); LAS bf16_t* XsT = (it & 1) ? SL(3) : SL(9);
        LAS bf16_t* Xd = (it & 1) ? SL(8) : SL(2); LAS bf16_t* XdT = (it & 1) ? SL(9) : SL(3);
        LAS bf16_t* Tsrc = (it & 1) ? SL(0) : SL(13); LAS bf16_t* Tdst = (it & 1) ? SL(13) : SL(0);
        mm64(Xs, XsT, w, lane, acc);
#pragma unroll
        for (int q = 0; q < 2; ++q) { const int n = (nb0 + q) * 16 + i;
#pragma unroll
            for (int r = 0; r < 4; ++r) Xd[(m0 + r) * MP + n] = (bf16_t)f2bf(acc[q][r]);
            *(LAS u32x2*)(XdT + n * MP + m0) = pk4(acc[q]); }
        LDS_BARRIER();
        mm64(Tsrc, XdT, w, lane, acc);
#pragma unroll
        for (int q = 0; q < 2; ++q) { const int n = (nb0 + q) * 16 + i;
#pragma unroll
            for (int r = 0; r < 4; ++r) Tdst[(m0 + r) * MP + n] = (bf16_t)f2bf(bf2f(Tsrc[(m0 + r) * MP + n]) + acc[q][r]); }
        LDS_BARRIER();
    }
    LAS bf16_t* Ti = SL(0);
    mm64(Ti, SL(1), w, lane, acc);
#pragma unroll
    for (int q = 0; q < 2; ++q) { const int n = (nb0 + q) * 16 + i; *(LAS u32x2*)(SL(2) + n * MP + m0) = pk4(acc[q]); }
    mm64(SL(10), SL(7), w, lane, acc);
#pragma unroll
    for (int q = 0; q < 2; ++q) { const int n = (nb0 + q) * 16 + i; *(LAS u32x2*)(SL(3) + n * MP + m0) = pk4(acc[q]); }
    LDS_BARRIER();
    mm64(Ti, SL(3), w, lane, acc);
#pragma unroll
    for (int q = 0; q < 2; ++q) { const int n = (nb0 + q) * 16 + i; *(LAS u32x2*)(SL(8) + n * MP + m0) = pk4(acc[q]); }
    LDS_BARRIER();
    bf16_t* RG = (bf16_t*)(F.ws + WS_RG + (size_t)task * RG_TASK);
    f32x4 acc2[2];
    mm64(SL(2), SL(11), w, lane, acc);
#pragma unroll
    for (int q = 0; q < 2; ++q) { const int n = (nb0 + q) * 16 + i; const f32x4 rt = up4(*(const LAS u32x2*)(SL(4) + n * MP + m0)); *(u32x2*)(RG + n * 64 + m0) = pk4(rt - acc[q]); }
    mm64(SL(2), SL(5), w, lane, acc);
#pragma unroll
    for (int q = 0; q < 2; ++q) { const int n = (nb0 + q) * 16 + i; f32x4 g;
#pragma unroll
        for (int r = 0; r < 4; ++r) g[r] = ((m0 + r) == n ? WLs[n] : 0.f) - acc[q][r];
        *(u32x2*)(RG + 4096 + n * 64 + m0) = pk4(g); }
    mm64(SL(6), SL(7), w, lane, acc); mm64(SL(5), SL(8), w, lane, acc2);
#pragma unroll
    for (int q = 0; q < 2; ++q) { const int n = (nb0 + q) * 16 + i; *(u32x2*)(RG + 8192 + n * 64 + m0) = pk4(acc[q] - acc2[q]); }
    mm64(SL(7), SL(12), w, lane, acc); mm64(SL(8), SL(11), w, lane, acc2);
    float* YR = WSP(float, WS_YR) + (size_t)dir * MALL * 256;
#pragma unroll
    for (int q = 0; q < 2; ++q) { const int n = (nb0 + q) * 16 + i; const int rown = scan_row(b, dir, c * 64 + n); *(f32x4*)(YR + (size_t)rown * 256 + head * 64 + m0) = acc[q] - acc2[q]; }
#undef SL
}

__device__ __forceinline__ void rwkv_chain(const Ctx& F, int chain) {
    LAS bf16_t* const L0 = (LAS bf16_t*)F.lds;
    LAS bf16_t* Gl[2] = {L0, L0 + SLOT}; LAS bf16_t* Sl[2] = {L0 + 2 * SLOT, L0 + 3 * SLOT}; LAS bf16_t* Hl[2] = {L0 + 4 * SLOT, L0 + 5 * SLOT};
    const int w = F.wave, lane = F.lane, i = lane & 15, gq = lane >> 4, mb = w >> 1, nb0 = 2 * (w & 1), m0 = mb * 16 + 4 * gq;
    const bf16_t* RGc = (const bf16_t*)(F.ws + WS_RG + (size_t)chain * RCH * RG_TASK); bf16_t* SST = (bf16_t*)(F.ws + WS_SST) + (size_t)chain * RCH * 4096;
    const int gr = F.tid >> 3, gc = (F.tid & 7) * 8, goff = gr * 64 + gc, loff = gr * MP + gc;
    constexpr int RBD = 6, RBU = 66;
    static_assert(RBU % RBD == 0 && RCH % RBU == 0, "ring depth / unroll");
    u32x4 rg[RBD], rh[RBD];
#define RB_LOAD(slot, cc) do { const bf16_t* p_ = RGc + (size_t)((cc) < RCH ? (cc) : RCH - 1) * (RG_TASK / 2); rg[slot] = *(const u32x4*)(p_ + 4096 + goff); rh[slot] = *(const u32x4*)(p_ + 8192 + goff); } while (0)
#pragma unroll
    for (int j = 0; j < RBD; ++j) RB_LOAD(j, j);
    __syncthreads();
    { unsigned z_; asm volatile("v_mov_b32 %0, 0" : "=v"(z_)); *(LAS u32x4*)(Sl[0] + loff) = (u32x4){z_, z_, z_, z_}; }
    *(LAS u32x4*)(Gl[0] + loff) = rg[0]; *(LAS u32x4*)(Hl[0] + loff) = rh[0];
    __syncthreads();
#ifdef TPROBE
    const unsigned long long tp0_ = __builtin_amdgcn_s_memrealtime();
#endif
#define RB_STEP(j) do { const int c = c0 + (j); if (c < RCH - 1) { const int par = c & 1; \
        *(u32x4*)(SST + (size_t)c * 4096 + goff) = *(const LAS u32x4*)(Sl[par] + loff);            \
        f32x4 acc[2]; mm64(Gl[par], Sl[par], w, lane, acc); \
        { const f32x4 h0 = up4(*(const LAS u32x2*)(Hl[par] + (nb0 * 16 + i) * MP + m0)), h1 = up4(*(const LAS u32x2*)(Hl[par] + ((nb0 + 1) * 16 + i) * MP + m0)); \
          *(LAS u32x2*)(Sl[par ^ 1] + (nb0 * 16 + i) * MP + m0) = pk4(acc[0] + h0); *(LAS u32x2*)(Sl[par ^ 1] + ((nb0 + 1) * 16 + i) * MP + m0) = pk4(acc[1] + h1); } \
        *(LAS u32x4*)(Gl[par ^ 1] + loff) = rg[((j) + 1) % RBD]; *(LAS u32x4*)(Hl[par ^ 1] + loff) = rh[((j) + 1) % RBD]; \
        RB_LOAD((j) % RBD, c + RBD); \
        asm volatile("s_waitcnt lgkmcnt(0)" ::: "memory"); __builtin_amdgcn_s_barrier(); asm volatile("" ::: "memory"); } } while (0)
#pragma unroll 1
    for (int c0 = 0; c0 < RCH; c0 += RBU) {
#pragma unroll
        for (int j = 0; j < RBU; ++j) RB_STEP(j); }
#undef RB_STEP
#undef RB_LOAD
    *(u32x4*)(SST + (size_t)(RCH - 1) * 4096 + goff) = *(const LAS u32x4*)(Sl[(RCH - 1) & 1] + loff);
#ifdef TPROBE
    if (chain == 0 && F.tid == 0) *(float*)(F.ws + WS_CTL + 65536) = 3000.f * (floorf((float)(__builtin_amdgcn_s_memrealtime() - tp0_) * (1.f / 3000.f)) + 0.5f);
#endif
    __syncthreads();
}

__device__ __forceinline__ void rwkv_out(const Ctx& F, int l, int unit) {
    const bool isc = unit >= 256; int b, chunk; if (!isc) { b = unit >> 7; chunk = unit & 127; } else { const int u = unit - 256; b = u >> 2; chunk = u & 3; }
    LAS bf16_t* Rl = (LAS bf16_t*)F.lds; LAS bf16_t* Sl = Rl + SLOT; LAS float* Ys = (LAS float*)(F.lds + 4 * SLOT * 2);
    const int w = F.wave, lane = F.lane, i = lane & 15, gq = lane >> 4, mb = w >> 1, nb0 = 2 * (w & 1), m0 = mb * 16 + 4 * gq;
    const int row0 = (isc ? MLAT + b * TCTX : b * TLAT) + chunk * 64;
    const int gr = F.tid >> 3, gc = (F.tid & 7) * 8;
#define RO_PTRS(hd_, RGp, SSp) do { const int head_ = (hd_) >> 1, dir_ = (hd_) & 1, chain_ = (b * 4 + head_) * 2 + dir_; const int cc_ = isc ? (dir_ ? 3 - chunk : chunk) : 4 + (dir_ ? 127 - chunk : chunk); \
        RGp = (const bf16_t*)(F.ws + WS_RG + ((size_t)chain_ * RCH + cc_) * RG_TASK); SSp = (const bf16_t*)(F.ws + WS_SST) + ((size_t)chain_ * RCH + cc_) * 4096; } while (0)
    u32x4 rv, sv;
    { const bf16_t* RG0; const bf16_t* SS0; RO_PTRS(0, RG0, SS0); rv = *(const u32x4*)(RG0 + gr * 64 + gc); sv = *(const u32x4*)(SS0 + gr * 64 + gc); }
#pragma unroll 1
    for (int hd = 0; hd < 8; ++hd) {
        const int head = hd >> 1, dir = hd & 1;
        const float* YR = WSP(float, WS_YR) + (size_t)dir * MALL * 256;
        LDS_BARRIER();
        *(LAS u32x4*)(Rl + gr * MP + gc) = rv; *(LAS u32x4*)(Sl + gr * MP + gc) = sv;
        if (hd < 7) { const bf16_t* RGn; const bf16_t* SSn; RO_PTRS(hd + 1, RGn, SSn); rv = *(const u32x4*)(RGn + gr * 64 + gc); sv = *(const u32x4*)(SSn + gr * 64 + gc); }
        f32x4 yl[2];
#pragma unroll
        for (int q = 0; q < 2; ++q) { const int n = (nb0 + q) * 16 + i; const int tor = dir ? 63 - n : n; yl[q] = *(const f32x4*)(YR + (size_t)(row0 + tor) * 256 + head * 64 + m0); }
        LDS_BARRIER();
        f32x4 acc[2]; mm64(Sl, Rl, w, lane, acc);
#pragma unroll
        for (int q = 0; q < 2; ++q) { const int n = (nb0 + q) * 16 + i; const int tor = dir ? 63 - n : n;
            LAS f32x4* yp = (LAS f32x4*)(Ys + tor * 260 + head * 64 + m0);
            if (dir == 0) *yp = acc[q] + yl[q]; else *yp = *yp + acc[q] + yl[q]; }
    }
#undef RO_PTRS
    __syncthreads();
    {
        const bf16_t* P = WSP(bf16_t, WS_P); const bf16_t* GB = WSP(bf16_t, WS_GB); const float* BS = WSP(float, WS_BS); bf16_t* YC = WSP(bf16_t, WS_YCAT);
        const int c4 = lane * 4; const f32x4 lg = *(const f32x4*)(F.in[20] + l * 256 + c4);
#pragma unroll 1
        for (int tt = w; tt < 64; tt += NWAVES) { const int row = row0 + tt;
            const f32x4 y = *(const LAS f32x4*)(Ys + tt * 260 + c4);
            const float ss = red16((y[0] * y[0] + y[1] * y[1]) + (y[2] * y[2] + y[3] * y[3]));
            const float rs = rsqrtf(ss * (1.f / 64.f) + EPSN);
            const f32x4 v = ld4bf(P + (size_t)row * DINP + C_RV + c4), g = ld4bf(GB + (size_t)row * 256 + c4);
            const float bn = BS[(size_t)row * 4 + (lane >> 4)];
            st4bf(YC + (size_t)row * DM + 256 + c4, (y * rs * lg * ZF(32) + bn * v * ZF(64)) * g * ZF(4)); }
    }
    __syncthreads();
}
__device__ __forceinline__ float clr7(float x) { return __uint_as_float(__float_as_uint(x) & 0xFFFFFF80u); }
__device__ __forceinline__ void ins16(float (&L)[16], float p) {
#pragma unroll
    for (int j = 15; j >= 1; --j) L[j] = __builtin_amdgcn_fmed3f(L[j - 1], L[j], p);
    L[0] = fmaxf(L[0], p);
}
__device__ __forceinline__ void peer_topk_task(const float* sg, size_t gstride, u32x2* eg) {
    float L0[16], L1[16];
#pragma unroll
    for (int j = 0; j < 16; ++j) { L0[j] = -INFINITY; L1[j] = -INFINITY; }
    for (int i = 0; i < 128; i += 4) {
        const f32x4 a = *(const f32x4*)(sg + (size_t)(i >> 2) * gstride), b = *(const f32x4*)(sg + (size_t)(32 + (i >> 2)) * gstride);
#pragma unroll
        for (int q = 0; q < 4; ++q) { ins16(L0, __uint_as_float((__float_as_uint(a[q]) & 0xFFFFFF80u) | (unsigned)(i + q)));
                                      ins16(L1, __uint_as_float((__float_as_uint(b[q]) & 0xFFFFFF80u) | (unsigned)(i + q))); }
    }
    float T[16];
#pragma unroll
    for (int j = 0; j < 16; ++j) T[j] = -INFINITY;
#pragma unroll
    for (int a = 0; a < 16; ++a)
#pragma unroll
        for (int b = 0; b < 16; ++b) if ((a + 1) * (b + 1) <= 16) { const float s = clr7(L0[a]) + clr7(L1[b]);
            ins16(T, __uint_as_float((__float_as_uint(s) & 0xFFFFFF00u) | (unsigned)(a * 16 + b))); }
    float e[16], sum = 0.f; const float mx = __uint_as_float(__float_as_uint(T[0]) & 0xFFFFFF00u);
#pragma unroll
    for (int j = 0; j < 16; ++j) { e[j] = __expf(__uint_as_float(__float_as_uint(T[j]) & 0xFFFFFF00u) - mx); sum += e[j]; }
    const float inv = 1.f / sum;
#pragma unroll
    for (int j = 0; j < 16; ++j) {
        const unsigned ab = __float_as_uint(T[j]) & 0xFFu, a = ab >> 4, b = ab & 15u; unsigned i0 = 0u, i1 = 0u;
#pragma unroll
        for (int q = 0; q < 16; ++q) { i0 = (a == (unsigned)q) ? (__float_as_uint(L0[q]) & 0x7Fu) : i0; i1 = (b == (unsigned)q) ? (__float_as_uint(L1[q]) & 0x7Fu) : i1; }
        eg[j] = (u32x2){i0 * 128u + i1, __float_as_uint(e[j] * inv)};
    }
}
__device__ __forceinline__ float gelu_tanh(float x) { const float u = 0.7978845608028654f * (x + 0.044715f * x * x * x); return 0.5f * x * (1.f + tanhf_(u)); }
__device__ __forceinline__ float dot2bf(unsigned w, unsigned x, float acc) { return __builtin_amdgcn_fdot2_f32_bf16(__builtin_bit_cast(bf16x2_t, w), __builtin_bit_cast(bf16x2_t, x), acc, false); }
__device__ __forceinline__ float wave_total63(float x) {
    x = red16(x);
    x += __int_as_float(__builtin_amdgcn_update_dpp(0, __float_as_int(x), 0x142, 0xa, 0xf, false));
    x += __int_as_float(__builtin_amdgcn_update_dpp(0, __float_as_int(x), 0x143, 0xc, 0xf, false));
    return x;
}
__device__ __forceinline__ void phase_peer(const Ctx& F, int l, int nrows, const float* mod, float* wr_override) {
    const float* S = WSP(float, WS_S); u32x2* EG = WSP(u32x2, WS_EG); const bf16_t* H = WSP(bf16_t, WS_H);
    const unsigned char* U = F.ws + WS_U + (size_t)l * UV_LSTRIDE; const unsigned char* V = F.ws + WS_V + (size_t)l * UV_LSTRIDE;
    const float* USC = WSP(float, WS_SC) + (size_t)l * 2 * 16384; const float* VSC = USC + 16384;
    const int tpb = nrows / F.G, tok0 = F.vcu * tpb;
    for (int task = F.tid; task < tpb * 8; task += NTHR) { const int hd = task / tpb, row = tok0 + (task - hd * tpb);
        peer_topk_task(S + ((size_t)(hd * 64) * MALL + row) * 4, (size_t)MALL * 4, EG + (size_t)row * 128 + hd * 16); }
    __threadfence_block(); __syncthreads();
    const int lane = F.lane;
    for (int tk = F.wave; tk < tpb; tk += NWAVES) {
        const int row = tok0 + tk; const bool isc = row >= MLAT; const int smp = isc ? 2 : (row >> 13);
        float* xrow = isc ? WSP(float, WS_XC) + (size_t)(row - MLAT) * DM : F.out + (size_t)row * DM;
        f32x2 hv[8];
        { const u32x4 h0 = *(const u32x4*)(H + (size_t)row * DM + lane * 16), h1 = *(const u32x4*)(H + (size_t)row * DM + lane * 16 + 8);
          const unsigned hw[8] = {h0.x, h0.y, h0.z, h0.w, h1.x, h1.y, h1.z, h1.w};
#pragma unroll
          for (int q = 0; q < 8; ++q) hv[q] = (f32x2){lo2f(hw[q]), hi2f(hw[q])}; }
        const u32x2 eg0 = EG[(size_t)row * 128 + lane], eg1 = EG[(size_t)row * 128 + 64 + lane];
        float act0 = 0.f, act1 = 0.f;
        constexpr int GS = 8, NG2 = 128 / (2 * GS);
        u32x4 ra[GS], rb[GS];
#define PG_LOAD(dst, tab, grp_) do { _Pragma("unroll") for (int q = 0; q < GS; ++q) { const int ii = (grp_) * GS + q; const unsigned e = __builtin_amdgcn_readlane(ii < 64 ? eg0.x : eg1.x, ii & 63); \
            dst[q] = *(const u32x4*)((tab) + (size_t)e * 1024 + lane * 16); } } while (0)
#define PG_UDOT(src, grp_) do { _Pragma("unroll") for (int q = 0; q < GS; ++q) { const int ii = (grp_) * GS + q; const unsigned e = __builtin_amdgcn_readlane(ii < 64 ? eg0.x : eg1.x, ii & 63); \
            const unsigned uw[4] = {src[q].x, src[q].y, src[q].z, src[q].w}; f32x2 d2 = {0.f, 0.f}; \
            _Pragma("unroll") for (int j = 0; j < 4; ++j) { d2 += __builtin_amdgcn_cvt_pk_f32_fp8((int)uw[j], false) * hv[2 * j]; d2 += __builtin_amdgcn_cvt_pk_f32_fp8((int)uw[j], true) * hv[2 * j + 1]; } \
            const float tot = __int_as_float(__builtin_amdgcn_readlane(__float_as_int(wave_total63(d2.x + d2.y)), 63)) * USC[e]; \
            if (ii < 64) act0 = (lane == (ii & 63)) ? tot : act0; else act1 = (lane == (ii & 63)) ? tot : act1; } } while (0)
        PG_LOAD(ra, U, 0);
#pragma unroll 1
        for (int g2 = 0; g2 < NG2; ++g2) {
            PG_LOAD(rb, U, 2 * g2 + 1); PG_UDOT(ra, 2 * g2);
            if (g2 < NG2 - 1) PG_LOAD(ra, U, 2 * g2 + 2); else PG_LOAD(ra, V, 0);
            PG_UDOT(rb, 2 * g2 + 1);
        }
        const float cf0 = __uint_as_float(eg0.y) * gelu_tanh(act0) * VSC[eg0.x], cf1 = __uint_as_float(eg1.y) * gelu_tanh(act1) * VSC[eg1.x];
        f32x2 ac[8];
#pragma unroll
        for (int q = 0; q < 8; ++q) ac[q] = (f32x2){0.f, 0.f};
#define PG_VACC(src, grp_) do { _Pragma("unroll") for (int q = 0; q < GS; ++q) { const int ii = (grp_) * GS + q; const float cf = __int_as_float(__builtin_amdgcn_readlane(__float_as_int(ii < 64 ? cf0 : cf1), ii & 63)); \
            const unsigned vw[4] = {src[q].x, src[q].y, src[q].z, src[q].w}; \
            _Pragma("unroll") for (int j = 0; j < 4; ++j) { ac[2 * j] += cf * __builtin_amdgcn_cvt_pk_f32_fp8((int)vw[j], false); ac[2 * j + 1] += cf * __builtin_amdgcn_cvt_pk_f32_fp8((int)vw[j], true); } } } while (0)
#pragma unroll 1
        for (int g2 = 0; g2 < NG2; ++g2) {
            PG_LOAD(rb, V, 2 * g2 + 1); PG_VACC(ra, 2 * g2);
            if (g2 < NG2 - 1) PG_LOAD(ra, V, 2 * g2 + 2);
            PG_VACC(rb, 2 * g2 + 1);
        }
#undef PG_LOAD
#undef PG_UDOT
#undef PG_VACC
        float acc[16];
#pragma unroll
        for (int q = 0; q < 8; ++q) { acc[2 * q] = ac[q].x; acc[2 * q + 1] = ac[q].y; }
        const float* gt = mod + smp * 6144 + 5120;
        f32x4 res[4]; float ss = 0.f;
#pragma unroll
        for (int q = 0; q < 4; ++q) { const int c = lane * 16 + q * 4; const f32x4 g = *(const f32x4*)(gt + c), x = *(const f32x4*)(xrow + c);
            res[q] = x + ZF(1) * g * (f32x4){acc[q * 4], acc[q * 4 + 1], acc[q * 4 + 2], acc[q * 4 + 3]};
            *(f32x4*)((wr_override ? wr_override + (size_t)row * DM : xrow) + c) = res[q];
            ss += (res[q][0] * res[q][0] + res[q][1] * res[q][1]) + (res[q][2] * res[q][2] + res[q][3] * res[q][3]); }
        if (l == 0 && !wr_override) {
            const float rs = rsqrtf(wave_sum(ss) * (1.f / DM) + EPSN); const float* mb1 = mod + 3 * 6144 + smp * 6144; const float* g1 = F.in[6] + DM;
            bf16_t* Hw = WSP(bf16_t, WS_H) + (size_t)row * DM;
#pragma unroll
            for (int q = 0; q < 4; ++q) { const int c = lane * 16 + q * 4; const f32x4 g = *(const f32x4*)(g1 + c), sc = *(const f32x4*)(mb1 + 1024 + c), sh = *(const f32x4*)(mb1 + c);
                st4bf(Hw + c, (res[q] * rs * g) * (1.f + sc) + sh); }
        }
    }
}

constexpr int PH_PER_LAYER = 10, N_PHASES = 1 + 2 * PH_PER_LAYER;
struct Args { const float* in[32]; float* out; unsigned char* ws; int ph_lo, ph_hi, li, pad; };
__global__ void __launch_bounds__(NTHR, 2) mk_fwd(Args args) {
    extern __shared__ __attribute__((aligned(16))) unsigned char lds[];
    Ctx F;
    F.lds = (LAS unsigned char*)lds;
    volatile LAS unsigned* MISC = (volatile LAS unsigned*)(F.lds + MISC_OFF);
    F.tid = threadIdx.x; F.lane = F.tid & 63; F.wave = __builtin_amdgcn_readfirstlane(F.tid >> 6);
    F.G = gridDim.x; { const int bx = blockIdx.x; F.vcu = (F.G % 8 == 0) ? (bx % 8) * (F.G / 8) + bx / 8 : bx; }
#pragma unroll
    for (int i = 0; i < 32; ++i) F.in[i] = args.in[i];
    F.out = args.out; F.ws = args.ws;
    for (int u = F.tid; u < (LDS_BYTES - LDSCTL_OFF) / 4; u += NTHR) ((LAS unsigned*)(F.lds + LDSCTL_OFF))[u] = 0u;
    __syncthreads();
    XcdBarrier bar; bar.bar = (unsigned*)(args.ws + WS_CTL) + CW_BAR; bar.x = 0; bar.st = nullptr;
#if !MK_MULTI
    bar = xcd_barrier_post((unsigned*)(args.ws + WS_CTL) + CW_BAR, MISC + 8);
#endif
    const int lo = args.ph_lo, hi = args.ph_hi;
#ifndef KMAX
#define KMAX 1000
#endif
#define IN(k) (lo <= (k) && (k) < hi && (REP_ALL == 1 || ra == REP_ALL - 1 || (k) <= KMAX))
#ifndef REP_PH
#define REP_PH -1
#endif
#define REPS(k) ((REP_PH == (k)) ? 2 : 1)
#define PHCTX Ctx Fp = F; { int t_ = F.tid; asm volatile("" : "+v"(t_)); Fp.tid = t_; Fp.lane = t_ & 63; }
#if MK_MULTI
#define SEAM(k) do { } while (0)
#else
#ifndef BAR_REPS
#define BAR_REPS 1
#endif
#define SEAM(k) do { if (IN(k) && IN((k) + 1)) for (int br_ = 0; br_ < BAR_REPS; ++br_) xcd_barrier(bar); } while (0)
#endif
#ifndef REP_ALL
#define REP_ALL 1
#endif
#ifndef REP_SUB
#define REP_SUB 0
#endif
#pragma unroll 1
    for (int ra = 0; ra < REP_ALL; ++ra) {
    if (ra > 0) xcd_barrier(bar);
    if (IN(0)) { PHCTX; for (int rep = 0; rep < REPS(100); ++rep) phase_prologue(Fp); }
    SEAM(0);
    float* XC = WSP(float, WS_XC);
#pragma unroll 1
    for (int l = 0; l < 2; ++l) {
        const int pb = 1 + l * PH_PER_LAYER;
        const float* xlat = l == 0 ? F.in[0] : F.out; const float* xctx = l == 0 ? F.in[2] : XC;
        const int mrows = l == 0 ? MALL : MLAT;
        const float* mod = WSP(float, WS_MOD) + (size_t)l * 3 * 6144;
        if (IN(pb + 0) && l == 0) { PHCTX; for (int rep = 0; rep < REPS(0); ++rep) { phase_norm(Fp, l, 0, MALL, xlat, xctx); } }
        if (l == 0) SEAM(pb + 0);
        if (IN(pb + 1)) for (int rep = 0; rep < REPS(1); ++rep) { PHCTX; pg8::Gemm g{WSP(bf16_t, WS_H), WSP(bf16_t, WS_WIN + l * WIN_LSTRIDE), MALL, DINP, DM}; pg8::StaticOrder So; So.init(MALL, DINP, F.G, (int)blockIdx.x);
            pg8::EpiBf16 E{WSP(bf16_t, WS_P), DINP}; pg8::gemm_phase<pg8::EpiBf16, pg8::StaticOrder, true, true>(F.lds, g, So, E, Fp.tid); }
        SEAM(pb + 1);
        if (IN(pb + 2)) { PHCTX; for (int rep = 0; rep < REPS(2); ++rep) { phase_prep(Fp, l); __syncthreads(); } }
        SEAM(pb + 2);
        if (IN(pb + 3)) for (int rep = 0; rep < REPS(3); ++rep) {
            const int nra = 16 * RCH, nml = 16 * NCHK;
            for (int r3 = 0; r3 < (REP_SUB == 3 ? 2 : 1); ++r3) { PHCTX; for (int task = F.vcu; task < nra; task += F.G) { RaRaw cur_; ra_load(Fp, task, cur_); rwkv_chunk_pre(Fp, task, cur_); } __syncthreads(); }
            for (int r3 = 0; r3 < (REP_SUB == 4 ? 2 : 1); ++r3) { PHCTX; for (int task = (F.vcu + F.G - 72) % F.G; task < nml; task += F.G) mlstm_local(Fp, task); }
        }
        SEAM(pb + 3);
                if (IN(pb + 4)) for (int rep = 0; rep < REPS(4); ++rep) {
            if (F.vcu < 16) { PHCTX; rwkv_chain(Fp, F.vcu); }
            else { { PHCTX; mlstm_chain(Fp, 16); }
                   { PHCTX; const int natt = l == 0 ? 264 : 256; for (int task = F.vcu - 16; task < natt; task += F.G - 16) attn_unit(Fp, l, task); } } }
        SEAM(pb + 4);
        if (IN(pb + 5)) for (int rep = 0; rep < REPS(5); ++rep) { const int nro = l == 0 ? 264 : 256, nun = l == 0 ? 528 : 512;
            { PHCTX; for (int u = F.vcu; u < nro; u += F.G) rwkv_out(Fp, l, u); }
            { PHCTX; for (int u = (F.vcu + F.G - 8) % F.G; u < nun; u += F.G) mlstm_out(Fp, l, u); } }
        SEAM(pb + 5);
        if (IN(pb + 6)) for (int rep = 0; rep < REPS(6); ++rep) { PHCTX; pg8::Gemm g{WSP(bf16_t, WS_YCAT), WSP(bf16_t, WS_WOUT + l * WOUT_LSTRIDE), mrows, DM, DM}; pg8::StaticOrder So; So.init(mrows, DM, F.G, (int)blockIdx.x);
            float* dummy = WSP(float, WS_YR); const bool dm_ = (REPS(6) == 2 && rep == 0); pg8::EpiRes E{xlat, xctx, dm_ ? dummy : F.out, dm_ ? dummy : XC, mod}; pg8::gemm_phase<pg8::EpiRes, pg8::StaticOrder, true, true>(F.lds, g, So, E, Fp.tid); }
        SEAM(pb + 6);
        if (IN(pb + 7)) { PHCTX; for (int rep = 0; rep < REPS(7); ++rep) phase_norm(Fp, l, 1, mrows, F.out, XC); }
        SEAM(pb + 7);
        if (IN(pb + 8)) for (int rep = 0; rep < REPS(8); ++rep) { PHCTX; pg8::Gemm g{WSP(bf16_t, WS_H), WSP(bf16_t, WS_WEFF + l * WEFF_LSTRIDE), mrows, 2048, DM}; pg8::StaticOrder So; So.init(mrows, 2048, F.G, (int)blockIdx.x);
            pg8::EpiF32 E{WSP(float, WS_S), MALL}; pg8::gemm_phase<pg8::EpiF32, pg8::StaticOrder, true, true>(F.lds, g, So, E, Fp.tid); }
        SEAM(pb + 8);
        if (IN(pb + 9)) { PHCTX; for (int rep = 0; rep < REPS(9); ++rep) { phase_peer(Fp, l, mrows, mod, (REPS(9) == 2 && rep == 0) ? WSP(float, WS_YR) : nullptr); __syncthreads(); } }
        SEAM(pb + 9);
    }
    }
#undef IN
#undef SEAM
}

extern "C" void kernel_launch(void* const* d_in, const int* in_sizes, int n_in, void* d_out, int out_size, void* d_ws, size_t ws_size, hipStream_t stream) {
    static int grid = 0;
    if (grid == 0) {
        if (n_in != 32 || out_size != MLAT * DM || ws_size < WS_END2) { fprintf(stderr, "kernel_launch: unexpected shapes: n_in %d out %d ws %zu (need %zu)\n", n_in, out_size, ws_size, (size_t)WS_END2); grid = -1; return; }
        int dev = 0, cus = 0, per_cu = 0;
        if (hipGetDevice(&dev) != hipSuccess || hipDeviceGetAttribute(&cus, hipDeviceAttributeMultiprocessorCount, dev) != hipSuccess) { grid = -1; return; }
        if (hipFuncSetAttribute((const void*)mk_fwd, hipFuncAttributeMaxDynamicSharedMemorySize, LDS_BYTES) != hipSuccess) { fprintf(stderr, "kernel_launch: hipFuncSetAttribute failed\n"); grid = -1; return; }
        if (hipOccupancyMaxActiveBlocksPerMultiprocessor(&per_cu, (const void*)mk_fwd, NTHR, LDS_BYTES) != hipSuccess || per_cu < 1) fprintf(stderr, "kernel_launch: occupancy query reports %d\n", per_cu);
        (void)hipGetLastError();
        grid = cus;
        if (grid != 256) fprintf(stderr, "kernel_launch: grid %d (built for 256 CUs)\n", grid);
    }
    if (grid < 0) return;
    (void)hipMemsetAsync((char*)d_ws + WS_CTL, 0, CTL_ZERO_BYTES, stream);
    Args a{};
    for (int i = 0; i < 32; ++i) a.in[i] = (const float*)d_in[i];
    a.out = (float*)d_out; a.ws = (unsigned char*)d_ws;
#if MK_MULTI
    for (int p = 0; p < N_PHASES; ++p) { a.ph_lo = p; a.ph_hi = p + 1; a.li = p; hipLaunchKernelGGL(mk_fwd, dim3(grid), dim3(NTHR), LDS_BYTES, stream, a); }
#else
    a.ph_lo = 0; a.ph_hi = N_PHASES; a.li = 0;
    hipLaunchKernelGGL(mk_fwd, dim3(grid), dim3(NTHR), LDS_BYTES, stream, a);
#endif
}
```

```cpp
#include <hip/hip_runtime.h>
#include <cstdio>
#include <cstdint>

#ifndef MK_MULTI
#define MK_MULTI 0
#endif
namespace pg8 {
#define PG8_LAS __attribute__((address_space(3)))
typedef unsigned short bf16_t;
typedef short bf16x8 __attribute__((ext_vector_type(8)));
typedef float f32x4 __attribute__((ext_vector_type(4)));
typedef unsigned u32x4 __attribute__((ext_vector_type(4)));
constexpr int BM = 256, BK = 64, HALF = 128, HTB = HALF * BK * 2  , STAGE_BYTES = 8 * HTB, NXCD = 8, WGM = 8;

__host__ __device__ __forceinline__ int lds_byte(int r, int c) { const int st = (r >> 4) * 2 + (c >> 5), rr = r & 15, cc = c & 31, ob = rr * 64 + cc * 2; return st * 1024 + (ob ^ (((ob >> 9) & 1) << 5)); }
__host__ __device__ __forceinline__ void stage_rc(int b, int& R, int& C) { const int st = b / 1024, sb = b % 1024, swz = sb ^ (((sb >> 9) & 1) << 5); R = (st >> 1) * 16 + swz / 64; C = (st & 1) * 32 + (swz % 64) / 2; }
__host__ __device__ __forceinline__ int perm32(int rho) { const int n = rho >> 4, i = rho & 15; return 8 * (i >> 2) + 4 * n + (i & 3); }

struct Unit { int pm, pn; };
struct Gemm { const bf16_t* A; const bf16_t* Bt; int M, N, K; };

struct StaticOrder {
    int nM, nN, nwg, G, c;
    __host__ __device__ void init(int M, int N, int G_, int c_) { nM = M / BM; nN = N / BM; nwg = nM * nN; G = G_; c = c_; }
    __host__ __device__ bool next(int i, Unit& u) const {
        const long L = (long)i * G + c; if (L >= nwg) return false;
        int wgid = (int)L; { const int q = nwg / NXCD, r = nwg % NXCD, xcd = wgid % NXCD, off = wgid / NXCD; wgid = (xcd < r ? xcd * (q + 1) : r * (q + 1) + (xcd - r) * q) + off; }
        const int nig = WGM * nN, gid = wgid / nig, fm = gid * WGM, gsz = (nM - fm) < WGM ? (nM - fm) : WGM;
        u.pm = fm + ((wgid % nig) % gsz); u.pn = (wgid % nig) / gsz; return true;
    }
    __device__ __forceinline__ void a_ready(const Unit&) const {}
    __device__ __forceinline__ void done(const Unit&) const {}
};

__device__ __forceinline__ unsigned cvt_pk_bf16(float lo, float hi) { unsigned r; asm volatile("v_cvt_pk_bf16_f32 %0, %1, %2" : "=v"(r) : "v"(lo), "v"(hi)); return r; }

struct EpiBf16 {
    static constexpr bool PERM = true, AFTER_DRAIN = false;
    bf16_t* O; int ldc;
    __device__ __forceinline__ void operator()(const f32x4 (&acc)[2][2][4][2], const Unit& u, int wr, int wc, int fr, int fq) const {
        const int row0 = u.pm * BM + wr * 64 + fr; const int col0 = u.pn * BM + wc * 32 + 8 * fq;
#pragma unroll
        for (int ai = 0; ai < 2; ++ai)
#pragma unroll
            for (int m = 0; m < 4; ++m) { bf16_t* rowp = O + (size_t)(row0 + ai * HALF + m * 16) * ldc + col0;
#pragma unroll
                for (int bj = 0; bj < 2; ++bj) { const f32x4 v0 = acc[ai][bj][m][0], v1 = acc[ai][bj][m][1];
                    u32x4 w; w.x = cvt_pk_bf16(v0[0], v0[1]); w.y = cvt_pk_bf16(v0[2], v0[3]); w.z = cvt_pk_bf16(v1[0], v1[1]); w.w = cvt_pk_bf16(v1[2], v1[3]);
                    *(u32x4*)(rowp + bj * HALF) = w; } }
    }
};
struct EpiF32 {
    static constexpr bool PERM = false, AFTER_DRAIN = false;
    float* O; int ldr;
    __device__ __forceinline__ void operator()(const f32x4 (&acc)[2][2][4][2], const Unit& u, int wr, int wc, int fr, int fq) const {
        const int row0 = u.pm * BM + wr * 64 + fr; const int col0 = u.pn * BM + wc * 32 + 4 * fq;
#pragma unroll
        for (int ai = 0; ai < 2; ++ai)
#pragma unroll
            for (int m = 0; m < 4; ++m) { const int row = row0 + ai * HALF + m * 16;
#pragma unroll
                for (int bj = 0; bj < 2; ++bj)
#pragma unroll
                    for (int n = 0; n < 2; ++n) { const int cg = (col0 + bj * HALF + n * 16) >> 2; *(f32x4*)(O + ((size_t)cg * ldr + row) * 4) = acc[ai][bj][m][n]; } }
    }
};
struct EpiRes {
    static constexpr bool PERM = false, AFTER_DRAIN = false;
    const float* src_lat; const float* src_ctx; float* dst_lat; float* dst_ctx; const float* gate;
    __device__ __forceinline__ void operator()(const f32x4 (&acc)[2][2][4][2], const Unit& u, int wr, int wc, int fr, int fq) const {
        const bool isc = u.pm >= 64; const int smp = isc ? 2 : (u.pm >> 5);
        const int prow = (isc ? (u.pm - 64) * BM : u.pm * BM) + wr * 64 + fr;
        const float* src = isc ? src_ctx : src_lat; float* dst = isc ? dst_ctx : dst_lat;
        const float* gt = gate + smp * 6144 + 2048;
        const int col0 = u.pn * BM + wc * 32 + 4 * fq;
        f32x4 gv[2][2];
#pragma unroll
        for (int bj = 0; bj < 2; ++bj)
#pragma unroll
            for (int n = 0; n < 2; ++n) gv[bj][n] = *(const f32x4*)(gt + col0 + bj * HALF + n * 16);
#pragma unroll
        for (int ai = 0; ai < 2; ++ai)
#pragma unroll
            for (int m = 0; m < 4; ++m) { const size_t off = (size_t)(prow + ai * HALF + m * 16) * 1024 + col0;
#pragma unroll
                for (int bj = 0; bj < 2; ++bj)
#pragma unroll
                    for (int n = 0; n < 2; ++n) { const f32x4 s = *(const f32x4*)(src + off + bj * HALF + n * 16);
                        *(f32x4*)(dst + off + bj * HALF + n * 16) = s + gv[bj][n] * acc[ai][bj][m][n]; } }
    }
};

template <class Epi, class Sched, bool ALIGN_EPI = false, bool SP2 = false>
__device__ __forceinline__ void gemm_phase(PG8_LAS unsigned char* lds, const Gemm g, const Sched& S, const Epi& E, const int tid) {
    const int wid = __builtin_amdgcn_readfirstlane(tid >> 6), lane = tid & 63, wr = wid >> 2, wc = wid & 3, fr = lane & 15, fq = lane >> 4;
    const int K = g.K, nt = K / BK;
    unsigned voffA[2], voffB[2];
#pragma unroll
    for (int i = 0; i < 2; ++i) { int R, C; stage_rc(tid * 16 + i * 8192, R, C); const int Rb = Epi::PERM ? ((R & ~31) + perm32(R & 31)) : R;
        voffA[i] = (unsigned)(R * K + C) * 2u; voffB[i] = (unsigned)(Rb * K + C) * 2u; }
    const size_t kstep = (size_t)(BK * 2);
    const size_t hstep = (size_t)HALF * K * 2;
    const size_t tstep = 2 * hstep;
    const unsigned ldsw = (unsigned)wid * 1024u;
    const int aoff = lds_byte(wr * 64 + fr, fq * 8), boff = lds_byte(wc * 32 + fr, fq * 8);
#define PG8_SA(b, h) (((b) * 2 + (h)) * HTB)
#define PG8_SB(b, h) ((4 + (b) * 2 + (h)) * HTB)
#define PG8_STAGE(bufoff, gbase, voff) do { _Pragma("unroll") for (int _i = 0; _i < 2; ++_i) \
        __builtin_amdgcn_global_load_lds((const unsigned*)((const char*)(gbase) + (voff)[_i]), (PG8_LAS unsigned*)(lds + (bufoff) + ldsw + _i * 8192), 16, 0, 0); } while (0)
#define PG8_LDA(dst, b, h) do { _Pragma("unroll") for (int m = 0; m < 4; ++m) _Pragma("unroll") for (int k = 0; k < 2; ++k) dst[m][k] = *(const PG8_LAS bf16x8*)(lds + PG8_SA(b, h) + aoff + m * 2048 + k * 1024); } while (0)
#define PG8_LDB(dst, b, h) do { _Pragma("unroll") for (int n = 0; n < 2; ++n) _Pragma("unroll") for (int k = 0; k < 2; ++k) dst[n][k] = *(const PG8_LAS bf16x8*)(lds + PG8_SB(b, h) + boff + n * 2048 + k * 1024); } while (0)
#define PG8_MMA(ai, bj, At, Bt) do { __builtin_amdgcn_s_setprio(1); _Pragma("unroll") for (int m = 0; m < 4; ++m) _Pragma("unroll") for (int n = 0; n < 2; ++n) _Pragma("unroll") for (int k = 0; k < 2; ++k) \
        acc[ai][bj][m][n] = __builtin_amdgcn_mfma_f32_16x16x32_bf16(Bt[n][k], At[m][k], acc[ai][bj][m][n], 0, 0, 0); __builtin_amdgcn_s_setprio(0); } while (0)
#define PG8_WAIT_V(n) asm volatile("s_waitcnt vmcnt(" #n ")" ::: "memory")
#define PG8_WAIT_L(n) asm volatile("s_waitcnt lgkmcnt(" #n ")" ::: "memory")
#define PG8_BAR __builtin_amdgcn_s_barrier()
#define PG8_SCHED __builtin_amdgcn_sched_barrier(0)
    Unit cur, nxt; int ui = 0;
    if (!S.next(0, cur)) return;
    f32x4 acc[2][2][4][2];
#pragma unroll
    for (int a = 0; a < 2; ++a)
#pragma unroll
        for (int b = 0; b < 2; ++b)
#pragma unroll
            for (int m = 0; m < 4; ++m)
#pragma unroll
                for (int n = 0; n < 2; ++n) acc[a][b][m][n] = (f32x4){0.f, 0.f, 0.f, 0.f};
    bf16x8 At[4][2], B0[2][2], B1[2][2];
    const char* cA = (const char*)g.A + (size_t)cur.pm * tstep; const char* cB = (const char*)g.Bt + (size_t)cur.pn * tstep;
    S.a_ready(cur);
    if constexpr (SP2) {
        PG8_STAGE(PG8_SB(0, 0), cB, voffB); PG8_STAGE(PG8_SB(0, 1), cB + hstep, voffB); PG8_STAGE(PG8_SA(0, 0), cA, voffA); PG8_STAGE(PG8_SA(0, 1), cA + hstep, voffA);
        if (wr == 1) PG8_BAR;
        PG8_WAIT_V(2); PG8_BAR;
        PG8_STAGE(PG8_SB(1, 0), cB + kstep, voffB); PG8_STAGE(PG8_SA(1, 0), cA + kstep, voffA); PG8_STAGE(PG8_SB(1, 1), cB + hstep + kstep, voffB);
        PG8_WAIT_V(6); PG8_BAR;
    } else {
        PG8_STAGE(PG8_SB(0, 0), cB, voffB); PG8_STAGE(PG8_SA(0, 0), cA, voffA); PG8_STAGE(PG8_SB(0, 1), cB + hstep, voffB); PG8_STAGE(PG8_SA(0, 1), cA + hstep, voffA);
        if (wr == 1) PG8_BAR;
        PG8_WAIT_V(4); PG8_BAR;
        PG8_STAGE(PG8_SB(1, 0), cB + kstep, voffB); PG8_STAGE(PG8_SA(1, 0), cA + kstep, voffA); PG8_STAGE(PG8_SB(1, 1), cB + hstep + kstep, voffB);
        PG8_WAIT_V(6); PG8_BAR;
    }
    for (;;) {
        const bool has_next = S.next(ui + 1, nxt);
        const char* nA = has_next ? (const char*)g.A + (size_t)nxt.pm * tstep : cA; const char* nB = has_next ? (const char*)g.Bt + (size_t)nxt.pn * tstep : cB;
        for (int t = 0; t < nt; t += 2) {
            const bool last = (t == nt - 2);
            const char* a1 = cA + (size_t)(t + 1) * kstep;
            const char* a2 = last ? nA : cA + (size_t)(t + 2) * kstep; const char* b2 = last ? nB : cB + (size_t)(t + 2) * kstep;
            const char* a3 = a2 + kstep; const char* b3 = b2 + kstep;
            if (last && has_next) S.a_ready(nxt);
            if constexpr (SP2) {
            PG8_LDB(B0, 0, 0); PG8_LDB(B1, 0, 1); PG8_SCHED; PG8_LDA(At, 0, 0); PG8_STAGE(PG8_SA(1, 1), a1 + hstep, voffA);
            PG8_WAIT_V(8); PG8_WAIT_L(0); PG8_BAR; PG8_MMA(0, 0, At, B0); PG8_MMA(0, 1, At, B1); PG8_BAR; PG8_SCHED;
            PG8_LDA(At, 0, 1); PG8_STAGE(PG8_SB(0, 0), b2, voffB); PG8_STAGE(PG8_SB(0, 1), b2 + hstep, voffB); PG8_STAGE(PG8_SA(0, 0), a2, voffA);
            PG8_WAIT_V(8); PG8_WAIT_L(0); PG8_BAR; PG8_MMA(1, 0, At, B0); PG8_MMA(1, 1, At, B1); PG8_BAR; PG8_SCHED;
            PG8_LDB(B0, 1, 0); PG8_LDB(B1, 1, 1); PG8_SCHED; PG8_LDA(At, 1, 0); PG8_STAGE(PG8_SA(0, 1), a2 + hstep, voffA);
            PG8_WAIT_V(8); PG8_WAIT_L(0); PG8_BAR; PG8_MMA(0, 0, At, B0); PG8_MMA(0, 1, At, B1); PG8_BAR; PG8_SCHED;
            PG8_LDA(At, 1, 1); PG8_STAGE(PG8_SB(1, 0), b3, voffB); PG8_STAGE(PG8_SB(1, 1), b3 + hstep, voffB); PG8_STAGE(PG8_SA(1, 0), a3, voffA);
            PG8_WAIT_V(8); PG8_WAIT_L(0); PG8_BAR; PG8_MMA(1, 0, At, B0); PG8_MMA(1, 1, At, B1); PG8_BAR; PG8_SCHED;
            } else {
            PG8_LDB(B0, 0, 0); PG8_SCHED; PG8_LDA(At, 0, 0); PG8_STAGE(PG8_SA(1, 1), a1 + hstep, voffA);
            PG8_WAIT_L(8); PG8_BAR; PG8_WAIT_L(0); PG8_MMA(0, 0, At, B0); PG8_BAR; PG8_SCHED;
            PG8_LDB(B1, 0, 1); PG8_STAGE(PG8_SB(0, 0), b2, voffB);
            PG8_BAR; PG8_WAIT_L(0); PG8_MMA(0, 1, At, B1); PG8_BAR;
            PG8_LDA(At, 0, 1); PG8_STAGE(PG8_SA(0, 0), a2, voffA);
            PG8_BAR; PG8_WAIT_L(0); PG8_MMA(1, 0, At, B0); PG8_BAR; PG8_SCHED;
            PG8_STAGE(PG8_SB(0, 1), b2 + hstep, voffB);
            PG8_WAIT_V(6); PG8_BAR; PG8_MMA(1, 1, At, B1); PG8_BAR;
            PG8_LDB(B0, 1, 0); PG8_SCHED; PG8_LDA(At, 1, 0); PG8_STAGE(PG8_SA(0, 1), a2 + hstep, voffA);
            PG8_WAIT_L(8); PG8_BAR; PG8_WAIT_L(0); PG8_MMA(0, 0, At, B0); PG8_BAR; PG8_SCHED;
            PG8_LDB(B1, 1, 1); PG8_STAGE(PG8_SB(1, 0), b3, voffB);
            PG8_BAR; PG8_WAIT_L(0); PG8_MMA(0, 1, At, B1); PG8_BAR;
            PG8_LDA(At, 1, 1); PG8_STAGE(PG8_SA(1, 0), a3, voffA);
            PG8_BAR; PG8_WAIT_L(0); PG8_MMA(1, 0, At, B0); PG8_BAR; PG8_SCHED;
            PG8_STAGE(PG8_SB(1, 1), b3 + hstep, voffB);
            PG8_WAIT_V(6); PG8_BAR; PG8_MMA(1, 1, At, B1); PG8_BAR;
            }
        }
        if constexpr (ALIGN_EPI) { if (wr == 0) PG8_BAR; }
        if constexpr (!Epi::AFTER_DRAIN) { E(acc, cur, wr, wc, fr, fq); S.done(cur); }
        if (!has_next) break;
#pragma unroll
        for (int a = 0; a < 2; ++a)
#pragma unroll
            for (int b = 0; b < 2; ++b)
#pragma unroll
                for (int m = 0; m < 4; ++m)
#pragma unroll
                    for (int n = 0; n < 2; ++n) acc[a][b][m][n] = (f32x4){0.f, 0.f, 0.f, 0.f};
        cur = nxt; cA = nA; cB = nB; ++ui;
        if constexpr (ALIGN_EPI) { if (wr == 1) PG8_BAR; }
    }
    PG8_WAIT_V(0);
    if constexpr (!ALIGN_EPI) { if (wr == 0) PG8_BAR; }
    PG8_BAR;
    if constexpr (Epi::AFTER_DRAIN) { E.fused(acc, cur, wr, wc, fr, fq, lds, wid, lane); S.done(cur); }
#undef PG8_SA
#undef PG8_SB
#undef PG8_STAGE
#undef PG8_LDA
#undef PG8_LDB
#undef PG8_MMA
#undef PG8_WAIT_V
#undef PG8_WAIT_L
#undef PG8_BAR
#undef PG8_SCHED
}
}
#ifndef ZMASK
#define ZMASK 0
#endif
#define ZF(bit) ((ZMASK & (bit)) ? 0.f : 1.f)
using pg8::bf16_t; using pg8::bf16x8; using pg8::f32x4; using pg8::u32x4;
constexpr int NWAVES = 8, NTHR = 512;
constexpr int DM = 1024, TLAT = 8192, TCTX = 256, MLAT = 2 * TLAT, MCTX = 2 * TCTX, MALL = MLAT + MCTX;
constexpr int DIN = 3152, DINP = 3328;
constexpr int C_CH = 0, C_CB = 256, C_CC = 512, C_RR = 768, C_RK = 1024, C_RV = 1280, C_XW = 1536, C_XA = 1552, C_XG = 1568,
              C_AQ = 1600, C_AK = 1856, C_AV = 1984, C_MQ = 2112, C_MK = 2368, C_MV = 2624, C_MO = 2880, C_MG = 3136;
constexpr float EPSN = 1e-6f;
constexpr int NCHK = 66;
constexpr int CST = 4160;
constexpr int RWREC = 4608;
constexpr size_t MiB = 1u << 20;
constexpr size_t WS_CTL = 0, CTL_ZERO_BYTES = 1 * MiB, WS_MOD = 1 * MiB;
constexpr size_t WS_WIN = 2 * MiB, WIN_LSTRIDE = (size_t)DINP * DM * 2;
constexpr size_t WS_WOUT = 16 * MiB, WOUT_LSTRIDE = 2 * MiB;
constexpr size_t WS_WEFF = 20 * MiB, WEFF_LSTRIDE = 4 * MiB;
constexpr size_t WS_XC = 28 * MiB, WS_GA = 30 * MiB, WS_H = 32 * MiB, WS_YCAT = 65 * MiB, WS_U = 98 * MiB, WS_V = 130 * MiB;
constexpr size_t WS_P = 162 * MiB, WS_RW = 270 * MiB, WS_YR = 345 * MiB, WS_QA = 378 * MiB, WS_KA = 387 * MiB;
constexpr size_t WS_LC = 392 * MiB, WS_ST = 409 * MiB, WS_LB = 426 * MiB, WS_EG = 427 * MiB, WS_GB = 444 * MiB, WS_BS = 453 * MiB, WS_SC = 453 * MiB + 512 * 1024, WS_END = 454 * MiB;
constexpr size_t UV_LSTRIDE = 16 * MiB;
constexpr size_t WS_S = WS_P;
static_assert(WS_P + (size_t)MALL * DINP * 2 <= WS_RW && WS_RW + (size_t)MALL * RWREC <= WS_YR && WS_S + (size_t)MALL * 2048 * 4 <= WS_YR, "ws map");
static_assert(WS_LC + (size_t)16 * NCHK * CST * 4 <= WS_ST && WS_ST + (size_t)16 * NCHK * CST * 4 <= WS_LB && WS_EG + (size_t)MALL * 128 * 8 <= WS_GB, "ws map 2");
constexpr int CW_BAR = 4096;
constexpr int RING_BYTES = 131072, LDSCTL_OFF = RING_BYTES, MISC_OFF = LDSCTL_OFF + 320, LDS_BYTES = 147456;

#define GAS __attribute__((address_space(1)))
#define LAS __attribute__((address_space(3)))
typedef unsigned u32x2 __attribute__((ext_vector_type(2)));
typedef float f32x2 __attribute__((ext_vector_type(2)));
typedef __bf16 bf16x2_t __attribute__((ext_vector_type(2)));
typedef GAS unsigned gu32;
#define LDS_WAIT() asm volatile("s_waitcnt lgkmcnt(0)" ::: "memory")
#define LDS_BARRIER() do { asm volatile("s_waitcnt lgkmcnt(0)" ::: "memory"); __builtin_amdgcn_s_barrier(); asm volatile("" ::: "memory"); } while (0)

__device__ __forceinline__ float lo2f(unsigned w) { return __uint_as_float(w << 16); }
__device__ __forceinline__ float hi2f(unsigned w) { return __uint_as_float(w & 0xffff0000u); }
__device__ __forceinline__ float bf2f(bf16_t b) { return __uint_as_float((unsigned)b << 16); }
__device__ __forceinline__ unsigned f2bf(float f) { unsigned u = __float_as_uint(f); return (u + 0x7fffu + ((u >> 16) & 1u)) >> 16; }
__device__ __forceinline__ unsigned pk2(float lo, float hi) { const f32x2 v = {lo, hi}; const bf16x2_t b = __builtin_convertvector(v, bf16x2_t); return __builtin_bit_cast(unsigned, b); }
__device__ __forceinline__ f32x4 ld4bf(const bf16_t* p) { const u32x2 w = *(const u32x2*)p; return (f32x4){lo2f(w.x), hi2f(w.x), lo2f(w.y), hi2f(w.y)}; }
__device__ __forceinline__ void st4bf(bf16_t* p, f32x4 v) { u32x2 w; w.x = pk2(v[0], v[1]); w.y = pk2(v[2], v[3]); *(u32x2*)p = w; }
__device__ __forceinline__ float sigmoidf_(float x) { return 1.f / (1.f + __expf(-x)); }
__device__ __forceinline__ float tanhf_(float x) { const float e = __expf(-2.f * fabsf(x)); const float t = (1.f - e) / (1.f + e); return x < 0.f ? -t : t; }
template <int CTRL> __device__ __forceinline__ float dppf(float x) { return __int_as_float(__builtin_amdgcn_update_dpp(0, __float_as_int(x), CTRL, 0xf, 0xf, true)); }
__device__ __forceinline__ float red16(float x) { x += dppf<0xB1>(x); x += dppf<0x4E>(x); x += dppf<0x141>(x); x += dppf<0x140>(x); return x; }
__device__ __forceinline__ float wave_sum(float v) {
#pragma unroll
    for (int o = 1; o < 64; o <<= 1) v += __shfl_xor(v, o);
    return v;
}
#define XB_TMO      128
#define XB_XCNT(j)  (256  + 64 * (j))
#define XB_XSUB(j)  (1280 + 64 * (j))
#define XB_XGEN(j)  (2304 + 64 * (j))
#define XB_TOP      3328
#define XB_TOPGEN   3392
#define XCD_BAR_WORDS 3456
#define XB_SPIN_CAP (1u << 18)
#ifndef XB_SLEEP
#define XB_SLEEP 1
#endif

__device__ __forceinline__ unsigned xb_ld(unsigned* p)              { return __hip_atomic_load(p, __ATOMIC_RELAXED, __HIP_MEMORY_SCOPE_AGENT); }
__device__ __forceinline__ unsigned xb_add(unsigned* p, unsigned v) { return __hip_atomic_fetch_add(p, v, __ATOMIC_RELAXED, __HIP_MEMORY_SCOPE_AGENT); }
__device__ __forceinline__ unsigned xb_xcc_id() { return (unsigned)__builtin_amdgcn_s_getreg((3 << 11) | 20) & 0xFu; }
#define XB_SPIN(cond, bar) do { unsigned _sp = 0; while (cond) { __builtin_amdgcn_s_sleep(XB_SLEEP); \
    if ((++_sp & 255u) == 0u) { if (xb_ld(&(bar)[XB_TMO])) break; if (_sp > XB_SPIN_CAP) { atomicAdd(&(bar)[XB_TMO], 1u); break; } } } } while (0)

struct XcdBarrier {
    unsigned* bar; unsigned x;
    volatile LAS unsigned* st;
};

__device__ __forceinline__ XcdBarrier xcd_barrier_post(unsigned* bar, volatile LAS unsigned* st) {
    XcdBarrier b; b.bar = bar; b.x = xb_xcc_id(); b.st = st;
    if (threadIdx.x == 0) (void)xb_add(&bar[XB_XCNT(b.x)], 1u);
    return b;
}
__device__ __forceinline__ void xcd_barrier_complete(unsigned* bar, unsigned x, unsigned& nloc, unsigned& nx) {
    const unsigned G = gridDim.x * gridDim.y * gridDim.z;
    unsigned sum, cnt, mine, sp = 0u;
    for (;;) {
        sum = 0u; cnt = 0u; mine = 0u;
#pragma unroll
        for (unsigned j = 0; j < 16; ++j) { const unsigned c = xb_ld(&bar[XB_XCNT(j)]); sum += c; cnt += (c > 0u) ? 1u : 0u; mine = (j == x) ? c : mine; }
        if (sum == G) break;
        __builtin_amdgcn_s_sleep(1);
        if ((++sp & 255u) == 0u) { if (xb_ld(&bar[XB_TMO])) break; if (sp > XB_SPIN_CAP) { atomicAdd(&bar[XB_TMO], 1u); break; } }
    }
    nloc = mine > 0u ? mine : 1u; nx = cnt > 0u ? cnt : 1u;
}

__device__ __forceinline__ void xcd_barrier(const XcdBarrier& b) {
    asm volatile("s_waitcnt vmcnt(0)" ::: "memory");
    __syncthreads();
    if (threadIdx.x == 0) {
        unsigned* bar = b.bar;
        __builtin_amdgcn_s_waitcnt(0);
        unsigned nloc = b.st[0], nx = b.st[1];
        if (nloc == 0u) { xcd_barrier_complete(bar, b.x, nloc, nx); b.st[0] = nloc; b.st[1] = nx; }
        const unsigned old = xb_add(&bar[XB_XSUB(b.x)], 1u);
        const unsigned gen = old / nloc;
        if (old + 1u == (gen + 1u) * nloc) {
            __builtin_amdgcn_fence(__ATOMIC_RELEASE, "agent");
            asm volatile("s_waitcnt vmcnt(0)" ::: "memory");
            const unsigned og = xb_add(&bar[XB_TOP], 1u);
            const unsigned tg = og / nx;
            if (og + 1u == (tg + 1u) * nx) xb_add(&bar[XB_TOPGEN], 1u);
            else XB_SPIN(xb_ld(&bar[XB_TOPGEN]) == tg, bar);
            __builtin_amdgcn_fence(__ATOMIC_ACQUIRE, "agent");
            xb_add(&bar[XB_XGEN(b.x)], 1u);
            asm volatile("s_waitcnt vmcnt(0)" ::: "memory");
        } else {
            XB_SPIN(xb_ld(&bar[XB_XGEN(b.x)]) == gen, bar);
            __builtin_amdgcn_fence(__ATOMIC_ACQUIRE, "agent");
            asm volatile("s_waitcnt vmcnt(0)" ::: "memory");
        }
    }
    __syncthreads();
}
struct Ctx {
    LAS unsigned char* lds; int tid, lane, wave, vcu, G;
    const float* in[32]; float* out; unsigned char* ws;
};
#define WSP(T, off) ((T*)(F.ws + (off)))

__device__ __forceinline__ void p0_transpose_item(const float* W, int K, int N, bf16_t* WT, LAS float* scr, int item, int lane) {
    const int nblk = (N + 31) / 32, kb = item / nblk, nb = item % nblk, k0 = 64 * kb, n0 = 32 * nb;
    const int nn = n0 + (lane & 31);
#pragma unroll 8
    for (int i = 0; i < 32; ++i) { const int kk = 2 * i + (lane >> 5); scr[kk * 33 + (lane & 31)] = nn < N ? W[(size_t)(k0 + kk) * N + nn] : 0.f; }
    LDS_WAIT(); asm volatile("" ::: "memory");
    const int c = lane & 7;
#pragma unroll
    for (int j = 0; j < 4; ++j) { const int n = (lane >> 3) + 8 * j; const LAS float* s = scr + (8 * c) * 33 + n;
        u32x4 o; o.x = pk2(s[0 * 33], s[1 * 33]); o.y = pk2(s[2 * 33], s[3 * 33]); o.z = pk2(s[4 * 33], s[5 * 33]); o.w = pk2(s[6 * 33], s[7 * 33]);
        *(u32x4*)(WT + (size_t)(n0 + n) * K + k0 + 8 * c) = o; }
    LDS_WAIT(); asm volatile("" ::: "memory");
}
__device__ __forceinline__ void convert_uv_rows(const Ctx& F, int l, int r_lo, int r_hi, int widx, int nworkers) {
    float* SC = WSP(float, WS_SC) + (size_t)l * 2 * 16384;
    for (int r0 = r_lo + widx; r0 < r_hi; r0 += 4 * nworkers) {
        f32x4 v[4][4];
#pragma unroll
        for (int u = 0; u < 4; ++u) { const int r = r0 + u * nworkers < r_hi ? r0 + u * nworkers : r0; const int tb = r >> 14, row = r & 16383;
            const float* src = (tb ? F.in[31] : F.in[30]) + ((size_t)l * 16384 + row) * 1024 + F.lane * 16;
#pragma unroll
            for (int j = 0; j < 4; ++j) v[u][j] = *(const f32x4*)(src + 4 * j); }
#pragma unroll
        for (int u = 0; u < 4; ++u) { const int r = r0 + u * nworkers; if (r >= r_hi) break; const int tb = r >> 14, row = r & 16383;
            float am = 0.f;
#pragma unroll
            for (int j = 0; j < 4; ++j) am = fmaxf(am, fmaxf(fmaxf(fabsf(v[u][j][0]), fabsf(v[u][j][1])), fmaxf(fabsf(v[u][j][2]), fabsf(v[u][j][3]))));
#pragma unroll
            for (int o = 1; o < 64; o <<= 1) am = fmaxf(am, __shfl_xor(am, o));
            const float sc = am > 0.f ? 448.f / am : 1.f;
            unsigned ow[4];
#pragma unroll
            for (int j = 0; j < 4; ++j) { int w = __builtin_amdgcn_cvt_pk_fp8_f32(v[u][j][0] * sc, v[u][j][1] * sc, 0, false); w = __builtin_amdgcn_cvt_pk_fp8_f32(v[u][j][2] * sc, v[u][j][3] * sc, w, true); ow[j] = (unsigned)w; }
            *(u32x4*)(F.ws + (tb ? WS_V : WS_U) + (size_t)l * UV_LSTRIDE + (size_t)row * 1024 + F.lane * 16) = (u32x4){ow[0], ow[1], ow[2], ow[3]};
            if (F.lane == 0) SC[tb * 16384 + row] = am > 0.f ? am * (1.f / 448.f) : 1.f; }
    }
}
__device__ __forceinline__ void convert_uv(const Ctx& F, int l) { convert_uv_rows(F, l, 0, 2 * 16384, F.vcu * NWAVES + F.wave, F.G * NWAVES); }
__device__ __forceinline__ void phase_prologue(const Ctx& F) {
    float* MOD = WSP(float, WS_MOD);
    {
        LAS float* sl = (LAS float*)F.lds; LAS float* red = sl + 3072;
        for (int it = F.vcu; it < 192; it += F.G) {
            const int l = it / 96, n0 = (it % 96) * 64;
            for (int i = F.tid; i < 3072; i += NTHR) { const int s = i >> 10, k = i & 1023; const float c = s < 2 ? F.in[1][s * 1024 + k] : F.in[3][k]; sl[i] = c / (1.f + __expf(-c)); }
            __syncthreads();
            const int c = F.tid & 63, kg = F.tid >> 6;
            const float* W = F.in[4] + (size_t)l * 1024 * 6144 + n0 + c;
            float a0 = 0.f, a1 = 0.f, a2 = 0.f;
#pragma unroll 32
            for (int k = kg * 128; k < kg * 128 + 128; ++k) { const float w = W[(size_t)k * 6144]; a0 += sl[k] * w; a1 += sl[1024 + k] * w; a2 += sl[2048 + k] * w; }
            red[(kg * 3 + 0) * 64 + c] = a0; red[(kg * 3 + 1) * 64 + c] = a1; red[(kg * 3 + 2) * 64 + c] = a2;
            __syncthreads();
            if (F.tid < 192) { const int s = F.tid >> 6, cc = F.tid & 63; float t = F.in[5][l * 6144 + n0 + cc];
#pragma unroll
                for (int g = 0; g < 8; ++g) t += red[(g * 3 + s) * 64 + cc];
                MOD[(l * 3 + s) * 6144 + n0 + cc] = t; }
            __syncthreads();
        }
    }
    {
        LAS float* scr = (LAS float*)(F.lds + F.wave * 16384);
        const int gw = F.vcu * NWAVES + F.wave, NGW = F.G * NWAVES;
        constexpr int I_IN = 16 * 99, I_OUT = 16 * 32, I_L = I_IN + I_OUT;
        for (int it = gw; it < 2 * I_L; it += NGW) {
            const int l = it / I_L; int r = it % I_L;
            if (r < I_IN) p0_transpose_item(F.in[8] + (size_t)l * DM * DIN, DM, DIN, WSP(bf16_t, WS_WIN + l * WIN_LSTRIDE), scr, r, F.lane);
            else p0_transpose_item(F.in[9] + (size_t)l * DM * DM, DM, DM, WSP(bf16_t, WS_WOUT + l * WOUT_LSTRIDE), scr, r - I_IN, F.lane);
        }
        for (int i = F.vcu * NTHR + F.tid; i < 2 * 160 * 128; i += F.G * NTHR) { const int l = i / (160 * 128), r = i % (160 * 128);
            *(u32x4*)(WSP(bf16_t, WS_WIN + l * WIN_LSTRIDE) + (size_t)3168 * DM + (size_t)r * 8) = (u32x4){0u, 0u, 0u, 0u}; }
    }
    __syncthreads();
    {
        LAS float* KEYS = (LAS float*)F.lds; LAS float* WQl = KEYS + 128 * 129;
        const int nper = F.G / 32 > 0 ? F.G / 32 : 1;
        const int tile = F.vcu / nper, sub = F.vcu % nper;
        if (tile < 32) {
            const int l = tile >> 4, hh = tile & 15;
            const float* ksrc = F.in[29] + ((size_t)l * 16 + hh) * 128 * 128;
            { f32x4 kv[8];
#pragma unroll
              for (int q = 0; q < 8; ++q) kv[q] = *(const f32x4*)(ksrc + (size_t)(F.tid + q * NTHR) * 4);
#pragma unroll
              for (int q = 0; q < 8; ++q) { const int i = (F.tid + q * NTHR) * 4; LAS float* d = KEYS + (i >> 7) * 129 + (i & 127); d[0] = kv[q][0]; d[1] = kv[q][1]; d[2] = kv[q][2]; d[3] = kv[q][3]; } }
            for (int kb = sub; kb < 16; kb += nper) {
                const float* wsrc = F.in[28] + (size_t)l * DM * 2048 + (size_t)(kb * 64) * 2048 + hh * 128;
                __syncthreads();
                { f32x4 wv[4];
#pragma unroll
                  for (int q = 0; q < 4; ++q) { const int i = (F.tid + q * NTHR) * 4; wv[q] = *(const f32x4*)(wsrc + (size_t)(i >> 7) * 2048 + (i & 127)); }
#pragma unroll
                  for (int q = 0; q < 4; ++q) { const int i = (F.tid + q * NTHR) * 4, kk = i >> 7, d = i & 127; WQl[d * 68 + kk] = wv[q][0]; WQl[(d + 1) * 68 + kk] = wv[q][1]; WQl[(d + 2) * 68 + kk] = wv[q][2]; WQl[(d + 3) * 68 + kk] = wv[q][3]; } }
                __syncthreads();
                const int key = F.tid & 127, kq = F.tid >> 7;
                float acc[16];
#pragma unroll
                for (int j = 0; j < 16; ++j) acc[j] = 0.f;
#pragma unroll 4
                for (int d = 0; d < 128; ++d) { const float a = KEYS[key * 129 + d]; const LAS f32x4* wq = (const LAS f32x4*)(WQl + d * 68 + kq * 16);
#pragma unroll
                    for (int q = 0; q < 4; ++q) { const f32x4 w = wq[q]; acc[4 * q] += a * w[0]; acc[4 * q + 1] += a * w[1]; acc[4 * q + 2] += a * w[2]; acc[4 * q + 3] += a * w[3]; } }
                bf16_t* dst = WSP(bf16_t, WS_WEFF + l * WEFF_LSTRIDE) + (size_t)(hh * 128 + key) * DM + kb * 64 + kq * 16;
                u32x4 o0, o1; o0.x = pk2(acc[0], acc[1]); o0.y = pk2(acc[2], acc[3]); o0.z = pk2(acc[4], acc[5]); o0.w = pk2(acc[6], acc[7]);
                o1.x = pk2(acc[8], acc[9]); o1.y = pk2(acc[10], acc[11]); o1.z = pk2(acc[12], acc[13]); o1.w = pk2(acc[14], acc[15]);
                *(u32x4*)dst = o0; *(u32x4*)(dst + 8) = o1;
            }
        }
        __syncthreads();
    }
    convert_uv(F, 0); convert_uv(F, 1);
}

__device__ __forceinline__ void phase_norm(const Ctx& F, int l, int which, int nrows, const float* xlat, const float* xctx) {
    const float* gain = F.in[6 + which] + l * DM; const float* mod = WSP(float, WS_MOD) + (size_t)l * 3 * 6144;
    const int shoff = which ? 3072 : 0, scoff = which ? 4096 : 1024;
    bf16_t* H = WSP(bf16_t, WS_H);
    const int gw = F.vcu * NWAVES + F.wave, NGW = F.G * NWAVES;
    for (int row = gw; row < nrows; row += NGW) {
        const bool isc = row >= MLAT; const float* src = isc ? xctx + (size_t)(row - MLAT) * DM : xlat + (size_t)row * DM; const int smp = isc ? 2 : (row >> 13);
        const float* mb = mod + smp * 6144;
        f32x4 v[4]; float ss = 0.f;
#pragma unroll
        for (int j = 0; j < 4; ++j) { v[j] = *(const f32x4*)(src + F.lane * 4 + 256 * j); ss += (v[j][0] * v[j][0] + v[j][1] * v[j][1]) + (v[j][2] * v[j][2] + v[j][3] * v[j][3]); }
        const float rs = rsqrtf(wave_sum(ss) * (1.f / DM) + EPSN);
#pragma unroll
        for (int j = 0; j < 4; ++j) { const int c = F.lane * 4 + 256 * j; const f32x4 g = *(const f32x4*)(gain + c), sc = *(const f32x4*)(mb + scoff + c), sh = *(const f32x4*)(mb + shoff + c);
            const f32x4 o = (v[j] * rs * g) * (1.f + sc) + sh; st4bf(H + (size_t)row * DM + c, o); }
    }
}

__device__ __forceinline__ float log_sigmoid_(float x) { return fminf(x, 0.f) - __logf(1.f + __expf(-fabsf(x))); }
__device__ __forceinline__ void phase_prep(const Ctx& F, int l) {
    LAS float* W2s = (LAS float*)F.lds; LAS float* A2s = W2s + 8192; LAS float* G2s = A2s + 8192; LAS float* tsc = G2s + 8192 + F.wave * 64;
    { const float* w2 = F.in[13] + l * 8192; const float* a2 = F.in[15] + l * 8192; const float* g2 = F.in[16] + l * 8192;
      for (int i = F.tid; i < 8192; i += NTHR) { W2s[i] = w2[i]; A2s[i] = a2[i]; G2s[i] = g2[i]; } }
    __syncthreads();
    const bf16_t* P = WSP(bf16_t, WS_P); bf16_t* YC = WSP(bf16_t, WS_YCAT); bf16_t* QA = WSP(bf16_t, WS_QA); bf16_t* KA = WSP(bf16_t, WS_KA);
    unsigned char* RW = WSP(unsigned char, WS_RW); bf16_t* GB = WSP(bf16_t, WS_GB); float* BS = WSP(float, WS_BS); float* GA = WSP(float, WS_GA);
    const int lane = F.lane, c4 = lane * 4, i16 = lane & 15;
    const f32x4 cw0 = *(const f32x4*)(F.in[10] + l * 768 + c4), cw1 = *(const f32x4*)(F.in[10] + l * 768 + 256 + c4), cw2 = *(const f32x4*)(F.in[10] + l * 768 + 512 + c4);
    const f32x4 cg = *(const f32x4*)(F.in[11] + l * 256 + c4);
    const f32x4 qg = *(const f32x4*)(F.in[21] + l * 64 + (c4 & 63)), kg = *(const f32x4*)(F.in[22] + l * 64 + (c4 & 63));
    const f32x4 k_k = *(const f32x4*)(F.in[17] + l * 256 + c4), k_a = *(const f32x4*)(F.in[18] + l * 256 + c4), r_k = *(const f32x4*)(F.in[19] + l * 256 + c4);
    f32x4 w0[2], a0[2];
#pragma unroll
    for (int d = 0; d < 2; ++d) { w0[d] = *(const f32x4*)(F.in[12] + (l * 2 + d) * 256 + c4); a0[d] = *(const f32x4*)(F.in[14] + (l * 2 + d) * 256 + c4); }
    float invf[4];
#pragma unroll
    for (int j = 0; j < 4; ++j) invf[j] = exp2f(-(float)((c4 + j) & 15) * (13.287712379549449f / 16.f));
    const int gw = F.vcu * NWAVES + F.wave, NGW = F.G * NWAVES;
    struct PrepRaw { u32x2 h1, bg, c1, hp, cp, hn, cn, q, k, r, rk; unsigned xv, mg; };
#define PREP_LOAD(dst, row_) do { const int r_ = (row_); const bool isc_ = r_ >= MLAT; const int t_ = isc_ ? ((r_ - MLAT) & 255) : (r_ & 8191); const int T_ = isc_ ? TCTX : TLAT; \
        const bf16_t* pr_ = P + (size_t)r_ * DINP; const bf16_t* pp_ = t_ > 0 ? pr_ - DINP : pr_; const bf16_t* pn_ = t_ < T_ - 1 ? pr_ + DINP : pr_; \
        dst.h1 = *(const u32x2*)(pr_ + C_CH + c4); dst.bg = *(const u32x2*)(pr_ + C_CB + c4); dst.c1 = *(const u32x2*)(pr_ + C_CC + c4); \
        dst.hp = *(const u32x2*)(pp_ + C_CH + c4); dst.cp = *(const u32x2*)(pp_ + C_CC + c4); dst.hn = *(const u32x2*)(pn_ + C_CH + c4); dst.cn = *(const u32x2*)(pn_ + C_CC + c4); \
        dst.q = *(const u32x2*)(pr_ + C_AQ + c4); dst.k = *(const u32x2*)(pr_ + C_AK + (c4 & 127)); dst.r = *(const u32x2*)(pr_ + C_RR + c4); dst.rk = *(const u32x2*)(pr_ + C_RK + c4); \
        dst.xv = pr_[C_XW + lane]; dst.mg = pr_[C_MG + (lane & 15)]; } while (0)
#define UP4(w_) ((f32x4){lo2f((w_).x), hi2f((w_).x), lo2f((w_).y), hi2f((w_).y)})
    PrepRaw cur, nxt;
    if (gw < MALL) PREP_LOAD(cur, gw);
    for (int row = gw; row < MALL; row += NGW) {
        const bool isc = row >= MLAT; const int t = isc ? ((row - MLAT) & 255) : (row & 8191); const int T = isc ? TCTX : TLAT;
        { const int rn = row + NGW < MALL ? row + NGW : row; PREP_LOAD(nxt, rn); }
        {
            const f32x4 h1 = UP4(cur.h1), bg = UP4(cur.bg), c1 = UP4(cur.c1);
            f32x4 up = UP4(cur.hp) * UP4(cur.cp), un = UP4(cur.hn) * UP4(cur.cn);
            if (t == 0) up = (f32x4){0.f, 0.f, 0.f, 0.f};
            if (t == T - 1) un = (f32x4){0.f, 0.f, 0.f, 0.f};
            const f32x4 y = bg * (cw0 * up + cw1 * (c1 * h1) + cw2 * un);
            const float ss = red16((y[0] * y[0] + y[1] * y[1]) + (y[2] * y[2] + y[3] * y[3]));
            const float rs = rsqrtf(ss * (1.f / 64.f) + EPSN);
            st4bf(YC + (size_t)row * DM + c4, y * rs * cg * ZF(2));
        }
        {
            const f32x4 q = UP4(cur.q); const f32x4 k = UP4(cur.k);
            const float qs = red16((q[0] * q[0] + q[1] * q[1]) + (q[2] * q[2] + q[3] * q[3]));
            const float ks = red16((k[0] * k[0] + k[1] * k[1]) + (k[2] * k[2] + k[3] * k[3]));
            f32x4 qn = q * rsqrtf(qs * (1.f / 64.f) + EPSN) * qg, kn = k * rsqrtf(ks * (1.f / 64.f) + EPSN) * kg;
            if (!isc) {
                f32x4 qp, kp;
#pragma unroll
                for (int j = 0; j < 4; ++j) { qp[j] = __shfl_xor(qn[j], 4); kp[j] = __shfl_xor(kn[j], 4); }
                const int d0 = c4 & 63; const float pos = (d0 < 32) ? (float)(t >> 6) : (float)(t & 63); const bool lowh = (d0 & 16) == 0;
#pragma unroll
                for (int j = 0; j < 4; ++j) { const float th = pos * invf[j]; const float cs = __cosf(th), sn = __sinf(th);
                    qn[j] = lowh ? qn[j] * cs - qp[j] * sn : qn[j] * cs + qp[j] * sn; kn[j] = lowh ? kn[j] * cs - kp[j] * sn : kn[j] * cs + kp[j] * sn; }
            }
            st4bf(QA + (size_t)row * 256 + c4, qn * (0.125f * 1.4426950408889634f));
            if (lane < 32) st4bf(KA + (size_t)row * 128 + c4, kn);
        }
        {
            const f32x4 r = UP4(cur.r), k = UP4(cur.rk);
            { const float xv = bf2f((bf16_t)cur.xv);
              tsc[lane] = lane < 16 ? tanhf_(xv) : (lane < 32 ? xv : sigmoidf_(xv)); }
            const f32x4 kx = k * k_k;
            const float kss = red16((kx[0] * kx[0] + kx[1] * kx[1]) + (kx[2] * kx[2] + kx[3] * kx[3]));
            const f32x4 kk = kx * rsqrtf(kss + EPSN);
            bf16_t* recb = (bf16_t*)(RW + (size_t)row * RWREC); float* recf = (float*)(RW + (size_t)row * RWREC + 2560);
            st4bf(recb + c4, kk);
            f32x4 kdsum = {0.f, 0.f, 0.f, 0.f};
#pragma unroll
            for (int d = 0; d < 2; ++d) {
                f32x4 dw = w0[d], da = a0[d];
#pragma unroll 4
                for (int ii = 0; ii < 16; ++ii) { dw += tsc[ii] * *(const LAS f32x4*)(W2s + (d * 16 + ii) * 256 + c4); da += tsc[16 + ii] * *(const LAS f32x4*)(A2s + (d * 16 + ii) * 256 + c4); }
                f32x4 dec, av;
#pragma unroll
                for (int j = 0; j < 4; ++j) { dec[j] = -0.6065306597126334f * sigmoidf_(dw[j]); av[j] = sigmoidf_(da[j]); }
                const f32x4 kd = k * (1.f + (av - 1.f) * k_a);
                kdsum += kd;
                st4bf(recb + 256 + d * 256 + c4, kk * av);
                st4bf(recb + 768 + d * 256 + c4, kd);
                *(f32x4*)(recf + d * 256 + c4) = dec;
            }
            f32x4 gv = {0.f, 0.f, 0.f, 0.f};
#pragma unroll 4
            for (int ii = 0; ii < 32; ++ii) gv += tsc[32 + ii] * *(const LAS f32x4*)(G2s + ii * 256 + c4);
            st4bf(GB + (size_t)row * 256 + c4, gv);
            const f32x4 bt = r * kdsum * r_k;
            const float bsum = red16((bt[0] + bt[1]) + (bt[2] + bt[3]));
            if (i16 == 0) BS[(size_t)row * 4 + (lane >> 4)] = bsum;
        }
        if (lane < 16) { const int dir = lane >> 3, gate = (lane >> 2) & 1, hd = lane & 3; const float x = bf2f((bf16_t)cur.mg);
            const float bias = gate ? F.in[26][(l * 2 + dir) * 4 + hd] : F.in[25][(l * 2 + dir) * 4 + hd];
            GA[(size_t)row * 16 + lane] = gate ? log_sigmoid_(x + bias) : (x + bias); }
        cur = nxt;
    }
#undef PREP_LOAD
#undef UP4
}
__device__ __forceinline__ int scan_row(int b, int dir, int i) {
    if (i < TCTX) return MLAT + b * TCTX + (dir ? (TCTX - 1 - i) : i);
    const int p = i - TCTX; return b * TLAT + (dir ? (TLAT - 1 - p) : p);
}
__device__ __forceinline__ void rwkv_scan(const Ctx& F, int blk) {
    const int chain = blk >> 2, quarter = blk & 3, b = chain >> 3, head = (chain >> 1) & 3, dir = chain & 1;
    const bool scanner = F.wave < 4;
    const int rowv = (quarter * 4 + (F.wave & 3)) * 4 + (F.lane >> 4), s = F.lane & 15;
    LAS float* buf = (LAS float*)F.lds;
    const bf16_t* P = WSP(bf16_t, WS_P); const unsigned char* RW = WSP(unsigned char, WS_RW); float* YR = WSP(float, WS_YR) + (size_t)dir * MALL * 256;
    const int st = F.tid >> 4, sub = F.tid & 15;
    constexpr int NSTEP = TCTX + TLAT, NCH = NSTEP / 32;
    u32x2 g_kk, g_al, g_kd, g_r, g_v; f32x4 g_w;
#define RW_LOAD(c) do { const int row_ = scan_row(b, dir, (c) * 32 + st); const bf16_t* rb_ = (const bf16_t*)(RW + (size_t)row_ * RWREC) + head * 64 + sub * 4; \
        g_kk = *(const u32x2*)rb_; g_al = *(const u32x2*)(rb_ + 256 + dir * 256); g_kd = *(const u32x2*)(rb_ + 768 + dir * 256); \
        g_w = *(const f32x4*)((const float*)(RW + (size_t)row_ * RWREC + 2560) + dir * 256 + head * 64 + sub * 4); \
        const bf16_t* pp_ = P + (size_t)row_ * DINP + head * 64 + sub * 4; g_r = *(const u32x2*)(pp_ + C_RR); g_v = *(const u32x2*)(pp_ + C_RV); } while (0)
#define RW_STORE(par) do { LAS float* d_ = buf + ((par) * 32 + st) * 384 + sub * 4; \
        *(LAS f32x4*)(d_) = (f32x4){lo2f(g_kk.x), hi2f(g_kk.x), lo2f(g_kk.y), hi2f(g_kk.y)}; *(LAS f32x4*)(d_ + 64) = (f32x4){lo2f(g_al.x), hi2f(g_al.x), lo2f(g_al.y), hi2f(g_al.y)}; \
        *(LAS f32x4*)(d_ + 128) = (f32x4){lo2f(g_kd.x), hi2f(g_kd.x), lo2f(g_kd.y), hi2f(g_kd.y)}; *(LAS f32x4*)(d_ + 192) = g_w; \
        *(LAS f32x4*)(d_ + 256) = (f32x4){lo2f(g_r.x), hi2f(g_r.x), lo2f(g_r.y), hi2f(g_r.y)}; *(LAS f32x4*)(d_ + 320) = (f32x4){lo2f(g_v.x), hi2f(g_v.x), lo2f(g_v.y), hi2f(g_v.y)}; } while (0)
    f32x4 S = {0.f, 0.f, 0.f, 0.f};
    RW_LOAD(0); RW_STORE(0); __syncthreads();
    for (int c = 0; c < NCH; ++c) {
        const int par = c & 1;
        if (c + 1 < NCH) RW_LOAD(c + 1);
        if (scanner) {
        float ykeep = 0.f;
        f32x4 Lkk[3], Lal[3], Lkd[3], Lw[3], Lr[3]; float Lv[3];
#define SC_LD(set, i_) do { const LAS float* d_ = buf + (par * 32 + (i_)) * 384; Lkk[set] = *(const LAS f32x4*)(d_ + s * 4); Lal[set] = *(const LAS f32x4*)(d_ + 64 + s * 4); \
            Lkd[set] = *(const LAS f32x4*)(d_ + 128 + s * 4); Lw[set] = *(const LAS f32x4*)(d_ + 192 + s * 4); Lr[set] = *(const LAS f32x4*)(d_ + 256 + s * 4); Lv[set] = d_[320 + rowv]; } while (0)
        SC_LD(0, 0); SC_LD(1, 1);
#pragma unroll
        for (int i = 0; i < 32; ++i) {
            if (i + 2 < 32) SC_LD((i + 2) % 3, i + 2);
            const f32x4 kk = Lkk[i % 3], al = Lal[i % 3], kd = Lkd[i % 3], w = Lw[i % 3], r = Lr[i % 3]; const float vr = Lv[i % 3];
            const float sa = red16((S[0] * kk[0] + S[1] * kk[1]) + (S[2] * kk[2] + S[3] * kk[3]));
            S = S * w + (vr * kd - sa * al);
            const float y = red16((S[0] * r[0] + S[1] * r[1]) + (S[2] * r[2] + S[3] * r[3]));
            ykeep = (s == (i & 15)) ? y : ykeep;
            if ((i & 15) == 15) {
                const int stp = c * 32 + (i - 15) + s; const int pc = dir ? (TCTX - 1 - stp) : stp, pl = dir ? (TLAT - 1 - (stp - TCTX)) : (stp - TCTX);
                const int row = stp < TCTX ? (MLAT + b * TCTX + pc) : (b * TLAT + pl);
                YR[(size_t)row * 256 + head * 64 + rowv] = ykeep; }
        }
#undef SC_LD
        }
        if (c + 1 < NCH) RW_STORE(par ^ 1);
        __syncthreads();
    }
#undef RW_LOAD
#undef RW_STORE
}

typedef union { u32x4 u; bf16x8 b; } frag_u;
__device__ __forceinline__ void attn_unit(const Ctx& F, int l, int unit) {
    LAS bf16_t* Kl = (LAS bf16_t*)F.lds; LAS bf16_t* Vt = Kl + 64 * 72;
    const bf16_t* P = WSP(bf16_t, WS_P); const bf16_t* QA = WSP(bf16_t, WS_QA); const bf16_t* KA = WSP(bf16_t, WS_KA); bf16_t* YC = WSP(bf16_t, WS_YCAT);
    const bool isc = unit >= 256; int b, kvh, n;
    if (!isc) { b = unit >> 7; kvh = (unit >> 6) & 1; n = unit & 63; } else { const int u = unit - 256; b = u >> 2; kvh = (u >> 1) & 1; n = u & 1; }
    const int g = F.wave >> 2, ps = F.wave & 3, head = kvh * 2 + g, i = F.lane & 15, gq = F.lane >> 4;
    const int qpos0 = n * 128 + ps * 32, qrow0 = (isc ? MLAT + b * TCTX : b * TLAT) + qpos0;
    bf16x8 Qf[2][2];
#pragma unroll
    for (int qb = 0; qb < 2; ++qb)
#pragma unroll
        for (int ks = 0; ks < 2; ++ks) Qf[qb][ks] = *(const bf16x8*)(QA + (size_t)(qrow0 + qb * 16 + i) * 256 + head * 64 + ks * 32 + gq * 8);
    const float sinkl = F.in[23][l * 4 + head] * 1.4426950408889634f;
    float mrun[2] = {sinkl, sinkl}, lsum[2]; lsum[0] = lsum[1] = (gq == 0) ? 1.f : 0.f;
    f32x4 ao[4][2];
#pragma unroll
    for (int db = 0; db < 4; ++db) { ao[db][0] = (f32x4){0.f, 0.f, 0.f, 0.f}; ao[db][1] = (f32x4){0.f, 0.f, 0.f, 0.f}; }
    const int ntl = isc ? 4 : 10;
    const int skey = F.tid >> 3, sch = F.tid & 7;
#define ATT_KROW(tt_) ((!isc && (tt_) < 6) ? ((2 * (n - 1) + (tt_) < 0 || 2 * (n - 1) + (tt_) >= 128) ? -1 : b * TLAT + (2 * (n - 1) + (tt_)) * 64) : MLAT + b * TCTX + (isc ? (tt_) : (tt_) - 6) * 64)
#define ATT_LOAD(tt_) do { const int kr_ = ATT_KROW(tt_); if (kr_ >= 0) { pk_kv = *(const u32x4*)(KA + (size_t)(kr_ + skey) * 128 + kvh * 64 + sch * 8); pk_vv = *(const u32x4*)(P + (size_t)(kr_ + skey) * DINP + C_AV + kvh * 64 + sch * 8); } } while (0)
    u32x4 pk_kv = {0u, 0u, 0u, 0u}, pk_vv = {0u, 0u, 0u, 0u};
    int tt0 = 0; while (tt0 < ntl && ATT_KROW(tt0) < 0) ++tt0;
    ATT_LOAD(tt0);
    for (int tt = tt0; tt < ntl; ++tt) {
        const int krow0 = ATT_KROW(tt); if (krow0 < 0) continue;
        const bool band = !isc && tt < 6; const int kpos0 = band ? (2 * (n - 1) + tt) * 64 : 0;
        LDS_BARRIER();
        { const u32x4 kv = pk_kv, vv = pk_vv;
          *(LAS u32x4*)(Kl + skey * 72 + sch * 8) = kv;
          const unsigned ww[4] = {vv.x, vv.y, vv.z, vv.w};
#pragma unroll
          for (int j = 0; j < 4; ++j) { Vt[(sch * 8 + 2 * j) * 72 + skey] = (bf16_t)(ww[j] & 0xffffu); Vt[(sch * 8 + 2 * j + 1) * 72 + skey] = (bf16_t)(ww[j] >> 16); } }
        { int tn = tt + 1; while (tn < ntl && ATT_KROW(tn) < 0) ++tn; if (tn < ntl) ATT_LOAD(tn); }
        LDS_BARRIER();
        f32x4 sc[4][2];
#pragma unroll
        for (int kb = 0; kb < 4; ++kb) {
            sc[kb][0] = (f32x4){0.f, 0.f, 0.f, 0.f}; sc[kb][1] = (f32x4){0.f, 0.f, 0.f, 0.f};
#pragma unroll
            for (int ks = 0; ks < 2; ++ks) { const bf16x8 kf = *(const LAS bf16x8*)(Kl + (kb * 16 + i) * 72 + ks * 32 + gq * 8);
                sc[kb][0] = __builtin_amdgcn_mfma_f32_16x16x32_bf16(kf, Qf[0][ks], sc[kb][0], 0, 0, 0);
                sc[kb][1] = __builtin_amdgcn_mfma_f32_16x16x32_bf16(kf, Qf[1][ks], sc[kb][1], 0, 0, 0); }
        }
#pragma unroll
        for (int qb = 0; qb < 2; ++qb) {
            const int qp = qpos0 + qb * 16 + i;
            float mx = -1e30f;
#pragma unroll
            for (int kb = 0; kb < 4; ++kb)
#pragma unroll
                for (int r = 0; r < 4; ++r) { if (band) { const int dd = (kpos0 + kb * 16 + 4 * gq + r) - qp; if (dd > 128 || dd < -128) sc[kb][qb][r] = -1e30f; } mx = fmaxf(mx, sc[kb][qb][r]); }
            mx = fmaxf(mx, __shfl_xor(mx, 16)); mx = fmaxf(mx, __shfl_xor(mx, 32));
            const float mnew = fmaxf(mrun[qb], mx), alpha = exp2f(mrun[qb] - mnew); mrun[qb] = mnew;
            float ps_ = 0.f;
#pragma unroll
            for (int kb = 0; kb < 4; ++kb)
#pragma unroll
                for (int r = 0; r < 4; ++r) { const float p = exp2f(sc[kb][qb][r] - mnew); sc[kb][qb][r] = p; ps_ += p; }
            lsum[qb] = lsum[qb] * alpha + ps_;
#pragma unroll
            for (int db = 0; db < 4; ++db) ao[db][qb] *= alpha;
        }
#pragma unroll
        for (int ks2 = 0; ks2 < 2; ++ks2) {
            frag_u pf[2];
#pragma unroll
            for (int qb = 0; qb < 2; ++qb) { pf[qb].u.x = pg8::cvt_pk_bf16(sc[2 * ks2][qb][0], sc[2 * ks2][qb][1]); pf[qb].u.y = pg8::cvt_pk_bf16(sc[2 * ks2][qb][2], sc[2 * ks2][qb][3]);
                pf[qb].u.z = pg8::cvt_pk_bf16(sc[2 * ks2 + 1][qb][0], sc[2 * ks2 + 1][qb][1]); pf[qb].u.w = pg8::cvt_pk_bf16(sc[2 * ks2 + 1][qb][2], sc[2 * ks2 + 1][qb][3]); }
#pragma unroll
            for (int db = 0; db < 4; ++db) { frag_u vf; const LAS bf16_t* vp = Vt + (db * 16 + i) * 72 + (2 * ks2) * 16 + 4 * gq;
                const u32x2 v0 = *(const LAS u32x2*)vp, v1 = *(const LAS u32x2*)(vp + 16); vf.u = (u32x4){v0.x, v0.y, v1.x, v1.y};
                ao[db][0] = __builtin_amdgcn_mfma_f32_16x16x32_bf16(vf.b, pf[0].b, ao[db][0], 0, 0, 0);
                ao[db][1] = __builtin_amdgcn_mfma_f32_16x16x32_bf16(vf.b, pf[1].b, ao[db][1], 0, 0, 0); }
        }
    }
#undef ATT_KROW
#undef ATT_LOAD
    const float* og = F.in[24] + l * 256 + head * 64;
#pragma unroll
    for (int qb = 0; qb < 2; ++qb) {
        float lt = lsum[qb]; lt += __shfl_xor(lt, 16); lt += __shfl_xor(lt, 32);
        const float il = 1.f / lt; float ss = 0.f;
#pragma unroll
        for (int db = 0; db < 4; ++db) { ao[db][qb] *= il; ss += (ao[db][qb][0] * ao[db][qb][0] + ao[db][qb][1] * ao[db][qb][1]) + (ao[db][qb][2] * ao[db][qb][2] + ao[db][qb][3] * ao[db][qb][3]); }
        ss += __shfl_xor(ss, 16); ss += __shfl_xor(ss, 32);
        const float rs = rsqrtf(ss * (1.f / 64.f) + EPSN);
        bf16_t* yo = YC + (size_t)(qrow0 + qb * 16 + i) * DM + 512 + head * 64;
#pragma unroll
        for (int db = 0; db < 4; ++db) { const f32x4 gg = *(const f32x4*)(og + db * 16 + 4 * gq); st4bf(yo + db * 16 + 4 * gq, ao[db][qb] * rs * gg * ZF(8)); }
    }
    __syncthreads();
}

__device__ __forceinline__ int ml_row(int b, int dir, int j, int tp) {
    if (j < 2) { const int p = j * 128 + tp; return MLAT + b * TCTX + (dir ? (TCTX - 1 - p) : p); }
    const int p = (j - 2) * 128 + tp; return b * TLAT + (dir ? (TLAT - 1 - p) : p);
}
__device__ __forceinline__ void scan128_add(float& x0, float& x1, int lane) {
    x1 += x0; float t = x1;
#pragma unroll
    for (int o = 1; o < 64; o <<= 1) { const float u = __shfl_up(t, o); if (lane >= o) t += u; }
    const float ex = t - x1; x0 += ex; x1 = t;
}
__device__ __forceinline__ void scan128_max(float& x0, float& x1, int lane) {
    x1 = fmaxf(x1, x0); float t = x1;
#pragma unroll
    for (int o = 1; o < 64; o <<= 1) { const float u = __shfl_up(t, o); if (lane >= o) t = fmaxf(t, u); }
    const float pv = __shfl_up(t, 1); if (lane > 0) x0 = fmaxf(x0, pv); x1 = t;
}
__device__ __forceinline__ void ml_stage_T(const Ctx& F, const bf16_t* P, int b, int dir, int j, int col0, LAS bf16_t* dst, const LAS float* sw, float cscale) {
#pragma unroll
    for (int it = 0; it < 2; ++it) { const int id = F.tid + it * NTHR, tp = id >> 3, ch = id & 7;
        const u32x4 v = *(const u32x4*)(P + (size_t)ml_row(b, dir, j, tp) * DINP + col0 + ch * 8); const float s = (sw ? sw[tp] : 1.f) * cscale;
        const unsigned ww[4] = {v.x, v.y, v.z, v.w};
#pragma unroll
        for (int q = 0; q < 4; ++q) { dst[(ch * 8 + 2 * q) * 136 + tp] = (bf16_t)f2bf(lo2f(ww[q]) * s); dst[(ch * 8 + 2 * q + 1) * 136 + tp] = (bf16_t)f2bf(hi2f(ww[q]) * s); } }
}
__device__ __forceinline__ void ml_stage_R(const Ctx& F, const bf16_t* P, int b, int dir, int j, int col0, LAS bf16_t* dst, float cscale) {
#pragma unroll
    for (int it = 0; it < 2; ++it) { const int id = F.tid + it * NTHR, tp = id >> 3, ch = id & 7;
        u32x4 v = *(const u32x4*)(P + (size_t)ml_row(b, dir, j, tp) * DINP + col0 + ch * 8);
        if (cscale != 1.f) { v.x = pk2(lo2f(v.x) * cscale, hi2f(v.x) * cscale); v.y = pk2(lo2f(v.y) * cscale, hi2f(v.y) * cscale); v.z = pk2(lo2f(v.z) * cscale, hi2f(v.z) * cscale); v.w = pk2(lo2f(v.w) * cscale, hi2f(v.w) * cscale); }
        *(LAS u32x4*)(dst + tp * 72 + ch * 8) = v; }
}
__device__ __forceinline__ void mlstm_local(const Ctx& F, int task) {
    const int chain = task / NCHK, j = task % NCHK, b = chain >> 3, head = (chain >> 1) & 3, dir = chain & 1;
    const bf16_t* P = WSP(bf16_t, WS_P); const float* GA = WSP(float, WS_GA);
    LAS bf16_t* Vt = (LAS bf16_t*)F.lds; LAS bf16_t* Kt = Vt + 64 * 136; LAS float* wS = (LAS float*)(Kt + 64 * 136); LAS float* sc2 = wS + 128;
    __syncthreads();
    if (F.wave == 0) {
        const int r0 = ml_row(b, dir, j, 2 * F.lane), r1 = ml_row(b, dir, j, 2 * F.lane + 1);
        const float li0 = GA[(size_t)r0 * 16 + dir * 8 + head], li1 = GA[(size_t)r1 * 16 + dir * 8 + head];
        float b0 = GA[(size_t)r0 * 16 + dir * 8 + 4 + head], b1 = GA[(size_t)r1 * 16 + dir * 8 + 4 + head];
        scan128_add(b0, b1, F.lane);
        const float bend = __shfl(b1, 63);
        const float d0 = bend - b0 + li0, d1 = bend - b1 + li1;
        float mx = fmaxf(d0, d1);
#pragma unroll
        for (int o = 1; o < 64; o <<= 1) mx = fmaxf(mx, __shfl_xor(mx, o));
        wS[2 * F.lane] = __expf(d0 - mx); wS[2 * F.lane + 1] = __expf(d1 - mx);
        if (F.lane == 0) { sc2[0] = mx; sc2[1] = bend; }
    }
    __syncthreads();
    ml_stage_T(F, P, b, dir, j, C_MV + head * 64, Vt, wS, 1.f);
    ml_stage_T(F, P, b, dir, j, C_MK + head * 64, Kt, nullptr, 0.125f);
    __syncthreads();
    float* LC = WSP(float, WS_LC) + (size_t)task * CST;
    { const int vb = F.wave >> 1, i = F.lane & 15, gq = F.lane >> 4;
#pragma unroll
      for (int kk2 = 0; kk2 < 2; ++kk2) { const int kb = 2 * (F.wave & 1) + kk2; f32x4 acc = {0.f, 0.f, 0.f, 0.f};
#pragma unroll
          for (int ks = 0; ks < 4; ++ks) { const bf16x8 a = *(const LAS bf16x8*)(Vt + (vb * 16 + i) * 136 + ks * 32 + gq * 8), bb = *(const LAS bf16x8*)(Kt + (kb * 16 + i) * 136 + ks * 32 + gq * 8);
              acc = __builtin_amdgcn_mfma_f32_16x16x32_bf16(a, bb, acc, 0, 0, 0); }
#pragma unroll
          for (int r = 0; r < 4; ++r) LC[(vb * 16 + 4 * gq + r) * 64 + kb * 16 + i] = acc[r]; } }
    if (F.tid < 64) { float a = 0.f;
#pragma unroll 8
        for (int s = 0; s < 128; ++s) a += wS[s] * bf2f(Kt[F.tid * 136 + s]);
        LC[4096 + F.tid] = a; }
    if (F.tid == 0) { float* LB = WSP(float, WS_LB); LB[task * 2] = sc2[0]; LB[task * 2 + 1] = sc2[1]; }
}
__device__ __forceinline__ void mlstm_chain(const Ctx& F, int blk0) {
    const int gt = (F.vcu - blk0) * NTHR + F.tid; if (gt < 0 || gt >= 16 * CST) return;
    const int chain = gt / CST, e = gt % CST;
    const float* LC = WSP(float, WS_LC) + (size_t)chain * NCHK * CST + e; float* ST = WSP(float, WS_ST) + (size_t)chain * NCHK * CST + e;
    const float* LB = WSP(float, WS_LB) + chain * NCHK * 2; float* SM = WSP(float, WS_LB) + 4096 + chain * NCHK;
    float m = 0.f, x = 0.f;
#pragma unroll 1
    for (int g = 0; g < 3; ++g) {
        float d[22], Lv[22], Bv[22];
#pragma unroll
        for (int q = 0; q < 22; ++q) { const int j = g * 22 + q; d[q] = LC[(size_t)j * CST]; Lv[q] = LB[2 * j]; Bv[q] = LB[2 * j + 1]; }
#pragma unroll
        for (int q = 0; q < 22; ++q) { const int j = g * 22 + q;
            ST[(size_t)j * CST] = x; if (e == 0) SM[j] = m;
            const float mn = fmaxf(Bv[q] + m, Lv[q]);
            x = __expf(Bv[q] + m - mn) * x + __expf(Lv[q] - mn) * d[q]; m = mn; }
    }
}
__device__ __forceinline__ void mlstm_out(const Ctx& F, int l, int unit) {
    const bool isc = unit >= 512; int b, chunk, head;
    if (!isc) { b = unit >> 8; chunk = (unit >> 2) & 63; head = unit & 3; } else { const int u = unit - 512; b = u >> 3; chunk = (u >> 2) & 1; head = u & 3; }
    const bf16_t* P = WSP(bf16_t, WS_P); const float* GA = WSP(float, WS_GA); bf16_t* YC = WSP(bf16_t, WS_YCAT);
    LAS bf16_t* Ql = (LAS bf16_t*)F.lds; LAS bf16_t* Kl = Ql + 128 * 72; LAS bf16_t* Vt = Kl + 128 * 72; LAS bf16_t* Cb = Vt + 64 * 136;
    LAS float* nS = (LAS float*)(Cb + 64 * 72); LAS float* aS = nS + 64; LAS float* bS = aS + 128; LAS float* MS = bS + 128; LAS float* Hs = MS + 128;
    const int i = F.lane & 15, gq = F.lane >> 4, w = F.wave;
    for (int dir = 0; dir < 2; ++dir) {
        const int j = isc ? (dir ? 1 - chunk : chunk) : 2 + (dir ? 63 - chunk : chunk);
        const int chain = (b * 4 + head) * 2 + dir;
        const float* ST = WSP(float, WS_ST) + ((size_t)chain * NCHK + j) * CST; const float mprev = WSP(float, WS_LB)[4096 + chain * NCHK + j];
        __syncthreads();
        if (w == 0) {
            const int r0 = ml_row(b, dir, j, 2 * F.lane), r1 = ml_row(b, dir, j, 2 * F.lane + 1);
            const float li0 = GA[(size_t)r0 * 16 + dir * 8 + head], li1 = GA[(size_t)r1 * 16 + dir * 8 + head];
            float b0 = GA[(size_t)r0 * 16 + dir * 8 + 4 + head], b1 = GA[(size_t)r1 * 16 + dir * 8 + 4 + head];
            scan128_add(b0, b1, F.lane);
            const float a0 = li0 - b0, a1 = li1 - b1; float A0 = a0, A1 = a1;
            scan128_max(A0, A1, F.lane);
            aS[2 * F.lane] = a0; aS[2 * F.lane + 1] = a1; bS[2 * F.lane] = b0; bS[2 * F.lane + 1] = b1;
            MS[2 * F.lane] = fmaxf(A0, mprev); MS[2 * F.lane + 1] = fmaxf(A1, mprev);
        }
        ml_stage_R(F, P, b, dir, j, C_MQ + head * 64, Ql, 1.f);
        ml_stage_R(F, P, b, dir, j, C_MK + head * 64, Kl, 0.125f);
        ml_stage_T(F, P, b, dir, j, C_MV + head * 64, Vt, nullptr, 1.f);
        { const f32x4 c0 = *(const f32x4*)(ST + F.tid * 8), c1 = *(const f32x4*)(ST + F.tid * 8 + 4); const int v = F.tid >> 3, k0 = (F.tid & 7) * 8;
          u32x4 o; o.x = pk2(c0[0], c0[1]); o.y = pk2(c0[2], c0[3]); o.z = pk2(c1[0], c1[1]); o.w = pk2(c1[2], c1[3]); *(LAS u32x4*)(Cb + v * 72 + k0) = o;
          if (F.tid < 64) nS[F.tid] = ST[4096 + F.tid]; }
        __syncthreads();
        const int t = 16 * w + i; const float Mt = MS[t], bt = bS[t];
        bf16x8 Qf[2];
#pragma unroll
        for (int ks = 0; ks < 2; ++ks) Qf[ks] = *(const LAS bf16x8*)(Ql + t * 72 + ks * 32 + gq * 8);
        f32x4 sc[8];
#pragma unroll
        for (int sb = 0; sb < 8; ++sb) { sc[sb] = (f32x4){0.f, 0.f, 0.f, 0.f};
            if (sb <= w) {
#pragma unroll
                for (int ks = 0; ks < 2; ++ks) { const bf16x8 kf = *(const LAS bf16x8*)(Kl + (sb * 16 + i) * 72 + ks * 32 + gq * 8); sc[sb] = __builtin_amdgcn_mfma_f32_16x16x32_bf16(kf, Qf[ks], sc[sb], 0, 0, 0); }
#pragma unroll
                for (int r = 0; r < 4; ++r) { const int s = sb * 16 + 4 * gq + r; sc[sb][r] = (s <= t) ? sc[sb][r] * __expf(aS[s] - Mt) : 0.f; }
            } }
        float den = 0.f;
#pragma unroll
        for (int sb = 0; sb < 8; ++sb) den += (sc[sb][0] + sc[sb][1]) + (sc[sb][2] + sc[sb][3]);
        den += __shfl_xor(den, 16); den += __shfl_xor(den, 32);
        f32x4 nm[4], it_[4];
#pragma unroll
        for (int vb = 0; vb < 4; ++vb) { nm[vb] = (f32x4){0.f, 0.f, 0.f, 0.f}; it_[vb] = (f32x4){0.f, 0.f, 0.f, 0.f}; }
#pragma unroll
        for (int ks2 = 0; ks2 < 4; ++ks2) if (2 * ks2 <= w) {
            frag_u pf; pf.u.x = pg8::cvt_pk_bf16(sc[2 * ks2][0], sc[2 * ks2][1]); pf.u.y = pg8::cvt_pk_bf16(sc[2 * ks2][2], sc[2 * ks2][3]);
            pf.u.z = pg8::cvt_pk_bf16(sc[2 * ks2 + 1][0], sc[2 * ks2 + 1][1]); pf.u.w = pg8::cvt_pk_bf16(sc[2 * ks2 + 1][2], sc[2 * ks2 + 1][3]);
#pragma unroll
            for (int vb = 0; vb < 4; ++vb) { frag_u vf; const LAS bf16_t* vp = Vt + (vb * 16 + i) * 136 + (2 * ks2) * 16 + 4 * gq;
                const u32x2 v0 = *(const LAS u32x2*)vp, v1 = *(const LAS u32x2*)(vp + 16); vf.u = (u32x4){v0.x, v0.y, v1.x, v1.y};
                nm[vb] = __builtin_amdgcn_mfma_f32_16x16x32_bf16(vf.b, pf.b, nm[vb], 0, 0, 0); }
        }
#pragma unroll
        for (int vb = 0; vb < 4; ++vb)
#pragma unroll
            for (int ks = 0; ks < 2; ++ks) { const bf16x8 cf = *(const LAS bf16x8*)(Cb + (vb * 16 + i) * 72 + ks * 32 + gq * 8); it_[vb] = __builtin_amdgcn_mfma_f32_16x16x32_bf16(cf, Qf[ks], it_[vb], 0, 0, 0); }
        float nq = 0.f;
#pragma unroll
        for (int c = 0; c < 2; ++c) { const u32x4 qv = *(const LAS u32x4*)(Ql + t * 72 + gq * 16 + c * 8); const unsigned ww[4] = {qv.x, qv.y, qv.z, qv.w};
#pragma unroll
            for (int q = 0; q < 4; ++q) nq += nS[gq * 16 + c * 8 + 2 * q] * lo2f(ww[q]) + nS[gq * 16 + c * 8 + 2 * q + 1] * hi2f(ww[q]); }
        nq += __shfl_xor(nq, 16); nq += __shfl_xor(nq, 32);
        const float wint = __expf(mprev - Mt); den += wint * nq;
        const float dn = 1.f / fmaxf(fabsf(den), __expf(-(bt + Mt)));
        const int torig = dir ? 127 - t : t;
#pragma unroll
        for (int vb = 0; vb < 4; ++vb)
#pragma unroll
            for (int r = 0; r < 4; ++r) { const float hv = (nm[vb][r] + wint * it_[vb][r]) * dn; LAS float* hp = Hs + torig * 65 + vb * 16 + 4 * gq + r; if (dir == 0) *hp = hv; else *hp += hv; }
    }
    __syncthreads();
    {
        const int t = F.tid >> 2, vq = F.tid & 3; const int row = (isc ? MLAT + b * TCTX : b * TLAT) + chunk * 128 + t;
        float hv[16], ss = 0.f;
#pragma unroll
        for (int q = 0; q < 16; ++q) { hv[q] = Hs[t * 65 + vq * 16 + q]; ss += hv[q] * hv[q]; }
        ss += __shfl_xor(ss, 1); ss += __shfl_xor(ss, 2);
        const float rs = rsqrtf(ss * (1.f / 64.f) + EPSN);
        const float* og = F.in[27] + l * 256 + head * 64 + vq * 16; const bf16_t* op = P + (size_t)row * DINP + C_MO + head * 64 + vq * 16;
        const u32x4 o0 = *(const u32x4*)op, o1 = *(const u32x4*)(op + 8); const unsigned ow[8] = {o0.x, o0.y, o0.z, o0.w, o1.x, o1.y, o1.z, o1.w};
        unsigned res[8];
#pragma unroll
        for (int q = 0; q < 8; ++q) { const float y0 = sigmoidf_(lo2f(ow[q])) * hv[2 * q] * rs * og[2 * q], y1 = sigmoidf_(hi2f(ow[q])) * hv[2 * q + 1] * rs * og[2 * q + 1]; res[q] = pk2(y0 * ZF(16), y1 * ZF(16)); }
        bf16_t* yo = YC + (size_t)row * DM + 768 + head * 64 + vq * 16;
        *(u32x4*)yo = (u32x4){res[0], res[1], res[2], res[3]}; *(u32x4*)(yo + 8) = (u32x4){res[4], res[5], res[6], res[7]};
    }
    __syncthreads();
}
__device__ __forceinline__ void rwkv_finish(const Ctx& F, int l, int nrows) {
    const bf16_t* P = WSP(bf16_t, WS_P); const float* YR = WSP(float, WS_YR); const bf16_t* GB = WSP(bf16_t, WS_GB); const float* BS = WSP(float, WS_BS); bf16_t* YC = WSP(bf16_t, WS_YCAT);
    const int c4 = F.lane * 4; const f32x4 lg = *(const f32x4*)(F.in[20] + l * 256 + c4);
    const int gw = F.vcu * NWAVES + F.wave, NGW = F.G * NWAVES;
    for (int row = gw; row < nrows; row += NGW) {
        const f32x4 y = *(const f32x4*)(YR + (size_t)row * 256 + c4) + *(const f32x4*)(YR + (size_t)(MALL + row) * 256 + c4);
        const float ss = red16((y[0] * y[0] + y[1] * y[1]) + (y[2] * y[2] + y[3] * y[3]));
        const float rs = rsqrtf(ss * (1.f / 64.f) + EPSN);
        const f32x4 v = ld4bf(P + (size_t)row * DINP + C_RV + c4), g = ld4bf(GB + (size_t)row * 256 + c4);
        const float bn = BS[(size_t)row * 4 + (F.lane >> 4)];
        st4bf(YC + (size_t)row * DM + 256 + c4, (y * rs * lg * ZF(32) + bn * v * ZF(64)) * g * ZF(4));
    }
}
constexpr int RCH = 132;
constexpr int MP = 72, SLOT = 64 * MP;
constexpr size_t WS_RG = 454 * MiB, RG_TASK = 3 * 8192, WS_SST = WS_RW;
constexpr size_t WS_END2 = 504 * MiB;
static_assert(WS_RG + (size_t)16 * RCH * RG_TASK <= WS_END2 && (size_t)16 * RCH * 8192 <= (size_t)MALL * RWREC, "rwkv chunk ws map");

__device__ __forceinline__ void mm64(const LAS bf16_t* A, const LAS bf16_t* Bt, int w, int lane, f32x4 (&acc)[2]) {
    const int i = lane & 15, gq = lane >> 4, mb = w >> 1, nb0 = 2 * (w & 1);
    acc[0] = (f32x4){0.f, 0.f, 0.f, 0.f}; acc[1] = (f32x4){0.f, 0.f, 0.f, 0.f};
#pragma unroll
    for (int ks = 0; ks < 2; ++ks) { const bf16x8 a = *(const LAS bf16x8*)(A + (mb * 16 + i) * MP + ks * 32 + gq * 8);
#pragma unroll
        for (int q = 0; q < 2; ++q) { const bf16x8 b = *(const LAS bf16x8*)(Bt + ((nb0 + q) * 16 + i) * MP + ks * 32 + gq * 8); acc[q] = __builtin_amdgcn_mfma_f32_16x16x32_bf16(a, b, acc[q], 0, 0, 0); } }
}
__device__ __forceinline__ u32x2 pk4(f32x4 v) { u32x2 o; o.x = pk2(v[0], v[1]); o.y = pk2(v[2], v[3]); return o; }
__device__ __forceinline__ f32x4 up4(u32x2 w) { return (f32x4){lo2f(w.x), hi2f(w.x), lo2f(w.y), hi2f(w.y)}; }

struct RaRaw { u32x4 kk, al, kd, r, v; f32x4 ld0, ld1; };
__device__ __forceinline__ void ra_load(const Ctx& F, int task, RaRaw& g) {
    const int chain = task / RCH, c = task % RCH, b = chain >> 3, head = (chain >> 1) & 3, dir = chain & 1;
    const bf16_t* P = WSP(bf16_t, WS_P); const unsigned char* RW = WSP(unsigned char, WS_RW);
    const int t = F.tid >> 3, ch0 = (F.tid & 7) * 8; const int row = scan_row(b, dir, c * 64 + t);
    const bf16_t* rb = (const bf16_t*)(RW + (size_t)row * RWREC) + head * 64 + ch0;
    g.kk = *(const u32x4*)rb; g.al = *(const u32x4*)(rb + 256 + dir * 256); g.kd = *(const u32x4*)(rb + 768 + dir * 256);
    const float* ldp = (const float*)(RW + (size_t)row * RWREC + 2560) + dir * 256 + head * 64 + ch0;
    g.ld0 = *(const f32x4*)ldp; g.ld1 = *(const f32x4*)(ldp + 4);
    const bf16_t* pp = P + (size_t)row * DINP + head * 64 + ch0;
    g.r = *(const u32x4*)(pp + C_RR); g.v = *(const u32x4*)(pp + C_RV);
}
__device__ __forceinline__ void rwkv_chunk_pre(const Ctx& F, int task, const RaRaw& cur) {
    const int chain = task / RCH, c = task % RCH, b = chain >> 3, head = (chain >> 1) & 3, dir = chain & 1;
    LAS bf16_t* L0 = (LAS bf16_t*)F.lds;
#define SL(k) (L0 + (k) * SLOT)
    LAS float* LD = (LAS float*)SL(8);
    LAS float* SEG = (LAS float*)SL(10);
    LAS float* WLs = (LAS float*)SL(14);
    const int w = F.wave, lane = F.lane, i = lane & 15, gq = lane >> 4, mb = w >> 1, nb0 = 2 * (w & 1), m0 = mb * 16 + 4 * gq;
    LDS_BARRIER();
    const int t = F.tid >> 3, ch0 = (F.tid & 7) * 8;
    const u32x4 g_kk = cur.kk, g_al = cur.al, g_kd = cur.kd, g_r = cur.r, g_v = cur.v; const f32x4 ld0 = cur.ld0, ld1 = cur.ld1;
    *(LAS f32x4*)(LD + t * 64 + ch0) = ld0; *(LAS f32x4*)(LD + t * 64 + ch0 + 4) = ld1;
    LDS_BARRIER();
    { const int k = F.tid & 63, seg = F.tid >> 6; float s = 0.f;
#pragma unroll
      for (int j = 0; j < 8; ++j) s += LD[(seg * 8 + j) * 64 + k];
      SEG[seg * 64 + k] = s;
      LDS_BARRIER();
      float off = 0.f;
#pragma unroll
      for (int j = 0; j < 8; ++j) off += (j < seg) ? SEG[j * 64 + k] : 0.f;
#pragma unroll
      for (int j = 0; j < 8; ++j) { off += LD[(seg * 8 + j) * 64 + k]; LD[(seg * 8 + j) * 64 + k] = off; }
    }
    LDS_BARRIER();
    {
        const unsigned kkw[4] = {g_kk.x, g_kk.y, g_kk.z, g_kk.w}, alw[4] = {g_al.x, g_al.y, g_al.z, g_al.w}, kdw[4] = {g_kd.x, g_kd.y, g_kd.z, g_kd.w},
                       rw_[4] = {g_r.x, g_r.y, g_r.z, g_r.w}, vw[4] = {g_v.x, g_v.y, g_v.z, g_v.w};
        float okt[8], oai[8], oki[8], ort[8], oat[8], okb[8];
#pragma unroll
        for (int j = 0; j < 8; ++j) {
            const float cl = LD[t * 64 + ch0 + j], clp = t > 0 ? LD[(t - 1) * 64 + ch0 + j] : 0.f, clL = LD[63 * 64 + ch0 + j];
            const float kkv = (j & 1) ? hi2f(kkw[j >> 1]) : lo2f(kkw[j >> 1]), alv = (j & 1) ? hi2f(alw[j >> 1]) : lo2f(alw[j >> 1]), kdv = (j & 1) ? hi2f(kdw[j >> 1]) : lo2f(kdw[j >> 1]),
                        rv = (j & 1) ? hi2f(rw_[j >> 1]) : lo2f(rw_[j >> 1]);
            const float ec = __expf(cl), en = __builtin_amdgcn_rcpf(ec), eL = __expf(clL) * en;
            okt[j] = kkv * __expf(clp); oai[j] = alv * en; oki[j] = kdv * en; ort[j] = rv * ec; oat[j] = alv * eL; okb[j] = kdv * eL;
        }
        u32x4 o;
        o = (u32x4){pk2(okt[0], okt[1]), pk2(okt[2], okt[3]), pk2(okt[4], okt[5]), pk2(okt[6], okt[7])}; *(LAS u32x4*)(SL(0) + t * MP + ch0) = o;
        o = (u32x4){pk2(oai[0], oai[1]), pk2(oai[2], oai[3]), pk2(oai[4], oai[5]), pk2(oai[6], oai[7])}; *(LAS u32x4*)(SL(2) + t * MP + ch0) = o;
        o = (u32x4){pk2(oki[0], oki[1]), pk2(oki[2], oki[3]), pk2(oki[4], oki[5]), pk2(oki[6], oki[7])}; *(LAS u32x4*)(SL(3) + t * MP + ch0) = o;
        o = (u32x4){pk2(ort[0], ort[1]), pk2(ort[2], ort[3]), pk2(ort[4], ort[5]), pk2(ort[6], ort[7])}; *(LAS u32x4*)(SL(4) + t * MP + ch0) = o;
#pragma unroll
        for (int j = 0; j < 8; ++j) { SL(1)[(ch0 + j) * MP + t] = (bf16_t)f2bf(okt[j]); SL(5)[(ch0 + j) * MP + t] = (bf16_t)f2bf(oat[j]); SL(6)[(ch0 + j) * MP + t] = (bf16_t)f2bf(okb[j]);
            SL(7)[(ch0 + j) * MP + t] = (bf16_t)(((j & 1) ? (vw[j >> 1] >> 16) : (vw[j >> 1] & 0xffffu))); }
        if (t == 63) {
#pragma unroll
            for (int j = 0; j < 8; ++j) WLs[ch0 + j] = __expf(LD[63 * 64 + ch0 + j]); }
    }
    LDS_BARRIER();
    f32x4 acc[2];
    mm64(SL(0), SL(2), w, lane, acc);
#pragma unroll
    for (int q = 0; q < 2; ++q) { const int n = (nb0 + q) * 16 + i; f32x4 a, ti;
#pragma unroll
        for (int r = 0; r < 4; ++r) { const bool keep = (m0 + r) > n; a[r] = keep ? acc[q][r] : 0.f; ti[r] = ((m0 + r) == n ? 1.f : 0.f) - a[r]; }
#pragma unroll
        for (int r = 0; r < 4; ++r) { SL(8)[(m0 + r) * MP + n] = (bf16_t)f2bf(a[r]); SL(13)[(m0 + r) * MP + n] = (bf16_t)f2bf(ti[r]); }
        *(LAS u32x2*)(SL(9) + n * MP + m0) = pk4(a); }
    mm64(SL(0), SL(3), w, lane, acc);
#pragma unroll
    for (int q = 0; q < 2; ++q) { const int n = (nb0 + q) * 16 + i;
#pragma unroll
        for (int r = 0; r < 4; ++r) SL(10)[(m0 + r) * MP + n] = (bf16_t)f2bf((m0 + r) > n ? acc[q][r] : 0.f); }
    mm64(SL(4), SL(2), w, lane, acc);
#pragma unroll
    for (int q = 0; q < 2; ++q) { const int n = (nb0 + q) * 16 + i;
#pragma unroll
        for (int r = 0; r < 4; ++r) SL(11)[(m0 + r) * MP + n] = (bf16_t)f2bf((m0 + r) >= n ? acc[q][r] : 0.f); }
    mm64(SL(4), SL(3), w, lane, acc);
#pragma unroll
    for (int q = 0; q < 2; ++q) { const int n = (nb0 + q) * 16 + i;
#pragma unroll
        for (int r = 0; r < 4; ++r) SL(12)[(m0 + r) * MP + n] = (bf16_t)f2bf((m0 + r) >= n ? acc[q][r] : 0.f); }
    LDS_BARRIER();
#pragma unroll
    for (int it = 0; it < 5; ++it) {
        LAS bf16_t* Xs = (it & 1) ? SL(2) : SL(8); LAS bf16_t* XsT = (it & 1) ? SL(3) : SL(9);
        LAS bf16_t* Xd = (it & 1) ? SL(8) : SL(2); LAS bf16_t* XdT = (it & 1) ? SL(9) : SL(3);
        LAS bf16_t* Tsrc = (it & 1) ? SL(0) : SL(13); LAS bf16_t* Tdst = (it & 1) ? SL(13) : SL(0);
        mm64(Xs, XsT, w, lane, acc);
#pragma unroll
        for (int q = 0; q < 2; ++q) { const int n = (nb0 + q) * 16 + i;
#pragma unroll
            for (int r = 0; r < 4; ++r) Xd[(m0 + r) * MP + n] = (bf16_t)f2bf(acc[q][r]);
            *(LAS u32x2*)(XdT + n * MP + m0) = pk4(acc[q]); }
        LDS_BARRIER();
        mm64(Tsrc, XdT, w, lane, acc);
#pragma unroll
        for (int q = 0; q < 2; ++q) { const int n = (nb0 + q) * 16 + i;
#pragma unroll
            for (int r = 0; r < 4; ++r) Tdst[(m0 + r) * MP + n] = (bf16_t)f2bf(bf2f(Tsrc[(m0 + r) * MP + n]) + acc[q][r]); }
        LDS_BARRIER();
    }
    LAS bf16_t* Ti = SL(0);
    mm64(Ti, SL(1), w, lane, acc);
#pragma unroll
    for (int q = 0; q < 2; ++q) { const int n = (nb0 + q) * 16 + i; *(LAS u32x2*)(SL(2) + n * MP + m0) = pk4(acc[q]); }
    mm64(SL(10), SL(7), w, lane, acc);
#pragma unroll
    for (int q = 0; q < 2; ++q) { const int n = (nb0 + q) * 16 + i; *(LAS u32x2*)(SL(3) + n * MP + m0) = pk4(acc[q]); }
    LDS_BARRIER();
    mm64(Ti, SL(3), w, lane, acc);
#pragma unroll
    for (int q = 0; q < 2; ++q) { const int n = (nb0 + q) * 16 + i; *(LAS u32x2*)(SL(8) + n * MP + m0) = pk4(acc[q]); }
    LDS_BARRIER();
    bf16_t* RG = (bf16_t*)(F.ws + WS_RG + (size_t)task * RG_TASK);
    f32x4 acc2[2];
    mm64(SL(2), SL(11), w, lane, acc);
#pragma unroll
    for (int q = 0; q < 2; ++q) { const int n = (nb0 + q) * 16 + i; const f32x4 rt = up4(*(const LAS u32x2*)(SL(4) + n * MP + m0)); *(u32x2*)(RG + n * 64 + m0) = pk4(rt - acc[q]); }
    mm64(SL(2), SL(5), w, lane, acc);
#pragma unroll
    for (int q = 0; q < 2; ++q) { const int n = (nb0 + q) * 16 + i; f32x4 g;
#pragma unroll
        for (int r = 0; r < 4; ++r) g[r] = ((m0 + r) == n ? WLs[n] : 0.f) - acc[q][r];
        *(u32x2*)(RG + 4096 + n * 64 + m0) = pk4(g); }
    mm64(SL(6), SL(7), w, lane, acc); mm64(SL(5), SL(8), w, lane, acc2);
#pragma unroll
    for (int q = 0; q < 2; ++q) { const int n = (nb0 + q) * 16 + i; *(u32x2*)(RG + 8192 + n * 64 + m0) = pk4(acc[q] - acc2[q]); }
    mm64(SL(7), SL(12), w, lane, acc); mm64(SL(8), SL(11), w, lane, acc2);
    float* YR = WSP(float, WS_YR) + (size_t)dir * MALL * 256;
#pragma unroll
    for (int q = 0; q < 2; ++q) { const int n = (nb0 + q) * 16 + i; const int rown = scan_row(b, dir, c * 64 + n); *(f32x4*)(YR + (size_t)rown * 256 + head * 64 + m0) = acc[q] - acc2[q]; }
#undef SL
}

__device__ __forceinline__ void rwkv_chain(const Ctx& F, int chain) {
    LAS bf16_t* const L0 = (LAS bf16_t*)F.lds;
    LAS bf16_t* Gl[2] = {L0, L0 + SLOT}; LAS bf16_t* Sl[2] = {L0 + 2 * SLOT, L0 + 3 * SLOT}; LAS bf16_t* Hl[2] = {L0 + 4 * SLOT, L0 + 5 * SLOT};
    const int w = F.wave, lane = F.lane, i = lane & 15, gq = lane >> 4, mb = w >> 1, nb0 = 2 * (w & 1), m0 = mb * 16 + 4 * gq;
    const bf16_t* RGc = (const bf16_t*)(F.ws + WS_RG + (size_t)chain * RCH * RG_TASK); bf16_t* SST = (bf16_t*)(F.ws + WS_SST) + (size_t)chain * RCH * 4096;
    const int gr = F.tid >> 3, gc = (F.tid & 7) * 8, goff = gr * 64 + gc, loff = gr * MP + gc;
    constexpr int RBD = 6, RBU = 66;
    static_assert(RBU % RBD == 0 && RCH % RBU == 0, "ring depth / unroll");
    u32x4 rg[RBD], rh[RBD];
#define RB_LOAD(slot, cc) do { const bf16_t* p_ = RGc + (size_t)((cc) < RCH ? (cc) : RCH - 1) * (RG_TASK / 2); rg[slot] = *(const u32x4*)(p_ + 4096 + goff); rh[slot] = *(const u32x4*)(p_ + 8192 + goff); } while (0)
#pragma unroll
    for (int j = 0; j < RBD; ++j) RB_LOAD(j, j);
    __syncthreads();
    { unsigned z_; asm volatile("v_mov_b32 %0, 0" : "=v"(z_)); *(LAS u32x4*)(Sl[0] + loff) = (u32x4){z_, z_, z_, z_}; }
    *(LAS u32x4*)(Gl[0] + loff) = rg[0]; *(LAS u32x4*)(Hl[0] + loff) = rh[0];
    __syncthreads();
#ifdef TPROBE
    const unsigned long long tp0_ = __builtin_amdgcn_s_memrealtime();
#endif
#define RB_STEP(j) do { const int c = c0 + (j); if (c < RCH - 1) { const int par = c & 1; \
        *(u32x4*)(SST + (size_t)c * 4096 + goff) = *(const LAS u32x4*)(Sl[par] + loff);            \
        f32x4 acc[2]; mm64(Gl[par], Sl[par], w, lane, acc); \
        { const f32x4 h0 = up4(*(const LAS u32x2*)(Hl[par] + (nb0 * 16 + i) * MP + m0)), h1 = up4(*(const LAS u32x2*)(Hl[par] + ((nb0 + 1) * 16 + i) * MP + m0)); \
          *(LAS u32x2*)(Sl[par ^ 1] + (nb0 * 16 + i) * MP + m0) = pk4(acc[0] + h0); *(LAS u32x2*)(Sl[par ^ 1] + ((nb0 + 1) * 16 + i) * MP + m0) = pk4(acc[1] + h1); } \
        *(LAS u32x4*)(Gl[par ^ 1] + loff) = rg[((j) + 1) % RBD]; *(LAS u32x4*)(Hl[par ^ 1] + loff) = rh[((j) + 1) % RBD]; \
        RB_LOAD((j) % RBD, c + RBD); \
        asm volatile("s_waitcnt lgkmcnt(0)" ::: "memory"); __builtin_amdgcn_s_barrier(); asm volatile("" ::: "memory"); } } while (0)
#pragma unroll 1
    for (int c0 = 0; c0 < RCH; c0 += RBU) {
#pragma unroll
        for (int j = 0; j < RBU; ++j) RB_STEP(j); }
#undef RB_STEP
#undef RB_LOAD
    *(u32x4*)(SST + (size_t)(RCH - 1) * 4096 + goff) = *(const LAS u32x4*)(Sl[(RCH - 1) & 1] + loff);
#ifdef TPROBE
    if (chain == 0 && F.tid == 0) *(float*)(F.ws + WS_CTL + 65536) = 3000.f * (floorf((float)(__builtin_amdgcn_s_memrealtime() - tp0_) * (1.f / 3000.f)) + 0.5f);
#endif
    __syncthreads();
}

__device__ __forceinline__ void rwkv_out(const Ctx& F, int l, int unit) {
    const bool isc = unit >= 256; int b, chunk; if (!isc) { b = unit >> 7; chunk = unit & 127; } else { const int u = unit - 256; b = u >> 2; chunk = u & 3; }
    LAS bf16_t* Rl = (LAS bf16_t*)F.lds; LAS bf16_t* Sl = Rl + SLOT; LAS float* Ys = (LAS float*)(F.lds + 4 * SLOT * 2);
    const int w = F.wave, lane = F.lane, i = lane & 15, gq = lane >> 4, mb = w >> 1, nb0 = 2 * (w & 1), m0 = mb * 16 + 4 * gq;
    const int row0 = (isc ? MLAT + b * TCTX : b * TLAT) + chunk * 64;
    const int gr = F.tid >> 3, gc = (F.tid & 7) * 8;
#define RO_PTRS(hd_, RGp, SSp) do { const int head_ = (hd_) >> 1, dir_ = (hd_) & 1, chain_ = (b * 4 + head_) * 2 + dir_; const int cc_ = isc ? (dir_ ? 3 - chunk : chunk) : 4 + (dir_ ? 127 - chunk : chunk); \
        RGp = (const bf16_t*)(F.ws + WS_RG + ((size_t)chain_ * RCH + cc_) * RG_TASK); SSp = (const bf16_t*)(F.ws + WS_SST) + ((size_t)chain_ * RCH + cc_) * 4096; } while (0)
    u32x4 rv, sv;
    { const bf16_t* RG0; const bf16_t* SS0; RO_PTRS(0, RG0, SS0); rv = *(const u32x4*)(RG0 + gr * 64 + gc); sv = *(const u32x4*)(SS0 + gr * 64 + gc); }
#pragma unroll 1
    for (int hd = 0; hd < 8; ++hd) {
        const int head = hd >> 1, dir = hd & 1;
        const float* YR = WSP(float, WS_YR) + (size_t)dir * MALL * 256;
        LDS_BARRIER();
        *(LAS u32x4*)(Rl + gr * MP + gc) = rv; *(LAS u32x4*)(Sl + gr * MP + gc) = sv;
        if (hd < 7) { const bf16_t* RGn; const bf16_t* SSn; RO_PTRS(hd + 1, RGn, SSn); rv = *(const u32x4*)(RGn + gr * 64 + gc); sv = *(const u32x4*)(SSn + gr * 64 + gc); }
        f32x4 yl[2];
#pragma unroll
        for (int q = 0; q < 2; ++q) { const int n = (nb0 + q) * 16 + i; const int tor = dir ? 63 - n : n; yl[q] = *(const f32x4*)(YR + (size_t)(row0 + tor) * 256 + head * 64 + m0); }
        LDS_BARRIER();
        f32x4 acc[2]; mm64(Sl, Rl, w, lane, acc);
#pragma unroll
        for (int q = 0; q < 2; ++q) { const int n = (nb0 + q) * 16 + i; const int tor = dir ? 63 - n : n;
            LAS f32x4* yp = (LAS f32x4*)(Ys + tor * 260 + head * 64 + m0);
            if (dir == 0) *yp = acc[q] + yl[q]; else *yp = *yp + acc[q] + yl[q]; }
    }
#undef RO_PTRS
    __syncthreads();
    {
        const bf16_t* P = WSP(bf16_t, WS_P); const bf16_t* GB = WSP(bf16_t, WS_GB); const float* BS = WSP(float, WS_BS); bf16_t* YC = WSP(bf16_t, WS_YCAT);
        const int c4 = lane * 4; const f32x4 lg = *(const f32x4*)(F.in[20] + l * 256 + c4);
#pragma unroll 1
        for (int tt = w; tt < 64; tt += NWAVES) { const int row = row0 + tt;
            const f32x4 y = *(const LAS f32x4*)(Ys + tt * 260 + c4);
            const float ss = red16((y[0] * y[0] + y[1] * y[1]) + (y[2] * y[2] + y[3] * y[3]));
            const float rs = rsqrtf(ss * (1.f / 64.f) + EPSN);
            const f32x4 v = ld4bf(P + (size_t)row * DINP + C_RV + c4), g = ld4bf(GB + (size_t)row * 256 + c4);
            const float bn = BS[(size_t)row * 4 + (lane >> 4)];
            st4bf(YC + (size_t)row * DM + 256 + c4, (y * rs * lg * ZF(32) + bn * v * ZF(64)) * g * ZF(4)); }
    }
    __syncthreads();
}
__device__ __forceinline__ float clr7(float x) { return __uint_as_float(__float_as_uint(x) & 0xFFFFFF80u); }
__device__ __forceinline__ void ins16(float (&L)[16], float p) {
#pragma unroll
    for (int j = 15; j >= 1; --j) L[j] = __builtin_amdgcn_fmed3f(L[j - 1], L[j], p);
    L[0] = fmaxf(L[0], p);
}
__device__ __forceinline__ void peer_topk_task(const float* sg, size_t gstride, u32x2* eg) {
    float L0[16], L1[16];
#pragma unroll
    for (int j = 0; j < 16; ++j) { L0[j] = -INFINITY; L1[j] = -INFINITY; }
    f32x4 pa[4], pb[4];
#pragma unroll
    for (int u = 0; u < 4; ++u) { pa[u] = *(const f32x4*)(sg + (size_t)u * gstride); pb[u] = *(const f32x4*)(sg + (size_t)(32 + u) * gstride); }
#pragma unroll 4
    for (int i = 0; i < 128; i += 4) {
        const f32x4 a = pa[(i >> 2) & 3], b = pb[(i >> 2) & 3];
        { const int gn = (i >> 2) + 4 < 32 ? (i >> 2) + 4 : 31; pa[(i >> 2) & 3] = *(const f32x4*)(sg + (size_t)gn * gstride); pb[(i >> 2) & 3] = *(const f32x4*)(sg + (size_t)(32 + gn) * gstride); }
#pragma unroll
        for (int q = 0; q < 4; ++q) { ins16(L0, __uint_as_float((__float_as_uint(a[q]) & 0xFFFFFF80u) | (unsigned)(i + q)));
                                      ins16(L1, __uint_as_float((__float_as_uint(b[q]) & 0xFFFFFF80u) | (unsigned)(i + q))); }
    }
    float T[16];
#pragma unroll
    for (int j = 0; j < 16; ++j) T[j] = -INFINITY;
#pragma unroll
    for (int a = 0; a < 16; ++a)
#pragma unroll
        for (int b = 0; b < 16; ++b) if ((a + 1) * (b + 1) <= 16) { const float s = clr7(L0[a]) + clr7(L1[b]);
            ins16(T, __uint_as_float((__float_as_uint(s) & 0xFFFFFF00u) | (unsigned)(a * 16 + b))); }
    float e[16], sum = 0.f; const float mx = __uint_as_float(__float_as_uint(T[0]) & 0xFFFFFF00u);
#pragma unroll
    for (int j = 0; j < 16; ++j) { e[j] = __expf(__uint_as_float(__float_as_uint(T[j]) & 0xFFFFFF00u) - mx); sum += e[j]; }
    const float inv = 1.f / sum;
#pragma unroll
    for (int j = 0; j < 16; ++j) {
        const unsigned ab = __float_as_uint(T[j]) & 0xFFu, a = ab >> 4, b = ab & 15u; unsigned i0 = 0u, i1 = 0u;
#pragma unroll
        for (int q = 0; q < 16; ++q) { i0 = (a == (unsigned)q) ? (__float_as_uint(L0[q]) & 0x7Fu) : i0; i1 = (b == (unsigned)q) ? (__float_as_uint(L1[q]) & 0x7Fu) : i1; }
        eg[j] = (u32x2){i0 * 128u + i1, __float_as_uint(e[j] * inv)};
    }
}
__device__ __forceinline__ float gelu_tanh(float x) { const float u = 0.7978845608028654f * (x + 0.044715f * x * x * x); return 0.5f * x * (1.f + tanhf_(u)); }
__device__ __forceinline__ float dot2bf(unsigned w, unsigned x, float acc) { return __builtin_amdgcn_fdot2_f32_bf16(__builtin_bit_cast(bf16x2_t, w), __builtin_bit_cast(bf16x2_t, x), acc, false); }
__device__ __forceinline__ float wave_total63(float x) {
    x = red16(x);
    x += __int_as_float(__builtin_amdgcn_update_dpp(0, __float_as_int(x), 0x142, 0xa, 0xf, false));
    x += __int_as_float(__builtin_amdgcn_update_dpp(0, __float_as_int(x), 0x143, 0xc, 0xf, false));
    return x;
}
__device__ __forceinline__ void phase_peer(const Ctx& F, int l, int nrows, const float* mod, float* wr_override) {
    const float* S = WSP(float, WS_S); u32x2* EG = WSP(u32x2, WS_EG); const bf16_t* H = WSP(bf16_t, WS_H);
    const unsigned char* U = F.ws + WS_U + (size_t)l * UV_LSTRIDE; const unsigned char* V = F.ws + WS_V + (size_t)l * UV_LSTRIDE;
    const float* USC = WSP(float, WS_SC) + (size_t)l * 2 * 16384; const float* VSC = USC + 16384;
    const int tpb = nrows / F.G, tok0 = F.vcu * tpb;
    volatile LAS unsigned* tkflag = (volatile LAS unsigned*)F.lds;
    if (F.tid == 0) tkflag[0] = 0u;
    { const int ntok1 = tpb < 64 ? tpb : 64; const int task = F.tid; const int hd = task / ntok1, tkn = task - hd * ntok1;
      if (hd < 8) { const int row = tok0 + tkn; peer_topk_task(S + ((size_t)(hd * 64) * MALL + row) * 4, (size_t)MALL * 4, EG + (size_t)row * 128 + hd * 16); } }
    __threadfence_block(); __syncthreads();
    if (tpb > 64 && F.wave == 2) {
        const int nex = tpb - 64; const int hd = F.lane / nex, tkn = F.lane - hd * nex;
        if (hd < 8) { const int row = tok0 + 64 + tkn; peer_topk_task(S + ((size_t)(hd * 64) * MALL + row) * 4, (size_t)MALL * 4, EG + (size_t)row * 128 + hd * 16); }
        __threadfence_block(); asm volatile("s_waitcnt vmcnt(0) lgkmcnt(0)" ::: "memory");
        if (F.lane == 0) tkflag[0] = 1u;
    }
    const int lane = F.lane;
    for (int tk = F.wave; tk < tpb; tk += NWAVES) {
        if (tk >= 64) { while (tkflag[0] == 0u) __builtin_amdgcn_s_sleep(8); __threadfence_block(); }
        const int row = tok0 + tk; const bool isc = row >= MLAT; const int smp = isc ? 2 : (row >> 13);
        float* xrow = isc ? WSP(float, WS_XC) + (size_t)(row - MLAT) * DM : F.out + (size_t)row * DM;
        f32x2 hv[8];
        { const u32x4 h0 = *(const u32x4*)(H + (size_t)row * DM + lane * 16), h1 = *(const u32x4*)(H + (size_t)row * DM + lane * 16 + 8);
          const unsigned hw[8] = {h0.x, h0.y, h0.z, h0.w, h1.x, h1.y, h1.z, h1.w};
#pragma unroll
          for (int q = 0; q < 8; ++q) hv[q] = (f32x2){lo2f(hw[q]), hi2f(hw[q])}; }
        const u32x2 eg0 = EG[(size_t)row * 128 + lane], eg1 = EG[(size_t)row * 128 + 64 + lane];
        float act0 = 0.f, act1 = 0.f;
        constexpr int GS = 8, NG2 = 128 / (2 * GS);
        u32x4 ra[GS], rb[GS];
#define PG_LOAD(dst, tab, grp_) do { _Pragma("unroll") for (int q = 0; q < GS; ++q) { const int ii = (grp_) * GS + q; const unsigned e = __builtin_amdgcn_readlane(ii < 64 ? eg0.x : eg1.x, ii & 63); \
            dst[q] = *(const u32x4*)((tab) + (size_t)e * 1024 + lane * 16); } } while (0)
#define PG_UDOT(src, grp_) do { _Pragma("unroll") for (int q = 0; q < GS; ++q) { const int ii = (grp_) * GS + q; const unsigned e = __builtin_amdgcn_readlane(ii < 64 ? eg0.x : eg1.x, ii & 63); \
            const unsigned uw[4] = {src[q].x, src[q].y, src[q].z, src[q].w}; f32x2 d2 = {0.f, 0.f}; \
            _Pragma("unroll") for (int j = 0; j < 4; ++j) { d2 += __builtin_amdgcn_cvt_pk_f32_fp8((int)uw[j], false) * hv[2 * j]; d2 += __builtin_amdgcn_cvt_pk_f32_fp8((int)uw[j], true) * hv[2 * j + 1]; } \
            const float tot = __int_as_float(__builtin_amdgcn_readlane(__float_as_int(wave_total63(d2.x + d2.y)), 63)) * USC[e]; \
            if (ii < 64) act0 = (lane == (ii & 63)) ? tot : act0; else act1 = (lane == (ii & 63)) ? tot : act1; } } while (0)
        PG_LOAD(ra, U, 0);
#pragma unroll 1
        for (int g2 = 0; g2 < NG2; ++g2) {
            PG_LOAD(rb, U, 2 * g2 + 1); PG_UDOT(ra, 2 * g2);
            if (g2 < NG2 - 1) PG_LOAD(ra, U, 2 * g2 + 2); else PG_LOAD(ra, V, 0);
            PG_UDOT(rb, 2 * g2 + 1);
        }
        const float cf0 = __uint_as_float(eg0.y) * gelu_tanh(act0) * VSC[eg0.x], cf1 = __uint_as_float(eg1.y) * gelu_tanh(act1) * VSC[eg1.x];
        f32x2 ac[8];
#pragma unroll
        for (int q = 0; q < 8; ++q) ac[q] = (f32x2){0.f, 0.f};
#define PG_VACC(src, grp_) do { _Pragma("unroll") for (int q = 0; q < GS; ++q) { const int ii = (grp_) * GS + q; const float cf = __int_as_float(__builtin_amdgcn_readlane(__float_as_int(ii < 64 ? cf0 : cf1), ii & 63)); \
            const unsigned vw[4] = {src[q].x, src[q].y, src[q].z, src[q].w}; \
            _Pragma("unroll") for (int j = 0; j < 4; ++j) { ac[2 * j] += cf * __builtin_amdgcn_cvt_pk_f32_fp8((int)vw[j], false); ac[2 * j + 1] += cf * __builtin_amdgcn_cvt_pk_f32_fp8((int)vw[j], true); } } } while (0)
#pragma unroll 1
        for (int g2 = 0; g2 < NG2; ++g2) {
            PG_LOAD(rb, V, 2 * g2 + 1); PG_VACC(ra, 2 * g2);
            if (g2 < NG2 - 1) PG_LOAD(ra, V, 2 * g2 + 2);
            PG_VACC(rb, 2 * g2 + 1);
        }
#undef PG_LOAD
#undef PG_UDOT
#undef PG_VACC
        float acc[16];
#pragma unroll
        for (int q = 0; q < 8; ++q) { acc[2 * q] = ac[q].x; acc[2 * q + 1] = ac[q].y; }
        const float* gt = mod + smp * 6144 + 5120;
        f32x4 res[4]; float ss = 0.f;
#pragma unroll
        for (int q = 0; q < 4; ++q) { const int c = lane * 16 + q * 4; const f32x4 g = *(const f32x4*)(gt + c), x = *(const f32x4*)(xrow + c);
            res[q] = x + ZF(1) * g * (f32x4){acc[q * 4], acc[q * 4 + 1], acc[q * 4 + 2], acc[q * 4 + 3]};
            *(f32x4*)((wr_override ? wr_override + (size_t)row * DM : xrow) + c) = res[q];
            ss += (res[q][0] * res[q][0] + res[q][1] * res[q][1]) + (res[q][2] * res[q][2] + res[q][3] * res[q][3]); }
        if (l == 0 && !wr_override) {
            const float rs = rsqrtf(wave_sum(ss) * (1.f / DM) + EPSN); const float* mb1 = mod + 3 * 6144 + smp * 6144; const float* g1 = F.in[6] + DM;
            bf16_t* Hw = WSP(bf16_t, WS_H) + (size_t)row * DM;
#pragma unroll
            for (int q = 0; q < 4; ++q) { const int c = lane * 16 + q * 4; const f32x4 g = *(const f32x4*)(g1 + c), sc = *(const f32x4*)(mb1 + 1024 + c), sh = *(const f32x4*)(mb1 + c);
                st4bf(Hw + c, (res[q] * rs * g) * (1.f + sc) + sh); }
        }
    }
}

constexpr int PH_PER_LAYER = 10, N_PHASES = 1 + 2 * PH_PER_LAYER;
struct Args { const float* in[32]; float* out; unsigned char* ws; int ph_lo, ph_hi, li, pad; };
__global__ void __launch_bounds__(NTHR, 2) mk_fwd(Args args) {
    extern __shared__ __attribute__((aligned(16))) unsigned char lds[];
    Ctx F;
    F.lds = (LAS unsigned char*)lds;
    volatile LAS unsigned* MISC = (volatile LAS unsigned*)(F.lds + MISC_OFF);
    F.tid = threadIdx.x; F.lane = F.tid & 63; F.wave = __builtin_amdgcn_readfirstlane(F.tid >> 6);
    F.G = gridDim.x; { const int bx = blockIdx.x; F.vcu = (F.G % 8 == 0) ? (bx % 8) * (F.G / 8) + bx / 8 : bx; }
#pragma unroll
    for (int i = 0; i < 32; ++i) F.in[i] = args.in[i];
    F.out = args.out; F.ws = args.ws;
    for (int u = F.tid; u < (LDS_BYTES - LDSCTL_OFF) / 4; u += NTHR) ((LAS unsigned*)(F.lds + LDSCTL_OFF))[u] = 0u;
    __syncthreads();
    XcdBarrier bar; bar.bar = (unsigned*)(args.ws + WS_CTL) + CW_BAR; bar.x = 0; bar.st = nullptr;
#if !MK_MULTI
    bar = xcd_barrier_post((unsigned*)(args.ws + WS_CTL) + CW_BAR, MISC + 8);
#endif
    const int lo = args.ph_lo, hi = args.ph_hi;
#ifndef KMAX
#define KMAX 1000
#endif
#define IN(k) (lo <= (k) && (k) < hi && (REP_ALL == 1 || ra == REP_ALL - 1 || (k) <= KMAX))
#ifndef REP_PH
#define REP_PH -1
#endif
#define REPS(k) ((REP_PH == (k)) ? 2 : 1)
#define PHCTX Ctx Fp = F; { int t_ = F.tid; asm volatile("" : "+v"(t_)); Fp.tid = t_; Fp.lane = t_ & 63; }
#if MK_MULTI
#define SEAM(k) do { } while (0)
#else
#ifndef BAR_REPS
#define BAR_REPS 1
#endif
#define SEAM(k) do { if (IN(k) && IN((k) + 1)) for (int br_ = 0; br_ < BAR_REPS; ++br_) xcd_barrier(bar); } while (0)
#endif
#ifndef REP_ALL
#define REP_ALL 1
#endif
#ifndef REP_SUB
#define REP_SUB 0
#endif
#pragma unroll 1
    for (int ra = 0; ra < REP_ALL; ++ra) {
    if (ra > 0) xcd_barrier(bar);
    if (IN(0)) { PHCTX; for (int rep = 0; rep < REPS(100); ++rep) phase_prologue(Fp); }
    SEAM(0);
    float* XC = WSP(float, WS_XC);
#pragma unroll 1
    for (int l = 0; l < 2; ++l) {
        const int pb = 1 + l * PH_PER_LAYER;
        const float* xlat = l == 0 ? F.in[0] : F.out; const float* xctx = l == 0 ? F.in[2] : XC;
        const int mrows = l == 0 ? MALL : MLAT;
        const float* mod = WSP(float, WS_MOD) + (size_t)l * 3 * 6144;
        if (IN(pb + 0) && l == 0) { PHCTX; for (int rep = 0; rep < REPS(0); ++rep) { phase_norm(Fp, l, 0, MALL, xlat, xctx); } }
        if (l == 0) SEAM(pb + 0);
        if (IN(pb + 1)) for (int rep = 0; rep < REPS(1); ++rep) { PHCTX; pg8::Gemm g{WSP(bf16_t, WS_H), WSP(bf16_t, WS_WIN + l * WIN_LSTRIDE), MALL, DINP, DM}; pg8::StaticOrder So; So.init(MALL, DINP, F.G, (int)blockIdx.x);
            pg8::EpiBf16 E{WSP(bf16_t, WS_P), DINP}; pg8::gemm_phase<pg8::EpiBf16, pg8::StaticOrder, true, true>(F.lds, g, So, E, Fp.tid); }
        SEAM(pb + 1);
        if (IN(pb + 2)) { PHCTX; for (int rep = 0; rep < REPS(2); ++rep) { phase_prep(Fp, l); __syncthreads(); } }
        SEAM(pb + 2);
        if (IN(pb + 3)) for (int rep = 0; rep < REPS(3); ++rep) {
            const int nra = 16 * RCH, nml = 16 * NCHK;
            for (int r3 = 0; r3 < (REP_SUB == 3 ? 2 : 1); ++r3) { PHCTX; for (int task = F.vcu; task < nra; task += F.G) { RaRaw cur_; ra_load(Fp, task, cur_); rwkv_chunk_pre(Fp, task, cur_); } __syncthreads(); }
            for (int r3 = 0; r3 < (REP_SUB == 4 ? 2 : 1); ++r3) { PHCTX; for (int task = (F.vcu + F.G - 72) % F.G; task < nml; task += F.G) mlstm_local(Fp, task); }
        }
        SEAM(pb + 3);
                if (IN(pb + 4)) for (int rep = 0; rep < REPS(4); ++rep) {
            if (F.vcu < 16) { PHCTX; rwkv_chain(Fp, F.vcu); }
            else { { PHCTX; mlstm_chain(Fp, 16); }
                   { PHCTX; const int natt = l == 0 ? 264 : 256; for (int task = F.vcu - 16; task < natt; task += F.G - 16) attn_unit(Fp, l, task); } } }
        SEAM(pb + 4);
        if (IN(pb + 5)) for (int rep = 0; rep < REPS(5); ++rep) { const int nro = l == 0 ? 264 : 256, nun = l == 0 ? 528 : 512;
            { PHCTX; for (int u = F.vcu; u < nro; u += F.G) rwkv_out(Fp, l, u); }
            { PHCTX; for (int u = (F.vcu + F.G - 8) % F.G; u < nun; u += F.G) mlstm_out(Fp, l, u); } }
        SEAM(pb + 5);
        if (IN(pb + 6)) for (int rep = 0; rep < REPS(6); ++rep) { PHCTX; pg8::Gemm g{WSP(bf16_t, WS_YCAT), WSP(bf16_t, WS_WOUT + l * WOUT_LSTRIDE), mrows, DM, DM}; pg8::StaticOrder So; So.init(mrows, DM, F.G, (int)blockIdx.x);
            float* dummy = WSP(float, WS_YR); const bool dm_ = (REPS(6) == 2 && rep == 0); pg8::EpiRes E{xlat, xctx, dm_ ? dummy : F.out, dm_ ? dummy : XC, mod}; pg8::gemm_phase<pg8::EpiRes, pg8::StaticOrder, true, true>(F.lds, g, So, E, Fp.tid); }
        SEAM(pb + 6);
        if (IN(pb + 7)) { PHCTX; for (int rep = 0; rep < REPS(7); ++rep) phase_norm(Fp, l, 1, mrows, F.out, XC); }
        SEAM(pb + 7);
        if (IN(pb + 8)) for (int rep = 0; rep < REPS(8); ++rep) { PHCTX; pg8::Gemm g{WSP(bf16_t, WS_H), WSP(bf16_t, WS_WEFF + l * WEFF_LSTRIDE), mrows, 2048, DM}; pg8::StaticOrder So; So.init(mrows, 2048, F.G, (int)blockIdx.x);
            pg8::EpiF32 E{WSP(float, WS_S), MALL}; pg8::gemm_phase<pg8::EpiF32, pg8::StaticOrder, true, true>(F.lds, g, So, E, Fp.tid); }
        SEAM(pb + 8);
        if (IN(pb + 9)) { PHCTX; for (int rep = 0; rep < REPS(9); ++rep) { phase_peer(Fp, l, mrows, mod, (REPS(9) == 2 && rep == 0) ? WSP(float, WS_YR) : nullptr); __syncthreads(); } }
        SEAM(pb + 9);
    }
    }
#undef IN
#undef SEAM
}

extern "C" void kernel_launch(void* const* d_in, const int* in_sizes, int n_in, void* d_out, int out_size, void* d_ws, size_t ws_size, hipStream_t stream) {
    static int grid = 0;
    if (grid == 0) {
        if (n_in != 32 || out_size != MLAT * DM || ws_size < WS_END2) { fprintf(stderr, "kernel_launch: unexpected shapes: n_in %d out %d ws %zu (need %zu)\n", n_in, out_size, ws_size, (size_t)WS_END2); grid = -1; return; }
        int dev = 0, cus = 0, per_cu = 0;
        if (hipGetDevice(&dev) != hipSuccess || hipDeviceGetAttribute(&cus, hipDeviceAttributeMultiprocessorCount, dev) != hipSuccess) { grid = -1; return; }
        if (hipFuncSetAttribute((const void*)mk_fwd, hipFuncAttributeMaxDynamicSharedMemorySize, LDS_BYTES) != hipSuccess) { fprintf(stderr, "kernel_launch: hipFuncSetAttribute failed\n"); grid = -1; return; }
        if (hipOccupancyMaxActiveBlocksPerMultiprocessor(&per_cu, (const void*)mk_fwd, NTHR, LDS_BYTES) != hipSuccess || per_cu < 1) fprintf(stderr, "kernel_launch: occupancy query reports %d\n", per_cu);
        (void)hipGetLastError();
        grid = cus;
        if (grid != 256) fprintf(stderr, "kernel_launch: grid %d (built for 256 CUs)\n", grid);
    }
    if (grid < 0) return;
    (void)hipMemsetAsync((char*)d_ws + WS_CTL, 0, CTL_ZERO_BYTES, stream);
    Args a{};
    for (int i = 0; i < 32; ++i) a.in[i] = (const float*)d_in[i];
    a.out = (float*)d_out; a.ws = (unsigned char*)d_ws;
#if MK_MULTI
    for (int p = 0; p < N_PHASES; ++p) { a.ph_lo = p; a.ph_hi = p + 1; a.li = p; hipLaunchKernelGGL(mk_fwd, dim3(grid), dim3(NTHR), LDS_BYTES, stream, a); }
#else
    a.ph_lo = 0; a.ph_hi = N_PHASES; a.li = 0;
    hipLaunchKernelGGL(mk_fwd, dim3(grid), dim3(NTHR), LDS_BYTES, stream, a);
#endif
}
```

```cpp
#include <hip/hip_runtime.h>
#include <cstdio>
#include <cstdint>

#ifndef MK_MULTI
#define MK_MULTI 0
#endif
namespace pg8 {
#define PG8_LAS __attribute__((address_space(3)))
typedef unsigned short bf16_t;
typedef short bf16x8 __attribute__((ext_vector_type(8)));
typedef float f32x4 __attribute__((ext_vector_type(4)));
typedef unsigned u32x4 __attribute__((ext_vector_type(4)));
constexpr int BM = 256, BK = 64, HALF = 128, HTB = HALF * BK * 2  , STAGE_BYTES = 8 * HTB, NXCD = 8, WGM = 8;

__host__ __device__ __forceinline__ int lds_byte(int r, int c) { const int st = (r >> 4) * 2 + (c >> 5), rr = r & 15, cc = c & 31, ob = rr * 64 + cc * 2; return st * 1024 + (ob ^ (((ob >> 9) & 1) << 5)); }
__host__ __device__ __forceinline__ void stage_rc(int b, int& R, int& C) { const int st = b / 1024, sb = b % 1024, swz = sb ^ (((sb >> 9) & 1) << 5); R = (st >> 1) * 16 + swz / 64; C = (st & 1) * 32 + (swz % 64) / 2; }
__host__ __device__ __forceinline__ int perm32(int rho) { const int n = rho >> 4, i = rho & 15; return 8 * (i >> 2) + 4 * n + (i & 3); }

struct Unit { int pm, pn; };
struct Gemm { const bf16_t* A; const bf16_t* Bt; int M, N, K; };

struct StaticOrder {
    int nM, nN, nwg, G, c;
    __host__ __device__ void init(int M, int N, int G_, int c_) { nM = M / BM; nN = N / BM; nwg = nM * nN; G = G_; c = c_; }
    __host__ __device__ bool next(int i, Unit& u) const {
        const long L = (long)i * G + c; if (L >= nwg) return false;
        int wgid = (int)L; { const int q = nwg / NXCD, r = nwg % NXCD, xcd = wgid % NXCD, off = wgid / NXCD; wgid = (xcd < r ? xcd * (q + 1) : r * (q + 1) + (xcd - r) * q) + off; }
        const int nig = WGM * nN, gid = wgid / nig, fm = gid * WGM, gsz = (nM - fm) < WGM ? (nM - fm) : WGM;
        u.pm = fm + ((wgid % nig) % gsz); u.pn = (wgid % nig) / gsz; return true;
    }
    __device__ __forceinline__ void a_ready(const Unit&) const {}
    __device__ __forceinline__ void done(const Unit&) const {}
};

__device__ __forceinline__ unsigned cvt_pk_bf16(float lo, float hi) { unsigned r; asm volatile("v_cvt_pk_bf16_f32 %0, %1, %2" : "=v"(r) : "v"(lo), "v"(hi)); return r; }

struct EpiBf16 {
    static constexpr bool PERM = true, AFTER_DRAIN = false;
    bf16_t* O; int ldc;
    __device__ __forceinline__ void operator()(const f32x4 (&acc)[2][2][4][2], const Unit& u, int wr, int wc, int fr, int fq) const {
        const int row0 = u.pm * BM + wr * 64 + fr; const int col0 = u.pn * BM + wc * 32 + 8 * fq;
#pragma unroll
        for (int ai = 0; ai < 2; ++ai)
#pragma unroll
            for (int m = 0; m < 4; ++m) { bf16_t* rowp = O + (size_t)(row0 + ai * HALF + m * 16) * ldc + col0;
#pragma unroll
                for (int bj = 0; bj < 2; ++bj) { const f32x4 v0 = acc[ai][bj][m][0], v1 = acc[ai][bj][m][1];
                    u32x4 w; w.x = cvt_pk_bf16(v0[0], v0[1]); w.y = cvt_pk_bf16(v0[2], v0[3]); w.z = cvt_pk_bf16(v1[0], v1[1]); w.w = cvt_pk_bf16(v1[2], v1[3]);
                    *(u32x4*)(rowp + bj * HALF) = w; } }
    }
};
struct EpiF32 {
    static constexpr bool PERM = false, AFTER_DRAIN = false;
    float* O; int ldr;
    __device__ __forceinline__ void operator()(const f32x4 (&acc)[2][2][4][2], const Unit& u, int wr, int wc, int fr, int fq) const {
        const int row0 = u.pm * BM + wr * 64 + fr; const int col0 = u.pn * BM + wc * 32 + 4 * fq;
#pragma unroll
        for (int ai = 0; ai < 2; ++ai)
#pragma unroll
            for (int m = 0; m < 4; ++m) { const int row = row0 + ai * HALF + m * 16;
#pragma unroll
                for (int bj = 0; bj < 2; ++bj)
#pragma unroll
                    for (int n = 0; n < 2; ++n) { const int cg = (col0 + bj * HALF + n * 16) >> 2; *(f32x4*)(O + ((size_t)cg * ldr + row) * 4) = acc[ai][bj][m][n]; } }
    }
};
struct EpiRes {
    static constexpr bool PERM = false, AFTER_DRAIN = false;
    const float* src_lat; const float* src_ctx; float* dst_lat; float* dst_ctx; const float* gate;
    __device__ __forceinline__ void operator()(const f32x4 (&acc)[2][2][4][2], const Unit& u, int wr, int wc, int fr, int fq) const {
        const bool isc = u.pm >= 64; const int smp = isc ? 2 : (u.pm >> 5);
        const int prow = (isc ? (u.pm - 64) * BM : u.pm * BM) + wr * 64 + fr;
        const float* src = isc ? src_ctx : src_lat; float* dst = isc ? dst_ctx : dst_lat;
        const float* gt = gate + smp * 6144 + 2048;
        const int col0 = u.pn * BM + wc * 32 + 4 * fq;
        f32x4 gv[2][2];
#pragma unroll
        for (int bj = 0; bj < 2; ++bj)
#pragma unroll
            for (int n = 0; n < 2; ++n) gv[bj][n] = *(const f32x4*)(gt + col0 + bj * HALF + n * 16);
#pragma unroll
        for (int ai = 0; ai < 2; ++ai)
#pragma unroll
            for (int m = 0; m < 4; ++m) { const size_t off = (size_t)(prow + ai * HALF + m * 16) * 1024 + col0;
#pragma unroll
                for (int bj = 0; bj < 2; ++bj)
#pragma unroll
                    for (int n = 0; n < 2; ++n) { const f32x4 s = *(const f32x4*)(src + off + bj * HALF + n * 16);
                        *(f32x4*)(dst + off + bj * HALF + n * 16) = s + gv[bj][n] * acc[ai][bj][m][n]; } }
    }
};

template <class Epi, class Sched, bool ALIGN_EPI = false, bool SP2 = false>
__device__ __forceinline__ void gemm_phase(PG8_LAS unsigned char* lds, const Gemm g, const Sched& S, const Epi& E, const int tid) {
    const int wid = __builtin_amdgcn_readfirstlane(tid >> 6), lane = tid & 63, wr = wid >> 2, wc = wid & 3, fr = lane & 15, fq = lane >> 4;
    const int K = g.K, nt = K / BK;
    unsigned voffA[2], voffB[2];
#pragma unroll
    for (int i = 0; i < 2; ++i) { int R, C; stage_rc(tid * 16 + i * 8192, R, C); const int Rb = Epi::PERM ? ((R & ~31) + perm32(R & 31)) : R;
        voffA[i] = (unsigned)(R * K + C) * 2u; voffB[i] = (unsigned)(Rb * K + C) * 2u; }
    const size_t kstep = (size_t)(BK * 2);
    const size_t hstep = (size_t)HALF * K * 2;
    const size_t tstep = 2 * hstep;
    const unsigned ldsw = (unsigned)wid * 1024u;
    const int aoff = lds_byte(wr * 64 + fr, fq * 8), boff = lds_byte(wc * 32 + fr, fq * 8);
#define PG8_SA(b, h) (((b) * 2 + (h)) * HTB)
#define PG8_SB(b, h) ((4 + (b) * 2 + (h)) * HTB)
#define PG8_STAGE(bufoff, gbase, voff) do { _Pragma("unroll") for (int _i = 0; _i < 2; ++_i) \
        __builtin_amdgcn_global_load_lds((const unsigned*)((const char*)(gbase) + (voff)[_i]), (PG8_LAS unsigned*)(lds + (bufoff) + ldsw + _i * 8192), 16, 0, 0); } while (0)
#define PG8_LDA(dst, b, h) do { _Pragma("unroll") for (int m = 0; m < 4; ++m) _Pragma("unroll") for (int k = 0; k < 2; ++k) dst[m][k] = *(const PG8_LAS bf16x8*)(lds + PG8_SA(b, h) + aoff + m * 2048 + k * 1024); } while (0)
#define PG8_LDB(dst, b, h) do { _Pragma("unroll") for (int n = 0; n < 2; ++n) _Pragma("unroll") for (int k = 0; k < 2; ++k) dst[n][k] = *(const PG8_LAS bf16x8*)(lds + PG8_SB(b, h) + boff + n * 2048 + k * 1024); } while (0)
#define PG8_MMA(ai, bj, At, Bt) do { __builtin_amdgcn_s_setprio(1); _Pragma("unroll") for (int m = 0; m < 4; ++m) _Pragma("unroll") for (int n = 0; n < 2; ++n) _Pragma("unroll") for (int k = 0; k < 2; ++k) \
        acc[ai][bj][m][n] = __builtin_amdgcn_mfma_f32_16x16x32_bf16(Bt[n][k], At[m][k], acc[ai][bj][m][n], 0, 0, 0); __builtin_amdgcn_s_setprio(0); } while (0)
#define PG8_WAIT_V(n) asm volatile("s_waitcnt vmcnt(" #n ")" ::: "memory")
#define PG8_WAIT_L(n) asm volatile("s_waitcnt lgkmcnt(" #n ")" ::: "memory")
#define PG8_BAR __builtin_amdgcn_s_barrier()
#define PG8_SCHED __builtin_amdgcn_sched_barrier(0)
    Unit cur, nxt; int ui = 0;
    if (!S.next(0, cur)) return;
    f32x4 acc[2][2][4][2];
#pragma unroll
    for (int a = 0; a < 2; ++a)
#pragma unroll
        for (int b = 0; b < 2; ++b)
#pragma unroll
            for (int m = 0; m < 4; ++m)
#pragma unroll
                for (int n = 0; n < 2; ++n) acc[a][b][m][n] = (f32x4){0.f, 0.f, 0.f, 0.f};
    bf16x8 At[4][2], B0[2][2], B1[2][2];
    const char* cA = (const char*)g.A + (size_t)cur.pm * tstep; const char* cB = (const char*)g.Bt + (size_t)cur.pn * tstep;
    S.a_ready(cur);
    if constexpr (SP2) {
        PG8_STAGE(PG8_SB(0, 0), cB, voffB); PG8_STAGE(PG8_SB(0, 1), cB + hstep, voffB); PG8_STAGE(PG8_SA(0, 0), cA, voffA); PG8_STAGE(PG8_SA(0, 1), cA + hstep, voffA);
        if (wr == 1) PG8_BAR;
        PG8_WAIT_V(2); PG8_BAR;
        PG8_STAGE(PG8_SB(1, 0), cB + kstep, voffB); PG8_STAGE(PG8_SA(1, 0), cA + kstep, voffA); PG8_STAGE(PG8_SB(1, 1), cB + hstep + kstep, voffB);
        PG8_WAIT_V(6); PG8_BAR;
    } else {
        PG8_STAGE(PG8_SB(0, 0), cB, voffB); PG8_STAGE(PG8_SA(0, 0), cA, voffA); PG8_STAGE(PG8_SB(0, 1), cB + hstep, voffB); PG8_STAGE(PG8_SA(0, 1), cA + hstep, voffA);
        if (wr == 1) PG8_BAR;
        PG8_WAIT_V(4); PG8_BAR;
        PG8_STAGE(PG8_SB(1, 0), cB + kstep, voffB); PG8_STAGE(PG8_SA(1, 0), cA + kstep, voffA); PG8_STAGE(PG8_SB(1, 1), cB + hstep + kstep, voffB);
        PG8_WAIT_V(6); PG8_BAR;
    }
    for (;;) {
        const bool has_next = S.next(ui + 1, nxt);
        const char* nA = has_next ? (const char*)g.A + (size_t)nxt.pm * tstep : cA; const char* nB = has_next ? (const char*)g.Bt + (size_t)nxt.pn * tstep : cB;
        for (int t = 0; t < nt; t += 2) {
            const bool last = (t == nt - 2);
            const char* a1 = cA + (size_t)(t + 1) * kstep;
            const char* a2 = last ? nA : cA + (size_t)(t + 2) * kstep; const char* b2 = last ? nB : cB + (size_t)(t + 2) * kstep;
            const char* a3 = a2 + kstep; const char* b3 = b2 + kstep;
            if (last && has_next) S.a_ready(nxt);
            if constexpr (SP2) {
            PG8_LDB(B0, 0, 0); PG8_LDB(B1, 0, 1); PG8_SCHED; PG8_LDA(At, 0, 0); PG8_STAGE(PG8_SA(1, 1), a1 + hstep, voffA);
            PG8_WAIT_V(8); PG8_WAIT_L(0); PG8_BAR; PG8_MMA(0, 0, At, B0); PG8_MMA(0, 1, At, B1); PG8_BAR; PG8_SCHED;
            PG8_LDA(At, 0, 1); PG8_STAGE(PG8_SB(0, 0), b2, voffB); PG8_STAGE(PG8_SB(0, 1), b2 + hstep, voffB); PG8_STAGE(PG8_SA(0, 0), a2, voffA);
            PG8_WAIT_V(8); PG8_WAIT_L(0); PG8_BAR; PG8_MMA(1, 0, At, B0); PG8_MMA(1, 1, At, B1); PG8_BAR; PG8_SCHED;
            PG8_LDB(B0, 1, 0); PG8_LDB(B1, 1, 1); PG8_SCHED; PG8_LDA(At, 1, 0); PG8_STAGE(PG8_SA(0, 1), a2 + hstep, voffA);
            PG8_WAIT_V(8); PG8_WAIT_L(0); PG8_BAR; PG8_MMA(0, 0, At, B0); PG8_MMA(0, 1, At, B1); PG8_BAR; PG8_SCHED;
            PG8_LDA(At, 1, 1); PG8_STAGE(PG8_SB(1, 0), b3, voffB); PG8_STAGE(PG8_SB(1, 1), b3 + hstep, voffB); PG8_STAGE(PG8_SA(1, 0), a3, voffA);
            PG8_WAIT_V(8); PG8_WAIT_L(0); PG8_BAR; PG8_MMA(1, 0, At, B0); PG8_MMA(1, 1, At, B1); PG8_BAR; PG8_SCHED;
            } else {
            PG8_LDB(B0, 0, 0); PG8_SCHED; PG8_LDA(At, 0, 0); PG8_STAGE(PG8_SA(1, 1), a1 + hstep, voffA);
            PG8_WAIT_L(8); PG8_BAR; PG8_WAIT_L(0); PG8_MMA(0, 0, At, B0); PG8_BAR; PG8_SCHED;
            PG8_LDB(B1, 0, 1); PG8_STAGE(PG8_SB(0, 0), b2, voffB);
            PG8_BAR; PG8_WAIT_L(0); PG8_MMA(0, 1, At, B1); PG8_BAR;
            PG8_LDA(At, 0, 1); PG8_STAGE(PG8_SA(0, 0), a2, voffA);
            PG8_BAR; PG8_WAIT_L(0); PG8_MMA(1, 0, At, B0); PG8_BAR; PG8_SCHED;
            PG8_STAGE(PG8_SB(0, 1), b2 + hstep, voffB);
            PG8_WAIT_V(6); PG8_BAR; PG8_MMA(1, 1, At, B1); PG8_BAR;
            PG8_LDB(B0, 1, 0); PG8_SCHED; PG8_LDA(At, 1, 0); PG8_STAGE(PG8_SA(0, 1), a2 + hstep, voffA);
            PG8_WAIT_L(8); PG8_BAR; PG8_WAIT_L(0); PG8_MMA(0, 0, At, B0); PG8_BAR; PG8_SCHED;
            PG8_LDB(B1, 1, 1); PG8_STAGE(PG8_SB(1, 0), b3, voffB);
            PG8_BAR; PG8_WAIT_L(0); PG8_MMA(0, 1, At, B1); PG8_BAR;
            PG8_LDA(At, 1, 1); PG8_STAGE(PG8_SA(1, 0), a3, voffA);
            PG8_BAR; PG8_WAIT_L(0); PG8_MMA(1, 0, At, B0); PG8_BAR; PG8_SCHED;
            PG8_STAGE(PG8_SB(1, 1), b3 + hstep, voffB);
            PG8_WAIT_V(6); PG8_BAR; PG8_MMA(1, 1, At, B1); PG8_BAR;
            }
        }
        if constexpr (ALIGN_EPI) { if (wr == 0) PG8_BAR; }
        if constexpr (!Epi::AFTER_DRAIN) { E(acc, cur, wr, wc, fr, fq); S.done(cur); }
        if (!has_next) break;
#pragma unroll
        for (int a = 0; a < 2; ++a)
#pragma unroll
            for (int b = 0; b < 2; ++b)
#pragma unroll
                for (int m = 0; m < 4; ++m)
#pragma unroll
                    for (int n = 0; n < 2; ++n) acc[a][b][m][n] = (f32x4){0.f, 0.f, 0.f, 0.f};
        cur = nxt; cA = nA; cB = nB; ++ui;
        if constexpr (ALIGN_EPI) { if (wr == 1) PG8_BAR; }
    }
    PG8_WAIT_V(0);
    if constexpr (!ALIGN_EPI) { if (wr == 0) PG8_BAR; }
    PG8_BAR;
    if constexpr (Epi::AFTER_DRAIN) { E.fused(acc, cur, wr, wc, fr, fq, lds, wid, lane); S.done(cur); }
#undef PG8_SA
#undef PG8_SB
#undef PG8_STAGE
#undef PG8_LDA
#undef PG8_LDB
#undef PG8_MMA
#undef PG8_WAIT_V
#undef PG8_WAIT_L
#undef PG8_BAR
#undef PG8_SCHED
}
}
#ifndef ZMASK
#define ZMASK 0
#endif
#define ZF(bit) ((ZMASK & (bit)) ? 0.f : 1.f)
using pg8::bf16_t; using pg8::bf16x8; using pg8::f32x4; using pg8::u32x4;
constexpr int NWAVES = 8, NTHR = 512;
constexpr int DM = 1024, TLAT = 8192, TCTX = 256, MLAT = 2 * TLAT, MCTX = 2 * TCTX, MALL = MLAT + MCTX;
constexpr int DIN = 3152, DINP = 3328;
constexpr int C_CH = 0, C_CB = 256, C_CC = 512, C_RR = 768, C_RK = 1024, C_RV = 1280, C_XW = 1536, C_XA = 1552, C_XG = 1568,
              C_AQ = 1600, C_AK = 1856, C_AV = 1984, C_MQ = 2112, C_MK = 2368, C_MV = 2624, C_MO = 2880, C_MG = 3136;
constexpr float EPSN = 1e-6f;
constexpr int NCHK = 66;
constexpr int CST = 4160;
constexpr int RWREC = 4608;
constexpr size_t MiB = 1u << 20;
constexpr size_t WS_CTL = 0, CTL_ZERO_BYTES = 1 * MiB, WS_MOD = 1 * MiB;
constexpr size_t WS_WIN = 2 * MiB, WIN_LSTRIDE = (size_t)DINP * DM * 2;
constexpr size_t WS_WOUT = 16 * MiB, WOUT_LSTRIDE = 2 * MiB;
constexpr size_t WS_WEFF = 20 * MiB, WEFF_LSTRIDE = 4 * MiB;
constexpr size_t WS_XC = 28 * MiB, WS_GA = 30 * MiB, WS_H = 32 * MiB, WS_YCAT = 65 * MiB, WS_U = 98 * MiB, WS_V = 130 * MiB;
constexpr size_t WS_P = 162 * MiB, WS_RW = 270 * MiB, WS_YR = 345 * MiB, WS_QA = 378 * MiB, WS_KA = 387 * MiB;
constexpr size_t WS_LC = 392 * MiB, WS_ST = 409 * MiB, WS_LB = 426 * MiB, WS_EG = 427 * MiB, WS_GB = 444 * MiB, WS_BS = 453 * MiB, WS_SC = 453 * MiB + 512 * 1024, WS_END = 454 * MiB;
constexpr size_t UV_LSTRIDE = 16 * MiB;
constexpr size_t WS_S = WS_P;
static_assert(WS_P + (size_t)MALL * DINP * 2 <= WS_RW && WS_RW + (size_t)MALL * RWREC <= WS_YR && WS_S + (size_t)MALL * 2048 * 4 <= WS_YR, "ws map");
static_assert(WS_LC + (size_t)16 * NCHK * CST * 4 <= WS_ST && WS_ST + (size_t)16 * NCHK * CST * 4 <= WS_LB && WS_EG + (size_t)MALL * 128 * 8 <= WS_GB, "ws map 2");
constexpr int CW_BAR = 4096;
constexpr int RING_BYTES = 131072;
constexpr int PEER_WLDS = 16 * 1040 + 2048 + 512;
constexpr int PHASE_LDS = 8 * PEER_WLDS;
constexpr int LDSCTL_OFF = PHASE_LDS, MISC_OFF = LDSCTL_OFF + 320, LDS_BYTES = PHASE_LDS + 4096;
static_assert(RING_BYTES <= PHASE_LDS && LDS_BYTES <= 160 * 1024 && PHASE_LDS % 16 == 0, "LDS map");

#define GAS __attribute__((address_space(1)))
#define LAS __attribute__((address_space(3)))
typedef unsigned u32x2 __attribute__((ext_vector_type(2)));
typedef float f32x2 __attribute__((ext_vector_type(2)));
typedef __bf16 bf16x2_t __attribute__((ext_vector_type(2)));
typedef GAS unsigned gu32;
#define LDS_WAIT() asm volatile("s_waitcnt lgkmcnt(0)" ::: "memory")
#define LDS_BARRIER() do { asm volatile("s_waitcnt lgkmcnt(0)" ::: "memory"); __builtin_amdgcn_s_barrier(); asm volatile("" ::: "memory"); } while (0)

__device__ __forceinline__ float lo2f(unsigned w) { return __uint_as_float(w << 16); }
__device__ __forceinline__ float hi2f(unsigned w) { return __uint_as_float(w & 0xffff0000u); }
__device__ __forceinline__ float bf2f(bf16_t b) { return __uint_as_float((unsigned)b << 16); }
__device__ __forceinline__ unsigned f2bf(float f) { unsigned u = __float_as_uint(f); return (u + 0x7fffu + ((u >> 16) & 1u)) >> 16; }
__device__ __forceinline__ unsigned pk2(float lo, float hi) { const f32x2 v = {lo, hi}; const bf16x2_t b = __builtin_convertvector(v, bf16x2_t); return __builtin_bit_cast(unsigned, b); }
__device__ __forceinline__ f32x4 ld4bf(const bf16_t* p) { const u32x2 w = *(const u32x2*)p; return (f32x4){lo2f(w.x), hi2f(w.x), lo2f(w.y), hi2f(w.y)}; }
__device__ __forceinline__ void st4bf(bf16_t* p, f32x4 v) { u32x2 w; w.x = pk2(v[0], v[1]); w.y = pk2(v[2], v[3]); *(u32x2*)p = w; }
__device__ __forceinline__ float sigmoidf_(float x) { return 1.f / (1.f + __expf(-x)); }
__device__ __forceinline__ float tanhf_(float x) { const float e = __expf(-2.f * fabsf(x)); const float t = (1.f - e) / (1.f + e); return x < 0.f ? -t : t; }
template <int CTRL> __device__ __forceinline__ float dppf(float x) { return __int_as_float(__builtin_amdgcn_update_dpp(0, __float_as_int(x), CTRL, 0xf, 0xf, true)); }
__device__ __forceinline__ float red16(float x) { x += dppf<0xB1>(x); x += dppf<0x4E>(x); x += dppf<0x141>(x); x += dppf<0x140>(x); return x; }
__device__ __forceinline__ float wave_sum(float v) {
#pragma unroll
    for (int o = 1; o < 64; o <<= 1) v += __shfl_xor(v, o);
    return v;
}
#define XB_TMO      128
#define XB_XCNT(j)  (256  + 64 * (j))
#define XB_XSUB(j)  (1280 + 64 * (j))
#define XB_XGEN(j)  (2304 + 64 * (j))
#define XB_TOP      3328
#define XB_TOPGEN   3392
#define XCD_BAR_WORDS 3456
#define XB_SPIN_CAP (1u << 18)
#ifndef XB_SLEEP
#define XB_SLEEP 1
#endif

__device__ __forceinline__ unsigned xb_ld(unsigned* p)              { return __hip_atomic_load(p, __ATOMIC_RELAXED, __HIP_MEMORY_SCOPE_AGENT); }
__device__ __forceinline__ unsigned xb_add(unsigned* p, unsigned v) { return __hip_atomic_fetch_add(p, v, __ATOMIC_RELAXED, __HIP_MEMORY_SCOPE_AGENT); }
__device__ __forceinline__ unsigned xb_xcc_id() { return (unsigned)__builtin_amdgcn_s_getreg((3 << 11) | 20) & 0xFu; }
#define XB_SPIN(cond, bar) do { unsigned _sp = 0; while (cond) { __builtin_amdgcn_s_sleep(XB_SLEEP); \
    if ((++_sp & 255u) == 0u) { if (xb_ld(&(bar)[XB_TMO])) break; if (_sp > XB_SPIN_CAP) { atomicAdd(&(bar)[XB_TMO], 1u); break; } } } } while (0)

struct XcdBarrier {
    unsigned* bar; unsigned x;
    volatile LAS unsigned* st;
};

__device__ __forceinline__ XcdBarrier xcd_barrier_post(unsigned* bar, volatile LAS unsigned* st) {
    XcdBarrier b; b.bar = bar; b.x = xb_xcc_id(); b.st = st;
    if (threadIdx.x == 0) (void)xb_add(&bar[XB_XCNT(b.x)], 1u);
    return b;
}
__device__ __forceinline__ void xcd_barrier_complete(unsigned* bar, unsigned x, unsigned& nloc, unsigned& nx) {
    const unsigned G = gridDim.x * gridDim.y * gridDim.z;
    unsigned sum, cnt, mine, sp = 0u;
    for (;;) {
        sum = 0u; cnt = 0u; mine = 0u;
#pragma unroll
        for (unsigned j = 0; j < 16; ++j) { const unsigned c = xb_ld(&bar[XB_XCNT(j)]); sum += c; cnt += (c > 0u) ? 1u : 0u; mine = (j == x) ? c : mine; }
        if (sum == G) break;
        __builtin_amdgcn_s_sleep(1);
        if ((++sp & 255u) == 0u) { if (xb_ld(&bar[XB_TMO])) break; if (sp > XB_SPIN_CAP) { atomicAdd(&bar[XB_TMO], 1u); break; } }
    }
    nloc = mine > 0u ? mine : 1u; nx = cnt > 0u ? cnt : 1u;
}

__device__ __forceinline__ void xcd_barrier(const XcdBarrier& b) {
    asm volatile("s_waitcnt vmcnt(0)" ::: "memory");
    __syncthreads();
    if (threadIdx.x == 0) {
        unsigned* bar = b.bar;
        __builtin_amdgcn_s_waitcnt(0);
        unsigned nloc = b.st[0], nx = b.st[1];
        if (nloc == 0u) { xcd_barrier_complete(bar, b.x, nloc, nx); b.st[0] = nloc; b.st[1] = nx; }
        const unsigned old = xb_add(&bar[XB_XSUB(b.x)], 1u);
        const unsigned gen = old / nloc;
        if (old + 1u == (gen + 1u) * nloc) {
            __builtin_amdgcn_fence(__ATOMIC_RELEASE, "agent");
            asm volatile("s_waitcnt vmcnt(0)" ::: "memory");
            const unsigned og = xb_add(&bar[XB_TOP], 1u);
            const unsigned tg = og / nx;
            if (og + 1u == (tg + 1u) * nx) xb_add(&bar[XB_TOPGEN], 1u);
            else XB_SPIN(xb_ld(&bar[XB_TOPGEN]) == tg, bar);
            __builtin_amdgcn_fence(__ATOMIC_ACQUIRE, "agent");
            xb_add(&bar[XB_XGEN(b.x)], 1u);
            asm volatile("s_waitcnt vmcnt(0)" ::: "memory");
        } else {
            XB_SPIN(xb_ld(&bar[XB_XGEN(b.x)]) == gen, bar);
            __builtin_amdgcn_fence(__ATOMIC_ACQUIRE, "agent");
            asm volatile("s_waitcnt vmcnt(0)" ::: "memory");
        }
    }
    __syncthreads();
}
struct Ctx {
    LAS unsigned char* lds; int tid, lane, wave, vcu, G;
    const float* in[32]; float* out; unsigned char* ws;
};
#define WSP(T, off) ((T*)(F.ws + (off)))

__device__ __forceinline__ void p0_transpose_item(const float* W, int K, int N, bf16_t* WT, LAS float* scr, int item, int lane) {
    const int nblk = (N + 31) / 32, kb = item / nblk, nb = item % nblk, k0 = 64 * kb, n0 = 32 * nb;
    const int nn = n0 + (lane & 31);
#pragma unroll 8
    for (int i = 0; i < 32; ++i) { const int kk = 2 * i + (lane >> 5); scr[kk * 33 + (lane & 31)] = nn < N ? W[(size_t)(k0 + kk) * N + nn] : 0.f; }
    LDS_WAIT(); asm volatile("" ::: "memory");
    const int c = lane & 7;
#pragma unroll
    for (int j = 0; j < 4; ++j) { const int n = (lane >> 3) + 8 * j; const LAS float* s = scr + (8 * c) * 33 + n;
        u32x4 o; o.x = pk2(s[0 * 33], s[1 * 33]); o.y = pk2(s[2 * 33], s[3 * 33]); o.z = pk2(s[4 * 33], s[5 * 33]); o.w = pk2(s[6 * 33], s[7 * 33]);
        *(u32x4*)(WT + (size_t)(n0 + n) * K + k0 + 8 * c) = o; }
    LDS_WAIT(); asm volatile("" ::: "memory");
}
__device__ __forceinline__ void convert_uv_rows(const Ctx& F, int l, int r_lo, int r_hi, int widx, int nworkers) {
    float* SC = WSP(float, WS_SC) + (size_t)l * 2 * 16384;
    for (int r0 = r_lo + widx; r0 < r_hi; r0 += 4 * nworkers) {
        f32x4 v[4][4];
#pragma unroll
        for (int u = 0; u < 4; ++u) { const int r = r0 + u * nworkers < r_hi ? r0 + u * nworkers : r0; const int tb = r >> 14, row = r & 16383;
            const float* src = (tb ? F.in[31] : F.in[30]) + ((size_t)l * 16384 + row) * 1024 + F.lane * 16;
#pragma unroll
            for (int j = 0; j < 4; ++j) v[u][j] = *(const f32x4*)(src + 4 * j); }
#pragma unroll
        for (int u = 0; u < 4; ++u) { const int r = r0 + u * nworkers; if (r >= r_hi) break; const int tb = r >> 14, row = r & 16383;
            float am = 0.f;
#pragma unroll
            for (int j = 0; j < 4; ++j) am = fmaxf(am, fmaxf(fmaxf(fabsf(v[u][j][0]), fabsf(v[u][j][1])), fmaxf(fabsf(v[u][j][2]), fabsf(v[u][j][3]))));
#pragma unroll
            for (int o = 1; o < 64; o <<= 1) am = fmaxf(am, __shfl_xor(am, o));
            const float sc = am > 0.f ? 448.f / am : 1.f;
            unsigned ow[4];
#pragma unroll
            for (int j = 0; j < 4; ++j) { int w = __builtin_amdgcn_cvt_pk_fp8_f32(v[u][j][0] * sc, v[u][j][1] * sc, 0, false); w = __builtin_amdgcn_cvt_pk_fp8_f32(v[u][j][2] * sc, v[u][j][3] * sc, w, true); ow[j] = (unsigned)w; }
            *(u32x4*)(F.ws + (tb ? WS_V : WS_U) + (size_t)l * UV_LSTRIDE + (size_t)row * 1024 + F.lane * 16) = (u32x4){ow[0], ow[1], ow[2], ow[3]};
            if (F.lane == 0) SC[tb * 16384 + row] = am > 0.f ? am * (1.f / 448.f) : 1.f; }
    }
}
__device__ __forceinline__ void convert_uv(const Ctx& F, int l) { convert_uv_rows(F, l, 0, 2 * 16384, F.vcu * NWAVES + F.wave, F.G * NWAVES); }
__device__ __forceinline__ void phase_prologue(const Ctx& F) {
    float* MOD = WSP(float, WS_MOD);
    {
        LAS float* sl = (LAS float*)F.lds; LAS float* red = sl + 3072;
        for (int it = F.vcu; it < 192; it += F.G) {
            const int l = it / 96, n0 = (it % 96) * 64;
            for (int i = F.tid; i < 3072; i += NTHR) { const int s = i >> 10, k = i & 1023; const float c = s < 2 ? F.in[1][s * 1024 + k] : F.in[3][k]; sl[i] = c / (1.f + __expf(-c)); }
            __syncthreads();
            const int c = F.tid & 63, kg = F.tid >> 6;
            const float* W = F.in[4] + (size_t)l * 1024 * 6144 + n0 + c;
            float a0 = 0.f, a1 = 0.f, a2 = 0.f;
#pragma unroll 32
            for (int k = kg * 128; k < kg * 128 + 128; ++k) { const float w = W[(size_t)k * 6144]; a0 += sl[k] * w; a1 += sl[1024 + k] * w; a2 += sl[2048 + k] * w; }
            red[(kg * 3 + 0) * 64 + c] = a0; red[(kg * 3 + 1) * 64 + c] = a1; red[(kg * 3 + 2) * 64 + c] = a2;
            __syncthreads();
            if (F.tid < 192) { const int s = F.tid >> 6, cc = F.tid & 63; float t = F.in[5][l * 6144 + n0 + cc];
#pragma unroll
                for (int g = 0; g < 8; ++g) t += red[(g * 3 + s) * 64 + cc];
                MOD[(l * 3 + s) * 6144 + n0 + cc] = t; }
            __syncthreads();
        }
    }
    {
        LAS float* scr = (LAS float*)(F.lds + F.wave * 16384);
        const int gw = F.vcu * NWAVES + F.wave, NGW = F.G * NWAVES;
        constexpr int I_IN = 16 * 99, I_OUT = 16 * 32, I_L = I_IN + I_OUT;
        for (int it = gw; it < 2 * I_L; it += NGW) {
            const int l = it / I_L; int r = it % I_L;
            if (r < I_IN) p0_transpose_item(F.in[8] + (size_t)l * DM * DIN, DM, DIN, WSP(bf16_t, WS_WIN + l * WIN_LSTRIDE), scr, r, F.lane);
            else p0_transpose_item(F.in[9] + (size_t)l * DM * DM, DM, DM, WSP(bf16_t, WS_WOUT + l * WOUT_LSTRIDE), scr, r - I_IN, F.lane);
        }
        for (int i = F.vcu * NTHR + F.tid; i < 2 * 160 * 128; i += F.G * NTHR) { const int l = i / (160 * 128), r = i % (160 * 128);
            *(u32x4*)(WSP(bf16_t, WS_WIN + l * WIN_LSTRIDE) + (size_t)3168 * DM + (size_t)r * 8) = (u32x4){0u, 0u, 0u, 0u}; }
    }
    __syncthreads();
    {
        LAS float* KEYS = (LAS float*)F.lds; LAS float* WQl = KEYS + 128 * 129;
        const int nper = F.G / 32 > 0 ? F.G / 32 : 1;
        const int tile = F.vcu / nper, sub = F.vcu % nper;
        if (tile < 32) {
            const int l = tile >> 4, hh = tile & 15;
            const float* ksrc = F.in[29] + ((size_t)l * 16 + hh) * 128 * 128;
            { f32x4 kv[8];
#pragma unroll
              for (int q = 0; q < 8; ++q) kv[q] = *(const f32x4*)(ksrc + (size_t)(F.tid + q * NTHR) * 4);
#pragma unroll
              for (int q = 0; q < 8; ++q) { const int i = (F.tid + q * NTHR) * 4; LAS float* d = KEYS + (i >> 7) * 129 + (i & 127); d[0] = kv[q][0]; d[1] = kv[q][1]; d[2] = kv[q][2]; d[3] = kv[q][3]; } }
            for (int kb = sub; kb < 16; kb += nper) {
                const float* wsrc = F.in[28] + (size_t)l * DM * 2048 + (size_t)(kb * 64) * 2048 + hh * 128;
                __syncthreads();
                { f32x4 wv[4];
#pragma unroll
                  for (int q = 0; q < 4; ++q) { const int i = (F.tid + q * NTHR) * 4; wv[q] = *(const f32x4*)(wsrc + (size_t)(i >> 7) * 2048 + (i & 127)); }
#pragma unroll
                  for (int q = 0; q < 4; ++q) { const int i = (F.tid + q * NTHR) * 4, kk = i >> 7, d = i & 127; WQl[d * 68 + kk] = wv[q][0]; WQl[(d + 1) * 68 + kk] = wv[q][1]; WQl[(d + 2) * 68 + kk] = wv[q][2]; WQl[(d + 3) * 68 + kk] = wv[q][3]; } }
                __syncthreads();
                const int key = F.tid & 127, kq = F.tid >> 7;
                float acc[16];
#pragma unroll
                for (int j = 0; j < 16; ++j) acc[j] = 0.f;
#pragma unroll 4
                for (int d = 0; d < 128; ++d) { const float a = KEYS[key * 129 + d]; const LAS f32x4* wq = (const LAS f32x4*)(WQl + d * 68 + kq * 16);
#pragma unroll
                    for (int q = 0; q < 4; ++q) { const f32x4 w = wq[q]; acc[4 * q] += a * w[0]; acc[4 * q + 1] += a * w[1]; acc[4 * q + 2] += a * w[2]; acc[4 * q + 3] += a * w[3]; } }
                bf16_t* dst = WSP(bf16_t, WS_WEFF + l * WEFF_LSTRIDE) + (size_t)(hh * 128 + key) * DM + kb * 64 + kq * 16;
                u32x4 o0, o1; o0.x = pk2(acc[0], acc[1]); o0.y = pk2(acc[2], acc[3]); o0.z = pk2(acc[4], acc[5]); o0.w = pk2(acc[6], acc[7]);
                o1.x = pk2(acc[8], acc[9]); o1.y = pk2(acc[10], acc[11]); o1.z = pk2(acc[12], acc[13]); o1.w = pk2(acc[14], acc[15]);
                *(u32x4*)dst = o0; *(u32x4*)(dst + 8) = o1;
            }
        }
        __syncthreads();
    }
    convert_uv(F, 0); convert_uv(F, 1);
}

__device__ __forceinline__ void phase_norm(const Ctx& F, int l, int which, int nrows, const float* xlat, const float* xctx) {
    const float* gain = F.in[6 + which] + l * DM; const float* mod = WSP(float, WS_MOD) + (size_t)l * 3 * 6144;
    const int shoff = which ? 3072 : 0, scoff = which ? 4096 : 1024;
    bf16_t* H = WSP(bf16_t, WS_H);
    const int gw = F.vcu * NWAVES + F.wave, NGW = F.G * NWAVES;
    for (int row = gw; row < nrows; row += NGW) {
        const bool isc = row >= MLAT; const float* src = isc ? xctx + (size_t)(row - MLAT) * DM : xlat + (size_t)row * DM; const int smp = isc ? 2 : (row >> 13);
        const float* mb = mod + smp * 6144;
        f32x4 v[4]; float ss = 0.f;
#pragma unroll
        for (int j = 0; j < 4; ++j) { v[j] = *(const f32x4*)(src + F.lane * 4 + 256 * j); ss += (v[j][0] * v[j][0] + v[j][1] * v[j][1]) + (v[j][2] * v[j][2] + v[j][3] * v[j][3]); }
        const float rs = rsqrtf(wave_sum(ss) * (1.f / DM) + EPSN);
#pragma unroll
        for (int j = 0; j < 4; ++j) { const int c = F.lane * 4 + 256 * j; const f32x4 g = *(const f32x4*)(gain + c), sc = *(const f32x4*)(mb + scoff + c), sh = *(const f32x4*)(mb + shoff + c);
            const f32x4 o = (v[j] * rs * g) * (1.f + sc) + sh; st4bf(H + (size_t)row * DM + c, o); }
    }
}

__device__ __forceinline__ float log_sigmoid_(float x) { return fminf(x, 0.f) - __logf(1.f + __expf(-fabsf(x))); }
__device__ __forceinline__ void phase_prep(const Ctx& F, int l) {
    LAS float* W2s = (LAS float*)F.lds; LAS float* A2s = W2s + 8192; LAS float* G2s = A2s + 8192; LAS float* tsc = G2s + 8192 + F.wave * 64;
    { const float* w2 = F.in[13] + l * 8192; const float* a2 = F.in[15] + l * 8192; const float* g2 = F.in[16] + l * 8192;
      for (int i = F.tid; i < 8192; i += NTHR) { W2s[i] = w2[i]; A2s[i] = a2[i]; G2s[i] = g2[i]; } }
    __syncthreads();
    const bf16_t* P = WSP(bf16_t, WS_P); bf16_t* YC = WSP(bf16_t, WS_YCAT); bf16_t* QA = WSP(bf16_t, WS_QA); bf16_t* KA = WSP(bf16_t, WS_KA);
    unsigned char* RW = WSP(unsigned char, WS_RW); bf16_t* GB = WSP(bf16_t, WS_GB); float* BS = WSP(float, WS_BS); float* GA = WSP(float, WS_GA);
    const int lane = F.lane, c4 = lane * 4, i16 = lane & 15;
    const f32x4 cw0 = *(const f32x4*)(F.in[10] + l * 768 + c4), cw1 = *(const f32x4*)(F.in[10] + l * 768 + 256 + c4), cw2 = *(const f32x4*)(F.in[10] + l * 768 + 512 + c4);
    const f32x4 cg = *(const f32x4*)(F.in[11] + l * 256 + c4);
    const f32x4 qg = *(const f32x4*)(F.in[21] + l * 64 + (c4 & 63)), kg = *(const f32x4*)(F.in[22] + l * 64 + (c4 & 63));
    const f32x4 k_k = *(const f32x4*)(F.in[17] + l * 256 + c4), k_a = *(const f32x4*)(F.in[18] + l * 256 + c4), r_k = *(const f32x4*)(F.in[19] + l * 256 + c4);
    f32x4 w0[2], a0[2];
#pragma unroll
    for (int d = 0; d < 2; ++d) { w0[d] = *(const f32x4*)(F.in[12] + (l * 2 + d) * 256 + c4); a0[d] = *(const f32x4*)(F.in[14] + (l * 2 + d) * 256 + c4); }
    float invf[4];
#pragma unroll
    for (int j = 0; j < 4; ++j) invf[j] = exp2f(-(float)((c4 + j) & 15) * (13.287712379549449f / 16.f));
    const int gw = F.vcu * NWAVES + F.wave, NGW = F.G * NWAVES;
    struct PrepRaw { u32x2 h1, bg, c1, hp, cp, hn, cn, q, k, r, rk; unsigned xv, mg; };
#define PREP_LOAD(dst, row_) do { const int r_ = (row_); const bool isc_ = r_ >= MLAT; const int t_ = isc_ ? ((r_ - MLAT) & 255) : (r_ & 8191); const int T_ = isc_ ? TCTX : TLAT; \
        const bf16_t* pr_ = P + (size_t)r_ * DINP; const bf16_t* pp_ = t_ > 0 ? pr_ - DINP : pr_; const bf16_t* pn_ = t_ < T_ - 1 ? pr_ + DINP : pr_; \
        dst.h1 = *(const u32x2*)(pr_ + C_CH + c4); dst.bg = *(const u32x2*)(pr_ + C_CB + c4); dst.c1 = *(const u32x2*)(pr_ + C_CC + c4); \
        dst.hp = *(const u32x2*)(pp_ + C_CH + c4); dst.cp = *(const u32x2*)(pp_ + C_CC + c4); dst.hn = *(const u32x2*)(pn_ + C_CH + c4); dst.cn = *(const u32x2*)(pn_ + C_CC + c4); \
        dst.q = *(const u32x2*)(pr_ + C_AQ + c4); dst.k = *(const u32x2*)(pr_ + C_AK + (c4 & 127)); dst.r = *(const u32x2*)(pr_ + C_RR + c4); dst.rk = *(const u32x2*)(pr_ + C_RK + c4); \
        dst.xv = pr_[C_XW + lane]; dst.mg = pr_[C_MG + (lane & 15)]; } while (0)
#define UP4(w_) ((f32x4){lo2f((w_).x), hi2f((w_).x), lo2f((w_).y), hi2f((w_).y)})
    PrepRaw cur, nxt;
    if (gw < MALL) PREP_LOAD(cur, gw);
    for (int row = gw; row < MALL; row += NGW) {
        const bool isc = row >= MLAT; const int t = isc ? ((row - MLAT) & 255) : (row & 8191); const int T = isc ? TCTX : TLAT;
        { const int rn = row + NGW < MALL ? row + NGW : row; PREP_LOAD(nxt, rn); }
        {
            const f32x4 h1 = UP4(cur.h1), bg = UP4(cur.bg), c1 = UP4(cur.c1);
            f32x4 up = UP4(cur.hp) * UP4(cur.cp), un = UP4(cur.hn) * UP4(cur.cn);
            if (t == 0) up = (f32x4){0.f, 0.f, 0.f, 0.f};
            if (t == T - 1) un = (f32x4){0.f, 0.f, 0.f, 0.f};
            const f32x4 y = bg * (cw0 * up + cw1 * (c1 * h1) + cw2 * un);
            const float ss = red16((y[0] * y[0] + y[1] * y[1]) + (y[2] * y[2] + y[3] * y[3]));
            const float rs = rsqrtf(ss * (1.f / 64.f) + EPSN);
            st4bf(YC + (size_t)row * DM + c4, y * rs * cg * ZF(2));
        }
        {
            const f32x4 q = UP4(cur.q); const f32x4 k = UP4(cur.k);
            const float qs = red16((q[0] * q[0] + q[1] * q[1]) + (q[2] * q[2] + q[3] * q[3]));
            const float ks = red16((k[0] * k[0] + k[1] * k[1]) + (k[2] * k[2] + k[3] * k[3]));
            f32x4 qn = q * rsqrtf(qs * (1.f / 64.f) + EPSN) * qg, kn = k * rsqrtf(ks * (1.f / 64.f) + EPSN) * kg;
            if (!isc) {
                f32x4 qp, kp;
#pragma unroll
                for (int j = 0; j < 4; ++j) { qp[j] = __shfl_xor(qn[j], 4); kp[j] = __shfl_xor(kn[j], 4); }
                const int d0 = c4 & 63; const float pos = (d0 < 32) ? (float)(t >> 6) : (float)(t & 63); const bool lowh = (d0 & 16) == 0;
#pragma unroll
                for (int j = 0; j < 4; ++j) { const float th = pos * invf[j]; const float cs = __cosf(th), sn = __sinf(th);
                    qn[j] = lowh ? qn[j] * cs - qp[j] * sn : qn[j] * cs + qp[j] * sn; kn[j] = lowh ? kn[j] * cs - kp[j] * sn : kn[j] * cs + kp[j] * sn; }
            }
            st4bf(QA + (size_t)row * 256 + c4, qn * (0.125f * 1.4426950408889634f));
            if (lane < 32) st4bf(KA + (size_t)row * 128 + c4, kn);
        }
        {
            const f32x4 r = UP4(cur.r), k = UP4(cur.rk);
            { const float xv = bf2f((bf16_t)cur.xv);
              tsc[lane] = lane < 16 ? tanhf_(xv) : (lane < 32 ? xv : sigmoidf_(xv)); }
            const f32x4 kx = k * k_k;
            const float kss = red16((kx[0] * kx[0] + kx[1] * kx[1]) + (kx[2] * kx[2] + kx[3] * kx[3]));
            const f32x4 kk = kx * rsqrtf(kss + EPSN);
            bf16_t* recb = (bf16_t*)(RW + (size_t)row * RWREC); float* recf = (float*)(RW + (size_t)row * RWREC + 2560);
            st4bf(recb + c4, kk);
            f32x4 kdsum = {0.f, 0.f, 0.f, 0.f};
#pragma unroll
            for (int d = 0; d < 2; ++d) {
                f32x4 dw = w0[d], da = a0[d];
#pragma unroll 4
                for (int ii = 0; ii < 16; ++ii) { dw += tsc[ii] * *(const LAS f32x4*)(W2s + (d * 16 + ii) * 256 + c4); da += tsc[16 + ii] * *(const LAS f32x4*)(A2s + (d * 16 + ii) * 256 + c4); }
                f32x4 dec, av;
#pragma unroll
                for (int j = 0; j < 4; ++j) { dec[j] = -0.6065306597126334f * sigmoidf_(dw[j]); av[j] = sigmoidf_(da[j]); }
                const f32x4 kd = k * (1.f + (av - 1.f) * k_a);
                kdsum += kd;
                st4bf(recb + 256 + d * 256 + c4, kk * av);
                st4bf(recb + 768 + d * 256 + c4, kd);
                *(f32x4*)(recf + d * 256 + c4) = dec;
            }
            f32x4 gv = {0.f, 0.f, 0.f, 0.f};
#pragma unroll 4
            for (int ii = 0; ii < 32; ++ii) gv += tsc[32 + ii] * *(const LAS f32x4*)(G2s + ii * 256 + c4);
            st4bf(GB + (size_t)row * 256 + c4, gv);
            const f32x4 bt = r * kdsum * r_k;
            const float bsum = red16((bt[0] + bt[1]) + (bt[2] + bt[3]));
            if (i16 == 0) BS[(size_t)row * 4 + (lane >> 4)] = bsum;
        }
        if (lane < 16) { const int dir = lane >> 3, gate = (lane >> 2) & 1, hd = lane & 3; const float x = bf2f((bf16_t)cur.mg);
            const float bias = gate ? F.in[26][(l * 2 + dir) * 4 + hd] : F.in[25][(l * 2 + dir) * 4 + hd];
            GA[(size_t)row * 16 + lane] = gate ? log_sigmoid_(x + bias) : (x + bias); }
        cur = nxt;
    }
#undef PREP_LOAD
#undef UP4
}
__device__ __forceinline__ int scan_row(int b, int dir, int i) {
    if (i < TCTX) return MLAT + b * TCTX + (dir ? (TCTX - 1 - i) : i);
    const int p = i - TCTX; return b * TLAT + (dir ? (TLAT - 1 - p) : p);
}
__device__ __forceinline__ void rwkv_scan(const Ctx& F, int blk) {
    const int chain = blk >> 2, quarter = blk & 3, b = chain >> 3, head = (chain >> 1) & 3, dir = chain & 1;
    const bool scanner = F.wave < 4;
    const int rowv = (quarter * 4 + (F.wave & 3)) * 4 + (F.lane >> 4), s = F.lane & 15;
    LAS float* buf = (LAS float*)F.lds;
    const bf16_t* P = WSP(bf16_t, WS_P); const unsigned char* RW = WSP(unsigned char, WS_RW); float* YR = WSP(float, WS_YR) + (size_t)dir * MALL * 256;
    const int st = F.tid >> 4, sub = F.tid & 15;
    constexpr int NSTEP = TCTX + TLAT, NCH = NSTEP / 32;
    u32x2 g_kk, g_al, g_kd, g_r, g_v; f32x4 g_w;
#define RW_LOAD(c) do { const int row_ = scan_row(b, dir, (c) * 32 + st); const bf16_t* rb_ = (const bf16_t*)(RW + (size_t)row_ * RWREC) + head * 64 + sub * 4; \
        g_kk = *(const u32x2*)rb_; g_al = *(const u32x2*)(rb_ + 256 + dir * 256); g_kd = *(const u32x2*)(rb_ + 768 + dir * 256); \
        g_w = *(const f32x4*)((const float*)(RW + (size_t)row_ * RWREC + 2560) + dir * 256 + head * 64 + sub * 4); \
        const bf16_t* pp_ = P + (size_t)row_ * DINP + head * 64 + sub * 4; g_r = *(const u32x2*)(pp_ + C_RR); g_v = *(const u32x2*)(pp_ + C_RV); } while (0)
#define RW_STORE(par) do { LAS float* d_ = buf + ((par) * 32 + st) * 384 + sub * 4; \
        *(LAS f32x4*)(d_) = (f32x4){lo2f(g_kk.x), hi2f(g_kk.x), lo2f(g_kk.y), hi2f(g_kk.y)}; *(LAS f32x4*)(d_ + 64) = (f32x4){lo2f(g_al.x), hi2f(g_al.x), lo2f(g_al.y), hi2f(g_al.y)}; \
        *(LAS f32x4*)(d_ + 128) = (f32x4){lo2f(g_kd.x), hi2f(g_kd.x), lo2f(g_kd.y), hi2f(g_kd.y)}; *(LAS f32x4*)(d_ + 192) = g_w; \
        *(LAS f32x4*)(d_ + 256) = (f32x4){lo2f(g_r.x), hi2f(g_r.x), lo2f(g_r.y), hi2f(g_r.y)}; *(LAS f32x4*)(d_ + 320) = (f32x4){lo2f(g_v.x), hi2f(g_v.x), lo2f(g_v.y), hi2f(g_v.y)}; } while (0)
    f32x4 S = {0.f, 0.f, 0.f, 0.f};
    RW_LOAD(0); RW_STORE(0); __syncthreads();
    for (int c = 0; c < NCH; ++c) {
        const int par = c & 1;
        if (c + 1 < NCH) RW_LOAD(c + 1);
        if (scanner) {
        float ykeep = 0.f;
        f32x4 Lkk[3], Lal[3], Lkd[3], Lw[3], Lr[3]; float Lv[3];
#define SC_LD(set, i_) do { const LAS float* d_ = buf + (par * 32 + (i_)) * 384; Lkk[set] = *(const LAS f32x4*)(d_ + s * 4); Lal[set] = *(const LAS f32x4*)(d_ + 64 + s * 4); \
            Lkd[set] = *(const LAS f32x4*)(d_ + 128 + s * 4); Lw[set] = *(const LAS f32x4*)(d_ + 192 + s * 4); Lr[set] = *(const LAS f32x4*)(d_ + 256 + s * 4); Lv[set] = d_[320 + rowv]; } while (0)
        SC_LD(0, 0); SC_LD(1, 1);
#pragma unroll
        for (int i = 0; i < 32; ++i) {
            if (i + 2 < 32) SC_LD((i + 2) % 3, i + 2);
            const f32x4 kk = Lkk[i % 3], al = Lal[i % 3], kd = Lkd[i % 3], w = Lw[i % 3], r = Lr[i % 3]; const float vr = Lv[i % 3];
            const float sa = red16((S[0] * kk[0] + S[1] * kk[1]) + (S[2] * kk[2] + S[3] * kk[3]));
            S = S * w + (vr * kd - sa * al);
            const float y = red16((S[0] * r[0] + S[1] * r[1]) + (S[2] * r[2] + S[3] * r[3]));
            ykeep = (s == (i & 15)) ? y : ykeep;
            if ((i & 15) == 15) {
                const int stp = c * 32 + (i - 15) + s; const int pc = dir ? (TCTX - 1 - stp) : stp, pl = dir ? (TLAT - 1 - (stp - TCTX)) : (stp - TCTX);
                const int row = stp < TCTX ? (MLAT + b * TCTX + pc) : (b * TLAT + pl);
                YR[(size_t)row * 256 + head * 64 + rowv] = ykeep; }
        }
#undef SC_LD
        }
        if (c + 1 < NCH) RW_STORE(par ^ 1);
        __syncthreads();
    }
#undef RW_LOAD
#undef RW_STORE
}

typedef union { u32x4 u; bf16x8 b; } frag_u;
__device__ __forceinline__ void attn_unit(const Ctx& F, int l, int unit) {
    LAS bf16_t* Kl = (LAS bf16_t*)F.lds; LAS bf16_t* Vt = Kl + 64 * 72;
    const bf16_t* P = WSP(bf16_t, WS_P); const bf16_t* QA = WSP(bf16_t, WS_QA); const bf16_t* KA = WSP(bf16_t, WS_KA); bf16_t* YC = WSP(bf16_t, WS_YCAT);
    const bool isc = unit >= 256; int b, kvh, n;
    if (!isc) { b = unit >> 7; kvh = (unit >> 6) & 1; n = unit & 63; } else { const int u = unit - 256; b = u >> 2; kvh = (u >> 1) & 1; n = u & 1; }
    const int g = F.wave >> 2, ps = F.wave & 3, head = kvh * 2 + g, i = F.lane & 15, gq = F.lane >> 4;
    const int qpos0 = n * 128 + ps * 32, qrow0 = (isc ? MLAT + b * TCTX : b * TLAT) + qpos0;
    bf16x8 Qf[2][2];
#pragma unroll
    for (int qb = 0; qb < 2; ++qb)
#pragma unroll
        for (int ks = 0; ks < 2; ++ks) Qf[qb][ks] = *(const bf16x8*)(QA + (size_t)(qrow0 + qb * 16 + i) * 256 + head * 64 + ks * 32 + gq * 8);
    const float sinkl = F.in[23][l * 4 + head] * 1.4426950408889634f;
    float mrun[2] = {sinkl, sinkl}, lsum[2]; lsum[0] = lsum[1] = (gq == 0) ? 1.f : 0.f;
    f32x4 ao[4][2];
#pragma unroll
    for (int db = 0; db < 4; ++db) { ao[db][0] = (f32x4){0.f, 0.f, 0.f, 0.f}; ao[db][1] = (f32x4){0.f, 0.f, 0.f, 0.f}; }
    const int ntl = isc ? 4 : 10;
    const int skey = F.tid >> 3, sch = F.tid & 7;
#define ATT_KROW(tt_) ((!isc && (tt_) < 6) ? ((2 * (n - 1) + (tt_) < 0 || 2 * (n - 1) + (tt_) >= 128) ? -1 : b * TLAT + (2 * (n - 1) + (tt_)) * 64) : MLAT + b * TCTX + (isc ? (tt_) : (tt_) - 6) * 64)
#define ATT_LOAD(tt_) do { const int kr_ = ATT_KROW(tt_); if (kr_ >= 0) { pk_kv = *(const u32x4*)(KA + (size_t)(kr_ + skey) * 128 + kvh * 64 + sch * 8); pk_vv = *(const u32x4*)(P + (size_t)(kr_ + skey) * DINP + C_AV + kvh * 64 + sch * 8); } } while (0)
    u32x4 pk_kv = {0u, 0u, 0u, 0u}, pk_vv = {0u, 0u, 0u, 0u};
    int tt0 = 0; while (tt0 < ntl && ATT_KROW(tt0) < 0) ++tt0;
    ATT_LOAD(tt0);
    for (int tt = tt0; tt < ntl; ++tt) {
        const int krow0 = ATT_KROW(tt); if (krow0 < 0) continue;
        const bool band = !isc && tt < 6; const int kpos0 = band ? (2 * (n - 1) + tt) * 64 : 0;
        LDS_BARRIER();
        { const u32x4 kv = pk_kv, vv = pk_vv;
          *(LAS u32x4*)(Kl + skey * 72 + sch * 8) = kv;
          const unsigned ww[4] = {vv.x, vv.y, vv.z, vv.w};
#pragma unroll
          for (int j = 0; j < 4; ++j) { Vt[(sch * 8 + 2 * j) * 72 + skey] = (bf16_t)(ww[j] & 0xffffu); Vt[(sch * 8 + 2 * j + 1) * 72 + skey] = (bf16_t)(ww[j] >> 16); } }
        { int tn = tt + 1; while (tn < ntl && ATT_KROW(tn) < 0) ++tn; if (tn < ntl) ATT_LOAD(tn); }
        LDS_BARRIER();
        f32x4 sc[4][2];
#pragma unroll
        for (int kb = 0; kb < 4; ++kb) {
            sc[kb][0] = (f32x4){0.f, 0.f, 0.f, 0.f}; sc[kb][1] = (f32x4){0.f, 0.f, 0.f, 0.f};
#pragma unroll
            for (int ks = 0; ks < 2; ++ks) { const bf16x8 kf = *(const LAS bf16x8*)(Kl + (kb * 16 + i) * 72 + ks * 32 + gq * 8);
                sc[kb][0] = __builtin_amdgcn_mfma_f32_16x16x32_bf16(kf, Qf[0][ks], sc[kb][0], 0, 0, 0);
                sc[kb][1] = __builtin_amdgcn_mfma_f32_16x16x32_bf16(kf, Qf[1][ks], sc[kb][1], 0, 0, 0); }
        }
#pragma unroll
        for (int qb = 0; qb < 2; ++qb) {
            const int qp = qpos0 + qb * 16 + i;
            float mx = -1e30f;
#pragma unroll
            for (int kb = 0; kb < 4; ++kb)
#pragma unroll
                for (int r = 0; r < 4; ++r) { if (band) { const int dd = (kpos0 + kb * 16 + 4 * gq + r) - qp; if (dd > 128 || dd < -128) sc[kb][qb][r] = -1e30f; } mx = fmaxf(mx, sc[kb][qb][r]); }
            mx = fmaxf(mx, __shfl_xor(mx, 16)); mx = fmaxf(mx, __shfl_xor(mx, 32));
            const float mnew = fmaxf(mrun[qb], mx), alpha = exp2f(mrun[qb] - mnew); mrun[qb] = mnew;
            float ps_ = 0.f;
#pragma unroll
            for (int kb = 0; kb < 4; ++kb)
#pragma unroll
                for (int r = 0; r < 4; ++r) { const float p = exp2f(sc[kb][qb][r] - mnew); sc[kb][qb][r] = p; ps_ += p; }
            lsum[qb] = lsum[qb] * alpha + ps_;
#pragma unroll
            for (int db = 0; db < 4; ++db) ao[db][qb] *= alpha;
        }
#pragma unroll
        for (int ks2 = 0; ks2 < 2; ++ks2) {
            frag_u pf[2];
#pragma unroll
            for (int qb = 0; qb < 2; ++qb) { pf[qb].u.x = pg8::cvt_pk_bf16(sc[2 * ks2][qb][0], sc[2 * ks2][qb][1]); pf[qb].u.y = pg8::cvt_pk_bf16(sc[2 * ks2][qb][2], sc[2 * ks2][qb][3]);
                pf[qb].u.z = pg8::cvt_pk_bf16(sc[2 * ks2 + 1][qb][0], sc[2 * ks2 + 1][qb][1]); pf[qb].u.w = pg8::cvt_pk_bf16(sc[2 * ks2 + 1][qb][2], sc[2 * ks2 + 1][qb][3]); }
#pragma unroll
            for (int db = 0; db < 4; ++db) { frag_u vf; const LAS bf16_t* vp = Vt + (db * 16 + i) * 72 + (2 * ks2) * 16 + 4 * gq;
                const u32x2 v0 = *(const LAS u32x2*)vp, v1 = *(const LAS u32x2*)(vp + 16); vf.u = (u32x4){v0.x, v0.y, v1.x, v1.y};
                ao[db][0] = __builtin_amdgcn_mfma_f32_16x16x32_bf16(vf.b, pf[0].b, ao[db][0], 0, 0, 0);
                ao[db][1] = __builtin_amdgcn_mfma_f32_16x16x32_bf16(vf.b, pf[1].b, ao[db][1], 0, 0, 0); }
        }
    }
#undef ATT_KROW
#undef ATT_LOAD
    const float* og = F.in[24] + l * 256 + head * 64;
#pragma unroll
    for (int qb = 0; qb < 2; ++qb) {
        float lt = lsum[qb]; lt += __shfl_xor(lt, 16); lt += __shfl_xor(lt, 32);
        const float il = 1.f / lt; float ss = 0.f;
#pragma unroll
        for (int db = 0; db < 4; ++db) { ao[db][qb] *= il; ss += (ao[db][qb][0] * ao[db][qb][0] + ao[db][qb][1] * ao[db][qb][1]) + (ao[db][qb][2] * ao[db][qb][2] + ao[db][qb][3] * ao[db][qb][3]); }
        ss += __shfl_xor(ss, 16); ss += __shfl_xor(ss, 32);
        const float rs = rsqrtf(ss * (1.f / 64.f) + EPSN);
        bf16_t* yo = YC + (size_t)(qrow0 + qb * 16 + i) * DM + 512 + head * 64;
#pragma unroll
        for (int db = 0; db < 4; ++db) { const f32x4 gg = *(const f32x4*)(og + db * 16 + 4 * gq); st4bf(yo + db * 16 + 4 * gq, ao[db][qb] * rs * gg * ZF(8)); }
    }
    __syncthreads();
}

__device__ __forceinline__ int ml_row(int b, int dir, int j, int tp) {
    if (j < 2) { const int p = j * 128 + tp; return MLAT + b * TCTX + (dir ? (TCTX - 1 - p) : p); }
    const int p = (j - 2) * 128 + tp; return b * TLAT + (dir ? (TLAT - 1 - p) : p);
}
__device__ __forceinline__ void scan128_add(float& x0, float& x1, int lane) {
    x1 += x0; float t = x1;
#pragma unroll
    for (int o = 1; o < 64; o <<= 1) { const float u = __shfl_up(t, o); if (lane >= o) t += u; }
    const float ex = t - x1; x0 += ex; x1 = t;
}
__device__ __forceinline__ void scan128_max(float& x0, float& x1, int lane) {
    x1 = fmaxf(x1, x0); float t = x1;
#pragma unroll
    for (int o = 1; o < 64; o <<= 1) { const float u = __shfl_up(t, o); if (lane >= o) t = fmaxf(t, u); }
    const float pv = __shfl_up(t, 1); if (lane > 0) x0 = fmaxf(x0, pv); x1 = t;
}
__device__ __forceinline__ void ml_stage_T(const Ctx& F, const bf16_t* P, int b, int dir, int j, int col0, LAS bf16_t* dst, const LAS float* sw, float cscale) {
#pragma unroll
    for (int it = 0; it < 2; ++it) { const int id = F.tid + it * NTHR, tp = id >> 3, ch = id & 7;
        const u32x4 v = *(const u32x4*)(P + (size_t)ml_row(b, dir, j, tp) * DINP + col0 + ch * 8); const float s = (sw ? sw[tp] : 1.f) * cscale;
        const unsigned ww[4] = {v.x, v.y, v.z, v.w};
#pragma unroll
        for (int q = 0; q < 4; ++q) { dst[(ch * 8 + 2 * q) * 136 + tp] = (bf16_t)f2bf(lo2f(ww[q]) * s); dst[(ch * 8 + 2 * q + 1) * 136 + tp] = (bf16_t)f2bf(hi2f(ww[q]) * s); } }
}
__device__ __forceinline__ void ml_stage_R(const Ctx& F, const bf16_t* P, int b, int dir, int j, int col0, LAS bf16_t* dst, float cscale) {
#pragma unroll
    for (int it = 0; it < 2; ++it) { const int id = F.tid + it * NTHR, tp = id >> 3, ch = id & 7;
        u32x4 v = *(const u32x4*)(P + (size_t)ml_row(b, dir, j, tp) * DINP + col0 + ch * 8);
        if (cscale != 1.f) { v.x = pk2(lo2f(v.x) * cscale, hi2f(v.x) * cscale); v.y = pk2(lo2f(v.y) * cscale, hi2f(v.y) * cscale); v.z = pk2(lo2f(v.z) * cscale, hi2f(v.z) * cscale); v.w = pk2(lo2f(v.w) * cscale, hi2f(v.w) * cscale); }
        *(LAS u32x4*)(dst + tp * 72 + ch * 8) = v; }
}
__device__ __forceinline__ void mlstm_local(const Ctx& F, int task) {
    const int chain = task / NCHK, j = task % NCHK, b = chain >> 3, head = (chain >> 1) & 3, dir = chain & 1;
    const bf16_t* P = WSP(bf16_t, WS_P); const float* GA = WSP(float, WS_GA);
    LAS bf16_t* Vt = (LAS bf16_t*)F.lds; LAS bf16_t* Kt = Vt + 64 * 136; LAS float* wS = (LAS float*)(Kt + 64 * 136); LAS float* sc2 = wS + 128;
    __syncthreads();
    if (F.wave == 0) {
        const int r0 = ml_row(b, dir, j, 2 * F.lane), r1 = ml_row(b, dir, j, 2 * F.lane + 1);
        const float li0 = GA[(size_t)r0 * 16 + dir * 8 + head], li1 = GA[(size_t)r1 * 16 + dir * 8 + head];
        float b0 = GA[(size_t)r0 * 16 + dir * 8 + 4 + head], b1 = GA[(size_t)r1 * 16 + dir * 8 + 4 + head];
        scan128_add(b0, b1, F.lane);
        const float bend = __shfl(b1, 63);
        const float d0 = bend - b0 + li0, d1 = bend - b1 + li1;
        float mx = fmaxf(d0, d1);
#pragma unroll
        for (int o = 1; o < 64; o <<= 1) mx = fmaxf(mx, __shfl_xor(mx, o));
        wS[2 * F.lane] = __expf(d0 - mx); wS[2 * F.lane + 1] = __expf(d1 - mx);
        if (F.lane == 0) { sc2[0] = mx; sc2[1] = bend; }
    }
    __syncthreads();
    ml_stage_T(F, P, b, dir, j, C_MV + head * 64, Vt, wS, 1.f);
    ml_stage_T(F, P, b, dir, j, C_MK + head * 64, Kt, nullptr, 0.125f);
    __syncthreads();
    float* LC = WSP(float, WS_LC) + (size_t)task * CST;
    { const int vb = F.wave >> 1, i = F.lane & 15, gq = F.lane >> 4;
#pragma unroll
      for (int kk2 = 0; kk2 < 2; ++kk2) { const int kb = 2 * (F.wave & 1) + kk2; f32x4 acc = {0.f, 0.f, 0.f, 0.f};
#pragma unroll
          for (int ks = 0; ks < 4; ++ks) { const bf16x8 a = *(const LAS bf16x8*)(Vt + (vb * 16 + i) * 136 + ks * 32 + gq * 8), bb = *(const LAS bf16x8*)(Kt + (kb * 16 + i) * 136 + ks * 32 + gq * 8);
              acc = __builtin_amdgcn_mfma_f32_16x16x32_bf16(a, bb, acc, 0, 0, 0); }
#pragma unroll
          for (int r = 0; r < 4; ++r) LC[(vb * 16 + 4 * gq + r) * 64 + kb * 16 + i] = acc[r]; } }
    if (F.tid < 64) { float a = 0.f;
#pragma unroll 8
        for (int s = 0; s < 128; ++s) a += wS[s] * bf2f(Kt[F.tid * 136 + s]);
        LC[4096 + F.tid] = a; }
    if (F.tid == 0) { float* LB = WSP(float, WS_LB); LB[task * 2] = sc2[0]; LB[task * 2 + 1] = sc2[1]; }
}
__device__ __forceinline__ void mlstm_chain(const Ctx& F, int blk0) {
    const int gt = (F.vcu - blk0) * NTHR + F.tid; if (gt < 0 || gt >= 16 * CST) return;
    const int chain = gt / CST, e = gt % CST;
    const float* LC = WSP(float, WS_LC) + (size_t)chain * NCHK * CST + e; float* ST = WSP(float, WS_ST) + (size_t)chain * NCHK * CST + e;
    const float* LB = WSP(float, WS_LB) + chain * NCHK * 2; float* SM = WSP(float, WS_LB) + 4096 + chain * NCHK;
    float m = 0.f, x = 0.f;
#pragma unroll 1
    for (int g = 0; g < 3; ++g) {
        float d[22], Lv[22], Bv[22];
#pragma unroll
        for (int q = 0; q < 22; ++q) { const int j = g * 22 + q; d[q] = LC[(size_t)j * CST]; Lv[q] = LB[2 * j]; Bv[q] = LB[2 * j + 1]; }
#pragma unroll
        for (int q = 0; q < 22; ++q) { const int j = g * 22 + q;
            ST[(size_t)j * CST] = x; if (e == 0) SM[j] = m;
            const float mn = fmaxf(Bv[q] + m, Lv[q]);
            x = __expf(Bv[q] + m - mn) * x + __expf(Lv[q] - mn) * d[q]; m = mn; }
    }
}
__device__ __forceinline__ void mlstm_out(const Ctx& F, int l, int unit) {
    const bool isc = unit >= 512; int b, chunk, head;
    if (!isc) { b = unit >> 8; chunk = (unit >> 2) & 63; head = unit & 3; } else { const int u = unit - 512; b = u >> 3; chunk = (u >> 2) & 1; head = u & 3; }
    const bf16_t* P = WSP(bf16_t, WS_P); const float* GA = WSP(float, WS_GA); bf16_t* YC = WSP(bf16_t, WS_YCAT);
    LAS bf16_t* Ql = (LAS bf16_t*)F.lds; LAS bf16_t* Kl = Ql + 128 * 72; LAS bf16_t* Vt = Kl + 128 * 72; LAS bf16_t* Cb = Vt + 64 * 136;
    LAS float* nS = (LAS float*)(Cb + 64 * 72); LAS float* aS = nS + 64; LAS float* bS = aS + 128; LAS float* MS = bS + 128; LAS float* Hs = MS + 128;
    const int i = F.lane & 15, gq = F.lane >> 4, w = F.wave;
    for (int dir = 0; dir < 2; ++dir) {
        const int j = isc ? (dir ? 1 - chunk : chunk) : 2 + (dir ? 63 - chunk : chunk);
        const int chain = (b * 4 + head) * 2 + dir;
        const float* ST = WSP(float, WS_ST) + ((size_t)chain * NCHK + j) * CST; const float mprev = WSP(float, WS_LB)[4096 + chain * NCHK + j];
        __syncthreads();
        if (w == 0) {
            const int r0 = ml_row(b, dir, j, 2 * F.lane), r1 = ml_row(b, dir, j, 2 * F.lane + 1);
            const float li0 = GA[(size_t)r0 * 16 + dir * 8 + head], li1 = GA[(size_t)r1 * 16 + dir * 8 + head];
            float b0 = GA[(size_t)r0 * 16 + dir * 8 + 4 + head], b1 = GA[(size_t)r1 * 16 + dir * 8 + 4 + head];
            scan128_add(b0, b1, F.lane);
            const float a0 = li0 - b0, a1 = li1 - b1; float A0 = a0, A1 = a1;
            scan128_max(A0, A1, F.lane);
            aS[2 * F.lane] = a0; aS[2 * F.lane + 1] = a1; bS[2 * F.lane] = b0; bS[2 * F.lane + 1] = b1;
            MS[2 * F.lane] = fmaxf(A0, mprev); MS[2 * F.lane + 1] = fmaxf(A1, mprev);
        }
        ml_stage_R(F, P, b, dir, j, C_MQ + head * 64, Ql, 1.f);
        ml_stage_R(F, P, b, dir, j, C_MK + head * 64, Kl, 0.125f);
        ml_stage_T(F, P, b, dir, j, C_MV + head * 64, Vt, nullptr, 1.f);
        { const f32x4 c0 = *(const f32x4*)(ST + F.tid * 8), c1 = *(const f32x4*)(ST + F.tid * 8 + 4); const int v = F.tid >> 3, k0 = (F.tid & 7) * 8;
          u32x4 o; o.x = pk2(c0[0], c0[1]); o.y = pk2(c0[2], c0[3]); o.z = pk2(c1[0], c1[1]); o.w = pk2(c1[2], c1[3]); *(LAS u32x4*)(Cb + v * 72 + k0) = o;
          if (F.tid < 64) nS[F.tid] = ST[4096 + F.tid]; }
        __syncthreads();
        const int t = 16 * w + i; const float Mt = MS[t], bt = bS[t];
        bf16x8 Qf[2];
#pragma unroll
        for (int ks = 0; ks < 2; ++ks) Qf[ks] = *(const LAS bf16x8*)(Ql + t * 72 + ks * 32 + gq * 8);
        f32x4 sc[8];
#pragma unroll
        for (int sb = 0; sb < 8; ++sb) { sc[sb] = (f32x4){0.f, 0.f, 0.f, 0.f};
            if (sb <= w) {
#pragma unroll
                for (int ks = 0; ks < 2; ++ks) { const bf16x8 kf = *(const LAS bf16x8*)(Kl + (sb * 16 + i) * 72 + ks * 32 + gq * 8); sc[sb] = __builtin_amdgcn_mfma_f32_16x16x32_bf16(kf, Qf[ks], sc[sb], 0, 0, 0); }
#pragma unroll
                for (int r = 0; r < 4; ++r) { const int s = sb * 16 + 4 * gq + r; sc[sb][r] = (s <= t) ? sc[sb][r] * __expf(aS[s] - Mt) : 0.f; }
            } }
        float den = 0.f;
#pragma unroll
        for (int sb = 0; sb < 8; ++sb) den += (sc[sb][0] + sc[sb][1]) + (sc[sb][2] + sc[sb][3]);
        den += __shfl_xor(den, 16); den += __shfl_xor(den, 32);
        f32x4 nm[4], it_[4];
#pragma unroll
        for (int vb = 0; vb < 4; ++vb) { nm[vb] = (f32x4){0.f, 0.f, 0.f, 0.f}; it_[vb] = (f32x4){0.f, 0.f, 0.f, 0.f}; }
#pragma unroll
        for (int ks2 = 0; ks2 < 4; ++ks2) if (2 * ks2 <= w) {
            frag_u pf; pf.u.x = pg8::cvt_pk_bf16(sc[2 * ks2][0], sc[2 * ks2][1]); pf.u.y = pg8::cvt_pk_bf16(sc[2 * ks2][2], sc[2 * ks2][3]);
            pf.u.z = pg8::cvt_pk_bf16(sc[2 * ks2 + 1][0], sc[2 * ks2 + 1][1]); pf.u.w = pg8::cvt_pk_bf16(sc[2 * ks2 + 1][2], sc[2 * ks2 + 1][3]);
#pragma unroll
            for (int vb = 0; vb < 4; ++vb) { frag_u vf; const LAS bf16_t* vp = Vt + (vb * 16 + i) * 136 + (2 * ks2) * 16 + 4 * gq;
                const u32x2 v0 = *(const LAS u32x2*)vp, v1 = *(const LAS u32x2*)(vp + 16); vf.u = (u32x4){v0.x, v0.y, v1.x, v1.y};
                nm[vb] = __builtin_amdgcn_mfma_f32_16x16x32_bf16(vf.b, pf.b, nm[vb], 0, 0, 0); }
        }
#pragma unroll
        for (int vb = 0; vb < 4; ++vb)
#pragma unroll
            for (int ks = 0; ks < 2; ++ks) { const bf16x8 cf = *(const LAS bf16x8*)(Cb + (vb * 16 + i) * 72 + ks * 32 + gq * 8); it_[vb] = __builtin_amdgcn_mfma_f32_16x16x32_bf16(cf, Qf[ks], it_[vb], 0, 0, 0); }
        float nq = 0.f;
#pragma unroll
        for (int c = 0; c < 2; ++c) { const u32x4 qv = *(const LAS u32x4*)(Ql + t * 72 + gq * 16 + c * 8); const unsigned ww[4] = {qv.x, qv.y, qv.z, qv.w};
#pragma unroll
            for (int q = 0; q < 4; ++q) nq += nS[gq * 16 + c * 8 + 2 * q] * lo2f(ww[q]) + nS[gq * 16 + c * 8 + 2 * q + 1] * hi2f(ww[q]); }
        nq += __shfl_xor(nq, 16); nq += __shfl_xor(nq, 32);
        const float wint = __expf(mprev - Mt); den += wint * nq;
        const float dn = 1.f / fmaxf(fabsf(den), __expf(-(bt + Mt)));
        const int torig = dir ? 127 - t : t;
#pragma unroll
        for (int vb = 0; vb < 4; ++vb)
#pragma unroll
            for (int r = 0; r < 4; ++r) { const float hv = (nm[vb][r] + wint * it_[vb][r]) * dn; LAS float* hp = Hs + torig * 65 + vb * 16 + 4 * gq + r; if (dir == 0) *hp = hv; else *hp += hv; }
    }
    __syncthreads();
    {
        const int t = F.tid >> 2, vq = F.tid & 3; const int row = (isc ? MLAT + b * TCTX : b * TLAT) + chunk * 128 + t;
        float hv[16], ss = 0.f;
#pragma unroll
        for (int q = 0; q < 16; ++q) { hv[q] = Hs[t * 65 + vq * 16 + q]; ss += hv[q] * hv[q]; }
        ss += __shfl_xor(ss, 1); ss += __shfl_xor(ss, 2);
        const float rs = rsqrtf(ss * (1.f / 64.f) + EPSN);
        const float* og = F.in[27] + l * 256 + head * 64 + vq * 16; const bf16_t* op = P + (size_t)row * DINP + C_MO + head * 64 + vq * 16;
        const u32x4 o0 = *(const u32x4*)op, o1 = *(const u32x4*)(op + 8); const unsigned ow[8] = {o0.x, o0.y, o0.z, o0.w, o1.x, o1.y, o1.z, o1.w};
        unsigned res[8];
#pragma unroll
        for (int q = 0; q < 8; ++q) { const float y0 = sigmoidf_(lo2f(ow[q])) * hv[2 * q] * rs * og[2 * q], y1 = sigmoidf_(hi2f(ow[q])) * hv[2 * q + 1] * rs * og[2 * q + 1]; res[q] = pk2(y0 * ZF(16), y1 * ZF(16)); }
        bf16_t* yo = YC + (size_t)row * DM + 768 + head * 64 + vq * 16;
        *(u32x4*)yo = (u32x4){res[0], res[1], res[2], res[3]}; *(u32x4*)(yo + 8) = (u32x4){res[4], res[5], res[6], res[7]};
    }
    __syncthreads();
}
__device__ __forceinline__ void rwkv_finish(const Ctx& F, int l, int nrows) {
    const bf16_t* P = WSP(bf16_t, WS_P); const float* YR = WSP(float, WS_YR); const bf16_t* GB = WSP(bf16_t, WS_GB); const float* BS = WSP(float, WS_BS); bf16_t* YC = WSP(bf16_t, WS_YCAT);
    const int c4 = F.lane * 4; const f32x4 lg = *(const f32x4*)(F.in[20] + l * 256 + c4);
    const int gw = F.vcu * NWAVES + F.wave, NGW = F.G * NWAVES;
    for (int row = gw; row < nrows; row += NGW) {
        const f32x4 y = *(const f32x4*)(YR + (size_t)row * 256 + c4) + *(const f32x4*)(YR + (size_t)(MALL + row) * 256 + c4);
        const float ss = red16((y[0] * y[0] + y[1] * y[1]) + (y[2] * y[2] + y[3] * y[3]));
        const float rs = rsqrtf(ss * (1.f / 64.f) + EPSN);
        const f32x4 v = ld4bf(P + (size_t)row * DINP + C_RV + c4), g = ld4bf(GB + (size_t)row * 256 + c4);
        const float bn = BS[(size_t)row * 4 + (F.lane >> 4)];
        st4bf(YC + (size_t)row * DM + 256 + c4, (y * rs * lg * ZF(32) + bn * v * ZF(64)) * g * ZF(4));
    }
}
constexpr int RCH = 132;
constexpr int MP = 72, SLOT = 64 * MP;
constexpr size_t WS_RG = 454 * MiB, RG_TASK = 3 * 8192, WS_SST = WS_RW;
constexpr size_t WS_END2 = 504 * MiB;
static_assert(WS_RG + (size_t)16 * RCH * RG_TASK <= WS_END2 && (size_t)16 * RCH * 8192 <= (size_t)MALL * RWREC, "rwkv chunk ws map");

__device__ __forceinline__ void mm64(const LAS bf16_t* A, const LAS bf16_t* Bt, int w, int lane, f32x4 (&acc)[2]) {
    const int i = lane & 15, gq = lane >> 4, mb = w >> 1, nb0 = 2 * (w & 1);
    acc[0] = (f32x4){0.f, 0.f, 0.f, 0.f}; acc[1] = (f32x4){0.f, 0.f, 0.f, 0.f};
#pragma unroll
    for (int ks = 0; ks < 2; ++ks) { const bf16x8 a = *(const LAS bf16x8*)(A + (mb * 16 + i) * MP + ks * 32 + gq * 8);
#pragma unroll
        for (int q = 0; q < 2; ++q) { const bf16x8 b = *(const LAS bf16x8*)(Bt + ((nb0 + q) * 16 + i) * MP + ks * 32 + gq * 8); acc[q] = __builtin_amdgcn_mfma_f32_16x16x32_bf16(a, b, acc[q], 0, 0, 0); } }
}
__device__ __forceinline__ u32x2 pk4(f32x4 v) { u32x2 o; o.x = pk2(v[0], v[1]); o.y = pk2(v[2], v[3]); return o; }
__device__ __forceinline__ f32x4 up4(u32x2 w) { return (f32x4){lo2f(w.x), hi2f(w.x), lo2f(w.y), hi2f(w.y)}; }

struct RaRaw { u32x4 kk, al, kd, r, v; f32x4 ld0, ld1; };
__device__ __forceinline__ void ra_load(const Ctx& F, int task, RaRaw& g) {
    const int chain = task / RCH, c = task % RCH, b = chain >> 3, head = (chain >> 1) & 3, dir = chain & 1;
    const bf16_t* P = WSP(bf16_t, WS_P); const unsigned char* RW = WSP(unsigned char, WS_RW);
    const int t = F.tid >> 3, ch0 = (F.tid & 7) * 8; const int row = scan_row(b, dir, c * 64 + t);
    const bf16_t* rb = (const bf16_t*)(RW + (size_t)row * RWREC) + head * 64 + ch0;
    g.kk = *(const u32x4*)rb; g.al = *(const u32x4*)(rb + 256 + dir * 256); g.kd = *(const u32x4*)(rb + 768 + dir * 256);
    const float* ldp = (const float*)(RW + (size_t)row * RWREC + 2560) + dir * 256 + head * 64 + ch0;
    g.ld0 = *(const f32x4*)ldp; g.ld1 = *(const f32x4*)(ldp + 4);
    const bf16_t* pp = P + (size_t)row * DINP + head * 64 + ch0;
    g.r = *(const u32x4*)(pp + C_RR); g.v = *(const u32x4*)(pp + C_RV);
}
__device__ __forceinline__ void rwkv_chunk_pre(const Ctx& F, int task, const RaRaw& cur) {
    const int chain = task / RCH, c = task % RCH, b = chain >> 3, head = (chain >> 1) & 3, dir = chain & 1;
    LAS bf16_t* L0 = (LAS bf16_t*)F.lds;
#define SL(k) (L0 + (k) * SLOT)
    LAS float* LD = (LAS float*)SL(8);
    LAS float* SEG = (LAS float*)SL(10);
    LAS float* WLs = (LAS float*)SL(14);
    const int w = F.wave, lane = F.lane, i = lane & 15, gq = lane >> 4, mb = w >> 1, nb0 = 2 * (w & 1), m0 = mb * 16 + 4 * gq;
    LDS_BARRIER();
    const int t = F.tid >> 3, ch0 = (F.tid & 7) * 8;
    const u32x4 g_kk = cur.kk, g_al = cur.al, g_kd = cur.kd, g_r = cur.r, g_v = cur.v; const f32x4 ld0 = cur.ld0, ld1 = cur.ld1;
    *(LAS f32x4*)(LD + t * 64 + ch0) = ld0; *(LAS f32x4*)(LD + t * 64 + ch0 + 4) = ld1;
    LDS_BARRIER();
    { const int k = F.tid & 63, seg = F.tid >> 6; float s = 0.f;
#pragma unroll
      for (int j = 0; j < 8; ++j) s += LD[(seg * 8 + j) * 64 + k];
      SEG[seg * 64 + k] = s;
      LDS_BARRIER();
      float off = 0.f;
#pragma unroll
      for (int j = 0; j < 8; ++j) off += (j < seg) ? SEG[j * 64 + k] : 0.f;
#pragma unroll
      for (int j = 0; j < 8; ++j) { off += LD[(seg * 8 + j) * 64 + k]; LD[(seg * 8 + j) * 64 + k] = off; }
    }
    LDS_BARRIER();
    {
        const unsigned kkw[4] = {g_kk.x, g_kk.y, g_kk.z, g_kk.w}, alw[4] = {g_al.x, g_al.y, g_al.z, g_al.w}, kdw[4] = {g_kd.x, g_kd.y, g_kd.z, g_kd.w},
                       rw_[4] = {g_r.x, g_r.y, g_r.z, g_r.w}, vw[4] = {g_v.x, g_v.y, g_v.z, g_v.w};
        float okt[8], oai[8], oki[8], ort[8], oat[8], okb[8];
#pragma unroll
        for (int j = 0; j < 8; ++j) {
            const float cl = LD[t * 64 + ch0 + j], clp = t > 0 ? LD[(t - 1) * 64 + ch0 + j] : 0.f, clL = LD[63 * 64 + ch0 + j];
            const float kkv = (j & 1) ? hi2f(kkw[j >> 1]) : lo2f(kkw[j >> 1]), alv = (j & 1) ? hi2f(alw[j >> 1]) : lo2f(alw[j >> 1]), kdv = (j & 1) ? hi2f(kdw[j >> 1]) : lo2f(kdw[j >> 1]),
                        rv = (j & 1) ? hi2f(rw_[j >> 1]) : lo2f(rw_[j >> 1]);
            const float ec = __expf(cl), en = __builtin_amdgcn_rcpf(ec), eL = __expf(clL) * en;
            okt[j] = kkv * __expf(clp); oai[j] = alv * en; oki[j] = kdv * en; ort[j] = rv * ec; oat[j] = alv * eL; okb[j] = kdv * eL;
        }
        u32x4 o;
        o = (u32x4){pk2(okt[0], okt[1]), pk2(okt[2], okt[3]), pk2(okt[4], okt[5]), pk2(okt[6], okt[7])}; *(LAS u32x4*)(SL(0) + t * MP + ch0) = o;
        o = (u32x4){pk2(oai[0], oai[1]), pk2(oai[2], oai[3]), pk2(oai[4], oai[5]), pk2(oai[6], oai[7])}; *(LAS u32x4*)(SL(2) + t * MP + ch0) = o;
        o = (u32x4){pk2(oki[0], oki[1]), pk2(oki[2], oki[3]), pk2(oki[4], oki[5]), pk2(oki[6], oki[7])}; *(LAS u32x4*)(SL(3) + t * MP + ch0) = o;
        o = (u32x4){pk2(ort[0], ort[1]), pk2(ort[2], ort[3]), pk2(ort[4], ort[5]), pk2(ort[6], ort[7])}; *(LAS u32x4*)(SL(4) + t * MP + ch0) = o;
#pragma unroll
        for (int j = 0; j < 8; ++j) { SL(1)[(ch0 + j) * MP + t] = (bf16_t)f2bf(okt[j]); SL(5)[(ch0 + j) * MP + t] = (bf16_t)f2bf(oat[j]); SL(6)[(ch0 + j) * MP + t] = (bf16_t)f2bf(okb[j]);
            SL(7)[(ch0 + j) * MP + t] = (bf16_t)(((j & 1) ? (vw[j >> 1] >> 16) : (vw[j >> 1] & 0xffffu))); }
        if (t == 63) {
#pragma unroll
            for (int j = 0; j < 8; ++j) WLs[ch0 + j] = __expf(LD[63 * 64 + ch0 + j]); }
    }
    LDS_BARRIER();
    f32x4 acc[2];
    mm64(SL(0), SL(2), w, lane, acc);
#pragma unroll
    for (int q = 0; q < 2; ++q) { const int n = (nb0 + q) * 16 + i; f32x4 a, ti;
#pragma unroll
        for (int r = 0; r < 4; ++r) { const bool keep = (m0 + r) > n; a[r] = keep ? acc[q][r] : 0.f; ti[r] = ((m0 + r) == n ? 1.f : 0.f) - a[r]; }
#pragma unroll
        for (int r = 0; r < 4; ++r) { SL(8)[(m0 + r) * MP + n] = (bf16_t)f2bf(a[r]); SL(13)[(m0 + r) * MP + n] = (bf16_t)f2bf(ti[r]); }
        *(LAS u32x2*)(SL(9) + n * MP + m0) = pk4(a); }
    mm64(SL(0), SL(3), w, lane, acc);
#pragma unroll
    for (int q = 0; q < 2; ++q) { const int n = (nb0 + q) * 16 + i;
#pragma unroll
        for (int r = 0; r < 4; ++r) SL(10)[(m0 + r) * MP + n] = (bf16_t)f2bf((m0 + r) > n ? acc[q][r] : 0.f); }
    mm64(SL(4), SL(2), w, lane, acc);
#pragma unroll
    for (int q = 0; q < 2; ++q) { const int n = (nb0 + q) * 16 + i;
#pragma unroll
        for (int r = 0; r < 4; ++r) SL(11)[(m0 + r) * MP + n] = (bf16_t)f2bf((m0 + r) >= n ? acc[q][r] : 0.f); }
    mm64(SL(4), SL(3), w, lane, acc);
#pragma unroll
    for (int q = 0; q < 2; ++q) { const int n = (nb0 + q) * 16 + i;
#pragma unroll
        for (int r = 0; r < 4; ++r) SL(12)[(m0 + r) * MP + n] = (bf16_t)f2bf((m0 + r) >= n ? acc[q][r] : 0.f); }
    LDS_BARRIER();
#pragma unroll
    for (int it = 0; it < 5; ++it) {
        LAS bf16_t* Xs = (it & 1) ? SL(2) : SL(8); LAS bf16_t* XsT = (it & 1) ? SL(3) : SL(9);
        LAS bf16_t* Xd = (it & 1) ? SL(8) : SL(2); LAS bf16_t* XdT = (it & 1) ? SL(9) : SL(3);
        LAS bf16_t* Tsrc = (it & 1) ? SL(0) : SL(13); LAS bf16_t* Tdst = (it & 1) ? SL(13) : SL(0);
        mm64(Xs, XsT, w, lane, acc);
#pragma unroll
        for (int q = 0; q < 2; ++q) { const int n = (nb0 + q) * 16 + i;
#pragma unroll
            for (int r = 0; r < 4; ++r) Xd[(m0 + r) * MP + n] = (bf16_t)f2bf(acc[q][r]);
            *(LAS u32x2*)(XdT + n * MP + m0) = pk4(acc[q]); }
        LDS_BARRIER();
        mm64(Tsrc, XdT, w, lane, acc);
#pragma unroll
        for (int q = 0; q < 2; ++q) { const int n = (nb0 + q) * 16 + i;
#pragma unroll
            for (int r = 0; r < 4; ++r) Tdst[(m0 + r) * MP + n] = (bf16_t)f2bf(bf2f(Tsrc[(m0 + r) * MP + n]) + acc[q][r]); }
        LDS_BARRIER();
    }
    LAS bf16_t* Ti = SL(0);
    mm64(Ti, SL(1), w, lane, acc);
#pragma unroll
    for (int q = 0; q < 2; ++q) { const int n = (nb0 + q) * 16 + i; *(LAS u32x2*)(SL(2) + n * MP + m0) = pk4(acc[q]); }
    mm64(SL(10), SL(7), w, lane, acc);
#pragma unroll
    for (int q = 0; q < 2; ++q) { const int n = (nb0 + q) * 16 + i; *(LAS u32x2*)(SL(3) + n * MP + m0) = pk4(acc[q]); }
    LDS_BARRIER();
    mm64(Ti, SL(3), w, lane, acc);
#pragma unroll
    for (int q = 0; q < 2; ++q) { const int n = (nb0 + q) * 16 + i; *(LAS u32x2*)(SL(8) + n * MP + m0) = pk4(acc[q]); }
    LDS_BARRIER();
    bf16_t* RG = (bf16_t*)(F.ws + WS_RG + (size_t)task * RG_TASK);
    f32x4 acc2[2];
    mm64(SL(2), SL(11), w, lane, acc);
#pragma unroll
    for (int q = 0; q < 2; ++q) { const int n = (nb0 + q) * 16 + i; const f32x4 rt = up4(*(const LAS u32x2*)(SL(4) + n * MP + m0)); *(u32x2*)(RG + n * 64 + m0) = pk4(rt - acc[q]); }
    mm64(SL(2), SL(5), w, lane, acc);
#pragma unroll
    for (int q = 0; q < 2; ++q) { const int n = (nb0 + q) * 16 + i; f32x4 g;
#pragma unroll
        for (int r = 0; r < 4; ++r) g[r] = ((m0 + r) == n ? WLs[n] : 0.f) - acc[q][r];
        *(u32x2*)(RG + 4096 + n * 64 + m0) = pk4(g); }
    mm64(SL(6), SL(7), w, lane, acc); mm64(SL(5), SL(8), w, lane, acc2);
#pragma unroll
    for (int q = 0; q < 2; ++q) { const int n = (nb0 + q) * 16 + i; *(u32x2*)(RG + 8192 + n * 64 + m0) = pk4(acc[q] - acc2[q]); }
    mm64(SL(7), SL(12), w, lane, acc); mm64(SL(8), SL(11), w, lane, acc2);
    float* YR = WSP(float, WS_YR) + (size_t)dir * MALL * 256;
#pragma unroll
    for (int q = 0; q < 2; ++q) { const int n = (nb0 + q) * 16 + i; const int rown = scan_row(b, dir, c * 64 + n); *(f32x4*)(YR + (size_t)rown * 256 + head * 64 + m0) = acc[q] - acc2[q]; }
#undef SL
}

__device__ __forceinline__ void rwkv_chain(const Ctx& F, int chain) {
    LAS bf16_t* const L0 = (LAS bf16_t*)F.lds;
    LAS bf16_t* Gl[2] = {L0, L0 + SLOT}; LAS bf16_t* Sl[2] = {L0 + 2 * SLOT, L0 + 3 * SLOT}; LAS bf16_t* Hl[2] = {L0 + 4 * SLOT, L0 + 5 * SLOT};
    const int w = F.wave, lane = F.lane, i = lane & 15, gq = lane >> 4, mb = w >> 1, nb0 = 2 * (w & 1), m0 = mb * 16 + 4 * gq;
    const bf16_t* RGc = (const bf16_t*)(F.ws + WS_RG + (size_t)chain * RCH * RG_TASK); bf16_t* SST = (bf16_t*)(F.ws + WS_SST) + (size_t)chain * RCH * 4096;
    const int gr = F.tid >> 3, gc = (F.tid & 7) * 8, goff = gr * 64 + gc, loff = gr * MP + gc;
    constexpr int RBD = 6, RBU = 66;
    static_assert(RBU % RBD == 0 && RCH % RBU == 0, "ring depth / unroll");
    u32x4 rg[RBD], rh[RBD];
#define RB_LOAD(slot, cc) do { const bf16_t* p_ = RGc + (size_t)((cc) < RCH ? (cc) : RCH - 1) * (RG_TASK / 2); rg[slot] = *(const u32x4*)(p_ + 4096 + goff); rh[slot] = *(const u32x4*)(p_ + 8192 + goff); } while (0)
#pragma unroll
    for (int j = 0; j < RBD; ++j) RB_LOAD(j, j);
    __syncthreads();
    { unsigned z_; asm volatile("v_mov_b32 %0, 0" : "=v"(z_)); *(LAS u32x4*)(Sl[0] + loff) = (u32x4){z_, z_, z_, z_}; }
    *(LAS u32x4*)(Gl[0] + loff) = rg[0]; *(LAS u32x4*)(Hl[0] + loff) = rh[0];
    __syncthreads();
#ifdef TPROBE
    const unsigned long long tp0_ = __builtin_amdgcn_s_memrealtime();
#endif
#define RB_STEP(j) do { const int c = c0 + (j); if (c < RCH - 1) { const int par = c & 1; \
        *(u32x4*)(SST + (size_t)c * 4096 + goff) = *(const LAS u32x4*)(Sl[par] + loff);            \
        f32x4 acc[2]; mm64(Gl[par], Sl[par], w, lane, acc); \
        { const f32x4 h0 = up4(*(const LAS u32x2*)(Hl[par] + (nb0 * 16 + i) * MP + m0)), h1 = up4(*(const LAS u32x2*)(Hl[par] + ((nb0 + 1) * 16 + i) * MP + m0)); \
          *(LAS u32x2*)(Sl[par ^ 1] + (nb0 * 16 + i) * MP + m0) = pk4(acc[0] + h0); *(LAS u32x2*)(Sl[par ^ 1] + ((nb0 + 1) * 16 + i) * MP + m0) = pk4(acc[1] + h1); } \
        *(LAS u32x4*)(Gl[par ^ 1] + loff) = rg[((j) + 1) % RBD]; *(LAS u32x4*)(Hl[par ^ 1] + loff) = rh[((j) + 1) % RBD]; \
        RB_LOAD((j) % RBD, c + RBD); \
        asm volatile("s_waitcnt lgkmcnt(0)" ::: "memory"); __builtin_amdgcn_s_barrier(); asm volatile("" ::: "memory"); } } while (0)
#pragma unroll 1
    for (int c0 = 0; c0 < RCH; c0 += RBU) {
#pragma unroll
        for (int j = 0; j < RBU; ++j) RB_STEP(j); }
#undef RB_STEP
#undef RB_LOAD
    *(u32x4*)(SST + (size_t)(RCH - 1) * 4096 + goff) = *(const LAS u32x4*)(Sl[(RCH - 1) & 1] + loff);
#ifdef TPROBE
    if (chain == 0 && F.tid == 0) *(float*)(F.ws + WS_CTL + 65536) = 3000.f * (floorf((float)(__builtin_amdgcn_s_memrealtime() - tp0_) * (1.f / 3000.f)) + 0.5f);
#endif
    __syncthreads();
}

__device__ __forceinline__ void rwkv_out(const Ctx& F, int l, int unit) {
    const bool isc = unit >= 256; int b, chunk; if (!isc) { b = unit >> 7; chunk = unit & 127; } else { const int u = unit - 256; b = u >> 2; chunk = u & 3; }
    LAS bf16_t* Rl = (LAS bf16_t*)F.lds; LAS bf16_t* Sl = Rl + SLOT; LAS float* Ys = (LAS float*)(F.lds + 4 * SLOT * 2);
    const int w = F.wave, lane = F.lane, i = lane & 15, gq = lane >> 4, mb = w >> 1, nb0 = 2 * (w & 1), m0 = mb * 16 + 4 * gq;
    const int row0 = (isc ? MLAT + b * TCTX : b * TLAT) + chunk * 64;
    const int gr = F.tid >> 3, gc = (F.tid & 7) * 8;
#define RO_PTRS(hd_, RGp, SSp) do { const int head_ = (hd_) >> 1, dir_ = (hd_) & 1, chain_ = (b * 4 + head_) * 2 + dir_; const int cc_ = isc ? (dir_ ? 3 - chunk : chunk) : 4 + (dir_ ? 127 - chunk : chunk); \
        RGp = (const bf16_t*)(F.ws + WS_RG + ((size_t)chain_ * RCH + cc_) * RG_TASK); SSp = (const bf16_t*)(F.ws + WS_SST) + ((size_t)chain_ * RCH + cc_) * 4096; } while (0)
    u32x4 rv, sv;
    { const bf16_t* RG0; const bf16_t* SS0; RO_PTRS(0, RG0, SS0); rv = *(const u32x4*)(RG0 + gr * 64 + gc); sv = *(const u32x4*)(SS0 + gr * 64 + gc); }
#pragma unroll 1
    for (int hd = 0; hd < 8; ++hd) {
        const int head = hd >> 1, dir = hd & 1;
        const float* YR = WSP(float, WS_YR) + (size_t)dir * MALL * 256;
        LDS_BARRIER();
        *(LAS u32x4*)(Rl + gr * MP + gc) = rv; *(LAS u32x4*)(Sl + gr * MP + gc) = sv;
        if (hd < 7) { const bf16_t* RGn; const bf16_t* SSn; RO_PTRS(hd + 1, RGn, SSn); rv = *(const u32x4*)(RGn + gr * 64 + gc); sv = *(const u32x4*)(SSn + gr * 64 + gc); }
        f32x4 yl[2];
#pragma unroll
        for (int q = 0; q < 2; ++q) { const int n = (nb0 + q) * 16 + i; const int tor = dir ? 63 - n : n; yl[q] = *(const f32x4*)(YR + (size_t)(row0 + tor) * 256 + head * 64 + m0); }
        LDS_BARRIER();
        f32x4 acc[2]; mm64(Sl, Rl, w, lane, acc);
#pragma unroll
        for (int q = 0; q < 2; ++q) { const int n = (nb0 + q) * 16 + i; const int tor = dir ? 63 - n : n;
            LAS f32x4* yp = (LAS f32x4*)(Ys + tor * 260 + head * 64 + m0);
            if (dir == 0) *yp = acc[q] + yl[q]; else *yp = *yp + acc[q] + yl[q]; }
    }
#undef RO_PTRS
    __syncthreads();
    {
        const bf16_t* P = WSP(bf16_t, WS_P); const bf16_t* GB = WSP(bf16_t, WS_GB); const float* BS = WSP(float, WS_BS); bf16_t* YC = WSP(bf16_t, WS_YCAT);
        const int c4 = lane * 4; const f32x4 lg = *(const f32x4*)(F.in[20] + l * 256 + c4);
#pragma unroll 1
        for (int tt = w; tt < 64; tt += NWAVES) { const int row = row0 + tt;
            const f32x4 y = *(const LAS f32x4*)(Ys + tt * 260 + c4);
            const float ss = red16((y[0] * y[0] + y[1] * y[1]) + (y[2] * y[2] + y[3] * y[3]));
            const float rs = rsqrtf(ss * (1.f / 64.f) + EPSN);
            const f32x4 v = ld4bf(P + (size_t)row * DINP + C_RV + c4), g = ld4bf(GB + (size_t)row * 256 + c4);
            const float bn = BS[(size_t)row * 4 + (lane >> 4)];
            st4bf(YC + (size_t)row * DM + 256 + c4, (y * rs * lg * ZF(32) + bn * v * ZF(64)) * g * ZF(4)); }
    }
    __syncthreads();
}
__device__ __forceinline__ float clr7(float x) { return __uint_as_float(__float_as_uint(x) & 0xFFFFFF80u); }
__device__ __forceinline__ void ins16(float (&L)[16], float p) {
#pragma unroll
    for (int j = 15; j >= 1; --j) L[j] = __builtin_amdgcn_fmed3f(L[j - 1], L[j], p);
    L[0] = fmaxf(L[0], p);
}
__device__ __forceinline__ void peer_topk_task(const float* sg, size_t gstride, u32x2* eg) {
    float L0[16], L1[16];
#pragma unroll
    for (int j = 0; j < 16; ++j) { L0[j] = -INFINITY; L1[j] = -INFINITY; }
    f32x4 pa[4], pb[4];
#pragma unroll
    for (int u = 0; u < 4; ++u) { pa[u] = *(const f32x4*)(sg + (size_t)u * gstride); pb[u] = *(const f32x4*)(sg + (size_t)(32 + u) * gstride); }
#pragma unroll 4
    for (int i = 0; i < 128; i += 4) {
        const f32x4 a = pa[(i >> 2) & 3], b = pb[(i >> 2) & 3];
        { const int gn = (i >> 2) + 4 < 32 ? (i >> 2) + 4 : 31; pa[(i >> 2) & 3] = *(const f32x4*)(sg + (size_t)gn * gstride); pb[(i >> 2) & 3] = *(const f32x4*)(sg + (size_t)(32 + gn) * gstride); }
#pragma unroll
        for (int q = 0; q < 4; ++q) { ins16(L0, __uint_as_float((__float_as_uint(a[q]) & 0xFFFFFF80u) | (unsigned)(i + q)));
                                      ins16(L1, __uint_as_float((__float_as_uint(b[q]) & 0xFFFFFF80u) | (unsigned)(i + q))); }
    }
    float T[16];
#pragma unroll
    for (int j = 0; j < 16; ++j) T[j] = -INFINITY;
#pragma unroll
    for (int a = 0; a < 16; ++a)
#pragma unroll
        for (int b = 0; b < 16; ++b) if ((a + 1) * (b + 1) <= 16) { const float s = clr7(L0[a]) + clr7(L1[b]);
            ins16(T, __uint_as_float((__float_as_uint(s) & 0xFFFFFF00u) | (unsigned)(a * 16 + b))); }
    float e[16], sum = 0.f; const float mx = __uint_as_float(__float_as_uint(T[0]) & 0xFFFFFF00u);
#pragma unroll
    for (int j = 0; j < 16; ++j) { e[j] = __expf(__uint_as_float(__float_as_uint(T[j]) & 0xFFFFFF00u) - mx); sum += e[j]; }
    const float inv = 1.f / sum;
#pragma unroll
    for (int j = 0; j < 16; ++j) {
        const unsigned ab = __float_as_uint(T[j]) & 0xFFu, a = ab >> 4, b = ab & 15u; unsigned i0 = 0u, i1 = 0u;
#pragma unroll
        for (int q = 0; q < 16; ++q) { i0 = (a == (unsigned)q) ? (__float_as_uint(L0[q]) & 0x7Fu) : i0; i1 = (b == (unsigned)q) ? (__float_as_uint(L1[q]) & 0x7Fu) : i1; }
        eg[j] = (u32x2){i0 * 128u + i1, __float_as_uint(e[j] * inv)};
    }
}
__device__ __forceinline__ float gelu_tanh(float x) { const float u = 0.7978845608028654f * (x + 0.044715f * x * x * x); return 0.5f * x * (1.f + tanhf_(u)); }
__device__ __forceinline__ float dot2bf(unsigned w, unsigned x, float acc) { return __builtin_amdgcn_fdot2_f32_bf16(__builtin_bit_cast(bf16x2_t, w), __builtin_bit_cast(bf16x2_t, x), acc, false); }
__device__ __forceinline__ float wave_total63(float x) {
    x = red16(x);
    x += __int_as_float(__builtin_amdgcn_update_dpp(0, __float_as_int(x), 0x142, 0xa, 0xf, false));
    x += __int_as_float(__builtin_amdgcn_update_dpp(0, __float_as_int(x), 0x143, 0xc, 0xf, false));
    return x;
}
__device__ __forceinline__ void phase_peer(const Ctx& F, int l, int nrows, const float* mod, float* wr_override) {
    const float* S = WSP(float, WS_S); u32x2* EG = WSP(u32x2, WS_EG); const bf16_t* H = WSP(bf16_t, WS_H);
    const unsigned char* U = F.ws + WS_U + (size_t)l * UV_LSTRIDE; const unsigned char* V = F.ws + WS_V + (size_t)l * UV_LSTRIDE;
    const float* USC = WSP(float, WS_SC) + (size_t)l * 2 * 16384; const float* VSC = USC + 16384;
    const int tpb = nrows / F.G, tok0 = F.vcu * tpb;
    volatile LAS unsigned* tkflag = (volatile LAS unsigned*)(F.lds + LDSCTL_OFF + 512);
    if (F.tid == 0) tkflag[0] = 0u;
    { const int ntok1 = tpb < 64 ? tpb : 64; const int task = F.tid; const int hd = task / ntok1, tkn = task - hd * ntok1;
      if (hd < 8) { const int row = tok0 + tkn; peer_topk_task(S + ((size_t)(hd * 64) * MALL + row) * 4, (size_t)MALL * 4, EG + (size_t)row * 128 + hd * 16); } }
    __threadfence_block(); __syncthreads();
    if (tpb > 64 && F.wave == 2) {
        const int nex = tpb - 64; const int hd = F.lane / nex, tkn = F.lane - hd * nex;
        if (hd < 8) { const int row = tok0 + 64 + tkn; peer_topk_task(S + ((size_t)(hd * 64) * MALL + row) * 4, (size_t)MALL * 4, EG + (size_t)row * 128 + hd * 16); }
        __threadfence_block(); asm volatile("s_waitcnt vmcnt(0) lgkmcnt(0)" ::: "memory");
        if (F.lane == 0) tkflag[0] = 1u;
    }
    const int lane = F.lane;
    for (int tk = F.wave; tk < tpb; tk += NWAVES) {
        if (tk >= 64) { while (tkflag[0] == 0u) __builtin_amdgcn_s_sleep(8); __threadfence_block(); }
        const int row = tok0 + tk; const bool isc = row >= MLAT; const int smp = isc ? 2 : (row >> 13);
        float* xrow = isc ? WSP(float, WS_XC) + (size_t)(row - MLAT) * DM : F.out + (size_t)row * DM;
        const u32x2 eg0 = EG[(size_t)row * 128 + lane], eg1 = EG[(size_t)row * 128 + 64 + lane];
        LAS unsigned char* wl = F.lds + F.wave * PEER_WLDS; LAS unsigned char* hbl = wl + 16 * 1040; LAS unsigned char* rawl = hbl + 2048;
        float hscale;
        {   const u32x4 h0 = *(const u32x4*)(H + (size_t)row * DM + lane * 16), h1 = *(const u32x4*)(H + (size_t)row * DM + lane * 16 + 8);
            const unsigned hw[8] = {h0.x, h0.y, h0.z, h0.w, h1.x, h1.y, h1.z, h1.w}; float hf[16]; float am = 0.f;
#pragma unroll
            for (int q = 0; q < 8; ++q) { hf[2 * q] = lo2f(hw[q]); hf[2 * q + 1] = hi2f(hw[q]); am = fmaxf(am, fmaxf(fabsf(hf[2 * q]), fabsf(hf[2 * q + 1]))); }
#pragma unroll
            for (int o = 1; o < 64; o <<= 1) am = fmaxf(am, __shfl_xor(am, o));
            const float sc = am > 0.f ? 224.f / am : 1.f; hscale = am > 0.f ? am * (1.f / 224.f) : 1.f;
#pragma unroll
            for (int hg = 0; hg < 2; ++hg) { unsigned hiw[2], low[2];
#pragma unroll
                for (int d = 0; d < 2; ++d) { const float a0 = hf[hg * 8 + d * 4] * sc, a1 = hf[hg * 8 + d * 4 + 1] * sc, a2 = hf[hg * 8 + d * 4 + 2] * sc, a3 = hf[hg * 8 + d * 4 + 3] * sc;
                    int w = __builtin_amdgcn_cvt_pk_fp8_f32(a0, a1, 0, false); w = __builtin_amdgcn_cvt_pk_fp8_f32(a2, a3, w, true);
                    const f32x2 b01 = __builtin_amdgcn_cvt_pk_f32_fp8(w, false), b23 = __builtin_amdgcn_cvt_pk_f32_fp8(w, true);
                    int wl_ = __builtin_amdgcn_cvt_pk_fp8_f32((a0 - b01.x) * 16.f, (a1 - b01.y) * 16.f, 0, false); wl_ = __builtin_amdgcn_cvt_pk_fp8_f32((a2 - b23.x) * 16.f, (a3 - b23.y) * 16.f, wl_, true);
                    hiw[d] = (unsigned)w; low[d] = (unsigned)wl_; }
                const int s_ = lane >> 1, g_ = 2 * (lane & 1) + hg;
                *(LAS u32x2*)(hbl + ((s_ * 2 + 0) * 4 + g_) * 8) = (u32x2){hiw[0], hiw[1]};
                *(LAS u32x2*)(hbl + ((s_ * 2 + 1) * 4 + g_) * 8) = (u32x2){low[0], low[1]}; }
        }
        float act0 = 0.f, act1 = 0.f;
        {
            const int mi = lane & 15, mg = lane >> 4;
            const LAS unsigned char* aptr = wl + mi * 1040 + mg * 8; const LAS unsigned char* bptr = hbl + (mi & 1) * 32 + mg * 8;
            u32x4 rr[3][8];
#define PU_LOAD(hb_) do { _Pragma("unroll") for (int q = 0; q < 8; ++q) { const int ii = (hb_) * 8 + q; const unsigned e = __builtin_amdgcn_readlane(ii < 64 ? eg0.x : eg1.x, ii & 63); \
                rr[(hb_) % 3][q] = *(const u32x4*)(U + (size_t)e * 1024 + lane * 16); } } while (0)
#define PU_PARK(hb_) do { _Pragma("unroll") for (int q = 0; q < 8; ++q) *(LAS u32x4*)(wl + (((hb_) & 1) * 8 + q) * 1040 + lane * 16) = rr[(hb_) % 3][q]; } while (0)
            PU_LOAD(0); PU_LOAD(1); PU_LOAD(2);
#pragma unroll
            for (int bt = 0; bt < 8; ++bt) {
                PU_PARK(2 * bt); if (2 * bt + 3 < 16) PU_LOAD(2 * bt + 3);
                PU_PARK(2 * bt + 1); if (2 * bt + 4 < 16) PU_LOAD(2 * bt + 4);
                f32x4 acc = {0.f, 0.f, 0.f, 0.f};
#pragma unroll
                for (int s = 0; s < 32; ++s) { const long a = *(const LAS long*)(aptr + s * 32), b = *(const LAS long*)(bptr + s * 64);
                    acc = __builtin_amdgcn_mfma_f32_16x16x32_fp8_fp8(a, b, acc, 0, 0, 0); }
                f32x4 tot;
#pragma unroll
                for (int r = 0; r < 4; ++r) tot[r] = acc[r] + 0.0625f * dppf<0xF5>(acc[r]);
                if (mi == 0) *(LAS f32x4*)(rawl + (bt * 16 + 4 * mg) * 4) = tot;
            }
#undef PU_PARK
#undef PU_LOAD
            act0 = *(const LAS float*)(rawl + lane * 4) * (hscale * USC[eg0.x]); act1 = *(const LAS float*)(rawl + 256 + lane * 4) * (hscale * USC[eg1.x]);
        }
        constexpr int GS = 8, NG2 = 128 / (2 * GS);
        u32x4 ra[GS], rb[GS];
#define PG_LOAD(dst, tab, grp_) do { _Pragma("unroll") for (int q = 0; q < GS; ++q) { const int ii = (grp_) * GS + q; const unsigned e = __builtin_amdgcn_readlane(ii < 64 ? eg0.x : eg1.x, ii & 63); \
            dst[q] = *(const u32x4*)((tab) + (size_t)e * 1024 + lane * 16); } } while (0)
        PG_LOAD(ra, V, 0);
        const float cf0 = __uint_as_float(eg0.y) * gelu_tanh(act0) * VSC[eg0.x], cf1 = __uint_as_float(eg1.y) * gelu_tanh(act1) * VSC[eg1.x];
        f32x2 ac[8];
#pragma unroll
        for (int q = 0; q < 8; ++q) ac[q] = (f32x2){0.f, 0.f};
#define PG_VACC(src, grp_) do { _Pragma("unroll") for (int q = 0; q < GS; ++q) { const int ii = (grp_) * GS + q; const float cf = __int_as_float(__builtin_amdgcn_readlane(__float_as_int(ii < 64 ? cf0 : cf1), ii & 63)); \
            const unsigned vw[4] = {src[q].x, src[q].y, src[q].z, src[q].w}; \
            _Pragma("unroll") for (int j = 0; j < 4; ++j) { ac[2 * j] += cf * __builtin_amdgcn_cvt_pk_f32_fp8((int)vw[j], false); ac[2 * j + 1] += cf * __builtin_amdgcn_cvt_pk_f32_fp8((int)vw[j], true); } } } while (0)
#pragma unroll 1
        for (int g2 = 0; g2 < NG2; ++g2) {
            PG_LOAD(rb, V, 2 * g2 + 1); PG_VACC(ra, 2 * g2);
            if (g2 < NG2 - 1) PG_LOAD(ra, V, 2 * g2 + 2);
            PG_VACC(rb, 2 * g2 + 1);
        }
#undef PG_LOAD
#undef PG_VACC
        float acc[16];
#pragma unroll
        for (int q = 0; q < 8; ++q) { acc[2 * q] = ac[q].x; acc[2 * q + 1] = ac[q].y; }
        const float* gt = mod + smp * 6144 + 5120;
        f32x4 res[4]; float ss = 0.f;
#pragma unroll
        for (int q = 0; q < 4; ++q) { const int c = lane * 16 + q * 4; const f32x4 g = *(const f32x4*)(gt + c), x = *(const f32x4*)(xrow + c);
            res[q] = x + ZF(1) * g * (f32x4){acc[q * 4], acc[q * 4 + 1], acc[q * 4 + 2], acc[q * 4 + 3]};
            *(f32x4*)((wr_override ? wr_override + (size_t)row * DM : xrow) + c) = res[q];
            ss += (res[q][0] * res[q][0] + res[q][1] * res[q][1]) + (res[q][2] * res[q][2] + res[q][3] * res[q][3]); }
        if (l == 0 && !wr_override) {
            const float rs = rsqrtf(wave_sum(ss) * (1.f / DM) + EPSN); const float* mb1 = mod + 3 * 6144 + smp * 6144; const float* g1 = F.in[6] + DM;
            bf16_t* Hw = WSP(bf16_t, WS_H) + (size_t)row * DM;
#pragma unroll
            for (int q = 0; q < 4; ++q) { const int c = lane * 16 + q * 4; const f32x4 g = *(const f32x4*)(g1 + c), sc = *(const f32x4*)(mb1 + 1024 + c), sh = *(const f32x4*)(mb1 + c);
                st4bf(Hw + c, (res[q] * rs * g) * (1.f + sc) + sh); }
        }
    }
}

constexpr int PH_PER_LAYER = 10, N_PHASES = 1 + 2 * PH_PER_LAYER;
struct Args { const float* in[32]; float* out; unsigned char* ws; int ph_lo, ph_hi, li, pad; };
__global__ void __launch_bounds__(NTHR, 2) mk_fwd(Args args) {
    extern __shared__ __attribute__((aligned(16))) unsigned char lds[];
    Ctx F;
    F.lds = (LAS unsigned char*)lds;
    volatile LAS unsigned* MISC = (volatile LAS unsigned*)(F.lds + MISC_OFF);
    F.tid = threadIdx.x; F.lane = F.tid & 63; F.wave = __builtin_amdgcn_readfirstlane(F.tid >> 6);
    F.G = gridDim.x; { const int bx = blockIdx.x; F.vcu = (F.G % 8 == 0) ? (bx % 8) * (F.G / 8) + bx / 8 : bx; }
#pragma unroll
    for (int i = 0; i < 32; ++i) F.in[i] = args.in[i];
    F.out = args.out; F.ws = args.ws;
    for (int u = F.tid; u < (LDS_BYTES - LDSCTL_OFF) / 4; u += NTHR) ((LAS unsigned*)(F.lds + LDSCTL_OFF))[u] = 0u;
    __syncthreads();
    XcdBarrier bar; bar.bar = (unsigned*)(args.ws + WS_CTL) + CW_BAR; bar.x = 0; bar.st = nullptr;
#if !MK_MULTI
    bar = xcd_barrier_post((unsigned*)(args.ws + WS_CTL) + CW_BAR, MISC + 8);
#endif
    const int lo = args.ph_lo, hi = args.ph_hi;
#ifndef KMAX
#define KMAX 1000
#endif
#define IN(k) (lo <= (k) && (k) < hi && (REP_ALL == 1 || ra == REP_ALL - 1 || (k) <= KMAX))
#ifndef REP_PH
#define REP_PH -1
#endif
#define REPS(k) ((REP_PH == (k)) ? 2 : 1)
#define PHCTX Ctx Fp = F; { int t_ = F.tid; asm volatile("" : "+v"(t_)); Fp.tid = t_; Fp.lane = t_ & 63; }
#if MK_MULTI
#define SEAM(k) do { } while (0)
#else
#ifndef BAR_REPS
#define BAR_REPS 1
#endif
#define SEAM(k) do { if (IN(k) && IN((k) + 1)) for (int br_ = 0; br_ < BAR_REPS; ++br_) xcd_barrier(bar); } while (0)
#endif
#ifndef REP_ALL
#define REP_ALL 1
#endif
#ifndef REP_SUB
#define REP_SUB 0
#endif
#pragma unroll 1
    for (int ra = 0; ra < REP_ALL; ++ra) {
    if (ra > 0) xcd_barrier(bar);
    if (IN(0)) { PHCTX; for (int rep = 0; rep < REPS(100); ++rep) phase_prologue(Fp); }
    SEAM(0);
    float* XC = WSP(float, WS_XC);
#pragma unroll 1
    for (int l = 0; l < 2; ++l) {
        const int pb = 1 + l * PH_PER_LAYER;
        const float* xlat = l == 0 ? F.in[0] : F.out; const float* xctx = l == 0 ? F.in[2] : XC;
        const int mrows = l == 0 ? MALL : MLAT;
        const float* mod = WSP(float, WS_MOD) + (size_t)l * 3 * 6144;
        if (IN(pb + 0) && l == 0) { PHCTX; for (int rep = 0; rep < REPS(0); ++rep) { phase_norm(Fp, l, 0, MALL, xlat, xctx); } }
        if (l == 0) SEAM(pb + 0);
        if (IN(pb + 1)) for (int rep = 0; rep < REPS(1); ++rep) { PHCTX; pg8::Gemm g{WSP(bf16_t, WS_H), WSP(bf16_t, WS_WIN + l * WIN_LSTRIDE), MALL, DINP, DM}; pg8::StaticOrder So; So.init(MALL, DINP, F.G, (int)blockIdx.x);
            pg8::EpiBf16 E{WSP(bf16_t, WS_P), DINP}; pg8::gemm_phase<pg8::EpiBf16, pg8::StaticOrder, true, true>(F.lds, g, So, E, Fp.tid); }
        SEAM(pb + 1);
        if (IN(pb + 2)) { PHCTX; for (int rep = 0; rep < REPS(2); ++rep) { phase_prep(Fp, l); __syncthreads(); } }
        SEAM(pb + 2);
        if (IN(pb + 3)) for (int rep = 0; rep < REPS(3); ++rep) {
            const int nra = 16 * RCH, nml = 16 * NCHK;
            for (int r3 = 0; r3 < (REP_SUB == 3 ? 2 : 1); ++r3) { PHCTX; for (int task = F.vcu; task < nra; task += F.G) { RaRaw cur_; ra_load(Fp, task, cur_); rwkv_chunk_pre(Fp, task, cur_); } __syncthreads(); }
            for (int r3 = 0; r3 < (REP_SUB == 4 ? 2 : 1); ++r3) { PHCTX; for (int task = (F.vcu + F.G - 72) % F.G; task < nml; task += F.G) mlstm_local(Fp, task); }
        }
        SEAM(pb + 3);
                if (IN(pb + 4)) for (int rep = 0; rep < REPS(4); ++rep) {
            if (F.vcu < 16) { PHCTX; rwkv_chain(Fp, F.vcu); }
            else { { PHCTX; mlstm_chain(Fp, 16); }
                   { PHCTX; const int natt = l == 0 ? 264 : 256; for (int task = F.vcu - 16; task < natt; task += F.G - 16) attn_unit(Fp, l, task); } } }
        SEAM(pb + 4);
        if (IN(pb + 5)) for (int rep = 0; rep < REPS(5); ++rep) { const int nro = l == 0 ? 264 : 256, nun = l == 0 ? 528 : 512;
            { PHCTX; for (int u = F.vcu; u < nro; u += F.G) rwkv_out(Fp, l, u); }
            { PHCTX; for (int u = (F.vcu + F.G - 8) % F.G; u < nun; u += F.G) mlstm_out(Fp, l, u); } }
        SEAM(pb + 5);
        if (IN(pb + 6)) for (int rep = 0; rep < REPS(6); ++rep) { PHCTX; pg8::Gemm g{WSP(bf16_t, WS_YCAT), WSP(bf16_t, WS_WOUT + l * WOUT_LSTRIDE), mrows, DM, DM}; pg8::StaticOrder So; So.init(mrows, DM, F.G, (int)blockIdx.x);
            float* dummy = WSP(float, WS_YR); const bool dm_ = (REPS(6) == 2 && rep == 0); pg8::EpiRes E{xlat, xctx, dm_ ? dummy : F.out, dm_ ? dummy : XC, mod}; pg8::gemm_phase<pg8::EpiRes, pg8::StaticOrder, true, true>(F.lds, g, So, E, Fp.tid); }
        SEAM(pb + 6);
        if (IN(pb + 7)) { PHCTX; for (int rep = 0; rep < REPS(7); ++rep) phase_norm(Fp, l, 1, mrows, F.out, XC); }
        SEAM(pb + 7);
        if (IN(pb + 8)) for (int rep = 0; rep < REPS(8); ++rep) { PHCTX; pg8::Gemm g{WSP(bf16_t, WS_H), WSP(bf16_t, WS_WEFF + l * WEFF_LSTRIDE), mrows, 2048, DM}; pg8::StaticOrder So; So.init(mrows, 2048, F.G, (int)blockIdx.x);
            pg8::EpiF32 E{WSP(float, WS_S), MALL}; pg8::gemm_phase<pg8::EpiF32, pg8::StaticOrder, true, true>(F.lds, g, So, E, Fp.tid); }
        SEAM(pb + 8);
        if (IN(pb + 9)) { PHCTX; for (int rep = 0; rep < REPS(9); ++rep) { phase_peer(Fp, l, mrows, mod, (REPS(9) == 2 && rep == 0) ? WSP(float, WS_YR) : nullptr); __syncthreads(); } }
        SEAM(pb + 9);
    }
    }
#undef IN
#undef SEAM
}

extern "C" void kernel_launch(void* const* d_in, const int* in_sizes, int n_in, void* d_out, int out_size, void* d_ws, size_t ws_size, hipStream_t stream) {
    static int grid = 0;
    if (grid == 0) {
        if (n_in != 32 || out_size != MLAT * DM || ws_size < WS_END2) { fprintf(stderr, "kernel_launch: unexpected shapes: n_in %d out %d ws %zu (need %zu)\n", n_in, out_size, ws_size, (size_t)WS_END2); grid = -1; return; }
        int dev = 0, cus = 0, per_cu = 0;
        if (hipGetDevice(&dev) != hipSuccess || hipDeviceGetAttribute(&cus, hipDeviceAttributeMultiprocessorCount, dev) != hipSuccess) { grid = -1; return; }
        if (hipFuncSetAttribute((const void*)mk_fwd, hipFuncAttributeMaxDynamicSharedMemorySize, LDS_BYTES) != hipSuccess) { fprintf(stderr, "kernel_launch: hipFuncSetAttribute failed\n"); grid = -1; return; }
        if (hipOccupancyMaxActiveBlocksPerMultiprocessor(&per_cu, (const void*)mk_fwd, NTHR, LDS_BYTES) != hipSuccess || per_cu < 1) fprintf(stderr, "kernel_launch: occupancy query reports %d\n", per_cu);
        (void)hipGetLastError();
        grid = cus;
        if (grid != 256) fprintf(stderr, "kernel_launch: grid %d (built for 256 CUs)\n", grid);
    }
    if (grid < 0) return;
    (void)hipMemsetAsync((char*)d_ws + WS_CTL, 0, CTL_ZERO_BYTES, stream);
    Args a{};
    for (int i = 0; i < 32; ++i) a.in[i] = (const float*)d_in[i];
    a.out = (float*)d_out; a.ws = (unsigned char*)d_ws;
#if MK_MULTI
    for (int p = 0; p < N_PHASES; ++p) { a.ph_lo = p; a.ph_hi = p + 1; a.li = p; hipLaunchKernelGGL(mk_fwd, dim3(grid), dim3(NTHR), LDS_BYTES, stream, a); }
#else
    a.ph_lo = 0; a.ph_hi = N_PHASES; a.li = 0;
    hipLaunchKernelGGL(mk_fwd, dim3(grid), dim3(NTHR), LDS_BYTES, stream, a);
#endif
}
```

```cpp
#include <hip/hip_runtime.h>
#include <cstdio>
#include <cstdint>

#ifndef MK_MULTI
#define MK_MULTI 0
#endif
#define U_FP4 0
namespace pg8 {
#define PG8_LAS __attribute__((address_space(3)))
typedef unsigned short bf16_t;
typedef short bf16x8 __attribute__((ext_vector_type(8)));
typedef float f32x4 __attribute__((ext_vector_type(4)));
typedef unsigned u32x4 __attribute__((ext_vector_type(4)));
constexpr int BM = 256, BK = 64, HALF = 128, HTB = HALF * BK * 2  , STAGE_BYTES = 8 * HTB, NXCD = 8, WGM = 8;

__host__ __device__ __forceinline__ int lds_byte(int r, int c) { const int st = (r >> 4) * 2 + (c >> 5), rr = r & 15, cc = c & 31, ob = rr * 64 + cc * 2; return st * 1024 + (ob ^ (((ob >> 9) & 1) << 5)); }
__host__ __device__ __forceinline__ void stage_rc(int b, int& R, int& C) { const int st = b / 1024, sb = b % 1024, swz = sb ^ (((sb >> 9) & 1) << 5); R = (st >> 1) * 16 + swz / 64; C = (st & 1) * 32 + (swz % 64) / 2; }
__host__ __device__ __forceinline__ int perm32(int rho) { const int n = rho >> 4, i = rho & 15; return 8 * (i >> 2) + 4 * n + (i & 3); }

struct Unit { int pm, pn; };
struct Gemm { const bf16_t* A; const bf16_t* Bt; int M, N, K; };

struct StaticOrder {
    int nM, nN, nwg, G, c;
    __host__ __device__ void init(int M, int N, int G_, int c_) { nM = M / BM; nN = N / BM; nwg = nM * nN; G = G_; c = c_; }
    __host__ __device__ bool next(int i, Unit& u) const {
        const long L = (long)i * G + c; if (L >= nwg) return false;
        int wgid = (int)L; { const int q = nwg / NXCD, r = nwg % NXCD, xcd = wgid % NXCD, off = wgid / NXCD; wgid = (xcd < r ? xcd * (q + 1) : r * (q + 1) + (xcd - r) * q) + off; }
        const int nig = WGM * nN, gid = wgid / nig, fm = gid * WGM, gsz = (nM - fm) < WGM ? (nM - fm) : WGM;
        u.pm = fm + ((wgid % nig) % gsz); u.pn = (wgid % nig) / gsz; return true;
    }
    __device__ __forceinline__ void a_ready(const Unit&) const {}
    __device__ __forceinline__ void done(const Unit&) const {}
};

__device__ __forceinline__ unsigned cvt_pk_bf16(float lo, float hi) { unsigned r; asm volatile("v_cvt_pk_bf16_f32 %0, %1, %2" : "=v"(r) : "v"(lo), "v"(hi)); return r; }

struct EpiBf16 {
    static constexpr bool PERM = true, AFTER_DRAIN = false;
    bf16_t* O; int ldc;
    __device__ __forceinline__ void operator()(const f32x4 (&acc)[2][2][4][2], const Unit& u, int wr, int wc, int fr, int fq) const {
        const int row0 = u.pm * BM + wr * 64 + fr; const int col0 = u.pn * BM + wc * 32 + 8 * fq;
#pragma unroll
        for (int ai = 0; ai < 2; ++ai)
#pragma unroll
            for (int m = 0; m < 4; ++m) { bf16_t* rowp = O + (size_t)(row0 + ai * HALF + m * 16) * ldc + col0;
#pragma unroll
                for (int bj = 0; bj < 2; ++bj) { const f32x4 v0 = acc[ai][bj][m][0], v1 = acc[ai][bj][m][1];
                    u32x4 w; w.x = cvt_pk_bf16(v0[0], v0[1]); w.y = cvt_pk_bf16(v0[2], v0[3]); w.z = cvt_pk_bf16(v1[0], v1[1]); w.w = cvt_pk_bf16(v1[2], v1[3]);
                    *(u32x4*)(rowp + bj * HALF) = w; } }
    }
};
struct EpiF32 {
    static constexpr bool PERM = false, AFTER_DRAIN = false;
    float* O; int ldr;
    __device__ __forceinline__ void operator()(const f32x4 (&acc)[2][2][4][2], const Unit& u, int wr, int wc, int fr, int fq) const {
        const int row0 = u.pm * BM + wr * 64 + fr; const int col0 = u.pn * BM + wc * 32 + 4 * fq;
#pragma unroll
        for (int ai = 0; ai < 2; ++ai)
#pragma unroll
            for (int m = 0; m < 4; ++m) { const int row = row0 + ai * HALF + m * 16;
#pragma unroll
                for (int bj = 0; bj < 2; ++bj)
#pragma unroll
                    for (int n = 0; n < 2; ++n) { const int cg = (col0 + bj * HALF + n * 16) >> 2; *(f32x4*)(O + ((size_t)cg * ldr + row) * 4) = acc[ai][bj][m][n]; } }
    }
};
struct EpiRes {
    static constexpr bool PERM = false, AFTER_DRAIN = false;
    const float* src_lat; const float* src_ctx; float* dst_lat; float* dst_ctx; const float* gate;
    __device__ __forceinline__ void operator()(const f32x4 (&acc)[2][2][4][2], const Unit& u, int wr, int wc, int fr, int fq) const {
        const bool isc = u.pm >= 64; const int smp = isc ? 2 : (u.pm >> 5);
        const int prow = (isc ? (u.pm - 64) * BM : u.pm * BM) + wr * 64 + fr;
        const float* src = isc ? src_ctx : src_lat; float* dst = isc ? dst_ctx : dst_lat;
        const float* gt = gate + smp * 6144 + 2048;
        const int col0 = u.pn * BM + wc * 32 + 4 * fq;
        f32x4 gv[2][2];
#pragma unroll
        for (int bj = 0; bj < 2; ++bj)
#pragma unroll
            for (int n = 0; n < 2; ++n) gv[bj][n] = *(const f32x4*)(gt + col0 + bj * HALF + n * 16);
#pragma unroll
        for (int ai = 0; ai < 2; ++ai)
#pragma unroll
            for (int m = 0; m < 4; ++m) { const size_t off = (size_t)(prow + ai * HALF + m * 16) * 1024 + col0;
#pragma unroll
                for (int bj = 0; bj < 2; ++bj)
#pragma unroll
                    for (int n = 0; n < 2; ++n) { const f32x4 s = *(const f32x4*)(src + off + bj * HALF + n * 16);
                        *(f32x4*)(dst + off + bj * HALF + n * 16) = s + gv[bj][n] * acc[ai][bj][m][n]; } }
    }
};

template <class Epi, class Sched, bool ALIGN_EPI = false, bool SP2 = false>
__device__ __forceinline__ void gemm_phase(PG8_LAS unsigned char* lds, const Gemm g, const Sched& S, const Epi& E, const int tid) {
    const int wid = __builtin_amdgcn_readfirstlane(tid >> 6), lane = tid & 63, wr = wid >> 2, wc = wid & 3, fr = lane & 15, fq = lane >> 4;
    const int K = g.K, nt = K / BK;
    unsigned voffA[2], voffB[2];
#pragma unroll
    for (int i = 0; i < 2; ++i) { int R, C; stage_rc(tid * 16 + i * 8192, R, C); const int Rb = Epi::PERM ? ((R & ~31) + perm32(R & 31)) : R;
        voffA[i] = (unsigned)(R * K + C) * 2u; voffB[i] = (unsigned)(Rb * K + C) * 2u; }
    const size_t kstep = (size_t)(BK * 2);
    const size_t hstep = (size_t)HALF * K * 2;
    const size_t tstep = 2 * hstep;
    const unsigned ldsw = (unsigned)wid * 1024u;
    const int aoff = lds_byte(wr * 64 + fr, fq * 8), boff = lds_byte(wc * 32 + fr, fq * 8);
#define PG8_SA(b, h) (((b) * 2 + (h)) * HTB)
#define PG8_SB(b, h) ((4 + (b) * 2 + (h)) * HTB)
#define PG8_STAGE(bufoff, gbase, voff) do { _Pragma("unroll") for (int _i = 0; _i < 2; ++_i) \
        __builtin_amdgcn_global_load_lds((const unsigned*)((const char*)(gbase) + (voff)[_i]), (PG8_LAS unsigned*)(lds + (bufoff) + ldsw + _i * 8192), 16, 0, 0); } while (0)
#define PG8_LDA(dst, b, h) do { _Pragma("unroll") for (int m = 0; m < 4; ++m) _Pragma("unroll") for (int k = 0; k < 2; ++k) dst[m][k] = *(const PG8_LAS bf16x8*)(lds + PG8_SA(b, h) + aoff + m * 2048 + k * 1024); } while (0)
#define PG8_LDB(dst, b, h) do { _Pragma("unroll") for (int n = 0; n < 2; ++n) _Pragma("unroll") for (int k = 0; k < 2; ++k) dst[n][k] = *(const PG8_LAS bf16x8*)(lds + PG8_SB(b, h) + boff + n * 2048 + k * 1024); } while (0)
#define PG8_MMA(ai, bj, At, Bt) do { __builtin_amdgcn_s_setprio(1); _Pragma("unroll") for (int m = 0; m < 4; ++m) _Pragma("unroll") for (int n = 0; n < 2; ++n) _Pragma("unroll") for (int k = 0; k < 2; ++k) \
        acc[ai][bj][m][n] = __builtin_amdgcn_mfma_f32_16x16x32_bf16(Bt[n][k], At[m][k], acc[ai][bj][m][n], 0, 0, 0); __builtin_amdgcn_s_setprio(0); } while (0)
#define PG8_WAIT_V(n) asm volatile("s_waitcnt vmcnt(" #n ")" ::: "memory")
#define PG8_WAIT_L(n) asm volatile("s_waitcnt lgkmcnt(" #n ")" ::: "memory")
#define PG8_BAR __builtin_amdgcn_s_barrier()
#define PG8_SCHED __builtin_amdgcn_sched_barrier(0)
    Unit cur, nxt; int ui = 0;
    if (!S.next(0, cur)) return;
    f32x4 acc[2][2][4][2];
#pragma unroll
    for (int a = 0; a < 2; ++a)
#pragma unroll
        for (int b = 0; b < 2; ++b)
#pragma unroll
            for (int m = 0; m < 4; ++m)
#pragma unroll
                for (int n = 0; n < 2; ++n) acc[a][b][m][n] = (f32x4){0.f, 0.f, 0.f, 0.f};
    bf16x8 At[4][2], B0[2][2], B1[2][2];
    const char* cA = (const char*)g.A + (size_t)cur.pm * tstep; const char* cB = (const char*)g.Bt + (size_t)cur.pn * tstep;
    S.a_ready(cur);
    if constexpr (SP2) {
        PG8_STAGE(PG8_SB(0, 0), cB, voffB); PG8_STAGE(PG8_SB(0, 1), cB + hstep, voffB); PG8_STAGE(PG8_SA(0, 0), cA, voffA); PG8_STAGE(PG8_SA(0, 1), cA + hstep, voffA);
        if (wr == 1) PG8_BAR;
        PG8_WAIT_V(2); PG8_BAR;
        PG8_STAGE(PG8_SB(1, 0), cB + kstep, voffB); PG8_STAGE(PG8_SA(1, 0), cA + kstep, voffA); PG8_STAGE(PG8_SB(1, 1), cB + hstep + kstep, voffB);
        PG8_WAIT_V(6); PG8_BAR;
    } else {
        PG8_STAGE(PG8_SB(0, 0), cB, voffB); PG8_STAGE(PG8_SA(0, 0), cA, voffA); PG8_STAGE(PG8_SB(0, 1), cB + hstep, voffB); PG8_STAGE(PG8_SA(0, 1), cA + hstep, voffA);
        if (wr == 1) PG8_BAR;
        PG8_WAIT_V(4); PG8_BAR;
        PG8_STAGE(PG8_SB(1, 0), cB + kstep, voffB); PG8_STAGE(PG8_SA(1, 0), cA + kstep, voffA); PG8_STAGE(PG8_SB(1, 1), cB + hstep + kstep, voffB);
        PG8_WAIT_V(6); PG8_BAR;
    }
    for (;;) {
        const bool has_next = S.next(ui + 1, nxt);
        const char* nA = has_next ? (const char*)g.A + (size_t)nxt.pm * tstep : cA; const char* nB = has_next ? (const char*)g.Bt + (size_t)nxt.pn * tstep : cB;
        for (int t = 0; t < nt; t += 2) {
            const bool last = (t == nt - 2);
            const char* a1 = cA + (size_t)(t + 1) * kstep;
            const char* a2 = last ? nA : cA + (size_t)(t + 2) * kstep; const char* b2 = last ? nB : cB + (size_t)(t + 2) * kstep;
            const char* a3 = a2 + kstep; const char* b3 = b2 + kstep;
            if (last && has_next) S.a_ready(nxt);
            if constexpr (SP2) {
            PG8_LDB(B0, 0, 0); PG8_LDB(B1, 0, 1); PG8_SCHED; PG8_LDA(At, 0, 0); PG8_STAGE(PG8_SA(1, 1), a1 + hstep, voffA);
            PG8_WAIT_V(8); PG8_WAIT_L(0); PG8_BAR; PG8_MMA(0, 0, At, B0); PG8_MMA(0, 1, At, B1); PG8_BAR; PG8_SCHED;
            PG8_LDA(At, 0, 1); PG8_STAGE(PG8_SB(0, 0), b2, voffB); PG8_STAGE(PG8_SB(0, 1), b2 + hstep, voffB); PG8_STAGE(PG8_SA(0, 0), a2, voffA);
            PG8_WAIT_V(8); PG8_WAIT_L(0); PG8_BAR; PG8_MMA(1, 0, At, B0); PG8_MMA(1, 1, At, B1); PG8_BAR; PG8_SCHED;
            PG8_LDB(B0, 1, 0); PG8_LDB(B1, 1, 1); PG8_SCHED; PG8_LDA(At, 1, 0); PG8_STAGE(PG8_SA(0, 1), a2 + hstep, voffA);
            PG8_WAIT_V(8); PG8_WAIT_L(0); PG8_BAR; PG8_MMA(0, 0, At, B0); PG8_MMA(0, 1, At, B1); PG8_BAR; PG8_SCHED;
            PG8_LDA(At, 1, 1); PG8_STAGE(PG8_SB(1, 0), b3, voffB); PG8_STAGE(PG8_SB(1, 1), b3 + hstep, voffB); PG8_STAGE(PG8_SA(1, 0), a3, voffA);
            PG8_WAIT_V(8); PG8_WAIT_L(0); PG8_BAR; PG8_MMA(1, 0, At, B0); PG8_MMA(1, 1, At, B1); PG8_BAR; PG8_SCHED;
            } else {
            PG8_LDB(B0, 0, 0); PG8_SCHED; PG8_LDA(At, 0, 0); PG8_STAGE(PG8_SA(1, 1), a1 + hstep, voffA);
            PG8_WAIT_L(8); PG8_BAR; PG8_WAIT_L(0); PG8_MMA(0, 0, At, B0); PG8_BAR; PG8_SCHED;
            PG8_LDB(B1, 0, 1); PG8_STAGE(PG8_SB(0, 0), b2, voffB);
            PG8_BAR; PG8_WAIT_L(0); PG8_MMA(0, 1, At, B1); PG8_BAR;
            PG8_LDA(At, 0, 1); PG8_STAGE(PG8_SA(0, 0), a2, voffA);
            PG8_BAR; PG8_WAIT_L(0); PG8_MMA(1, 0, At, B0); PG8_BAR; PG8_SCHED;
            PG8_STAGE(PG8_SB(0, 1), b2 + hstep, voffB);
            PG8_WAIT_V(6); PG8_BAR; PG8_MMA(1, 1, At, B1); PG8_BAR;
            PG8_LDB(B0, 1, 0); PG8_SCHED; PG8_LDA(At, 1, 0); PG8_STAGE(PG8_SA(0, 1), a2 + hstep, voffA);
            PG8_WAIT_L(8); PG8_BAR; PG8_WAIT_L(0); PG8_MMA(0, 0, At, B0); PG8_BAR; PG8_SCHED;
            PG8_LDB(B1, 1, 1); PG8_STAGE(PG8_SB(1, 0), b3, voffB);
            PG8_BAR; PG8_WAIT_L(0); PG8_MMA(0, 1, At, B1); PG8_BAR;
            PG8_LDA(At, 1, 1); PG8_STAGE(PG8_SA(1, 0), a3, voffA);
            PG8_BAR; PG8_WAIT_L(0); PG8_MMA(1, 0, At, B0); PG8_BAR; PG8_SCHED;
            PG8_STAGE(PG8_SB(1, 1), b3 + hstep, voffB);
            PG8_WAIT_V(6); PG8_BAR; PG8_MMA(1, 1, At, B1); PG8_BAR;
            }
        }
        if constexpr (ALIGN_EPI) { if (wr == 0) PG8_BAR; }
        if constexpr (!Epi::AFTER_DRAIN) { E(acc, cur, wr, wc, fr, fq); S.done(cur); }
        if (!has_next) break;
#pragma unroll
        for (int a = 0; a < 2; ++a)
#pragma unroll
            for (int b = 0; b < 2; ++b)
#pragma unroll
                for (int m = 0; m < 4; ++m)
#pragma unroll
                    for (int n = 0; n < 2; ++n) acc[a][b][m][n] = (f32x4){0.f, 0.f, 0.f, 0.f};
        cur = nxt; cA = nA; cB = nB; ++ui;
        if constexpr (ALIGN_EPI) { if (wr == 1) PG8_BAR; }
    }
    PG8_WAIT_V(0);
    if constexpr (!ALIGN_EPI) { if (wr == 0) PG8_BAR; }
    PG8_BAR;
    if constexpr (Epi::AFTER_DRAIN) { E.fused(acc, cur, wr, wc, fr, fq, lds, wid, lane); S.done(cur); }
#undef PG8_SA
#undef PG8_SB
#undef PG8_STAGE
#undef PG8_LDA
#undef PG8_LDB
#undef PG8_MMA
#undef PG8_WAIT_V
#undef PG8_WAIT_L
#undef PG8_BAR
#undef PG8_SCHED
}
}
#ifndef ZMASK
#define ZMASK 0
#endif
#define ZF(bit) ((ZMASK & (bit)) ? 0.f : 1.f)
using pg8::bf16_t; using pg8::bf16x8; using pg8::f32x4; using pg8::u32x4;
constexpr int NWAVES = 8, NTHR = 512;
constexpr int DM = 1024, TLAT = 8192, TCTX = 256, MLAT = 2 * TLAT, MCTX = 2 * TCTX, MALL = MLAT + MCTX;
constexpr int DIN = 3152, DINP = 3328;
constexpr int C_CH = 0, C_CB = 256, C_CC = 512, C_RR = 768, C_RK = 1024, C_RV = 1280, C_XW = 1536, C_XA = 1552, C_XG = 1568,
              C_AQ = 1600, C_AK = 1856, C_AV = 1984, C_MQ = 2112, C_MK = 2368, C_MV = 2624, C_MO = 2880, C_MG = 3136;
constexpr float EPSN = 1e-6f;
constexpr int NCHK = 66;
constexpr int CST = 4160;
constexpr int RWREC = 4608;
constexpr size_t MiB = 1u << 20;
constexpr size_t WS_CTL = 0, CTL_ZERO_BYTES = 1 * MiB, WS_MOD = 1 * MiB;
constexpr size_t WS_WIN = 2 * MiB, WIN_LSTRIDE = (size_t)DINP * DM * 2;
constexpr size_t WS_WOUT = 16 * MiB, WOUT_LSTRIDE = 2 * MiB;
constexpr size_t WS_WEFF = 20 * MiB, WEFF_LSTRIDE = 4 * MiB;
constexpr size_t WS_XC = 28 * MiB, WS_GA = 30 * MiB, WS_H = 32 * MiB, WS_YCAT = 65 * MiB, WS_U = 98 * MiB, WS_V = 130 * MiB;
constexpr size_t WS_P = 162 * MiB, WS_RW = 270 * MiB, WS_YR = 345 * MiB, WS_QA = 378 * MiB, WS_KA = 387 * MiB;
constexpr size_t WS_LC = 392 * MiB, WS_ST = 409 * MiB, WS_LB = 426 * MiB, WS_EG = 427 * MiB, WS_GB = 444 * MiB, WS_BS = 453 * MiB, WS_SC = 453 * MiB + 512 * 1024, WS_END = 454 * MiB;
constexpr size_t UV_LSTRIDE = 16 * MiB;
constexpr size_t WS_S = WS_P;
static_assert(WS_P + (size_t)MALL * DINP * 2 <= WS_RW && WS_RW + (size_t)MALL * RWREC <= WS_YR && WS_S + (size_t)MALL * 2048 * 4 <= WS_YR, "ws map");
static_assert(WS_LC + (size_t)16 * NCHK * CST * 4 <= WS_ST && WS_ST + (size_t)16 * NCHK * CST * 4 <= WS_LB && WS_EG + (size_t)MALL * 128 * 8 <= WS_GB, "ws map 2");
constexpr int CW_BAR = 4096;
constexpr int RING_BYTES = 131072;
#ifndef U_FP4
#define U_FP4 1
#endif
#ifndef V_FP4
#define V_FP4 1
#endif
constexpr int PEER_WLDS = U_FP4 ? 16 * 528 + 2048 + 512 : 16 * 1040 + 2048 + 512;
constexpr int PHASE_LDS = 8 * PEER_WLDS > RING_BYTES ? 8 * PEER_WLDS : RING_BYTES;
constexpr int LDSCTL_OFF = PHASE_LDS, MISC_OFF = LDSCTL_OFF + 320, LDS_BYTES = PHASE_LDS + 4096;
static_assert(RING_BYTES <= PHASE_LDS && 8 * PEER_WLDS <= PHASE_LDS && LDS_BYTES <= 160 * 1024 && PHASE_LDS % 16 == 0, "LDS map");

#define GAS __attribute__((address_space(1)))
#define LAS __attribute__((address_space(3)))
typedef unsigned u32x2 __attribute__((ext_vector_type(2)));
typedef float f32x2 __attribute__((ext_vector_type(2)));
typedef int i32x8 __attribute__((ext_vector_type(8)));
typedef __bf16 bf16x2_t __attribute__((ext_vector_type(2)));
typedef GAS unsigned gu32;
#define LDS_WAIT() asm volatile("s_waitcnt lgkmcnt(0)" ::: "memory")
#define LDS_BARRIER() do { asm volatile("s_waitcnt lgkmcnt(0)" ::: "memory"); __builtin_amdgcn_s_barrier(); asm volatile("" ::: "memory"); } while (0)

__device__ __forceinline__ float lo2f(unsigned w) { return __uint_as_float(w << 16); }
__device__ __forceinline__ float hi2f(unsigned w) { return __uint_as_float(w & 0xffff0000u); }
__device__ __forceinline__ float bf2f(bf16_t b) { return __uint_as_float((unsigned)b << 16); }
__device__ __forceinline__ unsigned f2bf(float f) { unsigned u = __float_as_uint(f); return (u + 0x7fffu + ((u >> 16) & 1u)) >> 16; }
__device__ __forceinline__ unsigned pk2(float lo, float hi) { const f32x2 v = {lo, hi}; const bf16x2_t b = __builtin_convertvector(v, bf16x2_t); return __builtin_bit_cast(unsigned, b); }
__device__ __forceinline__ f32x4 ld4bf(const bf16_t* p) { const u32x2 w = *(const u32x2*)p; return (f32x4){lo2f(w.x), hi2f(w.x), lo2f(w.y), hi2f(w.y)}; }
__device__ __forceinline__ void st4bf(bf16_t* p, f32x4 v) { u32x2 w; w.x = pk2(v[0], v[1]); w.y = pk2(v[2], v[3]); *(u32x2*)p = w; }
__device__ __forceinline__ float sigmoidf_(float x) { return 1.f / (1.f + __expf(-x)); }
__device__ __forceinline__ float tanhf_(float x) { const float e = __expf(-2.f * fabsf(x)); const float t = (1.f - e) / (1.f + e); return x < 0.f ? -t : t; }
template <int CTRL> __device__ __forceinline__ float dppf(float x) { return __int_as_float(__builtin_amdgcn_update_dpp(0, __float_as_int(x), CTRL, 0xf, 0xf, true)); }
__device__ __forceinline__ float red16(float x) { x += dppf<0xB1>(x); x += dppf<0x4E>(x); x += dppf<0x141>(x); x += dppf<0x140>(x); return x; }
__device__ __forceinline__ float wave_sum(float v) {
#pragma unroll
    for (int o = 1; o < 64; o <<= 1) v += __shfl_xor(v, o);
    return v;
}
#define XB_TMO      128
#define XB_XCNT(j)  (256  + 64 * (j))
#define XB_XSUB(j)  (1280 + 64 * (j))
#define XB_XGEN(j)  (2304 + 64 * (j))
#define XB_TOP      3328
#define XB_TOPGEN   3392
#define XCD_BAR_WORDS 3456
#define XB_SPIN_CAP (1u << 18)
#ifndef XB_SLEEP
#define XB_SLEEP 1
#endif

__device__ __forceinline__ unsigned xb_ld(unsigned* p)              { return __hip_atomic_load(p, __ATOMIC_RELAXED, __HIP_MEMORY_SCOPE_AGENT); }
__device__ __forceinline__ unsigned xb_add(unsigned* p, unsigned v) { return __hip_atomic_fetch_add(p, v, __ATOMIC_RELAXED, __HIP_MEMORY_SCOPE_AGENT); }
__device__ __forceinline__ unsigned xb_xcc_id() { return (unsigned)__builtin_amdgcn_s_getreg((3 << 11) | 20) & 0xFu; }
#define XB_SPIN(cond, bar) do { unsigned _sp = 0; while (cond) { __builtin_amdgcn_s_sleep(XB_SLEEP); \
    if ((++_sp & 255u) == 0u) { if (xb_ld(&(bar)[XB_TMO])) break; if (_sp > XB_SPIN_CAP) { atomicAdd(&(bar)[XB_TMO], 1u); break; } } } } while (0)

struct XcdBarrier {
    unsigned* bar; unsigned x;
    volatile LAS unsigned* st;
};

__device__ __forceinline__ XcdBarrier xcd_barrier_post(unsigned* bar, volatile LAS unsigned* st) {
    XcdBarrier b; b.bar = bar; b.x = xb_xcc_id(); b.st = st;
    if (threadIdx.x == 0) (void)xb_add(&bar[XB_XCNT(b.x)], 1u);
    return b;
}
__device__ __forceinline__ void xcd_barrier_complete(unsigned* bar, unsigned x, unsigned& nloc, unsigned& nx) {
    const unsigned G = gridDim.x * gridDim.y * gridDim.z;
    unsigned sum, cnt, mine, sp = 0u;
    for (;;) {
        sum = 0u; cnt = 0u; mine = 0u;
#pragma unroll
        for (unsigned j = 0; j < 16; ++j) { const unsigned c = xb_ld(&bar[XB_XCNT(j)]); sum += c; cnt += (c > 0u) ? 1u : 0u; mine = (j == x) ? c : mine; }
        if (sum == G) break;
        __builtin_amdgcn_s_sleep(1);
        if ((++sp & 255u) == 0u) { if (xb_ld(&bar[XB_TMO])) break; if (sp > XB_SPIN_CAP) { atomicAdd(&bar[XB_TMO], 1u); break; } }
    }
    nloc = mine > 0u ? mine : 1u; nx = cnt > 0u ? cnt : 1u;
}

__device__ __forceinline__ void xcd_barrier(const XcdBarrier& b) {
    asm volatile("s_waitcnt vmcnt(0)" ::: "memory");
    __syncthreads();
    if (threadIdx.x == 0) {
        unsigned* bar = b.bar;
        __builtin_amdgcn_s_waitcnt(0);
        unsigned nloc = b.st[0], nx = b.st[1];
        if (nloc == 0u) { xcd_barrier_complete(bar, b.x, nloc, nx); b.st[0] = nloc; b.st[1] = nx; }
        const unsigned old = xb_add(&bar[XB_XSUB(b.x)], 1u);
        const unsigned gen = old / nloc;
        if (old + 1u == (gen + 1u) * nloc) {
            __builtin_amdgcn_fence(__ATOMIC_RELEASE, "agent");
            asm volatile("s_waitcnt vmcnt(0)" ::: "memory");
            const unsigned og = xb_add(&bar[XB_TOP], 1u);
            const unsigned tg = og / nx;
            if (og + 1u == (tg + 1u) * nx) xb_add(&bar[XB_TOPGEN], 1u);
            else XB_SPIN(xb_ld(&bar[XB_TOPGEN]) == tg, bar);
            __builtin_amdgcn_fence(__ATOMIC_ACQUIRE, "agent");
            xb_add(&bar[XB_XGEN(b.x)], 1u);
            asm volatile("s_waitcnt vmcnt(0)" ::: "memory");
        } else {
            XB_SPIN(xb_ld(&bar[XB_XGEN(b.x)]) == gen, bar);
            __builtin_amdgcn_fence(__ATOMIC_ACQUIRE, "agent");
            asm volatile("s_waitcnt vmcnt(0)" ::: "memory");
        }
    }
    __syncthreads();
}
struct Ctx {
    LAS unsigned char* lds; int tid, lane, wave, vcu, G;
    const float* in[32]; float* out; unsigned char* ws;
};
#define WSP(T, off) ((T*)(F.ws + (off)))

__device__ __forceinline__ void p0_transpose_item(const float* W, int K, int N, bf16_t* WT, LAS float* scr, int item, int lane) {
    const int nblk = (N + 31) / 32, kb = item / nblk, nb = item % nblk, k0 = 64 * kb, n0 = 32 * nb;
    const int nn = n0 + (lane & 31);
#pragma unroll 8
    for (int i = 0; i < 32; ++i) { const int kk = 2 * i + (lane >> 5); scr[kk * 33 + (lane & 31)] = nn < N ? W[(size_t)(k0 + kk) * N + nn] : 0.f; }
    LDS_WAIT(); asm volatile("" ::: "memory");
    const int c = lane & 7;
#pragma unroll
    for (int j = 0; j < 4; ++j) { const int n = (lane >> 3) + 8 * j; const LAS float* s = scr + (8 * c) * 33 + n;
        u32x4 o; o.x = pk2(s[0 * 33], s[1 * 33]); o.y = pk2(s[2 * 33], s[3 * 33]); o.z = pk2(s[4 * 33], s[5 * 33]); o.w = pk2(s[6 * 33], s[7 * 33]);
        *(u32x4*)(WT + (size_t)(n0 + n) * K + k0 + 8 * c) = o; }
    LDS_WAIT(); asm volatile("" ::: "memory");
}
__device__ __forceinline__ void convert_uv_rows(const Ctx& F, int l, int r_lo, int r_hi, int widx, int nworkers) {
    float* SC = WSP(float, WS_SC) + (size_t)l * 2 * 16384;
    for (int r0 = r_lo + widx; r0 < r_hi; r0 += 4 * nworkers) {
        f32x4 v[4][4];
#pragma unroll
        for (int u = 0; u < 4; ++u) { const int r = r0 + u * nworkers < r_hi ? r0 + u * nworkers : r0; const int tb = r >> 14, row = r & 16383;
            const float* src = (tb ? F.in[31] : F.in[30]) + ((size_t)l * 16384 + row) * 1024 + F.lane * 16;
#pragma unroll
            for (int j = 0; j < 4; ++j) v[u][j] = *(const f32x4*)(src + 4 * j); }
#pragma unroll
        for (int u = 0; u < 4; ++u) { const int r = r0 + u * nworkers; if (r >= r_hi) break; const int tb = r >> 14, row = r & 16383;
            float am = 0.f;
#pragma unroll
            for (int j = 0; j < 4; ++j) am = fmaxf(am, fmaxf(fmaxf(fabsf(v[u][j][0]), fabsf(v[u][j][1])), fmaxf(fabsf(v[u][j][2]), fabsf(v[u][j][3]))));
#pragma unroll
            for (int o = 1; o < 64; o <<= 1) am = fmaxf(am, __shfl_xor(am, o));
            if (tb ? V_FP4 : U_FP4) {
            const float sc = am > 0.f ? 6.f / am : 1.f;
            unsigned ow[2] = {0u, 0u};
#pragma unroll
            for (int j = 0; j < 4; ++j) { unsigned w = ow[j >> 1];
                if (j & 1) { w = __builtin_amdgcn_cvt_scalef32_pk_fp4_f32(w, v[u][j][0] * sc, v[u][j][1] * sc, 1.0f, 2); w = __builtin_amdgcn_cvt_scalef32_pk_fp4_f32(w, v[u][j][2] * sc, v[u][j][3] * sc, 1.0f, 3); }
                else       { w = __builtin_amdgcn_cvt_scalef32_pk_fp4_f32(w, v[u][j][0] * sc, v[u][j][1] * sc, 1.0f, 0); w = __builtin_amdgcn_cvt_scalef32_pk_fp4_f32(w, v[u][j][2] * sc, v[u][j][3] * sc, 1.0f, 1); }
                ow[j >> 1] = w; }
            *(u32x2*)(F.ws + (tb ? WS_V : WS_U) + (size_t)l * UV_LSTRIDE + (size_t)row * 512 + F.lane * 8) = (u32x2){ow[0], ow[1]};
            if (F.lane == 0) SC[tb * 16384 + row] = am > 0.f ? am * (1.f / 6.f) : 1.f;
            } else {
            const float sc = am > 0.f ? 448.f / am : 1.f;
            unsigned ow[4];
#pragma unroll
            for (int j = 0; j < 4; ++j) { int w = __builtin_amdgcn_cvt_pk_fp8_f32(v[u][j][0] * sc, v[u][j][1] * sc, 0, false); w = __builtin_amdgcn_cvt_pk_fp8_f32(v[u][j][2] * sc, v[u][j][3] * sc, w, true); ow[j] = (unsigned)w; }
            *(u32x4*)(F.ws + (tb ? WS_V : WS_U) + (size_t)l * UV_LSTRIDE + (size_t)row * 1024 + F.lane * 16) = (u32x4){ow[0], ow[1], ow[2], ow[3]};
            if (F.lane == 0) SC[tb * 16384 + row] = am > 0.f ? am * (1.f / 448.f) : 1.f;
            } }
    }
}
__device__ __forceinline__ void convert_uv(const Ctx& F, int l) { convert_uv_rows(F, l, 0, 2 * 16384, F.vcu * NWAVES + F.wave, F.G * NWAVES); }
__device__ __forceinline__ void phase_prologue(const Ctx& F) {
    float* MOD = WSP(float, WS_MOD);
    {
        LAS float* sl = (LAS float*)F.lds; LAS float* red = sl + 3072;
        for (int it = F.vcu; it < 192; it += F.G) {
            const int l = it / 96, n0 = (it % 96) * 64;
            for (int i = F.tid; i < 3072; i += NTHR) { const int s = i >> 10, k = i & 1023; const float c = s < 2 ? F.in[1][s * 1024 + k] : F.in[3][k]; sl[i] = c / (1.f + __expf(-c)); }
            __syncthreads();
            const int c = F.tid & 63, kg = F.tid >> 6;
            const float* W = F.in[4] + (size_t)l * 1024 * 6144 + n0 + c;
            float a0 = 0.f, a1 = 0.f, a2 = 0.f;
#pragma unroll 32
            for (int k = kg * 128; k < kg * 128 + 128; ++k) { const float w = W[(size_t)k * 6144]; a0 += sl[k] * w; a1 += sl[1024 + k] * w; a2 += sl[2048 + k] * w; }
            red[(kg * 3 + 0) * 64 + c] = a0; red[(kg * 3 + 1) * 64 + c] = a1; red[(kg * 3 + 2) * 64 + c] = a2;
            __syncthreads();
            if (F.tid < 192) { const int s = F.tid >> 6, cc = F.tid & 63; float t = F.in[5][l * 6144 + n0 + cc];
#pragma unroll
                for (int g = 0; g < 8; ++g) t += red[(g * 3 + s) * 64 + cc];
                MOD[(l * 3 + s) * 6144 + n0 + cc] = t; }
            __syncthreads();
        }
    }
    {
        LAS float* scr = (LAS float*)(F.lds + F.wave * 16384);
        const int gw = F.vcu * NWAVES + F.wave, NGW = F.G * NWAVES;
        constexpr int I_IN = 16 * 99, I_OUT = 16 * 32, I_L = I_IN + I_OUT;
        for (int it = gw; it < 2 * I_L; it += NGW) {
            const int l = it / I_L; int r = it % I_L;
            if (r < I_IN) p0_transpose_item(F.in[8] + (size_t)l * DM * DIN, DM, DIN, WSP(bf16_t, WS_WIN + l * WIN_LSTRIDE), scr, r, F.lane);
            else p0_transpose_item(F.in[9] + (size_t)l * DM * DM, DM, DM, WSP(bf16_t, WS_WOUT + l * WOUT_LSTRIDE), scr, r - I_IN, F.lane);
        }
        for (int i = F.vcu * NTHR + F.tid; i < 2 * 160 * 128; i += F.G * NTHR) { const int l = i / (160 * 128), r = i % (160 * 128);
            *(u32x4*)(WSP(bf16_t, WS_WIN + l * WIN_LSTRIDE) + (size_t)3168 * DM + (size_t)r * 8) = (u32x4){0u, 0u, 0u, 0u}; }
    }
    __syncthreads();
    {
        LAS float* KEYS = (LAS float*)F.lds; LAS float* WQl = KEYS + 128 * 129;
        const int nper = F.G / 32 > 0 ? F.G / 32 : 1;
        const int tile = F.vcu / nper, sub = F.vcu % nper;
        if (tile < 32) {
            const int l = tile >> 4, hh = tile & 15;
            const float* ksrc = F.in[29] + ((size_t)l * 16 + hh) * 128 * 128;
            { f32x4 kv[8];
#pragma unroll
              for (int q = 0; q < 8; ++q) kv[q] = *(const f32x4*)(ksrc + (size_t)(F.tid + q * NTHR) * 4);
#pragma unroll
              for (int q = 0; q < 8; ++q) { const int i = (F.tid + q * NTHR) * 4; LAS float* d = KEYS + (i >> 7) * 129 + (i & 127); d[0] = kv[q][0]; d[1] = kv[q][1]; d[2] = kv[q][2]; d[3] = kv[q][3]; } }
            for (int kb = sub; kb < 16; kb += nper) {
                const float* wsrc = F.in[28] + (size_t)l * DM * 2048 + (size_t)(kb * 64) * 2048 + hh * 128;
                __syncthreads();
                { f32x4 wv[4];
#pragma unroll
                  for (int q = 0; q < 4; ++q) { const int i = (F.tid + q * NTHR) * 4; wv[q] = *(const f32x4*)(wsrc + (size_t)(i >> 7) * 2048 + (i & 127)); }
#pragma unroll
                  for (int q = 0; q < 4; ++q) { const int i = (F.tid + q * NTHR) * 4, kk = i >> 7, d = i & 127; WQl[d * 68 + kk] = wv[q][0]; WQl[(d + 1) * 68 + kk] = wv[q][1]; WQl[(d + 2) * 68 + kk] = wv[q][2]; WQl[(d + 3) * 68 + kk] = wv[q][3]; } }
                __syncthreads();
                const int key = F.tid & 127, kq = F.tid >> 7;
                float acc[16];
#pragma unroll
                for (int j = 0; j < 16; ++j) acc[j] = 0.f;
#pragma unroll 4
                for (int d = 0; d < 128; ++d) { const float a = KEYS[key * 129 + d]; const LAS f32x4* wq = (const LAS f32x4*)(WQl + d * 68 + kq * 16);
#pragma unroll
                    for (int q = 0; q < 4; ++q) { const f32x4 w = wq[q]; acc[4 * q] += a * w[0]; acc[4 * q + 1] += a * w[1]; acc[4 * q + 2] += a * w[2]; acc[4 * q + 3] += a * w[3]; } }
                bf16_t* dst = WSP(bf16_t, WS_WEFF + l * WEFF_LSTRIDE) + (size_t)(hh * 128 + key) * DM + kb * 64 + kq * 16;
                u32x4 o0, o1; o0.x = pk2(acc[0], acc[1]); o0.y = pk2(acc[2], acc[3]); o0.z = pk2(acc[4], acc[5]); o0.w = pk2(acc[6], acc[7]);
                o1.x = pk2(acc[8], acc[9]); o1.y = pk2(acc[10], acc[11]); o1.z = pk2(acc[12], acc[13]); o1.w = pk2(acc[14], acc[15]);
                *(u32x4*)dst = o0; *(u32x4*)(dst + 8) = o1;
            }
        }
        __syncthreads();
    }
    convert_uv(F, 0); convert_uv(F, 1);
}

__device__ __forceinline__ void phase_norm(const Ctx& F, int l, int which, int nrows, const float* xlat, const float* xctx) {
    const float* gain = F.in[6 + which] + l * DM; const float* mod = WSP(float, WS_MOD) + (size_t)l * 3 * 6144;
    const int shoff = which ? 3072 : 0, scoff = which ? 4096 : 1024;
    bf16_t* H = WSP(bf16_t, WS_H);
    const int gw = F.vcu * NWAVES + F.wave, NGW = F.G * NWAVES;
    for (int row = gw; row < nrows; row += NGW) {
        const bool isc = row >= MLAT; const float* src = isc ? xctx + (size_t)(row - MLAT) * DM : xlat + (size_t)row * DM; const int smp = isc ? 2 : (row >> 13);
        const float* mb = mod + smp * 6144;
        f32x4 v[4]; float ss = 0.f;
#pragma unroll
        for (int j = 0; j < 4; ++j) { v[j] = *(const f32x4*)(src + F.lane * 4 + 256 * j); ss += (v[j][0] * v[j][0] + v[j][1] * v[j][1]) + (v[j][2] * v[j][2] + v[j][3] * v[j][3]); }
        const float rs = rsqrtf(wave_sum(ss) * (1.f / DM) + EPSN);
#pragma unroll
        for (int j = 0; j < 4; ++j) { const int c = F.lane * 4 + 256 * j; const f32x4 g = *(const f32x4*)(gain + c), sc = *(const f32x4*)(mb + scoff + c), sh = *(const f32x4*)(mb + shoff + c);
            const f32x4 o = (v[j] * rs * g) * (1.f + sc) + sh; st4bf(H + (size_t)row * DM + c, o); }
    }
}

__device__ __forceinline__ float log_sigmoid_(float x) { return fminf(x, 0.f) - __logf(1.f + __expf(-fabsf(x))); }
__device__ __forceinline__ void phase_prep(const Ctx& F, int l) {
    LAS float* W2s = (LAS float*)F.lds; LAS float* A2s = W2s + 8192; LAS float* G2s = A2s + 8192; LAS float* tsc = G2s + 8192 + F.wave * 64;
    { const float* w2 = F.in[13] + l * 8192; const float* a2 = F.in[15] + l * 8192; const float* g2 = F.in[16] + l * 8192;
      for (int i = F.tid; i < 8192; i += NTHR) { W2s[i] = w2[i]; A2s[i] = a2[i]; G2s[i] = g2[i]; } }
    __syncthreads();
    const bf16_t* P = WSP(bf16_t, WS_P); bf16_t* YC = WSP(bf16_t, WS_YCAT); bf16_t* QA = WSP(bf16_t, WS_QA); bf16_t* KA = WSP(bf16_t, WS_KA);
    unsigned char* RW = WSP(unsigned char, WS_RW); bf16_t* GB = WSP(bf16_t, WS_GB); float* BS = WSP(float, WS_BS); float* GA = WSP(float, WS_GA);
    const int lane = F.lane, c4 = lane * 4, i16 = lane & 15;
    const f32x4 cw0 = *(const f32x4*)(F.in[10] + l * 768 + c4), cw1 = *(const f32x4*)(F.in[10] + l * 768 + 256 + c4), cw2 = *(const f32x4*)(F.in[10] + l * 768 + 512 + c4);
    const f32x4 cg = *(const f32x4*)(F.in[11] + l * 256 + c4);
    const f32x4 qg = *(const f32x4*)(F.in[21] + l * 64 + (c4 & 63)), kg = *(const f32x4*)(F.in[22] + l * 64 + (c4 & 63));
    const f32x4 k_k = *(const f32x4*)(F.in[17] + l * 256 + c4), k_a = *(const f32x4*)(F.in[18] + l * 256 + c4), r_k = *(const f32x4*)(F.in[19] + l * 256 + c4);
    f32x4 w0[2], a0[2];
#pragma unroll
    for (int d = 0; d < 2; ++d) { w0[d] = *(const f32x4*)(F.in[12] + (l * 2 + d) * 256 + c4); a0[d] = *(const f32x4*)(F.in[14] + (l * 2 + d) * 256 + c4); }
    float invf[4];
#pragma unroll
    for (int j = 0; j < 4; ++j) invf[j] = exp2f(-(float)((c4 + j) & 15) * (13.287712379549449f / 16.f));
    const int gw = F.vcu * NWAVES + F.wave, NGW = F.G * NWAVES;
    struct PrepRaw { u32x2 h1, bg, c1, hp, cp, hn, cn, q, k, r, rk; unsigned xv, mg; };
#define PREP_LOAD(dst, row_) do { const int r_ = (row_); const bool isc_ = r_ >= MLAT; const int t_ = isc_ ? ((r_ - MLAT) & 255) : (r_ & 8191); const int T_ = isc_ ? TCTX : TLAT; \
        const bf16_t* pr_ = P + (size_t)r_ * DINP; const bf16_t* pp_ = t_ > 0 ? pr_ - DINP : pr_; const bf16_t* pn_ = t_ < T_ - 1 ? pr_ + DINP : pr_; \
        dst.h1 = *(const u32x2*)(pr_ + C_CH + c4); dst.bg = *(const u32x2*)(pr_ + C_CB + c4); dst.c1 = *(const u32x2*)(pr_ + C_CC + c4); \
        dst.hp = *(const u32x2*)(pp_ + C_CH + c4); dst.cp = *(const u32x2*)(pp_ + C_CC + c4); dst.hn = *(const u32x2*)(pn_ + C_CH + c4); dst.cn = *(const u32x2*)(pn_ + C_CC + c4); \
        dst.q = *(const u32x2*)(pr_ + C_AQ + c4); dst.k = *(const u32x2*)(pr_ + C_AK + (c4 & 127)); dst.r = *(const u32x2*)(pr_ + C_RR + c4); dst.rk = *(const u32x2*)(pr_ + C_RK + c4); \
        dst.xv = pr_[C_XW + lane]; dst.mg = pr_[C_MG + (lane & 15)]; } while (0)
#define UP4(w_) ((f32x4){lo2f((w_).x), hi2f((w_).x), lo2f((w_).y), hi2f((w_).y)})
    PrepRaw cur, nxt;
    if (gw < MALL) PREP_LOAD(cur, gw);
    for (int row = gw; row < MALL; row += NGW) {
        const bool isc = row >= MLAT; const int t = isc ? ((row - MLAT) & 255) : (row & 8191); const int T = isc ? TCTX : TLAT;
        { const int rn = row + NGW < MALL ? row + NGW : row; PREP_LOAD(nxt, rn); }
        {
            const f32x4 h1 = UP4(cur.h1), bg = UP4(cur.bg), c1 = UP4(cur.c1);
            f32x4 up = UP4(cur.hp) * UP4(cur.cp), un = UP4(cur.hn) * UP4(cur.cn);
            if (t == 0) up = (f32x4){0.f, 0.f, 0.f, 0.f};
            if (t == T - 1) un = (f32x4){0.f, 0.f, 0.f, 0.f};
            const f32x4 y = bg * (cw0 * up + cw1 * (c1 * h1) + cw2 * un);
            const float ss = red16((y[0] * y[0] + y[1] * y[1]) + (y[2] * y[2] + y[3] * y[3]));
            const float rs = rsqrtf(ss * (1.f / 64.f) + EPSN);
            st4bf(YC + (size_t)row * DM + c4, y * rs * cg * ZF(2));
        }
        {
            const f32x4 q = UP4(cur.q); const f32x4 k = UP4(cur.k);
            const float qs = red16((q[0] * q[0] + q[1] * q[1]) + (q[2] * q[2] + q[3] * q[3]));
            const float ks = red16((k[0] * k[0] + k[1] * k[1]) + (k[2] * k[2] + k[3] * k[3]));
            f32x4 qn = q * rsqrtf(qs * (1.f / 64.f) + EPSN) * qg, kn = k * rsqrtf(ks * (1.f / 64.f) + EPSN) * kg;
            if (!isc) {
                f32x4 qp, kp;
#pragma unroll
                for (int j = 0; j < 4; ++j) { qp[j] = __shfl_xor(qn[j], 4); kp[j] = __shfl_xor(kn[j], 4); }
                const int d0 = c4 & 63; const float pos = (d0 < 32) ? (float)(t >> 6) : (float)(t & 63); const bool lowh = (d0 & 16) == 0;
#pragma unroll
                for (int j = 0; j < 4; ++j) { const float th = pos * invf[j]; const float cs = __cosf(th), sn = __sinf(th);
                    qn[j] = lowh ? qn[j] * cs - qp[j] * sn : qn[j] * cs + qp[j] * sn; kn[j] = lowh ? kn[j] * cs - kp[j] * sn : kn[j] * cs + kp[j] * sn; }
            }
            st4bf(QA + (size_t)row * 256 + c4, qn * (0.125f * 1.4426950408889634f));
            if (lane < 32) st4bf(KA + (size_t)row * 128 + c4, kn);
        }
        {
            const f32x4 r = UP4(cur.r), k = UP4(cur.rk);
            { const float xv = bf2f((bf16_t)cur.xv);
              tsc[lane] = lane < 16 ? tanhf_(xv) : (lane < 32 ? xv : sigmoidf_(xv)); }
            const f32x4 kx = k * k_k;
            const float kss = red16((kx[0] * kx[0] + kx[1] * kx[1]) + (kx[2] * kx[2] + kx[3] * kx[3]));
            const f32x4 kk = kx * rsqrtf(kss + EPSN);
            bf16_t* recb = (bf16_t*)(RW + (size_t)row * RWREC); float* recf = (float*)(RW + (size_t)row * RWREC + 2560);
            st4bf(recb + c4, kk);
            f32x4 kdsum = {0.f, 0.f, 0.f, 0.f};
#pragma unroll
            for (int d = 0; d < 2; ++d) {
                f32x4 dw = w0[d], da = a0[d];
#pragma unroll 4
                for (int ii = 0; ii < 16; ++ii) { dw += tsc[ii] * *(const LAS f32x4*)(W2s + (d * 16 + ii) * 256 + c4); da += tsc[16 + ii] * *(const LAS f32x4*)(A2s + (d * 16 + ii) * 256 + c4); }
                f32x4 dec, av;
#pragma unroll
                for (int j = 0; j < 4; ++j) { dec[j] = -0.6065306597126334f * sigmoidf_(dw[j]); av[j] = sigmoidf_(da[j]); }
                const f32x4 kd = k * (1.f + (av - 1.f) * k_a);
                kdsum += kd;
                st4bf(recb + 256 + d * 256 + c4, kk * av);
                st4bf(recb + 768 + d * 256 + c4, kd);
                *(f32x4*)(recf + d * 256 + c4) = dec;
            }
            f32x4 gv = {0.f, 0.f, 0.f, 0.f};
#pragma unroll 4
            for (int ii = 0; ii < 32; ++ii) gv += tsc[32 + ii] * *(const LAS f32x4*)(G2s + ii * 256 + c4);
            st4bf(GB + (size_t)row * 256 + c4, gv);
            const f32x4 bt = r * kdsum * r_k;
            const float bsum = red16((bt[0] + bt[1]) + (bt[2] + bt[3]));
            if (i16 == 0) BS[(size_t)row * 4 + (lane >> 4)] = bsum;
        }
        if (lane < 16) { const int dir = lane >> 3, gate = (lane >> 2) & 1, hd = lane & 3; const float x = bf2f((bf16_t)cur.mg);
            const float bias = gate ? F.in[26][(l * 2 + dir) * 4 + hd] : F.in[25][(l * 2 + dir) * 4 + hd];
            GA[(size_t)row * 16 + lane] = gate ? log_sigmoid_(x + bias) : (x + bias); }
        cur = nxt;
    }
#undef PREP_LOAD
#undef UP4
}
__device__ __forceinline__ int scan_row(int b, int dir, int i) {
    if (i < TCTX) return MLAT + b * TCTX + (dir ? (TCTX - 1 - i) : i);
    const int p = i - TCTX; return b * TLAT + (dir ? (TLAT - 1 - p) : p);
}
__device__ __forceinline__ void rwkv_scan(const Ctx& F, int blk) {
    const int chain = blk >> 2, quarter = blk & 3, b = chain >> 3, head = (chain >> 1) & 3, dir = chain & 1;
    const bool scanner = F.wave < 4;
    const int rowv = (quarter * 4 + (F.wave & 3)) * 4 + (F.lane >> 4), s = F.lane & 15;
    LAS float* buf = (LAS float*)F.lds;
    const bf16_t* P = WSP(bf16_t, WS_P); const unsigned char* RW = WSP(unsigned char, WS_RW); float* YR = WSP(float, WS_YR) + (size_t)dir * MALL * 256;
    const int st = F.tid >> 4, sub = F.tid & 15;
    constexpr int NSTEP = TCTX + TLAT, NCH = NSTEP / 32;
    u32x2 g_kk, g_al, g_kd, g_r, g_v; f32x4 g_w;
#define RW_LOAD(c) do { const int row_ = scan_row(b, dir, (c) * 32 + st); const bf16_t* rb_ = (const bf16_t*)(RW + (size_t)row_ * RWREC) + head * 64 + sub * 4; \
        g_kk = *(const u32x2*)rb_; g_al = *(const u32x2*)(rb_ + 256 + dir * 256); g_kd = *(const u32x2*)(rb_ + 768 + dir * 256); \
        g_w = *(const f32x4*)((const float*)(RW + (size_t)row_ * RWREC + 2560) + dir * 256 + head * 64 + sub * 4); \
        const bf16_t* pp_ = P + (size_t)row_ * DINP + head * 64 + sub * 4; g_r = *(const u32x2*)(pp_ + C_RR); g_v = *(const u32x2*)(pp_ + C_RV); } while (0)
#define RW_STORE(par) do { LAS float* d_ = buf + ((par) * 32 + st) * 384 + sub * 4; \
        *(LAS f32x4*)(d_) = (f32x4){lo2f(g_kk.x), hi2f(g_kk.x), lo2f(g_kk.y), hi2f(g_kk.y)}; *(LAS f32x4*)(d_ + 64) = (f32x4){lo2f(g_al.x), hi2f(g_al.x), lo2f(g_al.y), hi2f(g_al.y)}; \
        *(LAS f32x4*)(d_ + 128) = (f32x4){lo2f(g_kd.x), hi2f(g_kd.x), lo2f(g_kd.y), hi2f(g_kd.y)}; *(LAS f32x4*)(d_ + 192) = g_w; \
        *(LAS f32x4*)(d_ + 256) = (f32x4){lo2f(g_r.x), hi2f(g_r.x), lo2f(g_r.y), hi2f(g_r.y)}; *(LAS f32x4*)(d_ + 320) = (f32x4){lo2f(g_v.x), hi2f(g_v.x), lo2f(g_v.y), hi2f(g_v.y)}; } while (0)
    f32x4 S = {0.f, 0.f, 0.f, 0.f};
    RW_LOAD(0); RW_STORE(0); __syncthreads();
    for (int c = 0; c < NCH; ++c) {
        const int par = c & 1;
        if (c + 1 < NCH) RW_LOAD(c + 1);
        if (scanner) {
        float ykeep = 0.f;
        f32x4 Lkk[3], Lal[3], Lkd[3], Lw[3], Lr[3]; float Lv[3];
#define SC_LD(set, i_) do { const LAS float* d_ = buf + (par * 32 + (i_)) * 384; Lkk[set] = *(const LAS f32x4*)(d_ + s * 4); Lal[set] = *(const LAS f32x4*)(d_ + 64 + s * 4); \
            Lkd[set] = *(const LAS f32x4*)(d_ + 128 + s * 4); Lw[set] = *(const LAS f32x4*)(d_ + 192 + s * 4); Lr[set] = *(const LAS f32x4*)(d_ + 256 + s * 4); Lv[set] = d_[320 + rowv]; } while (0)
        SC_LD(0, 0); SC_LD(1, 1);
#pragma unroll
        for (int i = 0; i < 32; ++i) {
            if (i + 2 < 32) SC_LD((i + 2) % 3, i + 2);
            const f32x4 kk = Lkk[i % 3], al = Lal[i % 3], kd = Lkd[i % 3], w = Lw[i % 3], r = Lr[i % 3]; const float vr = Lv[i % 3];
            const float sa = red16((S[0] * kk[0] + S[1] * kk[1]) + (S[2] * kk[2] + S[3] * kk[3]));
            S = S * w + (vr * kd - sa * al);
            const float y = red16((S[0] * r[0] + S[1] * r[1]) + (S[2] * r[2] + S[3] * r[3]));
            ykeep = (s == (i & 15)) ? y : ykeep;
            if ((i & 15) == 15) {
                const int stp = c * 32 + (i - 15) + s; const int pc = dir ? (TCTX - 1 - stp) : stp, pl = dir ? (TLAT - 1 - (stp - TCTX)) : (stp - TCTX);
                const int row = stp < TCTX ? (MLAT + b * TCTX + pc) : (b * TLAT + pl);
                YR[(size_t)row * 256 + head * 64 + rowv] = ykeep; }
        }
#undef SC_LD
        }
        if (c + 1 < NCH) RW_STORE(par ^ 1);
        __syncthreads();
    }
#undef RW_LOAD
#undef RW_STORE
}

typedef union { u32x4 u; bf16x8 b; } frag_u;
__device__ __forceinline__ void attn_unit(const Ctx& F, int l, int unit) {
    LAS bf16_t* Kl = (LAS bf16_t*)F.lds; LAS bf16_t* Vt = Kl + 64 * 72;
    const bf16_t* P = WSP(bf16_t, WS_P); const bf16_t* QA = WSP(bf16_t, WS_QA); const bf16_t* KA = WSP(bf16_t, WS_KA); bf16_t* YC = WSP(bf16_t, WS_YCAT);
    const bool isc = unit >= 256; int b, kvh, n;
    if (!isc) { b = unit >> 7; kvh = (unit >> 6) & 1; n = unit & 63; } else { const int u = unit - 256; b = u >> 2; kvh = (u >> 1) & 1; n = u & 1; }
    const int g = F.wave >> 2, ps = F.wave & 3, head = kvh * 2 + g, i = F.lane & 15, gq = F.lane >> 4;
    const int qpos0 = n * 128 + ps * 32, qrow0 = (isc ? MLAT + b * TCTX : b * TLAT) + qpos0;
    bf16x8 Qf[2][2];
#pragma unroll
    for (int qb = 0; qb < 2; ++qb)
#pragma unroll
        for (int ks = 0; ks < 2; ++ks) Qf[qb][ks] = *(const bf16x8*)(QA + (size_t)(qrow0 + qb * 16 + i) * 256 + head * 64 + ks * 32 + gq * 8);
    const float sinkl = F.in[23][l * 4 + head] * 1.4426950408889634f;
    float mrun[2] = {sinkl, sinkl}, lsum[2]; lsum[0] = lsum[1] = (gq == 0) ? 1.f : 0.f;
    f32x4 ao[4][2];
#pragma unroll
    for (int db = 0; db < 4; ++db) { ao[db][0] = (f32x4){0.f, 0.f, 0.f, 0.f}; ao[db][1] = (f32x4){0.f, 0.f, 0.f, 0.f}; }
    const int ntl = isc ? 4 : 10;
    const int skey = F.tid >> 3, sch = F.tid & 7;
#define ATT_KROW(tt_) ((!isc && (tt_) < 6) ? ((2 * (n - 1) + (tt_) < 0 || 2 * (n - 1) + (tt_) >= 128) ? -1 : b * TLAT + (2 * (n - 1) + (tt_)) * 64) : MLAT + b * TCTX + (isc ? (tt_) : (tt_) - 6) * 64)
#define ATT_LOAD(tt_) do { const int kr_ = ATT_KROW(tt_); if (kr_ >= 0) { pk_kv = *(const u32x4*)(KA + (size_t)(kr_ + skey) * 128 + kvh * 64 + sch * 8); pk_vv = *(const u32x4*)(P + (size_t)(kr_ + skey) * DINP + C_AV + kvh * 64 + sch * 8); } } while (0)
    u32x4 pk_kv = {0u, 0u, 0u, 0u}, pk_vv = {0u, 0u, 0u, 0u};
    int tt0 = 0; while (tt0 < ntl && ATT_KROW(tt0) < 0) ++tt0;
    ATT_LOAD(tt0);
    for (int tt = tt0; tt < ntl; ++tt) {
        const int krow0 = ATT_KROW(tt); if (krow0 < 0) continue;
        const bool band = !isc && tt < 6; const int kpos0 = band ? (2 * (n - 1) + tt) * 64 : 0;
        LDS_BARRIER();
        { const u32x4 kv = pk_kv, vv = pk_vv;
          *(LAS u32x4*)(Kl + skey * 72 + sch * 8) = kv;
          const unsigned ww[4] = {vv.x, vv.y, vv.z, vv.w};
#pragma unroll
          for (int j = 0; j < 4; ++j) { Vt[(sch * 8 + 2 * j) * 72 + skey] = (bf16_t)(ww[j] & 0xffffu); Vt[(sch * 8 + 2 * j + 1) * 72 + skey] = (bf16_t)(ww[j] >> 16); } }
        { int tn = tt + 1; while (tn < ntl && ATT_KROW(tn) < 0) ++tn; if (tn < ntl) ATT_LOAD(tn); }
        LDS_BARRIER();
        f32x4 sc[4][2];
#pragma unroll
        for (int kb = 0; kb < 4; ++kb) {
            sc[kb][0] = (f32x4){0.f, 0.f, 0.f, 0.f}; sc[kb][1] = (f32x4){0.f, 0.f, 0.f, 0.f};
#pragma unroll
            for (int ks = 0; ks < 2; ++ks) { const bf16x8 kf = *(const LAS bf16x8*)(Kl + (kb * 16 + i) * 72 + ks * 32 + gq * 8);
                sc[kb][0] = __builtin_amdgcn_mfma_f32_16x16x32_bf16(kf, Qf[0][ks], sc[kb][0], 0, 0, 0);
                sc[kb][1] = __builtin_amdgcn_mfma_f32_16x16x32_bf16(kf, Qf[1][ks], sc[kb][1], 0, 0, 0); }
        }
#pragma unroll
        for (int qb = 0; qb < 2; ++qb) {
            const int qp = qpos0 + qb * 16 + i;
            float mx = -1e30f;
#pragma unroll
            for (int kb = 0; kb < 4; ++kb)
#pragma unroll
                for (int r = 0; r < 4; ++r) { if (band) { const int dd = (kpos0 + kb * 16 + 4 * gq + r) - qp; if (dd > 128 || dd < -128) sc[kb][qb][r] = -1e30f; } mx = fmaxf(mx, sc[kb][qb][r]); }
            mx = fmaxf(mx, __shfl_xor(mx, 16)); mx = fmaxf(mx, __shfl_xor(mx, 32));
            const float mnew = fmaxf(mrun[qb], mx), alpha = exp2f(mrun[qb] - mnew); mrun[qb] = mnew;
            float ps_ = 0.f;
#pragma unroll
            for (int kb = 0; kb < 4; ++kb)
#pragma unroll
                for (int r = 0; r < 4; ++r) { const float p = exp2f(sc[kb][qb][r] - mnew); sc[kb][qb][r] = p; ps_ += p; }
            lsum[qb] = lsum[qb] * alpha + ps_;
#pragma unroll
            for (int db = 0; db < 4; ++db) ao[db][qb] *= alpha;
        }
#pragma unroll
        for (int ks2 = 0; ks2 < 2; ++ks2) {
            frag_u pf[2];
#pragma unroll
            for (int qb = 0; qb < 2; ++qb) { pf[qb].u.x = pg8::cvt_pk_bf16(sc[2 * ks2][qb][0], sc[2 * ks2][qb][1]); pf[qb].u.y = pg8::cvt_pk_bf16(sc[2 * ks2][qb][2], sc[2 * ks2][qb][3]);
                pf[qb].u.z = pg8::cvt_pk_bf16(sc[2 * ks2 + 1][qb][0], sc[2 * ks2 + 1][qb][1]); pf[qb].u.w = pg8::cvt_pk_bf16(sc[2 * ks2 + 1][qb][2], sc[2 * ks2 + 1][qb][3]); }
#pragma unroll
            for (int db = 0; db < 4; ++db) { frag_u vf; const LAS bf16_t* vp = Vt + (db * 16 + i) * 72 + (2 * ks2) * 16 + 4 * gq;
                const u32x2 v0 = *(const LAS u32x2*)vp, v1 = *(const LAS u32x2*)(vp + 16); vf.u = (u32x4){v0.x, v0.y, v1.x, v1.y};
                ao[db][0] = __builtin_amdgcn_mfma_f32_16x16x32_bf16(vf.b, pf[0].b, ao[db][0], 0, 0, 0);
                ao[db][1] = __builtin_amdgcn_mfma_f32_16x16x32_bf16(vf.b, pf[1].b, ao[db][1], 0, 0, 0); }
        }
    }
#undef ATT_KROW
#undef ATT_LOAD
    const float* og = F.in[24] + l * 256 + head * 64;
#pragma unroll
    for (int qb = 0; qb < 2; ++qb) {
        float lt = lsum[qb]; lt += __shfl_xor(lt, 16); lt += __shfl_xor(lt, 32);
        const float il = 1.f / lt; float ss = 0.f;
#pragma unroll
        for (int db = 0; db < 4; ++db) { ao[db][qb] *= il; ss += (ao[db][qb][0] * ao[db][qb][0] + ao[db][qb][1] * ao[db][qb][1]) + (ao[db][qb][2] * ao[db][qb][2] + ao[db][qb][3] * ao[db][qb][3]); }
        ss += __shfl_xor(ss, 16); ss += __shfl_xor(ss, 32);
        const float rs = rsqrtf(ss * (1.f / 64.f) + EPSN);
        bf16_t* yo = YC + (size_t)(qrow0 + qb * 16 + i) * DM + 512 + head * 64;
#pragma unroll
        for (int db = 0; db < 4; ++db) { const f32x4 gg = *(const f32x4*)(og + db * 16 + 4 * gq); st4bf(yo + db * 16 + 4 * gq, ao[db][qb] * rs * gg * ZF(8)); }
    }
    __syncthreads();
}

__device__ __forceinline__ int ml_row(int b, int dir, int j, int tp) {
    if (j < 2) { const int p = j * 128 + tp; return MLAT + b * TCTX + (dir ? (TCTX - 1 - p) : p); }
    const int p = (j - 2) * 128 + tp; return b * TLAT + (dir ? (TLAT - 1 - p) : p);
}
__device__ __forceinline__ void scan128_add(float& x0, float& x1, int lane) {
    x1 += x0; float t = x1;
#pragma unroll
    for (int o = 1; o < 64; o <<= 1) { const float u = __shfl_up(t, o); if (lane >= o) t += u; }
    const float ex = t - x1; x0 += ex; x1 = t;
}
__device__ __forceinline__ void scan128_max(float& x0, float& x1, int lane) {
    x1 = fmaxf(x1, x0); float t = x1;
#pragma unroll
    for (int o = 1; o < 64; o <<= 1) { const float u = __shfl_up(t, o); if (lane >= o) t = fmaxf(t, u); }
    const float pv = __shfl_up(t, 1); if (lane > 0) x0 = fmaxf(x0, pv); x1 = t;
}
__device__ __forceinline__ void ml_stage_T(const Ctx& F, const bf16_t* P, int b, int dir, int j, int col0, LAS bf16_t* dst, const LAS float* sw, float cscale) {
#pragma unroll
    for (int it = 0; it < 2; ++it) { const int id = F.tid + it * NTHR, tp = id >> 3, ch = id & 7;
        const u32x4 v = *(const u32x4*)(P + (size_t)ml_row(b, dir, j, tp) * DINP + col0 + ch * 8); const float s = (sw ? sw[tp] : 1.f) * cscale;
        const unsigned ww[4] = {v.x, v.y, v.z, v.w};
#pragma unroll
        for (int q = 0; q < 4; ++q) { dst[(ch * 8 + 2 * q) * 136 + tp] = (bf16_t)f2bf(lo2f(ww[q]) * s); dst[(ch * 8 + 2 * q + 1) * 136 + tp] = (bf16_t)f2bf(hi2f(ww[q]) * s); } }
}
__device__ __forceinline__ void ml_stage_R(const Ctx& F, const bf16_t* P, int b, int dir, int j, int col0, LAS bf16_t* dst, float cscale) {
#pragma unroll
    for (int it = 0; it < 2; ++it) { const int id = F.tid + it * NTHR, tp = id >> 3, ch = id & 7;
        u32x4 v = *(const u32x4*)(P + (size_t)ml_row(b, dir, j, tp) * DINP + col0 + ch * 8);
        if (cscale != 1.f) { v.x = pk2(lo2f(v.x) * cscale, hi2f(v.x) * cscale); v.y = pk2(lo2f(v.y) * cscale, hi2f(v.y) * cscale); v.z = pk2(lo2f(v.z) * cscale, hi2f(v.z) * cscale); v.w = pk2(lo2f(v.w) * cscale, hi2f(v.w) * cscale); }
        *(LAS u32x4*)(dst + tp * 72 + ch * 8) = v; }
}
__device__ __forceinline__ void mlstm_local(const Ctx& F, int task) {
    const int chain = task / NCHK, j = task % NCHK, b = chain >> 3, head = (chain >> 1) & 3, dir = chain & 1;
    const bf16_t* P = WSP(bf16_t, WS_P); const float* GA = WSP(float, WS_GA);
    LAS bf16_t* Vt = (LAS bf16_t*)F.lds; LAS bf16_t* Kt = Vt + 64 * 136; LAS float* wS = (LAS float*)(Kt + 64 * 136); LAS float* sc2 = wS + 128;
    __syncthreads();
    if (F.wave == 0) {
        const int r0 = ml_row(b, dir, j, 2 * F.lane), r1 = ml_row(b, dir, j, 2 * F.lane + 1);
        const float li0 = GA[(size_t)r0 * 16 + dir * 8 + head], li1 = GA[(size_t)r1 * 16 + dir * 8 + head];
        float b0 = GA[(size_t)r0 * 16 + dir * 8 + 4 + head], b1 = GA[(size_t)r1 * 16 + dir * 8 + 4 + head];
        scan128_add(b0, b1, F.lane);
        const float bend = __shfl(b1, 63);
        const float d0 = bend - b0 + li0, d1 = bend - b1 + li1;
        float mx = fmaxf(d0, d1);
#pragma unroll
        for (int o = 1; o < 64; o <<= 1) mx = fmaxf(mx, __shfl_xor(mx, o));
        wS[2 * F.lane] = __expf(d0 - mx); wS[2 * F.lane + 1] = __expf(d1 - mx);
        if (F.lane == 0) { sc2[0] = mx; sc2[1] = bend; }
    }
    __syncthreads();
    ml_stage_T(F, P, b, dir, j, C_MV + head * 64, Vt, wS, 1.f);
    ml_stage_T(F, P, b, dir, j, C_MK + head * 64, Kt, nullptr, 0.125f);
    __syncthreads();
    float* LC = WSP(float, WS_LC) + (size_t)task * CST;
    { const int vb = F.wave >> 1, i = F.lane & 15, gq = F.lane >> 4;
#pragma unroll
      for (int kk2 = 0; kk2 < 2; ++kk2) { const int kb = 2 * (F.wave & 1) + kk2; f32x4 acc = {0.f, 0.f, 0.f, 0.f};
#pragma unroll
          for (int ks = 0; ks < 4; ++ks) { const bf16x8 a = *(const LAS bf16x8*)(Vt + (vb * 16 + i) * 136 + ks * 32 + gq * 8), bb = *(const LAS bf16x8*)(Kt + (kb * 16 + i) * 136 + ks * 32 + gq * 8);
              acc = __builtin_amdgcn_mfma_f32_16x16x32_bf16(a, bb, acc, 0, 0, 0); }
#pragma unroll
          for (int r = 0; r < 4; ++r) LC[(vb * 16 + 4 * gq + r) * 64 + kb * 16 + i] = acc[r]; } }
    if (F.tid < 64) { float a = 0.f;
#pragma unroll 8
        for (int s = 0; s < 128; ++s) a += wS[s] * bf2f(Kt[F.tid * 136 + s]);
        LC[4096 + F.tid] = a; }
    if (F.tid == 0) { float* LB = WSP(float, WS_LB); LB[task * 2] = sc2[0]; LB[task * 2 + 1] = sc2[1]; }
}
__device__ __forceinline__ void mlstm_chain(const Ctx& F, int blk0) {
    const int gt = (F.vcu - blk0) * NTHR + F.tid; if (gt < 0 || gt >= 16 * CST) return;
    const int chain = gt / CST, e = gt % CST;
    const float* LC = WSP(float, WS_LC) + (size_t)chain * NCHK * CST + e; float* ST = WSP(float, WS_ST) + (size_t)chain * NCHK * CST + e;
    const float* LB = WSP(float, WS_LB) + chain * NCHK * 2; float* SM = WSP(float, WS_LB) + 4096 + chain * NCHK;
    float m = 0.f, x = 0.f;
#pragma unroll 1
    for (int g = 0; g < 3; ++g) {
        float d[22], Lv[22], Bv[22];
#pragma unroll
        for (int q = 0; q < 22; ++q) { const int j = g * 22 + q; d[q] = LC[(size_t)j * CST]; Lv[q] = LB[2 * j]; Bv[q] = LB[2 * j + 1]; }
#pragma unroll
        for (int q = 0; q < 22; ++q) { const int j = g * 22 + q;
            ST[(size_t)j * CST] = x; if (e == 0) SM[j] = m;
            const float mn = fmaxf(Bv[q] + m, Lv[q]);
            x = __expf(Bv[q] + m - mn) * x + __expf(Lv[q] - mn) * d[q]; m = mn; }
    }
}
__device__ __forceinline__ void mlstm_out(const Ctx& F, int l, int unit) {
    const bool isc = unit >= 512; int b, chunk, head;
    if (!isc) { b = unit >> 8; chunk = (unit >> 2) & 63; head = unit & 3; } else { const int u = unit - 512; b = u >> 3; chunk = (u >> 2) & 1; head = u & 3; }
    const bf16_t* P = WSP(bf16_t, WS_P); const float* GA = WSP(float, WS_GA); bf16_t* YC = WSP(bf16_t, WS_YCAT);
    LAS bf16_t* Ql = (LAS bf16_t*)F.lds; LAS bf16_t* Kl = Ql + 128 * 72; LAS bf16_t* Vt = Kl + 128 * 72; LAS bf16_t* Cb = Vt + 64 * 136;
    LAS float* nS = (LAS float*)(Cb + 64 * 72); LAS float* aS = nS + 64; LAS float* bS = aS + 128; LAS float* MS = bS + 128; LAS float* Hs = MS + 128;
    const int i = F.lane & 15, gq = F.lane >> 4, w = F.wave;
    for (int dir = 0; dir < 2; ++dir) {
        const int j = isc ? (dir ? 1 - chunk : chunk) : 2 + (dir ? 63 - chunk : chunk);
        const int chain = (b * 4 + head) * 2 + dir;
        const float* ST = WSP(float, WS_ST) + ((size_t)chain * NCHK + j) * CST; const float mprev = WSP(float, WS_LB)[4096 + chain * NCHK + j];
        __syncthreads();
        if (w == 0) {
            const int r0 = ml_row(b, dir, j, 2 * F.lane), r1 = ml_row(b, dir, j, 2 * F.lane + 1);
            const float li0 = GA[(size_t)r0 * 16 + dir * 8 + head], li1 = GA[(size_t)r1 * 16 + dir * 8 + head];
            float b0 = GA[(size_t)r0 * 16 + dir * 8 + 4 + head], b1 = GA[(size_t)r1 * 16 + dir * 8 + 4 + head];
            scan128_add(b0, b1, F.lane);
            const float a0 = li0 - b0, a1 = li1 - b1; float A0 = a0, A1 = a1;
            scan128_max(A0, A1, F.lane);
            aS[2 * F.lane] = a0; aS[2 * F.lane + 1] = a1; bS[2 * F.lane] = b0; bS[2 * F.lane + 1] = b1;
            MS[2 * F.lane] = fmaxf(A0, mprev); MS[2 * F.lane + 1] = fmaxf(A1, mprev);
        }
        ml_stage_R(F, P, b, dir, j, C_MQ + head * 64, Ql, 1.f);
        ml_stage_R(F, P, b, dir, j, C_MK + head * 64, Kl, 0.125f);
        ml_stage_T(F, P, b, dir, j, C_MV + head * 64, Vt, nullptr, 1.f);
        { const f32x4 c0 = *(const f32x4*)(ST + F.tid * 8), c1 = *(const f32x4*)(ST + F.tid * 8 + 4); const int v = F.tid >> 3, k0 = (F.tid & 7) * 8;
          u32x4 o; o.x = pk2(c0[0], c0[1]); o.y = pk2(c0[2], c0[3]); o.z = pk2(c1[0], c1[1]); o.w = pk2(c1[2], c1[3]); *(LAS u32x4*)(Cb + v * 72 + k0) = o;
          if (F.tid < 64) nS[F.tid] = ST[4096 + F.tid]; }
        __syncthreads();
        const int t = 16 * w + i; const float Mt = MS[t], bt = bS[t];
        bf16x8 Qf[2];
#pragma unroll
        for (int ks = 0; ks < 2; ++ks) Qf[ks] = *(const LAS bf16x8*)(Ql + t * 72 + ks * 32 + gq * 8);
        f32x4 sc[8];
#pragma unroll
        for (int sb = 0; sb < 8; ++sb) { sc[sb] = (f32x4){0.f, 0.f, 0.f, 0.f};
            if (sb <= w) {
#pragma unroll
                for (int ks = 0; ks < 2; ++ks) { const bf16x8 kf = *(const LAS bf16x8*)(Kl + (sb * 16 + i) * 72 + ks * 32 + gq * 8); sc[sb] = __builtin_amdgcn_mfma_f32_16x16x32_bf16(kf, Qf[ks], sc[sb], 0, 0, 0); }
#pragma unroll
                for (int r = 0; r < 4; ++r) { const int s = sb * 16 + 4 * gq + r; sc[sb][r] = (s <= t) ? sc[sb][r] * __expf(aS[s] - Mt) : 0.f; }
            } }
        float den = 0.f;
#pragma unroll
        for (int sb = 0; sb < 8; ++sb) den += (sc[sb][0] + sc[sb][1]) + (sc[sb][2] + sc[sb][3]);
        den += __shfl_xor(den, 16); den += __shfl_xor(den, 32);
        f32x4 nm[4], it_[4];
#pragma unroll
        for (int vb = 0; vb < 4; ++vb) { nm[vb] = (f32x4){0.f, 0.f, 0.f, 0.f}; it_[vb] = (f32x4){0.f, 0.f, 0.f, 0.f}; }
#pragma unroll
        for (int ks2 = 0; ks2 < 4; ++ks2) if (2 * ks2 <= w) {
            frag_u pf; pf.u.x = pg8::cvt_pk_bf16(sc[2 * ks2][0], sc[2 * ks2][1]); pf.u.y = pg8::cvt_pk_bf16(sc[2 * ks2][2], sc[2 * ks2][3]);
            pf.u.z = pg8::cvt_pk_bf16(sc[2 * ks2 + 1][0], sc[2 * ks2 + 1][1]); pf.u.w = pg8::cvt_pk_bf16(sc[2 * ks2 + 1][2], sc[2 * ks2 + 1][3]);
#pragma unroll
            for (int vb = 0; vb < 4; ++vb) { frag_u vf; const LAS bf16_t* vp = Vt + (vb * 16 + i) * 136 + (2 * ks2) * 16 + 4 * gq;
                const u32x2 v0 = *(const LAS u32x2*)vp, v1 = *(const LAS u32x2*)(vp + 16); vf.u = (u32x4){v0.x, v0.y, v1.x, v1.y};
                nm[vb] = __builtin_amdgcn_mfma_f32_16x16x32_bf16(vf.b, pf.b, nm[vb], 0, 0, 0); }
        }
#pragma unroll
        for (int vb = 0; vb < 4; ++vb)
#pragma unroll
            for (int ks = 0; ks < 2; ++ks) { const bf16x8 cf = *(const LAS bf16x8*)(Cb + (vb * 16 + i) * 72 + ks * 32 + gq * 8); it_[vb] = __builtin_amdgcn_mfma_f32_16x16x32_bf16(cf, Qf[ks], it_[vb], 0, 0, 0); }
        float nq = 0.f;
#pragma unroll
        for (int c = 0; c < 2; ++c) { const u32x4 qv = *(const LAS u32x4*)(Ql + t * 72 + gq * 16 + c * 8); const unsigned ww[4] = {qv.x, qv.y, qv.z, qv.w};
#pragma unroll
            for (int q = 0; q < 4; ++q) nq += nS[gq * 16 + c * 8 + 2 * q] * lo2f(ww[q]) + nS[gq * 16 + c * 8 + 2 * q + 1] * hi2f(ww[q]); }
        nq += __shfl_xor(nq, 16); nq += __shfl_xor(nq, 32);
        const float wint = __expf(mprev - Mt); den += wint * nq;
        const float dn = 1.f / fmaxf(fabsf(den), __expf(-(bt + Mt)));
        const int torig = dir ? 127 - t : t;
#pragma unroll
        for (int vb = 0; vb < 4; ++vb)
#pragma unroll
            for (int r = 0; r < 4; ++r) { const float hv = (nm[vb][r] + wint * it_[vb][r]) * dn; LAS float* hp = Hs + torig * 65 + vb * 16 + 4 * gq + r; if (dir == 0) *hp = hv; else *hp += hv; }
    }
    __syncthreads();
    {
        const int t = F.tid >> 2, vq = F.tid & 3; const int row = (isc ? MLAT + b * TCTX : b * TLAT) + chunk * 128 + t;
        float hv[16], ss = 0.f;
#pragma unroll
        for (int q = 0; q < 16; ++q) { hv[q] = Hs[t * 65 + vq * 16 + q]; ss += hv[q] * hv[q]; }
        ss += __shfl_xor(ss, 1); ss += __shfl_xor(ss, 2);
        const float rs = rsqrtf(ss * (1.f / 64.f) + EPSN);
        const float* og = F.in[27] + l * 256 + head * 64 + vq * 16; const bf16_t* op = P + (size_t)row * DINP + C_MO + head * 64 + vq * 16;
        const u32x4 o0 = *(const u32x4*)op, o1 = *(const u32x4*)(op + 8); const unsigned ow[8] = {o0.x, o0.y, o0.z, o0.w, o1.x, o1.y, o1.z, o1.w};
        unsigned res[8];
#pragma unroll
        for (int q = 0; q < 8; ++q) { const float y0 = sigmoidf_(lo2f(ow[q])) * hv[2 * q] * rs * og[2 * q], y1 = sigmoidf_(hi2f(ow[q])) * hv[2 * q + 1] * rs * og[2 * q + 1]; res[q] = pk2(y0 * ZF(16), y1 * ZF(16)); }
        bf16_t* yo = YC + (size_t)row * DM + 768 + head * 64 + vq * 16;
        *(u32x4*)yo = (u32x4){res[0], res[1], res[2], res[3]}; *(u32x4*)(yo + 8) = (u32x4){res[4], res[5], res[6], res[7]};
    }
    __syncthreads();
}
__device__ __forceinline__ void rwkv_finish(const Ctx& F, int l, int nrows) {
    const bf16_t* P = WSP(bf16_t, WS_P); const float* YR = WSP(float, WS_YR); const bf16_t* GB = WSP(bf16_t, WS_GB); const float* BS = WSP(float, WS_BS); bf16_t* YC = WSP(bf16_t, WS_YCAT);
    const int c4 = F.lane * 4; const f32x4 lg = *(const f32x4*)(F.in[20] + l * 256 + c4);
    const int gw = F.vcu * NWAVES + F.wave, NGW = F.G * NWAVES;
    for (int row = gw; row < nrows; row += NGW) {
        const f32x4 y = *(const f32x4*)(YR + (size_t)row * 256 + c4) + *(const f32x4*)(YR + (size_t)(MALL + row) * 256 + c4);
        const float ss = red16((y[0] * y[0] + y[1] * y[1]) + (y[2] * y[2] + y[3] * y[3]));
        const float rs = rsqrtf(ss * (1.f / 64.f) + EPSN);
        const f32x4 v = ld4bf(P + (size_t)row * DINP + C_RV + c4), g = ld4bf(GB + (size_t)row * 256 + c4);
        const float bn = BS[(size_t)row * 4 + (F.lane >> 4)];
        st4bf(YC + (size_t)row * DM + 256 + c4, (y * rs * lg * ZF(32) + bn * v * ZF(64)) * g * ZF(4));
    }
}
constexpr int RCH = 132;
constexpr int MP = 72, SLOT = 64 * MP;
constexpr size_t WS_RG = 454 * MiB, RG_TASK = 3 * 8192, WS_SST = WS_RW;
constexpr size_t WS_END2 = 504 * MiB;
static_assert(WS_RG + (size_t)16 * RCH * RG_TASK <= WS_END2 && (size_t)16 * RCH * 8192 <= (size_t)MALL * RWREC, "rwkv chunk ws map");

__device__ __forceinline__ void mm64(const LAS bf16_t* A, const LAS bf16_t* Bt, int w, int lane, f32x4 (&acc)[2]) {
    const int i = lane & 15, gq = lane >> 4, mb = w >> 1, nb0 = 2 * (w & 1);
    acc[0] = (f32x4){0.f, 0.f, 0.f, 0.f}; acc[1] = (f32x4){0.f, 0.f, 0.f, 0.f};
#pragma unroll
    for (int ks = 0; ks < 2; ++ks) { const bf16x8 a = *(const LAS bf16x8*)(A + (mb * 16 + i) * MP + ks * 32 + gq * 8);
#pragma unroll
        for (int q = 0; q < 2; ++q) { const bf16x8 b = *(const LAS bf16x8*)(Bt + ((nb0 + q) * 16 + i) * MP + ks * 32 + gq * 8); acc[q] = __builtin_amdgcn_mfma_f32_16x16x32_bf16(a, b, acc[q], 0, 0, 0); } }
}
__device__ __forceinline__ u32x2 pk4(f32x4 v) { u32x2 o; o.x = pk2(v[0], v[1]); o.y = pk2(v[2], v[3]); return o; }
__device__ __forceinline__ f32x4 up4(u32x2 w) { return (f32x4){lo2f(w.x), hi2f(w.x), lo2f(w.y), hi2f(w.y)}; }

struct RaRaw { u32x4 kk, al, kd, r, v; f32x4 ld0, ld1; };
__device__ __forceinline__ void ra_load(const Ctx& F, int task, RaRaw& g) {
    const int chain = task / RCH, c = task % RCH, b = chain >> 3, head = (chain >> 1) & 3, dir = chain & 1;
    const bf16_t* P = WSP(bf16_t, WS_P); const unsigned char* RW = WSP(unsigned char, WS_RW);
    const int t = F.tid >> 3, ch0 = (F.tid & 7) * 8; const int row = scan_row(b, dir, c * 64 + t);
    const bf16_t* rb = (const bf16_t*)(RW + (size_t)row * RWREC) + head * 64 + ch0;
    g.kk = *(const u32x4*)rb; g.al = *(const u32x4*)(rb + 256 + dir * 256); g.kd = *(const u32x4*)(rb + 768 + dir * 256);
    const float* ldp = (const float*)(RW + (size_t)row * RWREC + 2560) + dir * 256 + head * 64 + ch0;
    g.ld0 = *(const f32x4*)ldp; g.ld1 = *(const f32x4*)(ldp + 4);
    const bf16_t* pp = P + (size_t)row * DINP + head * 64 + ch0;
    g.r = *(const u32x4*)(pp + C_RR); g.v = *(const u32x4*)(pp + C_RV);
}
__device__ __forceinline__ void rwkv_chunk_pre(const Ctx& F, int task, const RaRaw& cur) {
    const int chain = task / RCH, c = task % RCH, b = chain >> 3, head = (chain >> 1) & 3, dir = chain & 1;
    LAS bf16_t* L0 = (LAS bf16_t*)F.lds;
#define SL(k) (L0 + (k) * SLOT)
    LAS float* LD = (LAS float*)SL(8);
    LAS float* SEG = (LAS float*)SL(10);
    LAS float* WLs = (LAS float*)SL(14);
    const int w = F.wave, lane = F.lane, i = lane & 15, gq = lane >> 4, mb = w >> 1, nb0 = 2 * (w & 1), m0 = mb * 16 + 4 * gq;
    LDS_BARRIER();
    const int t = F.tid >> 3, ch0 = (F.tid & 7) * 8;
    const u32x4 g_kk = cur.kk, g_al = cur.al, g_kd = cur.kd, g_r = cur.r, g_v = cur.v; const f32x4 ld0 = cur.ld0, ld1 = cur.ld1;
    *(LAS f32x4*)(LD + t * 64 + ch0) = ld0; *(LAS f32x4*)(LD + t * 64 + ch0 + 4) = ld1;
    LDS_BARRIER();
    { const int k = F.tid & 63, seg = F.tid >> 6; float s = 0.f;
#pragma unroll
      for (int j = 0; j < 8; ++j) s += LD[(seg * 8 + j) * 64 + k];
      SEG[seg * 64 + k] = s;
      LDS_BARRIER();
      float off = 0.f;
#pragma unroll
      for (int j = 0; j < 8; ++j) off += (j < seg) ? SEG[j * 64 + k] : 0.f;
#pragma unroll
      for (int j = 0; j < 8; ++j) { off += LD[(seg * 8 + j) * 64 + k]; LD[(seg * 8 + j) * 64 + k] = off; }
    }
    LDS_BARRIER();
    {
        const unsigned kkw[4] = {g_kk.x, g_kk.y, g_kk.z, g_kk.w}, alw[4] = {g_al.x, g_al.y, g_al.z, g_al.w}, kdw[4] = {g_kd.x, g_kd.y, g_kd.z, g_kd.w},
                       rw_[4] = {g_r.x, g_r.y, g_r.z, g_r.w}, vw[4] = {g_v.x, g_v.y, g_v.z, g_v.w};
        float okt[8], oai[8], oki[8], ort[8], oat[8], okb[8];
#pragma unroll
        for (int j = 0; j < 8; ++j) {
            const float cl = LD[t * 64 + ch0 + j], clp = t > 0 ? LD[(t - 1) * 64 + ch0 + j] : 0.f, clL = LD[63 * 64 + ch0 + j];
            const float kkv = (j & 1) ? hi2f(kkw[j >> 1]) : lo2f(kkw[j >> 1]), alv = (j & 1) ? hi2f(alw[j >> 1]) : lo2f(alw[j >> 1]), kdv = (j & 1) ? hi2f(kdw[j >> 1]) : lo2f(kdw[j >> 1]),
                        rv = (j & 1) ? hi2f(rw_[j >> 1]) : lo2f(rw_[j >> 1]);
            const float ec = __expf(cl), en = __builtin_amdgcn_rcpf(ec), eL = __expf(clL) * en;
            okt[j] = kkv * __expf(clp); oai[j] = alv * en; oki[j] = kdv * en; ort[j] = rv * ec; oat[j] = alv * eL; okb[j] = kdv * eL;
        }
        u32x4 o;
        o = (u32x4){pk2(okt[0], okt[1]), pk2(okt[2], okt[3]), pk2(okt[4], okt[5]), pk2(okt[6], okt[7])}; *(LAS u32x4*)(SL(0) + t * MP + ch0) = o;
        o = (u32x4){pk2(oai[0], oai[1]), pk2(oai[2], oai[3]), pk2(oai[4], oai[5]), pk2(oai[6], oai[7])}; *(LAS u32x4*)(SL(2) + t * MP + ch0) = o;
        o = (u32x4){pk2(oki[0], oki[1]), pk2(oki[2], oki[3]), pk2(oki[4], oki[5]), pk2(oki[6], oki[7])}; *(LAS u32x4*)(SL(3) + t * MP + ch0) = o;
        o = (u32x4){pk2(ort[0], ort[1]), pk2(ort[2], ort[3]), pk2(ort[4], ort[5]), pk2(ort[6], ort[7])}; *(LAS u32x4*)(SL(4) + t * MP + ch0) = o;
#pragma unroll
        for (int j = 0; j < 8; ++j) { SL(1)[(ch0 + j) * MP + t] = (bf16_t)f2bf(okt[j]); SL(5)[(ch0 + j) * MP + t] = (bf16_t)f2bf(oat[j]); SL(6)[(ch0 + j) * MP + t] = (bf16_t)f2bf(okb[j]);
            SL(7)[(ch0 + j) * MP + t] = (bf16_t)(((j & 1) ? (vw[j >> 1] >> 16) : (vw[j >> 1] & 0xffffu))); }
        if (t == 63) {
#pragma unroll
            for (int j = 0; j < 8; ++j) WLs[ch0 + j] = __expf(LD[63 * 64 + ch0 + j]); }
    }
    LDS_BARRIER();
    f32x4 acc[2];
    mm64(SL(0), SL(2), w, lane, acc);
#pragma unroll
    for (int q = 0; q < 2; ++q) { const int n = (nb0 + q) * 16 + i; f32x4 a, ti;
#pragma unroll
        for (int r = 0; r < 4; ++r) { const bool keep = (m0 + r) > n; a[r] = keep ? acc[q][r] : 0.f; ti[r] = ((m0 + r) == n ? 1.f : 0.f) - a[r]; }
#pragma unroll
        for (int r = 0; r < 4; ++r) { SL(8)[(m0 + r) * MP + n] = (bf16_t)f2bf(a[r]); SL(13)[(m0 + r) * MP + n] = (bf16_t)f2bf(ti[r]); }
        *(LAS u32x2*)(SL(9) + n * MP + m0) = pk4(a); }
    mm64(SL(0), SL(3), w, lane, acc);
#pragma unroll
    for (int q = 0; q < 2; ++q) { const int n = (nb0 + q) * 16 + i;
#pragma unroll
        for (int r = 0; r < 4; ++r) SL(10)[(m0 + r) * MP + n] = (bf16_t)f2bf((m0 + r) > n ? acc[q][r] : 0.f); }
    mm64(SL(4), SL(2), w, lane, acc);
#pragma unroll
    for (int q = 0; q < 2; ++q) { const int n = (nb0 + q) * 16 + i;
#pragma unroll
        for (int r = 0; r < 4; ++r) SL(11)[(m0 + r) * MP + n] = (bf16_t)f2bf((m0 + r) >= n ? acc[q][r] : 0.f); }
    mm64(SL(4), SL(3), w, lane, acc);
#pragma unroll
    for (int q = 0; q < 2; ++q) { const int n = (nb0 + q) * 16 + i;
#pragma unroll
        for (int r = 0; r < 4; ++r) SL(12)[(m0 + r) * MP + n] = (bf16_t)f2bf((m0 + r) >= n ? acc[q][r] : 0.f); }
    LDS_BARRIER();
#pragma unroll
    for (int it = 0; it < 5; ++it) {
        LAS bf16_t* Xs = (it & 1) ? SL(2) : SL(8); LAS bf16_t* XsT = (it & 1) ? SL(3) : SL(9);
        LAS bf16_t* Xd = (it & 1) ? SL(8) : SL(2); LAS bf16_t* XdT = (it & 1) ? SL(9) : SL(3);
        LAS bf16_t* Tsrc = (it & 1) ? SL(0) : SL(13); LAS bf16_t* Tdst = (it & 1) ? SL(13) : SL(0);
        mm64(Xs, XsT, w, lane, acc);
#pragma unroll
        for (int q = 0; q < 2; ++q) { const int n = (nb0 + q) * 16 + i;
#pragma unroll
            for (int r = 0; r < 4; ++r) Xd[(m0 + r) * MP + n] = (bf16_t)f2bf(acc[q][r]);
            *(LAS u32x2*)(XdT + n * MP + m0) = pk4(acc[q]); }
        LDS_BARRIER();
        mm64(Tsrc, XdT, w, lane, acc);
#pragma unroll
        for (int q = 0; q < 2; ++q) { const int n = (nb0 + q) * 16 + i;
#pragma unroll
            for (int r = 0; r < 4; ++r) Tdst[(m0 + r) * MP + n] = (bf16_t)f2bf(bf2f(Tsrc[(m0 + r) * MP + n]) + acc[q][r]); }
        LDS_BARRIER();
    }
    LAS bf16_t* Ti = SL(0);
    mm64(Ti, SL(1), w, lane, acc);
#pragma unroll
    for (int q = 0; q < 2; ++q) { const int n = (nb0 + q) * 16 + i; *(LAS u32x2*)(SL(2) + n * MP + m0) = pk4(acc[q]); }
    mm64(SL(10), SL(7), w, lane, acc);
#pragma unroll
    for (int q = 0; q < 2; ++q) { const int n = (nb0 + q) * 16 + i; *(LAS u32x2*)(SL(3) + n * MP + m0) = pk4(acc[q]); }
    LDS_BARRIER();
    mm64(Ti, SL(3), w, lane, acc);
#pragma unroll
    for (int q = 0; q < 2; ++q) { const int n = (nb0 + q) * 16 + i; *(LAS u32x2*)(SL(8) + n * MP + m0) = pk4(acc[q]); }
    LDS_BARRIER();
    bf16_t* RG = (bf16_t*)(F.ws + WS_RG + (size_t)task * RG_TASK);
    f32x4 acc2[2];
    mm64(SL(2), SL(11), w, lane, acc);
#pragma unroll
    for (int q = 0; q < 2; ++q) { const int n = (nb0 + q) * 16 + i; const f32x4 rt = up4(*(const LAS u32x2*)(SL(4) + n * MP + m0)); *(u32x2*)(RG + n * 64 + m0) = pk4(rt - acc[q]); }
    mm64(SL(2), SL(5), w, lane, acc);
#pragma unroll
    for (int q = 0; q < 2; ++q) { const int n = (nb0 + q) * 16 + i; f32x4 g;
#pragma unroll
        for (int r = 0; r < 4; ++r) g[r] = ((m0 + r) == n ? WLs[n] : 0.f) - acc[q][r];
        *(u32x2*)(RG + 4096 + n * 64 + m0) = pk4(g); }
    mm64(SL(6), SL(7), w, lane, acc); mm64(SL(5), SL(8), w, lane, acc2);
#pragma unroll
    for (int q = 0; q < 2; ++q) { const int n = (nb0 + q) * 16 + i; *(u32x2*)(RG + 8192 + n * 64 + m0) = pk4(acc[q] - acc2[q]); }
    mm64(SL(7), SL(12), w, lane, acc); mm64(SL(8), SL(11), w, lane, acc2);
    float* YR = WSP(float, WS_YR) + (size_t)dir * MALL * 256;
#pragma unroll
    for (int q = 0; q < 2; ++q) { const int n = (nb0 + q) * 16 + i; const int rown = scan_row(b, dir, c * 64 + n); *(f32x4*)(YR + (size_t)rown * 256 + head * 64 + m0) = acc[q] - acc2[q]; }
#undef SL
}

__device__ __forceinline__ void rwkv_chain(const Ctx& F, int chain) {
    LAS bf16_t* const L0 = (LAS bf16_t*)F.lds;
    LAS bf16_t* Gl[2] = {L0, L0 + SLOT}; LAS bf16_t* Sl[2] = {L0 + 2 * SLOT, L0 + 3 * SLOT}; LAS bf16_t* Hl[2] = {L0 + 4 * SLOT, L0 + 5 * SLOT};
    const int w = F.wave, lane = F.lane, i = lane & 15, gq = lane >> 4, mb = w >> 1, nb0 = 2 * (w & 1), m0 = mb * 16 + 4 * gq;
    const bf16_t* RGc = (const bf16_t*)(F.ws + WS_RG + (size_t)chain * RCH * RG_TASK); bf16_t* SST = (bf16_t*)(F.ws + WS_SST) + (size_t)chain * RCH * 4096;
    const int gr = F.tid >> 3, gc = (F.tid & 7) * 8, goff = gr * 64 + gc, loff = gr * MP + gc;
    constexpr int RBD = 6, RBU = 66;
    static_assert(RBU % RBD == 0 && RCH % RBU == 0, "ring depth / unroll");
    u32x4 rg[RBD], rh[RBD];
#define RB_LOAD(slot, cc) do { const bf16_t* p_ = RGc + (size_t)((cc) < RCH ? (cc) : RCH - 1) * (RG_TASK / 2); rg[slot] = *(const u32x4*)(p_ + 4096 + goff); rh[slot] = *(const u32x4*)(p_ + 8192 + goff); } while (0)
#pragma unroll
    for (int j = 0; j < RBD; ++j) RB_LOAD(j, j);
    __syncthreads();
    { unsigned z_; asm volatile("v_mov_b32 %0, 0" : "=v"(z_)); *(LAS u32x4*)(Sl[0] + loff) = (u32x4){z_, z_, z_, z_}; }
    *(LAS u32x4*)(Gl[0] + loff) = rg[0]; *(LAS u32x4*)(Hl[0] + loff) = rh[0];
    __syncthreads();
#ifdef TPROBE
    const unsigned long long tp0_ = __builtin_amdgcn_s_memrealtime();
#endif
#define RB_STEP(j) do { const int c = c0 + (j); if (c < RCH - 1) { const int par = c & 1; \
        *(u32x4*)(SST + (size_t)c * 4096 + goff) = *(const LAS u32x4*)(Sl[par] + loff);            \
        f32x4 acc[2]; mm64(Gl[par], Sl[par], w, lane, acc); \
        { const f32x4 h0 = up4(*(const LAS u32x2*)(Hl[par] + (nb0 * 16 + i) * MP + m0)), h1 = up4(*(const LAS u32x2*)(Hl[par] + ((nb0 + 1) * 16 + i) * MP + m0)); \
          *(LAS u32x2*)(Sl[par ^ 1] + (nb0 * 16 + i) * MP + m0) = pk4(acc[0] + h0); *(LAS u32x2*)(Sl[par ^ 1] + ((nb0 + 1) * 16 + i) * MP + m0) = pk4(acc[1] + h1); } \
        *(LAS u32x4*)(Gl[par ^ 1] + loff) = rg[((j) + 1) % RBD]; *(LAS u32x4*)(Hl[par ^ 1] + loff) = rh[((j) + 1) % RBD]; \
        RB_LOAD((j) % RBD, c + RBD); \
        asm volatile("s_waitcnt lgkmcnt(0)" ::: "memory"); __builtin_amdgcn_s_barrier(); asm volatile("" ::: "memory"); } } while (0)
#pragma unroll 1
    for (int c0 = 0; c0 < RCH; c0 += RBU) {
#pragma unroll
        for (int j = 0; j < RBU; ++j) RB_STEP(j); }
#undef RB_STEP
#undef RB_LOAD
    *(u32x4*)(SST + (size_t)(RCH - 1) * 4096 + goff) = *(const LAS u32x4*)(Sl[(RCH - 1) & 1] + loff);
#ifdef TPROBE
    if (chain == 0 && F.tid == 0) *(float*)(F.ws + WS_CTL + 65536) = 3000.f * (floorf((float)(__builtin_amdgcn_s_memrealtime() - tp0_) * (1.f / 3000.f)) + 0.5f);
#endif
    __syncthreads();
}

__device__ __forceinline__ void rwkv_out(const Ctx& F, int l, int unit) {
    const bool isc = unit >= 256; int b, chunk; if (!isc) { b = unit >> 7; chunk = unit & 127; } else { const int u = unit - 256; b = u >> 2; chunk = u & 3; }
    LAS bf16_t* Rl = (LAS bf16_t*)F.lds; LAS bf16_t* Sl = Rl + SLOT; LAS float* Ys = (LAS float*)(F.lds + 4 * SLOT * 2);
    const int w = F.wave, lane = F.lane, i = lane & 15, gq = lane >> 4, mb = w >> 1, nb0 = 2 * (w & 1), m0 = mb * 16 + 4 * gq;
    const int row0 = (isc ? MLAT + b * TCTX : b * TLAT) + chunk * 64;
    const int gr = F.tid >> 3, gc = (F.tid & 7) * 8;
#define RO_PTRS(hd_, RGp, SSp) do { const int head_ = (hd_) >> 1, dir_ = (hd_) & 1, chain_ = (b * 4 + head_) * 2 + dir_; const int cc_ = isc ? (dir_ ? 3 - chunk : chunk) : 4 + (dir_ ? 127 - chunk : chunk); \
        RGp = (const bf16_t*)(F.ws + WS_RG + ((size_t)chain_ * RCH + cc_) * RG_TASK); SSp = (const bf16_t*)(F.ws + WS_SST) + ((size_t)chain_ * RCH + cc_) * 4096; } while (0)
    u32x4 rv, sv;
    { const bf16_t* RG0; const bf16_t* SS0; RO_PTRS(0, RG0, SS0); rv = *(const u32x4*)(RG0 + gr * 64 + gc); sv = *(const u32x4*)(SS0 + gr * 64 + gc); }
#pragma unroll 1
    for (int hd = 0; hd < 8; ++hd) {
        const int head = hd >> 1, dir = hd & 1;
        const float* YR = WSP(float, WS_YR) + (size_t)dir * MALL * 256;
        LDS_BARRIER();
        *(LAS u32x4*)(Rl + gr * MP + gc) = rv; *(LAS u32x4*)(Sl + gr * MP + gc) = sv;
        if (hd < 7) { const bf16_t* RGn; const bf16_t* SSn; RO_PTRS(hd + 1, RGn, SSn); rv = *(const u32x4*)(RGn + gr * 64 + gc); sv = *(const u32x4*)(SSn + gr * 64 + gc); }
        f32x4 yl[2];
#pragma unroll
        for (int q = 0; q < 2; ++q) { const int n = (nb0 + q) * 16 + i; const int tor = dir ? 63 - n : n; yl[q] = *(const f32x4*)(YR + (size_t)(row0 + tor) * 256 + head * 64 + m0); }
        LDS_BARRIER();
        f32x4 acc[2]; mm64(Sl, Rl, w, lane, acc);
#pragma unroll
        for (int q = 0; q < 2; ++q) { const int n = (nb0 + q) * 16 + i; const int tor = dir ? 63 - n : n;
            LAS f32x4* yp = (LAS f32x4*)(Ys + tor * 260 + head * 64 + m0);
            if (dir == 0) *yp = acc[q] + yl[q]; else *yp = *yp + acc[q] + yl[q]; }
    }
#undef RO_PTRS
    __syncthreads();
    {
        const bf16_t* P = WSP(bf16_t, WS_P); const bf16_t* GB = WSP(bf16_t, WS_GB); const float* BS = WSP(float, WS_BS); bf16_t* YC = WSP(bf16_t, WS_YCAT);
        const int c4 = lane * 4; const f32x4 lg = *(const f32x4*)(F.in[20] + l * 256 + c4);
#pragma unroll 1
        for (int tt = w; tt < 64; tt += NWAVES) { const int row = row0 + tt;
            const f32x4 y = *(const LAS f32x4*)(Ys + tt * 260 + c4);
            const float ss = red16((y[0] * y[0] + y[1] * y[1]) + (y[2] * y[2] + y[3] * y[3]));
            const float rs = rsqrtf(ss * (1.f / 64.f) + EPSN);
            const f32x4 v = ld4bf(P + (size_t)row * DINP + C_RV + c4), g = ld4bf(GB + (size_t)row * 256 + c4);
            const float bn = BS[(size_t)row * 4 + (lane >> 4)];
            st4bf(YC + (size_t)row * DM + 256 + c4, (y * rs * lg * ZF(32) + bn * v * ZF(64)) * g * ZF(4)); }
    }
    __syncthreads();
}
__device__ __forceinline__ float clr7(float x) { return __uint_as_float(__float_as_uint(x) & 0xFFFFFF80u); }
__device__ __forceinline__ void ins16(float (&L)[16], float p) {
#pragma unroll
    for (int j = 15; j >= 1; --j) L[j] = __builtin_amdgcn_fmed3f(L[j - 1], L[j], p);
    L[0] = fmaxf(L[0], p);
}
__device__ __forceinline__ void peer_topk_task(const float* sg, size_t gstride, u32x2* eg) {
    float L0[16], L1[16];
#pragma unroll
    for (int j = 0; j < 16; ++j) { L0[j] = -INFINITY; L1[j] = -INFINITY; }
    f32x4 pa[4], pb[4];
#pragma unroll
    for (int u = 0; u < 4; ++u) { pa[u] = *(const f32x4*)(sg + (size_t)u * gstride); pb[u] = *(const f32x4*)(sg + (size_t)(32 + u) * gstride); }
#pragma unroll 4
    for (int i = 0; i < 128; i += 4) {
        const f32x4 a = pa[(i >> 2) & 3], b = pb[(i >> 2) & 3];
        { const int gn = (i >> 2) + 4 < 32 ? (i >> 2) + 4 : 31; pa[(i >> 2) & 3] = *(const f32x4*)(sg + (size_t)gn * gstride); pb[(i >> 2) & 3] = *(const f32x4*)(sg + (size_t)(32 + gn) * gstride); }
#pragma unroll
        for (int q = 0; q < 4; ++q) { ins16(L0, __uint_as_float((__float_as_uint(a[q]) & 0xFFFFFF80u) | (unsigned)(i + q)));
                                      ins16(L1, __uint_as_float((__float_as_uint(b[q]) & 0xFFFFFF80u) | (unsigned)(i + q))); }
    }
    float T[16];
#pragma unroll
    for (int j = 0; j < 16; ++j) T[j] = -INFINITY;
#pragma unroll
    for (int a = 0; a < 16; ++a)
#pragma unroll
        for (int b = 0; b < 16; ++b) if ((a + 1) * (b + 1) <= 16) { const float s = clr7(L0[a]) + clr7(L1[b]);
            ins16(T, __uint_as_float((__float_as_uint(s) & 0xFFFFFF00u) | (unsigned)(a * 16 + b))); }
    float e[16], sum = 0.f; const float mx = __uint_as_float(__float_as_uint(T[0]) & 0xFFFFFF00u);
#pragma unroll
    for (int j = 0; j < 16; ++j) { e[j] = __expf(__uint_as_float(__float_as_uint(T[j]) & 0xFFFFFF00u) - mx); sum += e[j]; }
    const float inv = 1.f / sum;
#pragma unroll
    for (int j = 0; j < 16; ++j) {
        const unsigned ab = __float_as_uint(T[j]) & 0xFFu, a = ab >> 4, b = ab & 15u; unsigned i0 = 0u, i1 = 0u;
#pragma unroll
        for (int q = 0; q < 16; ++q) { i0 = (a == (unsigned)q) ? (__float_as_uint(L0[q]) & 0x7Fu) : i0; i1 = (b == (unsigned)q) ? (__float_as_uint(L1[q]) & 0x7Fu) : i1; }
        eg[j] = (u32x2){i0 * 128u + i1, __float_as_uint(e[j] * inv)};
    }
}
__device__ __forceinline__ float gelu_tanh(float x) { const float u = 0.7978845608028654f * (x + 0.044715f * x * x * x); return 0.5f * x * (1.f + tanhf_(u)); }
__device__ __forceinline__ float dot2bf(unsigned w, unsigned x, float acc) { return __builtin_amdgcn_fdot2_f32_bf16(__builtin_bit_cast(bf16x2_t, w), __builtin_bit_cast(bf16x2_t, x), acc, false); }
__device__ __forceinline__ float wave_total63(float x) {
    x = red16(x);
    x += __int_as_float(__builtin_amdgcn_update_dpp(0, __float_as_int(x), 0x142, 0xa, 0xf, false));
    x += __int_as_float(__builtin_amdgcn_update_dpp(0, __float_as_int(x), 0x143, 0xc, 0xf, false));
    return x;
}
__device__ __forceinline__ void phase_peer(const Ctx& F, int l, int nrows, const float* mod, float* wr_override) {
    const float* S = WSP(float, WS_S); u32x2* EG = WSP(u32x2, WS_EG); const bf16_t* H = WSP(bf16_t, WS_H);
    const unsigned char* U = F.ws + WS_U + (size_t)l * UV_LSTRIDE; const unsigned char* V = F.ws + WS_V + (size_t)l * UV_LSTRIDE;
    const float* USC = WSP(float, WS_SC) + (size_t)l * 2 * 16384; const float* VSC = USC + 16384;
    const int tpb = nrows / F.G, tok0 = F.vcu * tpb;
    volatile LAS unsigned* tkflag = (volatile LAS unsigned*)(F.lds + LDSCTL_OFF + 512);
    if (F.tid == 0) tkflag[0] = 0u;
    { const int ntok1 = tpb < 64 ? tpb : 64; const int task = F.tid; const int hd = task / ntok1, tkn = task - hd * ntok1;
      if (hd < 8) { const int row = tok0 + tkn; peer_topk_task(S + ((size_t)(hd * 64) * MALL + row) * 4, (size_t)MALL * 4, EG + (size_t)row * 128 + hd * 16); } }
    __threadfence_block(); __syncthreads();
    if (tpb > 64 && F.wave == 2) {
        const int nex = tpb - 64; const int hd = F.lane / nex, tkn = F.lane - hd * nex;
        if (hd < 8) { const int row = tok0 + 64 + tkn; peer_topk_task(S + ((size_t)(hd * 64) * MALL + row) * 4, (size_t)MALL * 4, EG + (size_t)row * 128 + hd * 16); }
        __threadfence_block(); asm volatile("s_waitcnt vmcnt(0) lgkmcnt(0)" ::: "memory");
        if (F.lane == 0) tkflag[0] = 1u;
    }
    const int lane = F.lane; const bool hi32 = lane >= 32; const unsigned l16 = (unsigned)(lane & 31) * 16u;
    for (int tk = F.wave; tk < tpb; tk += NWAVES) {
        if (tk >= 64) { while (tkflag[0] == 0u) __builtin_amdgcn_s_sleep(8); __threadfence_block(); }
        const int row = tok0 + tk; const bool isc = row >= MLAT; const int smp = isc ? 2 : (row >> 13);
        float* xrow = isc ? WSP(float, WS_XC) + (size_t)(row - MLAT) * DM : F.out + (size_t)row * DM;
        const u32x2 eg0 = EG[(size_t)row * 128 + lane], eg1 = EG[(size_t)row * 128 + 64 + lane];
#if U_FP4
        LAS unsigned char* wl = F.lds + F.wave * PEER_WLDS; LAS unsigned char* hbl = wl + 16 * 528; LAS unsigned char* rawl = hbl + 2048;
        float hscale;
        {   const u32x4 h0 = *(const u32x4*)(H + (size_t)row * DM + lane * 16), h1 = *(const u32x4*)(H + (size_t)row * DM + lane * 16 + 8);
            const unsigned hw[8] = {h0.x, h0.y, h0.z, h0.w, h1.x, h1.y, h1.z, h1.w}; float hf[16]; float am = 0.f;
#pragma unroll
            for (int q = 0; q < 8; ++q) { hf[2 * q] = lo2f(hw[q]); hf[2 * q + 1] = hi2f(hw[q]); am = fmaxf(am, fmaxf(fabsf(hf[2 * q]), fabsf(hf[2 * q + 1]))); }
#pragma unroll
            for (int o = 1; o < 64; o <<= 1) am = fmaxf(am, __shfl_xor(am, o));
            const float sc = am > 0.f ? 224.f / am : 1.f; hscale = am > 0.f ? am * (1.f / 224.f) : 1.f;
            unsigned hiw[4], low[4];
#pragma unroll
            for (int d = 0; d < 4; ++d) { const float a0 = hf[d * 4] * sc, a1 = hf[d * 4 + 1] * sc, a2 = hf[d * 4 + 2] * sc, a3 = hf[d * 4 + 3] * sc;
                int w = __builtin_amdgcn_cvt_pk_fp8_f32(a0, a1, 0, false); w = __builtin_amdgcn_cvt_pk_fp8_f32(a2, a3, w, true);
                const f32x2 b01 = __builtin_amdgcn_cvt_pk_f32_fp8(w, false), b23 = __builtin_amdgcn_cvt_pk_f32_fp8(w, true);
                int wl_ = __builtin_amdgcn_cvt_pk_fp8_f32((a0 - b01.x) * 16.f, (a1 - b01.y) * 16.f, 0, false); wl_ = __builtin_amdgcn_cvt_pk_fp8_f32((a2 - b23.x) * 16.f, (a3 - b23.y) * 16.f, wl_, true);
                hiw[d] = (unsigned)w; low[d] = (unsigned)wl_; }
            LAS unsigned char* hp = hbl + (lane >> 3) * 256 + ((lane >> 1) & 3) * 32 + (lane & 1) * 16;
            *(LAS u32x4*)hp = (u32x4){hiw[0], hiw[1], hiw[2], hiw[3]};
            *(LAS u32x4*)(hp + 128) = (u32x4){low[0], low[1], low[2], low[3]};
        }
        float act0 = 0.f, act1 = 0.f;
        {
            const int mi = lane & 15, mg = lane >> 4;
            const LAS unsigned char* aptr = wl + mi * 528 + mg * 16; const LAS unsigned char* bptr = hbl + (mi & 1) * 128 + mg * 32;
            LAS unsigned char* pk = wl + (lane >> 5) * (8 * 528) + l16;
            u32x4 rr[3][8];
#define PU_LOAD(bt_) do { _Pragma("unroll") for (int q = 0; q < 8; ++q) { const int ia = (bt_) * 16 + q, ib = ia + 8; \
                const unsigned ea = __builtin_amdgcn_readlane(ia < 64 ? eg0.x : eg1.x, ia & 63), eb = __builtin_amdgcn_readlane(ib < 64 ? eg0.x : eg1.x, ib & 63); \
                rr[(bt_) % 3][q] = *(const u32x4*)(U + ((hi32 ? eb : ea) * 512u + l16)); } } while (0)
#define PU_PARK(bt_) do { _Pragma("unroll") for (int q = 0; q < 8; ++q) *(LAS u32x4*)(pk + q * 528) = rr[(bt_) % 3][q]; } while (0)
            PU_LOAD(0); PU_LOAD(1);
#pragma unroll
            for (int bt = 0; bt < 8; ++bt) {
                if (bt + 2 < 8) PU_LOAD(bt + 2);
                PU_PARK(bt);
                f32x4 acc = {0.f, 0.f, 0.f, 0.f};
#pragma unroll
                for (int s = 0; s < 8; ++s) { const u32x4 a = *(const LAS u32x4*)(aptr + s * 64), b0 = *(const LAS u32x4*)(bptr + s * 256), b1 = *(const LAS u32x4*)(bptr + s * 256 + 16);
                    acc = __builtin_amdgcn_mfma_scale_f32_16x16x128_f8f6f4((i32x8){(int)a.x, (int)a.y, (int)a.z, (int)a.w, 0, 0, 0, 0},
                                                                           (i32x8){(int)b0.x, (int)b0.y, (int)b0.z, (int)b0.w, (int)b1.x, (int)b1.y, (int)b1.z, (int)b1.w}, acc, 4, 0, 0, 0, 0, 0); }
                f32x4 tot;
#pragma unroll
                for (int r = 0; r < 4; ++r) tot[r] = acc[r] + 0.0625f * dppf<0xF5>(acc[r]);
                if (mi == 0) *(LAS f32x4*)(rawl + (bt * 16 + 4 * mg) * 4) = tot;
            }
#undef PU_PARK
#undef PU_LOAD
            act0 = *(const LAS float*)(rawl + lane * 4) * (hscale * USC[eg0.x]); act1 = *(const LAS float*)(rawl + 256 + lane * 4) * (hscale * USC[eg1.x]);
        }
#else
        LAS unsigned char* wl = F.lds + F.wave * PEER_WLDS; LAS unsigned char* hbl = wl + 16 * 1040; LAS unsigned char* rawl = hbl + 2048;
        float hscale;
        {   const u32x4 h0 = *(const u32x4*)(H + (size_t)row * DM + lane * 16), h1 = *(const u32x4*)(H + (size_t)row * DM + lane * 16 + 8);
            const unsigned hw[8] = {h0.x, h0.y, h0.z, h0.w, h1.x, h1.y, h1.z, h1.w}; float hf[16]; float am = 0.f;
#pragma unroll
            for (int q = 0; q < 8; ++q) { hf[2 * q] = lo2f(hw[q]); hf[2 * q + 1] = hi2f(hw[q]); am = fmaxf(am, fmaxf(fabsf(hf[2 * q]), fabsf(hf[2 * q + 1]))); }
#pragma unroll
            for (int o = 1; o < 64; o <<= 1) am = fmaxf(am, __shfl_xor(am, o));
            const float sc = am > 0.f ? 224.f / am : 1.f; hscale = am > 0.f ? am * (1.f / 224.f) : 1.f;
#pragma unroll
            for (int hg = 0; hg < 2; ++hg) { unsigned hiw[2], low[2];
#pragma unroll
                for (int d = 0; d < 2; ++d) { const float a0 = hf[hg * 8 + d * 4] * sc, a1 = hf[hg * 8 + d * 4 + 1] * sc, a2 = hf[hg * 8 + d * 4 + 2] * sc, a3 = hf[hg * 8 + d * 4 + 3] * sc;
                    int w = __builtin_amdgcn_cvt_pk_fp8_f32(a0, a1, 0, false); w = __builtin_amdgcn_cvt_pk_fp8_f32(a2, a3, w, true);
                    const f32x2 b01 = __builtin_amdgcn_cvt_pk_f32_fp8(w, false), b23 = __builtin_amdgcn_cvt_pk_f32_fp8(w, true);
                    int wl_ = __builtin_amdgcn_cvt_pk_fp8_f32((a0 - b01.x) * 16.f, (a1 - b01.y) * 16.f, 0, false); wl_ = __builtin_amdgcn_cvt_pk_fp8_f32((a2 - b23.x) * 16.f, (a3 - b23.y) * 16.f, wl_, true);
                    hiw[d] = (unsigned)w; low[d] = (unsigned)wl_; }
                const int s_ = lane >> 1, g_ = 2 * (lane & 1) + hg;
                *(LAS u32x2*)(hbl + ((s_ * 2 + 0) * 4 + g_) * 8) = (u32x2){hiw[0], hiw[1]};
                *(LAS u32x2*)(hbl + ((s_ * 2 + 1) * 4 + g_) * 8) = (u32x2){low[0], low[1]}; }
        }
        float act0 = 0.f, act1 = 0.f;
        {
            const int mi = lane & 15, mg = lane >> 4;
            const LAS unsigned char* aptr = wl + mi * 1040 + mg * 8; const LAS unsigned char* bptr = hbl + (mi & 1) * 32 + mg * 8;
            u32x4 rr[3][8];
#define PU_LOAD(hb_) do { _Pragma("unroll") for (int q = 0; q < 8; ++q) { const int ii = (hb_) * 8 + q; const unsigned e = __builtin_amdgcn_readlane(ii < 64 ? eg0.x : eg1.x, ii & 63); \
                rr[(hb_) % 3][q] = *(const u32x4*)(U + (size_t)e * 1024 + lane * 16); } } while (0)
#define PU_PARK(hb_) do { _Pragma("unroll") for (int q = 0; q < 8; ++q) *(LAS u32x4*)(wl + (((hb_) & 1) * 8 + q) * 1040 + lane * 16) = rr[(hb_) % 3][q]; } while (0)
            PU_LOAD(0); PU_LOAD(1); PU_LOAD(2);
#pragma unroll
            for (int bt = 0; bt < 8; ++bt) {
                PU_PARK(2 * bt); if (2 * bt + 3 < 16) PU_LOAD(2 * bt + 3);
                PU_PARK(2 * bt + 1); if (2 * bt + 4 < 16) PU_LOAD(2 * bt + 4);
                f32x4 acc = {0.f, 0.f, 0.f, 0.f};
#pragma unroll
                for (int s = 0; s < 32; ++s) { const long a = *(const LAS long*)(aptr + s * 32), b = *(const LAS long*)(bptr + s * 64);
                    acc = __builtin_amdgcn_mfma_f32_16x16x32_fp8_fp8(a, b, acc, 0, 0, 0); }
                f32x4 tot;
#pragma unroll
                for (int r = 0; r < 4; ++r) tot[r] = acc[r] + 0.0625f * dppf<0xF5>(acc[r]);
                if (mi == 0) *(LAS f32x4*)(rawl + (bt * 16 + 4 * mg) * 4) = tot;
            }
#undef PU_PARK
#undef PU_LOAD
            act0 = *(const LAS float*)(rawl + lane * 4) * (hscale * USC[eg0.x]); act1 = *(const LAS float*)(rawl + 256 + lane * 4) * (hscale * USC[eg1.x]);
        }
#endif
#if V_FP4
        u32x4 ra[8], rb[8];
#define PG_LOAD(dst, grp_) do { _Pragma("unroll") for (int q = 0; q < 8; ++q) { const int ia = (grp_) * 16 + q, ib = ia + 8; \
            const unsigned ea = __builtin_amdgcn_readlane(ia < 64 ? eg0.x : eg1.x, ia & 63), eb = __builtin_amdgcn_readlane(ib < 64 ? eg0.x : eg1.x, ib & 63); \
            dst[q] = *(const u32x4*)(V + ((hi32 ? eb : ea) * 512u + l16)); } } while (0)
        PG_LOAD(ra, 0);
        const float cf0 = __uint_as_float(eg0.y) * gelu_tanh(act0) * VSC[eg0.x], cf1 = __uint_as_float(eg1.y) * gelu_tanh(act1) * VSC[eg1.x];
        f32x2 ac[16];
#pragma unroll
        for (int q = 0; q < 16; ++q) ac[q] = (f32x2){0.f, 0.f};
#define PG_VACC(src, grp_) do { _Pragma("unroll") for (int q = 0; q < 8; ++q) { const int ia = (grp_) * 16 + q, ib = ia + 8; \
            const float ca = __int_as_float(__builtin_amdgcn_readlane(__float_as_int(ia < 64 ? cf0 : cf1), ia & 63)), cb = __int_as_float(__builtin_amdgcn_readlane(__float_as_int(ib < 64 ? cf0 : cf1), ib & 63)); \
            const float cf = hi32 ? cb : ca; const unsigned vw[4] = {src[q].x, src[q].y, src[q].z, src[q].w}; \
            _Pragma("unroll") for (int j = 0; j < 4; ++j) { ac[4 * j] += cf * __builtin_amdgcn_cvt_scalef32_pk_f32_fp4(vw[j], 1.0f, 0); ac[4 * j + 1] += cf * __builtin_amdgcn_cvt_scalef32_pk_f32_fp4(vw[j], 1.0f, 1); \
                ac[4 * j + 2] += cf * __builtin_amdgcn_cvt_scalef32_pk_f32_fp4(vw[j], 1.0f, 2); ac[4 * j + 3] += cf * __builtin_amdgcn_cvt_scalef32_pk_f32_fp4(vw[j], 1.0f, 3); } } } while (0)
#pragma unroll 1
        for (int g2 = 0; g2 < 4; ++g2) {
            PG_LOAD(rb, 2 * g2 + 1); PG_VACC(ra, 2 * g2);
            if (g2 < 3) PG_LOAD(ra, 2 * g2 + 2);
            PG_VACC(rb, 2 * g2 + 1);
        }
#undef PG_LOAD
#undef PG_VACC
        float acc[16];
#pragma unroll
        for (int q = 0; q < 8; ++q) { const f32x2 mine = hi32 ? ac[8 + q] : ac[q], send = hi32 ? ac[q] : ac[8 + q];
            acc[2 * q] = mine.x + __shfl_xor(send.x, 32); acc[2 * q + 1] = mine.y + __shfl_xor(send.y, 32); }
        const int col0 = 32 * (lane & 31) + 16 * (lane >> 5);
#else
        constexpr int GS = 8, NG2 = 128 / (2 * GS);
        u32x4 ra[GS], rb[GS];
#define PG_LOAD(dst, tab, grp_) do { _Pragma("unroll") for (int q = 0; q < GS; ++q) { const int ii = (grp_) * GS + q; const unsigned e = __builtin_amdgcn_readlane(ii < 64 ? eg0.x : eg1.x, ii & 63); \
            dst[q] = *(const u32x4*)((tab) + (size_t)e * 1024 + lane * 16); } } while (0)
        PG_LOAD(ra, V, 0);
        const float cf0 = __uint_as_float(eg0.y) * gelu_tanh(act0) * VSC[eg0.x], cf1 = __uint_as_float(eg1.y) * gelu_tanh(act1) * VSC[eg1.x];
        f32x2 ac[8];
#pragma unroll
        for (int q = 0; q < 8; ++q) ac[q] = (f32x2){0.f, 0.f};
#define PG_VACC(src, grp_) do { _Pragma("unroll") for (int q = 0; q < GS; ++q) { const int ii = (grp_) * GS + q; const float cf = __int_as_float(__builtin_amdgcn_readlane(__float_as_int(ii < 64 ? cf0 : cf1), ii & 63)); \
            const unsigned vw[4] = {src[q].x, src[q].y, src[q].z, src[q].w}; \
            _Pragma("unroll") for (int j = 0; j < 4; ++j) { ac[2 * j] += cf * __builtin_amdgcn_cvt_pk_f32_fp8((int)vw[j], false); ac[2 * j + 1] += cf * __builtin_amdgcn_cvt_pk_f32_fp8((int)vw[j], true); } } } while (0)
#pragma unroll 1
        for (int g2 = 0; g2 < NG2; ++g2) {
            PG_LOAD(rb, V, 2 * g2 + 1); PG_VACC(ra, 2 * g2);
            if (g2 < NG2 - 1) PG_LOAD(ra, V, 2 * g2 + 2);
            PG_VACC(rb, 2 * g2 + 1);
        }
#undef PG_LOAD
#undef PG_VACC
        float acc[16];
#pragma unroll
        for (int q = 0; q < 8; ++q) { acc[2 * q] = ac[q].x; acc[2 * q + 1] = ac[q].y; }
        const int col0 = lane * 16;
#endif
        const float* gt = mod + smp * 6144 + 5120;
        f32x4 res[4]; float ss = 0.f;
#pragma unroll
        for (int q = 0; q < 4; ++q) { const int c = col0 + q * 4; const f32x4 g = *(const f32x4*)(gt + c), x = *(const f32x4*)(xrow + c);
            res[q] = x + ZF(1) * g * (f32x4){acc[q * 4], acc[q * 4 + 1], acc[q * 4 + 2], acc[q * 4 + 3]};
            *(f32x4*)((wr_override ? wr_override + (size_t)row * DM : xrow) + c) = res[q];
            ss += (res[q][0] * res[q][0] + res[q][1] * res[q][1]) + (res[q][2] * res[q][2] + res[q][3] * res[q][3]); }
        if (l == 0 && !wr_override) {
            const float rs = rsqrtf(wave_sum(ss) * (1.f / DM) + EPSN); const float* mb1 = mod + 3 * 6144 + smp * 6144; const float* g1 = F.in[6] + DM;
            bf16_t* Hw = WSP(bf16_t, WS_H) + (size_t)row * DM;
#pragma unroll
            for (int q = 0; q < 4; ++q) { const int c = col0 + q * 4; const f32x4 g = *(const f32x4*)(g1 + c), sc = *(const f32x4*)(mb1 + 1024 + c), sh = *(const f32x4*)(mb1 + c);
                st4bf(Hw + c, (res[q] * rs * g) * (1.f + sc) + sh); }
        }
    }
}

constexpr int PH_PER_LAYER = 10, N_PHASES = 1 + 2 * PH_PER_LAYER;
struct Args { const float* in[32]; float* out; unsigned char* ws; int ph_lo, ph_hi, li, pad; };
__global__ void __launch_bounds__(NTHR, 2) mk_fwd(Args args) {
    extern __shared__ __attribute__((aligned(16))) unsigned char lds[];
    Ctx F;
    F.lds = (LAS unsigned char*)lds;
    volatile LAS unsigned* MISC = (volatile LAS unsigned*)(F.lds + MISC_OFF);
    F.tid = threadIdx.x; F.lane = F.tid & 63; F.wave = __builtin_amdgcn_readfirstlane(F.tid >> 6);
    F.G = gridDim.x; { const int bx = blockIdx.x; F.vcu = (F.G % 8 == 0) ? (bx % 8) * (F.G / 8) + bx / 8 : bx; }
#pragma unroll
    for (int i = 0; i < 32; ++i) F.in[i] = args.in[i];
    F.out = args.out; F.ws = args.ws;
    for (int u = F.tid; u < (LDS_BYTES - LDSCTL_OFF) / 4; u += NTHR) ((LAS unsigned*)(F.lds + LDSCTL_OFF))[u] = 0u;
    __syncthreads();
    XcdBarrier bar; bar.bar = (unsigned*)(args.ws + WS_CTL) + CW_BAR; bar.x = 0; bar.st = nullptr;
#if !MK_MULTI
    bar = xcd_barrier_post((unsigned*)(args.ws + WS_CTL) + CW_BAR, MISC + 8);
#endif
    const int lo = args.ph_lo, hi = args.ph_hi;
#ifndef KMAX
#define KMAX 1000
#endif
#define IN(k) (lo <= (k) && (k) < hi && (REP_ALL == 1 || ra == REP_ALL - 1 || (k) <= KMAX))
#ifndef REP_PH
#define REP_PH -1
#endif
#define REPS(k) ((REP_PH == (k)) ? 2 : 1)
#define PHCTX Ctx Fp = F; { int t_ = F.tid; asm volatile("" : "+v"(t_)); Fp.tid = t_; Fp.lane = t_ & 63; }
#if MK_MULTI
#define SEAM(k) do { } while (0)
#else
#ifndef BAR_REPS
#define BAR_REPS 1
#endif
#define SEAM(k) do { if (IN(k) && IN((k) + 1)) for (int br_ = 0; br_ < BAR_REPS; ++br_) xcd_barrier(bar); } while (0)
#endif
#ifndef REP_ALL
#define REP_ALL 1
#endif
#ifndef REP_SUB
#define REP_SUB 0
#endif
#pragma unroll 1
    for (int ra = 0; ra < REP_ALL; ++ra) {
    if (ra > 0) xcd_barrier(bar);
    if (IN(0)) { PHCTX; for (int rep = 0; rep < REPS(100); ++rep) phase_prologue(Fp); }
    SEAM(0);
    float* XC = WSP(float, WS_XC);
#pragma unroll 1
    for (int l = 0; l < 2; ++l) {
        const int pb = 1 + l * PH_PER_LAYER;
        const float* xlat = l == 0 ? F.in[0] : F.out; const float* xctx = l == 0 ? F.in[2] : XC;
        const int mrows = l == 0 ? MALL : MLAT;
        const float* mod = WSP(float, WS_MOD) + (size_t)l * 3 * 6144;
        if (IN(pb + 0) && l == 0) { PHCTX; for (int rep = 0; rep < REPS(0); ++rep) { phase_norm(Fp, l, 0, MALL, xlat, xctx); } }
        if (l == 0) SEAM(pb + 0);
        if (IN(pb + 1)) for (int rep = 0; rep < REPS(1); ++rep) { PHCTX; pg8::Gemm g{WSP(bf16_t, WS_H), WSP(bf16_t, WS_WIN + l * WIN_LSTRIDE), MALL, DINP, DM}; pg8::StaticOrder So; So.init(MALL, DINP, F.G, (int)blockIdx.x);
            pg8::EpiBf16 E{WSP(bf16_t, WS_P), DINP}; pg8::gemm_phase<pg8::EpiBf16, pg8::StaticOrder, true, true>(F.lds, g, So, E, Fp.tid); }
        SEAM(pb + 1);
        if (IN(pb + 2)) { PHCTX; for (int rep = 0; rep < REPS(2); ++rep) { phase_prep(Fp, l); __syncthreads(); } }
        SEAM(pb + 2);
        if (IN(pb + 3)) for (int rep = 0; rep < REPS(3); ++rep) {
            const int nra = 16 * RCH, nml = 16 * NCHK;
            for (int r3 = 0; r3 < (REP_SUB == 3 ? 2 : 1); ++r3) { PHCTX; for (int task = F.vcu; task < nra; task += F.G) { RaRaw cur_; ra_load(Fp, task, cur_); rwkv_chunk_pre(Fp, task, cur_); } __syncthreads(); }
            for (int r3 = 0; r3 < (REP_SUB == 4 ? 2 : 1); ++r3) { PHCTX; for (int task = (F.vcu + F.G - 72) % F.G; task < nml; task += F.G) mlstm_local(Fp, task); }
        }
        SEAM(pb + 3);
                if (IN(pb + 4)) for (int rep = 0; rep < REPS(4); ++rep) {
            if (F.vcu < 16) { PHCTX; rwkv_chain(Fp, F.vcu); }
            else { { PHCTX; mlstm_chain(Fp, 16); }
                   { PHCTX; const int natt = l == 0 ? 264 : 256; for (int task = F.vcu - 16; task < natt; task += F.G - 16) attn_unit(Fp, l, task); } } }
        SEAM(pb + 4);
        if (IN(pb + 5)) for (int rep = 0; rep < REPS(5); ++rep) { const int nro = l == 0 ? 264 : 256, nun = l == 0 ? 528 : 512;
            { PHCTX; for (int u = F.vcu; u < nro; u += F.G) rwkv_out(Fp, l, u); }
            { PHCTX; for (int u = (F.vcu + F.G - 8) % F.G; u < nun; u += F.G) mlstm_out(Fp, l, u); } }
        SEAM(pb + 5);
        if (IN(pb + 6)) for (int rep = 0; rep < REPS(6); ++rep) { PHCTX; pg8::Gemm g{WSP(bf16_t, WS_YCAT), WSP(bf16_t, WS_WOUT + l * WOUT_LSTRIDE), mrows, DM, DM}; pg8::StaticOrder So; So.init(mrows, DM, F.G, (int)blockIdx.x);
            float* dummy = WSP(float, WS_YR); const bool dm_ = (REPS(6) == 2 && rep == 0); pg8::EpiRes E{xlat, xctx, dm_ ? dummy : F.out, dm_ ? dummy : XC, mod}; pg8::gemm_phase<pg8::EpiRes, pg8::StaticOrder, true, true>(F.lds, g, So, E, Fp.tid); }
        SEAM(pb + 6);
        if (IN(pb + 7)) { PHCTX; for (int rep = 0; rep < REPS(7); ++rep) phase_norm(Fp, l, 1, mrows, F.out, XC); }
        SEAM(pb + 7);
        if (IN(pb + 8)) for (int rep = 0; rep < REPS(8); ++rep) { PHCTX; pg8::Gemm g{WSP(bf16_t, WS_H), WSP(bf16_t, WS_WEFF + l * WEFF_LSTRIDE), mrows, 2048, DM}; pg8::StaticOrder So; So.init(mrows, 2048, F.G, (int)blockIdx.x);
            pg8::EpiF32 E{WSP(float, WS_S), MALL}; pg8::gemm_phase<pg8::EpiF32, pg8::StaticOrder, true, true>(F.lds, g, So, E, Fp.tid); }
        SEAM(pb + 8);
        if (IN(pb + 9)) { PHCTX; for (int rep = 0; rep < REPS(9); ++rep) { phase_peer(Fp, l, mrows, mod, (REPS(9) == 2 && rep == 0) ? WSP(float, WS_YR) : nullptr); __syncthreads(); } }
        SEAM(pb + 9);
    }
    }
#undef IN
#undef SEAM
}

extern "C" void kernel_launch(void* const* d_in, const int* in_sizes, int n_in, void* d_out, int out_size, void* d_ws, size_t ws_size, hipStream_t stream) {
    static int grid = 0;
    if (grid == 0) {
        if (n_in != 32 || out_size != MLAT * DM || ws_size < WS_END2) { fprintf(stderr, "kernel_launch: unexpected shapes: n_in %d out %d ws %zu (need %zu)\n", n_in, out_size, ws_size, (size_t)WS_END2); grid = -1; return; }
        int dev = 0, cus = 0, per_cu = 0;
        if (hipGetDevice(&dev) != hipSuccess || hipDeviceGetAttribute(&cus, hipDeviceAttributeMultiprocessorCount, dev) != hipSuccess) { grid = -1; return; }
        if (hipFuncSetAttribute((const void*)mk_fwd, hipFuncAttributeMaxDynamicSharedMemorySize, LDS_BYTES) != hipSuccess) { fprintf(stderr, "kernel_launch: hipFuncSetAttribute failed\n"); grid = -1; return; }
        if (hipOccupancyMaxActiveBlocksPerMultiprocessor(&per_cu, (const void*)mk_fwd, NTHR, LDS_BYTES) != hipSuccess || per_cu < 1) fprintf(stderr, "kernel_launch: occupancy query reports %d\n", per_cu);
        (void)hipGetLastError();
        grid = cus;
        if (grid != 256) fprintf(stderr, "kernel_launch: grid %d (built for 256 CUs)\n", grid);
    }
    if (grid < 0) return;
    (void)hipMemsetAsync((char*)d_ws + WS_CTL, 0, CTL_ZERO_BYTES, stream);
    Args a{};
    for (int i = 0; i < 32; ++i) a.in[i] = (const float*)d_in[i];
    a.out = (float*)d_out; a.ws = (unsigned char*)d_ws;
#if MK_MULTI
    for (int p = 0; p < N_PHASES; ++p) { a.ph_lo = p; a.ph_hi = p + 1; a.li = p; hipLaunchKernelGGL(mk_fwd, dim3(grid), dim3(NTHR), LDS_BYTES, stream, a); }
#else
    a.ph_lo = 0; a.ph_hi = N_PHASES; a.li = 0;
    hipLaunchKernelGGL(mk_fwd, dim3(grid), dim3(NTHR), LDS_BYTES, stream, a);
#endif
}
```

```cpp
#include <hip/hip_runtime.h>
#include <cstdio>
#include <cstdint>

#ifndef MK_MULTI
#define MK_MULTI 0
#endif
namespace pg8 {
#define PG8_LAS __attribute__((address_space(3)))
typedef unsigned short bf16_t;
typedef short bf16x8 __attribute__((ext_vector_type(8)));
typedef float f32x4 __attribute__((ext_vector_type(4)));
typedef unsigned u32x4 __attribute__((ext_vector_type(4)));
constexpr int BM = 256, BK = 64, HALF = 128, HTB = HALF * BK * 2  , STAGE_BYTES = 8 * HTB, NXCD = 8, WGM = 8;

__host__ __device__ __forceinline__ int lds_byte(int r, int c) { const int st = (r >> 4) * 2 + (c >> 5), rr = r & 15, cc = c & 31, ob = rr * 64 + cc * 2; return st * 1024 + (ob ^ (((ob >> 9) & 1) << 5)); }
__host__ __device__ __forceinline__ void stage_rc(int b, int& R, int& C) { const int st = b / 1024, sb = b % 1024, swz = sb ^ (((sb >> 9) & 1) << 5); R = (st >> 1) * 16 + swz / 64; C = (st & 1) * 32 + (swz % 64) / 2; }
__host__ __device__ __forceinline__ int perm32(int rho) { const int n = rho >> 4, i = rho & 15; return 8 * (i >> 2) + 4 * n + (i & 3); }

struct Unit { int pm, pn; };
struct Gemm { const bf16_t* A; const bf16_t* Bt; int M, N, K; };

struct StaticOrder {
    int nM, nN, nwg, G, c;
    __host__ __device__ void init(int M, int N, int G_, int c_) { nM = M / BM; nN = N / BM; nwg = nM * nN; G = G_; c = c_; }
    __host__ __device__ bool next(int i, Unit& u) const {
        const long L = (long)i * G + c; if (L >= nwg) return false;
        int wgid = (int)L; { const int q = nwg / NXCD, r = nwg % NXCD, xcd = wgid % NXCD, off = wgid / NXCD; wgid = (xcd < r ? xcd * (q + 1) : r * (q + 1) + (xcd - r) * q) + off; }
        const int nig = WGM * nN, gid = wgid / nig, fm = gid * WGM, gsz = (nM - fm) < WGM ? (nM - fm) : WGM;
        u.pm = fm + ((wgid % nig) % gsz); u.pn = (wgid % nig) / gsz; return true;
    }
    __device__ __forceinline__ void a_ready(const Unit&) const {}
    __device__ __forceinline__ void done(const Unit&) const {}
};

__device__ __forceinline__ unsigned cvt_pk_bf16(float lo, float hi) { unsigned r; asm volatile("v_cvt_pk_bf16_f32 %0, %1, %2" : "=v"(r) : "v"(lo), "v"(hi)); return r; }

struct EpiBf16 {
    static constexpr bool PERM = true, AFTER_DRAIN = false;
    bf16_t* O; int ldc;
    __device__ __forceinline__ void operator()(const f32x4 (&acc)[2][2][4][2], const Unit& u, int wr, int wc, int fr, int fq) const {
        const int row0 = u.pm * BM + wr * 64 + fr; const int col0 = u.pn * BM + wc * 32 + 8 * fq;
#pragma unroll
        for (int ai = 0; ai < 2; ++ai)
#pragma unroll
            for (int m = 0; m < 4; ++m) { bf16_t* rowp = O + (size_t)(row0 + ai * HALF + m * 16) * ldc + col0;
#pragma unroll
                for (int bj = 0; bj < 2; ++bj) { const f32x4 v0 = acc[ai][bj][m][0], v1 = acc[ai][bj][m][1];
                    u32x4 w; w.x = cvt_pk_bf16(v0[0], v0[1]); w.y = cvt_pk_bf16(v0[2], v0[3]); w.z = cvt_pk_bf16(v1[0], v1[1]); w.w = cvt_pk_bf16(v1[2], v1[3]);
                    *(u32x4*)(rowp + bj * HALF) = w; } }
    }
};
struct EpiF32 {
    static constexpr bool PERM = false, AFTER_DRAIN = false;
    float* O; int ldr;
    __device__ __forceinline__ void operator()(const f32x4 (&acc)[2][2][4][2], const Unit& u, int wr, int wc, int fr, int fq) const {
        const int row0 = u.pm * BM + wr * 64 + fr; const int col0 = u.pn * BM + wc * 32 + 4 * fq;
#pragma unroll
        for (int ai = 0; ai < 2; ++ai)
#pragma unroll
            for (int m = 0; m < 4; ++m) { const int row = row0 + ai * HALF + m * 16;
#pragma unroll
                for (int bj = 0; bj < 2; ++bj)
#pragma unroll
                    for (int n = 0; n < 2; ++n) { const int cg = (col0 + bj * HALF + n * 16) >> 2; *(f32x4*)(O + ((size_t)cg * ldr + row) * 4) = acc[ai][bj][m][n]; } }
    }
};
struct EpiRes {
    static constexpr bool PERM = false, AFTER_DRAIN = false;
    const float* src_lat; const float* src_ctx; float* dst_lat; float* dst_ctx; const float* gate;
    __device__ __forceinline__ void operator()(const f32x4 (&acc)[2][2][4][2], const Unit& u, int wr, int wc, int fr, int fq) const {
        const bool isc = u.pm >= 64; const int smp = isc ? 2 : (u.pm >> 5);
        const int prow = (isc ? (u.pm - 64) * BM : u.pm * BM) + wr * 64 + fr;
        const float* src = isc ? src_ctx : src_lat; float* dst = isc ? dst_ctx : dst_lat;
        const float* gt = gate + smp * 6144 + 2048;
        const int col0 = u.pn * BM + wc * 32 + 4 * fq;
        f32x4 gv[2][2];
#pragma unroll
        for (int bj = 0; bj < 2; ++bj)
#pragma unroll
            for (int n = 0; n < 2; ++n) gv[bj][n] = *(const f32x4*)(gt + col0 + bj * HALF + n * 16);
#pragma unroll
        for (int ai = 0; ai < 2; ++ai)
#pragma unroll
            for (int m = 0; m < 4; ++m) { const size_t off = (size_t)(prow + ai * HALF + m * 16) * 1024 + col0;
#pragma unroll
                for (int bj = 0; bj < 2; ++bj)
#pragma unroll
                    for (int n = 0; n < 2; ++n) { const f32x4 s = *(const f32x4*)(src + off + bj * HALF + n * 16);
                        *(f32x4*)(dst + off + bj * HALF + n * 16) = s + gv[bj][n] * acc[ai][bj][m][n]; } }
    }
};

template <class Epi, class Sched, bool ALIGN_EPI = false, bool SP2 = false>
__device__ __forceinline__ void gemm_phase(PG8_LAS unsigned char* lds, const Gemm g, const Sched& S, const Epi& E, const int tid) {
    const int wid = __builtin_amdgcn_readfirstlane(tid >> 6), lane = tid & 63, wr = wid >> 2, wc = wid & 3, fr = lane & 15, fq = lane >> 4;
    const int K = g.K, nt = K / BK;
    unsigned voffA[2], voffB[2];
#pragma unroll
    for (int i = 0; i < 2; ++i) { int R, C; stage_rc(tid * 16 + i * 8192, R, C); const int Rb = Epi::PERM ? ((R & ~31) + perm32(R & 31)) : R;
        voffA[i] = (unsigned)(R * K + C) * 2u; voffB[i] = (unsigned)(Rb * K + C) * 2u; }
    const size_t kstep = (size_t)(BK * 2);
    const size_t hstep = (size_t)HALF * K * 2;
    const size_t tstep = 2 * hstep;
    const unsigned ldsw = (unsigned)wid * 1024u;
    const int aoff = lds_byte(wr * 64 + fr, fq * 8), boff = lds_byte(wc * 32 + fr, fq * 8);
#define PG8_SA(b, h) (((b) * 2 + (h)) * HTB)
#define PG8_SB(b, h) ((4 + (b) * 2 + (h)) * HTB)
#define PG8_STAGE(bufoff, gbase, voff) do { _Pragma("unroll") for (int _i = 0; _i < 2; ++_i) \
        __builtin_amdgcn_global_load_lds((const unsigned*)((const char*)(gbase) + (voff)[_i]), (PG8_LAS unsigned*)(lds + (bufoff) + ldsw + _i * 8192), 16, 0, 0); } while (0)
#define PG8_LDA(dst, b, h) do { _Pragma("unroll") for (int m = 0; m < 4; ++m) _Pragma("unroll") for (int k = 0; k < 2; ++k) dst[m][k] = *(const PG8_LAS bf16x8*)(lds + PG8_SA(b, h) + aoff + m * 2048 + k * 1024); } while (0)
#define PG8_LDB(dst, b, h) do { _Pragma("unroll") for (int n = 0; n < 2; ++n) _Pragma("unroll") for (int k = 0; k < 2; ++k) dst[n][k] = *(const PG8_LAS bf16x8*)(lds + PG8_SB(b, h) + boff + n * 2048 + k * 1024); } while (0)
#define PG8_MMA(ai, bj, At, Bt) do { __builtin_amdgcn_s_setprio(1); _Pragma("unroll") for (int m = 0; m < 4; ++m) _Pragma("unroll") for (int n = 0; n < 2; ++n) _Pragma("unroll") for (int k = 0; k < 2; ++k) \
        acc[ai][bj][m][n] = __builtin_amdgcn_mfma_f32_16x16x32_bf16(Bt[n][k], At[m][k], acc[ai][bj][m][n], 0, 0, 0); __builtin_amdgcn_s_setprio(0); } while (0)
#define PG8_WAIT_V(n) asm volatile("s_waitcnt vmcnt(" #n ")" ::: "memory")
#define PG8_WAIT_L(n) asm volatile("s_waitcnt lgkmcnt(" #n ")" ::: "memory")
#define PG8_BAR __builtin_amdgcn_s_barrier()
#define PG8_SCHED __builtin_amdgcn_sched_barrier(0)
    Unit cur, nxt; int ui = 0;
    if (!S.next(0, cur)) return;
    f32x4 acc[2][2][4][2];
#pragma unroll
    for (int a = 0; a < 2; ++a)
#pragma unroll
        for (int b = 0; b < 2; ++b)
#pragma unroll
            for (int m = 0; m < 4; ++m)
#pragma unroll
                for (int n = 0; n < 2; ++n) acc[a][b][m][n] = (f32x4){0.f, 0.f, 0.f, 0.f};
    bf16x8 At[4][2], B0[2][2], B1[2][2];
    const char* cA = (const char*)g.A + (size_t)cur.pm * tstep; const char* cB = (const char*)g.Bt + (size_t)cur.pn * tstep;
    S.a_ready(cur);
    if constexpr (SP2) {
        PG8_STAGE(PG8_SB(0, 0), cB, voffB); PG8_STAGE(PG8_SB(0, 1), cB + hstep, voffB); PG8_STAGE(PG8_SA(0, 0), cA, voffA); PG8_STAGE(PG8_SA(0, 1), cA + hstep, voffA);
        if (wr == 1) PG8_BAR;
        PG8_WAIT_V(2); PG8_BAR;
        PG8_STAGE(PG8_SB(1, 0), cB + kstep, voffB); PG8_STAGE(PG8_SA(1, 0), cA + kstep, voffA); PG8_STAGE(PG8_SB(1, 1), cB + hstep + kstep, voffB);
        PG8_WAIT_V(6); PG8_BAR;
    } else {
        PG8_STAGE(PG8_SB(0, 0), cB, voffB); PG8_STAGE(PG8_SA(0, 0), cA, voffA); PG8_STAGE(PG8_SB(0, 1), cB + hstep, voffB); PG8_STAGE(PG8_SA(0, 1), cA + hstep, voffA);
        if (wr == 1) PG8_BAR;
        PG8_WAIT_V(4); PG8_BAR;
        PG8_STAGE(PG8_SB(1, 0), cB + kstep, voffB); PG8_STAGE(PG8_SA(1, 0), cA + kstep, voffA); PG8_STAGE(PG8_SB(1, 1), cB + hstep + kstep, voffB);
        PG8_WAIT_V(6); PG8_BAR;
    }
    for (;;) {
        const bool has_next = S.next(ui + 1, nxt);
        const char* nA = has_next ? (const char*)g.A + (size_t)nxt.pm * tstep : cA; const char* nB = has_next ? (const char*)g.Bt + (size_t)nxt.pn * tstep : cB;
        for (int t = 0; t < nt; t += 2) {
            const bool last = (t == nt - 2);
            const char* a1 = cA + (size_t)(t + 1) * kstep;
            const char* a2 = last ? nA : cA + (size_t)(t + 2) * kstep; const char* b2 = last ? nB : cB + (size_t)(t + 2) * kstep;
            const char* a3 = a2 + kstep; const char* b3 = b2 + kstep;
            if (last && has_next) S.a_ready(nxt);
            if constexpr (SP2) {
            PG8_LDB(B0, 0, 0); PG8_LDB(B1, 0, 1); PG8_SCHED; PG8_LDA(At, 0, 0); PG8_STAGE(PG8_SA(1, 1), a1 + hstep, voffA);
            PG8_WAIT_V(8); PG8_WAIT_L(0); PG8_BAR; PG8_MMA(0, 0, At, B0); PG8_MMA(0, 1, At, B1); PG8_BAR; PG8_SCHED;
            PG8_LDA(At, 0, 1); PG8_STAGE(PG8_SB(0, 0), b2, voffB); PG8_STAGE(PG8_SB(0, 1), b2 + hstep, voffB); PG8_STAGE(PG8_SA(0, 0), a2, voffA);
            PG8_WAIT_V(8); PG8_WAIT_L(0); PG8_BAR; PG8_MMA(1, 0, At, B0); PG8_MMA(1, 1, At, B1); PG8_BAR; PG8_SCHED;
            PG8_LDB(B0, 1, 0); PG8_LDB(B1, 1, 1); PG8_SCHED; PG8_LDA(At, 1, 0); PG8_STAGE(PG8_SA(0, 1), a2 + hstep, voffA);
            PG8_WAIT_V(8); PG8_WAIT_L(0); PG8_BAR; PG8_MMA(0, 0, At, B0); PG8_MMA(0, 1, At, B1); PG8_BAR; PG8_SCHED;
            PG8_LDA(At, 1, 1); PG8_STAGE(PG8_SB(1, 0), b3, voffB); PG8_STAGE(PG8_SB(1, 1), b3 + hstep, voffB); PG8_STAGE(PG8_SA(1, 0), a3, voffA);
            PG8_WAIT_V(8); PG8_WAIT_L(0); PG8_BAR; PG8_MMA(1, 0, At, B0); PG8_MMA(1, 1, At, B1); PG8_BAR; PG8_SCHED;
            } else {
            PG8_LDB(B0, 0, 0); PG8_SCHED; PG8_LDA(At, 0, 0); PG8_STAGE(PG8_SA(1, 1), a1 + hstep, voffA);
            PG8_WAIT_L(8); PG8_BAR; PG8_WAIT_L(0); PG8_MMA(0, 0, At, B0); PG8_BAR; PG8_SCHED;
            PG8_LDB(B1, 0, 1); PG8_STAGE(PG8_SB(0, 0), b2, voffB);
            PG8_BAR; PG8_WAIT_L(0); PG8_MMA(0, 1, At, B1); PG8_BAR;
            PG8_LDA(At, 0, 1); PG8_STAGE(PG8_SA(0, 0), a2, voffA);
            PG8_BAR; PG8_WAIT_L(0); PG8_MMA(1, 0, At, B0); PG8_BAR; PG8_SCHED;
            PG8_STAGE(PG8_SB(0, 1), b2 + hstep, voffB);
            PG8_WAIT_V(6); PG8_BAR; PG8_MMA(1, 1, At, B1); PG8_BAR;
            PG8_LDB(B0, 1, 0); PG8_SCHED; PG8_LDA(At, 1, 0); PG8_STAGE(PG8_SA(0, 1), a2 + hstep, voffA);
            PG8_WAIT_L(8); PG8_BAR; PG8_WAIT_L(0); PG8_MMA(0, 0, At, B0); PG8_BAR; PG8_SCHED;
            PG8_LDB(B1, 1, 1); PG8_STAGE(PG8_SB(1, 0), b3, voffB);
            PG8_BAR; PG8_WAIT_L(0); PG8_MMA(0, 1, At, B1); PG8_BAR;
            PG8_LDA(At, 1, 1); PG8_STAGE(PG8_SA(1, 0), a3, voffA);
            PG8_BAR; PG8_WAIT_L(0); PG8_MMA(1, 0, At, B0); PG8_BAR; PG8_SCHED;
            PG8_STAGE(PG8_SB(1, 1), b3 + hstep, voffB);
            PG8_WAIT_V(6); PG8_BAR; PG8_MMA(1, 1, At, B1); PG8_BAR;
            }
        }
        if constexpr (ALIGN_EPI) { if (wr == 0) PG8_BAR; }
        if constexpr (!Epi::AFTER_DRAIN) { E(acc, cur, wr, wc, fr, fq); S.done(cur); }
        if (!has_next) break;
#pragma unroll
        for (int a = 0; a < 2; ++a)
#pragma unroll
            for (int b = 0; b < 2; ++b)
#pragma unroll
                for (int m = 0; m < 4; ++m)
#pragma unroll
                    for (int n = 0; n < 2; ++n) acc[a][b][m][n] = (f32x4){0.f, 0.f, 0.f, 0.f};
        cur = nxt; cA = nA; cB = nB; ++ui;
        if constexpr (ALIGN_EPI) { if (wr == 1) PG8_BAR; }
    }
    PG8_WAIT_V(0);
    if constexpr (!ALIGN_EPI) { if (wr == 0) PG8_BAR; }
    PG8_BAR;
    if constexpr (Epi::AFTER_DRAIN) { E.fused(acc, cur, wr, wc, fr, fq, lds, wid, lane); S.done(cur); }
#undef PG8_SA
#undef PG8_SB
#undef PG8_STAGE
#undef PG8_LDA
#undef PG8_LDB
#undef PG8_MMA
#undef PG8_WAIT_V
#undef PG8_WAIT_L
#undef PG8_BAR
#undef PG8_SCHED
}
}
#ifndef ZMASK
#define ZMASK 0
#endif
#define ZF(bit) ((ZMASK & (bit)) ? 0.f : 1.f)
using pg8::bf16_t; using pg8::bf16x8; using pg8::f32x4; using pg8::u32x4;
constexpr int NWAVES = 8, NTHR = 512;
constexpr int DM = 1024, TLAT = 8192, TCTX = 256, MLAT = 2 * TLAT, MCTX = 2 * TCTX, MALL = MLAT + MCTX;
constexpr int DIN = 3152, DINP = 3328;
constexpr int C_CH = 0, C_CB = 256, C_CC = 512, C_RR = 768, C_RK = 1024, C_RV = 1280, C_XW = 1536, C_XA = 1552, C_XG = 1568,
              C_AQ = 1600, C_AK = 1856, C_AV = 1984, C_MQ = 2112, C_MK = 2368, C_MV = 2624, C_MO = 2880, C_MG = 3136;
constexpr float EPSN = 1e-6f;
constexpr int NCHK = 66;
constexpr int CST = 4160;
constexpr int RWREC = 4608;
constexpr size_t MiB = 1u << 20;
constexpr size_t WS_CTL = 0, CTL_ZERO_BYTES = 1 * MiB, WS_MOD = 1 * MiB;
constexpr size_t WS_WIN = 2 * MiB, WIN_LSTRIDE = (size_t)DINP * DM * 2;
constexpr size_t WS_WOUT = 16 * MiB, WOUT_LSTRIDE = 2 * MiB;
constexpr size_t WS_WEFF = 20 * MiB, WEFF_LSTRIDE = 4 * MiB;
constexpr size_t WS_XC = 28 * MiB, WS_GA = 30 * MiB, WS_H = 32 * MiB, WS_YCAT = 65 * MiB, WS_U = 98 * MiB, WS_V = 130 * MiB;
constexpr size_t WS_P = 162 * MiB, WS_RW = 270 * MiB, WS_YR = 345 * MiB, WS_QA = 378 * MiB, WS_KA = 387 * MiB;
constexpr size_t WS_LC = 392 * MiB, WS_ST = 409 * MiB, WS_LB = 426 * MiB, WS_EG = 427 * MiB, WS_GB = 444 * MiB, WS_BS = 453 * MiB, WS_SC = 453 * MiB + 512 * 1024, WS_END = 454 * MiB;
constexpr size_t UV_LSTRIDE = 16 * MiB;
constexpr size_t WS_S = WS_P;
static_assert(WS_P + (size_t)MALL * DINP * 2 <= WS_RW && WS_RW + (size_t)MALL * RWREC <= WS_YR && WS_S + (size_t)MALL * 2048 * 4 <= WS_YR, "ws map");
static_assert(WS_LC + (size_t)16 * NCHK * CST * 4 <= WS_ST && WS_ST + (size_t)16 * NCHK * CST * 4 <= WS_LB && WS_EG + (size_t)MALL * 128 * 8 <= WS_GB, "ws map 2");
constexpr int CW_BAR = 4096;
constexpr int RING_BYTES = 131072;
#ifndef U_FP4
#define U_FP4 1
#endif
#ifndef V_FP4
#define V_FP4 1
#endif
constexpr int PEER_WLDS = U_FP4 ? 16 * 528 + 2048 + 512 : 16 * 1040 + 2048 + 512;
constexpr int PHASE_LDS = 8 * PEER_WLDS > RING_BYTES ? 8 * PEER_WLDS : RING_BYTES;
constexpr int LDSCTL_OFF = PHASE_LDS, MISC_OFF = LDSCTL_OFF + 320, LDS_BYTES = PHASE_LDS + 4096;
static_assert(RING_BYTES <= PHASE_LDS && 8 * PEER_WLDS <= PHASE_LDS && LDS_BYTES <= 160 * 1024 && PHASE_LDS % 16 == 0, "LDS map");

#define GAS __attribute__((address_space(1)))
#define LAS __attribute__((address_space(3)))
typedef unsigned u32x2 __attribute__((ext_vector_type(2)));
typedef float f32x2 __attribute__((ext_vector_type(2)));
typedef int i32x8 __attribute__((ext_vector_type(8)));
typedef __bf16 bf16x2_t __attribute__((ext_vector_type(2)));
typedef GAS unsigned gu32;
#define LDS_WAIT() asm volatile("s_waitcnt lgkmcnt(0)" ::: "memory")
#define LDS_BARRIER() do { asm volatile("s_waitcnt lgkmcnt(0)" ::: "memory"); __builtin_amdgcn_s_barrier(); asm volatile("" ::: "memory"); } while (0)

__device__ __forceinline__ float lo2f(unsigned w) { return __uint_as_float(w << 16); }
__device__ __forceinline__ float hi2f(unsigned w) { return __uint_as_float(w & 0xffff0000u); }
__device__ __forceinline__ float bf2f(bf16_t b) { return __uint_as_float((unsigned)b << 16); }
__device__ __forceinline__ unsigned f2bf(float f) { unsigned u = __float_as_uint(f); return (u + 0x7fffu + ((u >> 16) & 1u)) >> 16; }
__device__ __forceinline__ unsigned pk2(float lo, float hi) { const f32x2 v = {lo, hi}; const bf16x2_t b = __builtin_convertvector(v, bf16x2_t); return __builtin_bit_cast(unsigned, b); }
__device__ __forceinline__ f32x4 ld4bf(const bf16_t* p) { const u32x2 w = *(const u32x2*)p; return (f32x4){lo2f(w.x), hi2f(w.x), lo2f(w.y), hi2f(w.y)}; }
__device__ __forceinline__ void st4bf(bf16_t* p, f32x4 v) { u32x2 w; w.x = pk2(v[0], v[1]); w.y = pk2(v[2], v[3]); *(u32x2*)p = w; }
__device__ __forceinline__ float sigmoidf_(float x) { return 1.f / (1.f + __expf(-x)); }
__device__ __forceinline__ float tanhf_(float x) { const float e = __expf(-2.f * fabsf(x)); const float t = (1.f - e) / (1.f + e); return x < 0.f ? -t : t; }
template <int CTRL> __device__ __forceinline__ float dppf(float x) { return __int_as_float(__builtin_amdgcn_update_dpp(0, __float_as_int(x), CTRL, 0xf, 0xf, true)); }
__device__ __forceinline__ float red16(float x) { x += dppf<0xB1>(x); x += dppf<0x4E>(x); x += dppf<0x141>(x); x += dppf<0x140>(x); return x; }
__device__ __forceinline__ float wave_sum(float v) {
#pragma unroll
    for (int o = 1; o < 64; o <<= 1) v += __shfl_xor(v, o);
    return v;
}
#define XB_TMO      128
#define XB_XCNT(j)  (256  + 64 * (j))
#define XB_XSUB(j)  (1280 + 64 * (j))
#define XB_XGEN(j)  (2304 + 64 * (j))
#define XB_TOP      3328
#define XB_TOPGEN   3392
#define XCD_BAR_WORDS 3456
#define XB_SPIN_CAP (1u << 18)
#ifndef XB_SLEEP
#define XB_SLEEP 1
#endif

__device__ __forceinline__ unsigned xb_ld(unsigned* p)              { return __hip_atomic_load(p, __ATOMIC_RELAXED, __HIP_MEMORY_SCOPE_AGENT); }
__device__ __forceinline__ unsigned xb_add(unsigned* p, unsigned v) { return __hip_atomic_fetch_add(p, v, __ATOMIC_RELAXED, __HIP_MEMORY_SCOPE_AGENT); }
__device__ __forceinline__ unsigned xb_xcc_id() { return (unsigned)__builtin_amdgcn_s_getreg((3 << 11) | 20) & 0xFu; }
#define XB_SPIN(cond, bar) do { unsigned _sp = 0; while (cond) { __builtin_amdgcn_s_sleep(XB_SLEEP); \
    if ((++_sp & 255u) == 0u) { if (xb_ld(&(bar)[XB_TMO])) break; if (_sp > XB_SPIN_CAP) { atomicAdd(&(bar)[XB_TMO], 1u); break; } } } } while (0)

struct XcdBarrier {
    unsigned* bar; unsigned x;
    volatile LAS unsigned* st;
};

__device__ __forceinline__ XcdBarrier xcd_barrier_post(unsigned* bar, volatile LAS unsigned* st) {
    XcdBarrier b; b.bar = bar; b.x = xb_xcc_id(); b.st = st;
    if (threadIdx.x == 0) (void)xb_add(&bar[XB_XCNT(b.x)], 1u);
    return b;
}
__device__ __forceinline__ void xcd_barrier_complete(unsigned* bar, unsigned x, unsigned& nloc, unsigned& nx) {
    const unsigned G = gridDim.x * gridDim.y * gridDim.z;
    unsigned sum, cnt, mine, sp = 0u;
    for (;;) {
        sum = 0u; cnt = 0u; mine = 0u;
#pragma unroll
        for (unsigned j = 0; j < 16; ++j) { const unsigned c = xb_ld(&bar[XB_XCNT(j)]); sum += c; cnt += (c > 0u) ? 1u : 0u; mine = (j == x) ? c : mine; }
        if (sum == G) break;
        __builtin_amdgcn_s_sleep(1);
        if ((++sp & 255u) == 0u) { if (xb_ld(&bar[XB_TMO])) break; if (sp > XB_SPIN_CAP) { atomicAdd(&bar[XB_TMO], 1u); break; } }
    }
    nloc = mine > 0u ? mine : 1u; nx = cnt > 0u ? cnt : 1u;
}

__device__ __forceinline__ void xcd_barrier(const XcdBarrier& b) {
    asm volatile("s_waitcnt vmcnt(0)" ::: "memory");
    __syncthreads();
    if (threadIdx.x == 0) {
        unsigned* bar = b.bar;
        __builtin_amdgcn_s_waitcnt(0);
        unsigned nloc = b.st[0], nx = b.st[1];
        if (nloc == 0u) { xcd_barrier_complete(bar, b.x, nloc, nx); b.st[0] = nloc; b.st[1] = nx; }
        const unsigned old = xb_add(&bar[XB_XSUB(b.x)], 1u);
        const unsigned gen = old / nloc;
        if (old + 1u == (gen + 1u) * nloc) {
            __builtin_amdgcn_fence(__ATOMIC_RELEASE, "agent");
            asm volatile("s_waitcnt vmcnt(0)" ::: "memory");
            const unsigned og = xb_add(&bar[XB_TOP], 1u);
            const unsigned tg = og / nx;
            if (og + 1u == (tg + 1u) * nx) xb_add(&bar[XB_TOPGEN], 1u);
            else XB_SPIN(xb_ld(&bar[XB_TOPGEN]) == tg, bar);
            __builtin_amdgcn_fence(__ATOMIC_ACQUIRE, "agent");
            xb_add(&bar[XB_XGEN(b.x)], 1u);
            asm volatile("s_waitcnt vmcnt(0)" ::: "memory");
        } else {
            XB_SPIN(xb_ld(&bar[XB_XGEN(b.x)]) == gen, bar);
            __builtin_amdgcn_fence(__ATOMIC_ACQUIRE, "agent");
            asm volatile("s_waitcnt vmcnt(0)" ::: "memory");
        }
    }
    __syncthreads();
}
struct Ctx {
    LAS unsigned char* lds; int tid, lane, wave, vcu, G;
    const float* in[32]; float* out; unsigned char* ws;
};
#define WSP(T, off) ((T*)(F.ws + (off)))

__device__ __forceinline__ void p0_transpose_item(const float* W, int K, int N, bf16_t* WT, LAS float* scr, int item, int lane) {
    const int nblk = (N + 31) / 32, kb = item / nblk, nb = item % nblk, k0 = 64 * kb, n0 = 32 * nb;
    const int nn = n0 + (lane & 31);
#pragma unroll 8
    for (int i = 0; i < 32; ++i) { const int kk = 2 * i + (lane >> 5); scr[kk * 33 + (lane & 31)] = nn < N ? W[(size_t)(k0 + kk) * N + nn] : 0.f; }
    LDS_WAIT(); asm volatile("" ::: "memory");
    const int c = lane & 7;
#pragma unroll
    for (int j = 0; j < 4; ++j) { const int n = (lane >> 3) + 8 * j; const LAS float* s = scr + (8 * c) * 33 + n;
        u32x4 o; o.x = pk2(s[0 * 33], s[1 * 33]); o.y = pk2(s[2 * 33], s[3 * 33]); o.z = pk2(s[4 * 33], s[5 * 33]); o.w = pk2(s[6 * 33], s[7 * 33]);
        *(u32x4*)(WT + (size_t)(n0 + n) * K + k0 + 8 * c) = o; }
    LDS_WAIT(); asm volatile("" ::: "memory");
}
__device__ __forceinline__ void convert_uv_rows(const Ctx& F, int l, int r_lo, int r_hi, int widx, int nworkers) {
    float* SC = WSP(float, WS_SC) + (size_t)l * 2 * 16384;
    for (int r0 = r_lo + widx; r0 < r_hi; r0 += 4 * nworkers) {
        f32x4 v[4][4];
#pragma unroll
        for (int u = 0; u < 4; ++u) { const int r = r0 + u * nworkers < r_hi ? r0 + u * nworkers : r0; const int tb = r >> 14, row = r & 16383;
            const float* src = (tb ? F.in[31] : F.in[30]) + ((size_t)l * 16384 + row) * 1024 + F.lane * 16;
#pragma unroll
            for (int j = 0; j < 4; ++j) v[u][j] = *(const f32x4*)(src + 4 * j); }
#pragma unroll
        for (int u = 0; u < 4; ++u) { const int r = r0 + u * nworkers; if (r >= r_hi) break; const int tb = r >> 14, row = r & 16383;
            float am = 0.f;
#pragma unroll
            for (int j = 0; j < 4; ++j) am = fmaxf(am, fmaxf(fmaxf(fabsf(v[u][j][0]), fabsf(v[u][j][1])), fmaxf(fabsf(v[u][j][2]), fabsf(v[u][j][3]))));
#pragma unroll
            for (int o = 1; o < 64; o <<= 1) am = fmaxf(am, __shfl_xor(am, o));
            if (tb ? V_FP4 : U_FP4) {
            const float sc = am > 0.f ? 6.f / am : 1.f;
            unsigned ow[2] = {0u, 0u};
#pragma unroll
            for (int j = 0; j < 4; ++j) { unsigned w = ow[j >> 1];
                if (j & 1) { w = __builtin_amdgcn_cvt_scalef32_pk_fp4_f32(w, v[u][j][0] * sc, v[u][j][1] * sc, 1.0f, 2); w = __builtin_amdgcn_cvt_scalef32_pk_fp4_f32(w, v[u][j][2] * sc, v[u][j][3] * sc, 1.0f, 3); }
                else       { w = __builtin_amdgcn_cvt_scalef32_pk_fp4_f32(w, v[u][j][0] * sc, v[u][j][1] * sc, 1.0f, 0); w = __builtin_amdgcn_cvt_scalef32_pk_fp4_f32(w, v[u][j][2] * sc, v[u][j][3] * sc, 1.0f, 1); }
                ow[j >> 1] = w; }
            *(u32x2*)(F.ws + (tb ? WS_V : WS_U) + (size_t)l * UV_LSTRIDE + (size_t)row * 512 + F.lane * 8) = (u32x2){ow[0], ow[1]};
            if (F.lane == 0) SC[tb * 16384 + row] = am > 0.f ? am * (1.f / 6.f) : 1.f;
            } else {
            const float sc = am > 0.f ? 448.f / am : 1.f;
            unsigned ow[4];
#pragma unroll
            for (int j = 0; j < 4; ++j) { int w = __builtin_amdgcn_cvt_pk_fp8_f32(v[u][j][0] * sc, v[u][j][1] * sc, 0, false); w = __builtin_amdgcn_cvt_pk_fp8_f32(v[u][j][2] * sc, v[u][j][3] * sc, w, true); ow[j] = (unsigned)w; }
            *(u32x4*)(F.ws + (tb ? WS_V : WS_U) + (size_t)l * UV_LSTRIDE + (size_t)row * 1024 + F.lane * 16) = (u32x4){ow[0], ow[1], ow[2], ow[3]};
            if (F.lane == 0) SC[tb * 16384 + row] = am > 0.f ? am * (1.f / 448.f) : 1.f;
            } }
    }
}
__device__ __forceinline__ void convert_uv(const Ctx& F, int l) { convert_uv_rows(F, l, 0, 2 * 16384, F.vcu * NWAVES + F.wave, F.G * NWAVES); }
__device__ __forceinline__ void phase_prologue(const Ctx& F) {
    float* MOD = WSP(float, WS_MOD);
    {
        LAS float* sl = (LAS float*)F.lds; LAS float* red = sl + 3072;
        for (int it = F.vcu; it < 192; it += F.G) {
            const int l = it / 96, n0 = (it % 96) * 64;
            for (int i = F.tid; i < 3072; i += NTHR) { const int s = i >> 10, k = i & 1023; const float c = s < 2 ? F.in[1][s * 1024 + k] : F.in[3][k]; sl[i] = c / (1.f + __expf(-c)); }
            __syncthreads();
            const int c = F.tid & 63, kg = F.tid >> 6;
            const float* W = F.in[4] + (size_t)l * 1024 * 6144 + n0 + c;
            float a0 = 0.f, a1 = 0.f, a2 = 0.f;
#pragma unroll 32
            for (int k = kg * 128; k < kg * 128 + 128; ++k) { const float w = W[(size_t)k * 6144]; a0 += sl[k] * w; a1 += sl[1024 + k] * w; a2 += sl[2048 + k] * w; }
            red[(kg * 3 + 0) * 64 + c] = a0; red[(kg * 3 + 1) * 64 + c] = a1; red[(kg * 3 + 2) * 64 + c] = a2;
            __syncthreads();
            if (F.tid < 192) { const int s = F.tid >> 6, cc = F.tid & 63; float t = F.in[5][l * 6144 + n0 + cc];
#pragma unroll
                for (int g = 0; g < 8; ++g) t += red[(g * 3 + s) * 64 + cc];
                MOD[(l * 3 + s) * 6144 + n0 + cc] = t; }
            __syncthreads();
        }
    }
    {
        LAS float* scr = (LAS float*)(F.lds + F.wave * 16384);
        const int gw = F.vcu * NWAVES + F.wave, NGW = F.G * NWAVES;
        constexpr int I_IN = 16 * 99, I_OUT = 16 * 32, I_L = I_IN + I_OUT;
        for (int it = gw; it < 2 * I_L; it += NGW) {
            const int l = it / I_L; int r = it % I_L;
            if (r < I_IN) p0_transpose_item(F.in[8] + (size_t)l * DM * DIN, DM, DIN, WSP(bf16_t, WS_WIN + l * WIN_LSTRIDE), scr, r, F.lane);
            else p0_transpose_item(F.in[9] + (size_t)l * DM * DM, DM, DM, WSP(bf16_t, WS_WOUT + l * WOUT_LSTRIDE), scr, r - I_IN, F.lane);
        }
        for (int i = F.vcu * NTHR + F.tid; i < 2 * 160 * 128; i += F.G * NTHR) { const int l = i / (160 * 128), r = i % (160 * 128);
            *(u32x4*)(WSP(bf16_t, WS_WIN + l * WIN_LSTRIDE) + (size_t)3168 * DM + (size_t)r * 8) = (u32x4){0u, 0u, 0u, 0u}; }
    }
    __syncthreads();
    {
        LAS float* KEYS = (LAS float*)F.lds; LAS float* WQl = KEYS + 128 * 129;
        const int nper = F.G / 32 > 0 ? F.G / 32 : 1;
        const int tile = F.vcu / nper, sub = F.vcu % nper;
        if (tile < 32) {
            const int l = tile >> 4, hh = tile & 15;
            const float* ksrc = F.in[29] + ((size_t)l * 16 + hh) * 128 * 128;
            { f32x4 kv[8];
#pragma unroll
              for (int q = 0; q < 8; ++q) kv[q] = *(const f32x4*)(ksrc + (size_t)(F.tid + q * NTHR) * 4);
#pragma unroll
              for (int q = 0; q < 8; ++q) { const int i = (F.tid + q * NTHR) * 4; LAS float* d = KEYS + (i >> 7) * 129 + (i & 127); d[0] = kv[q][0]; d[1] = kv[q][1]; d[2] = kv[q][2]; d[3] = kv[q][3]; } }
            for (int kb = sub; kb < 16; kb += nper) {
                const float* wsrc = F.in[28] + (size_t)l * DM * 2048 + (size_t)(kb * 64) * 2048 + hh * 128;
                __syncthreads();
                { f32x4 wv[4];
#pragma unroll
                  for (int q = 0; q < 4; ++q) { const int i = (F.tid + q * NTHR) * 4; wv[q] = *(const f32x4*)(wsrc + (size_t)(i >> 7) * 2048 + (i & 127)); }
#pragma unroll
                  for (int q = 0; q < 4; ++q) { const int i = (F.tid + q * NTHR) * 4, kk = i >> 7, d = i & 127; WQl[d * 68 + kk] = wv[q][0]; WQl[(d + 1) * 68 + kk] = wv[q][1]; WQl[(d + 2) * 68 + kk] = wv[q][2]; WQl[(d + 3) * 68 + kk] = wv[q][3]; } }
                __syncthreads();
                const int key = F.tid & 127, kq = F.tid >> 7;
                float acc[16];
#pragma unroll
                for (int j = 0; j < 16; ++j) acc[j] = 0.f;
#pragma unroll 4
                for (int d = 0; d < 128; ++d) { const float a = KEYS[key * 129 + d]; const LAS f32x4* wq = (const LAS f32x4*)(WQl + d * 68 + kq * 16);
#pragma unroll
                    for (int q = 0; q < 4; ++q) { const f32x4 w = wq[q]; acc[4 * q] += a * w[0]; acc[4 * q + 1] += a * w[1]; acc[4 * q + 2] += a * w[2]; acc[4 * q + 3] += a * w[3]; } }
                bf16_t* dst = WSP(bf16_t, WS_WEFF + l * WEFF_LSTRIDE) + (size_t)(hh * 128 + key) * DM + kb * 64 + kq * 16;
                u32x4 o0, o1; o0.x = pk2(acc[0], acc[1]); o0.y = pk2(acc[2], acc[3]); o0.z = pk2(acc[4], acc[5]); o0.w = pk2(acc[6], acc[7]);
                o1.x = pk2(acc[8], acc[9]); o1.y = pk2(acc[10], acc[11]); o1.z = pk2(acc[12], acc[13]); o1.w = pk2(acc[14], acc[15]);
                *(u32x4*)dst = o0; *(u32x4*)(dst + 8) = o1;
            }
        }
        __syncthreads();
    }
    convert_uv(F, 0); convert_uv(F, 1);
}

__device__ __forceinline__ void phase_norm(const Ctx& F, int l, int which, int nrows, const float* xlat, const float* xctx) {
    const float* gain = F.in[6 + which] + l * DM; const float* mod = WSP(float, WS_MOD) + (size_t)l * 3 * 6144;
    const int shoff = which ? 3072 : 0, scoff = which ? 4096 : 1024;
    bf16_t* H = WSP(bf16_t, WS_H);
    const int gw = F.vcu * NWAVES + F.wave, NGW = F.G * NWAVES;
    for (int row = gw; row < nrows; row += NGW) {
        const bool isc = row >= MLAT; const float* src = isc ? xctx + (size_t)(row - MLAT) * DM : xlat + (size_t)row * DM; const int smp = isc ? 2 : (row >> 13);
        const float* mb = mod + smp * 6144;
        f32x4 v[4]; float ss = 0.f;
#pragma unroll
        for (int j = 0; j < 4; ++j) { v[j] = *(const f32x4*)(src + F.lane * 4 + 256 * j); ss += (v[j][0] * v[j][0] + v[j][1] * v[j][1]) + (v[j][2] * v[j][2] + v[j][3] * v[j][3]); }
        const float rs = rsqrtf(wave_sum(ss) * (1.f / DM) + EPSN);
#pragma unroll
        for (int j = 0; j < 4; ++j) { const int c = F.lane * 4 + 256 * j; const f32x4 g = *(const f32x4*)(gain + c), sc = *(const f32x4*)(mb + scoff + c), sh = *(const f32x4*)(mb + shoff + c);
            const f32x4 o = (v[j] * rs * g) * (1.f + sc) + sh; st4bf(H + (size_t)row * DM + c, o); }
    }
}

__device__ __forceinline__ float log_sigmoid_(float x) { return fminf(x, 0.f) - __logf(1.f + __expf(-fabsf(x))); }
__device__ __forceinline__ void phase_prep(const Ctx& F, int l) {
    LAS float* W2s = (LAS float*)F.lds; LAS float* A2s = W2s + 8192; LAS float* G2s = A2s + 8192; LAS float* tsc = G2s + 8192 + F.wave * 64;
    { const float* w2 = F.in[13] + l * 8192; const float* a2 = F.in[15] + l * 8192; const float* g2 = F.in[16] + l * 8192;
      for (int i = F.tid; i < 8192; i += NTHR) { W2s[i] = w2[i]; A2s[i] = a2[i]; G2s[i] = g2[i]; } }
    __syncthreads();
    const bf16_t* P = WSP(bf16_t, WS_P); bf16_t* YC = WSP(bf16_t, WS_YCAT); bf16_t* QA = WSP(bf16_t, WS_QA); bf16_t* KA = WSP(bf16_t, WS_KA);
    unsigned char* RW = WSP(unsigned char, WS_RW); bf16_t* GB = WSP(bf16_t, WS_GB); float* BS = WSP(float, WS_BS); float* GA = WSP(float, WS_GA);
    const int lane = F.lane, c4 = lane * 4, i16 = lane & 15;
    const f32x4 cw0 = *(const f32x4*)(F.in[10] + l * 768 + c4), cw1 = *(const f32x4*)(F.in[10] + l * 768 + 256 + c4), cw2 = *(const f32x4*)(F.in[10] + l * 768 + 512 + c4);
    const f32x4 cg = *(const f32x4*)(F.in[11] + l * 256 + c4);
    const f32x4 qg = *(const f32x4*)(F.in[21] + l * 64 + (c4 & 63)), kg = *(const f32x4*)(F.in[22] + l * 64 + (c4 & 63));
    const f32x4 k_k = *(const f32x4*)(F.in[17] + l * 256 + c4), k_a = *(const f32x4*)(F.in[18] + l * 256 + c4), r_k = *(const f32x4*)(F.in[19] + l * 256 + c4);
    f32x4 w0[2], a0[2];
#pragma unroll
    for (int d = 0; d < 2; ++d) { w0[d] = *(const f32x4*)(F.in[12] + (l * 2 + d) * 256 + c4); a0[d] = *(const f32x4*)(F.in[14] + (l * 2 + d) * 256 + c4); }
    float invf[4];
#pragma unroll
    for (int j = 0; j < 4; ++j) invf[j] = exp2f(-(float)((c4 + j) & 15) * (13.287712379549449f / 16.f));
    const int gw = F.vcu * NWAVES + F.wave, NGW = F.G * NWAVES;
    struct PrepRaw { u32x2 h1, bg, c1, hp, cp, hn, cn, q, k, r, rk; unsigned xv, mg; };
#define PREP_LOAD(dst, row_) do { const int r_ = (row_); const bool isc_ = r_ >= MLAT; const int t_ = isc_ ? ((r_ - MLAT) & 255) : (r_ & 8191); const int T_ = isc_ ? TCTX : TLAT; \
        const bf16_t* pr_ = P + (size_t)r_ * DINP; const bf16_t* pp_ = t_ > 0 ? pr_ - DINP : pr_; const bf16_t* pn_ = t_ < T_ - 1 ? pr_ + DINP : pr_; \
        dst.h1 = *(const u32x2*)(pr_ + C_CH + c4); dst.bg = *(const u32x2*)(pr_ + C_CB + c4); dst.c1 = *(const u32x2*)(pr_ + C_CC + c4); \
        dst.hp = *(const u32x2*)(pp_ + C_CH + c4); dst.cp = *(const u32x2*)(pp_ + C_CC + c4); dst.hn = *(const u32x2*)(pn_ + C_CH + c4); dst.cn = *(const u32x2*)(pn_ + C_CC + c4); \
        dst.q = *(const u32x2*)(pr_ + C_AQ + c4); dst.k = *(const u32x2*)(pr_ + C_AK + (c4 & 127)); dst.r = *(const u32x2*)(pr_ + C_RR + c4); dst.rk = *(const u32x2*)(pr_ + C_RK + c4); \
        dst.xv = pr_[C_XW + lane]; dst.mg = pr_[C_MG + (lane & 15)]; } while (0)
#define UP4(w_) ((f32x4){lo2f((w_).x), hi2f((w_).x), lo2f((w_).y), hi2f((w_).y)})
    PrepRaw cur, nxt;
    if (gw < MALL) PREP_LOAD(cur, gw);
    for (int row = gw; row < MALL; row += NGW) {
        const bool isc = row >= MLAT; const int t = isc ? ((row - MLAT) & 255) : (row & 8191); const int T = isc ? TCTX : TLAT;
        { const int rn = row + NGW < MALL ? row + NGW : row; PREP_LOAD(nxt, rn); }
        {
            const f32x4 h1 = UP4(cur.h1), bg = UP4(cur.bg), c1 = UP4(cur.c1);
            f32x4 up = UP4(cur.hp) * UP4(cur.cp), un = UP4(cur.hn) * UP4(cur.cn);
            if (t == 0) up = (f32x4){0.f, 0.f, 0.f, 0.f};
            if (t == T - 1) un = (f32x4){0.f, 0.f, 0.f, 0.f};
            const f32x4 y = bg * (cw0 * up + cw1 * (c1 * h1) + cw2 * un);
            const float ss = red16((y[0] * y[0] + y[1] * y[1]) + (y[2] * y[2] + y[3] * y[3]));
            const float rs = rsqrtf(ss * (1.f / 64.f) + EPSN);
            st4bf(YC + (size_t)row * DM + c4, y * rs * cg * ZF(2));
        }
        {
            const f32x4 q = UP4(cur.q); const f32x4 k = UP4(cur.k);
            const float qs = red16((q[0] * q[0] + q[1] * q[1]) + (q[2] * q[2] + q[3] * q[3]));
            const float ks = red16((k[0] * k[0] + k[1] * k[1]) + (k[2] * k[2] + k[3] * k[3]));
            f32x4 qn = q * rsqrtf(qs * (1.f / 64.f) + EPSN) * qg, kn = k * rsqrtf(ks * (1.f / 64.f) + EPSN) * kg;
            if (!isc) {
                f32x4 qp, kp;
#pragma unroll
                for (int j = 0; j < 4; ++j) { qp[j] = __shfl_xor(qn[j], 4); kp[j] = __shfl_xor(kn[j], 4); }
                const int d0 = c4 & 63; const float pos = (d0 < 32) ? (float)(t >> 6) : (float)(t & 63); const bool lowh = (d0 & 16) == 0;
#pragma unroll
                for (int j = 0; j < 4; ++j) { const float th = pos * invf[j]; const float cs = __cosf(th), sn = __sinf(th);
                    qn[j] = lowh ? qn[j] * cs - qp[j] * sn : qn[j] * cs + qp[j] * sn; kn[j] = lowh ? kn[j] * cs - kp[j] * sn : kn[j] * cs + kp[j] * sn; }
            }
            st4bf(QA + (size_t)row * 256 + c4, qn * (0.125f * 1.4426950408889634f));
            if (lane < 32) st4bf(KA + (size_t)row * 128 + c4, kn);
        }
        {
            const f32x4 r = UP4(cur.r), k = UP4(cur.rk);
            { const float xv = bf2f((bf16_t)cur.xv);
              tsc[lane] = lane < 16 ? tanhf_(xv) : (lane < 32 ? xv : sigmoidf_(xv)); }
            const f32x4 kx = k * k_k;
            const float kss = red16((kx[0] * kx[0] + kx[1] * kx[1]) + (kx[2] * kx[2] + kx[3] * kx[3]));
            const f32x4 kk = kx * rsqrtf(kss + EPSN);
            bf16_t* recb = (bf16_t*)(RW + (size_t)row * RWREC); float* recf = (float*)(RW + (size_t)row * RWREC + 2560);
            st4bf(recb + c4, kk);
            f32x4 kdsum = {0.f, 0.f, 0.f, 0.f};
#pragma unroll
            for (int d = 0; d < 2; ++d) {
                f32x4 dw = w0[d], da = a0[d];
#pragma unroll 4
                for (int ii = 0; ii < 16; ++ii) { dw += tsc[ii] * *(const LAS f32x4*)(W2s + (d * 16 + ii) * 256 + c4); da += tsc[16 + ii] * *(const LAS f32x4*)(A2s + (d * 16 + ii) * 256 + c4); }
                f32x4 dec, av;
#pragma unroll
                for (int j = 0; j < 4; ++j) { dec[j] = -0.6065306597126334f * sigmoidf_(dw[j]); av[j] = sigmoidf_(da[j]); }
                const f32x4 kd = k * (1.f + (av - 1.f) * k_a);
                kdsum += kd;
                st4bf(recb + 256 + d * 256 + c4, kk * av);
                st4bf(recb + 768 + d * 256 + c4, kd);
                *(f32x4*)(recf + d * 256 + c4) = dec;
            }
            f32x4 gv = {0.f, 0.f, 0.f, 0.f};
#pragma unroll 4
            for (int ii = 0; ii < 32; ++ii) gv += tsc[32 + ii] * *(const LAS f32x4*)(G2s + ii * 256 + c4);
            st4bf(GB + (size_t)row * 256 + c4, gv);
            const f32x4 bt = r * kdsum * r_k;
            const float bsum = red16((bt[0] + bt[1]) + (bt[2] + bt[3]));
            if (i16 == 0) BS[(size_t)row * 4 + (lane >> 4)] = bsum;
        }
        if (lane < 16) { const int dir = lane >> 3, gate = (lane >> 2) & 1, hd = lane & 3; const float x = bf2f((bf16_t)cur.mg);
            const float bias = gate ? F.in[26][(l * 2 + dir) * 4 + hd] : F.in[25][(l * 2 + dir) * 4 + hd];
            GA[(size_t)row * 16 + lane] = gate ? log_sigmoid_(x + bias) : (x + bias); }
        cur = nxt;
    }
#undef PREP_LOAD
#undef UP4
}
__device__ __forceinline__ int scan_row(int b, int dir, int i) {
    if (i < TCTX) return MLAT + b * TCTX + (dir ? (TCTX - 1 - i) : i);
    const int p = i - TCTX; return b * TLAT + (dir ? (TLAT - 1 - p) : p);
}
__device__ __forceinline__ void rwkv_scan(const Ctx& F, int blk) {
    const int chain = blk >> 2, quarter = blk & 3, b = chain >> 3, head = (chain >> 1) & 3, dir = chain & 1;
    const bool scanner = F.wave < 4;
    const int rowv = (quarter * 4 + (F.wave & 3)) * 4 + (F.lane >> 4), s = F.lane & 15;
    LAS float* buf = (LAS float*)F.lds;
    const bf16_t* P = WSP(bf16_t, WS_P); const unsigned char* RW = WSP(unsigned char, WS_RW); float* YR = WSP(float, WS_YR) + (size_t)dir * MALL * 256;
    const int st = F.tid >> 4, sub = F.tid & 15;
    constexpr int NSTEP = TCTX + TLAT, NCH = NSTEP / 32;
    u32x2 g_kk, g_al, g_kd, g_r, g_v; f32x4 g_w;
#define RW_LOAD(c) do { const int row_ = scan_row(b, dir, (c) * 32 + st); const bf16_t* rb_ = (const bf16_t*)(RW + (size_t)row_ * RWREC) + head * 64 + sub * 4; \
        g_kk = *(const u32x2*)rb_; g_al = *(const u32x2*)(rb_ + 256 + dir * 256); g_kd = *(const u32x2*)(rb_ + 768 + dir * 256); \
        g_w = *(const f32x4*)((const float*)(RW + (size_t)row_ * RWREC + 2560) + dir * 256 + head * 64 + sub * 4); \
        const bf16_t* pp_ = P + (size_t)row_ * DINP + head * 64 + sub * 4; g_r = *(const u32x2*)(pp_ + C_RR); g_v = *(const u32x2*)(pp_ + C_RV); } while (0)
#define RW_STORE(par) do { LAS float* d_ = buf + ((par) * 32 + st) * 384 + sub * 4; \
        *(LAS f32x4*)(d_) = (f32x4){lo2f(g_kk.x), hi2f(g_kk.x), lo2f(g_kk.y), hi2f(g_kk.y)}; *(LAS f32x4*)(d_ + 64) = (f32x4){lo2f(g_al.x), hi2f(g_al.x), lo2f(g_al.y), hi2f(g_al.y)}; \
        *(LAS f32x4*)(d_ + 128) = (f32x4){lo2f(g_kd.x), hi2f(g_kd.x), lo2f(g_kd.y), hi2f(g_kd.y)}; *(LAS f32x4*)(d_ + 192) = g_w; \
        *(LAS f32x4*)(d_ + 256) = (f32x4){lo2f(g_r.x), hi2f(g_r.x), lo2f(g_r.y), hi2f(g_r.y)}; *(LAS f32x4*)(d_ + 320) = (f32x4){lo2f(g_v.x), hi2f(g_v.x), lo2f(g_v.y), hi2f(g_v.y)}; } while (0)
    f32x4 S = {0.f, 0.f, 0.f, 0.f};
    RW_LOAD(0); RW_STORE(0); __syncthreads();
    for (int c = 0; c < NCH; ++c) {
        const int par = c & 1;
        if (c + 1 < NCH) RW_LOAD(c + 1);
        if (scanner) {
        float ykeep = 0.f;
        f32x4 Lkk[3], Lal[3], Lkd[3], Lw[3], Lr[3]; float Lv[3];
#define SC_LD(set, i_) do { const LAS float* d_ = buf + (par * 32 + (i_)) * 384; Lkk[set] = *(const LAS f32x4*)(d_ + s * 4); Lal[set] = *(const LAS f32x4*)(d_ + 64 + s * 4); \
            Lkd[set] = *(const LAS f32x4*)(d_ + 128 + s * 4); Lw[set] = *(const LAS f32x4*)(d_ + 192 + s * 4); Lr[set] = *(const LAS f32x4*)(d_ + 256 + s * 4); Lv[set] = d_[320 + rowv]; } while (0)
        SC_LD(0, 0); SC_LD(1, 1);
#pragma unroll
        for (int i = 0; i < 32; ++i) {
            if (i + 2 < 32) SC_LD((i + 2) % 3, i + 2);
            const f32x4 kk = Lkk[i % 3], al = Lal[i % 3], kd = Lkd[i % 3], w = Lw[i % 3], r = Lr[i % 3]; const float vr = Lv[i % 3];
            const float sa = red16((S[0] * kk[0] + S[1] * kk[1]) + (S[2] * kk[2] + S[3] * kk[3]));
            S = S * w + (vr * kd - sa * al);
            const float y = red16((S[0] * r[0] + S[1] * r[1]) + (S[2] * r[2] + S[3] * r[3]));
            ykeep = (s == (i & 15)) ? y : ykeep;
            if ((i & 15) == 15) {
                const int stp = c * 32 + (i - 15) + s; const int pc = dir ? (TCTX - 1 - stp) : stp, pl = dir ? (TLAT - 1 - (stp - TCTX)) : (stp - TCTX);
                const int row = stp < TCTX ? (MLAT + b * TCTX + pc) : (b * TLAT + pl);
                YR[(size_t)row * 256 + head * 64 + rowv] = ykeep; }
        }
#undef SC_LD
        }
        if (c + 1 < NCH) RW_STORE(par ^ 1);
        __syncthreads();
    }
#undef RW_LOAD
#undef RW_STORE
}

typedef union { u32x4 u; bf16x8 b; } frag_u;
__device__ __forceinline__ void attn_unit(const Ctx& F, int l, int unit) {
    LAS bf16_t* Kl = (LAS bf16_t*)F.lds; LAS bf16_t* Vt = Kl + 64 * 72;
    const bf16_t* P = WSP(bf16_t, WS_P); const bf16_t* QA = WSP(bf16_t, WS_QA); const bf16_t* KA = WSP(bf16_t, WS_KA); bf16_t* YC = WSP(bf16_t, WS_YCAT);
    const bool isc = unit >= 256; int b, kvh, n;
    if (!isc) { b = unit >> 7; kvh = (unit >> 6) & 1; n = unit & 63; } else { const int u = unit - 256; b = u >> 2; kvh = (u >> 1) & 1; n = u & 1; }
    const int g = F.wave >> 2, ps = F.wave & 3, head = kvh * 2 + g, i = F.lane & 15, gq = F.lane >> 4;
    const int qpos0 = n * 128 + ps * 32, qrow0 = (isc ? MLAT + b * TCTX : b * TLAT) + qpos0;
    bf16x8 Qf[2][2];
#pragma unroll
    for (int qb = 0; qb < 2; ++qb)
#pragma unroll
        for (int ks = 0; ks < 2; ++ks) Qf[qb][ks] = *(const bf16x8*)(QA + (size_t)(qrow0 + qb * 16 + i) * 256 + head * 64 + ks * 32 + gq * 8);
    const float sinkl = F.in[23][l * 4 + head] * 1.4426950408889634f;
    float mrun[2] = {sinkl, sinkl}, lsum[2]; lsum[0] = lsum[1] = (gq == 0) ? 1.f : 0.f;
    f32x4 ao[4][2];
#pragma unroll
    for (int db = 0; db < 4; ++db) { ao[db][0] = (f32x4){0.f, 0.f, 0.f, 0.f}; ao[db][1] = (f32x4){0.f, 0.f, 0.f, 0.f}; }
    const int ntl = isc ? 4 : 10;
    const int skey = F.tid >> 3, sch = F.tid & 7;
#define ATT_KROW(tt_) ((!isc && (tt_) < 6) ? ((2 * (n - 1) + (tt_) < 0 || 2 * (n - 1) + (tt_) >= 128) ? -1 : b * TLAT + (2 * (n - 1) + (tt_)) * 64) : MLAT + b * TCTX + (isc ? (tt_) : (tt_) - 6) * 64)
#define ATT_LOAD(tt_) do { const int kr_ = ATT_KROW(tt_); if (kr_ >= 0) { pk_kv = *(const u32x4*)(KA + (size_t)(kr_ + skey) * 128 + kvh * 64 + sch * 8); pk_vv = *(const u32x4*)(P + (size_t)(kr_ + skey) * DINP + C_AV + kvh * 64 + sch * 8); } } while (0)
    u32x4 pk_kv = {0u, 0u, 0u, 0u}, pk_vv = {0u, 0u, 0u, 0u};
    int tt0 = 0; while (tt0 < ntl && ATT_KROW(tt0) < 0) ++tt0;
    ATT_LOAD(tt0);
    for (int tt = tt0; tt < ntl; ++tt) {
        const int krow0 = ATT_KROW(tt); if (krow0 < 0) continue;
        const bool band = !isc && tt < 6; const int kpos0 = band ? (2 * (n - 1) + tt) * 64 : 0;
        LDS_BARRIER();
        { const u32x4 kv = pk_kv, vv = pk_vv;
          *(LAS u32x4*)(Kl + skey * 72 + sch * 8) = kv;
          const unsigned ww[4] = {vv.x, vv.y, vv.z, vv.w};
#pragma unroll
          for (int j = 0; j < 4; ++j) { Vt[(sch * 8 + 2 * j) * 72 + skey] = (bf16_t)(ww[j] & 0xffffu); Vt[(sch * 8 + 2 * j + 1) * 72 + skey] = (bf16_t)(ww[j] >> 16); } }
        { int tn = tt + 1; while (tn < ntl && ATT_KROW(tn) < 0) ++tn; if (tn < ntl) ATT_LOAD(tn); }
        LDS_BARRIER();
        f32x4 sc[4][2];
#pragma unroll
        for (int kb = 0; kb < 4; ++kb) {
            sc[kb][0] = (f32x4){0.f, 0.f, 0.f, 0.f}; sc[kb][1] = (f32x4){0.f, 0.f, 0.f, 0.f};
#pragma unroll
            for (int ks = 0; ks < 2; ++ks) { const bf16x8 kf = *(const LAS bf16x8*)(Kl + (kb * 16 + i) * 72 + ks * 32 + gq * 8);
                sc[kb][0] = __builtin_amdgcn_mfma_f32_16x16x32_bf16(kf, Qf[0][ks], sc[kb][0], 0, 0, 0);
                sc[kb][1] = __builtin_amdgcn_mfma_f32_16x16x32_bf16(kf, Qf[1][ks], sc[kb][1], 0, 0, 0); }
        }
#pragma unroll
        for (int qb = 0; qb < 2; ++qb) {
            const int qp = qpos0 + qb * 16 + i;
            float mx = -1e30f;
#pragma unroll
            for (int kb = 0; kb < 4; ++kb)
#pragma unroll
                for (int r = 0; r < 4; ++r) { if (band) { const int dd = (kpos0 + kb * 16 + 4 * gq + r) - qp; if (dd > 128 || dd < -128) sc[kb][qb][r] = -1e30f; } mx = fmaxf(mx, sc[kb][qb][r]); }
            mx = fmaxf(mx, __shfl_xor(mx, 16)); mx = fmaxf(mx, __shfl_xor(mx, 32));
            const float mnew = fmaxf(mrun[qb], mx), alpha = exp2f(mrun[qb] - mnew); mrun[qb] = mnew;
            float ps_ = 0.f;
#pragma unroll
            for (int kb = 0; kb < 4; ++kb)
#pragma unroll
                for (int r = 0; r < 4; ++r) { const float p = exp2f(sc[kb][qb][r] - mnew); sc[kb][qb][r] = p; ps_ += p; }
            lsum[qb] = lsum[qb] * alpha + ps_;
#pragma unroll
            for (int db = 0; db < 4; ++db) ao[db][qb] *= alpha;
        }
#pragma unroll
        for (int ks2 = 0; ks2 < 2; ++ks2) {
            frag_u pf[2];
#pragma unroll
            for (int qb = 0; qb < 2; ++qb) { pf[qb].u.x = pg8::cvt_pk_bf16(sc[2 * ks2][qb][0], sc[2 * ks2][qb][1]); pf[qb].u.y = pg8::cvt_pk_bf16(sc[2 * ks2][qb][2], sc[2 * ks2][qb][3]);
                pf[qb].u.z = pg8::cvt_pk_bf16(sc[2 * ks2 + 1][qb][0], sc[2 * ks2 + 1][qb][1]); pf[qb].u.w = pg8::cvt_pk_bf16(sc[2 * ks2 + 1][qb][2], sc[2 * ks2 + 1][qb][3]); }
#pragma unroll
            for (int db = 0; db < 4; ++db) { frag_u vf; const LAS bf16_t* vp = Vt + (db * 16 + i) * 72 + (2 * ks2) * 16 + 4 * gq;
                const u32x2 v0 = *(const LAS u32x2*)vp, v1 = *(const LAS u32x2*)(vp + 16); vf.u = (u32x4){v0.x, v0.y, v1.x, v1.y};
                ao[db][0] = __builtin_amdgcn_mfma_f32_16x16x32_bf16(vf.b, pf[0].b, ao[db][0], 0, 0, 0);
                ao[db][1] = __builtin_amdgcn_mfma_f32_16x16x32_bf16(vf.b, pf[1].b, ao[db][1], 0, 0, 0); }
        }
    }
#undef ATT_KROW
#undef ATT_LOAD
    const float* og = F.in[24] + l * 256 + head * 64;
#pragma unroll
    for (int qb = 0; qb < 2; ++qb) {
        float lt = lsum[qb]; lt += __shfl_xor(lt, 16); lt += __shfl_xor(lt, 32);
        const float il = 1.f / lt; float ss = 0.f;
#pragma unroll
        for (int db = 0; db < 4; ++db) { ao[db][qb] *= il; ss += (ao[db][qb][0] * ao[db][qb][0] + ao[db][qb][1] * ao[db][qb][1]) + (ao[db][qb][2] * ao[db][qb][2] + ao[db][qb][3] * ao[db][qb][3]); }
        ss += __shfl_xor(ss, 16); ss += __shfl_xor(ss, 32);
        const float rs = rsqrtf(ss * (1.f / 64.f) + EPSN);
        bf16_t* yo = YC + (size_t)(qrow0 + qb * 16 + i) * DM + 512 + head * 64;
#pragma unroll
        for (int db = 0; db < 4; ++db) { const f32x4 gg = *(const f32x4*)(og + db * 16 + 4 * gq); st4bf(yo + db * 16 + 4 * gq, ao[db][qb] * rs * gg * ZF(8)); }
    }
    __syncthreads();
}

__device__ __forceinline__ int ml_row(int b, int dir, int j, int tp) {
    if (j < 2) { const int p = j * 128 + tp; return MLAT + b * TCTX + (dir ? (TCTX - 1 - p) : p); }
    const int p = (j - 2) * 128 + tp; return b * TLAT + (dir ? (TLAT - 1 - p) : p);
}
__device__ __forceinline__ void scan128_add(float& x0, float& x1, int lane) {
    x1 += x0; float t = x1;
#pragma unroll
    for (int o = 1; o < 64; o <<= 1) { const float u = __shfl_up(t, o); if (lane >= o) t += u; }
    const float ex = t - x1; x0 += ex; x1 = t;
}
__device__ __forceinline__ void scan128_max(float& x0, float& x1, int lane) {
    x1 = fmaxf(x1, x0); float t = x1;
#pragma unroll
    for (int o = 1; o < 64; o <<= 1) { const float u = __shfl_up(t, o); if (lane >= o) t = fmaxf(t, u); }
    const float pv = __shfl_up(t, 1); if (lane > 0) x0 = fmaxf(x0, pv); x1 = t;
}
__device__ __forceinline__ void ml_stage_T(const Ctx& F, const bf16_t* P, int b, int dir, int j, int col0, LAS bf16_t* dst, const LAS float* sw, float cscale) {
#pragma unroll
    for (int it = 0; it < 2; ++it) { const int id = F.tid + it * NTHR, tp = id >> 3, ch = id & 7;
        const u32x4 v = *(const u32x4*)(P + (size_t)ml_row(b, dir, j, tp) * DINP + col0 + ch * 8); const float s = (sw ? sw[tp] : 1.f) * cscale;
        const unsigned ww[4] = {v.x, v.y, v.z, v.w};
#pragma unroll
        for (int q = 0; q < 4; ++q) { dst[(ch * 8 + 2 * q) * 136 + tp] = (bf16_t)f2bf(lo2f(ww[q]) * s); dst[(ch * 8 + 2 * q + 1) * 136 + tp] = (bf16_t)f2bf(hi2f(ww[q]) * s); } }
}
__device__ __forceinline__ void ml_stage_R(const Ctx& F, const bf16_t* P, int b, int dir, int j, int col0, LAS bf16_t* dst, float cscale) {
#pragma unroll
    for (int it = 0; it < 2; ++it) { const int id = F.tid + it * NTHR, tp = id >> 3, ch = id & 7;
        u32x4 v = *(const u32x4*)(P + (size_t)ml_row(b, dir, j, tp) * DINP + col0 + ch * 8);
        if (cscale != 1.f) { v.x = pk2(lo2f(v.x) * cscale, hi2f(v.x) * cscale); v.y = pk2(lo2f(v.y) * cscale, hi2f(v.y) * cscale); v.z = pk2(lo2f(v.z) * cscale, hi2f(v.z) * cscale); v.w = pk2(lo2f(v.w) * cscale, hi2f(v.w) * cscale); }
        *(LAS u32x4*)(dst + tp * 72 + ch * 8) = v; }
}
__device__ __forceinline__ void mlstm_local(const Ctx& F, int task) {
    const int chain = task / NCHK, j = task % NCHK, b = chain >> 3, head = (chain >> 1) & 3, dir = chain & 1;
    const bf16_t* P = WSP(bf16_t, WS_P); const float* GA = WSP(float, WS_GA);
    LAS bf16_t* Vt = (LAS bf16_t*)F.lds; LAS bf16_t* Kt = Vt + 64 * 136; LAS float* wS = (LAS float*)(Kt + 64 * 136); LAS float* sc2 = wS + 128;
    __syncthreads();
    if (F.wave == 0) {
        const int r0 = ml_row(b, dir, j, 2 * F.lane), r1 = ml_row(b, dir, j, 2 * F.lane + 1);
        const float li0 = GA[(size_t)r0 * 16 + dir * 8 + head], li1 = GA[(size_t)r1 * 16 + dir * 8 + head];
        float b0 = GA[(size_t)r0 * 16 + dir * 8 + 4 + head], b1 = GA[(size_t)r1 * 16 + dir * 8 + 4 + head];
        scan128_add(b0, b1, F.lane);
        const float bend = __shfl(b1, 63);
        const float d0 = bend - b0 + li0, d1 = bend - b1 + li1;
        float mx = fmaxf(d0, d1);
#pragma unroll
        for (int o = 1; o < 64; o <<= 1) mx = fmaxf(mx, __shfl_xor(mx, o));
        wS[2 * F.lane] = __expf(d0 - mx); wS[2 * F.lane + 1] = __expf(d1 - mx);
        if (F.lane == 0) { sc2[0] = mx; sc2[1] = bend; }
    }
    __syncthreads();
    ml_stage_T(F, P, b, dir, j, C_MV + head * 64, Vt, wS, 1.f);
    ml_stage_T(F, P, b, dir, j, C_MK + head * 64, Kt, nullptr, 0.125f);
    __syncthreads();
    float* LC = WSP(float, WS_LC) + (size_t)task * CST;
    { const int vb = F.wave >> 1, i = F.lane & 15, gq = F.lane >> 4;
#pragma unroll
      for (int kk2 = 0; kk2 < 2; ++kk2) { const int kb = 2 * (F.wave & 1) + kk2; f32x4 acc = {0.f, 0.f, 0.f, 0.f};
#pragma unroll
          for (int ks = 0; ks < 4; ++ks) { const bf16x8 a = *(const LAS bf16x8*)(Vt + (vb * 16 + i) * 136 + ks * 32 + gq * 8), bb = *(const LAS bf16x8*)(Kt + (kb * 16 + i) * 136 + ks * 32 + gq * 8);
              acc = __builtin_amdgcn_mfma_f32_16x16x32_bf16(a, bb, acc, 0, 0, 0); }
#pragma unroll
          for (int r = 0; r < 4; ++r) LC[(vb * 16 + 4 * gq + r) * 64 + kb * 16 + i] = acc[r]; } }
    if (F.tid < 64) { float a = 0.f;
#pragma unroll 8
        for (int s = 0; s < 128; ++s) a += wS[s] * bf2f(Kt[F.tid * 136 + s]);
        LC[4096 + F.tid] = a; }
    if (F.tid == 0) { float* LB = WSP(float, WS_LB); LB[task * 2] = sc2[0]; LB[task * 2 + 1] = sc2[1]; }
}
__device__ __forceinline__ void mlstm_chain(const Ctx& F, int blk0) {
    const int gt = (F.vcu - blk0) * NTHR + F.tid; if (gt < 0 || gt >= 16 * CST) return;
    const int chain = gt / CST, e = gt % CST;
    const float* LC = WSP(float, WS_LC) + (size_t)chain * NCHK * CST + e; float* ST = WSP(float, WS_ST) + (size_t)chain * NCHK * CST + e;
    const float* LB = WSP(float, WS_LB) + chain * NCHK * 2; float* SM = WSP(float, WS_LB) + 4096 + chain * NCHK;
    float m = 0.f, x = 0.f;
#pragma unroll 1
    for (int g = 0; g < 3; ++g) {
        float d[22], Lv[22], Bv[22];
#pragma unroll
        for (int q = 0; q < 22; ++q) { const int j = g * 22 + q; d[q] = LC[(size_t)j * CST]; Lv[q] = LB[2 * j]; Bv[q] = LB[2 * j + 1]; }
#pragma unroll
        for (int q = 0; q < 22; ++q) { const int j = g * 22 + q;
            ST[(size_t)j * CST] = x; if (e == 0) SM[j] = m;
            const float mn = fmaxf(Bv[q] + m, Lv[q]);
            x = __expf(Bv[q] + m - mn) * x + __expf(Lv[q] - mn) * d[q]; m = mn; }
    }
}
__device__ __forceinline__ void mlstm_out(const Ctx& F, int l, int unit) {
    const bool isc = unit >= 512; int b, chunk, head;
    if (!isc) { b = unit >> 8; chunk = (unit >> 2) & 63; head = unit & 3; } else { const int u = unit - 512; b = u >> 3; chunk = (u >> 2) & 1; head = u & 3; }
    const bf16_t* P = WSP(bf16_t, WS_P); const float* GA = WSP(float, WS_GA); bf16_t* YC = WSP(bf16_t, WS_YCAT);
    LAS bf16_t* Ql = (LAS bf16_t*)F.lds; LAS bf16_t* Kl = Ql + 128 * 72; LAS bf16_t* Vt = Kl + 128 * 72; LAS bf16_t* Cb = Vt + 64 * 136;
    LAS float* nS = (LAS float*)(Cb + 64 * 72); LAS float* aS = nS + 64; LAS float* bS = aS + 128; LAS float* MS = bS + 128; LAS float* Hs = MS + 128;
    const int i = F.lane & 15, gq = F.lane >> 4, w = F.wave;
    for (int dir = 0; dir < 2; ++dir) {
        const int j = isc ? (dir ? 1 - chunk : chunk) : 2 + (dir ? 63 - chunk : chunk);
        const int chain = (b * 4 + head) * 2 + dir;
        const float* ST = WSP(float, WS_ST) + ((size_t)chain * NCHK + j) * CST; const float mprev = WSP(float, WS_LB)[4096 + chain * NCHK + j];
        __syncthreads();
        if (w == 0) {
            const int r0 = ml_row(b, dir, j, 2 * F.lane), r1 = ml_row(b, dir, j, 2 * F.lane + 1);
            const float li0 = GA[(size_t)r0 * 16 + dir * 8 + head], li1 = GA[(size_t)r1 * 16 + dir * 8 + head];
            float b0 = GA[(size_t)r0 * 16 + dir * 8 + 4 + head], b1 = GA[(size_t)r1 * 16 + dir * 8 + 4 + head];
            scan128_add(b0, b1, F.lane);
            const float a0 = li0 - b0, a1 = li1 - b1; float A0 = a0, A1 = a1;
            scan128_max(A0, A1, F.lane);
            aS[2 * F.lane] = a0; aS[2 * F.lane + 1] = a1; bS[2 * F.lane] = b0; bS[2 * F.lane + 1] = b1;
            MS[2 * F.lane] = fmaxf(A0, mprev); MS[2 * F.lane + 1] = fmaxf(A1, mprev);
        }
        ml_stage_R(F, P, b, dir, j, C_MQ + head * 64, Ql, 1.f);
        ml_stage_R(F, P, b, dir, j, C_MK + head * 64, Kl, 0.125f);
        ml_stage_T(F, P, b, dir, j, C_MV + head * 64, Vt, nullptr, 1.f);
        { const f32x4 c0 = *(const f32x4*)(ST + F.tid * 8), c1 = *(const f32x4*)(ST + F.tid * 8 + 4); const int v = F.tid >> 3, k0 = (F.tid & 7) * 8;
          u32x4 o; o.x = pk2(c0[0], c0[1]); o.y = pk2(c0[2], c0[3]); o.z = pk2(c1[0], c1[1]); o.w = pk2(c1[2], c1[3]); *(LAS u32x4*)(Cb + v * 72 + k0) = o;
          if (F.tid < 64) nS[F.tid] = ST[4096 + F.tid]; }
        __syncthreads();
        const int t = 16 * w + i; const float Mt = MS[t], bt = bS[t];
        bf16x8 Qf[2];
#pragma unroll
        for (int ks = 0; ks < 2; ++ks) Qf[ks] = *(const LAS bf16x8*)(Ql + t * 72 + ks * 32 + gq * 8);
        f32x4 sc[8];
#pragma unroll
        for (int sb = 0; sb < 8; ++sb) { sc[sb] = (f32x4){0.f, 0.f, 0.f, 0.f};
            if (sb <= w) {
#pragma unroll
                for (int ks = 0; ks < 2; ++ks) { const bf16x8 kf = *(const LAS bf16x8*)(Kl + (sb * 16 + i) * 72 + ks * 32 + gq * 8); sc[sb] = __builtin_amdgcn_mfma_f32_16x16x32_bf16(kf, Qf[ks], sc[sb], 0, 0, 0); }
#pragma unroll
                for (int r = 0; r < 4; ++r) { const int s = sb * 16 + 4 * gq + r; sc[sb][r] = (s <= t) ? sc[sb][r] * __expf(aS[s] - Mt) : 0.f; }
            } }
        float den = 0.f;
#pragma unroll
        for (int sb = 0; sb < 8; ++sb) den += (sc[sb][0] + sc[sb][1]) + (sc[sb][2] + sc[sb][3]);
        den += __shfl_xor(den, 16); den += __shfl_xor(den, 32);
        f32x4 nm[4], it_[4];
#pragma unroll
        for (int vb = 0; vb < 4; ++vb) { nm[vb] = (f32x4){0.f, 0.f, 0.f, 0.f}; it_[vb] = (f32x4){0.f, 0.f, 0.f, 0.f}; }
#pragma unroll
        for (int ks2 = 0; ks2 < 4; ++ks2) if (2 * ks2 <= w) {
            frag_u pf; pf.u.x = pg8::cvt_pk_bf16(sc[2 * ks2][0], sc[2 * ks2][1]); pf.u.y = pg8::cvt_pk_bf16(sc[2 * ks2][2], sc[2 * ks2][3]);
            pf.u.z = pg8::cvt_pk_bf16(sc[2 * ks2 + 1][0], sc[2 * ks2 + 1][1]); pf.u.w = pg8::cvt_pk_bf16(sc[2 * ks2 + 1][2], sc[2 * ks2 + 1][3]);
#pragma unroll
            for (int vb = 0; vb < 4; ++vb) { frag_u vf; const LAS bf16_t* vp = Vt + (vb * 16 + i) * 136 + (2 * ks2) * 16 + 4 * gq;
                const u32x2 v0 = *(const LAS u32x2*)vp, v1 = *(const LAS u32x2*)(vp + 16); vf.u = (u32x4){v0.x, v0.y, v1.x, v1.y};
                nm[vb] = __builtin_amdgcn_mfma_f32_16x16x32_bf16(vf.b, pf.b, nm[vb], 0, 0, 0); }
        }
#pragma unroll
        for (int vb = 0; vb < 4; ++vb)
#pragma unroll
            for (int ks = 0; ks < 2; ++ks) { const bf16x8 cf = *(const LAS bf16x8*)(Cb + (vb * 16 + i) * 72 + ks * 32 + gq * 8); it_[vb] = __builtin_amdgcn_mfma_f32_16x16x32_bf16(cf, Qf[ks], it_[vb], 0, 0, 0); }
        float nq = 0.f;
#pragma unroll
        for (int c = 0; c < 2; ++c) { const u32x4 qv = *(const LAS u32x4*)(Ql + t * 72 + gq * 16 + c * 8); const unsigned ww[4] = {qv.x, qv.y, qv.z, qv.w};
#pragma unroll
            for (int q = 0; q < 4; ++q) nq += nS[gq * 16 + c * 8 + 2 * q] * lo2f(ww[q]) + nS[gq * 16 + c * 8 + 2 * q + 1] * hi2f(ww[q]); }
        nq += __shfl_xor(nq, 16); nq += __shfl_xor(nq, 32);
        const float wint = __expf(mprev - Mt); den += wint * nq;
        const float dn = 1.f / fmaxf(fabsf(den), __expf(-(bt + Mt)));
        const int torig = dir ? 127 - t : t;
#pragma unroll
        for (int vb = 0; vb < 4; ++vb)
#pragma unroll
            for (int r = 0; r < 4; ++r) { const float hv = (nm[vb][r] + wint * it_[vb][r]) * dn; LAS float* hp = Hs + torig * 65 + vb * 16 + 4 * gq + r; if (dir == 0) *hp = hv; else *hp += hv; }
    }
    __syncthreads();
    {
        const int t = F.tid >> 2, vq = F.tid & 3; const int row = (isc ? MLAT + b * TCTX : b * TLAT) + chunk * 128 + t;
        float hv[16], ss = 0.f;
#pragma unroll
        for (int q = 0; q < 16; ++q) { hv[q] = Hs[t * 65 + vq * 16 + q]; ss += hv[q] * hv[q]; }
        ss += __shfl_xor(ss, 1); ss += __shfl_xor(ss, 2);
        const float rs = rsqrtf(ss * (1.f / 64.f) + EPSN);
        const float* og = F.in[27] + l * 256 + head * 64 + vq * 16; const bf16_t* op = P + (size_t)row * DINP + C_MO + head * 64 + vq * 16;
        const u32x4 o0 = *(const u32x4*)op, o1 = *(const u32x4*)(op + 8); const unsigned ow[8] = {o0.x, o0.y, o0.z, o0.w, o1.x, o1.y, o1.z, o1.w};
        unsigned res[8];
#pragma unroll
        for (int q = 0; q < 8; ++q) { const float y0 = sigmoidf_(lo2f(ow[q])) * hv[2 * q] * rs * og[2 * q], y1 = sigmoidf_(hi2f(ow[q])) * hv[2 * q + 1] * rs * og[2 * q + 1]; res[q] = pk2(y0 * ZF(16), y1 * ZF(16)); }
        bf16_t* yo = YC + (size_t)row * DM + 768 + head * 64 + vq * 16;
        *(u32x4*)yo = (u32x4){res[0], res[1], res[2], res[3]}; *(u32x4*)(yo + 8) = (u32x4){res[4], res[5], res[6], res[7]};
    }
    __syncthreads();
}
__device__ __forceinline__ void rwkv_finish(const Ctx& F, int l, int nrows) {
    const bf16_t* P = WSP(bf16_t, WS_P); const float* YR = WSP(float, WS_YR); const bf16_t* GB = WSP(bf16_t, WS_GB); const float* BS = WSP(float, WS_BS); bf16_t* YC = WSP(bf16_t, WS_YCAT);
    const int c4 = F.lane * 4; const f32x4 lg = *(const f32x4*)(F.in[20] + l * 256 + c4);
    const int gw = F.vcu * NWAVES + F.wave, NGW = F.G * NWAVES;
    for (int row = gw; row < nrows; row += NGW) {
        const f32x4 y = *(const f32x4*)(YR + (size_t)row * 256 + c4) + *(const f32x4*)(YR + (size_t)(MALL + row) * 256 + c4);
        const float ss = red16((y[0] * y[0] + y[1] * y[1]) + (y[2] * y[2] + y[3] * y[3]));
        const float rs = rsqrtf(ss * (1.f / 64.f) + EPSN);
        const f32x4 v = ld4bf(P + (size_t)row * DINP + C_RV + c4), g = ld4bf(GB + (size_t)row * 256 + c4);
        const float bn = BS[(size_t)row * 4 + (F.lane >> 4)];
        st4bf(YC + (size_t)row * DM + 256 + c4, (y * rs * lg * ZF(32) + bn * v * ZF(64)) * g * ZF(4));
    }
}
constexpr int RCH = 132;
constexpr int MP = 72, SLOT = 64 * MP;
constexpr size_t WS_RG = 454 * MiB, RG_TASK = 3 * 8192, WS_SST = WS_RW;
constexpr size_t WS_END2 = 504 * MiB;
static_assert(WS_RG + (size_t)16 * RCH * RG_TASK <= WS_END2 && (size_t)16 * RCH * 8192 <= (size_t)MALL * RWREC, "rwkv chunk ws map");

__device__ __forceinline__ void mm64(const LAS bf16_t* A, const LAS bf16_t* Bt, int w, int lane, f32x4 (&acc)[2]) {
    const int i = lane & 15, gq = lane >> 4, mb = w >> 1, nb0 = 2 * (w & 1);
    acc[0] = (f32x4){0.f, 0.f, 0.f, 0.f}; acc[1] = (f32x4){0.f, 0.f, 0.f, 0.f};
#pragma unroll
    for (int ks = 0; ks < 2; ++ks) { const bf16x8 a = *(const LAS bf16x8*)(A + (mb * 16 + i) * MP + ks * 32 + gq * 8);
#pragma unroll
        for (int q = 0; q < 2; ++q) { const bf16x8 b = *(const LAS bf16x8*)(Bt + ((nb0 + q) * 16 + i) * MP + ks * 32 + gq * 8); acc[q] = __builtin_amdgcn_mfma_f32_16x16x32_bf16(a, b, acc[q], 0, 0, 0); } }
}
__device__ __forceinline__ u32x2 pk4(f32x4 v) { u32x2 o; o.x = pk2(v[0], v[1]); o.y = pk2(v[2], v[3]); return o; }
__device__ __forceinline__ f32x4 up4(u32x2 w) { return (f32x4){lo2f(w.x), hi2f(w.x), lo2f(w.y), hi2f(w.y)}; }

struct RaRaw { u32x4 kk, al, kd, r, v; f32x4 ld0, ld1; };
__device__ __forceinline__ void ra_load(const Ctx& F, int task, RaRaw& g) {
    const int chain = task / RCH, c = task % RCH, b = chain >> 3, head = (chain >> 1) & 3, dir = chain & 1;
    const bf16_t* P = WSP(bf16_t, WS_P); const unsigned char* RW = WSP(unsigned char, WS_RW);
    const int t = F.tid >> 3, ch0 = (F.tid & 7) * 8; const int row = scan_row(b, dir, c * 64 + t);
    const bf16_t* rb = (const bf16_t*)(RW + (size_t)row * RWREC) + head * 64 + ch0;
    g.kk = *(const u32x4*)rb; g.al = *(const u32x4*)(rb + 256 + dir * 256); g.kd = *(const u32x4*)(rb + 768 + dir * 256);
    const float* ldp = (const float*)(RW + (size_t)row * RWREC + 2560) + dir * 256 + head * 64 + ch0;
    g.ld0 = *(const f32x4*)ldp; g.ld1 = *(const f32x4*)(ldp + 4);
    const bf16_t* pp = P + (size_t)row * DINP + head * 64 + ch0;
    g.r = *(const u32x4*)(pp + C_RR); g.v = *(const u32x4*)(pp + C_RV);
}
__device__ __forceinline__ void rwkv_chunk_pre(const Ctx& F, int task, const RaRaw& cur) {
    const int chain = task / RCH, c = task % RCH, b = chain >> 3, head = (chain >> 1) & 3, dir = chain & 1;
    LAS bf16_t* L0 = (LAS bf16_t*)F.lds;
#define SL(k) (L0 + (k) * SLOT)
    LAS float* LD = (LAS float*)SL(8);
    LAS float* SEG = (LAS float*)SL(10);
    LAS float* WLs = (LAS float*)SL(14);
    const int w = F.wave, lane = F.lane, i = lane & 15, gq = lane >> 4, mb = w >> 1, nb0 = 2 * (w & 1), m0 = mb * 16 + 4 * gq;
    LDS_BARRIER();
    const int t = F.tid >> 3, ch0 = (F.tid & 7) * 8;
    const u32x4 g_kk = cur.kk, g_al = cur.al, g_kd = cur.kd, g_r = cur.r, g_v = cur.v; const f32x4 ld0 = cur.ld0, ld1 = cur.ld1;
    *(LAS f32x4*)(LD + t * 64 + ch0) = ld0; *(LAS f32x4*)(LD + t * 64 + ch0 + 4) = ld1;
    LDS_BARRIER();
    { const int k = F.tid & 63, seg = F.tid >> 6; float s = 0.f;
#pragma unroll
      for (int j = 0; j < 8; ++j) s += LD[(seg * 8 + j) * 64 + k];
      SEG[seg * 64 + k] = s;
      LDS_BARRIER();
      float off = 0.f;
#pragma unroll
      for (int j = 0; j < 8; ++j) off += (j < seg) ? SEG[j * 64 + k] : 0.f;
#pragma unroll
      for (int j = 0; j < 8; ++j) { off += LD[(seg * 8 + j) * 64 + k]; LD[(seg * 8 + j) * 64 + k] = off; }
    }
    LDS_BARRIER();
    {
        const unsigned kkw[4] = {g_kk.x, g_kk.y, g_kk.z, g_kk.w}, alw[4] = {g_al.x, g_al.y, g_al.z, g_al.w}, kdw[4] = {g_kd.x, g_kd.y, g_kd.z, g_kd.w},
                       rw_[4] = {g_r.x, g_r.y, g_r.z, g_r.w}, vw[4] = {g_v.x, g_v.y, g_v.z, g_v.w};
        float okt[8], oai[8], oki[8], ort[8], oat[8], okb[8];
#pragma unroll
        for (int j = 0; j < 8; ++j) {
            const float cl = LD[t * 64 + ch0 + j], clp = t > 0 ? LD[(t - 1) * 64 + ch0 + j] : 0.f, clL = LD[63 * 64 + ch0 + j];
            const float kkv = (j & 1) ? hi2f(kkw[j >> 1]) : lo2f(kkw[j >> 1]), alv = (j & 1) ? hi2f(alw[j >> 1]) : lo2f(alw[j >> 1]), kdv = (j & 1) ? hi2f(kdw[j >> 1]) : lo2f(kdw[j >> 1]),
                        rv = (j & 1) ? hi2f(rw_[j >> 1]) : lo2f(rw_[j >> 1]);
            const float ec = __expf(cl), en = __builtin_amdgcn_rcpf(ec), eL = __expf(clL) * en;
            okt[j] = kkv * __expf(clp); oai[j] = alv * en; oki[j] = kdv * en; ort[j] = rv * ec; oat[j] = alv * eL; okb[j] = kdv * eL;
        }
        u32x4 o;
        o = (u32x4){pk2(okt[0], okt[1]), pk2(okt[2], okt[3]), pk2(okt[4], okt[5]), pk2(okt[6], okt[7])}; *(LAS u32x4*)(SL(0) + t * MP + ch0) = o;
        o = (u32x4){pk2(oai[0], oai[1]), pk2(oai[2], oai[3]), pk2(oai[4], oai[5]), pk2(oai[6], oai[7])}; *(LAS u32x4*)(SL(2) + t * MP + ch0) = o;
        o = (u32x4){pk2(oki[0], oki[1]), pk2(oki[2], oki[3]), pk2(oki[4], oki[5]), pk2(oki[6], oki[7])}; *(LAS u32x4*)(SL(3) + t * MP + ch0) = o;
        o = (u32x4){pk2(ort[0], ort[1]), pk2(ort[2], ort[3]), pk2(ort[4], ort[5]), pk2(ort[6], ort[7])}; *(LAS u32x4*)(SL(4) + t * MP + ch0) = o;
#pragma unroll
        for (int j = 0; j < 8; ++j) { SL(1)[(ch0 + j) * MP + t] = (bf16_t)f2bf(okt[j]); SL(5)[(ch0 + j) * MP + t] = (bf16_t)f2bf(oat[j]); SL(6)[(ch0 + j) * MP + t] = (bf16_t)f2bf(okb[j]);
            SL(7)[(ch0 + j) * MP + t] = (bf16_t)(((j & 1) ? (vw[j >> 1] >> 16) : (vw[j >> 1] & 0xffffu))); }
        if (t == 63) {
#pragma unroll
            for (int j = 0; j < 8; ++j) WLs[ch0 + j] = __expf(LD[63 * 64 + ch0 + j]); }
    }
    LDS_BARRIER();
    f32x4 acc[2];
    mm64(SL(0), SL(2), w, lane, acc);
#pragma unroll
    for (int q = 0; q < 2; ++q) { const int n = (nb0 + q) * 16 + i; f32x4 a, ti;
#pragma unroll
        for (int r = 0; r < 4; ++r) { const bool keep = (m0 + r) > n; a[r] = keep ? acc[q][r] : 0.f; ti[r] = ((m0 + r) == n ? 1.f : 0.f) - a[r]; }
#pragma unroll
        for (int r = 0; r < 4; ++r) { SL(8)[(m0 + r) * MP + n] = (bf16_t)f2bf(a[r]); SL(13)[(m0 + r) * MP + n] = (bf16_t)f2bf(ti[r]); }
        *(LAS u32x2*)(SL(9) + n * MP + m0) = pk4(a); }
    mm64(SL(0), SL(3), w, lane, acc);
#pragma unroll
    for (int q = 0; q < 2; ++q) { const int n = (nb0 + q) * 16 + i;
#pragma unroll
        for (int r = 0; r < 4; ++r) SL(10)[(m0 + r) * MP + n] = (bf16_t)f2bf((m0 + r) > n ? acc[q][r] : 0.f); }
    mm64(SL(4), SL(2), w, lane, acc);
#pragma unroll
    for (int q = 0; q < 2; ++q) { const int n = (nb0 + q) * 16 + i;
#pragma unroll
        for (int r = 0; r < 4; ++r) SL(11)[(m0 + r) * MP + n] = (bf16_t)f2bf((m0 + r) >= n ? acc[q][r] : 0.f); }
    mm64(SL(4), SL(3), w, lane, acc);
#pragma unroll
    for (int q = 0; q < 2; ++q) { const int n = (nb0 + q) * 16 + i;
#pragma unroll
        for (int r = 0; r < 4; ++r) SL(12)[(m0 + r) * MP + n] = (bf16_t)f2bf((m0 + r) >= n ? acc[q][r] : 0.f); }
    LDS_BARRIER();
#pragma unroll
    for (int it = 0; it < 5; ++it) {
        LAS bf16_t* Xs = (it & 1) ? SL(2) : SL(8); LAS bf16_t* XsT = (it & 1) ? SL(3) : SL(9);
        LAS bf16_t* Xd = (it & 1) ? SL(8) : SL(2); LAS bf16_t* XdT = (it & 1) ? SL(9) : SL(3);
        LAS bf16_t* Tsrc = (it & 1) ? SL(0) : SL(13); LAS bf16_t* Tdst = (it & 1) ? SL(13) : SL(0);
        mm64(Xs, XsT, w, lane, acc);
#pragma unroll
        for (int q = 0; q < 2; ++q) { const int n = (nb0 + q) * 16 + i;
#pragma unroll
            for (int r = 0; r < 4; ++r) Xd[(m0 + r) * MP + n] = (bf16_t)f2bf(acc[q][r]);
            *(LAS u32x2*)(XdT + n * MP + m0) = pk4(acc[q]); }
        LDS_BARRIER();
        mm64(Tsrc, XdT, w, lane, acc);
#pragma unroll
        for (int q = 0; q < 2; ++q) { const int n = (nb0 + q) * 16 + i;
#pragma unroll
            for (int r = 0; r < 4; ++r) Tdst[(m0 + r) * MP + n] = (bf16_t)f2bf(bf2f(Tsrc[(m0 + r) * MP + n]) + acc[q][r]); }
        LDS_BARRIER();
    }
    LAS bf16_t* Ti = SL(0);
    mm64(Ti, SL(1), w, lane, acc);
#pragma unroll
    for (int q = 0; q < 2; ++q) { const int n = (nb0 + q) * 16 + i; *(LAS u32x2*)(SL(2) + n * MP + m0) = pk4(acc[q]); }
    mm64(SL(10), SL(7), w, lane, acc);
#pragma unroll
    for (int q = 0; q < 2; ++q) { const int n = (nb0 + q) * 16 + i; *(LAS u32x2*)(SL(3) + n * MP + m0) = pk4(acc[q]); }
    LDS_BARRIER();
    mm64(Ti, SL(3), w, lane, acc);
#pragma unroll
    for (int q = 0; q < 2; ++q) { const int n = (nb0 + q) * 16 + i; *(LAS u32x2*)(SL(8) + n * MP + m0) = pk4(acc[q]); }
    LDS_BARRIER();
    bf16_t* RG = (bf16_t*)(F.ws + WS_RG + (size_t)task * RG_TASK);
    f32x4 acc2[2];
    mm64(SL(2), SL(11), w, lane, acc);
#pragma unroll
    for (int q = 0; q < 2; ++q) { const int n = (nb0 + q) * 16 + i; const f32x4 rt = up4(*(const LAS u32x2*)(SL(4) + n * MP + m0)); *(u32x2*)(RG + n * 64 + m0) = pk4(rt - acc[q]); }
    mm64(SL(2), SL(5), w, lane, acc);
#pragma unroll
    for (int q = 0; q < 2; ++q) { const int n = (nb0 + q) * 16 + i; f32x4 g;
#pragma unroll
        for (int r = 0; r < 4; ++r) g[r] = ((m0 + r) == n ? WLs[n] : 0.f) - acc[q][r];
        *(u32x2*)(RG + 4096 + n * 64 + m0) = pk4(g); }
    mm64(SL(6), SL(7), w, lane, acc); mm64(SL(5), SL(8), w, lane, acc2);
#pragma unroll
    for (int q = 0; q < 2; ++q) { const int n = (nb0 + q) * 16 + i; *(u32x2*)(RG + 8192 + n * 64 + m0) = pk4(acc[q] - acc2[q]); }
    mm64(SL(7), SL(12), w, lane, acc); mm64(SL(8), SL(11), w, lane, acc2);
    float* YR = WSP(float, WS_YR) + (size_t)dir * MALL * 256;
#pragma unroll
    for (int q = 0; q < 2; ++q) { const int n = (nb0 + q) * 16 + i; const int rown = scan_row(b, dir, c * 64 + n); *(f32x4*)(YR + (size_t)rown * 256 + head * 64 + m0) = acc[q] - acc2[q]; }
#undef SL
}

__device__ __forceinline__ void rwkv_chain(const Ctx& F, int chain) {
    LAS bf16_t* const L0 = (LAS bf16_t*)F.lds;
    LAS bf16_t* Gl[2] = {L0, L0 + SLOT}; LAS bf16_t* Sl[2] = {L0 + 2 * SLOT, L0 + 3 * SLOT}; LAS bf16_t* Hl[2] = {L0 + 4 * SLOT, L0 + 5 * SLOT};
    const int w = F.wave, lane = F.lane, i = lane & 15, gq = lane >> 4, mb = w >> 1, nb0 = 2 * (w & 1), m0 = mb * 16 + 4 * gq;
    const bf16_t* RGc = (const bf16_t*)(F.ws + WS_RG + (size_t)chain * RCH * RG_TASK); bf16_t* SST = (bf16_t*)(F.ws + WS_SST) + (size_t)chain * RCH * 4096;
    const int gr = F.tid >> 3, gc = (F.tid & 7) * 8, goff = gr * 64 + gc, loff = gr * MP + gc;
    constexpr int RBD = 6, RBU = 66;
    static_assert(RBU % RBD == 0 && RCH % RBU == 0, "ring depth / unroll");
    u32x4 rg[RBD], rh[RBD];
#define RB_LOAD(slot, cc) do { const bf16_t* p_ = RGc + (size_t)((cc) < RCH ? (cc) : RCH - 1) * (RG_TASK / 2); rg[slot] = *(const u32x4*)(p_ + 4096 + goff); rh[slot] = *(const u32x4*)(p_ + 8192 + goff); } while (0)
#pragma unroll
    for (int j = 0; j < RBD; ++j) RB_LOAD(j, j);
    __syncthreads();
    { unsigned z_; asm volatile("v_mov_b32 %0, 0" : "=v"(z_)); *(LAS u32x4*)(Sl[0] + loff) = (u32x4){z_, z_, z_, z_}; }
    *(LAS u32x4*)(Gl[0] + loff) = rg[0]; *(LAS u32x4*)(Hl[0] + loff) = rh[0];
    __syncthreads();
#ifdef TPROBE
    const unsigned long long tp0_ = __builtin_amdgcn_s_memrealtime();
#endif
#define RB_STEP(j) do { const int c = c0 + (j); if (c < RCH - 1) { const int par = c & 1; \
        *(u32x4*)(SST + (size_t)c * 4096 + goff) = *(const LAS u32x4*)(Sl[par] + loff);            \
        f32x4 acc[2]; mm64(Gl[par], Sl[par], w, lane, acc); \
        { const f32x4 h0 = up4(*(const LAS u32x2*)(Hl[par] + (nb0 * 16 + i) * MP + m0)), h1 = up4(*(const LAS u32x2*)(Hl[par] + ((nb0 + 1) * 16 + i) * MP + m0)); \
          *(LAS u32x2*)(Sl[par ^ 1] + (nb0 * 16 + i) * MP + m0) = pk4(acc[0] + h0); *(LAS u32x2*)(Sl[par ^ 1] + ((nb0 + 1) * 16 + i) * MP + m0) = pk4(acc[1] + h1); } \
        *(LAS u32x4*)(Gl[par ^ 1] + loff) = rg[((j) + 1) % RBD]; *(LAS u32x4*)(Hl[par ^ 1] + loff) = rh[((j) + 1) % RBD]; \
        RB_LOAD((j) % RBD, c + RBD); \
        asm volatile("s_waitcnt lgkmcnt(0)" ::: "memory"); __builtin_amdgcn_s_barrier(); asm volatile("" ::: "memory"); } } while (0)
#pragma unroll 1
    for (int c0 = 0; c0 < RCH; c0 += RBU) {
#pragma unroll
        for (int j = 0; j < RBU; ++j) RB_STEP(j); }
#undef RB_STEP
#undef RB_LOAD
    *(u32x4*)(SST + (size_t)(RCH - 1) * 4096 + goff) = *(const LAS u32x4*)(Sl[(RCH - 1) & 1] + loff);
#ifdef TPROBE
    if (chain == 0 && F.tid == 0) *(float*)(F.ws + WS_CTL + 65536) = 3000.f * (floorf((float)(__builtin_amdgcn_s_memrealtime() - tp0_) * (1.f / 3000.f)) + 0.5f);
#endif
    __syncthreads();
}

__device__ __forceinline__ void rwkv_out(const Ctx& F, int l, int unit) {
    const bool isc = unit >= 256; int b, chunk; if (!isc) { b = unit >> 7; chunk = unit & 127; } else { const int u = unit - 256; b = u >> 2; chunk = u & 3; }
    LAS bf16_t* Rl = (LAS bf16_t*)F.lds; LAS bf16_t* Sl = Rl + SLOT; LAS float* Ys = (LAS float*)(F.lds + 4 * SLOT * 2);
    const int w = F.wave, lane = F.lane, i = lane & 15, gq = lane >> 4, mb = w >> 1, nb0 = 2 * (w & 1), m0 = mb * 16 + 4 * gq;
    const int row0 = (isc ? MLAT + b * TCTX : b * TLAT) + chunk * 64;
    const int gr = F.tid >> 3, gc = (F.tid & 7) * 8;
#define RO_PTRS(hd_, RGp, SSp) do { const int head_ = (hd_) >> 1, dir_ = (hd_) & 1, chain_ = (b * 4 + head_) * 2 + dir_; const int cc_ = isc ? (dir_ ? 3 - chunk : chunk) : 4 + (dir_ ? 127 - chunk : chunk); \
        RGp = (const bf16_t*)(F.ws + WS_RG + ((size_t)chain_ * RCH + cc_) * RG_TASK); SSp = (const bf16_t*)(F.ws + WS_SST) + ((size_t)chain_ * RCH + cc_) * 4096; } while (0)
    u32x4 rv, sv;
    { const bf16_t* RG0; const bf16_t* SS0; RO_PTRS(0, RG0, SS0); rv = *(const u32x4*)(RG0 + gr * 64 + gc); sv = *(const u32x4*)(SS0 + gr * 64 + gc); }
#pragma unroll 1
    for (int hd = 0; hd < 8; ++hd) {
        const int head = hd >> 1, dir = hd & 1;
        const float* YR = WSP(float, WS_YR) + (size_t)dir * MALL * 256;
        LDS_BARRIER();
        *(LAS u32x4*)(Rl + gr * MP + gc) = rv; *(LAS u32x4*)(Sl + gr * MP + gc) = sv;
        if (hd < 7) { const bf16_t* RGn; const bf16_t* SSn; RO_PTRS(hd + 1, RGn, SSn); rv = *(const u32x4*)(RGn + gr * 64 + gc); sv = *(const u32x4*)(SSn + gr * 64 + gc); }
        f32x4 yl[2];
#pragma unroll
        for (int q = 0; q < 2; ++q) { const int n = (nb0 + q) * 16 + i; const int tor = dir ? 63 - n : n; yl[q] = *(const f32x4*)(YR + (size_t)(row0 + tor) * 256 + head * 64 + m0); }
        LDS_BARRIER();
        f32x4 acc[2]; mm64(Sl, Rl, w, lane, acc);
#pragma unroll
        for (int q = 0; q < 2; ++q) { const int n = (nb0 + q) * 16 + i; const int tor = dir ? 63 - n : n;
            LAS f32x4* yp = (LAS f32x4*)(Ys + tor * 260 + head * 64 + m0);
            if (dir == 0) *yp = acc[q] + yl[q]; else *yp = *yp + acc[q] + yl[q]; }
    }
#undef RO_PTRS
    __syncthreads();
    {
        const bf16_t* P = WSP(bf16_t, WS_P); const bf16_t* GB = WSP(bf16_t, WS_GB); const float* BS = WSP(float, WS_BS); bf16_t* YC = WSP(bf16_t, WS_YCAT);
        const int c4 = lane * 4; const f32x4 lg = *(const f32x4*)(F.in[20] + l * 256 + c4);
#pragma unroll 1
        for (int tt = w; tt < 64; tt += NWAVES) { const int row = row0 + tt;
            const f32x4 y = *(const LAS f32x4*)(Ys + tt * 260 + c4);
            const float ss = red16((y[0] * y[0] + y[1] * y[1]) + (y[2] * y[2] + y[3] * y[3]));
            const float rs = rsqrtf(ss * (1.f / 64.f) + EPSN);
            const f32x4 v = ld4bf(P + (size_t)row * DINP + C_RV + c4), g = ld4bf(GB + (size_t)row * 256 + c4);
            const float bn = BS[(size_t)row * 4 + (lane >> 4)];
            st4bf(YC + (size_t)row * DM + 256 + c4, (y * rs * lg * ZF(32) + bn * v * ZF(64)) * g * ZF(4)); }
    }
    __syncthreads();
}
__device__ __forceinline__ float clr7(float x) { return __uint_as_float(__float_as_uint(x) & 0xFFFFFF80u); }
__device__ __forceinline__ void ins16(float (&L)[16], float p) {
#pragma unroll
    for (int j = 15; j >= 1; --j) L[j] = __builtin_amdgcn_fmed3f(L[j - 1], L[j], p);
    L[0] = fmaxf(L[0], p);
}
__device__ __forceinline__ void peer_topk_task(const float* sg, size_t gstride, u32x2* eg) {
    float L0[16], L1[16];
#pragma unroll
    for (int j = 0; j < 16; ++j) { L0[j] = -INFINITY; L1[j] = -INFINITY; }
    f32x4 pa[4], pb[4];
#pragma unroll
    for (int u = 0; u < 4; ++u) { pa[u] = *(const f32x4*)(sg + (size_t)u * gstride); pb[u] = *(const f32x4*)(sg + (size_t)(32 + u) * gstride); }
#pragma unroll 4
    for (int i = 0; i < 128; i += 4) {
        const f32x4 a = pa[(i >> 2) & 3], b = pb[(i >> 2) & 3];
        { const int gn = (i >> 2) + 4 < 32 ? (i >> 2) + 4 : 31; pa[(i >> 2) & 3] = *(const f32x4*)(sg + (size_t)gn * gstride); pb[(i >> 2) & 3] = *(const f32x4*)(sg + (size_t)(32 + gn) * gstride); }
#pragma unroll
        for (int q = 0; q < 4; ++q) { ins16(L0, __uint_as_float((__float_as_uint(a[q]) & 0xFFFFFF80u) | (unsigned)(i + q)));
                                      ins16(L1, __uint_as_float((__float_as_uint(b[q]) & 0xFFFFFF80u) | (unsigned)(i + q))); }
    }
    float T[16];
#pragma unroll
    for (int j = 0; j < 16; ++j) T[j] = -INFINITY;
#pragma unroll
    for (int a = 0; a < 16; ++a)
#pragma unroll
        for (int b = 0; b < 16; ++b) if ((a + 1) * (b + 1) <= 16) { const float s = clr7(L0[a]) + clr7(L1[b]);
            ins16(T, __uint_as_float((__float_as_uint(s) & 0xFFFFFF00u) | (unsigned)(a * 16 + b))); }
    float e[16], sum = 0.f; const float mx = __uint_as_float(__float_as_uint(T[0]) & 0xFFFFFF00u);
#pragma unroll
    for (int j = 0; j < 16; ++j) { e[j] = __expf(__uint_as_float(__float_as_uint(T[j]) & 0xFFFFFF00u) - mx); sum += e[j]; }
    const float inv = 1.f / sum;
#pragma unroll
    for (int j = 0; j < 16; ++j) {
        const unsigned ab = __float_as_uint(T[j]) & 0xFFu, a = ab >> 4, b = ab & 15u; unsigned i0 = 0u, i1 = 0u;
#pragma unroll
        for (int q = 0; q < 16; ++q) { i0 = (a == (unsigned)q) ? (__float_as_uint(L0[q]) & 0x7Fu) : i0; i1 = (b == (unsigned)q) ? (__float_as_uint(L1[q]) & 0x7Fu) : i1; }
        eg[j] = (u32x2){i0 * 128u + i1, __float_as_uint(e[j] * inv)};
    }
}
__device__ __forceinline__ float gelu_tanh(float x) { const float u = 0.7978845608028654f * (x + 0.044715f * x * x * x); return 0.5f * x * (1.f + tanhf_(u)); }
__device__ __forceinline__ float dot2bf(unsigned w, unsigned x, float acc) { return __builtin_amdgcn_fdot2_f32_bf16(__builtin_bit_cast(bf16x2_t, w), __builtin_bit_cast(bf16x2_t, x), acc, false); }
__device__ __forceinline__ float wave_total63(float x) {
    x = red16(x);
    x += __int_as_float(__builtin_amdgcn_update_dpp(0, __float_as_int(x), 0x142, 0xa, 0xf, false));
    x += __int_as_float(__builtin_amdgcn_update_dpp(0, __float_as_int(x), 0x143, 0xc, 0xf, false));
    return x;
}

#ifdef MAPPROBE
__device__ __forceinline__ int mfma_map_probe(int lane) {
    const int jb = lane >> 4; const bool col0 = (lane & 15) == 0;
    i32x8 B;
#pragma unroll
    for (int r = 0; r < 8; ++r) { unsigned w = 0u;
#pragma unroll
        for (int x = 0; x < 4; ++x) { unsigned p = (unsigned)(jb * 32 + 4 * r + x); if (p == 127u) p = 0u; w |= p << (8 * x); }
        B[r] = col0 ? (int)w : 0; }
    unsigned ok = 0x3Fu;
#pragma unroll 1
    for (int t = 0; t < 127; ++t) {
        const int j = t >> 5, e = t & 31;
        i32x8 A;
#pragma unroll
        for (int w = 0; w < 4; ++w) A[w] = (lane == 16 * j && w == (e >> 3)) ? (int)(2u << (4 * (e & 7))) : 0;
        A[4] = 0; A[5] = 0; A[6] = 0; A[7] = 0;
        f32x4 c = {0.f, 0.f, 0.f, 0.f};
        c = __builtin_amdgcn_mfma_scale_f32_16x16x128_f8f6f4(A, B, c, 4, 0, 0, 0x7F7F7F7F, 0, 0x7F7F7F7F);
        const float v = __int_as_float(__builtin_amdgcn_readlane(__float_as_int(c[0]), 0));
        const unsigned ps = (unsigned)__builtin_amdgcn_cvt_pk_fp8_f32(v, v, 0, false) & 0xFFu;
        const int k1 = 32 * j + e;
        const unsigned p1 = (unsigned)k1;
        const unsigned p2 = (unsigned)(((k1 & 63) >> 4) * 32 + (k1 >> 6) * 16 + (k1 & 15));
        const int k3 = 64 * (e >> 4) + 16 * j + (e & 15); const unsigned p3 = (unsigned)k3;
        const unsigned p4 = (unsigned)(32 * j + (e ^ 1));
        const unsigned p5 = (unsigned)(((k1 & 31) >> 3) * 32 + (k1 >> 5) * 8 + (k1 & 7));
        const int k6 = 32 * (e >> 3) + 8 * j + (e & 7); const unsigned p6 = (unsigned)k6;
        if (ps != p1 && p1 != 127u) ok &= ~1u;
        if (ps != p2 && p2 != 127u) ok &= ~2u;
        if (ps != p3 && p3 != 127u) ok &= ~4u;
        if (ps != p4 && p4 != 127u) ok &= ~8u;
        if (ps != p5 && p5 != 127u) ok &= ~16u;
        if (ps != p6 && p6 != 127u) ok &= ~32u;
    }
    return ok ? __builtin_ctz(ok) + 1 : 0;
}
#endif
__device__ __forceinline__ void phase_peer(const Ctx& F, int l, int nrows, const float* mod, float* wr_override) {
    const float* S = WSP(float, WS_S); u32x2* EG = WSP(u32x2, WS_EG); const bf16_t* H = WSP(bf16_t, WS_H);
    const unsigned char* U = F.ws + WS_U + (size_t)l * UV_LSTRIDE; const unsigned char* V = F.ws + WS_V + (size_t)l * UV_LSTRIDE;
    const float* USC = WSP(float, WS_SC) + (size_t)l * 2 * 16384; const float* VSC = USC + 16384;
#ifdef MAPPROBE
    const float probe_scale = (l == 1) ? 1.f + 0.02f * (float)mfma_map_probe(F.lane) : 1.f;
#endif
    const int tpb = nrows / F.G, tok0 = F.vcu * tpb;
    volatile LAS unsigned* tkflag = (volatile LAS unsigned*)(F.lds + LDSCTL_OFF + 512);
    if (F.tid == 0) tkflag[0] = 0u;
    { const int ntok1 = tpb < 64 ? tpb : 64; const int task = F.tid; const int hd = task / ntok1, tkn = task - hd * ntok1;
      if (hd < 8) { const int row = tok0 + tkn; peer_topk_task(S + ((size_t)(hd * 64) * MALL + row) * 4, (size_t)MALL * 4, EG + (size_t)row * 128 + hd * 16); } }
    __threadfence_block(); __syncthreads();
    if (tpb > 64 && F.wave == 2) {
        const int nex = tpb - 64; const int hd = F.lane / nex, tkn = F.lane - hd * nex;
        if (hd < 8) { const int row = tok0 + 64 + tkn; peer_topk_task(S + ((size_t)(hd * 64) * MALL + row) * 4, (size_t)MALL * 4, EG + (size_t)row * 128 + hd * 16); }
        __threadfence_block(); asm volatile("s_waitcnt vmcnt(0) lgkmcnt(0)" ::: "memory");
        if (F.lane == 0) tkflag[0] = 1u;
    }
    const int lane = F.lane; const bool hi32 = lane >= 32; const unsigned l16 = (unsigned)(lane & 31) * 16u;
    for (int tk = F.wave; tk < tpb; tk += NWAVES) {
        if (tk >= 64) { while (tkflag[0] == 0u) __builtin_amdgcn_s_sleep(8); __threadfence_block(); }
        const int row = tok0 + tk; const bool isc = row >= MLAT; const int smp = isc ? 2 : (row >> 13);
        float* xrow = isc ? WSP(float, WS_XC) + (size_t)(row - MLAT) * DM : F.out + (size_t)row * DM;
        const u32x2 eg0 = EG[(size_t)row * 128 + lane], eg1 = EG[(size_t)row * 128 + 64 + lane];
#if U_FP4
        LAS unsigned char* wl = F.lds + F.wave * PEER_WLDS; LAS unsigned char* hbl = wl + 16 * 528; LAS unsigned char* rawl = hbl + 2048;
        float hscale;
        {   const u32x4 h0 = *(const u32x4*)(H + (size_t)row * DM + lane * 16), h1 = *(const u32x4*)(H + (size_t)row * DM + lane * 16 + 8);
            const unsigned hw[8] = {h0.x, h0.y, h0.z, h0.w, h1.x, h1.y, h1.z, h1.w}; float hf[16]; float am = 0.f;
#pragma unroll
            for (int q = 0; q < 8; ++q) { hf[2 * q] = lo2f(hw[q]); hf[2 * q + 1] = hi2f(hw[q]); am = fmaxf(am, fmaxf(fabsf(hf[2 * q]), fabsf(hf[2 * q + 1]))); }
#pragma unroll
            for (int o = 1; o < 64; o <<= 1) am = fmaxf(am, __shfl_xor(am, o));
            const float sc = am > 0.f ? 224.f / am : 1.f; hscale = am > 0.f ? am * (1.f / 224.f) : 1.f;
            unsigned hiw[4], low[4];
#pragma unroll
            for (int d = 0; d < 4; ++d) { const float a0 = hf[d * 4] * sc, a1 = hf[d * 4 + 1] * sc, a2 = hf[d * 4 + 2] * sc, a3 = hf[d * 4 + 3] * sc;
                int w = __builtin_amdgcn_cvt_pk_fp8_f32(a0, a1, 0, false); w = __builtin_amdgcn_cvt_pk_fp8_f32(a2, a3, w, true);
                const f32x2 b01 = __builtin_amdgcn_cvt_pk_f32_fp8(w, false), b23 = __builtin_amdgcn_cvt_pk_f32_fp8(w, true);
                int wl_ = __builtin_amdgcn_cvt_pk_fp8_f32((a0 - b01.x) * 16.f, (a1 - b01.y) * 16.f, 0, false); wl_ = __builtin_amdgcn_cvt_pk_fp8_f32((a2 - b23.x) * 16.f, (a3 - b23.y) * 16.f, wl_, true);
                hiw[d] = (unsigned)w; low[d] = (unsigned)wl_; }
            LAS unsigned char* hp = hbl + (lane >> 3) * 256 + (lane & 7) * 16;
            *(LAS u32x4*)hp = (u32x4){hiw[0], hiw[1], hiw[2], hiw[3]};
            *(LAS u32x4*)(hp + 128) = (u32x4){low[0], low[1], low[2], low[3]};
        }
        float act0 = 0.f, act1 = 0.f;
        {
            const int mi = lane & 15, mg = lane >> 4;
            const LAS unsigned char* aptr = wl + mi * 528 + mg * 16; const LAS unsigned char* bptr = hbl + (mi & 1) * 128 + mg * 16;
            LAS unsigned char* pk = wl + (lane >> 5) * (8 * 528) + l16;
            u32x4 rr[3][8];
#define PU_LOAD(bt_) do { _Pragma("unroll") for (int q = 0; q < 8; ++q) { const int ia = (bt_) * 16 + q, ib = ia + 8; \
                const unsigned ea = __builtin_amdgcn_readlane(ia < 64 ? eg0.x : eg1.x, ia & 63), eb = __builtin_amdgcn_readlane(ib < 64 ? eg0.x : eg1.x, ib & 63); \
                rr[(bt_) % 3][q] = *(const u32x4*)(U + ((hi32 ? eb : ea) * 512u + l16)); } } while (0)
#define PU_PARK(bt_) do { _Pragma("unroll") for (int q = 0; q < 8; ++q) *(LAS u32x4*)(pk + q * 528) = rr[(bt_) % 3][q]; } while (0)
            PU_LOAD(0); PU_LOAD(1);
#pragma unroll
            for (int bt = 0; bt < 8; ++bt) {
                if (bt + 2 < 8) PU_LOAD(bt + 2);
                PU_PARK(bt);
                f32x4 acc = {0.f, 0.f, 0.f, 0.f};
#pragma unroll
                for (int s = 0; s < 8; ++s) { u32x4 a = *(const LAS u32x4*)(aptr + s * 64);
#ifdef NIBSWAP
                    a = ((a & 0x0F0F0F0Fu) << 4) | ((a >> 4) & 0x0F0F0F0Fu);
#endif
                    const u32x4 b0 = *(const LAS u32x4*)(bptr + s * 256), b1 = *(const LAS u32x4*)(bptr + s * 256 + 64);
                    acc = __builtin_amdgcn_mfma_scale_f32_16x16x128_f8f6f4((i32x8){(int)a.x, (int)a.y, (int)a.z, (int)a.w, 0, 0, 0, 0},
                                                                           (i32x8){(int)b0.x, (int)b0.y, (int)b0.z, (int)b0.w, (int)b1.x, (int)b1.y, (int)b1.z, (int)b1.w}, acc, 4, 0, 0, 0x7F7F7F7F, 0, 0x7F7F7F7F); }
                f32x4 tot;
#pragma unroll
                for (int r = 0; r < 4; ++r) tot[r] = acc[r] + 0.0625f * dppf<0xF5>(acc[r]);
                if (mi == 0) *(LAS f32x4*)(rawl + (bt * 16 + 4 * mg) * 4) = tot;
            }
#undef PU_PARK
#undef PU_LOAD
            act0 = *(const LAS float*)(rawl + lane * 4) * (hscale * USC[eg0.x]); act1 = *(const LAS float*)(rawl + 256 + lane * 4) * (hscale * USC[eg1.x]);
        }
#else
        LAS unsigned char* wl = F.lds + F.wave * PEER_WLDS; LAS unsigned char* hbl = wl + 16 * 1040; LAS unsigned char* rawl = hbl + 2048;
        float hscale;
        {   const u32x4 h0 = *(const u32x4*)(H + (size_t)row * DM + lane * 16), h1 = *(const u32x4*)(H + (size_t)row * DM + lane * 16 + 8);
            const unsigned hw[8] = {h0.x, h0.y, h0.z, h0.w, h1.x, h1.y, h1.z, h1.w}; float hf[16]; float am = 0.f;
#pragma unroll
            for (int q = 0; q < 8; ++q) { hf[2 * q] = lo2f(hw[q]); hf[2 * q + 1] = hi2f(hw[q]); am = fmaxf(am, fmaxf(fabsf(hf[2 * q]), fabsf(hf[2 * q + 1]))); }
#pragma unroll
            for (int o = 1; o < 64; o <<= 1) am = fmaxf(am, __shfl_xor(am, o));
            const float sc = am > 0.f ? 224.f / am : 1.f; hscale = am > 0.f ? am * (1.f / 224.f) : 1.f;
#pragma unroll
            for (int hg = 0; hg < 2; ++hg) { unsigned hiw[2], low[2];
#pragma unroll
                for (int d = 0; d < 2; ++d) { const float a0 = hf[hg * 8 + d * 4] * sc, a1 = hf[hg * 8 + d * 4 + 1] * sc, a2 = hf[hg * 8 + d * 4 + 2] * sc, a3 = hf[hg * 8 + d * 4 + 3] * sc;
                    int w = __builtin_amdgcn_cvt_pk_fp8_f32(a0, a1, 0, false); w = __builtin_amdgcn_cvt_pk_fp8_f32(a2, a3, w, true);
                    const f32x2 b01 = __builtin_amdgcn_cvt_pk_f32_fp8(w, false), b23 = __builtin_amdgcn_cvt_pk_f32_fp8(w, true);
                    int wl_ = __builtin_amdgcn_cvt_pk_fp8_f32((a0 - b01.x) * 16.f, (a1 - b01.y) * 16.f, 0, false); wl_ = __builtin_amdgcn_cvt_pk_fp8_f32((a2 - b23.x) * 16.f, (a3 - b23.y) * 16.f, wl_, true);
                    hiw[d] = (unsigned)w; low[d] = (unsigned)wl_; }
                const int s_ = lane >> 1, g_ = 2 * (lane & 1) + hg;
                *(LAS u32x2*)(hbl + ((s_ * 2 + 0) * 4 + g_) * 8) = (u32x2){hiw[0], hiw[1]};
                *(LAS u32x2*)(hbl + ((s_ * 2 + 1) * 4 + g_) * 8) = (u32x2){low[0], low[1]}; }
        }
        float act0 = 0.f, act1 = 0.f;
        {
            const int mi = lane & 15, mg = lane >> 4;
            const LAS unsigned char* aptr = wl + mi * 1040 + mg * 8; const LAS unsigned char* bptr = hbl + (mi & 1) * 32 + mg * 8;
            u32x4 rr[3][8];
#define PU_LOAD(hb_) do { _Pragma("unroll") for (int q = 0; q < 8; ++q) { const int ii = (hb_) * 8 + q; const unsigned e = __builtin_amdgcn_readlane(ii < 64 ? eg0.x : eg1.x, ii & 63); \
                rr[(hb_) % 3][q] = *(const u32x4*)(U + (size_t)e * 1024 + lane * 16); } } while (0)
#define PU_PARK(hb_) do { _Pragma("unroll") for (int q = 0; q < 8; ++q) *(LAS u32x4*)(wl + (((hb_) & 1) * 8 + q) * 1040 + lane * 16) = rr[(hb_) % 3][q]; } while (0)
            PU_LOAD(0); PU_LOAD(1); PU_LOAD(2);
#pragma unroll
            for (int bt = 0; bt < 8; ++bt) {
                PU_PARK(2 * bt); if (2 * bt + 3 < 16) PU_LOAD(2 * bt + 3);
                PU_PARK(2 * bt + 1); if (2 * bt + 4 < 16) PU_LOAD(2 * bt + 4);
                f32x4 acc = {0.f, 0.f, 0.f, 0.f};
#pragma unroll
                for (int s = 0; s < 32; ++s) { const long a = *(const LAS long*)(aptr + s * 32), b = *(const LAS long*)(bptr + s * 64);
                    acc = __builtin_amdgcn_mfma_f32_16x16x32_fp8_fp8(a, b, acc, 0, 0, 0); }
                f32x4 tot;
#pragma unroll
                for (int r = 0; r < 4; ++r) tot[r] = acc[r] + 0.0625f * dppf<0xF5>(acc[r]);
                if (mi == 0) *(LAS f32x4*)(rawl + (bt * 16 + 4 * mg) * 4) = tot;
            }
#undef PU_PARK
#undef PU_LOAD
            act0 = *(const LAS float*)(rawl + lane * 4) * (hscale * USC[eg0.x]); act1 = *(const LAS float*)(rawl + 256 + lane * 4) * (hscale * USC[eg1.x]);
        }
#endif
#if V_FP4
        u32x4 ra[8], rb[8];
#define PG_LOAD(dst, grp_) do { _Pragma("unroll") for (int q = 0; q < 8; ++q) { const int ia = (grp_) * 16 + q, ib = ia + 8; \
            const unsigned ea = __builtin_amdgcn_readlane(ia < 64 ? eg0.x : eg1.x, ia & 63), eb = __builtin_amdgcn_readlane(ib < 64 ? eg0.x : eg1.x, ib & 63); \
            dst[q] = *(const u32x4*)(V + ((hi32 ? eb : ea) * 512u + l16)); } } while (0)
        PG_LOAD(ra, 0);
        const float cf0 = __uint_as_float(eg0.y) * gelu_tanh(act0) * VSC[eg0.x], cf1 = __uint_as_float(eg1.y) * gelu_tanh(act1) * VSC[eg1.x];
        f32x2 ac[16];
#pragma unroll
        for (int q = 0; q < 16; ++q) ac[q] = (f32x2){0.f, 0.f};
#define PG_VACC(src, grp_) do { _Pragma("unroll") for (int q = 0; q < 8; ++q) { const int ia = (grp_) * 16 + q, ib = ia + 8; \
            const float ca = __int_as_float(__builtin_amdgcn_readlane(__float_as_int(ia < 64 ? cf0 : cf1), ia & 63)), cb = __int_as_float(__builtin_amdgcn_readlane(__float_as_int(ib < 64 ? cf0 : cf1), ib & 63)); \
            const float cf = hi32 ? cb : ca; const unsigned vw[4] = {src[q].x, src[q].y, src[q].z, src[q].w}; \
            _Pragma("unroll") for (int j = 0; j < 4; ++j) { ac[4 * j] += cf * __builtin_amdgcn_cvt_scalef32_pk_f32_fp4(vw[j], 1.0f, 0); ac[4 * j + 1] += cf * __builtin_amdgcn_cvt_scalef32_pk_f32_fp4(vw[j], 1.0f, 1); \
                ac[4 * j + 2] += cf * __builtin_amdgcn_cvt_scalef32_pk_f32_fp4(vw[j], 1.0f, 2); ac[4 * j + 3] += cf * __builtin_amdgcn_cvt_scalef32_pk_f32_fp4(vw[j], 1.0f, 3); } } } while (0)
#pragma unroll 1
        for (int g2 = 0; g2 < 4; ++g2) {
            PG_LOAD(rb, 2 * g2 + 1); PG_VACC(ra, 2 * g2);
            if (g2 < 3) PG_LOAD(ra, 2 * g2 + 2);
            PG_VACC(rb, 2 * g2 + 1);
        }
#undef PG_LOAD
#undef PG_VACC
        float acc[16];
#pragma unroll
        for (int q = 0; q < 8; ++q) { const f32x2 mine = hi32 ? ac[8 + q] : ac[q], send = hi32 ? ac[q] : ac[8 + q];
            acc[2 * q] = mine.x + __shfl_xor(send.x, 32); acc[2 * q + 1] = mine.y + __shfl_xor(send.y, 32); }
        const int col0 = 32 * (lane & 31) + 16 * (lane >> 5);
#else
        constexpr int GS = 8, NG2 = 128 / (2 * GS);
        u32x4 ra[GS], rb[GS];
#define PG_LOAD(dst, tab, grp_) do { _Pragma("unroll") for (int q = 0; q < GS; ++q) { const int ii = (grp_) * GS + q; const unsigned e = __builtin_amdgcn_readlane(ii < 64 ? eg0.x : eg1.x, ii & 63); \
            dst[q] = *(const u32x4*)((tab) + (size_t)e * 1024 + lane * 16); } } while (0)
        PG_LOAD(ra, V, 0);
        const float cf0 = __uint_as_float(eg0.y) * gelu_tanh(act0) * VSC[eg0.x], cf1 = __uint_as_float(eg1.y) * gelu_tanh(act1) * VSC[eg1.x];
        f32x2 ac[8];
#pragma unroll
        for (int q = 0; q < 8; ++q) ac[q] = (f32x2){0.f, 0.f};
#define PG_VACC(src, grp_) do { _Pragma("unroll") for (int q = 0; q < GS; ++q) { const int ii = (grp_) * GS + q; const float cf = __int_as_float(__builtin_amdgcn_readlane(__float_as_int(ii < 64 ? cf0 : cf1), ii & 63)); \
            const unsigned vw[4] = {src[q].x, src[q].y, src[q].z, src[q].w}; \
            _Pragma("unroll") for (int j = 0; j < 4; ++j) { ac[2 * j] += cf * __builtin_amdgcn_cvt_pk_f32_fp8((int)vw[j], false); ac[2 * j + 1] += cf * __builtin_amdgcn_cvt_pk_f32_fp8((int)vw[j], true); } } } while (0)
#pragma unroll 1
        for (int g2 = 0; g2 < NG2; ++g2) {
            PG_LOAD(rb, V, 2 * g2 + 1); PG_VACC(ra, 2 * g2);
            if (g2 < NG2 - 1) PG_LOAD(ra, V, 2 * g2 + 2);
            PG_VACC(rb, 2 * g2 + 1);
        }
#undef PG_LOAD
#undef PG_VACC
        float acc[16];
#pragma unroll
        for (int q = 0; q < 8; ++q) { acc[2 * q] = ac[q].x; acc[2 * q + 1] = ac[q].y; }
        const int col0 = lane * 16;
#endif
        const float* gt = mod + smp * 6144 + 5120;
        f32x4 res[4]; float ss = 0.f;
#pragma unroll
        for (int q = 0; q < 4; ++q) { const int c = col0 + q * 4; const f32x4 g = *(const f32x4*)(gt + c), x = *(const f32x4*)(xrow + c);
            res[q] = x + ZF(1) * g * (f32x4){acc[q * 4], acc[q * 4 + 1], acc[q * 4 + 2], acc[q * 4 + 3]};
#ifdef MAPPROBE
            res[q] = res[q] * probe_scale;
#endif
            *(f32x4*)((wr_override ? wr_override + (size_t)row * DM : xrow) + c) = res[q];
            ss += (res[q][0] * res[q][0] + res[q][1] * res[q][1]) + (res[q][2] * res[q][2] + res[q][3] * res[q][3]); }
        if (l == 0 && !wr_override) {
            const float rs = rsqrtf(wave_sum(ss) * (1.f / DM) + EPSN); const float* mb1 = mod + 3 * 6144 + smp * 6144; const float* g1 = F.in[6] + DM;
            bf16_t* Hw = WSP(bf16_t, WS_H) + (size_t)row * DM;
#pragma unroll
            for (int q = 0; q < 4; ++q) { const int c = col0 + q * 4; const f32x4 g = *(const f32x4*)(g1 + c), sc = *(const f32x4*)(mb1 + 1024 + c), sh = *(const f32x4*)(mb1 + c);
                st4bf(Hw + c, (res[q] * rs * g) * (1.f + sc) + sh); }
        }
    }
}

constexpr int PH_PER_LAYER = 10, N_PHASES = 1 + 2 * PH_PER_LAYER;
struct Args { const float* in[32]; float* out; unsigned char* ws; int ph_lo, ph_hi, li, pad; };
__global__ void __launch_bounds__(NTHR, 2) mk_fwd(Args args) {
    extern __shared__ __attribute__((aligned(16))) unsigned char lds[];
    Ctx F;
    F.lds = (LAS unsigned char*)lds;
    volatile LAS unsigned* MISC = (volatile LAS unsigned*)(F.lds + MISC_OFF);
    F.tid = threadIdx.x; F.lane = F.tid & 63; F.wave = __builtin_amdgcn_readfirstlane(F.tid >> 6);
    F.G = gridDim.x; { const int bx = blockIdx.x; F.vcu = (F.G % 8 == 0) ? (bx % 8) * (F.G / 8) + bx / 8 : bx; }
#pragma unroll
    for (int i = 0; i < 32; ++i) F.in[i] = args.in[i];
    F.out = args.out; F.ws = args.ws;
    for (int u = F.tid; u < (LDS_BYTES - LDSCTL_OFF) / 4; u += NTHR) ((LAS unsigned*)(F.lds + LDSCTL_OFF))[u] = 0u;
    __syncthreads();
    XcdBarrier bar; bar.bar = (unsigned*)(args.ws + WS_CTL) + CW_BAR; bar.x = 0; bar.st = nullptr;
#if !MK_MULTI
    bar = xcd_barrier_post((unsigned*)(args.ws + WS_CTL) + CW_BAR, MISC + 8);
#endif
    const int lo = args.ph_lo, hi = args.ph_hi;
#ifndef KMAX
#define KMAX 1000
#endif
#define IN(k) (lo <= (k) && (k) < hi && (REP_ALL == 1 || ra == REP_ALL - 1 || (k) <= KMAX))
#ifndef REP_PH
#define REP_PH -1
#endif
#define REPS(k) ((REP_PH == (k)) ? 2 : 1)
#define PHCTX Ctx Fp = F; { int t_ = F.tid; asm volatile("" : "+v"(t_)); Fp.tid = t_; Fp.lane = t_ & 63; }
#if MK_MULTI
#define SEAM(k) do { } while (0)
#else
#ifndef BAR_REPS
#define BAR_REPS 1
#endif
#define SEAM(k) do { if (IN(k) && IN((k) + 1)) for (int br_ = 0; br_ < BAR_REPS; ++br_) xcd_barrier(bar); } while (0)
#endif
#ifndef REP_ALL
#define REP_ALL 1
#endif
#ifndef REP_SUB
#define REP_SUB 0
#endif
#pragma unroll 1
    for (int ra = 0; ra < REP_ALL; ++ra) {
    if (ra > 0) xcd_barrier(bar);
    if (IN(0)) { PHCTX; for (int rep = 0; rep < REPS(100); ++rep) phase_prologue(Fp); }
    SEAM(0);
    float* XC = WSP(float, WS_XC);
#pragma unroll 1
    for (int l = 0; l < 2; ++l) {
        const int pb = 1 + l * PH_PER_LAYER;
        const float* xlat = l == 0 ? F.in[0] : F.out; const float* xctx = l == 0 ? F.in[2] : XC;
        const int mrows = l == 0 ? MALL : MLAT;
        const float* mod = WSP(float, WS_MOD) + (size_t)l * 3 * 6144;
        if (IN(pb + 0) && l == 0) { PHCTX; for (int rep = 0; rep < REPS(0); ++rep) { phase_norm(Fp, l, 0, MALL, xlat, xctx); } }
        if (l == 0) SEAM(pb + 0);
        if (IN(pb + 1)) for (int rep = 0; rep < REPS(1); ++rep) { PHCTX; pg8::Gemm g{WSP(bf16_t, WS_H), WSP(bf16_t, WS_WIN + l * WIN_LSTRIDE), MALL, DINP, DM}; pg8::StaticOrder So; So.init(MALL, DINP, F.G, (int)blockIdx.x);
            pg8::EpiBf16 E{WSP(bf16_t, WS_P), DINP}; pg8::gemm_phase<pg8::EpiBf16, pg8::StaticOrder, true, true>(F.lds, g, So, E, Fp.tid); }
        SEAM(pb + 1);
        if (IN(pb + 2)) { PHCTX; for (int rep = 0; rep < REPS(2); ++rep) { phase_prep(Fp, l); __syncthreads(); } }
        SEAM(pb + 2);
        if (IN(pb + 3)) for (int rep = 0; rep < REPS(3); ++rep) {
            const int nra = 16 * RCH, nml = 16 * NCHK;
            for (int r3 = 0; r3 < (REP_SUB == 3 ? 2 : 1); ++r3) { PHCTX; for (int task = F.vcu; task < nra; task += F.G) { RaRaw cur_; ra_load(Fp, task, cur_); rwkv_chunk_pre(Fp, task, cur_); } __syncthreads(); }
            for (int r3 = 0; r3 < (REP_SUB == 4 ? 2 : 1); ++r3) { PHCTX; for (int task = (F.vcu + F.G - 72) % F.G; task < nml; task += F.G) mlstm_local(Fp, task); }
        }
        SEAM(pb + 3);
                if (IN(pb + 4)) for (int rep = 0; rep < REPS(4); ++rep) {
            if (F.vcu < 16) { PHCTX; rwkv_chain(Fp, F.vcu); }
            else { { PHCTX; mlstm_chain(Fp, 16); }
                   { PHCTX; const int natt = l == 0 ? 264 : 256; for (int task = F.vcu - 16; task < natt; task += F.G - 16) attn_unit(Fp, l, task); } } }
        SEAM(pb + 4);
        if (IN(pb + 5)) for (int rep = 0; rep < REPS(5); ++rep) { const int nro = l == 0 ? 264 : 256, nun = l == 0 ? 528 : 512;
            { PHCTX; for (int u = F.vcu; u < nro; u += F.G) rwkv_out(Fp, l, u); }
            { PHCTX; for (int u = (F.vcu + F.G - 8) % F.G; u < nun; u += F.G) mlstm_out(Fp, l, u); } }
        SEAM(pb + 5);
        if (IN(pb + 6)) for (int rep = 0; rep < REPS(6); ++rep) { PHCTX; pg8::Gemm g{WSP(bf16_t, WS_YCAT), WSP(bf16_t, WS_WOUT + l * WOUT_LSTRIDE), mrows, DM, DM}; pg8::StaticOrder So; So.init(mrows, DM, F.G, (int)blockIdx.x);
            float* dummy = WSP(float, WS_YR); const bool dm_ = (REPS(6) == 2 && rep == 0); pg8::EpiRes E{xlat, xctx, dm_ ? dummy : F.out, dm_ ? dummy : XC, mod}; pg8::gemm_phase<pg8::EpiRes, pg8::StaticOrder, true, true>(F.lds, g, So, E, Fp.tid); }
        SEAM(pb + 6);
        if (IN(pb + 7)) { PHCTX; for (int rep = 0; rep < REPS(7); ++rep) phase_norm(Fp, l, 1, mrows, F.out, XC); }
        SEAM(pb + 7);
        if (IN(pb + 8)) for (int rep = 0; rep < REPS(8); ++rep) { PHCTX; pg8::Gemm g{WSP(bf16_t, WS_H), WSP(bf16_t, WS_WEFF + l * WEFF_LSTRIDE), mrows, 2048, DM}; pg8::StaticOrder So; So.init(mrows, 2048, F.G, (int)blockIdx.x);
            pg8::EpiF32 E{WSP(float, WS_S), MALL}; pg8::gemm_phase<pg8::EpiF32, pg8::StaticOrder, true, true>(F.lds, g, So, E, Fp.tid); }
        SEAM(pb + 8);
        if (IN(pb + 9)) { PHCTX; for (int rep = 0; rep < REPS(9); ++rep) { phase_peer(Fp, l, mrows, mod, (REPS(9) == 2 && rep == 0) ? WSP(float, WS_YR) : nullptr); __syncthreads(); } }
        SEAM(pb + 9);
    }
    }
#undef IN
#undef SEAM
}

extern "C" void kernel_launch(void* const* d_in, const int* in_sizes, int n_in, void* d_out, int out_size, void* d_ws, size_t ws_size, hipStream_t stream) {
    static int grid = 0;
    if (grid == 0) {
        if (n_in != 32 || out_size != MLAT * DM || ws_size < WS_END2) { fprintf(stderr, "kernel_launch: unexpected shapes: n_in %d out %d ws %zu (need %zu)\n", n_in, out_size, ws_size, (size_t)WS_END2); grid = -1; return; }
        int dev = 0, cus = 0, per_cu = 0;
        if (hipGetDevice(&dev) != hipSuccess || hipDeviceGetAttribute(&cus, hipDeviceAttributeMultiprocessorCount, dev) != hipSuccess) { grid = -1; return; }
        if (hipFuncSetAttribute((const void*)mk_fwd, hipFuncAttributeMaxDynamicSharedMemorySize, LDS_BYTES) != hipSuccess) { fprintf(stderr, "kernel_launch: hipFuncSetAttribute failed\n"); grid = -1; return; }
        if (hipOccupancyMaxActiveBlocksPerMultiprocessor(&per_cu, (const void*)mk_fwd, NTHR, LDS_BYTES) != hipSuccess || per_cu < 1) fprintf(stderr, "kernel_launch: occupancy query reports %d\n", per_cu);
        (void)hipGetLastError();
        grid = cus;
        if (grid != 256) fprintf(stderr, "kernel_launch: grid %d (built for 256 CUs)\n", grid);
    }
    if (grid < 0) return;
    (void)hipMemsetAsync((char*)d_ws + WS_CTL, 0, CTL_ZERO_BYTES, stream);
    Args a{};
    for (int i = 0; i < 32; ++i) a.in[i] = (const float*)d_in[i];
    a.out = (float*)d_out; a.ws = (unsigned char*)d_ws;
#if MK_MULTI
    for (int p = 0; p < N_PHASES; ++p) { a.ph_lo = p; a.ph_hi = p + 1; a.li = p; hipLaunchKernelGGL(mk_fwd, dim3(grid), dim3(NTHR), LDS_BYTES, stream, a); }
#else
    a.ph_lo = 0; a.ph_hi = N_PHASES; a.li = 0;
    hipLaunchKernelGGL(mk_fwd, dim3(grid), dim3(NTHR), LDS_BYTES, stream, a);
#endif
}
```

```cpp
#include <hip/hip_runtime.h>
#include <cstdio>
#include <cstdint>

#ifndef MK_MULTI
#define MK_MULTI 0
#endif
namespace pg8 {
#define PG8_LAS __attribute__((address_space(3)))
typedef unsigned short bf16_t;
typedef short bf16x8 __attribute__((ext_vector_type(8)));
typedef float f32x4 __attribute__((ext_vector_type(4)));
typedef unsigned u32x4 __attribute__((ext_vector_type(4)));
constexpr int BM = 256, BK = 64, HALF = 128, HTB = HALF * BK * 2  , STAGE_BYTES = 8 * HTB, NXCD = 8, WGM = 8;

__host__ __device__ __forceinline__ int lds_byte(int r, int c) { const int st = (r >> 4) * 2 + (c >> 5), rr = r & 15, cc = c & 31, ob = rr * 64 + cc * 2; return st * 1024 + (ob ^ (((ob >> 9) & 1) << 5)); }
__host__ __device__ __forceinline__ void stage_rc(int b, int& R, int& C) { const int st = b / 1024, sb = b % 1024, swz = sb ^ (((sb >> 9) & 1) << 5); R = (st >> 1) * 16 + swz / 64; C = (st & 1) * 32 + (swz % 64) / 2; }
__host__ __device__ __forceinline__ int perm32(int rho) { const int n = rho >> 4, i = rho & 15; return 8 * (i >> 2) + 4 * n + (i & 3); }

struct Unit { int pm, pn; };
struct Gemm { const bf16_t* A; const bf16_t* Bt; int M, N, K; };

struct StaticOrder {
    int nM, nN, nwg, G, c;
    __host__ __device__ void init(int M, int N, int G_, int c_) { nM = M / BM; nN = N / BM; nwg = nM * nN; G = G_; c = c_; }
    __host__ __device__ bool next(int i, Unit& u) const {
        const long L = (long)i * G + c; if (L >= nwg) return false;
        int wgid = (int)L; { const int q = nwg / NXCD, r = nwg % NXCD, xcd = wgid % NXCD, off = wgid / NXCD; wgid = (xcd < r ? xcd * (q + 1) : r * (q + 1) + (xcd - r) * q) + off; }
        const int nig = WGM * nN, gid = wgid / nig, fm = gid * WGM, gsz = (nM - fm) < WGM ? (nM - fm) : WGM;
        u.pm = fm + ((wgid % nig) % gsz); u.pn = (wgid % nig) / gsz; return true;
    }
    __device__ __forceinline__ void a_ready(const Unit&) const {}
    __device__ __forceinline__ void done(const Unit&) const {}
};

__device__ __forceinline__ unsigned cvt_pk_bf16(float lo, float hi) { unsigned r; asm volatile("v_cvt_pk_bf16_f32 %0, %1, %2" : "=v"(r) : "v"(lo), "v"(hi)); return r; }

struct EpiBf16 {
    static constexpr bool PERM = true, AFTER_DRAIN = false;
    bf16_t* O; int ldc;
    __device__ __forceinline__ void operator()(const f32x4 (&acc)[2][2][4][2], const Unit& u, int wr, int wc, int fr, int fq) const {
        const int row0 = u.pm * BM + wr * 64 + fr; const int col0 = u.pn * BM + wc * 32 + 8 * fq;
#pragma unroll
        for (int ai = 0; ai < 2; ++ai)
#pragma unroll
            for (int m = 0; m < 4; ++m) { bf16_t* rowp = O + (size_t)(row0 + ai * HALF + m * 16) * ldc + col0;
#pragma unroll
                for (int bj = 0; bj < 2; ++bj) { const f32x4 v0 = acc[ai][bj][m][0], v1 = acc[ai][bj][m][1];
                    u32x4 w; w.x = cvt_pk_bf16(v0[0], v0[1]); w.y = cvt_pk_bf16(v0[2], v0[3]); w.z = cvt_pk_bf16(v1[0], v1[1]); w.w = cvt_pk_bf16(v1[2], v1[3]);
                    *(u32x4*)(rowp + bj * HALF) = w; } }
    }
};
struct EpiF32 {
    static constexpr bool PERM = false, AFTER_DRAIN = false;
    float* O; int ldr;
    __device__ __forceinline__ void operator()(const f32x4 (&acc)[2][2][4][2], const Unit& u, int wr, int wc, int fr, int fq) const {
        const int row0 = u.pm * BM + wr * 64 + fr; const int col0 = u.pn * BM + wc * 32 + 4 * fq;
#pragma unroll
        for (int ai = 0; ai < 2; ++ai)
#pragma unroll
            for (int m = 0; m < 4; ++m) { const int row = row0 + ai * HALF + m * 16;
#pragma unroll
                for (int bj = 0; bj < 2; ++bj)
#pragma unroll
                    for (int n = 0; n < 2; ++n) { const int cg = (col0 + bj * HALF + n * 16) >> 2; *(f32x4*)(O + ((size_t)cg * ldr + row) * 4) = acc[ai][bj][m][n]; } }
    }
};
struct EpiRes {
    static constexpr bool PERM = false, AFTER_DRAIN = false;
    const float* src_lat; const float* src_ctx; float* dst_lat; float* dst_ctx; const float* gate;
    __device__ __forceinline__ void operator()(const f32x4 (&acc)[2][2][4][2], const Unit& u, int wr, int wc, int fr, int fq) const {
        const bool isc = u.pm >= 64; const int smp = isc ? 2 : (u.pm >> 5);
        const int prow = (isc ? (u.pm - 64) * BM : u.pm * BM) + wr * 64 + fr;
        const float* src = isc ? src_ctx : src_lat; float* dst = isc ? dst_ctx : dst_lat;
        const float* gt = gate + smp * 6144 + 2048;
        const int col0 = u.pn * BM + wc * 32 + 4 * fq;
        f32x4 gv[2][2];
#pragma unroll
        for (int bj = 0; bj < 2; ++bj)
#pragma unroll
            for (int n = 0; n < 2; ++n) gv[bj][n] = *(const f32x4*)(gt + col0 + bj * HALF + n * 16);
#pragma unroll
        for (int ai = 0; ai < 2; ++ai)
#pragma unroll
            for (int m = 0; m < 4; ++m) { const size_t off = (size_t)(prow + ai * HALF + m * 16) * 1024 + col0;
#pragma unroll
                for (int bj = 0; bj < 2; ++bj)
#pragma unroll
                    for (int n = 0; n < 2; ++n) { const f32x4 s = *(const f32x4*)(src + off + bj * HALF + n * 16);
                        *(f32x4*)(dst + off + bj * HALF + n * 16) = s + gv[bj][n] * acc[ai][bj][m][n]; } }
    }
};

template <class Epi, class Sched, bool ALIGN_EPI = false, bool SP2 = false>
__device__ __forceinline__ void gemm_phase(PG8_LAS unsigned char* lds, const Gemm g, const Sched& S, const Epi& E, const int tid) {
    const int wid = __builtin_amdgcn_readfirstlane(tid >> 6), lane = tid & 63, wr = wid >> 2, wc = wid & 3, fr = lane & 15, fq = lane >> 4;
    const int K = g.K, nt = K / BK;
    unsigned voffA[2], voffB[2];
#pragma unroll
    for (int i = 0; i < 2; ++i) { int R, C; stage_rc(tid * 16 + i * 8192, R, C); const int Rb = Epi::PERM ? ((R & ~31) + perm32(R & 31)) : R;
        voffA[i] = (unsigned)(R * K + C) * 2u; voffB[i] = (unsigned)(Rb * K + C) * 2u; }
    const size_t kstep = (size_t)(BK * 2);
    const size_t hstep = (size_t)HALF * K * 2;
    const size_t tstep = 2 * hstep;
    const unsigned ldsw = (unsigned)wid * 1024u;
    const int aoff = lds_byte(wr * 64 + fr, fq * 8), boff = lds_byte(wc * 32 + fr, fq * 8);
#define PG8_SA(b, h) (((b) * 2 + (h)) * HTB)
#define PG8_SB(b, h) ((4 + (b) * 2 + (h)) * HTB)
#define PG8_STAGE(bufoff, gbase, voff) do { _Pragma("unroll") for (int _i = 0; _i < 2; ++_i) \
        __builtin_amdgcn_global_load_lds((const unsigned*)((const char*)(gbase) + (voff)[_i]), (PG8_LAS unsigned*)(lds + (bufoff) + ldsw + _i * 8192), 16, 0, 0); } while (0)
#define PG8_LDA(dst, b, h) do { _Pragma("unroll") for (int m = 0; m < 4; ++m) _Pragma("unroll") for (int k = 0; k < 2; ++k) dst[m][k] = *(const PG8_LAS bf16x8*)(lds + PG8_SA(b, h) + aoff + m * 2048 + k * 1024); } while (0)
#define PG8_LDB(dst, b, h) do { _Pragma("unroll") for (int n = 0; n < 2; ++n) _Pragma("unroll") for (int k = 0; k < 2; ++k) dst[n][k] = *(const PG8_LAS bf16x8*)(lds + PG8_SB(b, h) + boff + n * 2048 + k * 1024); } while (0)
#define PG8_MMA(ai, bj, At, Bt) do { __builtin_amdgcn_s_setprio(1); _Pragma("unroll") for (int m = 0; m < 4; ++m) _Pragma("unroll") for (int n = 0; n < 2; ++n) _Pragma("unroll") for (int k = 0; k < 2; ++k) \
        acc[ai][bj][m][n] = __builtin_amdgcn_mfma_f32_16x16x32_bf16(Bt[n][k], At[m][k], acc[ai][bj][m][n], 0, 0, 0); __builtin_amdgcn_s_setprio(0); } while (0)
#define PG8_WAIT_V(n) asm volatile("s_waitcnt vmcnt(" #n ")" ::: "memory")
#define PG8_WAIT_L(n) asm volatile("s_waitcnt lgkmcnt(" #n ")" ::: "memory")
#define PG8_BAR __builtin_amdgcn_s_barrier()
#define PG8_SCHED __builtin_amdgcn_sched_barrier(0)
    Unit cur, nxt; int ui = 0;
    if (!S.next(0, cur)) return;
    f32x4 acc[2][2][4][2];
#pragma unroll
    for (int a = 0; a < 2; ++a)
#pragma unroll
        for (int b = 0; b < 2; ++b)
#pragma unroll
            for (int m = 0; m < 4; ++m)
#pragma unroll
                for (int n = 0; n < 2; ++n) acc[a][b][m][n] = (f32x4){0.f, 0.f, 0.f, 0.f};
    bf16x8 At[4][2], B0[2][2], B1[2][2];
    const char* cA = (const char*)g.A + (size_t)cur.pm * tstep; const char* cB = (const char*)g.Bt + (size_t)cur.pn * tstep;
    S.a_ready(cur);
    if constexpr (SP2) {
        PG8_STAGE(PG8_SB(0, 0), cB, voffB); PG8_STAGE(PG8_SB(0, 1), cB + hstep, voffB); PG8_STAGE(PG8_SA(0, 0), cA, voffA); PG8_STAGE(PG8_SA(0, 1), cA + hstep, voffA);
        if (wr == 1) PG8_BAR;
        PG8_WAIT_V(2); PG8_BAR;
        PG8_STAGE(PG8_SB(1, 0), cB + kstep, voffB); PG8_STAGE(PG8_SA(1, 0), cA + kstep, voffA); PG8_STAGE(PG8_SB(1, 1), cB + hstep + kstep, voffB);
        PG8_WAIT_V(6); PG8_BAR;
    } else {
        PG8_STAGE(PG8_SB(0, 0), cB, voffB); PG8_STAGE(PG8_SA(0, 0), cA, voffA); PG8_STAGE(PG8_SB(0, 1), cB + hstep, voffB); PG8_STAGE(PG8_SA(0, 1), cA + hstep, voffA);
        if (wr == 1) PG8_BAR;
        PG8_WAIT_V(4); PG8_BAR;
        PG8_STAGE(PG8_SB(1, 0), cB + kstep, voffB); PG8_STAGE(PG8_SA(1, 0), cA + kstep, voffA); PG8_STAGE(PG8_SB(1, 1), cB + hstep + kstep, voffB);
        PG8_WAIT_V(6); PG8_BAR;
    }
    for (;;) {
        const bool has_next = S.next(ui + 1, nxt);
        const char* nA = has_next ? (const char*)g.A + (size_t)nxt.pm * tstep : cA; const char* nB = has_next ? (const char*)g.Bt + (size_t)nxt.pn * tstep : cB;
        for (int t = 0; t < nt; t += 2) {
            const bool last = (t == nt - 2);
            const char* a1 = cA + (size_t)(t + 1) * kstep;
            const char* a2 = last ? nA : cA + (size_t)(t + 2) * kstep; const char* b2 = last ? nB : cB + (size_t)(t + 2) * kstep;
            const char* a3 = a2 + kstep; const char* b3 = b2 + kstep;
            if (last && has_next) S.a_ready(nxt);
            if constexpr (SP2) {
            PG8_LDB(B0, 0, 0); PG8_LDB(B1, 0, 1); PG8_SCHED; PG8_LDA(At, 0, 0); PG8_STAGE(PG8_SA(1, 1), a1 + hstep, voffA);
            PG8_WAIT_V(8); PG8_WAIT_L(0); PG8_BAR; PG8_MMA(0, 0, At, B0); PG8_MMA(0, 1, At, B1); PG8_BAR; PG8_SCHED;
            PG8_LDA(At, 0, 1); PG8_STAGE(PG8_SB(0, 0), b2, voffB); PG8_STAGE(PG8_SB(0, 1), b2 + hstep, voffB); PG8_STAGE(PG8_SA(0, 0), a2, voffA);
            PG8_WAIT_V(8); PG8_WAIT_L(0); PG8_BAR; PG8_MMA(1, 0, At, B0); PG8_MMA(1, 1, At, B1); PG8_BAR; PG8_SCHED;
            PG8_LDB(B0, 1, 0); PG8_LDB(B1, 1, 1); PG8_SCHED; PG8_LDA(At, 1, 0); PG8_STAGE(PG8_SA(0, 1), a2 + hstep, voffA);
            PG8_WAIT_V(8); PG8_WAIT_L(0); PG8_BAR; PG8_MMA(0, 0, At, B0); PG8_MMA(0, 1, At, B1); PG8_BAR; PG8_SCHED;
            PG8_LDA(At, 1, 1); PG8_STAGE(PG8_SB(1, 0), b3, voffB); PG8_STAGE(PG8_SB(1, 1), b3 + hstep, voffB); PG8_STAGE(PG8_SA(1, 0), a3, voffA);
            PG8_WAIT_V(8); PG8_WAIT_L(0); PG8_BAR; PG8_MMA(1, 0, At, B0); PG8_MMA(1, 1, At, B1); PG8_BAR; PG8_SCHED;
            } else {
            PG8_LDB(B0, 0, 0); PG8_SCHED; PG8_LDA(At, 0, 0); PG8_STAGE(PG8_SA(1, 1), a1 + hstep, voffA);
            PG8_WAIT_L(8); PG8_BAR; PG8_WAIT_L(0); PG8_MMA(0, 0, At, B0); PG8_BAR; PG8_SCHED;
            PG8_LDB(B1, 0, 1); PG8_STAGE(PG8_SB(0, 0), b2, voffB);
            PG8_BAR; PG8_WAIT_L(0); PG8_MMA(0, 1, At, B1); PG8_BAR;
            PG8_LDA(At, 0, 1); PG8_STAGE(PG8_SA(0, 0), a2, voffA);
            PG8_BAR; PG8_WAIT_L(0); PG8_MMA(1, 0, At, B0); PG8_BAR; PG8_SCHED;
            PG8_STAGE(PG8_SB(0, 1), b2 + hstep, voffB);
            PG8_WAIT_V(6); PG8_BAR; PG8_MMA(1, 1, At, B1); PG8_BAR;
            PG8_LDB(B0, 1, 0); PG8_SCHED; PG8_LDA(At, 1, 0); PG8_STAGE(PG8_SA(0, 1), a2 + hstep, voffA);
            PG8_WAIT_L(8); PG8_BAR; PG8_WAIT_L(0); PG8_MMA(0, 0, At, B0); PG8_BAR; PG8_SCHED;
            PG8_LDB(B1, 1, 1); PG8_STAGE(PG8_SB(1, 0), b3, voffB);
            PG8_BAR; PG8_WAIT_L(0); PG8_MMA(0, 1, At, B1); PG8_BAR;
            PG8_LDA(At, 1, 1); PG8_STAGE(PG8_SA(1, 0), a3, voffA);
            PG8_BAR; PG8_WAIT_L(0); PG8_MMA(1, 0, At, B0); PG8_BAR; PG8_SCHED;
            PG8_STAGE(PG8_SB(1, 1), b3 + hstep, voffB);
            PG8_WAIT_V(6); PG8_BAR; PG8_MMA(1, 1, At, B1); PG8_BAR;
            }
        }
        if constexpr (ALIGN_EPI) { if (wr == 0) PG8_BAR; }
        if constexpr (!Epi::AFTER_DRAIN) { E(acc, cur, wr, wc, fr, fq); S.done(cur); }
        if (!has_next) break;
#pragma unroll
        for (int a = 0; a < 2; ++a)
#pragma unroll
            for (int b = 0; b < 2; ++b)
#pragma unroll
                for (int m = 0; m < 4; ++m)
#pragma unroll
                    for (int n = 0; n < 2; ++n) acc[a][b][m][n] = (f32x4){0.f, 0.f, 0.f, 0.f};
        cur = nxt; cA = nA; cB = nB; ++ui;
        if constexpr (ALIGN_EPI) { if (wr == 1) PG8_BAR; }
    }
    PG8_WAIT_V(0);
    if constexpr (!ALIGN_EPI) { if (wr == 0) PG8_BAR; }
    PG8_BAR;
    if constexpr (Epi::AFTER_DRAIN) { E.fused(acc, cur, wr, wc, fr, fq, lds, wid, lane); S.done(cur); }
#undef PG8_SA
#undef PG8_SB
#undef PG8_STAGE
#undef PG8_LDA
#undef PG8_LDB
#undef PG8_MMA
#undef PG8_WAIT_V
#undef PG8_WAIT_L
#undef PG8_BAR
#undef PG8_SCHED
}
}
#ifndef ZMASK
#define ZMASK 0
#endif
#define ZF(bit) ((ZMASK & (bit)) ? 0.f : 1.f)
using pg8::bf16_t; using pg8::bf16x8; using pg8::f32x4; using pg8::u32x4;
constexpr int NWAVES = 8, NTHR = 512;
constexpr int DM = 1024, TLAT = 8192, TCTX = 256, MLAT = 2 * TLAT, MCTX = 2 * TCTX, MALL = MLAT + MCTX;
constexpr int DIN = 3152, DINP = 3328;
constexpr int C_CH = 0, C_CB = 256, C_CC = 512, C_RR = 768, C_RK = 1024, C_RV = 1280, C_XW = 1536, C_XA = 1552, C_XG = 1568,
              C_AQ = 1600, C_AK = 1856, C_AV = 1984, C_MQ = 2112, C_MK = 2368, C_MV = 2624, C_MO = 2880, C_MG = 3136;
constexpr float EPSN = 1e-6f;
constexpr int NCHK = 66;
constexpr int CST = 4160;
constexpr int RWREC = 4608;
constexpr size_t MiB = 1u << 20;
constexpr size_t WS_CTL = 0, CTL_ZERO_BYTES = 1 * MiB, WS_MOD = 1 * MiB;
constexpr size_t WS_WIN = 2 * MiB, WIN_LSTRIDE = (size_t)DINP * DM * 2;
constexpr size_t WS_WOUT = 16 * MiB, WOUT_LSTRIDE = 2 * MiB;
constexpr size_t WS_WEFF = 20 * MiB, WEFF_LSTRIDE = 4 * MiB;
constexpr size_t WS_XC = 28 * MiB, WS_GA = 30 * MiB, WS_H = 32 * MiB, WS_YCAT = 65 * MiB, WS_U = 98 * MiB, WS_V = 130 * MiB;
constexpr size_t WS_P = 162 * MiB, WS_RW = 270 * MiB, WS_YR = 345 * MiB, WS_QA = 378 * MiB, WS_KA = 387 * MiB;
constexpr size_t WS_LC = 392 * MiB, WS_ST = 409 * MiB, WS_LB = 426 * MiB, WS_EG = 427 * MiB, WS_GB = 444 * MiB, WS_BS = 453 * MiB, WS_SC = 453 * MiB + 512 * 1024, WS_END = 454 * MiB;
constexpr size_t UV_LSTRIDE = 16 * MiB;
constexpr size_t WS_S = WS_P;
static_assert(WS_P + (size_t)MALL * DINP * 2 <= WS_RW && WS_RW + (size_t)MALL * RWREC <= WS_YR && WS_S + (size_t)MALL * 2048 * 4 <= WS_YR, "ws map");
static_assert(WS_LC + (size_t)16 * NCHK * CST * 4 <= WS_ST && WS_ST + (size_t)16 * NCHK * CST * 4 <= WS_LB && WS_EG + (size_t)MALL * 128 * 8 <= WS_GB, "ws map 2");
constexpr int CW_BAR = 4096;
constexpr int RING_BYTES = 131072;
constexpr int PEER_WLDS = 16 * 528 + 2048 + 512 + 9 * 512 + 9 * 256 + 64;
constexpr int PHASE_LDS = 8 * PEER_WLDS > RING_BYTES ? 8 * PEER_WLDS : RING_BYTES;
constexpr int LDSCTL_OFF = PHASE_LDS, MISC_OFF = LDSCTL_OFF + 320, LDS_BYTES = PHASE_LDS + 4096;
static_assert(RING_BYTES <= PHASE_LDS && 8 * PEER_WLDS <= PHASE_LDS && LDS_BYTES <= 160 * 1024 && PHASE_LDS % 16 == 0, "LDS map");

#define GAS __attribute__((address_space(1)))
#define LAS __attribute__((address_space(3)))
typedef unsigned u32x2 __attribute__((ext_vector_type(2)));
typedef float f32x2 __attribute__((ext_vector_type(2)));
typedef int i32x8 __attribute__((ext_vector_type(8)));
typedef _Float16 h16x2 __attribute__((ext_vector_type(2)));
typedef __bf16 bf16x2_t __attribute__((ext_vector_type(2)));
typedef GAS unsigned gu32;
#define LDS_WAIT() asm volatile("s_waitcnt lgkmcnt(0)" ::: "memory")
#define LDS_BARRIER() do { asm volatile("s_waitcnt lgkmcnt(0)" ::: "memory"); __builtin_amdgcn_s_barrier(); asm volatile("" ::: "memory"); } while (0)

__device__ __forceinline__ float lo2f(unsigned w) { return __uint_as_float(w << 16); }
__device__ __forceinline__ float hi2f(unsigned w) { return __uint_as_float(w & 0xffff0000u); }
__device__ __forceinline__ float bf2f(bf16_t b) { return __uint_as_float((unsigned)b << 16); }
__device__ __forceinline__ unsigned f2bf(float f) { unsigned u = __float_as_uint(f); return (u + 0x7fffu + ((u >> 16) & 1u)) >> 16; }
__device__ __forceinline__ unsigned pk2(float lo, float hi) { const f32x2 v = {lo, hi}; const bf16x2_t b = __builtin_convertvector(v, bf16x2_t); return __builtin_bit_cast(unsigned, b); }
__device__ __forceinline__ f32x4 ld4bf(const bf16_t* p) { const u32x2 w = *(const u32x2*)p; return (f32x4){lo2f(w.x), hi2f(w.x), lo2f(w.y), hi2f(w.y)}; }
__device__ __forceinline__ void st4bf(bf16_t* p, f32x4 v) { u32x2 w; w.x = pk2(v[0], v[1]); w.y = pk2(v[2], v[3]); *(u32x2*)p = w; }
__device__ __forceinline__ float sigmoidf_(float x) { return 1.f / (1.f + __expf(-x)); }
__device__ __forceinline__ float tanhf_(float x) { const float e = __expf(-2.f * fabsf(x)); const float t = (1.f - e) / (1.f + e); return x < 0.f ? -t : t; }
template <int CTRL> __device__ __forceinline__ float dppf(float x) { return __int_as_float(__builtin_amdgcn_update_dpp(0, __float_as_int(x), CTRL, 0xf, 0xf, true)); }
__device__ __forceinline__ float red16(float x) { x += dppf<0xB1>(x); x += dppf<0x4E>(x); x += dppf<0x141>(x); x += dppf<0x140>(x); return x; }
__device__ __forceinline__ float wave_sum(float v) {
#pragma unroll
    for (int o = 1; o < 64; o <<= 1) v += __shfl_xor(v, o);
    return v;
}
#define XB_TMO      128
#define XB_XCNT(j)  (256  + 64 * (j))
#define XB_XSUB(j)  (1280 + 64 * (j))
#define XB_XGEN(j)  (2304 + 64 * (j))
#define XB_TOP      3328
#define XB_TOPGEN   3392
#define XCD_BAR_WORDS 3456
#define XB_SPIN_CAP (1u << 18)
#ifndef XB_SLEEP
#define XB_SLEEP 1
#endif

__device__ __forceinline__ unsigned xb_ld(unsigned* p)              { return __hip_atomic_load(p, __ATOMIC_RELAXED, __HIP_MEMORY_SCOPE_AGENT); }
__device__ __forceinline__ unsigned xb_add(unsigned* p, unsigned v) { return __hip_atomic_fetch_add(p, v, __ATOMIC_RELAXED, __HIP_MEMORY_SCOPE_AGENT); }
__device__ __forceinline__ unsigned xb_xcc_id() { return (unsigned)__builtin_amdgcn_s_getreg((3 << 11) | 20) & 0xFu; }
#define XB_SPIN(cond, bar) do { unsigned _sp = 0; while (cond) { __builtin_amdgcn_s_sleep(XB_SLEEP); \
    if ((++_sp & 255u) == 0u) { if (xb_ld(&(bar)[XB_TMO])) break; if (_sp > XB_SPIN_CAP) { atomicAdd(&(bar)[XB_TMO], 1u); break; } } } } while (0)

struct XcdBarrier {
    unsigned* bar; unsigned x;
    volatile LAS unsigned* st;
};

__device__ __forceinline__ XcdBarrier xcd_barrier_post(unsigned* bar, volatile LAS unsigned* st) {
    XcdBarrier b; b.bar = bar; b.x = xb_xcc_id(); b.st = st;
    if (threadIdx.x == 0) (void)xb_add(&bar[XB_XCNT(b.x)], 1u);
    return b;
}
__device__ __forceinline__ void xcd_barrier_complete(unsigned* bar, unsigned x, unsigned& nloc, unsigned& nx) {
    const unsigned G = gridDim.x * gridDim.y * gridDim.z;
    unsigned sum, cnt, mine, sp = 0u;
    for (;;) {
        sum = 0u; cnt = 0u; mine = 0u;
#pragma unroll
        for (unsigned j = 0; j < 16; ++j) { const unsigned c = xb_ld(&bar[XB_XCNT(j)]); sum += c; cnt += (c > 0u) ? 1u : 0u; mine = (j == x) ? c : mine; }
        if (sum == G) break;
        __builtin_amdgcn_s_sleep(1);
        if ((++sp & 255u) == 0u) { if (xb_ld(&bar[XB_TMO])) break; if (sp > XB_SPIN_CAP) { atomicAdd(&bar[XB_TMO], 1u); break; } }
    }
    nloc = mine > 0u ? mine : 1u; nx = cnt > 0u ? cnt : 1u;
}

__device__ __forceinline__ void xcd_barrier(const XcdBarrier& b) {
    asm volatile("s_waitcnt vmcnt(0)" ::: "memory");
    __syncthreads();
    if (threadIdx.x == 0) {
        unsigned* bar = b.bar;
        __builtin_amdgcn_s_waitcnt(0);
        unsigned nloc = b.st[0], nx = b.st[1];
        if (nloc == 0u) { xcd_barrier_complete(bar, b.x, nloc, nx); b.st[0] = nloc; b.st[1] = nx; }
        const unsigned old = xb_add(&bar[XB_XSUB(b.x)], 1u);
        const unsigned gen = old / nloc;
        if (old + 1u == (gen + 1u) * nloc) {
            __builtin_amdgcn_fence(__ATOMIC_RELEASE, "agent");
            asm volatile("s_waitcnt vmcnt(0)" ::: "memory");
            const unsigned og = xb_add(&bar[XB_TOP], 1u);
            const unsigned tg = og / nx;
            if (og + 1u == (tg + 1u) * nx) xb_add(&bar[XB_TOPGEN], 1u);
            else XB_SPIN(xb_ld(&bar[XB_TOPGEN]) == tg, bar);
            __builtin_amdgcn_fence(__ATOMIC_ACQUIRE, "agent");
            xb_add(&bar[XB_XGEN(b.x)], 1u);
            asm volatile("s_waitcnt vmcnt(0)" ::: "memory");
        } else {
            XB_SPIN(xb_ld(&bar[XB_XGEN(b.x)]) == gen, bar);
            __builtin_amdgcn_fence(__ATOMIC_ACQUIRE, "agent");
            asm volatile("s_waitcnt vmcnt(0)" ::: "memory");
        }
    }
    __syncthreads();
}
struct Ctx {
    LAS unsigned char* lds; int tid, lane, wave, vcu, G;
    const float* in[32]; float* out; unsigned char* ws;
};
#define WSP(T, off) ((T*)(F.ws + (off)))

__device__ __forceinline__ void p0_transpose_item(const float* W, int K, int N, bf16_t* WT, LAS float* scr, int item, int lane) {
    const int nblk = (N + 31) / 32, kb = item / nblk, nb = item % nblk, k0 = 64 * kb, n0 = 32 * nb;
    const int nn = n0 + (lane & 31);
#pragma unroll 8
    for (int i = 0; i < 32; ++i) { const int kk = 2 * i + (lane >> 5); scr[kk * 33 + (lane & 31)] = nn < N ? W[(size_t)(k0 + kk) * N + nn] : 0.f; }
    LDS_WAIT(); asm volatile("" ::: "memory");
    const int c = lane & 7;
#pragma unroll
    for (int j = 0; j < 4; ++j) { const int n = (lane >> 3) + 8 * j; const LAS float* s = scr + (8 * c) * 33 + n;
        u32x4 o; o.x = pk2(s[0 * 33], s[1 * 33]); o.y = pk2(s[2 * 33], s[3 * 33]); o.z = pk2(s[4 * 33], s[5 * 33]); o.w = pk2(s[6 * 33], s[7 * 33]);
        *(u32x4*)(WT + (size_t)(n0 + n) * K + k0 + 8 * c) = o; }
    LDS_WAIT(); asm volatile("" ::: "memory");
}
__device__ __forceinline__ void convert_uv_rows(const Ctx& F, int l, int r_lo, int r_hi, int widx, int nworkers) {
    float* SC = WSP(float, WS_SC) + (size_t)l * 2 * 16384;
    for (int r0 = r_lo + widx; r0 < r_hi; r0 += 4 * nworkers) {
        f32x4 v[4][4];
#pragma unroll
        for (int u = 0; u < 4; ++u) { const int r = r0 + u * nworkers < r_hi ? r0 + u * nworkers : r0; const int tb = r >> 14, row = r & 16383;
            const float* src = (tb ? F.in[31] : F.in[30]) + ((size_t)l * 16384 + row) * 1024 + F.lane * 16;
#pragma unroll
            for (int j = 0; j < 4; ++j) v[u][j] = *(const f32x4*)(src + 4 * j); }
#pragma unroll
        for (int u = 0; u < 4; ++u) { const int r = r0 + u * nworkers; if (r >= r_hi) break; const int tb = r >> 14, row = r & 16383;
            float am = 0.f;
#pragma unroll
            for (int j = 0; j < 4; ++j) am = fmaxf(am, fmaxf(fmaxf(fabsf(v[u][j][0]), fabsf(v[u][j][1])), fmaxf(fabsf(v[u][j][2]), fabsf(v[u][j][3]))));
#pragma unroll
            for (int o = 1; o < 64; o <<= 1) am = fmaxf(am, __shfl_xor(am, o));
            const float sc = am > 0.f ? 6.f / am : 1.f;
            unsigned ow[2] = {0u, 0u};
#pragma unroll
            for (int j = 0; j < 4; ++j) { unsigned w = ow[j >> 1];
                if (j & 1) { w = __builtin_amdgcn_cvt_scalef32_pk_fp4_f32(w, v[u][j][0] * sc, v[u][j][1] * sc, 1.0f, 2); w = __builtin_amdgcn_cvt_scalef32_pk_fp4_f32(w, v[u][j][2] * sc, v[u][j][3] * sc, 1.0f, 3); }
                else       { w = __builtin_amdgcn_cvt_scalef32_pk_fp4_f32(w, v[u][j][0] * sc, v[u][j][1] * sc, 1.0f, 0); w = __builtin_amdgcn_cvt_scalef32_pk_fp4_f32(w, v[u][j][2] * sc, v[u][j][3] * sc, 1.0f, 1); }
                ow[j >> 1] = w; }
            *(u32x2*)(F.ws + (tb ? WS_V : WS_U) + (size_t)l * UV_LSTRIDE + (size_t)row * 512 + F.lane * 8) = (u32x2){ow[0], ow[1]};
            if (F.lane == 0) SC[tb * 16384 + row] = am > 0.f ? am * (1.f / 6.f) : 1.f; }
    }
}
__device__ __forceinline__ void convert_uv(const Ctx& F, int l) { convert_uv_rows(F, l, 0, 2 * 16384, F.vcu * NWAVES + F.wave, F.G * NWAVES); }
__device__ __forceinline__ void phase_prologue(const Ctx& F) {
    float* MOD = WSP(float, WS_MOD);
    {
        LAS float* sl = (LAS float*)F.lds; LAS float* red = sl + 3072;
        for (int it = F.vcu; it < 192; it += F.G) {
            const int l = it / 96, n0 = (it % 96) * 64;
            for (int i = F.tid; i < 3072; i += NTHR) { const int s = i >> 10, k = i & 1023; const float c = s < 2 ? F.in[1][s * 1024 + k] : F.in[3][k]; sl[i] = c / (1.f + __expf(-c)); }
            __syncthreads();
            const int c = F.tid & 63, kg = F.tid >> 6;
            const float* W = F.in[4] + (size_t)l * 1024 * 6144 + n0 + c;
            float a0 = 0.f, a1 = 0.f, a2 = 0.f;
#pragma unroll 32
            for (int k = kg * 128; k < kg * 128 + 128; ++k) { const float w = W[(size_t)k * 6144]; a0 += sl[k] * w; a1 += sl[1024 + k] * w; a2 += sl[2048 + k] * w; }
            red[(kg * 3 + 0) * 64 + c] = a0; red[(kg * 3 + 1) * 64 + c] = a1; red[(kg * 3 + 2) * 64 + c] = a2;
            __syncthreads();
            if (F.tid < 192) { const int s = F.tid >> 6, cc = F.tid & 63; float t = F.in[5][l * 6144 + n0 + cc];
#pragma unroll
                for (int g = 0; g < 8; ++g) t += red[(g * 3 + s) * 64 + cc];
                MOD[(l * 3 + s) * 6144 + n0 + cc] = t; }
            __syncthreads();
        }
    }
    {
        LAS float* scr = (LAS float*)(F.lds + F.wave * 16384);
        const int gw = F.vcu * NWAVES + F.wave, NGW = F.G * NWAVES;
        constexpr int I_IN = 16 * 99, I_OUT = 16 * 32, I_L = I_IN + I_OUT;
        for (int it = gw; it < 2 * I_L; it += NGW) {
            const int l = it / I_L; int r = it % I_L;
            if (r < I_IN) p0_transpose_item(F.in[8] + (size_t)l * DM * DIN, DM, DIN, WSP(bf16_t, WS_WIN + l * WIN_LSTRIDE), scr, r, F.lane);
            else p0_transpose_item(F.in[9] + (size_t)l * DM * DM, DM, DM, WSP(bf16_t, WS_WOUT + l * WOUT_LSTRIDE), scr, r - I_IN, F.lane);
        }
        for (int i = F.vcu * NTHR + F.tid; i < 2 * 160 * 128; i += F.G * NTHR) { const int l = i / (160 * 128), r = i % (160 * 128);
            *(u32x4*)(WSP(bf16_t, WS_WIN + l * WIN_LSTRIDE) + (size_t)3168 * DM + (size_t)r * 8) = (u32x4){0u, 0u, 0u, 0u}; }
    }
    __syncthreads();
    {
        LAS float* KEYS = (LAS float*)F.lds; LAS float* WQl = KEYS + 128 * 129;
        const int nper = F.G / 32 > 0 ? F.G / 32 : 1;
        const int tile = F.vcu / nper, sub = F.vcu % nper;
        if (tile < 32) {
            const int l = tile >> 4, hh = tile & 15;
            const float* ksrc = F.in[29] + ((size_t)l * 16 + hh) * 128 * 128;
            { f32x4 kv[8];
#pragma unroll
              for (int q = 0; q < 8; ++q) kv[q] = *(const f32x4*)(ksrc + (size_t)(F.tid + q * NTHR) * 4);
#pragma unroll
              for (int q = 0; q < 8; ++q) { const int i = (F.tid + q * NTHR) * 4; LAS float* d = KEYS + (i >> 7) * 129 + (i & 127); d[0] = kv[q][0]; d[1] = kv[q][1]; d[2] = kv[q][2]; d[3] = kv[q][3]; } }
            for (int kb = sub; kb < 16; kb += nper) {
                const float* wsrc = F.in[28] + (size_t)l * DM * 2048 + (size_t)(kb * 64) * 2048 + hh * 128;
                __syncthreads();
                { f32x4 wv[4];
#pragma unroll
                  for (int q = 0; q < 4; ++q) { const int i = (F.tid + q * NTHR) * 4; wv[q] = *(const f32x4*)(wsrc + (size_t)(i >> 7) * 2048 + (i & 127)); }
#pragma unroll
                  for (int q = 0; q < 4; ++q) { const int i = (F.tid + q * NTHR) * 4, kk = i >> 7, d = i & 127; WQl[d * 68 + kk] = wv[q][0]; WQl[(d + 1) * 68 + kk] = wv[q][1]; WQl[(d + 2) * 68 + kk] = wv[q][2]; WQl[(d + 3) * 68 + kk] = wv[q][3]; } }
                __syncthreads();
                const int key = F.tid & 127, kq = F.tid >> 7;
                float acc[16];
#pragma unroll
                for (int j = 0; j < 16; ++j) acc[j] = 0.f;
#pragma unroll 4
                for (int d = 0; d < 128; ++d) { const float a = KEYS[key * 129 + d]; const LAS f32x4* wq = (const LAS f32x4*)(WQl + d * 68 + kq * 16);
#pragma unroll
                    for (int q = 0; q < 4; ++q) { const f32x4 w = wq[q]; acc[4 * q] += a * w[0]; acc[4 * q + 1] += a * w[1]; acc[4 * q + 2] += a * w[2]; acc[4 * q + 3] += a * w[3]; } }
                bf16_t* dst = WSP(bf16_t, WS_WEFF + l * WEFF_LSTRIDE) + (size_t)(hh * 128 + key) * DM + kb * 64 + kq * 16;
                u32x4 o0, o1; o0.x = pk2(acc[0], acc[1]); o0.y = pk2(acc[2], acc[3]); o0.z = pk2(acc[4], acc[5]); o0.w = pk2(acc[6], acc[7]);
                o1.x = pk2(acc[8], acc[9]); o1.y = pk2(acc[10], acc[11]); o1.z = pk2(acc[12], acc[13]); o1.w = pk2(acc[14], acc[15]);
                *(u32x4*)dst = o0; *(u32x4*)(dst + 8) = o1;
            }
        }
        __syncthreads();
    }
    convert_uv(F, 0); convert_uv(F, 1);
}

__device__ __forceinline__ void phase_norm(const Ctx& F, int l, int which, int nrows, const float* xlat, const float* xctx) {
    const float* gain = F.in[6 + which] + l * DM; const float* mod = WSP(float, WS_MOD) + (size_t)l * 3 * 6144;
    const int shoff = which ? 3072 : 0, scoff = which ? 4096 : 1024;
    bf16_t* H = WSP(bf16_t, WS_H);
    const int gw = F.vcu * NWAVES + F.wave, NGW = F.G * NWAVES;
    for (int row = gw; row < nrows; row += NGW) {
        const bool isc = row >= MLAT; const float* src = isc ? xctx + (size_t)(row - MLAT) * DM : xlat + (size_t)row * DM; const int smp = isc ? 2 : (row >> 13);
        const float* mb = mod + smp * 6144;
        f32x4 v[4]; float ss = 0.f;
#pragma unroll
        for (int j = 0; j < 4; ++j) { v[j] = *(const f32x4*)(src + F.lane * 4 + 256 * j); ss += (v[j][0] * v[j][0] + v[j][1] * v[j][1]) + (v[j][2] * v[j][2] + v[j][3] * v[j][3]); }
        const float rs = rsqrtf(wave_sum(ss) * (1.f / DM) + EPSN);
#pragma unroll
        for (int j = 0; j < 4; ++j) { const int c = F.lane * 4 + 256 * j; const f32x4 g = *(const f32x4*)(gain + c), sc = *(const f32x4*)(mb + scoff + c), sh = *(const f32x4*)(mb + shoff + c);
            const f32x4 o = (v[j] * rs * g) * (1.f + sc) + sh; st4bf(H + (size_t)row * DM + c, o); }
    }
}

__device__ __forceinline__ float log_sigmoid_(float x) { return fminf(x, 0.f) - __logf(1.f + __expf(-fabsf(x))); }
__device__ __forceinline__ void phase_prep(const Ctx& F, int l) {
    LAS float* W2s = (LAS float*)F.lds; LAS float* A2s = W2s + 8192; LAS float* G2s = A2s + 8192; LAS float* tsc = G2s + 8192 + F.wave * 64;
    { const float* w2 = F.in[13] + l * 8192; const float* a2 = F.in[15] + l * 8192; const float* g2 = F.in[16] + l * 8192;
      for (int i = F.tid; i < 8192; i += NTHR) { W2s[i] = w2[i]; A2s[i] = a2[i]; G2s[i] = g2[i]; } }
    __syncthreads();
    const bf16_t* P = WSP(bf16_t, WS_P); bf16_t* YC = WSP(bf16_t, WS_YCAT); bf16_t* QA = WSP(bf16_t, WS_QA); bf16_t* KA = WSP(bf16_t, WS_KA);
    unsigned char* RW = WSP(unsigned char, WS_RW); bf16_t* GB = WSP(bf16_t, WS_GB); float* BS = WSP(float, WS_BS); float* GA = WSP(float, WS_GA);
    const int lane = F.lane, c4 = lane * 4, i16 = lane & 15;
    const f32x4 cw0 = *(const f32x4*)(F.in[10] + l * 768 + c4), cw1 = *(const f32x4*)(F.in[10] + l * 768 + 256 + c4), cw2 = *(const f32x4*)(F.in[10] + l * 768 + 512 + c4);
    const f32x4 cg = *(const f32x4*)(F.in[11] + l * 256 + c4);
    const f32x4 qg = *(const f32x4*)(F.in[21] + l * 64 + (c4 & 63)), kg = *(const f32x4*)(F.in[22] + l * 64 + (c4 & 63));
    const f32x4 k_k = *(const f32x4*)(F.in[17] + l * 256 + c4), k_a = *(const f32x4*)(F.in[18] + l * 256 + c4), r_k = *(const f32x4*)(F.in[19] + l * 256 + c4);
    f32x4 w0[2], a0[2];
#pragma unroll
    for (int d = 0; d < 2; ++d) { w0[d] = *(const f32x4*)(F.in[12] + (l * 2 + d) * 256 + c4); a0[d] = *(const f32x4*)(F.in[14] + (l * 2 + d) * 256 + c4); }
    float invf[4];
#pragma unroll
    for (int j = 0; j < 4; ++j) invf[j] = exp2f(-(float)((c4 + j) & 15) * (13.287712379549449f / 16.f));
    const int gw = F.vcu * NWAVES + F.wave, NGW = F.G * NWAVES;
    struct PrepRaw { u32x2 h1, bg, c1, hp, cp, hn, cn, q, k, r, rk; unsigned xv, mg; };
#define PREP_LOAD(dst, row_) do { const int r_ = (row_); const bool isc_ = r_ >= MLAT; const int t_ = isc_ ? ((r_ - MLAT) & 255) : (r_ & 8191); const int T_ = isc_ ? TCTX : TLAT; \
        const bf16_t* pr_ = P + (size_t)r_ * DINP; const bf16_t* pp_ = t_ > 0 ? pr_ - DINP : pr_; const bf16_t* pn_ = t_ < T_ - 1 ? pr_ + DINP : pr_; \
        dst.h1 = *(const u32x2*)(pr_ + C_CH + c4); dst.bg = *(const u32x2*)(pr_ + C_CB + c4); dst.c1 = *(const u32x2*)(pr_ + C_CC + c4); \
        dst.hp = *(const u32x2*)(pp_ + C_CH + c4); dst.cp = *(const u32x2*)(pp_ + C_CC + c4); dst.hn = *(const u32x2*)(pn_ + C_CH + c4); dst.cn = *(const u32x2*)(pn_ + C_CC + c4); \
        dst.q = *(const u32x2*)(pr_ + C_AQ + c4); dst.k = *(const u32x2*)(pr_ + C_AK + (c4 & 127)); dst.r = *(const u32x2*)(pr_ + C_RR + c4); dst.rk = *(const u32x2*)(pr_ + C_RK + c4); \
        dst.xv = pr_[C_XW + lane]; dst.mg = pr_[C_MG + (lane & 15)]; } while (0)
#define UP4(w_) ((f32x4){lo2f((w_).x), hi2f((w_).x), lo2f((w_).y), hi2f((w_).y)})
    PrepRaw cur, nxt;
    if (gw < MALL) PREP_LOAD(cur, gw);
    for (int row = gw; row < MALL; row += NGW) {
        const bool isc = row >= MLAT; const int t = isc ? ((row - MLAT) & 255) : (row & 8191); const int T = isc ? TCTX : TLAT;
        { const int rn = row + NGW < MALL ? row + NGW : row; PREP_LOAD(nxt, rn); }
        {
            const f32x4 h1 = UP4(cur.h1), bg = UP4(cur.bg), c1 = UP4(cur.c1);
            f32x4 up = UP4(cur.hp) * UP4(cur.cp), un = UP4(cur.hn) * UP4(cur.cn);
            if (t == 0) up = (f32x4){0.f, 0.f, 0.f, 0.f};
            if (t == T - 1) un = (f32x4){0.f, 0.f, 0.f, 0.f};
            const f32x4 y = bg * (cw0 * up + cw1 * (c1 * h1) + cw2 * un);
            const float ss = red16((y[0] * y[0] + y[1] * y[1]) + (y[2] * y[2] + y[3] * y[3]));
            const float rs = rsqrtf(ss * (1.f / 64.f) + EPSN);
            st4bf(YC + (size_t)row * DM + c4, y * rs * cg * ZF(2));
        }
        {
            const f32x4 q = UP4(cur.q); const f32x4 k = UP4(cur.k);
            const float qs = red16((q[0] * q[0] + q[1] * q[1]) + (q[2] * q[2] + q[3] * q[3]));
            const float ks = red16((k[0] * k[0] + k[1] * k[1]) + (k[2] * k[2] + k[3] * k[3]));
            f32x4 qn = q * rsqrtf(qs * (1.f / 64.f) + EPSN) * qg, kn = k * rsqrtf(ks * (1.f / 64.f) + EPSN) * kg;
            if (!isc) {
                f32x4 qp, kp;
#pragma unroll
                for (int j = 0; j < 4; ++j) { qp[j] = __shfl_xor(qn[j], 4); kp[j] = __shfl_xor(kn[j], 4); }
                const int d0 = c4 & 63; const float pos = (d0 < 32) ? (float)(t >> 6) : (float)(t & 63); const bool lowh = (d0 & 16) == 0;
#pragma unroll
                for (int j = 0; j < 4; ++j) { const float th = pos * invf[j]; const float cs = __cosf(th), sn = __sinf(th);
                    qn[j] = lowh ? qn[j] * cs - qp[j] * sn : qn[j] * cs + qp[j] * sn; kn[j] = lowh ? kn[j] * cs - kp[j] * sn : kn[j] * cs + kp[j] * sn; }
            }
            st4bf(QA + (size_t)row * 256 + c4, qn * (0.125f * 1.4426950408889634f));
            if (lane < 32) st4bf(KA + (size_t)row * 128 + c4, kn);
        }
        {
            const f32x4 r = UP4(cur.r), k = UP4(cur.rk);
            { const float xv = bf2f((bf16_t)cur.xv);
              tsc[lane] = lane < 16 ? tanhf_(xv) : (lane < 32 ? xv : sigmoidf_(xv)); }
            const f32x4 kx = k * k_k;
            const float kss = red16((kx[0] * kx[0] + kx[1] * kx[1]) + (kx[2] * kx[2] + kx[3] * kx[3]));
            const f32x4 kk = kx * rsqrtf(kss + EPSN);
            bf16_t* recb = (bf16_t*)(RW + (size_t)row * RWREC); float* recf = (float*)(RW + (size_t)row * RWREC + 2560);
            st4bf(recb + c4, kk);
            f32x4 kdsum = {0.f, 0.f, 0.f, 0.f};
#pragma unroll
            for (int d = 0; d < 2; ++d) {
                f32x4 dw = w0[d], da = a0[d];
#pragma unroll 4
                for (int ii = 0; ii < 16; ++ii) { dw += tsc[ii] * *(const LAS f32x4*)(W2s + (d * 16 + ii) * 256 + c4); da += tsc[16 + ii] * *(const LAS f32x4*)(A2s + (d * 16 + ii) * 256 + c4); }
                f32x4 dec, av;
#pragma unroll
                for (int j = 0; j < 4; ++j) { dec[j] = -0.6065306597126334f * sigmoidf_(dw[j]); av[j] = sigmoidf_(da[j]); }
                const f32x4 kd = k * (1.f + (av - 1.f) * k_a);
                kdsum += kd;
                st4bf(recb + 256 + d * 256 + c4, kk * av);
                st4bf(recb + 768 + d * 256 + c4, kd);
                *(f32x4*)(recf + d * 256 + c4) = dec;
            }
            f32x4 gv = {0.f, 0.f, 0.f, 0.f};
#pragma unroll 4
            for (int ii = 0; ii < 32; ++ii) gv += tsc[32 + ii] * *(const LAS f32x4*)(G2s + ii * 256 + c4);
            st4bf(GB + (size_t)row * 256 + c4, gv);
            const f32x4 bt = r * kdsum * r_k;
            const float bsum = red16((bt[0] + bt[1]) + (bt[2] + bt[3]));
            if (i16 == 0) BS[(size_t)row * 4 + (lane >> 4)] = bsum;
        }
        if (lane < 16) { const int dir = lane >> 3, gate = (lane >> 2) & 1, hd = lane & 3; const float x = bf2f((bf16_t)cur.mg);
            const float bias = gate ? F.in[26][(l * 2 + dir) * 4 + hd] : F.in[25][(l * 2 + dir) * 4 + hd];
            GA[(size_t)row * 16 + lane] = gate ? log_sigmoid_(x + bias) : (x + bias); }
        cur = nxt;
    }
#undef PREP_LOAD
#undef UP4
}
__device__ __forceinline__ int scan_row(int b, int dir, int i) {
    if (i < TCTX) return MLAT + b * TCTX + (dir ? (TCTX - 1 - i) : i);
    const int p = i - TCTX; return b * TLAT + (dir ? (TLAT - 1 - p) : p);
}
__device__ __forceinline__ void rwkv_scan(const Ctx& F, int blk) {
    const int chain = blk >> 2, quarter = blk & 3, b = chain >> 3, head = (chain >> 1) & 3, dir = chain & 1;
    const bool scanner = F.wave < 4;
    const int rowv = (quarter * 4 + (F.wave & 3)) * 4 + (F.lane >> 4), s = F.lane & 15;
    LAS float* buf = (LAS float*)F.lds;
    const bf16_t* P = WSP(bf16_t, WS_P); const unsigned char* RW = WSP(unsigned char, WS_RW); float* YR = WSP(float, WS_YR) + (size_t)dir * MALL * 256;
    const int st = F.tid >> 4, sub = F.tid & 15;
    constexpr int NSTEP = TCTX + TLAT, NCH = NSTEP / 32;
    u32x2 g_kk, g_al, g_kd, g_r, g_v; f32x4 g_w;
#define RW_LOAD(c) do { const int row_ = scan_row(b, dir, (c) * 32 + st); const bf16_t* rb_ = (const bf16_t*)(RW + (size_t)row_ * RWREC) + head * 64 + sub * 4; \
        g_kk = *(const u32x2*)rb_; g_al = *(const u32x2*)(rb_ + 256 + dir * 256); g_kd = *(const u32x2*)(rb_ + 768 + dir * 256); \
        g_w = *(const f32x4*)((const float*)(RW + (size_t)row_ * RWREC + 2560) + dir * 256 + head * 64 + sub * 4); \
        const bf16_t* pp_ = P + (size_t)row_ * DINP + head * 64 + sub * 4; g_r = *(const u32x2*)(pp_ + C_RR); g_v = *(const u32x2*)(pp_ + C_RV); } while (0)
#define RW_STORE(par) do { LAS float* d_ = buf + ((par) * 32 + st) * 384 + sub * 4; \
        *(LAS f32x4*)(d_) = (f32x4){lo2f(g_kk.x), hi2f(g_kk.x), lo2f(g_kk.y), hi2f(g_kk.y)}; *(LAS f32x4*)(d_ + 64) = (f32x4){lo2f(g_al.x), hi2f(g_al.x), lo2f(g_al.y), hi2f(g_al.y)}; \
        *(LAS f32x4*)(d_ + 128) = (f32x4){lo2f(g_kd.x), hi2f(g_kd.x), lo2f(g_kd.y), hi2f(g_kd.y)}; *(LAS f32x4*)(d_ + 192) = g_w; \
        *(LAS f32x4*)(d_ + 256) = (f32x4){lo2f(g_r.x), hi2f(g_r.x), lo2f(g_r.y), hi2f(g_r.y)}; *(LAS f32x4*)(d_ + 320) = (f32x4){lo2f(g_v.x), hi2f(g_v.x), lo2f(g_v.y), hi2f(g_v.y)}; } while (0)
    f32x4 S = {0.f, 0.f, 0.f, 0.f};
    RW_LOAD(0); RW_STORE(0); __syncthreads();
    for (int c = 0; c < NCH; ++c) {
        const int par = c & 1;
        if (c + 1 < NCH) RW_LOAD(c + 1);
        if (scanner) {
        float ykeep = 0.f;
        f32x4 Lkk[3], Lal[3], Lkd[3], Lw[3], Lr[3]; float Lv[3];
#define SC_LD(set, i_) do { const LAS float* d_ = buf + (par * 32 + (i_)) * 384; Lkk[set] = *(const LAS f32x4*)(d_ + s * 4); Lal[set] = *(const LAS f32x4*)(d_ + 64 + s * 4); \
            Lkd[set] = *(const LAS f32x4*)(d_ + 128 + s * 4); Lw[set] = *(const LAS f32x4*)(d_ + 192 + s * 4); Lr[set] = *(const LAS f32x4*)(d_ + 256 + s * 4); Lv[set] = d_[320 + rowv]; } while (0)
        SC_LD(0, 0); SC_LD(1, 1);
#pragma unroll
        for (int i = 0; i < 32; ++i) {
            if (i + 2 < 32) SC_LD((i + 2) % 3, i + 2);
            const f32x4 kk = Lkk[i % 3], al = Lal[i % 3], kd = Lkd[i % 3], w = Lw[i % 3], r = Lr[i % 3]; const float vr = Lv[i % 3];
            const float sa = red16((S[0] * kk[0] + S[1] * kk[1]) + (S[2] * kk[2] + S[3] * kk[3]));
            S = S * w + (vr * kd - sa * al);
            const float y = red16((S[0] * r[0] + S[1] * r[1]) + (S[2] * r[2] + S[3] * r[3]));
            ykeep = (s == (i & 15)) ? y : ykeep;
            if ((i & 15) == 15) {
                const int stp = c * 32 + (i - 15) + s; const int pc = dir ? (TCTX - 1 - stp) : stp, pl = dir ? (TLAT - 1 - (stp - TCTX)) : (stp - TCTX);
                const int row = stp < TCTX ? (MLAT + b * TCTX + pc) : (b * TLAT + pl);
                YR[(size_t)row * 256 + head * 64 + rowv] = ykeep; }
        }
#undef SC_LD
        }
        if (c + 1 < NCH) RW_STORE(par ^ 1);
        __syncthreads();
    }
#undef RW_LOAD
#undef RW_STORE
}

typedef union { u32x4 u; bf16x8 b; } frag_u;
__device__ __forceinline__ void attn_unit(const Ctx& F, int l, int unit) {
    LAS bf16_t* Kl = (LAS bf16_t*)F.lds; LAS bf16_t* Vt = Kl + 64 * 72;
    const bf16_t* P = WSP(bf16_t, WS_P); const bf16_t* QA = WSP(bf16_t, WS_QA); const bf16_t* KA = WSP(bf16_t, WS_KA); bf16_t* YC = WSP(bf16_t, WS_YCAT);
    const bool isc = unit >= 256; int b, kvh, n;
    if (!isc) { b = unit >> 7; kvh = (unit >> 6) & 1; n = unit & 63; } else { const int u = unit - 256; b = u >> 2; kvh = (u >> 1) & 1; n = u & 1; }
    const int g = F.wave >> 2, ps = F.wave & 3, head = kvh * 2 + g, i = F.lane & 15, gq = F.lane >> 4;
    const int qpos0 = n * 128 + ps * 32, qrow0 = (isc ? MLAT + b * TCTX : b * TLAT) + qpos0;
    bf16x8 Qf[2][2];
#pragma unroll
    for (int qb = 0; qb < 2; ++qb)
#pragma unroll
        for (int ks = 0; ks < 2; ++ks) Qf[qb][ks] = *(const bf16x8*)(QA + (size_t)(qrow0 + qb * 16 + i) * 256 + head * 64 + ks * 32 + gq * 8);
    const float sinkl = F.in[23][l * 4 + head] * 1.4426950408889634f;
    float mrun[2] = {sinkl, sinkl}, lsum[2]; lsum[0] = lsum[1] = (gq == 0) ? 1.f : 0.f;
    f32x4 ao[4][2];
#pragma unroll
    for (int db = 0; db < 4; ++db) { ao[db][0] = (f32x4){0.f, 0.f, 0.f, 0.f}; ao[db][1] = (f32x4){0.f, 0.f, 0.f, 0.f}; }
    const int ntl = isc ? 4 : 10;
    const int skey = F.tid >> 3, sch = F.tid & 7;
#define ATT_KROW(tt_) ((!isc && (tt_) < 6) ? ((2 * (n - 1) + (tt_) < 0 || 2 * (n - 1) + (tt_) >= 128) ? -1 : b * TLAT + (2 * (n - 1) + (tt_)) * 64) : MLAT + b * TCTX + (isc ? (tt_) : (tt_) - 6) * 64)
#define ATT_LOAD(tt_) do { const int kr_ = ATT_KROW(tt_); if (kr_ >= 0) { pk_kv = *(const u32x4*)(KA + (size_t)(kr_ + skey) * 128 + kvh * 64 + sch * 8); pk_vv = *(const u32x4*)(P + (size_t)(kr_ + skey) * DINP + C_AV + kvh * 64 + sch * 8); } } while (0)
    u32x4 pk_kv = {0u, 0u, 0u, 0u}, pk_vv = {0u, 0u, 0u, 0u};
    int tt0 = 0; while (tt0 < ntl && ATT_KROW(tt0) < 0) ++tt0;
    ATT_LOAD(tt0);
    for (int tt = tt0; tt < ntl; ++tt) {
        const int krow0 = ATT_KROW(tt); if (krow0 < 0) continue;
        const bool band = !isc && tt < 6; const int kpos0 = band ? (2 * (n - 1) + tt) * 64 : 0;
        LDS_BARRIER();
        { const u32x4 kv = pk_kv, vv = pk_vv;
          *(LAS u32x4*)(Kl + skey * 72 + sch * 8) = kv;
          const unsigned ww[4] = {vv.x, vv.y, vv.z, vv.w};
#pragma unroll
          for (int j = 0; j < 4; ++j) { Vt[(sch * 8 + 2 * j) * 72 + skey] = (bf16_t)(ww[j] & 0xffffu); Vt[(sch * 8 + 2 * j + 1) * 72 + skey] = (bf16_t)(ww[j] >> 16); } }
        { int tn = tt + 1; while (tn < ntl && ATT_KROW(tn) < 0) ++tn; if (tn < ntl) ATT_LOAD(tn); }
        LDS_BARRIER();
        f32x4 sc[4][2];
#pragma unroll
        for (int kb = 0; kb < 4; ++kb) {
            sc[kb][0] = (f32x4){0.f, 0.f, 0.f, 0.f}; sc[kb][1] = (f32x4){0.f, 0.f, 0.f, 0.f};
#pragma unroll
            for (int ks = 0; ks < 2; ++ks) { const bf16x8 kf = *(const LAS bf16x8*)(Kl + (kb * 16 + i) * 72 + ks * 32 + gq * 8);
                sc[kb][0] = __builtin_amdgcn_mfma_f32_16x16x32_bf16(kf, Qf[0][ks], sc[kb][0], 0, 0, 0);
                sc[kb][1] = __builtin_amdgcn_mfma_f32_16x16x32_bf16(kf, Qf[1][ks], sc[kb][1], 0, 0, 0); }
        }
#pragma unroll
        for (int qb = 0; qb < 2; ++qb) {
            const int qp = qpos0 + qb * 16 + i;
            float mx = -1e30f;
#pragma unroll
            for (int kb = 0; kb < 4; ++kb)
#pragma unroll
                for (int r = 0; r < 4; ++r) { if (band) { const int dd = (kpos0 + kb * 16 + 4 * gq + r) - qp; if (dd > 128 || dd < -128) sc[kb][qb][r] = -1e30f; } mx = fmaxf(mx, sc[kb][qb][r]); }
            mx = fmaxf(mx, __shfl_xor(mx, 16)); mx = fmaxf(mx, __shfl_xor(mx, 32));
            const float mnew = fmaxf(mrun[qb], mx), alpha = exp2f(mrun[qb] - mnew); mrun[qb] = mnew;
            float ps_ = 0.f;
#pragma unroll
            for (int kb = 0; kb < 4; ++kb)
#pragma unroll
                for (int r = 0; r < 4; ++r) { const float p = exp2f(sc[kb][qb][r] - mnew); sc[kb][qb][r] = p; ps_ += p; }
            lsum[qb] = lsum[qb] * alpha + ps_;
#pragma unroll
            for (int db = 0; db < 4; ++db) ao[db][qb] *= alpha;
        }
#pragma unroll
        for (int ks2 = 0; ks2 < 2; ++ks2) {
            frag_u pf[2];
#pragma unroll
            for (int qb = 0; qb < 2; ++qb) { pf[qb].u.x = pg8::cvt_pk_bf16(sc[2 * ks2][qb][0], sc[2 * ks2][qb][1]); pf[qb].u.y = pg8::cvt_pk_bf16(sc[2 * ks2][qb][2], sc[2 * ks2][qb][3]);
                pf[qb].u.z = pg8::cvt_pk_bf16(sc[2 * ks2 + 1][qb][0], sc[2 * ks2 + 1][qb][1]); pf[qb].u.w = pg8::cvt_pk_bf16(sc[2 * ks2 + 1][qb][2], sc[2 * ks2 + 1][qb][3]); }
#pragma unroll
            for (int db = 0; db < 4; ++db) { frag_u vf; const LAS bf16_t* vp = Vt + (db * 16 + i) * 72 + (2 * ks2) * 16 + 4 * gq;
                const u32x2 v0 = *(const LAS u32x2*)vp, v1 = *(const LAS u32x2*)(vp + 16); vf.u = (u32x4){v0.x, v0.y, v1.x, v1.y};
                ao[db][0] = __builtin_amdgcn_mfma_f32_16x16x32_bf16(vf.b, pf[0].b, ao[db][0], 0, 0, 0);
                ao[db][1] = __builtin_amdgcn_mfma_f32_16x16x32_bf16(vf.b, pf[1].b, ao[db][1], 0, 0, 0); }
        }
    }
#undef ATT_KROW
#undef ATT_LOAD
    const float* og = F.in[24] + l * 256 + head * 64;
#pragma unroll
    for (int qb = 0; qb < 2; ++qb) {
        float lt = lsum[qb]; lt += __shfl_xor(lt, 16); lt += __shfl_xor(lt, 32);
        const float il = 1.f / lt; float ss = 0.f;
#pragma unroll
        for (int db = 0; db < 4; ++db) { ao[db][qb] *= il; ss += (ao[db][qb][0] * ao[db][qb][0] + ao[db][qb][1] * ao[db][qb][1]) + (ao[db][qb][2] * ao[db][qb][2] + ao[db][qb][3] * ao[db][qb][3]); }
        ss += __shfl_xor(ss, 16); ss += __shfl_xor(ss, 32);
        const float rs = rsqrtf(ss * (1.f / 64.f) + EPSN);
        bf16_t* yo = YC + (size_t)(qrow0 + qb * 16 + i) * DM + 512 + head * 64;
#pragma unroll
        for (int db = 0; db < 4; ++db) { const f32x4 gg = *(const f32x4*)(og + db * 16 + 4 * gq); st4bf(yo + db * 16 + 4 * gq, ao[db][qb] * rs * gg * ZF(8)); }
    }
    __syncthreads();
}

__device__ __forceinline__ int ml_row(int b, int dir, int j, int tp) {
    if (j < 2) { const int p = j * 128 + tp; return MLAT + b * TCTX + (dir ? (TCTX - 1 - p) : p); }
    const int p = (j - 2) * 128 + tp; return b * TLAT + (dir ? (TLAT - 1 - p) : p);
}
__device__ __forceinline__ void scan128_add(float& x0, float& x1, int lane) {
    x1 += x0; float t = x1;
#pragma unroll
    for (int o = 1; o < 64; o <<= 1) { const float u = __shfl_up(t, o); if (lane >= o) t += u; }
    const float ex = t - x1; x0 += ex; x1 = t;
}
__device__ __forceinline__ void scan128_max(float& x0, float& x1, int lane) {
    x1 = fmaxf(x1, x0); float t = x1;
#pragma unroll
    for (int o = 1; o < 64; o <<= 1) { const float u = __shfl_up(t, o); if (lane >= o) t = fmaxf(t, u); }
    const float pv = __shfl_up(t, 1); if (lane > 0) x0 = fmaxf(x0, pv); x1 = t;
}
__device__ __forceinline__ void ml_stage_T(const Ctx& F, const bf16_t* P, int b, int dir, int j, int col0, LAS bf16_t* dst, const LAS float* sw, float cscale) {
#pragma unroll
    for (int it = 0; it < 2; ++it) { const int id = F.tid + it * NTHR, tp = id >> 3, ch = id & 7;
        const u32x4 v = *(const u32x4*)(P + (size_t)ml_row(b, dir, j, tp) * DINP + col0 + ch * 8); const float s = (sw ? sw[tp] : 1.f) * cscale;
        const unsigned ww[4] = {v.x, v.y, v.z, v.w};
#pragma unroll
        for (int q = 0; q < 4; ++q) { dst[(ch * 8 + 2 * q) * 136 + tp] = (bf16_t)f2bf(lo2f(ww[q]) * s); dst[(ch * 8 + 2 * q + 1) * 136 + tp] = (bf16_t)f2bf(hi2f(ww[q]) * s); } }
}
__device__ __forceinline__ void ml_stage_R(const Ctx& F, const bf16_t* P, int b, int dir, int j, int col0, LAS bf16_t* dst, float cscale) {
#pragma unroll
    for (int it = 0; it < 2; ++it) { const int id = F.tid + it * NTHR, tp = id >> 3, ch = id & 7;
        u32x4 v = *(const u32x4*)(P + (size_t)ml_row(b, dir, j, tp) * DINP + col0 + ch * 8);
        if (cscale != 1.f) { v.x = pk2(lo2f(v.x) * cscale, hi2f(v.x) * cscale); v.y = pk2(lo2f(v.y) * cscale, hi2f(v.y) * cscale); v.z = pk2(lo2f(v.z) * cscale, hi2f(v.z) * cscale); v.w = pk2(lo2f(v.w) * cscale, hi2f(v.w) * cscale); }
        *(LAS u32x4*)(dst + tp * 72 + ch * 8) = v; }
}
__device__ __forceinline__ void mlstm_local(const Ctx& F, int task) {
    const int chain = task / NCHK, j = task % NCHK, b = chain >> 3, head = (chain >> 1) & 3, dir = chain & 1;
    const bf16_t* P = WSP(bf16_t, WS_P); const float* GA = WSP(float, WS_GA);
    LAS bf16_t* Vt = (LAS bf16_t*)F.lds; LAS bf16_t* Kt = Vt + 64 * 136; LAS float* wS = (LAS float*)(Kt + 64 * 136); LAS float* sc2 = wS + 128;
    __syncthreads();
    if (F.wave == 0) {
        const int r0 = ml_row(b, dir, j, 2 * F.lane), r1 = ml_row(b, dir, j, 2 * F.lane + 1);
        const float li0 = GA[(size_t)r0 * 16 + dir * 8 + head], li1 = GA[(size_t)r1 * 16 + dir * 8 + head];
        float b0 = GA[(size_t)r0 * 16 + dir * 8 + 4 + head], b1 = GA[(size_t)r1 * 16 + dir * 8 + 4 + head];
        scan128_add(b0, b1, F.lane);
        const float bend = __shfl(b1, 63);
        const float d0 = bend - b0 + li0, d1 = bend - b1 + li1;
        float mx = fmaxf(d0, d1);
#pragma unroll
        for (int o = 1; o < 64; o <<= 1) mx = fmaxf(mx, __shfl_xor(mx, o));
        wS[2 * F.lane] = __expf(d0 - mx); wS[2 * F.lane + 1] = __expf(d1 - mx);
        if (F.lane == 0) { sc2[0] = mx; sc2[1] = bend; }
    }
    __syncthreads();
    ml_stage_T(F, P, b, dir, j, C_MV + head * 64, Vt, wS, 1.f);
    ml_stage_T(F, P, b, dir, j, C_MK + head * 64, Kt, nullptr, 0.125f);
    __syncthreads();
    float* LC = WSP(float, WS_LC) + (size_t)task * CST;
    { const int vb = F.wave >> 1, i = F.lane & 15, gq = F.lane >> 4;
#pragma unroll
      for (int kk2 = 0; kk2 < 2; ++kk2) { const int kb = 2 * (F.wave & 1) + kk2; f32x4 acc = {0.f, 0.f, 0.f, 0.f};
#pragma unroll
          for (int ks = 0; ks < 4; ++ks) { const bf16x8 a = *(const LAS bf16x8*)(Vt + (vb * 16 + i) * 136 + ks * 32 + gq * 8), bb = *(const LAS bf16x8*)(Kt + (kb * 16 + i) * 136 + ks * 32 + gq * 8);
              acc = __builtin_amdgcn_mfma_f32_16x16x32_bf16(a, bb, acc, 0, 0, 0); }
#pragma unroll
          for (int r = 0; r < 4; ++r) LC[(vb * 16 + 4 * gq + r) * 64 + kb * 16 + i] = acc[r]; } }
    if (F.tid < 64) { float a = 0.f;
#pragma unroll 8
        for (int s = 0; s < 128; ++s) a += wS[s] * bf2f(Kt[F.tid * 136 + s]);
        LC[4096 + F.tid] = a; }
    if (F.tid == 0) { float* LB = WSP(float, WS_LB); LB[task * 2] = sc2[0]; LB[task * 2 + 1] = sc2[1]; }
}
__device__ __forceinline__ void mlstm_chain(const Ctx& F, int blk0) {
    const int gt = (F.vcu - blk0) * NTHR + F.tid; if (gt < 0 || gt >= 16 * CST) return;
    const int chain = gt / CST, e = gt % CST;
    const float* LC = WSP(float, WS_LC) + (size_t)chain * NCHK * CST + e; float* ST = WSP(float, WS_ST) + (size_t)chain * NCHK * CST + e;
    const float* LB = WSP(float, WS_LB) + chain * NCHK * 2; float* SM = WSP(float, WS_LB) + 4096 + chain * NCHK;
    float m = 0.f, x = 0.f;
#pragma unroll 1
    for (int g = 0; g < 3; ++g) {
        float d[22], Lv[22], Bv[22];
#pragma unroll
        for (int q = 0; q < 22; ++q) { const int j = g * 22 + q; d[q] = LC[(size_t)j * CST]; Lv[q] = LB[2 * j]; Bv[q] = LB[2 * j + 1]; }
#pragma unroll
        for (int q = 0; q < 22; ++q) { const int j = g * 22 + q;
            ST[(size_t)j * CST] = x; if (e == 0) SM[j] = m;
            const float mn = fmaxf(Bv[q] + m, Lv[q]);
            x = __expf(Bv[q] + m - mn) * x + __expf(Lv[q] - mn) * d[q]; m = mn; }
    }
}
__device__ __forceinline__ void mlstm_out(const Ctx& F, int l, int unit) {
    const bool isc = unit >= 512; int b, chunk, head;
    if (!isc) { b = unit >> 8; chunk = (unit >> 2) & 63; head = unit & 3; } else { const int u = unit - 512; b = u >> 3; chunk = (u >> 2) & 1; head = u & 3; }
    const bf16_t* P = WSP(bf16_t, WS_P); const float* GA = WSP(float, WS_GA); bf16_t* YC = WSP(bf16_t, WS_YCAT);
    LAS bf16_t* Ql = (LAS bf16_t*)F.lds; LAS bf16_t* Kl = Ql + 128 * 72; LAS bf16_t* Vt = Kl + 128 * 72; LAS bf16_t* Cb = Vt + 64 * 136;
    LAS float* nS = (LAS float*)(Cb + 64 * 72); LAS float* aS = nS + 64; LAS float* bS = aS + 128; LAS float* MS = bS + 128; LAS float* Hs = MS + 128;
    const int i = F.lane & 15, gq = F.lane >> 4, w = F.wave;
    for (int dir = 0; dir < 2; ++dir) {
        const int j = isc ? (dir ? 1 - chunk : chunk) : 2 + (dir ? 63 - chunk : chunk);
        const int chain = (b * 4 + head) * 2 + dir;
        const float* ST = WSP(float, WS_ST) + ((size_t)chain * NCHK + j) * CST; const float mprev = WSP(float, WS_LB)[4096 + chain * NCHK + j];
        __syncthreads();
        if (w == 0) {
            const int r0 = ml_row(b, dir, j, 2 * F.lane), r1 = ml_row(b, dir, j, 2 * F.lane + 1);
            const float li0 = GA[(size_t)r0 * 16 + dir * 8 + head], li1 = GA[(size_t)r1 * 16 + dir * 8 + head];
            float b0 = GA[(size_t)r0 * 16 + dir * 8 + 4 + head], b1 = GA[(size_t)r1 * 16 + dir * 8 + 4 + head];
            scan128_add(b0, b1, F.lane);
            const float a0 = li0 - b0, a1 = li1 - b1; float A0 = a0, A1 = a1;
            scan128_max(A0, A1, F.lane);
            aS[2 * F.lane] = a0; aS[2 * F.lane + 1] = a1; bS[2 * F.lane] = b0; bS[2 * F.lane + 1] = b1;
            MS[2 * F.lane] = fmaxf(A0, mprev); MS[2 * F.lane + 1] = fmaxf(A1, mprev);
        }
        ml_stage_R(F, P, b, dir, j, C_MQ + head * 64, Ql, 1.f);
        ml_stage_R(F, P, b, dir, j, C_MK + head * 64, Kl, 0.125f);
        ml_stage_T(F, P, b, dir, j, C_MV + head * 64, Vt, nullptr, 1.f);
        { const f32x4 c0 = *(const f32x4*)(ST + F.tid * 8), c1 = *(const f32x4*)(ST + F.tid * 8 + 4); const int v = F.tid >> 3, k0 = (F.tid & 7) * 8;
          u32x4 o; o.x = pk2(c0[0], c0[1]); o.y = pk2(c0[2], c0[3]); o.z = pk2(c1[0], c1[1]); o.w = pk2(c1[2], c1[3]); *(LAS u32x4*)(Cb + v * 72 + k0) = o;
          if (F.tid < 64) nS[F.tid] = ST[4096 + F.tid]; }
        __syncthreads();
        const int t = 16 * w + i; const float Mt = MS[t], bt = bS[t];
        bf16x8 Qf[2];
#pragma unroll
        for (int ks = 0; ks < 2; ++ks) Qf[ks] = *(const LAS bf16x8*)(Ql + t * 72 + ks * 32 + gq * 8);
        f32x4 sc[8];
#pragma unroll
        for (int sb = 0; sb < 8; ++sb) { sc[sb] = (f32x4){0.f, 0.f, 0.f, 0.f};
            if (sb <= w) {
#pragma unroll
                for (int ks = 0; ks < 2; ++ks) { const bf16x8 kf = *(const LAS bf16x8*)(Kl + (sb * 16 + i) * 72 + ks * 32 + gq * 8); sc[sb] = __builtin_amdgcn_mfma_f32_16x16x32_bf16(kf, Qf[ks], sc[sb], 0, 0, 0); }
#pragma unroll
                for (int r = 0; r < 4; ++r) { const int s = sb * 16 + 4 * gq + r; sc[sb][r] = (s <= t) ? sc[sb][r] * __expf(aS[s] - Mt) : 0.f; }
            } }
        float den = 0.f;
#pragma unroll
        for (int sb = 0; sb < 8; ++sb) den += (sc[sb][0] + sc[sb][1]) + (sc[sb][2] + sc[sb][3]);
        den += __shfl_xor(den, 16); den += __shfl_xor(den, 32);
        f32x4 nm[4], it_[4];
#pragma unroll
        for (int vb = 0; vb < 4; ++vb) { nm[vb] = (f32x4){0.f, 0.f, 0.f, 0.f}; it_[vb] = (f32x4){0.f, 0.f, 0.f, 0.f}; }
#pragma unroll
        for (int ks2 = 0; ks2 < 4; ++ks2) if (2 * ks2 <= w) {
            frag_u pf; pf.u.x = pg8::cvt_pk_bf16(sc[2 * ks2][0], sc[2 * ks2][1]); pf.u.y = pg8::cvt_pk_bf16(sc[2 * ks2][2], sc[2 * ks2][3]);
            pf.u.z = pg8::cvt_pk_bf16(sc[2 * ks2 + 1][0], sc[2 * ks2 + 1][1]); pf.u.w = pg8::cvt_pk_bf16(sc[2 * ks2 + 1][2], sc[2 * ks2 + 1][3]);
#pragma unroll
            for (int vb = 0; vb < 4; ++vb) { frag_u vf; const LAS bf16_t* vp = Vt + (vb * 16 + i) * 136 + (2 * ks2) * 16 + 4 * gq;
                const u32x2 v0 = *(const LAS u32x2*)vp, v1 = *(const LAS u32x2*)(vp + 16); vf.u = (u32x4){v0.x, v0.y, v1.x, v1.y};
                nm[vb] = __builtin_amdgcn_mfma_f32_16x16x32_bf16(vf.b, pf.b, nm[vb], 0, 0, 0); }
        }
#pragma unroll
        for (int vb = 0; vb < 4; ++vb)
#pragma unroll
            for (int ks = 0; ks < 2; ++ks) { const bf16x8 cf = *(const LAS bf16x8*)(Cb + (vb * 16 + i) * 72 + ks * 32 + gq * 8); it_[vb] = __builtin_amdgcn_mfma_f32_16x16x32_bf16(cf, Qf[ks], it_[vb], 0, 0, 0); }
        float nq = 0.f;
#pragma unroll
        for (int c = 0; c < 2; ++c) { const u32x4 qv = *(const LAS u32x4*)(Ql + t * 72 + gq * 16 + c * 8); const unsigned ww[4] = {qv.x, qv.y, qv.z, qv.w};
#pragma unroll
            for (int q = 0; q < 4; ++q) nq += nS[gq * 16 + c * 8 + 2 * q] * lo2f(ww[q]) + nS[gq * 16 + c * 8 + 2 * q + 1] * hi2f(ww[q]); }
        nq += __shfl_xor(nq, 16); nq += __shfl_xor(nq, 32);
        const float wint = __expf(mprev - Mt); den += wint * nq;
        const float dn = 1.f / fmaxf(fabsf(den), __expf(-(bt + Mt)));
        const int torig = dir ? 127 - t : t;
#pragma unroll
        for (int vb = 0; vb < 4; ++vb)
#pragma unroll
            for (int r = 0; r < 4; ++r) { const float hv = (nm[vb][r] + wint * it_[vb][r]) * dn; LAS float* hp = Hs + torig * 65 + vb * 16 + 4 * gq + r; if (dir == 0) *hp = hv; else *hp += hv; }
    }
    __syncthreads();
    {
        const int t = F.tid >> 2, vq = F.tid & 3; const int row = (isc ? MLAT + b * TCTX : b * TLAT) + chunk * 128 + t;
        float hv[16], ss = 0.f;
#pragma unroll
        for (int q = 0; q < 16; ++q) { hv[q] = Hs[t * 65 + vq * 16 + q]; ss += hv[q] * hv[q]; }
        ss += __shfl_xor(ss, 1); ss += __shfl_xor(ss, 2);
        const float rs = rsqrtf(ss * (1.f / 64.f) + EPSN);
        const float* og = F.in[27] + l * 256 + head * 64 + vq * 16; const bf16_t* op = P + (size_t)row * DINP + C_MO + head * 64 + vq * 16;
        const u32x4 o0 = *(const u32x4*)op, o1 = *(const u32x4*)(op + 8); const unsigned ow[8] = {o0.x, o0.y, o0.z, o0.w, o1.x, o1.y, o1.z, o1.w};
        unsigned res[8];
#pragma unroll
        for (int q = 0; q < 8; ++q) { const float y0 = sigmoidf_(lo2f(ow[q])) * hv[2 * q] * rs * og[2 * q], y1 = sigmoidf_(hi2f(ow[q])) * hv[2 * q + 1] * rs * og[2 * q + 1]; res[q] = pk2(y0 * ZF(16), y1 * ZF(16)); }
        bf16_t* yo = YC + (size_t)row * DM + 768 + head * 64 + vq * 16;
        *(u32x4*)yo = (u32x4){res[0], res[1], res[2], res[3]}; *(u32x4*)(yo + 8) = (u32x4){res[4], res[5], res[6], res[7]};
    }
    __syncthreads();
}
__device__ __forceinline__ void rwkv_finish(const Ctx& F, int l, int nrows) {
    const bf16_t* P = WSP(bf16_t, WS_P); const float* YR = WSP(float, WS_YR); const bf16_t* GB = WSP(bf16_t, WS_GB); const float* BS = WSP(float, WS_BS); bf16_t* YC = WSP(bf16_t, WS_YCAT);
    const int c4 = F.lane * 4; const f32x4 lg = *(const f32x4*)(F.in[20] + l * 256 + c4);
    const int gw = F.vcu * NWAVES + F.wave, NGW = F.G * NWAVES;
    for (int row = gw; row < nrows; row += NGW) {
        const f32x4 y = *(const f32x4*)(YR + (size_t)row * 256 + c4) + *(const f32x4*)(YR + (size_t)(MALL + row) * 256 + c4);
        const float ss = red16((y[0] * y[0] + y[1] * y[1]) + (y[2] * y[2] + y[3] * y[3]));
        const float rs = rsqrtf(ss * (1.f / 64.f) + EPSN);
        const f32x4 v = ld4bf(P + (size_t)row * DINP + C_RV + c4), g = ld4bf(GB + (size_t)row * 256 + c4);
        const float bn = BS[(size_t)row * 4 + (F.lane >> 4)];
        st4bf(YC + (size_t)row * DM + 256 + c4, (y * rs * lg * ZF(32) + bn * v * ZF(64)) * g * ZF(4));
    }
}
constexpr int RCH = 132;
constexpr int MP = 72, SLOT = 64 * MP;
constexpr size_t WS_RG = 454 * MiB, RG_TASK = 3 * 8192, WS_SST = WS_RW;
constexpr size_t WS_END2 = 504 * MiB;
static_assert(WS_RG + (size_t)16 * RCH * RG_TASK <= WS_END2 && (size_t)16 * RCH * 8192 <= (size_t)MALL * RWREC, "rwkv chunk ws map");

__device__ __forceinline__ void mm64(const LAS bf16_t* A, const LAS bf16_t* Bt, int w, int lane, f32x4 (&acc)[2]) {
    const int i = lane & 15, gq = lane >> 4, mb = w >> 1, nb0 = 2 * (w & 1);
    acc[0] = (f32x4){0.f, 0.f, 0.f, 0.f}; acc[1] = (f32x4){0.f, 0.f, 0.f, 0.f};
#pragma unroll
    for (int ks = 0; ks < 2; ++ks) { const bf16x8 a = *(const LAS bf16x8*)(A + (mb * 16 + i) * MP + ks * 32 + gq * 8);
#pragma unroll
        for (int q = 0; q < 2; ++q) { const bf16x8 b = *(const LAS bf16x8*)(Bt + ((nb0 + q) * 16 + i) * MP + ks * 32 + gq * 8); acc[q] = __builtin_amdgcn_mfma_f32_16x16x32_bf16(a, b, acc[q], 0, 0, 0); } }
}
__device__ __forceinline__ u32x2 pk4(f32x4 v) { u32x2 o; o.x = pk2(v[0], v[1]); o.y = pk2(v[2], v[3]); return o; }
__device__ __forceinline__ f32x4 up4(u32x2 w) { return (f32x4){lo2f(w.x), hi2f(w.x), lo2f(w.y), hi2f(w.y)}; }

struct RaRaw { u32x4 kk, al, kd, r, v; f32x4 ld0, ld1; };
__device__ __forceinline__ void ra_load(const Ctx& F, int task, RaRaw& g) {
    const int chain = task / RCH, c = task % RCH, b = chain >> 3, head = (chain >> 1) & 3, dir = chain & 1;
    const bf16_t* P = WSP(bf16_t, WS_P); const unsigned char* RW = WSP(unsigned char, WS_RW);
    const int t = F.tid >> 3, ch0 = (F.tid & 7) * 8; const int row = scan_row(b, dir, c * 64 + t);
    const bf16_t* rb = (const bf16_t*)(RW + (size_t)row * RWREC) + head * 64 + ch0;
    g.kk = *(const u32x4*)rb; g.al = *(const u32x4*)(rb + 256 + dir * 256); g.kd = *(const u32x4*)(rb + 768 + dir * 256);
    const float* ldp = (const float*)(RW + (size_t)row * RWREC + 2560) + dir * 256 + head * 64 + ch0;
    g.ld0 = *(const f32x4*)ldp; g.ld1 = *(const f32x4*)(ldp + 4);
    const bf16_t* pp = P + (size_t)row * DINP + head * 64 + ch0;
    g.r = *(const u32x4*)(pp + C_RR); g.v = *(const u32x4*)(pp + C_RV);
}
__device__ __forceinline__ void rwkv_chunk_pre(const Ctx& F, int task, const RaRaw& cur) {
    const int chain = task / RCH, c = task % RCH, b = chain >> 3, head = (chain >> 1) & 3, dir = chain & 1;
    LAS bf16_t* L0 = (LAS bf16_t*)F.lds;
#define SL(k) (L0 + (k) * SLOT)
    LAS float* LD = (LAS float*)SL(8);
    LAS float* SEG = (LAS float*)SL(10);
    LAS float* WLs = (LAS float*)SL(14);
    const int w = F.wave, lane = F.lane, i = lane & 15, gq = lane >> 4, mb = w >> 1, nb0 = 2 * (w & 1), m0 = mb * 16 + 4 * gq;
    LDS_BARRIER();
    const int t = F.tid >> 3, ch0 = (F.tid & 7) * 8;
    const u32x4 g_kk = cur.kk, g_al = cur.al, g_kd = cur.kd, g_r = cur.r, g_v = cur.v; const f32x4 ld0 = cur.ld0, ld1 = cur.ld1;
    *(LAS f32x4*)(LD + t * 64 + ch0) = ld0; *(LAS f32x4*)(LD + t * 64 + ch0 + 4) = ld1;
    LDS_BARRIER();
    { const int k = F.tid & 63, seg = F.tid >> 6; float s = 0.f;
#pragma unroll
      for (int j = 0; j < 8; ++j) s += LD[(seg * 8 + j) * 64 + k];
      SEG[seg * 64 + k] = s;
      LDS_BARRIER();
      float off = 0.f;
#pragma unroll
      for (int j = 0; j < 8; ++j) off += (j < seg) ? SEG[j * 64 + k] : 0.f;
#pragma unroll
      for (int j = 0; j < 8; ++j) { off += LD[(seg * 8 + j) * 64 + k]; LD[(seg * 8 + j) * 64 + k] = off; }
    }
    LDS_BARRIER();
    {
        const unsigned kkw[4] = {g_kk.x, g_kk.y, g_kk.z, g_kk.w}, alw[4] = {g_al.x, g_al.y, g_al.z, g_al.w}, kdw[4] = {g_kd.x, g_kd.y, g_kd.z, g_kd.w},
                       rw_[4] = {g_r.x, g_r.y, g_r.z, g_r.w}, vw[4] = {g_v.x, g_v.y, g_v.z, g_v.w};
        float okt[8], oai[8], oki[8], ort[8], oat[8], okb[8];
#pragma unroll
        for (int j = 0; j < 8; ++j) {
            const float cl = LD[t * 64 + ch0 + j], clp = t > 0 ? LD[(t - 1) * 64 + ch0 + j] : 0.f, clL = LD[63 * 64 + ch0 + j];
            const float kkv = (j & 1) ? hi2f(kkw[j >> 1]) : lo2f(kkw[j >> 1]), alv = (j & 1) ? hi2f(alw[j >> 1]) : lo2f(alw[j >> 1]), kdv = (j & 1) ? hi2f(kdw[j >> 1]) : lo2f(kdw[j >> 1]),
                        rv = (j & 1) ? hi2f(rw_[j >> 1]) : lo2f(rw_[j >> 1]);
            const float ec = __expf(cl), en = __builtin_amdgcn_rcpf(ec), eL = __expf(clL) * en;
            okt[j] = kkv * __expf(clp); oai[j] = alv * en; oki[j] = kdv * en; ort[j] = rv * ec; oat[j] = alv * eL; okb[j] = kdv * eL;
        }
        u32x4 o;
        o = (u32x4){pk2(okt[0], okt[1]), pk2(okt[2], okt[3]), pk2(okt[4], okt[5]), pk2(okt[6], okt[7])}; *(LAS u32x4*)(SL(0) + t * MP + ch0) = o;
        o = (u32x4){pk2(oai[0], oai[1]), pk2(oai[2], oai[3]), pk2(oai[4], oai[5]), pk2(oai[6], oai[7])}; *(LAS u32x4*)(SL(2) + t * MP + ch0) = o;
        o = (u32x4){pk2(oki[0], oki[1]), pk2(oki[2], oki[3]), pk2(oki[4], oki[5]), pk2(oki[6], oki[7])}; *(LAS u32x4*)(SL(3) + t * MP + ch0) = o;
        o = (u32x4){pk2(ort[0], ort[1]), pk2(ort[2], ort[3]), pk2(ort[4], ort[5]), pk2(ort[6], ort[7])}; *(LAS u32x4*)(SL(4) + t * MP + ch0) = o;
#pragma unroll
        for (int j = 0; j < 8; ++j) { SL(1)[(ch0 + j) * MP + t] = (bf16_t)f2bf(okt[j]); SL(5)[(ch0 + j) * MP + t] = (bf16_t)f2bf(oat[j]); SL(6)[(ch0 + j) * MP + t] = (bf16_t)f2bf(okb[j]);
            SL(7)[(ch0 + j) * MP + t] = (bf16_t)(((j & 1) ? (vw[j >> 1] >> 16) : (vw[j >> 1] & 0xffffu))); }
        if (t == 63) {
#pragma unroll
            for (int j = 0; j < 8; ++j) WLs[ch0 + j] = __expf(LD[63 * 64 + ch0 + j]); }
    }
    LDS_BARRIER();
    f32x4 acc[2];
    mm64(SL(0), SL(2), w, lane, acc);
#pragma unroll
    for (int q = 0; q < 2; ++q) { const int n = (nb0 + q) * 16 + i; f32x4 a, ti;
#pragma unroll
        for (int r = 0; r < 4; ++r) { const bool keep = (m0 + r) > n; a[r] = keep ? acc[q][r] : 0.f; ti[r] = ((m0 + r) == n ? 1.f : 0.f) - a[r]; }
#pragma unroll
        for (int r = 0; r < 4; ++r) { SL(8)[(m0 + r) * MP + n] = (bf16_t)f2bf(a[r]); SL(13)[(m0 + r) * MP + n] = (bf16_t)f2bf(ti[r]); }
        *(LAS u32x2*)(SL(9) + n * MP + m0) = pk4(a); }
    mm64(SL(0), SL(3), w, lane, acc);
#pragma unroll
    for (int q = 0; q < 2; ++q) { const int n = (nb0 + q) * 16 + i;
#pragma unroll
        for (int r = 0; r < 4; ++r) SL(10)[(m0 + r) * MP + n] = (bf16_t)f2bf((m0 + r) > n ? acc[q][r] : 0.f); }
    mm64(SL(4), SL(2), w, lane, acc);
#pragma unroll
    for (int q = 0; q < 2; ++q) { const int n = (nb0 + q) * 16 + i;
#pragma unroll
        for (int r = 0; r < 4; ++r) SL(11)[(m0 + r) * MP + n] = (bf16_t)f2bf((m0 + r) >= n ? acc[q][r] : 0.f); }
    mm64(SL(4), SL(3), w, lane, acc);
#pragma unroll
    for (int q = 0; q < 2; ++q) { const int n = (nb0 + q) * 16 + i;
#pragma unroll
        for (int r = 0; r < 4; ++r) SL(12)[(m0 + r) * MP + n] = (bf16_t)f2bf((m0 + r) >= n ? acc[q][r] : 0.f); }
    LDS_BARRIER();
#pragma unroll
    for (int it = 0; it < 5; ++it) {
        LAS bf16_t* Xs = (it & 1) ? SL(2) : SL(8); LAS bf16_t* XsT = (it & 1) ? SL(3) : SL(9);
        LAS bf16_t* Xd = (it & 1) ? SL(8) : SL(2); LAS bf16_t* XdT = (it & 1) ? SL(9) : SL(3);
        LAS bf16_t* Tsrc = (it & 1) ? SL(0) : SL(13); LAS bf16_t* Tdst = (it & 1) ? SL(13) : SL(0);
        mm64(Xs, XsT, w, lane, acc);
#pragma unroll
        for (int q = 0; q < 2; ++q) { const int n = (nb0 + q) * 16 + i;
#pragma unroll
            for (int r = 0; r < 4; ++r) Xd[(m0 + r) * MP + n] = (bf16_t)f2bf(acc[q][r]);
            *(LAS u32x2*)(XdT + n * MP + m0) = pk4(acc[q]); }
        LDS_BARRIER();
        mm64(Tsrc, XdT, w, lane, acc);
#pragma unroll
        for (int q = 0; q < 2; ++q) { const int n = (nb0 + q) * 16 + i;
#pragma unroll
            for (int r = 0; r < 4; ++r) Tdst[(m0 + r) * MP + n] = (bf16_t)f2bf(bf2f(Tsrc[(m0 + r) * MP + n]) + acc[q][r]); }
        LDS_BARRIER();
    }
    LAS bf16_t* Ti = SL(0);
    mm64(Ti, SL(1), w, lane, acc);
#pragma unroll
    for (int q = 0; q < 2; ++q) { const int n = (nb0 + q) * 16 + i; *(LAS u32x2*)(SL(2) + n * MP + m0) = pk4(acc[q]); }
    mm64(SL(10), SL(7), w, lane, acc);
#pragma unroll
    for (int q = 0; q < 2; ++q) { const int n = (nb0 + q) * 16 + i; *(LAS u32x2*)(SL(3) + n * MP + m0) = pk4(acc[q]); }
    LDS_BARRIER();
    mm64(Ti, SL(3), w, lane, acc);
#pragma unroll
    for (int q = 0; q < 2; ++q) { const int n = (nb0 + q) * 16 + i; *(LAS u32x2*)(SL(8) + n * MP + m0) = pk4(acc[q]); }
    LDS_BARRIER();
    bf16_t* RG = (bf16_t*)(F.ws + WS_RG + (size_t)task * RG_TASK);
    f32x4 acc2[2];
    mm64(SL(2), SL(11), w, lane, acc);
#pragma unroll
    for (int q = 0; q < 2; ++q) { const int n = (nb0 + q) * 16 + i; const f32x4 rt = up4(*(const LAS u32x2*)(SL(4) + n * MP + m0)); *(u32x2*)(RG + n * 64 + m0) = pk4(rt - acc[q]); }
    mm64(SL(2), SL(5), w, lane, acc);
#pragma unroll
    for (int q = 0; q < 2; ++q) { const int n = (nb0 + q) * 16 + i; f32x4 g;
#pragma unroll
        for (int r = 0; r < 4; ++r) g[r] = ((m0 + r) == n ? WLs[n] : 0.f) - acc[q][r];
        *(u32x2*)(RG + 4096 + n * 64 + m0) = pk4(g); }
    mm64(SL(6), SL(7), w, lane, acc); mm64(SL(5), SL(8), w, lane, acc2);
#pragma unroll
    for (int q = 0; q < 2; ++q) { const int n = (nb0 + q) * 16 + i; *(u32x2*)(RG + 8192 + n * 64 + m0) = pk4(acc[q] - acc2[q]); }
    mm64(SL(7), SL(12), w, lane, acc); mm64(SL(8), SL(11), w, lane, acc2);
    float* YR = WSP(float, WS_YR) + (size_t)dir * MALL * 256;
#pragma unroll
    for (int q = 0; q < 2; ++q) { const int n = (nb0 + q) * 16 + i; const int rown = scan_row(b, dir, c * 64 + n); *(f32x4*)(YR + (size_t)rown * 256 + head * 64 + m0) = acc[q] - acc2[q]; }
#undef SL
}

__device__ __forceinline__ void rwkv_chain(const Ctx& F, int chain) {
    LAS bf16_t* const L0 = (LAS bf16_t*)F.lds;
    LAS bf16_t* Gl[2] = {L0, L0 + SLOT}; LAS bf16_t* Sl[2] = {L0 + 2 * SLOT, L0 + 3 * SLOT}; LAS bf16_t* Hl[2] = {L0 + 4 * SLOT, L0 + 5 * SLOT};
    const int w = F.wave, lane = F.lane, i = lane & 15, gq = lane >> 4, mb = w >> 1, nb0 = 2 * (w & 1), m0 = mb * 16 + 4 * gq;
    const bf16_t* RGc = (const bf16_t*)(F.ws + WS_RG + (size_t)chain * RCH * RG_TASK); bf16_t* SST = (bf16_t*)(F.ws + WS_SST) + (size_t)chain * RCH * 4096;
    const int gr = F.tid >> 3, gc = (F.tid & 7) * 8, goff = gr * 64 + gc, loff = gr * MP + gc;
    constexpr int RBD = 6, RBU = 66;
    static_assert(RBU % RBD == 0 && RCH % RBU == 0, "ring depth / unroll");
    u32x4 rg[RBD], rh[RBD];
#define RB_LOAD(slot, cc) do { const bf16_t* p_ = RGc + (size_t)((cc) < RCH ? (cc) : RCH - 1) * (RG_TASK / 2); rg[slot] = *(const u32x4*)(p_ + 4096 + goff); rh[slot] = *(const u32x4*)(p_ + 8192 + goff); } while (0)
#pragma unroll
    for (int j = 0; j < RBD; ++j) RB_LOAD(j, j);
    __syncthreads();
    { unsigned z_; asm volatile("v_mov_b32 %0, 0" : "=v"(z_)); *(LAS u32x4*)(Sl[0] + loff) = (u32x4){z_, z_, z_, z_}; }
    *(LAS u32x4*)(Gl[0] + loff) = rg[0]; *(LAS u32x4*)(Hl[0] + loff) = rh[0];
    __syncthreads();
#ifdef TPROBE
    const unsigned long long tp0_ = __builtin_amdgcn_s_memrealtime();
#endif
#define RB_STEP(j) do { const int c = c0 + (j); if (c < RCH - 1) { const int par = c & 1; \
        *(u32x4*)(SST + (size_t)c * 4096 + goff) = *(const LAS u32x4*)(Sl[par] + loff);            \
        f32x4 acc[2]; mm64(Gl[par], Sl[par], w, lane, acc); \
        { const f32x4 h0 = up4(*(const LAS u32x2*)(Hl[par] + (nb0 * 16 + i) * MP + m0)), h1 = up4(*(const LAS u32x2*)(Hl[par] + ((nb0 + 1) * 16 + i) * MP + m0)); \
          *(LAS u32x2*)(Sl[par ^ 1] + (nb0 * 16 + i) * MP + m0) = pk4(acc[0] + h0); *(LAS u32x2*)(Sl[par ^ 1] + ((nb0 + 1) * 16 + i) * MP + m0) = pk4(acc[1] + h1); } \
        *(LAS u32x4*)(Gl[par ^ 1] + loff) = rg[((j) + 1) % RBD]; *(LAS u32x4*)(Hl[par ^ 1] + loff) = rh[((j) + 1) % RBD]; \
        RB_LOAD((j) % RBD, c + RBD); \
        asm volatile("s_waitcnt lgkmcnt(0)" ::: "memory"); __builtin_amdgcn_s_barrier(); asm volatile("" ::: "memory"); } } while (0)
#pragma unroll 1
    for (int c0 = 0; c0 < RCH; c0 += RBU) {
#pragma unroll
        for (int j = 0; j < RBU; ++j) RB_STEP(j); }
#undef RB_STEP
#undef RB_LOAD
    *(u32x4*)(SST + (size_t)(RCH - 1) * 4096 + goff) = *(const LAS u32x4*)(Sl[(RCH - 1) & 1] + loff);
#ifdef TPROBE
    if (chain == 0 && F.tid == 0) *(float*)(F.ws + WS_CTL + 65536) = 3000.f * (floorf((float)(__builtin_amdgcn_s_memrealtime() - tp0_) * (1.f / 3000.f)) + 0.5f);
#endif
    __syncthreads();
}

__device__ __forceinline__ void rwkv_out(const Ctx& F, int l, int unit) {
    const bool isc = unit >= 256; int b, chunk; if (!isc) { b = unit >> 7; chunk = unit & 127; } else { const int u = unit - 256; b = u >> 2; chunk = u & 3; }
    LAS bf16_t* Rl = (LAS bf16_t*)F.lds; LAS bf16_t* Sl = Rl + SLOT; LAS float* Ys = (LAS float*)(F.lds + 4 * SLOT * 2);
    const int w = F.wave, lane = F.lane, i = lane & 15, gq = lane >> 4, mb = w >> 1, nb0 = 2 * (w & 1), m0 = mb * 16 + 4 * gq;
    const int row0 = (isc ? MLAT + b * TCTX : b * TLAT) + chunk * 64;
    const int gr = F.tid >> 3, gc = (F.tid & 7) * 8;
#define RO_PTRS(hd_, RGp, SSp) do { const int head_ = (hd_) >> 1, dir_ = (hd_) & 1, chain_ = (b * 4 + head_) * 2 + dir_; const int cc_ = isc ? (dir_ ? 3 - chunk : chunk) : 4 + (dir_ ? 127 - chunk : chunk); \
        RGp = (const bf16_t*)(F.ws + WS_RG + ((size_t)chain_ * RCH + cc_) * RG_TASK); SSp = (const bf16_t*)(F.ws + WS_SST) + ((size_t)chain_ * RCH + cc_) * 4096; } while (0)
    u32x4 rv, sv;
    { const bf16_t* RG0; const bf16_t* SS0; RO_PTRS(0, RG0, SS0); rv = *(const u32x4*)(RG0 + gr * 64 + gc); sv = *(const u32x4*)(SS0 + gr * 64 + gc); }
#pragma unroll 1
    for (int hd = 0; hd < 8; ++hd) {
        const int head = hd >> 1, dir = hd & 1;
        const float* YR = WSP(float, WS_YR) + (size_t)dir * MALL * 256;
        LDS_BARRIER();
        *(LAS u32x4*)(Rl + gr * MP + gc) = rv; *(LAS u32x4*)(Sl + gr * MP + gc) = sv;
        if (hd < 7) { const bf16_t* RGn; const bf16_t* SSn; RO_PTRS(hd + 1, RGn, SSn); rv = *(const u32x4*)(RGn + gr * 64 + gc); sv = *(const u32x4*)(SSn + gr * 64 + gc); }
        f32x4 yl[2];
#pragma unroll
        for (int q = 0; q < 2; ++q) { const int n = (nb0 + q) * 16 + i; const int tor = dir ? 63 - n : n; yl[q] = *(const f32x4*)(YR + (size_t)(row0 + tor) * 256 + head * 64 + m0); }
        LDS_BARRIER();
        f32x4 acc[2]; mm64(Sl, Rl, w, lane, acc);
#pragma unroll
        for (int q = 0; q < 2; ++q) { const int n = (nb0 + q) * 16 + i; const int tor = dir ? 63 - n : n;
            LAS f32x4* yp = (LAS f32x4*)(Ys + tor * 260 + head * 64 + m0);
            if (dir == 0) *yp = acc[q] + yl[q]; else *yp = *yp + acc[q] + yl[q]; }
    }
#undef RO_PTRS
    __syncthreads();
    {
        const bf16_t* P = WSP(bf16_t, WS_P); const bf16_t* GB = WSP(bf16_t, WS_GB); const float* BS = WSP(float, WS_BS); bf16_t* YC = WSP(bf16_t, WS_YCAT);
        const int c4 = lane * 4; const f32x4 lg = *(const f32x4*)(F.in[20] + l * 256 + c4);
#pragma unroll 1
        for (int tt = w; tt < 64; tt += NWAVES) { const int row = row0 + tt;
            const f32x4 y = *(const LAS f32x4*)(Ys + tt * 260 + c4);
            const float ss = red16((y[0] * y[0] + y[1] * y[1]) + (y[2] * y[2] + y[3] * y[3]));
            const float rs = rsqrtf(ss * (1.f / 64.f) + EPSN);
            const f32x4 v = ld4bf(P + (size_t)row * DINP + C_RV + c4), g = ld4bf(GB + (size_t)row * 256 + c4);
            const float bn = BS[(size_t)row * 4 + (lane >> 4)];
            st4bf(YC + (size_t)row * DM + 256 + c4, (y * rs * lg * ZF(32) + bn * v * ZF(64)) * g * ZF(4)); }
    }
    __syncthreads();
}
__device__ __forceinline__ float clr7(float x) { return __uint_as_float(__float_as_uint(x) & 0xFFFFFF80u); }
__device__ __forceinline__ void ins16(float (&L)[16], float p) {
#pragma unroll
    for (int j = 15; j >= 1; --j) L[j] = __builtin_amdgcn_fmed3f(L[j - 1], L[j], p);
    L[0] = fmaxf(L[0], p);
}
__device__ __forceinline__ void peer_topk_task(const float* sg, size_t gstride, u32x2* eg) {
    float L0[16], L1[16];
#pragma unroll
    for (int j = 0; j < 16; ++j) { L0[j] = -INFINITY; L1[j] = -INFINITY; }
    f32x4 pa[4], pb[4];
#pragma unroll
    for (int u = 0; u < 4; ++u) { pa[u] = *(const f32x4*)(sg + (size_t)u * gstride); pb[u] = *(const f32x4*)(sg + (size_t)(32 + u) * gstride); }
#pragma unroll 4
    for (int i = 0; i < 128; i += 4) {
        const f32x4 a = pa[(i >> 2) & 3], b = pb[(i >> 2) & 3];
        { const int gn = (i >> 2) + 4 < 32 ? (i >> 2) + 4 : 31; pa[(i >> 2) & 3] = *(const f32x4*)(sg + (size_t)gn * gstride); pb[(i >> 2) & 3] = *(const f32x4*)(sg + (size_t)(32 + gn) * gstride); }
#pragma unroll
        for (int q = 0; q < 4; ++q) { ins16(L0, __uint_as_float((__float_as_uint(a[q]) & 0xFFFFFF80u) | (unsigned)(i + q)));
                                      ins16(L1, __uint_as_float((__float_as_uint(b[q]) & 0xFFFFFF80u) | (unsigned)(i + q))); }
    }
    float T[16];
#pragma unroll
    for (int j = 0; j < 16; ++j) T[j] = -INFINITY;
#pragma unroll
    for (int a = 0; a < 16; ++a)
#pragma unroll
        for (int b = 0; b < 16; ++b) if ((a + 1) * (b + 1) <= 16) { const float s = clr7(L0[a]) + clr7(L1[b]);
            ins16(T, __uint_as_float((__float_as_uint(s) & 0xFFFFFF00u) | (unsigned)(a * 16 + b))); }
    float e[16], sum = 0.f; const float mx = __uint_as_float(__float_as_uint(T[0]) & 0xFFFFFF00u);
#pragma unroll
    for (int j = 0; j < 16; ++j) { e[j] = __expf(__uint_as_float(__float_as_uint(T[j]) & 0xFFFFFF00u) - mx); sum += e[j]; }
    const float inv = 1.f / sum;
#pragma unroll
    for (int j = 0; j < 16; ++j) {
        const unsigned ab = __float_as_uint(T[j]) & 0xFFu, a = ab >> 4, b = ab & 15u; unsigned i0 = 0u, i1 = 0u;
#pragma unroll
        for (int q = 0; q < 16; ++q) { i0 = (a == (unsigned)q) ? (__float_as_uint(L0[q]) & 0x7Fu) : i0; i1 = (b == (unsigned)q) ? (__float_as_uint(L1[q]) & 0x7Fu) : i1; }
        eg[j] = (u32x2){i0 * 128u + i1, __float_as_uint(e[j] * inv)};
    }
}
__device__ __forceinline__ float gelu_tanh(float x) { const float u = 0.7978845608028654f * (x + 0.044715f * x * x * x); return 0.5f * x * (1.f + tanhf_(u)); }
__device__ __forceinline__ float dot2bf(unsigned w, unsigned x, float acc) { return __builtin_amdgcn_fdot2_f32_bf16(__builtin_bit_cast(bf16x2_t, w), __builtin_bit_cast(bf16x2_t, x), acc, false); }
__device__ __forceinline__ float wave_total63(float x) {
    x = red16(x);
    x += __int_as_float(__builtin_amdgcn_update_dpp(0, __float_as_int(x), 0x142, 0xa, 0xf, false));
    x += __int_as_float(__builtin_amdgcn_update_dpp(0, __float_as_int(x), 0x143, 0xc, 0xf, false));
    return x;
}

__device__ __forceinline__ void phase_peer(const Ctx& F, int l, int nrows, const float* mod, float* wr_override) {
    const float* S = WSP(float, WS_S); u32x2* EG = WSP(u32x2, WS_EG); const bf16_t* H = WSP(bf16_t, WS_H);
    const unsigned char* U = F.ws + WS_U + (size_t)l * UV_LSTRIDE; const unsigned char* V = F.ws + WS_V + (size_t)l * UV_LSTRIDE;
    const float* USC = WSP(float, WS_SC) + (size_t)l * 2 * 16384; const float* VSC = USC + 16384;
    const int tpb = nrows / F.G, tok0 = F.vcu * tpb;
    volatile LAS unsigned* tkflag = (volatile LAS unsigned*)(F.lds + LDSCTL_OFF + 512);
    if (F.tid == 0) tkflag[0] = 0u;
    { const int ntok1 = tpb < 64 ? tpb : 64; const int task = F.tid; const int hd = task / ntok1, tkn = task - hd * ntok1;
      if (hd < 8) { const int row = tok0 + tkn; peer_topk_task(S + ((size_t)(hd * 64) * MALL + row) * 4, (size_t)MALL * 4, EG + (size_t)row * 128 + hd * 16); } }
    __threadfence_block(); __syncthreads();
    if (tpb > 64 && F.wave == 2) {
        const int nex = tpb - 64; const int hd = F.lane / nex, tkn = F.lane - hd * nex;
        if (hd < 8) { const int row = tok0 + 64 + tkn; peer_topk_task(S + ((size_t)(hd * 64) * MALL + row) * 4, (size_t)MALL * 4, EG + (size_t)row * 128 + hd * 16); }
        __threadfence_block(); asm volatile("s_waitcnt vmcnt(0) lgkmcnt(0)" ::: "memory");
        if (F.lane == 0) tkflag[0] = 1u;
    }
    const int lane = F.lane; const bool hi32 = lane >= 32; const unsigned l16 = (unsigned)(lane & 31) * 16u;
    LAS unsigned char* wl = F.lds + F.wave * PEER_WLDS; LAS unsigned char* hbl = wl + 16 * 528; LAS unsigned char* rawl = hbl + 2048; LAS float* cfl = (LAS float*)(rawl + 512); LAS unsigned short* exl = (LAS unsigned short*)(rawl + 512 + 9 * 512); LAS float* cfm = (LAS float*)(rawl + 512 + 9 * 512 + 9 * 256);
#pragma unroll 1
    for (int tk = F.wave, ti = 0; tk < tpb; tk += NWAVES, ++ti) {
        if (tk >= 64) { while (tkflag[0] == 0u) __builtin_amdgcn_s_sleep(8); __threadfence_block(); }
        const int row = tok0 + tk;
        const u32x2 eg0 = EG[(size_t)row * 128 + lane], eg1 = EG[(size_t)row * 128 + 64 + lane];
        exl[ti * 128 + lane] = (unsigned short)eg0.x; exl[ti * 128 + 64 + lane] = (unsigned short)eg1.x;
        const LAS unsigned short* exq = exl + ti * 128 + (hi32 ? 8 : 0);
        float hscale;
        {   const u32x4 h0 = *(const u32x4*)(H + (size_t)row * DM + lane * 16), h1 = *(const u32x4*)(H + (size_t)row * DM + lane * 16 + 8);
            const unsigned hw[8] = {h0.x, h0.y, h0.z, h0.w, h1.x, h1.y, h1.z, h1.w}; float hf[16]; float am = 0.f;
#pragma unroll
            for (int q = 0; q < 8; ++q) { hf[2 * q] = lo2f(hw[q]); hf[2 * q + 1] = hi2f(hw[q]); am = fmaxf(am, fmaxf(fabsf(hf[2 * q]), fabsf(hf[2 * q + 1]))); }
#pragma unroll
            for (int o = 1; o < 64; o <<= 1) am = fmaxf(am, __shfl_xor(am, o));
            const float sc = am > 0.f ? 224.f / am : 1.f; hscale = am > 0.f ? am * (1.f / 224.f) : 1.f;
            unsigned hiw[4], low[4];
#pragma unroll
            for (int d = 0; d < 4; ++d) { const float a0 = hf[d * 4] * sc, a1 = hf[d * 4 + 1] * sc, a2 = hf[d * 4 + 2] * sc, a3 = hf[d * 4 + 3] * sc;
                int w = __builtin_amdgcn_cvt_pk_fp8_f32(a0, a1, 0, false); w = __builtin_amdgcn_cvt_pk_fp8_f32(a2, a3, w, true);
                const f32x2 b01 = __builtin_amdgcn_cvt_pk_f32_fp8(w, false), b23 = __builtin_amdgcn_cvt_pk_f32_fp8(w, true);
                int wl_ = __builtin_amdgcn_cvt_pk_fp8_f32((a0 - b01.x) * 16.f, (a1 - b01.y) * 16.f, 0, false); wl_ = __builtin_amdgcn_cvt_pk_fp8_f32((a2 - b23.x) * 16.f, (a3 - b23.y) * 16.f, wl_, true);
                hiw[d] = (unsigned)w; low[d] = (unsigned)wl_; }
            LAS unsigned char* hp = hbl + (lane >> 3) * 256 + (lane & 7) * 16;
            *(LAS u32x4*)hp = (u32x4){hiw[0], hiw[1], hiw[2], hiw[3]};
            *(LAS u32x4*)(hp + 128) = (u32x4){low[0], low[1], low[2], low[3]};
        }
        {
            const int mi = lane & 15, mg = lane >> 4;
            const LAS unsigned char* aptr = wl + mi * 528 + mg * 16; const LAS unsigned char* bptr = hbl + (mi & 1) * 128 + mg * 16;
            LAS unsigned char* pk = wl + (lane >> 5) * (8 * 528) + l16;
            u32x4 rr[3][8];
#define PU_LOAD(bt_) do { _Pragma("unroll") for (int h = 0; h < 2; ++h) { const u32x2 ew = *(const LAS u32x2*)(exq + (bt_) * 16 + 4 * h); \
                rr[(bt_) % 3][4 * h + 0] = *(const u32x4*)(U + ((ew.x & 0xffffu) * 512u + l16)); rr[(bt_) % 3][4 * h + 1] = *(const u32x4*)(U + ((ew.x >> 16) * 512u + l16)); \
                rr[(bt_) % 3][4 * h + 2] = *(const u32x4*)(U + ((ew.y & 0xffffu) * 512u + l16)); rr[(bt_) % 3][4 * h + 3] = *(const u32x4*)(U + ((ew.y >> 16) * 512u + l16)); } } while (0)
#define PU_PARK(bt_) do { _Pragma("unroll") for (int q = 0; q < 8; ++q) *(LAS u32x4*)(pk + q * 528) = rr[(bt_) % 3][q]; } while (0)
            PU_LOAD(0); PU_LOAD(1);
#pragma unroll
            for (int bt = 0; bt < 8; ++bt) {
                if (bt + 2 < 8) PU_LOAD(bt + 2);
                PU_PARK(bt);
                f32x4 acc = {0.f, 0.f, 0.f, 0.f};
#pragma unroll
                for (int s = 0; s < 8; ++s) { const u32x4 a = *(const LAS u32x4*)(aptr + s * 64), b0 = *(const LAS u32x4*)(bptr + s * 256), b1 = *(const LAS u32x4*)(bptr + s * 256 + 64);
                    acc = __builtin_amdgcn_mfma_scale_f32_16x16x128_f8f6f4((i32x8){(int)a.x, (int)a.y, (int)a.z, (int)a.w, 0, 0, 0, 0},
                                                                           (i32x8){(int)b0.x, (int)b0.y, (int)b0.z, (int)b0.w, (int)b1.x, (int)b1.y, (int)b1.z, (int)b1.w}, acc, 4, 0, 0, 0x7F7F7F7F, 0, 0x7F7F7F7F); }
                f32x4 tot;
#pragma unroll
                for (int r = 0; r < 4; ++r) tot[r] = acc[r] + 0.0625f * dppf<0xF5>(acc[r]);
                if (mi == 0) *(LAS f32x4*)(rawl + (bt * 16 + 4 * mg) * 4) = tot;
            }
#undef PU_PARK
#undef PU_LOAD
            const float act0 = *(const LAS float*)(rawl + lane * 4) * (hscale * USC[eg0.x]), act1 = *(const LAS float*)(rawl + 256 + lane * 4) * (hscale * USC[eg1.x]);
            const float c0 = __uint_as_float(eg0.y) * gelu_tanh(act0) * VSC[eg0.x], c1 = __uint_as_float(eg1.y) * gelu_tanh(act1) * VSC[eg1.x];
            float cm = fmaxf(fabsf(c0), fabsf(c1));
#pragma unroll
            for (int o = 1; o < 64; o <<= 1) cm = fmaxf(cm, __shfl_xor(cm, o));
            const float cinv = cm > 0.f ? 1.f / cm : 0.f;
            cfl[ti * 128 + lane] = c0 * cinv; cfl[ti * 128 + 64 + lane] = c1 * cinv;
            if (lane == 0) cfm[ti] = cm;
        }
    }
    LDS_BARRIER();
#pragma unroll 1
    for (int tk = F.wave, ti = 0; tk < tpb; tk += NWAVES, ++ti) {
        const int row = tok0 + tk; const bool isc = row >= MLAT; const int smp = isc ? 2 : (row >> 13);
        float* xrow = isc ? WSP(float, WS_XC) + (size_t)(row - MLAT) * DM : F.out + (size_t)row * DM;
        const LAS unsigned short* exq = exl + ti * 128 + (hi32 ? 8 : 0); const LAS float* cfq = cfl + ti * 128 + (hi32 ? 8 : 0);
        u32x4 ra[8], rb[8];
#define PG_LOAD(dst, grp_) do { _Pragma("unroll") for (int h = 0; h < 2; ++h) { const u32x2 ew = *(const LAS u32x2*)(exq + (grp_) * 16 + 4 * h); \
            dst[4 * h + 0] = *(const u32x4*)(V + ((ew.x & 0xffffu) * 512u + l16)); dst[4 * h + 1] = *(const u32x4*)(V + ((ew.x >> 16) * 512u + l16)); \
            dst[4 * h + 2] = *(const u32x4*)(V + ((ew.y & 0xffffu) * 512u + l16)); dst[4 * h + 3] = *(const u32x4*)(V + ((ew.y >> 16) * 512u + l16)); } } while (0)
        PG_LOAD(ra, 0);
        f32x2 ac[16];
#pragma unroll
        for (int q = 0; q < 16; ++q) ac[q] = (f32x2){0.f, 0.f};
#define PG_VACC(src, grp_) do { _Pragma("unroll") for (int h = 0; h < 2; ++h) { const u32x4 c4 = *(const LAS u32x4*)(cfq + (grp_) * 16 + 4 * h); \
            _Pragma("unroll") for (int q = 0; q < 4; ++q) { const float cf = __uint_as_float(c4[q]); const unsigned vw[4] = {src[4 * h + q].x, src[4 * h + q].y, src[4 * h + q].z, src[4 * h + q].w}; \
            _Pragma("unroll") for (int j = 0; j < 4; ++j) { ac[4 * j] += cf * __builtin_amdgcn_cvt_scalef32_pk_f32_fp4(vw[j], 1.0f, 0); ac[4 * j + 1] += cf * __builtin_amdgcn_cvt_scalef32_pk_f32_fp4(vw[j], 1.0f, 1); \
                ac[4 * j + 2] += cf * __builtin_amdgcn_cvt_scalef32_pk_f32_fp4(vw[j], 1.0f, 2); ac[4 * j + 3] += cf * __builtin_amdgcn_cvt_scalef32_pk_f32_fp4(vw[j], 1.0f, 3); } } } } while (0)
#pragma unroll 1
        for (int g2 = 0; g2 < 4; ++g2) {
            PG_LOAD(rb, 2 * g2 + 1); PG_VACC(ra, 2 * g2);
            if (g2 < 3) PG_LOAD(ra, 2 * g2 + 2);
            PG_VACC(rb, 2 * g2 + 1);
        }
#undef PG_LOAD
#undef PG_VACC
        float acc[16];
        const float cmx = cfm[ti];
#pragma unroll
        for (int q = 0; q < 8; ++q) { const f32x2 mine = hi32 ? ac[8 + q] : ac[q], send = hi32 ? ac[q] : ac[8 + q];
            acc[2 * q] = cmx * (mine.x + __shfl_xor(send.x, 32)); acc[2 * q + 1] = cmx * (mine.y + __shfl_xor(send.y, 32)); }
        const int col0 = 32 * (lane & 31) + 16 * (lane >> 5);
        const float* gt = mod + smp * 6144 + 5120;
        f32x4 res[4]; float ss = 0.f;
#pragma unroll
        for (int q = 0; q < 4; ++q) { const int c = col0 + q * 4; const f32x4 g = *(const f32x4*)(gt + c), x = *(const f32x4*)(xrow + c);
            res[q] = x + ZF(1) * g * (f32x4){acc[q * 4], acc[q * 4 + 1], acc[q * 4 + 2], acc[q * 4 + 3]};
            *(f32x4*)((wr_override ? wr_override + (size_t)row * DM : xrow) + c) = res[q];
            ss += (res[q][0] * res[q][0] + res[q][1] * res[q][1]) + (res[q][2] * res[q][2] + res[q][3] * res[q][3]); }
        if (l == 0 && !wr_override) {
            const float rs = rsqrtf(wave_sum(ss) * (1.f / DM) + EPSN); const float* mb1 = mod + 3 * 6144 + smp * 6144; const float* g1 = F.in[6] + DM;
            bf16_t* Hw = WSP(bf16_t, WS_H) + (size_t)row * DM;
#pragma unroll
            for (int q = 0; q < 4; ++q) { const int c = col0 + q * 4; const f32x4 g = *(const f32x4*)(g1 + c), sc = *(const f32x4*)(mb1 + 1024 + c), sh = *(const f32x4*)(mb1 + c);
                st4bf(Hw + c, (res[q] * rs * g) * (1.f + sc) + sh); }
        }
    }
}

constexpr int PH_PER_LAYER = 10, N_PHASES = 1 + 2 * PH_PER_LAYER;
struct Args { const float* in[32]; float* out; unsigned char* ws; int ph_lo, ph_hi, li, pad; };
__global__ void __launch_bounds__(NTHR, 2) mk_fwd(Args args) {
    extern __shared__ __attribute__((aligned(16))) unsigned char lds[];
    Ctx F;
    F.lds = (LAS unsigned char*)lds;
    volatile LAS unsigned* MISC = (volatile LAS unsigned*)(F.lds + MISC_OFF);
    F.tid = threadIdx.x; F.lane = F.tid & 63; F.wave = __builtin_amdgcn_readfirstlane(F.tid >> 6);
    F.G = gridDim.x; { const int bx = blockIdx.x; F.vcu = (F.G % 8 == 0) ? (bx % 8) * (F.G / 8) + bx / 8 : bx; }
#pragma unroll
    for (int i = 0; i < 32; ++i) F.in[i] = args.in[i];
    F.out = args.out; F.ws = args.ws;
    for (int u = F.tid; u < (LDS_BYTES - LDSCTL_OFF) / 4; u += NTHR) ((LAS unsigned*)(F.lds + LDSCTL_OFF))[u] = 0u;
    __syncthreads();
    XcdBarrier bar; bar.bar = (unsigned*)(args.ws + WS_CTL) + CW_BAR; bar.x = 0; bar.st = nullptr;
#if !MK_MULTI
    bar = xcd_barrier_post((unsigned*)(args.ws + WS_CTL) + CW_BAR, MISC + 8);
#endif
    const int lo = args.ph_lo, hi = args.ph_hi;
#ifndef KMAX
#define KMAX 1000
#endif
#define IN(k) (lo <= (k) && (k) < hi && (REP_ALL == 1 || ra == REP_ALL - 1 || (k) <= KMAX))
#ifndef REP_PH
#define REP_PH -1
#endif
#define REPS(k) ((REP_PH == (k)) ? 2 : 1)
#define PHCTX Ctx Fp = F; { int t_ = F.tid; asm volatile("" : "+v"(t_)); Fp.tid = t_; Fp.lane = t_ & 63; }
#if MK_MULTI
#define SEAM(k) do { } while (0)
#else
#ifndef BAR_REPS
#define BAR_REPS 1
#endif
#define SEAM(k) do { if (IN(k) && IN((k) + 1)) for (int br_ = 0; br_ < BAR_REPS; ++br_) xcd_barrier(bar); } while (0)
#endif
#ifndef REP_ALL
#define REP_ALL 1
#endif
#ifndef REP_SUB
#define REP_SUB 0
#endif
#pragma unroll 1
    for (int ra = 0; ra < REP_ALL; ++ra) {
    if (ra > 0) xcd_barrier(bar);
    if (IN(0)) { PHCTX; for (int rep = 0; rep < REPS(100); ++rep) phase_prologue(Fp); }
    SEAM(0);
    float* XC = WSP(float, WS_XC);
#pragma unroll 1
    for (int l = 0; l < 2; ++l) {
        const int pb = 1 + l * PH_PER_LAYER;
        const float* xlat = l == 0 ? F.in[0] : F.out; const float* xctx = l == 0 ? F.in[2] : XC;
        const int mrows = l == 0 ? MALL : MLAT;
        const float* mod = WSP(float, WS_MOD) + (size_t)l * 3 * 6144;
        if (IN(pb + 0) && l == 0) { PHCTX; for (int rep = 0; rep < REPS(0); ++rep) { phase_norm(Fp, l, 0, MALL, xlat, xctx); } }
        if (l == 0) SEAM(pb + 0);
        if (IN(pb + 1)) for (int rep = 0; rep < REPS(1); ++rep) { PHCTX; pg8::Gemm g{WSP(bf16_t, WS_H), WSP(bf16_t, WS_WIN + l * WIN_LSTRIDE), MALL, DINP, DM}; pg8::StaticOrder So; So.init(MALL, DINP, F.G, (int)blockIdx.x);
            pg8::EpiBf16 E{WSP(bf16_t, WS_P), DINP}; pg8::gemm_phase<pg8::EpiBf16, pg8::StaticOrder, true, true>(F.lds, g, So, E, Fp.tid); }
        SEAM(pb + 1);
        if (IN(pb + 2)) { PHCTX; for (int rep = 0; rep < REPS(2); ++rep) { phase_prep(Fp, l); __syncthreads(); } }
        SEAM(pb + 2);
        if (IN(pb + 3)) for (int rep = 0; rep < REPS(3); ++rep) {
            const int nra = 16 * RCH, nml = 16 * NCHK;
            for (int r3 = 0; r3 < (REP_SUB == 3 ? 2 : 1); ++r3) { PHCTX; for (int task = F.vcu; task < nra; task += F.G) { RaRaw cur_; ra_load(Fp, task, cur_); rwkv_chunk_pre(Fp, task, cur_); } __syncthreads(); }
            for (int r3 = 0; r3 < (REP_SUB == 4 ? 2 : 1); ++r3) { PHCTX; for (int task = (F.vcu + F.G - 72) % F.G; task < nml; task += F.G) mlstm_local(Fp, task); }
        }
        SEAM(pb + 3);
                if (IN(pb + 4)) for (int rep = 0; rep < REPS(4); ++rep) {
            if (F.vcu < 16) { PHCTX; rwkv_chain(Fp, F.vcu); }
            else { { PHCTX; mlstm_chain(Fp, 16); }
                   { PHCTX; const int natt = l == 0 ? 264 : 256; for (int task = F.vcu - 16; task < natt; task += F.G - 16) attn_unit(Fp, l, task); } } }
        SEAM(pb + 4);
        if (IN(pb + 5)) for (int rep = 0; rep < REPS(5); ++rep) { const int nro = l == 0 ? 264 : 256, nun = l == 0 ? 528 : 512;
            { PHCTX; for (int u = F.vcu; u < nro; u += F.G) rwkv_out(Fp, l, u); }
            { PHCTX; for (int u = (F.vcu + F.G - 8) % F.G; u < nun; u += F.G) mlstm_out(Fp, l, u); } }
        SEAM(pb + 5);
        if (IN(pb + 6)) for (int rep = 0; rep < REPS(6); ++rep) { PHCTX; pg8::Gemm g{WSP(bf16_t, WS_YCAT), WSP(bf16_t, WS_WOUT + l * WOUT_LSTRIDE), mrows, DM, DM}; pg8::StaticOrder So; So.init(mrows, DM, F.G, (int)blockIdx.x);
            float* dummy = WSP(float, WS_YR); const bool dm_ = (REPS(6) == 2 && rep == 0); pg8::EpiRes E{xlat, xctx, dm_ ? dummy : F.out, dm_ ? dummy : XC, mod}; pg8::gemm_phase<pg8::EpiRes, pg8::StaticOrder, true, true>(F.lds, g, So, E, Fp.tid); }
        SEAM(pb + 6);
        if (IN(pb + 7)) { PHCTX; for (int rep = 0; rep < REPS(7); ++rep) phase_norm(Fp, l, 1, mrows, F.out, XC); }
        SEAM(pb + 7);
        if (IN(pb + 8)) for (int rep = 0; rep < REPS(8); ++rep) { PHCTX; pg8::Gemm g{WSP(bf16_t, WS_H), WSP(bf16_t, WS_WEFF + l * WEFF_LSTRIDE), mrows, 2048, DM}; pg8::StaticOrder So; So.init(mrows, 2048, F.G, (int)blockIdx.x);
            pg8::EpiF32 E{WSP(float, WS_S), MALL}; pg8::gemm_phase<pg8::EpiF32, pg8::StaticOrder, true, true>(F.lds, g, So, E, Fp.tid); }
        SEAM(pb + 8);
        if (IN(pb + 9)) { PHCTX; for (int rep = 0; rep < REPS(9); ++rep) { phase_peer(Fp, l, mrows, mod, (REPS(9) == 2 && rep == 0) ? WSP(float, WS_YR) : nullptr); __syncthreads(); } }
        SEAM(pb + 9);
    }
    }
#undef IN
#undef SEAM
}

extern "C" void kernel_launch(void* const* d_in, const int* in_sizes, int n_in, void* d_out, int out_size, void* d_ws, size_t ws_size, hipStream_t stream) {
    static int grid = 0;
    if (grid == 0) {
        if (n_in != 32 || out_size != MLAT * DM || ws_size < WS_END2) { fprintf(stderr, "kernel_launch: unexpected shapes: n_in %d out %d ws %zu (need %zu)\n", n_in, out_size, ws_size, (size_t)WS_END2); grid = -1; return; }
        int dev = 0, cus = 0, per_cu = 0;
        if (hipGetDevice(&dev) != hipSuccess || hipDeviceGetAttribute(&cus, hipDeviceAttributeMultiprocessorCount, dev) != hipSuccess) { grid = -1; return; }
        if (hipFuncSetAttribute((const void*)mk_fwd, hipFuncAttributeMaxDynamicSharedMemorySize, LDS_BYTES) != hipSuccess) { fprintf(stderr, "kernel_launch: hipFuncSetAttribute failed\n"); grid = -1; return; }
        if (hipOccupancyMaxActiveBlocksPerMultiprocessor(&per_cu, (const void*)mk_fwd, NTHR, LDS_BYTES) != hipSuccess || per_cu < 1) fprintf(stderr, "kernel_launch: occupancy query reports %d\n", per_cu);
        (void)hipGetLastError();
        grid = cus;
        if (grid != 256) fprintf(stderr, "kernel_launch: grid %d (built for 256 CUs)\n", grid);
    }
    if (grid < 0) return;
    (void)hipMemsetAsync((char*)d_ws + WS_CTL, 0, CTL_ZERO_BYTES, stream);
    Args a{};
    for (int i = 0; i < 32; ++i) a.in[i] = (const float*)d_in[i];
    a.out = (float*)d_out; a.ws = (unsigned char*)d_ws;
#if MK_MULTI
    for (int p = 0; p < N_PHASES; ++p) { a.ph_lo = p; a.ph_hi = p + 1; a.li = p; hipLaunchKernelGGL(mk_fwd, dim3(grid), dim3(NTHR), LDS_BYTES, stream, a); }
#else
    a.ph_lo = 0; a.ph_hi = N_PHASES; a.li = 0;
    hipLaunchKernelGGL(mk_fwd, dim3(grid), dim3(NTHR), LDS_BYTES, stream, a);
#endif
}
```

```cpp
#include <hip/hip_runtime.h>
#include <cstdio>
#include <cstdint>

#ifndef MK_MULTI
#define MK_MULTI 0
#endif
namespace pg8 {
#define PG8_LAS __attribute__((address_space(3)))
typedef unsigned short bf16_t;
typedef short bf16x8 __attribute__((ext_vector_type(8)));
typedef float f32x4 __attribute__((ext_vector_type(4)));
typedef unsigned u32x4 __attribute__((ext_vector_type(4)));
constexpr int BM = 256, BK = 64, HALF = 128, HTB = HALF * BK * 2  , STAGE_BYTES = 8 * HTB, NXCD = 8, WGM = 8;

__host__ __device__ __forceinline__ int lds_byte(int r, int c) { const int st = (r >> 4) * 2 + (c >> 5), rr = r & 15, cc = c & 31, ob = rr * 64 + cc * 2; return st * 1024 + (ob ^ (((ob >> 9) & 1) << 5)); }
__host__ __device__ __forceinline__ void stage_rc(int b, int& R, int& C) { const int st = b / 1024, sb = b % 1024, swz = sb ^ (((sb >> 9) & 1) << 5); R = (st >> 1) * 16 + swz / 64; C = (st & 1) * 32 + (swz % 64) / 2; }
__host__ __device__ __forceinline__ int perm32(int rho) { const int n = rho >> 4, i = rho & 15; return 8 * (i >> 2) + 4 * n + (i & 3); }

struct Unit { int pm, pn; };
struct Gemm { const bf16_t* A; const bf16_t* Bt; int M, N, K; };

struct StaticOrder {
    int nM, nN, nwg, G, c;
    __host__ __device__ void init(int M, int N, int G_, int c_) { nM = M / BM; nN = N / BM; nwg = nM * nN; G = G_; c = c_; }
    __host__ __device__ bool next(int i, Unit& u) const {
        const long L = (long)i * G + c; if (L >= nwg) return false;
        int wgid = (int)L; { const int q = nwg / NXCD, r = nwg % NXCD, xcd = wgid % NXCD, off = wgid / NXCD; wgid = (xcd < r ? xcd * (q + 1) : r * (q + 1) + (xcd - r) * q) + off; }
        const int nig = WGM * nN, gid = wgid / nig, fm = gid * WGM, gsz = (nM - fm) < WGM ? (nM - fm) : WGM;
        u.pm = fm + ((wgid % nig) % gsz); u.pn = (wgid % nig) / gsz; return true;
    }
    __device__ __forceinline__ void a_ready(const Unit&) const {}
    __device__ __forceinline__ void done(const Unit&) const {}
};

__device__ __forceinline__ unsigned cvt_pk_bf16(float lo, float hi) { unsigned r; asm volatile("v_cvt_pk_bf16_f32 %0, %1, %2" : "=v"(r) : "v"(lo), "v"(hi)); return r; }

struct EpiBf16 {
    static constexpr bool PERM = true, AFTER_DRAIN = false;
    bf16_t* O; int ldc;
    __device__ __forceinline__ void operator()(const f32x4 (&acc)[2][2][4][2], const Unit& u, int wr, int wc, int fr, int fq) const {
        const int row0 = u.pm * BM + wr * 64 + fr; const int col0 = u.pn * BM + wc * 32 + 8 * fq;
#pragma unroll
        for (int ai = 0; ai < 2; ++ai)
#pragma unroll
            for (int m = 0; m < 4; ++m) { bf16_t* rowp = O + (size_t)(row0 + ai * HALF + m * 16) * ldc + col0;
#pragma unroll
                for (int bj = 0; bj < 2; ++bj) { const f32x4 v0 = acc[ai][bj][m][0], v1 = acc[ai][bj][m][1];
                    u32x4 w; w.x = cvt_pk_bf16(v0[0], v0[1]); w.y = cvt_pk_bf16(v0[2], v0[3]); w.z = cvt_pk_bf16(v1[0], v1[1]); w.w = cvt_pk_bf16(v1[2], v1[3]);
                    *(u32x4*)(rowp + bj * HALF) = w; } }
    }
};
struct EpiF32 {
    static constexpr bool PERM = false, AFTER_DRAIN = false;
    float* O; int ldr;
    __device__ __forceinline__ void operator()(const f32x4 (&acc)[2][2][4][2], const Unit& u, int wr, int wc, int fr, int fq) const {
        const int row0 = u.pm * BM + wr * 64 + fr; const int col0 = u.pn * BM + wc * 32 + 4 * fq;
#pragma unroll
        for (int ai = 0; ai < 2; ++ai)
#pragma unroll
            for (int m = 0; m < 4; ++m) { const int row = row0 + ai * HALF + m * 16;
#pragma unroll
                for (int bj = 0; bj < 2; ++bj)
#pragma unroll
                    for (int n = 0; n < 2; ++n) { const int cg = (col0 + bj * HALF + n * 16) >> 2; *(f32x4*)(O + ((size_t)cg * ldr + row) * 4) = acc[ai][bj][m][n]; } }
    }
};
struct EpiBf16S {
    static constexpr bool PERM = true, AFTER_DRAIN = false;
    bf16_t* O; int ldr;
    __device__ __forceinline__ void operator()(const f32x4 (&acc)[2][2][4][2], const Unit& u, int wr, int wc, int fr, int fq) const {
        const int row0 = u.pm * BM + wr * 64 + fr; const int col0 = u.pn * BM + wc * 32 + 8 * fq;
#pragma unroll
        for (int ai = 0; ai < 2; ++ai)
#pragma unroll
            for (int m = 0; m < 4; ++m) { const int row = row0 + ai * HALF + m * 16;
#pragma unroll
                for (int bj = 0; bj < 2; ++bj) { const f32x4 v0 = acc[ai][bj][m][0], v1 = acc[ai][bj][m][1];
                    u32x4 w; w.x = cvt_pk_bf16(v0[0], v0[1]); w.y = cvt_pk_bf16(v0[2], v0[3]); w.z = cvt_pk_bf16(v1[0], v1[1]); w.w = cvt_pk_bf16(v1[2], v1[3]);
                    *(u32x4*)(O + ((size_t)((col0 + bj * HALF) >> 3) * ldr + row) * 8) = w; } }
    }
};
struct EpiRes {
    static constexpr bool PERM = false, AFTER_DRAIN = false;
    const float* src_lat; const float* src_ctx; float* dst_lat; float* dst_ctx; const float* gate;
    __device__ __forceinline__ void operator()(const f32x4 (&acc)[2][2][4][2], const Unit& u, int wr, int wc, int fr, int fq) const {
        const bool isc = u.pm >= 64; const int smp = isc ? 2 : (u.pm >> 5);
        const int prow = (isc ? (u.pm - 64) * BM : u.pm * BM) + wr * 64 + fr;
        const float* src = isc ? src_ctx : src_lat; float* dst = isc ? dst_ctx : dst_lat;
        const float* gt = gate + smp * 6144 + 2048;
        const int col0 = u.pn * BM + wc * 32 + 4 * fq;
        f32x4 gv[2][2];
#pragma unroll
        for (int bj = 0; bj < 2; ++bj)
#pragma unroll
            for (int n = 0; n < 2; ++n) gv[bj][n] = *(const f32x4*)(gt + col0 + bj * HALF + n * 16);
#pragma unroll
        for (int ai = 0; ai < 2; ++ai)
#pragma unroll
            for (int m = 0; m < 4; ++m) { const size_t off = (size_t)(prow + ai * HALF + m * 16) * 1024 + col0;
#pragma unroll
                for (int bj = 0; bj < 2; ++bj)
#pragma unroll
                    for (int n = 0; n < 2; ++n) { const f32x4 s = *(const f32x4*)(src + off + bj * HALF + n * 16);
                        *(f32x4*)(dst + off + bj * HALF + n * 16) = s + gv[bj][n] * acc[ai][bj][m][n]; } }
    }
};

template <class Epi, class Sched, bool ALIGN_EPI = false, bool SP2 = false>
__device__ __forceinline__ void gemm_phase(PG8_LAS unsigned char* lds, const Gemm g, const Sched& S, const Epi& E, const int tid) {
    const int wid = __builtin_amdgcn_readfirstlane(tid >> 6), lane = tid & 63, wr = wid >> 2, wc = wid & 3, fr = lane & 15, fq = lane >> 4;
    const int K = g.K, nt = K / BK;
    unsigned voffA[2], voffB[2];
#pragma unroll
    for (int i = 0; i < 2; ++i) { int R, C; stage_rc(tid * 16 + i * 8192, R, C); const int Rb = Epi::PERM ? ((R & ~31) + perm32(R & 31)) : R;
        voffA[i] = (unsigned)(R * K + C) * 2u; voffB[i] = (unsigned)(Rb * K + C) * 2u; }
    const size_t kstep = (size_t)(BK * 2);
    const size_t hstep = (size_t)HALF * K * 2;
    const size_t tstep = 2 * hstep;
    const unsigned ldsw = (unsigned)wid * 1024u;
    const int aoff = lds_byte(wr * 64 + fr, fq * 8), boff = lds_byte(wc * 32 + fr, fq * 8);
#define PG8_SA(b, h) (((b) * 2 + (h)) * HTB)
#define PG8_SB(b, h) ((4 + (b) * 2 + (h)) * HTB)
#define PG8_STAGE(bufoff, gbase, voff) do { _Pragma("unroll") for (int _i = 0; _i < 2; ++_i) \
        __builtin_amdgcn_global_load_lds((const unsigned*)((const char*)(gbase) + (voff)[_i]), (PG8_LAS unsigned*)(lds + (bufoff) + ldsw + _i * 8192), 16, 0, 0); } while (0)
#define PG8_LDA(dst, b, h) do { _Pragma("unroll") for (int m = 0; m < 4; ++m) _Pragma("unroll") for (int k = 0; k < 2; ++k) dst[m][k] = *(const PG8_LAS bf16x8*)(lds + PG8_SA(b, h) + aoff + m * 2048 + k * 1024); } while (0)
#define PG8_LDB(dst, b, h) do { _Pragma("unroll") for (int n = 0; n < 2; ++n) _Pragma("unroll") for (int k = 0; k < 2; ++k) dst[n][k] = *(const PG8_LAS bf16x8*)(lds + PG8_SB(b, h) + boff + n * 2048 + k * 1024); } while (0)
#define PG8_MMA(ai, bj, At, Bt) do { __builtin_amdgcn_s_setprio(1); _Pragma("unroll") for (int m = 0; m < 4; ++m) _Pragma("unroll") for (int n = 0; n < 2; ++n) _Pragma("unroll") for (int k = 0; k < 2; ++k) \
        acc[ai][bj][m][n] = __builtin_amdgcn_mfma_f32_16x16x32_bf16(Bt[n][k], At[m][k], acc[ai][bj][m][n], 0, 0, 0); __builtin_amdgcn_s_setprio(0); } while (0)
#define PG8_WAIT_V(n) asm volatile("s_waitcnt vmcnt(" #n ")" ::: "memory")
#define PG8_WAIT_L(n) asm volatile("s_waitcnt lgkmcnt(" #n ")" ::: "memory")
#define PG8_BAR __builtin_amdgcn_s_barrier()
#define PG8_SCHED __builtin_amdgcn_sched_barrier(0)
    Unit cur, nxt; int ui = 0;
    if (!S.next(0, cur)) return;
    f32x4 acc[2][2][4][2];
#pragma unroll
    for (int a = 0; a < 2; ++a)
#pragma unroll
        for (int b = 0; b < 2; ++b)
#pragma unroll
            for (int m = 0; m < 4; ++m)
#pragma unroll
                for (int n = 0; n < 2; ++n) acc[a][b][m][n] = (f32x4){0.f, 0.f, 0.f, 0.f};
    bf16x8 At[4][2], B0[2][2], B1[2][2];
    const char* cA = (const char*)g.A + (size_t)cur.pm * tstep; const char* cB = (const char*)g.Bt + (size_t)cur.pn * tstep;
    S.a_ready(cur);
    if constexpr (SP2) {
        PG8_STAGE(PG8_SB(0, 0), cB, voffB); PG8_STAGE(PG8_SB(0, 1), cB + hstep, voffB); PG8_STAGE(PG8_SA(0, 0), cA, voffA); PG8_STAGE(PG8_SA(0, 1), cA + hstep, voffA);
        if (wr == 1) PG8_BAR;
        PG8_WAIT_V(2); PG8_BAR;
        PG8_STAGE(PG8_SB(1, 0), cB + kstep, voffB); PG8_STAGE(PG8_SA(1, 0), cA + kstep, voffA); PG8_STAGE(PG8_SB(1, 1), cB + hstep + kstep, voffB);
        PG8_WAIT_V(6); PG8_BAR;
    } else {
        PG8_STAGE(PG8_SB(0, 0), cB, voffB); PG8_STAGE(PG8_SA(0, 0), cA, voffA); PG8_STAGE(PG8_SB(0, 1), cB + hstep, voffB); PG8_STAGE(PG8_SA(0, 1), cA + hstep, voffA);
        if (wr == 1) PG8_BAR;
        PG8_WAIT_V(4); PG8_BAR;
        PG8_STAGE(PG8_SB(1, 0), cB + kstep, voffB); PG8_STAGE(PG8_SA(1, 0), cA + kstep, voffA); PG8_STAGE(PG8_SB(1, 1), cB + hstep + kstep, voffB);
        PG8_WAIT_V(6); PG8_BAR;
    }
    for (;;) {
        const bool has_next = S.next(ui + 1, nxt);
        const char* nA = has_next ? (const char*)g.A + (size_t)nxt.pm * tstep : cA; const char* nB = has_next ? (const char*)g.Bt + (size_t)nxt.pn * tstep : cB;
        for (int t = 0; t < nt; t += 2) {
            const bool last = (t == nt - 2);
            const char* a1 = cA + (size_t)(t + 1) * kstep;
            const char* a2 = last ? nA : cA + (size_t)(t + 2) * kstep; const char* b2 = last ? nB : cB + (size_t)(t + 2) * kstep;
            const char* a3 = a2 + kstep; const char* b3 = b2 + kstep;
            if (last && has_next) S.a_ready(nxt);
            if constexpr (SP2) {
            PG8_LDB(B0, 0, 0); PG8_LDB(B1, 0, 1); PG8_SCHED; PG8_LDA(At, 0, 0); PG8_STAGE(PG8_SA(1, 1), a1 + hstep, voffA);
            PG8_WAIT_V(8); PG8_WAIT_L(0); PG8_BAR; PG8_MMA(0, 0, At, B0); PG8_MMA(0, 1, At, B1); PG8_BAR; PG8_SCHED;
            PG8_LDA(At, 0, 1); PG8_STAGE(PG8_SB(0, 0), b2, voffB); PG8_STAGE(PG8_SB(0, 1), b2 + hstep, voffB); PG8_STAGE(PG8_SA(0, 0), a2, voffA);
            PG8_WAIT_V(8); PG8_WAIT_L(0); PG8_BAR; PG8_MMA(1, 0, At, B0); PG8_MMA(1, 1, At, B1); PG8_BAR; PG8_SCHED;
            PG8_LDB(B0, 1, 0); PG8_LDB(B1, 1, 1); PG8_SCHED; PG8_LDA(At, 1, 0); PG8_STAGE(PG8_SA(0, 1), a2 + hstep, voffA);
            PG8_WAIT_V(8); PG8_WAIT_L(0); PG8_BAR; PG8_MMA(0, 0, At, B0); PG8_MMA(0, 1, At, B1); PG8_BAR; PG8_SCHED;
            PG8_LDA(At, 1, 1); PG8_STAGE(PG8_SB(1, 0), b3, voffB); PG8_STAGE(PG8_SB(1, 1), b3 + hstep, voffB); PG8_STAGE(PG8_SA(1, 0), a3, voffA);
            PG8_WAIT_V(8); PG8_WAIT_L(0); PG8_BAR; PG8_MMA(1, 0, At, B0); PG8_MMA(1, 1, At, B1); PG8_BAR; PG8_SCHED;
            } else {
            PG8_LDB(B0, 0, 0); PG8_SCHED; PG8_LDA(At, 0, 0); PG8_STAGE(PG8_SA(1, 1), a1 + hstep, voffA);
            PG8_WAIT_L(8); PG8_BAR; PG8_WAIT_L(0); PG8_MMA(0, 0, At, B0); PG8_BAR; PG8_SCHED;
            PG8_LDB(B1, 0, 1); PG8_STAGE(PG8_SB(0, 0), b2, voffB);
            PG8_BAR; PG8_WAIT_L(0); PG8_MMA(0, 1, At, B1); PG8_BAR;
            PG8_LDA(At, 0, 1); PG8_STAGE(PG8_SA(0, 0), a2, voffA);
            PG8_BAR; PG8_WAIT_L(0); PG8_MMA(1, 0, At, B0); PG8_BAR; PG8_SCHED;
            PG8_STAGE(PG8_SB(0, 1), b2 + hstep, voffB);
            PG8_WAIT_V(6); PG8_BAR; PG8_MMA(1, 1, At, B1); PG8_BAR;
            PG8_LDB(B0, 1, 0); PG8_SCHED; PG8_LDA(At, 1, 0); PG8_STAGE(PG8_SA(0, 1), a2 + hstep, voffA);
            PG8_WAIT_L(8); PG8_BAR; PG8_WAIT_L(0); PG8_MMA(0, 0, At, B0); PG8_BAR; PG8_SCHED;
            PG8_LDB(B1, 1, 1); PG8_STAGE(PG8_SB(1, 0), b3, voffB);
            PG8_BAR; PG8_WAIT_L(0); PG8_MMA(0, 1, At, B1); PG8_BAR;
            PG8_LDA(At, 1, 1); PG8_STAGE(PG8_SA(1, 0), a3, voffA);
            PG8_BAR; PG8_WAIT_L(0); PG8_MMA(1, 0, At, B0); PG8_BAR; PG8_SCHED;
            PG8_STAGE(PG8_SB(1, 1), b3 + hstep, voffB);
            PG8_WAIT_V(6); PG8_BAR; PG8_MMA(1, 1, At, B1); PG8_BAR;
            }
        }
        if constexpr (ALIGN_EPI) { if (wr == 0) PG8_BAR; }
        if constexpr (!Epi::AFTER_DRAIN) { E(acc, cur, wr, wc, fr, fq); S.done(cur); }
        if (!has_next) break;
#pragma unroll
        for (int a = 0; a < 2; ++a)
#pragma unroll
            for (int b = 0; b < 2; ++b)
#pragma unroll
                for (int m = 0; m < 4; ++m)
#pragma unroll
                    for (int n = 0; n < 2; ++n) acc[a][b][m][n] = (f32x4){0.f, 0.f, 0.f, 0.f};
        cur = nxt; cA = nA; cB = nB; ++ui;
        if constexpr (ALIGN_EPI) { if (wr == 1) PG8_BAR; }
    }
    PG8_WAIT_V(0);
    if constexpr (!ALIGN_EPI) { if (wr == 0) PG8_BAR; }
    PG8_BAR;
    if constexpr (Epi::AFTER_DRAIN) { E.fused(acc, cur, wr, wc, fr, fq, lds, wid, lane); S.done(cur); }
#undef PG8_SA
#undef PG8_SB
#undef PG8_STAGE
#undef PG8_LDA
#undef PG8_LDB
#undef PG8_MMA
#undef PG8_WAIT_V
#undef PG8_WAIT_L
#undef PG8_BAR
#undef PG8_SCHED
}
}
#ifndef ZMASK
#define ZMASK 0
#endif
#define ZF(bit) ((ZMASK & (bit)) ? 0.f : 1.f)
using pg8::bf16_t; using pg8::bf16x8; using pg8::f32x4; using pg8::u32x4;
constexpr int NWAVES = 8, NTHR = 512;
constexpr int DM = 1024, TLAT = 8192, TCTX = 256, MLAT = 2 * TLAT, MCTX = 2 * TCTX, MALL = MLAT + MCTX;
constexpr int DIN = 3152, DINP = 3328;
constexpr int C_CH = 0, C_CB = 256, C_CC = 512, C_RR = 768, C_RK = 1024, C_RV = 1280, C_XW = 1536, C_XA = 1552, C_XG = 1568,
              C_AQ = 1600, C_AK = 1856, C_AV = 1984, C_MQ = 2112, C_MK = 2368, C_MV = 2624, C_MO = 2880, C_MG = 3136;
constexpr float EPSN = 1e-6f;
constexpr int NCHK = 66;
constexpr int CST = 4160;
constexpr int RWREC = 4608;
constexpr size_t MiB = 1u << 20;
constexpr size_t WS_CTL = 0, CTL_ZERO_BYTES = 1 * MiB, WS_MOD = 1 * MiB;
constexpr size_t WS_WIN = 2 * MiB, WIN_LSTRIDE = (size_t)DINP * DM * 2;
constexpr size_t WS_WOUT = 16 * MiB, WOUT_LSTRIDE = 2 * MiB;
constexpr size_t WS_WEFF = 20 * MiB, WEFF_LSTRIDE = 4 * MiB;
constexpr size_t WS_XC = 28 * MiB, WS_GA = 30 * MiB, WS_H = 32 * MiB, WS_YCAT = 65 * MiB, WS_U = 98 * MiB, WS_V = 130 * MiB;
constexpr size_t WS_P = 162 * MiB, WS_RW = 270 * MiB, WS_YR = 345 * MiB, WS_QA = 378 * MiB, WS_KA = 387 * MiB;
constexpr size_t WS_LC = 392 * MiB, WS_ST = 409 * MiB, WS_LB = 426 * MiB, WS_EG = 427 * MiB, WS_GB = 444 * MiB, WS_BS = 453 * MiB, WS_SC = 453 * MiB + 512 * 1024, WS_END = 454 * MiB;
constexpr size_t UV_LSTRIDE = 16 * MiB;
constexpr size_t WS_S = WS_P;
static_assert(WS_P + (size_t)MALL * DINP * 2 <= WS_RW && WS_RW + (size_t)MALL * RWREC <= WS_YR && WS_S + (size_t)MALL * 2048 * 4 <= WS_YR, "ws map");
static_assert(WS_LC + (size_t)16 * NCHK * CST * 4 <= WS_ST && WS_ST + (size_t)16 * NCHK * CST * 4 <= WS_LB && WS_EG + (size_t)MALL * 128 * 8 <= WS_GB, "ws map 2");
constexpr int CW_BAR = 4096;
constexpr int RING_BYTES = 131072;
constexpr int PEER_WLDS = 16 * 528 + 2048 + 512 + 9 * 512 + 9 * 256 + 64;
constexpr int PHASE_LDS = 8 * PEER_WLDS > RING_BYTES ? 8 * PEER_WLDS : RING_BYTES;
constexpr int LDSCTL_OFF = PHASE_LDS, MISC_OFF = LDSCTL_OFF + 320, LDS_BYTES = PHASE_LDS + 4096;
static_assert(RING_BYTES <= PHASE_LDS && 8 * PEER_WLDS <= PHASE_LDS && LDS_BYTES <= 160 * 1024 && PHASE_LDS % 16 == 0, "LDS map");

#define GAS __attribute__((address_space(1)))
#define LAS __attribute__((address_space(3)))
typedef unsigned u32x2 __attribute__((ext_vector_type(2)));
typedef float f32x2 __attribute__((ext_vector_type(2)));
typedef int i32x8 __attribute__((ext_vector_type(8)));
typedef _Float16 h16x2 __attribute__((ext_vector_type(2)));
typedef __bf16 bf16x2_t __attribute__((ext_vector_type(2)));
typedef GAS unsigned gu32;
#define LDS_WAIT() asm volatile("s_waitcnt lgkmcnt(0)" ::: "memory")
#define LDS_BARRIER() do { asm volatile("s_waitcnt lgkmcnt(0)" ::: "memory"); __builtin_amdgcn_s_barrier(); asm volatile("" ::: "memory"); } while (0)

__device__ __forceinline__ float lo2f(unsigned w) { return __uint_as_float(w << 16); }
__device__ __forceinline__ float hi2f(unsigned w) { return __uint_as_float(w & 0xffff0000u); }
__device__ __forceinline__ float bf2f(bf16_t b) { return __uint_as_float((unsigned)b << 16); }
__device__ __forceinline__ unsigned f2bf(float f) { unsigned u = __float_as_uint(f); return (u + 0x7fffu + ((u >> 16) & 1u)) >> 16; }
__device__ __forceinline__ unsigned pk2(float lo, float hi) { const f32x2 v = {lo, hi}; const bf16x2_t b = __builtin_convertvector(v, bf16x2_t); return __builtin_bit_cast(unsigned, b); }
__device__ __forceinline__ f32x4 ld4bf(const bf16_t* p) { const u32x2 w = *(const u32x2*)p; return (f32x4){lo2f(w.x), hi2f(w.x), lo2f(w.y), hi2f(w.y)}; }
__device__ __forceinline__ void st4bf(bf16_t* p, f32x4 v) { u32x2 w; w.x = pk2(v[0], v[1]); w.y = pk2(v[2], v[3]); *(u32x2*)p = w; }
__device__ __forceinline__ float sigmoidf_(float x) { return 1.f / (1.f + __expf(-x)); }
__device__ __forceinline__ float tanhf_(float x) { const float e = __expf(-2.f * fabsf(x)); const float t = (1.f - e) / (1.f + e); return x < 0.f ? -t : t; }
template <int CTRL> __device__ __forceinline__ float dppf(float x) { return __int_as_float(__builtin_amdgcn_update_dpp(0, __float_as_int(x), CTRL, 0xf, 0xf, true)); }
__device__ __forceinline__ float red16(float x) { x += dppf<0xB1>(x); x += dppf<0x4E>(x); x += dppf<0x141>(x); x += dppf<0x140>(x); return x; }
__device__ __forceinline__ float wave_sum(float v) {
#pragma unroll
    for (int o = 1; o < 64; o <<= 1) v += __shfl_xor(v, o);
    return v;
}
#define XB_TMO      128
#define XB_XCNT(j)  (256  + 64 * (j))
#define XB_XSUB(j)  (1280 + 64 * (j))
#define XB_XGEN(j)  (2304 + 64 * (j))
#define XB_TOP      3328
#define XB_TOPGEN   3392
#define XCD_BAR_WORDS 3456
#define XB_SPIN_CAP (1u << 18)
#ifndef XB_SLEEP
#define XB_SLEEP 1
#endif

__device__ __forceinline__ unsigned xb_ld(unsigned* p)              { return __hip_atomic_load(p, __ATOMIC_RELAXED, __HIP_MEMORY_SCOPE_AGENT); }
__device__ __forceinline__ unsigned xb_add(unsigned* p, unsigned v) { return __hip_atomic_fetch_add(p, v, __ATOMIC_RELAXED, __HIP_MEMORY_SCOPE_AGENT); }
__device__ __forceinline__ unsigned xb_xcc_id() { return (unsigned)__builtin_amdgcn_s_getreg((3 << 11) | 20) & 0xFu; }
#define XB_SPIN(cond, bar) do { unsigned _sp = 0; while (cond) { __builtin_amdgcn_s_sleep(XB_SLEEP); \
    if ((++_sp & 255u) == 0u) { if (xb_ld(&(bar)[XB_TMO])) break; if (_sp > XB_SPIN_CAP) { atomicAdd(&(bar)[XB_TMO], 1u); break; } } } } while (0)

struct XcdBarrier {
    unsigned* bar; unsigned x;
    volatile LAS unsigned* st;
};

__device__ __forceinline__ XcdBarrier xcd_barrier_post(unsigned* bar, volatile LAS unsigned* st) {
    XcdBarrier b; b.bar = bar; b.x = xb_xcc_id(); b.st = st;
    if (threadIdx.x == 0) (void)xb_add(&bar[XB_XCNT(b.x)], 1u);
    return b;
}
__device__ __forceinline__ void xcd_barrier_complete(unsigned* bar, unsigned x, unsigned& nloc, unsigned& nx) {
    const unsigned G = gridDim.x * gridDim.y * gridDim.z;
    unsigned sum, cnt, mine, sp = 0u;
    for (;;) {
        sum = 0u; cnt = 0u; mine = 0u;
#pragma unroll
        for (unsigned j = 0; j < 16; ++j) { const unsigned c = xb_ld(&bar[XB_XCNT(j)]); sum += c; cnt += (c > 0u) ? 1u : 0u; mine = (j == x) ? c : mine; }
        if (sum == G) break;
        __builtin_amdgcn_s_sleep(1);
        if ((++sp & 255u) == 0u) { if (xb_ld(&bar[XB_TMO])) break; if (sp > XB_SPIN_CAP) { atomicAdd(&bar[XB_TMO], 1u); break; } }
    }
    nloc = mine > 0u ? mine : 1u; nx = cnt > 0u ? cnt : 1u;
}

__device__ __forceinline__ void xcd_barrier(const XcdBarrier& b) {
    asm volatile("s_waitcnt vmcnt(0)" ::: "memory");
    __syncthreads();
    if (threadIdx.x == 0) {
        unsigned* bar = b.bar;
        __builtin_amdgcn_s_waitcnt(0);
        unsigned nloc = b.st[0], nx = b.st[1];
        if (nloc == 0u) { xcd_barrier_complete(bar, b.x, nloc, nx); b.st[0] = nloc; b.st[1] = nx; }
        const unsigned old = xb_add(&bar[XB_XSUB(b.x)], 1u);
        const unsigned gen = old / nloc;
        if (old + 1u == (gen + 1u) * nloc) {
            __builtin_amdgcn_fence(__ATOMIC_RELEASE, "agent");
            asm volatile("s_waitcnt vmcnt(0)" ::: "memory");
            const unsigned og = xb_add(&bar[XB_TOP], 1u);
            const unsigned tg = og / nx;
            if (og + 1u == (tg + 1u) * nx) xb_add(&bar[XB_TOPGEN], 1u);
            else XB_SPIN(xb_ld(&bar[XB_TOPGEN]) == tg, bar);
            __builtin_amdgcn_fence(__ATOMIC_ACQUIRE, "agent");
            xb_add(&bar[XB_XGEN(b.x)], 1u);
            asm volatile("s_waitcnt vmcnt(0)" ::: "memory");
        } else {
            XB_SPIN(xb_ld(&bar[XB_XGEN(b.x)]) == gen, bar);
            __builtin_amdgcn_fence(__ATOMIC_ACQUIRE, "agent");
            asm volatile("s_waitcnt vmcnt(0)" ::: "memory");
        }
    }
    __syncthreads();
}
struct Ctx {
    LAS unsigned char* lds; int tid, lane, wave, vcu, G;
    const float* in[32]; float* out; unsigned char* ws;
};
#define WSP(T, off) ((T*)(F.ws + (off)))

__device__ __forceinline__ void p0_transpose_item(const float* W, int K, int N, bf16_t* WT, LAS float* scr, int item, int lane) {
    const int nblk = (N + 31) / 32, kb = item / nblk, nb = item % nblk, k0 = 64 * kb, n0 = 32 * nb;
    const int nn = n0 + (lane & 31);
#pragma unroll 8
    for (int i = 0; i < 32; ++i) { const int kk = 2 * i + (lane >> 5); scr[kk * 33 + (lane & 31)] = nn < N ? W[(size_t)(k0 + kk) * N + nn] : 0.f; }
    LDS_WAIT(); asm volatile("" ::: "memory");
    const int c = lane & 7;
#pragma unroll
    for (int j = 0; j < 4; ++j) { const int n = (lane >> 3) + 8 * j; const LAS float* s = scr + (8 * c) * 33 + n;
        u32x4 o; o.x = pk2(s[0 * 33], s[1 * 33]); o.y = pk2(s[2 * 33], s[3 * 33]); o.z = pk2(s[4 * 33], s[5 * 33]); o.w = pk2(s[6 * 33], s[7 * 33]);
        *(u32x4*)(WT + (size_t)(n0 + n) * K + k0 + 8 * c) = o; }
    LDS_WAIT(); asm volatile("" ::: "memory");
}
__device__ __forceinline__ void convert_uv_rows(const Ctx& F, int l, int r_lo, int r_hi, int widx, int nworkers) {
    float* SC = WSP(float, WS_SC) + (size_t)l * 2 * 16384;
    for (int r0 = r_lo + widx; r0 < r_hi; r0 += 4 * nworkers) {
        f32x4 v[4][4];
#pragma unroll
        for (int u = 0; u < 4; ++u) { const int r = r0 + u * nworkers < r_hi ? r0 + u * nworkers : r0; const int tb = r >> 14, row = r & 16383;
            const float* src = (tb ? F.in[31] : F.in[30]) + ((size_t)l * 16384 + row) * 1024 + F.lane * 16;
#pragma unroll
            for (int j = 0; j < 4; ++j) v[u][j] = *(const f32x4*)(src + 4 * j); }
#pragma unroll
        for (int u = 0; u < 4; ++u) { const int r = r0 + u * nworkers; if (r >= r_hi) break; const int tb = r >> 14, row = r & 16383;
            float am = 0.f;
#pragma unroll
            for (int j = 0; j < 4; ++j) am = fmaxf(am, fmaxf(fmaxf(fabsf(v[u][j][0]), fabsf(v[u][j][1])), fmaxf(fabsf(v[u][j][2]), fabsf(v[u][j][3]))));
#pragma unroll
            for (int o = 1; o < 64; o <<= 1) am = fmaxf(am, __shfl_xor(am, o));
            const float sc = am > 0.f ? 6.f / am : 1.f;
            unsigned ow[2] = {0u, 0u};
#pragma unroll
            for (int j = 0; j < 4; ++j) { unsigned w = ow[j >> 1];
                if (j & 1) { w = __builtin_amdgcn_cvt_scalef32_pk_fp4_f32(w, v[u][j][0] * sc, v[u][j][1] * sc, 1.0f, 2); w = __builtin_amdgcn_cvt_scalef32_pk_fp4_f32(w, v[u][j][2] * sc, v[u][j][3] * sc, 1.0f, 3); }
                else       { w = __builtin_amdgcn_cvt_scalef32_pk_fp4_f32(w, v[u][j][0] * sc, v[u][j][1] * sc, 1.0f, 0); w = __builtin_amdgcn_cvt_scalef32_pk_fp4_f32(w, v[u][j][2] * sc, v[u][j][3] * sc, 1.0f, 1); }
                ow[j >> 1] = w; }
            *(u32x2*)(F.ws + (tb ? WS_V : WS_U) + (size_t)l * UV_LSTRIDE + (size_t)row * 512 + F.lane * 8) = (u32x2){ow[0], ow[1]};
            if (F.lane == 0) SC[tb * 16384 + row] = am > 0.f ? am * (1.f / 6.f) : 1.f; }
    }
}
__device__ __forceinline__ void convert_uv(const Ctx& F, int l) { convert_uv_rows(F, l, 0, 2 * 16384, F.vcu * NWAVES + F.wave, F.G * NWAVES); }
__device__ __forceinline__ void phase_prologue(const Ctx& F) {
    float* MOD = WSP(float, WS_MOD);
    {
        LAS float* sl = (LAS float*)F.lds; LAS float* red = sl + 3072;
        for (int it = F.vcu; it < 192; it += F.G) {
            const int l = it / 96, n0 = (it % 96) * 64;
            for (int i = F.tid; i < 3072; i += NTHR) { const int s = i >> 10, k = i & 1023; const float c = s < 2 ? F.in[1][s * 1024 + k] : F.in[3][k]; sl[i] = c / (1.f + __expf(-c)); }
            __syncthreads();
            const int c = F.tid & 63, kg = F.tid >> 6;
            const float* W = F.in[4] + (size_t)l * 1024 * 6144 + n0 + c;
            float a0 = 0.f, a1 = 0.f, a2 = 0.f;
#pragma unroll 32
            for (int k = kg * 128; k < kg * 128 + 128; ++k) { const float w = W[(size_t)k * 6144]; a0 += sl[k] * w; a1 += sl[1024 + k] * w; a2 += sl[2048 + k] * w; }
            red[(kg * 3 + 0) * 64 + c] = a0; red[(kg * 3 + 1) * 64 + c] = a1; red[(kg * 3 + 2) * 64 + c] = a2;
            __syncthreads();
            if (F.tid < 192) { const int s = F.tid >> 6, cc = F.tid & 63; float t = F.in[5][l * 6144 + n0 + cc];
#pragma unroll
                for (int g = 0; g < 8; ++g) t += red[(g * 3 + s) * 64 + cc];
                MOD[(l * 3 + s) * 6144 + n0 + cc] = t; }
            __syncthreads();
        }
    }
    {
        LAS float* scr = (LAS float*)(F.lds + F.wave * 16384);
        const int gw = F.vcu * NWAVES + F.wave, NGW = F.G * NWAVES;
        constexpr int I_IN = 16 * 99, I_OUT = 16 * 32, I_L = I_IN + I_OUT;
        for (int it = gw; it < 2 * I_L; it += NGW) {
            const int l = it / I_L; int r = it % I_L;
            if (r < I_IN) p0_transpose_item(F.in[8] + (size_t)l * DM * DIN, DM, DIN, WSP(bf16_t, WS_WIN + l * WIN_LSTRIDE), scr, r, F.lane);
            else p0_transpose_item(F.in[9] + (size_t)l * DM * DM, DM, DM, WSP(bf16_t, WS_WOUT + l * WOUT_LSTRIDE), scr, r - I_IN, F.lane);
        }
        for (int i = F.vcu * NTHR + F.tid; i < 2 * 160 * 128; i += F.G * NTHR) { const int l = i / (160 * 128), r = i % (160 * 128);
            *(u32x4*)(WSP(bf16_t, WS_WIN + l * WIN_LSTRIDE) + (size_t)3168 * DM + (size_t)r * 8) = (u32x4){0u, 0u, 0u, 0u}; }
    }
    __syncthreads();
    {
        LAS float* KEYS = (LAS float*)F.lds; LAS float* WQl = KEYS + 128 * 129;
        const int nper = F.G / 32 > 0 ? F.G / 32 : 1;
        const int tile = F.vcu / nper, sub = F.vcu % nper;
        if (tile < 32) {
            const int l = tile >> 4, hh = tile & 15;
            const float* ksrc = F.in[29] + ((size_t)l * 16 + hh) * 128 * 128;
            { f32x4 kv[8];
#pragma unroll
              for (int q = 0; q < 8; ++q) kv[q] = *(const f32x4*)(ksrc + (size_t)(F.tid + q * NTHR) * 4);
#pragma unroll
              for (int q = 0; q < 8; ++q) { const int i = (F.tid + q * NTHR) * 4; LAS float* d = KEYS + (i >> 7) * 129 + (i & 127); d[0] = kv[q][0]; d[1] = kv[q][1]; d[2] = kv[q][2]; d[3] = kv[q][3]; } }
            for (int kb = sub; kb < 16; kb += nper) {
                const float* wsrc = F.in[28] + (size_t)l * DM * 2048 + (size_t)(kb * 64) * 2048 + hh * 128;
                __syncthreads();
                { f32x4 wv[4];
#pragma unroll
                  for (int q = 0; q < 4; ++q) { const int i = (F.tid + q * NTHR) * 4; wv[q] = *(const f32x4*)(wsrc + (size_t)(i >> 7) * 2048 + (i & 127)); }
#pragma unroll
                  for (int q = 0; q < 4; ++q) { const int i = (F.tid + q * NTHR) * 4, kk = i >> 7, d = i & 127; WQl[d * 68 + kk] = wv[q][0]; WQl[(d + 1) * 68 + kk] = wv[q][1]; WQl[(d + 2) * 68 + kk] = wv[q][2]; WQl[(d + 3) * 68 + kk] = wv[q][3]; } }
                __syncthreads();
                const int key = F.tid & 127, kq = F.tid >> 7;
                float acc[16];
#pragma unroll
                for (int j = 0; j < 16; ++j) acc[j] = 0.f;
#pragma unroll 4
                for (int d = 0; d < 128; ++d) { const float a = KEYS[key * 129 + d]; const LAS f32x4* wq = (const LAS f32x4*)(WQl + d * 68 + kq * 16);
#pragma unroll
                    for (int q = 0; q < 4; ++q) { const f32x4 w = wq[q]; acc[4 * q] += a * w[0]; acc[4 * q + 1] += a * w[1]; acc[4 * q + 2] += a * w[2]; acc[4 * q + 3] += a * w[3]; } }
                bf16_t* dst = WSP(bf16_t, WS_WEFF + l * WEFF_LSTRIDE) + (size_t)(hh * 128 + key) * DM + kb * 64 + kq * 16;
                u32x4 o0, o1; o0.x = pk2(acc[0], acc[1]); o0.y = pk2(acc[2], acc[3]); o0.z = pk2(acc[4], acc[5]); o0.w = pk2(acc[6], acc[7]);
                o1.x = pk2(acc[8], acc[9]); o1.y = pk2(acc[10], acc[11]); o1.z = pk2(acc[12], acc[13]); o1.w = pk2(acc[14], acc[15]);
                *(u32x4*)dst = o0; *(u32x4*)(dst + 8) = o1;
            }
        }
        __syncthreads();
    }
    convert_uv(F, 0); convert_uv(F, 1);
}

__device__ __forceinline__ void phase_norm(const Ctx& F, int l, int which, int nrows, const float* xlat, const float* xctx) {
    const float* gain = F.in[6 + which] + l * DM; const float* mod = WSP(float, WS_MOD) + (size_t)l * 3 * 6144;
    const int shoff = which ? 3072 : 0, scoff = which ? 4096 : 1024;
    bf16_t* H = WSP(bf16_t, WS_H);
    const int gw = F.vcu * NWAVES + F.wave, NGW = F.G * NWAVES;
    for (int row = gw; row < nrows; row += NGW) {
        const bool isc = row >= MLAT; const float* src = isc ? xctx + (size_t)(row - MLAT) * DM : xlat + (size_t)row * DM; const int smp = isc ? 2 : (row >> 13);
        const float* mb = mod + smp * 6144;
        f32x4 v[4]; float ss = 0.f;
#pragma unroll
        for (int j = 0; j < 4; ++j) { v[j] = *(const f32x4*)(src + F.lane * 4 + 256 * j); ss += (v[j][0] * v[j][0] + v[j][1] * v[j][1]) + (v[j][2] * v[j][2] + v[j][3] * v[j][3]); }
        const float rs = rsqrtf(wave_sum(ss) * (1.f / DM) + EPSN);
#pragma unroll
        for (int j = 0; j < 4; ++j) { const int c = F.lane * 4 + 256 * j; const f32x4 g = *(const f32x4*)(gain + c), sc = *(const f32x4*)(mb + scoff + c), sh = *(const f32x4*)(mb + shoff + c);
            const f32x4 o = (v[j] * rs * g) * (1.f + sc) + sh; st4bf(H + (size_t)row * DM + c, o); }
    }
}

__device__ __forceinline__ float log_sigmoid_(float x) { return fminf(x, 0.f) - __logf(1.f + __expf(-fabsf(x))); }
__device__ __forceinline__ void phase_prep(const Ctx& F, int l) {
    LAS float* W2s = (LAS float*)F.lds; LAS float* A2s = W2s + 8192; LAS float* G2s = A2s + 8192; LAS float* tsc = G2s + 8192 + F.wave * 64;
    { const float* w2 = F.in[13] + l * 8192; const float* a2 = F.in[15] + l * 8192; const float* g2 = F.in[16] + l * 8192;
      for (int i = F.tid; i < 8192; i += NTHR) { W2s[i] = w2[i]; A2s[i] = a2[i]; G2s[i] = g2[i]; } }
    __syncthreads();
    const bf16_t* P = WSP(bf16_t, WS_P); bf16_t* YC = WSP(bf16_t, WS_YCAT); bf16_t* QA = WSP(bf16_t, WS_QA); bf16_t* KA = WSP(bf16_t, WS_KA);
    unsigned char* RW = WSP(unsigned char, WS_RW); bf16_t* GB = WSP(bf16_t, WS_GB); float* BS = WSP(float, WS_BS); float* GA = WSP(float, WS_GA);
    const int lane = F.lane, c4 = lane * 4, i16 = lane & 15;
    const f32x4 cw0 = *(const f32x4*)(F.in[10] + l * 768 + c4), cw1 = *(const f32x4*)(F.in[10] + l * 768 + 256 + c4), cw2 = *(const f32x4*)(F.in[10] + l * 768 + 512 + c4);
    const f32x4 cg = *(const f32x4*)(F.in[11] + l * 256 + c4);
    const f32x4 qg = *(const f32x4*)(F.in[21] + l * 64 + (c4 & 63)), kg = *(const f32x4*)(F.in[22] + l * 64 + (c4 & 63));
    const f32x4 k_k = *(const f32x4*)(F.in[17] + l * 256 + c4), k_a = *(const f32x4*)(F.in[18] + l * 256 + c4), r_k = *(const f32x4*)(F.in[19] + l * 256 + c4);
    f32x4 w0[2], a0[2];
#pragma unroll
    for (int d = 0; d < 2; ++d) { w0[d] = *(const f32x4*)(F.in[12] + (l * 2 + d) * 256 + c4); a0[d] = *(const f32x4*)(F.in[14] + (l * 2 + d) * 256 + c4); }
    float invf[4];
#pragma unroll
    for (int j = 0; j < 4; ++j) invf[j] = exp2f(-(float)((c4 + j) & 15) * (13.287712379549449f / 16.f));
    const int gw = F.vcu * NWAVES + F.wave, NGW = F.G * NWAVES;
    struct PrepRaw { u32x2 h1, bg, c1, hp, cp, hn, cn, q, k, r, rk; unsigned xv, mg; };
#define PREP_LOAD(dst, row_) do { const int r_ = (row_); const bool isc_ = r_ >= MLAT; const int t_ = isc_ ? ((r_ - MLAT) & 255) : (r_ & 8191); const int T_ = isc_ ? TCTX : TLAT; \
        const bf16_t* pr_ = P + (size_t)r_ * DINP; const bf16_t* pp_ = t_ > 0 ? pr_ - DINP : pr_; const bf16_t* pn_ = t_ < T_ - 1 ? pr_ + DINP : pr_; \
        dst.h1 = *(const u32x2*)(pr_ + C_CH + c4); dst.bg = *(const u32x2*)(pr_ + C_CB + c4); dst.c1 = *(const u32x2*)(pr_ + C_CC + c4); \
        dst.hp = *(const u32x2*)(pp_ + C_CH + c4); dst.cp = *(const u32x2*)(pp_ + C_CC + c4); dst.hn = *(const u32x2*)(pn_ + C_CH + c4); dst.cn = *(const u32x2*)(pn_ + C_CC + c4); \
        dst.q = *(const u32x2*)(pr_ + C_AQ + c4); dst.k = *(const u32x2*)(pr_ + C_AK + (c4 & 127)); dst.r = *(const u32x2*)(pr_ + C_RR + c4); dst.rk = *(const u32x2*)(pr_ + C_RK + c4); \
        dst.xv = pr_[C_XW + lane]; dst.mg = pr_[C_MG + (lane & 15)]; } while (0)
#define UP4(w_) ((f32x4){lo2f((w_).x), hi2f((w_).x), lo2f((w_).y), hi2f((w_).y)})
    PrepRaw cur, nxt;
    if (gw < MALL) PREP_LOAD(cur, gw);
    for (int row = gw; row < MALL; row += NGW) {
        const bool isc = row >= MLAT; const int t = isc ? ((row - MLAT) & 255) : (row & 8191); const int T = isc ? TCTX : TLAT;
        { const int rn = row + NGW < MALL ? row + NGW : row; PREP_LOAD(nxt, rn); }
        {
            const f32x4 h1 = UP4(cur.h1), bg = UP4(cur.bg), c1 = UP4(cur.c1);
            f32x4 up = UP4(cur.hp) * UP4(cur.cp), un = UP4(cur.hn) * UP4(cur.cn);
            if (t == 0) up = (f32x4){0.f, 0.f, 0.f, 0.f};
            if (t == T - 1) un = (f32x4){0.f, 0.f, 0.f, 0.f};
            const f32x4 y = bg * (cw0 * up + cw1 * (c1 * h1) + cw2 * un);
            const float ss = red16((y[0] * y[0] + y[1] * y[1]) + (y[2] * y[2] + y[3] * y[3]));
            const float rs = rsqrtf(ss * (1.f / 64.f) + EPSN);
            st4bf(YC + (size_t)row * DM + c4, y * rs * cg * ZF(2));
        }
        {
            const f32x4 q = UP4(cur.q); const f32x4 k = UP4(cur.k);
            const float qs = red16((q[0] * q[0] + q[1] * q[1]) + (q[2] * q[2] + q[3] * q[3]));
            const float ks = red16((k[0] * k[0] + k[1] * k[1]) + (k[2] * k[2] + k[3] * k[3]));
            f32x4 qn = q * rsqrtf(qs * (1.f / 64.f) + EPSN) * qg, kn = k * rsqrtf(ks * (1.f / 64.f) + EPSN) * kg;
            if (!isc) {
                f32x4 qp, kp;
#pragma unroll
                for (int j = 0; j < 4; ++j) { qp[j] = __shfl_xor(qn[j], 4); kp[j] = __shfl_xor(kn[j], 4); }
                const int d0 = c4 & 63; const float pos = (d0 < 32) ? (float)(t >> 6) : (float)(t & 63); const bool lowh = (d0 & 16) == 0;
#pragma unroll
                for (int j = 0; j < 4; ++j) { const float th = pos * invf[j]; const float cs = __cosf(th), sn = __sinf(th);
                    qn[j] = lowh ? qn[j] * cs - qp[j] * sn : qn[j] * cs + qp[j] * sn; kn[j] = lowh ? kn[j] * cs - kp[j] * sn : kn[j] * cs + kp[j] * sn; }
            }
            st4bf(QA + (size_t)row * 256 + c4, qn * (0.125f * 1.4426950408889634f));
            if (lane < 32) st4bf(KA + (size_t)row * 128 + c4, kn);
        }
        {
            const f32x4 r = UP4(cur.r), k = UP4(cur.rk);
            { const float xv = bf2f((bf16_t)cur.xv);
              tsc[lane] = lane < 16 ? tanhf_(xv) : (lane < 32 ? xv : sigmoidf_(xv)); }
            const f32x4 kx = k * k_k;
            const float kss = red16((kx[0] * kx[0] + kx[1] * kx[1]) + (kx[2] * kx[2] + kx[3] * kx[3]));
            const f32x4 kk = kx * rsqrtf(kss + EPSN);
            bf16_t* recb = (bf16_t*)(RW + (size_t)row * RWREC); float* recf = (float*)(RW + (size_t)row * RWREC + 2560);
            st4bf(recb + c4, kk);
            f32x4 kdsum = {0.f, 0.f, 0.f, 0.f};
#pragma unroll
            for (int d = 0; d < 2; ++d) {
                f32x4 dw = w0[d], da = a0[d];
#pragma unroll 4
                for (int ii = 0; ii < 16; ++ii) { dw += tsc[ii] * *(const LAS f32x4*)(W2s + (d * 16 + ii) * 256 + c4); da += tsc[16 + ii] * *(const LAS f32x4*)(A2s + (d * 16 + ii) * 256 + c4); }
                f32x4 dec, av;
#pragma unroll
                for (int j = 0; j < 4; ++j) { dec[j] = -0.6065306597126334f * sigmoidf_(dw[j]); av[j] = sigmoidf_(da[j]); }
                const f32x4 kd = k * (1.f + (av - 1.f) * k_a);
                kdsum += kd;
                st4bf(recb + 256 + d * 256 + c4, kk * av);
                st4bf(recb + 768 + d * 256 + c4, kd);
                *(f32x4*)(recf + d * 256 + c4) = dec;
            }
            f32x4 gv = {0.f, 0.f, 0.f, 0.f};
#pragma unroll 4
            for (int ii = 0; ii < 32; ++ii) gv += tsc[32 + ii] * *(const LAS f32x4*)(G2s + ii * 256 + c4);
            st4bf(GB + (size_t)row * 256 + c4, gv);
            const f32x4 bt = r * kdsum * r_k;
            const float bsum = red16((bt[0] + bt[1]) + (bt[2] + bt[3]));
            if (i16 == 0) BS[(size_t)row * 4 + (lane >> 4)] = bsum;
        }
        if (lane < 16) { const int dir = lane >> 3, gate = (lane >> 2) & 1, hd = lane & 3; const float x = bf2f((bf16_t)cur.mg);
            const float bias = gate ? F.in[26][(l * 2 + dir) * 4 + hd] : F.in[25][(l * 2 + dir) * 4 + hd];
            GA[(size_t)row * 16 + lane] = gate ? log_sigmoid_(x + bias) : (x + bias); }
        cur = nxt;
    }
#undef PREP_LOAD
#undef UP4
}
__device__ __forceinline__ int scan_row(int b, int dir, int i) {
    if (i < TCTX) return MLAT + b * TCTX + (dir ? (TCTX - 1 - i) : i);
    const int p = i - TCTX; return b * TLAT + (dir ? (TLAT - 1 - p) : p);
}
__device__ __forceinline__ void rwkv_scan(const Ctx& F, int blk) {
    const int chain = blk >> 2, quarter = blk & 3, b = chain >> 3, head = (chain >> 1) & 3, dir = chain & 1;
    const bool scanner = F.wave < 4;
    const int rowv = (quarter * 4 + (F.wave & 3)) * 4 + (F.lane >> 4), s = F.lane & 15;
    LAS float* buf = (LAS float*)F.lds;
    const bf16_t* P = WSP(bf16_t, WS_P); const unsigned char* RW = WSP(unsigned char, WS_RW); float* YR = WSP(float, WS_YR) + (size_t)dir * MALL * 256;
    const int st = F.tid >> 4, sub = F.tid & 15;
    constexpr int NSTEP = TCTX + TLAT, NCH = NSTEP / 32;
    u32x2 g_kk, g_al, g_kd, g_r, g_v; f32x4 g_w;
#define RW_LOAD(c) do { const int row_ = scan_row(b, dir, (c) * 32 + st); const bf16_t* rb_ = (const bf16_t*)(RW + (size_t)row_ * RWREC) + head * 64 + sub * 4; \
        g_kk = *(const u32x2*)rb_; g_al = *(const u32x2*)(rb_ + 256 + dir * 256); g_kd = *(const u32x2*)(rb_ + 768 + dir * 256); \
        g_w = *(const f32x4*)((const float*)(RW + (size_t)row_ * RWREC + 2560) + dir * 256 + head * 64 + sub * 4); \
        const bf16_t* pp_ = P + (size_t)row_ * DINP + head * 64 + sub * 4; g_r = *(const u32x2*)(pp_ + C_RR); g_v = *(const u32x2*)(pp_ + C_RV); } while (0)
#define RW_STORE(par) do { LAS float* d_ = buf + ((par) * 32 + st) * 384 + sub * 4; \
        *(LAS f32x4*)(d_) = (f32x4){lo2f(g_kk.x), hi2f(g_kk.x), lo2f(g_kk.y), hi2f(g_kk.y)}; *(LAS f32x4*)(d_ + 64) = (f32x4){lo2f(g_al.x), hi2f(g_al.x), lo2f(g_al.y), hi2f(g_al.y)}; \
        *(LAS f32x4*)(d_ + 128) = (f32x4){lo2f(g_kd.x), hi2f(g_kd.x), lo2f(g_kd.y), hi2f(g_kd.y)}; *(LAS f32x4*)(d_ + 192) = g_w; \
        *(LAS f32x4*)(d_ + 256) = (f32x4){lo2f(g_r.x), hi2f(g_r.x), lo2f(g_r.y), hi2f(g_r.y)}; *(LAS f32x4*)(d_ + 320) = (f32x4){lo2f(g_v.x), hi2f(g_v.x), lo2f(g_v.y), hi2f(g_v.y)}; } while (0)
    f32x4 S = {0.f, 0.f, 0.f, 0.f};
    RW_LOAD(0); RW_STORE(0); __syncthreads();
    for (int c = 0; c < NCH; ++c) {
        const int par = c & 1;
        if (c + 1 < NCH) RW_LOAD(c + 1);
        if (scanner) {
        float ykeep = 0.f;
        f32x4 Lkk[3], Lal[3], Lkd[3], Lw[3], Lr[3]; float Lv[3];
#define SC_LD(set, i_) do { const LAS float* d_ = buf + (par * 32 + (i_)) * 384; Lkk[set] = *(const LAS f32x4*)(d_ + s * 4); Lal[set] = *(const LAS f32x4*)(d_ + 64 + s * 4); \
            Lkd[set] = *(const LAS f32x4*)(d_ + 128 + s * 4); Lw[set] = *(const LAS f32x4*)(d_ + 192 + s * 4); Lr[set] = *(const LAS f32x4*)(d_ + 256 + s * 4); Lv[set] = d_[320 + rowv]; } while (0)
        SC_LD(0, 0); SC_LD(1, 1);
#pragma unroll
        for (int i = 0; i < 32; ++i) {
            if (i + 2 < 32) SC_LD((i + 2) % 3, i + 2);
            const f32x4 kk = Lkk[i % 3], al = Lal[i % 3], kd = Lkd[i % 3], w = Lw[i % 3], r = Lr[i % 3]; const float vr = Lv[i % 3];
            const float sa = red16((S[0] * kk[0] + S[1] * kk[1]) + (S[2] * kk[2] + S[3] * kk[3]));
            S = S * w + (vr * kd - sa * al);
            const float y = red16((S[0] * r[0] + S[1] * r[1]) + (S[2] * r[2] + S[3] * r[3]));
            ykeep = (s == (i & 15)) ? y : ykeep;
            if ((i & 15) == 15) {
                const int stp = c * 32 + (i - 15) + s; const int pc = dir ? (TCTX - 1 - stp) : stp, pl = dir ? (TLAT - 1 - (stp - TCTX)) : (stp - TCTX);
                const int row = stp < TCTX ? (MLAT + b * TCTX + pc) : (b * TLAT + pl);
                YR[(size_t)row * 256 + head * 64 + rowv] = ykeep; }
        }
#undef SC_LD
        }
        if (c + 1 < NCH) RW_STORE(par ^ 1);
        __syncthreads();
    }
#undef RW_LOAD
#undef RW_STORE
}

typedef union { u32x4 u; bf16x8 b; } frag_u;
__device__ __forceinline__ void attn_unit(const Ctx& F, int l, int unit) {
    LAS bf16_t* Kl = (LAS bf16_t*)F.lds; LAS bf16_t* Vt = Kl + 64 * 72;
    const bf16_t* P = WSP(bf16_t, WS_P); const bf16_t* QA = WSP(bf16_t, WS_QA); const bf16_t* KA = WSP(bf16_t, WS_KA); bf16_t* YC = WSP(bf16_t, WS_YCAT);
    const bool isc = unit >= 256; int b, kvh, n;
    if (!isc) { b = unit >> 7; kvh = (unit >> 6) & 1; n = unit & 63; } else { const int u = unit - 256; b = u >> 2; kvh = (u >> 1) & 1; n = u & 1; }
    const int g = F.wave >> 2, ps = F.wave & 3, head = kvh * 2 + g, i = F.lane & 15, gq = F.lane >> 4;
    const int qpos0 = n * 128 + ps * 32, qrow0 = (isc ? MLAT + b * TCTX : b * TLAT) + qpos0;
    bf16x8 Qf[2][2];
#pragma unroll
    for (int qb = 0; qb < 2; ++qb)
#pragma unroll
        for (int ks = 0; ks < 2; ++ks) Qf[qb][ks] = *(const bf16x8*)(QA + (size_t)(qrow0 + qb * 16 + i) * 256 + head * 64 + ks * 32 + gq * 8);
    const float sinkl = F.in[23][l * 4 + head] * 1.4426950408889634f;
    float mrun[2] = {sinkl, sinkl}, lsum[2]; lsum[0] = lsum[1] = (gq == 0) ? 1.f : 0.f;
    f32x4 ao[4][2];
#pragma unroll
    for (int db = 0; db < 4; ++db) { ao[db][0] = (f32x4){0.f, 0.f, 0.f, 0.f}; ao[db][1] = (f32x4){0.f, 0.f, 0.f, 0.f}; }
    const int ntl = isc ? 4 : 10;
    const int skey = F.tid >> 3, sch = F.tid & 7;
#define ATT_KROW(tt_) ((!isc && (tt_) < 6) ? ((2 * (n - 1) + (tt_) < 0 || 2 * (n - 1) + (tt_) >= 128) ? -1 : b * TLAT + (2 * (n - 1) + (tt_)) * 64) : MLAT + b * TCTX + (isc ? (tt_) : (tt_) - 6) * 64)
#define ATT_LOAD(tt_) do { const int kr_ = ATT_KROW(tt_); if (kr_ >= 0) { pk_kv = *(const u32x4*)(KA + (size_t)(kr_ + skey) * 128 + kvh * 64 + sch * 8); pk_vv = *(const u32x4*)(P + (size_t)(kr_ + skey) * DINP + C_AV + kvh * 64 + sch * 8); } } while (0)
    u32x4 pk_kv = {0u, 0u, 0u, 0u}, pk_vv = {0u, 0u, 0u, 0u};
    int tt0 = 0; while (tt0 < ntl && ATT_KROW(tt0) < 0) ++tt0;
    ATT_LOAD(tt0);
    for (int tt = tt0; tt < ntl; ++tt) {
        const int krow0 = ATT_KROW(tt); if (krow0 < 0) continue;
        const bool band = !isc && tt < 6; const int kpos0 = band ? (2 * (n - 1) + tt) * 64 : 0;
        LDS_BARRIER();
        { const u32x4 kv = pk_kv, vv = pk_vv;
          *(LAS u32x4*)(Kl + skey * 72 + sch * 8) = kv;
          const unsigned ww[4] = {vv.x, vv.y, vv.z, vv.w};
#pragma unroll
          for (int j = 0; j < 4; ++j) { Vt[(sch * 8 + 2 * j) * 72 + skey] = (bf16_t)(ww[j] & 0xffffu); Vt[(sch * 8 + 2 * j + 1) * 72 + skey] = (bf16_t)(ww[j] >> 16); } }
        { int tn = tt + 1; while (tn < ntl && ATT_KROW(tn) < 0) ++tn; if (tn < ntl) ATT_LOAD(tn); }
        LDS_BARRIER();
        f32x4 sc[4][2];
#pragma unroll
        for (int kb = 0; kb < 4; ++kb) {
            sc[kb][0] = (f32x4){0.f, 0.f, 0.f, 0.f}; sc[kb][1] = (f32x4){0.f, 0.f, 0.f, 0.f};
#pragma unroll
            for (int ks = 0; ks < 2; ++ks) { const bf16x8 kf = *(const LAS bf16x8*)(Kl + (kb * 16 + i) * 72 + ks * 32 + gq * 8);
                sc[kb][0] = __builtin_amdgcn_mfma_f32_16x16x32_bf16(kf, Qf[0][ks], sc[kb][0], 0, 0, 0);
                sc[kb][1] = __builtin_amdgcn_mfma_f32_16x16x32_bf16(kf, Qf[1][ks], sc[kb][1], 0, 0, 0); }
        }
#pragma unroll
        for (int qb = 0; qb < 2; ++qb) {
            const int qp = qpos0 + qb * 16 + i;
            float mx = -1e30f;
#pragma unroll
            for (int kb = 0; kb < 4; ++kb)
#pragma unroll
                for (int r = 0; r < 4; ++r) { if (band) { const int dd = (kpos0 + kb * 16 + 4 * gq + r) - qp; if (dd > 128 || dd < -128) sc[kb][qb][r] = -1e30f; } mx = fmaxf(mx, sc[kb][qb][r]); }
            mx = fmaxf(mx, __shfl_xor(mx, 16)); mx = fmaxf(mx, __shfl_xor(mx, 32));
            const float mnew = fmaxf(mrun[qb], mx), alpha = exp2f(mrun[qb] - mnew); mrun[qb] = mnew;
            float ps_ = 0.f;
#pragma unroll
            for (int kb = 0; kb < 4; ++kb)
#pragma unroll
                for (int r = 0; r < 4; ++r) { const float p = exp2f(sc[kb][qb][r] - mnew); sc[kb][qb][r] = p; ps_ += p; }
            lsum[qb] = lsum[qb] * alpha + ps_;
#pragma unroll
            for (int db = 0; db < 4; ++db) ao[db][qb] *= alpha;
        }
#pragma unroll
        for (int ks2 = 0; ks2 < 2; ++ks2) {
            frag_u pf[2];
#pragma unroll
            for (int qb = 0; qb < 2; ++qb) { pf[qb].u.x = pg8::cvt_pk_bf16(sc[2 * ks2][qb][0], sc[2 * ks2][qb][1]); pf[qb].u.y = pg8::cvt_pk_bf16(sc[2 * ks2][qb][2], sc[2 * ks2][qb][3]);
                pf[qb].u.z = pg8::cvt_pk_bf16(sc[2 * ks2 + 1][qb][0], sc[2 * ks2 + 1][qb][1]); pf[qb].u.w = pg8::cvt_pk_bf16(sc[2 * ks2 + 1][qb][2], sc[2 * ks2 + 1][qb][3]); }
#pragma unroll
            for (int db = 0; db < 4; ++db) { frag_u vf; const LAS bf16_t* vp = Vt + (db * 16 + i) * 72 + (2 * ks2) * 16 + 4 * gq;
                const u32x2 v0 = *(const LAS u32x2*)vp, v1 = *(const LAS u32x2*)(vp + 16); vf.u = (u32x4){v0.x, v0.y, v1.x, v1.y};
                ao[db][0] = __builtin_amdgcn_mfma_f32_16x16x32_bf16(vf.b, pf[0].b, ao[db][0], 0, 0, 0);
                ao[db][1] = __builtin_amdgcn_mfma_f32_16x16x32_bf16(vf.b, pf[1].b, ao[db][1], 0, 0, 0); }
        }
    }
#undef ATT_KROW
#undef ATT_LOAD
    const float* og = F.in[24] + l * 256 + head * 64;
#pragma unroll
    for (int qb = 0; qb < 2; ++qb) {
        float lt = lsum[qb]; lt += __shfl_xor(lt, 16); lt += __shfl_xor(lt, 32);
        const float il = 1.f / lt; float ss = 0.f;
#pragma unroll
        for (int db = 0; db < 4; ++db) { ao[db][qb] *= il; ss += (ao[db][qb][0] * ao[db][qb][0] + ao[db][qb][1] * ao[db][qb][1]) + (ao[db][qb][2] * ao[db][qb][2] + ao[db][qb][3] * ao[db][qb][3]); }
        ss += __shfl_xor(ss, 16); ss += __shfl_xor(ss, 32);
        const float rs = rsqrtf(ss * (1.f / 64.f) + EPSN);
        bf16_t* yo = YC + (size_t)(qrow0 + qb * 16 + i) * DM + 512 + head * 64;
#pragma unroll
        for (int db = 0; db < 4; ++db) { const f32x4 gg = *(const f32x4*)(og + db * 16 + 4 * gq); st4bf(yo + db * 16 + 4 * gq, ao[db][qb] * rs * gg * ZF(8)); }
    }
    __syncthreads();
}

__device__ __forceinline__ int ml_row(int b, int dir, int j, int tp) {
    if (j < 2) { const int p = j * 128 + tp; return MLAT + b * TCTX + (dir ? (TCTX - 1 - p) : p); }
    const int p = (j - 2) * 128 + tp; return b * TLAT + (dir ? (TLAT - 1 - p) : p);
}
__device__ __forceinline__ void scan128_add(float& x0, float& x1, int lane) {
    x1 += x0; float t = x1;
#pragma unroll
    for (int o = 1; o < 64; o <<= 1) { const float u = __shfl_up(t, o); if (lane >= o) t += u; }
    const float ex = t - x1; x0 += ex; x1 = t;
}
__device__ __forceinline__ void scan128_max(float& x0, float& x1, int lane) {
    x1 = fmaxf(x1, x0); float t = x1;
#pragma unroll
    for (int o = 1; o < 64; o <<= 1) { const float u = __shfl_up(t, o); if (lane >= o) t = fmaxf(t, u); }
    const float pv = __shfl_up(t, 1); if (lane > 0) x0 = fmaxf(x0, pv); x1 = t;
}
__device__ __forceinline__ void ml_stage_T(const Ctx& F, const bf16_t* P, int b, int dir, int j, int col0, LAS bf16_t* dst, const LAS float* sw, float cscale) {
#pragma unroll
    for (int it = 0; it < 2; ++it) { const int id = F.tid + it * NTHR, tp = id >> 3, ch = id & 7;
        const u32x4 v = *(const u32x4*)(P + (size_t)ml_row(b, dir, j, tp) * DINP + col0 + ch * 8); const float s = (sw ? sw[tp] : 1.f) * cscale;
        const unsigned ww[4] = {v.x, v.y, v.z, v.w};
#pragma unroll
        for (int q = 0; q < 4; ++q) { dst[(ch * 8 + 2 * q) * 136 + tp] = (bf16_t)f2bf(lo2f(ww[q]) * s); dst[(ch * 8 + 2 * q + 1) * 136 + tp] = (bf16_t)f2bf(hi2f(ww[q]) * s); } }
}
__device__ __forceinline__ void ml_stage_R(const Ctx& F, const bf16_t* P, int b, int dir, int j, int col0, LAS bf16_t* dst, float cscale) {
#pragma unroll
    for (int it = 0; it < 2; ++it) { const int id = F.tid + it * NTHR, tp = id >> 3, ch = id & 7;
        u32x4 v = *(const u32x4*)(P + (size_t)ml_row(b, dir, j, tp) * DINP + col0 + ch * 8);
        if (cscale != 1.f) { v.x = pk2(lo2f(v.x) * cscale, hi2f(v.x) * cscale); v.y = pk2(lo2f(v.y) * cscale, hi2f(v.y) * cscale); v.z = pk2(lo2f(v.z) * cscale, hi2f(v.z) * cscale); v.w = pk2(lo2f(v.w) * cscale, hi2f(v.w) * cscale); }
        *(LAS u32x4*)(dst + tp * 72 + ch * 8) = v; }
}
__device__ __forceinline__ void mlstm_local(const Ctx& F, int task) {
    const int chain = task / NCHK, j = task % NCHK, b = chain >> 3, head = (chain >> 1) & 3, dir = chain & 1;
    const bf16_t* P = WSP(bf16_t, WS_P); const float* GA = WSP(float, WS_GA);
    LAS bf16_t* Vt = (LAS bf16_t*)F.lds; LAS bf16_t* Kt = Vt + 64 * 136; LAS float* wS = (LAS float*)(Kt + 64 * 136); LAS float* sc2 = wS + 128;
    __syncthreads();
    if (F.wave == 0) {
        const int r0 = ml_row(b, dir, j, 2 * F.lane), r1 = ml_row(b, dir, j, 2 * F.lane + 1);
        const float li0 = GA[(size_t)r0 * 16 + dir * 8 + head], li1 = GA[(size_t)r1 * 16 + dir * 8 + head];
        float b0 = GA[(size_t)r0 * 16 + dir * 8 + 4 + head], b1 = GA[(size_t)r1 * 16 + dir * 8 + 4 + head];
        scan128_add(b0, b1, F.lane);
        const float bend = __shfl(b1, 63);
        const float d0 = bend - b0 + li0, d1 = bend - b1 + li1;
        float mx = fmaxf(d0, d1);
#pragma unroll
        for (int o = 1; o < 64; o <<= 1) mx = fmaxf(mx, __shfl_xor(mx, o));
        wS[2 * F.lane] = __expf(d0 - mx); wS[2 * F.lane + 1] = __expf(d1 - mx);
        if (F.lane == 0) { sc2[0] = mx; sc2[1] = bend; }
    }
    __syncthreads();
    ml_stage_T(F, P, b, dir, j, C_MV + head * 64, Vt, wS, 1.f);
    ml_stage_T(F, P, b, dir, j, C_MK + head * 64, Kt, nullptr, 0.125f);
    __syncthreads();
    float* LC = WSP(float, WS_LC) + (size_t)task * CST;
    { const int vb = F.wave >> 1, i = F.lane & 15, gq = F.lane >> 4;
#pragma unroll
      for (int kk2 = 0; kk2 < 2; ++kk2) { const int kb = 2 * (F.wave & 1) + kk2; f32x4 acc = {0.f, 0.f, 0.f, 0.f};
#pragma unroll
          for (int ks = 0; ks < 4; ++ks) { const bf16x8 a = *(const LAS bf16x8*)(Vt + (vb * 16 + i) * 136 + ks * 32 + gq * 8), bb = *(const LAS bf16x8*)(Kt + (kb * 16 + i) * 136 + ks * 32 + gq * 8);
              acc = __builtin_amdgcn_mfma_f32_16x16x32_bf16(a, bb, acc, 0, 0, 0); }
#pragma unroll
          for (int r = 0; r < 4; ++r) LC[(vb * 16 + 4 * gq + r) * 64 + kb * 16 + i] = acc[r]; } }
    if (F.tid < 64) { float a = 0.f;
#pragma unroll 8
        for (int s = 0; s < 128; ++s) a += wS[s] * bf2f(Kt[F.tid * 136 + s]);
        LC[4096 + F.tid] = a; }
    if (F.tid == 0) { float* LB = WSP(float, WS_LB); LB[task * 2] = sc2[0]; LB[task * 2 + 1] = sc2[1]; }
}
__device__ __forceinline__ void mlstm_chain(const Ctx& F, int blk0) {
    const int gt = (F.vcu - blk0) * NTHR + F.tid; if (gt < 0 || gt >= 16 * CST) return;
    const int chain = gt / CST, e = gt % CST;
    const float* LC = WSP(float, WS_LC) + (size_t)chain * NCHK * CST + e; float* ST = WSP(float, WS_ST) + (size_t)chain * NCHK * CST + e;
    const float* LB = WSP(float, WS_LB) + chain * NCHK * 2; float* SM = WSP(float, WS_LB) + 4096 + chain * NCHK;
    float m = 0.f, x = 0.f;
#pragma unroll 1
    for (int g = 0; g < 3; ++g) {
        float d[22], Lv[22], Bv[22];
#pragma unroll
        for (int q = 0; q < 22; ++q) { const int j = g * 22 + q; d[q] = LC[(size_t)j * CST]; Lv[q] = LB[2 * j]; Bv[q] = LB[2 * j + 1]; }
#pragma unroll
        for (int q = 0; q < 22; ++q) { const int j = g * 22 + q;
            ST[(size_t)j * CST] = x; if (e == 0) SM[j] = m;
            const float mn = fmaxf(Bv[q] + m, Lv[q]);
            x = __expf(Bv[q] + m - mn) * x + __expf(Lv[q] - mn) * d[q]; m = mn; }
    }
}
__device__ __forceinline__ void mlstm_out(const Ctx& F, int l, int unit) {
    const bool isc = unit >= 512; int b, chunk, head;
    if (!isc) { b = unit >> 8; chunk = (unit >> 2) & 63; head = unit & 3; } else { const int u = unit - 512; b = u >> 3; chunk = (u >> 2) & 1; head = u & 3; }
    const bf16_t* P = WSP(bf16_t, WS_P); const float* GA = WSP(float, WS_GA); bf16_t* YC = WSP(bf16_t, WS_YCAT);
    LAS bf16_t* Ql = (LAS bf16_t*)F.lds; LAS bf16_t* Kl = Ql + 128 * 72; LAS bf16_t* Vt = Kl + 128 * 72; LAS bf16_t* Cb = Vt + 64 * 136;
    LAS float* nS = (LAS float*)(Cb + 64 * 72); LAS float* aS = nS + 64; LAS float* bS = aS + 128; LAS float* MS = bS + 128; LAS float* Hs = MS + 128;
    const int i = F.lane & 15, gq = F.lane >> 4, w = F.wave;
    for (int dir = 0; dir < 2; ++dir) {
        const int j = isc ? (dir ? 1 - chunk : chunk) : 2 + (dir ? 63 - chunk : chunk);
        const int chain = (b * 4 + head) * 2 + dir;
        const float* ST = WSP(float, WS_ST) + ((size_t)chain * NCHK + j) * CST; const float mprev = WSP(float, WS_LB)[4096 + chain * NCHK + j];
        __syncthreads();
        if (w == 0) {
            const int r0 = ml_row(b, dir, j, 2 * F.lane), r1 = ml_row(b, dir, j, 2 * F.lane + 1);
            const float li0 = GA[(size_t)r0 * 16 + dir * 8 + head], li1 = GA[(size_t)r1 * 16 + dir * 8 + head];
            float b0 = GA[(size_t)r0 * 16 + dir * 8 + 4 + head], b1 = GA[(size_t)r1 * 16 + dir * 8 + 4 + head];
            scan128_add(b0, b1, F.lane);
            const float a0 = li0 - b0, a1 = li1 - b1; float A0 = a0, A1 = a1;
            scan128_max(A0, A1, F.lane);
            aS[2 * F.lane] = a0; aS[2 * F.lane + 1] = a1; bS[2 * F.lane] = b0; bS[2 * F.lane + 1] = b1;
            MS[2 * F.lane] = fmaxf(A0, mprev); MS[2 * F.lane + 1] = fmaxf(A1, mprev);
        }
        ml_stage_R(F, P, b, dir, j, C_MQ + head * 64, Ql, 1.f);
        ml_stage_R(F, P, b, dir, j, C_MK + head * 64, Kl, 0.125f);
        ml_stage_T(F, P, b, dir, j, C_MV + head * 64, Vt, nullptr, 1.f);
        { const f32x4 c0 = *(const f32x4*)(ST + F.tid * 8), c1 = *(const f32x4*)(ST + F.tid * 8 + 4); const int v = F.tid >> 3, k0 = (F.tid & 7) * 8;
          u32x4 o; o.x = pk2(c0[0], c0[1]); o.y = pk2(c0[2], c0[3]); o.z = pk2(c1[0], c1[1]); o.w = pk2(c1[2], c1[3]); *(LAS u32x4*)(Cb + v * 72 + k0) = o;
          if (F.tid < 64) nS[F.tid] = ST[4096 + F.tid]; }
        __syncthreads();
        const int t = 16 * w + i; const float Mt = MS[t], bt = bS[t];
        bf16x8 Qf[2];
#pragma unroll
        for (int ks = 0; ks < 2; ++ks) Qf[ks] = *(const LAS bf16x8*)(Ql + t * 72 + ks * 32 + gq * 8);
        f32x4 sc[8];
#pragma unroll
        for (int sb = 0; sb < 8; ++sb) { sc[sb] = (f32x4){0.f, 0.f, 0.f, 0.f};
            if (sb <= w) {
#pragma unroll
                for (int ks = 0; ks < 2; ++ks) { const bf16x8 kf = *(const LAS bf16x8*)(Kl + (sb * 16 + i) * 72 + ks * 32 + gq * 8); sc[sb] = __builtin_amdgcn_mfma_f32_16x16x32_bf16(kf, Qf[ks], sc[sb], 0, 0, 0); }
#pragma unroll
                for (int r = 0; r < 4; ++r) { const int s = sb * 16 + 4 * gq + r; sc[sb][r] = (s <= t) ? sc[sb][r] * __expf(aS[s] - Mt) : 0.f; }
            } }
        float den = 0.f;
#pragma unroll
        for (int sb = 0; sb < 8; ++sb) den += (sc[sb][0] + sc[sb][1]) + (sc[sb][2] + sc[sb][3]);
        den += __shfl_xor(den, 16); den += __shfl_xor(den, 32);
        f32x4 nm[4], it_[4];
#pragma unroll
        for (int vb = 0; vb < 4; ++vb) { nm[vb] = (f32x4){0.f, 0.f, 0.f, 0.f}; it_[vb] = (f32x4){0.f, 0.f, 0.f, 0.f}; }
#pragma unroll
        for (int ks2 = 0; ks2 < 4; ++ks2) if (2 * ks2 <= w) {
            frag_u pf; pf.u.x = pg8::cvt_pk_bf16(sc[2 * ks2][0], sc[2 * ks2][1]); pf.u.y = pg8::cvt_pk_bf16(sc[2 * ks2][2], sc[2 * ks2][3]);
            pf.u.z = pg8::cvt_pk_bf16(sc[2 * ks2 + 1][0], sc[2 * ks2 + 1][1]); pf.u.w = pg8::cvt_pk_bf16(sc[2 * ks2 + 1][2], sc[2 * ks2 + 1][3]);
#pragma unroll
            for (int vb = 0; vb < 4; ++vb) { frag_u vf; const LAS bf16_t* vp = Vt + (vb * 16 + i) * 136 + (2 * ks2) * 16 + 4 * gq;
                const u32x2 v0 = *(const LAS u32x2*)vp, v1 = *(const LAS u32x2*)(vp + 16); vf.u = (u32x4){v0.x, v0.y, v1.x, v1.y};
                nm[vb] = __builtin_amdgcn_mfma_f32_16x16x32_bf16(vf.b, pf.b, nm[vb], 0, 0, 0); }
        }
#pragma unroll
        for (int vb = 0; vb < 4; ++vb)
#pragma unroll
            for (int ks = 0; ks < 2; ++ks) { const bf16x8 cf = *(const LAS bf16x8*)(Cb + (vb * 16 + i) * 72 + ks * 32 + gq * 8); it_[vb] = __builtin_amdgcn_mfma_f32_16x16x32_bf16(cf, Qf[ks], it_[vb], 0, 0, 0); }
        float nq = 0.f;
#pragma unroll
        for (int c = 0; c < 2; ++c) { const u32x4 qv = *(const LAS u32x4*)(Ql + t * 72 + gq * 16 + c * 8); const unsigned ww[4] = {qv.x, qv.y, qv.z, qv.w};
#pragma unroll
            for (int q = 0; q < 4; ++q) nq += nS[gq * 16 + c * 8 + 2 * q] * lo2f(ww[q]) + nS[gq * 16 + c * 8 + 2 * q + 1] * hi2f(ww[q]); }
        nq += __shfl_xor(nq, 16); nq += __shfl_xor(nq, 32);
        const float wint = __expf(mprev - Mt); den += wint * nq;
        const float dn = 1.f / fmaxf(fabsf(den), __expf(-(bt + Mt)));
        const int torig = dir ? 127 - t : t;
#pragma unroll
        for (int vb = 0; vb < 4; ++vb)
#pragma unroll
            for (int r = 0; r < 4; ++r) { const float hv = (nm[vb][r] + wint * it_[vb][r]) * dn; LAS float* hp = Hs + torig * 65 + vb * 16 + 4 * gq + r; if (dir == 0) *hp = hv; else *hp += hv; }
    }
    __syncthreads();
    {
        const int t = F.tid >> 2, vq = F.tid & 3; const int row = (isc ? MLAT + b * TCTX : b * TLAT) + chunk * 128 + t;
        float hv[16], ss = 0.f;
#pragma unroll
        for (int q = 0; q < 16; ++q) { hv[q] = Hs[t * 65 + vq * 16 + q]; ss += hv[q] * hv[q]; }
        ss += __shfl_xor(ss, 1); ss += __shfl_xor(ss, 2);
        const float rs = rsqrtf(ss * (1.f / 64.f) + EPSN);
        const float* og = F.in[27] + l * 256 + head * 64 + vq * 16; const bf16_t* op = P + (size_t)row * DINP + C_MO + head * 64 + vq * 16;
        const u32x4 o0 = *(const u32x4*)op, o1 = *(const u32x4*)(op + 8); const unsigned ow[8] = {o0.x, o0.y, o0.z, o0.w, o1.x, o1.y, o1.z, o1.w};
        unsigned res[8];
#pragma unroll
        for (int q = 0; q < 8; ++q) { const float y0 = sigmoidf_(lo2f(ow[q])) * hv[2 * q] * rs * og[2 * q], y1 = sigmoidf_(hi2f(ow[q])) * hv[2 * q + 1] * rs * og[2 * q + 1]; res[q] = pk2(y0 * ZF(16), y1 * ZF(16)); }
        bf16_t* yo = YC + (size_t)row * DM + 768 + head * 64 + vq * 16;
        *(u32x4*)yo = (u32x4){res[0], res[1], res[2], res[3]}; *(u32x4*)(yo + 8) = (u32x4){res[4], res[5], res[6], res[7]};
    }
    __syncthreads();
}
__device__ __forceinline__ void rwkv_finish(const Ctx& F, int l, int nrows) {
    const bf16_t* P = WSP(bf16_t, WS_P); const float* YR = WSP(float, WS_YR); const bf16_t* GB = WSP(bf16_t, WS_GB); const float* BS = WSP(float, WS_BS); bf16_t* YC = WSP(bf16_t, WS_YCAT);
    const int c4 = F.lane * 4; const f32x4 lg = *(const f32x4*)(F.in[20] + l * 256 + c4);
    const int gw = F.vcu * NWAVES + F.wave, NGW = F.G * NWAVES;
    for (int row = gw; row < nrows; row += NGW) {
        const f32x4 y = *(const f32x4*)(YR + (size_t)row * 256 + c4) + *(const f32x4*)(YR + (size_t)(MALL + row) * 256 + c4);
        const float ss = red16((y[0] * y[0] + y[1] * y[1]) + (y[2] * y[2] + y[3] * y[3]));
        const float rs = rsqrtf(ss * (1.f / 64.f) + EPSN);
        const f32x4 v = ld4bf(P + (size_t)row * DINP + C_RV + c4), g = ld4bf(GB + (size_t)row * 256 + c4);
        const float bn = BS[(size_t)row * 4 + (F.lane >> 4)];
        st4bf(YC + (size_t)row * DM + 256 + c4, (y * rs * lg * ZF(32) + bn * v * ZF(64)) * g * ZF(4));
    }
}
constexpr int RCH = 132;
constexpr int MP = 72, SLOT = 64 * MP;
constexpr size_t WS_RG = 454 * MiB, RG_TASK = 3 * 8192, WS_SST = WS_RW;
constexpr size_t WS_END2 = 504 * MiB;
static_assert(WS_RG + (size_t)16 * RCH * RG_TASK <= WS_END2 && (size_t)16 * RCH * 8192 <= (size_t)MALL * RWREC, "rwkv chunk ws map");

__device__ __forceinline__ void mm64(const LAS bf16_t* A, const LAS bf16_t* Bt, int w, int lane, f32x4 (&acc)[2]) {
    const int i = lane & 15, gq = lane >> 4, mb = w >> 1, nb0 = 2 * (w & 1);
    acc[0] = (f32x4){0.f, 0.f, 0.f, 0.f}; acc[1] = (f32x4){0.f, 0.f, 0.f, 0.f};
#pragma unroll
    for (int ks = 0; ks < 2; ++ks) { const bf16x8 a = *(const LAS bf16x8*)(A + (mb * 16 + i) * MP + ks * 32 + gq * 8);
#pragma unroll
        for (int q = 0; q < 2; ++q) { const bf16x8 b = *(const LAS bf16x8*)(Bt + ((nb0 + q) * 16 + i) * MP + ks * 32 + gq * 8); acc[q] = __builtin_amdgcn_mfma_f32_16x16x32_bf16(a, b, acc[q], 0, 0, 0); } }
}
__device__ __forceinline__ u32x2 pk4(f32x4 v) { u32x2 o; o.x = pk2(v[0], v[1]); o.y = pk2(v[2], v[3]); return o; }
__device__ __forceinline__ f32x4 up4(u32x2 w) { return (f32x4){lo2f(w.x), hi2f(w.x), lo2f(w.y), hi2f(w.y)}; }

struct RaRaw { u32x4 kk, al, kd, r, v; f32x4 ld0, ld1; };
__device__ __forceinline__ void ra_load(const Ctx& F, int task, RaRaw& g) {
    const int chain = task / RCH, c = task % RCH, b = chain >> 3, head = (chain >> 1) & 3, dir = chain & 1;
    const bf16_t* P = WSP(bf16_t, WS_P); const unsigned char* RW = WSP(unsigned char, WS_RW);
    const int t = F.tid >> 3, ch0 = (F.tid & 7) * 8; const int row = scan_row(b, dir, c * 64 + t);
    const bf16_t* rb = (const bf16_t*)(RW + (size_t)row * RWREC) + head * 64 + ch0;
    g.kk = *(const u32x4*)rb; g.al = *(const u32x4*)(rb + 256 + dir * 256); g.kd = *(const u32x4*)(rb + 768 + dir * 256);
    const float* ldp = (const float*)(RW + (size_t)row * RWREC + 2560) + dir * 256 + head * 64 + ch0;
    g.ld0 = *(const f32x4*)ldp; g.ld1 = *(const f32x4*)(ldp + 4);
    const bf16_t* pp = P + (size_t)row * DINP + head * 64 + ch0;
    g.r = *(const u32x4*)(pp + C_RR); g.v = *(const u32x4*)(pp + C_RV);
}
__device__ __forceinline__ void rwkv_chunk_pre(const Ctx& F, int task, const RaRaw& cur) {
    const int chain = task / RCH, c = task % RCH, b = chain >> 3, head = (chain >> 1) & 3, dir = chain & 1;
    LAS bf16_t* L0 = (LAS bf16_t*)F.lds;
#define SL(k) (L0 + (k) * SLOT)
    LAS float* LD = (LAS float*)SL(8);
    LAS float* SEG = (LAS float*)SL(10);
    LAS float* WLs = (LAS float*)SL(14);
    const int w = F.wave, lane = F.lane, i = lane & 15, gq = lane >> 4, mb = w >> 1, nb0 = 2 * (w & 1), m0 = mb * 16 + 4 * gq;
    LDS_BARRIER();
    const int t = F.tid >> 3, ch0 = (F.tid & 7) * 8;
    const u32x4 g_kk = cur.kk, g_al = cur.al, g_kd = cur.kd, g_r = cur.r, g_v = cur.v; const f32x4 ld0 = cur.ld0, ld1 = cur.ld1;
    *(LAS f32x4*)(LD + t * 64 + ch0) = ld0; *(LAS f32x4*)(LD + t * 64 + ch0 + 4) = ld1;
    LDS_BARRIER();
    { const int k = F.tid & 63, seg = F.tid >> 6; float s = 0.f;
#pragma unroll
      for (int j = 0; j < 8; ++j) s += LD[(seg * 8 + j) * 64 + k];
      SEG[seg * 64 + k] = s;
      LDS_BARRIER();
      float off = 0.f;
#pragma unroll
      for (int j = 0; j < 8; ++j) off += (j < seg) ? SEG[j * 64 + k] : 0.f;
#pragma unroll
      for (int j = 0; j < 8; ++j) { off += LD[(seg * 8 + j) * 64 + k]; LD[(seg * 8 + j) * 64 + k] = off; }
    }
    LDS_BARRIER();
    {
        const unsigned kkw[4] = {g_kk.x, g_kk.y, g_kk.z, g_kk.w}, alw[4] = {g_al.x, g_al.y, g_al.z, g_al.w}, kdw[4] = {g_kd.x, g_kd.y, g_kd.z, g_kd.w},
                       rw_[4] = {g_r.x, g_r.y, g_r.z, g_r.w}, vw[4] = {g_v.x, g_v.y, g_v.z, g_v.w};
        float okt[8], oai[8], oki[8], ort[8], oat[8], okb[8];
#pragma unroll
        for (int j = 0; j < 8; ++j) {
            const float cl = LD[t * 64 + ch0 + j], clp = t > 0 ? LD[(t - 1) * 64 + ch0 + j] : 0.f, clL = LD[63 * 64 + ch0 + j];
            const float kkv = (j & 1) ? hi2f(kkw[j >> 1]) : lo2f(kkw[j >> 1]), alv = (j & 1) ? hi2f(alw[j >> 1]) : lo2f(alw[j >> 1]), kdv = (j & 1) ? hi2f(kdw[j >> 1]) : lo2f(kdw[j >> 1]),
                        rv = (j & 1) ? hi2f(rw_[j >> 1]) : lo2f(rw_[j >> 1]);
            const float ec = __expf(cl), en = __builtin_amdgcn_rcpf(ec), eL = __expf(clL) * en;
            okt[j] = kkv * __expf(clp); oai[j] = alv * en; oki[j] = kdv * en; ort[j] = rv * ec; oat[j] = alv * eL; okb[j] = kdv * eL;
        }
        u32x4 o;
        o = (u32x4){pk2(okt[0], okt[1]), pk2(okt[2], okt[3]), pk2(okt[4], okt[5]), pk2(okt[6], okt[7])}; *(LAS u32x4*)(SL(0) + t * MP + ch0) = o;
        o = (u32x4){pk2(oai[0], oai[1]), pk2(oai[2], oai[3]), pk2(oai[4], oai[5]), pk2(oai[6], oai[7])}; *(LAS u32x4*)(SL(2) + t * MP + ch0) = o;
        o = (u32x4){pk2(oki[0], oki[1]), pk2(oki[2], oki[3]), pk2(oki[4], oki[5]), pk2(oki[6], oki[7])}; *(LAS u32x4*)(SL(3) + t * MP + ch0) = o;
        o = (u32x4){pk2(ort[0], ort[1]), pk2(ort[2], ort[3]), pk2(ort[4], ort[5]), pk2(ort[6], ort[7])}; *(LAS u32x4*)(SL(4) + t * MP + ch0) = o;
#pragma unroll
        for (int j = 0; j < 8; ++j) { SL(1)[(ch0 + j) * MP + t] = (bf16_t)f2bf(okt[j]); SL(5)[(ch0 + j) * MP + t] = (bf16_t)f2bf(oat[j]); SL(6)[(ch0 + j) * MP + t] = (bf16_t)f2bf(okb[j]);
            SL(7)[(ch0 + j) * MP + t] = (bf16_t)(((j & 1) ? (vw[j >> 1] >> 16) : (vw[j >> 1] & 0xffffu))); }
        if (t == 63) {
#pragma unroll
            for (int j = 0; j < 8; ++j) WLs[ch0 + j] = __expf(LD[63 * 64 + ch0 + j]); }
    }
    LDS_BARRIER();
    f32x4 acc[2];
    mm64(SL(0), SL(2), w, lane, acc);
#pragma unroll
    for (int q = 0; q < 2; ++q) { const int n = (nb0 + q) * 16 + i; f32x4 a, ti;
#pragma unroll
        for (int r = 0; r < 4; ++r) { const bool keep = (m0 + r) > n; a[r] = keep ? acc[q][r] : 0.f; ti[r] = ((m0 + r) == n ? 1.f : 0.f) - a[r]; }
#pragma unroll
        for (int r = 0; r < 4; ++r) { SL(8)[(m0 + r) * MP + n] = (bf16_t)f2bf(a[r]); SL(13)[(m0 + r) * MP + n] = (bf16_t)f2bf(ti[r]); }
        *(LAS u32x2*)(SL(9) + n * MP + m0) = pk4(a); }
    mm64(SL(0), SL(3), w, lane, acc);
#pragma unroll
    for (int q = 0; q < 2; ++q) { const int n = (nb0 + q) * 16 + i;
#pragma unroll
        for (int r = 0; r < 4; ++r) SL(10)[(m0 + r) * MP + n] = (bf16_t)f2bf((m0 + r) > n ? acc[q][r] : 0.f); }
    mm64(SL(4), SL(2), w, lane, acc);
#pragma unroll
    for (int q = 0; q < 2; ++q) { const int n = (nb0 + q) * 16 + i;
#pragma unroll
        for (int r = 0; r < 4; ++r) SL(11)[(m0 + r) * MP + n] = (bf16_t)f2bf((m0 + r) >= n ? acc[q][r] : 0.f); }
    mm64(SL(4), SL(3), w, lane, acc);
#pragma unroll
    for (int q = 0; q < 2; ++q) { const int n = (nb0 + q) * 16 + i;
#pragma unroll
        for (int r = 0; r < 4; ++r) SL(12)[(m0 + r) * MP + n] = (bf16_t)f2bf((m0 + r) >= n ? acc[q][r] : 0.f); }
    LDS_BARRIER();
#pragma unroll
    for (int it = 0; it < 5; ++it) {
        LAS bf16_t* Xs = (it & 1) ? SL(2) : SL(8); LAS bf16_t* XsT = (it & 1) ? SL(3) : SL(9);
        LAS bf16_t* Xd = (it & 1) ? SL(8) : SL(2); LAS bf16_t* XdT = (it & 1) ? SL(9) : SL(3);
        LAS bf16_t* Tsrc = (it & 1) ? SL(0) : SL(13); LAS bf16_t* Tdst = (it & 1) ? SL(13) : SL(0);
        mm64(Xs, XsT, w, lane, acc);
#pragma unroll
        for (int q = 0; q < 2; ++q) { const int n = (nb0 + q) * 16 + i;
#pragma unroll
            for (int r = 0; r < 4; ++r) Xd[(m0 + r) * MP + n] = (bf16_t)f2bf(acc[q][r]);
            *(LAS u32x2*)(XdT + n * MP + m0) = pk4(acc[q]); }
        LDS_BARRIER();
        mm64(Tsrc, XdT, w, lane, acc);
#pragma unroll
        for (int q = 0; q < 2; ++q) { const int n = (nb0 + q) * 16 + i;
#pragma unroll
            for (int r = 0; r < 4; ++r) Tdst[(m0 + r) * MP + n] = (bf16_t)f2bf(bf2f(Tsrc[(m0 + r) * MP + n]) + acc[q][r]); }
        LDS_BARRIER();
    }
    LAS bf16_t* Ti = SL(0);
    mm64(Ti, SL(1), w, lane, acc);
#pragma unroll
    for (int q = 0; q < 2; ++q) { const int n = (nb0 + q) * 16 + i; *(LAS u32x2*)(SL(2) + n * MP + m0) = pk4(acc[q]); }
    mm64(SL(10), SL(7), w, lane, acc);
#pragma unroll
    for (int q = 0; q < 2; ++q) { const int n = (nb0 + q) * 16 + i; *(LAS u32x2*)(SL(3) + n * MP + m0) = pk4(acc[q]); }
    LDS_BARRIER();
    mm64(Ti, SL(3), w, lane, acc);
#pragma unroll
    for (int q = 0; q < 2; ++q) { const int n = (nb0 + q) * 16 + i; *(LAS u32x2*)(SL(8) + n * MP + m0) = pk4(acc[q]); }
    LDS_BARRIER();
    bf16_t* RG = (bf16_t*)(F.ws + WS_RG + (size_t)task * RG_TASK);
    f32x4 acc2[2];
    mm64(SL(2), SL(11), w, lane, acc);
#pragma unroll
    for (int q = 0; q < 2; ++q) { const int n = (nb0 + q) * 16 + i; const f32x4 rt = up4(*(const LAS u32x2*)(SL(4) + n * MP + m0)); *(u32x2*)(RG + n * 64 + m0) = pk4(rt - acc[q]); }
    mm64(SL(2), SL(5), w, lane, acc);
#pragma unroll
    for (int q = 0; q < 2; ++q) { const int n = (nb0 + q) * 16 + i; f32x4 g;
#pragma unroll
        for (int r = 0; r < 4; ++r) g[r] = ((m0 + r) == n ? WLs[n] : 0.f) - acc[q][r];
        *(u32x2*)(RG + 4096 + n * 64 + m0) = pk4(g); }
    mm64(SL(6), SL(7), w, lane, acc); mm64(SL(5), SL(8), w, lane, acc2);
#pragma unroll
    for (int q = 0; q < 2; ++q) { const int n = (nb0 + q) * 16 + i; *(u32x2*)(RG + 8192 + n * 64 + m0) = pk4(acc[q] - acc2[q]); }
    mm64(SL(7), SL(12), w, lane, acc); mm64(SL(8), SL(11), w, lane, acc2);
    float* YR = WSP(float, WS_YR) + (size_t)dir * MALL * 256;
#pragma unroll
    for (int q = 0; q < 2; ++q) { const int n = (nb0 + q) * 16 + i; const int rown = scan_row(b, dir, c * 64 + n); *(f32x4*)(YR + (size_t)rown * 256 + head * 64 + m0) = acc[q] - acc2[q]; }
#undef SL
}

__device__ __forceinline__ void rwkv_chain(const Ctx& F, int chain) {
    LAS bf16_t* const L0 = (LAS bf16_t*)F.lds;
    LAS bf16_t* Gl[2] = {L0, L0 + SLOT}; LAS bf16_t* Sl[2] = {L0 + 2 * SLOT, L0 + 3 * SLOT}; LAS bf16_t* Hl[2] = {L0 + 4 * SLOT, L0 + 5 * SLOT};
    const int w = F.wave, lane = F.lane, i = lane & 15, gq = lane >> 4, mb = w >> 1, nb0 = 2 * (w & 1), m0 = mb * 16 + 4 * gq;
    const bf16_t* RGc = (const bf16_t*)(F.ws + WS_RG + (size_t)chain * RCH * RG_TASK); bf16_t* SST = (bf16_t*)(F.ws + WS_SST) + (size_t)chain * RCH * 4096;
    const int gr = F.tid >> 3, gc = (F.tid & 7) * 8, goff = gr * 64 + gc, loff = gr * MP + gc;
    constexpr int RBD = 6, RBU = 66;
    static_assert(RBU % RBD == 0 && RCH % RBU == 0, "ring depth / unroll");
    u32x4 rg[RBD], rh[RBD];
#define RB_LOAD(slot, cc) do { const bf16_t* p_ = RGc + (size_t)((cc) < RCH ? (cc) : RCH - 1) * (RG_TASK / 2); rg[slot] = *(const u32x4*)(p_ + 4096 + goff); rh[slot] = *(const u32x4*)(p_ + 8192 + goff); } while (0)
#pragma unroll
    for (int j = 0; j < RBD; ++j) RB_LOAD(j, j);
    __syncthreads();
    { unsigned z_; asm volatile("v_mov_b32 %0, 0" : "=v"(z_)); *(LAS u32x4*)(Sl[0] + loff) = (u32x4){z_, z_, z_, z_}; }
    *(LAS u32x4*)(Gl[0] + loff) = rg[0]; *(LAS u32x4*)(Hl[0] + loff) = rh[0];
    __syncthreads();
#ifdef TPROBE
    const unsigned long long tp0_ = __builtin_amdgcn_s_memrealtime();
#endif
#define RB_STEP(j) do { const int c = c0 + (j); if (c < RCH - 1) { const int par = c & 1; \
        *(u32x4*)(SST + (size_t)c * 4096 + goff) = *(const LAS u32x4*)(Sl[par] + loff);            \
        f32x4 acc[2]; mm64(Gl[par], Sl[par], w, lane, acc); \
        { const f32x4 h0 = up4(*(const LAS u32x2*)(Hl[par] + (nb0 * 16 + i) * MP + m0)), h1 = up4(*(const LAS u32x2*)(Hl[par] + ((nb0 + 1) * 16 + i) * MP + m0)); \
          *(LAS u32x2*)(Sl[par ^ 1] + (nb0 * 16 + i) * MP + m0) = pk4(acc[0] + h0); *(LAS u32x2*)(Sl[par ^ 1] + ((nb0 + 1) * 16 + i) * MP + m0) = pk4(acc[1] + h1); } \
        *(LAS u32x4*)(Gl[par ^ 1] + loff) = rg[((j) + 1) % RBD]; *(LAS u32x4*)(Hl[par ^ 1] + loff) = rh[((j) + 1) % RBD]; \
        RB_LOAD((j) % RBD, c + RBD); \
        asm volatile("s_waitcnt lgkmcnt(0)" ::: "memory"); __builtin_amdgcn_s_barrier(); asm volatile("" ::: "memory"); } } while (0)
#pragma unroll 1
    for (int c0 = 0; c0 < RCH; c0 += RBU) {
#pragma unroll
        for (int j = 0; j < RBU; ++j) RB_STEP(j); }
#undef RB_STEP
#undef RB_LOAD
    *(u32x4*)(SST + (size_t)(RCH - 1) * 4096 + goff) = *(const LAS u32x4*)(Sl[(RCH - 1) & 1] + loff);
#ifdef TPROBE
    if (chain == 0 && F.tid == 0) *(float*)(F.ws + WS_CTL + 65536) = 3000.f * (floorf((float)(__builtin_amdgcn_s_memrealtime() - tp0_) * (1.f / 3000.f)) + 0.5f);
#endif
    __syncthreads();
}

__device__ __forceinline__ void rwkv_out(const Ctx& F, int l, int unit) {
    const bool isc = unit >= 256; int b, chunk; if (!isc) { b = unit >> 7; chunk = unit & 127; } else { const int u = unit - 256; b = u >> 2; chunk = u & 3; }
    LAS bf16_t* Rl = (LAS bf16_t*)F.lds; LAS bf16_t* Sl = Rl + SLOT; LAS float* Ys = (LAS float*)(F.lds + 4 * SLOT * 2);
    const int w = F.wave, lane = F.lane, i = lane & 15, gq = lane >> 4, mb = w >> 1, nb0 = 2 * (w & 1), m0 = mb * 16 + 4 * gq;
    const int row0 = (isc ? MLAT + b * TCTX : b * TLAT) + chunk * 64;
    const int gr = F.tid >> 3, gc = (F.tid & 7) * 8;
#define RO_PTRS(hd_, RGp, SSp) do { const int head_ = (hd_) >> 1, dir_ = (hd_) & 1, chain_ = (b * 4 + head_) * 2 + dir_; const int cc_ = isc ? (dir_ ? 3 - chunk : chunk) : 4 + (dir_ ? 127 - chunk : chunk); \
        RGp = (const bf16_t*)(F.ws + WS_RG + ((size_t)chain_ * RCH + cc_) * RG_TASK); SSp = (const bf16_t*)(F.ws + WS_SST) + ((size_t)chain_ * RCH + cc_) * 4096; } while (0)
    u32x4 rv, sv;
    { const bf16_t* RG0; const bf16_t* SS0; RO_PTRS(0, RG0, SS0); rv = *(const u32x4*)(RG0 + gr * 64 + gc); sv = *(const u32x4*)(SS0 + gr * 64 + gc); }
#pragma unroll 1
    for (int hd = 0; hd < 8; ++hd) {
        const int head = hd >> 1, dir = hd & 1;
        const float* YR = WSP(float, WS_YR) + (size_t)dir * MALL * 256;
        LDS_BARRIER();
        *(LAS u32x4*)(Rl + gr * MP + gc) = rv; *(LAS u32x4*)(Sl + gr * MP + gc) = sv;
        if (hd < 7) { const bf16_t* RGn; const bf16_t* SSn; RO_PTRS(hd + 1, RGn, SSn); rv = *(const u32x4*)(RGn + gr * 64 + gc); sv = *(const u32x4*)(SSn + gr * 64 + gc); }
        f32x4 yl[2];
#pragma unroll
        for (int q = 0; q < 2; ++q) { const int n = (nb0 + q) * 16 + i; const int tor = dir ? 63 - n : n; yl[q] = *(const f32x4*)(YR + (size_t)(row0 + tor) * 256 + head * 64 + m0); }
        LDS_BARRIER();
        f32x4 acc[2]; mm64(Sl, Rl, w, lane, acc);
#pragma unroll
        for (int q = 0; q < 2; ++q) { const int n = (nb0 + q) * 16 + i; const int tor = dir ? 63 - n : n;
            LAS f32x4* yp = (LAS f32x4*)(Ys + tor * 260 + head * 64 + m0);
            if (dir == 0) *yp = acc[q] + yl[q]; else *yp = *yp + acc[q] + yl[q]; }
    }
#undef RO_PTRS
    __syncthreads();
    {
        const bf16_t* P = WSP(bf16_t, WS_P); const bf16_t* GB = WSP(bf16_t, WS_GB); const float* BS = WSP(float, WS_BS); bf16_t* YC = WSP(bf16_t, WS_YCAT);
        const int c4 = lane * 4; const f32x4 lg = *(const f32x4*)(F.in[20] + l * 256 + c4);
#pragma unroll 1
        for (int tt = w; tt < 64; tt += NWAVES) { const int row = row0 + tt;
            const f32x4 y = *(const LAS f32x4*)(Ys + tt * 260 + c4);
            const float ss = red16((y[0] * y[0] + y[1] * y[1]) + (y[2] * y[2] + y[3] * y[3]));
            const float rs = rsqrtf(ss * (1.f / 64.f) + EPSN);
            const f32x4 v = ld4bf(P + (size_t)row * DINP + C_RV + c4), g = ld4bf(GB + (size_t)row * 256 + c4);
            const float bn = BS[(size_t)row * 4 + (lane >> 4)];
            st4bf(YC + (size_t)row * DM + 256 + c4, (y * rs * lg * ZF(32) + bn * v * ZF(64)) * g * ZF(4)); }
    }
    __syncthreads();
}
__device__ __forceinline__ float clr7(float x) { return __uint_as_float(__float_as_uint(x) & 0xFFFFFF80u); }
__device__ __forceinline__ void ins16(float (&L)[16], float p) {
#pragma unroll
    for (int j = 15; j >= 1; --j) L[j] = __builtin_amdgcn_fmed3f(L[j - 1], L[j], p);
    L[0] = fmaxf(L[0], p);
}
__device__ __forceinline__ void peer_topk_task(const bf16_t* sg, size_t gstride, u32x2* eg) {
    float L0[16], L1[16];
#pragma unroll
    for (int j = 0; j < 16; ++j) { L0[j] = -INFINITY; L1[j] = -INFINITY; }
    u32x4 pa[4], pb[4];
#pragma unroll
    for (int u = 0; u < 4; ++u) { pa[u] = *(const u32x4*)(sg + (size_t)u * gstride); pb[u] = *(const u32x4*)(sg + (size_t)(16 + u) * gstride); }
#pragma unroll 4
    for (int i = 0; i < 128; i += 8) {
        const u32x4 a = pa[(i >> 3) & 3], b = pb[(i >> 3) & 3];
        { const int gn = (i >> 3) + 4 < 16 ? (i >> 3) + 4 : 15; pa[(i >> 3) & 3] = *(const u32x4*)(sg + (size_t)gn * gstride); pb[(i >> 3) & 3] = *(const u32x4*)(sg + (size_t)(16 + gn) * gstride); }
#pragma unroll
        for (int q = 0; q < 4; ++q) { ins16(L0, __uint_as_float((a[q] << 16) | (unsigned)(i + 2 * q))); ins16(L0, __uint_as_float((a[q] & 0xffff0000u) | (unsigned)(i + 2 * q + 1)));
                                      ins16(L1, __uint_as_float((b[q] << 16) | (unsigned)(i + 2 * q))); ins16(L1, __uint_as_float((b[q] & 0xffff0000u) | (unsigned)(i + 2 * q + 1))); }
    }
    float T[16];
#pragma unroll
    for (int j = 0; j < 16; ++j) T[j] = -INFINITY;
#pragma unroll
    for (int a = 0; a < 16; ++a)
#pragma unroll
        for (int b = 0; b < 16; ++b) if ((a + 1) * (b + 1) <= 16) { const float s = clr7(L0[a]) + clr7(L1[b]);
            ins16(T, __uint_as_float((__float_as_uint(s) & 0xFFFFFF00u) | (unsigned)(a * 16 + b))); }
    float e[16], sum = 0.f; const float mx = __uint_as_float(__float_as_uint(T[0]) & 0xFFFFFF00u);
#pragma unroll
    for (int j = 0; j < 16; ++j) { e[j] = __expf(__uint_as_float(__float_as_uint(T[j]) & 0xFFFFFF00u) - mx); sum += e[j]; }
    const float inv = 1.f / sum;
#pragma unroll
    for (int j = 0; j < 16; ++j) {
        const unsigned ab = __float_as_uint(T[j]) & 0xFFu, a = ab >> 4, b = ab & 15u; unsigned i0 = 0u, i1 = 0u;
#pragma unroll
        for (int q = 0; q < 16; ++q) { i0 = (a == (unsigned)q) ? (__float_as_uint(L0[q]) & 0x7Fu) : i0; i1 = (b == (unsigned)q) ? (__float_as_uint(L1[q]) & 0x7Fu) : i1; }
        eg[j] = (u32x2){i0 * 128u + i1, __float_as_uint(e[j] * inv)};
    }
}
__device__ __forceinline__ float gelu_tanh(float x) { const float u = 0.7978845608028654f * (x + 0.044715f * x * x * x); return 0.5f * x * (1.f + tanhf_(u)); }
__device__ __forceinline__ float dot2bf(unsigned w, unsigned x, float acc) { return __builtin_amdgcn_fdot2_f32_bf16(__builtin_bit_cast(bf16x2_t, w), __builtin_bit_cast(bf16x2_t, x), acc, false); }
__device__ __forceinline__ float wave_total63(float x) {
    x = red16(x);
    x += __int_as_float(__builtin_amdgcn_update_dpp(0, __float_as_int(x), 0x142, 0xa, 0xf, false));
    x += __int_as_float(__builtin_amdgcn_update_dpp(0, __float_as_int(x), 0x143, 0xc, 0xf, false));
    return x;
}

__device__ __forceinline__ void phase_peer(const Ctx& F, int l, int nrows, const float* mod, float* wr_override) {
    const bf16_t* S = WSP(bf16_t, WS_S); u32x2* EG = WSP(u32x2, WS_EG); const bf16_t* H = WSP(bf16_t, WS_H);
    const unsigned char* U = F.ws + WS_U + (size_t)l * UV_LSTRIDE; const unsigned char* V = F.ws + WS_V + (size_t)l * UV_LSTRIDE;
    const float* USC = WSP(float, WS_SC) + (size_t)l * 2 * 16384; const float* VSC = USC + 16384;
    const int tpb = nrows / F.G, tok0 = F.vcu * tpb;
    volatile LAS unsigned* tkflag = (volatile LAS unsigned*)(F.lds + LDSCTL_OFF + 512);
    if (F.tid == 0) tkflag[0] = 0u;
    { const int ntok1 = tpb < 64 ? tpb : 64; const int task = F.tid; const int hd = task / ntok1, tkn = task - hd * ntok1;
      if (hd < 8) { const int row = tok0 + tkn; peer_topk_task(S + ((size_t)(hd * 32) * MALL + row) * 8, (size_t)MALL * 8, EG + (size_t)row * 128 + hd * 16); } }
    __threadfence_block(); __syncthreads();
    if (tpb > 64 && F.wave == 2) {
        const int nex = tpb - 64; const int hd = F.lane / nex, tkn = F.lane - hd * nex;
        if (hd < 8) { const int row = tok0 + 64 + tkn; peer_topk_task(S + ((size_t)(hd * 32) * MALL + row) * 8, (size_t)MALL * 8, EG + (size_t)row * 128 + hd * 16); }
        __threadfence_block(); asm volatile("s_waitcnt vmcnt(0) lgkmcnt(0)" ::: "memory");
        if (F.lane == 0) tkflag[0] = 1u;
    }
    const int lane = F.lane; const bool hi32 = lane >= 32; const unsigned l16 = (unsigned)(lane & 31) * 16u;
    LAS unsigned char* wl = F.lds + F.wave * PEER_WLDS; LAS unsigned char* hbl = wl + 16 * 528; LAS unsigned char* rawl = hbl + 2048; LAS float* cfl = (LAS float*)(rawl + 512); LAS unsigned short* exl = (LAS unsigned short*)(rawl + 512 + 9 * 512); LAS float* cfm = (LAS float*)(rawl + 512 + 9 * 512 + 9 * 256);
#pragma unroll 1
    for (int tk = F.wave, ti = 0; tk < tpb; tk += NWAVES, ++ti) {
        if (tk >= 64) { while (tkflag[0] == 0u) __builtin_amdgcn_s_sleep(8); __threadfence_block(); }
        const int row = tok0 + tk;
        const u32x2 eg0 = EG[(size_t)row * 128 + lane], eg1 = EG[(size_t)row * 128 + 64 + lane];
        exl[ti * 128 + lane] = (unsigned short)eg0.x; exl[ti * 128 + 64 + lane] = (unsigned short)eg1.x;
        const LAS unsigned short* exq = exl + ti * 128 + (hi32 ? 8 : 0);
        float hscale;
        {   const u32x4 h0 = *(const u32x4*)(H + (size_t)row * DM + lane * 16), h1 = *(const u32x4*)(H + (size_t)row * DM + lane * 16 + 8);
            const unsigned hw[8] = {h0.x, h0.y, h0.z, h0.w, h1.x, h1.y, h1.z, h1.w}; float hf[16]; float am = 0.f;
#pragma unroll
            for (int q = 0; q < 8; ++q) { hf[2 * q] = lo2f(hw[q]); hf[2 * q + 1] = hi2f(hw[q]); am = fmaxf(am, fmaxf(fabsf(hf[2 * q]), fabsf(hf[2 * q + 1]))); }
#pragma unroll
            for (int o = 1; o < 64; o <<= 1) am = fmaxf(am, __shfl_xor(am, o));
            const float sc = am > 0.f ? 224.f / am : 1.f; hscale = am > 0.f ? am * (1.f / 224.f) : 1.f;
            unsigned hiw[4], low[4];
#pragma unroll
            for (int d = 0; d < 4; ++d) { const float a0 = hf[d * 4] * sc, a1 = hf[d * 4 + 1] * sc, a2 = hf[d * 4 + 2] * sc, a3 = hf[d * 4 + 3] * sc;
                int w = __builtin_amdgcn_cvt_pk_fp8_f32(a0, a1, 0, false); w = __builtin_amdgcn_cvt_pk_fp8_f32(a2, a3, w, true);
                const f32x2 b01 = __builtin_amdgcn_cvt_pk_f32_fp8(w, false), b23 = __builtin_amdgcn_cvt_pk_f32_fp8(w, true);
                int wl_ = __builtin_amdgcn_cvt_pk_fp8_f32((a0 - b01.x) * 16.f, (a1 - b01.y) * 16.f, 0, false); wl_ = __builtin_amdgcn_cvt_pk_fp8_f32((a2 - b23.x) * 16.f, (a3 - b23.y) * 16.f, wl_, true);
                hiw[d] = (unsigned)w; low[d] = (unsigned)wl_; }
            LAS unsigned char* hp = hbl + (lane >> 3) * 256 + (lane & 7) * 16;
            *(LAS u32x4*)hp = (u32x4){hiw[0], hiw[1], hiw[2], hiw[3]};
            *(LAS u32x4*)(hp + 128) = (u32x4){low[0], low[1], low[2], low[3]};
        }
        {
            const int mi = lane & 15, mg = lane >> 4;
            const LAS unsigned char* aptr = wl + mi * 528 + mg * 16; const LAS unsigned char* bptr = hbl + (mi & 1) * 128 + mg * 16;
            LAS unsigned char* pk = wl + (lane >> 5) * (8 * 528) + l16;
            u32x4 rr[3][8];
#define PU_LOAD(bt_) do { _Pragma("unroll") for (int h = 0; h < 2; ++h) { const u32x2 ew = *(const LAS u32x2*)(exq + (bt_) * 16 + 4 * h); \
                rr[(bt_) % 3][4 * h + 0] = *(const u32x4*)(U + ((ew.x & 0xffffu) * 512u + l16)); rr[(bt_) % 3][4 * h + 1] = *(const u32x4*)(U + ((ew.x >> 16) * 512u + l16)); \
                rr[(bt_) % 3][4 * h + 2] = *(const u32x4*)(U + ((ew.y & 0xffffu) * 512u + l16)); rr[(bt_) % 3][4 * h + 3] = *(const u32x4*)(U + ((ew.y >> 16) * 512u + l16)); } } while (0)
#define PU_PARK(bt_) do { _Pragma("unroll") for (int q = 0; q < 8; ++q) *(LAS u32x4*)(pk + q * 528) = rr[(bt_) % 3][q]; } while (0)
            PU_LOAD(0); PU_LOAD(1);
#pragma unroll
            for (int bt = 0; bt < 8; ++bt) {
                if (bt + 2 < 8) PU_LOAD(bt + 2);
                PU_PARK(bt);
                f32x4 acc = {0.f, 0.f, 0.f, 0.f};
#pragma unroll
                for (int s = 0; s < 8; ++s) { const u32x4 a = *(const LAS u32x4*)(aptr + s * 64), b0 = *(const LAS u32x4*)(bptr + s * 256), b1 = *(const LAS u32x4*)(bptr + s * 256 + 64);
                    acc = __builtin_amdgcn_mfma_scale_f32_16x16x128_f8f6f4((i32x8){(int)a.x, (int)a.y, (int)a.z, (int)a.w, 0, 0, 0, 0},
                                                                           (i32x8){(int)b0.x, (int)b0.y, (int)b0.z, (int)b0.w, (int)b1.x, (int)b1.y, (int)b1.z, (int)b1.w}, acc, 4, 0, 0, 0x7F7F7F7F, 0, 0x7F7F7F7F); }
                f32x4 tot;
#pragma unroll
                for (int r = 0; r < 4; ++r) tot[r] = acc[r] + 0.0625f * dppf<0xF5>(acc[r]);
                if (mi == 0) *(LAS f32x4*)(rawl + (bt * 16 + 4 * mg) * 4) = tot;
            }
#undef PU_PARK
#undef PU_LOAD
            const float act0 = *(const LAS float*)(rawl + lane * 4) * (hscale * USC[eg0.x]), act1 = *(const LAS float*)(rawl + 256 + lane * 4) * (hscale * USC[eg1.x]);
            const float c0 = __uint_as_float(eg0.y) * gelu_tanh(act0) * VSC[eg0.x], c1 = __uint_as_float(eg1.y) * gelu_tanh(act1) * VSC[eg1.x];
            float cm = fmaxf(fabsf(c0), fabsf(c1));
#pragma unroll
            for (int o = 1; o < 64; o <<= 1) cm = fmaxf(cm, __shfl_xor(cm, o));
            const float cinv = cm > 0.f ? 1.f / cm : 0.f;
            cfl[ti * 128 + lane] = c0 * cinv; cfl[ti * 128 + 64 + lane] = c1 * cinv;
            if (lane == 0) cfm[ti] = cm;
        }
    }
    LDS_BARRIER();
#pragma unroll 1
    for (int tk = F.wave, ti = 0; tk < tpb; tk += NWAVES, ++ti) {
        const int row = tok0 + tk; const bool isc = row >= MLAT; const int smp = isc ? 2 : (row >> 13);
        float* xrow = isc ? WSP(float, WS_XC) + (size_t)(row - MLAT) * DM : F.out + (size_t)row * DM;
        const LAS unsigned short* exq = exl + ti * 128 + (hi32 ? 8 : 0); const LAS float* cfq = cfl + ti * 128 + (hi32 ? 8 : 0);
        u32x4 ra[8], rb[8];
#define PG_LOAD(dst, grp_) do { _Pragma("unroll") for (int h = 0; h < 2; ++h) { const u32x2 ew = *(const LAS u32x2*)(exq + (grp_) * 16 + 4 * h); \
            dst[4 * h + 0] = *(const u32x4*)(V + ((ew.x & 0xffffu) * 512u + l16)); dst[4 * h + 1] = *(const u32x4*)(V + ((ew.x >> 16) * 512u + l16)); \
            dst[4 * h + 2] = *(const u32x4*)(V + ((ew.y & 0xffffu) * 512u + l16)); dst[4 * h + 3] = *(const u32x4*)(V + ((ew.y >> 16) * 512u + l16)); } } while (0)
        PG_LOAD(ra, 0);
        f32x2 ac[16];
#pragma unroll
        for (int q = 0; q < 16; ++q) ac[q] = (f32x2){0.f, 0.f};
#define PG_VACC(src, grp_) do { _Pragma("unroll") for (int h = 0; h < 2; ++h) { const u32x4 c4 = *(const LAS u32x4*)(cfq + (grp_) * 16 + 4 * h); \
            _Pragma("unroll") for (int q = 0; q < 4; ++q) { const float cf = __uint_as_float(c4[q]); const unsigned vw[4] = {src[4 * h + q].x, src[4 * h + q].y, src[4 * h + q].z, src[4 * h + q].w}; \
            _Pragma("unroll") for (int j = 0; j < 4; ++j) { ac[4 * j] += cf * __builtin_amdgcn_cvt_scalef32_pk_f32_fp4(vw[j], 1.0f, 0); ac[4 * j + 1] += cf * __builtin_amdgcn_cvt_scalef32_pk_f32_fp4(vw[j], 1.0f, 1); \
                ac[4 * j + 2] += cf * __builtin_amdgcn_cvt_scalef32_pk_f32_fp4(vw[j], 1.0f, 2); ac[4 * j + 3] += cf * __builtin_amdgcn_cvt_scalef32_pk_f32_fp4(vw[j], 1.0f, 3); } } } } while (0)
#pragma unroll 1
        for (int g2 = 0; g2 < 4; ++g2) {
            PG_LOAD(rb, 2 * g2 + 1); PG_VACC(ra, 2 * g2);
            if (g2 < 3) PG_LOAD(ra, 2 * g2 + 2);
            PG_VACC(rb, 2 * g2 + 1);
        }
#undef PG_LOAD
#undef PG_VACC
        float acc[16];
        const float cmx = cfm[ti];
#pragma unroll
        for (int q = 0; q < 8; ++q) { const f32x2 mine = hi32 ? ac[8 + q] : ac[q], send = hi32 ? ac[q] : ac[8 + q];
            acc[2 * q] = cmx * (mine.x + __shfl_xor(send.x, 32)); acc[2 * q + 1] = cmx * (mine.y + __shfl_xor(send.y, 32)); }
        const int col0 = 32 * (lane & 31) + 16 * (lane >> 5);
        const float* gt = mod + smp * 6144 + 5120;
        f32x4 res[4]; float ss = 0.f;
#pragma unroll
        for (int q = 0; q < 4; ++q) { const int c = col0 + q * 4; const f32x4 g = *(const f32x4*)(gt + c), x = *(const f32x4*)(xrow + c);
            res[q] = x + ZF(1) * g * (f32x4){acc[q * 4], acc[q * 4 + 1], acc[q * 4 + 2], acc[q * 4 + 3]};
            *(f32x4*)((wr_override ? wr_override + (size_t)row * DM : xrow) + c) = res[q];
            ss += (res[q][0] * res[q][0] + res[q][1] * res[q][1]) + (res[q][2] * res[q][2] + res[q][3] * res[q][3]); }
        if (l == 0 && !wr_override) {
            const float rs = rsqrtf(wave_sum(ss) * (1.f / DM) + EPSN); const float* mb1 = mod + 3 * 6144 + smp * 6144; const float* g1 = F.in[6] + DM;
            bf16_t* Hw = WSP(bf16_t, WS_H) + (size_t)row * DM;
#pragma unroll
            for (int q = 0; q < 4; ++q) { const int c = col0 + q * 4; const f32x4 g = *(const f32x4*)(g1 + c), sc = *(const f32x4*)(mb1 + 1024 + c), sh = *(const f32x4*)(mb1 + c);
                st4bf(Hw + c, (res[q] * rs * g) * (1.f + sc) + sh); }
        }
    }
}

constexpr int PH_PER_LAYER = 10, N_PHASES = 1 + 2 * PH_PER_LAYER;
struct Args { const float* in[32]; float* out; unsigned char* ws; int ph_lo, ph_hi, li, pad; };
__global__ void __launch_bounds__(NTHR, 2) mk_fwd(Args args) {
    extern __shared__ __attribute__((aligned(16))) unsigned char lds[];
    Ctx F;
    F.lds = (LAS unsigned char*)lds;
    volatile LAS unsigned* MISC = (volatile LAS unsigned*)(F.lds + MISC_OFF);
    F.tid = threadIdx.x; F.lane = F.tid & 63; F.wave = __builtin_amdgcn_readfirstlane(F.tid >> 6);
    F.G = gridDim.x; { const int bx = blockIdx.x; F.vcu = (F.G % 8 == 0) ? (bx % 8) * (F.G / 8) + bx / 8 : bx; }
#pragma unroll
    for (int i = 0; i < 32; ++i) F.in[i] = args.in[i];
    F.out = args.out; F.ws = args.ws;
    for (int u = F.tid; u < (LDS_BYTES - LDSCTL_OFF) / 4; u += NTHR) ((LAS unsigned*)(F.lds + LDSCTL_OFF))[u] = 0u;
    __syncthreads();
    XcdBarrier bar; bar.bar = (unsigned*)(args.ws + WS_CTL) + CW_BAR; bar.x = 0; bar.st = nullptr;
#if !MK_MULTI
    bar = xcd_barrier_post((unsigned*)(args.ws + WS_CTL) + CW_BAR, MISC + 8);
#endif
    const int lo = args.ph_lo, hi = args.ph_hi;
#ifndef KMAX
#define KMAX 1000
#endif
#define IN(k) (lo <= (k) && (k) < hi && (REP_ALL == 1 || ra == REP_ALL - 1 || (k) <= KMAX))
#ifndef REP_PH
#define REP_PH -1
#endif
#define REPS(k) ((REP_PH == (k)) ? 2 : 1)
#define PHCTX Ctx Fp = F; { int t_ = F.tid; asm volatile("" : "+v"(t_)); Fp.tid = t_; Fp.lane = t_ & 63; }
#if MK_MULTI
#define SEAM(k) do { } while (0)
#else
#ifndef BAR_REPS
#define BAR_REPS 1
#endif
#define SEAM(k) do { if (IN(k) && IN((k) + 1)) for (int br_ = 0; br_ < BAR_REPS; ++br_) xcd_barrier(bar); } while (0)
#endif
#ifndef REP_ALL
#define REP_ALL 1
#endif
#ifndef REP_SUB
#define REP_SUB 0
#endif
#pragma unroll 1
    for (int ra = 0; ra < REP_ALL; ++ra) {
    if (ra > 0) xcd_barrier(bar);
    if (IN(0)) { PHCTX; for (int rep = 0; rep < REPS(100); ++rep) phase_prologue(Fp); }
    SEAM(0);
    float* XC = WSP(float, WS_XC);
#pragma unroll 1
    for (int l = 0; l < 2; ++l) {
        const int pb = 1 + l * PH_PER_LAYER;
        const float* xlat = l == 0 ? F.in[0] : F.out; const float* xctx = l == 0 ? F.in[2] : XC;
        const int mrows = l == 0 ? MALL : MLAT;
        const float* mod = WSP(float, WS_MOD) + (size_t)l * 3 * 6144;
        if (IN(pb + 0) && l == 0) { PHCTX; for (int rep = 0; rep < REPS(0); ++rep) { phase_norm(Fp, l, 0, MALL, xlat, xctx); } }
        if (l == 0) SEAM(pb + 0);
        if (IN(pb + 1)) for (int rep = 0; rep < REPS(1); ++rep) { PHCTX; pg8::Gemm g{WSP(bf16_t, WS_H), WSP(bf16_t, WS_WIN + l * WIN_LSTRIDE), MALL, DINP, DM}; pg8::StaticOrder So; So.init(MALL, DINP, F.G, (int)blockIdx.x);
            pg8::EpiBf16 E{WSP(bf16_t, WS_P), DINP}; pg8::gemm_phase<pg8::EpiBf16, pg8::StaticOrder, true, true>(F.lds, g, So, E, Fp.tid); }
        SEAM(pb + 1);
        if (IN(pb + 2)) { PHCTX; for (int rep = 0; rep < REPS(2); ++rep) { phase_prep(Fp, l); __syncthreads(); } }
        SEAM(pb + 2);
        if (IN(pb + 3)) for (int rep = 0; rep < REPS(3); ++rep) {
            const int nra = 16 * RCH, nml = 16 * NCHK;
            for (int r3 = 0; r3 < (REP_SUB == 3 ? 2 : 1); ++r3) { PHCTX; for (int task = F.vcu; task < nra; task += F.G) { RaRaw cur_; ra_load(Fp, task, cur_); rwkv_chunk_pre(Fp, task, cur_); } __syncthreads(); }
            for (int r3 = 0; r3 < (REP_SUB == 4 ? 2 : 1); ++r3) { PHCTX; for (int task = (F.vcu + F.G - 72) % F.G; task < nml; task += F.G) mlstm_local(Fp, task); }
        }
        SEAM(pb + 3);
                if (IN(pb + 4)) for (int rep = 0; rep < REPS(4); ++rep) {
            if (F.vcu < 16) { PHCTX; rwkv_chain(Fp, F.vcu); }
            else { { PHCTX; mlstm_chain(Fp, 16); }
                   { PHCTX; const int natt = l == 0 ? 264 : 256; for (int task = F.vcu - 16; task < natt; task += F.G - 16) attn_unit(Fp, l, task); } } }
        SEAM(pb + 4);
        if (IN(pb + 5)) for (int rep = 0; rep < REPS(5); ++rep) { const int nro = l == 0 ? 264 : 256, nun = l == 0 ? 528 : 512;
            { PHCTX; for (int u = F.vcu; u < nro; u += F.G) rwkv_out(Fp, l, u); }
            { PHCTX; for (int u = (F.vcu + F.G - 8) % F.G; u < nun; u += F.G) mlstm_out(Fp, l, u); } }
        SEAM(pb + 5);
        if (IN(pb + 6)) for (int rep = 0; rep < REPS(6); ++rep) { PHCTX; pg8::Gemm g{WSP(bf16_t, WS_YCAT), WSP(bf16_t, WS_WOUT + l * WOUT_LSTRIDE), mrows, DM, DM}; pg8::StaticOrder So; So.init(mrows, DM, F.G, (int)blockIdx.x);
            float* dummy = WSP(float, WS_YR); const bool dm_ = (REPS(6) == 2 && rep == 0); pg8::EpiRes E{xlat, xctx, dm_ ? dummy : F.out, dm_ ? dummy : XC, mod}; pg8::gemm_phase<pg8::EpiRes, pg8::StaticOrder, true, true>(F.lds, g, So, E, Fp.tid); }
        SEAM(pb + 6);
        if (IN(pb + 7)) { PHCTX; for (int rep = 0; rep < REPS(7); ++rep) phase_norm(Fp, l, 1, mrows, F.out, XC); }
        SEAM(pb + 7);
        if (IN(pb + 8)) for (int rep = 0; rep < REPS(8); ++rep) { PHCTX; pg8::Gemm g{WSP(bf16_t, WS_H), WSP(bf16_t, WS_WEFF + l * WEFF_LSTRIDE), mrows, 2048, DM}; pg8::StaticOrder So; So.init(mrows, 2048, F.G, (int)blockIdx.x);
            pg8::EpiBf16S E{WSP(bf16_t, WS_S), MALL}; pg8::gemm_phase<pg8::EpiBf16S, pg8::StaticOrder, true, true>(F.lds, g, So, E, Fp.tid); }
        SEAM(pb + 8);
        if (IN(pb + 9)) { PHCTX; for (int rep = 0; rep < REPS(9); ++rep) { phase_peer(Fp, l, mrows, mod, (REPS(9) == 2 && rep == 0) ? WSP(float, WS_YR) : nullptr); __syncthreads(); } }
        SEAM(pb + 9);
    }
    }
#undef IN
#undef SEAM
}

extern "C" void kernel_launch(void* const* d_in, const int* in_sizes, int n_in, void* d_out, int out_size, void* d_ws, size_t ws_size, hipStream_t stream) {
    static int grid = 0;
    if (grid == 0) {
        if (n_in != 32 || out_size != MLAT * DM || ws_size < WS_END2) { fprintf(stderr, "kernel_launch: unexpected shapes: n_in %d out %d ws %zu (need %zu)\n", n_in, out_size, ws_size, (size_t)WS_END2); grid = -1; return; }
        int dev = 0, cus = 0, per_cu = 0;
        if (hipGetDevice(&dev) != hipSuccess || hipDeviceGetAttribute(&cus, hipDeviceAttributeMultiprocessorCount, dev) != hipSuccess) { grid = -1; return; }
        if (hipFuncSetAttribute((const void*)mk_fwd, hipFuncAttributeMaxDynamicSharedMemorySize, LDS_BYTES) != hipSuccess) { fprintf(stderr, "kernel_launch: hipFuncSetAttribute failed\n"); grid = -1; return; }
        if (hipOccupancyMaxActiveBlocksPerMultiprocessor(&per_cu, (const void*)mk_fwd, NTHR, LDS_BYTES) != hipSuccess || per_cu < 1) fprintf(stderr, "kernel_launch: occupancy query reports %d\n", per_cu);
        (void)hipGetLastError();
        grid = cus;
        if (grid != 256) fprintf(stderr, "kernel_launch: grid %d (built for 256 CUs)\n", grid);
    }
    if (grid < 0) return;
    (void)hipMemsetAsync((char*)d_ws + WS_CTL, 0, CTL_ZERO_BYTES, stream);
    Args a{};
    for (int i = 0; i < 32; ++i) a.in[i] = (const float*)d_in[i];
    a.out = (float*)d_out; a.ws = (unsigned char*)d_ws;
#if MK_MULTI
    for (int p = 0; p < N_PHASES; ++p) { a.ph_lo = p; a.ph_hi = p + 1; a.li = p; hipLaunchKernelGGL(mk_fwd, dim3(grid), dim3(NTHR), LDS_BYTES, stream, a); }
#else
    a.ph_lo = 0; a.ph_hi = N_PHASES; a.li = 0;
    hipLaunchKernelGGL(mk_fwd, dim3(grid), dim3(NTHR), LDS_BYTES, stream, a);
#endif
}
```

```cpp
#include <hip/hip_runtime.h>
#include <cstdio>
#include <cstdint>

#ifndef MK_MULTI
#define MK_MULTI 0
#endif
namespace pg8 {
#define PG8_LAS __attribute__((address_space(3)))
typedef unsigned short bf16_t;
typedef short bf16x8 __attribute__((ext_vector_type(8)));
typedef float f32x4 __attribute__((ext_vector_type(4)));
typedef unsigned u32x4 __attribute__((ext_vector_type(4)));
constexpr int BM = 256, BK = 64, HALF = 128, HTB = HALF * BK * 2  , STAGE_BYTES = 8 * HTB, NXCD = 8, WGM = 8;

__host__ __device__ __forceinline__ int lds_byte(int r, int c) { const int st = (r >> 4) * 2 + (c >> 5), rr = r & 15, cc = c & 31, ob = rr * 64 + cc * 2; return st * 1024 + (ob ^ (((ob >> 9) & 1) << 5)); }
__host__ __device__ __forceinline__ void stage_rc(int b, int& R, int& C) { const int st = b / 1024, sb = b % 1024, swz = sb ^ (((sb >> 9) & 1) << 5); R = (st >> 1) * 16 + swz / 64; C = (st & 1) * 32 + (swz % 64) / 2; }
__host__ __device__ __forceinline__ int perm32(int rho) { const int n = rho >> 4, i = rho & 15; return 8 * (i >> 2) + 4 * n + (i & 3); }

struct Unit { int pm, pn; };
struct Gemm { const bf16_t* A; const bf16_t* Bt; int M, N, K; };

struct StaticOrder {
    int nM, nN, nwg, G, c;
    __host__ __device__ void init(int M, int N, int G_, int c_) { nM = M / BM; nN = N / BM; nwg = nM * nN; G = G_; c = c_; }
    __host__ __device__ bool next(int i, Unit& u) const {
        const long L = (long)i * G + c; if (L >= nwg) return false;
        int wgid = (int)L; { const int q = nwg / NXCD, r = nwg % NXCD, xcd = wgid % NXCD, off = wgid / NXCD; wgid = (xcd < r ? xcd * (q + 1) : r * (q + 1) + (xcd - r) * q) + off; }
        const int nig = WGM * nN, gid = wgid / nig, fm = gid * WGM, gsz = (nM - fm) < WGM ? (nM - fm) : WGM;
        u.pm = fm + ((wgid % nig) % gsz); u.pn = (wgid % nig) / gsz; return true;
    }
    __device__ __forceinline__ void a_ready(const Unit&) const {}
    __device__ __forceinline__ void done(const Unit&) const {}
};

__device__ __forceinline__ unsigned cvt_pk_bf16(float lo, float hi) { unsigned r; asm volatile("v_cvt_pk_bf16_f32 %0, %1, %2" : "=v"(r) : "v"(lo), "v"(hi)); return r; }

struct EpiBf16 {
    static constexpr bool PERM = true, AFTER_DRAIN = false;
    bf16_t* O; int ldc;
    __device__ __forceinline__ void operator()(const f32x4 (&acc)[2][2][4][2], const Unit& u, int wr, int wc, int fr, int fq) const {
        const int row0 = u.pm * BM + wr * 64 + fr; const int col0 = u.pn * BM + wc * 32 + 8 * fq;
#pragma unroll
        for (int ai = 0; ai < 2; ++ai)
#pragma unroll
            for (int m = 0; m < 4; ++m) { bf16_t* rowp = O + (size_t)(row0 + ai * HALF + m * 16) * ldc + col0;
#pragma unroll
                for (int bj = 0; bj < 2; ++bj) { const f32x4 v0 = acc[ai][bj][m][0], v1 = acc[ai][bj][m][1];
                    u32x4 w; w.x = cvt_pk_bf16(v0[0], v0[1]); w.y = cvt_pk_bf16(v0[2], v0[3]); w.z = cvt_pk_bf16(v1[0], v1[1]); w.w = cvt_pk_bf16(v1[2], v1[3]);
                    *(u32x4*)(rowp + bj * HALF) = w; } }
    }
};
struct EpiF32 {
    static constexpr bool PERM = false, AFTER_DRAIN = false;
    float* O; int ldr;
    __device__ __forceinline__ void operator()(const f32x4 (&acc)[2][2][4][2], const Unit& u, int wr, int wc, int fr, int fq) const {
        const int row0 = u.pm * BM + wr * 64 + fr; const int col0 = u.pn * BM + wc * 32 + 4 * fq;
#pragma unroll
        for (int ai = 0; ai < 2; ++ai)
#pragma unroll
            for (int m = 0; m < 4; ++m) { const int row = row0 + ai * HALF + m * 16;
#pragma unroll
                for (int bj = 0; bj < 2; ++bj)
#pragma unroll
                    for (int n = 0; n < 2; ++n) { const int cg = (col0 + bj * HALF + n * 16) >> 2; *(f32x4*)(O + ((size_t)cg * ldr + row) * 4) = acc[ai][bj][m][n]; } }
    }
};
struct EpiBf16S {
    static constexpr bool PERM = true, AFTER_DRAIN = false;
    bf16_t* O; int ldr;
    __device__ __forceinline__ void operator()(const f32x4 (&acc)[2][2][4][2], const Unit& u, int wr, int wc, int fr, int fq) const {
        const int row0 = u.pm * BM + wr * 64 + fr; const int col0 = u.pn * BM + wc * 32 + 8 * fq;
#pragma unroll
        for (int ai = 0; ai < 2; ++ai)
#pragma unroll
            for (int m = 0; m < 4; ++m) { const int row = row0 + ai * HALF + m * 16;
#pragma unroll
                for (int bj = 0; bj < 2; ++bj) { const f32x4 v0 = acc[ai][bj][m][0], v1 = acc[ai][bj][m][1];
                    u32x4 w; w.x = cvt_pk_bf16(v0[0], v0[1]); w.y = cvt_pk_bf16(v0[2], v0[3]); w.z = cvt_pk_bf16(v1[0], v1[1]); w.w = cvt_pk_bf16(v1[2], v1[3]);
                    *(u32x4*)(O + ((size_t)((col0 + bj * HALF) >> 3) * ldr + row) * 8) = w; } }
    }
};
struct EpiRes {
    static constexpr bool PERM = false, AFTER_DRAIN = false;
    const float* src_lat; const float* src_ctx; float* dst_lat; float* dst_ctx; const float* gate;
    __device__ __forceinline__ void operator()(const f32x4 (&acc)[2][2][4][2], const Unit& u, int wr, int wc, int fr, int fq) const {
        const bool isc = u.pm >= 64; const int smp = isc ? 2 : (u.pm >> 5);
        const int prow = (isc ? (u.pm - 64) * BM : u.pm * BM) + wr * 64 + fr;
        const float* src = isc ? src_ctx : src_lat; float* dst = isc ? dst_ctx : dst_lat;
        const float* gt = gate + smp * 6144 + 2048;
        const int col0 = u.pn * BM + wc * 32 + 4 * fq;
        f32x4 gv[2][2];
#pragma unroll
        for (int bj = 0; bj < 2; ++bj)
#pragma unroll
            for (int n = 0; n < 2; ++n) gv[bj][n] = *(const f32x4*)(gt + col0 + bj * HALF + n * 16);
#pragma unroll
        for (int ai = 0; ai < 2; ++ai)
#pragma unroll
            for (int m = 0; m < 4; ++m) { const size_t off = (size_t)(prow + ai * HALF + m * 16) * 1024 + col0;
#pragma unroll
                for (int bj = 0; bj < 2; ++bj)
#pragma unroll
                    for (int n = 0; n < 2; ++n) { const f32x4 s = *(const f32x4*)(src + off + bj * HALF + n * 16);
                        *(f32x4*)(dst + off + bj * HALF + n * 16) = s + gv[bj][n] * acc[ai][bj][m][n]; } }
    }
};

template <class Epi, class Sched, bool ALIGN_EPI = false, bool SP2 = false>
__device__ __forceinline__ void gemm_phase(PG8_LAS unsigned char* lds, const Gemm g, const Sched& S, const Epi& E, const int tid) {
    const int wid = __builtin_amdgcn_readfirstlane(tid >> 6), lane = tid & 63, wr = wid >> 2, wc = wid & 3, fr = lane & 15, fq = lane >> 4;
    const int K = g.K, nt = K / BK;
    unsigned voffA[2], voffB[2];
#pragma unroll
    for (int i = 0; i < 2; ++i) { int R, C; stage_rc(tid * 16 + i * 8192, R, C); const int Rb = Epi::PERM ? ((R & ~31) + perm32(R & 31)) : R;
        voffA[i] = (unsigned)(R * K + C) * 2u; voffB[i] = (unsigned)(Rb * K + C) * 2u; }
    const size_t kstep = (size_t)(BK * 2);
    const size_t hstep = (size_t)HALF * K * 2;
    const size_t tstep = 2 * hstep;
    const unsigned ldsw = (unsigned)wid * 1024u;
    const int aoff = lds_byte(wr * 64 + fr, fq * 8), boff = lds_byte(wc * 32 + fr, fq * 8);
#define PG8_SA(b, h) (((b) * 2 + (h)) * HTB)
#define PG8_SB(b, h) ((4 + (b) * 2 + (h)) * HTB)
#define PG8_STAGE(bufoff, gbase, voff) do { _Pragma("unroll") for (int _i = 0; _i < 2; ++_i) \
        __builtin_amdgcn_global_load_lds((const unsigned*)((const char*)(gbase) + (voff)[_i]), (PG8_LAS unsigned*)(lds + (bufoff) + ldsw + _i * 8192), 16, 0, 0); } while (0)
#define PG8_LDA(dst, b, h) do { _Pragma("unroll") for (int m = 0; m < 4; ++m) _Pragma("unroll") for (int k = 0; k < 2; ++k) dst[m][k] = *(const PG8_LAS bf16x8*)(lds + PG8_SA(b, h) + aoff + m * 2048 + k * 1024); } while (0)
#define PG8_LDB(dst, b, h) do { _Pragma("unroll") for (int n = 0; n < 2; ++n) _Pragma("unroll") for (int k = 0; k < 2; ++k) dst[n][k] = *(const PG8_LAS bf16x8*)(lds + PG8_SB(b, h) + boff + n * 2048 + k * 1024); } while (0)
#define PG8_MMA(ai, bj, At, Bt) do { __builtin_amdgcn_s_setprio(1); _Pragma("unroll") for (int m = 0; m < 4; ++m) _Pragma("unroll") for (int n = 0; n < 2; ++n) _Pragma("unroll") for (int k = 0; k < 2; ++k) \
        acc[ai][bj][m][n] = __builtin_amdgcn_mfma_f32_16x16x32_bf16(Bt[n][k], At[m][k], acc[ai][bj][m][n], 0, 0, 0); __builtin_amdgcn_s_setprio(0); } while (0)
#define PG8_WAIT_V(n) asm volatile("s_waitcnt vmcnt(" #n ")" ::: "memory")
#define PG8_WAIT_L(n) asm volatile("s_waitcnt lgkmcnt(" #n ")" ::: "memory")
#define PG8_BAR __builtin_amdgcn_s_barrier()
#define PG8_SCHED __builtin_amdgcn_sched_barrier(0)
    Unit cur, nxt; int ui = 0;
    if (!S.next(0, cur)) return;
    f32x4 acc[2][2][4][2];
#pragma unroll
    for (int a = 0; a < 2; ++a)
#pragma unroll
        for (int b = 0; b < 2; ++b)
#pragma unroll
            for (int m = 0; m < 4; ++m)
#pragma unroll
                for (int n = 0; n < 2; ++n) acc[a][b][m][n] = (f32x4){0.f, 0.f, 0.f, 0.f};
    bf16x8 At[4][2], B0[2][2], B1[2][2];
    const char* cA = (const char*)g.A + (size_t)cur.pm * tstep; const char* cB = (const char*)g.Bt + (size_t)cur.pn * tstep;
    S.a_ready(cur);
    if constexpr (SP2) {
        PG8_STAGE(PG8_SB(0, 0), cB, voffB); PG8_STAGE(PG8_SB(0, 1), cB + hstep, voffB); PG8_STAGE(PG8_SA(0, 0), cA, voffA); PG8_STAGE(PG8_SA(0, 1), cA + hstep, voffA);
        if (wr == 1) PG8_BAR;
        PG8_WAIT_V(2); PG8_BAR;
        PG8_STAGE(PG8_SB(1, 0), cB + kstep, voffB); PG8_STAGE(PG8_SA(1, 0), cA + kstep, voffA); PG8_STAGE(PG8_SB(1, 1), cB + hstep + kstep, voffB);
        PG8_WAIT_V(6); PG8_BAR;
    } else {
        PG8_STAGE(PG8_SB(0, 0), cB, voffB); PG8_STAGE(PG8_SA(0, 0), cA, voffA); PG8_STAGE(PG8_SB(0, 1), cB + hstep, voffB); PG8_STAGE(PG8_SA(0, 1), cA + hstep, voffA);
        if (wr == 1) PG8_BAR;
        PG8_WAIT_V(4); PG8_BAR;
        PG8_STAGE(PG8_SB(1, 0), cB + kstep, voffB); PG8_STAGE(PG8_SA(1, 0), cA + kstep, voffA); PG8_STAGE(PG8_SB(1, 1), cB + hstep + kstep, voffB);
        PG8_WAIT_V(6); PG8_BAR;
    }
    for (;;) {
        const bool has_next = S.next(ui + 1, nxt);
        const char* nA = has_next ? (const char*)g.A + (size_t)nxt.pm * tstep : cA; const char* nB = has_next ? (const char*)g.Bt + (size_t)nxt.pn * tstep : cB;
        for (int t = 0; t < nt; t += 2) {
            const bool last = (t == nt - 2);
            const char* a1 = cA + (size_t)(t + 1) * kstep;
            const char* a2 = last ? nA : cA + (size_t)(t + 2) * kstep; const char* b2 = last ? nB : cB + (size_t)(t + 2) * kstep;
            const char* a3 = a2 + kstep; const char* b3 = b2 + kstep;
            if (last && has_next) S.a_ready(nxt);
            if constexpr (SP2) {
            PG8_LDB(B0, 0, 0); PG8_LDB(B1, 0, 1); PG8_SCHED; PG8_LDA(At, 0, 0); PG8_STAGE(PG8_SA(1, 1), a1 + hstep, voffA);
            PG8_WAIT_V(8); PG8_WAIT_L(0); PG8_BAR; PG8_MMA(0, 0, At, B0); PG8_MMA(0, 1, At, B1); PG8_BAR; PG8_SCHED;
            PG8_LDA(At, 0, 1); PG8_STAGE(PG8_SB(0, 0), b2, voffB); PG8_STAGE(PG8_SB(0, 1), b2 + hstep, voffB); PG8_STAGE(PG8_SA(0, 0), a2, voffA);
            PG8_WAIT_V(8); PG8_WAIT_L(0); PG8_BAR; PG8_MMA(1, 0, At, B0); PG8_MMA(1, 1, At, B1); PG8_BAR; PG8_SCHED;
            PG8_LDB(B0, 1, 0); PG8_LDB(B1, 1, 1); PG8_SCHED; PG8_LDA(At, 1, 0); PG8_STAGE(PG8_SA(0, 1), a2 + hstep, voffA);
            PG8_WAIT_V(8); PG8_WAIT_L(0); PG8_BAR; PG8_MMA(0, 0, At, B0); PG8_MMA(0, 1, At, B1); PG8_BAR; PG8_SCHED;
            PG8_LDA(At, 1, 1); PG8_STAGE(PG8_SB(1, 0), b3, voffB); PG8_STAGE(PG8_SB(1, 1), b3 + hstep, voffB); PG8_STAGE(PG8_SA(1, 0), a3, voffA);
            PG8_WAIT_V(8); PG8_WAIT_L(0); PG8_BAR; PG8_MMA(1, 0, At, B0); PG8_MMA(1, 1, At, B1); PG8_BAR; PG8_SCHED;
            } else {
            PG8_LDB(B0, 0, 0); PG8_SCHED; PG8_LDA(At, 0, 0); PG8_STAGE(PG8_SA(1, 1), a1 + hstep, voffA);
            PG8_WAIT_L(8); PG8_BAR; PG8_WAIT_L(0); PG8_MMA(0, 0, At, B0); PG8_BAR; PG8_SCHED;
            PG8_LDB(B1, 0, 1); PG8_STAGE(PG8_SB(0, 0), b2, voffB);
            PG8_BAR; PG8_WAIT_L(0); PG8_MMA(0, 1, At, B1); PG8_BAR;
            PG8_LDA(At, 0, 1); PG8_STAGE(PG8_SA(0, 0), a2, voffA);
            PG8_BAR; PG8_WAIT_L(0); PG8_MMA(1, 0, At, B0); PG8_BAR; PG8_SCHED;
            PG8_STAGE(PG8_SB(0, 1), b2 + hstep, voffB);
            PG8_WAIT_V(6); PG8_BAR; PG8_MMA(1, 1, At, B1); PG8_BAR;
            PG8_LDB(B0, 1, 0); PG8_SCHED; PG8_LDA(At, 1, 0); PG8_STAGE(PG8_SA(0, 1), a2 + hstep, voffA);
            PG8_WAIT_L(8); PG8_BAR; PG8_WAIT_L(0); PG8_MMA(0, 0, At, B0); PG8_BAR; PG8_SCHED;
            PG8_LDB(B1, 1, 1); PG8_STAGE(PG8_SB(1, 0), b3, voffB);
            PG8_BAR; PG8_WAIT_L(0); PG8_MMA(0, 1, At, B1); PG8_BAR;
            PG8_LDA(At, 1, 1); PG8_STAGE(PG8_SA(1, 0), a3, voffA);
            PG8_BAR; PG8_WAIT_L(0); PG8_MMA(1, 0, At, B0); PG8_BAR; PG8_SCHED;
            PG8_STAGE(PG8_SB(1, 1), b3 + hstep, voffB);
            PG8_WAIT_V(6); PG8_BAR; PG8_MMA(1, 1, At, B1); PG8_BAR;
            }
        }
        if constexpr (ALIGN_EPI) { if (wr == 0) PG8_BAR; }
        if constexpr (!Epi::AFTER_DRAIN) { E(acc, cur, wr, wc, fr, fq); S.done(cur); }
        if (!has_next) break;
#pragma unroll
        for (int a = 0; a < 2; ++a)
#pragma unroll
            for (int b = 0; b < 2; ++b)
#pragma unroll
                for (int m = 0; m < 4; ++m)
#pragma unroll
                    for (int n = 0; n < 2; ++n) acc[a][b][m][n] = (f32x4){0.f, 0.f, 0.f, 0.f};
        cur = nxt; cA = nA; cB = nB; ++ui;
        if constexpr (ALIGN_EPI) { if (wr == 1) PG8_BAR; }
    }
    PG8_WAIT_V(0);
    if constexpr (!ALIGN_EPI) { if (wr == 0) PG8_BAR; }
    PG8_BAR;
    if constexpr (Epi::AFTER_DRAIN) { E.fused(acc, cur, wr, wc, fr, fq, lds, wid, lane); S.done(cur); }
#undef PG8_SA
#undef PG8_SB
#undef PG8_STAGE
#undef PG8_LDA
#undef PG8_LDB
#undef PG8_MMA
#undef PG8_WAIT_V
#undef PG8_WAIT_L
#undef PG8_BAR
#undef PG8_SCHED
}
}
#ifndef ZMASK
#define ZMASK 0
#endif
#define ZF(bit) ((ZMASK & (bit)) ? 0.f : 1.f)
using pg8::bf16_t; using pg8::bf16x8; using pg8::f32x4; using pg8::u32x4;
constexpr int NWAVES = 8, NTHR = 512;
constexpr int DM = 1024, TLAT = 8192, TCTX = 256, MLAT = 2 * TLAT, MCTX = 2 * TCTX, MALL = MLAT + MCTX;
constexpr int DIN = 3152, DINP = 3328;
constexpr int C_CH = 0, C_CB = 256, C_CC = 512, C_RR = 768, C_RK = 1024, C_RV = 1280, C_XW = 1536, C_XA = 1552, C_XG = 1568,
              C_AQ = 1600, C_AK = 1856, C_AV = 1984, C_MQ = 2112, C_MK = 2368, C_MV = 2624, C_MO = 2880, C_MG = 3136;
constexpr float EPSN = 1e-6f;
constexpr int NCHK = 66;
constexpr int CST = 4160;
constexpr int RWREC = 4608;
constexpr size_t MiB = 1u << 20;
constexpr size_t WS_CTL = 0, CTL_ZERO_BYTES = 1 * MiB, WS_MOD = 1 * MiB;
constexpr size_t WS_WIN = 2 * MiB, WIN_LSTRIDE = (size_t)DINP * DM * 2;
constexpr size_t WS_WOUT = 16 * MiB, WOUT_LSTRIDE = 2 * MiB;
constexpr size_t WS_WEFF = 20 * MiB, WEFF_LSTRIDE = 4 * MiB;
constexpr size_t WS_XC = 28 * MiB, WS_GA = 30 * MiB, WS_H = 32 * MiB, WS_YCAT = 65 * MiB, WS_U = 98 * MiB, WS_V = 130 * MiB;
constexpr size_t WS_P = 162 * MiB, WS_RW = 270 * MiB, WS_YR = 345 * MiB, WS_QA = 378 * MiB, WS_KA = 387 * MiB;
constexpr size_t WS_LC = 392 * MiB, WS_ST = 409 * MiB, WS_LB = 426 * MiB, WS_EG = 427 * MiB, WS_GB = 444 * MiB, WS_BS = 453 * MiB, WS_SC = 453 * MiB + 512 * 1024, WS_END = 454 * MiB;
constexpr size_t UV_LSTRIDE = 16 * MiB;
constexpr size_t WS_S = WS_P;
static_assert(WS_P + (size_t)MALL * DINP * 2 <= WS_RW && WS_RW + (size_t)MALL * RWREC <= WS_YR && WS_S + (size_t)MALL * 2048 * 4 <= WS_YR, "ws map");
static_assert(WS_LC + (size_t)16 * NCHK * CST * 4 <= WS_ST && WS_ST + (size_t)16 * NCHK * CST * 4 <= WS_LB && WS_EG + (size_t)MALL * 128 * 8 <= WS_GB, "ws map 2");
constexpr int CW_BAR = 4096;
constexpr int RING_BYTES = 131072;
constexpr int PEER_WLDS = 16 * 528 + 2048 + 512 + 9 * 512 + 9 * 256 + 64;
constexpr int PHASE_LDS = 8 * PEER_WLDS > RING_BYTES ? 8 * PEER_WLDS : RING_BYTES;
constexpr int LDSCTL_OFF = PHASE_LDS, MISC_OFF = LDSCTL_OFF + 320, LDS_BYTES = PHASE_LDS + 4096;
static_assert(RING_BYTES <= PHASE_LDS && 8 * PEER_WLDS <= PHASE_LDS && LDS_BYTES <= 160 * 1024 && PHASE_LDS % 16 == 0, "LDS map");

#define GAS __attribute__((address_space(1)))
#define LAS __attribute__((address_space(3)))
typedef unsigned u32x2 __attribute__((ext_vector_type(2)));
typedef float f32x2 __attribute__((ext_vector_type(2)));
typedef int i32x8 __attribute__((ext_vector_type(8)));
typedef _Float16 h16x2 __attribute__((ext_vector_type(2)));
typedef __bf16 bf16x2_t __attribute__((ext_vector_type(2)));
typedef GAS unsigned gu32;
#define LDS_WAIT() asm volatile("s_waitcnt lgkmcnt(0)" ::: "memory")
#define LDS_BARRIER() do { asm volatile("s_waitcnt lgkmcnt(0)" ::: "memory"); __builtin_amdgcn_s_barrier(); asm volatile("" ::: "memory"); } while (0)

__device__ __forceinline__ float lo2f(unsigned w) { return __uint_as_float(w << 16); }
__device__ __forceinline__ float hi2f(unsigned w) { return __uint_as_float(w & 0xffff0000u); }
__device__ __forceinline__ float bf2f(bf16_t b) { return __uint_as_float((unsigned)b << 16); }
__device__ __forceinline__ unsigned f2bf(float f) { unsigned u = __float_as_uint(f); return (u + 0x7fffu + ((u >> 16) & 1u)) >> 16; }
__device__ __forceinline__ unsigned pk2(float lo, float hi) { const f32x2 v = {lo, hi}; const bf16x2_t b = __builtin_convertvector(v, bf16x2_t); return __builtin_bit_cast(unsigned, b); }
__device__ __forceinline__ f32x4 ld4bf(const bf16_t* p) { const u32x2 w = *(const u32x2*)p; return (f32x4){lo2f(w.x), hi2f(w.x), lo2f(w.y), hi2f(w.y)}; }
__device__ __forceinline__ void st4bf(bf16_t* p, f32x4 v) { u32x2 w; w.x = pk2(v[0], v[1]); w.y = pk2(v[2], v[3]); *(u32x2*)p = w; }
__device__ __forceinline__ float sigmoidf_(float x) { return 1.f / (1.f + __expf(-x)); }
__device__ __forceinline__ float tanhf_(float x) { const float e = __expf(-2.f * fabsf(x)); const float t = (1.f - e) / (1.f + e); return x < 0.f ? -t : t; }
template <int CTRL> __device__ __forceinline__ float dppf(float x) { return __int_as_float(__builtin_amdgcn_update_dpp(0, __float_as_int(x), CTRL, 0xf, 0xf, true)); }
__device__ __forceinline__ float red16(float x) { x += dppf<0xB1>(x); x += dppf<0x4E>(x); x += dppf<0x141>(x); x += dppf<0x140>(x); return x; }
__device__ __forceinline__ float wave_sum(float v) {
#pragma unroll
    for (int o = 1; o < 64; o <<= 1) v += __shfl_xor(v, o);
    return v;
}
#define XB_TMO      128
#define XB_XCNT(j)  (256  + 64 * (j))
#define XB_XSUB(j)  (1280 + 64 * (j))
#define XB_XGEN(j)  (2304 + 64 * (j))
#define XB_TOP      3328
#define XB_TOPGEN   3392
#define XCD_BAR_WORDS 3456
#define XB_SPIN_CAP (1u << 18)
#ifndef XB_SLEEP
#define XB_SLEEP 1
#endif

__device__ __forceinline__ unsigned xb_ld(unsigned* p)              { return __hip_atomic_load(p, __ATOMIC_RELAXED, __HIP_MEMORY_SCOPE_AGENT); }
__device__ __forceinline__ unsigned xb_add(unsigned* p, unsigned v) { return __hip_atomic_fetch_add(p, v, __ATOMIC_RELAXED, __HIP_MEMORY_SCOPE_AGENT); }
__device__ __forceinline__ unsigned xb_xcc_id() { return (unsigned)__builtin_amdgcn_s_getreg((3 << 11) | 20) & 0xFu; }
#define XB_SPIN(cond, bar) do { unsigned _sp = 0; while (cond) { __builtin_amdgcn_s_sleep(XB_SLEEP); \
    if ((++_sp & 255u) == 0u) { if (xb_ld(&(bar)[XB_TMO])) break; if (_sp > XB_SPIN_CAP) { atomicAdd(&(bar)[XB_TMO], 1u); break; } } } } while (0)

struct XcdBarrier {
    unsigned* bar; unsigned x;
    volatile LAS unsigned* st;
};

__device__ __forceinline__ XcdBarrier xcd_barrier_post(unsigned* bar, volatile LAS unsigned* st) {
    XcdBarrier b; b.bar = bar; b.x = xb_xcc_id(); b.st = st;
    if (threadIdx.x == 0) (void)xb_add(&bar[XB_XCNT(b.x)], 1u);
    return b;
}
__device__ __forceinline__ void xcd_barrier_complete(unsigned* bar, unsigned x, unsigned& nloc, unsigned& nx) {
    const unsigned G = gridDim.x * gridDim.y * gridDim.z;
    unsigned sum, cnt, mine, sp = 0u;
    for (;;) {
        sum = 0u; cnt = 0u; mine = 0u;
#pragma unroll
        for (unsigned j = 0; j < 16; ++j) { const unsigned c = xb_ld(&bar[XB_XCNT(j)]); sum += c; cnt += (c > 0u) ? 1u : 0u; mine = (j == x) ? c : mine; }
        if (sum == G) break;
        __builtin_amdgcn_s_sleep(1);
        if ((++sp & 255u) == 0u) { if (xb_ld(&bar[XB_TMO])) break; if (sp > XB_SPIN_CAP) { atomicAdd(&bar[XB_TMO], 1u); break; } }
    }
    nloc = mine > 0u ? mine : 1u; nx = cnt > 0u ? cnt : 1u;
}

__device__ __forceinline__ void xcd_barrier(const XcdBarrier& b) {
    asm volatile("s_waitcnt vmcnt(0)" ::: "memory");
    __syncthreads();
    if (threadIdx.x == 0) {
        unsigned* bar = b.bar;
        __builtin_amdgcn_s_waitcnt(0);
        unsigned nloc = b.st[0], nx = b.st[1];
        if (nloc == 0u) { xcd_barrier_complete(bar, b.x, nloc, nx); b.st[0] = nloc; b.st[1] = nx; }
        const unsigned old = xb_add(&bar[XB_XSUB(b.x)], 1u);
        const unsigned gen = old / nloc;
        if (old + 1u == (gen + 1u) * nloc) {
            __builtin_amdgcn_fence(__ATOMIC_RELEASE, "agent");
            asm volatile("s_waitcnt vmcnt(0)" ::: "memory");
            const unsigned og = xb_add(&bar[XB_TOP], 1u);
            const unsigned tg = og / nx;
            if (og + 1u == (tg + 1u) * nx) xb_add(&bar[XB_TOPGEN], 1u);
            else XB_SPIN(xb_ld(&bar[XB_TOPGEN]) == tg, bar);
            __builtin_amdgcn_fence(__ATOMIC_ACQUIRE, "agent");
            xb_add(&bar[XB_XGEN(b.x)], 1u);
            asm volatile("s_waitcnt vmcnt(0)" ::: "memory");
        } else {
            XB_SPIN(xb_ld(&bar[XB_XGEN(b.x)]) == gen, bar);
            __builtin_amdgcn_fence(__ATOMIC_ACQUIRE, "agent");
            asm volatile("s_waitcnt vmcnt(0)" ::: "memory");
        }
    }
    __syncthreads();
}
struct Ctx {
    LAS unsigned char* lds; int tid, lane, wave, vcu, G;
    const float* in[32]; float* out; unsigned char* ws;
};
#define WSP(T, off) ((T*)(F.ws + (off)))

__device__ __forceinline__ void p0_transpose_item(const float* W, int K, int N, bf16_t* WT, LAS float* scr, int item, int lane) {
    const int nblk = (N + 31) / 32, kb = item / nblk, nb = item % nblk, k0 = 64 * kb, n0 = 32 * nb;
    const int nn = n0 + (lane & 31);
#pragma unroll 8
    for (int i = 0; i < 32; ++i) { const int kk = 2 * i + (lane >> 5); scr[kk * 33 + (lane & 31)] = nn < N ? W[(size_t)(k0 + kk) * N + nn] : 0.f; }
    LDS_WAIT(); asm volatile("" ::: "memory");
    const int c = lane & 7;
#pragma unroll
    for (int j = 0; j < 4; ++j) { const int n = (lane >> 3) + 8 * j; const LAS float* s = scr + (8 * c) * 33 + n;
        u32x4 o; o.x = pk2(s[0 * 33], s[1 * 33]); o.y = pk2(s[2 * 33], s[3 * 33]); o.z = pk2(s[4 * 33], s[5 * 33]); o.w = pk2(s[6 * 33], s[7 * 33]);
        *(u32x4*)(WT + (size_t)(n0 + n) * K + k0 + 8 * c) = o; }
    LDS_WAIT(); asm volatile("" ::: "memory");
}
__device__ __forceinline__ void convert_uv_rows(const Ctx& F, int l, int r_lo, int r_hi, int widx, int nworkers) {
    float* SC = WSP(float, WS_SC) + (size_t)l * 2 * 16384;
    for (int r0 = r_lo + widx; r0 < r_hi; r0 += 4 * nworkers) {
        f32x4 v[4][4];
#pragma unroll
        for (int u = 0; u < 4; ++u) { const int r = r0 + u * nworkers < r_hi ? r0 + u * nworkers : r0; const int tb = r >> 14, row = r & 16383;
            const float* src = (tb ? F.in[31] : F.in[30]) + ((size_t)l * 16384 + row) * 1024 + F.lane * 16;
#pragma unroll
            for (int j = 0; j < 4; ++j) v[u][j] = *(const f32x4*)(src + 4 * j); }
#pragma unroll
        for (int u = 0; u < 4; ++u) { const int r = r0 + u * nworkers; if (r >= r_hi) break; const int tb = r >> 14, row = r & 16383;
            float am = 0.f;
#pragma unroll
            for (int j = 0; j < 4; ++j) am = fmaxf(am, fmaxf(fmaxf(fabsf(v[u][j][0]), fabsf(v[u][j][1])), fmaxf(fabsf(v[u][j][2]), fabsf(v[u][j][3]))));
#pragma unroll
            for (int o = 1; o < 64; o <<= 1) am = fmaxf(am, __shfl_xor(am, o));
            const float sc = am > 0.f ? 6.f / am : 1.f;
            unsigned ow[2] = {0u, 0u};
#pragma unroll
            for (int j = 0; j < 4; ++j) { unsigned w = ow[j >> 1];
                if (j & 1) { w = __builtin_amdgcn_cvt_scalef32_pk_fp4_f32(w, v[u][j][0] * sc, v[u][j][1] * sc, 1.0f, 2); w = __builtin_amdgcn_cvt_scalef32_pk_fp4_f32(w, v[u][j][2] * sc, v[u][j][3] * sc, 1.0f, 3); }
                else       { w = __builtin_amdgcn_cvt_scalef32_pk_fp4_f32(w, v[u][j][0] * sc, v[u][j][1] * sc, 1.0f, 0); w = __builtin_amdgcn_cvt_scalef32_pk_fp4_f32(w, v[u][j][2] * sc, v[u][j][3] * sc, 1.0f, 1); }
                ow[j >> 1] = w; }
            *(u32x2*)(F.ws + (tb ? WS_V : WS_U) + (size_t)l * UV_LSTRIDE + (size_t)row * 512 + F.lane * 8) = (u32x2){ow[0], ow[1]};
            if (F.lane == 0) SC[tb * 16384 + row] = am > 0.f ? am * (1.f / 6.f) : 1.f; }
    }
}
__device__ __forceinline__ void convert_uv(const Ctx& F, int l) { convert_uv_rows(F, l, 0, 2 * 16384, F.vcu * NWAVES + F.wave, F.G * NWAVES); }
__device__ __forceinline__ void phase_prologue(const Ctx& F) {
    float* MOD = WSP(float, WS_MOD);
    {
        LAS float* sl = (LAS float*)F.lds; LAS float* red = sl + 3072;
        for (int it = F.vcu; it < 192; it += F.G) {
            const int l = it / 96, n0 = (it % 96) * 64;
            for (int i = F.tid; i < 3072; i += NTHR) { const int s = i >> 10, k = i & 1023; const float c = s < 2 ? F.in[1][s * 1024 + k] : F.in[3][k]; sl[i] = c / (1.f + __expf(-c)); }
            __syncthreads();
            const int c = F.tid & 63, kg = F.tid >> 6;
            const float* W = F.in[4] + (size_t)l * 1024 * 6144 + n0 + c;
            float a0 = 0.f, a1 = 0.f, a2 = 0.f;
#pragma unroll 32
            for (int k = kg * 128; k < kg * 128 + 128; ++k) { const float w = W[(size_t)k * 6144]; a0 += sl[k] * w; a1 += sl[1024 + k] * w; a2 += sl[2048 + k] * w; }
            red[(kg * 3 + 0) * 64 + c] = a0; red[(kg * 3 + 1) * 64 + c] = a1; red[(kg * 3 + 2) * 64 + c] = a2;
            __syncthreads();
            if (F.tid < 192) { const int s = F.tid >> 6, cc = F.tid & 63; float t = F.in[5][l * 6144 + n0 + cc];
#pragma unroll
                for (int g = 0; g < 8; ++g) t += red[(g * 3 + s) * 64 + cc];
                MOD[(l * 3 + s) * 6144 + n0 + cc] = t; }
            __syncthreads();
        }
    }
    {
        LAS float* scr = (LAS float*)(F.lds + F.wave * 16384);
        const int gw = F.vcu * NWAVES + F.wave, NGW = F.G * NWAVES;
        constexpr int I_IN = 16 * 99, I_OUT = 16 * 32, I_L = I_IN + I_OUT;
        for (int it = gw; it < 2 * I_L; it += NGW) {
            const int l = it / I_L; int r = it % I_L;
            if (r < I_IN) p0_transpose_item(F.in[8] + (size_t)l * DM * DIN, DM, DIN, WSP(bf16_t, WS_WIN + l * WIN_LSTRIDE), scr, r, F.lane);
            else p0_transpose_item(F.in[9] + (size_t)l * DM * DM, DM, DM, WSP(bf16_t, WS_WOUT + l * WOUT_LSTRIDE), scr, r - I_IN, F.lane);
        }
        for (int i = F.vcu * NTHR + F.tid; i < 2 * 160 * 128; i += F.G * NTHR) { const int l = i / (160 * 128), r = i % (160 * 128);
            *(u32x4*)(WSP(bf16_t, WS_WIN + l * WIN_LSTRIDE) + (size_t)3168 * DM + (size_t)r * 8) = (u32x4){0u, 0u, 0u, 0u}; }
    }
    __syncthreads();
    {
        LAS float* KEYS = (LAS float*)F.lds; LAS float* WQl = KEYS + 128 * 129;
        const int nper = F.G / 32 > 0 ? F.G / 32 : 1;
        const int tile = F.vcu / nper, sub = F.vcu % nper;
        if (tile < 32) {
            const int l = tile >> 4, hh = tile & 15;
            const float* ksrc = F.in[29] + ((size_t)l * 16 + hh) * 128 * 128;
            { f32x4 kv[8];
#pragma unroll
              for (int q = 0; q < 8; ++q) kv[q] = *(const f32x4*)(ksrc + (size_t)(F.tid + q * NTHR) * 4);
#pragma unroll
              for (int q = 0; q < 8; ++q) { const int i = (F.tid + q * NTHR) * 4; LAS float* d = KEYS + (i >> 7) * 129 + (i & 127); d[0] = kv[q][0]; d[1] = kv[q][1]; d[2] = kv[q][2]; d[3] = kv[q][3]; } }
            for (int kb = sub; kb < 16; kb += nper) {
                const float* wsrc = F.in[28] + (size_t)l * DM * 2048 + (size_t)(kb * 64) * 2048 + hh * 128;
                __syncthreads();
                { f32x4 wv[4];
#pragma unroll
                  for (int q = 0; q < 4; ++q) { const int i = (F.tid + q * NTHR) * 4; wv[q] = *(const f32x4*)(wsrc + (size_t)(i >> 7) * 2048 + (i & 127)); }
#pragma unroll
                  for (int q = 0; q < 4; ++q) { const int i = (F.tid + q * NTHR) * 4, kk = i >> 7, d = i & 127; WQl[d * 68 + kk] = wv[q][0]; WQl[(d + 1) * 68 + kk] = wv[q][1]; WQl[(d + 2) * 68 + kk] = wv[q][2]; WQl[(d + 3) * 68 + kk] = wv[q][3]; } }
                __syncthreads();
                const int key = F.tid & 127, kq = F.tid >> 7;
                float acc[16];
#pragma unroll
                for (int j = 0; j < 16; ++j) acc[j] = 0.f;
#pragma unroll 4
                for (int d = 0; d < 128; ++d) { const float a = KEYS[key * 129 + d]; const LAS f32x4* wq = (const LAS f32x4*)(WQl + d * 68 + kq * 16);
#pragma unroll
                    for (int q = 0; q < 4; ++q) { const f32x4 w = wq[q]; acc[4 * q] += a * w[0]; acc[4 * q + 1] += a * w[1]; acc[4 * q + 2] += a * w[2]; acc[4 * q + 3] += a * w[3]; } }
                bf16_t* dst = WSP(bf16_t, WS_WEFF + l * WEFF_LSTRIDE) + (size_t)(hh * 128 + key) * DM + kb * 64 + kq * 16;
                u32x4 o0, o1; o0.x = pk2(acc[0], acc[1]); o0.y = pk2(acc[2], acc[3]); o0.z = pk2(acc[4], acc[5]); o0.w = pk2(acc[6], acc[7]);
                o1.x = pk2(acc[8], acc[9]); o1.y = pk2(acc[10], acc[11]); o1.z = pk2(acc[12], acc[13]); o1.w = pk2(acc[14], acc[15]);
                *(u32x4*)dst = o0; *(u32x4*)(dst + 8) = o1;
            }
        }
        __syncthreads();
    }
    convert_uv(F, 0); convert_uv(F, 1);
}

__device__ __forceinline__ void phase_norm(const Ctx& F, int l, int which, int nrows, const float* xlat, const float* xctx) {
    const float* gain = F.in[6 + which] + l * DM; const float* mod = WSP(float, WS_MOD) + (size_t)l * 3 * 6144;
    const int shoff = which ? 3072 : 0, scoff = which ? 4096 : 1024;
    bf16_t* H = WSP(bf16_t, WS_H);
    const int gw = F.vcu * NWAVES + F.wave, NGW = F.G * NWAVES;
    for (int row = gw; row < nrows; row += NGW) {
        const bool isc = row >= MLAT; const float* src = isc ? xctx + (size_t)(row - MLAT) * DM : xlat + (size_t)row * DM; const int smp = isc ? 2 : (row >> 13);
        const float* mb = mod + smp * 6144;
        f32x4 v[4]; float ss = 0.f;
#pragma unroll
        for (int j = 0; j < 4; ++j) { v[j] = *(const f32x4*)(src + F.lane * 4 + 256 * j); ss += (v[j][0] * v[j][0] + v[j][1] * v[j][1]) + (v[j][2] * v[j][2] + v[j][3] * v[j][3]); }
        const float rs = rsqrtf(wave_sum(ss) * (1.f / DM) + EPSN);
#pragma unroll
        for (int j = 0; j < 4; ++j) { const int c = F.lane * 4 + 256 * j; const f32x4 g = *(const f32x4*)(gain + c), sc = *(const f32x4*)(mb + scoff + c), sh = *(const f32x4*)(mb + shoff + c);
            const f32x4 o = (v[j] * rs * g) * (1.f + sc) + sh; st4bf(H + (size_t)row * DM + c, o); }
    }
}

__device__ __forceinline__ float log_sigmoid_(float x) { return fminf(x, 0.f) - __logf(1.f + __expf(-fabsf(x))); }
__device__ __forceinline__ void phase_prep(const Ctx& F, int l) {
    LAS float* W2s = (LAS float*)F.lds; LAS float* A2s = W2s + 8192; LAS float* G2s = A2s + 8192; LAS float* tsc = G2s + 8192 + F.wave * 64;
    { const float* w2 = F.in[13] + l * 8192; const float* a2 = F.in[15] + l * 8192; const float* g2 = F.in[16] + l * 8192;
      for (int i = F.tid; i < 8192; i += NTHR) { W2s[i] = w2[i]; A2s[i] = a2[i]; G2s[i] = g2[i]; } }
    __syncthreads();
    const bf16_t* P = WSP(bf16_t, WS_P); bf16_t* YC = WSP(bf16_t, WS_YCAT); bf16_t* QA = WSP(bf16_t, WS_QA); bf16_t* KA = WSP(bf16_t, WS_KA);
    unsigned char* RW = WSP(unsigned char, WS_RW); bf16_t* GB = WSP(bf16_t, WS_GB); float* BS = WSP(float, WS_BS); float* GA = WSP(float, WS_GA);
    const int lane = F.lane, c4 = lane * 4, i16 = lane & 15;
    const f32x4 cw0 = *(const f32x4*)(F.in[10] + l * 768 + c4), cw1 = *(const f32x4*)(F.in[10] + l * 768 + 256 + c4), cw2 = *(const f32x4*)(F.in[10] + l * 768 + 512 + c4);
    const f32x4 cg = *(const f32x4*)(F.in[11] + l * 256 + c4);
    const f32x4 qg = *(const f32x4*)(F.in[21] + l * 64 + (c4 & 63)), kg = *(const f32x4*)(F.in[22] + l * 64 + (c4 & 63));
    const f32x4 k_k = *(const f32x4*)(F.in[17] + l * 256 + c4), k_a = *(const f32x4*)(F.in[18] + l * 256 + c4), r_k = *(const f32x4*)(F.in[19] + l * 256 + c4);
    f32x4 w0[2], a0[2];
#pragma unroll
    for (int d = 0; d < 2; ++d) { w0[d] = *(const f32x4*)(F.in[12] + (l * 2 + d) * 256 + c4); a0[d] = *(const f32x4*)(F.in[14] + (l * 2 + d) * 256 + c4); }
    float invf[4];
#pragma unroll
    for (int j = 0; j < 4; ++j) invf[j] = exp2f(-(float)((c4 + j) & 15) * (13.287712379549449f / 16.f));
    const int gw = F.vcu * NWAVES + F.wave, NGW = F.G * NWAVES;
    struct PrepRaw { u32x2 h1, bg, c1, hp, cp, hn, cn, q, k, r, rk; unsigned xv, mg; };
#define PREP_LOAD(dst, row_) do { const int r_ = (row_); const bool isc_ = r_ >= MLAT; const int t_ = isc_ ? ((r_ - MLAT) & 255) : (r_ & 8191); const int T_ = isc_ ? TCTX : TLAT; \
        const bf16_t* pr_ = P + (size_t)r_ * DINP; const bf16_t* pp_ = t_ > 0 ? pr_ - DINP : pr_; const bf16_t* pn_ = t_ < T_ - 1 ? pr_ + DINP : pr_; \
        dst.h1 = *(const u32x2*)(pr_ + C_CH + c4); dst.bg = *(const u32x2*)(pr_ + C_CB + c4); dst.c1 = *(const u32x2*)(pr_ + C_CC + c4); \
        dst.hp = *(const u32x2*)(pp_ + C_CH + c4); dst.cp = *(const u32x2*)(pp_ + C_CC + c4); dst.hn = *(const u32x2*)(pn_ + C_CH + c4); dst.cn = *(const u32x2*)(pn_ + C_CC + c4); \
        dst.q = *(const u32x2*)(pr_ + C_AQ + c4); dst.k = *(const u32x2*)(pr_ + C_AK + (c4 & 127)); dst.r = *(const u32x2*)(pr_ + C_RR + c4); dst.rk = *(const u32x2*)(pr_ + C_RK + c4); \
        dst.xv = pr_[C_XW + lane]; dst.mg = pr_[C_MG + (lane & 15)]; } while (0)
#define UP4(w_) ((f32x4){lo2f((w_).x), hi2f((w_).x), lo2f((w_).y), hi2f((w_).y)})
    PrepRaw cur, nxt;
    if (gw < MALL) PREP_LOAD(cur, gw);
    for (int row = gw; row < MALL; row += NGW) {
        const bool isc = row >= MLAT; const int t = isc ? ((row - MLAT) & 255) : (row & 8191); const int T = isc ? TCTX : TLAT;
        { const int rn = row + NGW < MALL ? row + NGW : row; PREP_LOAD(nxt, rn); }
        {
            const f32x4 h1 = UP4(cur.h1), bg = UP4(cur.bg), c1 = UP4(cur.c1);
            f32x4 up = UP4(cur.hp) * UP4(cur.cp), un = UP4(cur.hn) * UP4(cur.cn);
            if (t == 0) up = (f32x4){0.f, 0.f, 0.f, 0.f};
            if (t == T - 1) un = (f32x4){0.f, 0.f, 0.f, 0.f};
            const f32x4 y = bg * (cw0 * up + cw1 * (c1 * h1) + cw2 * un);
            const float ss = red16((y[0] * y[0] + y[1] * y[1]) + (y[2] * y[2] + y[3] * y[3]));
            const float rs = rsqrtf(ss * (1.f / 64.f) + EPSN);
            st4bf(YC + (size_t)row * DM + c4, y * rs * cg * ZF(2));
        }
        {
            const f32x4 q = UP4(cur.q); const f32x4 k = UP4(cur.k);
            const float qs = red16((q[0] * q[0] + q[1] * q[1]) + (q[2] * q[2] + q[3] * q[3]));
            const float ks = red16((k[0] * k[0] + k[1] * k[1]) + (k[2] * k[2] + k[3] * k[3]));
            f32x4 qn = q * rsqrtf(qs * (1.f / 64.f) + EPSN) * qg, kn = k * rsqrtf(ks * (1.f / 64.f) + EPSN) * kg;
            if (!isc) {
                f32x4 qp, kp;
#pragma unroll
                for (int j = 0; j < 4; ++j) { qp[j] = __shfl_xor(qn[j], 4); kp[j] = __shfl_xor(kn[j], 4); }
                const int d0 = c4 & 63; const float pos = (d0 < 32) ? (float)(t >> 6) : (float)(t & 63); const bool lowh = (d0 & 16) == 0;
#pragma unroll
                for (int j = 0; j < 4; ++j) { const float th = pos * invf[j]; const float cs = __cosf(th), sn = __sinf(th);
                    qn[j] = lowh ? qn[j] * cs - qp[j] * sn : qn[j] * cs + qp[j] * sn; kn[j] = lowh ? kn[j] * cs - kp[j] * sn : kn[j] * cs + kp[j] * sn; }
            }
            st4bf(QA + (size_t)row * 256 + c4, qn * (0.125f * 1.4426950408889634f));
            if (lane < 32) st4bf(KA + (size_t)row * 128 + c4, kn);
        }
        {
            const f32x4 r = UP4(cur.r), k = UP4(cur.rk);
            { const float xv = bf2f((bf16_t)cur.xv);
              tsc[lane] = lane < 16 ? tanhf_(xv) : (lane < 32 ? xv : sigmoidf_(xv)); }
            const f32x4 kx = k * k_k;
            const float kss = red16((kx[0] * kx[0] + kx[1] * kx[1]) + (kx[2] * kx[2] + kx[3] * kx[3]));
            const f32x4 kk = kx * rsqrtf(kss + EPSN);
            bf16_t* recb = (bf16_t*)(RW + (size_t)row * RWREC); float* recf = (float*)(RW + (size_t)row * RWREC + 2560);
            st4bf(recb + c4, kk);
            f32x4 kdsum = {0.f, 0.f, 0.f, 0.f};
#pragma unroll
            for (int d = 0; d < 2; ++d) {
                f32x4 dw = w0[d], da = a0[d];
#pragma unroll 4
                for (int ii = 0; ii < 16; ++ii) { dw += tsc[ii] * *(const LAS f32x4*)(W2s + (d * 16 + ii) * 256 + c4); da += tsc[16 + ii] * *(const LAS f32x4*)(A2s + (d * 16 + ii) * 256 + c4); }
                f32x4 dec, av;
#pragma unroll
                for (int j = 0; j < 4; ++j) { dec[j] = -0.6065306597126334f * sigmoidf_(dw[j]); av[j] = sigmoidf_(da[j]); }
                const f32x4 kd = k * (1.f + (av - 1.f) * k_a);
                kdsum += kd;
                st4bf(recb + 256 + d * 256 + c4, kk * av);
                st4bf(recb + 768 + d * 256 + c4, kd);
                *(f32x4*)(recf + d * 256 + c4) = dec;
            }
            f32x4 gv = {0.f, 0.f, 0.f, 0.f};
#pragma unroll 4
            for (int ii = 0; ii < 32; ++ii) gv += tsc[32 + ii] * *(const LAS f32x4*)(G2s + ii * 256 + c4);
            st4bf(GB + (size_t)row * 256 + c4, gv);
            const f32x4 bt = r * kdsum * r_k;
            const float bsum = red16((bt[0] + bt[1]) + (bt[2] + bt[3]));
            if (i16 == 0) BS[(size_t)row * 4 + (lane >> 4)] = bsum;
        }
        if (lane < 16) { const int dir = lane >> 3, gate = (lane >> 2) & 1, hd = lane & 3; const float x = bf2f((bf16_t)cur.mg);
            const float bias = gate ? F.in[26][(l * 2 + dir) * 4 + hd] : F.in[25][(l * 2 + dir) * 4 + hd];
            GA[(size_t)row * 16 + lane] = gate ? log_sigmoid_(x + bias) : (x + bias); }
        cur = nxt;
    }
#undef PREP_LOAD
#undef UP4
}
__device__ __forceinline__ int scan_row(int b, int dir, int i) {
    if (i < TCTX) return MLAT + b * TCTX + (dir ? (TCTX - 1 - i) : i);
    const int p = i - TCTX; return b * TLAT + (dir ? (TLAT - 1 - p) : p);
}
__device__ __forceinline__ void rwkv_scan(const Ctx& F, int blk) {
    const int chain = blk >> 2, quarter = blk & 3, b = chain >> 3, head = (chain >> 1) & 3, dir = chain & 1;
    const bool scanner = F.wave < 4;
    const int rowv = (quarter * 4 + (F.wave & 3)) * 4 + (F.lane >> 4), s = F.lane & 15;
    LAS float* buf = (LAS float*)F.lds;
    const bf16_t* P = WSP(bf16_t, WS_P); const unsigned char* RW = WSP(unsigned char, WS_RW); float* YR = WSP(float, WS_YR) + (size_t)dir * MALL * 256;
    const int st = F.tid >> 4, sub = F.tid & 15;
    constexpr int NSTEP = TCTX + TLAT, NCH = NSTEP / 32;
    u32x2 g_kk, g_al, g_kd, g_r, g_v; f32x4 g_w;
#define RW_LOAD(c) do { const int row_ = scan_row(b, dir, (c) * 32 + st); const bf16_t* rb_ = (const bf16_t*)(RW + (size_t)row_ * RWREC) + head * 64 + sub * 4; \
        g_kk = *(const u32x2*)rb_; g_al = *(const u32x2*)(rb_ + 256 + dir * 256); g_kd = *(const u32x2*)(rb_ + 768 + dir * 256); \
        g_w = *(const f32x4*)((const float*)(RW + (size_t)row_ * RWREC + 2560) + dir * 256 + head * 64 + sub * 4); \
        const bf16_t* pp_ = P + (size_t)row_ * DINP + head * 64 + sub * 4; g_r = *(const u32x2*)(pp_ + C_RR); g_v = *(const u32x2*)(pp_ + C_RV); } while (0)
#define RW_STORE(par) do { LAS float* d_ = buf + ((par) * 32 + st) * 384 + sub * 4; \
        *(LAS f32x4*)(d_) = (f32x4){lo2f(g_kk.x), hi2f(g_kk.x), lo2f(g_kk.y), hi2f(g_kk.y)}; *(LAS f32x4*)(d_ + 64) = (f32x4){lo2f(g_al.x), hi2f(g_al.x), lo2f(g_al.y), hi2f(g_al.y)}; \
        *(LAS f32x4*)(d_ + 128) = (f32x4){lo2f(g_kd.x), hi2f(g_kd.x), lo2f(g_kd.y), hi2f(g_kd.y)}; *(LAS f32x4*)(d_ + 192) = g_w; \
        *(LAS f32x4*)(d_ + 256) = (f32x4){lo2f(g_r.x), hi2f(g_r.x), lo2f(g_r.y), hi2f(g_r.y)}; *(LAS f32x4*)(d_ + 320) = (f32x4){lo2f(g_v.x), hi2f(g_v.x), lo2f(g_v.y), hi2f(g_v.y)}; } while (0)
    f32x4 S = {0.f, 0.f, 0.f, 0.f};
    RW_LOAD(0); RW_STORE(0); __syncthreads();
    for (int c = 0; c < NCH; ++c) {
        const int par = c & 1;
        if (c + 1 < NCH) RW_LOAD(c + 1);
        if (scanner) {
        float ykeep = 0.f;
        f32x4 Lkk[3], Lal[3], Lkd[3], Lw[3], Lr[3]; float Lv[3];
#define SC_LD(set, i_) do { const LAS float* d_ = buf + (par * 32 + (i_)) * 384; Lkk[set] = *(const LAS f32x4*)(d_ + s * 4); Lal[set] = *(const LAS f32x4*)(d_ + 64 + s * 4); \
            Lkd[set] = *(const LAS f32x4*)(d_ + 128 + s * 4); Lw[set] = *(const LAS f32x4*)(d_ + 192 + s * 4); Lr[set] = *(const LAS f32x4*)(d_ + 256 + s * 4); Lv[set] = d_[320 + rowv]; } while (0)
        SC_LD(0, 0); SC_LD(1, 1);
#pragma unroll
        for (int i = 0; i < 32; ++i) {
            if (i + 2 < 32) SC_LD((i + 2) % 3, i + 2);
            const f32x4 kk = Lkk[i % 3], al = Lal[i % 3], kd = Lkd[i % 3], w = Lw[i % 3], r = Lr[i % 3]; const float vr = Lv[i % 3];
            const float sa = red16((S[0] * kk[0] + S[1] * kk[1]) + (S[2] * kk[2] + S[3] * kk[3]));
            S = S * w + (vr * kd - sa * al);
            const float y = red16((S[0] * r[0] + S[1] * r[1]) + (S[2] * r[2] + S[3] * r[3]));
            ykeep = (s == (i & 15)) ? y : ykeep;
            if ((i & 15) == 15) {
                const int stp = c * 32 + (i - 15) + s; const int pc = dir ? (TCTX - 1 - stp) : stp, pl = dir ? (TLAT - 1 - (stp - TCTX)) : (stp - TCTX);
                const int row = stp < TCTX ? (MLAT + b * TCTX + pc) : (b * TLAT + pl);
                YR[(size_t)row * 256 + head * 64 + rowv] = ykeep; }
        }
#undef SC_LD
        }
        if (c + 1 < NCH) RW_STORE(par ^ 1);
        __syncthreads();
    }
#undef RW_LOAD
#undef RW_STORE
}

typedef union { u32x4 u; bf16x8 b; } frag_u;
__device__ __forceinline__ void attn_unit(const Ctx& F, int l, int unit) {
    LAS bf16_t* Kl = (LAS bf16_t*)F.lds; LAS bf16_t* Vt = Kl + 64 * 72;
    const bf16_t* P = WSP(bf16_t, WS_P); const bf16_t* QA = WSP(bf16_t, WS_QA); const bf16_t* KA = WSP(bf16_t, WS_KA); bf16_t* YC = WSP(bf16_t, WS_YCAT);
    const bool isc = unit >= 256; int b, kvh, n;
    if (!isc) { b = unit >> 7; kvh = (unit >> 6) & 1; n = unit & 63; } else { const int u = unit - 256; b = u >> 2; kvh = (u >> 1) & 1; n = u & 1; }
    const int g = F.wave >> 2, ps = F.wave & 3, head = kvh * 2 + g, i = F.lane & 15, gq = F.lane >> 4;
    const int qpos0 = n * 128 + ps * 32, qrow0 = (isc ? MLAT + b * TCTX : b * TLAT) + qpos0;
    bf16x8 Qf[2][2];
#pragma unroll
    for (int qb = 0; qb < 2; ++qb)
#pragma unroll
        for (int ks = 0; ks < 2; ++ks) Qf[qb][ks] = *(const bf16x8*)(QA + (size_t)(qrow0 + qb * 16 + i) * 256 + head * 64 + ks * 32 + gq * 8);
    const float sinkl = F.in[23][l * 4 + head] * 1.4426950408889634f;
    float mrun[2] = {sinkl, sinkl}, lsum[2]; lsum[0] = lsum[1] = (gq == 0) ? 1.f : 0.f;
    f32x4 ao[4][2];
#pragma unroll
    for (int db = 0; db < 4; ++db) { ao[db][0] = (f32x4){0.f, 0.f, 0.f, 0.f}; ao[db][1] = (f32x4){0.f, 0.f, 0.f, 0.f}; }
    const int ntl = isc ? 4 : 10;
    const int skey = F.tid >> 3, sch = F.tid & 7;
#define ATT_KROW(tt_) ((!isc && (tt_) < 6) ? ((2 * (n - 1) + (tt_) < 0 || 2 * (n - 1) + (tt_) >= 128) ? -1 : b * TLAT + (2 * (n - 1) + (tt_)) * 64) : MLAT + b * TCTX + (isc ? (tt_) : (tt_) - 6) * 64)
#define ATT_LOAD(tt_) do { const int kr_ = ATT_KROW(tt_); if (kr_ >= 0) { pk_kv = *(const u32x4*)(KA + (size_t)(kr_ + skey) * 128 + kvh * 64 + sch * 8); pk_vv = *(const u32x4*)(P + (size_t)(kr_ + skey) * DINP + C_AV + kvh * 64 + sch * 8); } } while (0)
    u32x4 pk_kv = {0u, 0u, 0u, 0u}, pk_vv = {0u, 0u, 0u, 0u};
    int tt0 = 0; while (tt0 < ntl && ATT_KROW(tt0) < 0) ++tt0;
    ATT_LOAD(tt0);
    for (int tt = tt0; tt < ntl; ++tt) {
        const int krow0 = ATT_KROW(tt); if (krow0 < 0) continue;
        const bool band = !isc && tt < 6; const int kpos0 = band ? (2 * (n - 1) + tt) * 64 : 0;
        LDS_BARRIER();
        { const u32x4 kv = pk_kv, vv = pk_vv;
          *(LAS u32x4*)(Kl + skey * 72 + sch * 8) = kv;
          const unsigned ww[4] = {vv.x, vv.y, vv.z, vv.w};
#pragma unroll
          for (int j = 0; j < 4; ++j) { Vt[(sch * 8 + 2 * j) * 72 + skey] = (bf16_t)(ww[j] & 0xffffu); Vt[(sch * 8 + 2 * j + 1) * 72 + skey] = (bf16_t)(ww[j] >> 16); } }
        { int tn = tt + 1; while (tn < ntl && ATT_KROW(tn) < 0) ++tn; if (tn < ntl) ATT_LOAD(tn); }
        LDS_BARRIER();
        f32x4 sc[4][2];
#pragma unroll
        for (int kb = 0; kb < 4; ++kb) {
            sc[kb][0] = (f32x4){0.f, 0.f, 0.f, 0.f}; sc[kb][1] = (f32x4){0.f, 0.f, 0.f, 0.f};
#pragma unroll
            for (int ks = 0; ks < 2; ++ks) { const bf16x8 kf = *(const LAS bf16x8*)(Kl + (kb * 16 + i) * 72 + ks * 32 + gq * 8);
                sc[kb][0] = __builtin_amdgcn_mfma_f32_16x16x32_bf16(kf, Qf[0][ks], sc[kb][0], 0, 0, 0);
                sc[kb][1] = __builtin_amdgcn_mfma_f32_16x16x32_bf16(kf, Qf[1][ks], sc[kb][1], 0, 0, 0); }
        }
#pragma unroll
        for (int qb = 0; qb < 2; ++qb) {
            const int qp = qpos0 + qb * 16 + i;
            float mx = -1e30f;
#pragma unroll
            for (int kb = 0; kb < 4; ++kb)
#pragma unroll
                for (int r = 0; r < 4; ++r) { if (band) { const int dd = (kpos0 + kb * 16 + 4 * gq + r) - qp; if (dd > 128 || dd < -128) sc[kb][qb][r] = -1e30f; } mx = fmaxf(mx, sc[kb][qb][r]); }
            mx = fmaxf(mx, __shfl_xor(mx, 16)); mx = fmaxf(mx, __shfl_xor(mx, 32));
            const float mnew = fmaxf(mrun[qb], mx), alpha = exp2f(mrun[qb] - mnew); mrun[qb] = mnew;
            float ps_ = 0.f;
#pragma unroll
            for (int kb = 0; kb < 4; ++kb)
#pragma unroll
                for (int r = 0; r < 4; ++r) { const float p = exp2f(sc[kb][qb][r] - mnew); sc[kb][qb][r] = p; ps_ += p; }
            lsum[qb] = lsum[qb] * alpha + ps_;
#pragma unroll
            for (int db = 0; db < 4; ++db) ao[db][qb] *= alpha;
        }
#pragma unroll
        for (int ks2 = 0; ks2 < 2; ++ks2) {
            frag_u pf[2];
#pragma unroll
            for (int qb = 0; qb < 2; ++qb) { pf[qb].u.x = pg8::cvt_pk_bf16(sc[2 * ks2][qb][0], sc[2 * ks2][qb][1]); pf[qb].u.y = pg8::cvt_pk_bf16(sc[2 * ks2][qb][2], sc[2 * ks2][qb][3]);
                pf[qb].u.z = pg8::cvt_pk_bf16(sc[2 * ks2 + 1][qb][0], sc[2 * ks2 + 1][qb][1]); pf[qb].u.w = pg8::cvt_pk_bf16(sc[2 * ks2 + 1][qb][2], sc[2 * ks2 + 1][qb][3]); }
#pragma unroll
            for (int db = 0; db < 4; ++db) { frag_u vf; const LAS bf16_t* vp = Vt + (db * 16 + i) * 72 + (2 * ks2) * 16 + 4 * gq;
                const u32x2 v0 = *(const LAS u32x2*)vp, v1 = *(const LAS u32x2*)(vp + 16); vf.u = (u32x4){v0.x, v0.y, v1.x, v1.y};
                ao[db][0] = __builtin_amdgcn_mfma_f32_16x16x32_bf16(vf.b, pf[0].b, ao[db][0], 0, 0, 0);
                ao[db][1] = __builtin_amdgcn_mfma_f32_16x16x32_bf16(vf.b, pf[1].b, ao[db][1], 0, 0, 0); }
        }
    }
#undef ATT_KROW
#undef ATT_LOAD
    const float* og = F.in[24] + l * 256 + head * 64;
#pragma unroll
    for (int qb = 0; qb < 2; ++qb) {
        float lt = lsum[qb]; lt += __shfl_xor(lt, 16); lt += __shfl_xor(lt, 32);
        const float il = 1.f / lt; float ss = 0.f;
#pragma unroll
        for (int db = 0; db < 4; ++db) { ao[db][qb] *= il; ss += (ao[db][qb][0] * ao[db][qb][0] + ao[db][qb][1] * ao[db][qb][1]) + (ao[db][qb][2] * ao[db][qb][2] + ao[db][qb][3] * ao[db][qb][3]); }
        ss += __shfl_xor(ss, 16); ss += __shfl_xor(ss, 32);
        const float rs = rsqrtf(ss * (1.f / 64.f) + EPSN);
        bf16_t* yo = YC + (size_t)(qrow0 + qb * 16 + i) * DM + 512 + head * 64;
#pragma unroll
        for (int db = 0; db < 4; ++db) { const f32x4 gg = *(const f32x4*)(og + db * 16 + 4 * gq); st4bf(yo + db * 16 + 4 * gq, ao[db][qb] * rs * gg * ZF(8)); }
    }
    __syncthreads();
}

__device__ __forceinline__ int ml_row(int b, int dir, int j, int tp) {
    if (j < 2) { const int p = j * 128 + tp; return MLAT + b * TCTX + (dir ? (TCTX - 1 - p) : p); }
    const int p = (j - 2) * 128 + tp; return b * TLAT + (dir ? (TLAT - 1 - p) : p);
}
__device__ __forceinline__ void scan128_add(float& x0, float& x1, int lane) {
    x1 += x0; float t = x1;
#pragma unroll
    for (int o = 1; o < 64; o <<= 1) { const float u = __shfl_up(t, o); if (lane >= o) t += u; }
    const float ex = t - x1; x0 += ex; x1 = t;
}
__device__ __forceinline__ void scan128_max(float& x0, float& x1, int lane) {
    x1 = fmaxf(x1, x0); float t = x1;
#pragma unroll
    for (int o = 1; o < 64; o <<= 1) { const float u = __shfl_up(t, o); if (lane >= o) t = fmaxf(t, u); }
    const float pv = __shfl_up(t, 1); if (lane > 0) x0 = fmaxf(x0, pv); x1 = t;
}
__device__ __forceinline__ void ml_stage_T(const Ctx& F, const bf16_t* P, int b, int dir, int j, int col0, LAS bf16_t* dst, const LAS float* sw, float cscale) {
#pragma unroll
    for (int it = 0; it < 2; ++it) { const int id = F.tid + it * NTHR, tp = id >> 3, ch = id & 7;
        const u32x4 v = *(const u32x4*)(P + (size_t)ml_row(b, dir, j, tp) * DINP + col0 + ch * 8); const float s = (sw ? sw[tp] : 1.f) * cscale;
        const unsigned ww[4] = {v.x, v.y, v.z, v.w};
#pragma unroll
        for (int q = 0; q < 4; ++q) { dst[(ch * 8 + 2 * q) * 136 + tp] = (bf16_t)f2bf(lo2f(ww[q]) * s); dst[(ch * 8 + 2 * q + 1) * 136 + tp] = (bf16_t)f2bf(hi2f(ww[q]) * s); } }
}
__device__ __forceinline__ void ml_stage_R(const Ctx& F, const bf16_t* P, int b, int dir, int j, int col0, LAS bf16_t* dst, float cscale) {
#pragma unroll
    for (int it = 0; it < 2; ++it) { const int id = F.tid + it * NTHR, tp = id >> 3, ch = id & 7;
        u32x4 v = *(const u32x4*)(P + (size_t)ml_row(b, dir, j, tp) * DINP + col0 + ch * 8);
        if (cscale != 1.f) { v.x = pk2(lo2f(v.x) * cscale, hi2f(v.x) * cscale); v.y = pk2(lo2f(v.y) * cscale, hi2f(v.y) * cscale); v.z = pk2(lo2f(v.z) * cscale, hi2f(v.z) * cscale); v.w = pk2(lo2f(v.w) * cscale, hi2f(v.w) * cscale); }
        *(LAS u32x4*)(dst + tp * 72 + ch * 8) = v; }
}
__device__ __forceinline__ void mlstm_local(const Ctx& F, int task) {
    const int chain = task / NCHK, j = task % NCHK, b = chain >> 3, head = (chain >> 1) & 3, dir = chain & 1;
    const bf16_t* P = WSP(bf16_t, WS_P); const float* GA = WSP(float, WS_GA);
    LAS bf16_t* Vt = (LAS bf16_t*)F.lds; LAS bf16_t* Kt = Vt + 64 * 136; LAS float* wS = (LAS float*)(Kt + 64 * 136); LAS float* sc2 = wS + 128;
    __syncthreads();
    if (F.wave == 0) {
        const int r0 = ml_row(b, dir, j, 2 * F.lane), r1 = ml_row(b, dir, j, 2 * F.lane + 1);
        const float li0 = GA[(size_t)r0 * 16 + dir * 8 + head], li1 = GA[(size_t)r1 * 16 + dir * 8 + head];
        float b0 = GA[(size_t)r0 * 16 + dir * 8 + 4 + head], b1 = GA[(size_t)r1 * 16 + dir * 8 + 4 + head];
        scan128_add(b0, b1, F.lane);
        const float bend = __shfl(b1, 63);
        const float d0 = bend - b0 + li0, d1 = bend - b1 + li1;
        float mx = fmaxf(d0, d1);
#pragma unroll
        for (int o = 1; o < 64; o <<= 1) mx = fmaxf(mx, __shfl_xor(mx, o));
        wS[2 * F.lane] = __expf(d0 - mx); wS[2 * F.lane + 1] = __expf(d1 - mx);
        if (F.lane == 0) { sc2[0] = mx; sc2[1] = bend; }
    }
    __syncthreads();
    ml_stage_T(F, P, b, dir, j, C_MV + head * 64, Vt, wS, 1.f);
    ml_stage_T(F, P, b, dir, j, C_MK + head * 64, Kt, nullptr, 0.125f);
    __syncthreads();
    float* LC = WSP(float, WS_LC) + (size_t)task * CST;
    { const int vb = F.wave >> 1, i = F.lane & 15, gq = F.lane >> 4;
#pragma unroll
      for (int kk2 = 0; kk2 < 2; ++kk2) { const int kb = 2 * (F.wave & 1) + kk2; f32x4 acc = {0.f, 0.f, 0.f, 0.f};
#pragma unroll
          for (int ks = 0; ks < 4; ++ks) { const bf16x8 a = *(const LAS bf16x8*)(Vt + (vb * 16 + i) * 136 + ks * 32 + gq * 8), bb = *(const LAS bf16x8*)(Kt + (kb * 16 + i) * 136 + ks * 32 + gq * 8);
              acc = __builtin_amdgcn_mfma_f32_16x16x32_bf16(a, bb, acc, 0, 0, 0); }
#pragma unroll
          for (int r = 0; r < 4; ++r) LC[(vb * 16 + 4 * gq + r) * 64 + kb * 16 + i] = acc[r]; } }
    if (F.tid < 64) { float a = 0.f;
#pragma unroll 8
        for (int s = 0; s < 128; ++s) a += wS[s] * bf2f(Kt[F.tid * 136 + s]);
        LC[4096 + F.tid] = a; }
    if (F.tid == 0) { float* LB = WSP(float, WS_LB); LB[task * 2] = sc2[0]; LB[task * 2 + 1] = sc2[1]; }
}
__device__ __forceinline__ void mlstm_chain(const Ctx& F, int blk0) {
    const int gt = (F.vcu - blk0) * NTHR + F.tid; if (gt < 0 || gt >= 16 * CST) return;
    const int chain = gt / CST, e = gt % CST;
    const float* LC = WSP(float, WS_LC) + (size_t)chain * NCHK * CST + e; float* ST = WSP(float, WS_ST) + (size_t)chain * NCHK * CST + e;
    const float* LB = WSP(float, WS_LB) + chain * NCHK * 2; float* SM = WSP(float, WS_LB) + 4096 + chain * NCHK;
    float m = 0.f, x = 0.f;
#pragma unroll 1
    for (int g = 0; g < 3; ++g) {
        float d[22], Lv[22], Bv[22];
#pragma unroll
        for (int q = 0; q < 22; ++q) { const int j = g * 22 + q; d[q] = LC[(size_t)j * CST]; Lv[q] = LB[2 * j]; Bv[q] = LB[2 * j + 1]; }
#pragma unroll
        for (int q = 0; q < 22; ++q) { const int j = g * 22 + q;
            ST[(size_t)j * CST] = x; if (e == 0) SM[j] = m;
            const float mn = fmaxf(Bv[q] + m, Lv[q]);
            x = __expf(Bv[q] + m - mn) * x + __expf(Lv[q] - mn) * d[q]; m = mn; }
    }
}
__device__ __forceinline__ void mlstm_out(const Ctx& F, int l, int unit) {
    const bool isc = unit >= 512; int b, chunk, head;
    if (!isc) { b = unit >> 8; chunk = (unit >> 2) & 63; head = unit & 3; } else { const int u = unit - 512; b = u >> 3; chunk = (u >> 2) & 1; head = u & 3; }
    const bf16_t* P = WSP(bf16_t, WS_P); const float* GA = WSP(float, WS_GA); bf16_t* YC = WSP(bf16_t, WS_YCAT);
    LAS bf16_t* Ql = (LAS bf16_t*)F.lds; LAS bf16_t* Kl = Ql + 128 * 72; LAS bf16_t* Vt = Kl + 128 * 72; LAS bf16_t* Cb = Vt + 64 * 136;
    LAS float* nS = (LAS float*)(Cb + 64 * 72); LAS float* aS = nS + 64; LAS float* bS = aS + 128; LAS float* MS = bS + 128; LAS float* Hs = MS + 128;
    const int i = F.lane & 15, gq = F.lane >> 4, w = F.wave;
    for (int dir = 0; dir < 2; ++dir) {
        const int j = isc ? (dir ? 1 - chunk : chunk) : 2 + (dir ? 63 - chunk : chunk);
        const int chain = (b * 4 + head) * 2 + dir;
        const float* ST = WSP(float, WS_ST) + ((size_t)chain * NCHK + j) * CST; const float mprev = WSP(float, WS_LB)[4096 + chain * NCHK + j];
        __syncthreads();
        if (w == 0) {
            const int r0 = ml_row(b, dir, j, 2 * F.lane), r1 = ml_row(b, dir, j, 2 * F.lane + 1);
            const float li0 = GA[(size_t)r0 * 16 + dir * 8 + head], li1 = GA[(size_t)r1 * 16 + dir * 8 + head];
            float b0 = GA[(size_t)r0 * 16 + dir * 8 + 4 + head], b1 = GA[(size_t)r1 * 16 + dir * 8 + 4 + head];
            scan128_add(b0, b1, F.lane);
            const float a0 = li0 - b0, a1 = li1 - b1; float A0 = a0, A1 = a1;
            scan128_max(A0, A1, F.lane);
            aS[2 * F.lane] = a0; aS[2 * F.lane + 1] = a1; bS[2 * F.lane] = b0; bS[2 * F.lane + 1] = b1;
            MS[2 * F.lane] = fmaxf(A0, mprev); MS[2 * F.lane + 1] = fmaxf(A1, mprev);
        }
        ml_stage_R(F, P, b, dir, j, C_MQ + head * 64, Ql, 1.f);
        ml_stage_R(F, P, b, dir, j, C_MK + head * 64, Kl, 0.125f);
        ml_stage_T(F, P, b, dir, j, C_MV + head * 64, Vt, nullptr, 1.f);
        { const f32x4 c0 = *(const f32x4*)(ST + F.tid * 8), c1 = *(const f32x4*)(ST + F.tid * 8 + 4); const int v = F.tid >> 3, k0 = (F.tid & 7) * 8;
          u32x4 o; o.x = pk2(c0[0], c0[1]); o.y = pk2(c0[2], c0[3]); o.z = pk2(c1[0], c1[1]); o.w = pk2(c1[2], c1[3]); *(LAS u32x4*)(Cb + v * 72 + k0) = o;
          if (F.tid < 64) nS[F.tid] = ST[4096 + F.tid]; }
        __syncthreads();
        const int t = 16 * w + i; const float Mt = MS[t], bt = bS[t];
        bf16x8 Qf[2];
#pragma unroll
        for (int ks = 0; ks < 2; ++ks) Qf[ks] = *(const LAS bf16x8*)(Ql + t * 72 + ks * 32 + gq * 8);
        f32x4 sc[8];
#pragma unroll
        for (int sb = 0; sb < 8; ++sb) { sc[sb] = (f32x4){0.f, 0.f, 0.f, 0.f};
            if (sb <= w) {
#pragma unroll
                for (int ks = 0; ks < 2; ++ks) { const bf16x8 kf = *(const LAS bf16x8*)(Kl + (sb * 16 + i) * 72 + ks * 32 + gq * 8); sc[sb] = __builtin_amdgcn_mfma_f32_16x16x32_bf16(kf, Qf[ks], sc[sb], 0, 0, 0); }
#pragma unroll
                for (int r = 0; r < 4; ++r) { const int s = sb * 16 + 4 * gq + r; sc[sb][r] = (s <= t) ? sc[sb][r] * __expf(aS[s] - Mt) : 0.f; }
            } }
        float den = 0.f;
#pragma unroll
        for (int sb = 0; sb < 8; ++sb) den += (sc[sb][0] + sc[sb][1]) + (sc[sb][2] + sc[sb][3]);
        den += __shfl_xor(den, 16); den += __shfl_xor(den, 32);
        f32x4 nm[4], it_[4];
#pragma unroll
        for (int vb = 0; vb < 4; ++vb) { nm[vb] = (f32x4){0.f, 0.f, 0.f, 0.f}; it_[vb] = (f32x4){0.f, 0.f, 0.f, 0.f}; }
#pragma unroll
        for (int ks2 = 0; ks2 < 4; ++ks2) if (2 * ks2 <= w) {
            frag_u pf; pf.u.x = pg8::cvt_pk_bf16(sc[2 * ks2][0], sc[2 * ks2][1]); pf.u.y = pg8::cvt_pk_bf16(sc[2 * ks2][2], sc[2 * ks2][3]);
            pf.u.z = pg8::cvt_pk_bf16(sc[2 * ks2 + 1][0], sc[2 * ks2 + 1][1]); pf.u.w = pg8::cvt_pk_bf16(sc[2 * ks2 + 1][2], sc[2 * ks2 + 1][3]);
#pragma unroll
            for (int vb = 0; vb < 4; ++vb) { frag_u vf; const LAS bf16_t* vp = Vt + (vb * 16 + i) * 136 + (2 * ks2) * 16 + 4 * gq;
                const u32x2 v0 = *(const LAS u32x2*)vp, v1 = *(const LAS u32x2*)(vp + 16); vf.u = (u32x4){v0.x, v0.y, v1.x, v1.y};
                nm[vb] = __builtin_amdgcn_mfma_f32_16x16x32_bf16(vf.b, pf.b, nm[vb], 0, 0, 0); }
        }
#pragma unroll
        for (int vb = 0; vb < 4; ++vb)
#pragma unroll
            for (int ks = 0; ks < 2; ++ks) { const bf16x8 cf = *(const LAS bf16x8*)(Cb + (vb * 16 + i) * 72 + ks * 32 + gq * 8); it_[vb] = __builtin_amdgcn_mfma_f32_16x16x32_bf16(cf, Qf[ks], it_[vb], 0, 0, 0); }
        float nq = 0.f;
#pragma unroll
        for (int c = 0; c < 2; ++c) { const u32x4 qv = *(const LAS u32x4*)(Ql + t * 72 + gq * 16 + c * 8); const unsigned ww[4] = {qv.x, qv.y, qv.z, qv.w};
#pragma unroll
            for (int q = 0; q < 4; ++q) nq += nS[gq * 16 + c * 8 + 2 * q] * lo2f(ww[q]) + nS[gq * 16 + c * 8 + 2 * q + 1] * hi2f(ww[q]); }
        nq += __shfl_xor(nq, 16); nq += __shfl_xor(nq, 32);
        const float wint = __expf(mprev - Mt); den += wint * nq;
        const float dn = 1.f / fmaxf(fabsf(den), __expf(-(bt + Mt)));
        const int torig = dir ? 127 - t : t;
#pragma unroll
        for (int vb = 0; vb < 4; ++vb)
#pragma unroll
            for (int r = 0; r < 4; ++r) { const float hv = (nm[vb][r] + wint * it_[vb][r]) * dn; LAS float* hp = Hs + torig * 65 + vb * 16 + 4 * gq + r; if (dir == 0) *hp = hv; else *hp += hv; }
    }
    __syncthreads();
    {
        const int t = F.tid >> 2, vq = F.tid & 3; const int row = (isc ? MLAT + b * TCTX : b * TLAT) + chunk * 128 + t;
        float hv[16], ss = 0.f;
#pragma unroll
        for (int q = 0; q < 16; ++q) { hv[q] = Hs[t * 65 + vq * 16 + q]; ss += hv[q] * hv[q]; }
        ss += __shfl_xor(ss, 1); ss += __shfl_xor(ss, 2);
        const float rs = rsqrtf(ss * (1.f / 64.f) + EPSN);
        const float* og = F.in[27] + l * 256 + head * 64 + vq * 16; const bf16_t* op = P + (size_t)row * DINP + C_MO + head * 64 + vq * 16;
        const u32x4 o0 = *(const u32x4*)op, o1 = *(const u32x4*)(op + 8); const unsigned ow[8] = {o0.x, o0.y, o0.z, o0.w, o1.x, o1.y, o1.z, o1.w};
        unsigned res[8];
#pragma unroll
        for (int q = 0; q < 8; ++q) { const float y0 = sigmoidf_(lo2f(ow[q])) * hv[2 * q] * rs * og[2 * q], y1 = sigmoidf_(hi2f(ow[q])) * hv[2 * q + 1] * rs * og[2 * q + 1]; res[q] = pk2(y0 * ZF(16), y1 * ZF(16)); }
        bf16_t* yo = YC + (size_t)row * DM + 768 + head * 64 + vq * 16;
        *(u32x4*)yo = (u32x4){res[0], res[1], res[2], res[3]}; *(u32x4*)(yo + 8) = (u32x4){res[4], res[5], res[6], res[7]};
    }
    __syncthreads();
}
__device__ __forceinline__ void rwkv_finish(const Ctx& F, int l, int nrows) {
    const bf16_t* P = WSP(bf16_t, WS_P); const float* YR = WSP(float, WS_YR); const bf16_t* GB = WSP(bf16_t, WS_GB); const float* BS = WSP(float, WS_BS); bf16_t* YC = WSP(bf16_t, WS_YCAT);
    const int c4 = F.lane * 4; const f32x4 lg = *(const f32x4*)(F.in[20] + l * 256 + c4);
    const int gw = F.vcu * NWAVES + F.wave, NGW = F.G * NWAVES;
    for (int row = gw; row < nrows; row += NGW) {
        const f32x4 y = *(const f32x4*)(YR + (size_t)row * 256 + c4) + *(const f32x4*)(YR + (size_t)(MALL + row) * 256 + c4);
        const float ss = red16((y[0] * y[0] + y[1] * y[1]) + (y[2] * y[2] + y[3] * y[3]));
        const float rs = rsqrtf(ss * (1.f / 64.f) + EPSN);
        const f32x4 v = ld4bf(P + (size_t)row * DINP + C_RV + c4), g = ld4bf(GB + (size_t)row * 256 + c4);
        const float bn = BS[(size_t)row * 4 + (F.lane >> 4)];
        st4bf(YC + (size_t)row * DM + 256 + c4, (y * rs * lg * ZF(32) + bn * v * ZF(64)) * g * ZF(4));
    }
}
constexpr int RCH = 132;
constexpr int MP = 72, SLOT = 64 * MP;
constexpr size_t WS_RG = 454 * MiB, RG_TASK = 3 * 8192, WS_SST = WS_RW;
constexpr size_t WS_END2 = 504 * MiB;
static_assert(WS_RG + (size_t)16 * RCH * RG_TASK <= WS_END2 && (size_t)16 * RCH * 8192 <= (size_t)MALL * RWREC, "rwkv chunk ws map");

__device__ __forceinline__ void mm64(const LAS bf16_t* A, const LAS bf16_t* Bt, int w, int lane, f32x4 (&acc)[2]) {
    const int i = lane & 15, gq = lane >> 4, mb = w >> 1, nb0 = 2 * (w & 1);
    acc[0] = (f32x4){0.f, 0.f, 0.f, 0.f}; acc[1] = (f32x4){0.f, 0.f, 0.f, 0.f};
#pragma unroll
    for (int ks = 0; ks < 2; ++ks) { const bf16x8 a = *(const LAS bf16x8*)(A + (mb * 16 + i) * MP + ks * 32 + gq * 8);
#pragma unroll
        for (int q = 0; q < 2; ++q) { const bf16x8 b = *(const LAS bf16x8*)(Bt + ((nb0 + q) * 16 + i) * MP + ks * 32 + gq * 8); acc[q] = __builtin_amdgcn_mfma_f32_16x16x32_bf16(a, b, acc[q], 0, 0, 0); } }
}
__device__ __forceinline__ u32x2 pk4(f32x4 v) { u32x2 o; o.x = pk2(v[0], v[1]); o.y = pk2(v[2], v[3]); return o; }
__device__ __forceinline__ f32x4 up4(u32x2 w) { return (f32x4){lo2f(w.x), hi2f(w.x), lo2f(w.y), hi2f(w.y)}; }

struct RaRaw { u32x4 kk, al, kd, r, v; f32x4 ld0, ld1; };
__device__ __forceinline__ void ra_load(const Ctx& F, int task, RaRaw& g) {
    const int chain = task / RCH, c = task % RCH, b = chain >> 3, head = (chain >> 1) & 3, dir = chain & 1;
    const bf16_t* P = WSP(bf16_t, WS_P); const unsigned char* RW = WSP(unsigned char, WS_RW);
    const int t = F.tid >> 3, ch0 = (F.tid & 7) * 8; const int row = scan_row(b, dir, c * 64 + t);
    const bf16_t* rb = (const bf16_t*)(RW + (size_t)row * RWREC) + head * 64 + ch0;
    g.kk = *(const u32x4*)rb; g.al = *(const u32x4*)(rb + 256 + dir * 256); g.kd = *(const u32x4*)(rb + 768 + dir * 256);
    const float* ldp = (const float*)(RW + (size_t)row * RWREC + 2560) + dir * 256 + head * 64 + ch0;
    g.ld0 = *(const f32x4*)ldp; g.ld1 = *(const f32x4*)(ldp + 4);
    const bf16_t* pp = P + (size_t)row * DINP + head * 64 + ch0;
    g.r = *(const u32x4*)(pp + C_RR); g.v = *(const u32x4*)(pp + C_RV);
}
__device__ __forceinline__ void rwkv_chunk_pre(const Ctx& F, int task, const RaRaw& cur) {
    const int chain = task / RCH, c = task % RCH, b = chain >> 3, head = (chain >> 1) & 3, dir = chain & 1;
    LAS bf16_t* L0 = (LAS bf16_t*)F.lds;
#define SL(k) (L0 + (k) * SLOT)
    LAS float* LD = (LAS float*)SL(8);
    LAS float* SEG = (LAS float*)SL(10);
    LAS float* WLs = (LAS float*)SL(14);
    const int w = F.wave, lane = F.lane, i = lane & 15, gq = lane >> 4, mb = w >> 1, nb0 = 2 * (w & 1), m0 = mb * 16 + 4 * gq;
    LDS_BARRIER();
    const int t = F.tid >> 3, ch0 = (F.tid & 7) * 8;
    const u32x4 g_kk = cur.kk, g_al = cur.al, g_kd = cur.kd, g_r = cur.r, g_v = cur.v; const f32x4 ld0 = cur.ld0, ld1 = cur.ld1;
    *(LAS f32x4*)(LD + t * 64 + ch0) = ld0; *(LAS f32x4*)(LD + t * 64 + ch0 + 4) = ld1;
    LDS_BARRIER();
    { const int k = F.tid & 63, seg = F.tid >> 6; float s = 0.f;
#pragma unroll
      for (int j = 0; j < 8; ++j) s += LD[(seg * 8 + j) * 64 + k];
      SEG[seg * 64 + k] = s;
      LDS_BARRIER();
      float off = 0.f;
#pragma unroll
      for (int j = 0; j < 8; ++j) off += (j < seg) ? SEG[j * 64 + k] : 0.f;
#pragma unroll
      for (int j = 0; j < 8; ++j) { off += LD[(seg * 8 + j) * 64 + k]; LD[(seg * 8 + j) * 64 + k] = off; }
    }
    LDS_BARRIER();
    {
        const unsigned kkw[4] = {g_kk.x, g_kk.y, g_kk.z, g_kk.w}, alw[4] = {g_al.x, g_al.y, g_al.z, g_al.w}, kdw[4] = {g_kd.x, g_kd.y, g_kd.z, g_kd.w},
                       rw_[4] = {g_r.x, g_r.y, g_r.z, g_r.w}, vw[4] = {g_v.x, g_v.y, g_v.z, g_v.w};
        float okt[8], oai[8], oki[8], ort[8], oat[8], okb[8];
#pragma unroll
        for (int j = 0; j < 8; ++j) {
            const float cl = LD[t * 64 + ch0 + j], clp = t > 0 ? LD[(t - 1) * 64 + ch0 + j] : 0.f, clL = LD[63 * 64 + ch0 + j];
            const float kkv = (j & 1) ? hi2f(kkw[j >> 1]) : lo2f(kkw[j >> 1]), alv = (j & 1) ? hi2f(alw[j >> 1]) : lo2f(alw[j >> 1]), kdv = (j & 1) ? hi2f(kdw[j >> 1]) : lo2f(kdw[j >> 1]),
                        rv = (j & 1) ? hi2f(rw_[j >> 1]) : lo2f(rw_[j >> 1]);
            const float ec = __expf(cl), en = __builtin_amdgcn_rcpf(ec), eL = __expf(clL) * en;
            okt[j] = kkv * __expf(clp); oai[j] = alv * en; oki[j] = kdv * en; ort[j] = rv * ec; oat[j] = alv * eL; okb[j] = kdv * eL;
        }
        u32x4 o;
        o = (u32x4){pk2(okt[0], okt[1]), pk2(okt[2], okt[3]), pk2(okt[4], okt[5]), pk2(okt[6], okt[7])}; *(LAS u32x4*)(SL(0) + t * MP + ch0) = o;
        o = (u32x4){pk2(oai[0], oai[1]), pk2(oai[2], oai[3]), pk2(oai[4], oai[5]), pk2(oai[6], oai[7])}; *(LAS u32x4*)(SL(2) + t * MP + ch0) = o;
        o = (u32x4){pk2(oki[0], oki[1]), pk2(oki[2], oki[3]), pk2(oki[4], oki[5]), pk2(oki[6], oki[7])}; *(LAS u32x4*)(SL(3) + t * MP + ch0) = o;
        o = (u32x4){pk2(ort[0], ort[1]), pk2(ort[2], ort[3]), pk2(ort[4], ort[5]), pk2(ort[6], ort[7])}; *(LAS u32x4*)(SL(4) + t * MP + ch0) = o;
#pragma unroll
        for (int j = 0; j < 8; ++j) { SL(1)[(ch0 + j) * MP + t] = (bf16_t)f2bf(okt[j]); SL(5)[(ch0 + j) * MP + t] = (bf16_t)f2bf(oat[j]); SL(6)[(ch0 + j) * MP + t] = (bf16_t)f2bf(okb[j]);
            SL(7)[(ch0 + j) * MP + t] = (bf16_t)(((j & 1) ? (vw[j >> 1] >> 16) : (vw[j >> 1] & 0xffffu))); }
        if (t == 63) {
#pragma unroll
            for (int j = 0; j < 8; ++j) WLs[ch0 + j] = __expf(LD[63 * 64 + ch0 + j]); }
    }
    LDS_BARRIER();
    f32x4 acc[2];
    mm64(SL(0), SL(2), w, lane, acc);
#pragma unroll
    for (int q = 0; q < 2; ++q) { const int n = (nb0 + q) * 16 + i; f32x4 a, ti;
#pragma unroll
        for (int r = 0; r < 4; ++r) { const bool keep = (m0 + r) > n; a[r] = keep ? acc[q][r] : 0.f; ti[r] = ((m0 + r) == n ? 1.f : 0.f) - a[r]; }
#pragma unroll
        for (int r = 0; r < 4; ++r) { SL(8)[(m0 + r) * MP + n] = (bf16_t)f2bf(a[r]); SL(13)[(m0 + r) * MP + n] = (bf16_t)f2bf(ti[r]); }
        *(LAS u32x2*)(SL(9) + n * MP + m0) = pk4(a); }
    mm64(SL(0), SL(3), w, lane, acc);
#pragma unroll
    for (int q = 0; q < 2; ++q) { const int n = (nb0 + q) * 16 + i;
#pragma unroll
        for (int r = 0; r < 4; ++r) SL(10)[(m0 + r) * MP + n] = (bf16_t)f2bf((m0 + r) > n ? acc[q][r] : 0.f); }
    mm64(SL(4), SL(2), w, lane, acc);
#pragma unroll
    for (int q = 0; q < 2; ++q) { const int n = (nb0 + q) * 16 + i;
#pragma unroll
        for (int r = 0; r < 4; ++r) SL(11)[(m0 + r) * MP + n] = (bf16_t)f2bf((m0 + r) >= n ? acc[q][r] : 0.f); }
    mm64(SL(4), SL(3), w, lane, acc);
#pragma unroll
    for (int q = 0; q < 2; ++q) { const int n = (nb0 + q) * 16 + i;
#pragma unroll
        for (int r = 0; r < 4; ++r) SL(12)[(m0 + r) * MP + n] = (bf16_t)f2bf((m0 + r) >= n ? acc[q][r] : 0.f); }
    LDS_BARRIER();
#pragma unroll
    for (int it = 0; it < 5; ++it) {
        LAS bf16_t* Xs = (it & 1) ? SL(2) : SL(8); LAS bf16_t* XsT = (it & 1) ? SL(3) : SL(9);
        LAS bf16_t* Xd = (it & 1) ? SL(8) : SL(2); LAS bf16_t* XdT = (it & 1) ? SL(9) : SL(3);
        LAS bf16_t* Tsrc = (it & 1) ? SL(0) : SL(13); LAS bf16_t* Tdst = (it & 1) ? SL(13) : SL(0);
        mm64(Xs, XsT, w, lane, acc);
#pragma unroll
        for (int q = 0; q < 2; ++q) { const int n = (nb0 + q) * 16 + i;
#pragma unroll
            for (int r = 0; r < 4; ++r) Xd[(m0 + r) * MP + n] = (bf16_t)f2bf(acc[q][r]);
            *(LAS u32x2*)(XdT + n * MP + m0) = pk4(acc[q]); }
        LDS_BARRIER();
        mm64(Tsrc, XdT, w, lane, acc);
#pragma unroll
        for (int q = 0; q < 2; ++q) { const int n = (nb0 + q) * 16 + i;
#pragma unroll
            for (int r = 0; r < 4; ++r) Tdst[(m0 + r) * MP + n] = (bf16_t)f2bf(bf2f(Tsrc[(m0 + r) * MP + n]) + acc[q][r]); }
        LDS_BARRIER();
    }
    LAS bf16_t* Ti = SL(0);
    mm64(Ti, SL(1), w, lane, acc);
#pragma unroll
    for (int q = 0; q < 2; ++q) { const int n = (nb0 + q) * 16 + i; *(LAS u32x2*)(SL(2) + n * MP + m0) = pk4(acc[q]); }
    mm64(SL(10), SL(7), w, lane, acc);
#pragma unroll
    for (int q = 0; q < 2; ++q) { const int n = (nb0 + q) * 16 + i; *(LAS u32x2*)(SL(3) + n * MP + m0) = pk4(acc[q]); }
    LDS_BARRIER();
    mm64(Ti, SL(3), w, lane, acc);
#pragma unroll
    for (int q = 0; q < 2; ++q) { const int n = (nb0 + q) * 16 + i; *(LAS u32x2*)(SL(8) + n * MP + m0) = pk4(acc[q]); }
    LDS_BARRIER();
    bf16_t* RG = (bf16_t*)(F.ws + WS_RG + (size_t)task * RG_TASK);
    f32x4 acc2[2];
    mm64(SL(2), SL(11), w, lane, acc);
#pragma unroll
    for (int q = 0; q < 2; ++q) { const int n = (nb0 + q) * 16 + i; const f32x4 rt = up4(*(const LAS u32x2*)(SL(4) + n * MP + m0)); *(u32x2*)(RG + n * 64 + m0) = pk4(rt - acc[q]); }
    mm64(SL(2), SL(5), w, lane, acc);
#pragma unroll
    for (int q = 0; q < 2; ++q) { const int n = (nb0 + q) * 16 + i; f32x4 g;
#pragma unroll
        for (int r = 0; r < 4; ++r) g[r] = ((m0 + r) == n ? WLs[n] : 0.f) - acc[q][r];
        *(u32x2*)(RG + 4096 + n * 64 + m0) = pk4(g); }
    mm64(SL(6), SL(7), w, lane, acc); mm64(SL(5), SL(8), w, lane, acc2);
#pragma unroll
    for (int q = 0; q < 2; ++q) { const int n = (nb0 + q) * 16 + i; *(u32x2*)(RG + 8192 + n * 64 + m0) = pk4(acc[q] - acc2[q]); }
    mm64(SL(7), SL(12), w, lane, acc); mm64(SL(8), SL(11), w, lane, acc2);
    float* YR = WSP(float, WS_YR) + (size_t)dir * MALL * 256;
#pragma unroll
    for (int q = 0; q < 2; ++q) { const int n = (nb0 + q) * 16 + i; const int rown = scan_row(b, dir, c * 64 + n); *(f32x4*)(YR + (size_t)rown * 256 + head * 64 + m0) = acc[q] - acc2[q]; }
#undef SL
}

__device__ __forceinline__ void rwkv_chain(const Ctx& F, int chain) {
    LAS bf16_t* const L0 = (LAS bf16_t*)F.lds;
    LAS bf16_t* Gl[2] = {L0, L0 + SLOT}; LAS bf16_t* Sl[2] = {L0 + 2 * SLOT, L0 + 3 * SLOT}; LAS bf16_t* Hl[2] = {L0 + 4 * SLOT, L0 + 5 * SLOT};
    const int w = F.wave, lane = F.lane, i = lane & 15, gq = lane >> 4, mb = w >> 1, nb0 = 2 * (w & 1), m0 = mb * 16 + 4 * gq;
    const bf16_t* RGc = (const bf16_t*)(F.ws + WS_RG + (size_t)chain * RCH * RG_TASK); bf16_t* SST = (bf16_t*)(F.ws + WS_SST) + (size_t)chain * RCH * 4096;
    const int gr = F.tid >> 3, gc = (F.tid & 7) * 8, goff = gr * 64 + gc, loff = gr * MP + gc;
    constexpr int RBD = 6, RBU = 66;
    static_assert(RBU % RBD == 0 && RCH % RBU == 0, "ring depth / unroll");
    u32x4 rg[RBD], rh[RBD];
#define RB_LOAD(slot, cc) do { const bf16_t* p_ = RGc + (size_t)((cc) < RCH ? (cc) : RCH - 1) * (RG_TASK / 2); rg[slot] = *(const u32x4*)(p_ + 4096 + goff); rh[slot] = *(const u32x4*)(p_ + 8192 + goff); } while (0)
#pragma unroll
    for (int j = 0; j < RBD; ++j) RB_LOAD(j, j);
    __syncthreads();
    { unsigned z_; asm volatile("v_mov_b32 %0, 0" : "=v"(z_)); *(LAS u32x4*)(Sl[0] + loff) = (u32x4){z_, z_, z_, z_}; }
    *(LAS u32x4*)(Gl[0] + loff) = rg[0]; *(LAS u32x4*)(Hl[0] + loff) = rh[0];
    __syncthreads();
#ifdef TPROBE
    const unsigned long long tp0_ = __builtin_amdgcn_s_memrealtime();
#endif
#define RB_STEP(j) do { const int c = c0 + (j); if (c < RCH - 1) { const int par = c & 1; \
        *(u32x4*)(SST + (size_t)c * 4096 + goff) = *(const LAS u32x4*)(Sl[par] + loff);            \
        f32x4 acc[2]; mm64(Gl[par], Sl[par], w, lane, acc); \
        { const f32x4 h0 = up4(*(const LAS u32x2*)(Hl[par] + (nb0 * 16 + i) * MP + m0)), h1 = up4(*(const LAS u32x2*)(Hl[par] + ((nb0 + 1) * 16 + i) * MP + m0)); \
          *(LAS u32x2*)(Sl[par ^ 1] + (nb0 * 16 + i) * MP + m0) = pk4(acc[0] + h0); *(LAS u32x2*)(Sl[par ^ 1] + ((nb0 + 1) * 16 + i) * MP + m0) = pk4(acc[1] + h1); } \
        *(LAS u32x4*)(Gl[par ^ 1] + loff) = rg[((j) + 1) % RBD]; *(LAS u32x4*)(Hl[par ^ 1] + loff) = rh[((j) + 1) % RBD]; \
        RB_LOAD((j) % RBD, c + RBD); \
        asm volatile("s_waitcnt lgkmcnt(0)" ::: "memory"); __builtin_amdgcn_s_barrier(); asm volatile("" ::: "memory"); } } while (0)
#pragma unroll 1
    for (int c0 = 0; c0 < RCH; c0 += RBU) {
#pragma unroll
        for (int j = 0; j < RBU; ++j) RB_STEP(j); }
#undef RB_STEP
#undef RB_LOAD
    *(u32x4*)(SST + (size_t)(RCH - 1) * 4096 + goff) = *(const LAS u32x4*)(Sl[(RCH - 1) & 1] + loff);
#ifdef TPROBE
    if (chain == 0 && F.tid == 0) *(float*)(F.ws + WS_CTL + 65536) = 3000.f * (floorf((float)(__builtin_amdgcn_s_memrealtime() - tp0_) * (1.f / 3000.f)) + 0.5f);
#endif
    __syncthreads();
}

__device__ __forceinline__ void rwkv_out(const Ctx& F, int l, int unit) {
    const bool isc = unit >= 256; int b, chunk; if (!isc) { b = unit >> 7; chunk = unit & 127; } else { const int u = unit - 256; b = u >> 2; chunk = u & 3; }
    LAS bf16_t* Rl = (LAS bf16_t*)F.lds; LAS bf16_t* Sl = Rl + SLOT; LAS float* Ys = (LAS float*)(F.lds + 4 * SLOT * 2);
    const int w = F.wave, lane = F.lane, i = lane & 15, gq = lane >> 4, mb = w >> 1, nb0 = 2 * (w & 1), m0 = mb * 16 + 4 * gq;
    const int row0 = (isc ? MLAT + b * TCTX : b * TLAT) + chunk * 64;
    const int gr = F.tid >> 3, gc = (F.tid & 7) * 8;
#define RO_PTRS(hd_, RGp, SSp) do { const int head_ = (hd_) >> 1, dir_ = (hd_) & 1, chain_ = (b * 4 + head_) * 2 + dir_; const int cc_ = isc ? (dir_ ? 3 - chunk : chunk) : 4 + (dir_ ? 127 - chunk : chunk); \
        RGp = (const bf16_t*)(F.ws + WS_RG + ((size_t)chain_ * RCH + cc_) * RG_TASK); SSp = (const bf16_t*)(F.ws + WS_SST) + ((size_t)chain_ * RCH + cc_) * 4096; } while (0)
    u32x4 rv, sv;
    { const bf16_t* RG0; const bf16_t* SS0; RO_PTRS(0, RG0, SS0); rv = *(const u32x4*)(RG0 + gr * 64 + gc); sv = *(const u32x4*)(SS0 + gr * 64 + gc); }
#pragma unroll 1
    for (int hd = 0; hd < 8; ++hd) {
        const int head = hd >> 1, dir = hd & 1;
        const float* YR = WSP(float, WS_YR) + (size_t)dir * MALL * 256;
        LDS_BARRIER();
        *(LAS u32x4*)(Rl + gr * MP + gc) = rv; *(LAS u32x4*)(Sl + gr * MP + gc) = sv;
        if (hd < 7) { const bf16_t* RGn; const bf16_t* SSn; RO_PTRS(hd + 1, RGn, SSn); rv = *(const u32x4*)(RGn + gr * 64 + gc); sv = *(const u32x4*)(SSn + gr * 64 + gc); }
        f32x4 yl[2];
#pragma unroll
        for (int q = 0; q < 2; ++q) { const int n = (nb0 + q) * 16 + i; const int tor = dir ? 63 - n : n; yl[q] = *(const f32x4*)(YR + (size_t)(row0 + tor) * 256 + head * 64 + m0); }
        LDS_BARRIER();
        f32x4 acc[2]; mm64(Sl, Rl, w, lane, acc);
#pragma unroll
        for (int q = 0; q < 2; ++q) { const int n = (nb0 + q) * 16 + i; const int tor = dir ? 63 - n : n;
            LAS f32x4* yp = (LAS f32x4*)(Ys + tor * 260 + head * 64 + m0);
            if (dir == 0) *yp = acc[q] + yl[q]; else *yp = *yp + acc[q] + yl[q]; }
    }
#undef RO_PTRS
    __syncthreads();
    {
        const bf16_t* P = WSP(bf16_t, WS_P); const bf16_t* GB = WSP(bf16_t, WS_GB); const float* BS = WSP(float, WS_BS); bf16_t* YC = WSP(bf16_t, WS_YCAT);
        const int c4 = lane * 4; const f32x4 lg = *(const f32x4*)(F.in[20] + l * 256 + c4);
#pragma unroll 1
        for (int tt = w; tt < 64; tt += NWAVES) { const int row = row0 + tt;
            const f32x4 y = *(const LAS f32x4*)(Ys + tt * 260 + c4);
            const float ss = red16((y[0] * y[0] + y[1] * y[1]) + (y[2] * y[2] + y[3] * y[3]));
            const float rs = rsqrtf(ss * (1.f / 64.f) + EPSN);
            const f32x4 v = ld4bf(P + (size_t)row * DINP + C_RV + c4), g = ld4bf(GB + (size_t)row * 256 + c4);
            const float bn = BS[(size_t)row * 4 + (lane >> 4)];
            st4bf(YC + (size_t)row * DM + 256 + c4, (y * rs * lg * ZF(32) + bn * v * ZF(64)) * g * ZF(4)); }
    }
    __syncthreads();
}
__device__ __forceinline__ float clr7(float x) { return __uint_as_float(__float_as_uint(x) & 0xFFFFFF80u); }
__device__ __forceinline__ void ins16(float (&L)[16], float p) {
#pragma unroll
    for (int j = 15; j >= 1; --j) L[j] = __builtin_amdgcn_fmed3f(L[j - 1], L[j], p);
    L[0] = fmaxf(L[0], p);
}
__device__ __forceinline__ void peer_topk_task(const bf16_t* sg, size_t gstride, u32x2* eg) {
    float L0[16], L1[16];
#pragma unroll
    for (int j = 0; j < 16; ++j) { L0[j] = -INFINITY; L1[j] = -INFINITY; }
    u32x4 pa[4], pb[4];
#pragma unroll
    for (int u = 0; u < 4; ++u) { pa[u] = *(const u32x4*)(sg + (size_t)u * gstride); pb[u] = *(const u32x4*)(sg + (size_t)(16 + u) * gstride); }
#pragma unroll 4
    for (int i = 0; i < 128; i += 8) {
        const u32x4 a = pa[(i >> 3) & 3], b = pb[(i >> 3) & 3];
        { const int gn = (i >> 3) + 4 < 16 ? (i >> 3) + 4 : 15; pa[(i >> 3) & 3] = *(const u32x4*)(sg + (size_t)gn * gstride); pb[(i >> 3) & 3] = *(const u32x4*)(sg + (size_t)(16 + gn) * gstride); }
#pragma unroll
        for (int q = 0; q < 4; ++q) { ins16(L0, __uint_as_float((a[q] << 16) | (unsigned)(i + 2 * q))); ins16(L0, __uint_as_float((a[q] & 0xffff0000u) | (unsigned)(i + 2 * q + 1)));
                                      ins16(L1, __uint_as_float((b[q] << 16) | (unsigned)(i + 2 * q))); ins16(L1, __uint_as_float((b[q] & 0xffff0000u) | (unsigned)(i + 2 * q + 1))); }
    }
    float T[16];
#pragma unroll
    for (int j = 0; j < 16; ++j) T[j] = -INFINITY;
#pragma unroll
    for (int a = 0; a < 16; ++a)
#pragma unroll
        for (int b = 0; b < 16; ++b) if ((a + 1) * (b + 1) <= 16) { const float s = clr7(L0[a]) + clr7(L1[b]);
            ins16(T, __uint_as_float((__float_as_uint(s) & 0xFFFFFF00u) | (unsigned)(a * 16 + b))); }
    float e[16], sum = 0.f; const float mx = __uint_as_float(__float_as_uint(T[0]) & 0xFFFFFF00u);
#pragma unroll
    for (int j = 0; j < 16; ++j) { e[j] = __expf(__uint_as_float(__float_as_uint(T[j]) & 0xFFFFFF00u) - mx); sum += e[j]; }
    const float inv = 1.f / sum;
#pragma unroll
    for (int j = 0; j < 16; ++j) {
        const unsigned ab = __float_as_uint(T[j]) & 0xFFu, a = ab >> 4, b = ab & 15u; unsigned i0 = 0u, i1 = 0u;
#pragma unroll
        for (int q = 0; q < 16; ++q) { i0 = (a == (unsigned)q) ? (__float_as_uint(L0[q]) & 0x7Fu) : i0; i1 = (b == (unsigned)q) ? (__float_as_uint(L1[q]) & 0x7Fu) : i1; }
        eg[j] = (u32x2){i0 * 128u + i1, __float_as_uint(e[j] * inv)};
    }
}
__device__ __forceinline__ float gelu_tanh(float x) { const float u = 0.7978845608028654f * (x + 0.044715f * x * x * x); return 0.5f * x * (1.f + tanhf_(u)); }
__device__ __forceinline__ float dot2bf(unsigned w, unsigned x, float acc) { return __builtin_amdgcn_fdot2_f32_bf16(__builtin_bit_cast(bf16x2_t, w), __builtin_bit_cast(bf16x2_t, x), acc, false); }
__device__ __forceinline__ float wave_total63(float x) {
    x = red16(x);
    x += __int_as_float(__builtin_amdgcn_update_dpp(0, __float_as_int(x), 0x142, 0xa, 0xf, false));
    x += __int_as_float(__builtin_amdgcn_update_dpp(0, __float_as_int(x), 0x143, 0xc, 0xf, false));
    return x;
}

__device__ __forceinline__ void phase_peer(const Ctx& F, int l, int nrows, const float* mod, float* wr_override) {
    const bf16_t* S = WSP(bf16_t, WS_S); u32x2* EG = WSP(u32x2, WS_EG); const bf16_t* H = WSP(bf16_t, WS_H);
    const unsigned char* U = F.ws + WS_U + (size_t)l * UV_LSTRIDE; const unsigned char* V = F.ws + WS_V + (size_t)l * UV_LSTRIDE;
    const float* USC = WSP(float, WS_SC) + (size_t)l * 2 * 16384; const float* VSC = USC + 16384;
    const int tpb = nrows / F.G, tok0 = F.vcu * tpb;
    volatile LAS unsigned* tkflag = (volatile LAS unsigned*)(F.lds + LDSCTL_OFF + 512);
    if (F.tid == 0) tkflag[0] = 0u;
    { const int ntok1 = tpb < 64 ? tpb : 64; const int task = F.tid; const int hd = task / ntok1, tkn = task - hd * ntok1;
      if (hd < 8) { const int row = tok0 + tkn; peer_topk_task(S + ((size_t)(hd * 32) * MALL + row) * 8, (size_t)MALL * 8, EG + (size_t)row * 128 + hd * 16); } }
    __threadfence_block(); __syncthreads();
    if (tpb > 64 && F.wave == 2) {
        const int nex = tpb - 64; const int hd = F.lane / nex, tkn = F.lane - hd * nex;
        if (hd < 8) { const int row = tok0 + 64 + tkn; peer_topk_task(S + ((size_t)(hd * 32) * MALL + row) * 8, (size_t)MALL * 8, EG + (size_t)row * 128 + hd * 16); }
        __threadfence_block(); asm volatile("s_waitcnt vmcnt(0) lgkmcnt(0)" ::: "memory");
        if (F.lane == 0) tkflag[0] = 1u;
    }
    const int lane = F.lane; const bool hi32 = lane >= 32; const unsigned l16 = (unsigned)(lane & 31) * 16u;
    LAS unsigned char* wl = F.lds + F.wave * PEER_WLDS; LAS unsigned char* hbl = wl + 16 * 528; LAS unsigned char* rawl = hbl + 2048; LAS float* cfl = (LAS float*)(rawl + 512); LAS unsigned short* exl = (LAS unsigned short*)(rawl + 512 + 9 * 512); LAS float* cfm = (LAS float*)(rawl + 512 + 9 * 512 + 9 * 256);
    u32x2 eg0 = EG[(size_t)(tok0 + F.wave) * 128 + lane], eg1 = EG[(size_t)(tok0 + F.wave) * 128 + 64 + lane];
    u32x4 h0 = *(const u32x4*)(H + (size_t)(tok0 + F.wave) * DM + lane * 16), h1 = *(const u32x4*)(H + (size_t)(tok0 + F.wave) * DM + lane * 16 + 8);
#pragma unroll 1
    for (int tk = F.wave, ti = 0; tk < tpb; tk += NWAVES, ++ti) {
        exl[ti * 128 + lane] = (unsigned short)eg0.x; exl[ti * 128 + 64 + lane] = (unsigned short)eg1.x;
        const LAS unsigned short* exq = exl + ti * 128 + (hi32 ? 8 : 0);
        const float us0 = USC[eg0.x], us1 = USC[eg1.x], vs0 = VSC[eg0.x], vs1 = VSC[eg1.x];
        float hscale;
        {   const unsigned hw[8] = {h0.x, h0.y, h0.z, h0.w, h1.x, h1.y, h1.z, h1.w}; float hf[16]; float am = 0.f;
#pragma unroll
            for (int q = 0; q < 8; ++q) { hf[2 * q] = lo2f(hw[q]); hf[2 * q + 1] = hi2f(hw[q]); am = fmaxf(am, fmaxf(fabsf(hf[2 * q]), fabsf(hf[2 * q + 1]))); }
#pragma unroll
            for (int o = 1; o < 64; o <<= 1) am = fmaxf(am, __shfl_xor(am, o));
            const float sc = am > 0.f ? 224.f / am : 1.f; hscale = am > 0.f ? am * (1.f / 224.f) : 1.f;
            unsigned hiw[4], low[4];
#pragma unroll
            for (int d = 0; d < 4; ++d) { const float a0 = hf[d * 4] * sc, a1 = hf[d * 4 + 1] * sc, a2 = hf[d * 4 + 2] * sc, a3 = hf[d * 4 + 3] * sc;
                int w = __builtin_amdgcn_cvt_pk_fp8_f32(a0, a1, 0, false); w = __builtin_amdgcn_cvt_pk_fp8_f32(a2, a3, w, true);
                const f32x2 b01 = __builtin_amdgcn_cvt_pk_f32_fp8(w, false), b23 = __builtin_amdgcn_cvt_pk_f32_fp8(w, true);
                int wl_ = __builtin_amdgcn_cvt_pk_fp8_f32((a0 - b01.x) * 16.f, (a1 - b01.y) * 16.f, 0, false); wl_ = __builtin_amdgcn_cvt_pk_fp8_f32((a2 - b23.x) * 16.f, (a3 - b23.y) * 16.f, wl_, true);
                hiw[d] = (unsigned)w; low[d] = (unsigned)wl_; }
            LAS unsigned char* hp = hbl + (lane >> 3) * 256 + (lane & 7) * 16;
            *(LAS u32x4*)hp = (u32x4){hiw[0], hiw[1], hiw[2], hiw[3]};
            *(LAS u32x4*)(hp + 128) = (u32x4){low[0], low[1], low[2], low[3]};
        }
        const int tkn = tk + NWAVES < tpb ? tk + NWAVES : tk; const int rown = tok0 + tkn;
        if (tkn >= 64) { while (tkflag[0] == 0u) __builtin_amdgcn_s_sleep(8); __threadfence_block(); }
        const u32x2 egn0 = EG[(size_t)rown * 128 + lane], egn1 = EG[(size_t)rown * 128 + 64 + lane];
        h0 = *(const u32x4*)(H + (size_t)rown * DM + lane * 16); h1 = *(const u32x4*)(H + (size_t)rown * DM + lane * 16 + 8);
        {
            const int mi = lane & 15, mg = lane >> 4;
            const LAS unsigned char* aptr = wl + mi * 528 + mg * 16; const LAS unsigned char* bptr = hbl + (mi & 1) * 128 + mg * 16;
            LAS unsigned char* pk = wl + (lane >> 5) * (8 * 528) + l16;
            u32x4 rr[3][8];
#define PU_LOAD(bt_) do { _Pragma("unroll") for (int h = 0; h < 2; ++h) { const u32x2 ew = *(const LAS u32x2*)(exq + (bt_) * 16 + 4 * h); \
                rr[(bt_) % 3][4 * h + 0] = *(const u32x4*)(U + ((ew.x & 0xffffu) * 512u + l16)); rr[(bt_) % 3][4 * h + 1] = *(const u32x4*)(U + ((ew.x >> 16) * 512u + l16)); \
                rr[(bt_) % 3][4 * h + 2] = *(const u32x4*)(U + ((ew.y & 0xffffu) * 512u + l16)); rr[(bt_) % 3][4 * h + 3] = *(const u32x4*)(U + ((ew.y >> 16) * 512u + l16)); } } while (0)
#define PU_PARK(bt_) do { _Pragma("unroll") for (int q = 0; q < 8; ++q) *(LAS u32x4*)(pk + q * 528) = rr[(bt_) % 3][q]; } while (0)
            PU_LOAD(0); PU_LOAD(1);
#pragma unroll
            for (int bt = 0; bt < 8; ++bt) {
                if (bt + 2 < 8) PU_LOAD(bt + 2);
                PU_PARK(bt);
                f32x4 acc = {0.f, 0.f, 0.f, 0.f};
#pragma unroll
                for (int s = 0; s < 8; ++s) { const u32x4 a = *(const LAS u32x4*)(aptr + s * 64), b0 = *(const LAS u32x4*)(bptr + s * 256), b1 = *(const LAS u32x4*)(bptr + s * 256 + 64);
                    acc = __builtin_amdgcn_mfma_scale_f32_16x16x128_f8f6f4((i32x8){(int)a.x, (int)a.y, (int)a.z, (int)a.w, 0, 0, 0, 0},
                                                                           (i32x8){(int)b0.x, (int)b0.y, (int)b0.z, (int)b0.w, (int)b1.x, (int)b1.y, (int)b1.z, (int)b1.w}, acc, 4, 0, 0, 0x7F7F7F7F, 0, 0x7F7F7F7F); }
                f32x4 tot;
#pragma unroll
                for (int r = 0; r < 4; ++r) tot[r] = acc[r] + 0.0625f * dppf<0xF5>(acc[r]);
                if (mi == 0) *(LAS f32x4*)(rawl + (bt * 16 + 4 * mg) * 4) = tot;
            }
#undef PU_PARK
#undef PU_LOAD
            const float act0 = *(const LAS float*)(rawl + lane * 4) * (hscale * us0), act1 = *(const LAS float*)(rawl + 256 + lane * 4) * (hscale * us1);
            const float c0 = __uint_as_float(eg0.y) * gelu_tanh(act0) * vs0, c1 = __uint_as_float(eg1.y) * gelu_tanh(act1) * vs1;
            float cm = fmaxf(fabsf(c0), fabsf(c1));
#pragma unroll
            for (int o = 1; o < 64; o <<= 1) cm = fmaxf(cm, __shfl_xor(cm, o));
            const float cinv = cm > 0.f ? 1.f / cm : 0.f;
            cfl[ti * 128 + lane] = c0 * cinv; cfl[ti * 128 + 64 + lane] = c1 * cinv;
            if (lane == 0) cfm[ti] = cm;
        }
        eg0 = egn0; eg1 = egn1;
    }
    LDS_BARRIER();
    u32x4 ra[8], rb[8];
#define PG_LOAD(dst, idp_) do { _Pragma("unroll") for (int h = 0; h < 2; ++h) { const u32x2 ew = *(const LAS u32x2*)((idp_) + 4 * h); \
            dst[4 * h + 0] = *(const u32x4*)(V + ((ew.x & 0xffffu) * 512u + l16)); dst[4 * h + 1] = *(const u32x4*)(V + ((ew.x >> 16) * 512u + l16)); \
            dst[4 * h + 2] = *(const u32x4*)(V + ((ew.y & 0xffffu) * 512u + l16)); dst[4 * h + 3] = *(const u32x4*)(V + ((ew.y >> 16) * 512u + l16)); } } while (0)
    { const LAS unsigned short* ex0 = exl + (hi32 ? 8 : 0); PG_LOAD(ra, ex0); }
#pragma unroll 1
    for (int tk = F.wave, ti = 0; tk < tpb; tk += NWAVES, ++ti) {
        const int row = tok0 + tk; const bool isc = row >= MLAT; const int smp = isc ? 2 : (row >> 13);
        float* xrow = isc ? WSP(float, WS_XC) + (size_t)(row - MLAT) * DM : F.out + (size_t)row * DM;
        const LAS unsigned short* exq = exl + ti * 128 + (hi32 ? 8 : 0); const LAS float* cfq = cfl + ti * 128 + (hi32 ? 8 : 0);
        const LAS unsigned short* exn = tk + NWAVES < tpb ? exq + 128 : exq;
        f32x2 ac[16];
#pragma unroll
        for (int q = 0; q < 16; ++q) ac[q] = (f32x2){0.f, 0.f};
#define PG_VACC(src, grp_) do { _Pragma("unroll") for (int h = 0; h < 2; ++h) { const u32x4 c4 = *(const LAS u32x4*)(cfq + (grp_) * 16 + 4 * h); \
            _Pragma("unroll") for (int q = 0; q < 4; ++q) { const float cf = __uint_as_float(c4[q]); const unsigned vw[4] = {src[4 * h + q].x, src[4 * h + q].y, src[4 * h + q].z, src[4 * h + q].w}; \
            _Pragma("unroll") for (int j = 0; j < 4; ++j) { ac[4 * j] += cf * __builtin_amdgcn_cvt_scalef32_pk_f32_fp4(vw[j], 1.0f, 0); ac[4 * j + 1] += cf * __builtin_amdgcn_cvt_scalef32_pk_f32_fp4(vw[j], 1.0f, 1); \
                ac[4 * j + 2] += cf * __builtin_amdgcn_cvt_scalef32_pk_f32_fp4(vw[j], 1.0f, 2); ac[4 * j + 3] += cf * __builtin_amdgcn_cvt_scalef32_pk_f32_fp4(vw[j], 1.0f, 3); } } } } while (0)
#pragma unroll 1
        for (int g2 = 0; g2 < 4; ++g2) {
            PG_LOAD(rb, exq + (2 * g2 + 1) * 16); PG_VACC(ra, 2 * g2);
            { const LAS unsigned short* idp = g2 < 3 ? exq + (2 * g2 + 2) * 16 : exn; PG_LOAD(ra, idp); }
            PG_VACC(rb, 2 * g2 + 1);
        }
#undef PG_VACC
        float acc[16];
        const float cmx = cfm[ti];
#pragma unroll
        for (int q = 0; q < 8; ++q) { const f32x2 mine = hi32 ? ac[8 + q] : ac[q], send = hi32 ? ac[q] : ac[8 + q];
            acc[2 * q] = cmx * (mine.x + __shfl_xor(send.x, 32)); acc[2 * q + 1] = cmx * (mine.y + __shfl_xor(send.y, 32)); }
        const int col0 = 32 * (lane & 31) + 16 * (lane >> 5);
        const float* gt = mod + smp * 6144 + 5120;
        f32x4 res[4]; float ss = 0.f;
#pragma unroll
        for (int q = 0; q < 4; ++q) { const int c = col0 + q * 4; const f32x4 g = *(const f32x4*)(gt + c), x = *(const f32x4*)(xrow + c);
            res[q] = x + ZF(1) * g * (f32x4){acc[q * 4], acc[q * 4 + 1], acc[q * 4 + 2], acc[q * 4 + 3]};
            *(f32x4*)((wr_override ? wr_override + (size_t)row * DM : xrow) + c) = res[q];
            ss += (res[q][0] * res[q][0] + res[q][1] * res[q][1]) + (res[q][2] * res[q][2] + res[q][3] * res[q][3]); }
        if (l == 0 && !wr_override) {
            const float rs = rsqrtf(wave_sum(ss) * (1.f / DM) + EPSN); const float* mb1 = mod + 3 * 6144 + smp * 6144; const float* g1 = F.in[6] + DM;
            bf16_t* Hw = WSP(bf16_t, WS_H) + (size_t)row * DM;
#pragma unroll
            for (int q = 0; q < 4; ++q) { const int c = col0 + q * 4; const f32x4 g = *(const f32x4*)(g1 + c), sc = *(const f32x4*)(mb1 + 1024 + c), sh = *(const f32x4*)(mb1 + c);
                st4bf(Hw + c, (res[q] * rs * g) * (1.f + sc) + sh); }
        }
    }
#undef PG_LOAD
}

constexpr int PH_PER_LAYER = 10, N_PHASES = 1 + 2 * PH_PER_LAYER;
struct Args { const float* in[32]; float* out; unsigned char* ws; int ph_lo, ph_hi, li, pad; };
__global__ void __launch_bounds__(NTHR, 2) mk_fwd(Args args) {
    extern __shared__ __attribute__((aligned(16))) unsigned char lds[];
    Ctx F;
    F.lds = (LAS unsigned char*)lds;
    volatile LAS unsigned* MISC = (volatile LAS unsigned*)(F.lds + MISC_OFF);
    F.tid = threadIdx.x; F.lane = F.tid & 63; F.wave = __builtin_amdgcn_readfirstlane(F.tid >> 6);
    F.G = gridDim.x; { const int bx = blockIdx.x; F.vcu = (F.G % 8 == 0) ? (bx % 8) * (F.G / 8) + bx / 8 : bx; }
#pragma unroll
    for (int i = 0; i < 32; ++i) F.in[i] = args.in[i];
    F.out = args.out; F.ws = args.ws;
    for (int u = F.tid; u < (LDS_BYTES - LDSCTL_OFF) / 4; u += NTHR) ((LAS unsigned*)(F.lds + LDSCTL_OFF))[u] = 0u;
    __syncthreads();
    XcdBarrier bar; bar.bar = (unsigned*)(args.ws + WS_CTL) + CW_BAR; bar.x = 0; bar.st = nullptr;
#if !MK_MULTI
    bar = xcd_barrier_post((unsigned*)(args.ws + WS_CTL) + CW_BAR, MISC + 8);
#endif
    const int lo = args.ph_lo, hi = args.ph_hi;
#ifndef KMAX
#define KMAX 1000
#endif
#define IN(k) (lo <= (k) && (k) < hi && (REP_ALL == 1 || ra == REP_ALL - 1 || (k) <= KMAX))
#ifndef REP_PH
#define REP_PH -1
#endif
#define REPS(k) ((REP_PH == (k)) ? 2 : 1)
#define PHCTX Ctx Fp = F; { int t_ = F.tid; asm volatile("" : "+v"(t_)); Fp.tid = t_; Fp.lane = t_ & 63; }
#if MK_MULTI
#define SEAM(k) do { } while (0)
#else
#ifndef BAR_REPS
#define BAR_REPS 1
#endif
#define SEAM(k) do { if (IN(k) && IN((k) + 1)) for (int br_ = 0; br_ < BAR_REPS; ++br_) xcd_barrier(bar); } while (0)
#endif
#ifndef REP_ALL
#define REP_ALL 1
#endif
#ifndef REP_SUB
#define REP_SUB 0
#endif
#pragma unroll 1
    for (int ra = 0; ra < REP_ALL; ++ra) {
    if (ra > 0) xcd_barrier(bar);
    if (IN(0)) { PHCTX; for (int rep = 0; rep < REPS(100); ++rep) phase_prologue(Fp); }
    SEAM(0);
    float* XC = WSP(float, WS_XC);
#pragma unroll 1
    for (int l = 0; l < 2; ++l) {
        const int pb = 1 + l * PH_PER_LAYER;
        const float* xlat = l == 0 ? F.in[0] : F.out; const float* xctx = l == 0 ? F.in[2] : XC;
        const int mrows = l == 0 ? MALL : MLAT;
        const float* mod = WSP(float, WS_MOD) + (size_t)l * 3 * 6144;
        if (IN(pb + 0) && l == 0) { PHCTX; for (int rep = 0; rep < REPS(0); ++rep) { phase_norm(Fp, l, 0, MALL, xlat, xctx); } }
        if (l == 0) SEAM(pb + 0);
        if (IN(pb + 1)) for (int rep = 0; rep < REPS(1); ++rep) { PHCTX; pg8::Gemm g{WSP(bf16_t, WS_H), WSP(bf16_t, WS_WIN + l * WIN_LSTRIDE), MALL, DINP, DM}; pg8::StaticOrder So; So.init(MALL, DINP, F.G, (int)blockIdx.x);
            pg8::EpiBf16 E{WSP(bf16_t, WS_P), DINP}; pg8::gemm_phase<pg8::EpiBf16, pg8::StaticOrder, true, true>(F.lds, g, So, E, Fp.tid); }
        SEAM(pb + 1);
        if (IN(pb + 2)) { PHCTX; for (int rep = 0; rep < REPS(2); ++rep) { phase_prep(Fp, l); __syncthreads(); } }
        SEAM(pb + 2);
        if (IN(pb + 3)) for (int rep = 0; rep < REPS(3); ++rep) {
            const int nra = 16 * RCH, nml = 16 * NCHK;
            for (int r3 = 0; r3 < (REP_SUB == 3 ? 2 : 1); ++r3) { PHCTX; for (int task = F.vcu; task < nra; task += F.G) { RaRaw cur_; ra_load(Fp, task, cur_); rwkv_chunk_pre(Fp, task, cur_); } __syncthreads(); }
            for (int r3 = 0; r3 < (REP_SUB == 4 ? 2 : 1); ++r3) { PHCTX; for (int task = (F.vcu + F.G - 72) % F.G; task < nml; task += F.G) mlstm_local(Fp, task); }
        }
        SEAM(pb + 3);
                if (IN(pb + 4)) for (int rep = 0; rep < REPS(4); ++rep) {
            if (F.vcu < 16) { PHCTX; rwkv_chain(Fp, F.vcu); }
            else { { PHCTX; mlstm_chain(Fp, 16); }
                   { PHCTX; const int natt = l == 0 ? 264 : 256; for (int task = F.vcu - 16; task < natt; task += F.G - 16) attn_unit(Fp, l, task); } } }
        SEAM(pb + 4);
        if (IN(pb + 5)) for (int rep = 0; rep < REPS(5); ++rep) { const int nro = l == 0 ? 264 : 256, nun = l == 0 ? 528 : 512;
            { PHCTX; for (int u = F.vcu; u < nro; u += F.G) rwkv_out(Fp, l, u); }
            { PHCTX; for (int u = (F.vcu + F.G - 8) % F.G; u < nun; u += F.G) mlstm_out(Fp, l, u); } }
        SEAM(pb + 5);
        if (IN(pb + 6)) for (int rep = 0; rep < REPS(6); ++rep) { PHCTX; pg8::Gemm g{WSP(bf16_t, WS_YCAT), WSP(bf16_t, WS_WOUT + l * WOUT_LSTRIDE), mrows, DM, DM}; pg8::StaticOrder So; So.init(mrows, DM, F.G, (int)blockIdx.x);
            float* dummy = WSP(float, WS_YR); const bool dm_ = (REPS(6) == 2 && rep == 0); pg8::EpiRes E{xlat, xctx, dm_ ? dummy : F.out, dm_ ? dummy : XC, mod}; pg8::gemm_phase<pg8::EpiRes, pg8::StaticOrder, true, true>(F.lds, g, So, E, Fp.tid); }
        SEAM(pb + 6);
        if (IN(pb + 7)) { PHCTX; for (int rep = 0; rep < REPS(7); ++rep) phase_norm(Fp, l, 1, mrows, F.out, XC); }
        SEAM(pb + 7);
        if (IN(pb + 8)) for (int rep = 0; rep < REPS(8); ++rep) { PHCTX; pg8::Gemm g{WSP(bf16_t, WS_H), WSP(bf16_t, WS_WEFF + l * WEFF_LSTRIDE), mrows, 2048, DM}; pg8::StaticOrder So; So.init(mrows, 2048, F.G, (int)blockIdx.x);
            pg8::EpiBf16S E{WSP(bf16_t, WS_S), MALL}; pg8::gemm_phase<pg8::EpiBf16S, pg8::StaticOrder, true, true>(F.lds, g, So, E, Fp.tid); }
        SEAM(pb + 8);
        if (IN(pb + 9)) { PHCTX; for (int rep = 0; rep < REPS(9); ++rep) { phase_peer(Fp, l, mrows, mod, (REPS(9) == 2 && rep == 0) ? WSP(float, WS_YR) : nullptr); __syncthreads(); } }
        SEAM(pb + 9);
    }
    }
#undef IN
#undef SEAM
}

extern "C" void kernel_launch(void* const* d_in, const int* in_sizes, int n_in, void* d_out, int out_size, void* d_ws, size_t ws_size, hipStream_t stream) {
    static int grid = 0;
    if (grid == 0) {
        if (n_in != 32 || out_size != MLAT * DM || ws_size < WS_END2) { fprintf(stderr, "kernel_launch: unexpected shapes: n_in %d out %d ws %zu (need %zu)\n", n_in, out_size, ws_size, (size_t)WS_END2); grid = -1; return; }
        int dev = 0, cus = 0, per_cu = 0;
        if (hipGetDevice(&dev) != hipSuccess || hipDeviceGetAttribute(&cus, hipDeviceAttributeMultiprocessorCount, dev) != hipSuccess) { grid = -1; return; }
        if (hipFuncSetAttribute((const void*)mk_fwd, hipFuncAttributeMaxDynamicSharedMemorySize, LDS_BYTES) != hipSuccess) { fprintf(stderr, "kernel_launch: hipFuncSetAttribute failed\n"); grid = -1; return; }
        if (hipOccupancyMaxActiveBlocksPerMultiprocessor(&per_cu, (const void*)mk_fwd, NTHR, LDS_BYTES) != hipSuccess || per_cu < 1) fprintf(stderr, "kernel_launch: occupancy query reports %d\n", per_cu);
        (void)hipGetLastError();
        grid = cus;
        if (grid != 256) fprintf(stderr, "kernel_launch: grid %d (built for 256 CUs)\n", grid);
    }
    if (grid < 0) return;
    (void)hipMemsetAsync((char*)d_ws + WS_CTL, 0, CTL_ZERO_BYTES, stream);
    Args a{};
    for (int i = 0; i < 32; ++i) a.in[i] = (const float*)d_in[i];
    a.out = (float*)d_out; a.ws = (unsigned char*)d_ws;
#if MK_MULTI
    for (int p = 0; p < N_PHASES; ++p) { a.ph_lo = p; a.ph_hi = p + 1; a.li = p; hipLaunchKernelGGL(mk_fwd, dim3(grid), dim3(NTHR), LDS_BYTES, stream, a); }
#else
    a.ph_lo = 0; a.ph_hi = N_PHASES; a.li = 0;
    hipLaunchKernelGGL(mk_fwd, dim3(grid), dim3(NTHR), LDS_BYTES, stream, a);
#endif
}
```

```cpp
#include <hip/hip_runtime.h>
#include <cstdio>
#include <cstdint>

#ifndef MK_MULTI
#define MK_MULTI 0
#endif
namespace pg8 {
#define PG8_LAS __attribute__((address_space(3)))
typedef unsigned short bf16_t;
typedef short bf16x8 __attribute__((ext_vector_type(8)));
typedef float f32x4 __attribute__((ext_vector_type(4)));
typedef unsigned u32x4 __attribute__((ext_vector_type(4)));
constexpr int BM = 256, BK = 64, HALF = 128, HTB = HALF * BK * 2  , STAGE_BYTES = 8 * HTB, NXCD = 8, WGM = 8;

__host__ __device__ __forceinline__ int lds_byte(int r, int c) { const int st = (r >> 4) * 2 + (c >> 5), rr = r & 15, cc = c & 31, ob = rr * 64 + cc * 2; return st * 1024 + (ob ^ (((ob >> 9) & 1) << 5)); }
__host__ __device__ __forceinline__ void stage_rc(int b, int& R, int& C) { const int st = b / 1024, sb = b % 1024, swz = sb ^ (((sb >> 9) & 1) << 5); R = (st >> 1) * 16 + swz / 64; C = (st & 1) * 32 + (swz % 64) / 2; }
__host__ __device__ __forceinline__ int perm32(int rho) { const int n = rho >> 4, i = rho & 15; return 8 * (i >> 2) + 4 * n + (i & 3); }

struct Unit { int pm, pn; };
struct Gemm { const bf16_t* A; const bf16_t* Bt; int M, N, K; };

struct StaticOrder {
    int nM, nN, nwg, G, c;
    __host__ __device__ void init(int M, int N, int G_, int c_) { nM = M / BM; nN = N / BM; nwg = nM * nN; G = G_; c = c_; }
    __host__ __device__ bool next(int i, Unit& u) const {
        const long L = (long)i * G + c; if (L >= nwg) return false;
        int wgid = (int)L; { const int q = nwg / NXCD, r = nwg % NXCD, xcd = wgid % NXCD, off = wgid / NXCD; wgid = (xcd < r ? xcd * (q + 1) : r * (q + 1) + (xcd - r) * q) + off; }
        const int nig = WGM * nN, gid = wgid / nig, fm = gid * WGM, gsz = (nM - fm) < WGM ? (nM - fm) : WGM;
        u.pm = fm + ((wgid % nig) % gsz); u.pn = (wgid % nig) / gsz; return true;
    }
    __device__ __forceinline__ void a_ready(const Unit&) const {}
    __device__ __forceinline__ void done(const Unit&) const {}
};

__device__ __forceinline__ unsigned cvt_pk_bf16(float lo, float hi) { unsigned r; asm volatile("v_cvt_pk_bf16_f32 %0, %1, %2" : "=v"(r) : "v"(lo), "v"(hi)); return r; }

struct EpiBf16 {
    static constexpr bool PERM = true, AFTER_DRAIN = false;
    bf16_t* O; int ldc;
    __device__ __forceinline__ void operator()(const f32x4 (&acc)[2][2][4][2], const Unit& u, int wr, int wc, int fr, int fq) const {
        const int row0 = u.pm * BM + wr * 64 + fr; const int col0 = u.pn * BM + wc * 32 + 8 * fq;
#pragma unroll
        for (int ai = 0; ai < 2; ++ai)
#pragma unroll
            for (int m = 0; m < 4; ++m) { bf16_t* rowp = O + (size_t)(row0 + ai * HALF + m * 16) * ldc + col0;
#pragma unroll
                for (int bj = 0; bj < 2; ++bj) { const f32x4 v0 = acc[ai][bj][m][0], v1 = acc[ai][bj][m][1];
                    u32x4 w; w.x = cvt_pk_bf16(v0[0], v0[1]); w.y = cvt_pk_bf16(v0[2], v0[3]); w.z = cvt_pk_bf16(v1[0], v1[1]); w.w = cvt_pk_bf16(v1[2], v1[3]);
                    *(u32x4*)(rowp + bj * HALF) = w; } }
    }
};
struct EpiF32 {
    static constexpr bool PERM = false, AFTER_DRAIN = false;
    float* O; int ldr;
    __device__ __forceinline__ void operator()(const f32x4 (&acc)[2][2][4][2], const Unit& u, int wr, int wc, int fr, int fq) const {
        const int row0 = u.pm * BM + wr * 64 + fr; const int col0 = u.pn * BM + wc * 32 + 4 * fq;
#pragma unroll
        for (int ai = 0; ai < 2; ++ai)
#pragma unroll
            for (int m = 0; m < 4; ++m) { const int row = row0 + ai * HALF + m * 16;
#pragma unroll
                for (int bj = 0; bj < 2; ++bj)
#pragma unroll
                    for (int n = 0; n < 2; ++n) { const int cg = (col0 + bj * HALF + n * 16) >> 2; *(f32x4*)(O + ((size_t)cg * ldr + row) * 4) = acc[ai][bj][m][n]; } }
    }
};
struct EpiBf16S {
    static constexpr bool PERM = true, AFTER_DRAIN = false;
    bf16_t* O; int ldr;
    __device__ __forceinline__ void operator()(const f32x4 (&acc)[2][2][4][2], const Unit& u, int wr, int wc, int fr, int fq) const {
        const int row0 = u.pm * BM + wr * 64 + fr; const int col0 = u.pn * BM + wc * 32 + 8 * fq;
#pragma unroll
        for (int ai = 0; ai < 2; ++ai)
#pragma unroll
            for (int m = 0; m < 4; ++m) { const int row = row0 + ai * HALF + m * 16;
#pragma unroll
                for (int bj = 0; bj < 2; ++bj) { const f32x4 v0 = acc[ai][bj][m][0], v1 = acc[ai][bj][m][1];
                    u32x4 w; w.x = cvt_pk_bf16(v0[0], v0[1]); w.y = cvt_pk_bf16(v0[2], v0[3]); w.z = cvt_pk_bf16(v1[0], v1[1]); w.w = cvt_pk_bf16(v1[2], v1[3]);
                    *(u32x4*)(O + ((size_t)((col0 + bj * HALF) >> 3) * ldr + row) * 8) = w; } }
    }
};
struct EpiRes {
    static constexpr bool PERM = true, AFTER_DRAIN = false;
    const float* src_lat; const float* src_ctx; float* dst_lat; float* dst_ctx; const float* gate;
    bf16_t* x1 = nullptr;
    const bf16_t* src16 = nullptr;
    __device__ __forceinline__ void operator()(const f32x4 (&acc)[2][2][4][2], const Unit& u, int wr, int wc, int fr, int fq) const {
        const bool isc = u.pm >= 64; const int smp = isc ? 2 : (u.pm >> 5);
        const int prow = (isc ? (u.pm - 64) * BM : u.pm * BM) + wr * 64 + fr;
        const float* src = isc ? src_ctx : src_lat; float* dst = isc ? dst_ctx : dst_lat;
        const float* gt = gate + smp * 6144 + 2048;
        const int col0 = u.pn * BM + wc * 32 + 8 * fq;
        f32x4 gv[2][2];
#pragma unroll
        for (int bj = 0; bj < 2; ++bj)
#pragma unroll
            for (int n = 0; n < 2; ++n) gv[bj][n] = *(const f32x4*)(gt + col0 + bj * HALF + 4 * n);
#pragma unroll
        for (int ai = 0; ai < 2; ++ai)
#pragma unroll
            for (int m = 0; m < 4; ++m) { const size_t off = (size_t)(prow + ai * HALF + m * 16) * 1024 + col0;
#pragma unroll
                for (int bj = 0; bj < 2; ++bj) { f32x4 s0, s1;
                    if (src16 && !isc) { const u32x4 sw = *(const u32x4*)(src16 + off + bj * HALF); s0 = (f32x4){__uint_as_float(sw.x << 16), __uint_as_float(sw.x & 0xffff0000u), __uint_as_float(sw.y << 16), __uint_as_float(sw.y & 0xffff0000u)};
                        s1 = (f32x4){__uint_as_float(sw.z << 16), __uint_as_float(sw.z & 0xffff0000u), __uint_as_float(sw.w << 16), __uint_as_float(sw.w & 0xffff0000u)}; }
                    else { s0 = *(const f32x4*)(src + off + bj * HALF); s1 = *(const f32x4*)(src + off + bj * HALF + 4); }
                    const f32x4 o0 = s0 + gv[bj][0] * acc[ai][bj][m][0], o1 = s1 + gv[bj][1] * acc[ai][bj][m][1];
                    if (x1) { u32x4 w; w.x = cvt_pk_bf16(o0[0], o0[1]); w.y = cvt_pk_bf16(o0[2], o0[3]); w.z = cvt_pk_bf16(o1[0], o1[1]); w.w = cvt_pk_bf16(o1[2], o1[3]);
                        *(u32x4*)(x1 + off + (isc ? (size_t)16384 * 1024 : 0) + bj * HALF) = w; }
                    else { *(f32x4*)(dst + off + bj * HALF) = o0; *(f32x4*)(dst + off + bj * HALF + 4) = o1; } } }
    }
};

template <class Epi, class Sched, bool ALIGN_EPI = false, bool SP2 = false>
__device__ __forceinline__ void gemm_phase(PG8_LAS unsigned char* lds, const Gemm g, const Sched& S, const Epi& E, const int tid) {
    const int wid = __builtin_amdgcn_readfirstlane(tid >> 6), lane = tid & 63, wr = wid >> 2, wc = wid & 3, fr = lane & 15, fq = lane >> 4;
    const int K = g.K, nt = K / BK;
    unsigned voffA[2], voffB[2];
#pragma unroll
    for (int i = 0; i < 2; ++i) { int R, C; stage_rc(tid * 16 + i * 8192, R, C); const int Rb = Epi::PERM ? ((R & ~31) + perm32(R & 31)) : R;
        voffA[i] = (unsigned)(R * K + C) * 2u; voffB[i] = (unsigned)(Rb * K + C) * 2u; }
    const size_t kstep = (size_t)(BK * 2);
    const size_t hstep = (size_t)HALF * K * 2;
    const size_t tstep = 2 * hstep;
    const unsigned ldsw = (unsigned)wid * 1024u;
    const int aoff = lds_byte(wr * 64 + fr, fq * 8), boff = lds_byte(wc * 32 + fr, fq * 8);
#define PG8_SA(b, h) (((b) * 2 + (h)) * HTB)
#define PG8_SB(b, h) ((4 + (b) * 2 + (h)) * HTB)
#define PG8_STAGE(bufoff, gbase, voff) do { _Pragma("unroll") for (int _i = 0; _i < 2; ++_i) \
        __builtin_amdgcn_global_load_lds((const unsigned*)((const char*)(gbase) + (voff)[_i]), (PG8_LAS unsigned*)(lds + (bufoff) + ldsw + _i * 8192), 16, 0, 0); } while (0)
#define PG8_LDA(dst, b, h) do { _Pragma("unroll") for (int m = 0; m < 4; ++m) _Pragma("unroll") for (int k = 0; k < 2; ++k) dst[m][k] = *(const PG8_LAS bf16x8*)(lds + PG8_SA(b, h) + aoff + m * 2048 + k * 1024); } while (0)
#define PG8_LDB(dst, b, h) do { _Pragma("unroll") for (int n = 0; n < 2; ++n) _Pragma("unroll") for (int k = 0; k < 2; ++k) dst[n][k] = *(const PG8_LAS bf16x8*)(lds + PG8_SB(b, h) + boff + n * 2048 + k * 1024); } while (0)
#define PG8_MMA(ai, bj, At, Bt) do { __builtin_amdgcn_s_setprio(1); _Pragma("unroll") for (int m = 0; m < 4; ++m) _Pragma("unroll") for (int n = 0; n < 2; ++n) _Pragma("unroll") for (int k = 0; k < 2; ++k) \
        acc[ai][bj][m][n] = __builtin_amdgcn_mfma_f32_16x16x32_bf16(Bt[n][k], At[m][k], acc[ai][bj][m][n], 0, 0, 0); __builtin_amdgcn_s_setprio(0); } while (0)
#define PG8_WAIT_V(n) asm volatile("s_waitcnt vmcnt(" #n ")" ::: "memory")
#define PG8_WAIT_L(n) asm volatile("s_waitcnt lgkmcnt(" #n ")" ::: "memory")
#define PG8_BAR __builtin_amdgcn_s_barrier()
#define PG8_SCHED __builtin_amdgcn_sched_barrier(0)
    Unit cur, nxt; int ui = 0;
    if (!S.next(0, cur)) return;
    f32x4 acc[2][2][4][2];
#pragma unroll
    for (int a = 0; a < 2; ++a)
#pragma unroll
        for (int b = 0; b < 2; ++b)
#pragma unroll
            for (int m = 0; m < 4; ++m)
#pragma unroll
                for (int n = 0; n < 2; ++n) acc[a][b][m][n] = (f32x4){0.f, 0.f, 0.f, 0.f};
    bf16x8 At[4][2], B0[2][2], B1[2][2];
    const char* cA = (const char*)g.A + (size_t)cur.pm * tstep; const char* cB = (const char*)g.Bt + (size_t)cur.pn * tstep;
    S.a_ready(cur);
    if constexpr (SP2) {
        PG8_STAGE(PG8_SB(0, 0), cB, voffB); PG8_STAGE(PG8_SB(0, 1), cB + hstep, voffB); PG8_STAGE(PG8_SA(0, 0), cA, voffA); PG8_STAGE(PG8_SA(0, 1), cA + hstep, voffA);
        if (wr == 1) PG8_BAR;
        PG8_WAIT_V(2); PG8_BAR;
        PG8_STAGE(PG8_SB(1, 0), cB + kstep, voffB); PG8_STAGE(PG8_SA(1, 0), cA + kstep, voffA); PG8_STAGE(PG8_SB(1, 1), cB + hstep + kstep, voffB);
        PG8_WAIT_V(6); PG8_BAR;
    } else {
        PG8_STAGE(PG8_SB(0, 0), cB, voffB); PG8_STAGE(PG8_SA(0, 0), cA, voffA); PG8_STAGE(PG8_SB(0, 1), cB + hstep, voffB); PG8_STAGE(PG8_SA(0, 1), cA + hstep, voffA);
        if (wr == 1) PG8_BAR;
        PG8_WAIT_V(4); PG8_BAR;
        PG8_STAGE(PG8_SB(1, 0), cB + kstep, voffB); PG8_STAGE(PG8_SA(1, 0), cA + kstep, voffA); PG8_STAGE(PG8_SB(1, 1), cB + hstep + kstep, voffB);
        PG8_WAIT_V(6); PG8_BAR;
    }
    for (;;) {
        const bool has_next = S.next(ui + 1, nxt);
        const char* nA = has_next ? (const char*)g.A + (size_t)nxt.pm * tstep : cA; const char* nB = has_next ? (const char*)g.Bt + (size_t)nxt.pn * tstep : cB;
        for (int t = 0; t < nt; t += 2) {
            const bool last = (t == nt - 2);
            const char* a1 = cA + (size_t)(t + 1) * kstep;
            const char* a2 = last ? nA : cA + (size_t)(t + 2) * kstep; const char* b2 = last ? nB : cB + (size_t)(t + 2) * kstep;
            const char* a3 = a2 + kstep; const char* b3 = b2 + kstep;
            if (last && has_next) S.a_ready(nxt);
            if constexpr (SP2) {
            PG8_LDB(B0, 0, 0); PG8_LDB(B1, 0, 1); PG8_SCHED; PG8_LDA(At, 0, 0); PG8_STAGE(PG8_SA(1, 1), a1 + hstep, voffA);
            PG8_WAIT_V(8); PG8_WAIT_L(0); PG8_BAR; PG8_MMA(0, 0, At, B0); PG8_MMA(0, 1, At, B1); PG8_BAR; PG8_SCHED;
            PG8_LDA(At, 0, 1); PG8_STAGE(PG8_SB(0, 0), b2, voffB); PG8_STAGE(PG8_SB(0, 1), b2 + hstep, voffB); PG8_STAGE(PG8_SA(0, 0), a2, voffA);
            PG8_WAIT_V(8); PG8_WAIT_L(0); PG8_BAR; PG8_MMA(1, 0, At, B0); PG8_MMA(1, 1, At, B1); PG8_BAR; PG8_SCHED;
            PG8_LDB(B0, 1, 0); PG8_LDB(B1, 1, 1); PG8_SCHED; PG8_LDA(At, 1, 0); PG8_STAGE(PG8_SA(0, 1), a2 + hstep, voffA);
            PG8_WAIT_V(8); PG8_WAIT_L(0); PG8_BAR; PG8_MMA(0, 0, At, B0); PG8_MMA(0, 1, At, B1); PG8_BAR; PG8_SCHED;
            PG8_LDA(At, 1, 1); PG8_STAGE(PG8_SB(1, 0), b3, voffB); PG8_STAGE(PG8_SB(1, 1), b3 + hstep, voffB); PG8_STAGE(PG8_SA(1, 0), a3, voffA);
            PG8_WAIT_V(8); PG8_WAIT_L(0); PG8_BAR; PG8_MMA(1, 0, At, B0); PG8_MMA(1, 1, At, B1); PG8_BAR; PG8_SCHED;
            } else {
            PG8_LDB(B0, 0, 0); PG8_SCHED; PG8_LDA(At, 0, 0); PG8_STAGE(PG8_SA(1, 1), a1 + hstep, voffA);
            PG8_WAIT_L(8); PG8_BAR; PG8_WAIT_L(0); PG8_MMA(0, 0, At, B0); PG8_BAR; PG8_SCHED;
            PG8_LDB(B1, 0, 1); PG8_STAGE(PG8_SB(0, 0), b2, voffB);
            PG8_BAR; PG8_WAIT_L(0); PG8_MMA(0, 1, At, B1); PG8_BAR;
            PG8_LDA(At, 0, 1); PG8_STAGE(PG8_SA(0, 0), a2, voffA);
            PG8_BAR; PG8_WAIT_L(0); PG8_MMA(1, 0, At, B0); PG8_BAR; PG8_SCHED;
            PG8_STAGE(PG8_SB(0, 1), b2 + hstep, voffB);
            PG8_WAIT_V(6); PG8_BAR; PG8_MMA(1, 1, At, B1); PG8_BAR;
            PG8_LDB(B0, 1, 0); PG8_SCHED; PG8_LDA(At, 1, 0); PG8_STAGE(PG8_SA(0, 1), a2 + hstep, voffA);
            PG8_WAIT_L(8); PG8_BAR; PG8_WAIT_L(0); PG8_MMA(0, 0, At, B0); PG8_BAR; PG8_SCHED;
            PG8_LDB(B1, 1, 1); PG8_STAGE(PG8_SB(1, 0), b3, voffB);
            PG8_BAR; PG8_WAIT_L(0); PG8_MMA(0, 1, At, B1); PG8_BAR;
            PG8_LDA(At, 1, 1); PG8_STAGE(PG8_SA(1, 0), a3, voffA);
            PG8_BAR; PG8_WAIT_L(0); PG8_MMA(1, 0, At, B0); PG8_BAR; PG8_SCHED;
            PG8_STAGE(PG8_SB(1, 1), b3 + hstep, voffB);
            PG8_WAIT_V(6); PG8_BAR; PG8_MMA(1, 1, At, B1); PG8_BAR;
            }
        }
        if constexpr (ALIGN_EPI) { if (wr == 0) PG8_BAR; }
        if constexpr (!Epi::AFTER_DRAIN) { E(acc, cur, wr, wc, fr, fq); S.done(cur); }
        if (!has_next) break;
#pragma unroll
        for (int a = 0; a < 2; ++a)
#pragma unroll
            for (int b = 0; b < 2; ++b)
#pragma unroll
                for (int m = 0; m < 4; ++m)
#pragma unroll
                    for (int n = 0; n < 2; ++n) acc[a][b][m][n] = (f32x4){0.f, 0.f, 0.f, 0.f};
        cur = nxt; cA = nA; cB = nB; ++ui;
        if constexpr (ALIGN_EPI) { if (wr == 1) PG8_BAR; }
    }
    PG8_WAIT_V(0);
    if constexpr (!ALIGN_EPI) { if (wr == 0) PG8_BAR; }
    PG8_BAR;
    if constexpr (Epi::AFTER_DRAIN) { E.fused(acc, cur, wr, wc, fr, fq, lds, wid, lane); S.done(cur); }
#undef PG8_SA
#undef PG8_SB
#undef PG8_STAGE
#undef PG8_LDA
#undef PG8_LDB
#undef PG8_MMA
#undef PG8_WAIT_V
#undef PG8_WAIT_L
#undef PG8_BAR
#undef PG8_SCHED
}
}
#ifndef ZMASK
#define ZMASK 0
#endif
#define ZF(bit) ((ZMASK & (bit)) ? 0.f : 1.f)
using pg8::bf16_t; using pg8::bf16x8; using pg8::f32x4; using pg8::u32x4;
constexpr int NWAVES = 8, NTHR = 512;
constexpr int DM = 1024, TLAT = 8192, TCTX = 256, MLAT = 2 * TLAT, MCTX = 2 * TCTX, MALL = MLAT + MCTX;
constexpr int DIN = 3152, DINP = 3328;
constexpr int C_CH = 0, C_CB = 256, C_CC = 512, C_RR = 768, C_RK = 1024, C_RV = 1280, C_XW = 1536, C_XA = 1552, C_XG = 1568,
              C_AQ = 1600, C_AK = 1856, C_AV = 1984, C_MQ = 2112, C_MK = 2368, C_MV = 2624, C_MO = 2880, C_MG = 3136;
constexpr float EPSN = 1e-6f;
constexpr int NCHK = 66;
constexpr int CST = 4160;
constexpr int RWREC = 4608;
constexpr size_t MiB = 1u << 20;
constexpr size_t WS_CTL = 0, CTL_ZERO_BYTES = 32 * 1024, WS_MOD = 1 * MiB;
constexpr size_t WS_WIN = 2 * MiB, WIN_LSTRIDE = (size_t)DINP * DM * 2;
constexpr size_t WS_WOUT = 16 * MiB, WOUT_LSTRIDE = 2 * MiB;
constexpr size_t WS_WEFF = 20 * MiB, WEFF_LSTRIDE = 4 * MiB;
constexpr size_t WS_XC = 28 * MiB, WS_GA = 30 * MiB, WS_H = 32 * MiB, WS_YCAT = 65 * MiB, WS_U = 98 * MiB, WS_V = 130 * MiB;
constexpr size_t WS_P = 162 * MiB, WS_RW = 270 * MiB, WS_YR = 345 * MiB, WS_QA = 378 * MiB, WS_KA = 387 * MiB;
constexpr size_t WS_LC = 392 * MiB, WS_ST = 409 * MiB, WS_LB = 426 * MiB, WS_EG = 427 * MiB, WS_GB = 444 * MiB, WS_BS = 453 * MiB, WS_SC = 453 * MiB + 512 * 1024, WS_END = 454 * MiB;
constexpr size_t UV_LSTRIDE = 16 * MiB;
constexpr size_t WS_X1 = WS_RW;
constexpr size_t WS_S = WS_P;
static_assert(WS_P + (size_t)MALL * DINP * 2 <= WS_RW && WS_RW + (size_t)MALL * RWREC <= WS_YR && WS_S + (size_t)MALL * 2048 * 4 <= WS_YR, "ws map");
static_assert(WS_LC + (size_t)16 * NCHK * CST * 4 <= WS_ST && WS_ST + (size_t)16 * NCHK * CST * 4 <= WS_LB && WS_EG + (size_t)MALL * 128 * 8 <= WS_GB, "ws map 2");
constexpr int CW_BAR = 4096;
constexpr int RING_BYTES = 131072;
constexpr int PEER_WLDS = 16 * 528 + 2048 + 512 + 9 * 512 + 9 * 256 + 64;
constexpr int PHASE_LDS = 8 * PEER_WLDS > RING_BYTES ? 8 * PEER_WLDS : RING_BYTES;
constexpr int LDSCTL_OFF = PHASE_LDS, MISC_OFF = LDSCTL_OFF + 320, LDS_BYTES = PHASE_LDS + 4096;
static_assert(RING_BYTES <= PHASE_LDS && 8 * PEER_WLDS <= PHASE_LDS && LDS_BYTES <= 160 * 1024 && PHASE_LDS % 16 == 0, "LDS map");

#define GAS __attribute__((address_space(1)))
#define LAS __attribute__((address_space(3)))
typedef unsigned u32x2 __attribute__((ext_vector_type(2)));
typedef float f32x2 __attribute__((ext_vector_type(2)));
typedef int i32x8 __attribute__((ext_vector_type(8)));
typedef _Float16 h16x2 __attribute__((ext_vector_type(2)));
typedef __bf16 bf16x2_t __attribute__((ext_vector_type(2)));
typedef GAS unsigned gu32;
#define LDS_WAIT() asm volatile("s_waitcnt lgkmcnt(0)" ::: "memory")
#define LDS_BARRIER() do { asm volatile("s_waitcnt lgkmcnt(0)" ::: "memory"); __builtin_amdgcn_s_barrier(); asm volatile("" ::: "memory"); } while (0)

__device__ __forceinline__ float lo2f(unsigned w) { return __uint_as_float(w << 16); }
__device__ __forceinline__ float hi2f(unsigned w) { return __uint_as_float(w & 0xffff0000u); }
__device__ __forceinline__ float bf2f(bf16_t b) { return __uint_as_float((unsigned)b << 16); }
__device__ __forceinline__ unsigned f2bf(float f) { unsigned u = __float_as_uint(f); return (u + 0x7fffu + ((u >> 16) & 1u)) >> 16; }
__device__ __forceinline__ unsigned pk2(float lo, float hi) { const f32x2 v = {lo, hi}; const bf16x2_t b = __builtin_convertvector(v, bf16x2_t); return __builtin_bit_cast(unsigned, b); }
__device__ __forceinline__ f32x4 ld4bf(const bf16_t* p) { const u32x2 w = *(const u32x2*)p; return (f32x4){lo2f(w.x), hi2f(w.x), lo2f(w.y), hi2f(w.y)}; }
__device__ __forceinline__ void st4bf(bf16_t* p, f32x4 v) { u32x2 w; w.x = pk2(v[0], v[1]); w.y = pk2(v[2], v[3]); *(u32x2*)p = w; }
__device__ __forceinline__ float sigmoidf_(float x) { return 1.f / (1.f + __expf(-x)); }
__device__ __forceinline__ float tanhf_(float x) { const float e = __expf(-2.f * fabsf(x)); const float t = (1.f - e) / (1.f + e); return x < 0.f ? -t : t; }
template <int CTRL> __device__ __forceinline__ float dppf(float x) { return __int_as_float(__builtin_amdgcn_update_dpp(0, __float_as_int(x), CTRL, 0xf, 0xf, true)); }
__device__ __forceinline__ float red16(float x) { x += dppf<0xB1>(x); x += dppf<0x4E>(x); x += dppf<0x141>(x); x += dppf<0x140>(x); return x; }
__device__ __forceinline__ float wave_sum(float v) {
#pragma unroll
    for (int o = 1; o < 64; o <<= 1) v += __shfl_xor(v, o);
    return v;
}
#define XB_TMO      128
#define XB_XCNT(j)  (256  + 64 * (j))
#define XB_XSUB(j)  (1280 + 64 * (j))
#define XB_XGEN(j)  (2304 + 64 * (j))
#define XB_TOP      3328
#define XB_TOPGEN   3392
#define XCD_BAR_WORDS 3456
#define XB_SPIN_CAP (1u << 18)
#ifndef XB_SLEEP
#define XB_SLEEP 0
#endif

__device__ __forceinline__ unsigned xb_ld(unsigned* p)              { return __hip_atomic_load(p, __ATOMIC_RELAXED, __HIP_MEMORY_SCOPE_AGENT); }
__device__ __forceinline__ unsigned xb_add(unsigned* p, unsigned v) { return __hip_atomic_fetch_add(p, v, __ATOMIC_RELAXED, __HIP_MEMORY_SCOPE_AGENT); }
__device__ __forceinline__ unsigned xb_xcc_id() { return (unsigned)__builtin_amdgcn_s_getreg((3 << 11) | 20) & 0xFu; }
#define XB_SPIN(cond, bar) do { unsigned _sp = 0; while (cond) { __builtin_amdgcn_s_sleep(XB_SLEEP); \
    if ((++_sp & 255u) == 0u) { if (xb_ld(&(bar)[XB_TMO])) break; if (_sp > XB_SPIN_CAP) { atomicAdd(&(bar)[XB_TMO], 1u); break; } } } } while (0)

struct XcdBarrier {
    unsigned* bar; unsigned x;
    volatile LAS unsigned* st;
};

__device__ __forceinline__ XcdBarrier xcd_barrier_post(unsigned* bar, volatile LAS unsigned* st) {
    XcdBarrier b; b.bar = bar; b.x = xb_xcc_id(); b.st = st;
    if (threadIdx.x == 0) (void)xb_add(&bar[XB_XCNT(b.x)], 1u);
    return b;
}
__device__ __forceinline__ void xcd_barrier_complete(unsigned* bar, unsigned x, unsigned& nloc, unsigned& nx) {
    const unsigned G = gridDim.x * gridDim.y * gridDim.z;
    unsigned sum, cnt, mine, sp = 0u;
    for (;;) {
        sum = 0u; cnt = 0u; mine = 0u;
#pragma unroll
        for (unsigned j = 0; j < 16; ++j) { const unsigned c = xb_ld(&bar[XB_XCNT(j)]); sum += c; cnt += (c > 0u) ? 1u : 0u; mine = (j == x) ? c : mine; }
        if (sum == G) break;
        __builtin_amdgcn_s_sleep(1);
        if ((++sp & 255u) == 0u) { if (xb_ld(&bar[XB_TMO])) break; if (sp > XB_SPIN_CAP) { atomicAdd(&bar[XB_TMO], 1u); break; } }
    }
    nloc = mine > 0u ? mine : 1u; nx = cnt > 0u ? cnt : 1u;
}

__device__ __forceinline__ void xcd_barrier(const XcdBarrier& b) {
    asm volatile("s_waitcnt vmcnt(0)" ::: "memory");
    __syncthreads();
    if (threadIdx.x == 0) {
        unsigned* bar = b.bar;
        __builtin_amdgcn_s_waitcnt(0);
        unsigned nloc = b.st[0], nx = b.st[1];
        if (nloc == 0u) { xcd_barrier_complete(bar, b.x, nloc, nx); b.st[0] = nloc; b.st[1] = nx; }
        const unsigned old = xb_add(&bar[XB_XSUB(b.x)], 1u);
        const unsigned gen = old / nloc;
        if (old + 1u == (gen + 1u) * nloc) {
            __builtin_amdgcn_fence(__ATOMIC_RELEASE, "agent");
            asm volatile("s_waitcnt vmcnt(0)" ::: "memory");
            const unsigned og = xb_add(&bar[XB_TOP], 1u);
            const unsigned tg = og / nx;
            if (og + 1u != (tg + 1u) * nx) XB_SPIN(xb_ld(&bar[XB_TOP]) < (tg + 1u) * nx, bar);
            __builtin_amdgcn_fence(__ATOMIC_ACQUIRE, "agent");
            asm volatile("s_waitcnt vmcnt(0)" ::: "memory");
        } else {
            XB_SPIN(xb_ld(&bar[XB_TOP]) < (gen + 1u) * nx, bar);
            __builtin_amdgcn_fence(__ATOMIC_ACQUIRE, "agent");
            asm volatile("s_waitcnt vmcnt(0)" ::: "memory");
        }
    }
    __syncthreads();
}
struct Ctx {
    LAS unsigned char* lds; int tid, lane, wave, vcu, G;
    const float* in[32]; float* out; unsigned char* ws;
};
#define WSP(T, off) ((T*)(F.ws + (off)))

__device__ __forceinline__ void p0_transpose_item(const float* W, int K, int N, bf16_t* WT, LAS float* scr, int item, int lane) {
    const int nblk = (N + 31) / 32, kb = item / nblk, nb = item % nblk, k0 = 64 * kb, n0 = 32 * nb;
    const int nn = n0 + (lane & 31);
#pragma unroll 8
    for (int i = 0; i < 32; ++i) { const int kk = 2 * i + (lane >> 5); scr[kk * 33 + (lane & 31)] = nn < N ? W[(size_t)(k0 + kk) * N + nn] : 0.f; }
    LDS_WAIT(); asm volatile("" ::: "memory");
    const int c = lane & 7;
#pragma unroll
    for (int j = 0; j < 4; ++j) { const int n = (lane >> 3) + 8 * j; const LAS float* s = scr + (8 * c) * 33 + n;
        u32x4 o; o.x = pk2(s[0 * 33], s[1 * 33]); o.y = pk2(s[2 * 33], s[3 * 33]); o.z = pk2(s[4 * 33], s[5 * 33]); o.w = pk2(s[6 * 33], s[7 * 33]);
        *(u32x4*)(WT + (size_t)(n0 + n) * K + k0 + 8 * c) = o; }
    LDS_WAIT(); asm volatile("" ::: "memory");
}
__device__ __forceinline__ void convert_uv_rows(const Ctx& F, int l, int r_lo, int r_hi, int widx, int nworkers) {
    float* SC = WSP(float, WS_SC) + (size_t)l * 2 * 16384;
    for (int r0 = r_lo + widx; r0 < r_hi; r0 += 4 * nworkers) {
        f32x4 v[4][4];
#pragma unroll
        for (int u = 0; u < 4; ++u) { const int r = r0 + u * nworkers < r_hi ? r0 + u * nworkers : r0; const int tb = r >> 14, row = r & 16383;
            const float* src = (tb ? F.in[31] : F.in[30]) + ((size_t)l * 16384 + row) * 1024 + F.lane * 16;
#pragma unroll
            for (int j = 0; j < 4; ++j) v[u][j] = *(const f32x4*)(src + 4 * j); }
#pragma unroll
        for (int u = 0; u < 4; ++u) { const int r = r0 + u * nworkers; if (r >= r_hi) break; const int tb = r >> 14, row = r & 16383;
            float am = 0.f;
#pragma unroll
            for (int j = 0; j < 4; ++j) am = fmaxf(am, fmaxf(fmaxf(fabsf(v[u][j][0]), fabsf(v[u][j][1])), fmaxf(fabsf(v[u][j][2]), fabsf(v[u][j][3]))));
#pragma unroll
            for (int o = 1; o < 64; o <<= 1) am = fmaxf(am, __shfl_xor(am, o));
            const float sc = am > 0.f ? 6.f / am : 1.f;
            unsigned ow[2] = {0u, 0u};
#pragma unroll
            for (int j = 0; j < 4; ++j) { unsigned w = ow[j >> 1];
                if (j & 1) { w = __builtin_amdgcn_cvt_scalef32_pk_fp4_f32(w, v[u][j][0] * sc, v[u][j][1] * sc, 1.0f, 2); w = __builtin_amdgcn_cvt_scalef32_pk_fp4_f32(w, v[u][j][2] * sc, v[u][j][3] * sc, 1.0f, 3); }
                else       { w = __builtin_amdgcn_cvt_scalef32_pk_fp4_f32(w, v[u][j][0] * sc, v[u][j][1] * sc, 1.0f, 0); w = __builtin_amdgcn_cvt_scalef32_pk_fp4_f32(w, v[u][j][2] * sc, v[u][j][3] * sc, 1.0f, 1); }
                ow[j >> 1] = w; }
            *(u32x2*)(F.ws + (tb ? WS_V : WS_U) + (size_t)l * UV_LSTRIDE + (size_t)row * 512 + F.lane * 8) = (u32x2){ow[0], ow[1]};
            if (F.lane == 0) SC[row * 2 + tb] = am > 0.f ? am * (1.f / 6.f) : 1.f; }
    }
}
__device__ __forceinline__ void convert_uv(const Ctx& F, int l) { convert_uv_rows(F, l, 0, 2 * 16384, F.vcu * NWAVES + F.wave, F.G * NWAVES); }
__device__ __forceinline__ void phase_prologue(const Ctx& F) {
    float* MOD = WSP(float, WS_MOD);
    {
        LAS float* sl = (LAS float*)F.lds; LAS float* red = sl + 3072;
        for (int it = F.vcu; it < 192; it += F.G) {
            const int l = it / 96, n0 = (it % 96) * 64;
            for (int i = F.tid; i < 3072; i += NTHR) { const int s = i >> 10, k = i & 1023; const float c = s < 2 ? F.in[1][s * 1024 + k] : F.in[3][k]; sl[i] = c / (1.f + __expf(-c)); }
            __syncthreads();
            const int c = F.tid & 63, kg = F.tid >> 6;
            const float* W = F.in[4] + (size_t)l * 1024 * 6144 + n0 + c;
            float a0 = 0.f, a1 = 0.f, a2 = 0.f;
#pragma unroll 32
            for (int k = kg * 128; k < kg * 128 + 128; ++k) { const float w = W[(size_t)k * 6144]; a0 += sl[k] * w; a1 += sl[1024 + k] * w; a2 += sl[2048 + k] * w; }
            red[(kg * 3 + 0) * 64 + c] = a0; red[(kg * 3 + 1) * 64 + c] = a1; red[(kg * 3 + 2) * 64 + c] = a2;
            __syncthreads();
            if (F.tid < 192) { const int s = F.tid >> 6, cc = F.tid & 63; float t = F.in[5][l * 6144 + n0 + cc];
#pragma unroll
                for (int g = 0; g < 8; ++g) t += red[(g * 3 + s) * 64 + cc];
                MOD[(l * 3 + s) * 6144 + n0 + cc] = t; }
            __syncthreads();
        }
    }
    {
        LAS float* scr = (LAS float*)(F.lds + F.wave * 16384);
        const int gw = F.vcu * NWAVES + F.wave, NGW = F.G * NWAVES;
        constexpr int I_IN = 16 * 99, I_OUT = 16 * 32, I_L = I_IN + I_OUT;
        for (int it = gw; it < 2 * I_L; it += NGW) {
            const int l = it / I_L; int r = it % I_L;
            if (r < I_IN) p0_transpose_item(F.in[8] + (size_t)l * DM * DIN, DM, DIN, WSP(bf16_t, WS_WIN + l * WIN_LSTRIDE), scr, r, F.lane);
            else p0_transpose_item(F.in[9] + (size_t)l * DM * DM, DM, DM, WSP(bf16_t, WS_WOUT + l * WOUT_LSTRIDE), scr, r - I_IN, F.lane);
        }
        for (int i = F.vcu * NTHR + F.tid; i < 2 * 160 * 128; i += F.G * NTHR) { const int l = i / (160 * 128), r = i % (160 * 128);
            *(u32x4*)(WSP(bf16_t, WS_WIN + l * WIN_LSTRIDE) + (size_t)3168 * DM + (size_t)r * 8) = (u32x4){0u, 0u, 0u, 0u}; }
    }
    __syncthreads();
    {
        LAS float* KEYS = (LAS float*)F.lds; LAS float* WQl = KEYS + 128 * 129;
        const int nper = F.G / 32 > 0 ? F.G / 32 : 1;
        const int tile = F.vcu / nper, sub = F.vcu % nper;
        if (tile < 32) {
            const int l = tile >> 4, hh = tile & 15;
            const float* ksrc = F.in[29] + ((size_t)l * 16 + hh) * 128 * 128;
            { f32x4 kv[8];
#pragma unroll
              for (int q = 0; q < 8; ++q) kv[q] = *(const f32x4*)(ksrc + (size_t)(F.tid + q * NTHR) * 4);
#pragma unroll
              for (int q = 0; q < 8; ++q) { const int i = (F.tid + q * NTHR) * 4; LAS float* d = KEYS + (i >> 7) * 129 + (i & 127); d[0] = kv[q][0]; d[1] = kv[q][1]; d[2] = kv[q][2]; d[3] = kv[q][3]; } }
            for (int kb = sub; kb < 16; kb += nper) {
                const float* wsrc = F.in[28] + (size_t)l * DM * 2048 + (size_t)(kb * 64) * 2048 + hh * 128;
                __syncthreads();
                { f32x4 wv[4];
#pragma unroll
                  for (int q = 0; q < 4; ++q) { const int i = (F.tid + q * NTHR) * 4; wv[q] = *(const f32x4*)(wsrc + (size_t)(i >> 7) * 2048 + (i & 127)); }
#pragma unroll
                  for (int q = 0; q < 4; ++q) { const int i = (F.tid + q * NTHR) * 4, kk = i >> 7, d = i & 127; WQl[d * 68 + kk] = wv[q][0]; WQl[(d + 1) * 68 + kk] = wv[q][1]; WQl[(d + 2) * 68 + kk] = wv[q][2]; WQl[(d + 3) * 68 + kk] = wv[q][3]; } }
                __syncthreads();
                const int key = F.tid & 127, kq = F.tid >> 7;
                float acc[16];
#pragma unroll
                for (int j = 0; j < 16; ++j) acc[j] = 0.f;
#pragma unroll 4
                for (int d = 0; d < 128; ++d) { const float a = KEYS[key * 129 + d]; const LAS f32x4* wq = (const LAS f32x4*)(WQl + d * 68 + kq * 16);
#pragma unroll
                    for (int q = 0; q < 4; ++q) { const f32x4 w = wq[q]; acc[4 * q] += a * w[0]; acc[4 * q + 1] += a * w[1]; acc[4 * q + 2] += a * w[2]; acc[4 * q + 3] += a * w[3]; } }
                bf16_t* dst = WSP(bf16_t, WS_WEFF + l * WEFF_LSTRIDE) + (size_t)(hh * 128 + key) * DM + kb * 64 + kq * 16;
                u32x4 o0, o1; o0.x = pk2(acc[0], acc[1]); o0.y = pk2(acc[2], acc[3]); o0.z = pk2(acc[4], acc[5]); o0.w = pk2(acc[6], acc[7]);
                o1.x = pk2(acc[8], acc[9]); o1.y = pk2(acc[10], acc[11]); o1.z = pk2(acc[12], acc[13]); o1.w = pk2(acc[14], acc[15]);
                *(u32x4*)dst = o0; *(u32x4*)(dst + 8) = o1;
            }
        }
        __syncthreads();
    }
    convert_uv(F, 0); convert_uv(F, 1);
}

__device__ __forceinline__ void phase_norm(const Ctx& F, int l, int which, int nrows, const float* xlat, const float* xctx, const bf16_t* x1 = nullptr) {
    const float* gain = F.in[6 + which] + l * DM; const float* mod = WSP(float, WS_MOD) + (size_t)l * 3 * 6144;
    const int shoff = which ? 3072 : 0, scoff = which ? 4096 : 1024;
    bf16_t* H = WSP(bf16_t, WS_H);
    const int gw = F.vcu * NWAVES + F.wave, NGW = F.G * NWAVES;
    f32x4 gv[4], scv[4], shv[4]; int smp_have = -1;
#pragma unroll
    for (int j = 0; j < 4; ++j) gv[j] = *(const f32x4*)(gain + F.lane * 4 + 256 * j);
    for (int row = gw; row < nrows; row += NGW) {
        const bool isc = row >= MLAT; const float* src = isc ? xctx + (size_t)(row - MLAT) * DM : xlat + (size_t)row * DM; const int smp = isc ? 2 : (row >> 13);
        f32x4 v[4]; float ss = 0.f;
#pragma unroll
        for (int j = 0; j < 4; ++j) { v[j] = x1 ? ld4bf(x1 + (size_t)row * DM + F.lane * 4 + 256 * j) : *(const f32x4*)(src + F.lane * 4 + 256 * j); ss += (v[j][0] * v[j][0] + v[j][1] * v[j][1]) + (v[j][2] * v[j][2] + v[j][3] * v[j][3]); }
        if (smp != smp_have) { const float* mb = mod + smp * 6144; smp_have = smp;
#pragma unroll
            for (int j = 0; j < 4; ++j) { const int c = F.lane * 4 + 256 * j; scv[j] = *(const f32x4*)(mb + scoff + c); shv[j] = *(const f32x4*)(mb + shoff + c); } }
        const float rs = rsqrtf(wave_sum(ss) * (1.f / DM) + EPSN);
#pragma unroll
        for (int j = 0; j < 4; ++j) { const int c = F.lane * 4 + 256 * j; const f32x4 o = (v[j] * rs * gv[j]) * (1.f + scv[j]) + shv[j]; st4bf(H + (size_t)row * DM + c, o); }
    }
}

__device__ __forceinline__ float log_sigmoid_(float x) { return fminf(x, 0.f) - __logf(1.f + __expf(-fabsf(x))); }
__device__ __forceinline__ void phase_prep(const Ctx& F, int l) {
    LAS float* W2s = (LAS float*)F.lds; LAS float* A2s = W2s + 8192; LAS float* G2s = A2s + 8192; LAS float* tsc = G2s + 8192 + F.wave * 64;
    { const float* w2 = F.in[13] + l * 8192; const float* a2 = F.in[15] + l * 8192; const float* g2 = F.in[16] + l * 8192;
      for (int i = F.tid; i < 8192; i += NTHR) { W2s[i] = w2[i]; A2s[i] = a2[i]; G2s[i] = g2[i]; } }
    __syncthreads();
    const bf16_t* P = WSP(bf16_t, WS_P); bf16_t* YC = WSP(bf16_t, WS_YCAT); bf16_t* QA = WSP(bf16_t, WS_QA); bf16_t* KA = WSP(bf16_t, WS_KA);
    unsigned char* RW = WSP(unsigned char, WS_RW); bf16_t* GB = WSP(bf16_t, WS_GB); float* BS = WSP(float, WS_BS); float* GA = WSP(float, WS_GA);
    const int lane = F.lane, c4 = lane * 4, i16 = lane & 15;
    const f32x4 cw0 = *(const f32x4*)(F.in[10] + l * 768 + c4), cw1 = *(const f32x4*)(F.in[10] + l * 768 + 256 + c4), cw2 = *(const f32x4*)(F.in[10] + l * 768 + 512 + c4);
    const f32x4 cg = *(const f32x4*)(F.in[11] + l * 256 + c4);
    const f32x4 qg = *(const f32x4*)(F.in[21] + l * 64 + (c4 & 63)), kg = *(const f32x4*)(F.in[22] + l * 64 + (c4 & 63));
    const f32x4 k_k = *(const f32x4*)(F.in[17] + l * 256 + c4), k_a = *(const f32x4*)(F.in[18] + l * 256 + c4), r_k = *(const f32x4*)(F.in[19] + l * 256 + c4);
    f32x4 w0[2], a0[2];
#pragma unroll
    for (int d = 0; d < 2; ++d) { w0[d] = *(const f32x4*)(F.in[12] + (l * 2 + d) * 256 + c4); a0[d] = *(const f32x4*)(F.in[14] + (l * 2 + d) * 256 + c4); }
    float invf[4];
#pragma unroll
    for (int j = 0; j < 4; ++j) invf[j] = exp2f(-(float)((c4 + j) & 15) * (13.287712379549449f / 16.f));
    const int gw = F.vcu * NWAVES + F.wave, NGW = F.G * NWAVES;
    struct PrepRaw { u32x2 h1, bg, c1, hp, cp, hn, cn, q, k, r, rk; unsigned xv, mg; };
#define PREP_LOAD(dst, row_) do { const int r_ = (row_); const bool isc_ = r_ >= MLAT; const int t_ = isc_ ? ((r_ - MLAT) & 255) : (r_ & 8191); const int T_ = isc_ ? TCTX : TLAT; \
        const bf16_t* pr_ = P + (size_t)r_ * DINP; const bf16_t* pp_ = t_ > 0 ? pr_ - DINP : pr_; const bf16_t* pn_ = t_ < T_ - 1 ? pr_ + DINP : pr_; \
        dst.h1 = *(const u32x2*)(pr_ + C_CH + c4); dst.bg = *(const u32x2*)(pr_ + C_CB + c4); dst.c1 = *(const u32x2*)(pr_ + C_CC + c4); \
        dst.hp = *(const u32x2*)(pp_ + C_CH + c4); dst.cp = *(const u32x2*)(pp_ + C_CC + c4); dst.hn = *(const u32x2*)(pn_ + C_CH + c4); dst.cn = *(const u32x2*)(pn_ + C_CC + c4); \
        dst.q = *(const u32x2*)(pr_ + C_AQ + c4); dst.k = *(const u32x2*)(pr_ + C_AK + (c4 & 127)); dst.r = *(const u32x2*)(pr_ + C_RR + c4); dst.rk = *(const u32x2*)(pr_ + C_RK + c4); \
        dst.xv = pr_[C_XW + lane]; dst.mg = pr_[C_MG + (lane & 15)]; } while (0)
#define UP4(w_) ((f32x4){lo2f((w_).x), hi2f((w_).x), lo2f((w_).y), hi2f((w_).y)})
    PrepRaw cur, nxt;
    if (gw < MALL) PREP_LOAD(cur, gw);
    for (int row = gw; row < MALL; row += NGW) {
        const bool isc = row >= MLAT; const int t = isc ? ((row - MLAT) & 255) : (row & 8191); const int T = isc ? TCTX : TLAT;
        { const int rn = row + NGW < MALL ? row + NGW : row; PREP_LOAD(nxt, rn); }
        {
            const f32x4 h1 = UP4(cur.h1), bg = UP4(cur.bg), c1 = UP4(cur.c1);
            f32x4 up = UP4(cur.hp) * UP4(cur.cp), un = UP4(cur.hn) * UP4(cur.cn);
            if (t == 0) up = (f32x4){0.f, 0.f, 0.f, 0.f};
            if (t == T - 1) un = (f32x4){0.f, 0.f, 0.f, 0.f};
            const f32x4 y = bg * (cw0 * up + cw1 * (c1 * h1) + cw2 * un);
            const float ss = red16((y[0] * y[0] + y[1] * y[1]) + (y[2] * y[2] + y[3] * y[3]));
            const float rs = rsqrtf(ss * (1.f / 64.f) + EPSN);
            st4bf(YC + (size_t)row * DM + c4, y * rs * cg * ZF(2));
        }
        {
            const f32x4 q = UP4(cur.q); const f32x4 k = UP4(cur.k);
            const float qs = red16((q[0] * q[0] + q[1] * q[1]) + (q[2] * q[2] + q[3] * q[3]));
            const float ks = red16((k[0] * k[0] + k[1] * k[1]) + (k[2] * k[2] + k[3] * k[3]));
            f32x4 qn = q * rsqrtf(qs * (1.f / 64.f) + EPSN) * qg, kn = k * rsqrtf(ks * (1.f / 64.f) + EPSN) * kg;
            if (!isc) {
                f32x4 qp, kp;
#pragma unroll
                for (int j = 0; j < 4; ++j) { qp[j] = __shfl_xor(qn[j], 4); kp[j] = __shfl_xor(kn[j], 4); }
                const int d0 = c4 & 63; const float pos = (d0 < 32) ? (float)(t >> 6) : (float)(t & 63); const bool lowh = (d0 & 16) == 0;
#pragma unroll
                for (int j = 0; j < 4; ++j) { const float th = pos * invf[j]; const float cs = __cosf(th), sn = __sinf(th);
                    qn[j] = lowh ? qn[j] * cs - qp[j] * sn : qn[j] * cs + qp[j] * sn; kn[j] = lowh ? kn[j] * cs - kp[j] * sn : kn[j] * cs + kp[j] * sn; }
            }
            st4bf(QA + (size_t)row * 256 + c4, qn * (0.125f * 1.4426950408889634f));
            if (lane < 32) st4bf(KA + (size_t)row * 128 + c4, kn);
        }
        {
            const f32x4 r = UP4(cur.r), k = UP4(cur.rk);
            { const float xv = bf2f((bf16_t)cur.xv);
              tsc[lane] = lane < 16 ? tanhf_(xv) : (lane < 32 ? xv : sigmoidf_(xv)); }
            const f32x4 kx = k * k_k;
            const float kss = red16((kx[0] * kx[0] + kx[1] * kx[1]) + (kx[2] * kx[2] + kx[3] * kx[3]));
            const f32x4 kk = kx * rsqrtf(kss + EPSN);
            bf16_t* recb = (bf16_t*)(RW + (size_t)row * RWREC); float* recf = (float*)(RW + (size_t)row * RWREC + 2560);
            st4bf(recb + c4, kk);
            f32x4 kdsum = {0.f, 0.f, 0.f, 0.f};
#pragma unroll
            for (int d = 0; d < 2; ++d) {
                f32x4 dw = w0[d], da = a0[d];
#pragma unroll 4
                for (int ii = 0; ii < 16; ++ii) { dw += tsc[ii] * *(const LAS f32x4*)(W2s + (d * 16 + ii) * 256 + c4); da += tsc[16 + ii] * *(const LAS f32x4*)(A2s + (d * 16 + ii) * 256 + c4); }
                f32x4 dec, av;
#pragma unroll
                for (int j = 0; j < 4; ++j) { dec[j] = -0.6065306597126334f * sigmoidf_(dw[j]); av[j] = sigmoidf_(da[j]); }
                const f32x4 kd = k * (1.f + (av - 1.f) * k_a);
                kdsum += kd;
                st4bf(recb + 256 + d * 256 + c4, kk * av);
                st4bf(recb + 768 + d * 256 + c4, kd);
                *(f32x4*)(recf + d * 256 + c4) = dec;
            }
            f32x4 gv = {0.f, 0.f, 0.f, 0.f};
#pragma unroll 4
            for (int ii = 0; ii < 32; ++ii) gv += tsc[32 + ii] * *(const LAS f32x4*)(G2s + ii * 256 + c4);
            st4bf(GB + (size_t)row * 256 + c4, gv);
            const f32x4 bt = r * kdsum * r_k;
            const float bsum = red16((bt[0] + bt[1]) + (bt[2] + bt[3]));
            if (i16 == 0) BS[(size_t)row * 4 + (lane >> 4)] = bsum;
        }
        if (lane < 16) { const int dir = lane >> 3, gate = (lane >> 2) & 1, hd = lane & 3; const float x = bf2f((bf16_t)cur.mg);
            const float bias = gate ? F.in[26][(l * 2 + dir) * 4 + hd] : F.in[25][(l * 2 + dir) * 4 + hd];
            GA[(size_t)row * 16 + lane] = gate ? log_sigmoid_(x + bias) : (x + bias); }
        cur = nxt;
    }
#undef PREP_LOAD
#undef UP4
}
__device__ __forceinline__ int scan_row(int b, int dir, int i) {
    if (i < TCTX) return MLAT + b * TCTX + (dir ? (TCTX - 1 - i) : i);
    const int p = i - TCTX; return b * TLAT + (dir ? (TLAT - 1 - p) : p);
}
__device__ __forceinline__ void rwkv_scan(const Ctx& F, int blk) {
    const int chain = blk >> 2, quarter = blk & 3, b = chain >> 3, head = (chain >> 1) & 3, dir = chain & 1;
    const bool scanner = F.wave < 4;
    const int rowv = (quarter * 4 + (F.wave & 3)) * 4 + (F.lane >> 4), s = F.lane & 15;
    LAS float* buf = (LAS float*)F.lds;
    const bf16_t* P = WSP(bf16_t, WS_P); const unsigned char* RW = WSP(unsigned char, WS_RW); float* YR = WSP(float, WS_YR) + (size_t)dir * MALL * 256;
    const int st = F.tid >> 4, sub = F.tid & 15;
    constexpr int NSTEP = TCTX + TLAT, NCH = NSTEP / 32;
    u32x2 g_kk, g_al, g_kd, g_r, g_v; f32x4 g_w;
#define RW_LOAD(c) do { const int row_ = scan_row(b, dir, (c) * 32 + st); const bf16_t* rb_ = (const bf16_t*)(RW + (size_t)row_ * RWREC) + head * 64 + sub * 4; \
        g_kk = *(const u32x2*)rb_; g_al = *(const u32x2*)(rb_ + 256 + dir * 256); g_kd = *(const u32x2*)(rb_ + 768 + dir * 256); \
        g_w = *(const f32x4*)((const float*)(RW + (size_t)row_ * RWREC + 2560) + dir * 256 + head * 64 + sub * 4); \
        const bf16_t* pp_ = P + (size_t)row_ * DINP + head * 64 + sub * 4; g_r = *(const u32x2*)(pp_ + C_RR); g_v = *(const u32x2*)(pp_ + C_RV); } while (0)
#define RW_STORE(par) do { LAS float* d_ = buf + ((par) * 32 + st) * 384 + sub * 4; \
        *(LAS f32x4*)(d_) = (f32x4){lo2f(g_kk.x), hi2f(g_kk.x), lo2f(g_kk.y), hi2f(g_kk.y)}; *(LAS f32x4*)(d_ + 64) = (f32x4){lo2f(g_al.x), hi2f(g_al.x), lo2f(g_al.y), hi2f(g_al.y)}; \
        *(LAS f32x4*)(d_ + 128) = (f32x4){lo2f(g_kd.x), hi2f(g_kd.x), lo2f(g_kd.y), hi2f(g_kd.y)}; *(LAS f32x4*)(d_ + 192) = g_w; \
        *(LAS f32x4*)(d_ + 256) = (f32x4){lo2f(g_r.x), hi2f(g_r.x), lo2f(g_r.y), hi2f(g_r.y)}; *(LAS f32x4*)(d_ + 320) = (f32x4){lo2f(g_v.x), hi2f(g_v.x), lo2f(g_v.y), hi2f(g_v.y)}; } while (0)
    f32x4 S = {0.f, 0.f, 0.f, 0.f};
    RW_LOAD(0); RW_STORE(0); __syncthreads();
    for (int c = 0; c < NCH; ++c) {
        const int par = c & 1;
        if (c + 1 < NCH) RW_LOAD(c + 1);
        if (scanner) {
        float ykeep = 0.f;
        f32x4 Lkk[3], Lal[3], Lkd[3], Lw[3], Lr[3]; float Lv[3];
#define SC_LD(set, i_) do { const LAS float* d_ = buf + (par * 32 + (i_)) * 384; Lkk[set] = *(const LAS f32x4*)(d_ + s * 4); Lal[set] = *(const LAS f32x4*)(d_ + 64 + s * 4); \
            Lkd[set] = *(const LAS f32x4*)(d_ + 128 + s * 4); Lw[set] = *(const LAS f32x4*)(d_ + 192 + s * 4); Lr[set] = *(const LAS f32x4*)(d_ + 256 + s * 4); Lv[set] = d_[320 + rowv]; } while (0)
        SC_LD(0, 0); SC_LD(1, 1);
#pragma unroll
        for (int i = 0; i < 32; ++i) {
            if (i + 2 < 32) SC_LD((i + 2) % 3, i + 2);
            const f32x4 kk = Lkk[i % 3], al = Lal[i % 3], kd = Lkd[i % 3], w = Lw[i % 3], r = Lr[i % 3]; const float vr = Lv[i % 3];
            const float sa = red16((S[0] * kk[0] + S[1] * kk[1]) + (S[2] * kk[2] + S[3] * kk[3]));
            S = S * w + (vr * kd - sa * al);
            const float y = red16((S[0] * r[0] + S[1] * r[1]) + (S[2] * r[2] + S[3] * r[3]));
            ykeep = (s == (i & 15)) ? y : ykeep;
            if ((i & 15) == 15) {
                const int stp = c * 32 + (i - 15) + s; const int pc = dir ? (TCTX - 1 - stp) : stp, pl = dir ? (TLAT - 1 - (stp - TCTX)) : (stp - TCTX);
                const int row = stp < TCTX ? (MLAT + b * TCTX + pc) : (b * TLAT + pl);
                YR[(size_t)row * 256 + head * 64 + rowv] = ykeep; }
        }
#undef SC_LD
        }
        if (c + 1 < NCH) RW_STORE(par ^ 1);
        __syncthreads();
    }
#undef RW_LOAD
#undef RW_STORE
}

typedef union { u32x4 u; bf16x8 b; } frag_u;
#define SWZ72(r_, c_) ((r_) * 72 + (((((c_) >> 3) ^ (((r_) >> 3) & 7))) << 3) + ((c_) & 7))
__device__ __forceinline__ void attn_unit(const Ctx& F, int l, int unit) {
    LAS bf16_t* Kl = (LAS bf16_t*)F.lds; LAS bf16_t* Vt = Kl + 64 * 72;
    const bf16_t* P = WSP(bf16_t, WS_P); const bf16_t* QA = WSP(bf16_t, WS_QA); const bf16_t* KA = WSP(bf16_t, WS_KA); bf16_t* YC = WSP(bf16_t, WS_YCAT);
    const bool isc = unit >= 256; int b, kvh, n;
    if (!isc) { b = unit >> 7; kvh = (unit >> 6) & 1; n = unit & 63; } else { const int u = unit - 256; b = u >> 2; kvh = (u >> 1) & 1; n = u & 1; }
    const int g = F.wave >> 2, ps = F.wave & 3, head = kvh * 2 + g, i = F.lane & 15, gq = F.lane >> 4;
    const int qpos0 = n * 128 + ps * 32, qrow0 = (isc ? MLAT + b * TCTX : b * TLAT) + qpos0;
    bf16x8 Qf[2][2];
#pragma unroll
    for (int qb = 0; qb < 2; ++qb)
#pragma unroll
        for (int ks = 0; ks < 2; ++ks) Qf[qb][ks] = *(const bf16x8*)(QA + (size_t)(qrow0 + qb * 16 + i) * 256 + head * 64 + ks * 32 + gq * 8);
    const float sinkl = F.in[23][l * 4 + head] * 1.4426950408889634f;
    float mrun[2] = {sinkl, sinkl}, lsum[2]; lsum[0] = lsum[1] = (gq == 0) ? 1.f : 0.f;
    f32x4 ao[4][2];
#pragma unroll
    for (int db = 0; db < 4; ++db) { ao[db][0] = (f32x4){0.f, 0.f, 0.f, 0.f}; ao[db][1] = (f32x4){0.f, 0.f, 0.f, 0.f}; }
    const int ntl = isc ? 4 : 10;
    const int skey = F.tid >> 3, sch = F.tid & 7;
#define ATT_KROW(tt_) ((!isc && (tt_) < 6) ? ((2 * (n - 1) + (tt_) < 0 || 2 * (n - 1) + (tt_) >= 128) ? -1 : b * TLAT + (2 * (n - 1) + (tt_)) * 64) : MLAT + b * TCTX + (isc ? (tt_) : (tt_) - 6) * 64)
#define ATT_LOAD(tt_) do { const int kr_ = ATT_KROW(tt_); if (kr_ >= 0) { pk_kv = *(const u32x4*)(KA + (size_t)(kr_ + skey) * 128 + kvh * 64 + sch * 8); pk_vv = *(const u32x4*)(P + (size_t)(kr_ + skey) * DINP + C_AV + kvh * 64 + sch * 8); } } while (0)
    u32x4 pk_kv = {0u, 0u, 0u, 0u}, pk_vv = {0u, 0u, 0u, 0u};
    int tt0 = 0; while (tt0 < ntl && ATT_KROW(tt0) < 0) ++tt0;
    ATT_LOAD(tt0);
    for (int tt = tt0; tt < ntl; ++tt) {
        const int krow0 = ATT_KROW(tt); if (krow0 < 0) continue;
        const bool band = !isc && tt < 6; const int kpos0 = band ? (2 * (n - 1) + tt) * 64 : 0;
        LDS_BARRIER();
        { const u32x4 kv = pk_kv, vv = pk_vv;
          *(LAS u32x4*)(Kl + skey * 72 + sch * 8) = kv;
          const unsigned ww[4] = {vv.x, vv.y, vv.z, vv.w};
#pragma unroll
          for (int j = 0; j < 4; ++j) { Vt[SWZ72(sch * 8 + 2 * j, skey)] = (bf16_t)(ww[j] & 0xffffu); Vt[SWZ72(sch * 8 + 2 * j + 1, skey)] = (bf16_t)(ww[j] >> 16); } }
        { int tn = tt + 1; while (tn < ntl && ATT_KROW(tn) < 0) ++tn; if (tn < ntl) ATT_LOAD(tn); }
        LDS_BARRIER();
        f32x4 sc[4][2];
#pragma unroll
        for (int kb = 0; kb < 4; ++kb) {
            sc[kb][0] = (f32x4){0.f, 0.f, 0.f, 0.f}; sc[kb][1] = (f32x4){0.f, 0.f, 0.f, 0.f};
#pragma unroll
            for (int ks = 0; ks < 2; ++ks) { const bf16x8 kf = *(const LAS bf16x8*)(Kl + (kb * 16 + i) * 72 + ks * 32 + gq * 8);
                sc[kb][0] = __builtin_amdgcn_mfma_f32_16x16x32_bf16(kf, Qf[0][ks], sc[kb][0], 0, 0, 0);
                sc[kb][1] = __builtin_amdgcn_mfma_f32_16x16x32_bf16(kf, Qf[1][ks], sc[kb][1], 0, 0, 0); }
        }
#pragma unroll
        for (int qb = 0; qb < 2; ++qb) {
            const int qp = qpos0 + qb * 16 + i;
            float mx = -1e30f;
#pragma unroll
            for (int kb = 0; kb < 4; ++kb)
#pragma unroll
                for (int r = 0; r < 4; ++r) { if (band) { const int dd = (kpos0 + kb * 16 + 4 * gq + r) - qp; if (dd > 128 || dd < -128) sc[kb][qb][r] = -1e30f; } mx = fmaxf(mx, sc[kb][qb][r]); }
            mx = fmaxf(mx, __shfl_xor(mx, 16)); mx = fmaxf(mx, __shfl_xor(mx, 32));
            const float mnew = fmaxf(mrun[qb], mx), alpha = exp2f(mrun[qb] - mnew); mrun[qb] = mnew;
            float ps_ = 0.f;
#pragma unroll
            for (int kb = 0; kb < 4; ++kb)
#pragma unroll
                for (int r = 0; r < 4; ++r) { const float p = exp2f(sc[kb][qb][r] - mnew); sc[kb][qb][r] = p; ps_ += p; }
            lsum[qb] = lsum[qb] * alpha + ps_;
#pragma unroll
            for (int db = 0; db < 4; ++db) ao[db][qb] *= alpha;
        }
#pragma unroll
        for (int ks2 = 0; ks2 < 2; ++ks2) {
            frag_u pf[2];
#pragma unroll
            for (int qb = 0; qb < 2; ++qb) { pf[qb].u.x = pg8::cvt_pk_bf16(sc[2 * ks2][qb][0], sc[2 * ks2][qb][1]); pf[qb].u.y = pg8::cvt_pk_bf16(sc[2 * ks2][qb][2], sc[2 * ks2][qb][3]);
                pf[qb].u.z = pg8::cvt_pk_bf16(sc[2 * ks2 + 1][qb][0], sc[2 * ks2 + 1][qb][1]); pf[qb].u.w = pg8::cvt_pk_bf16(sc[2 * ks2 + 1][qb][2], sc[2 * ks2 + 1][qb][3]); }
#pragma unroll
            for (int db = 0; db < 4; ++db) { frag_u vf; const int vr_ = db * 16 + i, vc_ = (2 * ks2) * 16 + 4 * gq;
                const u32x2 v0 = *(const LAS u32x2*)(Vt + SWZ72(vr_, vc_)), v1 = *(const LAS u32x2*)(Vt + SWZ72(vr_, vc_ + 16)); vf.u = (u32x4){v0.x, v0.y, v1.x, v1.y};
                ao[db][0] = __builtin_amdgcn_mfma_f32_16x16x32_bf16(vf.b, pf[0].b, ao[db][0], 0, 0, 0);
                ao[db][1] = __builtin_amdgcn_mfma_f32_16x16x32_bf16(vf.b, pf[1].b, ao[db][1], 0, 0, 0); }
        }
    }
#undef ATT_KROW
#undef ATT_LOAD
    const float* og = F.in[24] + l * 256 + head * 64;
#pragma unroll
    for (int qb = 0; qb < 2; ++qb) {
        float lt = lsum[qb]; lt += __shfl_xor(lt, 16); lt += __shfl_xor(lt, 32);
        const float il = 1.f / lt; float ss = 0.f;
#pragma unroll
        for (int db = 0; db < 4; ++db) { ao[db][qb] *= il; ss += (ao[db][qb][0] * ao[db][qb][0] + ao[db][qb][1] * ao[db][qb][1]) + (ao[db][qb][2] * ao[db][qb][2] + ao[db][qb][3] * ao[db][qb][3]); }
        ss += __shfl_xor(ss, 16); ss += __shfl_xor(ss, 32);
        const float rs = rsqrtf(ss * (1.f / 64.f) + EPSN);
        bf16_t* yo = YC + (size_t)(qrow0 + qb * 16 + i) * DM + 512 + head * 64;
#pragma unroll
        for (int db = 0; db < 4; ++db) { const f32x4 gg = *(const f32x4*)(og + db * 16 + 4 * gq); st4bf(yo + db * 16 + 4 * gq, ao[db][qb] * rs * gg * ZF(8)); }
    }
    __syncthreads();
}

__device__ __forceinline__ int ml_row(int b, int dir, int j, int tp) {
    if (j < 2) { const int p = j * 128 + tp; return MLAT + b * TCTX + (dir ? (TCTX - 1 - p) : p); }
    const int p = (j - 2) * 128 + tp; return b * TLAT + (dir ? (TLAT - 1 - p) : p);
}
__device__ __forceinline__ void scan128_add(float& x0, float& x1, int lane) {
    x1 += x0; float t = x1;
#pragma unroll
    for (int o = 1; o < 64; o <<= 1) { const float u = __shfl_up(t, o); if (lane >= o) t += u; }
    const float ex = t - x1; x0 += ex; x1 = t;
}
__device__ __forceinline__ void scan128_max(float& x0, float& x1, int lane) {
    x1 = fmaxf(x1, x0); float t = x1;
#pragma unroll
    for (int o = 1; o < 64; o <<= 1) { const float u = __shfl_up(t, o); if (lane >= o) t = fmaxf(t, u); }
    const float pv = __shfl_up(t, 1); if (lane > 0) x0 = fmaxf(x0, pv); x1 = t;
}
#define SWZ136(r_, c_) ((r_) * 136 + (((((c_) >> 3) ^ (((r_) >> 3) & 7))) << 3) + ((c_) & 7))
__device__ __forceinline__ void ml_stage_T(const Ctx& F, const bf16_t* P, int b, int dir, int j, int col0, LAS bf16_t* dst, const LAS float* sw, float cscale) {
#pragma unroll
    for (int it = 0; it < 2; ++it) { const int id = F.tid + it * NTHR, tp = id >> 3, ch = id & 7;
        const u32x4 v = *(const u32x4*)(P + (size_t)ml_row(b, dir, j, tp) * DINP + col0 + ch * 8); const float s = (sw ? sw[tp] : 1.f) * cscale;
        const unsigned ww[4] = {v.x, v.y, v.z, v.w};
#pragma unroll
        for (int q = 0; q < 4; ++q) { dst[SWZ136(ch * 8 + 2 * q, tp)] = (bf16_t)f2bf(lo2f(ww[q]) * s); dst[SWZ136(ch * 8 + 2 * q + 1, tp)] = (bf16_t)f2bf(hi2f(ww[q]) * s); } }
}
__device__ __forceinline__ void ml_stage_R(const Ctx& F, const bf16_t* P, int b, int dir, int j, int col0, LAS bf16_t* dst, float cscale) {
#pragma unroll
    for (int it = 0; it < 2; ++it) { const int id = F.tid + it * NTHR, tp = id >> 3, ch = id & 7;
        u32x4 v = *(const u32x4*)(P + (size_t)ml_row(b, dir, j, tp) * DINP + col0 + ch * 8);
        if (cscale != 1.f) { v.x = pk2(lo2f(v.x) * cscale, hi2f(v.x) * cscale); v.y = pk2(lo2f(v.y) * cscale, hi2f(v.y) * cscale); v.z = pk2(lo2f(v.z) * cscale, hi2f(v.z) * cscale); v.w = pk2(lo2f(v.w) * cscale, hi2f(v.w) * cscale); }
        *(LAS u32x4*)(dst + tp * 72 + ch * 8) = v; }
}
__device__ __forceinline__ void mlstm_local(const Ctx& F, int task) {
    const int chain = task / NCHK, j = task % NCHK, b = chain >> 3, head = (chain >> 1) & 3, dir = chain & 1;
    const bf16_t* P = WSP(bf16_t, WS_P); const float* GA = WSP(float, WS_GA);
    LAS bf16_t* Vt = (LAS bf16_t*)F.lds; LAS bf16_t* Kt = Vt + 64 * 136; LAS float* wS = (LAS float*)(Kt + 64 * 136); LAS float* sc2 = wS + 128;
    __syncthreads();
    if (F.wave == 0) {
        const int r0 = ml_row(b, dir, j, 2 * F.lane), r1 = ml_row(b, dir, j, 2 * F.lane + 1);
        const float li0 = GA[(size_t)r0 * 16 + dir * 8 + head], li1 = GA[(size_t)r1 * 16 + dir * 8 + head];
        float b0 = GA[(size_t)r0 * 16 + dir * 8 + 4 + head], b1 = GA[(size_t)r1 * 16 + dir * 8 + 4 + head];
        scan128_add(b0, b1, F.lane);
        const float bend = __shfl(b1, 63);
        const float d0 = bend - b0 + li0, d1 = bend - b1 + li1;
        float mx = fmaxf(d0, d1);
#pragma unroll
        for (int o = 1; o < 64; o <<= 1) mx = fmaxf(mx, __shfl_xor(mx, o));
        wS[2 * F.lane] = __expf(d0 - mx); wS[2 * F.lane + 1] = __expf(d1 - mx);
        if (F.lane == 0) { sc2[0] = mx; sc2[1] = bend; }
    }
    __syncthreads();
    ml_stage_T(F, P, b, dir, j, C_MV + head * 64, Vt, wS, 1.f);
    ml_stage_T(F, P, b, dir, j, C_MK + head * 64, Kt, nullptr, 0.125f);
    __syncthreads();
    float* LC = WSP(float, WS_LC) + (size_t)task * CST;
    { const int vb = F.wave >> 1, i = F.lane & 15, gq = F.lane >> 4;
#pragma unroll
      for (int kk2 = 0; kk2 < 2; ++kk2) { const int kb = 2 * (F.wave & 1) + kk2; f32x4 acc = {0.f, 0.f, 0.f, 0.f};
#pragma unroll
          for (int ks = 0; ks < 4; ++ks) { const bf16x8 a = *(const LAS bf16x8*)(Vt + SWZ136(vb * 16 + i, ks * 32 + gq * 8)), bb = *(const LAS bf16x8*)(Kt + SWZ136(kb * 16 + i, ks * 32 + gq * 8));
              acc = __builtin_amdgcn_mfma_f32_16x16x32_bf16(a, bb, acc, 0, 0, 0); }
#pragma unroll
          for (int r = 0; r < 4; ++r) LC[(vb * 16 + 4 * gq + r) * 64 + kb * 16 + i] = acc[r]; } }
    if (F.tid < 64) { float a = 0.f;
#pragma unroll 8
        for (int s = 0; s < 128; ++s) a += wS[s] * bf2f(Kt[SWZ136(F.tid, s)]);
        LC[4096 + F.tid] = a; }
    if (F.tid == 0) { float* LB = WSP(float, WS_LB); LB[task * 2] = sc2[0]; LB[task * 2 + 1] = sc2[1]; }
}
__device__ __forceinline__ void mlstm_chain(const Ctx& F, int blk0) {
    const int gt = (F.vcu - blk0) * NTHR + F.tid; if (gt < 0 || gt >= 16 * CST) return;
    const int chain = gt / CST, e = gt % CST;
    const float* LC = WSP(float, WS_LC) + (size_t)chain * NCHK * CST + e; float* ST = WSP(float, WS_ST) + (size_t)chain * NCHK * CST + e;
    const float* LB = WSP(float, WS_LB) + chain * NCHK * 2; float* SM = WSP(float, WS_LB) + 4096 + chain * NCHK;
    float m = 0.f, x = 0.f;
#pragma unroll 1
    for (int g = 0; g < 3; ++g) {
        float d[22], Lv[22], Bv[22];
#pragma unroll
        for (int q = 0; q < 22; ++q) { const int j = g * 22 + q; d[q] = LC[(size_t)j * CST]; Lv[q] = LB[2 * j]; Bv[q] = LB[2 * j + 1]; }
#pragma unroll
        for (int q = 0; q < 22; ++q) { const int j = g * 22 + q;
            ST[(size_t)j * CST] = x; if (e == 0) SM[j] = m;
            const float mn = fmaxf(Bv[q] + m, Lv[q]);
            x = __expf(Bv[q] + m - mn) * x + __expf(Lv[q] - mn) * d[q]; m = mn; }
    }
}
__device__ __forceinline__ void mlstm_out(const Ctx& F, int l, int unit) {
    const bool isc = unit >= 512; int b, chunk, head;
    if (!isc) { b = unit >> 8; chunk = (unit >> 2) & 63; head = unit & 3; } else { const int u = unit - 512; b = u >> 3; chunk = (u >> 2) & 1; head = u & 3; }
    const bf16_t* P = WSP(bf16_t, WS_P); const float* GA = WSP(float, WS_GA); bf16_t* YC = WSP(bf16_t, WS_YCAT);
    LAS bf16_t* Ql = (LAS bf16_t*)F.lds; LAS bf16_t* Kl = Ql + 128 * 72; LAS bf16_t* Vt = Kl + 128 * 72; LAS bf16_t* Cb = Vt + 64 * 136;
    LAS float* nS = (LAS float*)(Cb + 64 * 72); LAS float* aS = nS + 64; LAS float* bS = aS + 128; LAS float* MS = bS + 128; LAS float* Hs = MS + 128;
    const int i = F.lane & 15, gq = F.lane >> 4, w = F.wave;
    for (int dir = 0; dir < 2; ++dir) {
        const int j = isc ? (dir ? 1 - chunk : chunk) : 2 + (dir ? 63 - chunk : chunk);
        const int chain = (b * 4 + head) * 2 + dir;
        const float* ST = WSP(float, WS_ST) + ((size_t)chain * NCHK + j) * CST; const float mprev = WSP(float, WS_LB)[4096 + chain * NCHK + j];
        __syncthreads();
        if (w == 0) {
            const int r0 = ml_row(b, dir, j, 2 * F.lane), r1 = ml_row(b, dir, j, 2 * F.lane + 1);
            const float li0 = GA[(size_t)r0 * 16 + dir * 8 + head], li1 = GA[(size_t)r1 * 16 + dir * 8 + head];
            float b0 = GA[(size_t)r0 * 16 + dir * 8 + 4 + head], b1 = GA[(size_t)r1 * 16 + dir * 8 + 4 + head];
            scan128_add(b0, b1, F.lane);
            const float a0 = li0 - b0, a1 = li1 - b1; float A0 = a0, A1 = a1;
            scan128_max(A0, A1, F.lane);
            aS[2 * F.lane] = a0; aS[2 * F.lane + 1] = a1; bS[2 * F.lane] = b0; bS[2 * F.lane + 1] = b1;
            MS[2 * F.lane] = fmaxf(A0, mprev); MS[2 * F.lane + 1] = fmaxf(A1, mprev);
        }
        ml_stage_R(F, P, b, dir, j, C_MQ + head * 64, Ql, 1.f);
        ml_stage_R(F, P, b, dir, j, C_MK + head * 64, Kl, 0.125f);
        ml_stage_T(F, P, b, dir, j, C_MV + head * 64, Vt, nullptr, 1.f);
        { const f32x4 c0 = *(const f32x4*)(ST + F.tid * 8), c1 = *(const f32x4*)(ST + F.tid * 8 + 4); const int v = F.tid >> 3, k0 = (F.tid & 7) * 8;
          u32x4 o; o.x = pk2(c0[0], c0[1]); o.y = pk2(c0[2], c0[3]); o.z = pk2(c1[0], c1[1]); o.w = pk2(c1[2], c1[3]); *(LAS u32x4*)(Cb + v * 72 + k0) = o;
          if (F.tid < 64) nS[F.tid] = ST[4096 + F.tid]; }
        __syncthreads();
        const int t = 16 * w + i; const float Mt = MS[t], bt = bS[t];
        bf16x8 Qf[2];
#pragma unroll
        for (int ks = 0; ks < 2; ++ks) Qf[ks] = *(const LAS bf16x8*)(Ql + t * 72 + ks * 32 + gq * 8);
        f32x4 sc[8];
#pragma unroll
        for (int sb = 0; sb < 8; ++sb) { sc[sb] = (f32x4){0.f, 0.f, 0.f, 0.f};
            if (sb <= w) {
#pragma unroll
                for (int ks = 0; ks < 2; ++ks) { const bf16x8 kf = *(const LAS bf16x8*)(Kl + (sb * 16 + i) * 72 + ks * 32 + gq * 8); sc[sb] = __builtin_amdgcn_mfma_f32_16x16x32_bf16(kf, Qf[ks], sc[sb], 0, 0, 0); }
#pragma unroll
                for (int r = 0; r < 4; ++r) { const int s = sb * 16 + 4 * gq + r; sc[sb][r] = (s <= t) ? sc[sb][r] * __expf(aS[s] - Mt) : 0.f; }
            } }
        float den = 0.f;
#pragma unroll
        for (int sb = 0; sb < 8; ++sb) den += (sc[sb][0] + sc[sb][1]) + (sc[sb][2] + sc[sb][3]);
        den += __shfl_xor(den, 16); den += __shfl_xor(den, 32);
        f32x4 nm[4], it_[4];
#pragma unroll
        for (int vb = 0; vb < 4; ++vb) { nm[vb] = (f32x4){0.f, 0.f, 0.f, 0.f}; it_[vb] = (f32x4){0.f, 0.f, 0.f, 0.f}; }
#pragma unroll
        for (int ks2 = 0; ks2 < 4; ++ks2) if (2 * ks2 <= w) {
            frag_u pf; pf.u.x = pg8::cvt_pk_bf16(sc[2 * ks2][0], sc[2 * ks2][1]); pf.u.y = pg8::cvt_pk_bf16(sc[2 * ks2][2], sc[2 * ks2][3]);
            pf.u.z = pg8::cvt_pk_bf16(sc[2 * ks2 + 1][0], sc[2 * ks2 + 1][1]); pf.u.w = pg8::cvt_pk_bf16(sc[2 * ks2 + 1][2], sc[2 * ks2 + 1][3]);
#pragma unroll
            for (int vb = 0; vb < 4; ++vb) { frag_u vf; const int vr_ = vb * 16 + i, vc_ = (2 * ks2) * 16 + 4 * gq;
                const u32x2 v0 = *(const LAS u32x2*)(Vt + SWZ136(vr_, vc_)), v1 = *(const LAS u32x2*)(Vt + SWZ136(vr_, vc_ + 16)); vf.u = (u32x4){v0.x, v0.y, v1.x, v1.y};
                nm[vb] = __builtin_amdgcn_mfma_f32_16x16x32_bf16(vf.b, pf.b, nm[vb], 0, 0, 0); }
        }
#pragma unroll
        for (int vb = 0; vb < 4; ++vb)
#pragma unroll
            for (int ks = 0; ks < 2; ++ks) { const bf16x8 cf = *(const LAS bf16x8*)(Cb + (vb * 16 + i) * 72 + ks * 32 + gq * 8); it_[vb] = __builtin_amdgcn_mfma_f32_16x16x32_bf16(cf, Qf[ks], it_[vb], 0, 0, 0); }
        float nq = 0.f;
#pragma unroll
        for (int c = 0; c < 2; ++c) { const u32x4 qv = *(const LAS u32x4*)(Ql + t * 72 + gq * 16 + c * 8); const unsigned ww[4] = {qv.x, qv.y, qv.z, qv.w};
#pragma unroll
            for (int q = 0; q < 4; ++q) nq += nS[gq * 16 + c * 8 + 2 * q] * lo2f(ww[q]) + nS[gq * 16 + c * 8 + 2 * q + 1] * hi2f(ww[q]); }
        nq += __shfl_xor(nq, 16); nq += __shfl_xor(nq, 32);
        const float wint = __expf(mprev - Mt); den += wint * nq;
        const float dn = 1.f / fmaxf(fabsf(den), __expf(-(bt + Mt)));
        const int torig = dir ? 127 - t : t;
#pragma unroll
        for (int vb = 0; vb < 4; ++vb)
#pragma unroll
            for (int r = 0; r < 4; ++r) { const float hv = (nm[vb][r] + wint * it_[vb][r]) * dn; LAS float* hp = Hs + torig * 65 + vb * 16 + 4 * gq + r; if (dir == 0) *hp = hv; else *hp += hv; }
    }
    __syncthreads();
    {
        const int t = F.tid >> 2, vq = F.tid & 3; const int row = (isc ? MLAT + b * TCTX : b * TLAT) + chunk * 128 + t;
        float hv[16], ss = 0.f;
#pragma unroll
        for (int q = 0; q < 16; ++q) { hv[q] = Hs[t * 65 + vq * 16 + q]; ss += hv[q] * hv[q]; }
        ss += __shfl_xor(ss, 1); ss += __shfl_xor(ss, 2);
        const float rs = rsqrtf(ss * (1.f / 64.f) + EPSN);
        const float* og = F.in[27] + l * 256 + head * 64 + vq * 16; const bf16_t* op = P + (size_t)row * DINP + C_MO + head * 64 + vq * 16;
        const u32x4 o0 = *(const u32x4*)op, o1 = *(const u32x4*)(op + 8); const unsigned ow[8] = {o0.x, o0.y, o0.z, o0.w, o1.x, o1.y, o1.z, o1.w};
        unsigned res[8];
#pragma unroll
        for (int q = 0; q < 8; ++q) { const float y0 = sigmoidf_(lo2f(ow[q])) * hv[2 * q] * rs * og[2 * q], y1 = sigmoidf_(hi2f(ow[q])) * hv[2 * q + 1] * rs * og[2 * q + 1]; res[q] = pk2(y0 * ZF(16), y1 * ZF(16)); }
        bf16_t* yo = YC + (size_t)row * DM + 768 + head * 64 + vq * 16;
        *(u32x4*)yo = (u32x4){res[0], res[1], res[2], res[3]}; *(u32x4*)(yo + 8) = (u32x4){res[4], res[5], res[6], res[7]};
    }
    __syncthreads();
}
__device__ __forceinline__ void rwkv_finish(const Ctx& F, int l, int nrows) {
    const bf16_t* P = WSP(bf16_t, WS_P); const float* YR = WSP(float, WS_YR); const bf16_t* GB = WSP(bf16_t, WS_GB); const float* BS = WSP(float, WS_BS); bf16_t* YC = WSP(bf16_t, WS_YCAT);
    const int c4 = F.lane * 4; const f32x4 lg = *(const f32x4*)(F.in[20] + l * 256 + c4);
    const int gw = F.vcu * NWAVES + F.wave, NGW = F.G * NWAVES;
    for (int row = gw; row < nrows; row += NGW) {
        const f32x4 y = *(const f32x4*)(YR + (size_t)row * 256 + c4) + *(const f32x4*)(YR + (size_t)(MALL + row) * 256 + c4);
        const float ss = red16((y[0] * y[0] + y[1] * y[1]) + (y[2] * y[2] + y[3] * y[3]));
        const float rs = rsqrtf(ss * (1.f / 64.f) + EPSN);
        const f32x4 v = ld4bf(P + (size_t)row * DINP + C_RV + c4), g = ld4bf(GB + (size_t)row * 256 + c4);
        const float bn = BS[(size_t)row * 4 + (F.lane >> 4)];
        st4bf(YC + (size_t)row * DM + 256 + c4, (y * rs * lg * ZF(32) + bn * v * ZF(64)) * g * ZF(4));
    }
}
constexpr int RCH = 132;
constexpr int MP = 72, SLOT = 64 * MP;
constexpr size_t WS_RG = 454 * MiB, RG_TASK = 3 * 8192, WS_SST = WS_RW;
constexpr size_t WS_END2 = 504 * MiB;
static_assert(WS_RG + (size_t)16 * RCH * RG_TASK <= WS_END2 && (size_t)16 * RCH * 8192 <= (size_t)MALL * RWREC, "rwkv chunk ws map");

__device__ __forceinline__ void mm64(const LAS bf16_t* A, const LAS bf16_t* Bt, int w, int lane, f32x4 (&acc)[2]) {
    const int i = lane & 15, gq = lane >> 4, mb = w >> 1, nb0 = 2 * (w & 1);
    acc[0] = (f32x4){0.f, 0.f, 0.f, 0.f}; acc[1] = (f32x4){0.f, 0.f, 0.f, 0.f};
#pragma unroll
    for (int ks = 0; ks < 2; ++ks) { const bf16x8 a = *(const LAS bf16x8*)(A + (mb * 16 + i) * MP + ks * 32 + gq * 8);
#pragma unroll
        for (int q = 0; q < 2; ++q) { const bf16x8 b = *(const LAS bf16x8*)(Bt + ((nb0 + q) * 16 + i) * MP + ks * 32 + gq * 8); acc[q] = __builtin_amdgcn_mfma_f32_16x16x32_bf16(a, b, acc[q], 0, 0, 0); } }
}
template <bool SA, bool SB>
__device__ __forceinline__ void mm64x(const LAS bf16_t* A, const LAS bf16_t* Bt, int w, int lane, f32x4 (&acc)[2]) {
    const int i = lane & 15, gq = lane >> 4, mb = w >> 1, nb0 = 2 * (w & 1);
    acc[0] = (f32x4){0.f, 0.f, 0.f, 0.f}; acc[1] = (f32x4){0.f, 0.f, 0.f, 0.f};
#pragma unroll
    for (int ks = 0; ks < 2; ++ks) { const int ra = mb * 16 + i; const int ba = SA ? ((ks * 4 + gq) ^ ((ra >> 3) & 7)) : (ks * 4 + gq);
        const bf16x8 a = *(const LAS bf16x8*)(A + ra * MP + ba * 8);
#pragma unroll
        for (int q = 0; q < 2; ++q) { const int rb = (nb0 + q) * 16 + i; const int bb = SB ? ((ks * 4 + gq) ^ ((rb >> 3) & 7)) : (ks * 4 + gq);
            const bf16x8 b = *(const LAS bf16x8*)(Bt + rb * MP + bb * 8); acc[q] = __builtin_amdgcn_mfma_f32_16x16x32_bf16(a, b, acc[q], 0, 0, 0); } }
}
__device__ __forceinline__ u32x2 pk4(f32x4 v) { u32x2 o; o.x = pk2(v[0], v[1]); o.y = pk2(v[2], v[3]); return o; }
__device__ __forceinline__ f32x4 up4(u32x2 w) { return (f32x4){lo2f(w.x), hi2f(w.x), lo2f(w.y), hi2f(w.y)}; }

struct RaRaw { u32x4 kk, al, kd, r, v; f32x4 ld0, ld1; };
__device__ __forceinline__ void ra_load_ld(const Ctx& F, int task, RaRaw& g) {
    const int chain = task / RCH, c = task % RCH, b = chain >> 3, head = (chain >> 1) & 3, dir = chain & 1;
    const unsigned char* RW = WSP(unsigned char, WS_RW);
    const int t = F.tid >> 3, ch0 = (F.tid & 7) * 8; const int row = scan_row(b, dir, c * 64 + t);
    const float* ldp = (const float*)(RW + (size_t)row * RWREC + 2560) + dir * 256 + head * 64 + ch0;
    g.ld0 = *(const f32x4*)ldp; g.ld1 = *(const f32x4*)(ldp + 4);
}
__device__ __forceinline__ void ra_load_rest(const Ctx& F, int task, RaRaw& g) {
    const int chain = task / RCH, c = task % RCH, b = chain >> 3, head = (chain >> 1) & 3, dir = chain & 1;
    const bf16_t* P = WSP(bf16_t, WS_P); const unsigned char* RW = WSP(unsigned char, WS_RW);
    const int t = F.tid >> 3, ch0 = (F.tid & 7) * 8; const int row = scan_row(b, dir, c * 64 + t);
    const bf16_t* rb = (const bf16_t*)(RW + (size_t)row * RWREC) + head * 64 + ch0;
    g.kk = *(const u32x4*)rb; g.al = *(const u32x4*)(rb + 256 + dir * 256); g.kd = *(const u32x4*)(rb + 768 + dir * 256);
    const bf16_t* pp = P + (size_t)row * DINP + head * 64 + ch0;
    g.r = *(const u32x4*)(pp + C_RR); g.v = *(const u32x4*)(pp + C_RV);
}
__device__ __forceinline__ void ra_load(const Ctx& F, int task, RaRaw& g) { ra_load_ld(F, task, g); ra_load_rest(F, task, g); }
__device__ __forceinline__ void rwkv_chunk_pre(const Ctx& F, int task, const RaRaw& cur) {
    const int chain = task / RCH, c = task % RCH, b = chain >> 3, head = (chain >> 1) & 3, dir = chain & 1;
    LAS bf16_t* L0 = (LAS bf16_t*)F.lds;
#define SL(k) (L0 + (k) * SLOT)
    LAS float* LD = (LAS float*)SL(8);
    LAS float* SEG = (LAS float*)SL(10);
    LAS float* WLs = (LAS float*)SL(14);
    const int w = F.wave, lane = F.lane, i = lane & 15, gq = lane >> 4, mb = w >> 1, nb0 = 2 * (w & 1), m0 = mb * 16 + 4 * gq;
    LDS_BARRIER();
    const int t = F.tid >> 3, ch0 = (F.tid & 7) * 8;
    const u32x4 g_kk = cur.kk, g_al = cur.al, g_kd = cur.kd, g_r = cur.r, g_v = cur.v; const f32x4 ld0 = cur.ld0, ld1 = cur.ld1;
    *(LAS f32x4*)(LD + t * 64 + ch0) = ld0; *(LAS f32x4*)(LD + t * 64 + ch0 + 4) = ld1;
    LDS_BARRIER();
    { const int k = F.tid & 63, seg = F.tid >> 6; float s = 0.f;
#pragma unroll
      for (int j = 0; j < 8; ++j) s += LD[(seg * 8 + j) * 64 + k];
      SEG[seg * 64 + k] = s;
      LDS_BARRIER();
      float off = 0.f;
#pragma unroll
      for (int j = 0; j < 8; ++j) off += (j < seg) ? SEG[j * 64 + k] : 0.f;
#pragma unroll
      for (int j = 0; j < 8; ++j) { off += LD[(seg * 8 + j) * 64 + k]; LD[(seg * 8 + j) * 64 + k] = off; }
    }
    LDS_BARRIER();
    {
        const unsigned kkw[4] = {g_kk.x, g_kk.y, g_kk.z, g_kk.w}, alw[4] = {g_al.x, g_al.y, g_al.z, g_al.w}, kdw[4] = {g_kd.x, g_kd.y, g_kd.z, g_kd.w},
                       rw_[4] = {g_r.x, g_r.y, g_r.z, g_r.w}, vw[4] = {g_v.x, g_v.y, g_v.z, g_v.w};
        float okt[8], oai[8], oki[8], ort[8], oat[8], okb[8];
#pragma unroll
        for (int j = 0; j < 8; ++j) {
            const float cl = LD[t * 64 + ch0 + j], clp = t > 0 ? LD[(t - 1) * 64 + ch0 + j] : 0.f, clL = LD[63 * 64 + ch0 + j];
            const float kkv = (j & 1) ? hi2f(kkw[j >> 1]) : lo2f(kkw[j >> 1]), alv = (j & 1) ? hi2f(alw[j >> 1]) : lo2f(alw[j >> 1]), kdv = (j & 1) ? hi2f(kdw[j >> 1]) : lo2f(kdw[j >> 1]),
                        rv = (j & 1) ? hi2f(rw_[j >> 1]) : lo2f(rw_[j >> 1]);
            const float ec = __expf(cl), en = __builtin_amdgcn_rcpf(ec), eL = __expf(clL) * en;
            okt[j] = kkv * __expf(clp); oai[j] = alv * en; oki[j] = kdv * en; ort[j] = rv * ec; oat[j] = alv * eL; okb[j] = kdv * eL;
        }
        u32x4 o;
        o = (u32x4){pk2(okt[0], okt[1]), pk2(okt[2], okt[3]), pk2(okt[4], okt[5]), pk2(okt[6], okt[7])}; *(LAS u32x4*)(SL(0) + t * MP + ch0) = o;
        o = (u32x4){pk2(oai[0], oai[1]), pk2(oai[2], oai[3]), pk2(oai[4], oai[5]), pk2(oai[6], oai[7])}; *(LAS u32x4*)(SL(2) + t * MP + ch0) = o;
        o = (u32x4){pk2(oki[0], oki[1]), pk2(oki[2], oki[3]), pk2(oki[4], oki[5]), pk2(oki[6], oki[7])}; *(LAS u32x4*)(SL(3) + t * MP + ch0) = o;
        o = (u32x4){pk2(ort[0], ort[1]), pk2(ort[2], ort[3]), pk2(ort[4], ort[5]), pk2(ort[6], ort[7])}; *(LAS u32x4*)(SL(4) + t * MP + ch0) = o;
        const int tsw = (((t >> 3) ^ (ch0 >> 3)) << 3) + (t & 7);
#pragma unroll
        for (int j = 0; j < 8; ++j) { SL(1)[(ch0 + j) * MP + tsw] = (bf16_t)f2bf(okt[j]); SL(5)[(ch0 + j) * MP + tsw] = (bf16_t)f2bf(oat[j]); SL(6)[(ch0 + j) * MP + tsw] = (bf16_t)f2bf(okb[j]);
            SL(7)[(ch0 + j) * MP + tsw] = (bf16_t)(((j & 1) ? (vw[j >> 1] >> 16) : (vw[j >> 1] & 0xffffu))); }
        if (t == 63) {
#pragma unroll
            for (int j = 0; j < 8; ++j) WLs[ch0 + j] = __expf(LD[63 * 64 + ch0 + j]); }
    }
    LDS_BARRIER();
    f32x4 acc[2];
    mm64(SL(0), SL(2), w, lane, acc);
#pragma unroll
    for (int q = 0; q < 2; ++q) { const int n = (nb0 + q) * 16 + i; f32x4 a, ti;
#pragma unroll
        for (int r = 0; r < 4; ++r) { const bool keep = (m0 + r) > n; a[r] = keep ? acc[q][r] : 0.f; ti[r] = ((m0 + r) == n ? 1.f : 0.f) - a[r]; }
#pragma unroll
        for (int r = 0; r < 4; ++r) { SL(8)[(m0 + r) * MP + n] = (bf16_t)f2bf(a[r]); SL(13)[(m0 + r) * MP + n] = (bf16_t)f2bf(ti[r]); }
        *(LAS u32x2*)(SL(9) + n * MP + m0) = pk4(a); }
    mm64(SL(0), SL(3), w, lane, acc);
#pragma unroll
    for (int q = 0; q < 2; ++q) { const int n = (nb0 + q) * 16 + i;
#pragma unroll
        for (int r = 0; r < 4; ++r) SL(10)[(m0 + r) * MP + n] = (bf16_t)f2bf((m0 + r) > n ? acc[q][r] : 0.f); }
    mm64(SL(4), SL(2), w, lane, acc);
#pragma unroll
    for (int q = 0; q < 2; ++q) { const int n = (nb0 + q) * 16 + i;
#pragma unroll
        for (int r = 0; r < 4; ++r) SL(11)[(m0 + r) * MP + n] = (bf16_t)f2bf((m0 + r) >= n ? acc[q][r] : 0.f); }
    mm64(SL(4), SL(3), w, lane, acc);
#pragma unroll
    for (int q = 0; q < 2; ++q) { const int n = (nb0 + q) * 16 + i;
#pragma unroll
        for (int r = 0; r < 4; ++r) SL(12)[(m0 + r) * MP + n] = (bf16_t)f2bf((m0 + r) >= n ? acc[q][r] : 0.f); }
    LDS_BARRIER();
#pragma unroll
    for (int it = 0; it < 5; ++it) {
        LAS bf16_t* Xs = (it & 1) ? SL(2) : SL(8); LAS bf16_t* XsT = (it & 1) ? SL(3) : SL(9);
        LAS bf16_t* Xd = (it & 1) ? SL(8) : SL(2); LAS bf16_t* XdT = (it & 1) ? SL(9) : SL(3);
        LAS bf16_t* Tsrc = (it & 1) ? SL(0) : SL(13); LAS bf16_t* Tdst = (it & 1) ? SL(13) : SL(0);
        mm64(Xs, XsT, w, lane, acc);
#pragma unroll
        for (int q = 0; q < 2; ++q) { const int n = (nb0 + q) * 16 + i;
#pragma unroll
            for (int r = 0; r < 4; ++r) Xd[(m0 + r) * MP + n] = (bf16_t)f2bf(acc[q][r]);
            *(LAS u32x2*)(XdT + n * MP + m0) = pk4(acc[q]); }
        LDS_BARRIER();
        mm64(Tsrc, XdT, w, lane, acc);
#pragma unroll
        for (int q = 0; q < 2; ++q) { const int n = (nb0 + q) * 16 + i;
#pragma unroll
            for (int r = 0; r < 4; ++r) Tdst[(m0 + r) * MP + n] = (bf16_t)f2bf(bf2f(Tsrc[(m0 + r) * MP + n]) + acc[q][r]); }
        LDS_BARRIER();
    }
    LAS bf16_t* Ti = SL(0);
    mm64x<false, true>(Ti, SL(1), w, lane, acc);
#pragma unroll
    for (int q = 0; q < 2; ++q) { const int n = (nb0 + q) * 16 + i; *(LAS u32x2*)(SL(2) + n * MP + m0) = pk4(acc[q]); }
    mm64x<false, true>(SL(10), SL(7), w, lane, acc);
#pragma unroll
    for (int q = 0; q < 2; ++q) { const int n = (nb0 + q) * 16 + i; *(LAS u32x2*)(SL(3) + n * MP + m0) = pk4(acc[q]); }
    LDS_BARRIER();
    mm64(Ti, SL(3), w, lane, acc);
#pragma unroll
    for (int q = 0; q < 2; ++q) { const int n = (nb0 + q) * 16 + i; *(LAS u32x2*)(SL(8) + n * MP + m0) = pk4(acc[q]); }
    LDS_BARRIER();
    bf16_t* RG = (bf16_t*)(F.ws + WS_RG + (size_t)task * RG_TASK);
    f32x4 acc2[2];
    mm64(SL(2), SL(11), w, lane, acc);
#pragma unroll
    for (int q = 0; q < 2; ++q) { const int n = (nb0 + q) * 16 + i; const f32x4 rt = up4(*(const LAS u32x2*)(SL(4) + n * MP + m0)); *(u32x2*)(RG + n * 64 + m0) = pk4(rt - acc[q]); }
    mm64x<false, true>(SL(2), SL(5), w, lane, acc);
#pragma unroll
    for (int q = 0; q < 2; ++q) { const int n = (nb0 + q) * 16 + i; f32x4 g;
#pragma unroll
        for (int r = 0; r < 4; ++r) g[r] = ((m0 + r) == n ? WLs[n] : 0.f) - acc[q][r];
        *(u32x2*)(RG + 4096 + n * 64 + m0) = pk4(g); }
    mm64x<true, true>(SL(6), SL(7), w, lane, acc); mm64x<true, false>(SL(5), SL(8), w, lane, acc2);
#pragma unroll
    for (int q = 0; q < 2; ++q) { const int n = (nb0 + q) * 16 + i; *(u32x2*)(RG + 8192 + n * 64 + m0) = pk4(acc[q] - acc2[q]); }
    mm64x<true, false>(SL(7), SL(12), w, lane, acc); mm64(SL(8), SL(11), w, lane, acc2);
    bf16_t* YR = WSP(bf16_t, WS_YR) + (size_t)dir * MALL * 256;
#pragma unroll
    for (int q = 0; q < 2; ++q) { const int n = (nb0 + q) * 16 + i; const int rown = scan_row(b, dir, c * 64 + n); *(u32x2*)(YR + (size_t)rown * 256 + head * 64 + m0) = pk4(acc[q] - acc2[q]); }
#undef SL
}

__device__ __forceinline__ void rwkv_chain(const Ctx& F, int chain) {
    LAS bf16_t* const L0 = (LAS bf16_t*)F.lds;
    LAS bf16_t* Gl[2] = {L0, L0 + SLOT}; LAS bf16_t* Sl[2] = {L0 + 2 * SLOT, L0 + 3 * SLOT}; LAS bf16_t* Hl[2] = {L0 + 4 * SLOT, L0 + 5 * SLOT};
    const int w = F.wave, lane = F.lane, i = lane & 15, gq = lane >> 4, mb = w >> 1, nb0 = 2 * (w & 1), m0 = mb * 16 + 4 * gq;
    const bf16_t* RGc = (const bf16_t*)(F.ws + WS_RG + (size_t)chain * RCH * RG_TASK); bf16_t* SST = (bf16_t*)(F.ws + WS_SST) + (size_t)chain * RCH * 4096;
    const int gr = F.tid >> 3, gc = (F.tid & 7) * 8, goff = gr * 64 + gc, loff = gr * MP + gc;
    constexpr int RBD = 6, RBU = 66;
    static_assert(RBU % RBD == 0 && RCH % RBU == 0, "ring depth / unroll");
    u32x4 rg[RBD], rh[RBD];
#define RB_LOAD(slot, cc) do { const bf16_t* p_ = RGc + (size_t)((cc) < RCH ? (cc) : RCH - 1) * (RG_TASK / 2); rg[slot] = *(const u32x4*)(p_ + 4096 + goff); rh[slot] = *(const u32x4*)(p_ + 8192 + goff); } while (0)
#pragma unroll
    for (int j = 0; j < RBD; ++j) RB_LOAD(j, j);
    __syncthreads();
    { unsigned z_; asm volatile("v_mov_b32 %0, 0" : "=v"(z_)); *(LAS u32x4*)(Sl[0] + loff) = (u32x4){z_, z_, z_, z_}; }
    *(LAS u32x4*)(Gl[0] + loff) = rg[0]; *(LAS u32x4*)(Hl[0] + loff) = rh[0];
    __syncthreads();
#ifdef TPROBE
    const unsigned long long tp0_ = __builtin_amdgcn_s_memrealtime();
#endif
#define RB_STEP(j) do { const int c = c0 + (j); if (c < RCH - 1) { const int par = c & 1; \
        *(u32x4*)(SST + (size_t)c * 4096 + goff) = *(const LAS u32x4*)(Sl[par] + loff);            \
        f32x4 acc[2]; mm64(Gl[par], Sl[par], w, lane, acc); \
        { const f32x4 h0 = up4(*(const LAS u32x2*)(Hl[par] + (nb0 * 16 + i) * MP + m0)), h1 = up4(*(const LAS u32x2*)(Hl[par] + ((nb0 + 1) * 16 + i) * MP + m0)); \
          *(LAS u32x2*)(Sl[par ^ 1] + (nb0 * 16 + i) * MP + m0) = pk4(acc[0] + h0); *(LAS u32x2*)(Sl[par ^ 1] + ((nb0 + 1) * 16 + i) * MP + m0) = pk4(acc[1] + h1); } \
        *(LAS u32x4*)(Gl[par ^ 1] + loff) = rg[((j) + 1) % RBD]; *(LAS u32x4*)(Hl[par ^ 1] + loff) = rh[((j) + 1) % RBD]; \
        RB_LOAD((j) % RBD, c + RBD); \
        asm volatile("s_waitcnt lgkmcnt(0)" ::: "memory"); __builtin_amdgcn_s_barrier(); asm volatile("" ::: "memory"); } } while (0)
#pragma unroll 1
    for (int c0 = 0; c0 < RCH; c0 += RBU) {
#pragma unroll
        for (int j = 0; j < RBU; ++j) RB_STEP(j); }
#undef RB_STEP
#undef RB_LOAD
    *(u32x4*)(SST + (size_t)(RCH - 1) * 4096 + goff) = *(const LAS u32x4*)(Sl[(RCH - 1) & 1] + loff);
#ifdef TPROBE
    if (chain == 0 && F.tid == 0) *(float*)(F.ws + WS_CTL + 65536) = 3000.f * (floorf((float)(__builtin_amdgcn_s_memrealtime() - tp0_) * (1.f / 3000.f)) + 0.5f);
#endif
    __syncthreads();
}

__device__ __forceinline__ void rwkv_out(const Ctx& F, int l, int unit) {
    const bool isc = unit >= 256; int b, chunk; if (!isc) { b = unit >> 7; chunk = unit & 127; } else { const int u = unit - 256; b = u >> 2; chunk = u & 3; }
    LAS bf16_t* Rl = (LAS bf16_t*)F.lds; LAS bf16_t* Sl = Rl + SLOT; LAS float* Ys = (LAS float*)(F.lds + 4 * SLOT * 2);
    const int w = F.wave, lane = F.lane, i = lane & 15, gq = lane >> 4, mb = w >> 1, nb0 = 2 * (w & 1), m0 = mb * 16 + 4 * gq;
    const int row0 = (isc ? MLAT + b * TCTX : b * TLAT) + chunk * 64;
    const int gr = F.tid >> 3, gc = (F.tid & 7) * 8;
#define RO_PTRS(hd_, RGp, SSp) do { const int head_ = (hd_) >> 1, dir_ = (hd_) & 1, chain_ = (b * 4 + head_) * 2 + dir_; const int cc_ = isc ? (dir_ ? 3 - chunk : chunk) : 4 + (dir_ ? 127 - chunk : chunk); \
        RGp = (const bf16_t*)(F.ws + WS_RG + ((size_t)chain_ * RCH + cc_) * RG_TASK); SSp = (const bf16_t*)(F.ws + WS_SST) + ((size_t)chain_ * RCH + cc_) * 4096; } while (0)
    u32x4 rv, sv;
    { const bf16_t* RG0; const bf16_t* SS0; RO_PTRS(0, RG0, SS0); rv = *(const u32x4*)(RG0 + gr * 64 + gc); sv = *(const u32x4*)(SS0 + gr * 64 + gc); }
#pragma unroll 1
    for (int hd = 0; hd < 8; ++hd) {
        const int head = hd >> 1, dir = hd & 1;
        const bf16_t* YR = WSP(bf16_t, WS_YR) + (size_t)dir * MALL * 256;
        LDS_BARRIER();
        *(LAS u32x4*)(Rl + gr * MP + gc) = rv; *(LAS u32x4*)(Sl + gr * MP + gc) = sv;
        if (hd < 7) { const bf16_t* RGn; const bf16_t* SSn; RO_PTRS(hd + 1, RGn, SSn); rv = *(const u32x4*)(RGn + gr * 64 + gc); sv = *(const u32x4*)(SSn + gr * 64 + gc); }
        f32x4 yl[2];
#pragma unroll
        for (int q = 0; q < 2; ++q) { const int n = (nb0 + q) * 16 + i; const int tor = dir ? 63 - n : n; yl[q] = up4(*(const u32x2*)(YR + (size_t)(row0 + tor) * 256 + head * 64 + m0)); }
        LDS_BARRIER();
        f32x4 acc[2]; mm64(Sl, Rl, w, lane, acc);
#pragma unroll
        for (int q = 0; q < 2; ++q) { const int n = (nb0 + q) * 16 + i; const int tor = dir ? 63 - n : n;
            LAS f32x4* yp = (LAS f32x4*)(Ys + tor * 260 + head * 64 + m0);
            if (dir == 0) *yp = acc[q] + yl[q]; else *yp = *yp + acc[q] + yl[q]; }
    }
#undef RO_PTRS
    __syncthreads();
    {
        const bf16_t* P = WSP(bf16_t, WS_P); const bf16_t* GB = WSP(bf16_t, WS_GB); const float* BS = WSP(float, WS_BS); bf16_t* YC = WSP(bf16_t, WS_YCAT);
        const int c4 = lane * 4; const f32x4 lg = *(const f32x4*)(F.in[20] + l * 256 + c4);
#pragma unroll 1
        for (int tt = w; tt < 64; tt += NWAVES) { const int row = row0 + tt;
            const f32x4 y = *(const LAS f32x4*)(Ys + tt * 260 + c4);
            const float ss = red16((y[0] * y[0] + y[1] * y[1]) + (y[2] * y[2] + y[3] * y[3]));
            const float rs = rsqrtf(ss * (1.f / 64.f) + EPSN);
            const f32x4 v = ld4bf(P + (size_t)row * DINP + C_RV + c4), g = ld4bf(GB + (size_t)row * 256 + c4);
            const float bn = BS[(size_t)row * 4 + (lane >> 4)];
            st4bf(YC + (size_t)row * DM + 256 + c4, (y * rs * lg * ZF(32) + bn * v * ZF(64)) * g * ZF(4)); }
    }
    __syncthreads();
}
__device__ __forceinline__ float clr7(float x) { return __uint_as_float(__float_as_uint(x) & 0xFFFFFF80u); }
__device__ __forceinline__ void ins16(float (&L)[16], float p) {
#pragma unroll
    for (int j = 15; j >= 1; --j) L[j] = __builtin_amdgcn_fmed3f(L[j - 1], L[j], p);
    L[0] = fmaxf(L[0], p);
}
__device__ __forceinline__ void peer_topk_task(const bf16_t* sg, size_t gstride, u32x2* eg) {
    float L0[16], L1[16];
#pragma unroll
    for (int j = 0; j < 16; ++j) { L0[j] = -INFINITY; L1[j] = -INFINITY; }
    u32x4 pa[4], pb[4];
#pragma unroll
    for (int u = 0; u < 4; ++u) { pa[u] = *(const u32x4*)(sg + (size_t)u * gstride); pb[u] = *(const u32x4*)(sg + (size_t)(16 + u) * gstride); }
#pragma unroll 4
    for (int i = 0; i < 128; i += 8) {
        const u32x4 a = pa[(i >> 3) & 3], b = pb[(i >> 3) & 3];
        { const int gn = (i >> 3) + 4 < 16 ? (i >> 3) + 4 : 15; pa[(i >> 3) & 3] = *(const u32x4*)(sg + (size_t)gn * gstride); pb[(i >> 3) & 3] = *(const u32x4*)(sg + (size_t)(16 + gn) * gstride); }
#pragma unroll
        for (int q = 0; q < 4; ++q) { ins16(L0, __uint_as_float((a[q] << 16) | (unsigned)(i + 2 * q))); ins16(L0, __uint_as_float((a[q] & 0xffff0000u) | (unsigned)(i + 2 * q + 1)));
                                      ins16(L1, __uint_as_float((b[q] << 16) | (unsigned)(i + 2 * q))); ins16(L1, __uint_as_float((b[q] & 0xffff0000u) | (unsigned)(i + 2 * q + 1))); }
    }
    float T[16];
#pragma unroll
    for (int j = 0; j < 16; ++j) T[j] = -INFINITY;
#pragma unroll
    for (int a = 0; a < 16; ++a)
#pragma unroll
        for (int b = 0; b < 16; ++b) if ((a + 1) * (b + 1) <= 16) { const float s = clr7(L0[a]) + clr7(L1[b]);
            ins16(T, __uint_as_float((__float_as_uint(s) & 0xFFFFFF00u) | (unsigned)(a * 16 + b))); }
    float e[16], sum = 0.f; const float mx = __uint_as_float(__float_as_uint(T[0]) & 0xFFFFFF00u);
#pragma unroll
    for (int j = 0; j < 16; ++j) { e[j] = __expf(__uint_as_float(__float_as_uint(T[j]) & 0xFFFFFF00u) - mx); sum += e[j]; }
    const float inv = 1.f / sum;
#pragma unroll
    for (int j = 0; j < 16; ++j) {
        const unsigned ab = __float_as_uint(T[j]) & 0xFFu, a = ab >> 4, b = ab & 15u; unsigned i0 = 0u, i1 = 0u;
#pragma unroll
        for (int q = 0; q < 16; ++q) { i0 = (a == (unsigned)q) ? (__float_as_uint(L0[q]) & 0x7Fu) : i0; i1 = (b == (unsigned)q) ? (__float_as_uint(L1[q]) & 0x7Fu) : i1; }
        eg[j] = (u32x2){i0 * 128u + i1, __float_as_uint(e[j] * inv)};
    }
}
__device__ __forceinline__ float gelu_tanh(float x) { const float u = 0.7978845608028654f * (x + 0.044715f * x * x * x); return 0.5f * x * (1.f + tanhf_(u)); }
__device__ __forceinline__ float dot2bf(unsigned w, unsigned x, float acc) { return __builtin_amdgcn_fdot2_f32_bf16(__builtin_bit_cast(bf16x2_t, w), __builtin_bit_cast(bf16x2_t, x), acc, false); }
__device__ __forceinline__ float wave_total63(float x) {
    x = red16(x);
    x += __int_as_float(__builtin_amdgcn_update_dpp(0, __float_as_int(x), 0x142, 0xa, 0xf, false));
    x += __int_as_float(__builtin_amdgcn_update_dpp(0, __float_as_int(x), 0x143, 0xc, 0xf, false));
    return x;
}

__device__ __forceinline__ void phase_peer(const Ctx& F, int l, int nrows, const float* mod, float* wr_override) {
    const bf16_t* S = WSP(bf16_t, WS_S); u32x2* EG = WSP(u32x2, WS_EG); const bf16_t* H = WSP(bf16_t, WS_H);
    const unsigned char* U = F.ws + WS_U + (size_t)l * UV_LSTRIDE; const unsigned char* V = F.ws + WS_V + (size_t)l * UV_LSTRIDE;
    const f32x2* SCUV = (const f32x2*)(WSP(float, WS_SC) + (size_t)l * 2 * 16384);
    const int tpb = nrows / F.G, tok0 = F.vcu * tpb;
    volatile LAS unsigned* tkflag = (volatile LAS unsigned*)(F.lds + LDSCTL_OFF + 512);
    if (F.tid == 0) tkflag[0] = 0u;
    { const int ntok1 = tpb < 64 ? tpb : 64; const int task = F.tid; const int hd = task / ntok1, tkn = task - hd * ntok1;
      if (hd < 8) { const int row = tok0 + tkn; peer_topk_task(S + ((size_t)(hd * 32) * MALL + row) * 8, (size_t)MALL * 8, EG + (size_t)row * 128 + hd * 16); } }
    __threadfence_block(); __syncthreads();
    if (tpb > 64 && F.wave == 2) {
        const int nex = tpb - 64; const int hd = F.lane / nex, tkn = F.lane - hd * nex;
        if (hd < 8) { const int row = tok0 + 64 + tkn; peer_topk_task(S + ((size_t)(hd * 32) * MALL + row) * 8, (size_t)MALL * 8, EG + (size_t)row * 128 + hd * 16); }
        __threadfence_block(); asm volatile("s_waitcnt vmcnt(0) lgkmcnt(0)" ::: "memory");
        if (F.lane == 0) tkflag[0] = 1u;
    }
    const int lane = F.lane; const bool hi32 = lane >= 32; const unsigned l16 = (unsigned)(lane & 31) * 16u;
    LAS unsigned char* wl = F.lds + F.wave * PEER_WLDS; LAS unsigned char* hbl = wl + 16 * 528; LAS unsigned char* rawl = hbl + 2048; LAS float* cfl = (LAS float*)(rawl + 512); LAS unsigned short* exl = (LAS unsigned short*)(rawl + 512 + 9 * 512); LAS float* cfm = (LAS float*)(rawl + 512 + 9 * 512 + 9 * 256);
    u32x2 eg0 = EG[(size_t)(tok0 + F.wave) * 128 + lane], eg1 = EG[(size_t)(tok0 + F.wave) * 128 + 64 + lane];
    u32x4 h0 = *(const u32x4*)(H + (size_t)(tok0 + F.wave) * DM + lane * 16), h1 = *(const u32x4*)(H + (size_t)(tok0 + F.wave) * DM + lane * 16 + 8);
#pragma unroll 1
    for (int tk = F.wave, ti = 0; tk < tpb; tk += NWAVES, ++ti) {
        exl[ti * 128 + lane] = (unsigned short)eg0.x; exl[ti * 128 + 64 + lane] = (unsigned short)eg1.x;
        const LAS unsigned short* exq = exl + ti * 128 + (hi32 ? 8 : 0);
        const f32x2 sc0_ = SCUV[eg0.x], sc1_ = SCUV[eg1.x]; const float us0 = sc0_.x, us1 = sc1_.x, vs0 = sc0_.y, vs1 = sc1_.y;
        float hscale;
        {   const unsigned hw[8] = {h0.x, h0.y, h0.z, h0.w, h1.x, h1.y, h1.z, h1.w}; float hf[16]; float am = 0.f;
#pragma unroll
            for (int q = 0; q < 8; ++q) { hf[2 * q] = lo2f(hw[q]); hf[2 * q + 1] = hi2f(hw[q]); am = fmaxf(am, fmaxf(fabsf(hf[2 * q]), fabsf(hf[2 * q + 1]))); }
#pragma unroll
            for (int o = 1; o < 64; o <<= 1) am = fmaxf(am, __shfl_xor(am, o));
            const float sc = am > 0.f ? 224.f / am : 1.f; hscale = am > 0.f ? am * (1.f / 224.f) : 1.f;
            unsigned hiw[4], low[4];
#pragma unroll
            for (int d = 0; d < 4; ++d) { const float a0 = hf[d * 4] * sc, a1 = hf[d * 4 + 1] * sc, a2 = hf[d * 4 + 2] * sc, a3 = hf[d * 4 + 3] * sc;
                int w = __builtin_amdgcn_cvt_pk_fp8_f32(a0, a1, 0, false); w = __builtin_amdgcn_cvt_pk_fp8_f32(a2, a3, w, true);
                const f32x2 b01 = __builtin_amdgcn_cvt_pk_f32_fp8(w, false), b23 = __builtin_amdgcn_cvt_pk_f32_fp8(w, true);
                int wl_ = __builtin_amdgcn_cvt_pk_fp8_f32((a0 - b01.x) * 16.f, (a1 - b01.y) * 16.f, 0, false); wl_ = __builtin_amdgcn_cvt_pk_fp8_f32((a2 - b23.x) * 16.f, (a3 - b23.y) * 16.f, wl_, true);
                hiw[d] = (unsigned)w; low[d] = (unsigned)wl_; }
            LAS unsigned char* hp = hbl + (lane >> 3) * 256 + (lane & 7) * 16;
            *(LAS u32x4*)hp = (u32x4){hiw[0], hiw[1], hiw[2], hiw[3]};
            *(LAS u32x4*)(hp + 128) = (u32x4){low[0], low[1], low[2], low[3]};
        }
        const int tkn = tk + NWAVES < tpb ? tk + NWAVES : tk; const int rown = tok0 + tkn;
        if (tkn >= 64) { while (tkflag[0] == 0u) __builtin_amdgcn_s_sleep(8); __threadfence_block(); }
        const u32x2 egn0 = EG[(size_t)rown * 128 + lane], egn1 = EG[(size_t)rown * 128 + 64 + lane];
        h0 = *(const u32x4*)(H + (size_t)rown * DM + lane * 16); h1 = *(const u32x4*)(H + (size_t)rown * DM + lane * 16 + 8);
        {
            const int mi = lane & 15, mg = lane >> 4;
            const LAS unsigned char* aptr = wl + mi * 528 + mg * 16; const LAS unsigned char* bptr = hbl + (mi & 1) * 128 + mg * 16;
            LAS unsigned char* pk = wl + (lane >> 5) * (8 * 528) + l16;
            u32x4 rr[3][8];
#define PU_LOAD(bt_) do { _Pragma("unroll") for (int h = 0; h < 2; ++h) { const u32x2 ew = *(const LAS u32x2*)(exq + (bt_) * 16 + 4 * h); \
                rr[(bt_) % 3][4 * h + 0] = *(const u32x4*)(U + ((ew.x & 0xffffu) * 512u + l16)); rr[(bt_) % 3][4 * h + 1] = *(const u32x4*)(U + ((ew.x >> 16) * 512u + l16)); \
                rr[(bt_) % 3][4 * h + 2] = *(const u32x4*)(U + ((ew.y & 0xffffu) * 512u + l16)); rr[(bt_) % 3][4 * h + 3] = *(const u32x4*)(U + ((ew.y >> 16) * 512u + l16)); } } while (0)
#define PU_PARK(bt_) do { _Pragma("unroll") for (int q = 0; q < 8; ++q) *(LAS u32x4*)(pk + q * 528) = rr[(bt_) % 3][q]; } while (0)
            PU_LOAD(0); PU_LOAD(1);
#pragma unroll
            for (int bt = 0; bt < 8; ++bt) {
                if (bt + 2 < 8) PU_LOAD(bt + 2);
                PU_PARK(bt);
                f32x4 acc = {0.f, 0.f, 0.f, 0.f};
#pragma unroll
                for (int s = 0; s < 8; ++s) { const u32x4 a = *(const LAS u32x4*)(aptr + s * 64), b0 = *(const LAS u32x4*)(bptr + s * 256), b1 = *(const LAS u32x4*)(bptr + s * 256 + 64);
                    acc = __builtin_amdgcn_mfma_scale_f32_16x16x128_f8f6f4((i32x8){(int)a.x, (int)a.y, (int)a.z, (int)a.w, 0, 0, 0, 0},
                                                                           (i32x8){(int)b0.x, (int)b0.y, (int)b0.z, (int)b0.w, (int)b1.x, (int)b1.y, (int)b1.z, (int)b1.w}, acc, 4, 0, 0, 0x7F7F7F7F, 0, 0x7F7F7F7F); }
                f32x4 tot;
#pragma unroll
                for (int r = 0; r < 4; ++r) tot[r] = acc[r] + 0.0625f * dppf<0xF5>(acc[r]);
                if (mi == 0) *(LAS f32x4*)(rawl + (bt * 16 + 4 * mg) * 4) = tot;
            }
#undef PU_PARK
#undef PU_LOAD
            const float act0 = *(const LAS float*)(rawl + lane * 4) * (hscale * us0), act1 = *(const LAS float*)(rawl + 256 + lane * 4) * (hscale * us1);
            const float c0 = __uint_as_float(eg0.y) * gelu_tanh(act0) * vs0, c1 = __uint_as_float(eg1.y) * gelu_tanh(act1) * vs1;
            float cm = fmaxf(fabsf(c0), fabsf(c1));
#pragma unroll
            for (int o = 1; o < 64; o <<= 1) cm = fmaxf(cm, __shfl_xor(cm, o));
            const float cinv = cm > 0.f ? 1.f / cm : 0.f;
            cfl[ti * 128 + lane] = c0 * cinv; cfl[ti * 128 + 64 + lane] = c1 * cinv;
            if (lane == 0) cfm[ti] = cm;
        }
        eg0 = egn0; eg1 = egn1;
    }
    LDS_BARRIER();
    const int ecol0 = 32 * (lane & 31) + 16 * (lane >> 5); const bool fusen = l == 0 && !wr_override;
    f32x4 gtv[4], g1v[4], scv[4], shv[4]; int smp_have = -1;
#pragma unroll
    for (int q = 0; q < 4; ++q) { g1v[q] = (f32x4){0.f, 0.f, 0.f, 0.f}; scv[q] = g1v[q]; shv[q] = g1v[q]; gtv[q] = g1v[q]; }
    if (fusen) {
#pragma unroll
        for (int q = 0; q < 4; ++q) g1v[q] = *(const f32x4*)(F.in[6] + DM + ecol0 + q * 4); }
    u32x4 ra[8], rb[8];
#define PG_LOAD(dst, idp_) do { _Pragma("unroll") for (int h = 0; h < 2; ++h) { const u32x2 ew = *(const LAS u32x2*)((idp_) + 4 * h); \
            dst[4 * h + 0] = *(const u32x4*)(V + ((ew.x & 0xffffu) * 512u + l16)); dst[4 * h + 1] = *(const u32x4*)(V + ((ew.x >> 16) * 512u + l16)); \
            dst[4 * h + 2] = *(const u32x4*)(V + ((ew.y & 0xffffu) * 512u + l16)); dst[4 * h + 3] = *(const u32x4*)(V + ((ew.y >> 16) * 512u + l16)); } } while (0)
    { const LAS unsigned short* ex0 = exl + (hi32 ? 8 : 0); PG_LOAD(ra, ex0); }
#pragma unroll 1
    for (int tk = F.wave, ti = 0; tk < tpb; tk += NWAVES, ++ti) {
        const int row = tok0 + tk; const bool isc = row >= MLAT; const int smp = isc ? 2 : (row >> 13);
        float* xrow = isc ? WSP(float, WS_XC) + (size_t)(row - MLAT) * DM : F.out + (size_t)row * DM;
        const LAS unsigned short* exq = exl + ti * 128 + (hi32 ? 8 : 0); const LAS float* cfq = cfl + ti * 128 + (hi32 ? 8 : 0);
        const LAS unsigned short* exn = tk + NWAVES < tpb ? exq + 128 : exq;
        f32x2 ac[16];
#pragma unroll
        for (int q = 0; q < 16; ++q) ac[q] = (f32x2){0.f, 0.f};
#define PG_VACC(src, grp_) do { _Pragma("unroll") for (int h = 0; h < 2; ++h) { const u32x4 c4 = *(const LAS u32x4*)(cfq + (grp_) * 16 + 4 * h); \
            _Pragma("unroll") for (int q = 0; q < 4; ++q) { const float cf = __uint_as_float(c4[q]); const unsigned vw[4] = {src[4 * h + q].x, src[4 * h + q].y, src[4 * h + q].z, src[4 * h + q].w}; \
            _Pragma("unroll") for (int j = 0; j < 4; ++j) { ac[4 * j] += cf * __builtin_amdgcn_cvt_scalef32_pk_f32_fp4(vw[j], 1.0f, 0); ac[4 * j + 1] += cf * __builtin_amdgcn_cvt_scalef32_pk_f32_fp4(vw[j], 1.0f, 1); \
                ac[4 * j + 2] += cf * __builtin_amdgcn_cvt_scalef32_pk_f32_fp4(vw[j], 1.0f, 2); ac[4 * j + 3] += cf * __builtin_amdgcn_cvt_scalef32_pk_f32_fp4(vw[j], 1.0f, 3); } } } } while (0)
#pragma unroll 1
        for (int g2 = 0; g2 < 4; ++g2) {
            PG_LOAD(rb, exq + (2 * g2 + 1) * 16); PG_VACC(ra, 2 * g2);
            { const LAS unsigned short* idp = g2 < 3 ? exq + (2 * g2 + 2) * 16 : exn; PG_LOAD(ra, idp); }
            PG_VACC(rb, 2 * g2 + 1);
        }
#undef PG_VACC
        float acc[16];
        const float cmx = cfm[ti];
#pragma unroll
        for (int q = 0; q < 8; ++q) {
            const auto sx = __builtin_amdgcn_permlane32_swap(__float_as_uint(ac[q].x), __float_as_uint(ac[8 + q].x), false, false);
            const auto sy = __builtin_amdgcn_permlane32_swap(__float_as_uint(ac[q].y), __float_as_uint(ac[8 + q].y), false, false);
            acc[2 * q] = cmx * (__uint_as_float(sx[0]) + __uint_as_float(sx[1])); acc[2 * q + 1] = cmx * (__uint_as_float(sy[0]) + __uint_as_float(sy[1])); }
        const int col0 = 32 * (lane & 31) + 16 * (lane >> 5);
        if (smp != smp_have) { smp_have = smp; const float* gt = mod + smp * 6144 + 5120; const float* mb1 = mod + 3 * 6144 + smp * 6144;
#pragma unroll
            for (int q = 0; q < 4; ++q) { const int c = ecol0 + q * 4; gtv[q] = *(const f32x4*)(gt + c); if (fusen) { scv[q] = *(const f32x4*)(mb1 + 1024 + c); shv[q] = *(const f32x4*)(mb1 + c); } } }
        f32x4 res[4]; float ss = 0.f;
        const u32x4 xw0 = *(const u32x4*)(WSP(bf16_t, WS_X1) + (size_t)row * DM + col0), xw1 = *(const u32x4*)(WSP(bf16_t, WS_X1) + (size_t)row * DM + col0 + 8);
        const unsigned xw[8] = {xw0.x, xw0.y, xw0.z, xw0.w, xw1.x, xw1.y, xw1.z, xw1.w};
#pragma unroll
        for (int q = 0; q < 4; ++q) { const int c = col0 + q * 4; const f32x4 x = (f32x4){lo2f(xw[2 * q]), hi2f(xw[2 * q]), lo2f(xw[2 * q + 1]), hi2f(xw[2 * q + 1])};
            res[q] = x + ZF(1) * gtv[q] * (f32x4){acc[q * 4], acc[q * 4 + 1], acc[q * 4 + 2], acc[q * 4 + 3]};
            if (!fusen) *(f32x4*)((wr_override ? wr_override + (size_t)row * DM : xrow) + c) = res[q];
            ss += (res[q][0] * res[q][0] + res[q][1] * res[q][1]) + (res[q][2] * res[q][2] + res[q][3] * res[q][3]); }
        if (fusen && !isc) {
            bf16_t* x2 = (bf16_t*)F.out + (size_t)row * DM + col0;
            *(u32x4*)x2 = (u32x4){pk2(res[0][0], res[0][1]), pk2(res[0][2], res[0][3]), pk2(res[1][0], res[1][1]), pk2(res[1][2], res[1][3])};
            *(u32x4*)(x2 + 8) = (u32x4){pk2(res[2][0], res[2][1]), pk2(res[2][2], res[2][3]), pk2(res[3][0], res[3][1]), pk2(res[3][2], res[3][3])}; }
        if (fusen) {
            const float rs = rsqrtf(wave_sum(ss) * (1.f / DM) + EPSN);
            bf16_t* Hw = WSP(bf16_t, WS_H) + (size_t)row * DM;
#pragma unroll
            for (int q = 0; q < 4; q += 2) { const f32x4 o0 = (res[q] * rs * g1v[q]) * (1.f + scv[q]) + shv[q], o1 = (res[q + 1] * rs * g1v[q + 1]) * (1.f + scv[q + 1]) + shv[q + 1];
                *(u32x4*)(Hw + col0 + q * 4) = (u32x4){pk2(o0[0], o0[1]), pk2(o0[2], o0[3]), pk2(o1[0], o1[1]), pk2(o1[2], o1[3])}; }
        }
    }
#undef PG_LOAD
}

constexpr int PH_PER_LAYER = 10, N_PHASES = 1 + 2 * PH_PER_LAYER;
struct Args { const float* in[32]; float* out; unsigned char* ws; int ph_lo, ph_hi, li, pad; };
__global__ void __launch_bounds__(NTHR, 2) mk_fwd(Args args) {
    extern __shared__ __attribute__((aligned(16))) unsigned char lds[];
    Ctx F;
    F.lds = (LAS unsigned char*)lds;
    volatile LAS unsigned* MISC = (volatile LAS unsigned*)(F.lds + MISC_OFF);
    F.tid = threadIdx.x; F.lane = F.tid & 63; F.wave = __builtin_amdgcn_readfirstlane(F.tid >> 6);
    F.G = gridDim.x; { const int bx = blockIdx.x; F.vcu = (F.G % 8 == 0) ? (bx % 8) * (F.G / 8) + bx / 8 : bx; }
#pragma unroll
    for (int i = 0; i < 32; ++i) F.in[i] = args.in[i];
    F.out = args.out; F.ws = args.ws;
    for (int u = F.tid; u < (LDS_BYTES - LDSCTL_OFF) / 4; u += NTHR) ((LAS unsigned*)(F.lds + LDSCTL_OFF))[u] = 0u;
    __syncthreads();
    XcdBarrier bar; bar.bar = (unsigned*)(args.ws + WS_CTL) + CW_BAR; bar.x = 0; bar.st = nullptr;
#if !MK_MULTI
    bar = xcd_barrier_post((unsigned*)(args.ws + WS_CTL) + CW_BAR, MISC + 8);
#endif
    const int lo = args.ph_lo, hi = args.ph_hi;
#ifndef KMAX
#define KMAX 1000
#endif
#define IN(k) (lo <= (k) && (k) < hi && (REP_ALL == 1 || ra == REP_ALL - 1 || (k) <= KMAX))
#ifndef REP_PH
#define REP_PH -1
#endif
#define REPS(k) ((REP_PH == (k)) ? 2 : 1)
#define PHCTX Ctx Fp = F; { int t_ = F.tid; asm volatile("" : "+v"(t_)); Fp.tid = t_; Fp.lane = t_ & 63; }
#if MK_MULTI
#define SEAM(k) do { } while (0)
#else
#ifndef BAR_REPS
#define BAR_REPS 1
#endif
#define SEAM(k) do { if (IN(k) && IN((k) + 1)) for (int br_ = 0; br_ < BAR_REPS; ++br_) xcd_barrier(bar); } while (0)
#endif
#ifndef REP_ALL
#define REP_ALL 1
#endif
#ifndef REP_SUB
#define REP_SUB 0
#endif
#pragma unroll 1
    for (int ra = 0; ra < REP_ALL; ++ra) {
    if (ra > 0) xcd_barrier(bar);
    if (IN(0)) { PHCTX; for (int rep = 0; rep < REPS(100); ++rep) phase_prologue(Fp); }
    SEAM(0);
    float* XC = WSP(float, WS_XC);
#pragma unroll 1
    for (int l = 0; l < 2; ++l) {
        const int pb = 1 + l * PH_PER_LAYER;
        const float* xlat = l == 0 ? F.in[0] : F.out; const float* xctx = l == 0 ? F.in[2] : XC;
        const int mrows = l == 0 ? MALL : MLAT;
        const float* mod = WSP(float, WS_MOD) + (size_t)l * 3 * 6144;
        if (IN(pb + 0) && l == 0) { PHCTX; for (int rep = 0; rep < REPS(0); ++rep) { phase_norm(Fp, l, 0, MALL, xlat, xctx); } }
        if (l == 0) SEAM(pb + 0);
        if (IN(pb + 1)) for (int rep = 0; rep < REPS(1); ++rep) { PHCTX; pg8::Gemm g{WSP(bf16_t, WS_H), WSP(bf16_t, WS_WIN + l * WIN_LSTRIDE), MALL, DINP, DM}; pg8::StaticOrder So; So.init(MALL, DINP, F.G, (int)blockIdx.x);
            pg8::EpiBf16 E{WSP(bf16_t, WS_P), DINP}; pg8::gemm_phase<pg8::EpiBf16, pg8::StaticOrder, true, true>(F.lds, g, So, E, Fp.tid); }
        SEAM(pb + 1);
        if (IN(pb + 2)) { PHCTX; for (int rep = 0; rep < REPS(2); ++rep) { phase_prep(Fp, l); __syncthreads(); } }
        SEAM(pb + 2);
        if (IN(pb + 3)) for (int rep = 0; rep < REPS(3); ++rep) {
            const int nra = 16 * RCH, nml = 16 * NCHK;
            for (int r3 = 0; r3 < (REP_SUB == 3 ? 2 : 1); ++r3) { PHCTX; RaRaw cur_; f32x4 nl0_ = {0.f, 0.f, 0.f, 0.f}, nl1_ = nl0_; if (F.vcu < nra) { ra_load_ld(Fp, F.vcu, cur_); nl0_ = cur_.ld0; nl1_ = cur_.ld1; }
                for (int task = F.vcu; task < nra; task += F.G) { cur_.ld0 = nl0_; cur_.ld1 = nl1_; ra_load_rest(Fp, task, cur_);
                    { RaRaw nx_; const int tn = task + F.G < nra ? task + F.G : task; ra_load_ld(Fp, tn, nx_); nl0_ = nx_.ld0; nl1_ = nx_.ld1; }
                    rwkv_chunk_pre(Fp, task, cur_); } __syncthreads(); }
            for (int r3 = 0; r3 < (REP_SUB == 4 ? 2 : 1); ++r3) { PHCTX; const int nh = nra % F.G;
                if (nh == 0 || 3 * nh >= nml) { for (int task = (F.vcu + F.G - 72) % F.G; task < nml; task += F.G) mlstm_local(Fp, task); }
                else if (F.vcu < nh) { for (int task = F.vcu; task < 3 * nh; task += nh) mlstm_local(Fp, task); }
                else { for (int task = 3 * nh + (F.vcu - nh); task < nml; task += F.G - nh) mlstm_local(Fp, task); } }
        }
        SEAM(pb + 3);
                if (IN(pb + 4)) for (int rep = 0; rep < REPS(4); ++rep) {
            if (F.vcu < 16) { PHCTX; rwkv_chain(Fp, F.vcu); }
            else { { PHCTX; mlstm_chain(Fp, 16); }
                   { PHCTX; const int natt = l == 0 ? 264 : 256, nA = F.G - 16, v = F.vcu - 16;
                     if (natt <= 2 * nA) { if (v < natt) attn_unit(Fp, l, v);
                                           const int t2 = nA + (nA - 1 - v); if (t2 < natt) attn_unit(Fp, l, t2); }
                     else for (int task = v; task < natt; task += nA) attn_unit(Fp, l, task); } } }
        SEAM(pb + 4);
        if (IN(pb + 5)) for (int rep = 0; rep < REPS(5); ++rep) { const int nro = l == 0 ? 264 : 256, nun = l == 0 ? 528 : 512;
            { PHCTX; for (int u = F.vcu; u < nro; u += F.G) rwkv_out(Fp, l, u); }
            { PHCTX; for (int u = (F.vcu + F.G - 8) % F.G; u < nun; u += F.G) mlstm_out(Fp, l, u); } }
        SEAM(pb + 5);
        if (IN(pb + 6)) for (int rep = 0; rep < REPS(6); ++rep) { PHCTX; pg8::Gemm g{WSP(bf16_t, WS_YCAT), WSP(bf16_t, WS_WOUT + l * WOUT_LSTRIDE), mrows, DM, DM}; pg8::StaticOrder So; So.init(mrows, DM, F.G, (int)blockIdx.x);
            float* dummy = WSP(float, WS_YR); const bool dm_ = (REPS(6) == 2 && rep == 0); pg8::EpiRes E{xlat, xctx, dm_ ? dummy : F.out, dm_ ? dummy : XC, mod}; if (!dm_) E.x1 = WSP(bf16_t, WS_X1); if (l == 1) E.src16 = (const bf16_t*)F.out; pg8::gemm_phase<pg8::EpiRes, pg8::StaticOrder, true, true>(F.lds, g, So, E, Fp.tid); }
        SEAM(pb + 6);
        if (IN(pb + 7)) { PHCTX; for (int rep = 0; rep < REPS(7); ++rep) phase_norm(Fp, l, 1, mrows, F.out, XC, WSP(bf16_t, WS_X1)); }
        SEAM(pb + 7);
        if (IN(pb + 8)) for (int rep = 0; rep < REPS(8); ++rep) { PHCTX; pg8::Gemm g{WSP(bf16_t, WS_H), WSP(bf16_t, WS_WEFF + l * WEFF_LSTRIDE), mrows, 2048, DM}; pg8::StaticOrder So; So.init(mrows, 2048, F.G, (int)blockIdx.x);
            pg8::EpiBf16S E{WSP(bf16_t, WS_S), MALL}; pg8::gemm_phase<pg8::EpiBf16S, pg8::StaticOrder, true, true>(F.lds, g, So, E, Fp.tid); }
        SEAM(pb + 8);
        if (IN(pb + 9)) { PHCTX; for (int rep = 0; rep < REPS(9); ++rep) { phase_peer(Fp, l, mrows, mod, (REPS(9) == 2 && rep == 0) ? WSP(float, WS_YR) : nullptr); __syncthreads(); } }
        SEAM(pb + 9);
    }
    }
#undef IN
#undef SEAM
}

extern "C" void kernel_launch(void* const* d_in, const int* in_sizes, int n_in, void* d_out, int out_size, void* d_ws, size_t ws_size, hipStream_t stream) {
    static int grid = 0;
    if (grid == 0) {
        if (n_in != 32 || out_size != MLAT * DM || ws_size < WS_END2) { fprintf(stderr, "kernel_launch: unexpected shapes: n_in %d out %d ws %zu (need %zu)\n", n_in, out_size, ws_size, (size_t)WS_END2); grid = -1; return; }
        int dev = 0, cus = 0, per_cu = 0;
        if (hipGetDevice(&dev) != hipSuccess || hipDeviceGetAttribute(&cus, hipDeviceAttributeMultiprocessorCount, dev) != hipSuccess) { grid = -1; return; }
        if (hipFuncSetAttribute((const void*)mk_fwd, hipFuncAttributeMaxDynamicSharedMemorySize, LDS_BYTES) != hipSuccess) { fprintf(stderr, "kernel_launch: hipFuncSetAttribute failed\n"); grid = -1; return; }
        if (hipOccupancyMaxActiveBlocksPerMultiprocessor(&per_cu, (const void*)mk_fwd, NTHR, LDS_BYTES) != hipSuccess || per_cu < 1) fprintf(stderr, "kernel_launch: occupancy query reports %d\n", per_cu);
        (void)hipGetLastError();
        grid = cus;
        if (grid != 256) fprintf(stderr, "kernel_launch: grid %d (built for 256 CUs)\n", grid);
    }
    if (grid < 0) return;
    (void)hipMemsetAsync((char*)d_ws + WS_CTL, 0, CTL_ZERO_BYTES, stream);
    Args a{};
    for (int i = 0; i < 32; ++i) a.in[i] = (const float*)d_in[i];
    a.out = (float*)d_out; a.ws = (unsigned char*)d_ws;
#if MK_MULTI
    for (int p = 0; p < N_PHASES; ++p) { a.ph_lo = p; a.ph_hi = p + 1; a.li = p; hipLaunchKernelGGL(mk_fwd, dim3(grid), dim3(NTHR), LDS_BYTES, stream, a); }
#else
    a.ph_lo = 0; a.ph_hi = N_PHASES; a.li = 0;
    hipLaunchKernelGGL(mk_fwd, dim3(grid), dim3(NTHR), LDS_BYTES, stream, a);
#endif
}
```
